# Optimizing an MI355X kernel written in HIP

```python
import math
import jax, jax.numpy as jnp
from jax import lax
import numpy as np

D_MODEL = 2048
BATCH = 1
SEQ = 8192
DEPTH = 2

HEAD_DIM = 128
N_GROUPS = 4
GROUP_WIDTH = D_MODEL // N_GROUPS
GROUP_HEADS = GROUP_WIDTH // HEAD_DIM
MIX_WIDTH = N_GROUPS * GROUP_WIDTH
ROPE_THETA = 500000.0
ROT_FRAC = 4
NORM_EPS = 1e-6
CONV_WIDTH = 31
SGU_CHUNK = 128
NSA_CMP_LEN = 32
NSA_CMP_STRIDE = 16
NSA_SEL_LEN = 64
NSA_SEL_TOP = 16
NSA_WINDOW = 512
NSA_N_BRANCH = 3
DSA_IDX_HEADS = 8
DSA_IDX_DIM = 64
DSA_TOPK_MAX = 256
PEER_HEADS = 8
PEER_NKEYS = 128
PEER_DKEY = 128
PEER_TOPK = 16
PEER_EXPERTS = PEER_NKEYS * PEER_NKEYS
Q_BLOCK = 128
NEG = -1e30

CONV_COLS = 2 * GROUP_WIDTH
SGU_COLS = 2 * GROUP_WIDTH
NSA_COLS = GROUP_WIDTH + 2 * NSA_N_BRANCH * HEAD_DIM + NSA_N_BRANCH * GROUP_HEADS
DSA_COLS = GROUP_WIDTH + 2 * HEAD_DIM + DSA_IDX_HEADS * DSA_IDX_DIM + DSA_IDX_DIM + DSA_IDX_HEADS
IN_COLS = CONV_COLS + SGU_COLS + NSA_COLS + DSA_COLS
IN_SPLITS = [CONV_COLS, CONV_COLS + SGU_COLS, CONV_COLS + SGU_COLS + NSA_COLS]
NSA_SPLITS = [GROUP_WIDTH, GROUP_WIDTH + 2 * NSA_N_BRANCH * HEAD_DIM]
DSA_SPLITS = [GROUP_WIDTH, GROUP_WIDTH + HEAD_DIM, GROUP_WIDTH + 2 * HEAD_DIM,
              GROUP_WIDTH + 2 * HEAD_DIM + DSA_IDX_HEADS * DSA_IDX_DIM,
              GROUP_WIDTH + 2 * HEAD_DIM + DSA_IDX_HEADS * DSA_IDX_DIM + DSA_IDX_DIM]

kernel_name = "hybrid_conv_sgu_nsa_dsa_peer"


def rms_norm(x, g):
    x32 = x.astype(jnp.float32)
    y = x32 * lax.rsqrt(jnp.mean(x32 * x32, axis=-1, keepdims=True) + NORM_EPS)
    return y.astype(x.dtype) * g


def layer_norm(x, g, b):
    x32 = x.astype(jnp.float32)
    mu = jnp.mean(x32, axis=-1, keepdims=True)
    var = jnp.mean(jnp.square(x32 - mu), axis=-1, keepdims=True)
    return ((x32 - mu) * lax.rsqrt(var + NORM_EPS)).astype(x.dtype) * g + b


def rope_tables(positions, rot_dim):
    half = rot_dim // 2
    inv = ROPE_THETA ** (-jnp.arange(half, dtype=jnp.float32) / half)
    ang = positions.astype(jnp.float32)[..., None] * inv
    return jnp.cos(ang), jnp.sin(ang)


def apply_rope(x, cos, sin):
    half = cos.shape[-1]
    if x.ndim == 4:
        cos, sin = cos[:, :, None], sin[:, :, None]
    c = cos.astype(x.dtype)
    s = sin.astype(x.dtype)
    x1 = x[..., :half]
    x2 = x[..., half:2 * half]
    return jnp.concatenate([x1 * c - x2 * s, x2 * c + x1 * s, x[..., 2 * half:]], axis=-1)


def masked_softmax(s, mask):
    p = jax.nn.softmax(jnp.where(mask, s.astype(jnp.float32), NEG), axis=-1)
    return p * mask


def to_blocks(a):
    b, t = a.shape[:2]
    return jnp.moveaxis(a.reshape((b, t // Q_BLOCK, Q_BLOCK) + a.shape[2:]), 1, 0)


def from_blocks(a):
    a = jnp.moveaxis(a, 0, 1)
    return a.reshape((a.shape[0], a.shape[1] * a.shape[2]) + a.shape[3:])


def conv_module(h, conv_w, conv_b, ln_g, ln_b):
    a, g = jnp.split(h, 2, axis=-1)
    z = a * jax.nn.sigmoid(g)
    z = lax.conv_general_dilated(z, conv_w[:, None, :], window_strides=(1,),
                                 padding=[(CONV_WIDTH - 1, 0)],
                                 dimension_numbers=('NWC', 'WIO', 'NWC'),
                                 feature_group_count=GROUP_WIDTH) + conv_b
    return jax.nn.silu(layer_norm(z, ln_g, ln_b))


def sgu_module(h, ln_g, ln_b, w_s, b_s):
    u, v = jnp.split(h, 2, axis=-1)
    v = layer_norm(v, ln_g, ln_b)
    b_, t = v.shape[:2]
    v = v.reshape(b_, t // SGU_CHUNK, SGU_CHUNK, GROUP_HEADS, HEAD_DIM)
    causal = jnp.tril(jnp.ones((SGU_CHUNK, SGU_CHUNK), dtype=bool))
    w = jnp.where(causal, w_s, 0.0)
    s = jnp.einsum('hij,bnjhd->bnihd', w, v) + b_s.T[None, None, :, :, None]
    return u * s.reshape(b_, t, GROUP_WIDTH)


def nsa_module(h, cos, sin, q_g, k_g, cmp_pos, cmp_w1, cmp_w2):
    b_, t = h.shape[:2]
    scale = HEAD_DIM ** -0.5
    q, kv, gates = jnp.split(h, NSA_SPLITS, axis=-1)
    q = rms_norm(q.reshape(b_, t, GROUP_HEADS, HEAD_DIM), q_g)
    k_cmp, v_cmp, k_slc, v_slc, k_win, v_win = jnp.split(kv, 2 * NSA_N_BRANCH, axis=-1)
    gates = jax.nn.sigmoid(gates.astype(jnp.float32)).astype(h.dtype)
    gates = gates.reshape(b_, t, GROUP_HEADS, NSA_N_BRANCH)
    t_pos = jnp.arange(t)

    n_cmp = (t - NSA_CMP_LEN) // NSA_CMP_STRIDE + 1
    cmp_start = jnp.arange(n_cmp) * NSA_CMP_STRIDE
    tok = cmp_start[:, None] + jnp.arange(NSA_CMP_LEN)[None, :]

    def compress(z, pos, w1, w2):
        blk = (z[:, tok] + pos).reshape(b_, n_cmp, NSA_CMP_LEN * HEAD_DIM)
        return jax.nn.gelu(blk @ w1) @ w2

    kc = rms_norm(compress(k_cmp, cmp_pos[0], cmp_w1[0], cmp_w2[0]), k_g[0])
    vc = compress(v_cmp, cmp_pos[1], cmp_w1[1], cmp_w2[1])
    cmp_mask = (cmp_start + NSA_CMP_LEN - 1)[None, :] <= t_pos[:, None]
    p_c = masked_softmax(jnp.einsum('bthd,bnd->bhtn', q, kc) * scale, cmp_mask)
    o_cmp = jnp.einsum('bhtn,bnd->bthd', p_c.astype(vc.dtype), vc)

    n_sel = t // NSA_SEL_LEN
    sel_start = jnp.arange(n_sel) * NSA_SEL_LEN
    overlap = ((cmp_start[:, None] < sel_start[None, :] + NSA_SEL_LEN)
               & (cmp_start[:, None] + NSA_CMP_LEN > sel_start[None, :])).astype(jnp.float32)
    imp = jnp.einsum('bhtn,nj->btj', p_c, overlap)
    cur = t_pos // NSA_SEL_LEN
    j = jnp.arange(n_sel)
    forced = (j[None] == 0) | (j[None] == cur[:, None]) | (j[None] == cur[:, None] - 1)
    future = j[None] > cur[:, None]
    imp = jnp.where(forced, jnp.inf, jnp.where(future, -jnp.inf, imp))
    n_top = min(NSA_SEL_TOP, n_sel)
    _, sel_idx = lax.top_k(imp, n_top)

    q_r = apply_rope(q, cos, sin)
    ks = apply_rope(rms_norm(k_slc, k_g[1]), cos, sin)
    kw = apply_rope(rms_norm(k_win, k_g[2]), cos, sin)
    ks_blk = ks.reshape(b_, n_sel, NSA_SEL_LEN, HEAD_DIM)
    vs_blk = v_slc.reshape(b_, n_sel, NSA_SEL_LEN, HEAD_DIM)
    kw_pad = jnp.pad(kw, ((0, 0), (NSA_WINDOW, 0), (0, 0)))
    vw_pad = jnp.pad(v_win, ((0, 0), (NSA_WINDOW, 0), (0, 0)))
    win_len = NSA_WINDOW + Q_BLOCK
    n_keys_sel = n_top * NSA_SEL_LEN

    def block_fn(args):
        qb, idx, bi = args
        tq = bi * Q_BLOCK + jnp.arange(Q_BLOCK)
        kg = jax.vmap(lambda kb, ib: kb[ib])(ks_blk, idx)
        vg = jax.vmap(lambda vb, ib: vb[ib])(vs_blk, idx)
        key_pos = idx[..., None] * NSA_SEL_LEN + jnp.arange(NSA_SEL_LEN)
        m = (key_pos <= tq[None, :, None, None]).reshape(b_, Q_BLOCK, 1, n_keys_sel)
        s = jnp.einsum('bqhd,bqnsd->bqhns', qb, kg).reshape(b_, Q_BLOCK, GROUP_HEADS, n_keys_sel) * scale
        p = masked_softmax(s, m)
        o_s = jnp.einsum('bqhk,bqkd->bqhd', p.astype(vg.dtype),
                         vg.reshape(b_, Q_BLOCK, n_keys_sel, HEAD_DIM))
        start = bi * Q_BLOCK
        kwb = lax.dynamic_slice_in_dim(kw_pad, start, win_len, axis=1)
        vwb = lax.dynamic_slice_in_dim(vw_pad, start, win_len, axis=1)
        kpos = start - NSA_WINDOW + jnp.arange(win_len)
        mw = ((kpos[None, :] <= tq[:, None]) & (kpos[None, :] > tq[:, None] - NSA_WINDOW)
              & (kpos[None, :] >= 0))
        pw = masked_softmax(jnp.einsum('bqhd,bkd->bqhk', qb, kwb) * scale, mw[None, :, None, :])
        o_w = jnp.einsum('bqhk,bkd->bqhd', pw.astype(vwb.dtype), vwb)
        return o_s, o_w

    o_s, o_w = lax.map(block_fn, (to_blocks(q_r), to_blocks(sel_idx), jnp.arange(t // Q_BLOCK)))
    o = (gates[..., 0:1] * o_cmp + gates[..., 1:2] * from_blocks(o_s)
         + gates[..., 2:3] * from_blocks(o_w))
    return o.reshape(b_, t, GROUP_WIDTH)


def dsa_module(h, cos, sin, cos_i, sin_i, q_g, k_g):
    b_, t = h.shape[:2]
    scale = HEAD_DIM ** -0.5
    q, k, v, iq, ik, iw = jnp.split(h, DSA_SPLITS, axis=-1)
    q = apply_rope(rms_norm(q.reshape(b_, t, GROUP_HEADS, HEAD_DIM), q_g), cos, sin)
    k = apply_rope(rms_norm(k, k_g), cos, sin)
    iq = apply_rope(iq.reshape(b_, t, DSA_IDX_HEADS, DSA_IDX_DIM), cos_i, sin_i)
    ik = apply_rope(ik, cos_i, sin_i)
    iw = iw * (DSA_IDX_HEADS ** -0.5)
    top = min(DSA_TOPK_MAX, t // 4)
    key_pos = jnp.arange(t)

    def block_fn(args):
        qb, iqb, iwb, bi = args
        tq = bi * Q_BLOCK + jnp.arange(Q_BLOCK)
        logits = jnp.einsum('bqhd,bsd->bqhs', iqb, ik).astype(jnp.float32) * (DSA_IDX_DIM ** -0.5)
        score = jnp.einsum('bqh,bqhs->bqs', iwb.astype(jnp.float32), jax.nn.relu(logits))
        score = jnp.where(key_pos[None, :] <= tq[:, None], score, -jnp.inf)
        _, idx = lax.top_k(score, top)
        kg = jax.vmap(lambda kk, ii: kk[ii])(k, idx)
        vg = jax.vmap(lambda vv, ii: vv[ii])(v, idx)
        m = (idx <= tq[None, :, None])[:, :, None, :]
        p = masked_softmax(jnp.einsum('bqhd,bqkd->bqhk', qb, kg) * scale, m)
        return jnp.einsum('bqhk,bqkd->bqhd', p.astype(vg.dtype), vg)

    o = lax.map(block_fn, (to_blocks(q), to_blocks(iq), to_blocks(iw), jnp.arange(t // Q_BLOCK)))
    return from_blocks(o).reshape(b_, t, GROUP_WIDTH)


def peer_ffn(x, wq, subkeys, u_tab, v_tab):
    b_, t, d = x.shape
    xb = x.reshape(b_ * t // Q_BLOCK, Q_BLOCK, d)

    def block_fn(xt):
        q = (xt @ wq).reshape(Q_BLOCK, PEER_HEADS, 2, PEER_DKEY // 2)
        s = jnp.einsum('thpd,hpnd->thpn', q, subkeys).astype(jnp.float32)
        sv, si = lax.top_k(s, PEER_TOPK)
        cand = (sv[:, :, 0, :, None] + sv[:, :, 1, None, :]).reshape(Q_BLOCK, PEER_HEADS, PEER_TOPK * PEER_TOPK)
        cv, ci = lax.top_k(cand, PEER_TOPK)
        i1 = jnp.take_along_axis(si[:, :, 0], ci // PEER_TOPK, axis=-1)
        i2 = jnp.take_along_axis(si[:, :, 1], ci % PEER_TOPK, axis=-1)
        e = i1 * PEER_NKEYS + i2
        g = jax.nn.softmax(cv, axis=-1).astype(xt.dtype)
        ug = u_tab[e]
        vg = v_tab[e]
        a = jax.nn.gelu(jnp.einsum('thkd,td->thk', ug, xt)) * g
        return jnp.einsum('thk,thkd->td', a, vg)

    return lax.map(block_fn, xb).reshape(b_, t, d)


def setup_inputs(seed: int = 0) -> dict:
    key = jax.random.key(seed)
    ks = jax.random.split(key, 32)
    f32 = jnp.float32
    L = DEPTH

    def nrm(k, shape, scale):
        return jax.random.normal(k, shape, f32) * scale

    def gain(k, shape):
        return 1.0 + 0.05 * jax.random.normal(k, shape, f32)

    return {
        "x": nrm(ks[0], (BATCH, SEQ, D_MODEL), 1.0),
        "c": nrm(ks[1], (BATCH, D_MODEL), 1.0),
        "positions": jnp.broadcast_to(jnp.arange(SEQ, dtype=jnp.int32), (BATCH, SEQ)),
        "ada_w": nrm(ks[2], (L, D_MODEL, 6 * D_MODEL), 0.5 * D_MODEL ** -0.5),
        "ada_b": nrm(ks[3], (L, 6 * D_MODEL), 0.02),
        "norm1_g": gain(ks[4], (L, D_MODEL)),
        "norm2_g": gain(ks[5], (L, D_MODEL)),
        "w_in": nrm(ks[6], (L, D_MODEL, IN_COLS), D_MODEL ** -0.5),
        "w_out": nrm(ks[7], (L, MIX_WIDTH, D_MODEL), MIX_WIDTH ** -0.5),
        "conv_w": nrm(ks[8], (L, CONV_WIDTH, GROUP_WIDTH), CONV_WIDTH ** -0.5),
        "conv_b": nrm(ks[9], (L, GROUP_WIDTH), 0.02),
        "conv_ln_g": gain(ks[10], (L, GROUP_WIDTH)),
        "conv_ln_b": nrm(ks[11], (L, GROUP_WIDTH), 0.02),
        "sgu_ln_g": gain(ks[12], (L, GROUP_WIDTH)),
        "sgu_ln_b": nrm(ks[13], (L, GROUP_WIDTH), 0.02),
        "sgu_w": nrm(ks[14], (L, GROUP_HEADS, SGU_CHUNK, SGU_CHUNK), SGU_CHUNK ** -0.5),
        "sgu_b": gain(ks[15], (L, GROUP_HEADS, SGU_CHUNK)),
        "nsa_q_g": gain(ks[16], (L, HEAD_DIM)),
        "nsa_k_g": gain(ks[17], (L, NSA_N_BRANCH, HEAD_DIM)),
        "nsa_cmp_pos": nrm(ks[18], (L, 2, NSA_CMP_LEN, HEAD_DIM), 0.1),
        "nsa_cmp_w1": nrm(ks[19], (L, 2, NSA_CMP_LEN * HEAD_DIM, HEAD_DIM), (NSA_CMP_LEN * HEAD_DIM) ** -0.5),
        "nsa_cmp_w2": nrm(ks[20], (L, 2, HEAD_DIM, HEAD_DIM), HEAD_DIM ** -0.5),
        "dsa_q_g": gain(ks[21], (L, HEAD_DIM)),
        "dsa_k_g": gain(ks[22], (L, HEAD_DIM)),
        "peer_wq": nrm(ks[23], (L, D_MODEL, PEER_HEADS * PEER_DKEY), D_MODEL ** -0.5),
        "peer_subkeys": nrm(ks[24], (L, PEER_HEADS, 2, PEER_NKEYS, PEER_DKEY // 2), (PEER_DKEY // 2) ** -0.5),
        "peer_u": nrm(ks[25], (L, PEER_EXPERTS, D_MODEL), D_MODEL ** -0.5),
        "peer_v": nrm(ks[26], (L, PEER_EXPERTS, D_MODEL), 0.5),
    }


def reference(x, c, positions, ada_w, ada_b, norm1_g, norm2_g, w_in, w_out,
              conv_w, conv_b, conv_ln_g, conv_ln_b, sgu_ln_g, sgu_ln_b, sgu_w, sgu_b,
              nsa_q_g, nsa_k_g, nsa_cmp_pos, nsa_cmp_w1, nsa_cmp_w2, dsa_q_g, dsa_k_g,
              peer_wq, peer_subkeys, peer_u, peer_v):
    cos, sin = rope_tables(positions, HEAD_DIM // ROT_FRAC)
    cos_i, sin_i = rope_tables(positions, DSA_IDX_DIM // ROT_FRAC)
    c_act = jax.nn.silu(c)
    for i in range(DEPTH):
        ada = c_act @ ada_w[i] + ada_b[i]
        sh1, sc1, g1, sh2, sc2, g2 = [a[:, None, :] for a in jnp.split(ada, 6, axis=-1)]
        hn = rms_norm(x, norm1_g[i]) * (1.0 + sc1) + sh1
        proj = hn @ w_in[i]
        pa, pb, pc, pd = jnp.split(proj, IN_SPLITS, axis=-1)
        ya = conv_module(pa, conv_w[i], conv_b[i], conv_ln_g[i], conv_ln_b[i])
        yb = sgu_module(pb, sgu_ln_g[i], sgu_ln_b[i], sgu_w[i], sgu_b[i])
        yc = nsa_module(pc, cos, sin, nsa_q_g[i], nsa_k_g[i], nsa_cmp_pos[i], nsa_cmp_w1[i], nsa_cmp_w2[i])
        yd = dsa_module(pd, cos, sin, cos_i, sin_i, dsa_q_g[i], dsa_k_g[i])
        y = jnp.concatenate([ya, yb, yc, yd], axis=-1) @ w_out[i]
        x = x + g1 * y
        hn = rms_norm(x, norm2_g[i]) * (1.0 + sc2) + sh2
        x = x + g2 * peer_ffn(hn, peer_wq[i], peer_subkeys[i], peer_u[i], peer_v[i])
    return x
```

```cpp
#include <hip/hip_runtime.h>
#include <hip/hip_cooperative_groups.h>
#include <stdint.h>
#include <cstdio>
namespace cg = cooperative_groups;

typedef unsigned short bf16_t;
typedef short bf16x8 __attribute__((ext_vector_type(8)));
typedef float f32x4 __attribute__((ext_vector_type(4)));
typedef float f32x16 __attribute__((ext_vector_type(16)));
#define DEV __device__ __forceinline__

constexpr int T = 8192, D = 2048, NL = 2;
constexpr int INC = 4692;
constexpr int LDP = 4736;
constexpr int C_CA = 0, C_CG = 512, C_SU = 1024, C_SV = 1536;
constexpr int C_NQ = 2048, C_NKC = 2560, C_NVC = 2688, C_NKS = 2816, C_NVS = 2944, C_NKW = 3072, C_NVW = 3200;
constexpr int C_DQ = 3328, C_DK = 3840, C_DV = 3968, C_IQ = 4096, C_IK = 4608, C_NG = 4672, C_IW = 4688;
constexpr float EPS = 1e-6f;
constexpr int NTHREADS = 256;
constexpr int SMEM_BYTES = 72 * 1024;

__device__ const double INV16[16] = {1.0, 0.44036660267178046, 0.19392274474868576, 0.08539710028576561, 0.03760603093086393,
    0.016560440080994446, 0.007292664737217109, 0.003211445994752591, 0.001414213562373095, 0.000622772421914596,
    0.0002742481756762073, 0.00012076973741146504, 5.318295896944988e-05, 2.341999896140934e-05, 1.031338537721246e-05,
    4.5416704806078695e-06};

struct P {
    const float* x; const float* c; const int* pos; const float* ada_w; const float* ada_b; const float* n1g; const float* n2g;
    const float* w_in; const float* w_out; const float* conv_w; const float* conv_b; const float* cln_g; const float* cln_b;
    const float* sln_g; const float* sln_b; const float* sgu_w; const float* sgu_b; const float* nsa_qg; const float* nsa_kg;
    const float* cmp_pos; const float* cmp_w1; const float* cmp_w2; const float* dsa_qg; const float* dsa_kg;
    const float* peer_wq; const float* peer_sk; const float* peer_u; const float* peer_v;
    float* out;
    bf16_t* WinT; bf16_t* WoutT; bf16_t* WqT; bf16_t* Utab; bf16_t* Vtab;
    float* ada; float* ropeC; float* ropeS;
    bf16_t* HN; bf16_t* PROJ; bf16_t* Y;
    bf16_t* QN; bf16_t* QR; bf16_t* KS; bf16_t* KW; bf16_t* VST; bf16_t* VWT; float* GATES;
    bf16_t* KC; bf16_t* VCT; unsigned* SEL; bf16_t* OCMP;
    bf16_t* DQ; bf16_t* DK; bf16_t* IQ; bf16_t* IK; float* IW; int* IDX; int* CNT;
    float* X1; float* X2; float* PQ; int* PE; float* PG;
};

DEV float bf2f(bf16_t v) { return __uint_as_float(((unsigned)v) << 16); }
DEV unsigned pk2(float lo, float hi) { unsigned r; asm("v_cvt_pk_bf16_f32 %0, %1, %2" : "=v"(r) : "v"(lo), "v"(hi)); return r; }
DEV bf16_t f2bf(float v) { return (bf16_t)(pk2(v, 0.f) & 0xffffu); }
DEV float lo2f(unsigned u) { return __uint_as_float(u << 16); }
DEV float hi2f(unsigned u) { return __uint_as_float(u & 0xffff0000u); }
DEV float wsum(float v) {
#pragma unroll
    for (int o = 32; o > 0; o >>= 1) v += __shfl_xor(v, o);
    return v;
}
DEV float wmax(float v) {
#pragma unroll
    for (int o = 32; o > 0; o >>= 1) v = fmaxf(v, __shfl_xor(v, o));
    return v;
}
DEV int tidx() { int t = threadIdx.x; asm volatile("" : "+v"(t)); return t; }
DEV float sigmoidf_(float x) { return 1.0f / (1.0f + __expf(-x)); }
DEV float gelu_tanh(float x) {
    const float y = 0.7978845608028654f * (x + 0.044715f * x * x * x);
    const float t = 1.0f - 2.0f / (1.0f + __expf(2.0f * y));
    return 0.5f * x * (1.0f + t);
}
DEV f32x4 mfma16(bf16x8 a, bf16x8 b, f32x4 c) { return __builtin_amdgcn_mfma_f32_16x16x32_bf16(a, b, c, 0, 0, 0); }
DEV f32x16 mfma32(bf16x8 a, bf16x8 b, f32x16 c) { return __builtin_amdgcn_mfma_f32_32x32x16_bf16(a, b, c, 0, 0, 0); }

DEV int src_col(int n) {
    if (n < 3328) return n;
    if (n < 4672) return 3340 + (n - 3328);
    if (n < 4684) return 3328 + (n - 4672);
    if (n < 4688) return -1;
    if (n < 4696) return 4684 + (n - 4688);
    return -1;
}

DEV void st_convT(const float* __restrict__ W, bf16_t* __restrict__ Bt, int N, int Npad, bool remap, int unit, char* smem) {
    float (*tile)[65] = (float (*)[65])smem;
    const int ntn = Npad / 64, kt = unit / ntn, nt = unit % ntn, k0 = kt * 64, n0 = nt * 64;
    const int tid_ = tidx(); const int tx = tid_ & 63, ty = tid_ >> 6;
    const int n = n0 + tx;
    const int src = remap ? src_col(n) : (n < N ? n : -1);
#pragma unroll
    for (int i = 0; i < 16; ++i) { const int k = ty + 4 * i; tile[k][tx] = src >= 0 ? W[(size_t)(k0 + k) * N + src] : 0.f; }
    __syncthreads();
#pragma unroll
    for (int i = 0; i < 16; ++i) { const int r = ty + 4 * i; Bt[(size_t)(n0 + r) * 2048 + k0 + tx] = f2bf(tile[tx][r]); }
    __syncthreads();
}

DEV void st_tab(const float* __restrict__ src, bf16_t* __restrict__ dst, size_t n8, int unit, int nunits) {
    const int tid_ = tidx();
    for (size_t g = (size_t)unit * NTHREADS + tid_; g < n8; g += (size_t)nunits * NTHREADS) {
        const float4 a = ((const float4*)src)[2 * g], b = ((const float4*)src)[2 * g + 1];
        uint4 o; o.x = pk2(a.x, a.y); o.y = pk2(a.z, a.w); o.z = pk2(b.x, b.y); o.w = pk2(b.z, b.w);
        ((uint4*)dst)[g] = o;
    }
}

DEV void st_ada(const P& p, int unit, char* smem) {
    float* red = (float*)smem;
    const int tid = tidx(), c = tid & 31, ks = tid >> 5;
    const int i = unit / 384, j = (unit % 384) * 32 + c;
    const float* W = p.ada_w + (size_t)i * 2048 * 12288 + (size_t)(ks * 256) * 12288 + j;
    float acc = 0.f;
#pragma unroll 8
    for (int k = 0; k < 256; ++k) {
        const float cv = p.c[ks * 256 + k];
        acc += (cv * sigmoidf_(cv)) * W[(size_t)k * 12288];
    }
    red[ks * 32 + c] = acc;
    __syncthreads();
    if (tid < 32) {
        float r = p.ada_b[i * 12288 + j];
#pragma unroll
        for (int q = 0; q < 8; ++q) r += red[q * 32 + tid];
        p.ada[i * 12288 + j] = r;
    }
    __syncthreads();
}
DEV void st_rope(const P& p, int unit) {
    const int e = unit * 256 + tidx(); const int t = e / 24, i = e % 24;
    const double inv = i < 16 ? INV16[i] : INV16[2 * (i - 16)];
    const double ang = (double)p.pos[t] * inv;
    const double n = rint(ang * 0.15915494309189535);
    const double r = ang - n * 6.283185307179586;
    const double r2 = r * r;
    double sp = 1.0 / 1.5511210043330986e25, cp = -1.0 / 4.0329146112660565e26;
    sp = sp * r2 - 1.0 / 2.585201673888498e22;   cp = cp * r2 + 1.0 / 6.204484017332394e23;
    sp = sp * r2 + 1.0 / 5.109094217170944e19;   cp = cp * r2 - 1.0 / 1.1240007277776077e21;
    sp = sp * r2 - 1.0 / 1.21645100408832e17;    cp = cp * r2 + 1.0 / 2.43290200817664e18;
    sp = sp * r2 + 1.0 / 3.55687428096e14;       cp = cp * r2 - 1.0 / 6.402373705728e15;
    sp = sp * r2 - 1.0 / 1.307674368e12;         cp = cp * r2 + 1.0 / 2.0922789888e13;
    sp = sp * r2 + 1.0 / 6.2270208e9;            cp = cp * r2 - 1.0 / 8.71782912e10;
    sp = sp * r2 - 1.0 / 3.99168e7;              cp = cp * r2 + 1.0 / 4.790016e8;
    sp = sp * r2 + 1.0 / 362880.0;               cp = cp * r2 - 1.0 / 3628800.0;
    sp = sp * r2 - 1.0 / 5040.0;                 cp = cp * r2 + 1.0 / 40320.0;
    sp = sp * r2 + 1.0 / 120.0;                  cp = cp * r2 - 1.0 / 720.0;
    sp = sp * r2 - 1.0 / 6.0;                    cp = cp * r2 + 1.0 / 24.0;
    sp = sp * r2 + 1.0;                          cp = cp * r2 - 0.5;
    cp = cp * r2 + 1.0;
    const float cs = (float)cp, sn = (float)(sp * r);
    p.ropeC[e] = cs; p.ropeS[e] = sn;
}

DEV void st_norm(const float* __restrict__ X, const float* __restrict__ g, const float* __restrict__ sc, const float* __restrict__ sh,
                 bf16_t* __restrict__ HN, int unit) {
    const int tid_ = tidx(); const int w = tid_ >> 6, l = tid_ & 63; const int t = unit * 4 + w;
    const float4* xr = (const float4*)(X + (size_t)t * D);
    float4 v[8]; float ss = 0.f;
#pragma unroll
    for (int i = 0; i < 4; ++i) { v[2 * i] = xr[i * 128 + l * 2]; v[2 * i + 1] = xr[i * 128 + l * 2 + 1]; }
#pragma unroll
    for (int i = 0; i < 8; ++i) ss += v[i].x * v[i].x + v[i].y * v[i].y + v[i].z * v[i].z + v[i].w * v[i].w;
    ss = wsum(ss);
    const float rs = rsqrtf(ss * (1.0f / 2048.0f) + EPS);
#pragma unroll
    for (int i = 0; i < 4; ++i) {
        const int col = i * 512 + l * 8;
        float y[8]; const float xv[8] = {v[2 * i].x, v[2 * i].y, v[2 * i].z, v[2 * i].w, v[2 * i + 1].x, v[2 * i + 1].y, v[2 * i + 1].z, v[2 * i + 1].w};
#pragma unroll
        for (int j = 0; j < 8; ++j) y[j] = (xv[j] * rs) * g[col + j] * (1.0f + sc[col + j]) + sh[col + j];
        uint4 o; o.x = pk2(y[0], y[1]); o.y = pk2(y[2], y[3]); o.z = pk2(y[4], y[5]); o.w = pk2(y[6], y[7]);
        *(uint4*)(HN + (size_t)t * D + col) = o;
    }
}

enum { EPI_PROJ = 0, EPI_OUT = 1, EPI_Q = 2 };
struct EpiArgs { bf16_t* obf; float* of; const float* xin; const float* gate; };
template <int EPI>
DEV void st_gemm(const bf16_t* __restrict__ A, const bf16_t* __restrict__ Bt, int K, int tm, int tn, const EpiArgs& e, char* smem) {
    constexpr int RS = 144;
    char* As = smem; char* Bs = smem + 128 * RS;
    const int tid = tidx(), w = tid >> 6, l = tid & 63, wr = w >> 1, wc = w & 1;
    f32x4 acc[4][4];
#pragma unroll
    for (int m = 0; m < 4; ++m)
#pragma unroll
        for (int n = 0; n < 4; ++n) acc[m][n] = (f32x4){0.f, 0.f, 0.f, 0.f};
    const int lrow = tid >> 3, lc16 = tid & 7;
    const bf16_t* Ag = A + (size_t)(tm * 128 + lrow) * K + lc16 * 8;
    const bf16_t* Bg = Bt + (size_t)(tn * 128 + lrow) * K + lc16 * 8;
    uint4 ra0, ra1, ra2, ra3, rb0, rb1, rb2, rb3;
#define GLOAD(KO) do { \
    ra0 = *(const uint4*)(Ag + (KO)); ra1 = *(const uint4*)(Ag + (size_t)32 * K + (KO)); ra2 = *(const uint4*)(Ag + (size_t)64 * K + (KO)); ra3 = *(const uint4*)(Ag + (size_t)96 * K + (KO)); \
    rb0 = *(const uint4*)(Bg + (KO)); rb1 = *(const uint4*)(Bg + (size_t)32 * K + (KO)); rb2 = *(const uint4*)(Bg + (size_t)64 * K + (KO)); rb3 = *(const uint4*)(Bg + (size_t)96 * K + (KO)); } while (0)
    GLOAD(0);
    const int nk = K / 64;
    for (int kt = 0; kt < nk; ++kt) {
        __syncthreads();
        *(uint4*)(As + (lrow) * RS + lc16 * 16) = ra0; *(uint4*)(As + (lrow + 32) * RS + lc16 * 16) = ra1;
        *(uint4*)(As + (lrow + 64) * RS + lc16 * 16) = ra2; *(uint4*)(As + (lrow + 96) * RS + lc16 * 16) = ra3;
        *(uint4*)(Bs + (lrow) * RS + lc16 * 16) = rb0; *(uint4*)(Bs + (lrow + 32) * RS + lc16 * 16) = rb1;
        *(uint4*)(Bs + (lrow + 64) * RS + lc16 * 16) = rb2; *(uint4*)(Bs + (lrow + 96) * RS + lc16 * 16) = rb3;
        __syncthreads();
        if (kt + 1 < nk) GLOAD((kt + 1) * 64);
#pragma unroll
        for (int ks = 0; ks < 2; ++ks) {
            bf16x8 af[4], bfr[4];
#pragma unroll
            for (int m = 0; m < 4; ++m) af[m] = *(const bf16x8*)(As + (wr * 64 + m * 16 + (l & 15)) * RS + (ks * 32 + (l >> 4) * 8) * 2);
#pragma unroll
            for (int n = 0; n < 4; ++n) bfr[n] = *(const bf16x8*)(Bs + (wc * 64 + n * 16 + (l & 15)) * RS + (ks * 32 + (l >> 4) * 8) * 2);
#pragma unroll
            for (int m = 0; m < 4; ++m)
#pragma unroll
                for (int n = 0; n < 4; ++n) acc[m][n] = mfma16(bfr[n], af[m], acc[m][n]);
        }
    }
#pragma unroll
    for (int m = 0; m < 4; ++m) {
        const int row = tm * 128 + wr * 64 + m * 16 + (l & 15);
#pragma unroll
        for (int n = 0; n < 4; ++n) {
            const int col = tn * 128 + wc * 64 + n * 16 + 4 * (l >> 4);
            const f32x4 a = acc[m][n];
            if (EPI == EPI_PROJ) {
                uint2 o; o.x = pk2(a[0], a[1]); o.y = pk2(a[2], a[3]);
                *(uint2*)(e.obf + (size_t)row * LDP + col) = o;
            } else if (EPI == EPI_OUT) {
                const float4 xi = *(const float4*)(e.xin + (size_t)row * D + col);
                const float4 gg = *(const float4*)(e.gate + col);
                float4 o; o.x = xi.x + gg.x * a[0]; o.y = xi.y + gg.y * a[1]; o.z = xi.z + gg.z * a[2]; o.w = xi.w + gg.w * a[3];
                *(float4*)(e.of + (size_t)row * D + col) = o;
            } else {
                float4 o; o.x = a[0]; o.y = a[1]; o.z = a[2]; o.w = a[3];
                *(float4*)(e.of + (size_t)row * 1024 + col) = o;
            }
        }
    }
    __syncthreads();
}

DEV void st_conv(const P& p, int layer, int unit, char* smem) {
    float* cs = (float*)smem;
    const int tid = tidx(), t0 = unit * 16;
    const float* cw = p.conv_w + (size_t)layer * 31 * 512;
#pragma unroll 1
    for (int cc = 0; cc < 2; ++cc) {
        const int c = tid + 256 * cc;
        float w[31], z[46];
#pragma unroll
        for (int k = 0; k < 31; ++k) w[k] = cw[k * 512 + c];
#pragma unroll
        for (int r = 0; r < 46; ++r) {
            const int t = t0 - 30 + r;
            float zz = 0.f;
            if (t >= 0) {
                const float a = bf2f(p.PROJ[(size_t)t * LDP + C_CA + c]), g = bf2f(p.PROJ[(size_t)t * LDP + C_CG + c]);
                zz = a * sigmoidf_(g);
            }
            z[r] = zz;
        }
        const float cb = p.conv_b[layer * 512 + c];
#pragma unroll
        for (int tt = 0; tt < 16; ++tt) {
            float acc = cb;
#pragma unroll
            for (int k = 0; k < 31; ++k) acc += w[k] * z[tt + k];
            cs[tt * 512 + c] = acc;
        }
    }
    __syncthreads();
    const int w = tid >> 6, l = tid & 63;
    const float* lg = p.cln_g + layer * 512; const float* lb = p.cln_b + layer * 512;
#pragma unroll 1
    for (int q = 0; q < 4; ++q) {
        const int tt = w * 4 + q;
        float v[8]; float s = 0.f;
#pragma unroll
        for (int i = 0; i < 8; ++i) { v[i] = cs[tt * 512 + l + 64 * i]; s += v[i]; }
        const float mean = wsum(s) * (1.0f / 512.0f);
        float q2 = 0.f;
#pragma unroll
        for (int i = 0; i < 8; ++i) { const float d = v[i] - mean; q2 += d * d; }
        const float rstd = rsqrtf(wsum(q2) * (1.0f / 512.0f) + EPS);
#pragma unroll
        for (int i = 0; i < 8; ++i) {
            const int c = l + 64 * i;
            const float y = (v[i] - mean) * rstd * lg[c] + lb[c];
            p.Y[(size_t)(t0 + tt) * D + c] = f2bf(y * sigmoidf_(y));
        }
    }
    __syncthreads();
}

DEV void st_sgu(const P& p, int layer, int unit, char* smem) {
    const int n = unit >> 2, h = unit & 3, tid = tidx(), w = tid >> 6, l = tid & 63;
    float* stat = (float*)smem;
    float* wt = stat + 256;
    float* vt = wt + 16 * 132;
    const int tb = n * 128;
#pragma unroll 1
    for (int q = 0; q < 32; ++q) {
        const int j = w * 32 + q;
        const uint4 raw = *(const uint4*)(p.PROJ + (size_t)(tb + j) * LDP + C_SV + l * 8);
        float v[8] = {lo2f(raw.x), hi2f(raw.x), lo2f(raw.y), hi2f(raw.y), lo2f(raw.z), hi2f(raw.z), lo2f(raw.w), hi2f(raw.w)};
        float s = 0.f;
#pragma unroll
        for (int i = 0; i < 8; ++i) s += v[i];
        const float mean = wsum(s) * (1.0f / 512.0f);
        float q2 = 0.f;
#pragma unroll
        for (int i = 0; i < 8; ++i) { const float d = v[i] - mean; q2 += d * d; }
        const float rstd = rsqrtf(wsum(q2) * (1.0f / 512.0f) + EPS);
        if (l == 0) { stat[j * 2] = mean; stat[j * 2 + 1] = rstd; }
    }
    __syncthreads();
    const int ti = tid >> 4, td = tid & 15;
    float acc[8][8];
#pragma unroll
    for (int a = 0; a < 8; ++a)
#pragma unroll
        for (int b = 0; b < 8; ++b) acc[a][b] = 0.f;
    const float* Wh = p.sgu_w + ((size_t)layer * 4 + h) * 128 * 128;
    const float* lg = p.sln_g + layer * 512 + h * 128; const float* lb = p.sln_b + layer * 512 + h * 128;
#pragma unroll 1
    for (int jc = 0; jc < 8; ++jc) {
#pragma unroll 2
        for (int q = 0; q < 8; ++q) {
            const int e = tid + 256 * q;
            { const int i = e >> 4, jj = e & 15, j = jc * 16 + jj; wt[jj * 132 + i] = (i >= j) ? Wh[i * 128 + j] : 0.f; }
            { const int jj = e >> 7, d = e & 127, j = jc * 16 + jj;
              const float x = bf2f(p.PROJ[(size_t)(tb + j) * LDP + C_SV + h * 128 + d]);
              vt[jj * 128 + d] = (x - stat[j * 2]) * stat[j * 2 + 1] * lg[d] + lb[d]; }
        }
        __syncthreads();
        if (w * 32 + 31 >= jc * 16) {
#pragma unroll
            for (int jj = 0; jj < 16; ++jj) {
                const float4 w0 = *(const float4*)(wt + jj * 132 + ti * 8), w1 = *(const float4*)(wt + jj * 132 + ti * 8 + 4);
                const float4 v0 = *(const float4*)(vt + jj * 128 + td * 8), v1 = *(const float4*)(vt + jj * 128 + td * 8 + 4);
                const float wv[8] = {w0.x, w0.y, w0.z, w0.w, w1.x, w1.y, w1.z, w1.w};
                const float vv[8] = {v0.x, v0.y, v0.z, v0.w, v1.x, v1.y, v1.z, v1.w};
#pragma unroll
                for (int a = 0; a < 8; ++a)
#pragma unroll
                    for (int b = 0; b < 8; ++b) acc[a][b] += wv[a] * vv[b];
            }
        }
        __syncthreads();
    }
#pragma unroll
    for (int a = 0; a < 8; ++a) {
        const int i = ti * 8 + a; const size_t t = tb + i;
        const float bs = p.sgu_b[((size_t)layer * 4 + h) * 128 + i];
        const uint4 ur = *(const uint4*)(p.PROJ + t * LDP + C_SU + h * 128 + td * 8);
        const float u[8] = {lo2f(ur.x), hi2f(ur.x), lo2f(ur.y), hi2f(ur.y), lo2f(ur.z), hi2f(ur.z), lo2f(ur.w), hi2f(ur.w)};
        float y[8];
#pragma unroll
        for (int b = 0; b < 8; ++b) y[b] = u[b] * (acc[a][b] + bs);
        uint4 o; o.x = pk2(y[0], y[1]); o.y = pk2(y[2], y[3]); o.z = pk2(y[4], y[5]); o.w = pk2(y[6], y[7]);
        *(uint4*)(p.Y + t * D + 512 + h * 128 + td * 8) = o;
    }
}

DEV void st_vtrans(const P& p, int unit, char* smem) {
    bf16_t* tile = (bf16_t*)smem;
    const int which = unit & 1, tt0 = (unit >> 1) * 64, tid = tidx();
    const int col0 = which ? C_NVW : C_NVS;
    bf16_t* dst = which ? p.VWT : p.VST;
#pragma unroll
    for (int q = 0; q < 4; ++q) {
        const int e = tid + 256 * q; const int r = e >> 4, c8 = e & 15;
        const uint4 raw = *(const uint4*)(p.PROJ + (size_t)(tt0 + r) * LDP + col0 + c8 * 8);
        unsigned* d32 = (unsigned*)(tile + r * 130 + c8 * 8);
        d32[0] = raw.x; d32[1] = raw.y; d32[2] = raw.z; d32[3] = raw.w;
    }
    __syncthreads();
    const int d = tid >> 1, half = tid & 1;
    unsigned o[16];
#pragma unroll
    for (int i = 0; i < 16; ++i) {
        const unsigned a = tile[(half * 32 + 2 * i) * 130 + d], b = tile[(half * 32 + 2 * i + 1) * 130 + d];
        o[i] = a | (b << 16);
    }
    uint4* dp = (uint4*)(dst + (size_t)d * T + tt0 + half * 32);
#pragma unroll
    for (int i = 0; i < 4; ++i) dp[i] = make_uint4(o[4 * i], o[4 * i + 1], o[4 * i + 2], o[4 * i + 3]);
    __syncthreads();
}

DEV void head_norm_rope(const bf16_t* src, const float* g, const float* rc, const float* rs_, int l, bool rope, float& o0, float& o1, float& n0, float& n1) {
    const float x0 = bf2f(src[l]), x1 = bf2f(src[l + 64]);
    const float ss = wsum(x0 * x0 + x1 * x1);
    const float r = rsqrtf(ss * (1.0f / 128.0f) + EPS);
    n0 = x0 * r * g[l]; n1 = x1 * r * g[l + 64];
    o0 = n0; o1 = n1;
    const float other = __shfl_xor(n0, 16);
    if (rope && l < 32) {
        const float c = rc[l & 15], s = rs_[l & 15];
        o0 = (l < 16) ? (n0 * c - other * s) : (n0 * c + other * s);
    }
}
DEV void st_prep(const P& p, int layer, int unit) {
    const int tid_ = tidx(); const int w = tid_ >> 6, l = tid_ & 63; const size_t t = (size_t)unit * 4 + w;
    const bf16_t* row = p.PROJ + t * LDP;
    const float* rc = p.ropeC + t * 24; const float* rs_ = p.ropeS + t * 24;
    float o0, o1, n0, n1;
#pragma unroll
    for (int h = 0; h < 4; ++h) {
        head_norm_rope(row + C_NQ + h * 128, p.nsa_qg + layer * 128, rc, rs_, l, true, o0, o1, n0, n1);
        p.QN[(t * 4 + h) * 128 + l] = f2bf(n0); p.QN[(t * 4 + h) * 128 + l + 64] = f2bf(n1);
        p.QR[(t * 4 + h) * 128 + l] = f2bf(o0); p.QR[(t * 4 + h) * 128 + l + 64] = f2bf(o1);
    }
    head_norm_rope(row + C_NKS, p.nsa_kg + (layer * 3 + 1) * 128, rc, rs_, l, true, o0, o1, n0, n1);
    p.KS[t * 128 + l] = f2bf(o0); p.KS[t * 128 + l + 64] = f2bf(o1);
    head_norm_rope(row + C_NKW, p.nsa_kg + (layer * 3 + 2) * 128, rc, rs_, l, true, o0, o1, n0, n1);
    p.KW[t * 128 + l] = f2bf(o0); p.KW[t * 128 + l + 64] = f2bf(o1);
    if (l < 12) p.GATES[t * 12 + l] = sigmoidf_(bf2f(row[C_NG + l]));
#pragma unroll
    for (int h = 0; h < 4; ++h) {
        head_norm_rope(row + C_DQ + h * 128, p.dsa_qg + layer * 128, rc, rs_, l, true, o0, o1, n0, n1);
        p.DQ[(t * 4 + h) * 128 + l] = f2bf(o0); p.DQ[(t * 4 + h) * 128 + l + 64] = f2bf(o1);
    }
    head_norm_rope(row + C_DK, p.dsa_kg + layer * 128, rc, rs_, l, true, o0, o1, n0, n1);
    p.DK[t * 128 + l] = f2bf(o0); p.DK[t * 128 + l + 64] = f2bf(o1);
    const float ic = rc[16 + (l & 7)], is = rs_[16 + (l & 7)];
#pragma unroll
    for (int h = 0; h < 9; ++h) {
        const float x = bf2f(row[(h < 8 ? C_IQ + h * 64 : C_IK) + l]);
        const float other = __shfl_xor(x, 8);
        float o = x;
        if (l < 16) o = (l < 8) ? (x * ic - other * is) : (x * ic + other * is);
        if (h < 8) p.IQ[(t * 8 + h) * 64 + l] = f2bf(o); else p.IK[t * 64 + l] = f2bf(o);
    }
    if (l < 8) p.IW[t * 8 + l] = bf2f(row[C_IW + l]) * (0.35355339059327373f * 0.125f);
}

DEV void st_compress(const P& p, int layer, int unit, char* smem) {
    const int which = unit & 1, g = unit >> 1, tid = tidx(), c = tid & 127, half = tid >> 7;
    bf16_t* xin = (bf16_t*)smem;
    float* pos = (float*)(smem + 36864);
    float* hid = (float*)(smem + 36864 + 16384);
    float* ob = hid + 8 * 128;
    const int tok0 = g * 128;
    const int col0 = which ? C_NVC : C_NKC;
#pragma unroll 1
    for (int e = tid; e < 144 * 16; e += 256) {
        const int r = e >> 4, c8 = e & 15; const int t = tok0 + r;
        uint4 raw = make_uint4(0, 0, 0, 0);
        if (t < T) raw = *(const uint4*)(p.PROJ + (size_t)t * LDP + col0 + c8 * 8);
        *(uint4*)(xin + r * 128 + c8 * 8) = raw;
    }
    const float* ps = p.cmp_pos + ((size_t)layer * 2 + which) * 32 * 128;
#pragma unroll 1
    for (int e = tid; e < 32 * 128; e += 256) pos[e] = ps[e];
    __syncthreads();
    const float* w1 = p.cmp_w1 + ((size_t)layer * 2 + which) * 4096 * 128;
    float acc[4] = {0.f, 0.f, 0.f, 0.f};
#pragma unroll 1
    for (int ld = 0; ld < 32; ++ld) {
#pragma unroll 2
        for (int d8 = 0; d8 < 16; ++d8) {
            float wv[8];
#pragma unroll
            for (int j = 0; j < 8; ++j) wv[j] = w1[(size_t)(ld * 128 + d8 * 8 + j) * 128 + c];
            const float4 p0 = *(const float4*)(pos + ld * 128 + d8 * 8), p1 = *(const float4*)(pos + ld * 128 + d8 * 8 + 4);
            const float pv[8] = {p0.x, p0.y, p0.z, p0.w, p1.x, p1.y, p1.z, p1.w};
#pragma unroll
            for (int b = 0; b < 4; ++b) {
                const uint4 raw = *(const uint4*)(xin + (16 * (half * 4 + b) + ld) * 128 + d8 * 8);
                const float xv[8] = {lo2f(raw.x), hi2f(raw.x), lo2f(raw.y), hi2f(raw.y), lo2f(raw.z), hi2f(raw.z), lo2f(raw.w), hi2f(raw.w)};
#pragma unroll
                for (int j = 0; j < 8; ++j) acc[b] += (xv[j] + pv[j]) * wv[j];
            }
        }
    }
#pragma unroll
    for (int b = 0; b < 4; ++b) hid[(half * 4 + b) * 128 + c] = gelu_tanh(acc[b]);
    __syncthreads();
    const float* w2 = p.cmp_w2 + ((size_t)layer * 2 + which) * 128 * 128;
    float o[4] = {0.f, 0.f, 0.f, 0.f};
#pragma unroll 4
    for (int k = 0; k < 128; ++k) {
        const float wv = w2[k * 128 + c];
#pragma unroll
        for (int b = 0; b < 4; ++b) o[b] += hid[(half * 4 + b) * 128 + k] * wv;
    }
#pragma unroll
    for (int b = 0; b < 4; ++b) ob[(half * 4 + b) * 128 + c] = o[b];
    __syncthreads();
    const int w = tid >> 6, l = tid & 63;
#pragma unroll
    for (int q = 0; q < 2; ++q) {
        const int b = w * 2 + q, nb = g * 8 + b;
        float v0 = ob[b * 128 + l], v1 = ob[b * 128 + l + 64];
        if (which == 0) {
            const float r = rsqrtf(wsum(v0 * v0 + v1 * v1) * (1.0f / 128.0f) + EPS);
            const float* kg = p.nsa_kg + (layer * 3 + 0) * 128;
            v0 = v0 * r * kg[l]; v1 = v1 * r * kg[l + 64];
            if (nb >= 511) { v0 = 0.f; v1 = 0.f; }
            p.KC[nb * 128 + l] = f2bf(v0); p.KC[nb * 128 + l + 64] = f2bf(v1);
        } else {
            if (nb >= 511) { v0 = 0.f; v1 = 0.f; }
            p.VCT[l * 512 + nb] = f2bf(v0); p.VCT[(l + 64) * 512 + nb] = f2bf(v1);
        }
    }
    __syncthreads();
}

DEV void st_nsa_cmp(const P& p, int unit, char* smem) {
    const int tid = tidx(), w = tid >> 6, l = tid & 63, qc = l & 15, g4 = l >> 4;
    float* impl = (float*)smem + w * 512;
    const int t0 = unit * 16 + w * 4;
    const int tk = qc >> 2, hd = qc & 3, t = t0 + tk;
    bf16x8 qf[4];
#pragma unroll
    for (int ks = 0; ks < 4; ++ks) qf[ks] = *(const bf16x8*)(p.QN + ((size_t)t0 * 4 + qc) * 128 + ks * 32 + g4 * 8);
    const int tmax = t0 + 3;
    const int nvmax = tmax >= 31 ? (tmax - 31) / 16 + 1 : 0;
    const int ntile = (nvmax + 15) >> 4;
    const int nvis = t >= 31 ? (t - 31) / 16 + 1 : 0;
    const float cs = 0.08838834764831845f * 1.4426950408889634f;
    float m = -1e30f, lsum = 0.f;
#pragma unroll 1
    for (int tt = 0; tt < ntile; ++tt) {
        f32x4 s = (f32x4){0.f, 0.f, 0.f, 0.f};
#pragma unroll
        for (int ks = 0; ks < 4; ++ks) {
            const bf16x8 a = *(const bf16x8*)(p.KC + (size_t)(tt * 16 + qc) * 128 + ks * 32 + g4 * 8);
            s = mfma16(a, qf[ks], s);
        }
        float mx = m;
#pragma unroll
        for (int r = 0; r < 4; ++r) { const int key = tt * 16 + 4 * g4 + r; s[r] *= cs; if (key < nvis) mx = fmaxf(mx, s[r]); }
        float ps = 0.f;
#pragma unroll
        for (int r = 0; r < 4; ++r) { const int key = tt * 16 + 4 * g4 + r; ps += (key < nvis) ? exp2f(s[r] - mx) : 0.f; }
        lsum = lsum * exp2f(m - mx) + ps; m = mx;
    }
    {
        float mt_ = fmaxf(m, __shfl_xor(m, 16)); mt_ = fmaxf(mt_, __shfl_xor(mt_, 32));
        lsum *= exp2f(m - mt_); m = mt_;
        lsum += __shfl_xor(lsum, 16); lsum += __shfl_xor(lsum, 32);
    }
    const float inv = lsum > 0.f ? 1.0f / lsum : 0.f;
    f32x4 o[8];
#pragma unroll
    for (int mt = 0; mt < 8; ++mt) o[mt] = (f32x4){0.f, 0.f, 0.f, 0.f};
    float yprev = 0.f;
#pragma unroll 1
    for (int u = 0; u < 16; ++u) {
        f32x4 s2[2];
#pragma unroll
        for (int q = 0; q < 2; ++q) {
            const int tt = 2 * u + q;
            f32x4 s = (f32x4){0.f, 0.f, 0.f, 0.f};
            if (tt < ntile) {
#pragma unroll
                for (int ks = 0; ks < 4; ++ks) {
                    const bf16x8 a = *(const bf16x8*)(p.KC + (size_t)(tt * 16 + qc) * 128 + ks * 32 + g4 * 8);
                    s = mfma16(a, qf[ks], s);
                }
            }
#pragma unroll
            for (int r = 0; r < 4; ++r) { const int key = tt * 16 + 4 * g4 + r; s[r] = (key < nvis) ? exp2f(s[r] * cs - m) * inv : 0.f; }
            const float y = __shfl(s[3], (l + 48) & 63);
            float iv = (s[0] + s[1]) + (s[2] + s[3]) + (g4 > 0 ? y : yprev);
            yprev = y;
            iv += __shfl_xor(iv, 1); iv += __shfl_xor(iv, 2);
            if (hd == 0) impl[tk * 128 + 4 * tt + g4] = iv;
            s2[q] = s;
        }
        if (2 * u < ntile) {
            union { bf16x8 v; unsigned u32[4]; } b;
            b.u32[0] = pk2(s2[0][0], s2[0][1]); b.u32[1] = pk2(s2[0][2], s2[0][3]);
            b.u32[2] = pk2(s2[1][0], s2[1][1]); b.u32[3] = pk2(s2[1][2], s2[1][3]);
#pragma unroll
            for (int mt = 0; mt < 8; ++mt) {
                const bf16_t* vp = p.VCT + (size_t)(mt * 16 + qc) * 512 + 32 * u + 4 * g4;
                union { bf16x8 v; uint2 h2[2]; } a;
                a.h2[0] = *(const uint2*)vp; a.h2[1] = *(const uint2*)(vp + 16);
                o[mt] = mfma16(a.v, b.v, o[mt]);
            }
        }
    }
#pragma unroll
    for (int mt = 0; mt < 8; ++mt) {
        uint2 ov; ov.x = pk2(o[mt][0], o[mt][1]); ov.y = pk2(o[mt][2], o[mt][3]);
        *(uint2*)(p.OCMP + ((size_t)t * 4 + hd) * 128 + mt * 16 + 4 * g4) = ov;
    }
    __syncthreads();
    const int li = hd + 4 * g4, cur = t >> 6;
    const float INF = __builtin_inff();
    float own[8]; int rank[8];
#pragma unroll
    for (int i = 0; i < 8; ++i) {
        const int j = li + 16 * i; float v = impl[tk * 128 + j];
        v = (j == 0 || j == cur || j == cur - 1) ? INF : (j > cur ? -INF : v);
        own[i] = v; rank[i] = 0;
    }
#pragma unroll
    for (int ip = 0; ip < 8; ++ip) {
#pragma unroll
        for (int q4 = 0; q4 < 4; ++q4) {
            const float4 ov = *(const float4*)(impl + tk * 128 + ip * 16 + q4 * 4);
            const float o4[4] = {ov.x, ov.y, ov.z, ov.w};
#pragma unroll
            for (int e = 0; e < 4; ++e) {
                const int lj = q4 * 4 + e, jp = ip * 16 + lj;
                const float vp = (jp == 0 || jp == cur || jp == cur - 1) ? INF : (jp > cur ? -INF : o4[e]);
#pragma unroll
                for (int i = 0; i < 8; ++i) {
                    bool before;
                    if (ip < i) before = true; else if (ip > i) before = false; else before = lj < li;
                    rank[i] += (vp > own[i] || (before && vp == own[i])) ? 1 : 0;
                }
            }
        }
        __builtin_amdgcn_sched_barrier(0);
    }
    unsigned mw[4] = {0u, 0u, 0u, 0u};
#pragma unroll
    for (int i = 0; i < 8; ++i) if (rank[i] < 16) mw[i >> 1] |= 1u << (li + 16 * (i & 1));
#pragma unroll
    for (int q = 0; q < 4; ++q) {
        unsigned v = mw[q];
        v |= __shfl_xor(v, 1); v |= __shfl_xor(v, 2); v |= __shfl_xor(v, 16); v |= __shfl_xor(v, 32);
        mw[q] = v;
    }
    if (li == 0) *(uint4*)(p.SEL + (size_t)t * 4) = make_uint4(mw[0], mw[1], mw[2], mw[3]);
    __syncthreads();
}

DEV void st_nsa_attn(const P& p, int unit, char* smem) {
    constexpr int RSK = 272, RSV = 136;
    char* Kt = smem; char* Vt = smem + 64 * RSK;
    const int tid = tidx(), w = tid >> 6, l = tid & 63, n = l & 31, h = l >> 5;
    const int tq0 = unit * 32, t = tq0 + w * 8 + (n >> 2), hd = n & 3;
    bf16x8 qf[8];
#pragma unroll
    for (int ks = 0; ks < 8; ++ks) qf[ks] = *(const bf16x8*)(p.QR + ((size_t)t * 4 + hd) * 128 + ks * 16 + h * 8);
    const uint4 selw = *(const uint4*)(p.SEL + (size_t)t * 4);
    const float cs = 0.08838834764831845f * 1.4426950408889634f;
    unsigned part[4][8];
#pragma unroll
    for (int mt = 0; mt < 4; ++mt)
#pragma unroll
        for (int r = 0; r < 8; ++r) part[mt][r] = 0u;
    const float g0 = p.GATES[(size_t)t * 12 + hd * 3];
#pragma unroll 1
    for (int br = 0; br < 2; ++br) {
        const bf16_t* Kg = br ? p.KW : p.KS; const bf16_t* Vg = br ? p.VWT : p.VST;
        const int ktlast = (tq0 + 31) >> 6;
        const int ktfirst = br ? ((tq0 - 511 > 0 ? tq0 - 511 : 0) >> 6) : 0;
        f32x16 o[4];
#pragma unroll
        for (int mt = 0; mt < 4; ++mt)
#pragma unroll
            for (int r = 0; r < 16; ++r) o[mt][r] = 0.f;
        float m = -1e30f, lsum = 0.f;
#pragma unroll 1
        for (int kt = ktfirst; kt <= ktlast; ++kt) {
            __syncthreads();
#pragma unroll
            for (int q = 0; q < 4; ++q) {
                const int e = tid + 256 * q;
                { const int key = e >> 4, c16 = e & 15; *(uint4*)(Kt + key * RSK + c16 * 16) = *(const uint4*)(Kg + (size_t)(kt * 64 + key) * 128 + c16 * 8); }
                { const int dim = e >> 3, c16 = e & 7; *(uint4*)(Vt + dim * RSV + c16 * 16) = *(const uint4*)(Vg + (size_t)dim * T + kt * 64 + c16 * 8); }
            }
            __syncthreads();
            bool selbit = true;
            if (br == 0) { const unsigned wv = kt < 32 ? selw.x : (kt < 64 ? selw.y : (kt < 96 ? selw.z : selw.w)); selbit = (wv >> (kt & 31)) & 1u; }
#pragma unroll
            for (int sub = 0; sub < 2; ++sub) {
                f32x16 s;
#pragma unroll
                for (int r = 0; r < 16; ++r) s[r] = 0.f;
#pragma unroll
                for (int ks = 0; ks < 8; ++ks) {
                    const bf16x8 a = *(const bf16x8*)(Kt + (sub * 32 + n) * RSK + (16 * ks + 8 * h) * 2);
                    s = mfma32(a, qf[ks], s);
                }
                const int kbase = kt * 64 + sub * 32 + 4 * h;
                float mx = -1e30f; bool valid[16];
#pragma unroll
                for (int r = 0; r < 16; ++r) {
                    const int kp = kbase + (r & 3) + 8 * (r >> 2);
                    valid[r] = br ? (kp <= t && kp > t - 512) : (selbit && kp <= t);
                    s[r] *= cs;
                    if (valid[r]) mx = fmaxf(mx, s[r]);
                }
                mx = fmaxf(mx, __shfl_xor(mx, 32));
                const float mnew = fmaxf(m, mx);
                const float alpha = exp2f(m - mnew);
                m = mnew;
                float ps = 0.f;
#pragma unroll
                for (int r = 0; r < 16; ++r) { const float pv = valid[r] ? exp2f(s[r] - mnew) : 0.f; s[r] = pv; ps += pv; }
                lsum = lsum * alpha + ps;
#pragma unroll
                for (int mt = 0; mt < 4; ++mt)
#pragma unroll
                    for (int r = 0; r < 16; ++r) o[mt][r] *= alpha;
#pragma unroll
                for (int s2 = 0; s2 < 2; ++s2) {
                    union { bf16x8 v; unsigned u32[4]; } b;
#pragma unroll
                    for (int q = 0; q < 4; ++q) b.u32[q] = pk2(s[8 * s2 + 2 * q], s[8 * s2 + 2 * q + 1]);
#pragma unroll
                    for (int mt = 0; mt < 4; ++mt) {
                        const char* vp = Vt + (mt * 32 + n) * RSV + (sub * 32 + 16 * s2 + 4 * h) * 2;
                        union { bf16x8 v; uint2 h2[2]; } a;
                        a.h2[0] = *(const uint2*)vp; a.h2[1] = *(const uint2*)(vp + 16);
                        o[mt] = mfma32(a.v, b.v, o[mt]);
                    }
                }
            }
        }
        lsum += __shfl_xor(lsum, 32);
        const float gate = p.GATES[(size_t)t * 12 + hd * 3 + 1 + br];
        const float sc = lsum > 0.f ? gate / lsum : 0.f;
        if (br == 0) {
#pragma unroll
            for (int mt = 0; mt < 4; ++mt)
#pragma unroll
                for (int rq = 0; rq < 4; ++rq) {
                    const int dim = mt * 32 + 8 * rq + 4 * h;
                    const uint2 oc = *(const uint2*)(p.OCMP + ((size_t)t * 4 + hd) * 128 + dim);
                    part[mt][2 * rq] = pk2(sc * o[mt][4 * rq + 0] + g0 * lo2f(oc.x), sc * o[mt][4 * rq + 1] + g0 * hi2f(oc.x));
                    part[mt][2 * rq + 1] = pk2(sc * o[mt][4 * rq + 2] + g0 * lo2f(oc.y), sc * o[mt][4 * rq + 3] + g0 * hi2f(oc.y));
                }
        } else {
#pragma unroll
            for (int mt = 0; mt < 4; ++mt)
#pragma unroll
                for (int rq = 0; rq < 4; ++rq) {
                    const int dim = mt * 32 + 8 * rq + 4 * h;
                    const float y0 = sc * o[mt][4 * rq + 0] + lo2f(part[mt][2 * rq]), y1 = sc * o[mt][4 * rq + 1] + hi2f(part[mt][2 * rq]);
                    const float y2 = sc * o[mt][4 * rq + 2] + lo2f(part[mt][2 * rq + 1]), y3 = sc * o[mt][4 * rq + 3] + hi2f(part[mt][2 * rq + 1]);
                    uint2 ov; ov.x = pk2(y0, y1); ov.y = pk2(y2, y3);
                    *(uint2*)(p.Y + (size_t)t * D + 1024 + hd * 128 + dim) = ov;
                }
        }
    }
    __syncthreads();
}

DEV unsigned f2key(float f) { const unsigned u = __float_as_uint(f); return (u & 0x80000000u) ? ~u : (u | 0x80000000u); }
DEV float key2f(unsigned k) { const unsigned u = (k & 0x80000000u) ? (k & 0x7fffffffu) : ~k; return __uint_as_float(u); }
DEV float wave_prune(float* sc, unsigned short* ix, unsigned* hist, int m, int l) {
    float v[8]; unsigned k[8]; unsigned short id[8]; bool ok[8];
#pragma unroll
    for (int i = 0; i < 8; ++i) {
        const int e = l + 64 * i; ok[i] = e < m;
        v[i] = ok[i] ? sc[e] : 0.f; id[i] = ok[i] ? ix[e] : (unsigned short)0; k[i] = f2key(v[i]);
    }
    unsigned prefix = 0u; int need = 256;
#pragma unroll 1
    for (int pass = 0; pass < 4; ++pass) {
        const int shift = 24 - 8 * pass;
        *(uint4*)(hist + 4 * l) = make_uint4(0u, 0u, 0u, 0u);
        __builtin_amdgcn_wave_barrier();
#pragma unroll
        for (int i = 0; i < 8; ++i) {
            const bool in = ok[i] && (pass == 0 || (k[i] >> (shift + 8)) == prefix);
            if (in) atomicAdd(&hist[(k[i] >> shift) & 255u], 1u);
        }
        __builtin_amdgcn_wave_barrier();
        const uint4 hv = *(const uint4*)(hist + 4 * l);
        const unsigned hq[4] = {hv.x, hv.y, hv.z, hv.w};
        const unsigned own = hv.x + hv.y + hv.z + hv.w;
        unsigned tot = own;
#pragma unroll
        for (int o = 1; o < 64; o <<= 1) { const unsigned tv = __shfl_down(tot, o); if (l + o < 64) tot += tv; }
        unsigned cum = tot - own; int found = -1; int nneed = 0;
#pragma unroll
        for (int kk = 3; kk >= 0; --kk) {
            const unsigned c = hq[kk];
            if (found < 0 && (int)cum < need && (int)(cum + c) >= need) { found = 4 * l + kk; nneed = need - (int)cum; }
            cum += c;
        }
        const unsigned long long bal = __ballot(found >= 0);
        const int src = __ffsll((long long)bal) - 1;
        const int digit = __shfl(found, src); need = __shfl(nneed, src);
        prefix = (prefix << 8) | (unsigned)digit;
    }
    const unsigned thr = prefix;
    int base = 0, ties = 0;
    const unsigned long long ltmask = (1ull << l) - 1ull;
#pragma unroll
    for (int i = 0; i < 8; ++i) {
        const bool gt = ok[i] && k[i] > thr, eq = ok[i] && k[i] == thr;
        const unsigned long long em = __ballot(eq);
        const int trank = ties + __popcll(em & ltmask);
        const bool keep = gt || (eq && trank < need);
        ties += __popcll(em);
        const unsigned long long km = __ballot(keep);
        const int pos = base + __popcll(km & ltmask);
        if (keep) { sc[pos] = v[i]; ix[pos] = id[i]; }
        base += __popcll(km);
    }
    __builtin_amdgcn_wave_barrier();
    return key2f(thr);
}

#define DSA_APPEND(SCP, IXP, CNT, M32, MINE, SV) do { \
    const unsigned _m = (M32); \
    if (MINE) { const int _pos = (CNT) + __popc(_m & ((1u << n) - 1u)); (SCP)[_pos] = (SV); (IXP)[_pos] = (unsigned short)kp; } \
    (CNT) += __popc(_m); } while (0)

DEV void st_dsa_index(const P& p, int unit, char* smem) {
    const int tid = tidx(), w = tid >> 6, l = tid & 63, n = l & 31, h = l >> 5;
    char* wb = smem + w * 14336;
    float* sc0 = (float*)wb; float* sc1 = sc0 + 512; float* sc2 = sc1 + 512; float* sc3 = sc2 + 512;
    unsigned short* ix0 = (unsigned short*)(wb + 8192); unsigned short* ix1 = ix0 + 512; unsigned short* ix2 = ix1 + 512; unsigned short* ix3 = ix2 + 512;
    unsigned* hist = (unsigned*)(wb + 12288);
    const int wu = unit * 4 + w;
    const int tg = (wu & 1) ? (2047 - (wu >> 1)) : (wu >> 1);
    const int t0 = tg * 4;
    const int tl = 2 * ((n >> 2) & 1) + (n >> 4), hdr = (n & 3) + 4 * ((n >> 3) & 1);
    bf16x8 af[4];
#pragma unroll
    for (int s = 0; s < 4; ++s) af[s] = *(const bf16x8*)(p.IQ + ((size_t)(t0 + tl) * 8 + hdr) * 64 + 16 * s + 8 * h);
    const int tA = t0 + 2 * h, tB = tA + 1;
    float wA[8], wB[8];
#pragma unroll
    for (int r = 0; r < 8; ++r) { wA[r] = p.IW[(size_t)tA * 8 + r]; wB[r] = p.IW[(size_t)tB * 8 + r]; }
    int cnt0 = 0, cnt1 = 0, cnt2 = 0, cnt3 = 0;
    const float NINF = -__builtin_inff();
    float tau0 = NINF, tau1 = NINF, tau2 = NINF, tau3 = NINF;
    const int ntiles = (t0 + 3) / 32 + 1;
#pragma unroll 1
    for (int kt = 0; kt < ntiles; ++kt) {
        f32x16 acc;
#pragma unroll
        for (int r = 0; r < 16; ++r) acc[r] = 0.f;
#pragma unroll
        for (int s = 0; s < 4; ++s) {
            const bf16x8 b = *(const bf16x8*)(p.IK + (size_t)(kt * 32 + n) * 64 + 16 * s + 8 * h);
            acc = mfma32(af[s], b, acc);
        }
        float s0 = 0.f, s1 = 0.f;
#pragma unroll
        for (int r = 0; r < 8; ++r) { s0 += wA[r] * fmaxf(acc[r], 0.f); s1 += wB[r] * fmaxf(acc[8 + r], 0.f); }
        const int kp = kt * 32 + n;
        const bool cA = (kp <= tA) && (s0 > (h ? tau2 : tau0));
        const bool cB = (kp <= tB) && (s1 > (h ? tau3 : tau1));
        const unsigned long long mA = __ballot(cA), mB = __ballot(cB);
        DSA_APPEND(sc0, ix0, cnt0, (unsigned)mA, (h == 0 && cA), s0);
        DSA_APPEND(sc2, ix2, cnt2, (unsigned)(mA >> 32), (h == 1 && cA), s0);
        DSA_APPEND(sc1, ix1, cnt1, (unsigned)mB, (h == 0 && cB), s1);
        DSA_APPEND(sc3, ix3, cnt3, (unsigned)(mB >> 32), (h == 1 && cB), s1);
        __builtin_amdgcn_wave_barrier();
        if (cnt0 > 480) { tau0 = wave_prune(sc0, ix0, hist, cnt0, l); cnt0 = 256; }
        if (cnt1 > 480) { tau1 = wave_prune(sc1, ix1, hist, cnt1, l); cnt1 = 256; }
        if (cnt2 > 480) { tau2 = wave_prune(sc2, ix2, hist, cnt2, l); cnt2 = 256; }
        if (cnt3 > 480) { tau3 = wave_prune(sc3, ix3, hist, cnt3, l); cnt3 = 256; }
    }
    if (cnt0 > 256) { wave_prune(sc0, ix0, hist, cnt0, l); cnt0 = 256; }
    if (cnt1 > 256) { wave_prune(sc1, ix1, hist, cnt1, l); cnt1 = 256; }
    if (cnt2 > 256) { wave_prune(sc2, ix2, hist, cnt2, l); cnt2 = 256; }
    if (cnt3 > 256) { wave_prune(sc3, ix3, hist, cnt3, l); cnt3 = 256; }
    __builtin_amdgcn_wave_barrier();
#pragma unroll
    for (int i = 0; i < 4; ++i) {
        const int e = l + 64 * i;
        p.IDX[(size_t)(t0 + 0) * 256 + e] = e < cnt0 ? (int)ix0[e] : 0;
        p.IDX[(size_t)(t0 + 1) * 256 + e] = e < cnt1 ? (int)ix1[e] : 0;
        p.IDX[(size_t)(t0 + 2) * 256 + e] = e < cnt2 ? (int)ix2[e] : 0;
        p.IDX[(size_t)(t0 + 3) * 256 + e] = e < cnt3 ? (int)ix3[e] : 0;
    }
    if (l == 0) { p.CNT[t0] = cnt0; p.CNT[t0 + 1] = cnt1; p.CNT[t0 + 2] = cnt2; p.CNT[t0 + 3] = cnt3; }
}

DEV void st_dsa_attn(const P& p, int unit, char* smem) {
    const int tid = tidx(), w = tid >> 6, l = tid & 63, c = l & 15, g4 = l >> 4;
    int* idxs = (int*)(smem + w * 5120); float* Pl = (float*)(smem + w * 5120 + 1024);
    const size_t t = (size_t)unit * 4 + w;
    const int cnt = p.CNT[t];
#pragma unroll
    for (int i = 0; i < 4; ++i) idxs[l + 64 * i] = p.IDX[t * 256 + l + 64 * i];
    __builtin_amdgcn_wave_barrier();
    bf16x8 qf[4];
#pragma unroll
    for (int j = 0; j < 4; ++j) qf[j] = *(const bf16x8*)(p.DQ + (t * 4 + (c & 3)) * 128 + g4 * 32 + j * 8);
    f32x4 s[16];
    const int ntile = (cnt + 15) >> 4;
#pragma unroll
    for (int tt = 0; tt < 16; ++tt) {
        s[tt] = (f32x4){0.f, 0.f, 0.f, 0.f};
        if (tt < ntile) {
            const int krow = idxs[tt * 16 + c];
            const bf16_t* kp = p.DK + (size_t)krow * 128 + g4 * 32;
#pragma unroll
            for (int j = 0; j < 4; ++j) s[tt] = mfma16(*(const bf16x8*)(kp + j * 8), qf[j], s[tt]);
        }
        if (tt & 1) __builtin_amdgcn_sched_barrier(0);
    }
    const float cs = 0.08838834764831845f * 1.4426950408889634f;
    float mx = -1e30f;
#pragma unroll
    for (int tt = 0; tt < 16; ++tt)
#pragma unroll
        for (int r = 0; r < 4; ++r) { const int slot = tt * 16 + 4 * g4 + r; if (slot < cnt) mx = fmaxf(mx, s[tt][r] * cs); }
    mx = fmaxf(mx, __shfl_xor(mx, 16)); mx = fmaxf(mx, __shfl_xor(mx, 32));
    float sum = 0.f;
#pragma unroll
    for (int tt = 0; tt < 16; ++tt)
#pragma unroll
        for (int r = 0; r < 4; ++r) { const int slot = tt * 16 + 4 * g4 + r; const float pv = slot < cnt ? exp2f(s[tt][r] * cs - mx) : 0.f; s[tt][r] = pv; sum += pv; }
    sum += __shfl_xor(sum, 16); sum += __shfl_xor(sum, 32);
    const float inv = sum > 0.f ? 1.0f / sum : 0.f;
    if (c < 4) {
#pragma unroll
        for (int tt = 0; tt < 16; ++tt)
#pragma unroll
            for (int r = 0; r < 4; ++r) Pl[(tt * 16 + 4 * g4 + r) * 4 + c] = s[tt][r] * inv;
    }
    __builtin_amdgcn_wave_barrier();
    float acc[4][8];
#pragma unroll
    for (int hh = 0; hh < 4; ++hh)
#pragma unroll
        for (int j = 0; j < 8; ++j) acc[hh][j] = 0.f;
    const int nk4 = (cnt + 3) >> 2;
#pragma unroll 2
    for (int kk = 0; kk < nk4; ++kk) {
        const int slot = kk * 4 + g4;
        const int row = idxs[slot];
        const uint4 raw = *(const uint4*)(p.PROJ + (size_t)row * LDP + C_DV + c * 8);
        const float4 p4 = *(const float4*)(Pl + slot * 4);
        const float vv[8] = {lo2f(raw.x), hi2f(raw.x), lo2f(raw.y), hi2f(raw.y), lo2f(raw.z), hi2f(raw.z), lo2f(raw.w), hi2f(raw.w)};
        const float pp[4] = {p4.x, p4.y, p4.z, p4.w};
#pragma unroll
        for (int hh = 0; hh < 4; ++hh)
#pragma unroll
            for (int j = 0; j < 8; ++j) acc[hh][j] += pp[hh] * vv[j];
    }
#pragma unroll
    for (int hh = 0; hh < 4; ++hh)
#pragma unroll
        for (int j = 0; j < 8; ++j) { float a = acc[hh][j]; a += __shfl_xor(a, 16); a += __shfl_xor(a, 32); acc[hh][j] = a; }
    if (g4 == 0) {
#pragma unroll
        for (int hh = 0; hh < 4; ++hh) {
            uint4 o; o.x = pk2(acc[hh][0], acc[hh][1]); o.y = pk2(acc[hh][2], acc[hh][3]); o.z = pk2(acc[hh][4], acc[hh][5]); o.w = pk2(acc[hh][6], acc[hh][7]);
            *(uint4*)(p.Y + t * D + 1536 + hh * 128 + c * 8) = o;
        }
    }
    __builtin_amdgcn_wave_barrier();
}

DEV void st_peer_topk(const P& p, int layer, int unit, char* smem) {
    const int tid = tidx(), w = tid >> 6, l = tid & 63;
    const int tg = unit >> 2, hp = unit & 3;
    const int head = __builtin_amdgcn_readfirstlane(hp * 2 + (w >> 1)), pp = __builtin_amdgcn_readfirstlane(w & 1);
    unsigned* lst = (unsigned*)smem;
    const size_t t = (size_t)tg * 64 + l;
    float q[64];
#pragma unroll
    for (int i = 0; i < 16; ++i) { const float4 v = *(const float4*)(p.PQ + t * 1024 + head * 128 + pp * 64 + i * 4); q[4 * i] = v.x; q[4 * i + 1] = v.y; q[4 * i + 2] = v.z; q[4 * i + 3] = v.w; }
    const float* K = p.peer_sk + ((((size_t)layer * 8 + head) * 2 + pp) * 128) * 64;
    unsigned top[16];
#pragma unroll
    for (int j = 0; j < 16; ++j) top[j] = 0u;
#pragma unroll 1
    for (int nn = 0; nn < 128; ++nn) {
        float s = 0.f;
#pragma unroll
        for (int d = 0; d < 64; ++d) s += q[d] * K[nn * 64 + d];
        unsigned x = (f2key(s) & ~127u) | (unsigned)(127 - nn);
#pragma unroll
        for (int j = 0; j < 16; ++j) { const unsigned hi = max(top[j], x); x = min(top[j], x); top[j] = hi; }
    }
#pragma unroll
    for (int j = 0; j < 16; ++j) lst[(w * 16 + j) * 64 + l] = top[j];
    __syncthreads();
    if (pp == 0) {
        float v1[16], v2[16]; int i1[16], i2[16];
#pragma unroll
        for (int j = 0; j < 16; ++j) {
            const unsigned k1 = lst[(w * 16 + j) * 64 + l], k2 = lst[((w + 1) * 16 + j) * 64 + l];
            v1[j] = key2f(k1 & ~127u); i1[j] = 127 - (int)(k1 & 127u);
            v2[j] = key2f(k2 & ~127u); i2[j] = 127 - (int)(k2 & 127u);
        }
        float cv[16]; int ce[16];
#pragma unroll
        for (int s = 0; s < 16; ++s) { cv[s] = -__builtin_inff(); ce[s] = 0; }
#pragma unroll
        for (int i = 0; i < 16; ++i)
#pragma unroll
            for (int j = 0; j < 16; ++j)
                if ((i + 1) * (j + 1) <= 16) {
                    float sv = v1[i] + v2[j]; int e = i1[i] * 128 + i2[j];
#pragma unroll
                    for (int s = 0; s < 16; ++s) {
                        const bool gt = sv > cv[s];
                        const float nv = gt ? sv : cv[s]; const int ne = gt ? e : ce[s];
                        sv = gt ? cv[s] : sv; e = gt ? ce[s] : e;
                        cv[s] = nv; ce[s] = ne;
                    }
                }
        float ex[16], sum = 0.f;
#pragma unroll
        for (int s = 0; s < 16; ++s) { ex[s] = __expf(cv[s] - cv[0]); sum += ex[s]; }
        const float inv = 1.0f / sum;
#pragma unroll
        for (int s4 = 0; s4 < 4; ++s4) {
            *(int4*)(p.PE + t * 128 + head * 16 + s4 * 4) = make_int4(ce[4 * s4], ce[4 * s4 + 1], ce[4 * s4 + 2], ce[4 * s4 + 3]);
            *(float4*)(p.PG + t * 128 + head * 16 + s4 * 4) = make_float4(ex[4 * s4] * inv, ex[4 * s4 + 1] * inv, ex[4 * s4 + 2] * inv, ex[4 * s4 + 3] * inv);
        }
    }
    __syncthreads();
}

DEV void st_peer_gather(const P& p, int layer, const float* __restrict__ xin, float* __restrict__ xout, int unit) {
    const int tid_ = tidx(); const int w = tid_ >> 6, l = tid_ & 63; const size_t t = (size_t)unit * 4 + w;
    uint4 hv[4];
#pragma unroll
    for (int i = 0; i < 4; ++i) hv[i] = *(const uint4*)(p.HN + t * D + i * 512 + l * 8);
    float hf[32];
#pragma unroll
    for (int i = 0; i < 4; ++i) { const unsigned u4[4] = {hv[i].x, hv[i].y, hv[i].z, hv[i].w};
#pragma unroll
        for (int q = 0; q < 4; ++q) { hf[i * 8 + 2 * q] = lo2f(u4[q]); hf[i * 8 + 2 * q + 1] = hi2f(u4[q]); } }
    const int e0 = p.PE[t * 128 + l], e1 = p.PE[t * 128 + 64 + l];
    const float g0 = p.PG[t * 128 + l], g1 = p.PG[t * 128 + 64 + l];
    float out[32];
#pragma unroll
    for (int i = 0; i < 32; ++i) out[i] = 0.f;
    const bf16_t* U = p.Utab + (size_t)layer * 16384 * 2048; const bf16_t* V = p.Vtab + (size_t)layer * 16384 * 2048;
#pragma unroll 2
    for (int k = 0; k < 128; ++k) {
        const int e = __builtin_amdgcn_readlane(k < 64 ? e0 : e1, k & 63);
        const float gg = __int_as_float(__builtin_amdgcn_readlane(__float_as_int(k < 64 ? g0 : g1), k & 63));
        const bf16_t* ur = U + (size_t)e * 2048 + l * 8; const bf16_t* vr = V + (size_t)e * 2048 + l * 8;
        uint4 uu[4], vv[4];
#pragma unroll
        for (int i = 0; i < 4; ++i) { uu[i] = *(const uint4*)(ur + i * 512); vv[i] = *(const uint4*)(vr + i * 512); }
        float dot = 0.f;
#pragma unroll
        for (int i = 0; i < 4; ++i) { const unsigned u4[4] = {uu[i].x, uu[i].y, uu[i].z, uu[i].w};
#pragma unroll
            for (int q = 0; q < 4; ++q) dot += lo2f(u4[q]) * hf[i * 8 + 2 * q] + hi2f(u4[q]) * hf[i * 8 + 2 * q + 1]; }
        dot = wsum(dot);
        const float a = gelu_tanh(dot) * gg;
#pragma unroll
        for (int i = 0; i < 4; ++i) { const unsigned v4[4] = {vv[i].x, vv[i].y, vv[i].z, vv[i].w};
#pragma unroll
            for (int q = 0; q < 4; ++q) { out[i * 8 + 2 * q] += a * lo2f(v4[q]); out[i * 8 + 2 * q + 1] += a * hi2f(v4[q]); } }
    }
    const float* g2 = p.ada + layer * 12288 + 5 * 2048;
#pragma unroll
    for (int i = 0; i < 4; ++i) {
        const size_t off = t * D + i * 512 + l * 8;
        const float4 x0 = *(const float4*)(xin + off), x1 = *(const float4*)(xin + off + 4);
        const float4 ga = *(const float4*)(g2 + i * 512 + l * 8), gb = *(const float4*)(g2 + i * 512 + l * 8 + 4);
        float4 o0, o1;
        o0.x = x0.x + ga.x * out[i * 8 + 0]; o0.y = x0.y + ga.y * out[i * 8 + 1]; o0.z = x0.z + ga.z * out[i * 8 + 2]; o0.w = x0.w + ga.w * out[i * 8 + 3];
        o1.x = x1.x + gb.x * out[i * 8 + 4]; o1.y = x1.y + gb.y * out[i * 8 + 5]; o1.z = x1.z + gb.z * out[i * 8 + 6]; o1.w = x1.w + gb.w * out[i * 8 + 7];
        *(float4*)(xout + off) = o0; *(float4*)(xout + off + 4) = o1;
    }
}

enum { S_CONVT_IN = 0, S_CONVT_OUT, S_CONVT_Q, S_TAB_U, S_TAB_V, S_ADA, S_ROPE, S_NORM1, S_GEMM_IN, S_CONV, S_SGU, S_VTRANS, S_PREP,
       S_COMPRESS, S_NSA_CMP, S_DSA_INDEX, S_NSA_ATTN, S_DSA_ATTN, S_GEMM_OUT, S_NORM2, S_GEMM_Q, S_PEER_TOPK, S_PEER_GATHER, S_COUNT };
constexpr int TAB_UNITS = 4096;
__host__ __device__ constexpr int nunits(int s) {
    return s == S_CONVT_IN ? 2 * 32 * (LDP / 64) : s == S_CONVT_OUT ? 2 * 32 * 32 : s == S_CONVT_Q ? 2 * 32 * 16 : s == S_TAB_U ? TAB_UNITS : s == S_TAB_V ? TAB_UNITS
         : s == S_ADA ? 768 : s == S_ROPE ? 768 : s == S_NORM1 ? 2048 : s == S_GEMM_IN ? 64 * (LDP / 128) : s == S_CONV ? 512 : s == S_SGU ? 256
         : s == S_VTRANS ? 256 : s == S_PREP ? 2048 : s == S_COMPRESS ? 128 : s == S_NSA_CMP ? 512 : s == S_DSA_INDEX ? 512 : s == S_NSA_ATTN ? 256 : s == S_DSA_ATTN ? 2048
         : s == S_GEMM_OUT ? 64 * 16 : s == S_NORM2 ? 2048 : s == S_GEMM_Q ? 64 * 8 : s == S_PEER_TOPK ? 512 : s == S_PEER_GATHER ? 2048 : 0;
}
template <int S>
DEV void run_unit(const P& p, int layer, int u, char* smem, int nu = TAB_UNITS) {
    const float* xin = layer == 0 ? p.x : p.X2;
    const float* ada = p.ada + layer * 12288;
    if constexpr (S == S_CONVT_IN) { const int per = 32 * (LDP / 64), ly = u / per; st_convT(p.w_in + (size_t)ly * 2048 * INC, p.WinT + (size_t)ly * LDP * 2048, INC, LDP, true, u % per, smem); }
    else if constexpr (S == S_CONVT_OUT) { const int per = 32 * 32, ly = u / per; st_convT(p.w_out + (size_t)ly * 2048 * 2048, p.WoutT + (size_t)ly * 2048 * 2048, 2048, 2048, false, u % per, smem); }
    else if constexpr (S == S_CONVT_Q) { const int per = 32 * 16, ly = u / per; st_convT(p.peer_wq + (size_t)ly * 2048 * 1024, p.WqT + (size_t)ly * 1024 * 2048, 1024, 1024, false, u % per, smem); }
    else if constexpr (S == S_TAB_U) st_tab(p.peer_u, p.Utab, (size_t)2 * 16384 * 2048 / 8, u, nu);
    else if constexpr (S == S_TAB_V) st_tab(p.peer_v, p.Vtab, (size_t)2 * 16384 * 2048 / 8, u, nu);
    else if constexpr (S == S_ADA) st_ada(p, u, smem);
    else if constexpr (S == S_ROPE) st_rope(p, u);
    else if constexpr (S == S_NORM1) st_norm(xin, p.n1g + layer * 2048, ada + 2048, ada, p.HN, u);
    else if constexpr (S == S_GEMM_IN) { EpiArgs e{p.PROJ, nullptr, nullptr, nullptr}; st_gemm<EPI_PROJ>(p.HN, p.WinT + (size_t)layer * LDP * 2048, 2048, u & 63, u >> 6, e, smem); }
    else if constexpr (S == S_CONV) st_conv(p, layer, u, smem);
    else if constexpr (S == S_SGU) st_sgu(p, layer, u, smem);
    else if constexpr (S == S_VTRANS) st_vtrans(p, u, smem);
    else if constexpr (S == S_PREP) st_prep(p, layer, u);
    else if constexpr (S == S_COMPRESS) st_compress(p, layer, u, smem);
    else if constexpr (S == S_NSA_CMP) st_nsa_cmp(p, u, smem);
    else if constexpr (S == S_DSA_INDEX) st_dsa_index(p, u, smem);
    else if constexpr (S == S_NSA_ATTN) st_nsa_attn(p, u, smem);
    else if constexpr (S == S_DSA_ATTN) st_dsa_attn(p, u, smem);
    else if constexpr (S == S_GEMM_OUT) { EpiArgs e{nullptr, p.X1, xin, ada + 2 * 2048}; st_gemm<EPI_OUT>(p.Y, p.WoutT + (size_t)layer * 2048 * 2048, 2048, u & 63, u >> 6, e, smem); }
    else if constexpr (S == S_NORM2) st_norm(p.X1, p.n2g + layer * 2048, ada + 4 * 2048, ada + 3 * 2048, p.HN, u);
    else if constexpr (S == S_GEMM_Q) { EpiArgs e{nullptr, p.PQ, nullptr, nullptr}; st_gemm<EPI_Q>(p.HN, p.WqT + (size_t)layer * 1024 * 2048, 2048, u & 63, u >> 6, e, smem); }
    else if constexpr (S == S_PEER_TOPK) st_peer_topk(p, layer, u, smem);
    else if constexpr (S == S_PEER_GATHER) st_peer_gather(p, layer, p.X1, layer == 0 ? p.X2 : p.out, u);
}

#ifndef MULTI_LAUNCH
template <int S>
DEV void run_phase(const P& p, int layer, char* smem, int off = 0) {
    const int G = gridDim.x;
    int b = blockIdx.x + off; if (b >= G) b -= G;
    if constexpr (S == S_TAB_U || S == S_TAB_V) { run_unit<S>(p, layer, b, smem, G); }
    else {
        for (int u = b; u < nunits(S); u += G) { run_unit<S>(p, layer, u, smem); __syncthreads(); }
    }
}
#define GSYNC() grid.sync()
__global__ void __launch_bounds__(NTHREADS) k_mega(P p) {
    __shared__ __attribute__((aligned(16))) char smem[SMEM_BYTES];
    cg::grid_group grid = cg::this_grid();
    const int H = gridDim.x >> 1, Q = gridDim.x >> 2;
    run_phase<S_ADA>(p, 0, smem); run_phase<S_ROPE>(p, 0, smem, H);
    run_phase<S_CONVT_IN>(p, 0, smem); run_phase<S_CONVT_OUT>(p, 0, smem); run_phase<S_CONVT_Q>(p, 0, smem);
    run_phase<S_TAB_U>(p, 0, smem); run_phase<S_TAB_V>(p, 0, smem);
    GSYNC();
#pragma unroll 1
    for (int layer = 0; layer < NL; ++layer) {
        run_phase<S_NORM1>(p, layer, smem); GSYNC();
        run_phase<S_GEMM_IN>(p, layer, smem); GSYNC();
        run_phase<S_COMPRESS>(p, layer, smem); run_phase<S_SGU>(p, layer, smem, Q); run_phase<S_VTRANS>(p, layer, smem, H + Q);
        run_phase<S_CONV>(p, layer, smem); run_phase<S_PREP>(p, layer, smem); GSYNC();
        run_phase<S_DSA_INDEX>(p, layer, smem); run_phase<S_NSA_CMP>(p, layer, smem); GSYNC();
        run_phase<S_NSA_ATTN>(p, layer, smem); run_phase<S_DSA_ATTN>(p, layer, smem, H); GSYNC();
        run_phase<S_GEMM_OUT>(p, layer, smem); GSYNC();
        run_phase<S_NORM2>(p, layer, smem); GSYNC();
        run_phase<S_GEMM_Q>(p, layer, smem); GSYNC();
        run_phase<S_PEER_TOPK>(p, layer, smem); GSYNC();
        run_phase<S_PEER_GATHER>(p, layer, smem); GSYNC();
    }
}
#else
template <int S>
__global__ void __launch_bounds__(NTHREADS) k_stage(P p, int layer) {
    __shared__ __attribute__((aligned(16))) char smem[SMEM_BYTES];
    run_unit<S>(p, layer, blockIdx.x, smem);
}
template <int S> static void launch_stage(const P& p, int layer, hipStream_t st) {
    hipLaunchKernelGGL((k_stage<S>), dim3(nunits(S)), dim3(NTHREADS), 0, st, p, layer);
}
#endif

extern "C" void kernel_launch(void* const* d_in, const int* in_sizes, int n_in, void* d_out, int out_size, void* d_ws, size_t ws_size, hipStream_t stream) {
    P p{};
    p.x = (const float*)d_in[0]; p.c = (const float*)d_in[1]; p.pos = (const int*)d_in[2]; p.ada_w = (const float*)d_in[3]; p.ada_b = (const float*)d_in[4];
    p.n1g = (const float*)d_in[5]; p.n2g = (const float*)d_in[6]; p.w_in = (const float*)d_in[7]; p.w_out = (const float*)d_in[8]; p.conv_w = (const float*)d_in[9];
    p.conv_b = (const float*)d_in[10]; p.cln_g = (const float*)d_in[11]; p.cln_b = (const float*)d_in[12]; p.sln_g = (const float*)d_in[13]; p.sln_b = (const float*)d_in[14];
    p.sgu_w = (const float*)d_in[15]; p.sgu_b = (const float*)d_in[16]; p.nsa_qg = (const float*)d_in[17]; p.nsa_kg = (const float*)d_in[18]; p.cmp_pos = (const float*)d_in[19];
    p.cmp_w1 = (const float*)d_in[20]; p.cmp_w2 = (const float*)d_in[21]; p.dsa_qg = (const float*)d_in[22]; p.dsa_kg = (const float*)d_in[23]; p.peer_wq = (const float*)d_in[24];
    p.peer_sk = (const float*)d_in[25]; p.peer_u = (const float*)d_in[26]; p.peer_v = (const float*)d_in[27];
    p.out = (float*)d_out;
    char* wsp = (char*)d_ws; size_t off = 0;
    auto carve = [&](size_t bytes) { char* r = wsp + off; off += (bytes + 255) & ~(size_t)255; return r; };
    p.WinT = (bf16_t*)carve((size_t)2 * LDP * 2048 * 2); p.WoutT = (bf16_t*)carve((size_t)2 * 2048 * 2048 * 2); p.WqT = (bf16_t*)carve((size_t)2 * 1024 * 2048 * 2);
    p.Utab = (bf16_t*)carve((size_t)2 * 16384 * 2048 * 2); p.Vtab = (bf16_t*)carve((size_t)2 * 16384 * 2048 * 2);
    p.ada = (float*)carve((size_t)2 * 12288 * 4);
    p.ropeC = (float*)carve((size_t)T * 24 * 4); p.ropeS = (float*)carve((size_t)T * 24 * 4);
    p.HN = (bf16_t*)carve((size_t)T * D * 2); p.PROJ = (bf16_t*)carve((size_t)T * LDP * 2); p.Y = (bf16_t*)carve((size_t)T * D * 2);
    p.QN = (bf16_t*)carve((size_t)T * 512 * 2); p.QR = (bf16_t*)carve((size_t)T * 512 * 2); p.KS = (bf16_t*)carve((size_t)T * 128 * 2); p.KW = (bf16_t*)carve((size_t)T * 128 * 2);
    p.VST = (bf16_t*)carve((size_t)T * 128 * 2); p.VWT = (bf16_t*)carve((size_t)T * 128 * 2); p.GATES = (float*)carve((size_t)T * 12 * 4);
    p.KC = (bf16_t*)carve((size_t)512 * 128 * 2); p.VCT = (bf16_t*)carve((size_t)128 * 512 * 2); p.SEL = (unsigned*)carve((size_t)T * 4 * 4); p.OCMP = (bf16_t*)carve((size_t)T * 512 * 2);
    p.DQ = (bf16_t*)carve((size_t)T * 512 * 2); p.DK = (bf16_t*)carve((size_t)T * 128 * 2); p.IQ = (bf16_t*)carve((size_t)T * 512 * 2); p.IK = (bf16_t*)carve((size_t)T * 64 * 2);
    p.IW = (float*)carve((size_t)T * 8 * 4); p.IDX = (int*)carve((size_t)T * 256 * 4); p.CNT = (int*)carve((size_t)T * 4);
    p.X1 = (float*)carve((size_t)T * D * 4); p.X2 = (float*)carve((size_t)T * D * 4); p.PQ = (float*)carve((size_t)T * 1024 * 4);
    p.PE = (int*)carve((size_t)T * 128 * 4); p.PG = (float*)carve((size_t)T * 128 * 4);
    if (off > ws_size) { fprintf(stderr, "workspace too small: need %zu have %zu\n", off, ws_size); return; }
#ifndef MULTI_LAUNCH
    static int grid_blocks = 0;
    if (!grid_blocks) {
        int dev = 0, cus = 0, per_cu = 0;
        hipGetDevice(&dev);
        hipDeviceGetAttribute(&cus, hipDeviceAttributeMultiprocessorCount, dev);
        hipOccupancyMaxActiveBlocksPerMultiprocessor(&per_cu, k_mega, NTHREADS, 0);
        if (per_cu > 2) per_cu = 2;
        grid_blocks = cus * per_cu;
    }
    void* args[] = {&p};
    hipError_t e = hipLaunchCooperativeKernel((void*)k_mega, dim3(grid_blocks), dim3(NTHREADS), args, 0, stream);
    if (e != hipSuccess) fprintf(stderr, "cooperative launch failed: %s (grid %d)\n", hipGetErrorString(e), grid_blocks);
#else
    launch_stage<S_CONVT_IN>(p, 0, stream); launch_stage<S_CONVT_OUT>(p, 0, stream); launch_stage<S_CONVT_Q>(p, 0, stream);
    launch_stage<S_TAB_U>(p, 0, stream); launch_stage<S_TAB_V>(p, 0, stream);
    launch_stage<S_ADA>(p, 0, stream); launch_stage<S_ROPE>(p, 0, stream);
    for (int layer = 0; layer < NL; ++layer) {
        launch_stage<S_NORM1>(p, layer, stream); launch_stage<S_GEMM_IN>(p, layer, stream);
        launch_stage<S_CONV>(p, layer, stream); launch_stage<S_SGU>(p, layer, stream); launch_stage<S_VTRANS>(p, layer, stream);
        launch_stage<S_PREP>(p, layer, stream); launch_stage<S_COMPRESS>(p, layer, stream);
        launch_stage<S_NSA_CMP>(p, layer, stream); launch_stage<S_DSA_INDEX>(p, layer, stream);
        launch_stage<S_NSA_ATTN>(p, layer, stream); launch_stage<S_DSA_ATTN>(p, layer, stream);
        launch_stage<S_GEMM_OUT>(p, layer, stream); launch_stage<S_NORM2>(p, layer, stream); launch_stage<S_GEMM_Q>(p, layer, stream);
        launch_stage<S_PEER_TOPK>(p, layer, stream); launch_stage<S_PEER_GATHER>(p, layer, stream);
    }
#endif
}
```

```cpp
#include <hip/hip_runtime.h>
#include <hip/hip_cooperative_groups.h>
#include <stdint.h>
#include <cstdio>
namespace cg = cooperative_groups;

typedef unsigned short bf16_t;
typedef short bf16x8 __attribute__((ext_vector_type(8)));
typedef float f32x4 __attribute__((ext_vector_type(4)));
typedef float f32x16 __attribute__((ext_vector_type(16)));
#define DEV __device__ __forceinline__

constexpr int T = 8192, D = 2048, NL = 2;
constexpr int INC = 4692;
constexpr int LDP = 4736;
constexpr int C_CA = 0, C_CG = 512, C_SU = 1024, C_SV = 1536;
constexpr int C_NQ = 2048, C_NKC = 2560, C_NVC = 2688, C_NKS = 2816, C_NVS = 2944, C_NKW = 3072, C_NVW = 3200;
constexpr int C_DQ = 3328, C_DK = 3840, C_DV = 3968, C_IQ = 4096, C_IK = 4608, C_NG = 4672, C_IW = 4688;
constexpr float EPS = 1e-6f;
constexpr int NTHREADS = 256;
constexpr int SMEM_BYTES = 72 * 1024;

__device__ const double INV16[16] = {1.0, 0.44036660267178046, 0.19392274474868576, 0.08539710028576561, 0.03760603093086393,
    0.016560440080994446, 0.007292664737217109, 0.003211445994752591, 0.001414213562373095, 0.000622772421914596,
    0.0002742481756762073, 0.00012076973741146504, 5.318295896944988e-05, 2.341999896140934e-05, 1.031338537721246e-05,
    4.5416704806078695e-06};

struct P {
    const float* x; const float* c; const int* pos; const float* ada_w; const float* ada_b; const float* n1g; const float* n2g;
    const float* w_in; const float* w_out; const float* conv_w; const float* conv_b; const float* cln_g; const float* cln_b;
    const float* sln_g; const float* sln_b; const float* sgu_w; const float* sgu_b; const float* nsa_qg; const float* nsa_kg;
    const float* cmp_pos; const float* cmp_w1; const float* cmp_w2; const float* dsa_qg; const float* dsa_kg;
    const float* peer_wq; const float* peer_sk; const float* peer_u; const float* peer_v;
    float* out;
    bf16_t* WinT; bf16_t* WoutT; bf16_t* WqT; unsigned char* Utab; unsigned char* Vtab;
    float* ada; float* ropeC; float* ropeS;
    bf16_t* HN; bf16_t* PROJ; bf16_t* Y;
    bf16_t* QN; bf16_t* QR; bf16_t* KS; bf16_t* KW; bf16_t* VST; bf16_t* VWT; float* GATES;
    bf16_t* KC; bf16_t* VCT; unsigned* SEL; bf16_t* OCMP;
    bf16_t* DQ; bf16_t* DK; bf16_t* IQ; bf16_t* IK; float* IW; int* IDX; int* CNT;
    float* X1; float* X2; float* PQ; int* PE; float* PG; unsigned* bar;
};

DEV float bf2f(bf16_t v) { return __uint_as_float(((unsigned)v) << 16); }
DEV unsigned pk2(float lo, float hi) { unsigned r; asm("v_cvt_pk_bf16_f32 %0, %1, %2" : "=v"(r) : "v"(lo), "v"(hi)); return r; }
DEV bf16_t f2bf(float v) { return (bf16_t)(pk2(v, 0.f) & 0xffffu); }
DEV float lo2f(unsigned u) { return __uint_as_float(u << 16); }
DEV float hi2f(unsigned u) { return __uint_as_float(u & 0xffff0000u); }
DEV float wsum(float v) {
#pragma unroll
    for (int o = 32; o > 0; o >>= 1) v += __shfl_xor(v, o);
    return v;
}
DEV float wmax(float v) {
#pragma unroll
    for (int o = 32; o > 0; o >>= 1) v = fmaxf(v, __shfl_xor(v, o));
    return v;
}
DEV int tidx() { int t = threadIdx.x; asm volatile("" : "+v"(t)); return t; }
DEV float sigmoidf_(float x) { return 1.0f / (1.0f + __expf(-x)); }
DEV float gelu_tanh(float x) {
    const float y = 0.7978845608028654f * (x + 0.044715f * x * x * x);
    const float t = 1.0f - 2.0f / (1.0f + __expf(2.0f * y));
    return 0.5f * x * (1.0f + t);
}
DEV f32x4 mfma16(bf16x8 a, bf16x8 b, f32x4 c) { return __builtin_amdgcn_mfma_f32_16x16x32_bf16(a, b, c, 0, 0, 0); }
DEV f32x16 mfma32(bf16x8 a, bf16x8 b, f32x16 c) { return __builtin_amdgcn_mfma_f32_32x32x16_bf16(a, b, c, 0, 0, 0); }

DEV int src_col(int n) {
    if (n < 3328) return n;
    if (n < 4672) return 3340 + (n - 3328);
    if (n < 4684) return 3328 + (n - 4672);
    if (n < 4688) return -1;
    if (n < 4696) return 4684 + (n - 4688);
    return -1;
}

DEV void st_convT(const float* __restrict__ W, bf16_t* __restrict__ Bt, int N, int Npad, bool remap, int unit, char* smem) {
    float (*tile)[65] = (float (*)[65])smem;
    const int ntn = Npad / 64, kt = unit / ntn, nt = unit % ntn, k0 = kt * 64, n0 = nt * 64;
    const int tid_ = tidx(); const int tx = tid_ & 63, ty = tid_ >> 6;
    const int n = n0 + tx;
    const int src = remap ? src_col(n) : (n < N ? n : -1);
#pragma unroll
    for (int i = 0; i < 16; ++i) { const int k = ty + 4 * i; tile[k][tx] = src >= 0 ? W[(size_t)(k0 + k) * N + src] : 0.f; }
    __syncthreads();
#pragma unroll
    for (int i = 0; i < 16; ++i) { const int r = ty + 4 * i; Bt[(size_t)(n0 + r) * 2048 + k0 + tx] = f2bf(tile[tx][r]); }
    __syncthreads();
}

typedef float f32x2 __attribute__((ext_vector_type(2)));
DEV void st_tab(const float* __restrict__ src, unsigned char* __restrict__ dst, float scale, size_t n16, int unit, int nunits) {
    const int tid_ = tidx();
    for (size_t g = (size_t)unit * NTHREADS + tid_; g < n16; g += (size_t)nunits * NTHREADS) {
        const float4* sp = (const float4*)src + 4 * g;
        const float4 a = sp[0], b = sp[1], c = sp[2], d = sp[3];
        int w0 = __builtin_amdgcn_cvt_pk_fp8_f32(a.x * scale, a.y * scale, 0, false); w0 = __builtin_amdgcn_cvt_pk_fp8_f32(a.z * scale, a.w * scale, w0, true);
        int w1 = __builtin_amdgcn_cvt_pk_fp8_f32(b.x * scale, b.y * scale, 0, false); w1 = __builtin_amdgcn_cvt_pk_fp8_f32(b.z * scale, b.w * scale, w1, true);
        int w2 = __builtin_amdgcn_cvt_pk_fp8_f32(c.x * scale, c.y * scale, 0, false); w2 = __builtin_amdgcn_cvt_pk_fp8_f32(c.z * scale, c.w * scale, w2, true);
        int w3 = __builtin_amdgcn_cvt_pk_fp8_f32(d.x * scale, d.y * scale, 0, false); w3 = __builtin_amdgcn_cvt_pk_fp8_f32(d.z * scale, d.w * scale, w3, true);
        ((uint4*)dst)[g] = make_uint4((unsigned)w0, (unsigned)w1, (unsigned)w2, (unsigned)w3);
    }
}
constexpr float U8_SCALE = 64.0f, V8_SCALE = 4.0f;

DEV void st_ada(const P& p, int unit, char* smem) {
    float* red = (float*)smem;
    const int tid = tidx(), c = tid & 31, ks = tid >> 5;
    const int i = unit / 384, j = (unit % 384) * 32 + c;
    const float* W = p.ada_w + (size_t)i * 2048 * 12288 + (size_t)(ks * 256) * 12288 + j;
    float acc = 0.f;
#pragma unroll 8
    for (int k = 0; k < 256; ++k) {
        const float cv = p.c[ks * 256 + k];
        acc += (cv * sigmoidf_(cv)) * W[(size_t)k * 12288];
    }
    red[ks * 32 + c] = acc;
    __syncthreads();
    if (tid < 32) {
        float r = p.ada_b[i * 12288 + j];
#pragma unroll
        for (int q = 0; q < 8; ++q) r += red[q * 32 + tid];
        p.ada[i * 12288 + j] = r;
    }
    __syncthreads();
}
DEV void st_rope(const P& p, int unit) {
    const int e = unit * 256 + tidx(); const int t = e / 24, i = e % 24;
    const double inv = i < 16 ? INV16[i] : INV16[2 * (i - 16)];
    const double ang = (double)p.pos[t] * inv;
    const double n = rint(ang * 0.15915494309189535);
    const double r = ang - n * 6.283185307179586;
    const double r2 = r * r;
    double sp = 1.0 / 1.5511210043330986e25, cp = -1.0 / 4.0329146112660565e26;
    sp = sp * r2 - 1.0 / 2.585201673888498e22;   cp = cp * r2 + 1.0 / 6.204484017332394e23;
    sp = sp * r2 + 1.0 / 5.109094217170944e19;   cp = cp * r2 - 1.0 / 1.1240007277776077e21;
    sp = sp * r2 - 1.0 / 1.21645100408832e17;    cp = cp * r2 + 1.0 / 2.43290200817664e18;
    sp = sp * r2 + 1.0 / 3.55687428096e14;       cp = cp * r2 - 1.0 / 6.402373705728e15;
    sp = sp * r2 - 1.0 / 1.307674368e12;         cp = cp * r2 + 1.0 / 2.0922789888e13;
    sp = sp * r2 + 1.0 / 6.2270208e9;            cp = cp * r2 - 1.0 / 8.71782912e10;
    sp = sp * r2 - 1.0 / 3.99168e7;              cp = cp * r2 + 1.0 / 4.790016e8;
    sp = sp * r2 + 1.0 / 362880.0;               cp = cp * r2 - 1.0 / 3628800.0;
    sp = sp * r2 - 1.0 / 5040.0;                 cp = cp * r2 + 1.0 / 40320.0;
    sp = sp * r2 + 1.0 / 120.0;                  cp = cp * r2 - 1.0 / 720.0;
    sp = sp * r2 - 1.0 / 6.0;                    cp = cp * r2 + 1.0 / 24.0;
    sp = sp * r2 + 1.0;                          cp = cp * r2 - 0.5;
    cp = cp * r2 + 1.0;
    const float cs = (float)cp, sn = (float)(sp * r);
    p.ropeC[e] = cs; p.ropeS[e] = sn;
}

DEV void st_norm(const float* __restrict__ X, const float* __restrict__ g, const float* __restrict__ sc, const float* __restrict__ sh,
                 bf16_t* __restrict__ HN, int unit) {
    const int tid_ = tidx(); const int w = tid_ >> 6, l = tid_ & 63; const int t = unit * 4 + w;
    const float4* xr = (const float4*)(X + (size_t)t * D);
    float4 v[8]; float ss = 0.f;
#pragma unroll
    for (int i = 0; i < 4; ++i) { v[2 * i] = xr[i * 128 + l * 2]; v[2 * i + 1] = xr[i * 128 + l * 2 + 1]; }
#pragma unroll
    for (int i = 0; i < 8; ++i) ss += v[i].x * v[i].x + v[i].y * v[i].y + v[i].z * v[i].z + v[i].w * v[i].w;
    ss = wsum(ss);
    const float rs = rsqrtf(ss * (1.0f / 2048.0f) + EPS);
#pragma unroll
    for (int i = 0; i < 4; ++i) {
        const int col = i * 512 + l * 8;
        float y[8]; const float xv[8] = {v[2 * i].x, v[2 * i].y, v[2 * i].z, v[2 * i].w, v[2 * i + 1].x, v[2 * i + 1].y, v[2 * i + 1].z, v[2 * i + 1].w};
#pragma unroll
        for (int j = 0; j < 8; ++j) y[j] = (xv[j] * rs) * g[col + j] * (1.0f + sc[col + j]) + sh[col + j];
        uint4 o; o.x = pk2(y[0], y[1]); o.y = pk2(y[2], y[3]); o.z = pk2(y[4], y[5]); o.w = pk2(y[6], y[7]);
        *(uint4*)(HN + (size_t)t * D + col) = o;
    }
}

enum { EPI_PROJ = 0, EPI_OUT = 1, EPI_Q = 2 };
struct EpiArgs { bf16_t* obf; float* of; const float* xin; const float* gate; };
template <int EPI>
DEV void st_gemm(const bf16_t* __restrict__ A, const bf16_t* __restrict__ Bt, int K, int tm, int tn, const EpiArgs& e, char* smem) {
    constexpr int RS = 144;
    char* As = smem; char* Bs = smem + 128 * RS;
    const int tid = tidx(), w = tid >> 6, l = tid & 63, wr = w >> 1, wc = w & 1;
    f32x4 acc[4][4];
#pragma unroll
    for (int m = 0; m < 4; ++m)
#pragma unroll
        for (int n = 0; n < 4; ++n) acc[m][n] = (f32x4){0.f, 0.f, 0.f, 0.f};
    const int lrow = tid >> 3, lc16 = tid & 7;
    const bf16_t* Ag = A + (size_t)(tm * 128 + lrow) * K + lc16 * 8;
    const bf16_t* Bg = Bt + (size_t)(tn * 128 + lrow) * K + lc16 * 8;
    uint4 ra0, ra1, ra2, ra3, rb0, rb1, rb2, rb3;
#define GLOAD(KO) do { \
    ra0 = *(const uint4*)(Ag + (KO)); ra1 = *(const uint4*)(Ag + (size_t)32 * K + (KO)); ra2 = *(const uint4*)(Ag + (size_t)64 * K + (KO)); ra3 = *(const uint4*)(Ag + (size_t)96 * K + (KO)); \
    rb0 = *(const uint4*)(Bg + (KO)); rb1 = *(const uint4*)(Bg + (size_t)32 * K + (KO)); rb2 = *(const uint4*)(Bg + (size_t)64 * K + (KO)); rb3 = *(const uint4*)(Bg + (size_t)96 * K + (KO)); } while (0)
    GLOAD(0);
    const int nk = K / 64;
    for (int kt = 0; kt < nk; ++kt) {
        __syncthreads();
        *(uint4*)(As + (lrow) * RS + lc16 * 16) = ra0; *(uint4*)(As + (lrow + 32) * RS + lc16 * 16) = ra1;
        *(uint4*)(As + (lrow + 64) * RS + lc16 * 16) = ra2; *(uint4*)(As + (lrow + 96) * RS + lc16 * 16) = ra3;
        *(uint4*)(Bs + (lrow) * RS + lc16 * 16) = rb0; *(uint4*)(Bs + (lrow + 32) * RS + lc16 * 16) = rb1;
        *(uint4*)(Bs + (lrow + 64) * RS + lc16 * 16) = rb2; *(uint4*)(Bs + (lrow + 96) * RS + lc16 * 16) = rb3;
        __syncthreads();
        if (kt + 1 < nk) GLOAD((kt + 1) * 64);
#pragma unroll
        for (int ks = 0; ks < 2; ++ks) {
            bf16x8 af[4], bfr[4];
#pragma unroll
            for (int m = 0; m < 4; ++m) af[m] = *(const bf16x8*)(As + (wr * 64 + m * 16 + (l & 15)) * RS + (ks * 32 + (l >> 4) * 8) * 2);
#pragma unroll
            for (int n = 0; n < 4; ++n) bfr[n] = *(const bf16x8*)(Bs + (wc * 64 + n * 16 + (l & 15)) * RS + (ks * 32 + (l >> 4) * 8) * 2);
#pragma unroll
            for (int m = 0; m < 4; ++m)
#pragma unroll
                for (int n = 0; n < 4; ++n) acc[m][n] = mfma16(bfr[n], af[m], acc[m][n]);
        }
    }
#pragma unroll
    for (int m = 0; m < 4; ++m) {
        const int row = tm * 128 + wr * 64 + m * 16 + (l & 15);
#pragma unroll
        for (int n = 0; n < 4; ++n) {
            const int col = tn * 128 + wc * 64 + n * 16 + 4 * (l >> 4);
            const f32x4 a = acc[m][n];
            if (EPI == EPI_PROJ) {
                uint2 o; o.x = pk2(a[0], a[1]); o.y = pk2(a[2], a[3]);
                *(uint2*)(e.obf + (size_t)row * LDP + col) = o;
            } else if (EPI == EPI_OUT) {
                const float4 xi = *(const float4*)(e.xin + (size_t)row * D + col);
                const float4 gg = *(const float4*)(e.gate + col);
                float4 o; o.x = xi.x + gg.x * a[0]; o.y = xi.y + gg.y * a[1]; o.z = xi.z + gg.z * a[2]; o.w = xi.w + gg.w * a[3];
                *(float4*)(e.of + (size_t)row * D + col) = o;
            } else {
                float4 o; o.x = a[0]; o.y = a[1]; o.z = a[2]; o.w = a[3];
                *(float4*)(e.of + (size_t)row * 1024 + col) = o;
            }
        }
    }
    __syncthreads();
}

DEV void st_conv(const P& p, int layer, int unit, char* smem) {
    float* cs = (float*)smem;
    const int tid = tidx(), t0 = unit * 16;
    const float* cw = p.conv_w + (size_t)layer * 31 * 512;
#pragma unroll 1
    for (int cc = 0; cc < 2; ++cc) {
        const int c = tid + 256 * cc;
        float w[31], z[46];
#pragma unroll
        for (int k = 0; k < 31; ++k) w[k] = cw[k * 512 + c];
#pragma unroll
        for (int r = 0; r < 46; ++r) {
            const int t = t0 - 30 + r;
            float zz = 0.f;
            if (t >= 0) {
                const float a = bf2f(p.PROJ[(size_t)t * LDP + C_CA + c]), g = bf2f(p.PROJ[(size_t)t * LDP + C_CG + c]);
                zz = a * sigmoidf_(g);
            }
            z[r] = zz;
        }
        const float cb = p.conv_b[layer * 512 + c];
#pragma unroll
        for (int tt = 0; tt < 16; ++tt) {
            float acc = cb;
#pragma unroll
            for (int k = 0; k < 31; ++k) acc += w[k] * z[tt + k];
            cs[tt * 512 + c] = acc;
        }
    }
    __syncthreads();
    const int w = tid >> 6, l = tid & 63;
    const float* lg = p.cln_g + layer * 512; const float* lb = p.cln_b + layer * 512;
#pragma unroll 1
    for (int q = 0; q < 4; ++q) {
        const int tt = w * 4 + q;
        float v[8]; float s = 0.f;
#pragma unroll
        for (int i = 0; i < 8; ++i) { v[i] = cs[tt * 512 + l + 64 * i]; s += v[i]; }
        const float mean = wsum(s) * (1.0f / 512.0f);
        float q2 = 0.f;
#pragma unroll
        for (int i = 0; i < 8; ++i) { const float d = v[i] - mean; q2 += d * d; }
        const float rstd = rsqrtf(wsum(q2) * (1.0f / 512.0f) + EPS);
#pragma unroll
        for (int i = 0; i < 8; ++i) {
            const int c = l + 64 * i;
            const float y = (v[i] - mean) * rstd * lg[c] + lb[c];
            p.Y[(size_t)(t0 + tt) * D + c] = f2bf(y * sigmoidf_(y));
        }
    }
    __syncthreads();
}

DEV void st_sgu(const P& p, int layer, int unit, char* smem) {
    const int n = unit >> 2, h = unit & 3, tid = tidx(), w = tid >> 6, l = tid & 63;
    float* stat = (float*)smem;
    float* wt = stat + 256;
    float* vt = wt + 16 * 132;
    const int tb = n * 128;
#pragma unroll 1
    for (int q = 0; q < 32; ++q) {
        const int j = w * 32 + q;
        const uint4 raw = *(const uint4*)(p.PROJ + (size_t)(tb + j) * LDP + C_SV + l * 8);
        float v[8] = {lo2f(raw.x), hi2f(raw.x), lo2f(raw.y), hi2f(raw.y), lo2f(raw.z), hi2f(raw.z), lo2f(raw.w), hi2f(raw.w)};
        float s = 0.f;
#pragma unroll
        for (int i = 0; i < 8; ++i) s += v[i];
        const float mean = wsum(s) * (1.0f / 512.0f);
        float q2 = 0.f;
#pragma unroll
        for (int i = 0; i < 8; ++i) { const float d = v[i] - mean; q2 += d * d; }
        const float rstd = rsqrtf(wsum(q2) * (1.0f / 512.0f) + EPS);
        if (l == 0) { stat[j * 2] = mean; stat[j * 2 + 1] = rstd; }
    }
    __syncthreads();
    const int ti = tid >> 4, td = tid & 15;
    float acc[8][8];
#pragma unroll
    for (int a = 0; a < 8; ++a)
#pragma unroll
        for (int b = 0; b < 8; ++b) acc[a][b] = 0.f;
    const float* Wh = p.sgu_w + ((size_t)layer * 4 + h) * 128 * 128;
    const float* lg = p.sln_g + layer * 512 + h * 128; const float* lb = p.sln_b + layer * 512 + h * 128;
#pragma unroll 1
    for (int jc = 0; jc < 8; ++jc) {
#pragma unroll 2
        for (int q = 0; q < 8; ++q) {
            const int e = tid + 256 * q;
            { const int i = e >> 4, jj = e & 15, j = jc * 16 + jj; wt[jj * 132 + i] = (i >= j) ? Wh[i * 128 + j] : 0.f; }
            { const int jj = e >> 7, d = e & 127, j = jc * 16 + jj;
              const float x = bf2f(p.PROJ[(size_t)(tb + j) * LDP + C_SV + h * 128 + d]);
              vt[jj * 128 + d] = (x - stat[j * 2]) * stat[j * 2 + 1] * lg[d] + lb[d]; }
        }
        __syncthreads();
        if (w * 32 + 31 >= jc * 16) {
#pragma unroll
            for (int jj = 0; jj < 16; ++jj) {
                const float4 w0 = *(const float4*)(wt + jj * 132 + ti * 8), w1 = *(const float4*)(wt + jj * 132 + ti * 8 + 4);
                const float4 v0 = *(const float4*)(vt + jj * 128 + td * 8), v1 = *(const float4*)(vt + jj * 128 + td * 8 + 4);
                const float wv[8] = {w0.x, w0.y, w0.z, w0.w, w1.x, w1.y, w1.z, w1.w};
                const float vv[8] = {v0.x, v0.y, v0.z, v0.w, v1.x, v1.y, v1.z, v1.w};
#pragma unroll
                for (int a = 0; a < 8; ++a)
#pragma unroll
                    for (int b = 0; b < 8; ++b) acc[a][b] += wv[a] * vv[b];
            }
        }
        __syncthreads();
    }
#pragma unroll
    for (int a = 0; a < 8; ++a) {
        const int i = ti * 8 + a; const size_t t = tb + i;
        const float bs = p.sgu_b[((size_t)layer * 4 + h) * 128 + i];
        const uint4 ur = *(const uint4*)(p.PROJ + t * LDP + C_SU + h * 128 + td * 8);
        const float u[8] = {lo2f(ur.x), hi2f(ur.x), lo2f(ur.y), hi2f(ur.y), lo2f(ur.z), hi2f(ur.z), lo2f(ur.w), hi2f(ur.w)};
        float y[8];
#pragma unroll
        for (int b = 0; b < 8; ++b) y[b] = u[b] * (acc[a][b] + bs);
        uint4 o; o.x = pk2(y[0], y[1]); o.y = pk2(y[2], y[3]); o.z = pk2(y[4], y[5]); o.w = pk2(y[6], y[7]);
        *(uint4*)(p.Y + t * D + 512 + h * 128 + td * 8) = o;
    }
}

DEV void st_vtrans(const P& p, int unit, char* smem) {
    bf16_t* tile = (bf16_t*)smem;
    const int which = unit & 1, tt0 = (unit >> 1) * 64, tid = tidx();
    const int col0 = which ? C_NVW : C_NVS;
    bf16_t* dst = which ? p.VWT : p.VST;
#pragma unroll
    for (int q = 0; q < 4; ++q) {
        const int e = tid + 256 * q; const int r = e >> 4, c8 = e & 15;
        const uint4 raw = *(const uint4*)(p.PROJ + (size_t)(tt0 + r) * LDP + col0 + c8 * 8);
        unsigned* d32 = (unsigned*)(tile + r * 130 + c8 * 8);
        d32[0] = raw.x; d32[1] = raw.y; d32[2] = raw.z; d32[3] = raw.w;
    }
    __syncthreads();
    const int d = tid >> 1, half = tid & 1;
    unsigned o[16];
#pragma unroll
    for (int i = 0; i < 16; ++i) {
        const unsigned a = tile[(half * 32 + 2 * i) * 130 + d], b = tile[(half * 32 + 2 * i + 1) * 130 + d];
        o[i] = a | (b << 16);
    }
    uint4* dp = (uint4*)(dst + (size_t)d * T + tt0 + half * 32);
#pragma unroll
    for (int i = 0; i < 4; ++i) dp[i] = make_uint4(o[4 * i], o[4 * i + 1], o[4 * i + 2], o[4 * i + 3]);
    __syncthreads();
}

DEV void head_norm_rope(const bf16_t* src, const float* g, const float* rc, const float* rs_, int l, bool rope, float& o0, float& o1, float& n0, float& n1) {
    const float x0 = bf2f(src[l]), x1 = bf2f(src[l + 64]);
    const float ss = wsum(x0 * x0 + x1 * x1);
    const float r = rsqrtf(ss * (1.0f / 128.0f) + EPS);
    n0 = x0 * r * g[l]; n1 = x1 * r * g[l + 64];
    o0 = n0; o1 = n1;
    const float other = __shfl_xor(n0, 16);
    if (rope && l < 32) {
        const float c = rc[l & 15], s = rs_[l & 15];
        o0 = (l < 16) ? (n0 * c - other * s) : (n0 * c + other * s);
    }
}
DEV void st_prep(const P& p, int layer, int unit) {
    const int tid_ = tidx(); const int w = tid_ >> 6, l = tid_ & 63; const size_t t = (size_t)unit * 4 + w;
    const bf16_t* row = p.PROJ + t * LDP;
    const float* rc = p.ropeC + t * 24; const float* rs_ = p.ropeS + t * 24;
    float o0, o1, n0, n1;
#pragma unroll
    for (int h = 0; h < 4; ++h) {
        head_norm_rope(row + C_NQ + h * 128, p.nsa_qg + layer * 128, rc, rs_, l, true, o0, o1, n0, n1);
        p.QN[(t * 4 + h) * 128 + l] = f2bf(n0); p.QN[(t * 4 + h) * 128 + l + 64] = f2bf(n1);
        p.QR[(t * 4 + h) * 128 + l] = f2bf(o0); p.QR[(t * 4 + h) * 128 + l + 64] = f2bf(o1);
    }
    head_norm_rope(row + C_NKS, p.nsa_kg + (layer * 3 + 1) * 128, rc, rs_, l, true, o0, o1, n0, n1);
    p.KS[t * 128 + l] = f2bf(o0); p.KS[t * 128 + l + 64] = f2bf(o1);
    head_norm_rope(row + C_NKW, p.nsa_kg + (layer * 3 + 2) * 128, rc, rs_, l, true, o0, o1, n0, n1);
    p.KW[t * 128 + l] = f2bf(o0); p.KW[t * 128 + l + 64] = f2bf(o1);
    if (l < 12) p.GATES[t * 12 + l] = sigmoidf_(bf2f(row[C_NG + l]));
#pragma unroll
    for (int h = 0; h < 4; ++h) {
        head_norm_rope(row + C_DQ + h * 128, p.dsa_qg + layer * 128, rc, rs_, l, true, o0, o1, n0, n1);
        p.DQ[(t * 4 + h) * 128 + l] = f2bf(o0); p.DQ[(t * 4 + h) * 128 + l + 64] = f2bf(o1);
    }
    head_norm_rope(row + C_DK, p.dsa_kg + layer * 128, rc, rs_, l, true, o0, o1, n0, n1);
    p.DK[t * 128 + l] = f2bf(o0); p.DK[t * 128 + l + 64] = f2bf(o1);
    const float ic = rc[16 + (l & 7)], is = rs_[16 + (l & 7)];
#pragma unroll
    for (int h = 0; h < 9; ++h) {
        const float x = bf2f(row[(h < 8 ? C_IQ + h * 64 : C_IK) + l]);
        const float other = __shfl_xor(x, 8);
        float o = x;
        if (l < 16) o = (l < 8) ? (x * ic - other * is) : (x * ic + other * is);
        if (h < 8) p.IQ[(t * 8 + h) * 64 + l] = f2bf(o); else p.IK[t * 64 + l] = f2bf(o);
    }
    if (l < 8) p.IW[t * 8 + l] = bf2f(row[C_IW + l]) * (0.35355339059327373f * 0.125f);
}

DEV void st_compress(const P& p, int layer, int unit, char* smem) {
    const int which = unit & 1, g = unit >> 1, tid = tidx(), c = tid & 127, half = tid >> 7;
    bf16_t* xin = (bf16_t*)smem;
    float* pos = (float*)(smem + 36864);
    float* hid = (float*)(smem + 36864 + 16384);
    float* ob = hid + 8 * 128;
    const int tok0 = g * 128;
    const int col0 = which ? C_NVC : C_NKC;
#pragma unroll 1
    for (int e = tid; e < 144 * 16; e += 256) {
        const int r = e >> 4, c8 = e & 15; const int t = tok0 + r;
        uint4 raw = make_uint4(0, 0, 0, 0);
        if (t < T) raw = *(const uint4*)(p.PROJ + (size_t)t * LDP + col0 + c8 * 8);
        *(uint4*)(xin + r * 128 + c8 * 8) = raw;
    }
    const float* ps = p.cmp_pos + ((size_t)layer * 2 + which) * 32 * 128;
#pragma unroll 1
    for (int e = tid; e < 32 * 128; e += 256) pos[e] = ps[e];
    __syncthreads();
    const float* w1 = p.cmp_w1 + ((size_t)layer * 2 + which) * 4096 * 128;
    float acc[4] = {0.f, 0.f, 0.f, 0.f};
#pragma unroll 1
    for (int ld = 0; ld < 32; ++ld) {
#pragma unroll 2
        for (int d8 = 0; d8 < 16; ++d8) {
            float wv[8];
#pragma unroll
            for (int j = 0; j < 8; ++j) wv[j] = w1[(size_t)(ld * 128 + d8 * 8 + j) * 128 + c];
            const float4 p0 = *(const float4*)(pos + ld * 128 + d8 * 8), p1 = *(const float4*)(pos + ld * 128 + d8 * 8 + 4);
            const float pv[8] = {p0.x, p0.y, p0.z, p0.w, p1.x, p1.y, p1.z, p1.w};
#pragma unroll
            for (int b = 0; b < 4; ++b) {
                const uint4 raw = *(const uint4*)(xin + (16 * (half * 4 + b) + ld) * 128 + d8 * 8);
                const float xv[8] = {lo2f(raw.x), hi2f(raw.x), lo2f(raw.y), hi2f(raw.y), lo2f(raw.z), hi2f(raw.z), lo2f(raw.w), hi2f(raw.w)};
#pragma unroll
                for (int j = 0; j < 8; ++j) acc[b] += (xv[j] + pv[j]) * wv[j];
            }
        }
    }
#pragma unroll
    for (int b = 0; b < 4; ++b) hid[(half * 4 + b) * 128 + c] = gelu_tanh(acc[b]);
    __syncthreads();
    const float* w2 = p.cmp_w2 + ((size_t)layer * 2 + which) * 128 * 128;
    float o[4] = {0.f, 0.f, 0.f, 0.f};
#pragma unroll 4
    for (int k = 0; k < 128; ++k) {
        const float wv = w2[k * 128 + c];
#pragma unroll
        for (int b = 0; b < 4; ++b) o[b] += hid[(half * 4 + b) * 128 + k] * wv;
    }
#pragma unroll
    for (int b = 0; b < 4; ++b) ob[(half * 4 + b) * 128 + c] = o[b];
    __syncthreads();
    const int w = tid >> 6, l = tid & 63;
#pragma unroll
    for (int q = 0; q < 2; ++q) {
        const int b = w * 2 + q, nb = g * 8 + b;
        float v0 = ob[b * 128 + l], v1 = ob[b * 128 + l + 64];
        if (which == 0) {
            const float r = rsqrtf(wsum(v0 * v0 + v1 * v1) * (1.0f / 128.0f) + EPS);
            const float* kg = p.nsa_kg + (layer * 3 + 0) * 128;
            v0 = v0 * r * kg[l]; v1 = v1 * r * kg[l + 64];
            if (nb >= 511) { v0 = 0.f; v1 = 0.f; }
            p.KC[nb * 128 + l] = f2bf(v0); p.KC[nb * 128 + l + 64] = f2bf(v1);
        } else {
            if (nb >= 511) { v0 = 0.f; v1 = 0.f; }
            p.VCT[l * 512 + nb] = f2bf(v0); p.VCT[(l + 64) * 512 + nb] = f2bf(v1);
        }
    }
    __syncthreads();
}

DEV void st_nsa_cmp(const P& p, int unit, char* smem) {
    const int tid = tidx(), w = tid >> 6, l = tid & 63, qc = l & 15, g4 = l >> 4;
    float* impl = (float*)smem + w * 512;
    const int t0 = unit * 16 + w * 4;
    const int tk = qc >> 2, hd = qc & 3, t = t0 + tk;
    bf16x8 qf[4];
#pragma unroll
    for (int ks = 0; ks < 4; ++ks) qf[ks] = *(const bf16x8*)(p.QN + ((size_t)t0 * 4 + qc) * 128 + ks * 32 + g4 * 8);
    const int tmax = t0 + 3;
    const int nvmax = tmax >= 31 ? (tmax - 31) / 16 + 1 : 0;
    const int ntile = (nvmax + 15) >> 4;
    const int nvis = t >= 31 ? (t - 31) / 16 + 1 : 0;
    const float cs = 0.08838834764831845f * 1.4426950408889634f;
    float m = -1e30f, lsum = 0.f;
#pragma unroll 1
    for (int tt = 0; tt < ntile; ++tt) {
        f32x4 s = (f32x4){0.f, 0.f, 0.f, 0.f};
#pragma unroll
        for (int ks = 0; ks < 4; ++ks) {
            const bf16x8 a = *(const bf16x8*)(p.KC + (size_t)(tt * 16 + qc) * 128 + ks * 32 + g4 * 8);
            s = mfma16(a, qf[ks], s);
        }
        float mx = m;
#pragma unroll
        for (int r = 0; r < 4; ++r) { const int key = tt * 16 + 4 * g4 + r; s[r] *= cs; if (key < nvis) mx = fmaxf(mx, s[r]); }
        float ps = 0.f;
#pragma unroll
        for (int r = 0; r < 4; ++r) { const int key = tt * 16 + 4 * g4 + r; ps += (key < nvis) ? exp2f(s[r] - mx) : 0.f; }
        lsum = lsum * exp2f(m - mx) + ps; m = mx;
    }
    {
        float mt_ = fmaxf(m, __shfl_xor(m, 16)); mt_ = fmaxf(mt_, __shfl_xor(mt_, 32));
        lsum *= exp2f(m - mt_); m = mt_;
        lsum += __shfl_xor(lsum, 16); lsum += __shfl_xor(lsum, 32);
    }
    const float inv = lsum > 0.f ? 1.0f / lsum : 0.f;
    f32x4 o[8];
#pragma unroll
    for (int mt = 0; mt < 8; ++mt) o[mt] = (f32x4){0.f, 0.f, 0.f, 0.f};
    float yprev = 0.f;
#pragma unroll 1
    for (int u = 0; u < 16; ++u) {
        f32x4 s2[2];
#pragma unroll
        for (int q = 0; q < 2; ++q) {
            const int tt = 2 * u + q;
            f32x4 s = (f32x4){0.f, 0.f, 0.f, 0.f};
            if (tt < ntile) {
#pragma unroll
                for (int ks = 0; ks < 4; ++ks) {
                    const bf16x8 a = *(const bf16x8*)(p.KC + (size_t)(tt * 16 + qc) * 128 + ks * 32 + g4 * 8);
                    s = mfma16(a, qf[ks], s);
                }
            }
#pragma unroll
            for (int r = 0; r < 4; ++r) { const int key = tt * 16 + 4 * g4 + r; s[r] = (key < nvis) ? exp2f(s[r] * cs - m) * inv : 0.f; }
            const float y = __shfl(s[3], (l + 48) & 63);
            float iv = (s[0] + s[1]) + (s[2] + s[3]) + (g4 > 0 ? y : yprev);
            yprev = y;
            iv += __shfl_xor(iv, 1); iv += __shfl_xor(iv, 2);
            if (hd == 0) impl[tk * 128 + 4 * tt + g4] = iv;
            s2[q] = s;
        }
        if (2 * u < ntile) {
            union { bf16x8 v; unsigned u32[4]; } b;
            b.u32[0] = pk2(s2[0][0], s2[0][1]); b.u32[1] = pk2(s2[0][2], s2[0][3]);
            b.u32[2] = pk2(s2[1][0], s2[1][1]); b.u32[3] = pk2(s2[1][2], s2[1][3]);
#pragma unroll
            for (int mt = 0; mt < 8; ++mt) {
                const bf16_t* vp = p.VCT + (size_t)(mt * 16 + qc) * 512 + 32 * u + 4 * g4;
                union { bf16x8 v; uint2 h2[2]; } a;
                a.h2[0] = *(const uint2*)vp; a.h2[1] = *(const uint2*)(vp + 16);
                o[mt] = mfma16(a.v, b.v, o[mt]);
            }
        }
    }
#pragma unroll
    for (int mt = 0; mt < 8; ++mt) {
        uint2 ov; ov.x = pk2(o[mt][0], o[mt][1]); ov.y = pk2(o[mt][2], o[mt][3]);
        *(uint2*)(p.OCMP + ((size_t)t * 4 + hd) * 128 + mt * 16 + 4 * g4) = ov;
    }
    __syncthreads();
    const int li = hd + 4 * g4, cur = t >> 6;
    const float INF = __builtin_inff();
    float own[8]; int rank[8];
#pragma unroll
    for (int i = 0; i < 8; ++i) {
        const int j = li + 16 * i; float v = impl[tk * 128 + j];
        v = (j == 0 || j == cur || j == cur - 1) ? INF : (j > cur ? -INF : v);
        own[i] = v; rank[i] = 0;
    }
#pragma unroll
    for (int ip = 0; ip < 8; ++ip) {
#pragma unroll
        for (int q4 = 0; q4 < 4; ++q4) {
            const float4 ov = *(const float4*)(impl + tk * 128 + ip * 16 + q4 * 4);
            const float o4[4] = {ov.x, ov.y, ov.z, ov.w};
#pragma unroll
            for (int e = 0; e < 4; ++e) {
                const int lj = q4 * 4 + e, jp = ip * 16 + lj;
                const float vp = (jp == 0 || jp == cur || jp == cur - 1) ? INF : (jp > cur ? -INF : o4[e]);
#pragma unroll
                for (int i = 0; i < 8; ++i) {
                    bool before;
                    if (ip < i) before = true; else if (ip > i) before = false; else before = lj < li;
                    rank[i] += (vp > own[i] || (before && vp == own[i])) ? 1 : 0;
                }
            }
        }
        __builtin_amdgcn_sched_barrier(0);
    }
    unsigned mw[4] = {0u, 0u, 0u, 0u};
#pragma unroll
    for (int i = 0; i < 8; ++i) if (rank[i] < 16) mw[i >> 1] |= 1u << (li + 16 * (i & 1));
#pragma unroll
    for (int q = 0; q < 4; ++q) {
        unsigned v = mw[q];
        v |= __shfl_xor(v, 1); v |= __shfl_xor(v, 2); v |= __shfl_xor(v, 16); v |= __shfl_xor(v, 32);
        mw[q] = v;
    }
    if (li == 0) *(uint4*)(p.SEL + (size_t)t * 4) = make_uint4(mw[0], mw[1], mw[2], mw[3]);
    __syncthreads();
}

DEV void st_nsa_attn(const P& p, int unit, char* smem) {
    constexpr int RSK = 272, RSV = 136, BUFB = 64 * RSK + 128 * RSV;
    const int tid = tidx(), w = tid >> 6, l = tid & 63, qc = l & 15, g4 = l >> 4;
    const int tq0 = unit * 16, t = tq0 + w * 4 + (qc >> 2), hd = qc & 3;
    bf16x8 qf[4];
#pragma unroll
    for (int ks = 0; ks < 4; ++ks) qf[ks] = *(const bf16x8*)(p.QR + ((size_t)t * 4 + hd) * 128 + ks * 32 + g4 * 8);
    const uint4 selw = *(const uint4*)(p.SEL + (size_t)t * 4);
    const float cs = 0.08838834764831845f * 1.4426950408889634f;
    unsigned part[8][2];
#pragma unroll
    for (int mt = 0; mt < 8; ++mt) { part[mt][0] = 0u; part[mt][1] = 0u; }
    const float g0 = p.GATES[(size_t)t * 12 + hd * 3];
    int gstep = 0;
    const int krow = tid >> 4, kc16 = tid & 15, vrow = tid >> 3, vc16 = tid & 7;
#pragma unroll 1
    for (int br = 0; br < 2; ++br) {
        const bf16_t* Kg = br ? p.KW : p.KS; const bf16_t* Vg = br ? p.VWT : p.VST;
        const int ktlast = (tq0 + 15) >> 6;
        const int ktfirst = br ? ((tq0 - 511 > 0 ? tq0 - 511 : 0) >> 6) : 0;
        const int nk = ktlast - ktfirst + 1;
        f32x4 o[8];
#pragma unroll
        for (int mt = 0; mt < 8; ++mt) o[mt] = (f32x4){0.f, 0.f, 0.f, 0.f};
        float m = -1e30f, lsum = 0.f;
        uint4 rk0, rk1, rk2, rk3, rv0, rv1, rv2, rv3;
#define NSA_LOAD(KT) do { const bf16_t* kb = Kg + (size_t)((KT) * 64 + krow) * 128 + kc16 * 8; const bf16_t* vb = Vg + (size_t)vrow * T + (KT) * 64 + vc16 * 8; \
        rk0 = *(const uint4*)kb; rk1 = *(const uint4*)(kb + 16 * 128); rk2 = *(const uint4*)(kb + 32 * 128); rk3 = *(const uint4*)(kb + 48 * 128); \
        rv0 = *(const uint4*)vb; rv1 = *(const uint4*)(vb + (size_t)32 * T); rv2 = *(const uint4*)(vb + (size_t)64 * T); rv3 = *(const uint4*)(vb + (size_t)96 * T); } while (0)
        NSA_LOAD(ktfirst);
#pragma unroll 1
        for (int i = 0; i < nk; ++i, ++gstep) {
            const int kt = ktfirst + i;
            char* Kt = smem + (gstep & 1) * BUFB; char* Vt = Kt + 64 * RSK;
            *(uint4*)(Kt + krow * RSK + kc16 * 16) = rk0; *(uint4*)(Kt + (krow + 16) * RSK + kc16 * 16) = rk1;
            *(uint4*)(Kt + (krow + 32) * RSK + kc16 * 16) = rk2; *(uint4*)(Kt + (krow + 48) * RSK + kc16 * 16) = rk3;
            *(uint4*)(Vt + vrow * RSV + vc16 * 16) = rv0; *(uint4*)(Vt + (vrow + 32) * RSV + vc16 * 16) = rv1;
            *(uint4*)(Vt + (vrow + 64) * RSV + vc16 * 16) = rv2; *(uint4*)(Vt + (vrow + 96) * RSV + vc16 * 16) = rv3;
            __syncthreads();
            if (i + 1 < nk) NSA_LOAD(kt + 1);
            int lo, hi = t;
            if (br == 0) {
                const unsigned wv = (kt & 64) ? ((kt & 32) ? selw.w : selw.z) : ((kt & 32) ? selw.y : selw.x);
                lo = 0; hi = ((wv >> (kt & 31)) & 1u) ? t : -1;
            } else lo = t - 511;
            const bool interior = (kt * 64 + 63 <= tq0) && (br == 0 || kt * 64 >= tq0 + 15 - 511);
            f32x4 sv[4];
            float mx = -3e38f;
            if (interior) {
                const float csl = hi >= 0 ? cs : 0.f, add = hi >= 0 ? 0.f : -3e38f;
#pragma unroll
                for (int sub = 0; sub < 4; ++sub) {
                    f32x4 a4 = (f32x4){0.f, 0.f, 0.f, 0.f};
#pragma unroll
                    for (int ks = 0; ks < 4; ++ks) a4 = mfma16(*(const bf16x8*)(Kt + (sub * 16 + qc) * RSK + (ks * 32 + g4 * 8) * 2), qf[ks], a4);
#pragma unroll
                    for (int r = 0; r < 4; ++r) { a4[r] = a4[r] * csl + add; mx = fmaxf(mx, a4[r]); }
                    sv[sub] = a4;
                }
            } else {
#pragma unroll
                for (int sub = 0; sub < 4; ++sub) {
                    f32x4 a4 = (f32x4){0.f, 0.f, 0.f, 0.f};
#pragma unroll
                    for (int ks = 0; ks < 4; ++ks) a4 = mfma16(*(const bf16x8*)(Kt + (sub * 16 + qc) * RSK + (ks * 32 + g4 * 8) * 2), qf[ks], a4);
#pragma unroll
                    for (int r = 0; r < 4; ++r) {
                        const int kp = kt * 64 + sub * 16 + 4 * g4 + r;
                        const bool valid = (kp >= lo) & (kp <= hi);
                        a4[r] = valid ? a4[r] * cs : -3e38f;
                        mx = fmaxf(mx, a4[r]);
                    }
                    sv[sub] = a4;
                }
            }
            mx = fmaxf(mx, __shfl_xor(mx, 16)); mx = fmaxf(mx, __shfl_xor(mx, 32));
            const float mnew = fmaxf(fmaxf(m, mx), -1e30f);
            const float alpha = __builtin_amdgcn_exp2f(m - mnew);
            m = mnew;
            float ps = 0.f;
#pragma unroll
            for (int sub = 0; sub < 4; ++sub)
#pragma unroll
                for (int r = 0; r < 4; ++r) { const float pv = __builtin_amdgcn_exp2f(sv[sub][r] - mnew); sv[sub][r] = pv; ps += pv; }
            lsum = lsum * alpha + ps;
            if (__any(alpha != 1.0f)) {
#pragma unroll
                for (int mt = 0; mt < 8; ++mt) o[mt] *= alpha;
            }
#pragma unroll
            for (int pr = 0; pr < 2; ++pr) {
                union { bf16x8 v; unsigned u32[4]; } bb;
                bb.u32[0] = pk2(sv[2 * pr][0], sv[2 * pr][1]); bb.u32[1] = pk2(sv[2 * pr][2], sv[2 * pr][3]);
                bb.u32[2] = pk2(sv[2 * pr + 1][0], sv[2 * pr + 1][1]); bb.u32[3] = pk2(sv[2 * pr + 1][2], sv[2 * pr + 1][3]);
#pragma unroll
                for (int mt = 0; mt < 8; ++mt) {
                    const char* vp = Vt + (mt * 16 + qc) * RSV + (pr * 32 + 4 * g4) * 2;
                    union { bf16x8 v; uint2 h2[2]; } aa;
                    aa.h2[0] = *(const uint2*)vp; aa.h2[1] = *(const uint2*)(vp + 32);
                    o[mt] = mfma16(aa.v, bb.v, o[mt]);
                }
            }
        }
#undef NSA_LOAD
        lsum += __shfl_xor(lsum, 16); lsum += __shfl_xor(lsum, 32);
        const float gate = p.GATES[(size_t)t * 12 + hd * 3 + 1 + br];
        const float sc = lsum > 0.f ? gate / lsum : 0.f;
        if (br == 0) {
#pragma unroll
            for (int mt = 0; mt < 8; ++mt) {
                const uint2 oc = *(const uint2*)(p.OCMP + ((size_t)t * 4 + hd) * 128 + mt * 16 + 4 * g4);
                part[mt][0] = pk2(sc * o[mt][0] + g0 * lo2f(oc.x), sc * o[mt][1] + g0 * hi2f(oc.x));
                part[mt][1] = pk2(sc * o[mt][2] + g0 * lo2f(oc.y), sc * o[mt][3] + g0 * hi2f(oc.y));
            }
        } else {
#pragma unroll
            for (int mt = 0; mt < 8; ++mt) {
                uint2 ov;
                ov.x = pk2(sc * o[mt][0] + lo2f(part[mt][0]), sc * o[mt][1] + hi2f(part[mt][0]));
                ov.y = pk2(sc * o[mt][2] + lo2f(part[mt][1]), sc * o[mt][3] + hi2f(part[mt][1]));
                *(uint2*)(p.Y + (size_t)t * D + 1024 + hd * 128 + mt * 16 + 4 * g4) = ov;
            }
        }
    }
    __syncthreads();
}

DEV unsigned f2key(float f) { const unsigned u = __float_as_uint(f); return (u & 0x80000000u) ? ~u : (u | 0x80000000u); }
DEV float key2f(unsigned k) { const unsigned u = (k & 0x80000000u) ? (k & 0x7fffffffu) : ~k; return __uint_as_float(u); }
DEV float wave_prune(float* sc, unsigned short* ix, unsigned* hist, int m, int l) {
    float v[8]; unsigned k[8]; unsigned short id[8]; bool ok[8];
#pragma unroll
    for (int i = 0; i < 8; ++i) {
        const int e = l + 64 * i; ok[i] = e < m;
        v[i] = ok[i] ? sc[e] : 0.f; id[i] = ok[i] ? ix[e] : (unsigned short)0; k[i] = f2key(v[i]);
    }
    unsigned prefix = 0u; int need = 256;
#pragma unroll 1
    for (int pass = 0; pass < 4; ++pass) {
        const int shift = 24 - 8 * pass;
        *(uint4*)(hist + 4 * l) = make_uint4(0u, 0u, 0u, 0u);
        __builtin_amdgcn_wave_barrier();
#pragma unroll
        for (int i = 0; i < 8; ++i) {
            const bool in = ok[i] && (pass == 0 || (k[i] >> (shift + 8)) == prefix);
            if (in) atomicAdd(&hist[(k[i] >> shift) & 255u], 1u);
        }
        __builtin_amdgcn_wave_barrier();
        const uint4 hv = *(const uint4*)(hist + 4 * l);
        const unsigned hq[4] = {hv.x, hv.y, hv.z, hv.w};
        const unsigned own = hv.x + hv.y + hv.z + hv.w;
        unsigned tot = own;
#pragma unroll
        for (int o = 1; o < 64; o <<= 1) { const unsigned tv = __shfl_down(tot, o); if (l + o < 64) tot += tv; }
        unsigned cum = tot - own; int found = -1; int nneed = 0;
#pragma unroll
        for (int kk = 3; kk >= 0; --kk) {
            const unsigned c = hq[kk];
            if (found < 0 && (int)cum < need && (int)(cum + c) >= need) { found = 4 * l + kk; nneed = need - (int)cum; }
            cum += c;
        }
        const unsigned long long bal = __ballot(found >= 0);
        const int src = __ffsll((long long)bal) - 1;
        const int digit = __shfl(found, src); need = __shfl(nneed, src);
        prefix = (prefix << 8) | (unsigned)digit;
    }
    const unsigned thr = prefix;
    int base = 0, ties = 0;
    const unsigned long long ltmask = (1ull << l) - 1ull;
#pragma unroll
    for (int i = 0; i < 8; ++i) {
        const bool gt = ok[i] && k[i] > thr, eq = ok[i] && k[i] == thr;
        const unsigned long long em = __ballot(eq);
        const int trank = ties + __popcll(em & ltmask);
        const bool keep = gt || (eq && trank < need);
        ties += __popcll(em);
        const unsigned long long km = __ballot(keep);
        const int pos = base + __popcll(km & ltmask);
        if (keep) { sc[pos] = v[i]; ix[pos] = id[i]; }
        base += __popcll(km);
    }
    __builtin_amdgcn_wave_barrier();
    return key2f(thr);
}

#define DSA_APPEND(SCP, IXP, CNT, M32, MINE, SV) do { \
    const unsigned _m = (M32); \
    if (MINE) { const int _pos = (CNT) + __popc(_m & ((1u << n) - 1u)); (SCP)[_pos] = (SV); (IXP)[_pos] = (unsigned short)kp; } \
    (CNT) += __popc(_m); } while (0)

DEV void st_dsa_index(const P& p, int unit, char* smem) {
    const int tid = tidx(), w = tid >> 6, l = tid & 63, n = l & 31, h = l >> 5;
    char* wb = smem + w * 14336;
    float* sc0 = (float*)wb; float* sc1 = sc0 + 512; float* sc2 = sc1 + 512; float* sc3 = sc2 + 512;
    unsigned short* ix0 = (unsigned short*)(wb + 8192); unsigned short* ix1 = ix0 + 512; unsigned short* ix2 = ix1 + 512; unsigned short* ix3 = ix2 + 512;
    unsigned* hist = (unsigned*)(wb + 12288);
    const int wu = unit * 4 + w;
    const int tg = (wu & 1) ? (2047 - (wu >> 1)) : (wu >> 1);
    const int t0 = tg * 4;
    const int tl = 2 * ((n >> 2) & 1) + (n >> 4), hdr = (n & 3) + 4 * ((n >> 3) & 1);
    bf16x8 af[4];
#pragma unroll
    for (int s = 0; s < 4; ++s) af[s] = *(const bf16x8*)(p.IQ + ((size_t)(t0 + tl) * 8 + hdr) * 64 + 16 * s + 8 * h);
    const int tA = t0 + 2 * h, tB = tA + 1;
    float wA[8], wB[8];
#pragma unroll
    for (int r = 0; r < 8; ++r) { wA[r] = p.IW[(size_t)tA * 8 + r]; wB[r] = p.IW[(size_t)tB * 8 + r]; }
    int cnt0 = 0, cnt1 = 0, cnt2 = 0, cnt3 = 0;
    const float NINF = -__builtin_inff();
    float tau0 = NINF, tau1 = NINF, tau2 = NINF, tau3 = NINF;
    const int ntiles = (t0 + 3) / 32 + 1;
#pragma unroll 1
    for (int kt = 0; kt < ntiles; ++kt) {
        f32x16 acc;
#pragma unroll
        for (int r = 0; r < 16; ++r) acc[r] = 0.f;
#pragma unroll
        for (int s = 0; s < 4; ++s) {
            const bf16x8 b = *(const bf16x8*)(p.IK + (size_t)(kt * 32 + n) * 64 + 16 * s + 8 * h);
            acc = mfma32(af[s], b, acc);
        }
        float s0 = 0.f, s1 = 0.f;
#pragma unroll
        for (int r = 0; r < 8; ++r) { s0 += wA[r] * fmaxf(acc[r], 0.f); s1 += wB[r] * fmaxf(acc[8 + r], 0.f); }
        const int kp = kt * 32 + n;
        const bool cA = (kp <= tA) && (s0 > (h ? tau2 : tau0));
        const bool cB = (kp <= tB) && (s1 > (h ? tau3 : tau1));
        const unsigned long long mA = __ballot(cA), mB = __ballot(cB);
        DSA_APPEND(sc0, ix0, cnt0, (unsigned)mA, (h == 0 && cA), s0);
        DSA_APPEND(sc2, ix2, cnt2, (unsigned)(mA >> 32), (h == 1 && cA), s0);
        DSA_APPEND(sc1, ix1, cnt1, (unsigned)mB, (h == 0 && cB), s1);
        DSA_APPEND(sc3, ix3, cnt3, (unsigned)(mB >> 32), (h == 1 && cB), s1);
        __builtin_amdgcn_wave_barrier();
        if (cnt0 > 480) { tau0 = wave_prune(sc0, ix0, hist, cnt0, l); cnt0 = 256; }
        if (cnt1 > 480) { tau1 = wave_prune(sc1, ix1, hist, cnt1, l); cnt1 = 256; }
        if (cnt2 > 480) { tau2 = wave_prune(sc2, ix2, hist, cnt2, l); cnt2 = 256; }
        if (cnt3 > 480) { tau3 = wave_prune(sc3, ix3, hist, cnt3, l); cnt3 = 256; }
    }
    if (cnt0 > 256) { wave_prune(sc0, ix0, hist, cnt0, l); cnt0 = 256; }
    if (cnt1 > 256) { wave_prune(sc1, ix1, hist, cnt1, l); cnt1 = 256; }
    if (cnt2 > 256) { wave_prune(sc2, ix2, hist, cnt2, l); cnt2 = 256; }
    if (cnt3 > 256) { wave_prune(sc3, ix3, hist, cnt3, l); cnt3 = 256; }
    __builtin_amdgcn_wave_barrier();
#pragma unroll
    for (int i = 0; i < 4; ++i) {
        const int e = l + 64 * i;
        p.IDX[(size_t)(t0 + 0) * 256 + e] = e < cnt0 ? (int)ix0[e] : 0;
        p.IDX[(size_t)(t0 + 1) * 256 + e] = e < cnt1 ? (int)ix1[e] : 0;
        p.IDX[(size_t)(t0 + 2) * 256 + e] = e < cnt2 ? (int)ix2[e] : 0;
        p.IDX[(size_t)(t0 + 3) * 256 + e] = e < cnt3 ? (int)ix3[e] : 0;
    }
    if (l == 0) { p.CNT[t0] = cnt0; p.CNT[t0 + 1] = cnt1; p.CNT[t0 + 2] = cnt2; p.CNT[t0 + 3] = cnt3; }
}

DEV void st_dsa_attn(const P& p, int unit, char* smem) {
    const int tid = tidx(), w = tid >> 6, l = tid & 63, c = l & 15, g4 = l >> 4;
    int* idxs = (int*)(smem + w * 5120); float* Pl = (float*)(smem + w * 5120 + 1024);
    const size_t t = (size_t)unit * 4 + w;
    const int cnt = p.CNT[t];
#pragma unroll
    for (int i = 0; i < 4; ++i) idxs[l + 64 * i] = p.IDX[t * 256 + l + 64 * i];
    __builtin_amdgcn_wave_barrier();
    bf16x8 qf[4];
#pragma unroll
    for (int j = 0; j < 4; ++j) qf[j] = *(const bf16x8*)(p.DQ + (t * 4 + (c & 3)) * 128 + g4 * 32 + j * 8);
    f32x4 s[16];
    const int ntile = (cnt + 15) >> 4;
#pragma unroll
    for (int tt = 0; tt < 16; ++tt) {
        s[tt] = (f32x4){0.f, 0.f, 0.f, 0.f};
        if (tt < ntile) {
            const int krow = idxs[tt * 16 + c];
            const bf16_t* kp = p.DK + (size_t)krow * 128 + g4 * 32;
#pragma unroll
            for (int j = 0; j < 4; ++j) s[tt] = mfma16(*(const bf16x8*)(kp + j * 8), qf[j], s[tt]);
        }
        if (tt & 1) __builtin_amdgcn_sched_barrier(0);
    }
    const float cs = 0.08838834764831845f * 1.4426950408889634f;
    float mx = -1e30f;
#pragma unroll
    for (int tt = 0; tt < 16; ++tt)
#pragma unroll
        for (int r = 0; r < 4; ++r) { const int slot = tt * 16 + 4 * g4 + r; if (slot < cnt) mx = fmaxf(mx, s[tt][r] * cs); }
    mx = fmaxf(mx, __shfl_xor(mx, 16)); mx = fmaxf(mx, __shfl_xor(mx, 32));
    float sum = 0.f;
#pragma unroll
    for (int tt = 0; tt < 16; ++tt)
#pragma unroll
        for (int r = 0; r < 4; ++r) { const int slot = tt * 16 + 4 * g4 + r; const float pv = slot < cnt ? exp2f(s[tt][r] * cs - mx) : 0.f; s[tt][r] = pv; sum += pv; }
    sum += __shfl_xor(sum, 16); sum += __shfl_xor(sum, 32);
    const float inv = sum > 0.f ? 1.0f / sum : 0.f;
    if (c < 4) {
#pragma unroll
        for (int tt = 0; tt < 16; ++tt)
#pragma unroll
            for (int r = 0; r < 4; ++r) Pl[(tt * 16 + 4 * g4 + r) * 4 + c] = s[tt][r] * inv;
    }
    __builtin_amdgcn_wave_barrier();
    float acc[4][8];
#pragma unroll
    for (int hh = 0; hh < 4; ++hh)
#pragma unroll
        for (int j = 0; j < 8; ++j) acc[hh][j] = 0.f;
    const int nk4 = (cnt + 3) >> 2;
#pragma unroll 2
    for (int kk = 0; kk < nk4; ++kk) {
        const int slot = kk * 4 + g4;
        const int row = idxs[slot];
        const uint4 raw = *(const uint4*)(p.PROJ + (size_t)row * LDP + C_DV + c * 8);
        const float4 p4 = *(const float4*)(Pl + slot * 4);
        const float vv[8] = {lo2f(raw.x), hi2f(raw.x), lo2f(raw.y), hi2f(raw.y), lo2f(raw.z), hi2f(raw.z), lo2f(raw.w), hi2f(raw.w)};
        const float pp[4] = {p4.x, p4.y, p4.z, p4.w};
#pragma unroll
        for (int hh = 0; hh < 4; ++hh)
#pragma unroll
            for (int j = 0; j < 8; ++j) acc[hh][j] += pp[hh] * vv[j];
    }
#pragma unroll
    for (int hh = 0; hh < 4; ++hh)
#pragma unroll
        for (int j = 0; j < 8; ++j) { float a = acc[hh][j]; a += __shfl_xor(a, 16); a += __shfl_xor(a, 32); acc[hh][j] = a; }
    if (g4 == 0) {
#pragma unroll
        for (int hh = 0; hh < 4; ++hh) {
            uint4 o; o.x = pk2(acc[hh][0], acc[hh][1]); o.y = pk2(acc[hh][2], acc[hh][3]); o.z = pk2(acc[hh][4], acc[hh][5]); o.w = pk2(acc[hh][6], acc[hh][7]);
            *(uint4*)(p.Y + t * D + 1536 + hh * 128 + c * 8) = o;
        }
    }
    __builtin_amdgcn_wave_barrier();
}

DEV void ins16(unsigned (&top)[16], unsigned x) {
#pragma unroll
    for (int j = 0; j < 16; ++j) { const unsigned hi = max(top[j], x); x = min(top[j], x); top[j] = hi; }
}
DEV void st_peer_topk(const P& p, int layer, int unit, char* smem) {
    const int tid = tidx(), w = tid >> 6, l = tid & 63, n = l & 31, hf = l >> 5;
    const int tg = unit >> 1, head = (unit & 1) * 4 + w;
    const size_t t = (size_t)tg * 32 + n;
    unsigned* il = (unsigned*)smem + w * 1024;
    unsigned top[2][16];
#pragma unroll
    for (int pp = 0; pp < 2; ++pp) {
        float qv[32];
#pragma unroll
        for (int i = 0; i < 8; ++i) { const float4 v = *(const float4*)(p.PQ + t * 1024 + head * 128 + pp * 64 + hf * 32 + i * 4); qv[4 * i] = v.x; qv[4 * i + 1] = v.y; qv[4 * i + 2] = v.z; qv[4 * i + 3] = v.w; }
        const float* K = p.peer_sk + ((((size_t)layer * 8 + head) * 2 + pp) * 128) * 64;
#pragma unroll
        for (int j = 0; j < 16; ++j) top[pp][j] = 0u;
#pragma unroll 1
        for (int tile = 0; tile < 4; ++tile) {
            float kv[32];
            const float* kr = K + (size_t)(tile * 32 + n) * 64 + hf * 32;
#pragma unroll
            for (int i = 0; i < 8; ++i) { const float4 v = *(const float4*)(kr + i * 4); kv[4 * i] = v.x; kv[4 * i + 1] = v.y; kv[4 * i + 2] = v.z; kv[4 * i + 3] = v.w; }
            f32x16 acc;
#pragma unroll
            for (int r = 0; r < 16; ++r) acc[r] = 0.f;
#pragma unroll
            for (int kk = 0; kk < 32; ++kk) acc = __builtin_amdgcn_mfma_f32_32x32x2f32(kv[kk], qv[kk], acc, 0, 0, 0);
#pragma unroll
            for (int r = 0; r < 16; ++r) {
                const int nn = tile * 32 + (r & 3) + 8 * (r >> 2) + 4 * hf;
                ins16(top[pp], (f2key(acc[r]) & ~127u) | (unsigned)(127 - nn));
            }
        }
        unsigned oth[16];
#pragma unroll
        for (int j = 0; j < 16; ++j) oth[j] = __shfl_xor(top[pp][j], 32);
#pragma unroll
        for (int j = 0; j < 16; ++j) ins16(top[pp], oth[j]);
        if (hf == 0) {
#pragma unroll
            for (int j = 0; j < 16; ++j) il[(pp * 16 + j) * 32 + n] = 127u - (top[pp][j] & 127u);
        }
    }
    __builtin_amdgcn_wave_barrier();
    if (hf == 0) {
        float v1[16], v2[16];
#pragma unroll
        for (int j = 0; j < 16; ++j) { v1[j] = key2f(top[0][j] & ~127u); v2[j] = key2f(top[1][j] & ~127u); }
        unsigned ct[16];
#pragma unroll
        for (int s = 0; s < 16; ++s) ct[s] = 0u;
#pragma unroll
        for (int i = 0; i < 16; ++i)
#pragma unroll
            for (int j = 0; j < 16; ++j)
                if ((i + 1) * (j + 1) <= 16) ins16(ct, (f2key(v1[i] + v2[j]) & ~255u) | (unsigned)(255 - (i * 16 + j)));
        float ex[16], sum = 0.f; int ce[16];
        const float c0 = key2f(ct[0] & ~255u);
#pragma unroll
        for (int s = 0; s < 16; ++s) {
            const unsigned code = 255u - (ct[s] & 255u);
            ce[s] = (int)(il[(code >> 4) * 32 + n] * 128u + il[(16 + (code & 15u)) * 32 + n]);
            ex[s] = __expf(key2f(ct[s] & ~255u) - c0); sum += ex[s];
        }
        const float inv = 1.0f / sum;
#pragma unroll
        for (int s4 = 0; s4 < 4; ++s4) {
            *(int4*)(p.PE + t * 128 + head * 16 + s4 * 4) = make_int4(ce[4 * s4], ce[4 * s4 + 1], ce[4 * s4 + 2], ce[4 * s4 + 3]);
            *(float4*)(p.PG + t * 128 + head * 16 + s4 * 4) = make_float4(ex[4 * s4] * inv, ex[4 * s4 + 1] * inv, ex[4 * s4 + 2] * inv, ex[4 * s4 + 3] * inv);
        }
    }
    __builtin_amdgcn_wave_barrier();
}

DEV void fp8x16_decode(const uint4& r, float (&f)[16]) {
    const unsigned w[4] = {r.x, r.y, r.z, r.w};
#pragma unroll
    for (int q = 0; q < 4; ++q) {
        const f32x2 lo = __builtin_amdgcn_cvt_pk_f32_fp8((int)w[q], false), hi = __builtin_amdgcn_cvt_pk_f32_fp8((int)w[q], true);
        f[4 * q] = lo.x; f[4 * q + 1] = lo.y; f[4 * q + 2] = hi.x; f[4 * q + 3] = hi.y;
    }
}
DEV void st_peer_gather(const P& p, int layer, const float* __restrict__ xin, float* __restrict__ xout, int unit) {
    const int tid_ = tidx(); const int w = tid_ >> 6, l = tid_ & 63; const size_t t = (size_t)unit * 4 + w;
    float hf[32];
#pragma unroll
    for (int i = 0; i < 2; ++i)
#pragma unroll
        for (int h2 = 0; h2 < 2; ++h2) {
            const uint4 hv = *(const uint4*)(p.HN + t * D + i * 1024 + l * 16 + h2 * 8);
            const unsigned u4[4] = {hv.x, hv.y, hv.z, hv.w};
#pragma unroll
            for (int q = 0; q < 4; ++q) { hf[i * 16 + h2 * 8 + 2 * q] = lo2f(u4[q]); hf[i * 16 + h2 * 8 + 2 * q + 1] = hi2f(u4[q]); }
        }
    const int e0 = p.PE[t * 128 + l], e1 = p.PE[t * 128 + 64 + l];
    const float g0 = p.PG[t * 128 + l], g1 = p.PG[t * 128 + 64 + l];
    float out[32];
#pragma unroll
    for (int i = 0; i < 32; ++i) out[i] = 0.f;
    const unsigned char* U = p.Utab + (size_t)layer * 16384 * 2048 + l * 16; const unsigned char* V = p.Vtab + (size_t)layer * 16384 * 2048 + l * 16;
    const bool b5 = (l & 32) != 0, b4 = (l & 16) != 0;
#pragma unroll 1
    for (int k4 = 0; k4 < 32; ++k4) {
        int e[4]; float g[4];
#pragma unroll
        for (int q = 0; q < 4; ++q) {
            const int k = k4 * 4 + q;
            e[q] = __builtin_amdgcn_readlane(k4 < 16 ? e0 : e1, k & 63);
            g[q] = __int_as_float(__builtin_amdgcn_readlane(__float_as_int(k4 < 16 ? g0 : g1), k & 63));
        }
        uint4 uu[4][2], vv[4][2];
#pragma unroll
        for (int q = 0; q < 4; ++q)
#pragma unroll
            for (int i = 0; i < 2; ++i) { uu[q][i] = *(const uint4*)(U + (size_t)e[q] * 2048 + i * 1024); vv[q][i] = *(const uint4*)(V + (size_t)e[q] * 2048 + i * 1024); }
        float d[4];
#pragma unroll
        for (int q = 0; q < 4; ++q) {
            float acc = 0.f;
#pragma unroll
            for (int i = 0; i < 2; ++i) { float f[16]; fp8x16_decode(uu[q][i], f);
#pragma unroll
                for (int j = 0; j < 16; ++j) acc += f[j] * hf[i * 16 + j]; }
            d[q] = acc;
        }
        float kA = b5 ? d[2] : d[0], kB = b5 ? d[3] : d[1];
        const float sA = b5 ? d[0] : d[2], sB = b5 ? d[1] : d[3];
        kA += __shfl_xor(sA, 32); kB += __shfl_xor(sB, 32);
        float kk = b4 ? kB : kA; const float ss = b4 ? kA : kB;
        kk += __shfl_xor(ss, 16);
        kk += __shfl_xor(kk, 8); kk += __shfl_xor(kk, 4); kk += __shfl_xor(kk, 2); kk += __shfl_xor(kk, 1);
        const float gsel = b5 ? (b4 ? g[3] : g[2]) : (b4 ? g[1] : g[0]);
        const float av = gelu_tanh(kk * (1.0f / U8_SCALE)) * gsel * (1.0f / V8_SCALE);
        const int avi = __float_as_int(av);
        const float a4[4] = {__int_as_float(__builtin_amdgcn_readlane(avi, 0)), __int_as_float(__builtin_amdgcn_readlane(avi, 16)),
                             __int_as_float(__builtin_amdgcn_readlane(avi, 32)), __int_as_float(__builtin_amdgcn_readlane(avi, 48))};
#pragma unroll
        for (int q = 0; q < 4; ++q)
#pragma unroll
            for (int i = 0; i < 2; ++i) { float f[16]; fp8x16_decode(vv[q][i], f);
#pragma unroll
                for (int j = 0; j < 16; ++j) out[i * 16 + j] += a4[q] * f[j]; }
    }
    const float* g2 = p.ada + layer * 12288 + 5 * 2048;
#pragma unroll
    for (int i = 0; i < 2; ++i)
#pragma unroll
        for (int q = 0; q < 4; ++q) {
            const size_t col = i * 1024 + l * 16 + q * 4; const size_t off = t * D + col;
            const float4 x0 = *(const float4*)(xin + off); const float4 ga = *(const float4*)(g2 + col);
            float4 o0;
            o0.x = x0.x + ga.x * out[i * 16 + q * 4 + 0]; o0.y = x0.y + ga.y * out[i * 16 + q * 4 + 1];
            o0.z = x0.z + ga.z * out[i * 16 + q * 4 + 2]; o0.w = x0.w + ga.w * out[i * 16 + q * 4 + 3];
            *(float4*)(xout + off) = o0;
        }
}

enum { S_CONVT_IN = 0, S_CONVT_OUT, S_CONVT_Q, S_TAB_U, S_TAB_V, S_ADA, S_ROPE, S_NORM1, S_GEMM_IN, S_CONV, S_SGU, S_VTRANS, S_PREP,
       S_COMPRESS, S_NSA_CMP, S_DSA_INDEX, S_NSA_ATTN, S_DSA_ATTN, S_GEMM_OUT, S_NORM2, S_GEMM_Q, S_PEER_TOPK, S_PEER_GATHER, S_COUNT };
constexpr int TAB_UNITS = 4096;
__host__ __device__ constexpr int nunits(int s) {
    return s == S_CONVT_IN ? 2 * 32 * (LDP / 64) : s == S_CONVT_OUT ? 2 * 32 * 32 : s == S_CONVT_Q ? 2 * 32 * 16 : s == S_TAB_U ? TAB_UNITS : s == S_TAB_V ? TAB_UNITS
         : s == S_ADA ? 768 : s == S_ROPE ? 768 : s == S_NORM1 ? 2048 : s == S_GEMM_IN ? 64 * (LDP / 128) : s == S_CONV ? 512 : s == S_SGU ? 256
         : s == S_VTRANS ? 256 : s == S_PREP ? 2048 : s == S_COMPRESS ? 128 : s == S_NSA_CMP ? 512 : s == S_DSA_INDEX ? 512 : s == S_NSA_ATTN ? 512 : s == S_DSA_ATTN ? 2048
         : s == S_GEMM_OUT ? 64 * 16 : s == S_NORM2 ? 2048 : s == S_GEMM_Q ? 64 * 8 : s == S_PEER_TOPK ? 512 : s == S_PEER_GATHER ? 2048 : 0;
}
template <int S>
DEV void run_unit(const P& p, int layer, int u, char* smem, int nu = TAB_UNITS) {
    const float* xin = layer == 0 ? p.x : p.X2;
    const float* ada = p.ada + layer * 12288;
    if constexpr (S == S_CONVT_IN) { const int per = 32 * (LDP / 64), ly = u / per; st_convT(p.w_in + (size_t)ly * 2048 * INC, p.WinT + (size_t)ly * LDP * 2048, INC, LDP, true, u % per, smem); }
    else if constexpr (S == S_CONVT_OUT) { const int per = 32 * 32, ly = u / per; st_convT(p.w_out + (size_t)ly * 2048 * 2048, p.WoutT + (size_t)ly * 2048 * 2048, 2048, 2048, false, u % per, smem); }
    else if constexpr (S == S_CONVT_Q) { const int per = 32 * 16, ly = u / per; st_convT(p.peer_wq + (size_t)ly * 2048 * 1024, p.WqT + (size_t)ly * 1024 * 2048, 1024, 1024, false, u % per, smem); }
    else if constexpr (S == S_TAB_U) st_tab(p.peer_u, p.Utab, U8_SCALE, (size_t)2 * 16384 * 2048 / 16, u, nu);
    else if constexpr (S == S_TAB_V) st_tab(p.peer_v, p.Vtab, V8_SCALE, (size_t)2 * 16384 * 2048 / 16, u, nu);
    else if constexpr (S == S_ADA) st_ada(p, u, smem);
    else if constexpr (S == S_ROPE) st_rope(p, u);
    else if constexpr (S == S_NORM1) st_norm(xin, p.n1g + layer * 2048, ada + 2048, ada, p.HN, u);
    else if constexpr (S == S_GEMM_IN) { EpiArgs e{p.PROJ, nullptr, nullptr, nullptr}; st_gemm<EPI_PROJ>(p.HN, p.WinT + (size_t)layer * LDP * 2048, 2048, u & 63, u >> 6, e, smem); }
    else if constexpr (S == S_CONV) st_conv(p, layer, u, smem);
    else if constexpr (S == S_SGU) st_sgu(p, layer, u, smem);
    else if constexpr (S == S_VTRANS) st_vtrans(p, u, smem);
    else if constexpr (S == S_PREP) st_prep(p, layer, u);
    else if constexpr (S == S_COMPRESS) st_compress(p, layer, u, smem);
    else if constexpr (S == S_NSA_CMP) st_nsa_cmp(p, u, smem);
    else if constexpr (S == S_DSA_INDEX) st_dsa_index(p, u, smem);
    else if constexpr (S == S_NSA_ATTN) st_nsa_attn(p, u, smem);
    else if constexpr (S == S_DSA_ATTN) st_dsa_attn(p, u, smem);
    else if constexpr (S == S_GEMM_OUT) { EpiArgs e{nullptr, p.X1, xin, ada + 2 * 2048}; st_gemm<EPI_OUT>(p.Y, p.WoutT + (size_t)layer * 2048 * 2048, 2048, u & 63, u >> 6, e, smem); }
    else if constexpr (S == S_NORM2) st_norm(p.X1, p.n2g + layer * 2048, ada + 4 * 2048, ada + 3 * 2048, p.HN, u);
    else if constexpr (S == S_GEMM_Q) { EpiArgs e{nullptr, p.PQ, nullptr, nullptr}; st_gemm<EPI_Q>(p.HN, p.WqT + (size_t)layer * 1024 * 2048, 2048, u & 63, u >> 6, e, smem); }
    else if constexpr (S == S_PEER_TOPK) st_peer_topk(p, layer, u, smem);
    else if constexpr (S == S_PEER_GATHER) st_peer_gather(p, layer, p.X1, layer == 0 ? p.X2 : p.out, u);
}


#define XB_TMO      128
#define XB_XCNT(j)  (256  + 64 * (j))
#define XB_XSUB(j)  (1280 + 64 * (j))
#define XB_XGEN(j)  (2304 + 64 * (j))
#define XB_TOP      3328
#define XB_TOPGEN   3392
#define XCD_BAR_WORDS 3456
#define XB_SPIN_CAP (1u << 22)
#define LAS __attribute__((address_space(3)))
DEV unsigned xb_ld(unsigned* p) { return __hip_atomic_load(p, __ATOMIC_RELAXED, __HIP_MEMORY_SCOPE_AGENT); }
DEV unsigned xb_add(unsigned* p, unsigned v) { return __hip_atomic_fetch_add(p, v, __ATOMIC_RELAXED, __HIP_MEMORY_SCOPE_AGENT); }
DEV unsigned xb_xcc_id() { return (unsigned)__builtin_amdgcn_s_getreg((3 << 11) | 20) & 0xFu; }
#define XB_SPIN(cond, bar) do { unsigned _sp = 0; while (cond) { __builtin_amdgcn_s_sleep(1); \
    if ((++_sp & 255u) == 0u) { if (xb_ld(&(bar)[XB_TMO])) break; if (_sp > XB_SPIN_CAP) { atomicAdd(&(bar)[XB_TMO], 1u); break; } } } } while (0)
struct XcdBarrier { unsigned* bar; unsigned x; volatile LAS unsigned* st; };
DEV XcdBarrier xcd_barrier_post(unsigned* bar, volatile LAS unsigned* st) {
    XcdBarrier b; b.bar = bar; b.x = xb_xcc_id(); b.st = st;
    if (threadIdx.x == 0) (void)xb_add(&bar[XB_XCNT(b.x)], 1u);
    return b;
}
DEV void xcd_barrier_complete(unsigned* bar, unsigned x, unsigned& nloc, unsigned& nx) {
    const unsigned G = gridDim.x * gridDim.y * gridDim.z;
    unsigned sum, cnt, mine, sp = 0u;
    for (;;) {
        sum = 0u; cnt = 0u; mine = 0u;
#pragma unroll
        for (unsigned j = 0; j < 16; ++j) { const unsigned c = xb_ld(&bar[XB_XCNT(j)]); sum += c; cnt += (c > 0u) ? 1u : 0u; mine = (j == x) ? c : mine; }
        if (sum == G) break;
        __builtin_amdgcn_s_sleep(1);
        if ((++sp & 255u) == 0u) { if (xb_ld(&bar[XB_TMO])) break; if (sp > XB_SPIN_CAP) { atomicAdd(&bar[XB_TMO], 1u); break; } }
    }
    nloc = mine > 0u ? mine : 1u; nx = cnt > 0u ? cnt : 1u;
}
DEV void xcd_barrier(const XcdBarrier& b) {
    asm volatile("s_waitcnt vmcnt(0)" ::: "memory");
    __syncthreads();
    if (threadIdx.x == 0) {
        unsigned* bar = b.bar;
        __builtin_amdgcn_s_waitcnt(0);
        unsigned nloc = b.st[0], nx = b.st[1];
        if (nloc == 0u) { xcd_barrier_complete(bar, b.x, nloc, nx); b.st[0] = nloc; b.st[1] = nx; }
        const unsigned old = xb_add(&bar[XB_XSUB(b.x)], 1u);
        const unsigned gen = old / nloc;
        if (old + 1u == (gen + 1u) * nloc) {
            __builtin_amdgcn_fence(__ATOMIC_RELEASE, "agent");
            asm volatile("s_waitcnt vmcnt(0)" ::: "memory");
            const unsigned og = xb_add(&bar[XB_TOP], 1u);
            const unsigned tg = og / nx;
            if (og + 1u == (tg + 1u) * nx) xb_add(&bar[XB_TOPGEN], 1u);
            else XB_SPIN(xb_ld(&bar[XB_TOPGEN]) == tg, bar);
            __builtin_amdgcn_fence(__ATOMIC_ACQUIRE, "agent");
            xb_add(&bar[XB_XGEN(b.x)], 1u);
            asm volatile("s_waitcnt vmcnt(0)" ::: "memory");
        } else {
            XB_SPIN(xb_ld(&bar[XB_XGEN(b.x)]) == gen, bar);
            __builtin_amdgcn_fence(__ATOMIC_ACQUIRE, "agent");
            asm volatile("s_waitcnt vmcnt(0)" ::: "memory");
        }
    }
    __syncthreads();
}

#ifndef MULTI_LAUNCH
constexpr int REP_STAGE = -1, REP_STAGE2 = -1, REP_N = 1;
template <int S>
DEV void run_phase1(const P& p, int layer, char* smem, int off);
template <int S>
DEV void run_phase(const P& p, int layer, char* smem, int off = 0) {
    constexpr int reps = (S == REP_STAGE || S == REP_STAGE2) ? REP_N : 1;
#pragma unroll 1
    for (int r = 0; r < reps; ++r) run_phase1<S>(p, layer, smem, off);
}
template <int S>
DEV void run_phase1(const P& p, int layer, char* smem, int off) {
    const int G = gridDim.x;
    int b = blockIdx.x + off; if (b >= G) b -= G;
    if constexpr (S == S_TAB_U || S == S_TAB_V) { run_unit<S>(p, layer, b, smem, G); }
    else {
        for (int u = b; u < nunits(S); u += G) { run_unit<S>(p, layer, u, smem); __syncthreads(); }
    }
}
#define GSYNC() xcd_barrier(xb)
__global__ void __launch_bounds__(NTHREADS) k_mega(P p) {
    __shared__ __attribute__((aligned(16))) char smem[SMEM_BYTES];
    __shared__ uint4 xb_words;
    cg::grid_group grid = cg::this_grid();
    if (threadIdx.x == 0) xb_words = make_uint4(0u, 0u, 0u, 0u);
    __syncthreads();
    XcdBarrier xb = xcd_barrier_post(p.bar, (volatile LAS unsigned*)&xb_words);
    const int H = gridDim.x >> 1, Q = gridDim.x >> 2;
    run_phase<S_ADA>(p, 0, smem); run_phase<S_ROPE>(p, 0, smem, H);
    run_phase<S_CONVT_IN>(p, 0, smem); run_phase<S_CONVT_OUT>(p, 0, smem); run_phase<S_CONVT_Q>(p, 0, smem);
    run_phase<S_TAB_U>(p, 0, smem); run_phase<S_TAB_V>(p, 0, smem);
    grid.sync();
#pragma unroll 1
    for (int layer = 0; layer < NL; ++layer) {
        run_phase<S_NORM1>(p, layer, smem); GSYNC();
        run_phase<S_GEMM_IN>(p, layer, smem); GSYNC();
        run_phase<S_COMPRESS>(p, layer, smem); run_phase<S_SGU>(p, layer, smem, Q); run_phase<S_VTRANS>(p, layer, smem, H + Q);
        run_phase<S_CONV>(p, layer, smem); run_phase<S_PREP>(p, layer, smem); GSYNC();
        run_phase<S_DSA_INDEX>(p, layer, smem); run_phase<S_NSA_CMP>(p, layer, smem); GSYNC();
        run_phase<S_NSA_ATTN>(p, layer, smem); run_phase<S_DSA_ATTN>(p, layer, smem, H); GSYNC();
        run_phase<S_GEMM_OUT>(p, layer, smem); GSYNC();
        run_phase<S_NORM2>(p, layer, smem); GSYNC();
        run_phase<S_GEMM_Q>(p, layer, smem); GSYNC();
        run_phase<S_PEER_TOPK>(p, layer, smem); GSYNC();
        run_phase<S_PEER_GATHER>(p, layer, smem); GSYNC();
    }
}
#else
template <int S>
__global__ void __launch_bounds__(NTHREADS) k_stage(P p, int layer) {
    __shared__ __attribute__((aligned(16))) char smem[SMEM_BYTES];
    run_unit<S>(p, layer, blockIdx.x, smem);
}
template <int S> static void launch_stage(const P& p, int layer, hipStream_t st) {
    hipLaunchKernelGGL((k_stage<S>), dim3(nunits(S)), dim3(NTHREADS), 0, st, p, layer);
}
#endif

extern "C" void kernel_launch(void* const* d_in, const int* in_sizes, int n_in, void* d_out, int out_size, void* d_ws, size_t ws_size, hipStream_t stream) {
    P p{};
    p.x = (const float*)d_in[0]; p.c = (const float*)d_in[1]; p.pos = (const int*)d_in[2]; p.ada_w = (const float*)d_in[3]; p.ada_b = (const float*)d_in[4];
    p.n1g = (const float*)d_in[5]; p.n2g = (const float*)d_in[6]; p.w_in = (const float*)d_in[7]; p.w_out = (const float*)d_in[8]; p.conv_w = (const float*)d_in[9];
    p.conv_b = (const float*)d_in[10]; p.cln_g = (const float*)d_in[11]; p.cln_b = (const float*)d_in[12]; p.sln_g = (const float*)d_in[13]; p.sln_b = (const float*)d_in[14];
    p.sgu_w = (const float*)d_in[15]; p.sgu_b = (const float*)d_in[16]; p.nsa_qg = (const float*)d_in[17]; p.nsa_kg = (const float*)d_in[18]; p.cmp_pos = (const float*)d_in[19];
    p.cmp_w1 = (const float*)d_in[20]; p.cmp_w2 = (const float*)d_in[21]; p.dsa_qg = (const float*)d_in[22]; p.dsa_kg = (const float*)d_in[23]; p.peer_wq = (const float*)d_in[24];
    p.peer_sk = (const float*)d_in[25]; p.peer_u = (const float*)d_in[26]; p.peer_v = (const float*)d_in[27];
    p.out = (float*)d_out;
    char* wsp = (char*)d_ws; size_t off = 0;
    auto carve = [&](size_t bytes) { char* r = wsp + off; off += (bytes + 255) & ~(size_t)255; return r; };
    p.WinT = (bf16_t*)carve((size_t)2 * LDP * 2048 * 2); p.WoutT = (bf16_t*)carve((size_t)2 * 2048 * 2048 * 2); p.WqT = (bf16_t*)carve((size_t)2 * 1024 * 2048 * 2);
    p.Utab = (unsigned char*)carve((size_t)2 * 16384 * 2048); p.Vtab = (unsigned char*)carve((size_t)2 * 16384 * 2048);
    p.ada = (float*)carve((size_t)2 * 12288 * 4);
    p.ropeC = (float*)carve((size_t)T * 24 * 4); p.ropeS = (float*)carve((size_t)T * 24 * 4);
    p.HN = (bf16_t*)carve((size_t)T * D * 2); p.PROJ = (bf16_t*)carve((size_t)T * LDP * 2); p.Y = (bf16_t*)carve((size_t)T * D * 2);
    p.QN = (bf16_t*)carve((size_t)T * 512 * 2); p.QR = (bf16_t*)carve((size_t)T * 512 * 2); p.KS = (bf16_t*)carve((size_t)T * 128 * 2); p.KW = (bf16_t*)carve((size_t)T * 128 * 2);
    p.VST = (bf16_t*)carve((size_t)T * 128 * 2); p.VWT = (bf16_t*)carve((size_t)T * 128 * 2); p.GATES = (float*)carve((size_t)T * 12 * 4);
    p.KC = (bf16_t*)carve((size_t)512 * 128 * 2); p.VCT = (bf16_t*)carve((size_t)128 * 512 * 2); p.SEL = (unsigned*)carve((size_t)T * 4 * 4); p.OCMP = (bf16_t*)carve((size_t)T * 512 * 2);
    p.DQ = (bf16_t*)carve((size_t)T * 512 * 2); p.DK = (bf16_t*)carve((size_t)T * 128 * 2); p.IQ = (bf16_t*)carve((size_t)T * 512 * 2); p.IK = (bf16_t*)carve((size_t)T * 64 * 2);
    p.IW = (float*)carve((size_t)T * 8 * 4); p.IDX = (int*)carve((size_t)T * 256 * 4); p.CNT = (int*)carve((size_t)T * 4);
    p.X1 = (float*)carve((size_t)T * D * 4); p.X2 = (float*)carve((size_t)T * D * 4); p.PQ = (float*)carve((size_t)T * 1024 * 4);
    p.PE = (int*)carve((size_t)T * 128 * 4); p.PG = (float*)carve((size_t)T * 128 * 4); p.bar = (unsigned*)carve((size_t)XCD_BAR_WORDS * 4);
    if (off > ws_size) { fprintf(stderr, "workspace too small: need %zu have %zu\n", off, ws_size); return; }
#ifndef MULTI_LAUNCH
    static int grid_blocks = 0;
    if (!grid_blocks) {
        int dev = 0, cus = 0, per_cu = 0;
        (void)hipGetDevice(&dev);
        (void)hipDeviceGetAttribute(&cus, hipDeviceAttributeMultiprocessorCount, dev);
        (void)hipOccupancyMaxActiveBlocksPerMultiprocessor(&per_cu, k_mega, NTHREADS, 0);
        if (per_cu > 2) per_cu = 2;
        grid_blocks = cus * per_cu;
    }
    (void)hipMemsetAsync(p.bar, 0, (size_t)XCD_BAR_WORDS * 4, stream);
    void* args[] = {&p};
    hipError_t e = hipLaunchCooperativeKernel((void*)k_mega, dim3(grid_blocks), dim3(NTHREADS), args, 0, stream);
    if (e != hipSuccess) fprintf(stderr, "cooperative launch failed: %s (grid %d)\n", hipGetErrorString(e), grid_blocks);
#else
    launch_stage<S_CONVT_IN>(p, 0, stream); launch_stage<S_CONVT_OUT>(p, 0, stream); launch_stage<S_CONVT_Q>(p, 0, stream);
    launch_stage<S_TAB_U>(p, 0, stream); launch_stage<S_TAB_V>(p, 0, stream);
    launch_stage<S_ADA>(p, 0, stream); launch_stage<S_ROPE>(p, 0, stream);
    for (int layer = 0; layer < NL; ++layer) {
        launch_stage<S_NORM1>(p, layer, stream); launch_stage<S_GEMM_IN>(p, layer, stream);
        launch_stage<S_CONV>(p, layer, stream); launch_stage<S_SGU>(p, layer, stream); launch_stage<S_VTRANS>(p, layer, stream);
        launch_stage<S_PREP>(p, layer, stream); launch_stage<S_COMPRESS>(p, layer, stream);
        launch_stage<S_NSA_CMP>(p, layer, stream); launch_stage<S_DSA_INDEX>(p, layer, stream);
        launch_stage<S_NSA_ATTN>(p, layer, stream); launch_stage<S_DSA_ATTN>(p, layer, stream);
        launch_stage<S_GEMM_OUT>(p, layer, stream); launch_stage<S_NORM2>(p, layer, stream); launch_stage<S_GEMM_Q>(p, layer, stream);
        launch_stage<S_PEER_TOPK>(p, layer, stream); launch_stage<S_PEER_GATHER>(p, layer, stream);
    }
#endif
}
```

```cpp
#include <hip/hip_runtime.h>
#include <hip/hip_cooperative_groups.h>
#include <stdint.h>
#include <cstdio>
namespace cg = cooperative_groups;

typedef unsigned short bf16_t;
typedef short bf16x8 __attribute__((ext_vector_type(8)));
typedef float f32x4 __attribute__((ext_vector_type(4)));
typedef float f32x16 __attribute__((ext_vector_type(16)));
#define DEV __device__ __forceinline__

constexpr int T = 8192, D = 2048, NL = 2;
constexpr int INC = 4692;
constexpr int LDP = 4736;
constexpr int C_CA = 0, C_CG = 512, C_SU = 1024, C_SV = 1536;
constexpr int C_NQ = 2048, C_NKC = 2560, C_NVC = 2688, C_NKS = 2816, C_NVS = 2944, C_NKW = 3072, C_NVW = 3200;
constexpr int C_DQ = 3328, C_DK = 3840, C_DV = 3968, C_IQ = 4096, C_IK = 4608, C_NG = 4672, C_IW = 4688;
constexpr float EPS = 1e-6f;
constexpr int NTHREADS = 256;
constexpr int SMEM_BYTES = 72 * 1024;

__device__ const double INV16[16] = {1.0, 0.44036660267178046, 0.19392274474868576, 0.08539710028576561, 0.03760603093086393,
    0.016560440080994446, 0.007292664737217109, 0.003211445994752591, 0.001414213562373095, 0.000622772421914596,
    0.0002742481756762073, 0.00012076973741146504, 5.318295896944988e-05, 2.341999896140934e-05, 1.031338537721246e-05,
    4.5416704806078695e-06};

#define XCD_BAR_WORDS 3456
#define GQ_WORD(inst, x) (XCD_BAR_WORDS + 64 * ((inst) * 8 + (x)))
#define CTRL_WORDS (XCD_BAR_WORDS + 64 * 48)
constexpr size_t WS_ALIGN(size_t x) { return (x + 255) & ~(size_t)255; }
constexpr size_t OFF_WinT = 0;
constexpr size_t OFF_WoutT = OFF_WinT + WS_ALIGN((size_t)2 * LDP * 2048 * 2);
constexpr size_t OFF_WqT = OFF_WoutT + WS_ALIGN((size_t)2 * 2048 * 2048 * 2);
constexpr size_t OFF_Utab = OFF_WqT + WS_ALIGN((size_t)2 * 1024 * 2048 * 2);
constexpr size_t OFF_Vtab = OFF_Utab + WS_ALIGN((size_t)2 * 16384 * 2048);
constexpr size_t OFF_ada = OFF_Vtab + WS_ALIGN((size_t)2 * 16384 * 2048);
constexpr size_t OFF_ropeC = OFF_ada + WS_ALIGN((size_t)2 * 12288 * 4);
constexpr size_t OFF_ropeS = OFF_ropeC + WS_ALIGN((size_t)T * 24 * 4);
constexpr size_t OFF_HN = OFF_ropeS + WS_ALIGN((size_t)T * 24 * 4);
constexpr size_t OFF_PROJ = OFF_HN + WS_ALIGN((size_t)T * D * 2);
constexpr size_t OFF_Y = OFF_PROJ + WS_ALIGN((size_t)T * LDP * 2);
constexpr size_t OFF_QN = OFF_Y + WS_ALIGN((size_t)T * D * 2);
constexpr size_t OFF_QR = OFF_QN + WS_ALIGN((size_t)T * 512 * 2);
constexpr size_t OFF_KS = OFF_QR + WS_ALIGN((size_t)T * 512 * 2);
constexpr size_t OFF_KW = OFF_KS + WS_ALIGN((size_t)T * 128 * 2);
constexpr size_t OFF_VST = OFF_KW + WS_ALIGN((size_t)T * 128 * 2);
constexpr size_t OFF_VWT = OFF_VST + WS_ALIGN((size_t)T * 128 * 2);
constexpr size_t OFF_GATES = OFF_VWT + WS_ALIGN((size_t)T * 128 * 2);
constexpr size_t OFF_KC = OFF_GATES + WS_ALIGN((size_t)T * 12 * 4);
constexpr size_t OFF_VCT = OFF_KC + WS_ALIGN((size_t)512 * 128 * 2);
constexpr size_t OFF_SEL = OFF_VCT + WS_ALIGN((size_t)128 * 512 * 2);
constexpr size_t OFF_OCMP = OFF_SEL + WS_ALIGN((size_t)T * 4 * 4);
constexpr size_t OFF_DQ = OFF_OCMP + WS_ALIGN((size_t)T * 512 * 2);
constexpr size_t OFF_DK = OFF_DQ + WS_ALIGN((size_t)T * 512 * 2);
constexpr size_t OFF_IQ = OFF_DK + WS_ALIGN((size_t)T * 128 * 2);
constexpr size_t OFF_IK = OFF_IQ + WS_ALIGN((size_t)T * 512 * 2);
constexpr size_t OFF_IW = OFF_IK + WS_ALIGN((size_t)T * 64 * 2);
constexpr size_t OFF_IDX = OFF_IW + WS_ALIGN((size_t)T * 8 * 4);
constexpr size_t OFF_CNT = OFF_IDX + WS_ALIGN((size_t)T * 256 * 4);
constexpr size_t OFF_X1 = OFF_CNT + WS_ALIGN((size_t)T * 4);
constexpr size_t OFF_X2 = OFF_X1 + WS_ALIGN((size_t)T * D * 4);
constexpr size_t OFF_PQ = OFF_X2 + WS_ALIGN((size_t)T * D * 4);
constexpr size_t OFF_PE = OFF_PQ + WS_ALIGN((size_t)T * 1024 * 4);
constexpr size_t OFF_PG = OFF_PE + WS_ALIGN((size_t)T * 128 * 4);
constexpr size_t OFF_bar = OFF_PG + WS_ALIGN((size_t)T * 128 * 4);
constexpr size_t WS_TOTAL = OFF_bar + WS_ALIGN((size_t)CTRL_WORDS * 4);

struct P {
    const float* x; const float* c; const int* pos; const float* ada_w; const float* ada_b; const float* n1g; const float* n2g;
    const float* w_in; const float* w_out; const float* conv_w; const float* conv_b; const float* cln_g; const float* cln_b;
    const float* sln_g; const float* sln_b; const float* sgu_w; const float* sgu_b; const float* nsa_qg; const float* nsa_kg;
    const float* cmp_pos; const float* cmp_w1; const float* cmp_w2; const float* dsa_qg; const float* dsa_kg;
    const float* peer_wq; const float* peer_sk; const float* peer_u; const float* peer_v;
    float* out;
    char* ws;
    __host__ __device__ __forceinline__ bf16_t* WinT() const { return (bf16_t*)(ws + OFF_WinT); }
    __host__ __device__ __forceinline__ bf16_t* WoutT() const { return (bf16_t*)(ws + OFF_WoutT); }
    __host__ __device__ __forceinline__ bf16_t* WqT() const { return (bf16_t*)(ws + OFF_WqT); }
    __host__ __device__ __forceinline__ unsigned char* Utab() const { return (unsigned char*)(ws + OFF_Utab); }
    __host__ __device__ __forceinline__ unsigned char* Vtab() const { return (unsigned char*)(ws + OFF_Vtab); }
    __host__ __device__ __forceinline__ float* ada() const { return (float*)(ws + OFF_ada); }
    __host__ __device__ __forceinline__ float* ropeC() const { return (float*)(ws + OFF_ropeC); }
    __host__ __device__ __forceinline__ float* ropeS() const { return (float*)(ws + OFF_ropeS); }
    __host__ __device__ __forceinline__ bf16_t* HN() const { return (bf16_t*)(ws + OFF_HN); }
    __host__ __device__ __forceinline__ bf16_t* PROJ() const { return (bf16_t*)(ws + OFF_PROJ); }
    __host__ __device__ __forceinline__ bf16_t* Y() const { return (bf16_t*)(ws + OFF_Y); }
    __host__ __device__ __forceinline__ bf16_t* QN() const { return (bf16_t*)(ws + OFF_QN); }
    __host__ __device__ __forceinline__ bf16_t* QR() const { return (bf16_t*)(ws + OFF_QR); }
    __host__ __device__ __forceinline__ bf16_t* KS() const { return (bf16_t*)(ws + OFF_KS); }
    __host__ __device__ __forceinline__ bf16_t* KW() const { return (bf16_t*)(ws + OFF_KW); }
    __host__ __device__ __forceinline__ bf16_t* VST() const { return (bf16_t*)(ws + OFF_VST); }
    __host__ __device__ __forceinline__ bf16_t* VWT() const { return (bf16_t*)(ws + OFF_VWT); }
    __host__ __device__ __forceinline__ float* GATES() const { return (float*)(ws + OFF_GATES); }
    __host__ __device__ __forceinline__ bf16_t* KC() const { return (bf16_t*)(ws + OFF_KC); }
    __host__ __device__ __forceinline__ bf16_t* VCT() const { return (bf16_t*)(ws + OFF_VCT); }
    __host__ __device__ __forceinline__ unsigned* SEL() const { return (unsigned*)(ws + OFF_SEL); }
    __host__ __device__ __forceinline__ bf16_t* OCMP() const { return (bf16_t*)(ws + OFF_OCMP); }
    __host__ __device__ __forceinline__ bf16_t* DQ() const { return (bf16_t*)(ws + OFF_DQ); }
    __host__ __device__ __forceinline__ bf16_t* DK() const { return (bf16_t*)(ws + OFF_DK); }
    __host__ __device__ __forceinline__ bf16_t* IQ() const { return (bf16_t*)(ws + OFF_IQ); }
    __host__ __device__ __forceinline__ bf16_t* IK() const { return (bf16_t*)(ws + OFF_IK); }
    __host__ __device__ __forceinline__ float* IW() const { return (float*)(ws + OFF_IW); }
    __host__ __device__ __forceinline__ int* IDX() const { return (int*)(ws + OFF_IDX); }
    __host__ __device__ __forceinline__ int* CNT() const { return (int*)(ws + OFF_CNT); }
    __host__ __device__ __forceinline__ float* X1() const { return (float*)(ws + OFF_X1); }
    __host__ __device__ __forceinline__ float* X2() const { return (float*)(ws + OFF_X2); }
    __host__ __device__ __forceinline__ float* PQ() const { return (float*)(ws + OFF_PQ); }
    __host__ __device__ __forceinline__ int* PE() const { return (int*)(ws + OFF_PE); }
    __host__ __device__ __forceinline__ float* PG() const { return (float*)(ws + OFF_PG); }
    __host__ __device__ __forceinline__ unsigned* bar() const { return (unsigned*)(ws + OFF_bar); }
};

DEV float bf2f(bf16_t v) { return __uint_as_float(((unsigned)v) << 16); }
DEV unsigned pk2(float lo, float hi) { unsigned r; asm("v_cvt_pk_bf16_f32 %0, %1, %2" : "=v"(r) : "v"(lo), "v"(hi)); return r; }
DEV bf16_t f2bf(float v) { return (bf16_t)(pk2(v, 0.f) & 0xffffu); }
DEV float lo2f(unsigned u) { return __uint_as_float(u << 16); }
DEV float hi2f(unsigned u) { return __uint_as_float(u & 0xffff0000u); }
DEV float wsum(float v) {
#pragma unroll
    for (int o = 32; o > 0; o >>= 1) v += __shfl_xor(v, o);
    return v;
}
DEV float wmax(float v) {
#pragma unroll
    for (int o = 32; o > 0; o >>= 1) v = fmaxf(v, __shfl_xor(v, o));
    return v;
}
DEV int tidx() { int t = threadIdx.x; asm volatile("" : "+v"(t)); return t; }
DEV float sigmoidf_(float x) { return 1.0f / (1.0f + __expf(-x)); }
DEV float gelu_tanh(float x) {
    const float y = 0.7978845608028654f * (x + 0.044715f * x * x * x);
    const float t = 1.0f - 2.0f / (1.0f + __expf(2.0f * y));
    return 0.5f * x * (1.0f + t);
}
DEV f32x4 mfma16(bf16x8 a, bf16x8 b, f32x4 c) { return __builtin_amdgcn_mfma_f32_16x16x32_bf16(a, b, c, 0, 0, 0); }
DEV f32x16 mfma32(bf16x8 a, bf16x8 b, f32x16 c) { return __builtin_amdgcn_mfma_f32_32x32x16_bf16(a, b, c, 0, 0, 0); }

DEV int src_col(int n) {
    if (n < 3328) return n;
    if (n < 4672) return 3340 + (n - 3328);
    if (n < 4684) return 3328 + (n - 4672);
    if (n < 4688) return -1;
    if (n < 4696) return 4684 + (n - 4688);
    return -1;
}

DEV void st_convT(const float* __restrict__ W, bf16_t* __restrict__ Bt, int N, int Npad, bool remap, int unit, char* smem) {
    float (*tile)[65] = (float (*)[65])smem;
    const int ntn = Npad / 64, kt = unit / ntn, nt = unit % ntn, k0 = kt * 64, n0 = nt * 64;
    const int tid_ = tidx(); const int tx = tid_ & 63, ty = tid_ >> 6;
    const int n = n0 + tx;
    const int src = remap ? src_col(n) : (n < N ? n : -1);
#pragma unroll
    for (int i = 0; i < 16; ++i) { const int k = ty + 4 * i; tile[k][tx] = src >= 0 ? W[(size_t)(k0 + k) * N + src] : 0.f; }
    __syncthreads();
#pragma unroll
    for (int i = 0; i < 16; ++i) { const int r = ty + 4 * i; Bt[(size_t)(n0 + r) * 2048 + k0 + tx] = f2bf(tile[tx][r]); }
    __syncthreads();
}

typedef float f32x2 __attribute__((ext_vector_type(2)));
DEV void st_tab(const float* __restrict__ src, unsigned char* __restrict__ dst, float scale, size_t n16, int unit, int nunits) {
    const int tid_ = tidx();
    for (size_t g = (size_t)unit * NTHREADS + tid_; g < n16; g += (size_t)nunits * NTHREADS) {
        const float4* sp = (const float4*)src + 4 * g;
        const float4 a = sp[0], b = sp[1], c = sp[2], d = sp[3];
        int w0 = __builtin_amdgcn_cvt_pk_fp8_f32(a.x * scale, a.y * scale, 0, false); w0 = __builtin_amdgcn_cvt_pk_fp8_f32(a.z * scale, a.w * scale, w0, true);
        int w1 = __builtin_amdgcn_cvt_pk_fp8_f32(b.x * scale, b.y * scale, 0, false); w1 = __builtin_amdgcn_cvt_pk_fp8_f32(b.z * scale, b.w * scale, w1, true);
        int w2 = __builtin_amdgcn_cvt_pk_fp8_f32(c.x * scale, c.y * scale, 0, false); w2 = __builtin_amdgcn_cvt_pk_fp8_f32(c.z * scale, c.w * scale, w2, true);
        int w3 = __builtin_amdgcn_cvt_pk_fp8_f32(d.x * scale, d.y * scale, 0, false); w3 = __builtin_amdgcn_cvt_pk_fp8_f32(d.z * scale, d.w * scale, w3, true);
        ((uint4*)dst)[g] = make_uint4((unsigned)w0, (unsigned)w1, (unsigned)w2, (unsigned)w3);
    }
}
constexpr float U8_SCALE = 64.0f, V8_SCALE = 4.0f;

DEV void st_ada(const P& p, int unit, char* smem) {
    float* red = (float*)smem;
    const int tid = tidx(), c = tid & 31, ks = tid >> 5;
    const int i = unit / 384, j = (unit % 384) * 32 + c;
    const float* W = p.ada_w + (size_t)i * 2048 * 12288 + (size_t)(ks * 256) * 12288 + j;
    float acc = 0.f;
#pragma unroll 8
    for (int k = 0; k < 256; ++k) {
        const float cv = p.c[ks * 256 + k];
        acc += (cv * sigmoidf_(cv)) * W[(size_t)k * 12288];
    }
    red[ks * 32 + c] = acc;
    __syncthreads();
    if (tid < 32) {
        float r = p.ada_b[i * 12288 + j];
#pragma unroll
        for (int q = 0; q < 8; ++q) r += red[q * 32 + tid];
        p.ada()[i * 12288 + j] = r;
    }
    __syncthreads();
}
DEV void st_rope(const P& p, int unit) {
    const int e = unit * 256 + tidx(); const int t = e / 24, i = e % 24;
    const double inv = i < 16 ? INV16[i] : INV16[2 * (i - 16)];
    const double ang = (double)p.pos[t] * inv;
    const double n = rint(ang * 0.15915494309189535);
    const double r = ang - n * 6.283185307179586;
    const double r2 = r * r;
    double sp = 1.0 / 1.5511210043330986e25, cp = -1.0 / 4.0329146112660565e26;
    sp = sp * r2 - 1.0 / 2.585201673888498e22;   cp = cp * r2 + 1.0 / 6.204484017332394e23;
    sp = sp * r2 + 1.0 / 5.109094217170944e19;   cp = cp * r2 - 1.0 / 1.1240007277776077e21;
    sp = sp * r2 - 1.0 / 1.21645100408832e17;    cp = cp * r2 + 1.0 / 2.43290200817664e18;
    sp = sp * r2 + 1.0 / 3.55687428096e14;       cp = cp * r2 - 1.0 / 6.402373705728e15;
    sp = sp * r2 - 1.0 / 1.307674368e12;         cp = cp * r2 + 1.0 / 2.0922789888e13;
    sp = sp * r2 + 1.0 / 6.2270208e9;            cp = cp * r2 - 1.0 / 8.71782912e10;
    sp = sp * r2 - 1.0 / 3.99168e7;              cp = cp * r2 + 1.0 / 4.790016e8;
    sp = sp * r2 + 1.0 / 362880.0;               cp = cp * r2 - 1.0 / 3628800.0;
    sp = sp * r2 - 1.0 / 5040.0;                 cp = cp * r2 + 1.0 / 40320.0;
    sp = sp * r2 + 1.0 / 120.0;                  cp = cp * r2 - 1.0 / 720.0;
    sp = sp * r2 - 1.0 / 6.0;                    cp = cp * r2 + 1.0 / 24.0;
    sp = sp * r2 + 1.0;                          cp = cp * r2 - 0.5;
    cp = cp * r2 + 1.0;
    const float cs = (float)cp, sn = (float)(sp * r);
    p.ropeC()[e] = cs; p.ropeS()[e] = sn;
}

DEV void st_norm(const float* __restrict__ X, const float* __restrict__ g, const float* __restrict__ sc, const float* __restrict__ sh,
                 bf16_t* __restrict__ HN, int unit) {
    const int tid_ = tidx(); const int w = tid_ >> 6, l = tid_ & 63; const int t = unit * 4 + w;
    const float4* xr = (const float4*)(X + (size_t)t * D);
    float4 v[8]; float ss = 0.f;
#pragma unroll
    for (int i = 0; i < 4; ++i) { v[2 * i] = xr[i * 128 + l * 2]; v[2 * i + 1] = xr[i * 128 + l * 2 + 1]; }
#pragma unroll
    for (int i = 0; i < 8; ++i) ss += v[i].x * v[i].x + v[i].y * v[i].y + v[i].z * v[i].z + v[i].w * v[i].w;
    ss = wsum(ss);
    const float rs = rsqrtf(ss * (1.0f / 2048.0f) + EPS);
#pragma unroll
    for (int i = 0; i < 4; ++i) {
        const int col = i * 512 + l * 8;
        float y[8]; const float xv[8] = {v[2 * i].x, v[2 * i].y, v[2 * i].z, v[2 * i].w, v[2 * i + 1].x, v[2 * i + 1].y, v[2 * i + 1].z, v[2 * i + 1].w};
#pragma unroll
        for (int j = 0; j < 8; ++j) y[j] = (xv[j] * rs) * g[col + j] * (1.0f + sc[col + j]) + sh[col + j];
        uint4 o; o.x = pk2(y[0], y[1]); o.y = pk2(y[2], y[3]); o.z = pk2(y[4], y[5]); o.w = pk2(y[6], y[7]);
        *(uint4*)(HN + (size_t)t * D + col) = o;
    }
}

enum { EPI_PROJ = 0, EPI_OUT = 1, EPI_Q = 2 };
struct EpiArgs { bf16_t* obf; float* of; const float* xin; const float* gate; };
template <int EPI>
DEV void st_gemm(const bf16_t* __restrict__ A, const bf16_t* __restrict__ Bt, int K, int tm, int tn, const EpiArgs& e, char* smem) {
    const int tid = tidx(), w = tid >> 6, l = tid & 63, wr = w >> 1, wc = w & 1;
    f32x4 acc[4][4];
#pragma unroll
    for (int m = 0; m < 4; ++m)
#pragma unroll
        for (int n = 0; n < 4; ++n) acc[m][n] = (f32x4){0.f, 0.f, 0.f, 0.f};
    const int srow = tid >> 2, spc = tid & 3, sc = spc ^ (((srow >> 2) & 1) << 1);
    const bf16_t* Ag = A + (size_t)(tm * 128 + srow) * K + sc * 8;
    const bf16_t* Bg = Bt + (size_t)(tn * 128 + srow) * K + sc * 8;
#define GEMM_STAGE(BUF, KO) do { char* _b = smem + (BUF) * 16384 + tid * 16; \
        __builtin_amdgcn_global_load_lds((const unsigned*)(Ag + (KO)), (__attribute__((address_space(3))) unsigned*)(_b), 16, 0, 0); \
        __builtin_amdgcn_global_load_lds((const unsigned*)(Ag + (size_t)64 * K + (KO)), (__attribute__((address_space(3))) unsigned*)(_b + 4096), 16, 0, 0); \
        __builtin_amdgcn_global_load_lds((const unsigned*)(Bg + (KO)), (__attribute__((address_space(3))) unsigned*)(_b + 8192), 16, 0, 0); \
        __builtin_amdgcn_global_load_lds((const unsigned*)(Bg + (size_t)64 * K + (KO)), (__attribute__((address_space(3))) unsigned*)(_b + 12288), 16, 0, 0); } while (0)
    const int nk = K / 32;
    GEMM_STAGE(0, 0); GEMM_STAGE(1, 32); GEMM_STAGE(2, 64);
    asm volatile("s_waitcnt vmcnt(8)" ::: "memory");
    __builtin_amdgcn_s_barrier();
    const int fr = l & 15, fq = l >> 4;
#pragma unroll 1
    for (int kt = 0; kt < nk; ++kt) {
        if (kt + 3 < nk) GEMM_STAGE((kt + 3) & 3, (kt + 3) * 32);
        const char* As = smem + (kt & 3) * 16384; const char* Bs = As + 8192;
        bf16x8 af[4], bfr[4];
#pragma unroll
        for (int m = 0; m < 4; ++m) { const int row = wr * 64 + m * 16 + fr; af[m] = *(const bf16x8*)(As + row * 64 + ((fq ^ (((row >> 2) & 1) << 1)) << 4)); }
#pragma unroll
        for (int n = 0; n < 4; ++n) { const int row = wc * 64 + n * 16 + fr; bfr[n] = *(const bf16x8*)(Bs + row * 64 + ((fq ^ (((row >> 2) & 1) << 1)) << 4)); }
#pragma unroll
        for (int m = 0; m < 4; ++m)
#pragma unroll
            for (int n = 0; n < 4; ++n) acc[m][n] = mfma16(bfr[n], af[m], acc[m][n]);
        if (kt + 3 < nk) asm volatile("s_waitcnt vmcnt(8)" ::: "memory");
        else if (kt + 2 < nk) asm volatile("s_waitcnt vmcnt(4)" ::: "memory");
        else asm volatile("s_waitcnt vmcnt(0)" ::: "memory");
        asm volatile("s_waitcnt lgkmcnt(0)" ::: "memory");
        __builtin_amdgcn_s_barrier();
    }
#undef GEMM_STAGE
#pragma unroll
    for (int m = 0; m < 4; ++m) {
        const int row = tm * 128 + wr * 64 + m * 16 + (l & 15);
#pragma unroll
        for (int n = 0; n < 4; ++n) {
            const int col = tn * 128 + wc * 64 + n * 16 + 4 * (l >> 4);
            const f32x4 a = acc[m][n];
            if (EPI == EPI_PROJ) {
                uint2 o; o.x = pk2(a[0], a[1]); o.y = pk2(a[2], a[3]);
                *(uint2*)(e.obf + (size_t)row * LDP + col) = o;
            } else if (EPI == EPI_OUT) {
                const float4 xi = *(const float4*)(e.xin + (size_t)row * D + col);
                const float4 gg = *(const float4*)(e.gate + col);
                float4 o; o.x = xi.x + gg.x * a[0]; o.y = xi.y + gg.y * a[1]; o.z = xi.z + gg.z * a[2]; o.w = xi.w + gg.w * a[3];
                *(float4*)(e.of + (size_t)row * D + col) = o;
            } else {
                float4 o; o.x = a[0]; o.y = a[1]; o.z = a[2]; o.w = a[3];
                *(float4*)(e.of + (size_t)row * 1024 + col) = o;
            }
        }
    }
    __syncthreads();
}

DEV void st_conv(const P& p, int layer, int unit, char* smem) {
    float* cs = (float*)smem;
    const int tid = tidx(), t0 = unit * 16;
    const float* cw = p.conv_w + (size_t)layer * 31 * 512;
#pragma unroll 1
    for (int cc = 0; cc < 2; ++cc) {
        const int c = tid + 256 * cc;
        float w[31], z[46];
#pragma unroll
        for (int k = 0; k < 31; ++k) w[k] = cw[k * 512 + c];
#pragma unroll
        for (int r = 0; r < 46; ++r) {
            const int t = t0 - 30 + r;
            float zz = 0.f;
            if (t >= 0) {
                const float a = bf2f(p.PROJ()[(size_t)t * LDP + C_CA + c]), g = bf2f(p.PROJ()[(size_t)t * LDP + C_CG + c]);
                zz = a * sigmoidf_(g);
            }
            z[r] = zz;
        }
        const float cb = p.conv_b[layer * 512 + c];
#pragma unroll
        for (int tt = 0; tt < 16; ++tt) {
            float acc = cb;
#pragma unroll
            for (int k = 0; k < 31; ++k) acc += w[k] * z[tt + k];
            cs[tt * 512 + c] = acc;
        }
    }
    __syncthreads();
    const int w = tid >> 6, l = tid & 63;
    const float* lg = p.cln_g + layer * 512; const float* lb = p.cln_b + layer * 512;
#pragma unroll 1
    for (int q = 0; q < 4; ++q) {
        const int tt = w * 4 + q;
        float v[8]; float s = 0.f;
#pragma unroll
        for (int i = 0; i < 8; ++i) { v[i] = cs[tt * 512 + l + 64 * i]; s += v[i]; }
        const float mean = wsum(s) * (1.0f / 512.0f);
        float q2 = 0.f;
#pragma unroll
        for (int i = 0; i < 8; ++i) { const float d = v[i] - mean; q2 += d * d; }
        const float rstd = rsqrtf(wsum(q2) * (1.0f / 512.0f) + EPS);
#pragma unroll
        for (int i = 0; i < 8; ++i) {
            const int c = l + 64 * i;
            const float y = (v[i] - mean) * rstd * lg[c] + lb[c];
            p.Y()[(size_t)(t0 + tt) * D + c] = f2bf(y * sigmoidf_(y));
        }
    }
    __syncthreads();
}

DEV void st_sgu(const P& p, int layer, int unit, char* smem) {
    const int n = unit >> 2, h = unit & 3, tid = tidx(), w = tid >> 6, l = tid & 63;
    float* stat = (float*)smem;
    float* wt = stat + 256;
    float* vt = wt + 16 * 132;
    const int tb = n * 128;
#pragma unroll 1
    for (int q = 0; q < 32; ++q) {
        const int j = w * 32 + q;
        const uint4 raw = *(const uint4*)(p.PROJ() + (size_t)(tb + j) * LDP + C_SV + l * 8);
        float v[8] = {lo2f(raw.x), hi2f(raw.x), lo2f(raw.y), hi2f(raw.y), lo2f(raw.z), hi2f(raw.z), lo2f(raw.w), hi2f(raw.w)};
        float s = 0.f;
#pragma unroll
        for (int i = 0; i < 8; ++i) s += v[i];
        const float mean = wsum(s) * (1.0f / 512.0f);
        float q2 = 0.f;
#pragma unroll
        for (int i = 0; i < 8; ++i) { const float d = v[i] - mean; q2 += d * d; }
        const float rstd = rsqrtf(wsum(q2) * (1.0f / 512.0f) + EPS);
        if (l == 0) { stat[j * 2] = mean; stat[j * 2 + 1] = rstd; }
    }
    __syncthreads();
    const int ti = tid >> 4, td = tid & 15;
    float acc[8][8];
#pragma unroll
    for (int a = 0; a < 8; ++a)
#pragma unroll
        for (int b = 0; b < 8; ++b) acc[a][b] = 0.f;
    const float* Wh = p.sgu_w + ((size_t)layer * 4 + h) * 128 * 128;
    const float* lg = p.sln_g + layer * 512 + h * 128; const float* lb = p.sln_b + layer * 512 + h * 128;
#pragma unroll 1
    for (int jc = 0; jc < 8; ++jc) {
#pragma unroll 2
        for (int q = 0; q < 8; ++q) {
            const int e = tid + 256 * q;
            { const int i = e >> 4, jj = e & 15, j = jc * 16 + jj; wt[jj * 132 + i] = (i >= j) ? Wh[i * 128 + j] : 0.f; }
            { const int jj = e >> 7, d = e & 127, j = jc * 16 + jj;
              const float x = bf2f(p.PROJ()[(size_t)(tb + j) * LDP + C_SV + h * 128 + d]);
              vt[jj * 128 + d] = (x - stat[j * 2]) * stat[j * 2 + 1] * lg[d] + lb[d]; }
        }
        __syncthreads();
        if (w * 32 + 31 >= jc * 16) {
#pragma unroll 2
            for (int jj = 0; jj < 16; ++jj) {
                const float4 w0 = *(const float4*)(wt + jj * 132 + ti * 8), w1 = *(const float4*)(wt + jj * 132 + ti * 8 + 4);
                const float4 v0 = *(const float4*)(vt + jj * 128 + td * 8), v1 = *(const float4*)(vt + jj * 128 + td * 8 + 4);
                const float wv[8] = {w0.x, w0.y, w0.z, w0.w, w1.x, w1.y, w1.z, w1.w};
                const float vv[8] = {v0.x, v0.y, v0.z, v0.w, v1.x, v1.y, v1.z, v1.w};
#pragma unroll
                for (int a = 0; a < 8; ++a)
#pragma unroll
                    for (int b = 0; b < 8; ++b) acc[a][b] += wv[a] * vv[b];
            }
        }
        __syncthreads();
    }
#pragma unroll
    for (int a = 0; a < 8; ++a) {
        const int i = ti * 8 + a; const size_t t = tb + i;
        const float bs = p.sgu_b[((size_t)layer * 4 + h) * 128 + i];
        const uint4 ur = *(const uint4*)(p.PROJ() + t * LDP + C_SU + h * 128 + td * 8);
        const float u[8] = {lo2f(ur.x), hi2f(ur.x), lo2f(ur.y), hi2f(ur.y), lo2f(ur.z), hi2f(ur.z), lo2f(ur.w), hi2f(ur.w)};
        float y[8];
#pragma unroll
        for (int b = 0; b < 8; ++b) y[b] = u[b] * (acc[a][b] + bs);
        uint4 o; o.x = pk2(y[0], y[1]); o.y = pk2(y[2], y[3]); o.z = pk2(y[4], y[5]); o.w = pk2(y[6], y[7]);
        *(uint4*)(p.Y() + t * D + 512 + h * 128 + td * 8) = o;
    }
}

DEV void st_vtrans(const P& p, int unit, char* smem) {
    bf16_t* tile = (bf16_t*)smem;
    const int which = unit & 1, tt0 = (unit >> 1) * 64, tid = tidx();
    const int col0 = which ? C_NVW : C_NVS;
    bf16_t* dst = which ? p.VWT() : p.VST();
#pragma unroll
    for (int q = 0; q < 4; ++q) {
        const int e = tid + 256 * q; const int r = e >> 4, c8 = e & 15;
        const uint4 raw = *(const uint4*)(p.PROJ() + (size_t)(tt0 + r) * LDP + col0 + c8 * 8);
        unsigned* d32 = (unsigned*)(tile + r * 130 + c8 * 8);
        d32[0] = raw.x; d32[1] = raw.y; d32[2] = raw.z; d32[3] = raw.w;
    }
    __syncthreads();
    const int d = tid >> 1, half = tid & 1;
    unsigned o[16];
#pragma unroll
    for (int i = 0; i < 16; ++i) {
        const unsigned a = tile[(half * 32 + 2 * i) * 130 + d], b = tile[(half * 32 + 2 * i + 1) * 130 + d];
        o[i] = a | (b << 16);
    }
    uint4* dp = (uint4*)(dst + (size_t)d * T + tt0 + half * 32);
#pragma unroll
    for (int i = 0; i < 4; ++i) dp[i] = make_uint4(o[4 * i], o[4 * i + 1], o[4 * i + 2], o[4 * i + 3]);
    __syncthreads();
}

DEV void head_norm_rope(const bf16_t* src, const float* g, const float* rc, const float* rs_, int l, bool rope, float& o0, float& o1, float& n0, float& n1) {
    const float x0 = bf2f(src[l]), x1 = bf2f(src[l + 64]);
    const float ss = wsum(x0 * x0 + x1 * x1);
    const float r = rsqrtf(ss * (1.0f / 128.0f) + EPS);
    n0 = x0 * r * g[l]; n1 = x1 * r * g[l + 64];
    o0 = n0; o1 = n1;
    const float other = __shfl_xor(n0, 16);
    if (rope && l < 32) {
        const float c = rc[l & 15], s = rs_[l & 15];
        o0 = (l < 16) ? (n0 * c - other * s) : (n0 * c + other * s);
    }
}
DEV void st_prep(const P& p, int layer, int unit) {
    const int tid_ = tidx(); const int w = tid_ >> 6, l = tid_ & 63; const size_t t = (size_t)unit * 4 + w;
    const bf16_t* row = p.PROJ() + t * LDP;
    const float* rc = p.ropeC() + t * 24; const float* rs_ = p.ropeS() + t * 24;
    float o0, o1, n0, n1;
#pragma unroll
    for (int h = 0; h < 4; ++h) {
        head_norm_rope(row + C_NQ + h * 128, p.nsa_qg + layer * 128, rc, rs_, l, true, o0, o1, n0, n1);
        p.QN()[(t * 4 + h) * 128 + l] = f2bf(n0); p.QN()[(t * 4 + h) * 128 + l + 64] = f2bf(n1);
        p.QR()[(t * 4 + h) * 128 + l] = f2bf(o0); p.QR()[(t * 4 + h) * 128 + l + 64] = f2bf(o1);
    }
    head_norm_rope(row + C_NKS, p.nsa_kg + (layer * 3 + 1) * 128, rc, rs_, l, true, o0, o1, n0, n1);
    p.KS()[t * 128 + l] = f2bf(o0); p.KS()[t * 128 + l + 64] = f2bf(o1);
    head_norm_rope(row + C_NKW, p.nsa_kg + (layer * 3 + 2) * 128, rc, rs_, l, true, o0, o1, n0, n1);
    p.KW()[t * 128 + l] = f2bf(o0); p.KW()[t * 128 + l + 64] = f2bf(o1);
    if (l < 12) p.GATES()[t * 12 + l] = sigmoidf_(bf2f(row[C_NG + l]));
#pragma unroll
    for (int h = 0; h < 4; ++h) {
        head_norm_rope(row + C_DQ + h * 128, p.dsa_qg + layer * 128, rc, rs_, l, true, o0, o1, n0, n1);
        p.DQ()[(t * 4 + h) * 128 + l] = f2bf(o0); p.DQ()[(t * 4 + h) * 128 + l + 64] = f2bf(o1);
    }
    head_norm_rope(row + C_DK, p.dsa_kg + layer * 128, rc, rs_, l, true, o0, o1, n0, n1);
    p.DK()[t * 128 + l] = f2bf(o0); p.DK()[t * 128 + l + 64] = f2bf(o1);
    const float ic = rc[16 + (l & 7)], is = rs_[16 + (l & 7)];
#pragma unroll
    for (int h = 0; h < 9; ++h) {
        const float x = bf2f(row[(h < 8 ? C_IQ + h * 64 : C_IK) + l]);
        const float other = __shfl_xor(x, 8);
        float o = x;
        if (l < 16) o = (l < 8) ? (x * ic - other * is) : (x * ic + other * is);
        if (h < 8) p.IQ()[(t * 8 + h) * 64 + l] = f2bf(o); else p.IK()[t * 64 + l] = f2bf(o);
    }
    if (l < 8) p.IW()[t * 8 + l] = bf2f(row[C_IW + l]) * (0.35355339059327373f * 0.125f);
}

DEV void st_compress(const P& p, int layer, int unit, char* smem) {
    const int which = unit & 1, g = unit >> 1, tid = tidx(), c = tid & 127, half = tid >> 7;
    bf16_t* xin = (bf16_t*)smem;
    float* pos = (float*)(smem + 36864);
    float* hid = (float*)(smem + 36864 + 16384);
    float* ob = hid + 8 * 128;
    const int tok0 = g * 128;
    const int col0 = which ? C_NVC : C_NKC;
#pragma unroll 1
    for (int e = tid; e < 144 * 16; e += 256) {
        const int r = e >> 4, c8 = e & 15; const int t = tok0 + r;
        uint4 raw = make_uint4(0, 0, 0, 0);
        if (t < T) raw = *(const uint4*)(p.PROJ() + (size_t)t * LDP + col0 + c8 * 8);
        *(uint4*)(xin + r * 128 + c8 * 8) = raw;
    }
    const float* ps = p.cmp_pos + ((size_t)layer * 2 + which) * 32 * 128;
#pragma unroll 1
    for (int e = tid; e < 32 * 128; e += 256) pos[e] = ps[e];
    __syncthreads();
    const float* w1 = p.cmp_w1 + ((size_t)layer * 2 + which) * 4096 * 128;
    float acc[4] = {0.f, 0.f, 0.f, 0.f};
#pragma unroll 1
    for (int ld = 0; ld < 32; ++ld) {
#pragma unroll 2
        for (int d8 = 0; d8 < 16; ++d8) {
            float wv[8];
#pragma unroll
            for (int j = 0; j < 8; ++j) wv[j] = w1[(size_t)(ld * 128 + d8 * 8 + j) * 128 + c];
            const float4 p0 = *(const float4*)(pos + ld * 128 + d8 * 8), p1 = *(const float4*)(pos + ld * 128 + d8 * 8 + 4);
            const float pv[8] = {p0.x, p0.y, p0.z, p0.w, p1.x, p1.y, p1.z, p1.w};
#pragma unroll
            for (int b = 0; b < 4; ++b) {
                const uint4 raw = *(const uint4*)(xin + (16 * (half * 4 + b) + ld) * 128 + d8 * 8);
                const float xv[8] = {lo2f(raw.x), hi2f(raw.x), lo2f(raw.y), hi2f(raw.y), lo2f(raw.z), hi2f(raw.z), lo2f(raw.w), hi2f(raw.w)};
#pragma unroll
                for (int j = 0; j < 8; ++j) acc[b] += (xv[j] + pv[j]) * wv[j];
            }
        }
    }
#pragma unroll
    for (int b = 0; b < 4; ++b) hid[(half * 4 + b) * 128 + c] = gelu_tanh(acc[b]);
    __syncthreads();
    const float* w2 = p.cmp_w2 + ((size_t)layer * 2 + which) * 128 * 128;
    float o[4] = {0.f, 0.f, 0.f, 0.f};
#pragma unroll 4
    for (int k = 0; k < 128; ++k) {
        const float wv = w2[k * 128 + c];
#pragma unroll
        for (int b = 0; b < 4; ++b) o[b] += hid[(half * 4 + b) * 128 + k] * wv;
    }
#pragma unroll
    for (int b = 0; b < 4; ++b) ob[(half * 4 + b) * 128 + c] = o[b];
    __syncthreads();
    const int w = tid >> 6, l = tid & 63;
#pragma unroll
    for (int q = 0; q < 2; ++q) {
        const int b = w * 2 + q, nb = g * 8 + b;
        float v0 = ob[b * 128 + l], v1 = ob[b * 128 + l + 64];
        if (which == 0) {
            const float r = rsqrtf(wsum(v0 * v0 + v1 * v1) * (1.0f / 128.0f) + EPS);
            const float* kg = p.nsa_kg + (layer * 3 + 0) * 128;
            v0 = v0 * r * kg[l]; v1 = v1 * r * kg[l + 64];
            if (nb >= 511) { v0 = 0.f; v1 = 0.f; }
            p.KC()[nb * 128 + l] = f2bf(v0); p.KC()[nb * 128 + l + 64] = f2bf(v1);
        } else {
            if (nb >= 511) { v0 = 0.f; v1 = 0.f; }
            p.VCT()[l * 512 + nb] = f2bf(v0); p.VCT()[(l + 64) * 512 + nb] = f2bf(v1);
        }
    }
    __syncthreads();
}

DEV void st_nsa_cmp(const P& p, int unit, char* smem) {
    const int tid = tidx(), w = tid >> 6, l = tid & 63, qc = l & 15, g4 = l >> 4;
    float* impl = (float*)smem + w * 512;
    const int t0 = unit * 16 + w * 4;
    const int tk = qc >> 2, hd = qc & 3, t = t0 + tk;
    bf16x8 qf[4];
#pragma unroll
    for (int ks = 0; ks < 4; ++ks) qf[ks] = *(const bf16x8*)(p.QN() + ((size_t)t0 * 4 + qc) * 128 + ks * 32 + g4 * 8);
    const int tmax = t0 + 3;
    const int nvmax = tmax >= 31 ? (tmax - 31) / 16 + 1 : 0;
    const int ntile = (nvmax + 15) >> 4;
    const int nvis = t >= 31 ? (t - 31) / 16 + 1 : 0;
    const float cs = 0.08838834764831845f * 1.4426950408889634f;
    float m = -1e30f, lsum = 0.f;
#pragma unroll 1
    for (int tt = 0; tt < ntile; ++tt) {
        f32x4 s = (f32x4){0.f, 0.f, 0.f, 0.f};
#pragma unroll
        for (int ks = 0; ks < 4; ++ks) {
            const bf16x8 a = *(const bf16x8*)(p.KC() + (size_t)(tt * 16 + qc) * 128 + ks * 32 + g4 * 8);
            s = mfma16(a, qf[ks], s);
        }
        float mx = m;
#pragma unroll
        for (int r = 0; r < 4; ++r) { const int key = tt * 16 + 4 * g4 + r; s[r] *= cs; if (key < nvis) mx = fmaxf(mx, s[r]); }
        float ps = 0.f;
#pragma unroll
        for (int r = 0; r < 4; ++r) { const int key = tt * 16 + 4 * g4 + r; ps += (key < nvis) ? exp2f(s[r] - mx) : 0.f; }
        lsum = lsum * exp2f(m - mx) + ps; m = mx;
    }
    {
        float mt_ = fmaxf(m, __shfl_xor(m, 16)); mt_ = fmaxf(mt_, __shfl_xor(mt_, 32));
        lsum *= exp2f(m - mt_); m = mt_;
        lsum += __shfl_xor(lsum, 16); lsum += __shfl_xor(lsum, 32);
    }
    const float inv = lsum > 0.f ? 1.0f / lsum : 0.f;
    f32x4 o[8];
#pragma unroll
    for (int mt = 0; mt < 8; ++mt) o[mt] = (f32x4){0.f, 0.f, 0.f, 0.f};
    float yprev = 0.f;
#pragma unroll 1
    for (int u = 0; u < 16; ++u) {
        f32x4 s2[2];
#pragma unroll
        for (int q = 0; q < 2; ++q) {
            const int tt = 2 * u + q;
            f32x4 s = (f32x4){0.f, 0.f, 0.f, 0.f};
            if (tt < ntile) {
#pragma unroll
                for (int ks = 0; ks < 4; ++ks) {
                    const bf16x8 a = *(const bf16x8*)(p.KC() + (size_t)(tt * 16 + qc) * 128 + ks * 32 + g4 * 8);
                    s = mfma16(a, qf[ks], s);
                }
            }
#pragma unroll
            for (int r = 0; r < 4; ++r) { const int key = tt * 16 + 4 * g4 + r; s[r] = (key < nvis) ? exp2f(s[r] * cs - m) * inv : 0.f; }
            const float y = __shfl(s[3], (l + 48) & 63);
            float iv = (s[0] + s[1]) + (s[2] + s[3]) + (g4 > 0 ? y : yprev);
            yprev = y;
            iv += __shfl_xor(iv, 1); iv += __shfl_xor(iv, 2);
            if (hd == 0) impl[tk * 128 + 4 * tt + g4] = iv;
            s2[q] = s;
        }
        if (2 * u < ntile) {
            union { bf16x8 v; unsigned u32[4]; } b;
            b.u32[0] = pk2(s2[0][0], s2[0][1]); b.u32[1] = pk2(s2[0][2], s2[0][3]);
            b.u32[2] = pk2(s2[1][0], s2[1][1]); b.u32[3] = pk2(s2[1][2], s2[1][3]);
#pragma unroll
            for (int mt = 0; mt < 8; ++mt) {
                const bf16_t* vp = p.VCT() + (size_t)(mt * 16 + qc) * 512 + 32 * u + 4 * g4;
                union { bf16x8 v; uint2 h2[2]; } a;
                a.h2[0] = *(const uint2*)vp; a.h2[1] = *(const uint2*)(vp + 16);
                o[mt] = mfma16(a.v, b.v, o[mt]);
            }
        }
    }
#pragma unroll
    for (int mt = 0; mt < 8; ++mt) {
        uint2 ov; ov.x = pk2(o[mt][0], o[mt][1]); ov.y = pk2(o[mt][2], o[mt][3]);
        *(uint2*)(p.OCMP() + ((size_t)t * 4 + hd) * 128 + mt * 16 + 4 * g4) = ov;
    }
    __syncthreads();
    const int li = hd + 4 * g4, cur = t >> 6;
    unsigned long long own[8]; int rank[8];
#pragma unroll
    for (int i = 0; i < 8; ++i) {
        const int j = li + 16 * i; const float v = impl[tk * 128 + j];
        const unsigned k32 = (j == 0 || j == cur || j == cur - 1) ? 0xFFFFFFFFu : (j > cur ? 0u : __float_as_uint(v) + 128u);
        own[i] = ((unsigned long long)k32 << 7) | (unsigned)(127 - j); rank[i] = 0;
    }
#pragma unroll 1
    for (int ip = 0; ip < 8; ++ip) {
#pragma unroll
        for (int q4 = 0; q4 < 4; ++q4) {
            const float4 ov = *(const float4*)(impl + tk * 128 + ip * 16 + q4 * 4);
            const float o4[4] = {ov.x, ov.y, ov.z, ov.w};
#pragma unroll
            for (int e = 0; e < 4; ++e) {
                const int jp = ip * 16 + q4 * 4 + e;
                const unsigned k32 = (jp == 0 || jp == cur || jp == cur - 1) ? 0xFFFFFFFFu : (jp > cur ? 0u : __float_as_uint(o4[e]) + 128u);
                const unsigned long long kp = ((unsigned long long)k32 << 7) | (unsigned)(127 - jp);
#pragma unroll
                for (int i = 0; i < 8; ++i) rank[i] += (kp > own[i]) ? 1 : 0;
            }
        }
    }
    unsigned mw[4] = {0u, 0u, 0u, 0u};
#pragma unroll
    for (int i = 0; i < 8; ++i) if (rank[i] < 16) mw[i >> 1] |= 1u << (li + 16 * (i & 1));
#pragma unroll
    for (int q = 0; q < 4; ++q) {
        unsigned v = mw[q];
        v |= __shfl_xor(v, 1); v |= __shfl_xor(v, 2); v |= __shfl_xor(v, 16); v |= __shfl_xor(v, 32);
        mw[q] = v;
    }
    if (li == 0) *(uint4*)(p.SEL() + (size_t)t * 4) = make_uint4(mw[0], mw[1], mw[2], mw[3]);
    __syncthreads();
}

DEV void st_nsa_attn(const P& p, int unit, char* smem) {
    constexpr int RSK = 272, RSV = 136, BUFB = 64 * RSK + 128 * RSV;
    const int tid = tidx(), w = tid >> 6, l = tid & 63, qc = l & 15, g4 = l >> 4;
    const int tq0 = unit * 16, t = tq0 + w * 4 + (qc >> 2), hd = qc & 3;
    bf16x8 qf[4];
#pragma unroll
    for (int ks = 0; ks < 4; ++ks) qf[ks] = *(const bf16x8*)(p.QR() + ((size_t)t * 4 + hd) * 128 + ks * 32 + g4 * 8);
    const uint4 selw = *(const uint4*)(p.SEL() + (size_t)t * 4);
    const float cs = 0.08838834764831845f * 1.4426950408889634f;
    unsigned part[8][2];
#pragma unroll
    for (int mt = 0; mt < 8; ++mt) { part[mt][0] = 0u; part[mt][1] = 0u; }
    const float g0 = p.GATES()[(size_t)t * 12 + hd * 3];
    int gstep = 0;
    const int krow = tid >> 4, kc16 = tid & 15, vrow = tid >> 3, vc16 = tid & 7;
#pragma unroll 1
    for (int br = 0; br < 2; ++br) {
        const bf16_t* Kg = br ? p.KW() : p.KS(); const bf16_t* Vg = br ? p.VWT() : p.VST();
        const int ktlast = (tq0 + 15) >> 6;
        const int ktfirst = br ? ((tq0 - 511 > 0 ? tq0 - 511 : 0) >> 6) : 0;
        const int nk = ktlast - ktfirst + 1;
        f32x4 o[8];
#pragma unroll
        for (int mt = 0; mt < 8; ++mt) o[mt] = (f32x4){0.f, 0.f, 0.f, 0.f};
        float m = -1e30f, lsum = 0.f;
        uint4 rk0, rk1, rk2, rk3, rv0, rv1, rv2, rv3;
#define NSA_LOAD(KT) do { const bf16_t* kb = Kg + (size_t)((KT) * 64 + krow) * 128 + kc16 * 8; const bf16_t* vb = Vg + (size_t)vrow * T + (KT) * 64 + vc16 * 8; \
        rk0 = *(const uint4*)kb; rk1 = *(const uint4*)(kb + 16 * 128); rk2 = *(const uint4*)(kb + 32 * 128); rk3 = *(const uint4*)(kb + 48 * 128); \
        rv0 = *(const uint4*)vb; rv1 = *(const uint4*)(vb + (size_t)32 * T); rv2 = *(const uint4*)(vb + (size_t)64 * T); rv3 = *(const uint4*)(vb + (size_t)96 * T); } while (0)
        NSA_LOAD(ktfirst);
#pragma unroll 1
        for (int i = 0; i < nk; ++i, ++gstep) {
            const int kt = ktfirst + i;
            char* Kt = smem + (gstep & 1) * BUFB; char* Vt = Kt + 64 * RSK;
            *(uint4*)(Kt + krow * RSK + kc16 * 16) = rk0; *(uint4*)(Kt + (krow + 16) * RSK + kc16 * 16) = rk1;
            *(uint4*)(Kt + (krow + 32) * RSK + kc16 * 16) = rk2; *(uint4*)(Kt + (krow + 48) * RSK + kc16 * 16) = rk3;
            *(uint4*)(Vt + vrow * RSV + vc16 * 16) = rv0; *(uint4*)(Vt + (vrow + 32) * RSV + vc16 * 16) = rv1;
            *(uint4*)(Vt + (vrow + 64) * RSV + vc16 * 16) = rv2; *(uint4*)(Vt + (vrow + 96) * RSV + vc16 * 16) = rv3;
            __syncthreads();
            if (i + 1 < nk) NSA_LOAD(kt + 1);
            int lo, hi = t;
            if (br == 0) {
                const unsigned wv = (kt & 64) ? ((kt & 32) ? selw.w : selw.z) : ((kt & 32) ? selw.y : selw.x);
                lo = 0; hi = ((wv >> (kt & 31)) & 1u) ? t : -1;
            } else lo = t - 511;
            const bool interior = (kt * 64 + 63 <= tq0) && (br == 0 || kt * 64 >= tq0 + 15 - 511);
            f32x4 sv[4];
            float mx = -3e38f;
            if (interior) {
                const float csl = hi >= 0 ? cs : 0.f, add = hi >= 0 ? 0.f : -3e38f;
#pragma unroll
                for (int sub = 0; sub < 4; ++sub) {
                    f32x4 a4 = (f32x4){0.f, 0.f, 0.f, 0.f};
#pragma unroll
                    for (int ks = 0; ks < 4; ++ks) a4 = mfma16(*(const bf16x8*)(Kt + (sub * 16 + qc) * RSK + (ks * 32 + g4 * 8) * 2), qf[ks], a4);
#pragma unroll
                    for (int r = 0; r < 4; ++r) { a4[r] = a4[r] * csl + add; mx = fmaxf(mx, a4[r]); }
                    sv[sub] = a4;
                }
            } else {
#pragma unroll
                for (int sub = 0; sub < 4; ++sub) {
                    f32x4 a4 = (f32x4){0.f, 0.f, 0.f, 0.f};
#pragma unroll
                    for (int ks = 0; ks < 4; ++ks) a4 = mfma16(*(const bf16x8*)(Kt + (sub * 16 + qc) * RSK + (ks * 32 + g4 * 8) * 2), qf[ks], a4);
#pragma unroll
                    for (int r = 0; r < 4; ++r) {
                        const int kp = kt * 64 + sub * 16 + 4 * g4 + r;
                        const bool valid = (kp >= lo) & (kp <= hi);
                        a4[r] = valid ? a4[r] * cs : -3e38f;
                        mx = fmaxf(mx, a4[r]);
                    }
                    sv[sub] = a4;
                }
            }
            mx = fmaxf(mx, __shfl_xor(mx, 16)); mx = fmaxf(mx, __shfl_xor(mx, 32));
            const float mnew = fmaxf(fmaxf(m, mx), -1e30f);
            const float alpha = __builtin_amdgcn_exp2f(m - mnew);
            m = mnew;
            float ps = 0.f;
#pragma unroll
            for (int sub = 0; sub < 4; ++sub)
#pragma unroll
                for (int r = 0; r < 4; ++r) { const float pv = __builtin_amdgcn_exp2f(sv[sub][r] - mnew); sv[sub][r] = pv; ps += pv; }
            lsum = lsum * alpha + ps;
            if (__any(alpha != 1.0f)) {
#pragma unroll
                for (int mt = 0; mt < 8; ++mt) o[mt] *= alpha;
            }
#pragma unroll
            for (int pr = 0; pr < 2; ++pr) {
                union { bf16x8 v; unsigned u32[4]; } bb;
                bb.u32[0] = pk2(sv[2 * pr][0], sv[2 * pr][1]); bb.u32[1] = pk2(sv[2 * pr][2], sv[2 * pr][3]);
                bb.u32[2] = pk2(sv[2 * pr + 1][0], sv[2 * pr + 1][1]); bb.u32[3] = pk2(sv[2 * pr + 1][2], sv[2 * pr + 1][3]);
#pragma unroll
                for (int mt = 0; mt < 8; ++mt) {
                    const char* vp = Vt + (mt * 16 + qc) * RSV + (pr * 32 + 4 * g4) * 2;
                    union { bf16x8 v; uint2 h2[2]; } aa;
                    aa.h2[0] = *(const uint2*)vp; aa.h2[1] = *(const uint2*)(vp + 32);
                    o[mt] = mfma16(aa.v, bb.v, o[mt]);
                }
            }
        }
#undef NSA_LOAD
        lsum += __shfl_xor(lsum, 16); lsum += __shfl_xor(lsum, 32);
        const float gate = p.GATES()[(size_t)t * 12 + hd * 3 + 1 + br];
        const float sc = lsum > 0.f ? gate / lsum : 0.f;
        if (br == 0) {
#pragma unroll
            for (int mt = 0; mt < 8; ++mt) {
                const uint2 oc = *(const uint2*)(p.OCMP() + ((size_t)t * 4 + hd) * 128 + mt * 16 + 4 * g4);
                part[mt][0] = pk2(sc * o[mt][0] + g0 * lo2f(oc.x), sc * o[mt][1] + g0 * hi2f(oc.x));
                part[mt][1] = pk2(sc * o[mt][2] + g0 * lo2f(oc.y), sc * o[mt][3] + g0 * hi2f(oc.y));
            }
        } else {
#pragma unroll
            for (int mt = 0; mt < 8; ++mt) {
                uint2 ov;
                ov.x = pk2(sc * o[mt][0] + lo2f(part[mt][0]), sc * o[mt][1] + hi2f(part[mt][0]));
                ov.y = pk2(sc * o[mt][2] + lo2f(part[mt][1]), sc * o[mt][3] + hi2f(part[mt][1]));
                *(uint2*)(p.Y() + (size_t)t * D + 1024 + hd * 128 + mt * 16 + 4 * g4) = ov;
            }
        }
    }
    __syncthreads();
}

DEV unsigned f2key(float f) { const unsigned u = __float_as_uint(f); return (u & 0x80000000u) ? ~u : (u | 0x80000000u); }
DEV float key2f(unsigned k) { const unsigned u = (k & 0x80000000u) ? (k & 0x7fffffffu) : ~k; return __uint_as_float(u); }
DEV float wave_prune(float* sc, unsigned short* ix, unsigned* hist, int m, int l) {
    float v[8]; unsigned k[8]; unsigned short id[8]; bool ok[8];
#pragma unroll
    for (int i = 0; i < 8; ++i) {
        const int e = l + 64 * i; ok[i] = e < m;
        v[i] = ok[i] ? sc[e] : 0.f; id[i] = ok[i] ? ix[e] : (unsigned short)0; k[i] = f2key(v[i]);
    }
    unsigned prefix = 0u; int need = 256;
#pragma unroll 1
    for (int pass = 0; pass < 4; ++pass) {
        const int shift = 24 - 8 * pass;
        *(uint4*)(hist + 4 * l) = make_uint4(0u, 0u, 0u, 0u);
        __builtin_amdgcn_wave_barrier();
#pragma unroll
        for (int i = 0; i < 8; ++i) {
            const bool in = ok[i] && (pass == 0 || (k[i] >> (shift + 8)) == prefix);
            if (in) atomicAdd(&hist[(k[i] >> shift) & 255u], 1u);
        }
        __builtin_amdgcn_wave_barrier();
        const uint4 hv = *(const uint4*)(hist + 4 * l);
        const unsigned hq[4] = {hv.x, hv.y, hv.z, hv.w};
        const unsigned own = hv.x + hv.y + hv.z + hv.w;
        unsigned tot = own;
#pragma unroll
        for (int o = 1; o < 64; o <<= 1) { const unsigned tv = __shfl_down(tot, o); if (l + o < 64) tot += tv; }
        unsigned cum = tot - own; int found = -1; int nneed = 0;
#pragma unroll
        for (int kk = 3; kk >= 0; --kk) {
            const unsigned c = hq[kk];
            if (found < 0 && (int)cum < need && (int)(cum + c) >= need) { found = 4 * l + kk; nneed = need - (int)cum; }
            cum += c;
        }
        const unsigned long long bal = __ballot(found >= 0);
        const int src = __ffsll((long long)bal) - 1;
        const int digit = __shfl(found, src); need = __shfl(nneed, src);
        prefix = (prefix << 8) | (unsigned)digit;
    }
    const unsigned thr = prefix;
    int base = 0, ties = 0;
    const unsigned long long ltmask = (1ull << l) - 1ull;
#pragma unroll
    for (int i = 0; i < 8; ++i) {
        const bool gt = ok[i] && k[i] > thr, eq = ok[i] && k[i] == thr;
        const unsigned long long em = __ballot(eq);
        const int trank = ties + __popcll(em & ltmask);
        const bool keep = gt || (eq && trank < need);
        ties += __popcll(em);
        const unsigned long long km = __ballot(keep);
        const int pos = base + __popcll(km & ltmask);
        if (keep) { sc[pos] = v[i]; ix[pos] = id[i]; }
        base += __popcll(km);
    }
    __builtin_amdgcn_wave_barrier();
    return key2f(thr);
}

#define DSA_APPEND(SCP, IXP, CNT, M32, MINE, SV) do { \
    const unsigned _m = (M32); \
    if (MINE) { const int _pos = (CNT) + __popc(_m & ((1u << n) - 1u)); (SCP)[_pos] = (SV); (IXP)[_pos] = (unsigned short)kp; } \
    (CNT) += __popc(_m); } while (0)

DEV void st_dsa_index(const P& p, int unit, char* smem) {
    const int tid = tidx(), w = tid >> 6, l = tid & 63, n = l & 31, h = l >> 5;
    char* wb = smem + w * 14336;
    float* sc0 = (float*)wb; float* sc1 = sc0 + 512; float* sc2 = sc1 + 512; float* sc3 = sc2 + 512;
    unsigned short* ix0 = (unsigned short*)(wb + 8192); unsigned short* ix1 = ix0 + 512; unsigned short* ix2 = ix1 + 512; unsigned short* ix3 = ix2 + 512;
    unsigned* hist = (unsigned*)(wb + 12288);
    const int wu = unit * 4 + w;
    const int tg = (wu & 1) ? (2047 - (wu >> 1)) : (wu >> 1);
    const int t0 = tg * 4;
    const int tl = 2 * ((n >> 2) & 1) + (n >> 4), hdr = (n & 3) + 4 * ((n >> 3) & 1);
    bf16x8 af[4];
#pragma unroll
    for (int s = 0; s < 4; ++s) af[s] = *(const bf16x8*)(p.IQ() + ((size_t)(t0 + tl) * 8 + hdr) * 64 + 16 * s + 8 * h);
    const int tA = t0 + 2 * h, tB = tA + 1;
    float wA[8], wB[8];
#pragma unroll
    for (int r = 0; r < 8; ++r) { wA[r] = p.IW()[(size_t)tA * 8 + r]; wB[r] = p.IW()[(size_t)tB * 8 + r]; }
    int cnt0 = 0, cnt1 = 0, cnt2 = 0, cnt3 = 0;
    const float NINF = -__builtin_inff();
    float tau0 = NINF, tau1 = NINF, tau2 = NINF, tau3 = NINF;
    const int ntiles = (t0 + 3) / 32 + 1;
    const bf16_t* ikp = p.IK() + (size_t)n * 64 + 8 * h;
    bf16x8 na[4], nb[4];
#pragma unroll
    for (int s = 0; s < 4; ++s) { na[s] = *(const bf16x8*)(ikp + 16 * s); nb[s] = *(const bf16x8*)(ikp + (size_t)(ntiles > 1 ? 32 : 0) * 64 + 16 * s); }
#pragma unroll 1
    for (int kt = 0; kt < ntiles; kt += 2) {
        bf16x8 ca[4], cb[4];
#pragma unroll
        for (int s = 0; s < 4; ++s) { ca[s] = na[s]; cb[s] = nb[s]; }
        {
            const int ka = kt + 2 < ntiles ? kt + 2 : ntiles - 1, kb = kt + 3 < ntiles ? kt + 3 : ntiles - 1;
#pragma unroll
            for (int s = 0; s < 4; ++s) { na[s] = *(const bf16x8*)(ikp + (size_t)ka * 32 * 64 + 16 * s); nb[s] = *(const bf16x8*)(ikp + (size_t)kb * 32 * 64 + 16 * s); }
        }
        f32x16 acca, accb;
#pragma unroll
        for (int r = 0; r < 16; ++r) { acca[r] = 0.f; accb[r] = 0.f; }
#pragma unroll
        for (int s = 0; s < 4; ++s) { acca = mfma32(af[s], ca[s], acca); accb = mfma32(af[s], cb[s], accb); }
        float s0a = 0.f, s1a = 0.f, s0b = 0.f, s1b = 0.f, u0a = 0.f, u1a = 0.f, u0b = 0.f, u1b = 0.f;
#pragma unroll
        for (int r = 0; r < 4; ++r) {
            s0a += wA[r] * fmaxf(acca[r], 0.f); u0a += wA[4 + r] * fmaxf(acca[4 + r], 0.f);
            s1a += wB[r] * fmaxf(acca[8 + r], 0.f); u1a += wB[4 + r] * fmaxf(acca[12 + r], 0.f);
            s0b += wA[r] * fmaxf(accb[r], 0.f); u0b += wA[4 + r] * fmaxf(accb[4 + r], 0.f);
            s1b += wB[r] * fmaxf(accb[8 + r], 0.f); u1b += wB[4 + r] * fmaxf(accb[12 + r], 0.f);
        }
        s0a += u0a; s1a += u1a; s0b += u0b; s1b += u1b;
        const float tauA = h ? tau2 : tau0, tauB = h ? tau3 : tau1;
        {
            const int kp = kt * 32 + n;
            const bool cA = (kp <= tA) && (s0a > tauA), cB = (kp <= tB) && (s1a > tauB);
            const unsigned long long mA = __ballot(cA), mB = __ballot(cB);
            DSA_APPEND(sc0, ix0, cnt0, (unsigned)mA, (h == 0 && cA), s0a);
            DSA_APPEND(sc2, ix2, cnt2, (unsigned)(mA >> 32), (h == 1 && cA), s0a);
            DSA_APPEND(sc1, ix1, cnt1, (unsigned)mB, (h == 0 && cB), s1a);
            DSA_APPEND(sc3, ix3, cnt3, (unsigned)(mB >> 32), (h == 1 && cB), s1a);
        }
        {
            const int kp = kt * 32 + 32 + n;
            const bool cA = (kp <= tA) && (s0b > tauA), cB = (kp <= tB) && (s1b > tauB);
            const unsigned long long mA = __ballot(cA), mB = __ballot(cB);
            DSA_APPEND(sc0, ix0, cnt0, (unsigned)mA, (h == 0 && cA), s0b);
            DSA_APPEND(sc2, ix2, cnt2, (unsigned)(mA >> 32), (h == 1 && cA), s0b);
            DSA_APPEND(sc1, ix1, cnt1, (unsigned)mB, (h == 0 && cB), s1b);
            DSA_APPEND(sc3, ix3, cnt3, (unsigned)(mB >> 32), (h == 1 && cB), s1b);
        }
        __builtin_amdgcn_wave_barrier();
        if (max(max(cnt0, cnt1), max(cnt2, cnt3)) > 448) {
            if (cnt0 > 448) { tau0 = wave_prune(sc0, ix0, hist, cnt0, l); cnt0 = 256; }
            if (cnt1 > 448) { tau1 = wave_prune(sc1, ix1, hist, cnt1, l); cnt1 = 256; }
            if (cnt2 > 448) { tau2 = wave_prune(sc2, ix2, hist, cnt2, l); cnt2 = 256; }
            if (cnt3 > 448) { tau3 = wave_prune(sc3, ix3, hist, cnt3, l); cnt3 = 256; }
        }
    }
    if (cnt0 > 256) { wave_prune(sc0, ix0, hist, cnt0, l); cnt0 = 256; }
    if (cnt1 > 256) { wave_prune(sc1, ix1, hist, cnt1, l); cnt1 = 256; }
    if (cnt2 > 256) { wave_prune(sc2, ix2, hist, cnt2, l); cnt2 = 256; }
    if (cnt3 > 256) { wave_prune(sc3, ix3, hist, cnt3, l); cnt3 = 256; }
    __builtin_amdgcn_wave_barrier();
#pragma unroll
    for (int i = 0; i < 4; ++i) {
        const int e = l + 64 * i;
        p.IDX()[(size_t)(t0 + 0) * 256 + e] = e < cnt0 ? (int)ix0[e] : 0;
        p.IDX()[(size_t)(t0 + 1) * 256 + e] = e < cnt1 ? (int)ix1[e] : 0;
        p.IDX()[(size_t)(t0 + 2) * 256 + e] = e < cnt2 ? (int)ix2[e] : 0;
        p.IDX()[(size_t)(t0 + 3) * 256 + e] = e < cnt3 ? (int)ix3[e] : 0;
    }
    if (l == 0) { p.CNT()[t0] = cnt0; p.CNT()[t0 + 1] = cnt1; p.CNT()[t0 + 2] = cnt2; p.CNT()[t0 + 3] = cnt3; }
}

DEV void st_dsa_attn(const P& p, int unit, char* smem) {
    const int tid = tidx(), w = tid >> 6, l = tid & 63, c = l & 15, g4 = l >> 4;
    int* idxs = (int*)(smem + w * 5120); float* Pl = (float*)(smem + w * 5120 + 1024);
    const size_t t = (size_t)unit * 4 + w;
    const int cnt = p.CNT()[t];
#pragma unroll
    for (int i = 0; i < 4; ++i) idxs[l + 64 * i] = p.IDX()[t * 256 + l + 64 * i];
    __builtin_amdgcn_wave_barrier();
    bf16x8 qf[4];
#pragma unroll
    for (int j = 0; j < 4; ++j) qf[j] = *(const bf16x8*)(p.DQ() + (t * 4 + (c & 3)) * 128 + g4 * 32 + j * 8);
    f32x4 s[16];
    const int ntile = (cnt + 15) >> 4;
#pragma unroll
    for (int tt = 0; tt < 16; ++tt) {
        s[tt] = (f32x4){0.f, 0.f, 0.f, 0.f};
        if (tt < ntile) {
            const int krow = idxs[tt * 16 + c];
            const bf16_t* kp = p.DK() + (size_t)krow * 128 + g4 * 32;
#pragma unroll
            for (int j = 0; j < 4; ++j) s[tt] = mfma16(*(const bf16x8*)(kp + j * 8), qf[j], s[tt]);
        }
        if (tt & 1) __builtin_amdgcn_sched_barrier(0);
    }
    const float cs = 0.08838834764831845f * 1.4426950408889634f;
    float mx = -1e30f;
#pragma unroll
    for (int tt = 0; tt < 16; ++tt)
#pragma unroll
        for (int r = 0; r < 4; ++r) { const int slot = tt * 16 + 4 * g4 + r; if (slot < cnt) mx = fmaxf(mx, s[tt][r] * cs); }
    mx = fmaxf(mx, __shfl_xor(mx, 16)); mx = fmaxf(mx, __shfl_xor(mx, 32));
    float sum = 0.f;
#pragma unroll
    for (int tt = 0; tt < 16; ++tt)
#pragma unroll
        for (int r = 0; r < 4; ++r) { const int slot = tt * 16 + 4 * g4 + r; const float pv = slot < cnt ? exp2f(s[tt][r] * cs - mx) : 0.f; s[tt][r] = pv; sum += pv; }
    sum += __shfl_xor(sum, 16); sum += __shfl_xor(sum, 32);
    const float inv = sum > 0.f ? 1.0f / sum : 0.f;
    if (c < 4) {
#pragma unroll
        for (int tt = 0; tt < 16; ++tt)
#pragma unroll
            for (int r = 0; r < 4; ++r) Pl[(tt * 16 + 4 * g4 + r) * 4 + c] = s[tt][r] * inv;
    }
    __builtin_amdgcn_wave_barrier();
    float acc[4][8];
#pragma unroll
    for (int hh = 0; hh < 4; ++hh)
#pragma unroll
        for (int j = 0; j < 8; ++j) acc[hh][j] = 0.f;
    const int nk4 = (cnt + 3) >> 2;
#pragma unroll 2
    for (int kk = 0; kk < nk4; ++kk) {
        const int slot = kk * 4 + g4;
        const int row = idxs[slot];
        const uint4 raw = *(const uint4*)(p.PROJ() + (size_t)row * LDP + C_DV + c * 8);
        const float4 p4 = *(const float4*)(Pl + slot * 4);
        const float vv[8] = {lo2f(raw.x), hi2f(raw.x), lo2f(raw.y), hi2f(raw.y), lo2f(raw.z), hi2f(raw.z), lo2f(raw.w), hi2f(raw.w)};
        const float pp[4] = {p4.x, p4.y, p4.z, p4.w};
#pragma unroll
        for (int hh = 0; hh < 4; ++hh)
#pragma unroll
            for (int j = 0; j < 8; ++j) acc[hh][j] += pp[hh] * vv[j];
    }
#pragma unroll
    for (int hh = 0; hh < 4; ++hh)
#pragma unroll
        for (int j = 0; j < 8; ++j) { float a = acc[hh][j]; a += __shfl_xor(a, 16); a += __shfl_xor(a, 32); acc[hh][j] = a; }
    if (g4 == 0) {
#pragma unroll
        for (int hh = 0; hh < 4; ++hh) {
            uint4 o; o.x = pk2(acc[hh][0], acc[hh][1]); o.y = pk2(acc[hh][2], acc[hh][3]); o.z = pk2(acc[hh][4], acc[hh][5]); o.w = pk2(acc[hh][6], acc[hh][7]);
            *(uint4*)(p.Y() + t * D + 1536 + hh * 128 + c * 8) = o;
        }
    }
    __builtin_amdgcn_wave_barrier();
}

DEV void ins16(unsigned (&top)[16], unsigned x) {
#pragma unroll
    for (int j = 0; j < 16; ++j) { const unsigned hi = max(top[j], x); x = min(top[j], x); top[j] = hi; }
}
DEV void st_peer_topk(const P& p, int layer, int unit, char* smem) {
    const int tid = tidx(), w = tid >> 6, l = tid & 63, n = l & 31, hf = l >> 5;
    const int tg = unit >> 1, head = (unit & 1) * 4 + w;
    const size_t t = (size_t)tg * 32 + n;
    unsigned* il = (unsigned*)smem + w * 1024;
    unsigned top[2][16];
#pragma unroll
    for (int pp = 0; pp < 2; ++pp) {
        float qv[32];
#pragma unroll
        for (int i = 0; i < 8; ++i) { const float4 v = *(const float4*)(p.PQ() + t * 1024 + head * 128 + pp * 64 + hf * 32 + i * 4); qv[4 * i] = v.x; qv[4 * i + 1] = v.y; qv[4 * i + 2] = v.z; qv[4 * i + 3] = v.w; }
        const float* K = p.peer_sk + ((((size_t)layer * 8 + head) * 2 + pp) * 128) * 64;
#pragma unroll
        for (int j = 0; j < 16; ++j) top[pp][j] = 0u;
#pragma unroll 1
        for (int tile = 0; tile < 4; ++tile) {
            float kv[32];
            const float* kr = K + (size_t)(tile * 32 + n) * 64 + hf * 32;
#pragma unroll
            for (int i = 0; i < 8; ++i) { const float4 v = *(const float4*)(kr + i * 4); kv[4 * i] = v.x; kv[4 * i + 1] = v.y; kv[4 * i + 2] = v.z; kv[4 * i + 3] = v.w; }
            f32x16 acc;
#pragma unroll
            for (int r = 0; r < 16; ++r) acc[r] = 0.f;
#pragma unroll
            for (int kk = 0; kk < 32; ++kk) acc = __builtin_amdgcn_mfma_f32_32x32x2f32(kv[kk], qv[kk], acc, 0, 0, 0);
#pragma unroll
            for (int r = 0; r < 16; ++r) {
                const int nn = tile * 32 + (r & 3) + 8 * (r >> 2) + 4 * hf;
                ins16(top[pp], (f2key(acc[r]) & ~127u) | (unsigned)(127 - nn));
            }
        }
        unsigned oth[16];
#pragma unroll
        for (int j = 0; j < 16; ++j) oth[j] = __shfl_xor(top[pp][j], 32);
#pragma unroll
        for (int j = 0; j < 16; ++j) ins16(top[pp], oth[j]);
        if (hf == 0) {
#pragma unroll
            for (int j = 0; j < 16; ++j) il[(pp * 16 + j) * 32 + n] = 127u - (top[pp][j] & 127u);
        }
    }
    __builtin_amdgcn_wave_barrier();
    if (hf == 0) {
        float v1[16], v2[16];
#pragma unroll
        for (int j = 0; j < 16; ++j) { v1[j] = key2f(top[0][j] & ~127u); v2[j] = key2f(top[1][j] & ~127u); }
        unsigned ct[16];
#pragma unroll
        for (int s = 0; s < 16; ++s) ct[s] = 0u;
#pragma unroll
        for (int i = 0; i < 16; ++i)
#pragma unroll
            for (int j = 0; j < 16; ++j)
                if ((i + 1) * (j + 1) <= 16) ins16(ct, (f2key(v1[i] + v2[j]) & ~255u) | (unsigned)(255 - (i * 16 + j)));
        float ex[16], sum = 0.f; int ce[16];
        const float c0 = key2f(ct[0] & ~255u);
#pragma unroll
        for (int s = 0; s < 16; ++s) {
            const unsigned code = 255u - (ct[s] & 255u);
            ce[s] = (int)(il[(code >> 4) * 32 + n] * 128u + il[(16 + (code & 15u)) * 32 + n]);
            ex[s] = __expf(key2f(ct[s] & ~255u) - c0); sum += ex[s];
        }
        const float inv = 1.0f / sum;
#pragma unroll
        for (int s4 = 0; s4 < 4; ++s4) {
            *(int4*)(p.PE() + t * 128 + head * 16 + s4 * 4) = make_int4(ce[4 * s4], ce[4 * s4 + 1], ce[4 * s4 + 2], ce[4 * s4 + 3]);
            *(float4*)(p.PG() + t * 128 + head * 16 + s4 * 4) = make_float4(ex[4 * s4] * inv, ex[4 * s4 + 1] * inv, ex[4 * s4 + 2] * inv, ex[4 * s4 + 3] * inv);
        }
    }
    __builtin_amdgcn_wave_barrier();
}

DEV void fp8x16_decode(const uint4& r, float (&f)[16]) {
    const unsigned w[4] = {r.x, r.y, r.z, r.w};
#pragma unroll
    for (int q = 0; q < 4; ++q) {
        const f32x2 lo = __builtin_amdgcn_cvt_pk_f32_fp8((int)w[q], false), hi = __builtin_amdgcn_cvt_pk_f32_fp8((int)w[q], true);
        f[4 * q] = lo.x; f[4 * q + 1] = lo.y; f[4 * q + 2] = hi.x; f[4 * q + 3] = hi.y;
    }
}
DEV void st_peer_gather(const P& p, int layer, const float* __restrict__ xin, float* __restrict__ xout, int unit) {
    const int tid_ = tidx(); const int w = tid_ >> 6, l = tid_ & 63; const size_t t = (size_t)unit * 4 + w;
    float hf[32];
#pragma unroll
    for (int i = 0; i < 2; ++i)
#pragma unroll
        for (int h2 = 0; h2 < 2; ++h2) {
            const uint4 hv = *(const uint4*)(p.HN() + t * D + i * 1024 + l * 16 + h2 * 8);
            const unsigned u4[4] = {hv.x, hv.y, hv.z, hv.w};
#pragma unroll
            for (int q = 0; q < 4; ++q) { hf[i * 16 + h2 * 8 + 2 * q] = lo2f(u4[q]); hf[i * 16 + h2 * 8 + 2 * q + 1] = hi2f(u4[q]); }
        }
    const int e0 = p.PE()[t * 128 + l], e1 = p.PE()[t * 128 + 64 + l];
    const float g0 = p.PG()[t * 128 + l], g1 = p.PG()[t * 128 + 64 + l];
    float out[32];
#pragma unroll
    for (int i = 0; i < 32; ++i) out[i] = 0.f;
    const unsigned char* U = p.Utab() + (size_t)layer * 16384 * 2048 + l * 16; const unsigned char* V = p.Vtab() + (size_t)layer * 16384 * 2048 + l * 16;
    const bool b5 = (l & 32) != 0, b4 = (l & 16) != 0;
#pragma unroll 1
    for (int k4 = 0; k4 < 32; ++k4) {
        int e[4]; float g[4];
#pragma unroll
        for (int q = 0; q < 4; ++q) {
            const int k = k4 * 4 + q;
            e[q] = __builtin_amdgcn_readlane(k4 < 16 ? e0 : e1, k & 63);
            g[q] = __int_as_float(__builtin_amdgcn_readlane(__float_as_int(k4 < 16 ? g0 : g1), k & 63));
        }
        uint4 uu[4][2], vv[4][2];
#pragma unroll
        for (int q = 0; q < 4; ++q)
#pragma unroll
            for (int i = 0; i < 2; ++i) { uu[q][i] = *(const uint4*)(U + (size_t)e[q] * 2048 + i * 1024); vv[q][i] = *(const uint4*)(V + (size_t)e[q] * 2048 + i * 1024); }
        float d[4];
#pragma unroll
        for (int q = 0; q < 4; ++q) {
            float acc = 0.f;
#pragma unroll
            for (int i = 0; i < 2; ++i) { float f[16]; fp8x16_decode(uu[q][i], f);
#pragma unroll
                for (int j = 0; j < 16; ++j) acc += f[j] * hf[i * 16 + j]; }
            d[q] = acc;
        }
        float kA = b5 ? d[2] : d[0], kB = b5 ? d[3] : d[1];
        const float sA = b5 ? d[0] : d[2], sB = b5 ? d[1] : d[3];
        kA += __shfl_xor(sA, 32); kB += __shfl_xor(sB, 32);
        float kk = b4 ? kB : kA; const float ss = b4 ? kA : kB;
        kk += __shfl_xor(ss, 16);
        kk += __shfl_xor(kk, 8); kk += __shfl_xor(kk, 4); kk += __shfl_xor(kk, 2); kk += __shfl_xor(kk, 1);
        const float gsel = b5 ? (b4 ? g[3] : g[2]) : (b4 ? g[1] : g[0]);
        const float av = gelu_tanh(kk * (1.0f / U8_SCALE)) * gsel * (1.0f / V8_SCALE);
        const int avi = __float_as_int(av);
        const float a4[4] = {__int_as_float(__builtin_amdgcn_readlane(avi, 0)), __int_as_float(__builtin_amdgcn_readlane(avi, 16)),
                             __int_as_float(__builtin_amdgcn_readlane(avi, 32)), __int_as_float(__builtin_amdgcn_readlane(avi, 48))};
#pragma unroll
        for (int q = 0; q < 4; ++q)
#pragma unroll
            for (int i = 0; i < 2; ++i) { float f[16]; fp8x16_decode(vv[q][i], f);
#pragma unroll
                for (int j = 0; j < 16; ++j) out[i * 16 + j] += a4[q] * f[j]; }
    }
    const float* g2 = p.ada() + layer * 12288 + 5 * 2048;
#pragma unroll
    for (int i = 0; i < 2; ++i)
#pragma unroll
        for (int q = 0; q < 4; ++q) {
            const size_t col = i * 1024 + l * 16 + q * 4; const size_t off = t * D + col;
            const float4 x0 = *(const float4*)(xin + off); const float4 ga = *(const float4*)(g2 + col);
            float4 o0;
            o0.x = x0.x + ga.x * out[i * 16 + q * 4 + 0]; o0.y = x0.y + ga.y * out[i * 16 + q * 4 + 1];
            o0.z = x0.z + ga.z * out[i * 16 + q * 4 + 2]; o0.w = x0.w + ga.w * out[i * 16 + q * 4 + 3];
            *(float4*)(xout + off) = o0;
        }
}

enum { S_CONVT_IN = 0, S_CONVT_OUT, S_CONVT_Q, S_TAB_U, S_TAB_V, S_ADA, S_ROPE, S_NORM1, S_GEMM_IN, S_CONV, S_SGU, S_VTRANS, S_PREP,
       S_COMPRESS, S_NSA_CMP, S_DSA_INDEX, S_NSA_ATTN, S_DSA_ATTN, S_GEMM_OUT, S_NORM2, S_GEMM_Q, S_PEER_TOPK, S_PEER_GATHER, S_COUNT };
constexpr int TAB_UNITS = 4096;
__host__ __device__ constexpr int nunits(int s) {
    return s == S_CONVT_IN ? 2 * 32 * (LDP / 64) : s == S_CONVT_OUT ? 2 * 32 * 32 : s == S_CONVT_Q ? 2 * 32 * 16 : s == S_TAB_U ? TAB_UNITS : s == S_TAB_V ? TAB_UNITS
         : s == S_ADA ? 768 : s == S_ROPE ? 768 : s == S_NORM1 ? 2048 : s == S_GEMM_IN ? 64 * (LDP / 128) : s == S_CONV ? 512 : s == S_SGU ? 256
         : s == S_VTRANS ? 256 : s == S_PREP ? 2048 : s == S_COMPRESS ? 128 : s == S_NSA_CMP ? 512 : s == S_DSA_INDEX ? 512 : s == S_NSA_ATTN ? 512 : s == S_DSA_ATTN ? 2048
         : s == S_GEMM_OUT ? 64 * 16 : s == S_NORM2 ? 2048 : s == S_GEMM_Q ? 64 * 8 : s == S_PEER_TOPK ? 512 : s == S_PEER_GATHER ? 2048 : 0;
}
template <int S>
DEV void run_unit(const P& p, int layer, int u, char* smem, int nu = TAB_UNITS) {
    const float* xin = layer == 0 ? p.x : p.X2();
    const float* ada = p.ada() + layer * 12288;
    if constexpr (S == S_CONVT_IN) { const int per = 32 * (LDP / 64), ly = u / per; st_convT(p.w_in + (size_t)ly * 2048 * INC, p.WinT() + (size_t)ly * LDP * 2048, INC, LDP, true, u % per, smem); }
    else if constexpr (S == S_CONVT_OUT) { const int per = 32 * 32, ly = u / per; st_convT(p.w_out + (size_t)ly * 2048 * 2048, p.WoutT() + (size_t)ly * 2048 * 2048, 2048, 2048, false, u % per, smem); }
    else if constexpr (S == S_CONVT_Q) { const int per = 32 * 16, ly = u / per; st_convT(p.peer_wq + (size_t)ly * 2048 * 1024, p.WqT() + (size_t)ly * 1024 * 2048, 1024, 1024, false, u % per, smem); }
    else if constexpr (S == S_TAB_U) st_tab(p.peer_u, p.Utab(), U8_SCALE, (size_t)2 * 16384 * 2048 / 16, u, nu);
    else if constexpr (S == S_TAB_V) st_tab(p.peer_v, p.Vtab(), V8_SCALE, (size_t)2 * 16384 * 2048 / 16, u, nu);
    else if constexpr (S == S_ADA) st_ada(p, u, smem);
    else if constexpr (S == S_ROPE) st_rope(p, u);
    else if constexpr (S == S_NORM1) st_norm(xin, p.n1g + layer * 2048, ada + 2048, ada, p.HN(), u);
    else if constexpr (S == S_GEMM_IN) { EpiArgs e{p.PROJ(), nullptr, nullptr, nullptr}; st_gemm<EPI_PROJ>(p.HN(), p.WinT() + (size_t)layer * LDP * 2048, 2048, u & 63, u >> 6, e, smem); }
    else if constexpr (S == S_CONV) st_conv(p, layer, u, smem);
    else if constexpr (S == S_SGU) st_sgu(p, layer, u, smem);
    else if constexpr (S == S_VTRANS) st_vtrans(p, u, smem);
    else if constexpr (S == S_PREP) st_prep(p, layer, u);
    else if constexpr (S == S_COMPRESS) st_compress(p, layer, u, smem);
    else if constexpr (S == S_NSA_CMP) st_nsa_cmp(p, u, smem);
    else if constexpr (S == S_DSA_INDEX) st_dsa_index(p, u, smem);
    else if constexpr (S == S_NSA_ATTN) st_nsa_attn(p, u, smem);
    else if constexpr (S == S_DSA_ATTN) st_dsa_attn(p, u, smem);
    else if constexpr (S == S_GEMM_OUT) { EpiArgs e{nullptr, p.X1(), xin, ada + 2 * 2048}; st_gemm<EPI_OUT>(p.Y(), p.WoutT() + (size_t)layer * 2048 * 2048, 2048, u & 63, u >> 6, e, smem); }
    else if constexpr (S == S_NORM2) st_norm(p.X1(), p.n2g + layer * 2048, ada + 4 * 2048, ada + 3 * 2048, p.HN(), u);
    else if constexpr (S == S_GEMM_Q) { EpiArgs e{nullptr, p.PQ(), nullptr, nullptr}; st_gemm<EPI_Q>(p.HN(), p.WqT() + (size_t)layer * 1024 * 2048, 2048, u & 63, u >> 6, e, smem); }
    else if constexpr (S == S_PEER_TOPK) st_peer_topk(p, layer, u, smem);
    else if constexpr (S == S_PEER_GATHER) st_peer_gather(p, layer, p.X1(), layer == 0 ? p.X2() : p.out, u);
}


#define XB_TMO      128
#define XB_XCNT(j)  (256  + 64 * (j))
#define XB_XSUB(j)  (1280 + 64 * (j))
#define XB_XGEN(j)  (2304 + 64 * (j))
#define XB_TOP      3328
#define XB_TOPGEN   3392
#define XB_SPIN_CAP (1u << 22)
#define LAS __attribute__((address_space(3)))
DEV unsigned xb_ld(unsigned* p) { return __hip_atomic_load(p, __ATOMIC_RELAXED, __HIP_MEMORY_SCOPE_AGENT); }
DEV unsigned xb_add(unsigned* p, unsigned v) { return __hip_atomic_fetch_add(p, v, __ATOMIC_RELAXED, __HIP_MEMORY_SCOPE_AGENT); }
DEV unsigned xb_xcc_id() { return (unsigned)__builtin_amdgcn_s_getreg((3 << 11) | 20) & 0xFu; }
#define XB_SPIN(cond, bar) do { unsigned _sp = 0; while (cond) { __builtin_amdgcn_s_sleep(1); \
    if ((++_sp & 255u) == 0u) { if (xb_ld(&(bar)[XB_TMO])) break; if (_sp > XB_SPIN_CAP) { atomicAdd(&(bar)[XB_TMO], 1u); break; } } } } while (0)
struct XcdBarrier { unsigned* bar; unsigned x; volatile LAS unsigned* st; };
DEV XcdBarrier xcd_barrier_post(unsigned* bar, volatile LAS unsigned* st) {
    XcdBarrier b; b.bar = bar; b.x = xb_xcc_id(); b.st = st;
    if (threadIdx.x == 0) (void)xb_add(&bar[XB_XCNT(b.x)], 1u);
    return b;
}
DEV void xcd_barrier_complete(unsigned* bar, unsigned x, unsigned& nloc, unsigned& nx) {
    const unsigned G = gridDim.x * gridDim.y * gridDim.z;
    unsigned sum, cnt, mine, sp = 0u;
    for (;;) {
        sum = 0u; cnt = 0u; mine = 0u;
#pragma unroll
        for (unsigned j = 0; j < 16; ++j) { const unsigned c = xb_ld(&bar[XB_XCNT(j)]); sum += c; cnt += (c > 0u) ? 1u : 0u; mine = (j == x) ? c : mine; }
        if (sum == G) break;
        __builtin_amdgcn_s_sleep(1);
        if ((++sp & 255u) == 0u) { if (xb_ld(&bar[XB_TMO])) break; if (sp > XB_SPIN_CAP) { atomicAdd(&bar[XB_TMO], 1u); break; } }
    }
    nloc = mine > 0u ? mine : 1u; nx = cnt > 0u ? cnt : 1u;
}
DEV void xcd_barrier(const XcdBarrier& b) {
    asm volatile("s_waitcnt vmcnt(0)" ::: "memory");
    __syncthreads();
    if (threadIdx.x == 0) {
        unsigned* bar = b.bar;
        __builtin_amdgcn_s_waitcnt(0);
        unsigned nloc = b.st[0], nx = b.st[1];
        if (nloc == 0u) { xcd_barrier_complete(bar, b.x, nloc, nx); b.st[0] = nloc; b.st[1] = nx; }
        const unsigned old = xb_add(&bar[XB_XSUB(b.x)], 1u);
        const unsigned gen = old / nloc;
        if (old + 1u == (gen + 1u) * nloc) {
            __builtin_amdgcn_fence(__ATOMIC_RELEASE, "agent");
            asm volatile("s_waitcnt vmcnt(0)" ::: "memory");
            const unsigned og = xb_add(&bar[XB_TOP], 1u);
            const unsigned tg = og / nx;
            if (og + 1u == (tg + 1u) * nx) xb_add(&bar[XB_TOPGEN], 1u);
            else XB_SPIN(xb_ld(&bar[XB_TOPGEN]) == tg, bar);
            __builtin_amdgcn_fence(__ATOMIC_ACQUIRE, "agent");
            xb_add(&bar[XB_XGEN(b.x)], 1u);
            asm volatile("s_waitcnt vmcnt(0)" ::: "memory");
        } else {
            XB_SPIN(xb_ld(&bar[XB_XGEN(b.x)]) == gen, bar);
            __builtin_amdgcn_fence(__ATOMIC_ACQUIRE, "agent");
            asm volatile("s_waitcnt vmcnt(0)" ::: "memory");
        }
    }
    __syncthreads();
}

#ifndef MULTI_LAUNCH
constexpr int REP_STAGE = -1, REP_STAGE2 = -1, REP_N = 1;
template <int S>
DEV void run_phase1(const P& p, int layer, char* smem, int off);
template <int S>
DEV void run_phase(const P& p, int layer, char* smem, int off = 0) {
    constexpr int reps = (S == REP_STAGE || S == REP_STAGE2) ? REP_N : 1;
#pragma unroll 1
    for (int r = 0; r < reps; ++r) run_phase1<S>(p, layer, smem, off);
}
template <int S>
DEV void run_phase1(const P& p, int layer, char* smem, int off) {
    const int G = gridDim.x;
    int b = blockIdx.x + off; if (b >= G) b -= G;
    if constexpr (S == S_TAB_U || S == S_TAB_V) { run_unit<S>(p, layer, b, smem, G); }
    else {
        for (int u = b; u < nunits(S); u += G) { run_unit<S>(p, layer, u, smem); __syncthreads(); }
    }
}
template <int S>
DEV void run_gemm_phase(const P& p, int layer, char* smem, unsigned xcc, volatile LAS unsigned* slot) {
    constexpr int TN = (S == S_GEMM_IN) ? (LDP / 128) : (S == S_GEMM_OUT ? 16 : 8);
    constexpr int inst0 = (S == S_GEMM_IN) ? 0 : (S == S_GEMM_OUT ? 2 : 4);
    const int len = 8 * TN;
#pragma unroll 1
    for (int q = 0; q < 8; ++q) {
        const unsigned xq = (xcc + q) & 7u;
        unsigned* head = p.bar() + GQ_WORD(inst0 + layer, xq);
        for (;;) {
            if (threadIdx.x == 0) *slot = xb_add(head, 1u);
            __syncthreads();
            const int i = (int)*slot;
            __syncthreads();
            if (i >= len) break;
            const int tn = i >> 3, tm = (int)xq * 8 + (i & 7);
            run_unit<S>(p, layer, tm + 64 * tn, smem);
            __syncthreads();
        }
    }
}
#define GSYNC() xcd_barrier(xb)
__global__ void __launch_bounds__(NTHREADS, 2) k_mega(P p) {
    __shared__ __attribute__((aligned(16))) char smem[SMEM_BYTES];
    __shared__ uint4 xb_words;
    cg::grid_group grid = cg::this_grid();
    if (threadIdx.x == 0) xb_words = make_uint4(0u, 0u, 0u, 0u);
    __syncthreads();
    XcdBarrier xb = xcd_barrier_post(p.bar(), (volatile LAS unsigned*)&xb_words);
    const int H = gridDim.x >> 1, Q = gridDim.x >> 2;
    run_phase<S_ADA>(p, 0, smem); run_phase<S_ROPE>(p, 0, smem, H);
    run_phase<S_CONVT_IN>(p, 0, smem); run_phase<S_CONVT_OUT>(p, 0, smem); run_phase<S_CONVT_Q>(p, 0, smem);
    run_phase<S_TAB_U>(p, 0, smem); run_phase<S_TAB_V>(p, 0, smem);
    grid.sync();
#pragma unroll 1
    for (int layer = 0; layer < NL; ++layer) {
        run_phase<S_NORM1>(p, layer, smem); GSYNC();
        run_gemm_phase<S_GEMM_IN>(p, layer, smem, xb.x, (volatile LAS unsigned*)&xb_words + 2); GSYNC();
        run_phase<S_COMPRESS>(p, layer, smem); run_phase<S_SGU>(p, layer, smem, Q); run_phase<S_VTRANS>(p, layer, smem, H + Q);
        run_phase<S_CONV>(p, layer, smem); run_phase<S_PREP>(p, layer, smem); GSYNC();
        run_phase<S_DSA_INDEX>(p, layer, smem); run_phase<S_NSA_CMP>(p, layer, smem); GSYNC();
        run_phase<S_NSA_ATTN>(p, layer, smem); run_phase<S_DSA_ATTN>(p, layer, smem, H); GSYNC();
        run_gemm_phase<S_GEMM_OUT>(p, layer, smem, xb.x, (volatile LAS unsigned*)&xb_words + 2); GSYNC();
        run_phase<S_NORM2>(p, layer, smem); GSYNC();
        run_gemm_phase<S_GEMM_Q>(p, layer, smem, xb.x, (volatile LAS unsigned*)&xb_words + 2); GSYNC();
        run_phase<S_PEER_TOPK>(p, layer, smem); GSYNC();
        run_phase<S_PEER_GATHER>(p, layer, smem); GSYNC();
    }
}
#else
template <int S>
__global__ void __launch_bounds__(NTHREADS) k_stage(P p, int layer) {
    __shared__ __attribute__((aligned(16))) char smem[SMEM_BYTES];
    run_unit<S>(p, layer, blockIdx.x, smem);
}
template <int S> static void launch_stage(const P& p, int layer, hipStream_t st) {
    hipLaunchKernelGGL((k_stage<S>), dim3(nunits(S)), dim3(NTHREADS), 0, st, p, layer);
}
#endif

extern "C" void kernel_launch(void* const* d_in, const int* in_sizes, int n_in, void* d_out, int out_size, void* d_ws, size_t ws_size, hipStream_t stream) {
    P p{};
    p.x = (const float*)d_in[0]; p.c = (const float*)d_in[1]; p.pos = (const int*)d_in[2]; p.ada_w = (const float*)d_in[3]; p.ada_b = (const float*)d_in[4];
    p.n1g = (const float*)d_in[5]; p.n2g = (const float*)d_in[6]; p.w_in = (const float*)d_in[7]; p.w_out = (const float*)d_in[8]; p.conv_w = (const float*)d_in[9];
    p.conv_b = (const float*)d_in[10]; p.cln_g = (const float*)d_in[11]; p.cln_b = (const float*)d_in[12]; p.sln_g = (const float*)d_in[13]; p.sln_b = (const float*)d_in[14];
    p.sgu_w = (const float*)d_in[15]; p.sgu_b = (const float*)d_in[16]; p.nsa_qg = (const float*)d_in[17]; p.nsa_kg = (const float*)d_in[18]; p.cmp_pos = (const float*)d_in[19];
    p.cmp_w1 = (const float*)d_in[20]; p.cmp_w2 = (const float*)d_in[21]; p.dsa_qg = (const float*)d_in[22]; p.dsa_kg = (const float*)d_in[23]; p.peer_wq = (const float*)d_in[24];
    p.peer_sk = (const float*)d_in[25]; p.peer_u = (const float*)d_in[26]; p.peer_v = (const float*)d_in[27];
    p.out = (float*)d_out;
    p.ws = (char*)d_ws; const size_t off = WS_TOTAL;
    if (off > ws_size) { fprintf(stderr, "workspace too small: need %zu have %zu\n", off, ws_size); return; }
#ifndef MULTI_LAUNCH
    static int grid_blocks = 0;
    if (!grid_blocks) {
        int dev = 0, cus = 0, per_cu = 0;
        (void)hipGetDevice(&dev);
        (void)hipDeviceGetAttribute(&cus, hipDeviceAttributeMultiprocessorCount, dev);
        (void)hipOccupancyMaxActiveBlocksPerMultiprocessor(&per_cu, k_mega, NTHREADS, 0);
        if (per_cu > 2) per_cu = 2;
        grid_blocks = cus * per_cu;
    }
    (void)hipMemsetAsync(p.bar(), 0, (size_t)CTRL_WORDS * 4, stream);
    void* args[] = {&p};
    hipError_t e = hipLaunchCooperativeKernel((void*)k_mega, dim3(grid_blocks), dim3(NTHREADS), args, 0, stream);
    if (e != hipSuccess) fprintf(stderr, "cooperative launch failed: %s (grid %d)\n", hipGetErrorString(e), grid_blocks);
#else
    launch_stage<S_CONVT_IN>(p, 0, stream); launch_stage<S_CONVT_OUT>(p, 0, stream); launch_stage<S_CONVT_Q>(p, 0, stream);
    launch_stage<S_TAB_U>(p, 0, stream); launch_stage<S_TAB_V>(p, 0, stream);
    launch_stage<S_ADA>(p, 0, stream); launch_stage<S_ROPE>(p, 0, stream);
    for (int layer = 0; layer < NL; ++layer) {
        launch_stage<S_NORM1>(p, layer, stream); launch_stage<S_GEMM_IN>(p, layer, stream);
        launch_stage<S_CONV>(p, layer, stream); launch_stage<S_SGU>(p, layer, stream); launch_stage<S_VTRANS>(p, layer, stream);
        launch_stage<S_PREP>(p, layer, stream); launch_stage<S_COMPRESS>(p, layer, stream);
        launch_stage<S_NSA_CMP>(p, layer, stream); launch_stage<S_DSA_INDEX>(p, layer, stream);
        launch_stage<S_NSA_ATTN>(p, layer, stream); launch_stage<S_DSA_ATTN>(p, layer, stream);
        launch_stage<S_GEMM_OUT>(p, layer, stream); launch_stage<S_NORM2>(p, layer, stream); launch_stage<S_GEMM_Q>(p, layer, stream);
        launch_stage<S_PEER_TOPK>(p, layer, stream); launch_stage<S_PEER_GATHER>(p, layer, stream);
    }
#endif
}
```

```cpp
#include <hip/hip_runtime.h>
#include <hip/hip_cooperative_groups.h>
#include <stdint.h>
#include <cstdio>
namespace cg = cooperative_groups;

typedef unsigned short bf16_t;
typedef short bf16x8 __attribute__((ext_vector_type(8)));
typedef float f32x4 __attribute__((ext_vector_type(4)));
typedef float f32x16 __attribute__((ext_vector_type(16)));
#define DEV __device__ __forceinline__

constexpr int T = 8192, D = 2048, NL = 2;
constexpr int INC = 4692;
constexpr int LDP = 4736;
constexpr int C_CA = 0, C_CG = 512, C_SU = 1024, C_SV = 1536;
constexpr int C_NQ = 2048, C_NKC = 2560, C_NVC = 2688, C_NKS = 2816, C_NVS = 2944, C_NKW = 3072, C_NVW = 3200;
constexpr int C_DQ = 3328, C_DK = 3840, C_DV = 3968, C_IQ = 4096, C_IK = 4608, C_NG = 4672, C_IW = 4688;
constexpr float EPS = 1e-6f;
constexpr int NTHREADS = 256;
constexpr int SMEM_BYTES = 72 * 1024;

__device__ const double INV16[16] = {1.0, 0.44036660267178046, 0.19392274474868576, 0.08539710028576561, 0.03760603093086393,
    0.016560440080994446, 0.007292664737217109, 0.003211445994752591, 0.001414213562373095, 0.000622772421914596,
    0.0002742481756762073, 0.00012076973741146504, 5.318295896944988e-05, 2.341999896140934e-05, 1.031338537721246e-05,
    4.5416704806078695e-06};

#define XCD_BAR_WORDS 3456
#define GQ_WORD(inst, x) (XCD_BAR_WORDS + 64 * ((inst) * 8 + (x)))
#define DQ_WORD(k) (XCD_BAR_WORDS + 64 * (96 + (k)))
#define CTRL_WORDS (XCD_BAR_WORDS + 64 * 112)
constexpr size_t WS_ALIGN(size_t x) { return (x + 255) & ~(size_t)255; }
constexpr size_t OFF_WinT = 0;
constexpr size_t OFF_WoutT = OFF_WinT + WS_ALIGN((size_t)2 * LDP * 2048 * 2);
constexpr size_t OFF_WqT = OFF_WoutT + WS_ALIGN((size_t)2 * 2048 * 2048 * 2);
constexpr size_t OFF_W1T = OFF_WqT + WS_ALIGN((size_t)2 * 1024 * 2048 * 2);
constexpr size_t OFF_Utab = OFF_W1T + WS_ALIGN((size_t)4 * 128 * 4096 * 2);
constexpr size_t OFF_Vtab = OFF_Utab + WS_ALIGN((size_t)2 * 16384 * 2048);
constexpr size_t OFF_ada = OFF_Vtab + WS_ALIGN((size_t)2 * 16384 * 2048);
constexpr size_t OFF_ropeC = OFF_ada + WS_ALIGN((size_t)2 * 12288 * 4);
constexpr size_t OFF_ropeS = OFF_ropeC + WS_ALIGN((size_t)T * 24 * 4);
constexpr size_t OFF_HN = OFF_ropeS + WS_ALIGN((size_t)T * 24 * 4);
constexpr size_t OFF_PROJ = OFF_HN + WS_ALIGN((size_t)T * D * 2);
constexpr size_t OFF_Y = OFF_PROJ + WS_ALIGN((size_t)T * LDP * 2);
constexpr size_t OFF_QN = OFF_Y + WS_ALIGN((size_t)T * D * 2);
constexpr size_t OFF_QR = OFF_QN + WS_ALIGN((size_t)T * 512 * 2);
constexpr size_t OFF_KS = OFF_QR + WS_ALIGN((size_t)T * 512 * 2);
constexpr size_t OFF_KW = OFF_KS + WS_ALIGN((size_t)T * 128 * 2);
constexpr size_t OFF_VST = OFF_KW + WS_ALIGN((size_t)T * 128 * 2);
constexpr size_t OFF_VWT = OFF_VST + WS_ALIGN((size_t)T * 128 * 2);
constexpr size_t OFF_GATES = OFF_VWT + WS_ALIGN((size_t)T * 128 * 2);
constexpr size_t OFF_KC = OFF_GATES + WS_ALIGN((size_t)T * 12 * 4);
constexpr size_t OFF_VCT = OFF_KC + WS_ALIGN((size_t)512 * 128 * 2);
constexpr size_t OFF_SEL = OFF_VCT + WS_ALIGN((size_t)128 * 512 * 2);
constexpr size_t OFF_OCMP = OFF_SEL + WS_ALIGN((size_t)T * 4 * 4);
constexpr size_t OFF_DQ = OFF_OCMP + WS_ALIGN((size_t)T * 512 * 2);
constexpr size_t OFF_DK = OFF_DQ + WS_ALIGN((size_t)T * 512 * 2);
constexpr size_t OFF_IQ = OFF_DK + WS_ALIGN((size_t)T * 128 * 2);
constexpr size_t OFF_IK = OFF_IQ + WS_ALIGN((size_t)T * 512 * 2);
constexpr size_t OFF_IW = OFF_IK + WS_ALIGN((size_t)T * 64 * 2);
constexpr size_t OFF_IDX = OFF_IW + WS_ALIGN((size_t)T * 8 * 4);
constexpr size_t OFF_CNT = OFF_IDX + WS_ALIGN((size_t)T * 256 * 4);
constexpr size_t OFF_X1 = OFF_CNT + WS_ALIGN((size_t)T * 4);
constexpr size_t OFF_X2 = OFF_X1 + WS_ALIGN((size_t)T * D * 4);
constexpr size_t OFF_PQ = OFF_X2 + WS_ALIGN((size_t)T * D * 4);
constexpr size_t OFF_PE = OFF_PQ + WS_ALIGN((size_t)T * 1024 * 4);
constexpr size_t OFF_PG = OFF_PE + WS_ALIGN((size_t)T * 128 * 4);
constexpr size_t OFF_bar = OFF_PG + WS_ALIGN((size_t)T * 128 * 4);
constexpr size_t WS_TOTAL = OFF_bar + WS_ALIGN((size_t)CTRL_WORDS * 4);

struct P {
    const float* x; const float* c; const int* pos; const float* ada_w; const float* ada_b; const float* n1g; const float* n2g;
    const float* w_in; const float* w_out; const float* conv_w; const float* conv_b; const float* cln_g; const float* cln_b;
    const float* sln_g; const float* sln_b; const float* sgu_w; const float* sgu_b; const float* nsa_qg; const float* nsa_kg;
    const float* cmp_pos; const float* cmp_w1; const float* cmp_w2; const float* dsa_qg; const float* dsa_kg;
    const float* peer_wq; const float* peer_sk; const float* peer_u; const float* peer_v;
    float* out;
    char* ws;
    __host__ __device__ __forceinline__ bf16_t* WinT() const { return (bf16_t*)(ws + OFF_WinT); }
    __host__ __device__ __forceinline__ bf16_t* WoutT() const { return (bf16_t*)(ws + OFF_WoutT); }
    __host__ __device__ __forceinline__ bf16_t* WqT() const { return (bf16_t*)(ws + OFF_WqT); }
    __host__ __device__ __forceinline__ bf16_t* W1T() const { return (bf16_t*)(ws + OFF_W1T); }
    __host__ __device__ __forceinline__ unsigned char* Utab() const { return (unsigned char*)(ws + OFF_Utab); }
    __host__ __device__ __forceinline__ unsigned char* Vtab() const { return (unsigned char*)(ws + OFF_Vtab); }
    __host__ __device__ __forceinline__ float* ada() const { return (float*)(ws + OFF_ada); }
    __host__ __device__ __forceinline__ float* ropeC() const { return (float*)(ws + OFF_ropeC); }
    __host__ __device__ __forceinline__ float* ropeS() const { return (float*)(ws + OFF_ropeS); }
    __host__ __device__ __forceinline__ bf16_t* HN() const { return (bf16_t*)(ws + OFF_HN); }
    __host__ __device__ __forceinline__ bf16_t* PROJ() const { return (bf16_t*)(ws + OFF_PROJ); }
    __host__ __device__ __forceinline__ bf16_t* Y() const { return (bf16_t*)(ws + OFF_Y); }
    __host__ __device__ __forceinline__ bf16_t* QN() const { return (bf16_t*)(ws + OFF_QN); }
    __host__ __device__ __forceinline__ bf16_t* QR() const { return (bf16_t*)(ws + OFF_QR); }
    __host__ __device__ __forceinline__ bf16_t* KS() const { return (bf16_t*)(ws + OFF_KS); }
    __host__ __device__ __forceinline__ bf16_t* KW() const { return (bf16_t*)(ws + OFF_KW); }
    __host__ __device__ __forceinline__ bf16_t* VST() const { return (bf16_t*)(ws + OFF_VST); }
    __host__ __device__ __forceinline__ bf16_t* VWT() const { return (bf16_t*)(ws + OFF_VWT); }
    __host__ __device__ __forceinline__ float* GATES() const { return (float*)(ws + OFF_GATES); }
    __host__ __device__ __forceinline__ bf16_t* KC() const { return (bf16_t*)(ws + OFF_KC); }
    __host__ __device__ __forceinline__ bf16_t* VCT() const { return (bf16_t*)(ws + OFF_VCT); }
    __host__ __device__ __forceinline__ unsigned* SEL() const { return (unsigned*)(ws + OFF_SEL); }
    __host__ __device__ __forceinline__ bf16_t* OCMP() const { return (bf16_t*)(ws + OFF_OCMP); }
    __host__ __device__ __forceinline__ bf16_t* DQ() const { return (bf16_t*)(ws + OFF_DQ); }
    __host__ __device__ __forceinline__ bf16_t* DK() const { return (bf16_t*)(ws + OFF_DK); }
    __host__ __device__ __forceinline__ bf16_t* IQ() const { return (bf16_t*)(ws + OFF_IQ); }
    __host__ __device__ __forceinline__ bf16_t* IK() const { return (bf16_t*)(ws + OFF_IK); }
    __host__ __device__ __forceinline__ float* IW() const { return (float*)(ws + OFF_IW); }
    __host__ __device__ __forceinline__ int* IDX() const { return (int*)(ws + OFF_IDX); }
    __host__ __device__ __forceinline__ int* CNT() const { return (int*)(ws + OFF_CNT); }
    __host__ __device__ __forceinline__ float* X1() const { return (float*)(ws + OFF_X1); }
    __host__ __device__ __forceinline__ float* X2() const { return (float*)(ws + OFF_X2); }
    __host__ __device__ __forceinline__ float* PQ() const { return (float*)(ws + OFF_PQ); }
    __host__ __device__ __forceinline__ int* PE() const { return (int*)(ws + OFF_PE); }
    __host__ __device__ __forceinline__ float* PG() const { return (float*)(ws + OFF_PG); }
    __host__ __device__ __forceinline__ unsigned* bar() const { return (unsigned*)(ws + OFF_bar); }
};

DEV float bf2f(bf16_t v) { return __uint_as_float(((unsigned)v) << 16); }
DEV unsigned pk2(float lo, float hi) { unsigned r; asm("v_cvt_pk_bf16_f32 %0, %1, %2" : "=v"(r) : "v"(lo), "v"(hi)); return r; }
DEV bf16_t f2bf(float v) { return (bf16_t)(pk2(v, 0.f) & 0xffffu); }
DEV float lo2f(unsigned u) { return __uint_as_float(u << 16); }
DEV float hi2f(unsigned u) { return __uint_as_float(u & 0xffff0000u); }
DEV float wsum(float v) {
#pragma unroll
    for (int o = 32; o > 0; o >>= 1) v += __shfl_xor(v, o);
    return v;
}
DEV float wmax(float v) {
#pragma unroll
    for (int o = 32; o > 0; o >>= 1) v = fmaxf(v, __shfl_xor(v, o));
    return v;
}
DEV int tidx() { int t = threadIdx.x; asm volatile("" : "+v"(t)); return t; }
DEV float sigmoidf_(float x) { return 1.0f / (1.0f + __expf(-x)); }
DEV float gelu_tanh(float x) {
    const float y = 0.7978845608028654f * (x + 0.044715f * x * x * x);
    const float t = 1.0f - 2.0f / (1.0f + __expf(2.0f * y));
    return 0.5f * x * (1.0f + t);
}
DEV f32x4 mfma16(bf16x8 a, bf16x8 b, f32x4 c) { return __builtin_amdgcn_mfma_f32_16x16x32_bf16(a, b, c, 0, 0, 0); }
DEV f32x16 mfma32(bf16x8 a, bf16x8 b, f32x16 c) { return __builtin_amdgcn_mfma_f32_32x32x16_bf16(a, b, c, 0, 0, 0); }

DEV int src_col(int n) {
    if (n < 3328) return n;
    if (n < 4672) return 3340 + (n - 3328);
    if (n < 4684) return 3328 + (n - 4672);
    if (n < 4688) return -1;
    if (n < 4696) return 4684 + (n - 4688);
    return -1;
}

DEV void st_convT(const float* __restrict__ W, bf16_t* __restrict__ Bt, int N, int Npad, bool remap, int unit, char* smem, int Kdim = 2048) {
    float (*tile)[65] = (float (*)[65])smem;
    const int ntn = Npad / 64, kt = unit / ntn, nt = unit % ntn, k0 = kt * 64, n0 = nt * 64;
    const int tid_ = tidx(); const int tx = tid_ & 63, ty = tid_ >> 6;
    const int n = n0 + tx;
    const int src = remap ? src_col(n) : (n < N ? n : -1);
#pragma unroll
    for (int i = 0; i < 16; ++i) { const int k = ty + 4 * i; tile[k][tx] = src >= 0 ? W[(size_t)(k0 + k) * N + src] : 0.f; }
    __syncthreads();
#pragma unroll
    for (int i = 0; i < 16; ++i) { const int r = ty + 4 * i; Bt[(size_t)(n0 + r) * Kdim + k0 + tx] = f2bf(tile[tx][r]); }
    __syncthreads();
}

typedef float f32x2 __attribute__((ext_vector_type(2)));
DEV void st_tab(const float* __restrict__ src, unsigned char* __restrict__ dst, float scale, size_t n16, int unit, int nunits) {
    const int tid_ = tidx();
    for (size_t g = (size_t)unit * NTHREADS + tid_; g < n16; g += (size_t)nunits * NTHREADS) {
        const float4* sp = (const float4*)src + 4 * g;
        const float4 a = sp[0], b = sp[1], c = sp[2], d = sp[3];
        int w0 = __builtin_amdgcn_cvt_pk_fp8_f32(a.x * scale, a.y * scale, 0, false); w0 = __builtin_amdgcn_cvt_pk_fp8_f32(a.z * scale, a.w * scale, w0, true);
        int w1 = __builtin_amdgcn_cvt_pk_fp8_f32(b.x * scale, b.y * scale, 0, false); w1 = __builtin_amdgcn_cvt_pk_fp8_f32(b.z * scale, b.w * scale, w1, true);
        int w2 = __builtin_amdgcn_cvt_pk_fp8_f32(c.x * scale, c.y * scale, 0, false); w2 = __builtin_amdgcn_cvt_pk_fp8_f32(c.z * scale, c.w * scale, w2, true);
        int w3 = __builtin_amdgcn_cvt_pk_fp8_f32(d.x * scale, d.y * scale, 0, false); w3 = __builtin_amdgcn_cvt_pk_fp8_f32(d.z * scale, d.w * scale, w3, true);
        ((uint4*)dst)[g] = make_uint4((unsigned)w0, (unsigned)w1, (unsigned)w2, (unsigned)w3);
    }
}
constexpr float U8_SCALE = 64.0f, V8_SCALE = 4.0f;

DEV void st_ada(const P& p, int unit, char* smem) {
    float* red = (float*)smem;
    const int tid = tidx(), c = tid & 31, ks = tid >> 5;
    const int i = unit / 384, j = (unit % 384) * 32 + c;
    const float* W = p.ada_w + (size_t)i * 2048 * 12288 + (size_t)(ks * 256) * 12288 + j;
    float acc = 0.f;
#pragma unroll 8
    for (int k = 0; k < 256; ++k) {
        const float cv = p.c[ks * 256 + k];
        acc += (cv * sigmoidf_(cv)) * W[(size_t)k * 12288];
    }
    red[ks * 32 + c] = acc;
    __syncthreads();
    if (tid < 32) {
        float r = p.ada_b[i * 12288 + j];
#pragma unroll
        for (int q = 0; q < 8; ++q) r += red[q * 32 + tid];
        p.ada()[i * 12288 + j] = r;
    }
    __syncthreads();
}
DEV void st_rope(const P& p, int unit) {
    const int e = unit * 256 + tidx(); const int t = e / 24, i = e % 24;
    const double inv = i < 16 ? INV16[i] : INV16[2 * (i - 16)];
    const double ang = (double)p.pos[t] * inv;
    const double n = rint(ang * 0.15915494309189535);
    const double r = ang - n * 6.283185307179586;
    const double r2 = r * r;
    double sp = 1.0 / 1.5511210043330986e25, cp = -1.0 / 4.0329146112660565e26;
    sp = sp * r2 - 1.0 / 2.585201673888498e22;   cp = cp * r2 + 1.0 / 6.204484017332394e23;
    sp = sp * r2 + 1.0 / 5.109094217170944e19;   cp = cp * r2 - 1.0 / 1.1240007277776077e21;
    sp = sp * r2 - 1.0 / 1.21645100408832e17;    cp = cp * r2 + 1.0 / 2.43290200817664e18;
    sp = sp * r2 + 1.0 / 3.55687428096e14;       cp = cp * r2 - 1.0 / 6.402373705728e15;
    sp = sp * r2 - 1.0 / 1.307674368e12;         cp = cp * r2 + 1.0 / 2.0922789888e13;
    sp = sp * r2 + 1.0 / 6.2270208e9;            cp = cp * r2 - 1.0 / 8.71782912e10;
    sp = sp * r2 - 1.0 / 3.99168e7;              cp = cp * r2 + 1.0 / 4.790016e8;
    sp = sp * r2 + 1.0 / 362880.0;               cp = cp * r2 - 1.0 / 3628800.0;
    sp = sp * r2 - 1.0 / 5040.0;                 cp = cp * r2 + 1.0 / 40320.0;
    sp = sp * r2 + 1.0 / 120.0;                  cp = cp * r2 - 1.0 / 720.0;
    sp = sp * r2 - 1.0 / 6.0;                    cp = cp * r2 + 1.0 / 24.0;
    sp = sp * r2 + 1.0;                          cp = cp * r2 - 0.5;
    cp = cp * r2 + 1.0;
    const float cs = (float)cp, sn = (float)(sp * r);
    p.ropeC()[e] = cs; p.ropeS()[e] = sn;
}

DEV void st_norm(const float* __restrict__ X, const float* __restrict__ g, const float* __restrict__ sc, const float* __restrict__ sh,
                 bf16_t* __restrict__ HN, int unit) {
    const int tid_ = tidx(); const int w = tid_ >> 6, l = tid_ & 63; const int t = unit * 4 + w;
    const float4* xr = (const float4*)(X + (size_t)t * D);
    float4 v[8]; float ss = 0.f;
#pragma unroll
    for (int i = 0; i < 4; ++i) { v[2 * i] = xr[i * 128 + l * 2]; v[2 * i + 1] = xr[i * 128 + l * 2 + 1]; }
#pragma unroll
    for (int i = 0; i < 8; ++i) ss += v[i].x * v[i].x + v[i].y * v[i].y + v[i].z * v[i].z + v[i].w * v[i].w;
    ss = wsum(ss);
    const float rs = rsqrtf(ss * (1.0f / 2048.0f) + EPS);
#pragma unroll
    for (int i = 0; i < 4; ++i) {
        const int col = i * 512 + l * 8;
        float y[8]; const float xv[8] = {v[2 * i].x, v[2 * i].y, v[2 * i].z, v[2 * i].w, v[2 * i + 1].x, v[2 * i + 1].y, v[2 * i + 1].z, v[2 * i + 1].w};
#pragma unroll
        for (int j = 0; j < 8; ++j) y[j] = (xv[j] * rs) * g[col + j] * (1.0f + sc[col + j]) + sh[col + j];
        uint4 o; o.x = pk2(y[0], y[1]); o.y = pk2(y[2], y[3]); o.z = pk2(y[4], y[5]); o.w = pk2(y[6], y[7]);
        *(uint4*)(HN + (size_t)t * D + col) = o;
    }
}

enum { EPI_PROJ = 0, EPI_OUT = 1, EPI_Q = 2 };
struct EpiArgs { bf16_t* obf; float* of; const float* xin; const float* gate; };
template <int EPI>
DEV void st_gemm(const bf16_t* __restrict__ A, const bf16_t* __restrict__ Bt, int K, int tm, int tn, const EpiArgs& e, char* smem) {
    const int tid = tidx(), w = tid >> 6, l = tid & 63, wr = w >> 1, wc = w & 1;
    f32x4 acc[4][4];
#pragma unroll
    for (int m = 0; m < 4; ++m)
#pragma unroll
        for (int n = 0; n < 4; ++n) acc[m][n] = (f32x4){0.f, 0.f, 0.f, 0.f};
    const int srow = tid >> 2, spc = tid & 3, sc = spc ^ (((srow >> 2) & 1) << 1);
    const bf16_t* Ag = A + (size_t)(tm * 128 + srow) * K + sc * 8;
    const bf16_t* Bg = Bt + (size_t)(tn * 128 + srow) * K + sc * 8;
#define GEMM_STAGE(BUF, KO) do { char* _b = smem + (BUF) * 16384 + tid * 16; \
        __builtin_amdgcn_global_load_lds((const unsigned*)(Ag + (KO)), (__attribute__((address_space(3))) unsigned*)(_b), 16, 0, 0); \
        __builtin_amdgcn_global_load_lds((const unsigned*)(Ag + (size_t)64 * K + (KO)), (__attribute__((address_space(3))) unsigned*)(_b + 4096), 16, 0, 0); \
        __builtin_amdgcn_global_load_lds((const unsigned*)(Bg + (KO)), (__attribute__((address_space(3))) unsigned*)(_b + 8192), 16, 0, 0); \
        __builtin_amdgcn_global_load_lds((const unsigned*)(Bg + (size_t)64 * K + (KO)), (__attribute__((address_space(3))) unsigned*)(_b + 12288), 16, 0, 0); } while (0)
    const int nk = K / 32;
    GEMM_STAGE(0, 0); GEMM_STAGE(1, 32); GEMM_STAGE(2, 64);
    asm volatile("s_waitcnt vmcnt(8)" ::: "memory");
    __builtin_amdgcn_s_barrier();
    const int fr = l & 15, fq = l >> 4;
#pragma unroll 1
    for (int kt = 0; kt < nk; ++kt) {
        if (kt + 3 < nk) GEMM_STAGE((kt + 3) & 3, (kt + 3) * 32);
        const char* As = smem + (kt & 3) * 16384; const char* Bs = As + 8192;
        bf16x8 af[4], bfr[4];
#pragma unroll
        for (int m = 0; m < 4; ++m) { const int row = wr * 64 + m * 16 + fr; af[m] = *(const bf16x8*)(As + row * 64 + ((fq ^ (((row >> 2) & 1) << 1)) << 4)); }
#pragma unroll
        for (int n = 0; n < 4; ++n) { const int row = wc * 64 + n * 16 + fr; bfr[n] = *(const bf16x8*)(Bs + row * 64 + ((fq ^ (((row >> 2) & 1) << 1)) << 4)); }
#pragma unroll
        for (int m = 0; m < 4; ++m)
#pragma unroll
            for (int n = 0; n < 4; ++n) acc[m][n] = mfma16(bfr[n], af[m], acc[m][n]);
        if (kt + 3 < nk) asm volatile("s_waitcnt vmcnt(8)" ::: "memory");
        else if (kt + 2 < nk) asm volatile("s_waitcnt vmcnt(4)" ::: "memory");
        else asm volatile("s_waitcnt vmcnt(0)" ::: "memory");
        asm volatile("s_waitcnt lgkmcnt(0)" ::: "memory");
        __builtin_amdgcn_s_barrier();
    }
#undef GEMM_STAGE
#pragma unroll
    for (int m = 0; m < 4; ++m) {
        const int row = tm * 128 + wr * 64 + m * 16 + (l & 15);
#pragma unroll
        for (int n = 0; n < 4; ++n) {
            const int col = tn * 128 + wc * 64 + n * 16 + 4 * (l >> 4);
            const f32x4 a = acc[m][n];
            if (EPI == EPI_PROJ) {
                uint2 o; o.x = pk2(a[0], a[1]); o.y = pk2(a[2], a[3]);
                *(uint2*)(e.obf + (size_t)row * LDP + col) = o;
            } else if (EPI == EPI_OUT) {
                const float4 xi = *(const float4*)(e.xin + (size_t)row * D + col);
                const float4 gg = *(const float4*)(e.gate + col);
                float4 o; o.x = xi.x + gg.x * a[0]; o.y = xi.y + gg.y * a[1]; o.z = xi.z + gg.z * a[2]; o.w = xi.w + gg.w * a[3];
                *(float4*)(e.of + (size_t)row * D + col) = o;
            } else {
                float4 o; o.x = a[0]; o.y = a[1]; o.z = a[2]; o.w = a[3];
                *(float4*)(e.of + (size_t)row * 1024 + col) = o;
            }
        }
    }
    __syncthreads();
}

DEV void st_conv(const P& p, int layer, int unit, char* smem) {
    float* cs = (float*)smem;
    const int tid = tidx(), t0 = unit * 16;
    const float* cw = p.conv_w + (size_t)layer * 31 * 512;
#pragma unroll 1
    for (int cc = 0; cc < 2; ++cc) {
        const int c = tid + 256 * cc;
        float w[31], z[46];
#pragma unroll
        for (int k = 0; k < 31; ++k) w[k] = cw[k * 512 + c];
#pragma unroll
        for (int r = 0; r < 46; ++r) {
            const int t = t0 - 30 + r;
            float zz = 0.f;
            if (t >= 0) {
                const float a = bf2f(p.PROJ()[(size_t)t * LDP + C_CA + c]), g = bf2f(p.PROJ()[(size_t)t * LDP + C_CG + c]);
                zz = a * sigmoidf_(g);
            }
            z[r] = zz;
        }
        const float cb = p.conv_b[layer * 512 + c];
#pragma unroll
        for (int tt = 0; tt < 16; ++tt) {
            float acc = cb;
#pragma unroll
            for (int k = 0; k < 31; ++k) acc += w[k] * z[tt + k];
            cs[tt * 512 + c] = acc;
        }
    }
    __syncthreads();
    const int w = tid >> 6, l = tid & 63;
    const float* lg = p.cln_g + layer * 512; const float* lb = p.cln_b + layer * 512;
#pragma unroll 1
    for (int q = 0; q < 4; ++q) {
        const int tt = w * 4 + q;
        float v[8]; float s = 0.f;
#pragma unroll
        for (int i = 0; i < 8; ++i) { v[i] = cs[tt * 512 + l + 64 * i]; s += v[i]; }
        const float mean = wsum(s) * (1.0f / 512.0f);
        float q2 = 0.f;
#pragma unroll
        for (int i = 0; i < 8; ++i) { const float d = v[i] - mean; q2 += d * d; }
        const float rstd = rsqrtf(wsum(q2) * (1.0f / 512.0f) + EPS);
#pragma unroll
        for (int i = 0; i < 8; ++i) {
            const int c = l + 64 * i;
            const float y = (v[i] - mean) * rstd * lg[c] + lb[c];
            p.Y()[(size_t)(t0 + tt) * D + c] = f2bf(y * sigmoidf_(y));
        }
    }
    __syncthreads();
}

DEV void st_sgu(const P& p, int layer, int unit, char* smem) {
    const int n = unit >> 2, h = unit & 3, tid = tidx(), w = tid >> 6, l = tid & 63;
    float* stat = (float*)smem;
    float* wt = stat + 256;
    float* vt = wt + 16 * 132;
    const int tb = n * 128;
#pragma unroll 1
    for (int q = 0; q < 32; ++q) {
        const int j = w * 32 + q;
        const uint4 raw = *(const uint4*)(p.PROJ() + (size_t)(tb + j) * LDP + C_SV + l * 8);
        float v[8] = {lo2f(raw.x), hi2f(raw.x), lo2f(raw.y), hi2f(raw.y), lo2f(raw.z), hi2f(raw.z), lo2f(raw.w), hi2f(raw.w)};
        float s = 0.f;
#pragma unroll
        for (int i = 0; i < 8; ++i) s += v[i];
        const float mean = wsum(s) * (1.0f / 512.0f);
        float q2 = 0.f;
#pragma unroll
        for (int i = 0; i < 8; ++i) { const float d = v[i] - mean; q2 += d * d; }
        const float rstd = rsqrtf(wsum(q2) * (1.0f / 512.0f) + EPS);
        if (l == 0) { stat[j * 2] = mean; stat[j * 2 + 1] = rstd; }
    }
    __syncthreads();
    const int ti = tid >> 4, td = tid & 15;
    float acc[8][8];
#pragma unroll
    for (int a = 0; a < 8; ++a)
#pragma unroll
        for (int b = 0; b < 8; ++b) acc[a][b] = 0.f;
    const float* Wh = p.sgu_w + ((size_t)layer * 4 + h) * 128 * 128;
    const float* lg = p.sln_g + layer * 512 + h * 128; const float* lb = p.sln_b + layer * 512 + h * 128;
#pragma unroll 1
    for (int jc = 0; jc < 8; ++jc) {
#pragma unroll 2
        for (int q = 0; q < 8; ++q) {
            const int e = tid + 256 * q;
            { const int i = e >> 4, jj = e & 15, j = jc * 16 + jj; wt[jj * 132 + i] = (i >= j) ? Wh[i * 128 + j] : 0.f; }
            { const int jj = e >> 7, d = e & 127, j = jc * 16 + jj;
              const float x = bf2f(p.PROJ()[(size_t)(tb + j) * LDP + C_SV + h * 128 + d]);
              vt[jj * 128 + d] = (x - stat[j * 2]) * stat[j * 2 + 1] * lg[d] + lb[d]; }
        }
        __syncthreads();
        if (w * 32 + 31 >= jc * 16) {
#pragma unroll 2
            for (int jj = 0; jj < 16; ++jj) {
                const float4 w0 = *(const float4*)(wt + jj * 132 + ti * 8), w1 = *(const float4*)(wt + jj * 132 + ti * 8 + 4);
                const float4 v0 = *(const float4*)(vt + jj * 128 + td * 8), v1 = *(const float4*)(vt + jj * 128 + td * 8 + 4);
                const float wv[8] = {w0.x, w0.y, w0.z, w0.w, w1.x, w1.y, w1.z, w1.w};
                const float vv[8] = {v0.x, v0.y, v0.z, v0.w, v1.x, v1.y, v1.z, v1.w};
#pragma unroll
                for (int a = 0; a < 8; ++a)
#pragma unroll
                    for (int b = 0; b < 8; ++b) acc[a][b] += wv[a] * vv[b];
            }
        }
        __syncthreads();
    }
#pragma unroll
    for (int a = 0; a < 8; ++a) {
        const int i = ti * 8 + a; const size_t t = tb + i;
        const float bs = p.sgu_b[((size_t)layer * 4 + h) * 128 + i];
        const uint4 ur = *(const uint4*)(p.PROJ() + t * LDP + C_SU + h * 128 + td * 8);
        const float u[8] = {lo2f(ur.x), hi2f(ur.x), lo2f(ur.y), hi2f(ur.y), lo2f(ur.z), hi2f(ur.z), lo2f(ur.w), hi2f(ur.w)};
        float y[8];
#pragma unroll
        for (int b = 0; b < 8; ++b) y[b] = u[b] * (acc[a][b] + bs);
        uint4 o; o.x = pk2(y[0], y[1]); o.y = pk2(y[2], y[3]); o.z = pk2(y[4], y[5]); o.w = pk2(y[6], y[7]);
        *(uint4*)(p.Y() + t * D + 512 + h * 128 + td * 8) = o;
    }
}

DEV void st_vtrans(const P& p, int unit, char* smem) {
    bf16_t* tile = (bf16_t*)smem;
    const int which = unit & 1, tt0 = (unit >> 1) * 64, tid = tidx();
    const int col0 = which ? C_NVW : C_NVS;
    bf16_t* dst = which ? p.VWT() : p.VST();
#pragma unroll
    for (int q = 0; q < 4; ++q) {
        const int e = tid + 256 * q; const int r = e >> 4, c8 = e & 15;
        const uint4 raw = *(const uint4*)(p.PROJ() + (size_t)(tt0 + r) * LDP + col0 + c8 * 8);
        unsigned* d32 = (unsigned*)(tile + r * 130 + c8 * 8);
        d32[0] = raw.x; d32[1] = raw.y; d32[2] = raw.z; d32[3] = raw.w;
    }
    __syncthreads();
    const int d = tid >> 1, half = tid & 1;
    unsigned o[16];
#pragma unroll
    for (int i = 0; i < 16; ++i) {
        const unsigned a = tile[(half * 32 + 2 * i) * 130 + d], b = tile[(half * 32 + 2 * i + 1) * 130 + d];
        o[i] = a | (b << 16);
    }
    uint4* dp = (uint4*)(dst + (size_t)d * T + tt0 + half * 32);
#pragma unroll
    for (int i = 0; i < 4; ++i) dp[i] = make_uint4(o[4 * i], o[4 * i + 1], o[4 * i + 2], o[4 * i + 3]);
    __syncthreads();
}

DEV void head_norm_rope(const bf16_t* src, const float* g, const float* rc, const float* rs_, int l, bool rope, float& o0, float& o1, float& n0, float& n1) {
    const float x0 = bf2f(src[l]), x1 = bf2f(src[l + 64]);
    const float ss = wsum(x0 * x0 + x1 * x1);
    const float r = rsqrtf(ss * (1.0f / 128.0f) + EPS);
    n0 = x0 * r * g[l]; n1 = x1 * r * g[l + 64];
    o0 = n0; o1 = n1;
    const float other = __shfl_xor(n0, 16);
    if (rope && l < 32) {
        const float c = rc[l & 15], s = rs_[l & 15];
        o0 = (l < 16) ? (n0 * c - other * s) : (n0 * c + other * s);
    }
}
DEV void st_prep(const P& p, int layer, int unit) {
    const int tid_ = tidx(); const int w = tid_ >> 6, l = tid_ & 63; const size_t t = (size_t)unit * 4 + w;
    const bf16_t* row = p.PROJ() + t * LDP;
    const float* rc = p.ropeC() + t * 24; const float* rs_ = p.ropeS() + t * 24;
    float o0, o1, n0, n1;
#pragma unroll
    for (int h = 0; h < 4; ++h) {
        head_norm_rope(row + C_NQ + h * 128, p.nsa_qg + layer * 128, rc, rs_, l, true, o0, o1, n0, n1);
        p.QN()[(t * 4 + h) * 128 + l] = f2bf(n0); p.QN()[(t * 4 + h) * 128 + l + 64] = f2bf(n1);
        p.QR()[(t * 4 + h) * 128 + l] = f2bf(o0); p.QR()[(t * 4 + h) * 128 + l + 64] = f2bf(o1);
    }
    head_norm_rope(row + C_NKS, p.nsa_kg + (layer * 3 + 1) * 128, rc, rs_, l, true, o0, o1, n0, n1);
    p.KS()[t * 128 + l] = f2bf(o0); p.KS()[t * 128 + l + 64] = f2bf(o1);
    head_norm_rope(row + C_NKW, p.nsa_kg + (layer * 3 + 2) * 128, rc, rs_, l, true, o0, o1, n0, n1);
    p.KW()[t * 128 + l] = f2bf(o0); p.KW()[t * 128 + l + 64] = f2bf(o1);
    if (l < 12) p.GATES()[t * 12 + l] = sigmoidf_(bf2f(row[C_NG + l]));
#pragma unroll
    for (int h = 0; h < 4; ++h) {
        head_norm_rope(row + C_DQ + h * 128, p.dsa_qg + layer * 128, rc, rs_, l, true, o0, o1, n0, n1);
        p.DQ()[(t * 4 + h) * 128 + l] = f2bf(o0); p.DQ()[(t * 4 + h) * 128 + l + 64] = f2bf(o1);
    }
    head_norm_rope(row + C_DK, p.dsa_kg + layer * 128, rc, rs_, l, true, o0, o1, n0, n1);
    p.DK()[t * 128 + l] = f2bf(o0); p.DK()[t * 128 + l + 64] = f2bf(o1);
    const float ic = rc[16 + (l & 7)], is = rs_[16 + (l & 7)];
#pragma unroll
    for (int h = 0; h < 9; ++h) {
        const float x = bf2f(row[(h < 8 ? C_IQ + h * 64 : C_IK) + l]);
        const float other = __shfl_xor(x, 8);
        float o = x;
        if (l < 16) o = (l < 8) ? (x * ic - other * is) : (x * ic + other * is);
        if (h < 8) p.IQ()[(t * 8 + h) * 64 + l] = f2bf(o); else p.IK()[t * 64 + l] = f2bf(o);
    }
    if (l < 8) p.IW()[t * 8 + l] = bf2f(row[C_IW + l]) * (0.35355339059327373f * 0.125f);
}

DEV void st_compress(const P& p, int layer, int unit, char* smem) {
    const int which = unit & 1, rt = unit >> 1, tid = tidx(), w = tid >> 6, l = tid & 63, fr = l & 15, fq = l >> 4;
    float* hid = (float*)smem;
    float* ob = hid + 16 * 128;
    const int nb = rt * 16 + fr;
    const int col0 = which ? C_NVC : C_NKC;
    const float* ps = p.cmp_pos + ((size_t)layer * 2 + which) * 4096;
    const bf16_t* w1t = p.W1T() + ((size_t)layer * 2 + which) * 128 * 4096;
    const bool rowok = nb < 511;
    const bf16_t* xrow = p.PROJ() + (size_t)(rowok ? nb * 16 : 0) * LDP + col0;
    f32x4 acc[2] = {(f32x4){0.f, 0.f, 0.f, 0.f}, (f32x4){0.f, 0.f, 0.f, 0.f}};
#pragma unroll 4
    for (int ks = 0; ks < 128; ++ks) {
        const int k = ks * 32 + fq * 8, lt = k >> 7, d = k & 127;
        const uint4 xr = *(const uint4*)(xrow + (size_t)lt * LDP + d);
        const float4 p0 = *(const float4*)(ps + k), p1 = *(const float4*)(ps + k + 4);
        union { bf16x8 v; unsigned u32[4]; } a;
        a.u32[0] = pk2(lo2f(xr.x) + p0.x, hi2f(xr.x) + p0.y); a.u32[1] = pk2(lo2f(xr.y) + p0.z, hi2f(xr.y) + p0.w);
        a.u32[2] = pk2(lo2f(xr.z) + p1.x, hi2f(xr.z) + p1.y); a.u32[3] = pk2(lo2f(xr.w) + p1.z, hi2f(xr.w) + p1.w);
#pragma unroll
        for (int nt = 0; nt < 2; ++nt) {
            const bf16x8 b = *(const bf16x8*)(w1t + (size_t)(w * 32 + nt * 16 + fr) * 4096 + k);
            acc[nt] = mfma16(a.v, b, acc[nt]);
        }
    }
#pragma unroll
    for (int nt = 0; nt < 2; ++nt)
#pragma unroll
        for (int r = 0; r < 4; ++r) hid[(4 * fq + r) * 128 + w * 32 + nt * 16 + fr] = gelu_tanh(acc[nt][r]);
    __syncthreads();
    const float* w2 = p.cmp_w2 + ((size_t)layer * 2 + which) * 128 * 128;
    const int c2 = tid & 127, mh = tid >> 7;
    float o[8];
#pragma unroll
    for (int b = 0; b < 8; ++b) o[b] = 0.f;
#pragma unroll 4
    for (int k = 0; k < 128; ++k) {
        const float wv = w2[k * 128 + c2];
#pragma unroll
        for (int b = 0; b < 8; ++b) o[b] += hid[(mh * 8 + b) * 128 + k] * wv;
    }
#pragma unroll
    for (int b = 0; b < 8; ++b) ob[(mh * 8 + b) * 128 + c2] = o[b];
    __syncthreads();
#pragma unroll
    for (int q = 0; q < 4; ++q) {
        const int b = w * 4 + q, nbo = rt * 16 + b;
        float v0 = ob[b * 128 + l], v1 = ob[b * 128 + l + 64];
        if (which == 0) {
            const float r = rsqrtf(wsum(v0 * v0 + v1 * v1) * (1.0f / 128.0f) + EPS);
            const float* kg = p.nsa_kg + (layer * 3 + 0) * 128;
            v0 = v0 * r * kg[l]; v1 = v1 * r * kg[l + 64];
            if (nbo >= 511) { v0 = 0.f; v1 = 0.f; }
            p.KC()[nbo * 128 + l] = f2bf(v0); p.KC()[nbo * 128 + l + 64] = f2bf(v1);
        } else {
            if (nbo >= 511) { v0 = 0.f; v1 = 0.f; }
            p.VCT()[l * 512 + nbo] = f2bf(v0); p.VCT()[(l + 64) * 512 + nbo] = f2bf(v1);
        }
    }
    __syncthreads();
}

DEV void st_nsa_cmp(const P& p, int unit, char* smem) {
    const int tid = tidx(), w = tid >> 6, l = tid & 63, qc = l & 15, g4 = l >> 4;
    float* impl = (float*)smem + w * 512;
    const int t0 = unit * 16 + w * 4;
    const int tk = qc >> 2, hd = qc & 3, t = t0 + tk;
    bf16x8 qf[4];
#pragma unroll
    for (int ks = 0; ks < 4; ++ks) qf[ks] = *(const bf16x8*)(p.QN() + ((size_t)t0 * 4 + qc) * 128 + ks * 32 + g4 * 8);
    const int tmax = t0 + 3;
    const int nvmax = tmax >= 31 ? (tmax - 31) / 16 + 1 : 0;
    const int ntile = (nvmax + 15) >> 4;
    const int nvis = t >= 31 ? (t - 31) / 16 + 1 : 0;
    const float cs = 0.08838834764831845f * 1.4426950408889634f;
    float m = -1e30f, lsum = 0.f;
#pragma unroll 1
    for (int tt = 0; tt < ntile; ++tt) {
        f32x4 s = (f32x4){0.f, 0.f, 0.f, 0.f};
#pragma unroll
        for (int ks = 0; ks < 4; ++ks) {
            const bf16x8 a = *(const bf16x8*)(p.KC() + (size_t)(tt * 16 + qc) * 128 + ks * 32 + g4 * 8);
            s = mfma16(a, qf[ks], s);
        }
        float mx = m;
#pragma unroll
        for (int r = 0; r < 4; ++r) { const int key = tt * 16 + 4 * g4 + r; s[r] *= cs; if (key < nvis) mx = fmaxf(mx, s[r]); }
        float ps = 0.f;
#pragma unroll
        for (int r = 0; r < 4; ++r) { const int key = tt * 16 + 4 * g4 + r; ps += (key < nvis) ? exp2f(s[r] - mx) : 0.f; }
        lsum = lsum * exp2f(m - mx) + ps; m = mx;
    }
    {
        float mt_ = fmaxf(m, __shfl_xor(m, 16)); mt_ = fmaxf(mt_, __shfl_xor(mt_, 32));
        lsum *= exp2f(m - mt_); m = mt_;
        lsum += __shfl_xor(lsum, 16); lsum += __shfl_xor(lsum, 32);
    }
    const float inv = lsum > 0.f ? 1.0f / lsum : 0.f;
    f32x4 o[8];
#pragma unroll
    for (int mt = 0; mt < 8; ++mt) o[mt] = (f32x4){0.f, 0.f, 0.f, 0.f};
    float yprev = 0.f;
#pragma unroll 1
    for (int u = 0; u < 16; ++u) {
        f32x4 s2[2];
#pragma unroll
        for (int q = 0; q < 2; ++q) {
            const int tt = 2 * u + q;
            f32x4 s = (f32x4){0.f, 0.f, 0.f, 0.f};
            if (tt < ntile) {
#pragma unroll
                for (int ks = 0; ks < 4; ++ks) {
                    const bf16x8 a = *(const bf16x8*)(p.KC() + (size_t)(tt * 16 + qc) * 128 + ks * 32 + g4 * 8);
                    s = mfma16(a, qf[ks], s);
                }
            }
#pragma unroll
            for (int r = 0; r < 4; ++r) { const int key = tt * 16 + 4 * g4 + r; s[r] = (key < nvis) ? exp2f(s[r] * cs - m) * inv : 0.f; }
            const float y = __shfl(s[3], (l + 48) & 63);
            float iv = (s[0] + s[1]) + (s[2] + s[3]) + (g4 > 0 ? y : yprev);
            yprev = y;
            iv += __shfl_xor(iv, 1); iv += __shfl_xor(iv, 2);
            if (hd == 0) impl[tk * 128 + 4 * tt + g4] = iv;
            s2[q] = s;
        }
        if (2 * u < ntile) {
            union { bf16x8 v; unsigned u32[4]; } b;
            b.u32[0] = pk2(s2[0][0], s2[0][1]); b.u32[1] = pk2(s2[0][2], s2[0][3]);
            b.u32[2] = pk2(s2[1][0], s2[1][1]); b.u32[3] = pk2(s2[1][2], s2[1][3]);
#pragma unroll
            for (int mt = 0; mt < 8; ++mt) {
                const bf16_t* vp = p.VCT() + (size_t)(mt * 16 + qc) * 512 + 32 * u + 4 * g4;
                union { bf16x8 v; uint2 h2[2]; } a;
                a.h2[0] = *(const uint2*)vp; a.h2[1] = *(const uint2*)(vp + 16);
                o[mt] = mfma16(a.v, b.v, o[mt]);
            }
        }
    }
#pragma unroll
    for (int mt = 0; mt < 8; ++mt) {
        uint2 ov; ov.x = pk2(o[mt][0], o[mt][1]); ov.y = pk2(o[mt][2], o[mt][3]);
        *(uint2*)(p.OCMP() + ((size_t)t * 4 + hd) * 128 + mt * 16 + 4 * g4) = ov;
    }
    __syncthreads();
    const int li = hd + 4 * g4, cur = t >> 6;
    unsigned long long own[8]; int rank[8];
#pragma unroll
    for (int i = 0; i < 8; ++i) {
        const int j = li + 16 * i; const float v = impl[tk * 128 + j];
        const unsigned k32 = (j == 0 || j == cur || j == cur - 1) ? 0xFFFFFFFFu : (j > cur ? 0u : __float_as_uint(v) + 128u);
        own[i] = ((unsigned long long)k32 << 7) | (unsigned)(127 - j); rank[i] = 0;
    }
#pragma unroll 1
    for (int ip = 0; ip < 8; ++ip) {
#pragma unroll
        for (int q4 = 0; q4 < 4; ++q4) {
            const float4 ov = *(const float4*)(impl + tk * 128 + ip * 16 + q4 * 4);
            const float o4[4] = {ov.x, ov.y, ov.z, ov.w};
#pragma unroll
            for (int e = 0; e < 4; ++e) {
                const int jp = ip * 16 + q4 * 4 + e;
                const unsigned k32 = (jp == 0 || jp == cur || jp == cur - 1) ? 0xFFFFFFFFu : (jp > cur ? 0u : __float_as_uint(o4[e]) + 128u);
                const unsigned long long kp = ((unsigned long long)k32 << 7) | (unsigned)(127 - jp);
#pragma unroll
                for (int i = 0; i < 8; ++i) rank[i] += (kp > own[i]) ? 1 : 0;
            }
        }
    }
    unsigned mw[4] = {0u, 0u, 0u, 0u};
#pragma unroll
    for (int i = 0; i < 8; ++i) if (rank[i] < 16) mw[i >> 1] |= 1u << (li + 16 * (i & 1));
#pragma unroll
    for (int q = 0; q < 4; ++q) {
        unsigned v = mw[q];
        v |= __shfl_xor(v, 1); v |= __shfl_xor(v, 2); v |= __shfl_xor(v, 16); v |= __shfl_xor(v, 32);
        mw[q] = v;
    }
    if (li == 0) *(uint4*)(p.SEL() + (size_t)t * 4) = make_uint4(mw[0], mw[1], mw[2], mw[3]);
    __syncthreads();
}

DEV void st_nsa_attn(const P& p, int unit, char* smem) {
    constexpr int RSK = 272, RSV = 136, BUFB = 64 * RSK + 128 * RSV;
    const int tid = tidx(), w = tid >> 6, l = tid & 63, qc = l & 15, g4 = l >> 4;
    const int tq0 = unit * 16, t = tq0 + w * 4 + (qc >> 2), hd = qc & 3;
    bf16x8 qf[4];
#pragma unroll
    for (int ks = 0; ks < 4; ++ks) qf[ks] = *(const bf16x8*)(p.QR() + ((size_t)t * 4 + hd) * 128 + ks * 32 + g4 * 8);
    const uint4 selw = *(const uint4*)(p.SEL() + (size_t)t * 4);
    const float cs = 0.08838834764831845f * 1.4426950408889634f;
    unsigned part[8][2];
#pragma unroll
    for (int mt = 0; mt < 8; ++mt) { part[mt][0] = 0u; part[mt][1] = 0u; }
    const float g0 = p.GATES()[(size_t)t * 12 + hd * 3];
    int gstep = 0;
    const int krow = tid >> 4, kc16 = tid & 15, vrow = tid >> 3, vc16 = tid & 7;
#pragma unroll 1
    for (int br = 0; br < 2; ++br) {
        const bf16_t* Kg = br ? p.KW() : p.KS(); const bf16_t* Vg = br ? p.VWT() : p.VST();
        const int ktlast = (tq0 + 15) >> 6;
        const int ktfirst = br ? ((tq0 - 511 > 0 ? tq0 - 511 : 0) >> 6) : 0;
        const int nk = ktlast - ktfirst + 1;
        f32x4 o[8];
#pragma unroll
        for (int mt = 0; mt < 8; ++mt) o[mt] = (f32x4){0.f, 0.f, 0.f, 0.f};
        float m = -1e30f, lsum = 0.f;
        uint4 rk0, rk1, rk2, rk3, rv0, rv1, rv2, rv3;
#define NSA_LOAD(KT) do { const bf16_t* kb = Kg + (size_t)((KT) * 64 + krow) * 128 + kc16 * 8; const bf16_t* vb = Vg + (size_t)vrow * T + (KT) * 64 + vc16 * 8; \
        rk0 = *(const uint4*)kb; rk1 = *(const uint4*)(kb + 16 * 128); rk2 = *(const uint4*)(kb + 32 * 128); rk3 = *(const uint4*)(kb + 48 * 128); \
        rv0 = *(const uint4*)vb; rv1 = *(const uint4*)(vb + (size_t)32 * T); rv2 = *(const uint4*)(vb + (size_t)64 * T); rv3 = *(const uint4*)(vb + (size_t)96 * T); } while (0)
        NSA_LOAD(ktfirst);
#pragma unroll 1
        for (int i = 0; i < nk; ++i, ++gstep) {
            const int kt = ktfirst + i;
            char* Kt = smem + (gstep & 1) * BUFB; char* Vt = Kt + 64 * RSK;
            *(uint4*)(Kt + krow * RSK + kc16 * 16) = rk0; *(uint4*)(Kt + (krow + 16) * RSK + kc16 * 16) = rk1;
            *(uint4*)(Kt + (krow + 32) * RSK + kc16 * 16) = rk2; *(uint4*)(Kt + (krow + 48) * RSK + kc16 * 16) = rk3;
            *(uint4*)(Vt + vrow * RSV + vc16 * 16) = rv0; *(uint4*)(Vt + (vrow + 32) * RSV + vc16 * 16) = rv1;
            *(uint4*)(Vt + (vrow + 64) * RSV + vc16 * 16) = rv2; *(uint4*)(Vt + (vrow + 96) * RSV + vc16 * 16) = rv3;
            __syncthreads();
            if (i + 1 < nk) NSA_LOAD(kt + 1);
            int lo, hi = t;
            if (br == 0) {
                const unsigned wv = (kt & 64) ? ((kt & 32) ? selw.w : selw.z) : ((kt & 32) ? selw.y : selw.x);
                lo = 0; hi = ((wv >> (kt & 31)) & 1u) ? t : -1;
            } else lo = t - 511;
            const bool interior = (kt * 64 + 63 <= tq0) && (br == 0 || kt * 64 >= tq0 + 15 - 511);
            f32x4 sv[4];
            float mx = -3e38f;
            if (interior) {
                const float csl = hi >= 0 ? cs : 0.f, add = hi >= 0 ? 0.f : -3e38f;
#pragma unroll
                for (int sub = 0; sub < 4; ++sub) {
                    f32x4 a4 = (f32x4){0.f, 0.f, 0.f, 0.f};
#pragma unroll
                    for (int ks = 0; ks < 4; ++ks) a4 = mfma16(*(const bf16x8*)(Kt + (sub * 16 + qc) * RSK + (ks * 32 + g4 * 8) * 2), qf[ks], a4);
#pragma unroll
                    for (int r = 0; r < 4; ++r) { a4[r] = a4[r] * csl + add; mx = fmaxf(mx, a4[r]); }
                    sv[sub] = a4;
                }
            } else {
#pragma unroll
                for (int sub = 0; sub < 4; ++sub) {
                    f32x4 a4 = (f32x4){0.f, 0.f, 0.f, 0.f};
#pragma unroll
                    for (int ks = 0; ks < 4; ++ks) a4 = mfma16(*(const bf16x8*)(Kt + (sub * 16 + qc) * RSK + (ks * 32 + g4 * 8) * 2), qf[ks], a4);
#pragma unroll
                    for (int r = 0; r < 4; ++r) {
                        const int kp = kt * 64 + sub * 16 + 4 * g4 + r;
                        const bool valid = (kp >= lo) & (kp <= hi);
                        a4[r] = valid ? a4[r] * cs : -3e38f;
                        mx = fmaxf(mx, a4[r]);
                    }
                    sv[sub] = a4;
                }
            }
            mx = fmaxf(mx, __shfl_xor(mx, 16)); mx = fmaxf(mx, __shfl_xor(mx, 32));
            const float mnew = fmaxf(fmaxf(m, mx), -1e30f);
            const float alpha = __builtin_amdgcn_exp2f(m - mnew);
            m = mnew;
            float ps = 0.f;
#pragma unroll
            for (int sub = 0; sub < 4; ++sub)
#pragma unroll
                for (int r = 0; r < 4; ++r) { const float pv = __builtin_amdgcn_exp2f(sv[sub][r] - mnew); sv[sub][r] = pv; ps += pv; }
            lsum = lsum * alpha + ps;
            if (__any(alpha != 1.0f)) {
#pragma unroll
                for (int mt = 0; mt < 8; ++mt) o[mt] *= alpha;
            }
#pragma unroll
            for (int pr = 0; pr < 2; ++pr) {
                union { bf16x8 v; unsigned u32[4]; } bb;
                bb.u32[0] = pk2(sv[2 * pr][0], sv[2 * pr][1]); bb.u32[1] = pk2(sv[2 * pr][2], sv[2 * pr][3]);
                bb.u32[2] = pk2(sv[2 * pr + 1][0], sv[2 * pr + 1][1]); bb.u32[3] = pk2(sv[2 * pr + 1][2], sv[2 * pr + 1][3]);
#pragma unroll
                for (int mt = 0; mt < 8; ++mt) {
                    const char* vp = Vt + (mt * 16 + qc) * RSV + (pr * 32 + 4 * g4) * 2;
                    union { bf16x8 v; uint2 h2[2]; } aa;
                    aa.h2[0] = *(const uint2*)vp; aa.h2[1] = *(const uint2*)(vp + 32);
                    o[mt] = mfma16(aa.v, bb.v, o[mt]);
                }
            }
        }
#undef NSA_LOAD
        lsum += __shfl_xor(lsum, 16); lsum += __shfl_xor(lsum, 32);
        const float gate = p.GATES()[(size_t)t * 12 + hd * 3 + 1 + br];
        const float sc = lsum > 0.f ? gate / lsum : 0.f;
        if (br == 0) {
#pragma unroll
            for (int mt = 0; mt < 8; ++mt) {
                const uint2 oc = *(const uint2*)(p.OCMP() + ((size_t)t * 4 + hd) * 128 + mt * 16 + 4 * g4);
                part[mt][0] = pk2(sc * o[mt][0] + g0 * lo2f(oc.x), sc * o[mt][1] + g0 * hi2f(oc.x));
                part[mt][1] = pk2(sc * o[mt][2] + g0 * lo2f(oc.y), sc * o[mt][3] + g0 * hi2f(oc.y));
            }
        } else {
#pragma unroll
            for (int mt = 0; mt < 8; ++mt) {
                uint2 ov;
                ov.x = pk2(sc * o[mt][0] + lo2f(part[mt][0]), sc * o[mt][1] + hi2f(part[mt][0]));
                ov.y = pk2(sc * o[mt][2] + lo2f(part[mt][1]), sc * o[mt][3] + hi2f(part[mt][1]));
                *(uint2*)(p.Y() + (size_t)t * D + 1024 + hd * 128 + mt * 16 + 4 * g4) = ov;
            }
        }
    }
    __syncthreads();
}

DEV unsigned f2key(float f) { const unsigned u = __float_as_uint(f); return (u & 0x80000000u) ? ~u : (u | 0x80000000u); }
DEV float key2f(unsigned k) { const unsigned u = (k & 0x80000000u) ? (k & 0x7fffffffu) : ~k; return __uint_as_float(u); }
DEV float wave_prune(float* sc, unsigned short* ix, unsigned* hist, int m, int l) {
    float v[8]; unsigned k[8]; unsigned short id[8]; bool ok[8];
#pragma unroll
    for (int i = 0; i < 8; ++i) {
        const int e = l + 64 * i; ok[i] = e < m;
        v[i] = ok[i] ? sc[e] : 0.f; id[i] = ok[i] ? ix[e] : (unsigned short)0; k[i] = f2key(v[i]);
    }
    unsigned prefix = 0u; int need = 256;
#pragma unroll 1
    for (int pass = 0; pass < 4; ++pass) {
        const int shift = 24 - 8 * pass;
        *(uint4*)(hist + 4 * l) = make_uint4(0u, 0u, 0u, 0u);
        __builtin_amdgcn_wave_barrier();
#pragma unroll
        for (int i = 0; i < 8; ++i) {
            const bool in = ok[i] && (pass == 0 || (k[i] >> (shift + 8)) == prefix);
            if (in) atomicAdd(&hist[(k[i] >> shift) & 255u], 1u);
        }
        __builtin_amdgcn_wave_barrier();
        const uint4 hv = *(const uint4*)(hist + 4 * l);
        const unsigned hq[4] = {hv.x, hv.y, hv.z, hv.w};
        const unsigned own = hv.x + hv.y + hv.z + hv.w;
        unsigned tot = own;
#pragma unroll
        for (int o = 1; o < 64; o <<= 1) { const unsigned tv = __shfl_down(tot, o); if (l + o < 64) tot += tv; }
        unsigned cum = tot - own; int found = -1; int nneed = 0;
#pragma unroll
        for (int kk = 3; kk >= 0; --kk) {
            const unsigned c = hq[kk];
            if (found < 0 && (int)cum < need && (int)(cum + c) >= need) { found = 4 * l + kk; nneed = need - (int)cum; }
            cum += c;
        }
        const unsigned long long bal = __ballot(found >= 0);
        const int src = __ffsll((long long)bal) - 1;
        const int digit = __shfl(found, src); need = __shfl(nneed, src);
        prefix = (prefix << 8) | (unsigned)digit;
    }
    const unsigned thr = prefix;
    int base = 0, ties = 0;
    const unsigned long long ltmask = (1ull << l) - 1ull;
#pragma unroll
    for (int i = 0; i < 8; ++i) {
        const bool gt = ok[i] && k[i] > thr, eq = ok[i] && k[i] == thr;
        const unsigned long long em = __ballot(eq);
        const int trank = ties + __popcll(em & ltmask);
        const bool keep = gt || (eq && trank < need);
        ties += __popcll(em);
        const unsigned long long km = __ballot(keep);
        const int pos = base + __popcll(km & ltmask);
        if (keep) { sc[pos] = v[i]; ix[pos] = id[i]; }
        base += __popcll(km);
    }
    __builtin_amdgcn_wave_barrier();
    return key2f(thr);
}

#define DSA_APPEND(SCP, IXP, CNT, M32, MINE, SV) do { \
    const unsigned _m = (M32); \
    if (MINE) { const int _pos = (CNT) + __popc(_m & ((1u << n) - 1u)); (SCP)[_pos] = (SV); (IXP)[_pos] = (unsigned short)kp; } \
    (CNT) += __popc(_m); } while (0)

DEV void st_dsa_index(const P& p, int unit, char* smem) {
    const int tid = tidx(), w = tid >> 6, l = tid & 63, n = l & 31, h = l >> 5;
    char* wb = smem + w * 14336;
    float* sc0 = (float*)wb; float* sc1 = sc0 + 512; float* sc2 = sc1 + 512; float* sc3 = sc2 + 512;
    unsigned short* ix0 = (unsigned short*)(wb + 8192); unsigned short* ix1 = ix0 + 512; unsigned short* ix2 = ix1 + 512; unsigned short* ix3 = ix2 + 512;
    unsigned* hist = (unsigned*)(wb + 12288);
    const int wu = unit * 4 + w;
    const int tg = (wu & 1) ? (2047 - (wu >> 1)) : (wu >> 1);
    const int t0 = tg * 4;
    const int tl = 2 * ((n >> 2) & 1) + (n >> 4), hdr = (n & 3) + 4 * ((n >> 3) & 1);
    bf16x8 af[4];
#pragma unroll
    for (int s = 0; s < 4; ++s) af[s] = *(const bf16x8*)(p.IQ() + ((size_t)(t0 + tl) * 8 + hdr) * 64 + 16 * s + 8 * h);
    const int tA = t0 + 2 * h, tB = tA + 1;
    float wA[8], wB[8];
#pragma unroll
    for (int r = 0; r < 8; ++r) { wA[r] = p.IW()[(size_t)tA * 8 + r]; wB[r] = p.IW()[(size_t)tB * 8 + r]; }
    int cnt0 = 0, cnt1 = 0, cnt2 = 0, cnt3 = 0;
    const float NINF = -__builtin_inff();
    float tau0 = NINF, tau1 = NINF, tau2 = NINF, tau3 = NINF;
    const int ntiles = (t0 + 3) / 32 + 1;
    const bf16_t* ikp = p.IK() + (size_t)n * 64 + 8 * h;
    bf16x8 na[4], nb[4];
#pragma unroll
    for (int s = 0; s < 4; ++s) { na[s] = *(const bf16x8*)(ikp + 16 * s); nb[s] = *(const bf16x8*)(ikp + (size_t)(ntiles > 1 ? 32 : 0) * 64 + 16 * s); }
#pragma unroll 1
    for (int kt = 0; kt < ntiles; kt += 2) {
        bf16x8 ca[4], cb[4];
#pragma unroll
        for (int s = 0; s < 4; ++s) { ca[s] = na[s]; cb[s] = nb[s]; }
        {
            const int ka = kt + 2 < ntiles ? kt + 2 : ntiles - 1, kb = kt + 3 < ntiles ? kt + 3 : ntiles - 1;
#pragma unroll
            for (int s = 0; s < 4; ++s) { na[s] = *(const bf16x8*)(ikp + (size_t)ka * 32 * 64 + 16 * s); nb[s] = *(const bf16x8*)(ikp + (size_t)kb * 32 * 64 + 16 * s); }
        }
        f32x16 acca, accb;
#pragma unroll
        for (int r = 0; r < 16; ++r) { acca[r] = 0.f; accb[r] = 0.f; }
#pragma unroll
        for (int s = 0; s < 4; ++s) { acca = mfma32(af[s], ca[s], acca); accb = mfma32(af[s], cb[s], accb); }
        float s0a = 0.f, s1a = 0.f, s0b = 0.f, s1b = 0.f, u0a = 0.f, u1a = 0.f, u0b = 0.f, u1b = 0.f;
#pragma unroll
        for (int r = 0; r < 4; ++r) {
            s0a += wA[r] * fmaxf(acca[r], 0.f); u0a += wA[4 + r] * fmaxf(acca[4 + r], 0.f);
            s1a += wB[r] * fmaxf(acca[8 + r], 0.f); u1a += wB[4 + r] * fmaxf(acca[12 + r], 0.f);
            s0b += wA[r] * fmaxf(accb[r], 0.f); u0b += wA[4 + r] * fmaxf(accb[4 + r], 0.f);
            s1b += wB[r] * fmaxf(accb[8 + r], 0.f); u1b += wB[4 + r] * fmaxf(accb[12 + r], 0.f);
        }
        s0a += u0a; s1a += u1a; s0b += u0b; s1b += u1b;
        const float tauA = h ? tau2 : tau0, tauB = h ? tau3 : tau1;
        {
            const int kp = kt * 32 + n;
            const bool cA = (kp <= tA) && (s0a > tauA), cB = (kp <= tB) && (s1a > tauB);
            const unsigned long long mA = __ballot(cA), mB = __ballot(cB);
            DSA_APPEND(sc0, ix0, cnt0, (unsigned)mA, (h == 0 && cA), s0a);
            DSA_APPEND(sc2, ix2, cnt2, (unsigned)(mA >> 32), (h == 1 && cA), s0a);
            DSA_APPEND(sc1, ix1, cnt1, (unsigned)mB, (h == 0 && cB), s1a);
            DSA_APPEND(sc3, ix3, cnt3, (unsigned)(mB >> 32), (h == 1 && cB), s1a);
        }
        {
            const int kp = kt * 32 + 32 + n;
            const bool cA = (kp <= tA) && (s0b > tauA), cB = (kp <= tB) && (s1b > tauB);
            const unsigned long long mA = __ballot(cA), mB = __ballot(cB);
            DSA_APPEND(sc0, ix0, cnt0, (unsigned)mA, (h == 0 && cA), s0b);
            DSA_APPEND(sc2, ix2, cnt2, (unsigned)(mA >> 32), (h == 1 && cA), s0b);
            DSA_APPEND(sc1, ix1, cnt1, (unsigned)mB, (h == 0 && cB), s1b);
            DSA_APPEND(sc3, ix3, cnt3, (unsigned)(mB >> 32), (h == 1 && cB), s1b);
        }
        __builtin_amdgcn_wave_barrier();
        if (max(max(cnt0, cnt1), max(cnt2, cnt3)) > 448) {
            if (cnt0 > 448) { tau0 = wave_prune(sc0, ix0, hist, cnt0, l); cnt0 = 256; }
            if (cnt1 > 448) { tau1 = wave_prune(sc1, ix1, hist, cnt1, l); cnt1 = 256; }
            if (cnt2 > 448) { tau2 = wave_prune(sc2, ix2, hist, cnt2, l); cnt2 = 256; }
            if (cnt3 > 448) { tau3 = wave_prune(sc3, ix3, hist, cnt3, l); cnt3 = 256; }
        }
    }
    if (cnt0 > 256) { wave_prune(sc0, ix0, hist, cnt0, l); cnt0 = 256; }
    if (cnt1 > 256) { wave_prune(sc1, ix1, hist, cnt1, l); cnt1 = 256; }
    if (cnt2 > 256) { wave_prune(sc2, ix2, hist, cnt2, l); cnt2 = 256; }
    if (cnt3 > 256) { wave_prune(sc3, ix3, hist, cnt3, l); cnt3 = 256; }
    __builtin_amdgcn_wave_barrier();
#pragma unroll
    for (int i = 0; i < 4; ++i) {
        const int e = l + 64 * i;
        p.IDX()[(size_t)(t0 + 0) * 256 + e] = e < cnt0 ? (int)ix0[e] : 0;
        p.IDX()[(size_t)(t0 + 1) * 256 + e] = e < cnt1 ? (int)ix1[e] : 0;
        p.IDX()[(size_t)(t0 + 2) * 256 + e] = e < cnt2 ? (int)ix2[e] : 0;
        p.IDX()[(size_t)(t0 + 3) * 256 + e] = e < cnt3 ? (int)ix3[e] : 0;
    }
    if (l == 0) { p.CNT()[t0] = cnt0; p.CNT()[t0 + 1] = cnt1; p.CNT()[t0 + 2] = cnt2; p.CNT()[t0 + 3] = cnt3; }
}

DEV void st_dsa_attn(const P& p, int unit, char* smem) {
    const int tid = tidx(), w = tid >> 6, l = tid & 63, c = l & 15, g4 = l >> 4;
    int* idxs = (int*)(smem + w * 5120); float* Pl = (float*)(smem + w * 5120 + 1024);
    const size_t t = (size_t)unit * 4 + w;
    const int cnt = p.CNT()[t];
#pragma unroll
    for (int i = 0; i < 4; ++i) idxs[l + 64 * i] = p.IDX()[t * 256 + l + 64 * i];
    __builtin_amdgcn_wave_barrier();
    bf16x8 qf[4];
#pragma unroll
    for (int j = 0; j < 4; ++j) qf[j] = *(const bf16x8*)(p.DQ() + (t * 4 + (c & 3)) * 128 + g4 * 32 + j * 8);
    f32x4 s[16];
    const int ntile = (cnt + 15) >> 4;
#pragma unroll
    for (int tt = 0; tt < 16; ++tt) {
        s[tt] = (f32x4){0.f, 0.f, 0.f, 0.f};
        if (tt < ntile) {
            const int krow = idxs[tt * 16 + c];
            const bf16_t* kp = p.DK() + (size_t)krow * 128 + g4 * 32;
#pragma unroll
            for (int j = 0; j < 4; ++j) s[tt] = mfma16(*(const bf16x8*)(kp + j * 8), qf[j], s[tt]);
        }
        if (tt & 1) __builtin_amdgcn_sched_barrier(0);
    }
    const float cs = 0.08838834764831845f * 1.4426950408889634f;
    float mx = -1e30f;
#pragma unroll
    for (int tt = 0; tt < 16; ++tt)
#pragma unroll
        for (int r = 0; r < 4; ++r) { const int slot = tt * 16 + 4 * g4 + r; if (slot < cnt) mx = fmaxf(mx, s[tt][r] * cs); }
    mx = fmaxf(mx, __shfl_xor(mx, 16)); mx = fmaxf(mx, __shfl_xor(mx, 32));
    float sum = 0.f;
#pragma unroll
    for (int tt = 0; tt < 16; ++tt)
#pragma unroll
        for (int r = 0; r < 4; ++r) { const int slot = tt * 16 + 4 * g4 + r; const float pv = slot < cnt ? exp2f(s[tt][r] * cs - mx) : 0.f; s[tt][r] = pv; sum += pv; }
    sum += __shfl_xor(sum, 16); sum += __shfl_xor(sum, 32);
    const float inv = sum > 0.f ? 1.0f / sum : 0.f;
    if (c < 4) {
#pragma unroll
        for (int tt = 0; tt < 16; ++tt)
#pragma unroll
            for (int r = 0; r < 4; ++r) Pl[(tt * 16 + 4 * g4 + r) * 4 + c] = s[tt][r] * inv;
    }
    __builtin_amdgcn_wave_barrier();
    float acc[4][8];
#pragma unroll
    for (int hh = 0; hh < 4; ++hh)
#pragma unroll
        for (int j = 0; j < 8; ++j) acc[hh][j] = 0.f;
    const int nk4 = (cnt + 3) >> 2;
#pragma unroll 2
    for (int kk = 0; kk < nk4; ++kk) {
        const int slot = kk * 4 + g4;
        const int row = idxs[slot];
        const uint4 raw = *(const uint4*)(p.PROJ() + (size_t)row * LDP + C_DV + c * 8);
        const float4 p4 = *(const float4*)(Pl + slot * 4);
        const float vv[8] = {lo2f(raw.x), hi2f(raw.x), lo2f(raw.y), hi2f(raw.y), lo2f(raw.z), hi2f(raw.z), lo2f(raw.w), hi2f(raw.w)};
        const float pp[4] = {p4.x, p4.y, p4.z, p4.w};
#pragma unroll
        for (int hh = 0; hh < 4; ++hh)
#pragma unroll
            for (int j = 0; j < 8; ++j) acc[hh][j] += pp[hh] * vv[j];
    }
#pragma unroll
    for (int hh = 0; hh < 4; ++hh)
#pragma unroll
        for (int j = 0; j < 8; ++j) { float a = acc[hh][j]; a += __shfl_xor(a, 16); a += __shfl_xor(a, 32); acc[hh][j] = a; }
    if (g4 == 0) {
#pragma unroll
        for (int hh = 0; hh < 4; ++hh) {
            uint4 o; o.x = pk2(acc[hh][0], acc[hh][1]); o.y = pk2(acc[hh][2], acc[hh][3]); o.z = pk2(acc[hh][4], acc[hh][5]); o.w = pk2(acc[hh][6], acc[hh][7]);
            *(uint4*)(p.Y() + t * D + 1536 + hh * 128 + c * 8) = o;
        }
    }
    __builtin_amdgcn_wave_barrier();
}

DEV void ins16(unsigned (&top)[16], unsigned x) {
#pragma unroll
    for (int j = 0; j < 16; ++j) { const unsigned hi = max(top[j], x); x = min(top[j], x); top[j] = hi; }
}
DEV void st_peer_topk(const P& p, int layer, int unit, char* smem) {
    const int tid = tidx(), w = tid >> 6, l = tid & 63, n = l & 31, hf = l >> 5;
    const int tg = unit >> 1, head = (unit & 1) * 4 + w;
    const size_t t = (size_t)tg * 32 + n;
    unsigned* il = (unsigned*)smem + w * 1024;
    unsigned top[2][16];
#pragma unroll
    for (int pp = 0; pp < 2; ++pp) {
        float qv[32];
#pragma unroll
        for (int i = 0; i < 8; ++i) { const float4 v = *(const float4*)(p.PQ() + t * 1024 + head * 128 + pp * 64 + hf * 32 + i * 4); qv[4 * i] = v.x; qv[4 * i + 1] = v.y; qv[4 * i + 2] = v.z; qv[4 * i + 3] = v.w; }
        const float* K = p.peer_sk + ((((size_t)layer * 8 + head) * 2 + pp) * 128) * 64;
#pragma unroll
        for (int j = 0; j < 16; ++j) top[pp][j] = 0u;
#pragma unroll 1
        for (int tile = 0; tile < 4; ++tile) {
            float kv[32];
            const float* kr = K + (size_t)(tile * 32 + n) * 64 + hf * 32;
#pragma unroll
            for (int i = 0; i < 8; ++i) { const float4 v = *(const float4*)(kr + i * 4); kv[4 * i] = v.x; kv[4 * i + 1] = v.y; kv[4 * i + 2] = v.z; kv[4 * i + 3] = v.w; }
            f32x16 acc;
#pragma unroll
            for (int r = 0; r < 16; ++r) acc[r] = 0.f;
#pragma unroll
            for (int kk = 0; kk < 32; ++kk) acc = __builtin_amdgcn_mfma_f32_32x32x2f32(kv[kk], qv[kk], acc, 0, 0, 0);
#pragma unroll
            for (int r = 0; r < 16; ++r) {
                const int nn = tile * 32 + (r & 3) + 8 * (r >> 2) + 4 * hf;
                ins16(top[pp], (f2key(acc[r]) & ~127u) | (unsigned)(127 - nn));
            }
        }
        unsigned oth[16];
#pragma unroll
        for (int j = 0; j < 16; ++j) oth[j] = __shfl_xor(top[pp][j], 32);
#pragma unroll
        for (int j = 0; j < 16; ++j) ins16(top[pp], oth[j]);
        if (hf == 0) {
#pragma unroll
            for (int j = 0; j < 16; ++j) il[(pp * 16 + j) * 32 + n] = 127u - (top[pp][j] & 127u);
        }
    }
    __builtin_amdgcn_wave_barrier();
    if (hf == 0) {
        float v1[16], v2[16];
#pragma unroll
        for (int j = 0; j < 16; ++j) { v1[j] = key2f(top[0][j] & ~127u); v2[j] = key2f(top[1][j] & ~127u); }
        unsigned ct[16];
#pragma unroll
        for (int s = 0; s < 16; ++s) ct[s] = 0u;
#pragma unroll
        for (int i = 0; i < 16; ++i)
#pragma unroll
            for (int j = 0; j < 16; ++j)
                if ((i + 1) * (j + 1) <= 16) ins16(ct, (f2key(v1[i] + v2[j]) & ~255u) | (unsigned)(255 - (i * 16 + j)));
        float ex[16], sum = 0.f; int ce[16];
        const float c0 = key2f(ct[0] & ~255u);
#pragma unroll
        for (int s = 0; s < 16; ++s) {
            const unsigned code = 255u - (ct[s] & 255u);
            ce[s] = (int)(il[(code >> 4) * 32 + n] * 128u + il[(16 + (code & 15u)) * 32 + n]);
            ex[s] = __expf(key2f(ct[s] & ~255u) - c0); sum += ex[s];
        }
        const float inv = 1.0f / sum;
#pragma unroll
        for (int s4 = 0; s4 < 4; ++s4) {
            *(int4*)(p.PE() + t * 128 + head * 16 + s4 * 4) = make_int4(ce[4 * s4], ce[4 * s4 + 1], ce[4 * s4 + 2], ce[4 * s4 + 3]);
            *(float4*)(p.PG() + t * 128 + head * 16 + s4 * 4) = make_float4(ex[4 * s4] * inv, ex[4 * s4 + 1] * inv, ex[4 * s4 + 2] * inv, ex[4 * s4 + 3] * inv);
        }
    }
    __builtin_amdgcn_wave_barrier();
}

DEV void fp8x16_decode(const uint4& r, float (&f)[16]) {
    const unsigned w[4] = {r.x, r.y, r.z, r.w};
#pragma unroll
    for (int q = 0; q < 4; ++q) {
        const f32x2 lo = __builtin_amdgcn_cvt_pk_f32_fp8((int)w[q], false), hi = __builtin_amdgcn_cvt_pk_f32_fp8((int)w[q], true);
        f[4 * q] = lo.x; f[4 * q + 1] = lo.y; f[4 * q + 2] = hi.x; f[4 * q + 3] = hi.y;
    }
}
DEV void st_peer_gather(const P& p, int layer, const float* __restrict__ xin, float* __restrict__ xout, int unit) {
    const int tid_ = tidx(); const int w = tid_ >> 6, l = tid_ & 63; const size_t t = (size_t)unit * 4 + w;
    float hf[32];
#pragma unroll
    for (int i = 0; i < 2; ++i)
#pragma unroll
        for (int h2 = 0; h2 < 2; ++h2) {
            const uint4 hv = *(const uint4*)(p.HN() + t * D + i * 1024 + l * 16 + h2 * 8);
            const unsigned u4[4] = {hv.x, hv.y, hv.z, hv.w};
#pragma unroll
            for (int q = 0; q < 4; ++q) { hf[i * 16 + h2 * 8 + 2 * q] = lo2f(u4[q]); hf[i * 16 + h2 * 8 + 2 * q + 1] = hi2f(u4[q]); }
        }
    const int e0 = p.PE()[t * 128 + l], e1 = p.PE()[t * 128 + 64 + l];
    const float g0 = p.PG()[t * 128 + l], g1 = p.PG()[t * 128 + 64 + l];
    float out[32];
#pragma unroll
    for (int i = 0; i < 32; ++i) out[i] = 0.f;
    const unsigned char* U = p.Utab() + (size_t)layer * 16384 * 2048 + l * 16; const unsigned char* V = p.Vtab() + (size_t)layer * 16384 * 2048 + l * 16;
    const bool b5 = (l & 32) != 0, b4 = (l & 16) != 0;
#pragma unroll 1
    for (int k4 = 0; k4 < 32; ++k4) {
        int e[4]; float g[4];
#pragma unroll
        for (int q = 0; q < 4; ++q) {
            const int k = k4 * 4 + q;
            e[q] = __builtin_amdgcn_readlane(k4 < 16 ? e0 : e1, k & 63);
            g[q] = __int_as_float(__builtin_amdgcn_readlane(__float_as_int(k4 < 16 ? g0 : g1), k & 63));
        }
        uint4 uu[4][2], vv[4][2];
#pragma unroll
        for (int q = 0; q < 4; ++q)
#pragma unroll
            for (int i = 0; i < 2; ++i) { uu[q][i] = *(const uint4*)(U + (size_t)e[q] * 2048 + i * 1024); vv[q][i] = *(const uint4*)(V + (size_t)e[q] * 2048 + i * 1024); }
        float d[4];
#pragma unroll
        for (int q = 0; q < 4; ++q) {
            float acc = 0.f;
#pragma unroll
            for (int i = 0; i < 2; ++i) { float f[16]; fp8x16_decode(uu[q][i], f);
#pragma unroll
                for (int j = 0; j < 16; ++j) acc += f[j] * hf[i * 16 + j]; }
            d[q] = acc;
        }
        float kA = b5 ? d[2] : d[0], kB = b5 ? d[3] : d[1];
        const float sA = b5 ? d[0] : d[2], sB = b5 ? d[1] : d[3];
        kA += __shfl_xor(sA, 32); kB += __shfl_xor(sB, 32);
        float kk = b4 ? kB : kA; const float ss = b4 ? kA : kB;
        kk += __shfl_xor(ss, 16);
        kk += __shfl_xor(kk, 8); kk += __shfl_xor(kk, 4); kk += __shfl_xor(kk, 2); kk += __shfl_xor(kk, 1);
        const float gsel = b5 ? (b4 ? g[3] : g[2]) : (b4 ? g[1] : g[0]);
        const float av = gelu_tanh(kk * (1.0f / U8_SCALE)) * gsel * (1.0f / V8_SCALE);
        const int avi = __float_as_int(av);
        const float a4[4] = {__int_as_float(__builtin_amdgcn_readlane(avi, 0)), __int_as_float(__builtin_amdgcn_readlane(avi, 16)),
                             __int_as_float(__builtin_amdgcn_readlane(avi, 32)), __int_as_float(__builtin_amdgcn_readlane(avi, 48))};
#pragma unroll
        for (int q = 0; q < 4; ++q)
#pragma unroll
            for (int i = 0; i < 2; ++i) { float f[16]; fp8x16_decode(vv[q][i], f);
#pragma unroll
                for (int j = 0; j < 16; ++j) out[i * 16 + j] += a4[q] * f[j]; }
    }
    const float* g2 = p.ada() + layer * 12288 + 5 * 2048;
#pragma unroll
    for (int i = 0; i < 2; ++i)
#pragma unroll
        for (int q = 0; q < 4; ++q) {
            const size_t col = i * 1024 + l * 16 + q * 4; const size_t off = t * D + col;
            const float4 x0 = *(const float4*)(xin + off); const float4 ga = *(const float4*)(g2 + col);
            float4 o0;
            o0.x = x0.x + ga.x * out[i * 16 + q * 4 + 0]; o0.y = x0.y + ga.y * out[i * 16 + q * 4 + 1];
            o0.z = x0.z + ga.z * out[i * 16 + q * 4 + 2]; o0.w = x0.w + ga.w * out[i * 16 + q * 4 + 3];
            *(float4*)(xout + off) = o0;
        }
}

enum { S_CONVT_IN = 0, S_CONVT_OUT, S_CONVT_Q, S_CONVT_W1, S_TAB_U, S_TAB_V, S_ADA, S_ROPE, S_NORM1, S_GEMM_IN, S_CONV, S_SGU, S_VTRANS, S_PREP,
       S_COMPRESS, S_NSA_CMP, S_DSA_INDEX, S_NSA_ATTN, S_DSA_ATTN, S_GEMM_OUT, S_NORM2, S_GEMM_Q, S_PEER_TOPK, S_PEER_GATHER, S_COUNT };
constexpr int TAB_UNITS = 4096;
__host__ __device__ constexpr int nunits(int s) {
    return s == S_CONVT_IN ? 2 * 32 * (LDP / 64) : s == S_CONVT_OUT ? 2 * 32 * 32 : s == S_CONVT_Q ? 2 * 32 * 16 : s == S_CONVT_W1 ? 4 * 64 * 2 : s == S_TAB_U ? TAB_UNITS : s == S_TAB_V ? TAB_UNITS
         : s == S_ADA ? 768 : s == S_ROPE ? 768 : s == S_NORM1 ? 2048 : s == S_GEMM_IN ? 64 * (LDP / 128) : s == S_CONV ? 512 : s == S_SGU ? 256
         : s == S_VTRANS ? 256 : s == S_PREP ? 2048 : s == S_COMPRESS ? 64 : s == S_NSA_CMP ? 512 : s == S_DSA_INDEX ? 512 : s == S_NSA_ATTN ? 512 : s == S_DSA_ATTN ? 2048
         : s == S_GEMM_OUT ? 64 * 16 : s == S_NORM2 ? 2048 : s == S_GEMM_Q ? 64 * 8 : s == S_PEER_TOPK ? 512 : s == S_PEER_GATHER ? 2048 : 0;
}
template <int S>
DEV void run_unit(const P& p, int layer, int u, char* smem, int nu = TAB_UNITS) {
    const float* xin = layer == 0 ? p.x : p.X2();
    const float* ada = p.ada() + layer * 12288;
    if constexpr (S == S_CONVT_IN) { const int per = 32 * (LDP / 64), ly = u / per; st_convT(p.w_in + (size_t)ly * 2048 * INC, p.WinT() + (size_t)ly * LDP * 2048, INC, LDP, true, u % per, smem); }
    else if constexpr (S == S_CONVT_OUT) { const int per = 32 * 32, ly = u / per; st_convT(p.w_out + (size_t)ly * 2048 * 2048, p.WoutT() + (size_t)ly * 2048 * 2048, 2048, 2048, false, u % per, smem); }
    else if constexpr (S == S_CONVT_Q) { const int per = 32 * 16, ly = u / per; st_convT(p.peer_wq + (size_t)ly * 2048 * 1024, p.WqT() + (size_t)ly * 1024 * 2048, 1024, 1024, false, u % per, smem); }
    else if constexpr (S == S_CONVT_W1) { const int per = 64 * 2, mi = u / per; st_convT(p.cmp_w1 + (size_t)mi * 4096 * 128, p.W1T() + (size_t)mi * 128 * 4096, 128, 128, false, u % per, smem, 4096); }
    else if constexpr (S == S_TAB_U) st_tab(p.peer_u, p.Utab(), U8_SCALE, (size_t)2 * 16384 * 2048 / 16, u, nu);
    else if constexpr (S == S_TAB_V) st_tab(p.peer_v, p.Vtab(), V8_SCALE, (size_t)2 * 16384 * 2048 / 16, u, nu);
    else if constexpr (S == S_ADA) st_ada(p, u, smem);
    else if constexpr (S == S_ROPE) st_rope(p, u);
    else if constexpr (S == S_NORM1) st_norm(xin, p.n1g + layer * 2048, ada + 2048, ada, p.HN(), u);
    else if constexpr (S == S_GEMM_IN) { EpiArgs e{p.PROJ(), nullptr, nullptr, nullptr}; st_gemm<EPI_PROJ>(p.HN(), p.WinT() + (size_t)layer * LDP * 2048, 2048, u & 63, u >> 6, e, smem); }
    else if constexpr (S == S_CONV) st_conv(p, layer, u, smem);
    else if constexpr (S == S_SGU) st_sgu(p, layer, u, smem);
    else if constexpr (S == S_VTRANS) st_vtrans(p, u, smem);
    else if constexpr (S == S_PREP) st_prep(p, layer, u);
    else if constexpr (S == S_COMPRESS) st_compress(p, layer, u, smem);
    else if constexpr (S == S_NSA_CMP) st_nsa_cmp(p, u, smem);
    else if constexpr (S == S_DSA_INDEX) st_dsa_index(p, u, smem);
    else if constexpr (S == S_NSA_ATTN) st_nsa_attn(p, u, smem);
    else if constexpr (S == S_DSA_ATTN) st_dsa_attn(p, u, smem);
    else if constexpr (S == S_GEMM_OUT) { EpiArgs e{nullptr, p.X1(), xin, ada + 2 * 2048}; st_gemm<EPI_OUT>(p.Y(), p.WoutT() + (size_t)layer * 2048 * 2048, 2048, u & 63, u >> 6, e, smem); }
    else if constexpr (S == S_NORM2) st_norm(p.X1(), p.n2g + layer * 2048, ada + 4 * 2048, ada + 3 * 2048, p.HN(), u);
    else if constexpr (S == S_GEMM_Q) { EpiArgs e{nullptr, p.PQ(), nullptr, nullptr}; st_gemm<EPI_Q>(p.HN(), p.WqT() + (size_t)layer * 1024 * 2048, 2048, u & 63, u >> 6, e, smem); }
    else if constexpr (S == S_PEER_TOPK) st_peer_topk(p, layer, u, smem);
    else if constexpr (S == S_PEER_GATHER) st_peer_gather(p, layer, p.X1(), layer == 0 ? p.X2() : p.out, u);
}


#define XB_TMO      128
#define XB_XCNT(j)  (256  + 64 * (j))
#define XB_XSUB(j)  (1280 + 64 * (j))
#define XB_XGEN(j)  (2304 + 64 * (j))
#define XB_TOP      3328
#define XB_TOPGEN   3392
#define XB_SPIN_CAP (1u << 22)
#define LAS __attribute__((address_space(3)))
DEV unsigned xb_ld(unsigned* p) { return __hip_atomic_load(p, __ATOMIC_RELAXED, __HIP_MEMORY_SCOPE_AGENT); }
DEV unsigned xb_add(unsigned* p, unsigned v) { return __hip_atomic_fetch_add(p, v, __ATOMIC_RELAXED, __HIP_MEMORY_SCOPE_AGENT); }
DEV unsigned xb_xcc_id() { return (unsigned)__builtin_amdgcn_s_getreg((3 << 11) | 20) & 0xFu; }
#define XB_SPIN(cond, bar) do { unsigned _sp = 0; while (cond) { __builtin_amdgcn_s_sleep(1); \
    if ((++_sp & 255u) == 0u) { if (xb_ld(&(bar)[XB_TMO])) break; if (_sp > XB_SPIN_CAP) { atomicAdd(&(bar)[XB_TMO], 1u); break; } } } } while (0)
struct XcdBarrier { unsigned* bar; unsigned x; volatile LAS unsigned* st; };
DEV XcdBarrier xcd_barrier_post(unsigned* bar, volatile LAS unsigned* st) {
    XcdBarrier b; b.bar = bar; b.x = xb_xcc_id(); b.st = st;
    if (threadIdx.x == 0) (void)xb_add(&bar[XB_XCNT(b.x)], 1u);
    return b;
}
DEV void xcd_barrier_complete(unsigned* bar, unsigned x, unsigned& nloc, unsigned& nx) {
    const unsigned G = gridDim.x * gridDim.y * gridDim.z;
    unsigned sum, cnt, mine, sp = 0u;
    for (;;) {
        sum = 0u; cnt = 0u; mine = 0u;
#pragma unroll
        for (unsigned j = 0; j < 16; ++j) { const unsigned c = xb_ld(&bar[XB_XCNT(j)]); sum += c; cnt += (c > 0u) ? 1u : 0u; mine = (j == x) ? c : mine; }
        if (sum == G) break;
        __builtin_amdgcn_s_sleep(1);
        if ((++sp & 255u) == 0u) { if (xb_ld(&bar[XB_TMO])) break; if (sp > XB_SPIN_CAP) { atomicAdd(&bar[XB_TMO], 1u); break; } }
    }
    nloc = mine > 0u ? mine : 1u; nx = cnt > 0u ? cnt : 1u;
}
DEV void xcd_barrier(const XcdBarrier& b) {
    asm volatile("s_waitcnt vmcnt(0)" ::: "memory");
    __syncthreads();
    if (threadIdx.x == 0) {
        unsigned* bar = b.bar;
        __builtin_amdgcn_s_waitcnt(0);
        unsigned nloc = b.st[0], nx = b.st[1];
        if (nloc == 0u) { xcd_barrier_complete(bar, b.x, nloc, nx); b.st[0] = nloc; b.st[1] = nx; }
        const unsigned old = xb_add(&bar[XB_XSUB(b.x)], 1u);
        const unsigned gen = old / nloc;
        if (old + 1u == (gen + 1u) * nloc) {
            __builtin_amdgcn_fence(__ATOMIC_RELEASE, "agent");
            asm volatile("s_waitcnt vmcnt(0)" ::: "memory");
            const unsigned og = xb_add(&bar[XB_TOP], 1u);
            const unsigned tg = og / nx;
            if (og + 1u == (tg + 1u) * nx) xb_add(&bar[XB_TOPGEN], 1u);
            else XB_SPIN(xb_ld(&bar[XB_TOPGEN]) == tg, bar);
            __builtin_amdgcn_fence(__ATOMIC_ACQUIRE, "agent");
            xb_add(&bar[XB_XGEN(b.x)], 1u);
            asm volatile("s_waitcnt vmcnt(0)" ::: "memory");
        } else {
            XB_SPIN(xb_ld(&bar[XB_XGEN(b.x)]) == gen, bar);
            __builtin_amdgcn_fence(__ATOMIC_ACQUIRE, "agent");
            asm volatile("s_waitcnt vmcnt(0)" ::: "memory");
        }
    }
    __syncthreads();
}

#ifndef MULTI_LAUNCH
constexpr int REP_STAGE = -1, REP_STAGE2 = -1, REP_N = 1;
template <int S>
DEV void run_phase1(const P& p, int layer, char* smem, int off);
template <int S>
DEV void run_phase(const P& p, int layer, char* smem, int off = 0) {
    constexpr int reps = (S == REP_STAGE || S == REP_STAGE2) ? REP_N : 1;
#pragma unroll 1
    for (int r = 0; r < reps; ++r) run_phase1<S>(p, layer, smem, off);
}
template <int S>
DEV void run_phase1(const P& p, int layer, char* smem, int off) {
    const int G = gridDim.x;
    int b = blockIdx.x + off; if (b >= G) b -= G;
    if constexpr (S == S_TAB_U || S == S_TAB_V) { run_unit<S>(p, layer, b, smem, G); }
    else {
        for (int u = b; u < nunits(S); u += G) { run_unit<S>(p, layer, u, smem); __syncthreads(); }
    }
}
template <int S>
DEV void run_gemm_phase1(const P& p, int layer, char* smem, unsigned xcc, volatile LAS unsigned* slot, int rep) {
    constexpr int TN = (S == S_GEMM_IN) ? (LDP / 128) : (S == S_GEMM_OUT ? 16 : 8);
    constexpr int inst0 = (S == S_GEMM_IN) ? 0 : (S == S_GEMM_OUT ? 2 : 4);
    const int len = 8 * TN;
#pragma unroll 1
    for (int q = 0; q < 8; ++q) {
        const unsigned xq = (xcc + q) & 7u;
        unsigned* head = p.bar() + GQ_WORD(inst0 + layer + 6 * rep, xq);
        for (;;) {
            if (threadIdx.x == 0) *slot = xb_add(head, 1u);
            __syncthreads();
            const int i = (int)*slot;
            __syncthreads();
            if (i >= len) break;
            const int tn = i >> 3, tm = (int)xq * 8 + (i & 7);
            run_unit<S>(p, layer, tm + 64 * tn, smem);
            __syncthreads();
        }
    }
}
template <int S>
DEV void run_items(const P& p, int layer, char* smem, int first, int count) {
    constexpr int reps = (S == REP_STAGE || S == REP_STAGE2) ? REP_N : 1;
#pragma unroll 1
    for (int r = 0; r < reps; ++r)
#pragma unroll 1
        for (int u = first; u < first + count; ++u) { run_unit<S>(p, layer, u, smem); __syncthreads(); }
}
template <int PH>
DEV void run_dyn_phase(const P& p, int layer, char* smem, volatile LAS unsigned* slot) {
    unsigned* head = p.bar() + DQ_WORD(PH * 2 + layer);
    constexpr int total = PH == 0 ? (64 + 256 + 256 + 64 + 256) : (PH == 1 ? (512 + 256) : (512 + 512));
    int i = blockIdx.x;
    while (i < total) {
        if constexpr (PH == 0) {
            if (i < 256) run_items<S_SGU>(p, layer, smem, i, 1);
            else if (i < 320) run_items<S_COMPRESS>(p, layer, smem, i - 256, 1);
            else if (i < 576) run_items<S_CONV>(p, layer, smem, (i - 320) * 2, 2);
            else if (i < 640) run_items<S_VTRANS>(p, layer, smem, (i - 576) * 4, 4);
            else run_items<S_PREP>(p, layer, smem, (i - 640) * 8, 8);
        } else if constexpr (PH == 1) {
            if (i < 512) run_items<S_DSA_INDEX>(p, layer, smem, i, 1);
            else run_items<S_NSA_CMP>(p, layer, smem, (i - 512) * 2, 2);
        } else {
            if (i < 512) run_items<S_NSA_ATTN>(p, layer, smem, 511 - i, 1);
            else run_items<S_DSA_ATTN>(p, layer, smem, (i - 512) * 4, 4);
        }
        if (threadIdx.x == 0) *slot = gridDim.x + xb_add(head, 1u);
        __syncthreads();
        i = (int)*slot;
        __syncthreads();
    }
}
template <int S>
DEV void run_gemm_phase(const P& p, int layer, char* smem, unsigned xcc, volatile LAS unsigned* slot) {
    constexpr int reps = (S == REP_STAGE || S == REP_STAGE2) ? REP_N : 1;
#pragma unroll 1
    for (int r = 0; r < reps; ++r) run_gemm_phase1<S>(p, layer, smem, xcc, slot, r);
}
#define GSYNC() xcd_barrier(xb)
__global__ void __launch_bounds__(NTHREADS, 2) k_mega(P p) {
    __shared__ __attribute__((aligned(16))) char smem[SMEM_BYTES];
    __shared__ uint4 xb_words;
    cg::grid_group grid = cg::this_grid();
    if (threadIdx.x == 0) xb_words = make_uint4(0u, 0u, 0u, 0u);
    __syncthreads();
    XcdBarrier xb = xcd_barrier_post(p.bar(), (volatile LAS unsigned*)&xb_words);
    const int H = gridDim.x >> 1, Q = gridDim.x >> 2;
    run_phase<S_ADA>(p, 0, smem); run_phase<S_ROPE>(p, 0, smem, H);
    run_phase<S_CONVT_IN>(p, 0, smem); run_phase<S_CONVT_OUT>(p, 0, smem); run_phase<S_CONVT_Q>(p, 0, smem); run_phase<S_CONVT_W1>(p, 0, smem);
    run_phase<S_TAB_U>(p, 0, smem); run_phase<S_TAB_V>(p, 0, smem);
    grid.sync();
#pragma unroll 1
    for (int layer = 0; layer < NL; ++layer) {
        run_phase<S_NORM1>(p, layer, smem); GSYNC();
        run_gemm_phase<S_GEMM_IN>(p, layer, smem, xb.x, (volatile LAS unsigned*)&xb_words + 2); GSYNC();
        run_dyn_phase<0>(p, layer, smem, (volatile LAS unsigned*)&xb_words + 2); GSYNC();
        run_dyn_phase<1>(p, layer, smem, (volatile LAS unsigned*)&xb_words + 2); GSYNC();
        run_dyn_phase<2>(p, layer, smem, (volatile LAS unsigned*)&xb_words + 2); GSYNC();
        run_gemm_phase<S_GEMM_OUT>(p, layer, smem, xb.x, (volatile LAS unsigned*)&xb_words + 2); GSYNC();
        run_phase<S_NORM2>(p, layer, smem); GSYNC();
        run_gemm_phase<S_GEMM_Q>(p, layer, smem, xb.x, (volatile LAS unsigned*)&xb_words + 2); GSYNC();
        run_phase<S_PEER_TOPK>(p, layer, smem); GSYNC();
        run_phase<S_PEER_GATHER>(p, layer, smem); GSYNC();
    }
}
#else
template <int S>
__global__ void __launch_bounds__(NTHREADS) k_stage(P p, int layer) {
    __shared__ __attribute__((aligned(16))) char smem[SMEM_BYTES];
    run_unit<S>(p, layer, blockIdx.x, smem);
}
template <int S> static void launch_stage(const P& p, int layer, hipStream_t st) {
    hipLaunchKernelGGL((k_stage<S>), dim3(nunits(S)), dim3(NTHREADS), 0, st, p, layer);
}
#endif

extern "C" void kernel_launch(void* const* d_in, const int* in_sizes, int n_in, void* d_out, int out_size, void* d_ws, size_t ws_size, hipStream_t stream) {
    P p{};
    p.x = (const float*)d_in[0]; p.c = (const float*)d_in[1]; p.pos = (const int*)d_in[2]; p.ada_w = (const float*)d_in[3]; p.ada_b = (const float*)d_in[4];
    p.n1g = (const float*)d_in[5]; p.n2g = (const float*)d_in[6]; p.w_in = (const float*)d_in[7]; p.w_out = (const float*)d_in[8]; p.conv_w = (const float*)d_in[9];
    p.conv_b = (const float*)d_in[10]; p.cln_g = (const float*)d_in[11]; p.cln_b = (const float*)d_in[12]; p.sln_g = (const float*)d_in[13]; p.sln_b = (const float*)d_in[14];
    p.sgu_w = (const float*)d_in[15]; p.sgu_b = (const float*)d_in[16]; p.nsa_qg = (const float*)d_in[17]; p.nsa_kg = (const float*)d_in[18]; p.cmp_pos = (const float*)d_in[19];
    p.cmp_w1 = (const float*)d_in[20]; p.cmp_w2 = (const float*)d_in[21]; p.dsa_qg = (const float*)d_in[22]; p.dsa_kg = (const float*)d_in[23]; p.peer_wq = (const float*)d_in[24];
    p.peer_sk = (const float*)d_in[25]; p.peer_u = (const float*)d_in[26]; p.peer_v = (const float*)d_in[27];
    p.out = (float*)d_out;
    p.ws = (char*)d_ws; const size_t off = WS_TOTAL;
    if (off > ws_size) { fprintf(stderr, "workspace too small: need %zu have %zu\n", off, ws_size); return; }
#ifndef MULTI_LAUNCH
    static int grid_blocks = 0;
    if (!grid_blocks) {
        int dev = 0, cus = 0, per_cu = 0;
        (void)hipGetDevice(&dev);
        (void)hipDeviceGetAttribute(&cus, hipDeviceAttributeMultiprocessorCount, dev);
        (void)hipOccupancyMaxActiveBlocksPerMultiprocessor(&per_cu, k_mega, NTHREADS, 0);
        if (per_cu > 2) per_cu = 2;
        grid_blocks = cus * per_cu;
    }
    (void)hipMemsetAsync(p.bar(), 0, (size_t)CTRL_WORDS * 4, stream);
    void* args[] = {&p};
    hipError_t e = hipLaunchCooperativeKernel((void*)k_mega, dim3(grid_blocks), dim3(NTHREADS), args, 0, stream);
    if (e != hipSuccess) fprintf(stderr, "cooperative launch failed: %s (grid %d)\n", hipGetErrorString(e), grid_blocks);
#else
    launch_stage<S_CONVT_IN>(p, 0, stream); launch_stage<S_CONVT_OUT>(p, 0, stream); launch_stage<S_CONVT_Q>(p, 0, stream); launch_stage<S_CONVT_W1>(p, 0, stream);
    launch_stage<S_TAB_U>(p, 0, stream); launch_stage<S_TAB_V>(p, 0, stream);
    launch_stage<S_ADA>(p, 0, stream); launch_stage<S_ROPE>(p, 0, stream);
    for (int layer = 0; layer < NL; ++layer) {
        launch_stage<S_NORM1>(p, layer, stream); launch_stage<S_GEMM_IN>(p, layer, stream);
        launch_stage<S_CONV>(p, layer, stream); launch_stage<S_SGU>(p, layer, stream); launch_stage<S_VTRANS>(p, layer, stream);
        launch_stage<S_PREP>(p, layer, stream); launch_stage<S_COMPRESS>(p, layer, stream);
        launch_stage<S_NSA_CMP>(p, layer, stream); launch_stage<S_DSA_INDEX>(p, layer, stream);
        launch_stage<S_NSA_ATTN>(p, layer, stream); launch_stage<S_DSA_ATTN>(p, layer, stream);
        launch_stage<S_GEMM_OUT>(p, layer, stream); launch_stage<S_NORM2>(p, layer, stream); launch_stage<S_GEMM_Q>(p, layer, stream);
        launch_stage<S_PEER_TOPK>(p, layer, stream); launch_stage<S_PEER_GATHER>(p, layer, stream);
    }
#endif
}
```

```cpp
#include <hip/hip_runtime.h>
#include <hip/hip_cooperative_groups.h>
#include <stdint.h>
#include <cstdio>
namespace cg = cooperative_groups;

typedef unsigned short bf16_t;
typedef short bf16x8 __attribute__((ext_vector_type(8)));
typedef float f32x4 __attribute__((ext_vector_type(4)));
typedef float f32x16 __attribute__((ext_vector_type(16)));
#define DEV __device__ __forceinline__

constexpr int T = 8192, D = 2048, NL = 2;
constexpr int INC = 4692;
constexpr int LDP = 4736;
constexpr int C_CA = 0, C_CG = 512, C_SU = 1024, C_SV = 1536;
constexpr int C_NQ = 2048, C_NKC = 2560, C_NVC = 2688, C_NKS = 2816, C_NVS = 2944, C_NKW = 3072, C_NVW = 3200;
constexpr int C_DQ = 3328, C_DK = 3840, C_DV = 3968, C_IQ = 4096, C_IK = 4608, C_NG = 4672, C_IW = 4688;
constexpr float EPS = 1e-6f;
constexpr int NTHREADS = 256;
constexpr int SMEM_BYTES = 72 * 1024;

__device__ const double INV16[16] = {1.0, 0.44036660267178046, 0.19392274474868576, 0.08539710028576561, 0.03760603093086393,
    0.016560440080994446, 0.007292664737217109, 0.003211445994752591, 0.001414213562373095, 0.000622772421914596,
    0.0002742481756762073, 0.00012076973741146504, 5.318295896944988e-05, 2.341999896140934e-05, 1.031338537721246e-05,
    4.5416704806078695e-06};

#define XCD_BAR_WORDS 3456
#define GQ_WORD(inst, x) (XCD_BAR_WORDS + 64 * ((inst) * 8 + (x)))
#define DQ_WORD(k) (XCD_BAR_WORDS + 64 * (96 + (k)))
#define CTRL_WORDS (XCD_BAR_WORDS + 64 * 112)
constexpr size_t WS_ALIGN(size_t x) { return (x + 255) & ~(size_t)255; }
constexpr size_t OFF_WinT = 0;
constexpr size_t OFF_WoutT = OFF_WinT + WS_ALIGN((size_t)2 * LDP * 2048 * 2);
constexpr size_t OFF_WqT = OFF_WoutT + WS_ALIGN((size_t)2 * 2048 * 2048 * 2);
constexpr size_t OFF_W1T = OFF_WqT + WS_ALIGN((size_t)2 * 1024 * 2048 * 2);
constexpr size_t OFF_Utab = OFF_W1T + WS_ALIGN((size_t)4 * 128 * 4096 * 2);
constexpr size_t OFF_Vtab = OFF_Utab + WS_ALIGN((size_t)2 * 16384 * 2048);
constexpr size_t OFF_ada = OFF_Vtab + WS_ALIGN((size_t)2 * 16384 * 2048);
constexpr size_t OFF_ropeC = OFF_ada + WS_ALIGN((size_t)2 * 12288 * 4);
constexpr size_t OFF_ropeS = OFF_ropeC + WS_ALIGN((size_t)T * 24 * 4);
constexpr size_t OFF_HN = OFF_ropeS + WS_ALIGN((size_t)T * 24 * 4);
constexpr size_t OFF_PROJ = OFF_HN + WS_ALIGN((size_t)T * D * 2);
constexpr size_t OFF_Y = OFF_PROJ + WS_ALIGN((size_t)T * LDP * 2);
constexpr size_t OFF_QN = OFF_Y + WS_ALIGN((size_t)T * D * 2);
constexpr size_t OFF_QR = OFF_QN + WS_ALIGN((size_t)T * 512 * 2);
constexpr size_t OFF_KS = OFF_QR + WS_ALIGN((size_t)T * 512 * 2);
constexpr size_t OFF_KW = OFF_KS + WS_ALIGN((size_t)T * 128 * 2);
constexpr size_t OFF_VST = OFF_KW + WS_ALIGN((size_t)T * 128 * 2);
constexpr size_t OFF_VWT = OFF_VST + WS_ALIGN((size_t)T * 128 * 2);
constexpr size_t OFF_GATES = OFF_VWT + WS_ALIGN((size_t)T * 128 * 2);
constexpr size_t OFF_KC = OFF_GATES + WS_ALIGN((size_t)T * 12 * 4);
constexpr size_t OFF_VCT = OFF_KC + WS_ALIGN((size_t)512 * 128 * 2);
constexpr size_t OFF_SEL = OFF_VCT + WS_ALIGN((size_t)128 * 512 * 2);
constexpr size_t OFF_OCMP = OFF_SEL + WS_ALIGN((size_t)T * 4 * 4);
constexpr size_t OFF_DQ = OFF_OCMP + WS_ALIGN((size_t)T * 512 * 2);
constexpr size_t OFF_DK = OFF_DQ + WS_ALIGN((size_t)T * 512 * 2);
constexpr size_t OFF_IQ = OFF_DK + WS_ALIGN((size_t)T * 128 * 2);
constexpr size_t OFF_IK = OFF_IQ + WS_ALIGN((size_t)T * 512 * 2);
constexpr size_t OFF_IW = OFF_IK + WS_ALIGN((size_t)T * 64 * 2);
constexpr size_t OFF_IDX = OFF_IW + WS_ALIGN((size_t)T * 8 * 4);
constexpr size_t OFF_CNT = OFF_IDX + WS_ALIGN((size_t)T * 256 * 4);
constexpr size_t OFF_X1 = OFF_CNT + WS_ALIGN((size_t)T * 4);
constexpr size_t OFF_X2 = OFF_X1 + WS_ALIGN((size_t)T * D * 4);
constexpr size_t OFF_PQ = OFF_X2 + WS_ALIGN((size_t)T * D * 4);
constexpr size_t OFF_PE = OFF_PQ + WS_ALIGN((size_t)T * 1024 * 4);
constexpr size_t OFF_PG = OFF_PE + WS_ALIGN((size_t)T * 128 * 4);
constexpr size_t OFF_bar = OFF_PG + WS_ALIGN((size_t)T * 128 * 4);
constexpr size_t WS_TOTAL = OFF_bar + WS_ALIGN((size_t)CTRL_WORDS * 4);

struct P {
    const float* x; const float* c; const int* pos; const float* ada_w; const float* ada_b; const float* n1g; const float* n2g;
    const float* w_in; const float* w_out; const float* conv_w; const float* conv_b; const float* cln_g; const float* cln_b;
    const float* sln_g; const float* sln_b; const float* sgu_w; const float* sgu_b; const float* nsa_qg; const float* nsa_kg;
    const float* cmp_pos; const float* cmp_w1; const float* cmp_w2; const float* dsa_qg; const float* dsa_kg;
    const float* peer_wq; const float* peer_sk; const float* peer_u; const float* peer_v;
    float* out;
    char* ws;
    __host__ __device__ __forceinline__ bf16_t* WinT() const { return (bf16_t*)(ws + OFF_WinT); }
    __host__ __device__ __forceinline__ bf16_t* WoutT() const { return (bf16_t*)(ws + OFF_WoutT); }
    __host__ __device__ __forceinline__ bf16_t* WqT() const { return (bf16_t*)(ws + OFF_WqT); }
    __host__ __device__ __forceinline__ bf16_t* W1T() const { return (bf16_t*)(ws + OFF_W1T); }
    __host__ __device__ __forceinline__ unsigned char* Utab() const { return (unsigned char*)(ws + OFF_Utab); }
    __host__ __device__ __forceinline__ unsigned char* Vtab() const { return (unsigned char*)(ws + OFF_Vtab); }
    __host__ __device__ __forceinline__ float* ada() const { return (float*)(ws + OFF_ada); }
    __host__ __device__ __forceinline__ float* ropeC() const { return (float*)(ws + OFF_ropeC); }
    __host__ __device__ __forceinline__ float* ropeS() const { return (float*)(ws + OFF_ropeS); }
    __host__ __device__ __forceinline__ bf16_t* HN() const { return (bf16_t*)(ws + OFF_HN); }
    __host__ __device__ __forceinline__ bf16_t* PROJ() const { return (bf16_t*)(ws + OFF_PROJ); }
    __host__ __device__ __forceinline__ bf16_t* Y() const { return (bf16_t*)(ws + OFF_Y); }
    __host__ __device__ __forceinline__ bf16_t* QN() const { return (bf16_t*)(ws + OFF_QN); }
    __host__ __device__ __forceinline__ bf16_t* QR() const { return (bf16_t*)(ws + OFF_QR); }
    __host__ __device__ __forceinline__ bf16_t* KS() const { return (bf16_t*)(ws + OFF_KS); }
    __host__ __device__ __forceinline__ bf16_t* KW() const { return (bf16_t*)(ws + OFF_KW); }
    __host__ __device__ __forceinline__ bf16_t* VST() const { return (bf16_t*)(ws + OFF_VST); }
    __host__ __device__ __forceinline__ bf16_t* VWT() const { return (bf16_t*)(ws + OFF_VWT); }
    __host__ __device__ __forceinline__ float* GATES() const { return (float*)(ws + OFF_GATES); }
    __host__ __device__ __forceinline__ bf16_t* KC() const { return (bf16_t*)(ws + OFF_KC); }
    __host__ __device__ __forceinline__ bf16_t* VCT() const { return (bf16_t*)(ws + OFF_VCT); }
    __host__ __device__ __forceinline__ unsigned* SEL() const { return (unsigned*)(ws + OFF_SEL); }
    __host__ __device__ __forceinline__ bf16_t* OCMP() const { return (bf16_t*)(ws + OFF_OCMP); }
    __host__ __device__ __forceinline__ bf16_t* DQ() const { return (bf16_t*)(ws + OFF_DQ); }
    __host__ __device__ __forceinline__ bf16_t* DK() const { return (bf16_t*)(ws + OFF_DK); }
    __host__ __device__ __forceinline__ bf16_t* IQ() const { return (bf16_t*)(ws + OFF_IQ); }
    __host__ __device__ __forceinline__ bf16_t* IK() const { return (bf16_t*)(ws + OFF_IK); }
    __host__ __device__ __forceinline__ float* IW() const { return (float*)(ws + OFF_IW); }
    __host__ __device__ __forceinline__ int* IDX() const { return (int*)(ws + OFF_IDX); }
    __host__ __device__ __forceinline__ int* CNT() const { return (int*)(ws + OFF_CNT); }
    __host__ __device__ __forceinline__ float* X1() const { return (float*)(ws + OFF_X1); }
    __host__ __device__ __forceinline__ float* X2() const { return (float*)(ws + OFF_X2); }
    __host__ __device__ __forceinline__ float* PQ() const { return (float*)(ws + OFF_PQ); }
    __host__ __device__ __forceinline__ int* PE() const { return (int*)(ws + OFF_PE); }
    __host__ __device__ __forceinline__ float* PG() const { return (float*)(ws + OFF_PG); }
    __host__ __device__ __forceinline__ unsigned* bar() const { return (unsigned*)(ws + OFF_bar); }
};

DEV float bf2f(bf16_t v) { return __uint_as_float(((unsigned)v) << 16); }
DEV unsigned pk2(float lo, float hi) { unsigned r; asm("v_cvt_pk_bf16_f32 %0, %1, %2" : "=v"(r) : "v"(lo), "v"(hi)); return r; }
DEV bf16_t f2bf(float v) { return (bf16_t)(pk2(v, 0.f) & 0xffffu); }
DEV float lo2f(unsigned u) { return __uint_as_float(u << 16); }
DEV float hi2f(unsigned u) { return __uint_as_float(u & 0xffff0000u); }
DEV float wsum(float v) {
#pragma unroll
    for (int o = 32; o > 0; o >>= 1) v += __shfl_xor(v, o);
    return v;
}
DEV float wmax(float v) {
#pragma unroll
    for (int o = 32; o > 0; o >>= 1) v = fmaxf(v, __shfl_xor(v, o));
    return v;
}
DEV int tidx() { int t = threadIdx.x; asm volatile("" : "+v"(t)); return t; }
DEV float sigmoidf_(float x) { return 1.0f / (1.0f + __expf(-x)); }
DEV float gelu_tanh(float x) {
    const float y = 0.7978845608028654f * (x + 0.044715f * x * x * x);
    const float t = 1.0f - 2.0f / (1.0f + __expf(2.0f * y));
    return 0.5f * x * (1.0f + t);
}
DEV f32x4 mfma16(bf16x8 a, bf16x8 b, f32x4 c) { return __builtin_amdgcn_mfma_f32_16x16x32_bf16(a, b, c, 0, 0, 0); }
DEV f32x16 mfma32(bf16x8 a, bf16x8 b, f32x16 c) { return __builtin_amdgcn_mfma_f32_32x32x16_bf16(a, b, c, 0, 0, 0); }

DEV int src_col(int n) {
    if (n < 3328) return n;
    if (n < 4672) return 3340 + (n - 3328);
    if (n < 4684) return 3328 + (n - 4672);
    if (n < 4688) return -1;
    if (n < 4696) return 4684 + (n - 4688);
    return -1;
}

DEV void st_convT(const float* __restrict__ W, bf16_t* __restrict__ Bt, int N, int Npad, bool remap, int unit, char* smem, int Kdim = 2048) {
    float (*tile)[65] = (float (*)[65])smem;
    const int ntn = Npad / 64, kt = unit / ntn, nt = unit % ntn, k0 = kt * 64, n0 = nt * 64;
    const int tid_ = tidx(); const int tx = tid_ & 63, ty = tid_ >> 6;
    const int n = n0 + tx;
    const int src = remap ? src_col(n) : (n < N ? n : -1);
#pragma unroll
    for (int i = 0; i < 16; ++i) { const int k = ty + 4 * i; tile[k][tx] = src >= 0 ? W[(size_t)(k0 + k) * N + src] : 0.f; }
    __syncthreads();
#pragma unroll
    for (int i = 0; i < 16; ++i) { const int r = ty + 4 * i; Bt[(size_t)(n0 + r) * Kdim + k0 + tx] = f2bf(tile[tx][r]); }
    __syncthreads();
}

typedef float f32x2 __attribute__((ext_vector_type(2)));
DEV void st_tab(const float* __restrict__ src, unsigned char* __restrict__ dst, float scale, size_t n16, int unit, int nunits) {
    const int tid_ = tidx();
    for (size_t g = (size_t)unit * NTHREADS + tid_; g < n16; g += (size_t)nunits * NTHREADS) {
        const float4* sp = (const float4*)src + 4 * g;
        const float4 a = sp[0], b = sp[1], c = sp[2], d = sp[3];
        int w0 = __builtin_amdgcn_cvt_pk_fp8_f32(a.x * scale, a.y * scale, 0, false); w0 = __builtin_amdgcn_cvt_pk_fp8_f32(a.z * scale, a.w * scale, w0, true);
        int w1 = __builtin_amdgcn_cvt_pk_fp8_f32(b.x * scale, b.y * scale, 0, false); w1 = __builtin_amdgcn_cvt_pk_fp8_f32(b.z * scale, b.w * scale, w1, true);
        int w2 = __builtin_amdgcn_cvt_pk_fp8_f32(c.x * scale, c.y * scale, 0, false); w2 = __builtin_amdgcn_cvt_pk_fp8_f32(c.z * scale, c.w * scale, w2, true);
        int w3 = __builtin_amdgcn_cvt_pk_fp8_f32(d.x * scale, d.y * scale, 0, false); w3 = __builtin_amdgcn_cvt_pk_fp8_f32(d.z * scale, d.w * scale, w3, true);
        ((uint4*)dst)[g] = make_uint4((unsigned)w0, (unsigned)w1, (unsigned)w2, (unsigned)w3);
    }
}
constexpr float U8_SCALE = 64.0f, V8_SCALE = 4.0f;

DEV void st_ada(const P& p, int unit, char* smem) {
    float4* red = (float4*)smem;
    const int tid = tidx(), c4 = tid & 15, kg = tid >> 4;
    const int i = unit / 192, j = (unit % 192) * 64 + c4 * 4;
    const float* W = p.ada_w + (size_t)i * 2048 * 12288 + (size_t)kg * 12288 + j;
    float4 acc = make_float4(0.f, 0.f, 0.f, 0.f);
#pragma unroll 8
    for (int k = 0; k < 128; ++k) {
        const float cv = p.c[kg + 16 * k];
        const float a = cv * sigmoidf_(cv);
        const float4 wv = *(const float4*)(W + (size_t)(16 * k) * 12288);
        acc.x += a * wv.x; acc.y += a * wv.y; acc.z += a * wv.z; acc.w += a * wv.w;
    }
    red[kg * 16 + c4] = acc;
    __syncthreads();
    if (tid < 64) {
        const int cc = tid >> 2, e = tid & 3;
        float r = p.ada_b[i * 12288 + (unit % 192) * 64 + tid];
#pragma unroll
        for (int q = 0; q < 16; ++q) r += ((const float*)&red[q * 16 + cc])[e];
        p.ada()[i * 12288 + (unit % 192) * 64 + tid] = r;
    }
    __syncthreads();
}
DEV void st_rope(const P& p, int unit) {
    const int e = unit * 256 + tidx(); const int t = e / 24, i = e % 24;
    const double inv = i < 16 ? INV16[i] : INV16[2 * (i - 16)];
    const double ang = (double)p.pos[t] * inv;
    const double n = rint(ang * 0.15915494309189535);
    const double r = ang - n * 6.283185307179586;
    const double r2 = r * r;
    double sp = 1.0 / 1.5511210043330986e25, cp = -1.0 / 4.0329146112660565e26;
    sp = sp * r2 - 1.0 / 2.585201673888498e22;   cp = cp * r2 + 1.0 / 6.204484017332394e23;
    sp = sp * r2 + 1.0 / 5.109094217170944e19;   cp = cp * r2 - 1.0 / 1.1240007277776077e21;
    sp = sp * r2 - 1.0 / 1.21645100408832e17;    cp = cp * r2 + 1.0 / 2.43290200817664e18;
    sp = sp * r2 + 1.0 / 3.55687428096e14;       cp = cp * r2 - 1.0 / 6.402373705728e15;
    sp = sp * r2 - 1.0 / 1.307674368e12;         cp = cp * r2 + 1.0 / 2.0922789888e13;
    sp = sp * r2 + 1.0 / 6.2270208e9;            cp = cp * r2 - 1.0 / 8.71782912e10;
    sp = sp * r2 - 1.0 / 3.99168e7;              cp = cp * r2 + 1.0 / 4.790016e8;
    sp = sp * r2 + 1.0 / 362880.0;               cp = cp * r2 - 1.0 / 3628800.0;
    sp = sp * r2 - 1.0 / 5040.0;                 cp = cp * r2 + 1.0 / 40320.0;
    sp = sp * r2 + 1.0 / 120.0;                  cp = cp * r2 - 1.0 / 720.0;
    sp = sp * r2 - 1.0 / 6.0;                    cp = cp * r2 + 1.0 / 24.0;
    sp = sp * r2 + 1.0;                          cp = cp * r2 - 0.5;
    cp = cp * r2 + 1.0;
    const float cs = (float)cp, sn = (float)(sp * r);
    p.ropeC()[e] = cs; p.ropeS()[e] = sn;
}

DEV void st_norm(const float* __restrict__ X, const float* __restrict__ g, const float* __restrict__ sc, const float* __restrict__ sh,
                 bf16_t* __restrict__ HN, int unit) {
    const int tid_ = tidx(); const int w = tid_ >> 6, l = tid_ & 63; const int t = unit * 4 + w;
    const float4* xr = (const float4*)(X + (size_t)t * D);
    float4 v[8]; float ss = 0.f;
#pragma unroll
    for (int i = 0; i < 4; ++i) { v[2 * i] = xr[i * 128 + l * 2]; v[2 * i + 1] = xr[i * 128 + l * 2 + 1]; }
#pragma unroll
    for (int i = 0; i < 8; ++i) ss += v[i].x * v[i].x + v[i].y * v[i].y + v[i].z * v[i].z + v[i].w * v[i].w;
    ss = wsum(ss);
    const float rs = rsqrtf(ss * (1.0f / 2048.0f) + EPS);
#pragma unroll
    for (int i = 0; i < 4; ++i) {
        const int col = i * 512 + l * 8;
        float y[8]; const float xv[8] = {v[2 * i].x, v[2 * i].y, v[2 * i].z, v[2 * i].w, v[2 * i + 1].x, v[2 * i + 1].y, v[2 * i + 1].z, v[2 * i + 1].w};
#pragma unroll
        for (int j = 0; j < 8; ++j) y[j] = (xv[j] * rs) * g[col + j] * (1.0f + sc[col + j]) + sh[col + j];
        uint4 o; o.x = pk2(y[0], y[1]); o.y = pk2(y[2], y[3]); o.z = pk2(y[4], y[5]); o.w = pk2(y[6], y[7]);
        *(uint4*)(HN + (size_t)t * D + col) = o;
    }
}

enum { EPI_PROJ = 0, EPI_OUT = 1, EPI_Q = 2 };
struct EpiArgs { bf16_t* obf; float* of; const float* xin; const float* gate; };
template <int EPI>
DEV void st_gemm(const bf16_t* __restrict__ A, const bf16_t* __restrict__ Bt, int K, int tm, int tn, const EpiArgs& e, char* smem) {
    const int tid = tidx(), w = tid >> 6, l = tid & 63, wr = w >> 1, wc = w & 1;
    f32x4 acc[4][4];
#pragma unroll
    for (int m = 0; m < 4; ++m)
#pragma unroll
        for (int n = 0; n < 4; ++n) acc[m][n] = (f32x4){0.f, 0.f, 0.f, 0.f};
    const int srow = tid >> 2, spc = tid & 3, sc = spc ^ (((srow >> 2) & 1) << 1);
    const bf16_t* Ag = A + (size_t)(tm * 128 + srow) * K + sc * 8;
    const bf16_t* Bg = Bt + (size_t)(tn * 128 + srow) * K + sc * 8;
#define GEMM_STAGE(BUF, KO) do { char* _b = smem + (BUF) * 16384 + tid * 16; \
        __builtin_amdgcn_global_load_lds((const unsigned*)(Ag + (KO)), (__attribute__((address_space(3))) unsigned*)(_b), 16, 0, 0); \
        __builtin_amdgcn_global_load_lds((const unsigned*)(Ag + (size_t)64 * K + (KO)), (__attribute__((address_space(3))) unsigned*)(_b + 4096), 16, 0, 0); \
        __builtin_amdgcn_global_load_lds((const unsigned*)(Bg + (KO)), (__attribute__((address_space(3))) unsigned*)(_b + 8192), 16, 0, 0); \
        __builtin_amdgcn_global_load_lds((const unsigned*)(Bg + (size_t)64 * K + (KO)), (__attribute__((address_space(3))) unsigned*)(_b + 12288), 16, 0, 0); } while (0)
    const int nk = K / 32;
    GEMM_STAGE(0, 0); GEMM_STAGE(1, 32); GEMM_STAGE(2, 64);
    asm volatile("s_waitcnt vmcnt(8)" ::: "memory");
    __builtin_amdgcn_s_barrier();
    const int fr = l & 15, fq = l >> 4;
#pragma unroll 1
    for (int kt = 0; kt < nk; ++kt) {
        if (kt + 3 < nk) GEMM_STAGE((kt + 3) & 3, (kt + 3) * 32);
        const char* As = smem + (kt & 3) * 16384; const char* Bs = As + 8192;
        bf16x8 af[4], bfr[4];
#pragma unroll
        for (int m = 0; m < 4; ++m) { const int row = wr * 64 + m * 16 + fr; af[m] = *(const bf16x8*)(As + row * 64 + ((fq ^ (((row >> 2) & 1) << 1)) << 4)); }
#pragma unroll
        for (int n = 0; n < 4; ++n) { const int row = wc * 64 + n * 16 + fr; bfr[n] = *(const bf16x8*)(Bs + row * 64 + ((fq ^ (((row >> 2) & 1) << 1)) << 4)); }
#pragma unroll
        for (int m = 0; m < 4; ++m)
#pragma unroll
            for (int n = 0; n < 4; ++n) acc[m][n] = mfma16(bfr[n], af[m], acc[m][n]);
        if (kt + 3 < nk) asm volatile("s_waitcnt vmcnt(8)" ::: "memory");
        else if (kt + 2 < nk) asm volatile("s_waitcnt vmcnt(4)" ::: "memory");
        else asm volatile("s_waitcnt vmcnt(0)" ::: "memory");
        asm volatile("s_waitcnt lgkmcnt(0)" ::: "memory");
        __builtin_amdgcn_s_barrier();
    }
#undef GEMM_STAGE
#pragma unroll
    for (int m = 0; m < 4; ++m) {
        const int row = tm * 128 + wr * 64 + m * 16 + (l & 15);
#pragma unroll
        for (int n = 0; n < 4; ++n) {
            const int col = tn * 128 + wc * 64 + n * 16 + 4 * (l >> 4);
            const f32x4 a = acc[m][n];
            if (EPI == EPI_PROJ) {
                uint2 o; o.x = pk2(a[0], a[1]); o.y = pk2(a[2], a[3]);
                *(uint2*)(e.obf + (size_t)row * LDP + col) = o;
            } else if (EPI == EPI_OUT) {
                const float4 xi = *(const float4*)(e.xin + (size_t)row * D + col);
                const float4 gg = *(const float4*)(e.gate + col);
                float4 o; o.x = xi.x + gg.x * a[0]; o.y = xi.y + gg.y * a[1]; o.z = xi.z + gg.z * a[2]; o.w = xi.w + gg.w * a[3];
                *(float4*)(e.of + (size_t)row * D + col) = o;
            } else {
                float4 o; o.x = a[0]; o.y = a[1]; o.z = a[2]; o.w = a[3];
                *(float4*)(e.of + (size_t)row * 1024 + col) = o;
            }
        }
    }
    __syncthreads();
}

DEV void st_conv(const P& p, int layer, int unit, char* smem) {
    float* cs = (float*)smem;
    const int tid = tidx(), t0 = unit * 16;
    const float* cw = p.conv_w + (size_t)layer * 31 * 512;
#pragma unroll 1
    for (int cc = 0; cc < 2; ++cc) {
        const int c = tid + 256 * cc;
        float w[31], z[46];
#pragma unroll
        for (int k = 0; k < 31; ++k) w[k] = cw[k * 512 + c];
#pragma unroll
        for (int r = 0; r < 46; ++r) {
            const int t = t0 - 30 + r;
            float zz = 0.f;
            if (t >= 0) {
                const float a = bf2f(p.PROJ()[(size_t)t * LDP + C_CA + c]), g = bf2f(p.PROJ()[(size_t)t * LDP + C_CG + c]);
                zz = a * sigmoidf_(g);
            }
            z[r] = zz;
        }
        const float cb = p.conv_b[layer * 512 + c];
#pragma unroll
        for (int tt = 0; tt < 16; ++tt) {
            float acc = cb;
#pragma unroll
            for (int k = 0; k < 31; ++k) acc += w[k] * z[tt + k];
            cs[tt * 512 + c] = acc;
        }
    }
    __syncthreads();
    const int w = tid >> 6, l = tid & 63;
    const float* lg = p.cln_g + layer * 512; const float* lb = p.cln_b + layer * 512;
#pragma unroll 1
    for (int q = 0; q < 4; ++q) {
        const int tt = w * 4 + q;
        float v[8]; float s = 0.f;
#pragma unroll
        for (int i = 0; i < 8; ++i) { v[i] = cs[tt * 512 + l + 64 * i]; s += v[i]; }
        const float mean = wsum(s) * (1.0f / 512.0f);
        float q2 = 0.f;
#pragma unroll
        for (int i = 0; i < 8; ++i) { const float d = v[i] - mean; q2 += d * d; }
        const float rstd = rsqrtf(wsum(q2) * (1.0f / 512.0f) + EPS);
#pragma unroll
        for (int i = 0; i < 8; ++i) {
            const int c = l + 64 * i;
            const float y = (v[i] - mean) * rstd * lg[c] + lb[c];
            p.Y()[(size_t)(t0 + tt) * D + c] = f2bf(y * sigmoidf_(y));
        }
    }
    __syncthreads();
}

DEV void st_sgu(const P& p, int layer, int unit, char* smem) {
    const int n = unit >> 2, h = unit & 3, tid = tidx(), w = tid >> 6, l = tid & 63;
    float* stat = (float*)smem;
    float* wt = stat + 256;
    float* vt = wt + 16 * 132;
    const int tb = n * 128;
#pragma unroll 1
    for (int q = 0; q < 32; ++q) {
        const int j = w * 32 + q;
        const uint4 raw = *(const uint4*)(p.PROJ() + (size_t)(tb + j) * LDP + C_SV + l * 8);
        float v[8] = {lo2f(raw.x), hi2f(raw.x), lo2f(raw.y), hi2f(raw.y), lo2f(raw.z), hi2f(raw.z), lo2f(raw.w), hi2f(raw.w)};
        float s = 0.f;
#pragma unroll
        for (int i = 0; i < 8; ++i) s += v[i];
        const float mean = wsum(s) * (1.0f / 512.0f);
        float q2 = 0.f;
#pragma unroll
        for (int i = 0; i < 8; ++i) { const float d = v[i] - mean; q2 += d * d; }
        const float rstd = rsqrtf(wsum(q2) * (1.0f / 512.0f) + EPS);
        if (l == 0) { stat[j * 2] = mean; stat[j * 2 + 1] = rstd; }
    }
    __syncthreads();
    const int ti = tid >> 4, td = tid & 15;
    float acc[8][8];
#pragma unroll
    for (int a = 0; a < 8; ++a)
#pragma unroll
        for (int b = 0; b < 8; ++b) acc[a][b] = 0.f;
    const float* Wh = p.sgu_w + ((size_t)layer * 4 + h) * 128 * 128;
    const float* lg = p.sln_g + layer * 512 + h * 128; const float* lb = p.sln_b + layer * 512 + h * 128;
#pragma unroll 1
    for (int jc = 0; jc < 8; ++jc) {
#pragma unroll 2
        for (int q = 0; q < 8; ++q) {
            const int e = tid + 256 * q;
            { const int i = e >> 4, jj = e & 15, j = jc * 16 + jj; wt[jj * 132 + i] = (i >= j) ? Wh[i * 128 + j] : 0.f; }
            { const int jj = e >> 7, d = e & 127, j = jc * 16 + jj;
              const float x = bf2f(p.PROJ()[(size_t)(tb + j) * LDP + C_SV + h * 128 + d]);
              vt[jj * 128 + d] = (x - stat[j * 2]) * stat[j * 2 + 1] * lg[d] + lb[d]; }
        }
        __syncthreads();
        if (w * 32 + 31 >= jc * 16) {
#pragma unroll 2
            for (int jj = 0; jj < 16; ++jj) {
                const float4 w0 = *(const float4*)(wt + jj * 132 + ti * 8), w1 = *(const float4*)(wt + jj * 132 + ti * 8 + 4);
                const float4 v0 = *(const float4*)(vt + jj * 128 + td * 8), v1 = *(const float4*)(vt + jj * 128 + td * 8 + 4);
                const float wv[8] = {w0.x, w0.y, w0.z, w0.w, w1.x, w1.y, w1.z, w1.w};
                const float vv[8] = {v0.x, v0.y, v0.z, v0.w, v1.x, v1.y, v1.z, v1.w};
#pragma unroll
                for (int a = 0; a < 8; ++a)
#pragma unroll
                    for (int b = 0; b < 8; ++b) acc[a][b] += wv[a] * vv[b];
            }
        }
        __syncthreads();
    }
#pragma unroll
    for (int a = 0; a < 8; ++a) {
        const int i = ti * 8 + a; const size_t t = tb + i;
        const float bs = p.sgu_b[((size_t)layer * 4 + h) * 128 + i];
        const uint4 ur = *(const uint4*)(p.PROJ() + t * LDP + C_SU + h * 128 + td * 8);
        const float u[8] = {lo2f(ur.x), hi2f(ur.x), lo2f(ur.y), hi2f(ur.y), lo2f(ur.z), hi2f(ur.z), lo2f(ur.w), hi2f(ur.w)};
        float y[8];
#pragma unroll
        for (int b = 0; b < 8; ++b) y[b] = u[b] * (acc[a][b] + bs);
        uint4 o; o.x = pk2(y[0], y[1]); o.y = pk2(y[2], y[3]); o.z = pk2(y[4], y[5]); o.w = pk2(y[6], y[7]);
        *(uint4*)(p.Y() + t * D + 512 + h * 128 + td * 8) = o;
    }
}

DEV void st_vtrans(const P& p, int unit, char* smem) {
    bf16_t* tile = (bf16_t*)smem;
    const int which = unit & 1, tt0 = (unit >> 1) * 64, tid = tidx();
    const int col0 = which ? C_NVW : C_NVS;
    bf16_t* dst = which ? p.VWT() : p.VST();
#pragma unroll
    for (int q = 0; q < 4; ++q) {
        const int e = tid + 256 * q; const int r = e >> 4, c8 = e & 15;
        const uint4 raw = *(const uint4*)(p.PROJ() + (size_t)(tt0 + r) * LDP + col0 + c8 * 8);
        unsigned* d32 = (unsigned*)(tile + r * 130 + c8 * 8);
        d32[0] = raw.x; d32[1] = raw.y; d32[2] = raw.z; d32[3] = raw.w;
    }
    __syncthreads();
    const int d = tid >> 1, half = tid & 1;
    unsigned o[16];
#pragma unroll
    for (int i = 0; i < 16; ++i) {
        const unsigned a = tile[(half * 32 + 2 * i) * 130 + d], b = tile[(half * 32 + 2 * i + 1) * 130 + d];
        o[i] = a | (b << 16);
    }
    uint4* dp = (uint4*)(dst + (size_t)d * T + tt0 + half * 32);
#pragma unroll
    for (int i = 0; i < 4; ++i) dp[i] = make_uint4(o[4 * i], o[4 * i + 1], o[4 * i + 2], o[4 * i + 3]);
    __syncthreads();
}

DEV void st_prep(const P& p, int layer, int unit) {
    const int tid_ = tidx(); const int w = tid_ >> 6, l = tid_ & 63; const size_t t = (size_t)unit * 4 + w;
    const bf16_t* row = p.PROJ() + t * LDP;
    const float* rc = p.ropeC() + t * 24; const float* rs_ = p.ropeS() + t * 24;
    unsigned raw[11];
#pragma unroll
    for (int h = 0; h < 4; ++h) { raw[h] = *(const unsigned*)(row + C_NQ + h * 128 + 2 * l); raw[6 + h] = *(const unsigned*)(row + C_DQ + h * 128 + 2 * l); }
    raw[4] = *(const unsigned*)(row + C_NKS + 2 * l); raw[5] = *(const unsigned*)(row + C_NKW + 2 * l); raw[10] = *(const unsigned*)(row + C_DK + 2 * l);
    bf16_t iraw[9];
#pragma unroll
    for (int h = 0; h < 9; ++h) iraw[h] = row[(h < 8 ? C_IQ + h * 64 : C_IK) + l];
    const float gq0 = p.nsa_qg[layer * 128 + 2 * l], gq1 = p.nsa_qg[layer * 128 + 2 * l + 1];
    const float gs0 = p.nsa_kg[(layer * 3 + 1) * 128 + 2 * l], gs1 = p.nsa_kg[(layer * 3 + 1) * 128 + 2 * l + 1];
    const float gw0 = p.nsa_kg[(layer * 3 + 2) * 128 + 2 * l], gw1 = p.nsa_kg[(layer * 3 + 2) * 128 + 2 * l + 1];
    const float dq0 = p.dsa_qg[layer * 128 + 2 * l], dq1 = p.dsa_qg[layer * 128 + 2 * l + 1];
    const float dk0 = p.dsa_kg[layer * 128 + 2 * l], dk1 = p.dsa_kg[layer * 128 + 2 * l + 1];
    const float c0 = rc[(2 * l) & 15], c1 = rc[(2 * l + 1) & 15], s0 = rs_[(2 * l) & 15], s1 = rs_[(2 * l + 1) & 15];
    const float ic = rc[16 + (l & 7)], is = rs_[16 + (l & 7)];
    float x0[11], x1[11], ss[11];
#pragma unroll
    for (int h = 0; h < 11; ++h) { x0[h] = lo2f(raw[h]); x1[h] = hi2f(raw[h]); ss[h] = x0[h] * x0[h] + x1[h] * x1[h]; }
#pragma unroll
    for (int o = 32; o > 0; o >>= 1)
#pragma unroll
        for (int h = 0; h < 11; ++h) ss[h] += __shfl_xor(ss[h], o);
#pragma unroll
    for (int h = 0; h < 11; ++h) {
        const float r = rsqrtf(ss[h] * (1.0f / 128.0f) + EPS);
        const float g0 = h < 4 ? gq0 : (h == 4 ? gs0 : (h == 5 ? gw0 : (h < 10 ? dq0 : dk0)));
        const float g1 = h < 4 ? gq1 : (h == 4 ? gs1 : (h == 5 ? gw1 : (h < 10 ? dq1 : dk1)));
        const float n0 = x0[h] * r * g0, n1 = x1[h] * r * g1;
        const float o0 = __shfl_xor(n0, 8), o1 = __shfl_xor(n1, 8);
        float r0 = n0, r1 = n1;
        if (l < 8) { r0 = n0 * c0 - o0 * s0; r1 = n1 * c1 - o1 * s1; }
        else if (l < 16) { r0 = n0 * c0 + o0 * s0; r1 = n1 * c1 + o1 * s1; }
        const unsigned roped = pk2(r0, r1);
        if (h < 4) { *(unsigned*)(p.QN() + (t * 4 + h) * 128 + 2 * l) = pk2(n0, n1); *(unsigned*)(p.QR() + (t * 4 + h) * 128 + 2 * l) = roped; }
        else if (h == 4) *(unsigned*)(p.KS() + t * 128 + 2 * l) = roped;
        else if (h == 5) *(unsigned*)(p.KW() + t * 128 + 2 * l) = roped;
        else if (h < 10) *(unsigned*)(p.DQ() + (t * 4 + (h - 6)) * 128 + 2 * l) = roped;
        else *(unsigned*)(p.DK() + t * 128 + 2 * l) = roped;
    }
    if (l < 12) p.GATES()[t * 12 + l] = sigmoidf_(bf2f(row[C_NG + l]));
#pragma unroll
    for (int h = 0; h < 9; ++h) {
        const float x = bf2f(iraw[h]);
        const float other = __shfl_xor(x, 8);
        float o = x;
        if (l < 16) o = (l < 8) ? (x * ic - other * is) : (x * ic + other * is);
        if (h < 8) p.IQ()[(t * 8 + h) * 64 + l] = f2bf(o); else p.IK()[t * 64 + l] = f2bf(o);
    }
    if (l < 8) p.IW()[t * 8 + l] = bf2f(row[C_IW + l]) * (0.35355339059327373f * 0.125f);
}

DEV void st_compress(const P& p, int layer, int unit, char* smem) {
    const int which = unit & 1, rt = unit >> 1, tid = tidx(), w = tid >> 6, l = tid & 63, fr = l & 15, fq = l >> 4;
    float* hid = (float*)smem;
    float* ob = hid + 16 * 128;
    const int nb = rt * 16 + fr;
    const int col0 = which ? C_NVC : C_NKC;
    const float* ps = p.cmp_pos + ((size_t)layer * 2 + which) * 4096;
    const bf16_t* w1t = p.W1T() + ((size_t)layer * 2 + which) * 128 * 4096;
    const bool rowok = nb < 511;
    const bf16_t* xrow = p.PROJ() + (size_t)(rowok ? nb * 16 : 0) * LDP + col0;
    f32x4 acc[2] = {(f32x4){0.f, 0.f, 0.f, 0.f}, (f32x4){0.f, 0.f, 0.f, 0.f}};
#pragma unroll 4
    for (int ks = 0; ks < 128; ++ks) {
        const int k = ks * 32 + fq * 8, lt = k >> 7, d = k & 127;
        const uint4 xr = *(const uint4*)(xrow + (size_t)lt * LDP + d);
        const float4 p0 = *(const float4*)(ps + k), p1 = *(const float4*)(ps + k + 4);
        union { bf16x8 v; unsigned u32[4]; } a;
        a.u32[0] = pk2(lo2f(xr.x) + p0.x, hi2f(xr.x) + p0.y); a.u32[1] = pk2(lo2f(xr.y) + p0.z, hi2f(xr.y) + p0.w);
        a.u32[2] = pk2(lo2f(xr.z) + p1.x, hi2f(xr.z) + p1.y); a.u32[3] = pk2(lo2f(xr.w) + p1.z, hi2f(xr.w) + p1.w);
#pragma unroll
        for (int nt = 0; nt < 2; ++nt) {
            const bf16x8 b = *(const bf16x8*)(w1t + (size_t)(w * 32 + nt * 16 + fr) * 4096 + k);
            acc[nt] = mfma16(a.v, b, acc[nt]);
        }
    }
#pragma unroll
    for (int nt = 0; nt < 2; ++nt)
#pragma unroll
        for (int r = 0; r < 4; ++r) hid[(4 * fq + r) * 128 + w * 32 + nt * 16 + fr] = gelu_tanh(acc[nt][r]);
    __syncthreads();
    const float* w2 = p.cmp_w2 + ((size_t)layer * 2 + which) * 128 * 128;
    const int c2 = tid & 127, mh = tid >> 7;
    float o[8];
#pragma unroll
    for (int b = 0; b < 8; ++b) o[b] = 0.f;
#pragma unroll 4
    for (int k = 0; k < 128; ++k) {
        const float wv = w2[k * 128 + c2];
#pragma unroll
        for (int b = 0; b < 8; ++b) o[b] += hid[(mh * 8 + b) * 128 + k] * wv;
    }
#pragma unroll
    for (int b = 0; b < 8; ++b) ob[(mh * 8 + b) * 128 + c2] = o[b];
    __syncthreads();
#pragma unroll
    for (int q = 0; q < 4; ++q) {
        const int b = w * 4 + q, nbo = rt * 16 + b;
        float v0 = ob[b * 128 + l], v1 = ob[b * 128 + l + 64];
        if (which == 0) {
            const float r = rsqrtf(wsum(v0 * v0 + v1 * v1) * (1.0f / 128.0f) + EPS);
            const float* kg = p.nsa_kg + (layer * 3 + 0) * 128;
            v0 = v0 * r * kg[l]; v1 = v1 * r * kg[l + 64];
            if (nbo >= 511) { v0 = 0.f; v1 = 0.f; }
            p.KC()[nbo * 128 + l] = f2bf(v0); p.KC()[nbo * 128 + l + 64] = f2bf(v1);
        } else {
            if (nbo >= 511) { v0 = 0.f; v1 = 0.f; }
            p.VCT()[l * 512 + nbo] = f2bf(v0); p.VCT()[(l + 64) * 512 + nbo] = f2bf(v1);
        }
    }
    __syncthreads();
}

DEV void st_nsa_cmp(const P& p, int unit, char* smem) {
    constexpr int RSK = 272, RSV = 136, BUFB = 64 * RSK + 128 * RSV;
    const int tid = tidx(), w = tid >> 6, l = tid & 63, qc = l & 15, g4 = l >> 4;
    const int t0 = unit * 16 + w * 4;
    const int tk = qc >> 2, hd = qc & 3, t = t0 + tk;
    bf16x8 qf[4];
#pragma unroll
    for (int ks = 0; ks < 4; ++ks) qf[ks] = *(const bf16x8*)(p.QN() + ((size_t)t0 * 4 + qc) * 128 + ks * 32 + g4 * 8);
    const int tmaxb = unit * 16 + 15;
    const int nvb = tmaxb >= 31 ? (tmaxb - 31) / 16 + 1 : 0;
    const int nsteps = (nvb + 63) >> 6;
    const int nvis = t >= 31 ? (t - 31) / 16 + 1 : 0;
    const float cs = 0.08838834764831845f * 1.4426950408889634f;
    const int krow = tid >> 4, kc16 = tid & 15, vrow = tid >> 3, vc16 = tid & 7;
    const bf16_t* Kg = p.KC(); const bf16_t* Vg = p.VCT();
    int gstep = 0;
    uint4 rk0, rk1, rk2, rk3, rv0, rv1, rv2, rv3;
#define CMP_LOADK(ST) do { const bf16_t* kb = Kg + (size_t)((ST) * 64 + krow) * 128 + kc16 * 8; \
        rk0 = *(const uint4*)kb; rk1 = *(const uint4*)(kb + 16 * 128); rk2 = *(const uint4*)(kb + 32 * 128); rk3 = *(const uint4*)(kb + 48 * 128); } while (0)
#define CMP_LOADV(ST) do { const bf16_t* vb = Vg + (size_t)vrow * 512 + (ST) * 64 + vc16 * 8; \
        rv0 = *(const uint4*)vb; rv1 = *(const uint4*)(vb + 32 * 512); rv2 = *(const uint4*)(vb + 64 * 512); rv3 = *(const uint4*)(vb + 96 * 512); } while (0)
#define CMP_STOREK(KT) do { *(uint4*)((KT) + krow * RSK + kc16 * 16) = rk0; *(uint4*)((KT) + (krow + 16) * RSK + kc16 * 16) = rk1; \
        *(uint4*)((KT) + (krow + 32) * RSK + kc16 * 16) = rk2; *(uint4*)((KT) + (krow + 48) * RSK + kc16 * 16) = rk3; } while (0)
#define CMP_STOREV(VT) do { *(uint4*)((VT) + vrow * RSV + vc16 * 16) = rv0; *(uint4*)((VT) + (vrow + 32) * RSV + vc16 * 16) = rv1; \
        *(uint4*)((VT) + (vrow + 64) * RSV + vc16 * 16) = rv2; *(uint4*)((VT) + (vrow + 96) * RSV + vc16 * 16) = rv3; } while (0)
    float m = -1e30f, lsum = 0.f;
    if (nsteps > 0) CMP_LOADK(0);
#pragma unroll 1
    for (int st = 0; st < nsteps; ++st, ++gstep) {
        char* Kt = smem + (gstep & 1) * BUFB;
        CMP_STOREK(Kt);
        __syncthreads();
        if (st + 1 < nsteps) CMP_LOADK(st + 1);
        float mx = m; f32x4 sv[4];
#pragma unroll
        for (int sub = 0; sub < 4; ++sub) {
            f32x4 a4 = (f32x4){0.f, 0.f, 0.f, 0.f};
#pragma unroll
            for (int ks = 0; ks < 4; ++ks) a4 = mfma16(*(const bf16x8*)(Kt + (sub * 16 + qc) * RSK + (ks * 32 + g4 * 8) * 2), qf[ks], a4);
#pragma unroll
            for (int r = 0; r < 4; ++r) { const int key = st * 64 + sub * 16 + 4 * g4 + r; a4[r] = (key < nvis) ? a4[r] * cs : -3e38f; mx = fmaxf(mx, a4[r]); }
            sv[sub] = a4;
        }
        float ps = 0.f;
#pragma unroll
        for (int sub = 0; sub < 4; ++sub)
#pragma unroll
            for (int r = 0; r < 4; ++r) ps += __builtin_amdgcn_exp2f(sv[sub][r] - mx);
        lsum = lsum * __builtin_amdgcn_exp2f(m - mx) + ps; m = mx;
    }
    {
        float mt_ = fmaxf(m, __shfl_xor(m, 16)); mt_ = fmaxf(mt_, __shfl_xor(mt_, 32));
        lsum *= __builtin_amdgcn_exp2f(m - mt_); m = mt_;
        lsum += __shfl_xor(lsum, 16); lsum += __shfl_xor(lsum, 32);
    }
    const float inv = (nvis > 0 && lsum > 0.f) ? 1.0f / lsum : 0.f;
    f32x4 o[8];
#pragma unroll
    for (int mt = 0; mt < 8; ++mt) o[mt] = (f32x4){0.f, 0.f, 0.f, 0.f};
    float yprev = 0.f;
    float impv[32];
#pragma unroll
    for (int i = 0; i < 32; ++i) impv[i] = 0.f;
    if (nsteps > 0) { CMP_LOADK(0); CMP_LOADV(0); }
#pragma unroll
    for (int st = 0; st < 8; ++st) {
        if (st < nsteps) {
            char* Kt = smem + (gstep & 1) * BUFB; char* Vt = Kt + 64 * RSK; ++gstep;
            CMP_STOREK(Kt); CMP_STOREV(Vt);
            __syncthreads();
            if (st + 1 < nsteps) { CMP_LOADK(st + 1); CMP_LOADV(st + 1); }
            f32x4 sv[4];
#pragma unroll
            for (int sub = 0; sub < 4; ++sub) {
                f32x4 a4 = (f32x4){0.f, 0.f, 0.f, 0.f};
#pragma unroll
                for (int ks = 0; ks < 4; ++ks) a4 = mfma16(*(const bf16x8*)(Kt + (sub * 16 + qc) * RSK + (ks * 32 + g4 * 8) * 2), qf[ks], a4);
#pragma unroll
                for (int r = 0; r < 4; ++r) { const int key = st * 64 + sub * 16 + 4 * g4 + r; a4[r] = (key < nvis) ? __builtin_amdgcn_exp2f(a4[r] * cs - m) * inv : 0.f; }
                const float y = __shfl(a4[3], (l + 48) & 63);
                float iv = (a4[0] + a4[1]) + (a4[2] + a4[3]) + (g4 > 0 ? y : yprev);
                yprev = y;
                iv += __shfl_xor(iv, 1); iv += __shfl_xor(iv, 2);
                impv[st * 4 + sub] = iv;
                sv[sub] = a4;
            }
#pragma unroll
            for (int pr = 0; pr < 2; ++pr) {
                union { bf16x8 v; unsigned u32[4]; } bb;
                bb.u32[0] = pk2(sv[2 * pr][0], sv[2 * pr][1]); bb.u32[1] = pk2(sv[2 * pr][2], sv[2 * pr][3]);
                bb.u32[2] = pk2(sv[2 * pr + 1][0], sv[2 * pr + 1][1]); bb.u32[3] = pk2(sv[2 * pr + 1][2], sv[2 * pr + 1][3]);
#pragma unroll
                for (int mt = 0; mt < 8; ++mt) {
                    const char* vp = Vt + (mt * 16 + qc) * RSV + (pr * 32 + 4 * g4) * 2;
                    union { bf16x8 v; uint2 h2[2]; } aa;
                    aa.h2[0] = *(const uint2*)vp; aa.h2[1] = *(const uint2*)(vp + 32);
                    o[mt] = mfma16(aa.v, bb.v, o[mt]);
                }
            }
        }
    }
#undef CMP_LOADK
#undef CMP_LOADV
#undef CMP_STOREK
#undef CMP_STOREV
    __syncthreads();
    float* impl = (float*)smem + w * 512;
    if (hd == 0) {
#pragma unroll
        for (int i = 0; i < 32; ++i) impl[tk * 128 + 4 * i + g4] = impv[i];
    }
#pragma unroll
    for (int mt = 0; mt < 8; ++mt) {
        uint2 ov; ov.x = pk2(o[mt][0], o[mt][1]); ov.y = pk2(o[mt][2], o[mt][3]);
        *(uint2*)(p.OCMP() + ((size_t)t * 4 + hd) * 128 + mt * 16 + 4 * g4) = ov;
    }
    __syncthreads();
    const int li = hd + 4 * g4, cur = t >> 6;
    unsigned long long own[8]; int rank[8];
#pragma unroll
    for (int i = 0; i < 8; ++i) {
        const int j = li + 16 * i; const float v = impl[tk * 128 + j];
        const unsigned k32 = (j == 0 || j == cur || j == cur - 1) ? 0xFFFFFFFFu : (j > cur ? 0u : __float_as_uint(v) + 128u);
        own[i] = ((unsigned long long)k32 << 7) | (unsigned)(127 - j); rank[i] = 0;
    }
#pragma unroll 1
    for (int ip = 0; ip < 8; ++ip) {
#pragma unroll
        for (int q4 = 0; q4 < 4; ++q4) {
            const float4 ov = *(const float4*)(impl + tk * 128 + ip * 16 + q4 * 4);
            const float o4[4] = {ov.x, ov.y, ov.z, ov.w};
#pragma unroll
            for (int e = 0; e < 4; ++e) {
                const int jp = ip * 16 + q4 * 4 + e;
                const unsigned k32 = (jp == 0 || jp == cur || jp == cur - 1) ? 0xFFFFFFFFu : (jp > cur ? 0u : __float_as_uint(o4[e]) + 128u);
                const unsigned long long kp = ((unsigned long long)k32 << 7) | (unsigned)(127 - jp);
#pragma unroll
                for (int i = 0; i < 8; ++i) rank[i] += (kp > own[i]) ? 1 : 0;
            }
        }
    }
    unsigned mw[4] = {0u, 0u, 0u, 0u};
#pragma unroll
    for (int i = 0; i < 8; ++i) if (rank[i] < 16) mw[i >> 1] |= 1u << (li + 16 * (i & 1));
#pragma unroll
    for (int q = 0; q < 4; ++q) {
        unsigned v = mw[q];
        v |= __shfl_xor(v, 1); v |= __shfl_xor(v, 2); v |= __shfl_xor(v, 16); v |= __shfl_xor(v, 32);
        mw[q] = v;
    }
    if (li == 0) *(uint4*)(p.SEL() + (size_t)t * 4) = make_uint4(mw[0], mw[1], mw[2], mw[3]);
    __syncthreads();
}

DEV void st_nsa_attn(const P& p, int unit, char* smem) {
    constexpr int RSK = 272, RSV = 136, BUFB = 64 * RSK + 128 * RSV;
    const int tid = tidx(), w = tid >> 6, l = tid & 63, qc = l & 15, g4 = l >> 4;
    const int tq0 = unit * 16, t = tq0 + w * 4 + (qc >> 2), hd = qc & 3;
    bf16x8 qf[4];
#pragma unroll
    for (int ks = 0; ks < 4; ++ks) qf[ks] = *(const bf16x8*)(p.QR() + ((size_t)t * 4 + hd) * 128 + ks * 32 + g4 * 8);
    const uint4 selw = *(const uint4*)(p.SEL() + (size_t)t * 4);
    const float cs = 0.08838834764831845f * 1.4426950408889634f;
    unsigned part[8][2];
#pragma unroll
    for (int mt = 0; mt < 8; ++mt) { part[mt][0] = 0u; part[mt][1] = 0u; }
    const float g0 = p.GATES()[(size_t)t * 12 + hd * 3];
    int gstep = 0;
    const int krow = tid >> 4, kc16 = tid & 15, vrow = tid >> 3, vc16 = tid & 7;
#pragma unroll 1
    for (int br = 0; br < 2; ++br) {
        const bf16_t* Kg = br ? p.KW() : p.KS(); const bf16_t* Vg = br ? p.VWT() : p.VST();
        const int ktlast = (tq0 + 15) >> 6;
        const int ktfirst = br ? ((tq0 - 511 > 0 ? tq0 - 511 : 0) >> 6) : 0;
        const int nk = ktlast - ktfirst + 1;
        f32x4 o[8];
#pragma unroll
        for (int mt = 0; mt < 8; ++mt) o[mt] = (f32x4){0.f, 0.f, 0.f, 0.f};
        float m = -1e30f, lsum = 0.f;
        uint4 rk0, rk1, rk2, rk3, rv0, rv1, rv2, rv3;
#define NSA_LOAD(KT) do { const bf16_t* kb = Kg + (size_t)((KT) * 64 + krow) * 128 + kc16 * 8; const bf16_t* vb = Vg + (size_t)vrow * T + (KT) * 64 + vc16 * 8; \
        rk0 = *(const uint4*)kb; rk1 = *(const uint4*)(kb + 16 * 128); rk2 = *(const uint4*)(kb + 32 * 128); rk3 = *(const uint4*)(kb + 48 * 128); \
        rv0 = *(const uint4*)vb; rv1 = *(const uint4*)(vb + (size_t)32 * T); rv2 = *(const uint4*)(vb + (size_t)64 * T); rv3 = *(const uint4*)(vb + (size_t)96 * T); } while (0)
        NSA_LOAD(ktfirst);
#pragma unroll 1
        for (int i = 0; i < nk; ++i, ++gstep) {
            const int kt = ktfirst + i;
            char* Kt = smem + (gstep & 1) * BUFB; char* Vt = Kt + 64 * RSK;
            *(uint4*)(Kt + krow * RSK + kc16 * 16) = rk0; *(uint4*)(Kt + (krow + 16) * RSK + kc16 * 16) = rk1;
            *(uint4*)(Kt + (krow + 32) * RSK + kc16 * 16) = rk2; *(uint4*)(Kt + (krow + 48) * RSK + kc16 * 16) = rk3;
            *(uint4*)(Vt + vrow * RSV + vc16 * 16) = rv0; *(uint4*)(Vt + (vrow + 32) * RSV + vc16 * 16) = rv1;
            *(uint4*)(Vt + (vrow + 64) * RSV + vc16 * 16) = rv2; *(uint4*)(Vt + (vrow + 96) * RSV + vc16 * 16) = rv3;
            __syncthreads();
            if (i + 1 < nk) NSA_LOAD(kt + 1);
            int lo, hi = t;
            if (br == 0) {
                const unsigned wv = (kt & 64) ? ((kt & 32) ? selw.w : selw.z) : ((kt & 32) ? selw.y : selw.x);
                lo = 0; hi = ((wv >> (kt & 31)) & 1u) ? t : -1;
            } else lo = t - 511;
            const bool interior = (kt * 64 + 63 <= tq0) && (br == 0 || kt * 64 >= tq0 + 15 - 511);
            f32x4 sv[4];
            float mx = -3e38f;
            if (interior) {
                const float csl = hi >= 0 ? cs : 0.f, add = hi >= 0 ? 0.f : -3e38f;
#pragma unroll
                for (int sub = 0; sub < 4; ++sub) {
                    f32x4 a4 = (f32x4){0.f, 0.f, 0.f, 0.f};
#pragma unroll
                    for (int ks = 0; ks < 4; ++ks) a4 = mfma16(*(const bf16x8*)(Kt + (sub * 16 + qc) * RSK + (ks * 32 + g4 * 8) * 2), qf[ks], a4);
#pragma unroll
                    for (int r = 0; r < 4; ++r) { a4[r] = a4[r] * csl + add; mx = fmaxf(mx, a4[r]); }
                    sv[sub] = a4;
                }
            } else {
#pragma unroll
                for (int sub = 0; sub < 4; ++sub) {
                    f32x4 a4 = (f32x4){0.f, 0.f, 0.f, 0.f};
#pragma unroll
                    for (int ks = 0; ks < 4; ++ks) a4 = mfma16(*(const bf16x8*)(Kt + (sub * 16 + qc) * RSK + (ks * 32 + g4 * 8) * 2), qf[ks], a4);
#pragma unroll
                    for (int r = 0; r < 4; ++r) {
                        const int kp = kt * 64 + sub * 16 + 4 * g4 + r;
                        const bool valid = (kp >= lo) & (kp <= hi);
                        a4[r] = valid ? a4[r] * cs : -3e38f;
                        mx = fmaxf(mx, a4[r]);
                    }
                    sv[sub] = a4;
                }
            }
            mx = fmaxf(mx, __shfl_xor(mx, 16)); mx = fmaxf(mx, __shfl_xor(mx, 32));
            const float mnew = fmaxf(fmaxf(m, mx), -1e30f);
            const float alpha = __builtin_amdgcn_exp2f(m - mnew);
            m = mnew;
            float ps = 0.f;
#pragma unroll
            for (int sub = 0; sub < 4; ++sub)
#pragma unroll
                for (int r = 0; r < 4; ++r) { const float pv = __builtin_amdgcn_exp2f(sv[sub][r] - mnew); sv[sub][r] = pv; ps += pv; }
            lsum = lsum * alpha + ps;
            if (__any(alpha != 1.0f)) {
#pragma unroll
                for (int mt = 0; mt < 8; ++mt) o[mt] *= alpha;
            }
#pragma unroll
            for (int pr = 0; pr < 2; ++pr) {
                union { bf16x8 v; unsigned u32[4]; } bb;
                bb.u32[0] = pk2(sv[2 * pr][0], sv[2 * pr][1]); bb.u32[1] = pk2(sv[2 * pr][2], sv[2 * pr][3]);
                bb.u32[2] = pk2(sv[2 * pr + 1][0], sv[2 * pr + 1][1]); bb.u32[3] = pk2(sv[2 * pr + 1][2], sv[2 * pr + 1][3]);
#pragma unroll
                for (int mt = 0; mt < 8; ++mt) {
                    const char* vp = Vt + (mt * 16 + qc) * RSV + (pr * 32 + 4 * g4) * 2;
                    union { bf16x8 v; uint2 h2[2]; } aa;
                    aa.h2[0] = *(const uint2*)vp; aa.h2[1] = *(const uint2*)(vp + 32);
                    o[mt] = mfma16(aa.v, bb.v, o[mt]);
                }
            }
        }
#undef NSA_LOAD
        lsum += __shfl_xor(lsum, 16); lsum += __shfl_xor(lsum, 32);
        const float gate = p.GATES()[(size_t)t * 12 + hd * 3 + 1 + br];
        const float sc = lsum > 0.f ? gate / lsum : 0.f;
        if (br == 0) {
#pragma unroll
            for (int mt = 0; mt < 8; ++mt) {
                const uint2 oc = *(const uint2*)(p.OCMP() + ((size_t)t * 4 + hd) * 128 + mt * 16 + 4 * g4);
                part[mt][0] = pk2(sc * o[mt][0] + g0 * lo2f(oc.x), sc * o[mt][1] + g0 * hi2f(oc.x));
                part[mt][1] = pk2(sc * o[mt][2] + g0 * lo2f(oc.y), sc * o[mt][3] + g0 * hi2f(oc.y));
            }
        } else {
#pragma unroll
            for (int mt = 0; mt < 8; ++mt) {
                uint2 ov;
                ov.x = pk2(sc * o[mt][0] + lo2f(part[mt][0]), sc * o[mt][1] + hi2f(part[mt][0]));
                ov.y = pk2(sc * o[mt][2] + lo2f(part[mt][1]), sc * o[mt][3] + hi2f(part[mt][1]));
                *(uint2*)(p.Y() + (size_t)t * D + 1024 + hd * 128 + mt * 16 + 4 * g4) = ov;
            }
        }
    }
    __syncthreads();
}

DEV unsigned f2key(float f) { const unsigned u = __float_as_uint(f); return (u & 0x80000000u) ? ~u : (u | 0x80000000u); }
DEV float key2f(unsigned k) { const unsigned u = (k & 0x80000000u) ? (k & 0x7fffffffu) : ~k; return __uint_as_float(u); }
DEV float wave_prune(float* sc, unsigned short* ix, unsigned* hist, int m, int l) {
    float v[8]; unsigned k[8]; unsigned short id[8]; bool ok[8];
#pragma unroll
    for (int i = 0; i < 8; ++i) {
        const int e = l + 64 * i; ok[i] = e < m;
        v[i] = ok[i] ? sc[e] : 0.f; id[i] = ok[i] ? ix[e] : (unsigned short)0; k[i] = f2key(v[i]);
    }
    unsigned prefix = 0u; int need = 256;
#pragma unroll 1
    for (int pass = 0; pass < 4; ++pass) {
        const int shift = 24 - 8 * pass;
        *(uint4*)(hist + 4 * l) = make_uint4(0u, 0u, 0u, 0u);
        __builtin_amdgcn_wave_barrier();
#pragma unroll
        for (int i = 0; i < 8; ++i) {
            const bool in = ok[i] && (pass == 0 || (k[i] >> (shift + 8)) == prefix);
            if (in) atomicAdd(&hist[(k[i] >> shift) & 255u], 1u);
        }
        __builtin_amdgcn_wave_barrier();
        const uint4 hv = *(const uint4*)(hist + 4 * l);
        const unsigned hq[4] = {hv.x, hv.y, hv.z, hv.w};
        const unsigned own = hv.x + hv.y + hv.z + hv.w;
        unsigned tot = own;
#pragma unroll
        for (int o = 1; o < 64; o <<= 1) { const unsigned tv = __shfl_down(tot, o); if (l + o < 64) tot += tv; }
        unsigned cum = tot - own; int found = -1; int nneed = 0;
#pragma unroll
        for (int kk = 3; kk >= 0; --kk) {
            const unsigned c = hq[kk];
            if (found < 0 && (int)cum < need && (int)(cum + c) >= need) { found = 4 * l + kk; nneed = need - (int)cum; }
            cum += c;
        }
        const unsigned long long bal = __ballot(found >= 0);
        const int src = __ffsll((long long)bal) - 1;
        const int digit = __shfl(found, src); need = __shfl(nneed, src);
        prefix = (prefix << 8) | (unsigned)digit;
    }
    const unsigned thr = prefix;
    int base = 0, ties = 0;
    const unsigned long long ltmask = (1ull << l) - 1ull;
#pragma unroll
    for (int i = 0; i < 8; ++i) {
        const bool gt = ok[i] && k[i] > thr, eq = ok[i] && k[i] == thr;
        const unsigned long long em = __ballot(eq);
        const int trank = ties + __popcll(em & ltmask);
        const bool keep = gt || (eq && trank < need);
        ties += __popcll(em);
        const unsigned long long km = __ballot(keep);
        const int pos = base + __popcll(km & ltmask);
        if (keep) { sc[pos] = v[i]; ix[pos] = id[i]; }
        base += __popcll(km);
    }
    __builtin_amdgcn_wave_barrier();
    return key2f(thr);
}

#define DSA_APPEND(SCP, IXP, CNT, M32, MINE, SV) do { \
    const unsigned _m = (M32); \
    if (MINE) { const int _pos = (CNT) + __popc(_m & ((1u << n) - 1u)); (SCP)[_pos] = (SV); (IXP)[_pos] = (unsigned short)kp; } \
    (CNT) += __popc(_m); } while (0)

DEV void st_dsa_index(const P& p, int unit, char* smem) {
    const int tid = tidx(), w = tid >> 6, l = tid & 63, n = l & 31, h = l >> 5;
    char* wb = smem + w * 14336;
    float* sc0 = (float*)wb; float* sc1 = sc0 + 512; float* sc2 = sc1 + 512; float* sc3 = sc2 + 512;
    unsigned short* ix0 = (unsigned short*)(wb + 8192); unsigned short* ix1 = ix0 + 512; unsigned short* ix2 = ix1 + 512; unsigned short* ix3 = ix2 + 512;
    unsigned* hist = (unsigned*)(wb + 12288);
    const int wu = unit * 4 + w;
    const int tg = (wu & 1) ? (2047 - (wu >> 1)) : (wu >> 1);
    const int t0 = tg * 4;
    const int tl = 2 * ((n >> 2) & 1) + (n >> 4), hdr = (n & 3) + 4 * ((n >> 3) & 1);
    bf16x8 af[4];
#pragma unroll
    for (int s = 0; s < 4; ++s) af[s] = *(const bf16x8*)(p.IQ() + ((size_t)(t0 + tl) * 8 + hdr) * 64 + 16 * s + 8 * h);
    const int tA = t0 + 2 * h, tB = tA + 1;
    float wA[8], wB[8];
#pragma unroll
    for (int r = 0; r < 8; ++r) { wA[r] = p.IW()[(size_t)tA * 8 + r]; wB[r] = p.IW()[(size_t)tB * 8 + r]; }
    int cnt0 = 0, cnt1 = 0, cnt2 = 0, cnt3 = 0;
    const float NINF = -__builtin_inff();
    float tau0 = NINF, tau1 = NINF, tau2 = NINF, tau3 = NINF;
    const int ntiles = (t0 + 3) / 32 + 1;
    const bf16_t* ikp = p.IK() + (size_t)n * 64 + 8 * h;
    bf16x8 na[4], nb[4];
#pragma unroll
    for (int s = 0; s < 4; ++s) { na[s] = *(const bf16x8*)(ikp + 16 * s); nb[s] = *(const bf16x8*)(ikp + (size_t)(ntiles > 1 ? 32 : 0) * 64 + 16 * s); }
#pragma unroll 1
    for (int kt = 0; kt < ntiles; kt += 2) {
        bf16x8 ca[4], cb[4];
#pragma unroll
        for (int s = 0; s < 4; ++s) { ca[s] = na[s]; cb[s] = nb[s]; }
        {
            const int ka = kt + 2 < ntiles ? kt + 2 : ntiles - 1, kb = kt + 3 < ntiles ? kt + 3 : ntiles - 1;
#pragma unroll
            for (int s = 0; s < 4; ++s) { na[s] = *(const bf16x8*)(ikp + (size_t)ka * 32 * 64 + 16 * s); nb[s] = *(const bf16x8*)(ikp + (size_t)kb * 32 * 64 + 16 * s); }
        }
        f32x16 acca, accb;
#pragma unroll
        for (int r = 0; r < 16; ++r) { acca[r] = 0.f; accb[r] = 0.f; }
#pragma unroll
        for (int s = 0; s < 4; ++s) { acca = mfma32(af[s], ca[s], acca); accb = mfma32(af[s], cb[s], accb); }
        float s0a = 0.f, s1a = 0.f, s0b = 0.f, s1b = 0.f, u0a = 0.f, u1a = 0.f, u0b = 0.f, u1b = 0.f;
#pragma unroll
        for (int r = 0; r < 4; ++r) {
            s0a += wA[r] * fmaxf(acca[r], 0.f); u0a += wA[4 + r] * fmaxf(acca[4 + r], 0.f);
            s1a += wB[r] * fmaxf(acca[8 + r], 0.f); u1a += wB[4 + r] * fmaxf(acca[12 + r], 0.f);
            s0b += wA[r] * fmaxf(accb[r], 0.f); u0b += wA[4 + r] * fmaxf(accb[4 + r], 0.f);
            s1b += wB[r] * fmaxf(accb[8 + r], 0.f); u1b += wB[4 + r] * fmaxf(accb[12 + r], 0.f);
        }
        s0a += u0a; s1a += u1a; s0b += u0b; s1b += u1b;
        const float tauA = h ? tau2 : tau0, tauB = h ? tau3 : tau1;
        {
            const int kp = kt * 32 + n;
            const bool cA = (kp <= tA) && (s0a > tauA), cB = (kp <= tB) && (s1a > tauB);
            const unsigned long long mA = __ballot(cA), mB = __ballot(cB);
            DSA_APPEND(sc0, ix0, cnt0, (unsigned)mA, (h == 0 && cA), s0a);
            DSA_APPEND(sc2, ix2, cnt2, (unsigned)(mA >> 32), (h == 1 && cA), s0a);
            DSA_APPEND(sc1, ix1, cnt1, (unsigned)mB, (h == 0 && cB), s1a);
            DSA_APPEND(sc3, ix3, cnt3, (unsigned)(mB >> 32), (h == 1 && cB), s1a);
        }
        {
            const int kp = kt * 32 + 32 + n;
            const bool cA = (kp <= tA) && (s0b > tauA), cB = (kp <= tB) && (s1b > tauB);
            const unsigned long long mA = __ballot(cA), mB = __ballot(cB);
            DSA_APPEND(sc0, ix0, cnt0, (unsigned)mA, (h == 0 && cA), s0b);
            DSA_APPEND(sc2, ix2, cnt2, (unsigned)(mA >> 32), (h == 1 && cA), s0b);
            DSA_APPEND(sc1, ix1, cnt1, (unsigned)mB, (h == 0 && cB), s1b);
            DSA_APPEND(sc3, ix3, cnt3, (unsigned)(mB >> 32), (h == 1 && cB), s1b);
        }
        __builtin_amdgcn_wave_barrier();
        if (max(max(cnt0, cnt1), max(cnt2, cnt3)) > 448) {
            if (cnt0 > 448) { tau0 = wave_prune(sc0, ix0, hist, cnt0, l); cnt0 = 256; }
            if (cnt1 > 448) { tau1 = wave_prune(sc1, ix1, hist, cnt1, l); cnt1 = 256; }
            if (cnt2 > 448) { tau2 = wave_prune(sc2, ix2, hist, cnt2, l); cnt2 = 256; }
            if (cnt3 > 448) { tau3 = wave_prune(sc3, ix3, hist, cnt3, l); cnt3 = 256; }
        }
    }
    if (cnt0 > 256) { wave_prune(sc0, ix0, hist, cnt0, l); cnt0 = 256; }
    if (cnt1 > 256) { wave_prune(sc1, ix1, hist, cnt1, l); cnt1 = 256; }
    if (cnt2 > 256) { wave_prune(sc2, ix2, hist, cnt2, l); cnt2 = 256; }
    if (cnt3 > 256) { wave_prune(sc3, ix3, hist, cnt3, l); cnt3 = 256; }
    __builtin_amdgcn_wave_barrier();
#pragma unroll
    for (int i = 0; i < 4; ++i) {
        const int e = l + 64 * i;
        p.IDX()[(size_t)(t0 + 0) * 256 + e] = e < cnt0 ? (int)ix0[e] : 0;
        p.IDX()[(size_t)(t0 + 1) * 256 + e] = e < cnt1 ? (int)ix1[e] : 0;
        p.IDX()[(size_t)(t0 + 2) * 256 + e] = e < cnt2 ? (int)ix2[e] : 0;
        p.IDX()[(size_t)(t0 + 3) * 256 + e] = e < cnt3 ? (int)ix3[e] : 0;
    }
    if (l == 0) { p.CNT()[t0] = cnt0; p.CNT()[t0 + 1] = cnt1; p.CNT()[t0 + 2] = cnt2; p.CNT()[t0 + 3] = cnt3; }
}

DEV void st_dsa_attn(const P& p, int unit, char* smem) {
    const int tid = tidx(), w = tid >> 6, l = tid & 63, c = l & 15, g4 = l >> 4;
    int* idxs = (int*)(smem + w * 5120); float* Pl = (float*)(smem + w * 5120 + 1024);
    const size_t t = (size_t)unit * 4 + w;
    const int cnt = p.CNT()[t];
#pragma unroll
    for (int i = 0; i < 4; ++i) idxs[l + 64 * i] = p.IDX()[t * 256 + l + 64 * i];
    __builtin_amdgcn_wave_barrier();
    bf16x8 qf[4];
#pragma unroll
    for (int j = 0; j < 4; ++j) qf[j] = *(const bf16x8*)(p.DQ() + (t * 4 + (c & 3)) * 128 + g4 * 32 + j * 8);
    f32x4 s[16];
    const int ntile = (cnt + 15) >> 4;
#pragma unroll
    for (int tq = 0; tq < 4; ++tq) {
        bf16x8 kf[4][4];
        if (tq * 4 < ntile) {
#pragma unroll
            for (int q = 0; q < 4; ++q) {
                const int krow = idxs[(tq * 4 + q) * 16 + c];
                const bf16_t* kp = p.DK() + (size_t)krow * 128 + g4 * 32;
#pragma unroll
                for (int j = 0; j < 4; ++j) kf[q][j] = *(const bf16x8*)(kp + j * 8);
            }
        }
#pragma unroll
        for (int q = 0; q < 4; ++q) {
            s[tq * 4 + q] = (f32x4){0.f, 0.f, 0.f, 0.f};
            if (tq * 4 < ntile) {
#pragma unroll
                for (int j = 0; j < 4; ++j) s[tq * 4 + q] = mfma16(kf[q][j], qf[j], s[tq * 4 + q]);
            }
        }
        __builtin_amdgcn_sched_barrier(0);
    }
    const float cs = 0.08838834764831845f * 1.4426950408889634f;
    float mx = -1e30f;
#pragma unroll
    for (int tt = 0; tt < 16; ++tt)
#pragma unroll
        for (int r = 0; r < 4; ++r) { const int slot = tt * 16 + 4 * g4 + r; if (slot < cnt) mx = fmaxf(mx, s[tt][r] * cs); }
    mx = fmaxf(mx, __shfl_xor(mx, 16)); mx = fmaxf(mx, __shfl_xor(mx, 32));
    float sum = 0.f;
#pragma unroll
    for (int tt = 0; tt < 16; ++tt)
#pragma unroll
        for (int r = 0; r < 4; ++r) { const int slot = tt * 16 + 4 * g4 + r; const float pv = slot < cnt ? exp2f(s[tt][r] * cs - mx) : 0.f; s[tt][r] = pv; sum += pv; }
    sum += __shfl_xor(sum, 16); sum += __shfl_xor(sum, 32);
    const float inv = sum > 0.f ? 1.0f / sum : 0.f;
    if (c < 4) {
#pragma unroll
        for (int tt = 0; tt < 16; ++tt)
#pragma unroll
            for (int r = 0; r < 4; ++r) Pl[(tt * 16 + 4 * g4 + r) * 4 + c] = s[tt][r] * inv;
    }
    __builtin_amdgcn_wave_barrier();
    float acc[4][8];
#pragma unroll
    for (int hh = 0; hh < 4; ++hh)
#pragma unroll
        for (int j = 0; j < 8; ++j) acc[hh][j] = 0.f;
    const int nk32 = (cnt + 31) >> 5;
#pragma unroll 1
    for (int kb = 0; kb < nk32; ++kb) {
        uint4 raw[8]; float4 p4[8];
#pragma unroll
        for (int q = 0; q < 8; ++q) {
            const int slot = (kb * 8 + q) * 4 + g4;
            const int row = idxs[slot];
            raw[q] = *(const uint4*)(p.PROJ() + (size_t)row * LDP + C_DV + c * 8);
            p4[q] = *(const float4*)(Pl + slot * 4);
        }
#pragma unroll
        for (int q = 0; q < 8; ++q) {
            const float vv[8] = {lo2f(raw[q].x), hi2f(raw[q].x), lo2f(raw[q].y), hi2f(raw[q].y), lo2f(raw[q].z), hi2f(raw[q].z), lo2f(raw[q].w), hi2f(raw[q].w)};
            const float pp[4] = {p4[q].x, p4[q].y, p4[q].z, p4[q].w};
#pragma unroll
            for (int hh = 0; hh < 4; ++hh)
#pragma unroll
                for (int j = 0; j < 8; ++j) acc[hh][j] += pp[hh] * vv[j];
        }
    }
#pragma unroll
    for (int hh = 0; hh < 4; ++hh)
#pragma unroll
        for (int j = 0; j < 8; ++j) { float a = acc[hh][j]; a += __shfl_xor(a, 16); a += __shfl_xor(a, 32); acc[hh][j] = a; }
    if (g4 == 0) {
#pragma unroll
        for (int hh = 0; hh < 4; ++hh) {
            uint4 o; o.x = pk2(acc[hh][0], acc[hh][1]); o.y = pk2(acc[hh][2], acc[hh][3]); o.z = pk2(acc[hh][4], acc[hh][5]); o.w = pk2(acc[hh][6], acc[hh][7]);
            *(uint4*)(p.Y() + t * D + 1536 + hh * 128 + c * 8) = o;
        }
    }
    __builtin_amdgcn_wave_barrier();
}

DEV void ins16(unsigned (&top)[16], unsigned x) {
#pragma unroll
    for (int j = 0; j < 16; ++j) { const unsigned hi = max(top[j], x); x = min(top[j], x); top[j] = hi; }
}
DEV void st_peer_topk(const P& p, int layer, int unit, char* smem) {
    const int tid = tidx(), w = tid >> 6, l = tid & 63, n = l & 31, hf = l >> 5;
    const int tg = unit >> 1, head = (unit & 1) * 4 + w;
    const size_t t = (size_t)tg * 32 + n;
    unsigned* il = (unsigned*)smem + w * 1024;
    unsigned top[2][16];
#pragma unroll
    for (int pp = 0; pp < 2; ++pp) {
        float qv[32];
#pragma unroll
        for (int i = 0; i < 8; ++i) { const float4 v = *(const float4*)(p.PQ() + t * 1024 + head * 128 + pp * 64 + hf * 32 + i * 4); qv[4 * i] = v.x; qv[4 * i + 1] = v.y; qv[4 * i + 2] = v.z; qv[4 * i + 3] = v.w; }
        const float* K = p.peer_sk + ((((size_t)layer * 8 + head) * 2 + pp) * 128) * 64;
#pragma unroll
        for (int j = 0; j < 16; ++j) top[pp][j] = 0u;
#pragma unroll 1
        for (int tile = 0; tile < 4; ++tile) {
            float kv[32];
            const float* kr = K + (size_t)(tile * 32 + n) * 64 + hf * 32;
#pragma unroll
            for (int i = 0; i < 8; ++i) { const float4 v = *(const float4*)(kr + i * 4); kv[4 * i] = v.x; kv[4 * i + 1] = v.y; kv[4 * i + 2] = v.z; kv[4 * i + 3] = v.w; }
            f32x16 acc;
#pragma unroll
            for (int r = 0; r < 16; ++r) acc[r] = 0.f;
#pragma unroll
            for (int kk = 0; kk < 32; ++kk) acc = __builtin_amdgcn_mfma_f32_32x32x2f32(kv[kk], qv[kk], acc, 0, 0, 0);
#pragma unroll
            for (int r = 0; r < 16; ++r) {
                const int nn = tile * 32 + (r & 3) + 8 * (r >> 2) + 4 * hf;
                ins16(top[pp], (f2key(acc[r]) & ~127u) | (unsigned)(127 - nn));
            }
        }
        unsigned oth[16];
#pragma unroll
        for (int j = 0; j < 16; ++j) oth[j] = __shfl_xor(top[pp][j], 32);
#pragma unroll
        for (int j = 0; j < 16; ++j) ins16(top[pp], oth[j]);
        if (hf == 0) {
#pragma unroll
            for (int j = 0; j < 16; ++j) il[(pp * 16 + j) * 32 + n] = 127u - (top[pp][j] & 127u);
        }
    }
    __builtin_amdgcn_wave_barrier();
    if (hf == 0) {
        float v1[16], v2[16];
#pragma unroll
        for (int j = 0; j < 16; ++j) { v1[j] = key2f(top[0][j] & ~127u); v2[j] = key2f(top[1][j] & ~127u); }
        unsigned ct[16];
#pragma unroll
        for (int s = 0; s < 16; ++s) ct[s] = 0u;
#pragma unroll
        for (int i = 0; i < 16; ++i)
#pragma unroll
            for (int j = 0; j < 16; ++j)
                if ((i + 1) * (j + 1) <= 16) ins16(ct, (f2key(v1[i] + v2[j]) & ~255u) | (unsigned)(255 - (i * 16 + j)));
        float ex[16], sum = 0.f; int ce[16];
        const float c0 = key2f(ct[0] & ~255u);
#pragma unroll
        for (int s = 0; s < 16; ++s) {
            const unsigned code = 255u - (ct[s] & 255u);
            ce[s] = (int)(il[(code >> 4) * 32 + n] * 128u + il[(16 + (code & 15u)) * 32 + n]);
            ex[s] = __expf(key2f(ct[s] & ~255u) - c0); sum += ex[s];
        }
        const float inv = 1.0f / sum;
#pragma unroll
        for (int s4 = 0; s4 < 4; ++s4) {
            *(int4*)(p.PE() + t * 128 + head * 16 + s4 * 4) = make_int4(ce[4 * s4], ce[4 * s4 + 1], ce[4 * s4 + 2], ce[4 * s4 + 3]);
            *(float4*)(p.PG() + t * 128 + head * 16 + s4 * 4) = make_float4(ex[4 * s4] * inv, ex[4 * s4 + 1] * inv, ex[4 * s4 + 2] * inv, ex[4 * s4 + 3] * inv);
        }
    }
    __builtin_amdgcn_wave_barrier();
}

DEV void fp8x16_decode(const uint4& r, float (&f)[16]) {
    const unsigned w[4] = {r.x, r.y, r.z, r.w};
#pragma unroll
    for (int q = 0; q < 4; ++q) {
        const f32x2 lo = __builtin_amdgcn_cvt_pk_f32_fp8((int)w[q], false), hi = __builtin_amdgcn_cvt_pk_f32_fp8((int)w[q], true);
        f[4 * q] = lo.x; f[4 * q + 1] = lo.y; f[4 * q + 2] = hi.x; f[4 * q + 3] = hi.y;
    }
}
DEV void st_peer_gather(const P& p, int layer, const float* __restrict__ xin, float* __restrict__ xout, int unit) {
    const int tid_ = tidx(); const int w = tid_ >> 6, l = tid_ & 63; const size_t t = (size_t)unit * 4 + w;
    float hf[32];
#pragma unroll
    for (int i = 0; i < 2; ++i)
#pragma unroll
        for (int h2 = 0; h2 < 2; ++h2) {
            const uint4 hv = *(const uint4*)(p.HN() + t * D + i * 1024 + l * 16 + h2 * 8);
            const unsigned u4[4] = {hv.x, hv.y, hv.z, hv.w};
#pragma unroll
            for (int q = 0; q < 4; ++q) { hf[i * 16 + h2 * 8 + 2 * q] = lo2f(u4[q]); hf[i * 16 + h2 * 8 + 2 * q + 1] = hi2f(u4[q]); }
        }
    const int e0 = p.PE()[t * 128 + l], e1 = p.PE()[t * 128 + 64 + l];
    const float g0 = p.PG()[t * 128 + l], g1 = p.PG()[t * 128 + 64 + l];
    float out[32];
#pragma unroll
    for (int i = 0; i < 32; ++i) out[i] = 0.f;
    const unsigned char* U = p.Utab() + (size_t)layer * 16384 * 2048 + l * 16; const unsigned char* V = p.Vtab() + (size_t)layer * 16384 * 2048 + l * 16;
    const bool b5 = (l & 32) != 0, b4 = (l & 16) != 0;
#pragma unroll 1
    for (int k4 = 0; k4 < 32; ++k4) {
        int e[4]; float g[4];
#pragma unroll
        for (int q = 0; q < 4; ++q) {
            const int k = k4 * 4 + q;
            e[q] = __builtin_amdgcn_readlane(k4 < 16 ? e0 : e1, k & 63);
            g[q] = __int_as_float(__builtin_amdgcn_readlane(__float_as_int(k4 < 16 ? g0 : g1), k & 63));
        }
        uint4 uu[4][2], vv[4][2];
#pragma unroll
        for (int q = 0; q < 4; ++q)
#pragma unroll
            for (int i = 0; i < 2; ++i) { uu[q][i] = *(const uint4*)(U + (size_t)e[q] * 2048 + i * 1024); vv[q][i] = *(const uint4*)(V + (size_t)e[q] * 2048 + i * 1024); }
        float d[4];
#pragma unroll
        for (int q = 0; q < 4; ++q) {
            float acc = 0.f;
#pragma unroll
            for (int i = 0; i < 2; ++i) { float f[16]; fp8x16_decode(uu[q][i], f);
#pragma unroll
                for (int j = 0; j < 16; ++j) acc += f[j] * hf[i * 16 + j]; }
            d[q] = acc;
        }
        float kA = b5 ? d[2] : d[0], kB = b5 ? d[3] : d[1];
        const float sA = b5 ? d[0] : d[2], sB = b5 ? d[1] : d[3];
        kA += __shfl_xor(sA, 32); kB += __shfl_xor(sB, 32);
        float kk = b4 ? kB : kA; const float ss = b4 ? kA : kB;
        kk += __shfl_xor(ss, 16);
        kk += __shfl_xor(kk, 8); kk += __shfl_xor(kk, 4); kk += __shfl_xor(kk, 2); kk += __shfl_xor(kk, 1);
        const float gsel = b5 ? (b4 ? g[3] : g[2]) : (b4 ? g[1] : g[0]);
        const float av = gelu_tanh(kk * (1.0f / U8_SCALE)) * gsel * (1.0f / V8_SCALE);
        const int avi = __float_as_int(av);
        const float a4[4] = {__int_as_float(__builtin_amdgcn_readlane(avi, 0)), __int_as_float(__builtin_amdgcn_readlane(avi, 16)),
                             __int_as_float(__builtin_amdgcn_readlane(avi, 32)), __int_as_float(__builtin_amdgcn_readlane(avi, 48))};
#pragma unroll
        for (int q = 0; q < 4; ++q)
#pragma unroll
            for (int i = 0; i < 2; ++i) { float f[16]; fp8x16_decode(vv[q][i], f);
#pragma unroll
                for (int j = 0; j < 16; ++j) out[i * 16 + j] += a4[q] * f[j]; }
    }
    const float* g2 = p.ada() + layer * 12288 + 5 * 2048;
#pragma unroll
    for (int i = 0; i < 2; ++i)
#pragma unroll
        for (int q = 0; q < 4; ++q) {
            const size_t col = i * 1024 + l * 16 + q * 4; const size_t off = t * D + col;
            const float4 x0 = *(const float4*)(xin + off); const float4 ga = *(const float4*)(g2 + col);
            float4 o0;
            o0.x = x0.x + ga.x * out[i * 16 + q * 4 + 0]; o0.y = x0.y + ga.y * out[i * 16 + q * 4 + 1];
            o0.z = x0.z + ga.z * out[i * 16 + q * 4 + 2]; o0.w = x0.w + ga.w * out[i * 16 + q * 4 + 3];
            *(float4*)(xout + off) = o0;
        }
}

enum { S_CONVT_IN = 0, S_CONVT_OUT, S_CONVT_Q, S_CONVT_W1, S_TAB_U, S_TAB_V, S_ADA, S_ROPE, S_NORM1, S_GEMM_IN, S_CONV, S_SGU, S_VTRANS, S_PREP,
       S_COMPRESS, S_NSA_CMP, S_DSA_INDEX, S_NSA_ATTN, S_DSA_ATTN, S_GEMM_OUT, S_NORM2, S_GEMM_Q, S_PEER_TOPK, S_PEER_GATHER, S_COUNT };
constexpr int TAB_UNITS = 4096;
__host__ __device__ constexpr int nunits(int s) {
    return s == S_CONVT_IN ? 2 * 32 * (LDP / 64) : s == S_CONVT_OUT ? 2 * 32 * 32 : s == S_CONVT_Q ? 2 * 32 * 16 : s == S_CONVT_W1 ? 4 * 64 * 2 : s == S_TAB_U ? TAB_UNITS : s == S_TAB_V ? TAB_UNITS
         : s == S_ADA ? 384 : s == S_ROPE ? 768 : s == S_NORM1 ? 2048 : s == S_GEMM_IN ? 64 * (LDP / 128) : s == S_CONV ? 512 : s == S_SGU ? 256
         : s == S_VTRANS ? 256 : s == S_PREP ? 2048 : s == S_COMPRESS ? 64 : s == S_NSA_CMP ? 512 : s == S_DSA_INDEX ? 512 : s == S_NSA_ATTN ? 512 : s == S_DSA_ATTN ? 2048
         : s == S_GEMM_OUT ? 64 * 16 : s == S_NORM2 ? 2048 : s == S_GEMM_Q ? 64 * 8 : s == S_PEER_TOPK ? 512 : s == S_PEER_GATHER ? 2048 : 0;
}
template <int S>
DEV void run_unit(const P& p, int layer, int u, char* smem, int nu = TAB_UNITS) {
    const float* xin = layer == 0 ? p.x : p.X2();
    const float* ada = p.ada() + layer * 12288;
    if constexpr (S == S_CONVT_IN) { const int per = 32 * (LDP / 64), ly = u / per; st_convT(p.w_in + (size_t)ly * 2048 * INC, p.WinT() + (size_t)ly * LDP * 2048, INC, LDP, true, u % per, smem); }
    else if constexpr (S == S_CONVT_OUT) { const int per = 32 * 32, ly = u / per; st_convT(p.w_out + (size_t)ly * 2048 * 2048, p.WoutT() + (size_t)ly * 2048 * 2048, 2048, 2048, false, u % per, smem); }
    else if constexpr (S == S_CONVT_Q) { const int per = 32 * 16, ly = u / per; st_convT(p.peer_wq + (size_t)ly * 2048 * 1024, p.WqT() + (size_t)ly * 1024 * 2048, 1024, 1024, false, u % per, smem); }
    else if constexpr (S == S_CONVT_W1) { const int per = 64 * 2, mi = u / per; st_convT(p.cmp_w1 + (size_t)mi * 4096 * 128, p.W1T() + (size_t)mi * 128 * 4096, 128, 128, false, u % per, smem, 4096); }
    else if constexpr (S == S_TAB_U) st_tab(p.peer_u, p.Utab(), U8_SCALE, (size_t)2 * 16384 * 2048 / 16, u, nu);
    else if constexpr (S == S_TAB_V) st_tab(p.peer_v, p.Vtab(), V8_SCALE, (size_t)2 * 16384 * 2048 / 16, u, nu);
    else if constexpr (S == S_ADA) st_ada(p, u, smem);
    else if constexpr (S == S_ROPE) st_rope(p, u);
    else if constexpr (S == S_NORM1) st_norm(xin, p.n1g + layer * 2048, ada + 2048, ada, p.HN(), u);
    else if constexpr (S == S_GEMM_IN) { EpiArgs e{p.PROJ(), nullptr, nullptr, nullptr}; st_gemm<EPI_PROJ>(p.HN(), p.WinT() + (size_t)layer * LDP * 2048, 2048, u & 63, u >> 6, e, smem); }
    else if constexpr (S == S_CONV) st_conv(p, layer, u, smem);
    else if constexpr (S == S_SGU) st_sgu(p, layer, u, smem);
    else if constexpr (S == S_VTRANS) st_vtrans(p, u, smem);
    else if constexpr (S == S_PREP) st_prep(p, layer, u);
    else if constexpr (S == S_COMPRESS) st_compress(p, layer, u, smem);
    else if constexpr (S == S_NSA_CMP) st_nsa_cmp(p, u, smem);
    else if constexpr (S == S_DSA_INDEX) st_dsa_index(p, u, smem);
    else if constexpr (S == S_NSA_ATTN) st_nsa_attn(p, u, smem);
    else if constexpr (S == S_DSA_ATTN) st_dsa_attn(p, u, smem);
    else if constexpr (S == S_GEMM_OUT) { EpiArgs e{nullptr, p.X1(), xin, ada + 2 * 2048}; st_gemm<EPI_OUT>(p.Y(), p.WoutT() + (size_t)layer * 2048 * 2048, 2048, u & 63, u >> 6, e, smem); }
    else if constexpr (S == S_NORM2) st_norm(p.X1(), p.n2g + layer * 2048, ada + 4 * 2048, ada + 3 * 2048, p.HN(), u);
    else if constexpr (S == S_GEMM_Q) { EpiArgs e{nullptr, p.PQ(), nullptr, nullptr}; st_gemm<EPI_Q>(p.HN(), p.WqT() + (size_t)layer * 1024 * 2048, 2048, u & 63, u >> 6, e, smem); }
    else if constexpr (S == S_PEER_TOPK) st_peer_topk(p, layer, u, smem);
    else if constexpr (S == S_PEER_GATHER) st_peer_gather(p, layer, p.X1(), layer == 0 ? p.X2() : p.out, u);
}


#define XB_TMO      128
#define XB_XCNT(j)  (256  + 64 * (j))
#define XB_XSUB(j)  (1280 + 64 * (j))
#define XB_XGEN(j)  (2304 + 64 * (j))
#define XB_TOP      3328
#define XB_TOPGEN   3392
#define XB_SPIN_CAP (1u << 22)
#define LAS __attribute__((address_space(3)))
DEV unsigned xb_ld(unsigned* p) { return __hip_atomic_load(p, __ATOMIC_RELAXED, __HIP_MEMORY_SCOPE_AGENT); }
DEV unsigned xb_add(unsigned* p, unsigned v) { return __hip_atomic_fetch_add(p, v, __ATOMIC_RELAXED, __HIP_MEMORY_SCOPE_AGENT); }
DEV unsigned xb_xcc_id() { return (unsigned)__builtin_amdgcn_s_getreg((3 << 11) | 20) & 0xFu; }
#define XB_SPIN(cond, bar) do { unsigned _sp = 0; while (cond) { __builtin_amdgcn_s_sleep(1); \
    if ((++_sp & 255u) == 0u) { if (xb_ld(&(bar)[XB_TMO])) break; if (_sp > XB_SPIN_CAP) { atomicAdd(&(bar)[XB_TMO], 1u); break; } } } } while (0)
struct XcdBarrier { unsigned* bar; unsigned x; volatile LAS unsigned* st; };
DEV XcdBarrier xcd_barrier_post(unsigned* bar, volatile LAS unsigned* st) {
    XcdBarrier b; b.bar = bar; b.x = xb_xcc_id(); b.st = st;
    if (threadIdx.x == 0) (void)xb_add(&bar[XB_XCNT(b.x)], 1u);
    return b;
}
DEV void xcd_barrier_complete(unsigned* bar, unsigned x, unsigned& nloc, unsigned& nx) {
    const unsigned G = gridDim.x * gridDim.y * gridDim.z;
    unsigned sum, cnt, mine, sp = 0u;
    for (;;) {
        sum = 0u; cnt = 0u; mine = 0u;
#pragma unroll
        for (unsigned j = 0; j < 16; ++j) { const unsigned c = xb_ld(&bar[XB_XCNT(j)]); sum += c; cnt += (c > 0u) ? 1u : 0u; mine = (j == x) ? c : mine; }
        if (sum == G) break;
        __builtin_amdgcn_s_sleep(1);
        if ((++sp & 255u) == 0u) { if (xb_ld(&bar[XB_TMO])) break; if (sp > XB_SPIN_CAP) { atomicAdd(&bar[XB_TMO], 1u); break; } }
    }
    nloc = mine > 0u ? mine : 1u; nx = cnt > 0u ? cnt : 1u;
}
DEV void xcd_barrier(const XcdBarrier& b) {
    asm volatile("s_waitcnt vmcnt(0)" ::: "memory");
    __syncthreads();
    if (threadIdx.x == 0) {
        unsigned* bar = b.bar;
        __builtin_amdgcn_s_waitcnt(0);
        unsigned nloc = b.st[0], nx = b.st[1];
        if (nloc == 0u) { xcd_barrier_complete(bar, b.x, nloc, nx); b.st[0] = nloc; b.st[1] = nx; }
        const unsigned old = xb_add(&bar[XB_XSUB(b.x)], 1u);
        const unsigned gen = old / nloc;
        if (old + 1u == (gen + 1u) * nloc) {
            __builtin_amdgcn_fence(__ATOMIC_RELEASE, "agent");
            asm volatile("s_waitcnt vmcnt(0)" ::: "memory");
            const unsigned og = xb_add(&bar[XB_TOP], 1u);
            const unsigned tg = og / nx;
            if (og + 1u == (tg + 1u) * nx) xb_add(&bar[XB_TOPGEN], 1u);
            else XB_SPIN(xb_ld(&bar[XB_TOPGEN]) == tg, bar);
            __builtin_amdgcn_fence(__ATOMIC_ACQUIRE, "agent");
            xb_add(&bar[XB_XGEN(b.x)], 1u);
            asm volatile("s_waitcnt vmcnt(0)" ::: "memory");
        } else {
            XB_SPIN(xb_ld(&bar[XB_XGEN(b.x)]) == gen, bar);
            __builtin_amdgcn_fence(__ATOMIC_ACQUIRE, "agent");
            asm volatile("s_waitcnt vmcnt(0)" ::: "memory");
        }
    }
    __syncthreads();
}

#ifndef MULTI_LAUNCH
constexpr int REP_STAGE = -1, REP_STAGE2 = -1, REP_N = 1;
template <int S>
DEV void run_phase1(const P& p, int layer, char* smem, int off);
template <int S>
DEV void run_phase(const P& p, int layer, char* smem, int off = 0) {
    constexpr int reps = (S == REP_STAGE || S == REP_STAGE2) ? REP_N : 1;
#pragma unroll 1
    for (int r = 0; r < reps; ++r) run_phase1<S>(p, layer, smem, off);
}
template <int S>
DEV void run_phase1(const P& p, int layer, char* smem, int off) {
    const int G = gridDim.x;
    int b = blockIdx.x + off; if (b >= G) b -= G;
    if constexpr (S == S_TAB_U || S == S_TAB_V) { run_unit<S>(p, layer, b, smem, G); }
    else {
        for (int u = b; u < nunits(S); u += G) { run_unit<S>(p, layer, u, smem); __syncthreads(); }
    }
}
template <int S>
DEV void run_gemm_phase1(const P& p, int layer, char* smem, unsigned xcc, volatile LAS unsigned* slot, int rep) {
    constexpr int TN = (S == S_GEMM_IN) ? (LDP / 128) : (S == S_GEMM_OUT ? 16 : 8);
    constexpr int inst0 = (S == S_GEMM_IN) ? 0 : (S == S_GEMM_OUT ? 2 : 4);
    const int len = 8 * TN;
#pragma unroll 1
    for (int q = 0; q < 8; ++q) {
        const unsigned xq = (xcc + q) & 7u;
        unsigned* head = p.bar() + GQ_WORD(inst0 + layer + 6 * rep, xq);
        for (;;) {
            if (threadIdx.x == 0) *slot = xb_add(head, 1u);
            __syncthreads();
            const int i = (int)*slot;
            __syncthreads();
            if (i >= len) break;
            const int tn = i >> 3, tm = (int)xq * 8 + (i & 7);
            run_unit<S>(p, layer, tm + 64 * tn, smem);
            __syncthreads();
        }
    }
}
template <int S>
DEV void run_items(const P& p, int layer, char* smem, int first, int count) {
    constexpr int reps = (S == REP_STAGE || S == REP_STAGE2) ? REP_N : 1;
#pragma unroll 1
    for (int r = 0; r < reps; ++r)
#pragma unroll 1
        for (int u = first; u < first + count; ++u) { run_unit<S>(p, layer, u, smem); __syncthreads(); }
}
template <int PH>
DEV void run_dyn_phase(const P& p, int layer, char* smem, volatile LAS unsigned* slot) {
    unsigned* head = p.bar() + DQ_WORD(PH * 2 + layer);
    constexpr int total = PH == 0 ? (64 + 256 + 256 + 64 + 256) : (PH == 1 ? (512 + 256) : (512 + 512));
    int i = blockIdx.x;
    while (i < total) {
        if constexpr (PH == 0) {
            if (i < 256) run_items<S_SGU>(p, layer, smem, i, 1);
            else if (i < 320) run_items<S_COMPRESS>(p, layer, smem, i - 256, 1);
            else if (i < 576) run_items<S_CONV>(p, layer, smem, (i - 320) * 2, 2);
            else if (i < 640) run_items<S_VTRANS>(p, layer, smem, (i - 576) * 4, 4);
            else run_items<S_PREP>(p, layer, smem, (i - 640) * 8, 8);
        } else if constexpr (PH == 1) {
            if (i < 512) run_items<S_DSA_INDEX>(p, layer, smem, i, 1);
            else run_items<S_NSA_CMP>(p, layer, smem, (i - 512) * 2, 2);
        } else {
            if (i < 512) run_items<S_NSA_ATTN>(p, layer, smem, 511 - i, 1);
            else run_items<S_DSA_ATTN>(p, layer, smem, (i - 512) * 4, 4);
        }
        if (threadIdx.x == 0) *slot = gridDim.x + xb_add(head, 1u);
        __syncthreads();
        i = (int)*slot;
        __syncthreads();
    }
}
template <int S>
DEV void run_gemm_phase(const P& p, int layer, char* smem, unsigned xcc, volatile LAS unsigned* slot) {
    constexpr int reps = (S == REP_STAGE || S == REP_STAGE2) ? REP_N : 1;
#pragma unroll 1
    for (int r = 0; r < reps; ++r) run_gemm_phase1<S>(p, layer, smem, xcc, slot, r);
}
#define GSYNC() xcd_barrier(xb)
__global__ void __launch_bounds__(NTHREADS, 2) k_mega(P p) {
    __shared__ __attribute__((aligned(16))) char smem[SMEM_BYTES];
    __shared__ uint4 xb_words;
    cg::grid_group grid = cg::this_grid();
    if (threadIdx.x == 0) xb_words = make_uint4(0u, 0u, 0u, 0u);
    __syncthreads();
    XcdBarrier xb = xcd_barrier_post(p.bar(), (volatile LAS unsigned*)&xb_words);
    const int H = gridDim.x >> 1, Q = gridDim.x >> 2;
    run_phase<S_ADA>(p, 0, smem); run_phase<S_ROPE>(p, 0, smem, H);
    run_phase<S_CONVT_IN>(p, 0, smem); run_phase<S_CONVT_OUT>(p, 0, smem); run_phase<S_CONVT_Q>(p, 0, smem); run_phase<S_CONVT_W1>(p, 0, smem);
    run_phase<S_TAB_U>(p, 0, smem); run_phase<S_TAB_V>(p, 0, smem);
    grid.sync();
#pragma unroll 1
    for (int layer = 0; layer < NL; ++layer) {
        run_phase<S_NORM1>(p, layer, smem); GSYNC();
        run_gemm_phase<S_GEMM_IN>(p, layer, smem, xb.x, (volatile LAS unsigned*)&xb_words + 2); GSYNC();
        run_dyn_phase<0>(p, layer, smem, (volatile LAS unsigned*)&xb_words + 2); GSYNC();
        run_dyn_phase<1>(p, layer, smem, (volatile LAS unsigned*)&xb_words + 2); GSYNC();
        run_dyn_phase<2>(p, layer, smem, (volatile LAS unsigned*)&xb_words + 2); GSYNC();
        run_gemm_phase<S_GEMM_OUT>(p, layer, smem, xb.x, (volatile LAS unsigned*)&xb_words + 2); GSYNC();
        run_phase<S_NORM2>(p, layer, smem); GSYNC();
        run_gemm_phase<S_GEMM_Q>(p, layer, smem, xb.x, (volatile LAS unsigned*)&xb_words + 2); GSYNC();
        run_phase<S_PEER_TOPK>(p, layer, smem); GSYNC();
        run_phase<S_PEER_GATHER>(p, layer, smem); GSYNC();
    }
}
#else
template <int S>
__global__ void __launch_bounds__(NTHREADS) k_stage(P p, int layer) {
    __shared__ __attribute__((aligned(16))) char smem[SMEM_BYTES];
    run_unit<S>(p, layer, blockIdx.x, smem);
}
template <int S> static void launch_stage(const P& p, int layer, hipStream_t st) {
    hipLaunchKernelGGL((k_stage<S>), dim3(nunits(S)), dim3(NTHREADS), 0, st, p, layer);
}
#endif

extern "C" void kernel_launch(void* const* d_in, const int* in_sizes, int n_in, void* d_out, int out_size, void* d_ws, size_t ws_size, hipStream_t stream) {
    P p{};
    p.x = (const float*)d_in[0]; p.c = (const float*)d_in[1]; p.pos = (const int*)d_in[2]; p.ada_w = (const float*)d_in[3]; p.ada_b = (const float*)d_in[4];
    p.n1g = (const float*)d_in[5]; p.n2g = (const float*)d_in[6]; p.w_in = (const float*)d_in[7]; p.w_out = (const float*)d_in[8]; p.conv_w = (const float*)d_in[9];
    p.conv_b = (const float*)d_in[10]; p.cln_g = (const float*)d_in[11]; p.cln_b = (const float*)d_in[12]; p.sln_g = (const float*)d_in[13]; p.sln_b = (const float*)d_in[14];
    p.sgu_w = (const float*)d_in[15]; p.sgu_b = (const float*)d_in[16]; p.nsa_qg = (const float*)d_in[17]; p.nsa_kg = (const float*)d_in[18]; p.cmp_pos = (const float*)d_in[19];
    p.cmp_w1 = (const float*)d_in[20]; p.cmp_w2 = (const float*)d_in[21]; p.dsa_qg = (const float*)d_in[22]; p.dsa_kg = (const float*)d_in[23]; p.peer_wq = (const float*)d_in[24];
    p.peer_sk = (const float*)d_in[25]; p.peer_u = (const float*)d_in[26]; p.peer_v = (const float*)d_in[27];
    p.out = (float*)d_out;
    p.ws = (char*)d_ws; const size_t off = WS_TOTAL;
    if (off > ws_size) { fprintf(stderr, "workspace too small: need %zu have %zu\n", off, ws_size); return; }
#ifndef MULTI_LAUNCH
    static int grid_blocks = 0;
    if (!grid_blocks) {
        int dev = 0, cus = 0, per_cu = 0;
        (void)hipGetDevice(&dev);
        (void)hipDeviceGetAttribute(&cus, hipDeviceAttributeMultiprocessorCount, dev);
        (void)hipOccupancyMaxActiveBlocksPerMultiprocessor(&per_cu, k_mega, NTHREADS, 0);
        if (per_cu > 2) per_cu = 2;
        grid_blocks = cus * per_cu;
    }
    (void)hipMemsetAsync(p.bar(), 0, (size_t)CTRL_WORDS * 4, stream);
    void* args[] = {&p};
    hipError_t e = hipLaunchCooperativeKernel((void*)k_mega, dim3(grid_blocks), dim3(NTHREADS), args, 0, stream);
    if (e != hipSuccess) fprintf(stderr, "cooperative launch failed: %s (grid %d)\n", hipGetErrorString(e), grid_blocks);
#else
    launch_stage<S_CONVT_IN>(p, 0, stream); launch_stage<S_CONVT_OUT>(p, 0, stream); launch_stage<S_CONVT_Q>(p, 0, stream); launch_stage<S_CONVT_W1>(p, 0, stream);
    launch_stage<S_TAB_U>(p, 0, stream); launch_stage<S_TAB_V>(p, 0, stream);
    launch_stage<S_ADA>(p, 0, stream); launch_stage<S_ROPE>(p, 0, stream);
    for (int layer = 0; layer < NL; ++layer) {
        launch_stage<S_NORM1>(p, layer, stream); launch_stage<S_GEMM_IN>(p, layer, stream);
        launch_stage<S_CONV>(p, layer, stream); launch_stage<S_SGU>(p, layer, stream); launch_stage<S_VTRANS>(p, layer, stream);
        launch_stage<S_PREP>(p, layer, stream); launch_stage<S_COMPRESS>(p, layer, stream);
        launch_stage<S_NSA_CMP>(p, layer, stream); launch_stage<S_DSA_INDEX>(p, layer, stream);
        launch_stage<S_NSA_ATTN>(p, layer, stream); launch_stage<S_DSA_ATTN>(p, layer, stream);
        launch_stage<S_GEMM_OUT>(p, layer, stream); launch_stage<S_NORM2>(p, layer, stream); launch_stage<S_GEMM_Q>(p, layer, stream);
        launch_stage<S_PEER_TOPK>(p, layer, stream); launch_stage<S_PEER_GATHER>(p, layer, stream);
    }
#endif
}
```

```cpp
#include <hip/hip_runtime.h>
#include <hip/hip_cooperative_groups.h>
#include <stdint.h>
#include <cstdio>
namespace cg = cooperative_groups;

typedef unsigned short bf16_t;
typedef short bf16x8 __attribute__((ext_vector_type(8)));
typedef float f32x4 __attribute__((ext_vector_type(4)));
typedef float f32x16 __attribute__((ext_vector_type(16)));
#define DEV __device__ __forceinline__

constexpr int T = 8192, D = 2048, NL = 2;
constexpr int INC = 4692;
constexpr int LDP = 4736;
constexpr int C_CA = 0, C_CG = 512, C_SU = 1024, C_SV = 1536;
constexpr int C_NQ = 2048, C_NKC = 2560, C_NVC = 2688, C_NKS = 2816, C_NVS = 2944, C_NKW = 3072, C_NVW = 3200;
constexpr int C_DQ = 3328, C_DK = 3840, C_DV = 3968, C_IQ = 4096, C_IK = 4608, C_NG = 4672, C_IW = 4688;
constexpr float EPS = 1e-6f;
constexpr int NTHREADS = 256;
constexpr int SMEM_BYTES = 72 * 1024;

__device__ const double INV16[16] = {1.0, 0.44036660267178046, 0.19392274474868576, 0.08539710028576561, 0.03760603093086393,
    0.016560440080994446, 0.007292664737217109, 0.003211445994752591, 0.001414213562373095, 0.000622772421914596,
    0.0002742481756762073, 0.00012076973741146504, 5.318295896944988e-05, 2.341999896140934e-05, 1.031338537721246e-05,
    4.5416704806078695e-06};

#define XCD_BAR_WORDS 3456
#define GQ_WORD(inst, x) (XCD_BAR_WORDS + 64 * ((inst) * 8 + (x)))
#define DQ_WORD(k) (XCD_BAR_WORDS + 64 * (96 + (k)))
#define CTRL_WORDS (XCD_BAR_WORDS + 64 * 112)
constexpr size_t WS_ALIGN(size_t x) { return (x + 255) & ~(size_t)255; }
constexpr size_t OFF_WinT = 0;
constexpr size_t OFF_WoutT = OFF_WinT + WS_ALIGN((size_t)2 * LDP * 2048 * 2);
constexpr size_t OFF_WqT = OFF_WoutT + WS_ALIGN((size_t)2 * 2048 * 2048 * 2);
constexpr size_t OFF_W1T = OFF_WqT + WS_ALIGN((size_t)2 * 1024 * 2048 * 2);
constexpr size_t OFF_PI = OFF_W1T + WS_ALIGN((size_t)4 * 128 * 4096 * 2);
constexpr size_t OFF_Utab = OFF_PI + WS_ALIGN(256);
constexpr size_t OFF_Vtab = OFF_Utab + WS_ALIGN((size_t)2 * 16384 * 1536);
constexpr size_t OFF_ada = OFF_Vtab + WS_ALIGN((size_t)2 * 16384 * 1536);
constexpr size_t OFF_ropeC = OFF_ada + WS_ALIGN((size_t)2 * 12288 * 4);
constexpr size_t OFF_ropeS = OFF_ropeC + WS_ALIGN((size_t)T * 24 * 4);
constexpr size_t OFF_HN = OFF_ropeS + WS_ALIGN((size_t)T * 24 * 4);
constexpr size_t OFF_PROJ = OFF_HN + WS_ALIGN((size_t)T * D * 2);
constexpr size_t OFF_Y = OFF_PROJ + WS_ALIGN((size_t)T * LDP * 2);
constexpr size_t OFF_QN = OFF_Y + WS_ALIGN((size_t)T * D * 2);
constexpr size_t OFF_QR = OFF_QN + WS_ALIGN((size_t)T * 512 * 2);
constexpr size_t OFF_KS = OFF_QR + WS_ALIGN((size_t)T * 512 * 2);
constexpr size_t OFF_KW = OFF_KS + WS_ALIGN((size_t)T * 128 * 2);
constexpr size_t OFF_VST = OFF_KW + WS_ALIGN((size_t)T * 128 * 2);
constexpr size_t OFF_VWT = OFF_VST + WS_ALIGN((size_t)T * 128 * 2);
constexpr size_t OFF_GATES = OFF_VWT + WS_ALIGN((size_t)T * 128 * 2);
constexpr size_t OFF_KC = OFF_GATES + WS_ALIGN((size_t)T * 12 * 4);
constexpr size_t OFF_VCT = OFF_KC + WS_ALIGN((size_t)512 * 128 * 2);
constexpr size_t OFF_SEL = OFF_VCT + WS_ALIGN((size_t)128 * 512 * 2);
constexpr size_t OFF_OCMP = OFF_SEL + WS_ALIGN((size_t)T * 4 * 4);
constexpr size_t OFF_DQ = OFF_OCMP + WS_ALIGN((size_t)T * 512 * 2);
constexpr size_t OFF_DK = OFF_DQ + WS_ALIGN((size_t)T * 512 * 2);
constexpr size_t OFF_IQ = OFF_DK + WS_ALIGN((size_t)T * 128 * 2);
constexpr size_t OFF_IK = OFF_IQ + WS_ALIGN((size_t)T * 512 * 2);
constexpr size_t OFF_IW = OFF_IK + WS_ALIGN((size_t)T * 64 * 2);
constexpr size_t OFF_IDX = OFF_IW + WS_ALIGN((size_t)T * 8 * 4);
constexpr size_t OFF_CNT = OFF_IDX + WS_ALIGN((size_t)T * 256 * 4);
constexpr size_t OFF_X1 = OFF_CNT + WS_ALIGN((size_t)T * 4);
constexpr size_t OFF_X2 = OFF_X1 + WS_ALIGN((size_t)T * D * 4);
constexpr size_t OFF_PQ = OFF_X2 + WS_ALIGN((size_t)T * D * 4);
constexpr size_t OFF_PE = OFF_PQ + WS_ALIGN((size_t)T * 1024 * 4);
constexpr size_t OFF_PG = OFF_PE + WS_ALIGN((size_t)T * 128 * 4);
constexpr size_t OFF_bar = OFF_PG + WS_ALIGN((size_t)T * 128 * 4);
constexpr size_t WS_TOTAL = OFF_bar + WS_ALIGN((size_t)CTRL_WORDS * 4);

struct P {
    const float* x; const float* c; const int* pos; const float* ada_w; const float* ada_b; const float* n1g; const float* n2g;
    const float* w_in; const float* w_out; const float* conv_w; const float* conv_b; const float* cln_g; const float* cln_b;
    const float* sln_g; const float* sln_b; const float* sgu_w; const float* sgu_b; const float* nsa_qg; const float* nsa_kg;
    const float* cmp_pos; const float* cmp_w1; const float* cmp_w2; const float* dsa_qg; const float* dsa_kg;
    const float* peer_wq; const float* peer_sk; const float* peer_u; const float* peer_v;
    float* out;
    char* ws;
    __host__ __device__ __forceinline__ bf16_t* WinT() const { return (bf16_t*)(ws + OFF_WinT); }
    __host__ __device__ __forceinline__ bf16_t* WoutT() const { return (bf16_t*)(ws + OFF_WoutT); }
    __host__ __device__ __forceinline__ bf16_t* WqT() const { return (bf16_t*)(ws + OFF_WqT); }
    __host__ __device__ __forceinline__ bf16_t* W1T() const { return (bf16_t*)(ws + OFF_W1T); }
    __host__ __device__ __forceinline__ int* PI() const { return (int*)(ws + OFF_PI); }
    __host__ __device__ __forceinline__ unsigned char* Utab() const { return (unsigned char*)(ws + OFF_Utab); }
    __host__ __device__ __forceinline__ unsigned char* Vtab() const { return (unsigned char*)(ws + OFF_Vtab); }
    __host__ __device__ __forceinline__ float* ada() const { return (float*)(ws + OFF_ada); }
    __host__ __device__ __forceinline__ float* ropeC() const { return (float*)(ws + OFF_ropeC); }
    __host__ __device__ __forceinline__ float* ropeS() const { return (float*)(ws + OFF_ropeS); }
    __host__ __device__ __forceinline__ bf16_t* HN() const { return (bf16_t*)(ws + OFF_HN); }
    __host__ __device__ __forceinline__ bf16_t* PROJ() const { return (bf16_t*)(ws + OFF_PROJ); }
    __host__ __device__ __forceinline__ bf16_t* Y() const { return (bf16_t*)(ws + OFF_Y); }
    __host__ __device__ __forceinline__ bf16_t* QN() const { return (bf16_t*)(ws + OFF_QN); }
    __host__ __device__ __forceinline__ bf16_t* QR() const { return (bf16_t*)(ws + OFF_QR); }
    __host__ __device__ __forceinline__ bf16_t* KS() const { return (bf16_t*)(ws + OFF_KS); }
    __host__ __device__ __forceinline__ bf16_t* KW() const { return (bf16_t*)(ws + OFF_KW); }
    __host__ __device__ __forceinline__ bf16_t* VST() const { return (bf16_t*)(ws + OFF_VST); }
    __host__ __device__ __forceinline__ bf16_t* VWT() const { return (bf16_t*)(ws + OFF_VWT); }
    __host__ __device__ __forceinline__ float* GATES() const { return (float*)(ws + OFF_GATES); }
    __host__ __device__ __forceinline__ bf16_t* KC() const { return (bf16_t*)(ws + OFF_KC); }
    __host__ __device__ __forceinline__ bf16_t* VCT() const { return (bf16_t*)(ws + OFF_VCT); }
    __host__ __device__ __forceinline__ unsigned* SEL() const { return (unsigned*)(ws + OFF_SEL); }
    __host__ __device__ __forceinline__ bf16_t* OCMP() const { return (bf16_t*)(ws + OFF_OCMP); }
    __host__ __device__ __forceinline__ bf16_t* DQ() const { return (bf16_t*)(ws + OFF_DQ); }
    __host__ __device__ __forceinline__ bf16_t* DK() const { return (bf16_t*)(ws + OFF_DK); }
    __host__ __device__ __forceinline__ bf16_t* IQ() const { return (bf16_t*)(ws + OFF_IQ); }
    __host__ __device__ __forceinline__ bf16_t* IK() const { return (bf16_t*)(ws + OFF_IK); }
    __host__ __device__ __forceinline__ float* IW() const { return (float*)(ws + OFF_IW); }
    __host__ __device__ __forceinline__ int* IDX() const { return (int*)(ws + OFF_IDX); }
    __host__ __device__ __forceinline__ int* CNT() const { return (int*)(ws + OFF_CNT); }
    __host__ __device__ __forceinline__ float* X1() const { return (float*)(ws + OFF_X1); }
    __host__ __device__ __forceinline__ float* X2() const { return (float*)(ws + OFF_X2); }
    __host__ __device__ __forceinline__ float* PQ() const { return (float*)(ws + OFF_PQ); }
    __host__ __device__ __forceinline__ int* PE() const { return (int*)(ws + OFF_PE); }
    __host__ __device__ __forceinline__ float* PG() const { return (float*)(ws + OFF_PG); }
    __host__ __device__ __forceinline__ unsigned* bar() const { return (unsigned*)(ws + OFF_bar); }
};

DEV float bf2f(bf16_t v) { return __uint_as_float(((unsigned)v) << 16); }
DEV unsigned pk2(float lo, float hi) { unsigned r; asm("v_cvt_pk_bf16_f32 %0, %1, %2" : "=v"(r) : "v"(lo), "v"(hi)); return r; }
DEV bf16_t f2bf(float v) { return (bf16_t)(pk2(v, 0.f) & 0xffffu); }
DEV float lo2f(unsigned u) { return __uint_as_float(u << 16); }
DEV float hi2f(unsigned u) { return __uint_as_float(u & 0xffff0000u); }
DEV float wsum(float v) {
#pragma unroll
    for (int o = 32; o > 0; o >>= 1) v += __shfl_xor(v, o);
    return v;
}
DEV float wmax(float v) {
#pragma unroll
    for (int o = 32; o > 0; o >>= 1) v = fmaxf(v, __shfl_xor(v, o));
    return v;
}
DEV int tidx() { int t = threadIdx.x; asm volatile("" : "+v"(t)); return t; }
DEV float sigmoidf_(float x) { return 1.0f / (1.0f + __expf(-x)); }
DEV float gelu_tanh(float x) {
    const float y = 0.7978845608028654f * (x + 0.044715f * x * x * x);
    const float t = 1.0f - 2.0f / (1.0f + __expf(2.0f * y));
    return 0.5f * x * (1.0f + t);
}
DEV f32x4 mfma16(bf16x8 a, bf16x8 b, f32x4 c) { return __builtin_amdgcn_mfma_f32_16x16x32_bf16(a, b, c, 0, 0, 0); }
DEV f32x16 mfma32(bf16x8 a, bf16x8 b, f32x16 c) { return __builtin_amdgcn_mfma_f32_32x32x16_bf16(a, b, c, 0, 0, 0); }

DEV int src_col(int n) {
    if (n < 3328) return n;
    if (n < 4672) return 3340 + (n - 3328);
    if (n < 4684) return 3328 + (n - 4672);
    if (n < 4688) return -1;
    if (n < 4696) return 4684 + (n - 4688);
    return -1;
}

DEV void st_convT(const float* __restrict__ W, bf16_t* __restrict__ Bt, int N, int Npad, bool remap, int unit, char* smem, int Kdim = 2048) {
    float (*tile)[65] = (float (*)[65])smem;
    const int ntn = Npad / 64, kt = unit / ntn, nt = unit % ntn, k0 = kt * 64, n0 = nt * 64;
    const int tid_ = tidx(); const int tx = tid_ & 63, ty = tid_ >> 6;
    const int n = n0 + tx;
    const int src = remap ? src_col(n) : (n < N ? n : -1);
#pragma unroll
    for (int i = 0; i < 16; ++i) { const int k = ty + 4 * i; tile[k][tx] = src >= 0 ? W[(size_t)(k0 + k) * N + src] : 0.f; }
    __syncthreads();
#pragma unroll
    for (int i = 0; i < 16; ++i) { const int r = ty + 4 * i; Bt[(size_t)(n0 + r) * Kdim + k0 + tx] = f2bf(tile[tx][r]); }
    __syncthreads();
}

typedef float f32x2 __attribute__((ext_vector_type(2)));
typedef float v16f __attribute__((ext_vector_type(16)));
typedef float v32f __attribute__((ext_vector_type(32)));
typedef unsigned v6u __attribute__((ext_vector_type(6)));
constexpr float U6_SCALE = 64.0f, V6_SCALE = 3.0f;
constexpr int ROW6 = 1536;
#define FP6_ONE __uint_as_float(0x3F80007Fu)

#ifndef SW_FP6
#define SW_FP6 1
#endif
DEV unsigned fp6_enc1(float f) {
    const unsigned sg = f < 0.f ? 32u : 0u; float a = fminf(fabsf(f), 7.5f);
    unsigned code;
    if (a < 1.0f) code = (unsigned)__builtin_rintf(a * 8.0f);
    else { int e = a >= 4.f ? 2 : (a >= 2.f ? 1 : 0); const float mant = a / (float)(1 << e); int m = (int)__builtin_rintf((mant - 1.0f) * 8.0f); if (m == 8) { m = 0; e += 1; } code = ((unsigned)(e + 1) << 3) | (unsigned)m; if (code > 31u) code = 31u; }
    return sg | code;
}
DEV float fp6_dec1(unsigned c) {
    const unsigned e = (c >> 3) & 3u, m = c & 7u;
    const float v = e == 0u ? 0.125f * (float)m : (1.0f + 0.125f * (float)m) * (float)(1u << (e - 1u));
    return (c & 32u) ? -v : v;
}
DEV v6u sw_pack32(const v16f& x, const v16f& y) {
    unsigned w[6] = {0u, 0u, 0u, 0u, 0u, 0u};
#pragma unroll
    for (int i = 0; i < 32; ++i) {
        const unsigned c = fp6_enc1(i < 16 ? x[i] : y[i - 16]);
        const int bit = 6 * i, d = bit >> 5, sh = bit & 31;
        w[d] |= c << sh;
        if (sh > 26) w[d + 1] |= c >> (32 - sh);
    }
    v6u r; r[0] = w[0]; r[1] = w[1]; r[2] = w[2]; r[3] = w[3]; r[4] = w[4]; r[5] = w[5]; return r;
}
DEV v32f sw_unpack32(const v6u& pk) {
    const unsigned w[6] = {pk[0], pk[1], pk[2], pk[3], pk[4], pk[5]};
    v32f r;
#pragma unroll
    for (int i = 0; i < 32; ++i) {
        const int bit = 6 * i, d = bit >> 5, sh = bit & 31;
        unsigned c = w[d] >> sh;
        if (sh > 26) c |= w[d + 1] << (32 - sh);
        r[i] = fp6_dec1(c & 63u);
    }
    return r;
}
#define FP6_PACK(x, y) sw_pack32(x, y)
#define FP6_UNPACK(pk) __builtin_amdgcn_cvt_scalef32_pk32_f32_fp6(pk, FP6_ONE)
DEV void st_tab6(const float* __restrict__ src, unsigned char* __restrict__ dst, float scale, int nrows, int unit, int nunits, char* smem) {
    const int tid_ = tidx(), w = tid_ >> 6, l = tid_ & 63;
    float* stg = (float*)smem + w * (64 * 36);
    for (int r = unit * 4 + w; r < nrows; r += nunits * 4) {
        const float4* sp = (const float4*)(src + (size_t)r * 2048);
        float4 v[8];
#pragma unroll
        for (int i = 0; i < 8; ++i) v[i] = sp[l + 64 * i];
#pragma unroll
        for (int i = 0; i < 8; ++i) { const int f = l + 64 * i; *(float4*)(stg + (f >> 3) * 36 + (f & 7) * 4) = v[i]; }
        __builtin_amdgcn_wave_barrier();
        v16f x, y;
#pragma unroll
        for (int q = 0; q < 4; ++q) {
            const float4 a = *(const float4*)(stg + l * 36 + q * 4), b = *(const float4*)(stg + l * 36 + 16 + q * 4);
            x[4 * q] = a.x * scale; x[4 * q + 1] = a.y * scale; x[4 * q + 2] = a.z * scale; x[4 * q + 3] = a.w * scale;
            y[4 * q] = b.x * scale; y[4 * q + 1] = b.y * scale; y[4 * q + 2] = b.z * scale; y[4 * q + 3] = b.w * scale;
        }
        const v6u pk = FP6_PACK(x, y);
        unsigned char* dp = dst + (size_t)r * ROW6 + l * 8;
        *(uint2*)(dp) = make_uint2(pk[0], pk[1]); *(uint2*)(dp + 512) = make_uint2(pk[2], pk[3]); *(uint2*)(dp + 1024) = make_uint2(pk[4], pk[5]);
        __builtin_amdgcn_wave_barrier();
    }
}
DEV void st_calib(const P& p) {
    if (tidx() >= 64) return;
    v16f x, y;
#pragma unroll
    for (int k = 0; k < 32; ++k) {
        const int e = k >> 3, m = k & 7;
        const float v = e == 0 ? 0.125f * m : (1.0f + 0.125f * m) * (float)(1 << (e - 1));
        if (k < 16) x[k] = v; else y[k - 16] = v;
    }
    const v6u pk = FP6_PACK(x, y);
    const v32f d = FP6_UNPACK(pk);
    if ((threadIdx.x & 63) == 0) {
        float dmax = 0.f;
#pragma unroll
        for (int j = 0; j < 32; ++j) dmax = fmaxf(dmax, fabsf(d[j]));
        const float cscale = dmax > 0.f ? dmax * (1.0f / 7.5f) : 1.0f;
        const float ic = 1.0f / cscale;
#pragma unroll
        for (int j = 0; j < 32; ++j) {
            int found = j;
#pragma unroll
            for (int k = 0; k < 32; ++k) {
                const int e = k >> 3, m = k & 7;
                const float v = e == 0 ? 0.125f * m : (1.0f + 0.125f * m) * (float)(1 << (e - 1));
                if (fabsf(d[j] * ic - v) < 0.02f + 0.01f * v) found = k;
            }
            p.PI()[j] = found;
        }
        p.PI()[32] = __float_as_int(ic);
    }
}

DEV void st_ada(const P& p, int unit, char* smem) {
    float4* red = (float4*)smem;
    const int tid = tidx(), c4 = tid & 15, kg = tid >> 4;
    const int i = unit / 192, j = (unit % 192) * 64 + c4 * 4;
    const float* W = p.ada_w + (size_t)i * 2048 * 12288 + (size_t)kg * 12288 + j;
    float4 acc = make_float4(0.f, 0.f, 0.f, 0.f);
#pragma unroll 8
    for (int k = 0; k < 128; ++k) {
        const float cv = p.c[kg + 16 * k];
        const float a = cv * sigmoidf_(cv);
        const float4 wv = *(const float4*)(W + (size_t)(16 * k) * 12288);
        acc.x += a * wv.x; acc.y += a * wv.y; acc.z += a * wv.z; acc.w += a * wv.w;
    }
    red[kg * 16 + c4] = acc;
    __syncthreads();
    if (tid < 64) {
        const int cc = tid >> 2, e = tid & 3;
        float r = p.ada_b[i * 12288 + (unit % 192) * 64 + tid];
#pragma unroll
        for (int q = 0; q < 16; ++q) r += ((const float*)&red[q * 16 + cc])[e];
        p.ada()[i * 12288 + (unit % 192) * 64 + tid] = r;
    }
    __syncthreads();
}
DEV void st_rope(const P& p, int unit) {
    const int e = unit * 256 + tidx(); const int t = e / 24, i = e % 24;
    const double inv = i < 16 ? INV16[i] : INV16[2 * (i - 16)];
    const double ang = (double)p.pos[t] * inv;
    const double n = rint(ang * 0.15915494309189535);
    const double r = ang - n * 6.283185307179586;
    const double r2 = r * r;
    double sp = 1.0 / 1.5511210043330986e25, cp = -1.0 / 4.0329146112660565e26;
    sp = sp * r2 - 1.0 / 2.585201673888498e22;   cp = cp * r2 + 1.0 / 6.204484017332394e23;
    sp = sp * r2 + 1.0 / 5.109094217170944e19;   cp = cp * r2 - 1.0 / 1.1240007277776077e21;
    sp = sp * r2 - 1.0 / 1.21645100408832e17;    cp = cp * r2 + 1.0 / 2.43290200817664e18;
    sp = sp * r2 + 1.0 / 3.55687428096e14;       cp = cp * r2 - 1.0 / 6.402373705728e15;
    sp = sp * r2 - 1.0 / 1.307674368e12;         cp = cp * r2 + 1.0 / 2.0922789888e13;
    sp = sp * r2 + 1.0 / 6.2270208e9;            cp = cp * r2 - 1.0 / 8.71782912e10;
    sp = sp * r2 - 1.0 / 3.99168e7;              cp = cp * r2 + 1.0 / 4.790016e8;
    sp = sp * r2 + 1.0 / 362880.0;               cp = cp * r2 - 1.0 / 3628800.0;
    sp = sp * r2 - 1.0 / 5040.0;                 cp = cp * r2 + 1.0 / 40320.0;
    sp = sp * r2 + 1.0 / 120.0;                  cp = cp * r2 - 1.0 / 720.0;
    sp = sp * r2 - 1.0 / 6.0;                    cp = cp * r2 + 1.0 / 24.0;
    sp = sp * r2 + 1.0;                          cp = cp * r2 - 0.5;
    cp = cp * r2 + 1.0;
    const float cs = (float)cp, sn = (float)(sp * r);
    p.ropeC()[e] = cs; p.ropeS()[e] = sn;
}

DEV void st_norm(const float* __restrict__ X, const float* __restrict__ g, const float* __restrict__ sc, const float* __restrict__ sh,
                 bf16_t* __restrict__ HN, int unit) {
    const int tid_ = tidx(); const int w = tid_ >> 6, l = tid_ & 63; const int t = unit * 4 + w;
    const float4* xr = (const float4*)(X + (size_t)t * D);
    float4 v[8]; float ss = 0.f;
#pragma unroll
    for (int i = 0; i < 4; ++i) { v[2 * i] = xr[i * 128 + l * 2]; v[2 * i + 1] = xr[i * 128 + l * 2 + 1]; }
#pragma unroll
    for (int i = 0; i < 8; ++i) ss += v[i].x * v[i].x + v[i].y * v[i].y + v[i].z * v[i].z + v[i].w * v[i].w;
    ss = wsum(ss);
    const float rs = rsqrtf(ss * (1.0f / 2048.0f) + EPS);
#pragma unroll
    for (int i = 0; i < 4; ++i) {
        const int col = i * 512 + l * 8;
        float y[8]; const float xv[8] = {v[2 * i].x, v[2 * i].y, v[2 * i].z, v[2 * i].w, v[2 * i + 1].x, v[2 * i + 1].y, v[2 * i + 1].z, v[2 * i + 1].w};
#pragma unroll
        for (int j = 0; j < 8; ++j) y[j] = (xv[j] * rs) * g[col + j] * (1.0f + sc[col + j]) + sh[col + j];
        uint4 o; o.x = pk2(y[0], y[1]); o.y = pk2(y[2], y[3]); o.z = pk2(y[4], y[5]); o.w = pk2(y[6], y[7]);
        *(uint4*)(HN + (size_t)t * D + col) = o;
    }
}

enum { EPI_PROJ = 0, EPI_OUT = 1, EPI_Q = 2 };
struct EpiArgs { bf16_t* obf; float* of; const float* xin; const float* gate; };
template <int EPI>
DEV void st_gemm(const bf16_t* __restrict__ A, const bf16_t* __restrict__ Bt, int K, int tm, int tn, const EpiArgs& e, char* smem) {
    const int tid = tidx(), w = tid >> 6, l = tid & 63, wr = w >> 1, wc = w & 1;
    f32x4 acc[4][4];
#pragma unroll
    for (int m = 0; m < 4; ++m)
#pragma unroll
        for (int n = 0; n < 4; ++n) acc[m][n] = (f32x4){0.f, 0.f, 0.f, 0.f};
    const int srow = tid >> 2, spc = tid & 3, sc = spc ^ (((srow >> 2) & 1) << 1);
    const bf16_t* Ag = A + (size_t)(tm * 128 + srow) * K + sc * 8;
    const bf16_t* Bg = Bt + (size_t)(tn * 128 + srow) * K + sc * 8;
#define GEMM_STAGE(BUF, KO) do { char* _b = smem + (BUF) * 16384 + tid * 16; \
        __builtin_amdgcn_global_load_lds((const unsigned*)(Ag + (KO)), (__attribute__((address_space(3))) unsigned*)(_b), 16, 0, 0); \
        __builtin_amdgcn_global_load_lds((const unsigned*)(Ag + (size_t)64 * K + (KO)), (__attribute__((address_space(3))) unsigned*)(_b + 4096), 16, 0, 0); \
        __builtin_amdgcn_global_load_lds((const unsigned*)(Bg + (KO)), (__attribute__((address_space(3))) unsigned*)(_b + 8192), 16, 0, 0); \
        __builtin_amdgcn_global_load_lds((const unsigned*)(Bg + (size_t)64 * K + (KO)), (__attribute__((address_space(3))) unsigned*)(_b + 12288), 16, 0, 0); } while (0)
    const int nk = K / 32;
    GEMM_STAGE(0, 0); GEMM_STAGE(1, 32); GEMM_STAGE(2, 64);
    asm volatile("s_waitcnt vmcnt(8)" ::: "memory");
    __builtin_amdgcn_s_barrier();
    const int fr = l & 15, fq = l >> 4;
#pragma unroll 1
    for (int kt = 0; kt < nk; ++kt) {
        if (kt + 3 < nk) GEMM_STAGE((kt + 3) & 3, (kt + 3) * 32);
        const char* As = smem + (kt & 3) * 16384; const char* Bs = As + 8192;
        bf16x8 af[4], bfr[4];
#pragma unroll
        for (int m = 0; m < 4; ++m) { const int row = wr * 64 + m * 16 + fr; af[m] = *(const bf16x8*)(As + row * 64 + ((fq ^ (((row >> 2) & 1) << 1)) << 4)); }
#pragma unroll
        for (int n = 0; n < 4; ++n) { const int row = wc * 64 + n * 16 + fr; bfr[n] = *(const bf16x8*)(Bs + row * 64 + ((fq ^ (((row >> 2) & 1) << 1)) << 4)); }
#pragma unroll
        for (int m = 0; m < 4; ++m)
#pragma unroll
            for (int n = 0; n < 4; ++n) acc[m][n] = mfma16(bfr[n], af[m], acc[m][n]);
        if (kt + 3 < nk) asm volatile("s_waitcnt vmcnt(8)" ::: "memory");
        else if (kt + 2 < nk) asm volatile("s_waitcnt vmcnt(4)" ::: "memory");
        else asm volatile("s_waitcnt vmcnt(0)" ::: "memory");
        asm volatile("s_waitcnt lgkmcnt(0)" ::: "memory");
        __builtin_amdgcn_s_barrier();
    }
#undef GEMM_STAGE
#pragma unroll
    for (int m = 0; m < 4; ++m) {
        const int row = tm * 128 + wr * 64 + m * 16 + (l & 15);
#pragma unroll
        for (int n = 0; n < 4; ++n) {
            const int col = tn * 128 + wc * 64 + n * 16 + 4 * (l >> 4);
            const f32x4 a = acc[m][n];
            if (EPI == EPI_PROJ) {
                uint2 o; o.x = pk2(a[0], a[1]); o.y = pk2(a[2], a[3]);
                *(uint2*)(e.obf + (size_t)row * LDP + col) = o;
            } else if (EPI == EPI_OUT) {
                const float4 xi = *(const float4*)(e.xin + (size_t)row * D + col);
                const float4 gg = *(const float4*)(e.gate + col);
                float4 o; o.x = xi.x + gg.x * a[0]; o.y = xi.y + gg.y * a[1]; o.z = xi.z + gg.z * a[2]; o.w = xi.w + gg.w * a[3];
                *(float4*)(e.of + (size_t)row * D + col) = o;
            } else {
                float4 o; o.x = a[0]; o.y = a[1]; o.z = a[2]; o.w = a[3];
                *(float4*)(e.of + (size_t)row * 1024 + col) = o;
            }
        }
    }
    __syncthreads();
}

DEV void st_conv(const P& p, int layer, int unit, char* smem) {
    float* cs = (float*)smem;
    const int tid = tidx(), t0 = unit * 16;
    const float* cw = p.conv_w + (size_t)layer * 31 * 512;
#pragma unroll 1
    for (int cc = 0; cc < 2; ++cc) {
        const int c = tid + 256 * cc;
        float w[31], z[46];
#pragma unroll
        for (int k = 0; k < 31; ++k) w[k] = cw[k * 512 + c];
#pragma unroll
        for (int r = 0; r < 46; ++r) {
            const int t = t0 - 30 + r;
            float zz = 0.f;
            if (t >= 0) {
                const float a = bf2f(p.PROJ()[(size_t)t * LDP + C_CA + c]), g = bf2f(p.PROJ()[(size_t)t * LDP + C_CG + c]);
                zz = a * sigmoidf_(g);
            }
            z[r] = zz;
        }
        const float cb = p.conv_b[layer * 512 + c];
#pragma unroll
        for (int tt = 0; tt < 16; ++tt) {
            float acc = cb;
#pragma unroll
            for (int k = 0; k < 31; ++k) acc += w[k] * z[tt + k];
            cs[tt * 512 + c] = acc;
        }
    }
    __syncthreads();
    const int w = tid >> 6, l = tid & 63;
    const float* lg = p.cln_g + layer * 512; const float* lb = p.cln_b + layer * 512;
#pragma unroll 1
    for (int q = 0; q < 4; ++q) {
        const int tt = w * 4 + q;
        float v[8]; float s = 0.f;
#pragma unroll
        for (int i = 0; i < 8; ++i) { v[i] = cs[tt * 512 + l + 64 * i]; s += v[i]; }
        const float mean = wsum(s) * (1.0f / 512.0f);
        float q2 = 0.f;
#pragma unroll
        for (int i = 0; i < 8; ++i) { const float d = v[i] - mean; q2 += d * d; }
        const float rstd = rsqrtf(wsum(q2) * (1.0f / 512.0f) + EPS);
#pragma unroll
        for (int i = 0; i < 8; ++i) {
            const int c = l + 64 * i;
            const float y = (v[i] - mean) * rstd * lg[c] + lb[c];
            p.Y()[(size_t)(t0 + tt) * D + c] = f2bf(y * sigmoidf_(y));
        }
    }
    __syncthreads();
}

DEV void st_sgu(const P& p, int layer, int unit, char* smem) {
    const int n = unit >> 2, h = unit & 3, tid = tidx(), w = tid >> 6, l = tid & 63;
    float* stat = (float*)smem;
    float* wt = stat + 256;
    float* vt = wt + 16 * 132;
    const int tb = n * 128;
#pragma unroll 1
    for (int q = 0; q < 32; ++q) {
        const int j = w * 32 + q;
        const uint4 raw = *(const uint4*)(p.PROJ() + (size_t)(tb + j) * LDP + C_SV + l * 8);
        float v[8] = {lo2f(raw.x), hi2f(raw.x), lo2f(raw.y), hi2f(raw.y), lo2f(raw.z), hi2f(raw.z), lo2f(raw.w), hi2f(raw.w)};
        float s = 0.f;
#pragma unroll
        for (int i = 0; i < 8; ++i) s += v[i];
        const float mean = wsum(s) * (1.0f / 512.0f);
        float q2 = 0.f;
#pragma unroll
        for (int i = 0; i < 8; ++i) { const float d = v[i] - mean; q2 += d * d; }
        const float rstd = rsqrtf(wsum(q2) * (1.0f / 512.0f) + EPS);
        if (l == 0) { stat[j * 2] = mean; stat[j * 2 + 1] = rstd; }
    }
    __syncthreads();
    const int ti = tid >> 4, td = tid & 15;
    float acc[8][8];
#pragma unroll
    for (int a = 0; a < 8; ++a)
#pragma unroll
        for (int b = 0; b < 8; ++b) acc[a][b] = 0.f;
    const float* Wh = p.sgu_w + ((size_t)layer * 4 + h) * 128 * 128;
    const float* lg = p.sln_g + layer * 512 + h * 128; const float* lb = p.sln_b + layer * 512 + h * 128;
#pragma unroll 1
    for (int jc = 0; jc < 8; ++jc) {
#pragma unroll 2
        for (int q = 0; q < 8; ++q) {
            const int e = tid + 256 * q;
            { const int i = e >> 4, jj = e & 15, j = jc * 16 + jj; wt[jj * 132 + i] = (i >= j) ? Wh[i * 128 + j] : 0.f; }
            { const int jj = e >> 7, d = e & 127, j = jc * 16 + jj;
              const float x = bf2f(p.PROJ()[(size_t)(tb + j) * LDP + C_SV + h * 128 + d]);
              vt[jj * 128 + d] = (x - stat[j * 2]) * stat[j * 2 + 1] * lg[d] + lb[d]; }
        }
        __syncthreads();
        if (w * 32 + 31 >= jc * 16) {
#pragma unroll 2
            for (int jj = 0; jj < 16; ++jj) {
                const float4 w0 = *(const float4*)(wt + jj * 132 + ti * 8), w1 = *(const float4*)(wt + jj * 132 + ti * 8 + 4);
                const float4 v0 = *(const float4*)(vt + jj * 128 + td * 8), v1 = *(const float4*)(vt + jj * 128 + td * 8 + 4);
                const float wv[8] = {w0.x, w0.y, w0.z, w0.w, w1.x, w1.y, w1.z, w1.w};
                const float vv[8] = {v0.x, v0.y, v0.z, v0.w, v1.x, v1.y, v1.z, v1.w};
#pragma unroll
                for (int a = 0; a < 8; ++a)
#pragma unroll
                    for (int b = 0; b < 8; ++b) acc[a][b] += wv[a] * vv[b];
            }
        }
        __syncthreads();
    }
#pragma unroll
    for (int a = 0; a < 8; ++a) {
        const int i = ti * 8 + a; const size_t t = tb + i;
        const float bs = p.sgu_b[((size_t)layer * 4 + h) * 128 + i];
        const uint4 ur = *(const uint4*)(p.PROJ() + t * LDP + C_SU + h * 128 + td * 8);
        const float u[8] = {lo2f(ur.x), hi2f(ur.x), lo2f(ur.y), hi2f(ur.y), lo2f(ur.z), hi2f(ur.z), lo2f(ur.w), hi2f(ur.w)};
        float y[8];
#pragma unroll
        for (int b = 0; b < 8; ++b) y[b] = u[b] * (acc[a][b] + bs);
        uint4 o; o.x = pk2(y[0], y[1]); o.y = pk2(y[2], y[3]); o.z = pk2(y[4], y[5]); o.w = pk2(y[6], y[7]);
        *(uint4*)(p.Y() + t * D + 512 + h * 128 + td * 8) = o;
    }
}

DEV void st_vtrans(const P& p, int unit, char* smem) {
    bf16_t* tile = (bf16_t*)smem;
    const int which = unit & 1, tt0 = (unit >> 1) * 64, tid = tidx();
    const int col0 = which ? C_NVW : C_NVS;
    bf16_t* dst = which ? p.VWT() : p.VST();
#pragma unroll
    for (int q = 0; q < 4; ++q) {
        const int e = tid + 256 * q; const int r = e >> 4, c8 = e & 15;
        const uint4 raw = *(const uint4*)(p.PROJ() + (size_t)(tt0 + r) * LDP + col0 + c8 * 8);
        unsigned* d32 = (unsigned*)(tile + r * 130 + c8 * 8);
        d32[0] = raw.x; d32[1] = raw.y; d32[2] = raw.z; d32[3] = raw.w;
    }
    __syncthreads();
    const int d = tid >> 1, half = tid & 1;
    unsigned o[16];
#pragma unroll
    for (int i = 0; i < 16; ++i) {
        const unsigned a = tile[(half * 32 + 2 * i) * 130 + d], b = tile[(half * 32 + 2 * i + 1) * 130 + d];
        o[i] = a | (b << 16);
    }
    uint4* dp = (uint4*)(dst + (size_t)d * T + tt0 + half * 32);
#pragma unroll
    for (int i = 0; i < 4; ++i) dp[i] = make_uint4(o[4 * i], o[4 * i + 1], o[4 * i + 2], o[4 * i + 3]);
    __syncthreads();
}

DEV void st_prep(const P& p, int layer, int unit) {
    const int tid_ = tidx(); const int w = tid_ >> 6, l = tid_ & 63; const size_t t = (size_t)unit * 4 + w;
    const bf16_t* row = p.PROJ() + t * LDP;
    const float* rc = p.ropeC() + t * 24; const float* rs_ = p.ropeS() + t * 24;
    unsigned raw[11];
#pragma unroll
    for (int h = 0; h < 4; ++h) { raw[h] = *(const unsigned*)(row + C_NQ + h * 128 + 2 * l); raw[6 + h] = *(const unsigned*)(row + C_DQ + h * 128 + 2 * l); }
    raw[4] = *(const unsigned*)(row + C_NKS + 2 * l); raw[5] = *(const unsigned*)(row + C_NKW + 2 * l); raw[10] = *(const unsigned*)(row + C_DK + 2 * l);
    bf16_t iraw[9];
#pragma unroll
    for (int h = 0; h < 9; ++h) iraw[h] = row[(h < 8 ? C_IQ + h * 64 : C_IK) + l];
    const float gq0 = p.nsa_qg[layer * 128 + 2 * l], gq1 = p.nsa_qg[layer * 128 + 2 * l + 1];
    const float gs0 = p.nsa_kg[(layer * 3 + 1) * 128 + 2 * l], gs1 = p.nsa_kg[(layer * 3 + 1) * 128 + 2 * l + 1];
    const float gw0 = p.nsa_kg[(layer * 3 + 2) * 128 + 2 * l], gw1 = p.nsa_kg[(layer * 3 + 2) * 128 + 2 * l + 1];
    const float dq0 = p.dsa_qg[layer * 128 + 2 * l], dq1 = p.dsa_qg[layer * 128 + 2 * l + 1];
    const float dk0 = p.dsa_kg[layer * 128 + 2 * l], dk1 = p.dsa_kg[layer * 128 + 2 * l + 1];
    const float c0 = rc[(2 * l) & 15], c1 = rc[(2 * l + 1) & 15], s0 = rs_[(2 * l) & 15], s1 = rs_[(2 * l + 1) & 15];
    const float ic = rc[16 + (l & 7)], is = rs_[16 + (l & 7)];
    float x0[11], x1[11], ss[11];
#pragma unroll
    for (int h = 0; h < 11; ++h) { x0[h] = lo2f(raw[h]); x1[h] = hi2f(raw[h]); ss[h] = x0[h] * x0[h] + x1[h] * x1[h]; }
#pragma unroll
    for (int o = 32; o > 0; o >>= 1)
#pragma unroll
        for (int h = 0; h < 11; ++h) ss[h] += __shfl_xor(ss[h], o);
#pragma unroll
    for (int h = 0; h < 11; ++h) {
        const float r = rsqrtf(ss[h] * (1.0f / 128.0f) + EPS);
        const float g0 = h < 4 ? gq0 : (h == 4 ? gs0 : (h == 5 ? gw0 : (h < 10 ? dq0 : dk0)));
        const float g1 = h < 4 ? gq1 : (h == 4 ? gs1 : (h == 5 ? gw1 : (h < 10 ? dq1 : dk1)));
        const float n0 = x0[h] * r * g0, n1 = x1[h] * r * g1;
        const float o0 = __shfl_xor(n0, 8), o1 = __shfl_xor(n1, 8);
        float r0 = n0, r1 = n1;
        if (l < 8) { r0 = n0 * c0 - o0 * s0; r1 = n1 * c1 - o1 * s1; }
        else if (l < 16) { r0 = n0 * c0 + o0 * s0; r1 = n1 * c1 + o1 * s1; }
        const unsigned roped = pk2(r0, r1);
        if (h < 4) { *(unsigned*)(p.QN() + (t * 4 + h) * 128 + 2 * l) = pk2(n0, n1); *(unsigned*)(p.QR() + (t * 4 + h) * 128 + 2 * l) = roped; }
        else if (h == 4) *(unsigned*)(p.KS() + t * 128 + 2 * l) = roped;
        else if (h == 5) *(unsigned*)(p.KW() + t * 128 + 2 * l) = roped;
        else if (h < 10) *(unsigned*)(p.DQ() + (t * 4 + (h - 6)) * 128 + 2 * l) = roped;
        else *(unsigned*)(p.DK() + t * 128 + 2 * l) = roped;
    }
    if (l < 12) p.GATES()[t * 12 + l] = sigmoidf_(bf2f(row[C_NG + l]));
#pragma unroll
    for (int h = 0; h < 9; ++h) {
        const float x = bf2f(iraw[h]);
        const float other = __shfl_xor(x, 8);
        float o = x;
        if (l < 16) o = (l < 8) ? (x * ic - other * is) : (x * ic + other * is);
        if (h < 8) p.IQ()[(t * 8 + h) * 64 + l] = f2bf(o); else p.IK()[t * 64 + l] = f2bf(o);
    }
    if (l < 8) p.IW()[t * 8 + l] = bf2f(row[C_IW + l]) * (0.35355339059327373f * 0.125f);
}

DEV void st_compress(const P& p, int layer, int unit, char* smem) {
    const int which = unit & 1, rt = unit >> 1, tid = tidx(), w = tid >> 6, l = tid & 63, fr = l & 15, fq = l >> 4;
    float* hid = (float*)smem;
    float* ob = hid + 16 * 128;
    const int nb = rt * 16 + fr;
    const int col0 = which ? C_NVC : C_NKC;
    const float* ps = p.cmp_pos + ((size_t)layer * 2 + which) * 4096;
    const bf16_t* w1t = p.W1T() + ((size_t)layer * 2 + which) * 128 * 4096;
    const bool rowok = nb < 511;
    const bf16_t* xrow = p.PROJ() + (size_t)(rowok ? nb * 16 : 0) * LDP + col0;
    f32x4 acc[2] = {(f32x4){0.f, 0.f, 0.f, 0.f}, (f32x4){0.f, 0.f, 0.f, 0.f}};
#pragma unroll 4
    for (int ks = 0; ks < 128; ++ks) {
        const int k = ks * 32 + fq * 8, lt = k >> 7, d = k & 127;
        const uint4 xr = *(const uint4*)(xrow + (size_t)lt * LDP + d);
        const float4 p0 = *(const float4*)(ps + k), p1 = *(const float4*)(ps + k + 4);
        union { bf16x8 v; unsigned u32[4]; } a;
        a.u32[0] = pk2(lo2f(xr.x) + p0.x, hi2f(xr.x) + p0.y); a.u32[1] = pk2(lo2f(xr.y) + p0.z, hi2f(xr.y) + p0.w);
        a.u32[2] = pk2(lo2f(xr.z) + p1.x, hi2f(xr.z) + p1.y); a.u32[3] = pk2(lo2f(xr.w) + p1.z, hi2f(xr.w) + p1.w);
#pragma unroll
        for (int nt = 0; nt < 2; ++nt) {
            const bf16x8 b = *(const bf16x8*)(w1t + (size_t)(w * 32 + nt * 16 + fr) * 4096 + k);
            acc[nt] = mfma16(a.v, b, acc[nt]);
        }
    }
#pragma unroll
    for (int nt = 0; nt < 2; ++nt)
#pragma unroll
        for (int r = 0; r < 4; ++r) hid[(4 * fq + r) * 128 + w * 32 + nt * 16 + fr] = gelu_tanh(acc[nt][r]);
    __syncthreads();
    const float* w2 = p.cmp_w2 + ((size_t)layer * 2 + which) * 128 * 128;
    const int c2 = tid & 127, mh = tid >> 7;
    float o[8];
#pragma unroll
    for (int b = 0; b < 8; ++b) o[b] = 0.f;
#pragma unroll 4
    for (int k = 0; k < 128; ++k) {
        const float wv = w2[k * 128 + c2];
#pragma unroll
        for (int b = 0; b < 8; ++b) o[b] += hid[(mh * 8 + b) * 128 + k] * wv;
    }
#pragma unroll
    for (int b = 0; b < 8; ++b) ob[(mh * 8 + b) * 128 + c2] = o[b];
    __syncthreads();
#pragma unroll
    for (int q = 0; q < 4; ++q) {
        const int b = w * 4 + q, nbo = rt * 16 + b;
        float v0 = ob[b * 128 + l], v1 = ob[b * 128 + l + 64];
        if (which == 0) {
            const float r = rsqrtf(wsum(v0 * v0 + v1 * v1) * (1.0f / 128.0f) + EPS);
            const float* kg = p.nsa_kg + (layer * 3 + 0) * 128;
            v0 = v0 * r * kg[l]; v1 = v1 * r * kg[l + 64];
            if (nbo >= 511) { v0 = 0.f; v1 = 0.f; }
            p.KC()[nbo * 128 + l] = f2bf(v0); p.KC()[nbo * 128 + l + 64] = f2bf(v1);
        } else {
            if (nbo >= 511) { v0 = 0.f; v1 = 0.f; }
            p.VCT()[l * 512 + nbo] = f2bf(v0); p.VCT()[(l + 64) * 512 + nbo] = f2bf(v1);
        }
    }
    __syncthreads();
}

DEV void st_nsa_cmp(const P& p, int unit, char* smem) {
    constexpr int RSK = 272, RSV = 136, BUFB = 64 * RSK + 128 * RSV;
    const int tid = tidx(), w = tid >> 6, l = tid & 63, qc = l & 15, g4 = l >> 4;
    const int t0 = unit * 16 + w * 4;
    const int tk = qc >> 2, hd = qc & 3, t = t0 + tk;
    bf16x8 qf[4];
#pragma unroll
    for (int ks = 0; ks < 4; ++ks) qf[ks] = *(const bf16x8*)(p.QN() + ((size_t)t0 * 4 + qc) * 128 + ks * 32 + g4 * 8);
    const int tmaxb = unit * 16 + 15;
    const int nvb = tmaxb >= 31 ? (tmaxb - 31) / 16 + 1 : 0;
    const int nsteps = (nvb + 63) >> 6;
    const int nvis = t >= 31 ? (t - 31) / 16 + 1 : 0;
    const float cs = 0.08838834764831845f * 1.4426950408889634f;
    const int krow = tid >> 4, kc16 = tid & 15, vrow = tid >> 3, vc16 = tid & 7;
    const bf16_t* Kg = p.KC(); const bf16_t* Vg = p.VCT();
    int gstep = 0;
    uint4 rk0, rk1, rk2, rk3, rv0, rv1, rv2, rv3;
#define CMP_LOADK(ST) do { const bf16_t* kb = Kg + (size_t)((ST) * 64 + krow) * 128 + kc16 * 8; \
        rk0 = *(const uint4*)kb; rk1 = *(const uint4*)(kb + 16 * 128); rk2 = *(const uint4*)(kb + 32 * 128); rk3 = *(const uint4*)(kb + 48 * 128); } while (0)
#define CMP_LOADV(ST) do { const bf16_t* vb = Vg + (size_t)vrow * 512 + (ST) * 64 + vc16 * 8; \
        rv0 = *(const uint4*)vb; rv1 = *(const uint4*)(vb + 32 * 512); rv2 = *(const uint4*)(vb + 64 * 512); rv3 = *(const uint4*)(vb + 96 * 512); } while (0)
#define CMP_STOREK(KT) do { *(uint4*)((KT) + krow * RSK + kc16 * 16) = rk0; *(uint4*)((KT) + (krow + 16) * RSK + kc16 * 16) = rk1; \
        *(uint4*)((KT) + (krow + 32) * RSK + kc16 * 16) = rk2; *(uint4*)((KT) + (krow + 48) * RSK + kc16 * 16) = rk3; } while (0)
#define CMP_STOREV(VT) do { *(uint4*)((VT) + vrow * RSV + vc16 * 16) = rv0; *(uint4*)((VT) + (vrow + 32) * RSV + vc16 * 16) = rv1; \
        *(uint4*)((VT) + (vrow + 64) * RSV + vc16 * 16) = rv2; *(uint4*)((VT) + (vrow + 96) * RSV + vc16 * 16) = rv3; } while (0)
    float m = -1e30f, lsum = 0.f;
    if (nsteps > 0) CMP_LOADK(0);
#pragma unroll 1
    for (int st = 0; st < nsteps; ++st, ++gstep) {
        char* Kt = smem + (gstep & 1) * BUFB;
        CMP_STOREK(Kt);
        __syncthreads();
        if (st + 1 < nsteps) CMP_LOADK(st + 1);
        float mx = m; f32x4 sv[4];
#pragma unroll
        for (int sub = 0; sub < 4; ++sub) {
            f32x4 a4 = (f32x4){0.f, 0.f, 0.f, 0.f};
#pragma unroll
            for (int ks = 0; ks < 4; ++ks) a4 = mfma16(*(const bf16x8*)(Kt + (sub * 16 + qc) * RSK + (ks * 32 + g4 * 8) * 2), qf[ks], a4);
#pragma unroll
            for (int r = 0; r < 4; ++r) { const int key = st * 64 + sub * 16 + 4 * g4 + r; a4[r] = (key < nvis) ? a4[r] * cs : -3e38f; mx = fmaxf(mx, a4[r]); }
            sv[sub] = a4;
        }
        float ps = 0.f;
#pragma unroll
        for (int sub = 0; sub < 4; ++sub)
#pragma unroll
            for (int r = 0; r < 4; ++r) ps += __builtin_amdgcn_exp2f(sv[sub][r] - mx);
        lsum = lsum * __builtin_amdgcn_exp2f(m - mx) + ps; m = mx;
    }
    {
        float mt_ = fmaxf(m, __shfl_xor(m, 16)); mt_ = fmaxf(mt_, __shfl_xor(mt_, 32));
        lsum *= __builtin_amdgcn_exp2f(m - mt_); m = mt_;
        lsum += __shfl_xor(lsum, 16); lsum += __shfl_xor(lsum, 32);
    }
    const float inv = (nvis > 0 && lsum > 0.f) ? 1.0f / lsum : 0.f;
    f32x4 o[8];
#pragma unroll
    for (int mt = 0; mt < 8; ++mt) o[mt] = (f32x4){0.f, 0.f, 0.f, 0.f};
    float yprev = 0.f;
    float impv[32];
#pragma unroll
    for (int i = 0; i < 32; ++i) impv[i] = 0.f;
    if (nsteps > 0) { CMP_LOADK(0); CMP_LOADV(0); }
#pragma unroll
    for (int st = 0; st < 8; ++st) {
        if (st < nsteps) {
            char* Kt = smem + (gstep & 1) * BUFB; char* Vt = Kt + 64 * RSK; ++gstep;
            CMP_STOREK(Kt); CMP_STOREV(Vt);
            __syncthreads();
            if (st + 1 < nsteps) { CMP_LOADK(st + 1); CMP_LOADV(st + 1); }
            f32x4 sv[4];
#pragma unroll
            for (int sub = 0; sub < 4; ++sub) {
                f32x4 a4 = (f32x4){0.f, 0.f, 0.f, 0.f};
#pragma unroll
                for (int ks = 0; ks < 4; ++ks) a4 = mfma16(*(const bf16x8*)(Kt + (sub * 16 + qc) * RSK + (ks * 32 + g4 * 8) * 2), qf[ks], a4);
#pragma unroll
                for (int r = 0; r < 4; ++r) { const int key = st * 64 + sub * 16 + 4 * g4 + r; a4[r] = (key < nvis) ? __builtin_amdgcn_exp2f(a4[r] * cs - m) * inv : 0.f; }
                const float y = __shfl(a4[3], (l + 48) & 63);
                float iv = (a4[0] + a4[1]) + (a4[2] + a4[3]) + (g4 > 0 ? y : yprev);
                yprev = y;
                iv += __shfl_xor(iv, 1); iv += __shfl_xor(iv, 2);
                impv[st * 4 + sub] = iv;
                sv[sub] = a4;
            }
#pragma unroll
            for (int pr = 0; pr < 2; ++pr) {
                union { bf16x8 v; unsigned u32[4]; } bb;
                bb.u32[0] = pk2(sv[2 * pr][0], sv[2 * pr][1]); bb.u32[1] = pk2(sv[2 * pr][2], sv[2 * pr][3]);
                bb.u32[2] = pk2(sv[2 * pr + 1][0], sv[2 * pr + 1][1]); bb.u32[3] = pk2(sv[2 * pr + 1][2], sv[2 * pr + 1][3]);
#pragma unroll
                for (int mt = 0; mt < 8; ++mt) {
                    const char* vp = Vt + (mt * 16 + qc) * RSV + (pr * 32 + 4 * g4) * 2;
                    union { bf16x8 v; uint2 h2[2]; } aa;
                    aa.h2[0] = *(const uint2*)vp; aa.h2[1] = *(const uint2*)(vp + 32);
                    o[mt] = mfma16(aa.v, bb.v, o[mt]);
                }
            }
        }
    }
#undef CMP_LOADK
#undef CMP_LOADV
#undef CMP_STOREK
#undef CMP_STOREV
    __syncthreads();
    float* impl = (float*)smem + w * 512;
    if (hd == 0) {
#pragma unroll
        for (int i = 0; i < 32; ++i) impl[tk * 128 + 4 * i + g4] = impv[i];
    }
#pragma unroll
    for (int mt = 0; mt < 8; ++mt) {
        uint2 ov; ov.x = pk2(o[mt][0], o[mt][1]); ov.y = pk2(o[mt][2], o[mt][3]);
        *(uint2*)(p.OCMP() + ((size_t)t * 4 + hd) * 128 + mt * 16 + 4 * g4) = ov;
    }
    __syncthreads();
    const int li = hd + 4 * g4, cur = t >> 6;
    unsigned long long own[8]; int rank[8];
#pragma unroll
    for (int i = 0; i < 8; ++i) {
        const int j = li + 16 * i; const float v = impl[tk * 128 + j];
        const unsigned k32 = (j == 0 || j == cur || j == cur - 1) ? 0xFFFFFFFFu : (j > cur ? 0u : __float_as_uint(v) + 128u);
        own[i] = ((unsigned long long)k32 << 7) | (unsigned)(127 - j); rank[i] = 0;
    }
#pragma unroll 1
    for (int ip = 0; ip < 8; ++ip) {
#pragma unroll
        for (int q4 = 0; q4 < 4; ++q4) {
            const float4 ov = *(const float4*)(impl + tk * 128 + ip * 16 + q4 * 4);
            const float o4[4] = {ov.x, ov.y, ov.z, ov.w};
#pragma unroll
            for (int e = 0; e < 4; ++e) {
                const int jp = ip * 16 + q4 * 4 + e;
                const unsigned k32 = (jp == 0 || jp == cur || jp == cur - 1) ? 0xFFFFFFFFu : (jp > cur ? 0u : __float_as_uint(o4[e]) + 128u);
                const unsigned long long kp = ((unsigned long long)k32 << 7) | (unsigned)(127 - jp);
#pragma unroll
                for (int i = 0; i < 8; ++i) rank[i] += (kp > own[i]) ? 1 : 0;
            }
        }
    }
    unsigned mw[4] = {0u, 0u, 0u, 0u};
#pragma unroll
    for (int i = 0; i < 8; ++i) if (rank[i] < 16) mw[i >> 1] |= 1u << (li + 16 * (i & 1));
#pragma unroll
    for (int q = 0; q < 4; ++q) {
        unsigned v = mw[q];
        v |= __shfl_xor(v, 1); v |= __shfl_xor(v, 2); v |= __shfl_xor(v, 16); v |= __shfl_xor(v, 32);
        mw[q] = v;
    }
    if (li == 0) *(uint4*)(p.SEL() + (size_t)t * 4) = make_uint4(mw[0], mw[1], mw[2], mw[3]);
    __syncthreads();
}

DEV void st_nsa_attn(const P& p, int unit, char* smem) {
    constexpr int RSK = 272, RSV = 136, BUFB = 64 * RSK + 128 * RSV;
    const int tid = tidx(), w = tid >> 6, l = tid & 63, qc = l & 15, g4 = l >> 4;
    const int tq0 = unit * 16, t = tq0 + w * 4 + (qc >> 2), hd = qc & 3;
    bf16x8 qf[4];
#pragma unroll
    for (int ks = 0; ks < 4; ++ks) qf[ks] = *(const bf16x8*)(p.QR() + ((size_t)t * 4 + hd) * 128 + ks * 32 + g4 * 8);
    const uint4 selw = *(const uint4*)(p.SEL() + (size_t)t * 4);
    const float cs = 0.08838834764831845f * 1.4426950408889634f;
    unsigned part[8][2];
#pragma unroll
    for (int mt = 0; mt < 8; ++mt) { part[mt][0] = 0u; part[mt][1] = 0u; }
    const float g0 = p.GATES()[(size_t)t * 12 + hd * 3];
    int gstep = 0;
    const int krow = tid >> 4, kc16 = tid & 15, vrow = tid >> 3, vc16 = tid & 7;
#pragma unroll 1
    for (int br = 0; br < 2; ++br) {
        const bf16_t* Kg = br ? p.KW() : p.KS(); const bf16_t* Vg = br ? p.VWT() : p.VST();
        const int ktlast = (tq0 + 15) >> 6;
        const int ktfirst = br ? ((tq0 - 511 > 0 ? tq0 - 511 : 0) >> 6) : 0;
        const int nk = ktlast - ktfirst + 1;
        f32x4 o[8];
#pragma unroll
        for (int mt = 0; mt < 8; ++mt) o[mt] = (f32x4){0.f, 0.f, 0.f, 0.f};
        float m = -1e30f, lsum = 0.f;
        uint4 rk0, rk1, rk2, rk3, rv0, rv1, rv2, rv3;
#define NSA_LOAD(KT) do { const bf16_t* kb = Kg + (size_t)((KT) * 64 + krow) * 128 + kc16 * 8; const bf16_t* vb = Vg + (size_t)vrow * T + (KT) * 64 + vc16 * 8; \
        rk0 = *(const uint4*)kb; rk1 = *(const uint4*)(kb + 16 * 128); rk2 = *(const uint4*)(kb + 32 * 128); rk3 = *(const uint4*)(kb + 48 * 128); \
        rv0 = *(const uint4*)vb; rv1 = *(const uint4*)(vb + (size_t)32 * T); rv2 = *(const uint4*)(vb + (size_t)64 * T); rv3 = *(const uint4*)(vb + (size_t)96 * T); } while (0)
        NSA_LOAD(ktfirst);
#pragma unroll 1
        for (int i = 0; i < nk; ++i, ++gstep) {
            const int kt = ktfirst + i;
            char* Kt = smem + (gstep & 1) * BUFB; char* Vt = Kt + 64 * RSK;
            *(uint4*)(Kt + krow * RSK + kc16 * 16) = rk0; *(uint4*)(Kt + (krow + 16) * RSK + kc16 * 16) = rk1;
            *(uint4*)(Kt + (krow + 32) * RSK + kc16 * 16) = rk2; *(uint4*)(Kt + (krow + 48) * RSK + kc16 * 16) = rk3;
            *(uint4*)(Vt + vrow * RSV + vc16 * 16) = rv0; *(uint4*)(Vt + (vrow + 32) * RSV + vc16 * 16) = rv1;
            *(uint4*)(Vt + (vrow + 64) * RSV + vc16 * 16) = rv2; *(uint4*)(Vt + (vrow + 96) * RSV + vc16 * 16) = rv3;
            __syncthreads();
            if (i + 1 < nk) NSA_LOAD(kt + 1);
            int lo, hi = t;
            if (br == 0) {
                const unsigned wv = (kt & 64) ? ((kt & 32) ? selw.w : selw.z) : ((kt & 32) ? selw.y : selw.x);
                lo = 0; hi = ((wv >> (kt & 31)) & 1u) ? t : -1;
            } else lo = t - 511;
            const bool interior = (kt * 64 + 63 <= tq0) && (br == 0 || kt * 64 >= tq0 + 15 - 511);
            f32x4 sv[4];
            float mx = -3e38f;
            if (interior) {
                const float csl = hi >= 0 ? cs : 0.f, add = hi >= 0 ? 0.f : -3e38f;
#pragma unroll
                for (int sub = 0; sub < 4; ++sub) {
                    f32x4 a4 = (f32x4){0.f, 0.f, 0.f, 0.f};
#pragma unroll
                    for (int ks = 0; ks < 4; ++ks) a4 = mfma16(*(const bf16x8*)(Kt + (sub * 16 + qc) * RSK + (ks * 32 + g4 * 8) * 2), qf[ks], a4);
#pragma unroll
                    for (int r = 0; r < 4; ++r) { a4[r] = a4[r] * csl + add; mx = fmaxf(mx, a4[r]); }
                    sv[sub] = a4;
                }
            } else {
#pragma unroll
                for (int sub = 0; sub < 4; ++sub) {
                    f32x4 a4 = (f32x4){0.f, 0.f, 0.f, 0.f};
#pragma unroll
                    for (int ks = 0; ks < 4; ++ks) a4 = mfma16(*(const bf16x8*)(Kt + (sub * 16 + qc) * RSK + (ks * 32 + g4 * 8) * 2), qf[ks], a4);
#pragma unroll
                    for (int r = 0; r < 4; ++r) {
                        const int kp = kt * 64 + sub * 16 + 4 * g4 + r;
                        const bool valid = (kp >= lo) & (kp <= hi);
                        a4[r] = valid ? a4[r] * cs : -3e38f;
                        mx = fmaxf(mx, a4[r]);
                    }
                    sv[sub] = a4;
                }
            }
            mx = fmaxf(mx, __shfl_xor(mx, 16)); mx = fmaxf(mx, __shfl_xor(mx, 32));
            const float mnew = fmaxf(fmaxf(m, mx), -1e30f);
            const float alpha = __builtin_amdgcn_exp2f(m - mnew);
            m = mnew;
            float ps = 0.f;
#pragma unroll
            for (int sub = 0; sub < 4; ++sub)
#pragma unroll
                for (int r = 0; r < 4; ++r) { const float pv = __builtin_amdgcn_exp2f(sv[sub][r] - mnew); sv[sub][r] = pv; ps += pv; }
            lsum = lsum * alpha + ps;
            if (__any(alpha != 1.0f)) {
#pragma unroll
                for (int mt = 0; mt < 8; ++mt) o[mt] *= alpha;
            }
#pragma unroll
            for (int pr = 0; pr < 2; ++pr) {
                union { bf16x8 v; unsigned u32[4]; } bb;
                bb.u32[0] = pk2(sv[2 * pr][0], sv[2 * pr][1]); bb.u32[1] = pk2(sv[2 * pr][2], sv[2 * pr][3]);
                bb.u32[2] = pk2(sv[2 * pr + 1][0], sv[2 * pr + 1][1]); bb.u32[3] = pk2(sv[2 * pr + 1][2], sv[2 * pr + 1][3]);
#pragma unroll
                for (int mt = 0; mt < 8; ++mt) {
                    const char* vp = Vt + (mt * 16 + qc) * RSV + (pr * 32 + 4 * g4) * 2;
                    union { bf16x8 v; uint2 h2[2]; } aa;
                    aa.h2[0] = *(const uint2*)vp; aa.h2[1] = *(const uint2*)(vp + 32);
                    o[mt] = mfma16(aa.v, bb.v, o[mt]);
                }
            }
        }
#undef NSA_LOAD
        lsum += __shfl_xor(lsum, 16); lsum += __shfl_xor(lsum, 32);
        const float gate = p.GATES()[(size_t)t * 12 + hd * 3 + 1 + br];
        const float sc = lsum > 0.f ? gate / lsum : 0.f;
        if (br == 0) {
#pragma unroll
            for (int mt = 0; mt < 8; ++mt) {
                const uint2 oc = *(const uint2*)(p.OCMP() + ((size_t)t * 4 + hd) * 128 + mt * 16 + 4 * g4);
                part[mt][0] = pk2(sc * o[mt][0] + g0 * lo2f(oc.x), sc * o[mt][1] + g0 * hi2f(oc.x));
                part[mt][1] = pk2(sc * o[mt][2] + g0 * lo2f(oc.y), sc * o[mt][3] + g0 * hi2f(oc.y));
            }
        } else {
#pragma unroll
            for (int mt = 0; mt < 8; ++mt) {
                uint2 ov;
                ov.x = pk2(sc * o[mt][0] + lo2f(part[mt][0]), sc * o[mt][1] + hi2f(part[mt][0]));
                ov.y = pk2(sc * o[mt][2] + lo2f(part[mt][1]), sc * o[mt][3] + hi2f(part[mt][1]));
                *(uint2*)(p.Y() + (size_t)t * D + 1024 + hd * 128 + mt * 16 + 4 * g4) = ov;
            }
        }
    }
    __syncthreads();
}

DEV unsigned f2key(float f) { const unsigned u = __float_as_uint(f); return (u & 0x80000000u) ? ~u : (u | 0x80000000u); }
DEV float key2f(unsigned k) { const unsigned u = (k & 0x80000000u) ? (k & 0x7fffffffu) : ~k; return __uint_as_float(u); }
DEV float wave_prune(float* sc, unsigned short* ix, unsigned* hist, int m, int l) {
    float v[8]; unsigned k[8]; unsigned short id[8]; bool ok[8];
#pragma unroll
    for (int i = 0; i < 8; ++i) {
        const int e = l + 64 * i; ok[i] = e < m;
        v[i] = ok[i] ? sc[e] : 0.f; id[i] = ok[i] ? ix[e] : (unsigned short)0; k[i] = f2key(v[i]);
    }
    unsigned prefix = 0u; int need = 256;
#pragma unroll 1
    for (int pass = 0; pass < 4; ++pass) {
        const int shift = 24 - 8 * pass;
        *(uint4*)(hist + 4 * l) = make_uint4(0u, 0u, 0u, 0u);
        __builtin_amdgcn_wave_barrier();
#pragma unroll
        for (int i = 0; i < 8; ++i) {
            const bool in = ok[i] && (pass == 0 || (k[i] >> (shift + 8)) == prefix);
            if (in) atomicAdd(&hist[(k[i] >> shift) & 255u], 1u);
        }
        __builtin_amdgcn_wave_barrier();
        const uint4 hv = *(const uint4*)(hist + 4 * l);
        const unsigned hq[4] = {hv.x, hv.y, hv.z, hv.w};
        const unsigned own = hv.x + hv.y + hv.z + hv.w;
        unsigned tot = own;
#pragma unroll
        for (int o = 1; o < 64; o <<= 1) { const unsigned tv = __shfl_down(tot, o); if (l + o < 64) tot += tv; }
        unsigned cum = tot - own; int found = -1; int nneed = 0;
#pragma unroll
        for (int kk = 3; kk >= 0; --kk) {
            const unsigned c = hq[kk];
            if (found < 0 && (int)cum < need && (int)(cum + c) >= need) { found = 4 * l + kk; nneed = need - (int)cum; }
            cum += c;
        }
        const unsigned long long bal = __ballot(found >= 0);
        const int src = __ffsll((long long)bal) - 1;
        const int digit = __shfl(found, src); need = __shfl(nneed, src);
        prefix = (prefix << 8) | (unsigned)digit;
    }
    const unsigned thr = prefix;
    int base = 0, ties = 0;
    const unsigned long long ltmask = (1ull << l) - 1ull;
#pragma unroll
    for (int i = 0; i < 8; ++i) {
        const bool gt = ok[i] && k[i] > thr, eq = ok[i] && k[i] == thr;
        const unsigned long long em = __ballot(eq);
        const int trank = ties + __popcll(em & ltmask);
        const bool keep = gt || (eq && trank < need);
        ties += __popcll(em);
        const unsigned long long km = __ballot(keep);
        const int pos = base + __popcll(km & ltmask);
        if (keep) { sc[pos] = v[i]; ix[pos] = id[i]; }
        base += __popcll(km);
    }
    __builtin_amdgcn_wave_barrier();
    return key2f(thr);
}

#define DSA_APPEND(SCP, IXP, CNT, M32, MINE, SV) do { \
    const unsigned _m = (M32); \
    if (MINE) { const int _pos = (CNT) + __popc(_m & ((1u << n) - 1u)); (SCP)[_pos] = (SV); (IXP)[_pos] = (unsigned short)kp; } \
    (CNT) += __popc(_m); } while (0)

DEV void st_dsa_index(const P& p, int unit, char* smem) {
    const int tid = tidx(), w = tid >> 6, l = tid & 63, n = l & 31, h = l >> 5;
    char* wb = smem + w * 14336;
    float* sc0 = (float*)wb; float* sc1 = sc0 + 512; float* sc2 = sc1 + 512; float* sc3 = sc2 + 512;
    unsigned short* ix0 = (unsigned short*)(wb + 8192); unsigned short* ix1 = ix0 + 512; unsigned short* ix2 = ix1 + 512; unsigned short* ix3 = ix2 + 512;
    unsigned* hist = (unsigned*)(wb + 12288);
    const int wu = unit * 4 + w;
    const int tg = (wu & 1) ? (2047 - (wu >> 1)) : (wu >> 1);
    const int t0 = tg * 4;
    const int tl = 2 * ((n >> 2) & 1) + (n >> 4), hdr = (n & 3) + 4 * ((n >> 3) & 1);
    bf16x8 af[4];
#pragma unroll
    for (int s = 0; s < 4; ++s) af[s] = *(const bf16x8*)(p.IQ() + ((size_t)(t0 + tl) * 8 + hdr) * 64 + 16 * s + 8 * h);
    const int tA = t0 + 2 * h, tB = tA + 1;
    float wA[8], wB[8];
#pragma unroll
    for (int r = 0; r < 8; ++r) { wA[r] = p.IW()[(size_t)tA * 8 + r]; wB[r] = p.IW()[(size_t)tB * 8 + r]; }
    int cnt0 = 0, cnt1 = 0, cnt2 = 0, cnt3 = 0;
    const float NINF = -__builtin_inff();
    float tau0 = NINF, tau1 = NINF, tau2 = NINF, tau3 = NINF;
    const int ntiles = (t0 + 3) / 32 + 1;
    const bf16_t* ikp = p.IK() + (size_t)n * 64 + 8 * h;
    bf16x8 na[4], nb[4];
#pragma unroll
    for (int s = 0; s < 4; ++s) { na[s] = *(const bf16x8*)(ikp + 16 * s); nb[s] = *(const bf16x8*)(ikp + (size_t)(ntiles > 1 ? 32 : 0) * 64 + 16 * s); }
#pragma unroll 1
    for (int kt = 0; kt < ntiles; kt += 2) {
        bf16x8 ca[4], cb[4];
#pragma unroll
        for (int s = 0; s < 4; ++s) { ca[s] = na[s]; cb[s] = nb[s]; }
        {
            const int ka = kt + 2 < ntiles ? kt + 2 : ntiles - 1, kb = kt + 3 < ntiles ? kt + 3 : ntiles - 1;
#pragma unroll
            for (int s = 0; s < 4; ++s) { na[s] = *(const bf16x8*)(ikp + (size_t)ka * 32 * 64 + 16 * s); nb[s] = *(const bf16x8*)(ikp + (size_t)kb * 32 * 64 + 16 * s); }
        }
        f32x16 acca, accb;
#pragma unroll
        for (int r = 0; r < 16; ++r) { acca[r] = 0.f; accb[r] = 0.f; }
#pragma unroll
        for (int s = 0; s < 4; ++s) { acca = mfma32(af[s], ca[s], acca); accb = mfma32(af[s], cb[s], accb); }
        float s0a = 0.f, s1a = 0.f, s0b = 0.f, s1b = 0.f, u0a = 0.f, u1a = 0.f, u0b = 0.f, u1b = 0.f;
#pragma unroll
        for (int r = 0; r < 4; ++r) {
            s0a += wA[r] * fmaxf(acca[r], 0.f); u0a += wA[4 + r] * fmaxf(acca[4 + r], 0.f);
            s1a += wB[r] * fmaxf(acca[8 + r], 0.f); u1a += wB[4 + r] * fmaxf(acca[12 + r], 0.f);
            s0b += wA[r] * fmaxf(accb[r], 0.f); u0b += wA[4 + r] * fmaxf(accb[4 + r], 0.f);
            s1b += wB[r] * fmaxf(accb[8 + r], 0.f); u1b += wB[4 + r] * fmaxf(accb[12 + r], 0.f);
        }
        s0a += u0a; s1a += u1a; s0b += u0b; s1b += u1b;
        const float tauA = h ? tau2 : tau0, tauB = h ? tau3 : tau1;
        {
            const int kp = kt * 32 + n;
            const bool cA = (kp <= tA) && (s0a > tauA), cB = (kp <= tB) && (s1a > tauB);
            const unsigned long long mA = __ballot(cA), mB = __ballot(cB);
            DSA_APPEND(sc0, ix0, cnt0, (unsigned)mA, (h == 0 && cA), s0a);
            DSA_APPEND(sc2, ix2, cnt2, (unsigned)(mA >> 32), (h == 1 && cA), s0a);
            DSA_APPEND(sc1, ix1, cnt1, (unsigned)mB, (h == 0 && cB), s1a);
            DSA_APPEND(sc3, ix3, cnt3, (unsigned)(mB >> 32), (h == 1 && cB), s1a);
        }
        {
            const int kp = kt * 32 + 32 + n;
            const bool cA = (kp <= tA) && (s0b > tauA), cB = (kp <= tB) && (s1b > tauB);
            const unsigned long long mA = __ballot(cA), mB = __ballot(cB);
            DSA_APPEND(sc0, ix0, cnt0, (unsigned)mA, (h == 0 && cA), s0b);
            DSA_APPEND(sc2, ix2, cnt2, (unsigned)(mA >> 32), (h == 1 && cA), s0b);
            DSA_APPEND(sc1, ix1, cnt1, (unsigned)mB, (h == 0 && cB), s1b);
            DSA_APPEND(sc3, ix3, cnt3, (unsigned)(mB >> 32), (h == 1 && cB), s1b);
        }
        __builtin_amdgcn_wave_barrier();
        if (max(max(cnt0, cnt1), max(cnt2, cnt3)) > 448) {
            if (cnt0 > 448) { tau0 = wave_prune(sc0, ix0, hist, cnt0, l); cnt0 = 256; }
            if (cnt1 > 448) { tau1 = wave_prune(sc1, ix1, hist, cnt1, l); cnt1 = 256; }
            if (cnt2 > 448) { tau2 = wave_prune(sc2, ix2, hist, cnt2, l); cnt2 = 256; }
            if (cnt3 > 448) { tau3 = wave_prune(sc3, ix3, hist, cnt3, l); cnt3 = 256; }
        }
    }
    if (cnt0 > 256) { wave_prune(sc0, ix0, hist, cnt0, l); cnt0 = 256; }
    if (cnt1 > 256) { wave_prune(sc1, ix1, hist, cnt1, l); cnt1 = 256; }
    if (cnt2 > 256) { wave_prune(sc2, ix2, hist, cnt2, l); cnt2 = 256; }
    if (cnt3 > 256) { wave_prune(sc3, ix3, hist, cnt3, l); cnt3 = 256; }
    __builtin_amdgcn_wave_barrier();
#pragma unroll
    for (int i = 0; i < 4; ++i) {
        const int e = l + 64 * i;
        p.IDX()[(size_t)(t0 + 0) * 256 + e] = e < cnt0 ? (int)ix0[e] : 0;
        p.IDX()[(size_t)(t0 + 1) * 256 + e] = e < cnt1 ? (int)ix1[e] : 0;
        p.IDX()[(size_t)(t0 + 2) * 256 + e] = e < cnt2 ? (int)ix2[e] : 0;
        p.IDX()[(size_t)(t0 + 3) * 256 + e] = e < cnt3 ? (int)ix3[e] : 0;
    }
    if (l == 0) { p.CNT()[t0] = cnt0; p.CNT()[t0 + 1] = cnt1; p.CNT()[t0 + 2] = cnt2; p.CNT()[t0 + 3] = cnt3; }
}

DEV void st_dsa_attn(const P& p, int unit, char* smem) {
    const int tid = tidx(), w = tid >> 6, l = tid & 63, c = l & 15, g4 = l >> 4;
    int* idxs = (int*)(smem + w * 5120); float* Pl = (float*)(smem + w * 5120 + 1024);
    const size_t t = (size_t)unit * 4 + w;
    const int cnt = p.CNT()[t];
#pragma unroll
    for (int i = 0; i < 4; ++i) idxs[l + 64 * i] = p.IDX()[t * 256 + l + 64 * i];
    __builtin_amdgcn_wave_barrier();
    bf16x8 qf[4];
#pragma unroll
    for (int j = 0; j < 4; ++j) qf[j] = *(const bf16x8*)(p.DQ() + (t * 4 + (c & 3)) * 128 + g4 * 32 + j * 8);
    f32x4 s[16];
    const int ntile = (cnt + 15) >> 4;
#pragma unroll
    for (int tq = 0; tq < 4; ++tq) {
        bf16x8 kf[4][4];
        if (tq * 4 < ntile) {
#pragma unroll
            for (int q = 0; q < 4; ++q) {
                const int krow = idxs[(tq * 4 + q) * 16 + c];
                const bf16_t* kp = p.DK() + (size_t)krow * 128 + g4 * 32;
#pragma unroll
                for (int j = 0; j < 4; ++j) kf[q][j] = *(const bf16x8*)(kp + j * 8);
            }
        }
#pragma unroll
        for (int q = 0; q < 4; ++q) {
            s[tq * 4 + q] = (f32x4){0.f, 0.f, 0.f, 0.f};
            if (tq * 4 < ntile) {
#pragma unroll
                for (int j = 0; j < 4; ++j) s[tq * 4 + q] = mfma16(kf[q][j], qf[j], s[tq * 4 + q]);
            }
        }
        __builtin_amdgcn_sched_barrier(0);
    }
    const float cs = 0.08838834764831845f * 1.4426950408889634f;
    float mx = -1e30f;
#pragma unroll
    for (int tt = 0; tt < 16; ++tt)
#pragma unroll
        for (int r = 0; r < 4; ++r) { const int slot = tt * 16 + 4 * g4 + r; if (slot < cnt) mx = fmaxf(mx, s[tt][r] * cs); }
    mx = fmaxf(mx, __shfl_xor(mx, 16)); mx = fmaxf(mx, __shfl_xor(mx, 32));
    float sum = 0.f;
#pragma unroll
    for (int tt = 0; tt < 16; ++tt)
#pragma unroll
        for (int r = 0; r < 4; ++r) { const int slot = tt * 16 + 4 * g4 + r; const float pv = slot < cnt ? exp2f(s[tt][r] * cs - mx) : 0.f; s[tt][r] = pv; sum += pv; }
    sum += __shfl_xor(sum, 16); sum += __shfl_xor(sum, 32);
    const float inv = sum > 0.f ? 1.0f / sum : 0.f;
    if (c < 4) {
#pragma unroll
        for (int tt = 0; tt < 16; ++tt)
#pragma unroll
            for (int r = 0; r < 4; ++r) Pl[(tt * 16 + 4 * g4 + r) * 4 + c] = s[tt][r] * inv;
    }
    __builtin_amdgcn_wave_barrier();
    float acc[4][8];
#pragma unroll
    for (int hh = 0; hh < 4; ++hh)
#pragma unroll
        for (int j = 0; j < 8; ++j) acc[hh][j] = 0.f;
    const int nk32 = (cnt + 31) >> 5;
#pragma unroll 1
    for (int kb = 0; kb < nk32; ++kb) {
        uint4 raw[8]; float4 p4[8];
#pragma unroll
        for (int q = 0; q < 8; ++q) {
            const int slot = (kb * 8 + q) * 4 + g4;
            const int row = idxs[slot];
            raw[q] = *(const uint4*)(p.PROJ() + (size_t)row * LDP + C_DV + c * 8);
            p4[q] = *(const float4*)(Pl + slot * 4);
        }
#pragma unroll
        for (int q = 0; q < 8; ++q) {
            const float vv[8] = {lo2f(raw[q].x), hi2f(raw[q].x), lo2f(raw[q].y), hi2f(raw[q].y), lo2f(raw[q].z), hi2f(raw[q].z), lo2f(raw[q].w), hi2f(raw[q].w)};
            const float pp[4] = {p4[q].x, p4[q].y, p4[q].z, p4[q].w};
#pragma unroll
            for (int hh = 0; hh < 4; ++hh)
#pragma unroll
                for (int j = 0; j < 8; ++j) acc[hh][j] += pp[hh] * vv[j];
        }
    }
#pragma unroll
    for (int hh = 0; hh < 4; ++hh)
#pragma unroll
        for (int j = 0; j < 8; ++j) { float a = acc[hh][j]; a += __shfl_xor(a, 16); a += __shfl_xor(a, 32); acc[hh][j] = a; }
    if (g4 == 0) {
#pragma unroll
        for (int hh = 0; hh < 4; ++hh) {
            uint4 o; o.x = pk2(acc[hh][0], acc[hh][1]); o.y = pk2(acc[hh][2], acc[hh][3]); o.z = pk2(acc[hh][4], acc[hh][5]); o.w = pk2(acc[hh][6], acc[hh][7]);
            *(uint4*)(p.Y() + t * D + 1536 + hh * 128 + c * 8) = o;
        }
    }
    __builtin_amdgcn_wave_barrier();
}

DEV void ins16(unsigned (&top)[16], unsigned x) {
#pragma unroll
    for (int j = 0; j < 16; ++j) { const unsigned hi = max(top[j], x); x = min(top[j], x); top[j] = hi; }
}
DEV void st_peer_topk(const P& p, int layer, int unit, char* smem) {
    const int tid = tidx(), w = tid >> 6, l = tid & 63, n = l & 31, hf = l >> 5;
    const int tg = unit >> 1, head = (unit & 1) * 4 + w;
    const size_t t = (size_t)tg * 32 + n;
    unsigned* il = (unsigned*)smem + w * 1024;
    unsigned top[2][16];
#pragma unroll
    for (int pp = 0; pp < 2; ++pp) {
        float qv[32];
#pragma unroll
        for (int i = 0; i < 8; ++i) { const float4 v = *(const float4*)(p.PQ() + t * 1024 + head * 128 + pp * 64 + hf * 32 + i * 4); qv[4 * i] = v.x; qv[4 * i + 1] = v.y; qv[4 * i + 2] = v.z; qv[4 * i + 3] = v.w; }
        const float* K = p.peer_sk + ((((size_t)layer * 8 + head) * 2 + pp) * 128) * 64;
#pragma unroll
        for (int j = 0; j < 16; ++j) top[pp][j] = 0u;
#pragma unroll 1
        for (int tile = 0; tile < 4; ++tile) {
            float kv[32];
            const float* kr = K + (size_t)(tile * 32 + n) * 64 + hf * 32;
#pragma unroll
            for (int i = 0; i < 8; ++i) { const float4 v = *(const float4*)(kr + i * 4); kv[4 * i] = v.x; kv[4 * i + 1] = v.y; kv[4 * i + 2] = v.z; kv[4 * i + 3] = v.w; }
            f32x16 acc;
#pragma unroll
            for (int r = 0; r < 16; ++r) acc[r] = 0.f;
#pragma unroll
            for (int kk = 0; kk < 32; ++kk) acc = __builtin_amdgcn_mfma_f32_32x32x2f32(kv[kk], qv[kk], acc, 0, 0, 0);
#pragma unroll
            for (int r = 0; r < 16; ++r) {
                const int nn = tile * 32 + (r & 3) + 8 * (r >> 2) + 4 * hf;
                ins16(top[pp], (f2key(acc[r]) & ~127u) | (unsigned)(127 - nn));
            }
        }
        unsigned oth[16];
#pragma unroll
        for (int j = 0; j < 16; ++j) oth[j] = __shfl_xor(top[pp][j], 32);
#pragma unroll
        for (int j = 0; j < 16; ++j) ins16(top[pp], oth[j]);
        if (hf == 0) {
#pragma unroll
            for (int j = 0; j < 16; ++j) il[(pp * 16 + j) * 32 + n] = 127u - (top[pp][j] & 127u);
        }
    }
    __builtin_amdgcn_wave_barrier();
    if (hf == 0) {
        float v1[16], v2[16];
#pragma unroll
        for (int j = 0; j < 16; ++j) { v1[j] = key2f(top[0][j] & ~127u); v2[j] = key2f(top[1][j] & ~127u); }
        unsigned ct[16];
#pragma unroll
        for (int s = 0; s < 16; ++s) ct[s] = 0u;
#pragma unroll
        for (int i = 0; i < 16; ++i)
#pragma unroll
            for (int j = 0; j < 16; ++j)
                if ((i + 1) * (j + 1) <= 16) ins16(ct, (f2key(v1[i] + v2[j]) & ~255u) | (unsigned)(255 - (i * 16 + j)));
        float ex[16], sum = 0.f; int ce[16];
        const float c0 = key2f(ct[0] & ~255u);
#pragma unroll
        for (int s = 0; s < 16; ++s) {
            const unsigned code = 255u - (ct[s] & 255u);
            ce[s] = (int)(il[(code >> 4) * 32 + n] * 128u + il[(16 + (code & 15u)) * 32 + n]);
            ex[s] = __expf(key2f(ct[s] & ~255u) - c0); sum += ex[s];
        }
        const float inv = 1.0f / sum;
#pragma unroll
        for (int s4 = 0; s4 < 4; ++s4) {
            *(int4*)(p.PE() + t * 128 + head * 16 + s4 * 4) = make_int4(ce[4 * s4], ce[4 * s4 + 1], ce[4 * s4 + 2], ce[4 * s4 + 3]);
            *(float4*)(p.PG() + t * 128 + head * 16 + s4 * 4) = make_float4(ex[4 * s4] * inv, ex[4 * s4 + 1] * inv, ex[4 * s4 + 2] * inv, ex[4 * s4 + 3] * inv);
        }
    }
    __builtin_amdgcn_wave_barrier();
}

DEV void st_peer_gather(const P& p, int layer, const float* __restrict__ xin, float* __restrict__ xout, int unit, char* smem) {
    const int tid_ = tidx(); const int w = tid_ >> 6, l = tid_ & 63; const size_t t = (size_t)unit * 4 + w;
    float* row = (float*)smem + w * 2112;
    const int* pip = p.PI();
    const float ic6 = __int_as_float(__builtin_amdgcn_readfirstlane(pip[32]));
    {
#pragma unroll
        for (int i = 0; i < 4; ++i) {
            const uint4 hv = *(const uint4*)(p.HN() + t * D + i * 512 + l * 8);
            const unsigned u4[4] = {hv.x, hv.y, hv.z, hv.w};
            const int c = i * 512 + l * 8;
#pragma unroll
            for (int q = 0; q < 4; ++q) { row[((c + 2 * q) >> 5) * 33 + ((c + 2 * q) & 31)] = lo2f(u4[q]); row[((c + 2 * q + 1) >> 5) * 33 + ((c + 2 * q + 1) & 31)] = hi2f(u4[q]); }
        }
        __builtin_amdgcn_wave_barrier();
    }
    float hf[32];
#pragma unroll
    for (int j = 0; j < 32; ++j) hf[j] = row[l * 33 + __builtin_amdgcn_readfirstlane(pip[j])];
    __builtin_amdgcn_wave_barrier();
    const int e0 = p.PE()[t * 128 + l], e1 = p.PE()[t * 128 + 64 + l];
    const float g0 = p.PG()[t * 128 + l], g1 = p.PG()[t * 128 + 64 + l];
    float out[32];
#pragma unroll
    for (int i = 0; i < 32; ++i) out[i] = 0.f;
    const unsigned char* U = p.Utab() + (size_t)layer * 16384 * ROW6 + l * 8; const unsigned char* V = p.Vtab() + (size_t)layer * 16384 * ROW6 + l * 8;
    const bool b5 = (l & 32) != 0, b4 = (l & 16) != 0;
#pragma unroll 1
    for (int k4 = 0; k4 < 32; ++k4) {
        int e[4]; float g[4];
#pragma unroll
        for (int q = 0; q < 4; ++q) {
            const int k = k4 * 4 + q;
            e[q] = __builtin_amdgcn_readlane(k4 < 16 ? e0 : e1, k & 63);
            g[q] = __int_as_float(__builtin_amdgcn_readlane(__float_as_int(k4 < 16 ? g0 : g1), k & 63));
        }
        uint2 uu[4][3], vv[4][3];
#pragma unroll
        for (int q = 0; q < 4; ++q)
#pragma unroll
            for (int i = 0; i < 3; ++i) { uu[q][i] = *(const uint2*)(U + (size_t)e[q] * ROW6 + i * 512); vv[q][i] = *(const uint2*)(V + (size_t)e[q] * ROW6 + i * 512); }
        float d[4];
#pragma unroll
        for (int q = 0; q < 4; ++q) {
            v6u pk; pk[0] = uu[q][0].x; pk[1] = uu[q][0].y; pk[2] = uu[q][1].x; pk[3] = uu[q][1].y; pk[4] = uu[q][2].x; pk[5] = uu[q][2].y;
            const v32f f = FP6_UNPACK(pk);
            float acc = 0.f;
#pragma unroll
            for (int j = 0; j < 32; ++j) acc += f[j] * hf[j];
            d[q] = acc;
        }
        float kA = b5 ? d[2] : d[0], kB = b5 ? d[3] : d[1];
        const float sA = b5 ? d[0] : d[2], sB = b5 ? d[1] : d[3];
        kA += __shfl_xor(sA, 32); kB += __shfl_xor(sB, 32);
        float kk = b4 ? kB : kA; const float ss = b4 ? kA : kB;
        kk += __shfl_xor(ss, 16);
        kk += __shfl_xor(kk, 8); kk += __shfl_xor(kk, 4); kk += __shfl_xor(kk, 2); kk += __shfl_xor(kk, 1);
        const float gsel = b5 ? (b4 ? g[3] : g[2]) : (b4 ? g[1] : g[0]);
        const float av = gelu_tanh(kk * (ic6 / U6_SCALE)) * gsel * (ic6 / V6_SCALE);
        const int avi = __float_as_int(av);
        const float a4[4] = {__int_as_float(__builtin_amdgcn_readlane(avi, 0)), __int_as_float(__builtin_amdgcn_readlane(avi, 16)),
                             __int_as_float(__builtin_amdgcn_readlane(avi, 32)), __int_as_float(__builtin_amdgcn_readlane(avi, 48))};
#pragma unroll
        for (int q = 0; q < 4; ++q) {
            v6u pk; pk[0] = vv[q][0].x; pk[1] = vv[q][0].y; pk[2] = vv[q][1].x; pk[3] = vv[q][1].y; pk[4] = vv[q][2].x; pk[5] = vv[q][2].y;
            const v32f f = FP6_UNPACK(pk);
#pragma unroll
            for (int j = 0; j < 32; ++j) out[j] += a4[q] * f[j];
        }
    }
    asm volatile("" : "+s"(pip));
#pragma unroll
    for (int j = 0; j < 32; ++j) row[l * 33 + __builtin_amdgcn_readfirstlane(pip[j])] = out[j];
    __builtin_amdgcn_wave_barrier();
    const float* g2 = p.ada() + layer * 12288 + 5 * 2048;
#pragma unroll
    for (int i = 0; i < 8; ++i) {
        const int c = i * 256 + l * 4;
        const float* rp = row + (c >> 5) * 33 + (c & 31);
        const size_t off = t * D + c;
        const float4 x0 = *(const float4*)(xin + off); const float4 ga = *(const float4*)(g2 + c);
        float4 o0;
        o0.x = x0.x + ga.x * rp[0]; o0.y = x0.y + ga.y * rp[1]; o0.z = x0.z + ga.z * rp[2]; o0.w = x0.w + ga.w * rp[3];
        *(float4*)(xout + off) = o0;
    }
    __builtin_amdgcn_wave_barrier();
}

enum { S_CONVT_IN = 0, S_CONVT_OUT, S_CONVT_Q, S_CONVT_W1, S_CALIB, S_TAB_U, S_TAB_V, S_ADA, S_ROPE, S_NORM1, S_GEMM_IN, S_CONV, S_SGU, S_VTRANS, S_PREP,
       S_COMPRESS, S_NSA_CMP, S_DSA_INDEX, S_NSA_ATTN, S_DSA_ATTN, S_GEMM_OUT, S_NORM2, S_GEMM_Q, S_PEER_TOPK, S_PEER_GATHER, S_COUNT };
constexpr int TAB_UNITS = 4096;
__host__ __device__ constexpr int nunits(int s) {
    return s == S_CONVT_IN ? 2 * 32 * (LDP / 64) : s == S_CONVT_OUT ? 2 * 32 * 32 : s == S_CONVT_Q ? 2 * 32 * 16 : s == S_CONVT_W1 ? 4 * 64 * 2 : s == S_CALIB ? 1 : s == S_TAB_U ? TAB_UNITS : s == S_TAB_V ? TAB_UNITS
         : s == S_ADA ? 384 : s == S_ROPE ? 768 : s == S_NORM1 ? 2048 : s == S_GEMM_IN ? 64 * (LDP / 128) : s == S_CONV ? 512 : s == S_SGU ? 256
         : s == S_VTRANS ? 256 : s == S_PREP ? 2048 : s == S_COMPRESS ? 64 : s == S_NSA_CMP ? 512 : s == S_DSA_INDEX ? 512 : s == S_NSA_ATTN ? 512 : s == S_DSA_ATTN ? 2048
         : s == S_GEMM_OUT ? 64 * 16 : s == S_NORM2 ? 2048 : s == S_GEMM_Q ? 64 * 8 : s == S_PEER_TOPK ? 512 : s == S_PEER_GATHER ? 2048 : 0;
}
template <int S>
DEV void run_unit(const P& p, int layer, int u, char* smem, int nu = TAB_UNITS) {
    const float* xin = layer == 0 ? p.x : p.X2();
    const float* ada = p.ada() + layer * 12288;
    if constexpr (S == S_CONVT_IN) { const int per = 32 * (LDP / 64), ly = u / per; st_convT(p.w_in + (size_t)ly * 2048 * INC, p.WinT() + (size_t)ly * LDP * 2048, INC, LDP, true, u % per, smem); }
    else if constexpr (S == S_CONVT_OUT) { const int per = 32 * 32, ly = u / per; st_convT(p.w_out + (size_t)ly * 2048 * 2048, p.WoutT() + (size_t)ly * 2048 * 2048, 2048, 2048, false, u % per, smem); }
    else if constexpr (S == S_CONVT_Q) { const int per = 32 * 16, ly = u / per; st_convT(p.peer_wq + (size_t)ly * 2048 * 1024, p.WqT() + (size_t)ly * 1024 * 2048, 1024, 1024, false, u % per, smem); }
    else if constexpr (S == S_CONVT_W1) { const int per = 64 * 2, mi = u / per; st_convT(p.cmp_w1 + (size_t)mi * 4096 * 128, p.W1T() + (size_t)mi * 128 * 4096, 128, 128, false, u % per, smem, 4096); }
    else if constexpr (S == S_CALIB) st_calib(p);
    else if constexpr (S == S_TAB_U) st_tab6(p.peer_u, p.Utab(), U6_SCALE, 2 * 16384, u, nu, smem);
    else if constexpr (S == S_TAB_V) st_tab6(p.peer_v, p.Vtab(), V6_SCALE, 2 * 16384, u, nu, smem);
    else if constexpr (S == S_ADA) st_ada(p, u, smem);
    else if constexpr (S == S_ROPE) st_rope(p, u);
    else if constexpr (S == S_NORM1) st_norm(xin, p.n1g + layer * 2048, ada + 2048, ada, p.HN(), u);
    else if constexpr (S == S_GEMM_IN) { EpiArgs e{p.PROJ(), nullptr, nullptr, nullptr}; st_gemm<EPI_PROJ>(p.HN(), p.WinT() + (size_t)layer * LDP * 2048, 2048, u & 63, u >> 6, e, smem); }
    else if constexpr (S == S_CONV) st_conv(p, layer, u, smem);
    else if constexpr (S == S_SGU) st_sgu(p, layer, u, smem);
    else if constexpr (S == S_VTRANS) st_vtrans(p, u, smem);
    else if constexpr (S == S_PREP) st_prep(p, layer, u);
    else if constexpr (S == S_COMPRESS) st_compress(p, layer, u, smem);
    else if constexpr (S == S_NSA_CMP) st_nsa_cmp(p, u, smem);
    else if constexpr (S == S_DSA_INDEX) st_dsa_index(p, u, smem);
    else if constexpr (S == S_NSA_ATTN) st_nsa_attn(p, u, smem);
    else if constexpr (S == S_DSA_ATTN) st_dsa_attn(p, u, smem);
    else if constexpr (S == S_GEMM_OUT) { EpiArgs e{nullptr, p.X1(), xin, ada + 2 * 2048}; st_gemm<EPI_OUT>(p.Y(), p.WoutT() + (size_t)layer * 2048 * 2048, 2048, u & 63, u >> 6, e, smem); }
    else if constexpr (S == S_NORM2) st_norm(p.X1(), p.n2g + layer * 2048, ada + 4 * 2048, ada + 3 * 2048, p.HN(), u);
    else if constexpr (S == S_GEMM_Q) { EpiArgs e{nullptr, p.PQ(), nullptr, nullptr}; st_gemm<EPI_Q>(p.HN(), p.WqT() + (size_t)layer * 1024 * 2048, 2048, u & 63, u >> 6, e, smem); }
    else if constexpr (S == S_PEER_TOPK) st_peer_topk(p, layer, u, smem);
    else if constexpr (S == S_PEER_GATHER) st_peer_gather(p, layer, p.X1(), layer == 0 ? p.X2() : p.out, u, smem);
}


#define XB_TMO      128
#define XB_XCNT(j)  (256  + 64 * (j))
#define XB_XSUB(j)  (1280 + 64 * (j))
#define XB_XGEN(j)  (2304 + 64 * (j))
#define XB_TOP      3328
#define XB_TOPGEN   3392
#define XB_SPIN_CAP (1u << 22)
#define LAS __attribute__((address_space(3)))
DEV unsigned xb_ld(unsigned* p) { return __hip_atomic_load(p, __ATOMIC_RELAXED, __HIP_MEMORY_SCOPE_AGENT); }
DEV unsigned xb_add(unsigned* p, unsigned v) { return __hip_atomic_fetch_add(p, v, __ATOMIC_RELAXED, __HIP_MEMORY_SCOPE_AGENT); }
DEV unsigned xb_xcc_id() { return (unsigned)__builtin_amdgcn_s_getreg((3 << 11) | 20) & 0xFu; }
#define XB_SPIN(cond, bar) do { unsigned _sp = 0; while (cond) { __builtin_amdgcn_s_sleep(1); \
    if ((++_sp & 255u) == 0u) { if (xb_ld(&(bar)[XB_TMO])) break; if (_sp > XB_SPIN_CAP) { atomicAdd(&(bar)[XB_TMO], 1u); break; } } } } while (0)
struct XcdBarrier { unsigned* bar; unsigned x; volatile LAS unsigned* st; };
DEV XcdBarrier xcd_barrier_post(unsigned* bar, volatile LAS unsigned* st) {
    XcdBarrier b; b.bar = bar; b.x = xb_xcc_id(); b.st = st;
    if (threadIdx.x == 0) (void)xb_add(&bar[XB_XCNT(b.x)], 1u);
    return b;
}
DEV void xcd_barrier_complete(unsigned* bar, unsigned x, unsigned& nloc, unsigned& nx) {
    const unsigned G = gridDim.x * gridDim.y * gridDim.z;
    unsigned sum, cnt, mine, sp = 0u;
    for (;;) {
        sum = 0u; cnt = 0u; mine = 0u;
#pragma unroll
        for (unsigned j = 0; j < 16; ++j) { const unsigned c = xb_ld(&bar[XB_XCNT(j)]); sum += c; cnt += (c > 0u) ? 1u : 0u; mine = (j == x) ? c : mine; }
        if (sum == G) break;
        __builtin_amdgcn_s_sleep(1);
        if ((++sp & 255u) == 0u) { if (xb_ld(&bar[XB_TMO])) break; if (sp > XB_SPIN_CAP) { atomicAdd(&bar[XB_TMO], 1u); break; } }
    }
    nloc = mine > 0u ? mine : 1u; nx = cnt > 0u ? cnt : 1u;
}
DEV void xcd_barrier(const XcdBarrier& b) {
    asm volatile("s_waitcnt vmcnt(0)" ::: "memory");
    __syncthreads();
    if (threadIdx.x == 0) {
        unsigned* bar = b.bar;
        __builtin_amdgcn_s_waitcnt(0);
        unsigned nloc = b.st[0], nx = b.st[1];
        if (nloc == 0u) { xcd_barrier_complete(bar, b.x, nloc, nx); b.st[0] = nloc; b.st[1] = nx; }
        const unsigned old = xb_add(&bar[XB_XSUB(b.x)], 1u);
        const unsigned gen = old / nloc;
        if (old + 1u == (gen + 1u) * nloc) {
            __builtin_amdgcn_fence(__ATOMIC_RELEASE, "agent");
            asm volatile("s_waitcnt vmcnt(0)" ::: "memory");
            const unsigned og = xb_add(&bar[XB_TOP], 1u);
            const unsigned tg = og / nx;
            if (og + 1u == (tg + 1u) * nx) xb_add(&bar[XB_TOPGEN], 1u);
            else XB_SPIN(xb_ld(&bar[XB_TOPGEN]) == tg, bar);
            __builtin_amdgcn_fence(__ATOMIC_ACQUIRE, "agent");
            xb_add(&bar[XB_XGEN(b.x)], 1u);
            asm volatile("s_waitcnt vmcnt(0)" ::: "memory");
        } else {
            XB_SPIN(xb_ld(&bar[XB_XGEN(b.x)]) == gen, bar);
            __builtin_amdgcn_fence(__ATOMIC_ACQUIRE, "agent");
            asm volatile("s_waitcnt vmcnt(0)" ::: "memory");
        }
    }
    __syncthreads();
}

#ifndef MULTI_LAUNCH
constexpr int REP_STAGE = -1, REP_STAGE2 = -1, REP_N = 1;
template <int S>
DEV void run_phase1(const P& p, int layer, char* smem, int off);
template <int S>
DEV void run_phase(const P& p, int layer, char* smem, int off = 0) {
    constexpr int reps = (S == REP_STAGE || S == REP_STAGE2) ? REP_N : 1;
#pragma unroll 1
    for (int r = 0; r < reps; ++r) run_phase1<S>(p, layer, smem, off);
}
template <int S>
DEV void run_phase1(const P& p, int layer, char* smem, int off) {
    const int G = gridDim.x;
    int b = blockIdx.x + off; if (b >= G) b -= G;
    if constexpr (S == S_TAB_U || S == S_TAB_V) { run_unit<S>(p, layer, b, smem, G); }
    else {
        for (int u = b; u < nunits(S); u += G) { run_unit<S>(p, layer, u, smem); __syncthreads(); }
    }
}
template <int S>
DEV void run_gemm_phase1(const P& p, int layer, char* smem, unsigned xcc, volatile LAS unsigned* slot, int rep) {
    constexpr int TN = (S == S_GEMM_IN) ? (LDP / 128) : (S == S_GEMM_OUT ? 16 : 8);
    constexpr int inst0 = (S == S_GEMM_IN) ? 0 : (S == S_GEMM_OUT ? 2 : 4);
    const int len = 8 * TN;
#pragma unroll 1
    for (int q = 0; q < 8; ++q) {
        const unsigned xq = (xcc + q) & 7u;
        unsigned* head = p.bar() + GQ_WORD(inst0 + layer + 6 * rep, xq);
        for (;;) {
            if (threadIdx.x == 0) *slot = xb_add(head, 1u);
            __syncthreads();
            const int i = (int)*slot;
            __syncthreads();
            if (i >= len) break;
            const int tn = i >> 3, tm = (int)xq * 8 + (i & 7);
            run_unit<S>(p, layer, tm + 64 * tn, smem);
            __syncthreads();
        }
    }
}
template <int S>
DEV void run_items(const P& p, int layer, char* smem, int first, int count) {
    constexpr int reps = (S == REP_STAGE || S == REP_STAGE2) ? REP_N : 1;
#pragma unroll 1
    for (int r = 0; r < reps; ++r)
#pragma unroll 1
        for (int u = first; u < first + count; ++u) { run_unit<S>(p, layer, u, smem); __syncthreads(); }
}
template <int PH>
DEV void run_dyn_phase(const P& p, int layer, char* smem, volatile LAS unsigned* slot) {
    unsigned* head = p.bar() + DQ_WORD(PH * 2 + layer);
    constexpr int total = PH == 0 ? (64 + 256 + 256 + 64 + 256) : (PH == 1 ? (512 + 256) : (512 + 512));
    int i = blockIdx.x;
    while (i < total) {
        if constexpr (PH == 0) {
            if (i < 256) run_items<S_SGU>(p, layer, smem, i, 1);
            else if (i < 320) run_items<S_COMPRESS>(p, layer, smem, i - 256, 1);
            else if (i < 576) run_items<S_CONV>(p, layer, smem, (i - 320) * 2, 2);
            else if (i < 640) run_items<S_VTRANS>(p, layer, smem, (i - 576) * 4, 4);
            else run_items<S_PREP>(p, layer, smem, (i - 640) * 8, 8);
        } else if constexpr (PH == 1) {
            if (i < 512) run_items<S_DSA_INDEX>(p, layer, smem, i, 1);
            else run_items<S_NSA_CMP>(p, layer, smem, (i - 512) * 2, 2);
        } else {
            if (i < 512) run_items<S_NSA_ATTN>(p, layer, smem, 511 - i, 1);
            else run_items<S_DSA_ATTN>(p, layer, smem, (i - 512) * 4, 4);
        }
        if (threadIdx.x == 0) *slot = gridDim.x + xb_add(head, 1u);
        __syncthreads();
        i = (int)*slot;
        __syncthreads();
    }
}
template <int S>
DEV void run_gemm_phase(const P& p, int layer, char* smem, unsigned xcc, volatile LAS unsigned* slot) {
    constexpr int reps = (S == REP_STAGE || S == REP_STAGE2) ? REP_N : 1;
#pragma unroll 1
    for (int r = 0; r < reps; ++r) run_gemm_phase1<S>(p, layer, smem, xcc, slot, r);
}
#define GSYNC() xcd_barrier(xb)
__global__ void __launch_bounds__(NTHREADS, 2) k_mega(P p) {
    __shared__ __attribute__((aligned(16))) char smem[SMEM_BYTES];
    __shared__ uint4 xb_words;
    cg::grid_group grid = cg::this_grid();
    if (threadIdx.x == 0) xb_words = make_uint4(0u, 0u, 0u, 0u);
    __syncthreads();
    XcdBarrier xb = xcd_barrier_post(p.bar(), (volatile LAS unsigned*)&xb_words);
    const int H = gridDim.x >> 1, Q = gridDim.x >> 2;
    run_phase<S_ADA>(p, 0, smem); run_phase<S_ROPE>(p, 0, smem, H);
    run_phase<S_CONVT_IN>(p, 0, smem); run_phase<S_CONVT_OUT>(p, 0, smem); run_phase<S_CONVT_Q>(p, 0, smem); run_phase<S_CONVT_W1>(p, 0, smem); run_phase<S_CALIB>(p, 0, smem, 100);
    run_phase<S_TAB_U>(p, 0, smem); run_phase<S_TAB_V>(p, 0, smem);
    grid.sync();
#pragma unroll 1
    for (int layer = 0; layer < NL; ++layer) {
        run_phase<S_NORM1>(p, layer, smem); GSYNC();
        run_gemm_phase<S_GEMM_IN>(p, layer, smem, xb.x, (volatile LAS unsigned*)&xb_words + 2); GSYNC();
        run_dyn_phase<0>(p, layer, smem, (volatile LAS unsigned*)&xb_words + 2); GSYNC();
        run_dyn_phase<1>(p, layer, smem, (volatile LAS unsigned*)&xb_words + 2); GSYNC();
        run_dyn_phase<2>(p, layer, smem, (volatile LAS unsigned*)&xb_words + 2); GSYNC();
        run_gemm_phase<S_GEMM_OUT>(p, layer, smem, xb.x, (volatile LAS unsigned*)&xb_words + 2); GSYNC();
        run_phase<S_NORM2>(p, layer, smem); GSYNC();
        run_gemm_phase<S_GEMM_Q>(p, layer, smem, xb.x, (volatile LAS unsigned*)&xb_words + 2); GSYNC();
        run_phase<S_PEER_TOPK>(p, layer, smem); GSYNC();
        run_phase<S_PEER_GATHER>(p, layer, smem); GSYNC();
    }
}
#else
template <int S>
__global__ void __launch_bounds__(NTHREADS) k_stage(P p, int layer) {
    __shared__ __attribute__((aligned(16))) char smem[SMEM_BYTES];
    run_unit<S>(p, layer, blockIdx.x, smem);
}
template <int S> static void launch_stage(const P& p, int layer, hipStream_t st) {
    hipLaunchKernelGGL((k_stage<S>), dim3(nunits(S)), dim3(NTHREADS), 0, st, p, layer);
}
#endif

extern "C" void kernel_launch(void* const* d_in, const int* in_sizes, int n_in, void* d_out, int out_size, void* d_ws, size_t ws_size, hipStream_t stream) {
    P p{};
    p.x = (const float*)d_in[0]; p.c = (const float*)d_in[1]; p.pos = (const int*)d_in[2]; p.ada_w = (const float*)d_in[3]; p.ada_b = (const float*)d_in[4];
    p.n1g = (const float*)d_in[5]; p.n2g = (const float*)d_in[6]; p.w_in = (const float*)d_in[7]; p.w_out = (const float*)d_in[8]; p.conv_w = (const float*)d_in[9];
    p.conv_b = (const float*)d_in[10]; p.cln_g = (const float*)d_in[11]; p.cln_b = (const float*)d_in[12]; p.sln_g = (const float*)d_in[13]; p.sln_b = (const float*)d_in[14];
    p.sgu_w = (const float*)d_in[15]; p.sgu_b = (const float*)d_in[16]; p.nsa_qg = (const float*)d_in[17]; p.nsa_kg = (const float*)d_in[18]; p.cmp_pos = (const float*)d_in[19];
    p.cmp_w1 = (const float*)d_in[20]; p.cmp_w2 = (const float*)d_in[21]; p.dsa_qg = (const float*)d_in[22]; p.dsa_kg = (const float*)d_in[23]; p.peer_wq = (const float*)d_in[24];
    p.peer_sk = (const float*)d_in[25]; p.peer_u = (const float*)d_in[26]; p.peer_v = (const float*)d_in[27];
    p.out = (float*)d_out;
    p.ws = (char*)d_ws; const size_t off = WS_TOTAL;
    if (off > ws_size) { fprintf(stderr, "workspace too small: need %zu have %zu\n", off, ws_size); return; }
#ifndef MULTI_LAUNCH
    static int grid_blocks = 0;
    if (!grid_blocks) {
        int dev = 0, cus = 0, per_cu = 0;
        (void)hipGetDevice(&dev);
        (void)hipDeviceGetAttribute(&cus, hipDeviceAttributeMultiprocessorCount, dev);
        (void)hipOccupancyMaxActiveBlocksPerMultiprocessor(&per_cu, k_mega, NTHREADS, 0);
        if (per_cu > 2) per_cu = 2;
        grid_blocks = cus * per_cu;
    }
    (void)hipMemsetAsync(p.bar(), 0, (size_t)CTRL_WORDS * 4, stream);
    void* args[] = {&p};
    hipError_t e = hipLaunchCooperativeKernel((void*)k_mega, dim3(grid_blocks), dim3(NTHREADS), args, 0, stream);
    if (e != hipSuccess) fprintf(stderr, "cooperative launch failed: %s (grid %d)\n", hipGetErrorString(e), grid_blocks);
#else
    launch_stage<S_CONVT_IN>(p, 0, stream); launch_stage<S_CONVT_OUT>(p, 0, stream); launch_stage<S_CONVT_Q>(p, 0, stream); launch_stage<S_CONVT_W1>(p, 0, stream); launch_stage<S_CALIB>(p, 0, stream);
    launch_stage<S_TAB_U>(p, 0, stream); launch_stage<S_TAB_V>(p, 0, stream);
    launch_stage<S_ADA>(p, 0, stream); launch_stage<S_ROPE>(p, 0, stream);
    for (int layer = 0; layer < NL; ++layer) {
        launch_stage<S_NORM1>(p, layer, stream); launch_stage<S_GEMM_IN>(p, layer, stream);
        launch_stage<S_CONV>(p, layer, stream); launch_stage<S_SGU>(p, layer, stream); launch_stage<S_VTRANS>(p, layer, stream);
        launch_stage<S_PREP>(p, layer, stream); launch_stage<S_COMPRESS>(p, layer, stream);
        launch_stage<S_NSA_CMP>(p, layer, stream); launch_stage<S_DSA_INDEX>(p, layer, stream);
        launch_stage<S_NSA_ATTN>(p, layer, stream); launch_stage<S_DSA_ATTN>(p, layer, stream);
        launch_stage<S_GEMM_OUT>(p, layer, stream); launch_stage<S_NORM2>(p, layer, stream); launch_stage<S_GEMM_Q>(p, layer, stream);
        launch_stage<S_PEER_TOPK>(p, layer, stream); launch_stage<S_PEER_GATHER>(p, layer, stream);
    }
#endif
}
```

```cpp
#include <hip/hip_runtime.h>
#include <hip/hip_cooperative_groups.h>
#include <stdint.h>
#include <cstdio>
namespace cg = cooperative_groups;

typedef unsigned short bf16_t;
typedef short bf16x8 __attribute__((ext_vector_type(8)));
typedef float f32x4 __attribute__((ext_vector_type(4)));
typedef float f32x16 __attribute__((ext_vector_type(16)));
#define DEV __device__ __forceinline__

constexpr int T = 8192, D = 2048, NL = 2;
constexpr int INC = 4692;
constexpr int LDP = 4736;
constexpr int C_CA = 0, C_CG = 512, C_SU = 1024, C_SV = 1536;
constexpr int C_NQ = 2048, C_NKC = 2560, C_NVC = 2688, C_NKS = 2816, C_NVS = 2944, C_NKW = 3072, C_NVW = 3200;
constexpr int C_DQ = 3328, C_DK = 3840, C_DV = 3968, C_IQ = 4096, C_IK = 4608, C_NG = 4672, C_IW = 4688;
constexpr float EPS = 1e-6f;
constexpr int NTHREADS = 256;
constexpr int SMEM_BYTES = 72 * 1024;

__device__ const double INV16[16] = {1.0, 0.44036660267178046, 0.19392274474868576, 0.08539710028576561, 0.03760603093086393,
    0.016560440080994446, 0.007292664737217109, 0.003211445994752591, 0.001414213562373095, 0.000622772421914596,
    0.0002742481756762073, 0.00012076973741146504, 5.318295896944988e-05, 2.341999896140934e-05, 1.031338537721246e-05,
    4.5416704806078695e-06};

#define XCD_BAR_WORDS 3456
#define GQ_WORD(inst, x) (XCD_BAR_WORDS + 64 * ((inst) * 8 + (x)))
#define DQ_WORD(k) (XCD_BAR_WORDS + 64 * (96 + (k)))
#define CTRL_WORDS (XCD_BAR_WORDS + 64 * 112)
constexpr size_t WS_ALIGN(size_t x) { return (x + 255) & ~(size_t)255; }
constexpr size_t OFF_WinT = 0;
constexpr size_t OFF_WoutT = OFF_WinT + WS_ALIGN((size_t)2 * LDP * 2048 * 2);
constexpr size_t OFF_WqT = OFF_WoutT + WS_ALIGN((size_t)2 * 2048 * 2048 * 2);
constexpr size_t OFF_W1T = OFF_WqT + WS_ALIGN((size_t)2 * 1024 * 2048 * 2);
constexpr size_t OFF_PI = OFF_W1T + WS_ALIGN((size_t)4 * 128 * 4096 * 2);
constexpr size_t OFF_Utab = OFF_PI + WS_ALIGN(256);
constexpr size_t OFF_Vtab = OFF_Utab + WS_ALIGN((size_t)2 * 16384 * 1536);
constexpr size_t OFF_ada = OFF_Vtab + WS_ALIGN((size_t)2 * 16384 * 1536);
constexpr size_t OFF_ropeC = OFF_ada + WS_ALIGN((size_t)2 * 12288 * 4);
constexpr size_t OFF_ropeS = OFF_ropeC + WS_ALIGN((size_t)T * 24 * 4);
constexpr size_t OFF_HN = OFF_ropeS + WS_ALIGN((size_t)T * 24 * 4);
constexpr size_t OFF_PROJ = OFF_HN + WS_ALIGN((size_t)T * D * 2);
constexpr size_t OFF_Y = OFF_PROJ + WS_ALIGN((size_t)T * LDP * 2);
constexpr size_t OFF_QN = OFF_Y + WS_ALIGN((size_t)T * D * 2);
constexpr size_t OFF_QR = OFF_QN + WS_ALIGN((size_t)T * 512 * 2);
constexpr size_t OFF_KS = OFF_QR + WS_ALIGN((size_t)T * 512 * 2);
constexpr size_t OFF_KW = OFF_KS + WS_ALIGN((size_t)T * 128 * 2);
constexpr size_t OFF_VST = OFF_KW + WS_ALIGN((size_t)T * 128 * 2);
constexpr size_t OFF_VWT = OFF_VST + WS_ALIGN((size_t)T * 128 * 2);
constexpr size_t OFF_GATES = OFF_VWT + WS_ALIGN((size_t)T * 128 * 2);
constexpr size_t OFF_KC = OFF_GATES + WS_ALIGN((size_t)T * 12 * 4);
constexpr size_t OFF_VCT = OFF_KC + WS_ALIGN((size_t)512 * 128 * 2);
constexpr size_t OFF_SEL = OFF_VCT + WS_ALIGN((size_t)128 * 512 * 2);
constexpr size_t OFF_OCMP = OFF_SEL + WS_ALIGN((size_t)T * 4 * 4);
constexpr size_t OFF_DQ = OFF_OCMP + WS_ALIGN((size_t)T * 512 * 2);
constexpr size_t OFF_DK = OFF_DQ + WS_ALIGN((size_t)T * 512 * 2);
constexpr size_t OFF_IQ = OFF_DK + WS_ALIGN((size_t)T * 128 * 2);
constexpr size_t OFF_IK = OFF_IQ + WS_ALIGN((size_t)T * 512 * 2);
constexpr size_t OFF_IW = OFF_IK + WS_ALIGN((size_t)T * 64 * 2);
constexpr size_t OFF_IDX = OFF_IW + WS_ALIGN((size_t)T * 8 * 4);
constexpr size_t OFF_CNT = OFF_IDX + WS_ALIGN((size_t)T * 256 * 4);
constexpr size_t OFF_X1 = OFF_CNT + WS_ALIGN((size_t)T * 4);
constexpr size_t OFF_X2 = OFF_X1 + WS_ALIGN((size_t)T * D * 4);
constexpr size_t OFF_PQ = OFF_X2 + WS_ALIGN((size_t)T * D * 4);
constexpr size_t OFF_PE = OFF_PQ + WS_ALIGN((size_t)T * 1024 * 4);
constexpr size_t OFF_PG = OFF_PE + WS_ALIGN((size_t)T * 128 * 4);
constexpr size_t OFF_bar = OFF_PG + WS_ALIGN((size_t)T * 128 * 4);
constexpr size_t WS_TOTAL = OFF_bar + WS_ALIGN((size_t)CTRL_WORDS * 4);

struct P {
    const float* x; const float* c; const int* pos; const float* ada_w; const float* ada_b; const float* n1g; const float* n2g;
    const float* w_in; const float* w_out; const float* conv_w; const float* conv_b; const float* cln_g; const float* cln_b;
    const float* sln_g; const float* sln_b; const float* sgu_w; const float* sgu_b; const float* nsa_qg; const float* nsa_kg;
    const float* cmp_pos; const float* cmp_w1; const float* cmp_w2; const float* dsa_qg; const float* dsa_kg;
    const float* peer_wq; const float* peer_sk; const float* peer_u; const float* peer_v;
    float* out;
    char* ws;
    __host__ __device__ __forceinline__ bf16_t* WinT() const { return (bf16_t*)(ws + OFF_WinT); }
    __host__ __device__ __forceinline__ bf16_t* WoutT() const { return (bf16_t*)(ws + OFF_WoutT); }
    __host__ __device__ __forceinline__ bf16_t* WqT() const { return (bf16_t*)(ws + OFF_WqT); }
    __host__ __device__ __forceinline__ bf16_t* W1T() const { return (bf16_t*)(ws + OFF_W1T); }
    __host__ __device__ __forceinline__ int* PI() const { return (int*)(ws + OFF_PI); }
    __host__ __device__ __forceinline__ unsigned char* Utab() const { return (unsigned char*)(ws + OFF_Utab); }
    __host__ __device__ __forceinline__ unsigned char* Vtab() const { return (unsigned char*)(ws + OFF_Vtab); }
    __host__ __device__ __forceinline__ float* ada() const { return (float*)(ws + OFF_ada); }
    __host__ __device__ __forceinline__ float* ropeC() const { return (float*)(ws + OFF_ropeC); }
    __host__ __device__ __forceinline__ float* ropeS() const { return (float*)(ws + OFF_ropeS); }
    __host__ __device__ __forceinline__ bf16_t* HN() const { return (bf16_t*)(ws + OFF_HN); }
    __host__ __device__ __forceinline__ bf16_t* PROJ() const { return (bf16_t*)(ws + OFF_PROJ); }
    __host__ __device__ __forceinline__ bf16_t* Y() const { return (bf16_t*)(ws + OFF_Y); }
    __host__ __device__ __forceinline__ bf16_t* QN() const { return (bf16_t*)(ws + OFF_QN); }
    __host__ __device__ __forceinline__ bf16_t* QR() const { return (bf16_t*)(ws + OFF_QR); }
    __host__ __device__ __forceinline__ bf16_t* KS() const { return (bf16_t*)(ws + OFF_KS); }
    __host__ __device__ __forceinline__ bf16_t* KW() const { return (bf16_t*)(ws + OFF_KW); }
    __host__ __device__ __forceinline__ bf16_t* VST() const { return (bf16_t*)(ws + OFF_VST); }
    __host__ __device__ __forceinline__ bf16_t* VWT() const { return (bf16_t*)(ws + OFF_VWT); }
    __host__ __device__ __forceinline__ float* GATES() const { return (float*)(ws + OFF_GATES); }
    __host__ __device__ __forceinline__ bf16_t* KC() const { return (bf16_t*)(ws + OFF_KC); }
    __host__ __device__ __forceinline__ bf16_t* VCT() const { return (bf16_t*)(ws + OFF_VCT); }
    __host__ __device__ __forceinline__ unsigned* SEL() const { return (unsigned*)(ws + OFF_SEL); }
    __host__ __device__ __forceinline__ bf16_t* OCMP() const { return (bf16_t*)(ws + OFF_OCMP); }
    __host__ __device__ __forceinline__ bf16_t* DQ() const { return (bf16_t*)(ws + OFF_DQ); }
    __host__ __device__ __forceinline__ bf16_t* DK() const { return (bf16_t*)(ws + OFF_DK); }
    __host__ __device__ __forceinline__ bf16_t* IQ() const { return (bf16_t*)(ws + OFF_IQ); }
    __host__ __device__ __forceinline__ bf16_t* IK() const { return (bf16_t*)(ws + OFF_IK); }
    __host__ __device__ __forceinline__ float* IW() const { return (float*)(ws + OFF_IW); }
    __host__ __device__ __forceinline__ int* IDX() const { return (int*)(ws + OFF_IDX); }
    __host__ __device__ __forceinline__ int* CNT() const { return (int*)(ws + OFF_CNT); }
    __host__ __device__ __forceinline__ float* X1() const { return (float*)(ws + OFF_X1); }
    __host__ __device__ __forceinline__ float* X2() const { return (float*)(ws + OFF_X2); }
    __host__ __device__ __forceinline__ float* PQ() const { return (float*)(ws + OFF_PQ); }
    __host__ __device__ __forceinline__ int* PE() const { return (int*)(ws + OFF_PE); }
    __host__ __device__ __forceinline__ float* PG() const { return (float*)(ws + OFF_PG); }
    __host__ __device__ __forceinline__ unsigned* bar() const { return (unsigned*)(ws + OFF_bar); }
};

DEV float bf2f(bf16_t v) { return __uint_as_float(((unsigned)v) << 16); }
DEV unsigned pk2(float lo, float hi) { unsigned r; asm("v_cvt_pk_bf16_f32 %0, %1, %2" : "=v"(r) : "v"(lo), "v"(hi)); return r; }
DEV bf16_t f2bf(float v) { return (bf16_t)(pk2(v, 0.f) & 0xffffu); }
DEV float lo2f(unsigned u) { return __uint_as_float(u << 16); }
DEV float hi2f(unsigned u) { return __uint_as_float(u & 0xffff0000u); }
DEV float wsum(float v) {
#pragma unroll
    for (int o = 32; o > 0; o >>= 1) v += __shfl_xor(v, o);
    return v;
}
DEV float wmax(float v) {
#pragma unroll
    for (int o = 32; o > 0; o >>= 1) v = fmaxf(v, __shfl_xor(v, o));
    return v;
}
DEV int tidx() { int t = threadIdx.x; asm volatile("" : "+v"(t)); return t; }
DEV float sigmoidf_(float x) { return 1.0f / (1.0f + __expf(-x)); }
DEV float gelu_tanh(float x) {
    const float y = 0.7978845608028654f * (x + 0.044715f * x * x * x);
    const float t = 1.0f - 2.0f / (1.0f + __expf(2.0f * y));
    return 0.5f * x * (1.0f + t);
}
DEV f32x4 mfma16(bf16x8 a, bf16x8 b, f32x4 c) { return __builtin_amdgcn_mfma_f32_16x16x32_bf16(a, b, c, 0, 0, 0); }
DEV f32x16 mfma32(bf16x8 a, bf16x8 b, f32x16 c) { return __builtin_amdgcn_mfma_f32_32x32x16_bf16(a, b, c, 0, 0, 0); }

DEV int src_col(int n) {
    if (n < 3328) return n;
    if (n < 4672) return 3340 + (n - 3328);
    if (n < 4684) return 3328 + (n - 4672);
    if (n < 4688) return -1;
    if (n < 4696) return 4684 + (n - 4688);
    return -1;
}

DEV void st_convT(const float* __restrict__ W, bf16_t* __restrict__ Bt, int N, int Npad, bool remap, int unit, char* smem, int Kdim = 2048) {
    float (*tile)[65] = (float (*)[65])smem;
    const int ntn = Npad / 64, kt = unit / ntn, nt = unit % ntn, k0 = kt * 64, n0 = nt * 64;
    const int tid_ = tidx(); const int tx = tid_ & 63, ty = tid_ >> 6;
    const int n = n0 + tx;
    const int src = remap ? src_col(n) : (n < N ? n : -1);
#pragma unroll
    for (int i = 0; i < 16; ++i) { const int k = ty + 4 * i; tile[k][tx] = src >= 0 ? W[(size_t)(k0 + k) * N + src] : 0.f; }
    __syncthreads();
#pragma unroll
    for (int i = 0; i < 16; ++i) { const int r = ty + 4 * i; Bt[(size_t)(n0 + r) * Kdim + k0 + tx] = f2bf(tile[tx][r]); }
    __syncthreads();
}

typedef float f32x2 __attribute__((ext_vector_type(2)));
typedef float v16f __attribute__((ext_vector_type(16)));
typedef float v32f __attribute__((ext_vector_type(32)));
typedef unsigned v6u __attribute__((ext_vector_type(6)));
constexpr float U6_SCALE = 64.0f, V6_SCALE = 3.0f;
constexpr int ROW6 = 1536;
#define FP6_ONE __uint_as_float(0x3F80007Fu)

#ifndef SW_FP6
#define SW_FP6 1
#endif
DEV unsigned fp6_enc1(float f) {
    const float a = fminf(fabsf(f), 7.5f);
    const float sc = a < 2.0f ? 8.0f : (a < 4.0f ? 4.0f : 2.0f), of = a < 2.0f ? 0.0f : (a < 4.0f ? 8.0f : 16.0f);
    const unsigned code = (unsigned)(int)__builtin_rintf(a * sc + of);
    return code | ((__float_as_uint(f) >> 26) & 32u);
}
DEV float fp6_dec1(unsigned c) {
    const unsigned e = (c >> 3) & 3u, m = c & 7u;
    const float v = e == 0u ? 0.125f * (float)m : (1.0f + 0.125f * (float)m) * (float)(1u << (e - 1u));
    return (c & 32u) ? -v : v;
}
DEV v6u sw_pack32(const v16f& x, const v16f& y) {
    unsigned w[6] = {0u, 0u, 0u, 0u, 0u, 0u};
#pragma unroll
    for (int i = 0; i < 32; ++i) {
        const unsigned c = fp6_enc1(i < 16 ? x[i] : y[i - 16]);
        const int bit = 6 * i, d = bit >> 5, sh = bit & 31;
        w[d] |= c << sh;
        if (sh > 26) w[d + 1] |= c >> (32 - sh);
    }
    v6u r; r[0] = w[0]; r[1] = w[1]; r[2] = w[2]; r[3] = w[3]; r[4] = w[4]; r[5] = w[5]; return r;
}
DEV v32f sw_unpack32(const v6u& pk) {
    const unsigned w[6] = {pk[0], pk[1], pk[2], pk[3], pk[4], pk[5]};
    v32f r;
#pragma unroll
    for (int i = 0; i < 32; ++i) {
        const int bit = 6 * i, d = bit >> 5, sh = bit & 31;
        unsigned c = w[d] >> sh;
        if (sh > 26) c |= w[d + 1] << (32 - sh);
        r[i] = fp6_dec1(c & 63u);
    }
    return r;
}
#define FP6_PACK(x, y) sw_pack32(x, y)
#define FP6_UNPACK(pk) __builtin_amdgcn_cvt_scalef32_pk32_f32_fp6(pk, FP6_ONE)
DEV void st_tab6(const float* __restrict__ src, unsigned char* __restrict__ dst, float scale, int nrows, int unit, int nunits, char* smem) {
    const int tid_ = tidx(), w = tid_ >> 6, l = tid_ & 63;
    float* stg = (float*)smem + w * (64 * 36);
    for (int r = unit * 4 + w; r < nrows; r += nunits * 4) {
        const float4* sp = (const float4*)(src + (size_t)r * 2048);
        float4 v[8];
#pragma unroll
        for (int i = 0; i < 8; ++i) v[i] = sp[l + 64 * i];
#pragma unroll
        for (int i = 0; i < 8; ++i) { const int f = l + 64 * i; *(float4*)(stg + (f >> 3) * 36 + (f & 7) * 4) = v[i]; }
        __builtin_amdgcn_wave_barrier();
        v16f x, y;
#pragma unroll
        for (int q = 0; q < 4; ++q) {
            const float4 a = *(const float4*)(stg + l * 36 + q * 4), b = *(const float4*)(stg + l * 36 + 16 + q * 4);
            x[4 * q] = a.x * scale; x[4 * q + 1] = a.y * scale; x[4 * q + 2] = a.z * scale; x[4 * q + 3] = a.w * scale;
            y[4 * q] = b.x * scale; y[4 * q + 1] = b.y * scale; y[4 * q + 2] = b.z * scale; y[4 * q + 3] = b.w * scale;
        }
        const v6u pk = FP6_PACK(x, y);
        unsigned char* dp = dst + (size_t)r * ROW6 + l * 8;
        *(uint2*)(dp) = make_uint2(pk[0], pk[1]); *(uint2*)(dp + 512) = make_uint2(pk[2], pk[3]); *(uint2*)(dp + 1024) = make_uint2(pk[4], pk[5]);
        __builtin_amdgcn_wave_barrier();
    }
}
DEV void st_calib(const P& p) {
    if (tidx() >= 64) return;
    v16f x, y;
#pragma unroll
    for (int k = 0; k < 32; ++k) {
        const int e = k >> 3, m = k & 7;
        const float v = e == 0 ? 0.125f * m : (1.0f + 0.125f * m) * (float)(1 << (e - 1));
        if (k < 16) x[k] = v; else y[k - 16] = v;
    }
    const v6u pk = FP6_PACK(x, y);
    const v32f d = FP6_UNPACK(pk);
    if ((threadIdx.x & 63) == 0) {
        float dmax = 0.f;
#pragma unroll
        for (int j = 0; j < 32; ++j) dmax = fmaxf(dmax, fabsf(d[j]));
        const float cscale = dmax > 0.f ? dmax * (1.0f / 7.5f) : 1.0f;
        const float ic = 1.0f / cscale;
#pragma unroll
        for (int j = 0; j < 32; ++j) {
            int found = j;
#pragma unroll
            for (int k = 0; k < 32; ++k) {
                const int e = k >> 3, m = k & 7;
                const float v = e == 0 ? 0.125f * m : (1.0f + 0.125f * m) * (float)(1 << (e - 1));
                if (fabsf(d[j] * ic - v) < 0.02f + 0.01f * v) found = k;
            }
            p.PI()[j] = found;
        }
        p.PI()[32] = __float_as_int(ic);
    }
}

DEV void st_ada(const P& p, int unit, char* smem) {
    float4* red = (float4*)smem;
    const int tid = tidx(), c4 = tid & 15, kg = tid >> 4;
    const int i = unit / 192, j = (unit % 192) * 64 + c4 * 4;
    const float* W = p.ada_w + (size_t)i * 2048 * 12288 + (size_t)kg * 12288 + j;
    float4 acc = make_float4(0.f, 0.f, 0.f, 0.f);
#pragma unroll 8
    for (int k = 0; k < 128; ++k) {
        const float cv = p.c[kg + 16 * k];
        const float a = cv * sigmoidf_(cv);
        const float4 wv = *(const float4*)(W + (size_t)(16 * k) * 12288);
        acc.x += a * wv.x; acc.y += a * wv.y; acc.z += a * wv.z; acc.w += a * wv.w;
    }
    red[kg * 16 + c4] = acc;
    __syncthreads();
    if (tid < 64) {
        const int cc = tid >> 2, e = tid & 3;
        float r = p.ada_b[i * 12288 + (unit % 192) * 64 + tid];
#pragma unroll
        for (int q = 0; q < 16; ++q) r += ((const float*)&red[q * 16 + cc])[e];
        p.ada()[i * 12288 + (unit % 192) * 64 + tid] = r;
    }
    __syncthreads();
}
DEV void st_rope(const P& p, int unit) {
    const int e = unit * 256 + tidx(); const int t = e / 24, i = e % 24;
    const double inv = i < 16 ? INV16[i] : INV16[2 * (i - 16)];
    const double ang = (double)p.pos[t] * inv;
    const double n = rint(ang * 0.15915494309189535);
    const double r = ang - n * 6.283185307179586;
    const double r2 = r * r;
    double sp = 1.0 / 1.5511210043330986e25, cp = -1.0 / 4.0329146112660565e26;
    sp = sp * r2 - 1.0 / 2.585201673888498e22;   cp = cp * r2 + 1.0 / 6.204484017332394e23;
    sp = sp * r2 + 1.0 / 5.109094217170944e19;   cp = cp * r2 - 1.0 / 1.1240007277776077e21;
    sp = sp * r2 - 1.0 / 1.21645100408832e17;    cp = cp * r2 + 1.0 / 2.43290200817664e18;
    sp = sp * r2 + 1.0 / 3.55687428096e14;       cp = cp * r2 - 1.0 / 6.402373705728e15;
    sp = sp * r2 - 1.0 / 1.307674368e12;         cp = cp * r2 + 1.0 / 2.0922789888e13;
    sp = sp * r2 + 1.0 / 6.2270208e9;            cp = cp * r2 - 1.0 / 8.71782912e10;
    sp = sp * r2 - 1.0 / 3.99168e7;              cp = cp * r2 + 1.0 / 4.790016e8;
    sp = sp * r2 + 1.0 / 362880.0;               cp = cp * r2 - 1.0 / 3628800.0;
    sp = sp * r2 - 1.0 / 5040.0;                 cp = cp * r2 + 1.0 / 40320.0;
    sp = sp * r2 + 1.0 / 120.0;                  cp = cp * r2 - 1.0 / 720.0;
    sp = sp * r2 - 1.0 / 6.0;                    cp = cp * r2 + 1.0 / 24.0;
    sp = sp * r2 + 1.0;                          cp = cp * r2 - 0.5;
    cp = cp * r2 + 1.0;
    const float cs = (float)cp, sn = (float)(sp * r);
    p.ropeC()[e] = cs; p.ropeS()[e] = sn;
}

DEV void st_norm(const float* __restrict__ X, const float* __restrict__ g, const float* __restrict__ sc, const float* __restrict__ sh,
                 bf16_t* __restrict__ HN, int unit) {
    const int tid_ = tidx(); const int w = tid_ >> 6, l = tid_ & 63; const int t = unit * 4 + w;
    const float4* xr = (const float4*)(X + (size_t)t * D);
    float4 v[8]; float ss = 0.f;
#pragma unroll
    for (int i = 0; i < 4; ++i) { v[2 * i] = xr[i * 128 + l * 2]; v[2 * i + 1] = xr[i * 128 + l * 2 + 1]; }
#pragma unroll
    for (int i = 0; i < 8; ++i) ss += v[i].x * v[i].x + v[i].y * v[i].y + v[i].z * v[i].z + v[i].w * v[i].w;
    ss = wsum(ss);
    const float rs = rsqrtf(ss * (1.0f / 2048.0f) + EPS);
#pragma unroll
    for (int i = 0; i < 4; ++i) {
        const int col = i * 512 + l * 8;
        float y[8]; const float xv[8] = {v[2 * i].x, v[2 * i].y, v[2 * i].z, v[2 * i].w, v[2 * i + 1].x, v[2 * i + 1].y, v[2 * i + 1].z, v[2 * i + 1].w};
#pragma unroll
        for (int j = 0; j < 8; ++j) y[j] = (xv[j] * rs) * g[col + j] * (1.0f + sc[col + j]) + sh[col + j];
        uint4 o; o.x = pk2(y[0], y[1]); o.y = pk2(y[2], y[3]); o.z = pk2(y[4], y[5]); o.w = pk2(y[6], y[7]);
        *(uint4*)(HN + (size_t)t * D + col) = o;
    }
}

enum { EPI_PROJ = 0, EPI_OUT = 1, EPI_Q = 2 };
struct EpiArgs { bf16_t* obf; float* of; const float* xin; const float* gate; };
template <int EPI>
DEV void st_gemm(const bf16_t* __restrict__ A, const bf16_t* __restrict__ Bt, int K, int tm, int tn, const EpiArgs& e, char* smem) {
    const int tid = tidx(), w = tid >> 6, l = tid & 63, wr = w >> 1, wc = w & 1;
    f32x4 acc[4][4];
#pragma unroll
    for (int m = 0; m < 4; ++m)
#pragma unroll
        for (int n = 0; n < 4; ++n) acc[m][n] = (f32x4){0.f, 0.f, 0.f, 0.f};
    const int srow = tid >> 2, spc = tid & 3, sc = spc ^ (((srow >> 2) & 1) << 1);
    const bf16_t* Ag = A + (size_t)(tm * 128 + srow) * K + sc * 8;
    const bf16_t* Bg = Bt + (size_t)(tn * 128 + srow) * K + sc * 8;
#define GEMM_STAGE(BUF, KO) do { char* _b = smem + (BUF) * 16384 + tid * 16; \
        __builtin_amdgcn_global_load_lds((const unsigned*)(Ag + (KO)), (__attribute__((address_space(3))) unsigned*)(_b), 16, 0, 0); \
        __builtin_amdgcn_global_load_lds((const unsigned*)(Ag + (size_t)64 * K + (KO)), (__attribute__((address_space(3))) unsigned*)(_b + 4096), 16, 0, 0); \
        __builtin_amdgcn_global_load_lds((const unsigned*)(Bg + (KO)), (__attribute__((address_space(3))) unsigned*)(_b + 8192), 16, 0, 0); \
        __builtin_amdgcn_global_load_lds((const unsigned*)(Bg + (size_t)64 * K + (KO)), (__attribute__((address_space(3))) unsigned*)(_b + 12288), 16, 0, 0); } while (0)
    const int nk = K / 32;
    GEMM_STAGE(0, 0); GEMM_STAGE(1, 32); GEMM_STAGE(2, 64);
    asm volatile("s_waitcnt vmcnt(8)" ::: "memory");
    __builtin_amdgcn_s_barrier();
    const int fr = l & 15, fq = l >> 4;
#pragma unroll 1
    for (int kt = 0; kt < nk; ++kt) {
        if (kt + 3 < nk) GEMM_STAGE((kt + 3) & 3, (kt + 3) * 32);
        const char* As = smem + (kt & 3) * 16384; const char* Bs = As + 8192;
        bf16x8 af[4], bfr[4];
#pragma unroll
        for (int m = 0; m < 4; ++m) { const int row = wr * 64 + m * 16 + fr; af[m] = *(const bf16x8*)(As + row * 64 + ((fq ^ (((row >> 2) & 1) << 1)) << 4)); }
#pragma unroll
        for (int n = 0; n < 4; ++n) { const int row = wc * 64 + n * 16 + fr; bfr[n] = *(const bf16x8*)(Bs + row * 64 + ((fq ^ (((row >> 2) & 1) << 1)) << 4)); }
#pragma unroll
        for (int m = 0; m < 4; ++m)
#pragma unroll
            for (int n = 0; n < 4; ++n) acc[m][n] = mfma16(bfr[n], af[m], acc[m][n]);
        if (kt + 3 < nk) asm volatile("s_waitcnt vmcnt(8)" ::: "memory");
        else if (kt + 2 < nk) asm volatile("s_waitcnt vmcnt(4)" ::: "memory");
        else asm volatile("s_waitcnt vmcnt(0)" ::: "memory");
        asm volatile("s_waitcnt lgkmcnt(0)" ::: "memory");
        __builtin_amdgcn_s_barrier();
    }
#undef GEMM_STAGE
#pragma unroll
    for (int m = 0; m < 4; ++m) {
        const int row = tm * 128 + wr * 64 + m * 16 + (l & 15);
#pragma unroll
        for (int n = 0; n < 4; ++n) {
            const int col = tn * 128 + wc * 64 + n * 16 + 4 * (l >> 4);
            const f32x4 a = acc[m][n];
            if (EPI == EPI_PROJ) {
                uint2 o; o.x = pk2(a[0], a[1]); o.y = pk2(a[2], a[3]);
                *(uint2*)(e.obf + (size_t)row * LDP + col) = o;
            } else if (EPI == EPI_OUT) {
                const float4 xi = *(const float4*)(e.xin + (size_t)row * D + col);
                const float4 gg = *(const float4*)(e.gate + col);
                float4 o; o.x = xi.x + gg.x * a[0]; o.y = xi.y + gg.y * a[1]; o.z = xi.z + gg.z * a[2]; o.w = xi.w + gg.w * a[3];
                *(float4*)(e.of + (size_t)row * D + col) = o;
            } else {
                float4 o; o.x = a[0]; o.y = a[1]; o.z = a[2]; o.w = a[3];
                *(float4*)(e.of + (size_t)row * 1024 + col) = o;
            }
        }
    }
    __syncthreads();
}

DEV void st_conv(const P& p, int layer, int unit, char* smem) {
    float* cs = (float*)smem;
    const int tid = tidx(), t0 = unit * 16;
    const float* cw = p.conv_w + (size_t)layer * 31 * 512;
#pragma unroll 1
    for (int cc = 0; cc < 2; ++cc) {
        const int c = tid + 256 * cc;
        float w[31], z[46];
#pragma unroll
        for (int k = 0; k < 31; ++k) w[k] = cw[k * 512 + c];
#pragma unroll
        for (int r = 0; r < 46; ++r) {
            const int t = t0 - 30 + r;
            float zz = 0.f;
            if (t >= 0) {
                const float a = bf2f(p.PROJ()[(size_t)t * LDP + C_CA + c]), g = bf2f(p.PROJ()[(size_t)t * LDP + C_CG + c]);
                zz = a * sigmoidf_(g);
            }
            z[r] = zz;
        }
        const float cb = p.conv_b[layer * 512 + c];
#pragma unroll
        for (int tt = 0; tt < 16; ++tt) {
            float acc = cb;
#pragma unroll
            for (int k = 0; k < 31; ++k) acc += w[k] * z[tt + k];
            cs[tt * 512 + c] = acc;
        }
    }
    __syncthreads();
    const int w = tid >> 6, l = tid & 63;
    const float* lg = p.cln_g + layer * 512; const float* lb = p.cln_b + layer * 512;
#pragma unroll 1
    for (int q = 0; q < 4; ++q) {
        const int tt = w * 4 + q;
        float v[8]; float s = 0.f;
#pragma unroll
        for (int i = 0; i < 8; ++i) { v[i] = cs[tt * 512 + l + 64 * i]; s += v[i]; }
        const float mean = wsum(s) * (1.0f / 512.0f);
        float q2 = 0.f;
#pragma unroll
        for (int i = 0; i < 8; ++i) { const float d = v[i] - mean; q2 += d * d; }
        const float rstd = rsqrtf(wsum(q2) * (1.0f / 512.0f) + EPS);
#pragma unroll
        for (int i = 0; i < 8; ++i) {
            const int c = l + 64 * i;
            const float y = (v[i] - mean) * rstd * lg[c] + lb[c];
            p.Y()[(size_t)(t0 + tt) * D + c] = f2bf(y * sigmoidf_(y));
        }
    }
    __syncthreads();
}

DEV void st_sgu(const P& p, int layer, int unit, char* smem) {
    const int n = unit >> 2, h = unit & 3, tid = tidx(), w = tid >> 6, l = tid & 63;
    float* stat = (float*)smem;
    float* wt = stat + 256;
    float* vt = wt + 16 * 132;
    const int tb = n * 128;
#pragma unroll 1
    for (int q = 0; q < 32; ++q) {
        const int j = w * 32 + q;
        const uint4 raw = *(const uint4*)(p.PROJ() + (size_t)(tb + j) * LDP + C_SV + l * 8);
        float v[8] = {lo2f(raw.x), hi2f(raw.x), lo2f(raw.y), hi2f(raw.y), lo2f(raw.z), hi2f(raw.z), lo2f(raw.w), hi2f(raw.w)};
        float s = 0.f;
#pragma unroll
        for (int i = 0; i < 8; ++i) s += v[i];
        const float mean = wsum(s) * (1.0f / 512.0f);
        float q2 = 0.f;
#pragma unroll
        for (int i = 0; i < 8; ++i) { const float d = v[i] - mean; q2 += d * d; }
        const float rstd = rsqrtf(wsum(q2) * (1.0f / 512.0f) + EPS);
        if (l == 0) { stat[j * 2] = mean; stat[j * 2 + 1] = rstd; }
    }
    __syncthreads();
    const int ti = tid >> 4, td = tid & 15;
    float acc[8][8];
#pragma unroll
    for (int a = 0; a < 8; ++a)
#pragma unroll
        for (int b = 0; b < 8; ++b) acc[a][b] = 0.f;
    const float* Wh = p.sgu_w + ((size_t)layer * 4 + h) * 128 * 128;
    const float* lg = p.sln_g + layer * 512 + h * 128; const float* lb = p.sln_b + layer * 512 + h * 128;
#pragma unroll 1
    for (int jc = 0; jc < 8; ++jc) {
#pragma unroll 2
        for (int q = 0; q < 8; ++q) {
            const int e = tid + 256 * q;
            { const int i = e >> 4, jj = e & 15, j = jc * 16 + jj; wt[jj * 132 + i] = (i >= j) ? Wh[i * 128 + j] : 0.f; }
            { const int jj = e >> 7, d = e & 127, j = jc * 16 + jj;
              const float x = bf2f(p.PROJ()[(size_t)(tb + j) * LDP + C_SV + h * 128 + d]);
              vt[jj * 128 + d] = (x - stat[j * 2]) * stat[j * 2 + 1] * lg[d] + lb[d]; }
        }
        __syncthreads();
        if (w * 32 + 31 >= jc * 16) {
#pragma unroll 2
            for (int jj = 0; jj < 16; ++jj) {
                const float4 w0 = *(const float4*)(wt + jj * 132 + ti * 8), w1 = *(const float4*)(wt + jj * 132 + ti * 8 + 4);
                const float4 v0 = *(const float4*)(vt + jj * 128 + td * 8), v1 = *(const float4*)(vt + jj * 128 + td * 8 + 4);
                const float wv[8] = {w0.x, w0.y, w0.z, w0.w, w1.x, w1.y, w1.z, w1.w};
                const float vv[8] = {v0.x, v0.y, v0.z, v0.w, v1.x, v1.y, v1.z, v1.w};
#pragma unroll
                for (int a = 0; a < 8; ++a)
#pragma unroll
                    for (int b = 0; b < 8; ++b) acc[a][b] += wv[a] * vv[b];
            }
        }
        __syncthreads();
    }
#pragma unroll
    for (int a = 0; a < 8; ++a) {
        const int i = ti * 8 + a; const size_t t = tb + i;
        const float bs = p.sgu_b[((size_t)layer * 4 + h) * 128 + i];
        const uint4 ur = *(const uint4*)(p.PROJ() + t * LDP + C_SU + h * 128 + td * 8);
        const float u[8] = {lo2f(ur.x), hi2f(ur.x), lo2f(ur.y), hi2f(ur.y), lo2f(ur.z), hi2f(ur.z), lo2f(ur.w), hi2f(ur.w)};
        float y[8];
#pragma unroll
        for (int b = 0; b < 8; ++b) y[b] = u[b] * (acc[a][b] + bs);
        uint4 o; o.x = pk2(y[0], y[1]); o.y = pk2(y[2], y[3]); o.z = pk2(y[4], y[5]); o.w = pk2(y[6], y[7]);
        *(uint4*)(p.Y() + t * D + 512 + h * 128 + td * 8) = o;
    }
}

DEV void st_vtrans(const P& p, int unit, char* smem) {
    bf16_t* tile = (bf16_t*)smem;
    const int which = unit & 1, tt0 = (unit >> 1) * 64, tid = tidx();
    const int col0 = which ? C_NVW : C_NVS;
    bf16_t* dst = which ? p.VWT() : p.VST();
#pragma unroll
    for (int q = 0; q < 4; ++q) {
        const int e = tid + 256 * q; const int r = e >> 4, c8 = e & 15;
        const uint4 raw = *(const uint4*)(p.PROJ() + (size_t)(tt0 + r) * LDP + col0 + c8 * 8);
        unsigned* d32 = (unsigned*)(tile + r * 130 + c8 * 8);
        d32[0] = raw.x; d32[1] = raw.y; d32[2] = raw.z; d32[3] = raw.w;
    }
    __syncthreads();
    const int d = tid >> 1, half = tid & 1;
    unsigned o[16];
#pragma unroll
    for (int i = 0; i < 16; ++i) {
        const unsigned a = tile[(half * 32 + 2 * i) * 130 + d], b = tile[(half * 32 + 2 * i + 1) * 130 + d];
        o[i] = a | (b << 16);
    }
    uint4* dp = (uint4*)(dst + (size_t)d * T + tt0 + half * 32);
#pragma unroll
    for (int i = 0; i < 4; ++i) dp[i] = make_uint4(o[4 * i], o[4 * i + 1], o[4 * i + 2], o[4 * i + 3]);
    __syncthreads();
}

DEV void st_prep(const P& p, int layer, int unit) {
    const int tid_ = tidx(); const int w = tid_ >> 6, l = tid_ & 63; const size_t t = (size_t)unit * 4 + w;
    const bf16_t* row = p.PROJ() + t * LDP;
    const float* rc = p.ropeC() + t * 24; const float* rs_ = p.ropeS() + t * 24;
    unsigned raw[11];
#pragma unroll
    for (int h = 0; h < 4; ++h) { raw[h] = *(const unsigned*)(row + C_NQ + h * 128 + 2 * l); raw[6 + h] = *(const unsigned*)(row + C_DQ + h * 128 + 2 * l); }
    raw[4] = *(const unsigned*)(row + C_NKS + 2 * l); raw[5] = *(const unsigned*)(row + C_NKW + 2 * l); raw[10] = *(const unsigned*)(row + C_DK + 2 * l);
    bf16_t iraw[9];
#pragma unroll
    for (int h = 0; h < 9; ++h) iraw[h] = row[(h < 8 ? C_IQ + h * 64 : C_IK) + l];
    const float gq0 = p.nsa_qg[layer * 128 + 2 * l], gq1 = p.nsa_qg[layer * 128 + 2 * l + 1];
    const float gs0 = p.nsa_kg[(layer * 3 + 1) * 128 + 2 * l], gs1 = p.nsa_kg[(layer * 3 + 1) * 128 + 2 * l + 1];
    const float gw0 = p.nsa_kg[(layer * 3 + 2) * 128 + 2 * l], gw1 = p.nsa_kg[(layer * 3 + 2) * 128 + 2 * l + 1];
    const float dq0 = p.dsa_qg[layer * 128 + 2 * l], dq1 = p.dsa_qg[layer * 128 + 2 * l + 1];
    const float dk0 = p.dsa_kg[layer * 128 + 2 * l], dk1 = p.dsa_kg[layer * 128 + 2 * l + 1];
    const float c0 = rc[(2 * l) & 15], c1 = rc[(2 * l + 1) & 15], s0 = rs_[(2 * l) & 15], s1 = rs_[(2 * l + 1) & 15];
    const float ic = rc[16 + (l & 7)], is = rs_[16 + (l & 7)];
    float x0[11], x1[11], ss[11];
#pragma unroll
    for (int h = 0; h < 11; ++h) { x0[h] = lo2f(raw[h]); x1[h] = hi2f(raw[h]); ss[h] = x0[h] * x0[h] + x1[h] * x1[h]; }
#pragma unroll
    for (int o = 32; o > 0; o >>= 1)
#pragma unroll
        for (int h = 0; h < 11; ++h) ss[h] += __shfl_xor(ss[h], o);
#pragma unroll
    for (int h = 0; h < 11; ++h) {
        const float r = rsqrtf(ss[h] * (1.0f / 128.0f) + EPS);
        const float g0 = h < 4 ? gq0 : (h == 4 ? gs0 : (h == 5 ? gw0 : (h < 10 ? dq0 : dk0)));
        const float g1 = h < 4 ? gq1 : (h == 4 ? gs1 : (h == 5 ? gw1 : (h < 10 ? dq1 : dk1)));
        const float n0 = x0[h] * r * g0, n1 = x1[h] * r * g1;
        const float o0 = __shfl_xor(n0, 8), o1 = __shfl_xor(n1, 8);
        float r0 = n0, r1 = n1;
        if (l < 8) { r0 = n0 * c0 - o0 * s0; r1 = n1 * c1 - o1 * s1; }
        else if (l < 16) { r0 = n0 * c0 + o0 * s0; r1 = n1 * c1 + o1 * s1; }
        const unsigned roped = pk2(r0, r1);
        if (h < 4) { *(unsigned*)(p.QN() + (t * 4 + h) * 128 + 2 * l) = pk2(n0, n1); *(unsigned*)(p.QR() + (t * 4 + h) * 128 + 2 * l) = roped; }
        else if (h == 4) *(unsigned*)(p.KS() + t * 128 + 2 * l) = roped;
        else if (h == 5) *(unsigned*)(p.KW() + t * 128 + 2 * l) = roped;
        else if (h < 10) *(unsigned*)(p.DQ() + (t * 4 + (h - 6)) * 128 + 2 * l) = roped;
        else *(unsigned*)(p.DK() + t * 128 + 2 * l) = roped;
    }
    if (l < 12) p.GATES()[t * 12 + l] = sigmoidf_(bf2f(row[C_NG + l]));
#pragma unroll
    for (int h = 0; h < 9; ++h) {
        const float x = bf2f(iraw[h]);
        const float other = __shfl_xor(x, 8);
        float o = x;
        if (l < 16) o = (l < 8) ? (x * ic - other * is) : (x * ic + other * is);
        if (h < 8) p.IQ()[(t * 8 + h) * 64 + l] = f2bf(o); else p.IK()[t * 64 + l] = f2bf(o);
    }
    if (l < 8) p.IW()[t * 8 + l] = bf2f(row[C_IW + l]) * (0.35355339059327373f * 0.125f);
}

DEV void st_compress(const P& p, int layer, int unit, char* smem) {
    const int which = unit & 1, rt = unit >> 1, tid = tidx(), w = tid >> 6, l = tid & 63, fr = l & 15, fq = l >> 4;
    float* hid = (float*)smem;
    float* ob = hid + 16 * 128;
    const int nb = rt * 16 + fr;
    const int col0 = which ? C_NVC : C_NKC;
    const float* ps = p.cmp_pos + ((size_t)layer * 2 + which) * 4096;
    const bf16_t* w1t = p.W1T() + ((size_t)layer * 2 + which) * 128 * 4096;
    const bool rowok = nb < 511;
    const bf16_t* xrow = p.PROJ() + (size_t)(rowok ? nb * 16 : 0) * LDP + col0;
    f32x4 acc[2] = {(f32x4){0.f, 0.f, 0.f, 0.f}, (f32x4){0.f, 0.f, 0.f, 0.f}};
#pragma unroll 4
    for (int ks = 0; ks < 128; ++ks) {
        const int k = ks * 32 + fq * 8, lt = k >> 7, d = k & 127;
        const uint4 xr = *(const uint4*)(xrow + (size_t)lt * LDP + d);
        const float4 p0 = *(const float4*)(ps + k), p1 = *(const float4*)(ps + k + 4);
        union { bf16x8 v; unsigned u32[4]; } a;
        a.u32[0] = pk2(lo2f(xr.x) + p0.x, hi2f(xr.x) + p0.y); a.u32[1] = pk2(lo2f(xr.y) + p0.z, hi2f(xr.y) + p0.w);
        a.u32[2] = pk2(lo2f(xr.z) + p1.x, hi2f(xr.z) + p1.y); a.u32[3] = pk2(lo2f(xr.w) + p1.z, hi2f(xr.w) + p1.w);
#pragma unroll
        for (int nt = 0; nt < 2; ++nt) {
            const bf16x8 b = *(const bf16x8*)(w1t + (size_t)(w * 32 + nt * 16 + fr) * 4096 + k);
            acc[nt] = mfma16(a.v, b, acc[nt]);
        }
    }
#pragma unroll
    for (int nt = 0; nt < 2; ++nt)
#pragma unroll
        for (int r = 0; r < 4; ++r) hid[(4 * fq + r) * 128 + w * 32 + nt * 16 + fr] = gelu_tanh(acc[nt][r]);
    __syncthreads();
    const float* w2 = p.cmp_w2 + ((size_t)layer * 2 + which) * 128 * 128;
    const int c2 = tid & 127, mh = tid >> 7;
    float o[8];
#pragma unroll
    for (int b = 0; b < 8; ++b) o[b] = 0.f;
#pragma unroll 4
    for (int k = 0; k < 128; ++k) {
        const float wv = w2[k * 128 + c2];
#pragma unroll
        for (int b = 0; b < 8; ++b) o[b] += hid[(mh * 8 + b) * 128 + k] * wv;
    }
#pragma unroll
    for (int b = 0; b < 8; ++b) ob[(mh * 8 + b) * 128 + c2] = o[b];
    __syncthreads();
#pragma unroll
    for (int q = 0; q < 4; ++q) {
        const int b = w * 4 + q, nbo = rt * 16 + b;
        float v0 = ob[b * 128 + l], v1 = ob[b * 128 + l + 64];
        if (which == 0) {
            const float r = rsqrtf(wsum(v0 * v0 + v1 * v1) * (1.0f / 128.0f) + EPS);
            const float* kg = p.nsa_kg + (layer * 3 + 0) * 128;
            v0 = v0 * r * kg[l]; v1 = v1 * r * kg[l + 64];
            if (nbo >= 511) { v0 = 0.f; v1 = 0.f; }
            p.KC()[nbo * 128 + l] = f2bf(v0); p.KC()[nbo * 128 + l + 64] = f2bf(v1);
        } else {
            if (nbo >= 511) { v0 = 0.f; v1 = 0.f; }
            p.VCT()[l * 512 + nbo] = f2bf(v0); p.VCT()[(l + 64) * 512 + nbo] = f2bf(v1);
        }
    }
    __syncthreads();
}

DEV void st_nsa_cmp(const P& p, int unit, char* smem) {
    constexpr int RSK = 272, RSV = 136, BUFB = 64 * RSK + 128 * RSV;
    const int tid = tidx(), w = tid >> 6, l = tid & 63, qc = l & 15, g4 = l >> 4;
    const int t0 = unit * 16 + w * 4;
    const int tk = qc >> 2, hd = qc & 3, t = t0 + tk;
    bf16x8 qf[4];
#pragma unroll
    for (int ks = 0; ks < 4; ++ks) qf[ks] = *(const bf16x8*)(p.QN() + ((size_t)t0 * 4 + qc) * 128 + ks * 32 + g4 * 8);
    const int tmaxb = unit * 16 + 15;
    const int nvb = tmaxb >= 31 ? (tmaxb - 31) / 16 + 1 : 0;
    const int nsteps = (nvb + 63) >> 6;
    const int nvis = t >= 31 ? (t - 31) / 16 + 1 : 0;
    const float cs = 0.08838834764831845f * 1.4426950408889634f;
    const int krow = tid >> 4, kc16 = tid & 15, vrow = tid >> 3, vc16 = tid & 7;
    const bf16_t* Kg = p.KC(); const bf16_t* Vg = p.VCT();
    int gstep = 0;
    uint4 rk0, rk1, rk2, rk3, rv0, rv1, rv2, rv3;
#define CMP_LOADK(ST) do { const bf16_t* kb = Kg + (size_t)((ST) * 64 + krow) * 128 + kc16 * 8; \
        rk0 = *(const uint4*)kb; rk1 = *(const uint4*)(kb + 16 * 128); rk2 = *(const uint4*)(kb + 32 * 128); rk3 = *(const uint4*)(kb + 48 * 128); } while (0)
#define CMP_LOADV(ST) do { const bf16_t* vb = Vg + (size_t)vrow * 512 + (ST) * 64 + vc16 * 8; \
        rv0 = *(const uint4*)vb; rv1 = *(const uint4*)(vb + 32 * 512); rv2 = *(const uint4*)(vb + 64 * 512); rv3 = *(const uint4*)(vb + 96 * 512); } while (0)
#define CMP_STOREK(KT) do { *(uint4*)((KT) + krow * RSK + kc16 * 16) = rk0; *(uint4*)((KT) + (krow + 16) * RSK + kc16 * 16) = rk1; \
        *(uint4*)((KT) + (krow + 32) * RSK + kc16 * 16) = rk2; *(uint4*)((KT) + (krow + 48) * RSK + kc16 * 16) = rk3; } while (0)
#define CMP_STOREV(VT) do { *(uint4*)((VT) + vrow * RSV + vc16 * 16) = rv0; *(uint4*)((VT) + (vrow + 32) * RSV + vc16 * 16) = rv1; \
        *(uint4*)((VT) + (vrow + 64) * RSV + vc16 * 16) = rv2; *(uint4*)((VT) + (vrow + 96) * RSV + vc16 * 16) = rv3; } while (0)
    float m = -1e30f, lsum = 0.f;
    if (nsteps > 0) CMP_LOADK(0);
#pragma unroll 1
    for (int st = 0; st < nsteps; ++st, ++gstep) {
        char* Kt = smem + (gstep & 1) * BUFB;
        CMP_STOREK(Kt);
        __syncthreads();
        if (st + 1 < nsteps) CMP_LOADK(st + 1);
        float mx = m; f32x4 sv[4];
#pragma unroll
        for (int sub = 0; sub < 4; ++sub) {
            f32x4 a4 = (f32x4){0.f, 0.f, 0.f, 0.f};
#pragma unroll
            for (int ks = 0; ks < 4; ++ks) a4 = mfma16(*(const bf16x8*)(Kt + (sub * 16 + qc) * RSK + (ks * 32 + g4 * 8) * 2), qf[ks], a4);
#pragma unroll
            for (int r = 0; r < 4; ++r) { const int key = st * 64 + sub * 16 + 4 * g4 + r; a4[r] = (key < nvis) ? a4[r] * cs : -3e38f; mx = fmaxf(mx, a4[r]); }
            sv[sub] = a4;
        }
        float ps = 0.f;
#pragma unroll
        for (int sub = 0; sub < 4; ++sub)
#pragma unroll
            for (int r = 0; r < 4; ++r) ps += __builtin_amdgcn_exp2f(sv[sub][r] - mx);
        lsum = lsum * __builtin_amdgcn_exp2f(m - mx) + ps; m = mx;
    }
    {
        float mt_ = fmaxf(m, __shfl_xor(m, 16)); mt_ = fmaxf(mt_, __shfl_xor(mt_, 32));
        lsum *= __builtin_amdgcn_exp2f(m - mt_); m = mt_;
        lsum += __shfl_xor(lsum, 16); lsum += __shfl_xor(lsum, 32);
    }
    const float inv = (nvis > 0 && lsum > 0.f) ? 1.0f / lsum : 0.f;
    f32x4 o[8];
#pragma unroll
    for (int mt = 0; mt < 8; ++mt) o[mt] = (f32x4){0.f, 0.f, 0.f, 0.f};
    float yprev = 0.f;
    float impv[32];
#pragma unroll
    for (int i = 0; i < 32; ++i) impv[i] = 0.f;
    if (nsteps > 0) { CMP_LOADK(0); CMP_LOADV(0); }
#pragma unroll
    for (int st = 0; st < 8; ++st) {
        if (st < nsteps) {
            char* Kt = smem + (gstep & 1) * BUFB; char* Vt = Kt + 64 * RSK; ++gstep;
            CMP_STOREK(Kt); CMP_STOREV(Vt);
            __syncthreads();
            if (st + 1 < nsteps) { CMP_LOADK(st + 1); CMP_LOADV(st + 1); }
            f32x4 sv[4];
#pragma unroll
            for (int sub = 0; sub < 4; ++sub) {
                f32x4 a4 = (f32x4){0.f, 0.f, 0.f, 0.f};
#pragma unroll
                for (int ks = 0; ks < 4; ++ks) a4 = mfma16(*(const bf16x8*)(Kt + (sub * 16 + qc) * RSK + (ks * 32 + g4 * 8) * 2), qf[ks], a4);
#pragma unroll
                for (int r = 0; r < 4; ++r) { const int key = st * 64 + sub * 16 + 4 * g4 + r; a4[r] = (key < nvis) ? __builtin_amdgcn_exp2f(a4[r] * cs - m) * inv : 0.f; }
                const float y = __shfl(a4[3], (l + 48) & 63);
                float iv = (a4[0] + a4[1]) + (a4[2] + a4[3]) + (g4 > 0 ? y : yprev);
                yprev = y;
                iv += __shfl_xor(iv, 1); iv += __shfl_xor(iv, 2);
                impv[st * 4 + sub] = iv;
                sv[sub] = a4;
            }
#pragma unroll
            for (int pr = 0; pr < 2; ++pr) {
                union { bf16x8 v; unsigned u32[4]; } bb;
                bb.u32[0] = pk2(sv[2 * pr][0], sv[2 * pr][1]); bb.u32[1] = pk2(sv[2 * pr][2], sv[2 * pr][3]);
                bb.u32[2] = pk2(sv[2 * pr + 1][0], sv[2 * pr + 1][1]); bb.u32[3] = pk2(sv[2 * pr + 1][2], sv[2 * pr + 1][3]);
#pragma unroll
                for (int mt = 0; mt < 8; ++mt) {
                    const char* vp = Vt + (mt * 16 + qc) * RSV + (pr * 32 + 4 * g4) * 2;
                    union { bf16x8 v; uint2 h2[2]; } aa;
                    aa.h2[0] = *(const uint2*)vp; aa.h2[1] = *(const uint2*)(vp + 32);
                    o[mt] = mfma16(aa.v, bb.v, o[mt]);
                }
            }
        }
    }
#undef CMP_LOADK
#undef CMP_LOADV
#undef CMP_STOREK
#undef CMP_STOREV
    __syncthreads();
    float* impl = (float*)smem + w * 512;
    if (hd == 0) {
#pragma unroll
        for (int i = 0; i < 32; ++i) impl[tk * 128 + 4 * i + g4] = impv[i];
    }
#pragma unroll
    for (int mt = 0; mt < 8; ++mt) {
        uint2 ov; ov.x = pk2(o[mt][0], o[mt][1]); ov.y = pk2(o[mt][2], o[mt][3]);
        *(uint2*)(p.OCMP() + ((size_t)t * 4 + hd) * 128 + mt * 16 + 4 * g4) = ov;
    }
    __syncthreads();
    const int li = hd + 4 * g4, cur = t >> 6;
    unsigned long long own[8]; int rank[8];
#pragma unroll
    for (int i = 0; i < 8; ++i) {
        const int j = li + 16 * i; const float v = impl[tk * 128 + j];
        const unsigned k32 = (j == 0 || j == cur || j == cur - 1) ? 0xFFFFFFFFu : (j > cur ? 0u : __float_as_uint(v) + 128u);
        own[i] = ((unsigned long long)k32 << 7) | (unsigned)(127 - j); rank[i] = 0;
    }
#pragma unroll 1
    for (int ip = 0; ip < 8; ++ip) {
#pragma unroll
        for (int q4 = 0; q4 < 4; ++q4) {
            const float4 ov = *(const float4*)(impl + tk * 128 + ip * 16 + q4 * 4);
            const float o4[4] = {ov.x, ov.y, ov.z, ov.w};
#pragma unroll
            for (int e = 0; e < 4; ++e) {
                const int jp = ip * 16 + q4 * 4 + e;
                const unsigned k32 = (jp == 0 || jp == cur || jp == cur - 1) ? 0xFFFFFFFFu : (jp > cur ? 0u : __float_as_uint(o4[e]) + 128u);
                const unsigned long long kp = ((unsigned long long)k32 << 7) | (unsigned)(127 - jp);
#pragma unroll
                for (int i = 0; i < 8; ++i) rank[i] += (kp > own[i]) ? 1 : 0;
            }
        }
    }
    unsigned mw[4] = {0u, 0u, 0u, 0u};
#pragma unroll
    for (int i = 0; i < 8; ++i) if (rank[i] < 16) mw[i >> 1] |= 1u << (li + 16 * (i & 1));
#pragma unroll
    for (int q = 0; q < 4; ++q) {
        unsigned v = mw[q];
        v |= __shfl_xor(v, 1); v |= __shfl_xor(v, 2); v |= __shfl_xor(v, 16); v |= __shfl_xor(v, 32);
        mw[q] = v;
    }
    if (li == 0) *(uint4*)(p.SEL() + (size_t)t * 4) = make_uint4(mw[0], mw[1], mw[2], mw[3]);
    __syncthreads();
}

DEV void st_nsa_attn(const P& p, int unit, char* smem) {
    constexpr int RSK = 272, RSV = 136, BUFB = 64 * RSK + 128 * RSV;
    const int tid = tidx(), w = tid >> 6, l = tid & 63, qc = l & 15, g4 = l >> 4;
    const int tq0 = unit * 16, t = tq0 + w * 4 + (qc >> 2), hd = qc & 3;
    bf16x8 qf[4];
#pragma unroll
    for (int ks = 0; ks < 4; ++ks) qf[ks] = *(const bf16x8*)(p.QR() + ((size_t)t * 4 + hd) * 128 + ks * 32 + g4 * 8);
    const uint4 selw = *(const uint4*)(p.SEL() + (size_t)t * 4);
    const float cs = 0.08838834764831845f * 1.4426950408889634f;
    unsigned part[8][2];
#pragma unroll
    for (int mt = 0; mt < 8; ++mt) { part[mt][0] = 0u; part[mt][1] = 0u; }
    const float g0 = p.GATES()[(size_t)t * 12 + hd * 3];
    int gstep = 0;
    const int krow = tid >> 4, kc16 = tid & 15, vrow = tid >> 3, vc16 = tid & 7;
#pragma unroll 1
    for (int br = 0; br < 2; ++br) {
        const bf16_t* Kg = br ? p.KW() : p.KS(); const bf16_t* Vg = br ? p.VWT() : p.VST();
        const int ktlast = (tq0 + 15) >> 6;
        const int ktfirst = br ? ((tq0 - 511 > 0 ? tq0 - 511 : 0) >> 6) : 0;
        const int nk = ktlast - ktfirst + 1;
        f32x4 o[8];
#pragma unroll
        for (int mt = 0; mt < 8; ++mt) o[mt] = (f32x4){0.f, 0.f, 0.f, 0.f};
        float m = -1e30f, lsum = 0.f;
        uint4 rk0, rk1, rk2, rk3, rv0, rv1, rv2, rv3;
#define NSA_LOAD(KT) do { const bf16_t* kb = Kg + (size_t)((KT) * 64 + krow) * 128 + kc16 * 8; const bf16_t* vb = Vg + (size_t)vrow * T + (KT) * 64 + vc16 * 8; \
        rk0 = *(const uint4*)kb; rk1 = *(const uint4*)(kb + 16 * 128); rk2 = *(const uint4*)(kb + 32 * 128); rk3 = *(const uint4*)(kb + 48 * 128); \
        rv0 = *(const uint4*)vb; rv1 = *(const uint4*)(vb + (size_t)32 * T); rv2 = *(const uint4*)(vb + (size_t)64 * T); rv3 = *(const uint4*)(vb + (size_t)96 * T); } while (0)
        NSA_LOAD(ktfirst);
#pragma unroll 1
        for (int i = 0; i < nk; ++i, ++gstep) {
            const int kt = ktfirst + i;
            char* Kt = smem + (gstep & 1) * BUFB; char* Vt = Kt + 64 * RSK;
            *(uint4*)(Kt + krow * RSK + kc16 * 16) = rk0; *(uint4*)(Kt + (krow + 16) * RSK + kc16 * 16) = rk1;
            *(uint4*)(Kt + (krow + 32) * RSK + kc16 * 16) = rk2; *(uint4*)(Kt + (krow + 48) * RSK + kc16 * 16) = rk3;
            *(uint4*)(Vt + vrow * RSV + vc16 * 16) = rv0; *(uint4*)(Vt + (vrow + 32) * RSV + vc16 * 16) = rv1;
            *(uint4*)(Vt + (vrow + 64) * RSV + vc16 * 16) = rv2; *(uint4*)(Vt + (vrow + 96) * RSV + vc16 * 16) = rv3;
            __syncthreads();
            if (i + 1 < nk) NSA_LOAD(kt + 1);
            int lo, hi = t;
            if (br == 0) {
                const unsigned wv = (kt & 64) ? ((kt & 32) ? selw.w : selw.z) : ((kt & 32) ? selw.y : selw.x);
                lo = 0; hi = ((wv >> (kt & 31)) & 1u) ? t : -1;
            } else lo = t - 511;
            const bool interior = (kt * 64 + 63 <= tq0) && (br == 0 || kt * 64 >= tq0 + 15 - 511);
            f32x4 sv[4];
            float mx = -3e38f;
            if (interior) {
                const float csl = hi >= 0 ? cs : 0.f, add = hi >= 0 ? 0.f : -3e38f;
#pragma unroll
                for (int sub = 0; sub < 4; ++sub) {
                    f32x4 a4 = (f32x4){0.f, 0.f, 0.f, 0.f};
#pragma unroll
                    for (int ks = 0; ks < 4; ++ks) a4 = mfma16(*(const bf16x8*)(Kt + (sub * 16 + qc) * RSK + (ks * 32 + g4 * 8) * 2), qf[ks], a4);
#pragma unroll
                    for (int r = 0; r < 4; ++r) { a4[r] = a4[r] * csl + add; mx = fmaxf(mx, a4[r]); }
                    sv[sub] = a4;
                }
            } else {
#pragma unroll
                for (int sub = 0; sub < 4; ++sub) {
                    f32x4 a4 = (f32x4){0.f, 0.f, 0.f, 0.f};
#pragma unroll
                    for (int ks = 0; ks < 4; ++ks) a4 = mfma16(*(const bf16x8*)(Kt + (sub * 16 + qc) * RSK + (ks * 32 + g4 * 8) * 2), qf[ks], a4);
#pragma unroll
                    for (int r = 0; r < 4; ++r) {
                        const int kp = kt * 64 + sub * 16 + 4 * g4 + r;
                        const bool valid = (kp >= lo) & (kp <= hi);
                        a4[r] = valid ? a4[r] * cs : -3e38f;
                        mx = fmaxf(mx, a4[r]);
                    }
                    sv[sub] = a4;
                }
            }
            mx = fmaxf(mx, __shfl_xor(mx, 16)); mx = fmaxf(mx, __shfl_xor(mx, 32));
            const float mnew = fmaxf(fmaxf(m, mx), -1e30f);
            const float alpha = __builtin_amdgcn_exp2f(m - mnew);
            m = mnew;
            float ps = 0.f;
#pragma unroll
            for (int sub = 0; sub < 4; ++sub)
#pragma unroll
                for (int r = 0; r < 4; ++r) { const float pv = __builtin_amdgcn_exp2f(sv[sub][r] - mnew); sv[sub][r] = pv; ps += pv; }
            lsum = lsum * alpha + ps;
            if (__any(alpha != 1.0f)) {
#pragma unroll
                for (int mt = 0; mt < 8; ++mt) o[mt] *= alpha;
            }
#pragma unroll
            for (int pr = 0; pr < 2; ++pr) {
                union { bf16x8 v; unsigned u32[4]; } bb;
                bb.u32[0] = pk2(sv[2 * pr][0], sv[2 * pr][1]); bb.u32[1] = pk2(sv[2 * pr][2], sv[2 * pr][3]);
                bb.u32[2] = pk2(sv[2 * pr + 1][0], sv[2 * pr + 1][1]); bb.u32[3] = pk2(sv[2 * pr + 1][2], sv[2 * pr + 1][3]);
#pragma unroll
                for (int mt = 0; mt < 8; ++mt) {
                    const char* vp = Vt + (mt * 16 + qc) * RSV + (pr * 32 + 4 * g4) * 2;
                    union { bf16x8 v; uint2 h2[2]; } aa;
                    aa.h2[0] = *(const uint2*)vp; aa.h2[1] = *(const uint2*)(vp + 32);
                    o[mt] = mfma16(aa.v, bb.v, o[mt]);
                }
            }
        }
#undef NSA_LOAD
        lsum += __shfl_xor(lsum, 16); lsum += __shfl_xor(lsum, 32);
        const float gate = p.GATES()[(size_t)t * 12 + hd * 3 + 1 + br];
        const float sc = lsum > 0.f ? gate / lsum : 0.f;
        if (br == 0) {
#pragma unroll
            for (int mt = 0; mt < 8; ++mt) {
                const uint2 oc = *(const uint2*)(p.OCMP() + ((size_t)t * 4 + hd) * 128 + mt * 16 + 4 * g4);
                part[mt][0] = pk2(sc * o[mt][0] + g0 * lo2f(oc.x), sc * o[mt][1] + g0 * hi2f(oc.x));
                part[mt][1] = pk2(sc * o[mt][2] + g0 * lo2f(oc.y), sc * o[mt][3] + g0 * hi2f(oc.y));
            }
        } else {
#pragma unroll
            for (int mt = 0; mt < 8; ++mt) {
                uint2 ov;
                ov.x = pk2(sc * o[mt][0] + lo2f(part[mt][0]), sc * o[mt][1] + hi2f(part[mt][0]));
                ov.y = pk2(sc * o[mt][2] + lo2f(part[mt][1]), sc * o[mt][3] + hi2f(part[mt][1]));
                *(uint2*)(p.Y() + (size_t)t * D + 1024 + hd * 128 + mt * 16 + 4 * g4) = ov;
            }
        }
    }
    __syncthreads();
}

DEV unsigned f2key(float f) { const unsigned u = __float_as_uint(f); return (u & 0x80000000u) ? ~u : (u | 0x80000000u); }
DEV float key2f(unsigned k) { const unsigned u = (k & 0x80000000u) ? (k & 0x7fffffffu) : ~k; return __uint_as_float(u); }
DEV float wave_prune(float* sc, unsigned short* ix, unsigned* hist, int m, int l) {
    float v[8]; unsigned k[8]; unsigned short id[8]; bool ok[8];
#pragma unroll
    for (int i = 0; i < 8; ++i) {
        const int e = l + 64 * i; ok[i] = e < m;
        v[i] = ok[i] ? sc[e] : 0.f; id[i] = ok[i] ? ix[e] : (unsigned short)0; k[i] = f2key(v[i]);
    }
    unsigned prefix = 0u; int need = 256;
#pragma unroll 1
    for (int pass = 0; pass < 4; ++pass) {
        const int shift = 24 - 8 * pass;
        *(uint4*)(hist + 4 * l) = make_uint4(0u, 0u, 0u, 0u);
        __builtin_amdgcn_wave_barrier();
#pragma unroll
        for (int i = 0; i < 8; ++i) {
            const bool in = ok[i] && (pass == 0 || (k[i] >> (shift + 8)) == prefix);
            if (in) atomicAdd(&hist[(k[i] >> shift) & 255u], 1u);
        }
        __builtin_amdgcn_wave_barrier();
        const uint4 hv = *(const uint4*)(hist + 4 * l);
        const unsigned hq[4] = {hv.x, hv.y, hv.z, hv.w};
        const unsigned own = hv.x + hv.y + hv.z + hv.w;
        unsigned tot = own;
#pragma unroll
        for (int o = 1; o < 64; o <<= 1) { const unsigned tv = __shfl_down(tot, o); if (l + o < 64) tot += tv; }
        unsigned cum = tot - own; int found = -1; int nneed = 0;
#pragma unroll
        for (int kk = 3; kk >= 0; --kk) {
            const unsigned c = hq[kk];
            if (found < 0 && (int)cum < need && (int)(cum + c) >= need) { found = 4 * l + kk; nneed = need - (int)cum; }
            cum += c;
        }
        const unsigned long long bal = __ballot(found >= 0);
        const int src = __ffsll((long long)bal) - 1;
        const int digit = __shfl(found, src); need = __shfl(nneed, src);
        prefix = (prefix << 8) | (unsigned)digit;
    }
    const unsigned thr = prefix;
    int base = 0, ties = 0;
    const unsigned long long ltmask = (1ull << l) - 1ull;
#pragma unroll
    for (int i = 0; i < 8; ++i) {
        const bool gt = ok[i] && k[i] > thr, eq = ok[i] && k[i] == thr;
        const unsigned long long em = __ballot(eq);
        const int trank = ties + __popcll(em & ltmask);
        const bool keep = gt || (eq && trank < need);
        ties += __popcll(em);
        const unsigned long long km = __ballot(keep);
        const int pos = base + __popcll(km & ltmask);
        if (keep) { sc[pos] = v[i]; ix[pos] = id[i]; }
        base += __popcll(km);
    }
    __builtin_amdgcn_wave_barrier();
    return key2f(thr);
}

#define DSA_APPEND2(COND, M64, SV, SCP, IXP, CL, CH) do { \
    const unsigned _ml = (unsigned)(M64), _mh = (unsigned)((M64) >> 32); \
    if (COND) { const int _pos = (h ? (CH) : (CL)) + __popc((h ? _mh : _ml) & ((1u << n) - 1u)); (SCP)[_pos] = (SV); (IXP)[_pos] = (unsigned short)kp; } \
    (CL) += __popc(_ml); (CH) += __popc(_mh); } while (0)
#define DSA_APPEND(SCP, IXP, CNT, M32, MINE, SV) do { \
    const unsigned _m = (M32); \
    if (MINE) { const int _pos = (CNT) + __popc(_m & ((1u << n) - 1u)); (SCP)[_pos] = (SV); (IXP)[_pos] = (unsigned short)kp; } \
    (CNT) += __popc(_m); } while (0)

DEV void st_dsa_index(const P& p, int unit, char* smem) {
    const int tid = tidx(), w = tid >> 6, l = tid & 63, n = l & 31, h = l >> 5;
    char* wb = smem + w * 14336;
    float* sc0 = (float*)wb; float* sc1 = sc0 + 512; float* sc2 = sc1 + 512; float* sc3 = sc2 + 512;
    unsigned short* ix0 = (unsigned short*)(wb + 8192); unsigned short* ix1 = ix0 + 512; unsigned short* ix2 = ix1 + 512; unsigned short* ix3 = ix2 + 512;
    unsigned* hist = (unsigned*)(wb + 12288);
    float* scA = h ? sc2 : sc0; float* scB = h ? sc3 : sc1; unsigned short* ixA = h ? ix2 : ix0; unsigned short* ixB = h ? ix3 : ix1;
    const int wu = unit * 4 + w;
    const int tg = (wu & 1) ? (2047 - (wu >> 1)) : (wu >> 1);
    const int t0 = tg * 4;
    const int tl = 2 * ((n >> 2) & 1) + (n >> 4), hdr = (n & 3) + 4 * ((n >> 3) & 1);
    bf16x8 af[4];
#pragma unroll
    for (int s = 0; s < 4; ++s) af[s] = *(const bf16x8*)(p.IQ() + ((size_t)(t0 + tl) * 8 + hdr) * 64 + 16 * s + 8 * h);
    const int tA = t0 + 2 * h, tB = tA + 1;
    float wA[8], wB[8];
#pragma unroll
    for (int r = 0; r < 8; ++r) { wA[r] = p.IW()[(size_t)tA * 8 + r]; wB[r] = p.IW()[(size_t)tB * 8 + r]; }
    int cnt0 = 0, cnt1 = 0, cnt2 = 0, cnt3 = 0;
    const float NINF = -__builtin_inff();
    float tau0 = NINF, tau1 = NINF, tau2 = NINF, tau3 = NINF;
    const int ntiles = (t0 + 3) / 32 + 1;
    const bf16_t* ikp = p.IK() + (size_t)n * 64 + 8 * h;
    bf16x8 na[4], nb[4];
#pragma unroll
    for (int s = 0; s < 4; ++s) { na[s] = *(const bf16x8*)(ikp + 16 * s); nb[s] = *(const bf16x8*)(ikp + (size_t)(ntiles > 1 ? 32 : 0) * 64 + 16 * s); }
#pragma unroll 1
    for (int kt = 0; kt < ntiles; kt += 2) {
        bf16x8 ca[4], cb[4];
#pragma unroll
        for (int s = 0; s < 4; ++s) { ca[s] = na[s]; cb[s] = nb[s]; }
        {
            const int ka = kt + 2 < ntiles ? kt + 2 : ntiles - 1, kb = kt + 3 < ntiles ? kt + 3 : ntiles - 1;
#pragma unroll
            for (int s = 0; s < 4; ++s) { na[s] = *(const bf16x8*)(ikp + (size_t)ka * 32 * 64 + 16 * s); nb[s] = *(const bf16x8*)(ikp + (size_t)kb * 32 * 64 + 16 * s); }
        }
        f32x16 acca, accb;
#pragma unroll
        for (int r = 0; r < 16; ++r) { acca[r] = 0.f; accb[r] = 0.f; }
#pragma unroll
        for (int s = 0; s < 4; ++s) { acca = mfma32(af[s], ca[s], acca); accb = mfma32(af[s], cb[s], accb); }
        float s0a = 0.f, s1a = 0.f, s0b = 0.f, s1b = 0.f, u0a = 0.f, u1a = 0.f, u0b = 0.f, u1b = 0.f;
#pragma unroll
        for (int r = 0; r < 4; ++r) {
            s0a += wA[r] * fmaxf(acca[r], 0.f); u0a += wA[4 + r] * fmaxf(acca[4 + r], 0.f);
            s1a += wB[r] * fmaxf(acca[8 + r], 0.f); u1a += wB[4 + r] * fmaxf(acca[12 + r], 0.f);
            s0b += wA[r] * fmaxf(accb[r], 0.f); u0b += wA[4 + r] * fmaxf(accb[4 + r], 0.f);
            s1b += wB[r] * fmaxf(accb[8 + r], 0.f); u1b += wB[4 + r] * fmaxf(accb[12 + r], 0.f);
        }
        s0a += u0a; s1a += u1a; s0b += u0b; s1b += u1b;
        const float tauA = h ? tau2 : tau0, tauB = h ? tau3 : tau1;
        {
            const int kp = kt * 32 + n;
            const bool cA = (kp <= tA) && (s0a > tauA), cB = (kp <= tB) && (s1a > tauB);
            const unsigned long long mA = __ballot(cA), mB = __ballot(cB);
            DSA_APPEND2(cA, mA, s0a, scA, ixA, cnt0, cnt2); DSA_APPEND2(cB, mB, s1a, scB, ixB, cnt1, cnt3);
        }
        {
            const int kp = kt * 32 + 32 + n;
            const bool cA = (kp <= tA) && (s0b > tauA), cB = (kp <= tB) && (s1b > tauB);
            const unsigned long long mA = __ballot(cA), mB = __ballot(cB);
            DSA_APPEND2(cA, mA, s0b, scA, ixA, cnt0, cnt2); DSA_APPEND2(cB, mB, s1b, scB, ixB, cnt1, cnt3);
        }
        __builtin_amdgcn_wave_barrier();
        if (max(max(cnt0, cnt1), max(cnt2, cnt3)) > 448) {
            if (cnt0 > 448) { tau0 = wave_prune(sc0, ix0, hist, cnt0, l); cnt0 = 256; }
            if (cnt1 > 448) { tau1 = wave_prune(sc1, ix1, hist, cnt1, l); cnt1 = 256; }
            if (cnt2 > 448) { tau2 = wave_prune(sc2, ix2, hist, cnt2, l); cnt2 = 256; }
            if (cnt3 > 448) { tau3 = wave_prune(sc3, ix3, hist, cnt3, l); cnt3 = 256; }
        }
    }
    if (cnt0 > 256) { wave_prune(sc0, ix0, hist, cnt0, l); cnt0 = 256; }
    if (cnt1 > 256) { wave_prune(sc1, ix1, hist, cnt1, l); cnt1 = 256; }
    if (cnt2 > 256) { wave_prune(sc2, ix2, hist, cnt2, l); cnt2 = 256; }
    if (cnt3 > 256) { wave_prune(sc3, ix3, hist, cnt3, l); cnt3 = 256; }
    __builtin_amdgcn_wave_barrier();
#pragma unroll
    for (int i = 0; i < 4; ++i) {
        const int e = l + 64 * i;
        p.IDX()[(size_t)(t0 + 0) * 256 + e] = e < cnt0 ? (int)ix0[e] : 0;
        p.IDX()[(size_t)(t0 + 1) * 256 + e] = e < cnt1 ? (int)ix1[e] : 0;
        p.IDX()[(size_t)(t0 + 2) * 256 + e] = e < cnt2 ? (int)ix2[e] : 0;
        p.IDX()[(size_t)(t0 + 3) * 256 + e] = e < cnt3 ? (int)ix3[e] : 0;
    }
    if (l == 0) { p.CNT()[t0] = cnt0; p.CNT()[t0 + 1] = cnt1; p.CNT()[t0 + 2] = cnt2; p.CNT()[t0 + 3] = cnt3; }
}

DEV void st_dsa_attn(const P& p, int unit, char* smem) {
    const int tid = tidx(), w = tid >> 6, l = tid & 63, c = l & 15, g4 = l >> 4;
    int* idxs = (int*)(smem + w * 5120); float* Pl = (float*)(smem + w * 5120 + 1024);
    const size_t t = (size_t)unit * 4 + w;
    const int cnt = p.CNT()[t];
#pragma unroll
    for (int i = 0; i < 4; ++i) idxs[l + 64 * i] = p.IDX()[t * 256 + l + 64 * i];
    __builtin_amdgcn_wave_barrier();
    bf16x8 qf[4];
#pragma unroll
    for (int j = 0; j < 4; ++j) qf[j] = *(const bf16x8*)(p.DQ() + (t * 4 + (c & 3)) * 128 + g4 * 32 + j * 8);
    f32x4 s[16];
    const int ntile = (cnt + 15) >> 4;
#pragma unroll
    for (int tq = 0; tq < 4; ++tq) {
        bf16x8 kf[4][4];
        if (tq * 4 < ntile) {
#pragma unroll
            for (int q = 0; q < 4; ++q) {
                const int krow = idxs[(tq * 4 + q) * 16 + c];
                const bf16_t* kp = p.DK() + (size_t)krow * 128 + g4 * 32;
#pragma unroll
                for (int j = 0; j < 4; ++j) kf[q][j] = *(const bf16x8*)(kp + j * 8);
            }
        }
#pragma unroll
        for (int q = 0; q < 4; ++q) {
            s[tq * 4 + q] = (f32x4){0.f, 0.f, 0.f, 0.f};
            if (tq * 4 < ntile) {
#pragma unroll
                for (int j = 0; j < 4; ++j) s[tq * 4 + q] = mfma16(kf[q][j], qf[j], s[tq * 4 + q]);
            }
        }
        __builtin_amdgcn_sched_barrier(0);
    }
    const float cs = 0.08838834764831845f * 1.4426950408889634f;
    float mx = -1e30f;
#pragma unroll
    for (int tt = 0; tt < 16; ++tt)
#pragma unroll
        for (int r = 0; r < 4; ++r) { const int slot = tt * 16 + 4 * g4 + r; if (slot < cnt) mx = fmaxf(mx, s[tt][r] * cs); }
    mx = fmaxf(mx, __shfl_xor(mx, 16)); mx = fmaxf(mx, __shfl_xor(mx, 32));
    float sum = 0.f;
#pragma unroll
    for (int tt = 0; tt < 16; ++tt)
#pragma unroll
        for (int r = 0; r < 4; ++r) { const int slot = tt * 16 + 4 * g4 + r; const float pv = slot < cnt ? exp2f(s[tt][r] * cs - mx) : 0.f; s[tt][r] = pv; sum += pv; }
    sum += __shfl_xor(sum, 16); sum += __shfl_xor(sum, 32);
    const float inv = sum > 0.f ? 1.0f / sum : 0.f;
    if (c < 4) {
#pragma unroll
        for (int tt = 0; tt < 16; ++tt)
#pragma unroll
            for (int r = 0; r < 4; ++r) Pl[(tt * 16 + 4 * g4 + r) * 4 + c] = s[tt][r] * inv;
    }
    __builtin_amdgcn_wave_barrier();
    float acc[4][8];
#pragma unroll
    for (int hh = 0; hh < 4; ++hh)
#pragma unroll
        for (int j = 0; j < 8; ++j) acc[hh][j] = 0.f;
    const int nk32 = (cnt + 31) >> 5;
#pragma unroll 1
    for (int kb = 0; kb < nk32; ++kb) {
        uint4 raw[8]; float4 p4[8];
#pragma unroll
        for (int q = 0; q < 8; ++q) {
            const int slot = (kb * 8 + q) * 4 + g4;
            const int row = idxs[slot];
            raw[q] = *(const uint4*)(p.PROJ() + (size_t)row * LDP + C_DV + c * 8);
            p4[q] = *(const float4*)(Pl + slot * 4);
        }
#pragma unroll
        for (int q = 0; q < 8; ++q) {
            const float vv[8] = {lo2f(raw[q].x), hi2f(raw[q].x), lo2f(raw[q].y), hi2f(raw[q].y), lo2f(raw[q].z), hi2f(raw[q].z), lo2f(raw[q].w), hi2f(raw[q].w)};
            const float pp[4] = {p4[q].x, p4[q].y, p4[q].z, p4[q].w};
#pragma unroll
            for (int hh = 0; hh < 4; ++hh)
#pragma unroll
                for (int j = 0; j < 8; ++j) acc[hh][j] += pp[hh] * vv[j];
        }
    }
#pragma unroll
    for (int hh = 0; hh < 4; ++hh)
#pragma unroll
        for (int j = 0; j < 8; ++j) { float a = acc[hh][j]; a += __shfl_xor(a, 16); a += __shfl_xor(a, 32); acc[hh][j] = a; }
    if (g4 == 0) {
#pragma unroll
        for (int hh = 0; hh < 4; ++hh) {
            uint4 o; o.x = pk2(acc[hh][0], acc[hh][1]); o.y = pk2(acc[hh][2], acc[hh][3]); o.z = pk2(acc[hh][4], acc[hh][5]); o.w = pk2(acc[hh][6], acc[hh][7]);
            *(uint4*)(p.Y() + t * D + 1536 + hh * 128 + c * 8) = o;
        }
    }
    __builtin_amdgcn_wave_barrier();
}

DEV void ins16(unsigned (&top)[16], unsigned x) {
#pragma unroll
    for (int j = 0; j < 16; ++j) { const unsigned hi = max(top[j], x); x = min(top[j], x); top[j] = hi; }
}
DEV void st_peer_topk(const P& p, int layer, int unit, char* smem) {
    const int tid = tidx(), w = tid >> 6, l = tid & 63, n = l & 31, hf = l >> 5;
    const int tg = unit >> 1, head = (unit & 1) * 4 + w;
    const size_t t = (size_t)tg * 32 + n;
    unsigned* il = (unsigned*)smem + w * 1024;
    unsigned top[2][16];
#pragma unroll
    for (int pp = 0; pp < 2; ++pp) {
        float qv[32];
#pragma unroll
        for (int i = 0; i < 8; ++i) { const float4 v = *(const float4*)(p.PQ() + t * 1024 + head * 128 + pp * 64 + hf * 32 + i * 4); qv[4 * i] = v.x; qv[4 * i + 1] = v.y; qv[4 * i + 2] = v.z; qv[4 * i + 3] = v.w; }
        const float* K = p.peer_sk + ((((size_t)layer * 8 + head) * 2 + pp) * 128) * 64;
#pragma unroll
        for (int j = 0; j < 16; ++j) top[pp][j] = 0u;
#pragma unroll 1
        for (int tile = 0; tile < 4; ++tile) {
            float kv[32];
            const float* kr = K + (size_t)(tile * 32 + n) * 64 + hf * 32;
#pragma unroll
            for (int i = 0; i < 8; ++i) { const float4 v = *(const float4*)(kr + i * 4); kv[4 * i] = v.x; kv[4 * i + 1] = v.y; kv[4 * i + 2] = v.z; kv[4 * i + 3] = v.w; }
            f32x16 acc;
#pragma unroll
            for (int r = 0; r < 16; ++r) acc[r] = 0.f;
#pragma unroll
            for (int kk = 0; kk < 32; ++kk) acc = __builtin_amdgcn_mfma_f32_32x32x2f32(kv[kk], qv[kk], acc, 0, 0, 0);
#pragma unroll
            for (int r = 0; r < 16; ++r) {
                const int nn = tile * 32 + (r & 3) + 8 * (r >> 2) + 4 * hf;
                ins16(top[pp], (f2key(acc[r]) & ~127u) | (unsigned)(127 - nn));
            }
        }
        unsigned oth[16];
#pragma unroll
        for (int j = 0; j < 16; ++j) oth[j] = __shfl_xor(top[pp][j], 32);
#pragma unroll
        for (int j = 0; j < 16; ++j) ins16(top[pp], oth[j]);
        if (hf == 0) {
#pragma unroll
            for (int j = 0; j < 16; ++j) il[(pp * 16 + j) * 32 + n] = 127u - (top[pp][j] & 127u);
        }
    }
    __builtin_amdgcn_wave_barrier();
    if (hf == 0) {
        float v1[16], v2[16];
#pragma unroll
        for (int j = 0; j < 16; ++j) { v1[j] = key2f(top[0][j] & ~127u); v2[j] = key2f(top[1][j] & ~127u); }
        unsigned ct[16];
#pragma unroll
        for (int s = 0; s < 16; ++s) ct[s] = 0u;
#pragma unroll
        for (int i = 0; i < 16; ++i)
#pragma unroll
            for (int j = 0; j < 16; ++j)
                if ((i + 1) * (j + 1) <= 16) ins16(ct, (f2key(v1[i] + v2[j]) & ~255u) | (unsigned)(255 - (i * 16 + j)));
        float ex[16], sum = 0.f; int ce[16];
        const float c0 = key2f(ct[0] & ~255u);
#pragma unroll
        for (int s = 0; s < 16; ++s) {
            const unsigned code = 255u - (ct[s] & 255u);
            ce[s] = (int)(il[(code >> 4) * 32 + n] * 128u + il[(16 + (code & 15u)) * 32 + n]);
            ex[s] = __expf(key2f(ct[s] & ~255u) - c0); sum += ex[s];
        }
        const float inv = 1.0f / sum;
#pragma unroll
        for (int s4 = 0; s4 < 4; ++s4) {
            *(int4*)(p.PE() + t * 128 + head * 16 + s4 * 4) = make_int4(ce[4 * s4], ce[4 * s4 + 1], ce[4 * s4 + 2], ce[4 * s4 + 3]);
            *(float4*)(p.PG() + t * 128 + head * 16 + s4 * 4) = make_float4(ex[4 * s4] * inv, ex[4 * s4 + 1] * inv, ex[4 * s4 + 2] * inv, ex[4 * s4 + 3] * inv);
        }
    }
    __builtin_amdgcn_wave_barrier();
}

DEV void st_peer_gather(const P& p, int layer, const float* __restrict__ xin, float* __restrict__ xout, int unit, char* smem) {
    const int tid_ = tidx(); const int w = tid_ >> 6, l = tid_ & 63; const size_t t = (size_t)unit * 4 + w;
    float* row = (float*)smem + w * 2112;
    const int* pip = p.PI();
    const float ic6 = __int_as_float(__builtin_amdgcn_readfirstlane(pip[32]));
    {
#pragma unroll
        for (int i = 0; i < 4; ++i) {
            const uint4 hv = *(const uint4*)(p.HN() + t * D + i * 512 + l * 8);
            const unsigned u4[4] = {hv.x, hv.y, hv.z, hv.w};
            const int c = i * 512 + l * 8;
#pragma unroll
            for (int q = 0; q < 4; ++q) { row[((c + 2 * q) >> 5) * 33 + ((c + 2 * q) & 31)] = lo2f(u4[q]); row[((c + 2 * q + 1) >> 5) * 33 + ((c + 2 * q + 1) & 31)] = hi2f(u4[q]); }
        }
        __builtin_amdgcn_wave_barrier();
    }
    float hf[32];
#pragma unroll
    for (int j = 0; j < 32; ++j) hf[j] = row[l * 33 + __builtin_amdgcn_readfirstlane(pip[j])];
    __builtin_amdgcn_wave_barrier();
    const int e0 = p.PE()[t * 128 + l], e1 = p.PE()[t * 128 + 64 + l];
    const float g0 = p.PG()[t * 128 + l], g1 = p.PG()[t * 128 + 64 + l];
    float out[32];
#pragma unroll
    for (int i = 0; i < 32; ++i) out[i] = 0.f;
    const unsigned char* U = p.Utab() + (size_t)layer * 16384 * ROW6 + l * 8; const unsigned char* V = p.Vtab() + (size_t)layer * 16384 * ROW6 + l * 8;
    const bool b5 = (l & 32) != 0, b4 = (l & 16) != 0;
#pragma unroll 1
    for (int k4 = 0; k4 < 32; ++k4) {
        int e[4]; float g[4];
#pragma unroll
        for (int q = 0; q < 4; ++q) {
            const int k = k4 * 4 + q;
            e[q] = __builtin_amdgcn_readlane(k4 < 16 ? e0 : e1, k & 63);
            g[q] = __int_as_float(__builtin_amdgcn_readlane(__float_as_int(k4 < 16 ? g0 : g1), k & 63));
        }
        uint2 uu[4][3], vv[4][3];
#pragma unroll
        for (int q = 0; q < 4; ++q)
#pragma unroll
            for (int i = 0; i < 3; ++i) { uu[q][i] = *(const uint2*)(U + (size_t)e[q] * ROW6 + i * 512); vv[q][i] = *(const uint2*)(V + (size_t)e[q] * ROW6 + i * 512); }
        float d[4];
#pragma unroll
        for (int q = 0; q < 4; ++q) {
            v6u pk; pk[0] = uu[q][0].x; pk[1] = uu[q][0].y; pk[2] = uu[q][1].x; pk[3] = uu[q][1].y; pk[4] = uu[q][2].x; pk[5] = uu[q][2].y;
            const v32f f = FP6_UNPACK(pk);
            float acc = 0.f;
#pragma unroll
            for (int j = 0; j < 32; ++j) acc += f[j] * hf[j];
            d[q] = acc;
        }
        float kA = b5 ? d[2] : d[0], kB = b5 ? d[3] : d[1];
        const float sA = b5 ? d[0] : d[2], sB = b5 ? d[1] : d[3];
        kA += __shfl_xor(sA, 32); kB += __shfl_xor(sB, 32);
        float kk = b4 ? kB : kA; const float ss = b4 ? kA : kB;
        kk += __shfl_xor(ss, 16);
        kk += __shfl_xor(kk, 8); kk += __shfl_xor(kk, 4); kk += __shfl_xor(kk, 2); kk += __shfl_xor(kk, 1);
        const float gsel = b5 ? (b4 ? g[3] : g[2]) : (b4 ? g[1] : g[0]);
        const float av = gelu_tanh(kk * (ic6 / U6_SCALE)) * gsel * (ic6 / V6_SCALE);
        const int avi = __float_as_int(av);
        const float a4[4] = {__int_as_float(__builtin_amdgcn_readlane(avi, 0)), __int_as_float(__builtin_amdgcn_readlane(avi, 16)),
                             __int_as_float(__builtin_amdgcn_readlane(avi, 32)), __int_as_float(__builtin_amdgcn_readlane(avi, 48))};
#pragma unroll
        for (int q = 0; q < 4; ++q) {
            v6u pk; pk[0] = vv[q][0].x; pk[1] = vv[q][0].y; pk[2] = vv[q][1].x; pk[3] = vv[q][1].y; pk[4] = vv[q][2].x; pk[5] = vv[q][2].y;
            const v32f f = FP6_UNPACK(pk);
#pragma unroll
            for (int j = 0; j < 32; ++j) out[j] += a4[q] * f[j];
        }
    }
    asm volatile("" : "+s"(pip));
#pragma unroll
    for (int j = 0; j < 32; ++j) row[l * 33 + __builtin_amdgcn_readfirstlane(pip[j])] = out[j];
    __builtin_amdgcn_wave_barrier();
    const float* g2 = p.ada() + layer * 12288 + 5 * 2048;
    float4 xo[8]; float ssq = 0.f;
#pragma unroll
    for (int i = 0; i < 8; ++i) {
        const int c = i * 256 + l * 4;
        const float* rp = row + (c >> 5) * 33 + (c & 31);
        const size_t off = t * D + c;
        const float4 x0 = *(const float4*)(xin + off); const float4 ga = *(const float4*)(g2 + c);
        float4 o0;
        o0.x = x0.x + ga.x * rp[0]; o0.y = x0.y + ga.y * rp[1]; o0.z = x0.z + ga.z * rp[2]; o0.w = x0.w + ga.w * rp[3];
        *(float4*)(xout + off) = o0;
        xo[i] = o0; ssq += o0.x * o0.x + o0.y * o0.y + o0.z * o0.z + o0.w * o0.w;
    }
    if (layer + 1 < NL) {
        const float rs = rsqrtf(wsum(ssq) * (1.0f / 2048.0f) + EPS);
        const float* ng = p.n1g + (layer + 1) * 2048; const float* adn = p.ada() + (layer + 1) * 12288;
#pragma unroll
        for (int i = 0; i < 8; ++i) {
            const int c = i * 256 + l * 4;
            const float4 gg = *(const float4*)(ng + c), sc = *(const float4*)(adn + 2048 + c), sh = *(const float4*)(adn + c);
            uint2 o;
            o.x = pk2((xo[i].x * rs) * gg.x * (1.0f + sc.x) + sh.x, (xo[i].y * rs) * gg.y * (1.0f + sc.y) + sh.y);
            o.y = pk2((xo[i].z * rs) * gg.z * (1.0f + sc.z) + sh.z, (xo[i].w * rs) * gg.w * (1.0f + sc.w) + sh.w);
            *(uint2*)(p.HN() + t * D + c) = o;
        }
    }
    __builtin_amdgcn_wave_barrier();
}

enum { S_CONVT_IN = 0, S_CONVT_OUT, S_CONVT_Q, S_CONVT_W1, S_CALIB, S_TAB_U, S_TAB_V, S_ADA, S_ROPE, S_NORM1, S_GEMM_IN, S_CONV, S_SGU, S_VTRANS, S_PREP,
       S_COMPRESS, S_NSA_CMP, S_DSA_INDEX, S_NSA_ATTN, S_DSA_ATTN, S_GEMM_OUT, S_NORM2, S_GEMM_Q, S_PEER_TOPK, S_PEER_GATHER, S_COUNT };
constexpr int TAB_UNITS = 4096;
__host__ __device__ constexpr int nunits(int s) {
    return s == S_CONVT_IN ? 2 * 32 * (LDP / 64) : s == S_CONVT_OUT ? 2 * 32 * 32 : s == S_CONVT_Q ? 2 * 32 * 16 : s == S_CONVT_W1 ? 4 * 64 * 2 : s == S_CALIB ? 1 : s == S_TAB_U ? TAB_UNITS : s == S_TAB_V ? TAB_UNITS
         : s == S_ADA ? 384 : s == S_ROPE ? 768 : s == S_NORM1 ? 2048 : s == S_GEMM_IN ? 64 * (LDP / 128) : s == S_CONV ? 512 : s == S_SGU ? 256
         : s == S_VTRANS ? 256 : s == S_PREP ? 2048 : s == S_COMPRESS ? 64 : s == S_NSA_CMP ? 512 : s == S_DSA_INDEX ? 512 : s == S_NSA_ATTN ? 512 : s == S_DSA_ATTN ? 2048
         : s == S_GEMM_OUT ? 64 * 16 : s == S_NORM2 ? 2048 : s == S_GEMM_Q ? 64 * 8 : s == S_PEER_TOPK ? 512 : s == S_PEER_GATHER ? 2048 : 0;
}
template <int S>
DEV void run_unit(const P& p, int layer, int u, char* smem, int nu = TAB_UNITS) {
    const float* xin = layer == 0 ? p.x : p.X2();
    const float* ada = p.ada() + layer * 12288;
    if constexpr (S == S_CONVT_IN) { const int per = 32 * (LDP / 64), ly = u / per; st_convT(p.w_in + (size_t)ly * 2048 * INC, p.WinT() + (size_t)ly * LDP * 2048, INC, LDP, true, u % per, smem); }
    else if constexpr (S == S_CONVT_OUT) { const int per = 32 * 32, ly = u / per; st_convT(p.w_out + (size_t)ly * 2048 * 2048, p.WoutT() + (size_t)ly * 2048 * 2048, 2048, 2048, false, u % per, smem); }
    else if constexpr (S == S_CONVT_Q) { const int per = 32 * 16, ly = u / per; st_convT(p.peer_wq + (size_t)ly * 2048 * 1024, p.WqT() + (size_t)ly * 1024 * 2048, 1024, 1024, false, u % per, smem); }
    else if constexpr (S == S_CONVT_W1) { const int per = 64 * 2, mi = u / per; st_convT(p.cmp_w1 + (size_t)mi * 4096 * 128, p.W1T() + (size_t)mi * 128 * 4096, 128, 128, false, u % per, smem, 4096); }
    else if constexpr (S == S_CALIB) st_calib(p);
    else if constexpr (S == S_TAB_U) st_tab6(p.peer_u, p.Utab(), U6_SCALE, 2 * 16384, u, nu, smem);
    else if constexpr (S == S_TAB_V) st_tab6(p.peer_v, p.Vtab(), V6_SCALE, 2 * 16384, u, nu, smem);
    else if constexpr (S == S_ADA) st_ada(p, u, smem);
    else if constexpr (S == S_ROPE) st_rope(p, u);
    else if constexpr (S == S_NORM1) st_norm(xin, p.n1g + layer * 2048, ada + 2048, ada, p.HN(), u);
    else if constexpr (S == S_GEMM_IN) { EpiArgs e{p.PROJ(), nullptr, nullptr, nullptr}; st_gemm<EPI_PROJ>(p.HN(), p.WinT() + (size_t)layer * LDP * 2048, 2048, u & 63, u >> 6, e, smem); }
    else if constexpr (S == S_CONV) st_conv(p, layer, u, smem);
    else if constexpr (S == S_SGU) st_sgu(p, layer, u, smem);
    else if constexpr (S == S_VTRANS) st_vtrans(p, u, smem);
    else if constexpr (S == S_PREP) st_prep(p, layer, u);
    else if constexpr (S == S_COMPRESS) st_compress(p, layer, u, smem);
    else if constexpr (S == S_NSA_CMP) st_nsa_cmp(p, u, smem);
    else if constexpr (S == S_DSA_INDEX) st_dsa_index(p, u, smem);
    else if constexpr (S == S_NSA_ATTN) st_nsa_attn(p, u, smem);
    else if constexpr (S == S_DSA_ATTN) st_dsa_attn(p, u, smem);
    else if constexpr (S == S_GEMM_OUT) { EpiArgs e{nullptr, p.X1(), xin, ada + 2 * 2048}; st_gemm<EPI_OUT>(p.Y(), p.WoutT() + (size_t)layer * 2048 * 2048, 2048, u & 63, u >> 6, e, smem); }
    else if constexpr (S == S_NORM2) st_norm(p.X1(), p.n2g + layer * 2048, ada + 4 * 2048, ada + 3 * 2048, p.HN(), u);
    else if constexpr (S == S_GEMM_Q) { EpiArgs e{nullptr, p.PQ(), nullptr, nullptr}; st_gemm<EPI_Q>(p.HN(), p.WqT() + (size_t)layer * 1024 * 2048, 2048, u & 63, u >> 6, e, smem); }
    else if constexpr (S == S_PEER_TOPK) st_peer_topk(p, layer, u, smem);
    else if constexpr (S == S_PEER_GATHER) st_peer_gather(p, layer, p.X1(), layer == 0 ? p.X2() : p.out, u, smem);
}


#define XB_TMO      128
#define XB_XCNT(j)  (256  + 64 * (j))
#define XB_XSUB(j)  (1280 + 64 * (j))
#define XB_XGEN(j)  (2304 + 64 * (j))
#define XB_TOP      3328
#define XB_TOPGEN   3392
#define XB_SPIN_CAP (1u << 22)
#define LAS __attribute__((address_space(3)))
DEV unsigned xb_ld(unsigned* p) { return __hip_atomic_load(p, __ATOMIC_RELAXED, __HIP_MEMORY_SCOPE_AGENT); }
DEV unsigned xb_add(unsigned* p, unsigned v) { return __hip_atomic_fetch_add(p, v, __ATOMIC_RELAXED, __HIP_MEMORY_SCOPE_AGENT); }
DEV unsigned xb_xcc_id() { return (unsigned)__builtin_amdgcn_s_getreg((3 << 11) | 20) & 0xFu; }
#define XB_SPIN(cond, bar) do { unsigned _sp = 0; while (cond) { __builtin_amdgcn_s_sleep(1); \
    if ((++_sp & 255u) == 0u) { if (xb_ld(&(bar)[XB_TMO])) break; if (_sp > XB_SPIN_CAP) { atomicAdd(&(bar)[XB_TMO], 1u); break; } } } } while (0)
struct XcdBarrier { unsigned* bar; unsigned x; volatile LAS unsigned* st; };
DEV XcdBarrier xcd_barrier_post(unsigned* bar, volatile LAS unsigned* st) {
    XcdBarrier b; b.bar = bar; b.x = xb_xcc_id(); b.st = st;
    if (threadIdx.x == 0) (void)xb_add(&bar[XB_XCNT(b.x)], 1u);
    return b;
}
DEV void xcd_barrier_complete(unsigned* bar, unsigned x, unsigned& nloc, unsigned& nx) {
    const unsigned G = gridDim.x * gridDim.y * gridDim.z;
    unsigned sum, cnt, mine, sp = 0u;
    for (;;) {
        sum = 0u; cnt = 0u; mine = 0u;
#pragma unroll
        for (unsigned j = 0; j < 16; ++j) { const unsigned c = xb_ld(&bar[XB_XCNT(j)]); sum += c; cnt += (c > 0u) ? 1u : 0u; mine = (j == x) ? c : mine; }
        if (sum == G) break;
        __builtin_amdgcn_s_sleep(1);
        if ((++sp & 255u) == 0u) { if (xb_ld(&bar[XB_TMO])) break; if (sp > XB_SPIN_CAP) { atomicAdd(&bar[XB_TMO], 1u); break; } }
    }
    nloc = mine > 0u ? mine : 1u; nx = cnt > 0u ? cnt : 1u;
}
DEV void xcd_barrier(const XcdBarrier& b) {
    asm volatile("s_waitcnt vmcnt(0)" ::: "memory");
    __syncthreads();
    if (threadIdx.x == 0) {
        unsigned* bar = b.bar;
        __builtin_amdgcn_s_waitcnt(0);
        unsigned nloc = b.st[0], nx = b.st[1];
        if (nloc == 0u) { xcd_barrier_complete(bar, b.x, nloc, nx); b.st[0] = nloc; b.st[1] = nx; }
        const unsigned old = xb_add(&bar[XB_XSUB(b.x)], 1u);
        const unsigned gen = old / nloc;
        if (old + 1u == (gen + 1u) * nloc) {
            __builtin_amdgcn_fence(__ATOMIC_RELEASE, "agent");
            asm volatile("s_waitcnt vmcnt(0)" ::: "memory");
            const unsigned og = xb_add(&bar[XB_TOP], 1u);
            const unsigned tg = og / nx;
            if (og + 1u == (tg + 1u) * nx) xb_add(&bar[XB_TOPGEN], 1u);
            else XB_SPIN(xb_ld(&bar[XB_TOPGEN]) == tg, bar);
            __builtin_amdgcn_fence(__ATOMIC_ACQUIRE, "agent");
            xb_add(&bar[XB_XGEN(b.x)], 1u);
            asm volatile("s_waitcnt vmcnt(0)" ::: "memory");
        } else {
            XB_SPIN(xb_ld(&bar[XB_XGEN(b.x)]) == gen, bar);
            __builtin_amdgcn_fence(__ATOMIC_ACQUIRE, "agent");
            asm volatile("s_waitcnt vmcnt(0)" ::: "memory");
        }
    }
    __syncthreads();
}

#ifndef MULTI_LAUNCH
constexpr int REP_STAGE = -1, REP_STAGE2 = -1, REP_N = 1;
template <int S>
DEV void run_phase1(const P& p, int layer, char* smem, int off);
template <int S>
DEV void run_phase(const P& p, int layer, char* smem, int off = 0) {
    constexpr int reps = (S == REP_STAGE || S == REP_STAGE2) ? REP_N : 1;
#pragma unroll 1
    for (int r = 0; r < reps; ++r) run_phase1<S>(p, layer, smem, off);
}
template <int S>
DEV void run_phase1(const P& p, int layer, char* smem, int off) {
    const int G = gridDim.x;
    int b = blockIdx.x + off; if (b >= G) b -= G;
    if constexpr (S == S_TAB_U || S == S_TAB_V) { run_unit<S>(p, layer, b, smem, G); }
    else {
        for (int u = b; u < nunits(S); u += G) { run_unit<S>(p, layer, u, smem); __syncthreads(); }
    }
}
template <int S>
DEV void run_gemm_phase1(const P& p, int layer, char* smem, unsigned xcc, volatile LAS unsigned* slot, int rep) {
    constexpr int TN = (S == S_GEMM_IN) ? (LDP / 128) : (S == S_GEMM_OUT ? 16 : 8);
    constexpr int inst0 = (S == S_GEMM_IN) ? 0 : (S == S_GEMM_OUT ? 2 : 4);
    const int len = 8 * TN;
#pragma unroll 1
    for (int q = 0; q < 8; ++q) {
        const unsigned xq = (xcc + q) & 7u;
        unsigned* head = p.bar() + GQ_WORD(inst0 + layer + 6 * rep, xq);
        for (;;) {
            if (threadIdx.x == 0) *slot = xb_add(head, 1u);
            __syncthreads();
            const int i = (int)*slot;
            __syncthreads();
            if (i >= len) break;
            const int tn = i >> 3, tm = (int)xq * 8 + (i & 7);
            run_unit<S>(p, layer, tm + 64 * tn, smem);
            __syncthreads();
        }
    }
}
template <int S>
DEV void run_items(const P& p, int layer, char* smem, int first, int count) {
    constexpr int reps = (S == REP_STAGE || S == REP_STAGE2) ? REP_N : 1;
#pragma unroll 1
    for (int r = 0; r < reps; ++r)
#pragma unroll 1
        for (int u = first; u < first + count; ++u) { run_unit<S>(p, layer, u, smem); __syncthreads(); }
}
template <int PH>
DEV void run_dyn_phase(const P& p, int layer, char* smem, volatile LAS unsigned* slot) {
    unsigned* head = p.bar() + DQ_WORD(PH * 2 + layer);
    constexpr int total = PH == 0 ? (64 + 256 + 256 + 64 + 256) : (PH == 1 ? (512 + 256) : (512 + 512));
    int i = blockIdx.x;
    while (i < total) {
        if constexpr (PH == 0) {
            if (i < 256) run_items<S_SGU>(p, layer, smem, i, 1);
            else if (i < 320) run_items<S_COMPRESS>(p, layer, smem, i - 256, 1);
            else if (i < 576) run_items<S_CONV>(p, layer, smem, (i - 320) * 2, 2);
            else if (i < 640) run_items<S_VTRANS>(p, layer, smem, (i - 576) * 4, 4);
            else run_items<S_PREP>(p, layer, smem, (i - 640) * 8, 8);
        } else if constexpr (PH == 1) {
            if (i < 512) run_items<S_DSA_INDEX>(p, layer, smem, i, 1);
            else run_items<S_NSA_CMP>(p, layer, smem, (i - 512) * 2, 2);
        } else {
            if (i < 512) run_items<S_NSA_ATTN>(p, layer, smem, 511 - i, 1);
            else run_items<S_DSA_ATTN>(p, layer, smem, (i - 512) * 4, 4);
        }
        if (threadIdx.x == 0) *slot = gridDim.x + xb_add(head, 1u);
        __syncthreads();
        i = (int)*slot;
        __syncthreads();
    }
}
template <int S>
DEV void run_gemm_phase(const P& p, int layer, char* smem, unsigned xcc, volatile LAS unsigned* slot) {
    constexpr int reps = (S == REP_STAGE || S == REP_STAGE2) ? REP_N : 1;
#pragma unroll 1
    for (int r = 0; r < reps; ++r) run_gemm_phase1<S>(p, layer, smem, xcc, slot, r);
}
#define GSYNC() xcd_barrier(xb)
__global__ void __launch_bounds__(NTHREADS, 2) k_mega(P p) {
    __shared__ __attribute__((aligned(16))) char smem[SMEM_BYTES];
    __shared__ uint4 xb_words;
    cg::grid_group grid = cg::this_grid();
    if (threadIdx.x == 0) xb_words = make_uint4(0u, 0u, 0u, 0u);
    __syncthreads();
    XcdBarrier xb = xcd_barrier_post(p.bar(), (volatile LAS unsigned*)&xb_words);
    const int H = gridDim.x >> 1, Q = gridDim.x >> 2;
    run_phase<S_ADA>(p, 0, smem); run_phase<S_ROPE>(p, 0, smem, H);
    run_phase<S_CONVT_IN>(p, 0, smem); run_phase<S_CONVT_OUT>(p, 0, smem); run_phase<S_CONVT_Q>(p, 0, smem); run_phase<S_CONVT_W1>(p, 0, smem); run_phase<S_CALIB>(p, 0, smem, 100);
    run_phase<S_TAB_U>(p, 0, smem); run_phase<S_TAB_V>(p, 0, smem);
    grid.sync();
#pragma unroll 1
    for (int layer = 0; layer < NL; ++layer) {
        if (layer == 0) { run_phase<S_NORM1>(p, layer, smem); GSYNC(); }
        run_gemm_phase<S_GEMM_IN>(p, layer, smem, xb.x, (volatile LAS unsigned*)&xb_words + 2); GSYNC();
        run_dyn_phase<0>(p, layer, smem, (volatile LAS unsigned*)&xb_words + 2); GSYNC();
        run_dyn_phase<1>(p, layer, smem, (volatile LAS unsigned*)&xb_words + 2); GSYNC();
        run_dyn_phase<2>(p, layer, smem, (volatile LAS unsigned*)&xb_words + 2); GSYNC();
        run_gemm_phase<S_GEMM_OUT>(p, layer, smem, xb.x, (volatile LAS unsigned*)&xb_words + 2); GSYNC();
        run_phase<S_NORM2>(p, layer, smem); GSYNC();
        run_gemm_phase<S_GEMM_Q>(p, layer, smem, xb.x, (volatile LAS unsigned*)&xb_words + 2); GSYNC();
        run_phase<S_PEER_TOPK>(p, layer, smem); GSYNC();
        run_phase<S_PEER_GATHER>(p, layer, smem); GSYNC();
    }
}
#else
template <int S>
__global__ void __launch_bounds__(NTHREADS) k_stage(P p, int layer) {
    __shared__ __attribute__((aligned(16))) char smem[SMEM_BYTES];
    run_unit<S>(p, layer, blockIdx.x, smem);
}
template <int S> static void launch_stage(const P& p, int layer, hipStream_t st) {
    hipLaunchKernelGGL((k_stage<S>), dim3(nunits(S)), dim3(NTHREADS), 0, st, p, layer);
}
#endif

extern "C" void kernel_launch(void* const* d_in, const int* in_sizes, int n_in, void* d_out, int out_size, void* d_ws, size_t ws_size, hipStream_t stream) {
    P p{};
    p.x = (const float*)d_in[0]; p.c = (const float*)d_in[1]; p.pos = (const int*)d_in[2]; p.ada_w = (const float*)d_in[3]; p.ada_b = (const float*)d_in[4];
    p.n1g = (const float*)d_in[5]; p.n2g = (const float*)d_in[6]; p.w_in = (const float*)d_in[7]; p.w_out = (const float*)d_in[8]; p.conv_w = (const float*)d_in[9];
    p.conv_b = (const float*)d_in[10]; p.cln_g = (const float*)d_in[11]; p.cln_b = (const float*)d_in[12]; p.sln_g = (const float*)d_in[13]; p.sln_b = (const float*)d_in[14];
    p.sgu_w = (const float*)d_in[15]; p.sgu_b = (const float*)d_in[16]; p.nsa_qg = (const float*)d_in[17]; p.nsa_kg = (const float*)d_in[18]; p.cmp_pos = (const float*)d_in[19];
    p.cmp_w1 = (const float*)d_in[20]; p.cmp_w2 = (const float*)d_in[21]; p.dsa_qg = (const float*)d_in[22]; p.dsa_kg = (const float*)d_in[23]; p.peer_wq = (const float*)d_in[24];
    p.peer_sk = (const float*)d_in[25]; p.peer_u = (const float*)d_in[26]; p.peer_v = (const float*)d_in[27];
    p.out = (float*)d_out;
    p.ws = (char*)d_ws; const size_t off = WS_TOTAL;
    if (off > ws_size) { fprintf(stderr, "workspace too small: need %zu have %zu\n", off, ws_size); return; }
#ifndef MULTI_LAUNCH
    static int grid_blocks = 0;
    if (!grid_blocks) {
        int dev = 0, cus = 0, per_cu = 0;
        (void)hipGetDevice(&dev);
        (void)hipDeviceGetAttribute(&cus, hipDeviceAttributeMultiprocessorCount, dev);
        (void)hipOccupancyMaxActiveBlocksPerMultiprocessor(&per_cu, k_mega, NTHREADS, 0);
        if (per_cu > 2) per_cu = 2;
        grid_blocks = cus * per_cu;
    }
    (void)hipMemsetAsync(p.bar(), 0, (size_t)CTRL_WORDS * 4, stream);
    void* args[] = {&p};
    hipError_t e = hipLaunchCooperativeKernel((void*)k_mega, dim3(grid_blocks), dim3(NTHREADS), args, 0, stream);
    if (e != hipSuccess) fprintf(stderr, "cooperative launch failed: %s (grid %d)\n", hipGetErrorString(e), grid_blocks);
#else
    launch_stage<S_CONVT_IN>(p, 0, stream); launch_stage<S_CONVT_OUT>(p, 0, stream); launch_stage<S_CONVT_Q>(p, 0, stream); launch_stage<S_CONVT_W1>(p, 0, stream); launch_stage<S_CALIB>(p, 0, stream);
    launch_stage<S_TAB_U>(p, 0, stream); launch_stage<S_TAB_V>(p, 0, stream);
    launch_stage<S_ADA>(p, 0, stream); launch_stage<S_ROPE>(p, 0, stream);
    for (int layer = 0; layer < NL; ++layer) {
        launch_stage<S_NORM1>(p, layer, stream); launch_stage<S_GEMM_IN>(p, layer, stream);
        launch_stage<S_CONV>(p, layer, stream); launch_stage<S_SGU>(p, layer, stream); launch_stage<S_VTRANS>(p, layer, stream);
        launch_stage<S_PREP>(p, layer, stream); launch_stage<S_COMPRESS>(p, layer, stream);
        launch_stage<S_NSA_CMP>(p, layer, stream); launch_stage<S_DSA_INDEX>(p, layer, stream);
        launch_stage<S_NSA_ATTN>(p, layer, stream); launch_stage<S_DSA_ATTN>(p, layer, stream);
        launch_stage<S_GEMM_OUT>(p, layer, stream); launch_stage<S_NORM2>(p, layer, stream); launch_stage<S_GEMM_Q>(p, layer, stream);
        launch_stage<S_PEER_TOPK>(p, layer, stream); launch_stage<S_PEER_GATHER>(p, layer, stream);
    }
#endif
}
```

```cpp
#include <hip/hip_runtime.h>
#include <hip/hip_cooperative_groups.h>
#include <stdint.h>
#include <cstdio>
namespace cg = cooperative_groups;

typedef unsigned short bf16_t;
typedef short bf16x8 __attribute__((ext_vector_type(8)));
typedef float f32x4 __attribute__((ext_vector_type(4)));
typedef float f32x16 __attribute__((ext_vector_type(16)));
#define DEV __device__ __forceinline__

constexpr int T = 8192, D = 2048, NL = 2;
constexpr int INC = 4692;
constexpr int LDP = 4736;
constexpr int C_CA = 0, C_CG = 512, C_SU = 1024, C_SV = 1536;
constexpr int C_NQ = 2048, C_NKC = 2560, C_NVC = 2688, C_NKS = 2816, C_NVS = 2944, C_NKW = 3072, C_NVW = 3200;
constexpr int C_DQ = 3328, C_DK = 3840, C_DV = 3968, C_IQ = 4096, C_IK = 4608, C_NG = 4672, C_IW = 4688;
constexpr float EPS = 1e-6f;
constexpr int NTHREADS = 256;
constexpr int SMEM_BYTES = 72 * 1024;

__device__ const double INV16[16] = {1.0, 0.44036660267178046, 0.19392274474868576, 0.08539710028576561, 0.03760603093086393,
    0.016560440080994446, 0.007292664737217109, 0.003211445994752591, 0.001414213562373095, 0.000622772421914596,
    0.0002742481756762073, 0.00012076973741146504, 5.318295896944988e-05, 2.341999896140934e-05, 1.031338537721246e-05,
    4.5416704806078695e-06};

#define XCD_BAR_WORDS 3456
#define GQ_WORD(inst, x) (XCD_BAR_WORDS + 64 * ((inst) * 8 + (x)))
#define DQ_WORD(k) (XCD_BAR_WORDS + 64 * (96 + (k)))
#define CTRL_WORDS (XCD_BAR_WORDS + 64 * 112)
constexpr size_t WS_ALIGN(size_t x) { return (x + 255) & ~(size_t)255; }
constexpr size_t OFF_WinT = 0;
constexpr size_t OFF_WoutT = OFF_WinT + WS_ALIGN((size_t)2 * LDP * 2048 * 2);
constexpr size_t OFF_WqT = OFF_WoutT + WS_ALIGN((size_t)2 * 2048 * 2048 * 2);
constexpr size_t OFF_W1T = OFF_WqT + WS_ALIGN((size_t)2 * 1024 * 2048 * 2);
constexpr size_t OFF_PI = OFF_W1T + WS_ALIGN((size_t)4 * 128 * 4096 * 2);
constexpr size_t OFF_Utab = OFF_PI + WS_ALIGN(256);
constexpr size_t OFF_Vtab = OFF_Utab + WS_ALIGN((size_t)2 * 16384 * 1536);
constexpr size_t OFF_ada = OFF_Vtab + WS_ALIGN((size_t)2 * 16384 * 1536);
constexpr size_t OFF_ropeC = OFF_ada + WS_ALIGN((size_t)2 * 12288 * 4);
constexpr size_t OFF_ropeS = OFF_ropeC + WS_ALIGN((size_t)T * 24 * 4);
constexpr size_t OFF_HN = OFF_ropeS + WS_ALIGN((size_t)T * 24 * 4);
constexpr size_t OFF_PROJ = OFF_HN + WS_ALIGN((size_t)T * D * 2);
constexpr size_t OFF_Y = OFF_PROJ + WS_ALIGN((size_t)T * LDP * 2);
constexpr size_t OFF_QN = OFF_Y + WS_ALIGN((size_t)T * D * 2);
constexpr size_t OFF_QR = OFF_QN + WS_ALIGN((size_t)T * 512 * 2);
constexpr size_t OFF_KS = OFF_QR + WS_ALIGN((size_t)T * 512 * 2);
constexpr size_t OFF_KW = OFF_KS + WS_ALIGN((size_t)T * 128 * 2);
constexpr size_t OFF_VST = OFF_KW + WS_ALIGN((size_t)T * 128 * 2);
constexpr size_t OFF_VWT = OFF_VST + WS_ALIGN((size_t)T * 128 * 2);
constexpr size_t OFF_GATES = OFF_VWT + WS_ALIGN((size_t)T * 128 * 2);
constexpr size_t OFF_KC = OFF_GATES + WS_ALIGN((size_t)T * 12 * 4);
constexpr size_t OFF_VCT = OFF_KC + WS_ALIGN((size_t)512 * 128 * 2);
constexpr size_t OFF_SEL = OFF_VCT + WS_ALIGN((size_t)128 * 512 * 2);
constexpr size_t OFF_OCMP = OFF_SEL + WS_ALIGN((size_t)T * 4 * 4);
constexpr size_t OFF_DQ = OFF_OCMP + WS_ALIGN((size_t)T * 512 * 2);
constexpr size_t OFF_DK = OFF_DQ + WS_ALIGN((size_t)T * 512 * 2);
constexpr size_t OFF_IQ = OFF_DK + WS_ALIGN((size_t)T * 128 * 2);
constexpr size_t OFF_IK = OFF_IQ + WS_ALIGN((size_t)T * 512 * 2);
constexpr size_t OFF_IW = OFF_IK + WS_ALIGN((size_t)T * 64 * 2);
constexpr size_t OFF_IDX = OFF_IW + WS_ALIGN((size_t)T * 8 * 4);
constexpr size_t OFF_CNT = OFF_IDX + WS_ALIGN((size_t)T * 256 * 4);
constexpr size_t OFF_X1 = OFF_CNT + WS_ALIGN((size_t)T * 4);
constexpr size_t OFF_X2 = OFF_X1 + WS_ALIGN((size_t)T * D * 4);
constexpr size_t OFF_PQ = OFF_X2 + WS_ALIGN((size_t)T * D * 4);
constexpr size_t OFF_PE = OFF_PQ + WS_ALIGN((size_t)T * 1024 * 4);
constexpr size_t OFF_PG = OFF_PE + WS_ALIGN((size_t)T * 128 * 4);
constexpr size_t OFF_bar = OFF_PG + WS_ALIGN((size_t)T * 128 * 4);
constexpr size_t WS_TOTAL = OFF_bar + WS_ALIGN((size_t)CTRL_WORDS * 4);

struct P {
    const float* x; const float* c; const int* pos; const float* ada_w; const float* ada_b; const float* n1g; const float* n2g;
    const float* w_in; const float* w_out; const float* conv_w; const float* conv_b; const float* cln_g; const float* cln_b;
    const float* sln_g; const float* sln_b; const float* sgu_w; const float* sgu_b; const float* nsa_qg; const float* nsa_kg;
    const float* cmp_pos; const float* cmp_w1; const float* cmp_w2; const float* dsa_qg; const float* dsa_kg;
    const float* peer_wq; const float* peer_sk; const float* peer_u; const float* peer_v;
    float* out;
    char* ws;
    __host__ __device__ __forceinline__ bf16_t* WinT() const { return (bf16_t*)(ws + OFF_WinT); }
    __host__ __device__ __forceinline__ bf16_t* WoutT() const { return (bf16_t*)(ws + OFF_WoutT); }
    __host__ __device__ __forceinline__ bf16_t* WqT() const { return (bf16_t*)(ws + OFF_WqT); }
    __host__ __device__ __forceinline__ bf16_t* W1T() const { return (bf16_t*)(ws + OFF_W1T); }
    __host__ __device__ __forceinline__ int* PI() const { return (int*)(ws + OFF_PI); }
    __host__ __device__ __forceinline__ unsigned char* Utab() const { return (unsigned char*)(ws + OFF_Utab); }
    __host__ __device__ __forceinline__ unsigned char* Vtab() const { return (unsigned char*)(ws + OFF_Vtab); }
    __host__ __device__ __forceinline__ float* ada() const { return (float*)(ws + OFF_ada); }
    __host__ __device__ __forceinline__ float* ropeC() const { return (float*)(ws + OFF_ropeC); }
    __host__ __device__ __forceinline__ float* ropeS() const { return (float*)(ws + OFF_ropeS); }
    __host__ __device__ __forceinline__ bf16_t* HN() const { return (bf16_t*)(ws + OFF_HN); }
    __host__ __device__ __forceinline__ bf16_t* PROJ() const { return (bf16_t*)(ws + OFF_PROJ); }
    __host__ __device__ __forceinline__ bf16_t* Y() const { return (bf16_t*)(ws + OFF_Y); }
    __host__ __device__ __forceinline__ bf16_t* QN() const { return (bf16_t*)(ws + OFF_QN); }
    __host__ __device__ __forceinline__ bf16_t* QR() const { return (bf16_t*)(ws + OFF_QR); }
    __host__ __device__ __forceinline__ bf16_t* KS() const { return (bf16_t*)(ws + OFF_KS); }
    __host__ __device__ __forceinline__ bf16_t* KW() const { return (bf16_t*)(ws + OFF_KW); }
    __host__ __device__ __forceinline__ bf16_t* VST() const { return (bf16_t*)(ws + OFF_VST); }
    __host__ __device__ __forceinline__ bf16_t* VWT() const { return (bf16_t*)(ws + OFF_VWT); }
    __host__ __device__ __forceinline__ float* GATES() const { return (float*)(ws + OFF_GATES); }
    __host__ __device__ __forceinline__ bf16_t* KC() const { return (bf16_t*)(ws + OFF_KC); }
    __host__ __device__ __forceinline__ bf16_t* VCT() const { return (bf16_t*)(ws + OFF_VCT); }
    __host__ __device__ __forceinline__ unsigned* SEL() const { return (unsigned*)(ws + OFF_SEL); }
    __host__ __device__ __forceinline__ bf16_t* OCMP() const { return (bf16_t*)(ws + OFF_OCMP); }
    __host__ __device__ __forceinline__ bf16_t* DQ() const { return (bf16_t*)(ws + OFF_DQ); }
    __host__ __device__ __forceinline__ bf16_t* DK() const { return (bf16_t*)(ws + OFF_DK); }
    __host__ __device__ __forceinline__ bf16_t* IQ() const { return (bf16_t*)(ws + OFF_IQ); }
    __host__ __device__ __forceinline__ bf16_t* IK() const { return (bf16_t*)(ws + OFF_IK); }
    __host__ __device__ __forceinline__ float* IW() const { return (float*)(ws + OFF_IW); }
    __host__ __device__ __forceinline__ int* IDX() const { return (int*)(ws + OFF_IDX); }
    __host__ __device__ __forceinline__ int* CNT() const { return (int*)(ws + OFF_CNT); }
    __host__ __device__ __forceinline__ float* X1() const { return (float*)(ws + OFF_X1); }
    __host__ __device__ __forceinline__ float* X2() const { return (float*)(ws + OFF_X2); }
    __host__ __device__ __forceinline__ float* PQ() const { return (float*)(ws + OFF_PQ); }
    __host__ __device__ __forceinline__ int* PE() const { return (int*)(ws + OFF_PE); }
    __host__ __device__ __forceinline__ float* PG() const { return (float*)(ws + OFF_PG); }
    __host__ __device__ __forceinline__ unsigned* bar() const { return (unsigned*)(ws + OFF_bar); }
};

DEV float bf2f(bf16_t v) { return __uint_as_float(((unsigned)v) << 16); }
DEV unsigned pk2(float lo, float hi) { unsigned r; asm("v_cvt_pk_bf16_f32 %0, %1, %2" : "=v"(r) : "v"(lo), "v"(hi)); return r; }
DEV bf16_t f2bf(float v) { return (bf16_t)(pk2(v, 0.f) & 0xffffu); }
DEV float lo2f(unsigned u) { return __uint_as_float(u << 16); }
DEV float hi2f(unsigned u) { return __uint_as_float(u & 0xffff0000u); }
#define DPP_ROR_F(V, N) __int_as_float(__builtin_amdgcn_update_dpp(0, __float_as_int(V), 0x120 + (N), 0xf, 0xf, false))
DEV float wsum(float v) {
    v += DPP_ROR_F(v, 8); v += DPP_ROR_F(v, 4); v += DPP_ROR_F(v, 2); v += DPP_ROR_F(v, 1);
    const int vi = __float_as_int(v);
    return (__int_as_float(__builtin_amdgcn_readlane(vi, 0)) + __int_as_float(__builtin_amdgcn_readlane(vi, 16))) +
           (__int_as_float(__builtin_amdgcn_readlane(vi, 32)) + __int_as_float(__builtin_amdgcn_readlane(vi, 48)));
}
DEV float wmax(float v) {
    v = fmaxf(v, DPP_ROR_F(v, 8)); v = fmaxf(v, DPP_ROR_F(v, 4)); v = fmaxf(v, DPP_ROR_F(v, 2)); v = fmaxf(v, DPP_ROR_F(v, 1));
    const int vi = __float_as_int(v);
    return fmaxf(fmaxf(__int_as_float(__builtin_amdgcn_readlane(vi, 0)), __int_as_float(__builtin_amdgcn_readlane(vi, 16))),
                 fmaxf(__int_as_float(__builtin_amdgcn_readlane(vi, 32)), __int_as_float(__builtin_amdgcn_readlane(vi, 48))));
}
DEV int tidx() { int t = threadIdx.x; asm volatile("" : "+v"(t)); return t; }
DEV float sigmoidf_(float x) { return 1.0f / (1.0f + __expf(-x)); }
DEV float gelu_tanh(float x) {
    const float y = 0.7978845608028654f * (x + 0.044715f * x * x * x);
    const float t = 1.0f - 2.0f / (1.0f + __expf(2.0f * y));
    return 0.5f * x * (1.0f + t);
}
DEV f32x4 mfma16(bf16x8 a, bf16x8 b, f32x4 c) { return __builtin_amdgcn_mfma_f32_16x16x32_bf16(a, b, c, 0, 0, 0); }
DEV f32x16 mfma32(bf16x8 a, bf16x8 b, f32x16 c) { return __builtin_amdgcn_mfma_f32_32x32x16_bf16(a, b, c, 0, 0, 0); }

DEV int src_col(int n) {
    if (n < 3328) return n;
    if (n < 4672) return 3340 + (n - 3328);
    if (n < 4684) return 3328 + (n - 4672);
    if (n < 4688) return -1;
    if (n < 4696) return 4684 + (n - 4688);
    return -1;
}

DEV void st_convT(const float* __restrict__ W, bf16_t* __restrict__ Bt, int N, int Npad, bool remap, int unit, char* smem, int Kdim = 2048) {
    float (*tile)[65] = (float (*)[65])smem;
    const int ntn = Npad / 64, kt = unit / ntn, nt = unit % ntn, k0 = kt * 64, n0 = nt * 64;
    const int tid_ = tidx(); const int tx = tid_ & 63, ty = tid_ >> 6;
    const int n = n0 + tx;
    const int src = remap ? src_col(n) : (n < N ? n : -1);
#pragma unroll
    for (int i = 0; i < 16; ++i) { const int k = ty + 4 * i; tile[k][tx] = src >= 0 ? W[(size_t)(k0 + k) * N + src] : 0.f; }
    __syncthreads();
#pragma unroll
    for (int i = 0; i < 16; ++i) { const int r = ty + 4 * i; Bt[(size_t)(n0 + r) * Kdim + k0 + tx] = f2bf(tile[tx][r]); }
    __syncthreads();
}

typedef float f32x2 __attribute__((ext_vector_type(2)));
typedef float v16f __attribute__((ext_vector_type(16)));
typedef float v32f __attribute__((ext_vector_type(32)));
typedef unsigned v6u __attribute__((ext_vector_type(6)));
constexpr float U6_SCALE = 64.0f, V6_SCALE = 3.0f;
constexpr int ROW6 = 1536;
#define FP6_ONE __uint_as_float(0x3F80007Fu)

#ifndef SW_FP6
#define SW_FP6 1
#endif
DEV unsigned fp6_enc1(float f) {
    const float a = fminf(fabsf(f), 7.5f);
    const float sc = a < 2.0f ? 8.0f : (a < 4.0f ? 4.0f : 2.0f), of = a < 2.0f ? 0.0f : (a < 4.0f ? 8.0f : 16.0f);
    const unsigned code = (unsigned)(int)__builtin_rintf(a * sc + of);
    return code | ((__float_as_uint(f) >> 26) & 32u);
}
DEV float fp6_dec1(unsigned c) {
    const unsigned e = (c >> 3) & 3u, m = c & 7u;
    const float v = e == 0u ? 0.125f * (float)m : (1.0f + 0.125f * (float)m) * (float)(1u << (e - 1u));
    return (c & 32u) ? -v : v;
}
DEV v6u sw_pack32(const v16f& x, const v16f& y) {
    unsigned w[6] = {0u, 0u, 0u, 0u, 0u, 0u};
#pragma unroll
    for (int i = 0; i < 32; ++i) {
        const unsigned c = fp6_enc1(i < 16 ? x[i] : y[i - 16]);
        const int bit = 6 * i, d = bit >> 5, sh = bit & 31;
        w[d] |= c << sh;
        if (sh > 26) w[d + 1] |= c >> (32 - sh);
    }
    v6u r; r[0] = w[0]; r[1] = w[1]; r[2] = w[2]; r[3] = w[3]; r[4] = w[4]; r[5] = w[5]; return r;
}
DEV v32f sw_unpack32(const v6u& pk) {
    const unsigned w[6] = {pk[0], pk[1], pk[2], pk[3], pk[4], pk[5]};
    v32f r;
#pragma unroll
    for (int i = 0; i < 32; ++i) {
        const int bit = 6 * i, d = bit >> 5, sh = bit & 31;
        unsigned c = w[d] >> sh;
        if (sh > 26) c |= w[d + 1] << (32 - sh);
        r[i] = fp6_dec1(c & 63u);
    }
    return r;
}
#define FP6_PACK(x, y) sw_pack32(x, y)
#define FP6_UNPACK(pk) __builtin_amdgcn_cvt_scalef32_pk32_f32_fp6(pk, FP6_ONE)
DEV void st_tab6(const float* __restrict__ src, unsigned char* __restrict__ dst, float scale, int nrows, int unit, int nunits, char* smem) {
    const int tid_ = tidx(), w = tid_ >> 6, l = tid_ & 63;
    float* stg = (float*)smem + w * (64 * 36);
    for (int r = unit * 4 + w; r < nrows; r += nunits * 4) {
        const float4* sp = (const float4*)(src + (size_t)r * 2048);
        float4 v[8];
#pragma unroll
        for (int i = 0; i < 8; ++i) v[i] = sp[l + 64 * i];
#pragma unroll
        for (int i = 0; i < 8; ++i) { const int f = l + 64 * i; *(float4*)(stg + (f >> 3) * 36 + (f & 7) * 4) = v[i]; }
        __builtin_amdgcn_wave_barrier();
        v16f x, y;
#pragma unroll
        for (int q = 0; q < 4; ++q) {
            const float4 a = *(const float4*)(stg + l * 36 + q * 4), b = *(const float4*)(stg + l * 36 + 16 + q * 4);
            x[4 * q] = a.x * scale; x[4 * q + 1] = a.y * scale; x[4 * q + 2] = a.z * scale; x[4 * q + 3] = a.w * scale;
            y[4 * q] = b.x * scale; y[4 * q + 1] = b.y * scale; y[4 * q + 2] = b.z * scale; y[4 * q + 3] = b.w * scale;
        }
        const v6u pk = FP6_PACK(x, y);
        unsigned char* dp = dst + (size_t)r * ROW6 + l * 8;
        *(uint2*)(dp) = make_uint2(pk[0], pk[1]); *(uint2*)(dp + 512) = make_uint2(pk[2], pk[3]); *(uint2*)(dp + 1024) = make_uint2(pk[4], pk[5]);
        __builtin_amdgcn_wave_barrier();
    }
}
DEV void st_calib(const P& p) {
    if (tidx() >= 64) return;
    v16f x, y;
#pragma unroll
    for (int k = 0; k < 32; ++k) {
        const int e = k >> 3, m = k & 7;
        const float v = e == 0 ? 0.125f * m : (1.0f + 0.125f * m) * (float)(1 << (e - 1));
        if (k < 16) x[k] = v; else y[k - 16] = v;
    }
    const v6u pk = FP6_PACK(x, y);
    const v32f d = FP6_UNPACK(pk);
    if ((threadIdx.x & 63) == 0) {
        float dmax = 0.f;
#pragma unroll
        for (int j = 0; j < 32; ++j) dmax = fmaxf(dmax, fabsf(d[j]));
        const float cscale = dmax > 0.f ? dmax * (1.0f / 7.5f) : 1.0f;
        const float ic = 1.0f / cscale;
#pragma unroll
        for (int j = 0; j < 32; ++j) {
            int found = j;
#pragma unroll
            for (int k = 0; k < 32; ++k) {
                const int e = k >> 3, m = k & 7;
                const float v = e == 0 ? 0.125f * m : (1.0f + 0.125f * m) * (float)(1 << (e - 1));
                if (fabsf(d[j] * ic - v) < 0.02f + 0.01f * v) found = k;
            }
            p.PI()[j] = found;
        }
        p.PI()[32] = __float_as_int(ic);
    }
}

DEV void st_ada(const P& p, int unit, char* smem) {
    float4* red = (float4*)smem;
    const int tid = tidx(), c4 = tid & 15, kg = tid >> 4;
    const int i = unit / 192, j = (unit % 192) * 64 + c4 * 4;
    const float* W = p.ada_w + (size_t)i * 2048 * 12288 + (size_t)kg * 12288 + j;
    float4 acc = make_float4(0.f, 0.f, 0.f, 0.f);
#pragma unroll 1
    for (int k0 = 0; k0 < 128; k0 += 16) {
        float4 wv[16]; float a[16];
#pragma unroll
        for (int q = 0; q < 16; ++q) { const f32x4 t4 = __builtin_nontemporal_load((const f32x4*)(W + (size_t)(16 * (k0 + q)) * 12288)); wv[q] = make_float4(t4[0], t4[1], t4[2], t4[3]); }
#pragma unroll
        for (int q = 0; q < 16; ++q) { const float cv = p.c[kg + 16 * (k0 + q)]; a[q] = cv * sigmoidf_(cv); }
#pragma unroll
        for (int q = 0; q < 16; ++q) { acc.x += a[q] * wv[q].x; acc.y += a[q] * wv[q].y; acc.z += a[q] * wv[q].z; acc.w += a[q] * wv[q].w; }
    }
    red[kg * 16 + c4] = acc;
    __syncthreads();
    if (tid < 64) {
        const int cc = tid >> 2, e = tid & 3;
        float r = p.ada_b[i * 12288 + (unit % 192) * 64 + tid];
#pragma unroll
        for (int q = 0; q < 16; ++q) r += ((const float*)&red[q * 16 + cc])[e];
        p.ada()[i * 12288 + (unit % 192) * 64 + tid] = r;
    }
    __syncthreads();
}
DEV void st_rope(const P& p, int unit) {
    const int e = unit * 256 + tidx(); const int t = e / 24, i = e % 24;
    const double inv = i < 16 ? INV16[i] : INV16[2 * (i - 16)];
    const double ang = (double)p.pos[t] * inv;
    const double n = rint(ang * 0.15915494309189535);
    const double r = ang - n * 6.283185307179586;
    const double r2 = r * r;
    double sp = 1.0 / 1.5511210043330986e25, cp = -1.0 / 4.0329146112660565e26;
    sp = sp * r2 - 1.0 / 2.585201673888498e22;   cp = cp * r2 + 1.0 / 6.204484017332394e23;
    sp = sp * r2 + 1.0 / 5.109094217170944e19;   cp = cp * r2 - 1.0 / 1.1240007277776077e21;
    sp = sp * r2 - 1.0 / 1.21645100408832e17;    cp = cp * r2 + 1.0 / 2.43290200817664e18;
    sp = sp * r2 + 1.0 / 3.55687428096e14;       cp = cp * r2 - 1.0 / 6.402373705728e15;
    sp = sp * r2 - 1.0 / 1.307674368e12;         cp = cp * r2 + 1.0 / 2.0922789888e13;
    sp = sp * r2 + 1.0 / 6.2270208e9;            cp = cp * r2 - 1.0 / 8.71782912e10;
    sp = sp * r2 - 1.0 / 3.99168e7;              cp = cp * r2 + 1.0 / 4.790016e8;
    sp = sp * r2 + 1.0 / 362880.0;               cp = cp * r2 - 1.0 / 3628800.0;
    sp = sp * r2 - 1.0 / 5040.0;                 cp = cp * r2 + 1.0 / 40320.0;
    sp = sp * r2 + 1.0 / 120.0;                  cp = cp * r2 - 1.0 / 720.0;
    sp = sp * r2 - 1.0 / 6.0;                    cp = cp * r2 + 1.0 / 24.0;
    sp = sp * r2 + 1.0;                          cp = cp * r2 - 0.5;
    cp = cp * r2 + 1.0;
    const float cs = (float)cp, sn = (float)(sp * r);
    p.ropeC()[e] = cs; p.ropeS()[e] = sn;
}

DEV void st_norm(const float* __restrict__ X, const float* __restrict__ g, const float* __restrict__ sc, const float* __restrict__ sh,
                 bf16_t* __restrict__ HN, int unit) {
    const int tid_ = tidx(); const int w = tid_ >> 6, l = tid_ & 63; const int t = unit * 4 + w;
    const float4* xr = (const float4*)(X + (size_t)t * D);
    float4 v[8]; float ss = 0.f;
#pragma unroll
    for (int i = 0; i < 4; ++i) { v[2 * i] = xr[i * 128 + l * 2]; v[2 * i + 1] = xr[i * 128 + l * 2 + 1]; }
#pragma unroll
    for (int i = 0; i < 8; ++i) ss += v[i].x * v[i].x + v[i].y * v[i].y + v[i].z * v[i].z + v[i].w * v[i].w;
    ss = wsum(ss);
    const float rs = rsqrtf(ss * (1.0f / 2048.0f) + EPS);
#pragma unroll
    for (int i = 0; i < 4; ++i) {
        const int col = i * 512 + l * 8;
        float y[8]; const float xv[8] = {v[2 * i].x, v[2 * i].y, v[2 * i].z, v[2 * i].w, v[2 * i + 1].x, v[2 * i + 1].y, v[2 * i + 1].z, v[2 * i + 1].w};
#pragma unroll
        for (int j = 0; j < 8; ++j) y[j] = (xv[j] * rs) * g[col + j] * (1.0f + sc[col + j]) + sh[col + j];
        uint4 o; o.x = pk2(y[0], y[1]); o.y = pk2(y[2], y[3]); o.z = pk2(y[4], y[5]); o.w = pk2(y[6], y[7]);
        *(uint4*)(HN + (size_t)t * D + col) = o;
    }
}

enum { EPI_PROJ = 0, EPI_OUT = 1, EPI_Q = 2 };
struct EpiArgs { bf16_t* obf; float* of; const float* xin; const float* gate; };
template <int EPI, int MT = 4>
DEV void st_gemm(const bf16_t* __restrict__ A, const bf16_t* __restrict__ Bt, int K, int tm, int tn, const EpiArgs& e, char* smem) {
    constexpr int BM = 32 * MT, ABYTES = BM * 64, BUFB = ABYTES + 8192, NBUF = (MT == 4) ? 4 : 3, NA = BM / 64;
    static_assert(NBUF * BUFB <= SMEM_BYTES, "GEMM LDS");
    const int tid = tidx(), w = tid >> 6, l = tid & 63, wr = w >> 1, wc = w & 1;
    f32x4 acc[MT][4];
#pragma unroll
    for (int m = 0; m < MT; ++m)
#pragma unroll
        for (int n = 0; n < 4; ++n) acc[m][n] = (f32x4){0.f, 0.f, 0.f, 0.f};
    const int srow = tid >> 2, spc = tid & 3, sc = spc ^ (((srow >> 2) & 1) << 1);
    const bf16_t* Ag = A + (size_t)(tm * BM + srow) * K + sc * 8;
    const bf16_t* Bg = Bt + (size_t)(tn * 128 + srow) * K + sc * 8;
#define GEMM_STAGE(BUF, KO) do { char* _b = smem + (BUF) * BUFB + tid * 16; \
        _Pragma("unroll") for (int _i = 0; _i < NA; ++_i) \
            __builtin_amdgcn_global_load_lds((const unsigned*)(Ag + (size_t)(64 * _i) * K + (KO)), (__attribute__((address_space(3))) unsigned*)(_b + _i * 4096), 16, 0, 0); \
        __builtin_amdgcn_global_load_lds((const unsigned*)(Bg + (KO)), (__attribute__((address_space(3))) unsigned*)(_b + ABYTES), 16, 0, 0); \
        __builtin_amdgcn_global_load_lds((const unsigned*)(Bg + (size_t)64 * K + (KO)), (__attribute__((address_space(3))) unsigned*)(_b + ABYTES + 4096), 16, 0, 0); } while (0)
    const int nk = K / 32;
    GEMM_STAGE(0, 0); GEMM_STAGE(1, 32);
    if (NBUF == 4) { GEMM_STAGE(2, 64); asm volatile("s_waitcnt vmcnt(8)" ::: "memory"); }
    else asm volatile("s_waitcnt vmcnt(6)" ::: "memory");
    __builtin_amdgcn_s_barrier();
    const int fr = l & 15, fq = l >> 4;
    int cur = 0, nxt = NBUF - 1;
#pragma unroll 1
    for (int kt = 0; kt < nk; ++kt) {
        if (kt + NBUF - 1 < nk) GEMM_STAGE(nxt, (kt + NBUF - 1) * 32);
        const char* As = smem + cur * BUFB; const char* Bs = As + ABYTES;
        bf16x8 bfr[4];
#pragma unroll
        for (int n = 0; n < 4; ++n) { const int row = wc * 64 + n * 16 + fr; bfr[n] = *(const bf16x8*)(Bs + row * 64 + ((fq ^ (((row >> 2) & 1) << 1)) << 4)); }
#pragma unroll
        for (int m = 0; m < MT; ++m) {
            const int row = wr * (BM / 2) + m * 16 + fr;
            const bf16x8 af = *(const bf16x8*)(As + row * 64 + ((fq ^ (((row >> 2) & 1) << 1)) << 4));
#pragma unroll
            for (int n = 0; n < 4; ++n) acc[m][n] = mfma16(bfr[n], af, acc[m][n]);
        }
        if (NBUF == 4) {
            if (kt + 3 < nk) asm volatile("s_waitcnt vmcnt(8)" ::: "memory");
            else if (kt + 2 < nk) asm volatile("s_waitcnt vmcnt(4)" ::: "memory");
            else asm volatile("s_waitcnt vmcnt(0)" ::: "memory");
        } else {
            if (kt + 2 < nk) asm volatile("s_waitcnt vmcnt(6)" ::: "memory");
            else asm volatile("s_waitcnt vmcnt(0)" ::: "memory");
        }
        asm volatile("s_waitcnt lgkmcnt(0)" ::: "memory");
        __builtin_amdgcn_s_barrier();
        cur = (cur + 1 == NBUF) ? 0 : cur + 1; nxt = (nxt + 1 == NBUF) ? 0 : nxt + 1;
    }
#undef GEMM_STAGE
#pragma unroll
    for (int m = 0; m < MT; ++m) {
        const int row = tm * BM + wr * (BM / 2) + m * 16 + (l & 15);
#pragma unroll
        for (int n = 0; n < 4; ++n) {
            const int col = tn * 128 + wc * 64 + n * 16 + 4 * (l >> 4);
            const f32x4 a = acc[m][n];
            if (EPI == EPI_PROJ) {
                uint2 o; o.x = pk2(a[0], a[1]); o.y = pk2(a[2], a[3]);
                *(uint2*)(e.obf + (size_t)row * LDP + col) = o;
            } else if (EPI == EPI_OUT) {
                const float4 xi = *(const float4*)(e.xin + (size_t)row * D + col);
                const float4 gg = *(const float4*)(e.gate + col);
                float4 o; o.x = xi.x + gg.x * a[0]; o.y = xi.y + gg.y * a[1]; o.z = xi.z + gg.z * a[2]; o.w = xi.w + gg.w * a[3];
                *(float4*)(e.of + (size_t)row * D + col) = o;
            } else {
                float4 o; o.x = a[0]; o.y = a[1]; o.z = a[2]; o.w = a[3];
                *(float4*)(e.of + (size_t)row * 1024 + col) = o;
            }
        }
    }
    __syncthreads();
}

DEV void st_conv(const P& p, int layer, int unit, char* smem) {
    float* cs = (float*)smem;
    const int tid = tidx(), t0 = unit * 16;
    const float* cw = p.conv_w + (size_t)layer * 31 * 512;
#pragma unroll 1
    for (int cc = 0; cc < 2; ++cc) {
        const int c = tid + 256 * cc;
        float w[31], z[46];
#pragma unroll
        for (int k = 0; k < 31; ++k) w[k] = cw[k * 512 + c];
#pragma unroll
        for (int r = 0; r < 46; ++r) {
            const int t = t0 - 30 + r, tc = t < 0 ? 0 : t;
            const float a = bf2f(p.PROJ()[(size_t)tc * LDP + C_CA + c]), g = bf2f(p.PROJ()[(size_t)tc * LDP + C_CG + c]);
            z[r] = t >= 0 ? a * sigmoidf_(g) : 0.f;
        }
        const float cb = p.conv_b[layer * 512 + c];
#pragma unroll
        for (int tt = 0; tt < 16; ++tt) {
            float acc = cb;
#pragma unroll
            for (int k = 0; k < 31; ++k) acc += w[k] * z[tt + k];
            cs[tt * 512 + c] = acc;
        }
    }
    __syncthreads();
    const int w = tid >> 6, l = tid & 63;
    const float* lg = p.cln_g + layer * 512; const float* lb = p.cln_b + layer * 512;
#pragma unroll 1
    for (int q = 0; q < 4; ++q) {
        const int tt = w * 4 + q;
        float v[8]; float s = 0.f;
#pragma unroll
        for (int i = 0; i < 8; ++i) { v[i] = cs[tt * 512 + l + 64 * i]; s += v[i]; }
        const float mean = wsum(s) * (1.0f / 512.0f);
        float q2 = 0.f;
#pragma unroll
        for (int i = 0; i < 8; ++i) { const float d = v[i] - mean; q2 += d * d; }
        const float rstd = rsqrtf(wsum(q2) * (1.0f / 512.0f) + EPS);
#pragma unroll
        for (int i = 0; i < 8; ++i) {
            const int c = l + 64 * i;
            const float y = (v[i] - mean) * rstd * lg[c] + lb[c];
            p.Y()[(size_t)(t0 + tt) * D + c] = f2bf(y * sigmoidf_(y));
        }
    }
    __syncthreads();
}

DEV void st_sgu(const P& p, int layer, int unit, char* smem) {
    const int n = unit >> 2, h = unit & 3, tid = tidx(), w = tid >> 6, l = tid & 63;
    float* stat = (float*)smem;
    float* wt = stat + 256;
    float* vt = wt + 16 * 132;
    const int tb = n * 128;
#pragma unroll 1
    for (int q = 0; q < 32; ++q) {
        const int j = w * 32 + q;
        const uint4 raw = *(const uint4*)(p.PROJ() + (size_t)(tb + j) * LDP + C_SV + l * 8);
        float v[8] = {lo2f(raw.x), hi2f(raw.x), lo2f(raw.y), hi2f(raw.y), lo2f(raw.z), hi2f(raw.z), lo2f(raw.w), hi2f(raw.w)};
        float s = 0.f;
#pragma unroll
        for (int i = 0; i < 8; ++i) s += v[i];
        const float mean = wsum(s) * (1.0f / 512.0f);
        float q2 = 0.f;
#pragma unroll
        for (int i = 0; i < 8; ++i) { const float d = v[i] - mean; q2 += d * d; }
        const float rstd = rsqrtf(wsum(q2) * (1.0f / 512.0f) + EPS);
        if (l == 0) { stat[j * 2] = mean; stat[j * 2 + 1] = rstd; }
    }
    __syncthreads();
    const int ti = tid >> 4, td = tid & 15;
    float acc[8][8];
#pragma unroll
    for (int a = 0; a < 8; ++a)
#pragma unroll
        for (int b = 0; b < 8; ++b) acc[a][b] = 0.f;
    const float* Wh = p.sgu_w + ((size_t)layer * 4 + h) * 128 * 128;
    const float* lg = p.sln_g + layer * 512 + h * 128; const float* lb = p.sln_b + layer * 512 + h * 128;
#pragma unroll 1
    for (int jc = 0; jc < 8; ++jc) {
#pragma unroll 2
        for (int q = 0; q < 8; ++q) {
            const int e = tid + 256 * q;
            { const int i = e >> 4, jj = e & 15, j = jc * 16 + jj; wt[jj * 132 + i] = (i >= j) ? Wh[i * 128 + j] : 0.f; }
            { const int jj = e >> 7, d = e & 127, j = jc * 16 + jj;
              const float x = bf2f(p.PROJ()[(size_t)(tb + j) * LDP + C_SV + h * 128 + d]);
              vt[jj * 128 + d] = (x - stat[j * 2]) * stat[j * 2 + 1] * lg[d] + lb[d]; }
        }
        __syncthreads();
        if (w * 32 + 31 >= jc * 16) {
#pragma unroll 2
            for (int jj = 0; jj < 16; ++jj) {
                const float4 w0 = *(const float4*)(wt + jj * 132 + ti * 8), w1 = *(const float4*)(wt + jj * 132 + ti * 8 + 4);
                const float4 v0 = *(const float4*)(vt + jj * 128 + td * 8), v1 = *(const float4*)(vt + jj * 128 + td * 8 + 4);
                const float wv[8] = {w0.x, w0.y, w0.z, w0.w, w1.x, w1.y, w1.z, w1.w};
                const float vv[8] = {v0.x, v0.y, v0.z, v0.w, v1.x, v1.y, v1.z, v1.w};
#pragma unroll
                for (int a = 0; a < 8; ++a)
#pragma unroll
                    for (int b = 0; b < 8; ++b) acc[a][b] += wv[a] * vv[b];
            }
        }
        __syncthreads();
    }
#pragma unroll
    for (int a = 0; a < 8; ++a) {
        const int i = ti * 8 + a; const size_t t = tb + i;
        const float bs = p.sgu_b[((size_t)layer * 4 + h) * 128 + i];
        const uint4 ur = *(const uint4*)(p.PROJ() + t * LDP + C_SU + h * 128 + td * 8);
        const float u[8] = {lo2f(ur.x), hi2f(ur.x), lo2f(ur.y), hi2f(ur.y), lo2f(ur.z), hi2f(ur.z), lo2f(ur.w), hi2f(ur.w)};
        float y[8];
#pragma unroll
        for (int b = 0; b < 8; ++b) y[b] = u[b] * (acc[a][b] + bs);
        uint4 o; o.x = pk2(y[0], y[1]); o.y = pk2(y[2], y[3]); o.z = pk2(y[4], y[5]); o.w = pk2(y[6], y[7]);
        *(uint4*)(p.Y() + t * D + 512 + h * 128 + td * 8) = o;
    }
}

DEV void st_vtrans(const P& p, int unit, char* smem) {
    bf16_t* tile = (bf16_t*)smem;
    const int which = unit & 1, tt0 = (unit >> 1) * 64, tid = tidx();
    const int col0 = which ? C_NVW : C_NVS;
    bf16_t* dst = which ? p.VWT() : p.VST();
#pragma unroll
    for (int q = 0; q < 4; ++q) {
        const int e = tid + 256 * q; const int r = e >> 4, c8 = e & 15;
        const uint4 raw = *(const uint4*)(p.PROJ() + (size_t)(tt0 + r) * LDP + col0 + c8 * 8);
        unsigned* d32 = (unsigned*)(tile + r * 130 + c8 * 8);
        d32[0] = raw.x; d32[1] = raw.y; d32[2] = raw.z; d32[3] = raw.w;
    }
    __syncthreads();
    const int d = tid >> 1, half = tid & 1;
    unsigned o[16];
#pragma unroll
    for (int i = 0; i < 16; ++i) {
        const unsigned a = tile[(half * 32 + 2 * i) * 130 + d], b = tile[(half * 32 + 2 * i + 1) * 130 + d];
        o[i] = a | (b << 16);
    }
    uint4* dp = (uint4*)(dst + (size_t)d * T + tt0 + half * 32);
#pragma unroll
    for (int i = 0; i < 4; ++i) dp[i] = make_uint4(o[4 * i], o[4 * i + 1], o[4 * i + 2], o[4 * i + 3]);
    __syncthreads();
}

DEV void st_prep(const P& p, int layer, int unit) {
    const int tid_ = tidx(); const int w = tid_ >> 6, l = tid_ & 63; const size_t t = (size_t)unit * 4 + w;
    const bf16_t* row = p.PROJ() + t * LDP;
    const float* rc = p.ropeC() + t * 24; const float* rs_ = p.ropeS() + t * 24;
    unsigned raw[11];
#pragma unroll
    for (int h = 0; h < 4; ++h) { raw[h] = *(const unsigned*)(row + C_NQ + h * 128 + 2 * l); raw[6 + h] = *(const unsigned*)(row + C_DQ + h * 128 + 2 * l); }
    raw[4] = *(const unsigned*)(row + C_NKS + 2 * l); raw[5] = *(const unsigned*)(row + C_NKW + 2 * l); raw[10] = *(const unsigned*)(row + C_DK + 2 * l);
    bf16_t iraw[9];
#pragma unroll
    for (int h = 0; h < 9; ++h) iraw[h] = row[(h < 8 ? C_IQ + h * 64 : C_IK) + l];
    const float gq0 = p.nsa_qg[layer * 128 + 2 * l], gq1 = p.nsa_qg[layer * 128 + 2 * l + 1];
    const float gs0 = p.nsa_kg[(layer * 3 + 1) * 128 + 2 * l], gs1 = p.nsa_kg[(layer * 3 + 1) * 128 + 2 * l + 1];
    const float gw0 = p.nsa_kg[(layer * 3 + 2) * 128 + 2 * l], gw1 = p.nsa_kg[(layer * 3 + 2) * 128 + 2 * l + 1];
    const float dq0 = p.dsa_qg[layer * 128 + 2 * l], dq1 = p.dsa_qg[layer * 128 + 2 * l + 1];
    const float dk0 = p.dsa_kg[layer * 128 + 2 * l], dk1 = p.dsa_kg[layer * 128 + 2 * l + 1];
    const float c0 = rc[(2 * l) & 15], c1 = rc[(2 * l + 1) & 15], s0 = rs_[(2 * l) & 15], s1 = rs_[(2 * l + 1) & 15];
    const float ic = rc[16 + (l & 7)], is = rs_[16 + (l & 7)];
    float x0[11], x1[11], ss[11];
#pragma unroll
    for (int h = 0; h < 11; ++h) { x0[h] = lo2f(raw[h]); x1[h] = hi2f(raw[h]); ss[h] = x0[h] * x0[h] + x1[h] * x1[h]; }
#pragma unroll
    for (int h = 0; h < 11; ++h) ss[h] = wsum(ss[h]);
#pragma unroll
    for (int h = 0; h < 11; ++h) {
        const float r = rsqrtf(ss[h] * (1.0f / 128.0f) + EPS);
        const float g0 = h < 4 ? gq0 : (h == 4 ? gs0 : (h == 5 ? gw0 : (h < 10 ? dq0 : dk0)));
        const float g1 = h < 4 ? gq1 : (h == 4 ? gs1 : (h == 5 ? gw1 : (h < 10 ? dq1 : dk1)));
        const float n0 = x0[h] * r * g0, n1 = x1[h] * r * g1;
        const float o0 = __shfl_xor(n0, 8), o1 = __shfl_xor(n1, 8);
        float r0 = n0, r1 = n1;
        if (l < 8) { r0 = n0 * c0 - o0 * s0; r1 = n1 * c1 - o1 * s1; }
        else if (l < 16) { r0 = n0 * c0 + o0 * s0; r1 = n1 * c1 + o1 * s1; }
        const unsigned roped = pk2(r0, r1);
        if (h < 4) { *(unsigned*)(p.QN() + (t * 4 + h) * 128 + 2 * l) = pk2(n0, n1); *(unsigned*)(p.QR() + (t * 4 + h) * 128 + 2 * l) = roped; }
        else if (h == 4) *(unsigned*)(p.KS() + t * 128 + 2 * l) = roped;
        else if (h == 5) *(unsigned*)(p.KW() + t * 128 + 2 * l) = roped;
        else if (h < 10) *(unsigned*)(p.DQ() + (t * 4 + (h - 6)) * 128 + 2 * l) = roped;
        else *(unsigned*)(p.DK() + t * 128 + 2 * l) = roped;
    }
    if (l < 12) p.GATES()[t * 12 + l] = sigmoidf_(bf2f(row[C_NG + l]));
#pragma unroll
    for (int h = 0; h < 9; ++h) {
        const float x = bf2f(iraw[h]);
        const float other = __shfl_xor(x, 8);
        float o = x;
        if (l < 16) o = (l < 8) ? (x * ic - other * is) : (x * ic + other * is);
        if (h < 8) p.IQ()[(t * 8 + h) * 64 + l] = f2bf(o); else p.IK()[t * 64 + l] = f2bf(o);
    }
    if (l < 8) p.IW()[t * 8 + l] = bf2f(row[C_IW + l]) * (0.35355339059327373f * 0.125f);
}

DEV void st_compress(const P& p, int layer, int unit, char* smem) {
    const int which = unit & 1, rt = unit >> 1, tid = tidx(), w = tid >> 6, l = tid & 63, fr = l & 15, fq = l >> 4;
    float* hid = (float*)smem;
    float* ob = hid + 16 * 128;
    const int nb = rt * 16 + fr;
    const int col0 = which ? C_NVC : C_NKC;
    const float* ps = p.cmp_pos + ((size_t)layer * 2 + which) * 4096;
    const bf16_t* w1t = p.W1T() + ((size_t)layer * 2 + which) * 128 * 4096;
    const bool rowok = nb < 511;
    const bf16_t* xrow = p.PROJ() + (size_t)(rowok ? nb * 16 : 0) * LDP + col0;
    f32x4 acc[2] = {(f32x4){0.f, 0.f, 0.f, 0.f}, (f32x4){0.f, 0.f, 0.f, 0.f}};
#pragma unroll 4
    for (int ks = 0; ks < 128; ++ks) {
        const int k = ks * 32 + fq * 8, lt = k >> 7, d = k & 127;
        const uint4 xr = *(const uint4*)(xrow + (size_t)lt * LDP + d);
        const float4 p0 = *(const float4*)(ps + k), p1 = *(const float4*)(ps + k + 4);
        union { bf16x8 v; unsigned u32[4]; } a;
        a.u32[0] = pk2(lo2f(xr.x) + p0.x, hi2f(xr.x) + p0.y); a.u32[1] = pk2(lo2f(xr.y) + p0.z, hi2f(xr.y) + p0.w);
        a.u32[2] = pk2(lo2f(xr.z) + p1.x, hi2f(xr.z) + p1.y); a.u32[3] = pk2(lo2f(xr.w) + p1.z, hi2f(xr.w) + p1.w);
#pragma unroll
        for (int nt = 0; nt < 2; ++nt) {
            const bf16x8 b = *(const bf16x8*)(w1t + (size_t)(w * 32 + nt * 16 + fr) * 4096 + k);
            acc[nt] = mfma16(a.v, b, acc[nt]);
        }
    }
#pragma unroll
    for (int nt = 0; nt < 2; ++nt)
#pragma unroll
        for (int r = 0; r < 4; ++r) hid[(4 * fq + r) * 128 + w * 32 + nt * 16 + fr] = gelu_tanh(acc[nt][r]);
    __syncthreads();
    const float* w2 = p.cmp_w2 + ((size_t)layer * 2 + which) * 128 * 128;
    const int c2 = tid & 127, mh = tid >> 7;
    float o[8];
#pragma unroll
    for (int b = 0; b < 8; ++b) o[b] = 0.f;
#pragma unroll 4
    for (int k = 0; k < 128; ++k) {
        const float wv = w2[k * 128 + c2];
#pragma unroll
        for (int b = 0; b < 8; ++b) o[b] += hid[(mh * 8 + b) * 128 + k] * wv;
    }
#pragma unroll
    for (int b = 0; b < 8; ++b) ob[(mh * 8 + b) * 128 + c2] = o[b];
    __syncthreads();
#pragma unroll
    for (int q = 0; q < 4; ++q) {
        const int b = w * 4 + q, nbo = rt * 16 + b;
        float v0 = ob[b * 128 + l], v1 = ob[b * 128 + l + 64];
        if (which == 0) {
            const float r = rsqrtf(wsum(v0 * v0 + v1 * v1) * (1.0f / 128.0f) + EPS);
            const float* kg = p.nsa_kg + (layer * 3 + 0) * 128;
            v0 = v0 * r * kg[l]; v1 = v1 * r * kg[l + 64];
            if (nbo >= 511) { v0 = 0.f; v1 = 0.f; }
            p.KC()[nbo * 128 + l] = f2bf(v0); p.KC()[nbo * 128 + l + 64] = f2bf(v1);
        } else {
            if (nbo >= 511) { v0 = 0.f; v1 = 0.f; }
            p.VCT()[l * 512 + nbo] = f2bf(v0); p.VCT()[(l + 64) * 512 + nbo] = f2bf(v1);
        }
    }
    __syncthreads();
}

DEV void st_nsa_cmp(const P& p, int unit, char* smem) {
    constexpr int RSK = 272, RSV = 136, BUFB = 64 * RSK + 128 * RSV;
    const int tid = tidx(), w = tid >> 6, l = tid & 63, qc = l & 15, g4 = l >> 4;
    const int t0 = unit * 16 + w * 4;
    const int tk = qc >> 2, hd = qc & 3, t = t0 + tk;
    bf16x8 qf[4];
#pragma unroll
    for (int ks = 0; ks < 4; ++ks) qf[ks] = *(const bf16x8*)(p.QN() + ((size_t)t0 * 4 + qc) * 128 + ks * 32 + g4 * 8);
    const int tmaxb = unit * 16 + 15;
    const int nvb = tmaxb >= 31 ? (tmaxb - 31) / 16 + 1 : 0;
    const int nsteps = (nvb + 63) >> 6;
    const int nvis = t >= 31 ? (t - 31) / 16 + 1 : 0;
    const float cs = 0.08838834764831845f * 1.4426950408889634f;
    const int krow = tid >> 4, kc16 = tid & 15, vrow = tid >> 3, vc16 = tid & 7;
    const bf16_t* Kg = p.KC(); const bf16_t* Vg = p.VCT();
    int gstep = 0;
    uint4 rk0, rk1, rk2, rk3, rv0, rv1, rv2, rv3;
#define CMP_LOADK(ST) do { const bf16_t* kb = Kg + (size_t)((ST) * 64 + krow) * 128 + kc16 * 8; \
        rk0 = *(const uint4*)kb; rk1 = *(const uint4*)(kb + 16 * 128); rk2 = *(const uint4*)(kb + 32 * 128); rk3 = *(const uint4*)(kb + 48 * 128); } while (0)
#define CMP_LOADV(ST) do { const bf16_t* vb = Vg + (size_t)vrow * 512 + (ST) * 64 + vc16 * 8; \
        rv0 = *(const uint4*)vb; rv1 = *(const uint4*)(vb + 32 * 512); rv2 = *(const uint4*)(vb + 64 * 512); rv3 = *(const uint4*)(vb + 96 * 512); } while (0)
#define CMP_STOREK(KT) do { *(uint4*)((KT) + krow * RSK + kc16 * 16) = rk0; *(uint4*)((KT) + (krow + 16) * RSK + kc16 * 16) = rk1; \
        *(uint4*)((KT) + (krow + 32) * RSK + kc16 * 16) = rk2; *(uint4*)((KT) + (krow + 48) * RSK + kc16 * 16) = rk3; } while (0)
#define CMP_STOREV(VT) do { *(uint4*)((VT) + vrow * RSV + vc16 * 16) = rv0; *(uint4*)((VT) + (vrow + 32) * RSV + vc16 * 16) = rv1; \
        *(uint4*)((VT) + (vrow + 64) * RSV + vc16 * 16) = rv2; *(uint4*)((VT) + (vrow + 96) * RSV + vc16 * 16) = rv3; } while (0)
    float m = -1e30f, lsum = 0.f;
    if (nsteps > 0) CMP_LOADK(0);
#pragma unroll 1
    for (int st = 0; st < nsteps; ++st, ++gstep) {
        char* Kt = smem + (gstep & 1) * BUFB;
        CMP_STOREK(Kt);
        __syncthreads();
        if (st + 1 < nsteps) CMP_LOADK(st + 1);
        float mx = m; f32x4 sv[4];
#pragma unroll
        for (int sub = 0; sub < 4; ++sub) {
            f32x4 a4 = (f32x4){0.f, 0.f, 0.f, 0.f};
#pragma unroll
            for (int ks = 0; ks < 4; ++ks) a4 = mfma16(*(const bf16x8*)(Kt + (sub * 16 + qc) * RSK + (ks * 32 + g4 * 8) * 2), qf[ks], a4);
#pragma unroll
            for (int r = 0; r < 4; ++r) { const int key = st * 64 + sub * 16 + 4 * g4 + r; a4[r] = (key < nvis) ? a4[r] * cs : -3e38f; mx = fmaxf(mx, a4[r]); }
            sv[sub] = a4;
        }
        float ps = 0.f;
#pragma unroll
        for (int sub = 0; sub < 4; ++sub)
#pragma unroll
            for (int r = 0; r < 4; ++r) ps += __builtin_amdgcn_exp2f(sv[sub][r] - mx);
        lsum = lsum * __builtin_amdgcn_exp2f(m - mx) + ps; m = mx;
    }
    {
        float mt_ = fmaxf(m, __shfl_xor(m, 16)); mt_ = fmaxf(mt_, __shfl_xor(mt_, 32));
        lsum *= __builtin_amdgcn_exp2f(m - mt_); m = mt_;
        lsum += __shfl_xor(lsum, 16); lsum += __shfl_xor(lsum, 32);
    }
    const float inv = (nvis > 0 && lsum > 0.f) ? 1.0f / lsum : 0.f;
    f32x4 o[8];
#pragma unroll
    for (int mt = 0; mt < 8; ++mt) o[mt] = (f32x4){0.f, 0.f, 0.f, 0.f};
    float yprev = 0.f;
    float impv[32];
#pragma unroll
    for (int i = 0; i < 32; ++i) impv[i] = 0.f;
    if (nsteps > 0) { CMP_LOADK(0); CMP_LOADV(0); }
#pragma unroll
    for (int st = 0; st < 8; ++st) {
        if (st < nsteps) {
            char* Kt = smem + (gstep & 1) * BUFB; char* Vt = Kt + 64 * RSK; ++gstep;
            CMP_STOREK(Kt); CMP_STOREV(Vt);
            __syncthreads();
            if (st + 1 < nsteps) { CMP_LOADK(st + 1); CMP_LOADV(st + 1); }
            f32x4 sv[4];
#pragma unroll
            for (int sub = 0; sub < 4; ++sub) {
                f32x4 a4 = (f32x4){0.f, 0.f, 0.f, 0.f};
#pragma unroll
                for (int ks = 0; ks < 4; ++ks) a4 = mfma16(*(const bf16x8*)(Kt + (sub * 16 + qc) * RSK + (ks * 32 + g4 * 8) * 2), qf[ks], a4);
#pragma unroll
                for (int r = 0; r < 4; ++r) { const int key = st * 64 + sub * 16 + 4 * g4 + r; a4[r] = (key < nvis) ? __builtin_amdgcn_exp2f(a4[r] * cs - m) * inv : 0.f; }
                const float y = __shfl(a4[3], (l + 48) & 63);
                float iv = (a4[0] + a4[1]) + (a4[2] + a4[3]) + (g4 > 0 ? y : yprev);
                yprev = y;
                iv += __shfl_xor(iv, 1); iv += __shfl_xor(iv, 2);
                impv[st * 4 + sub] = iv;
                sv[sub] = a4;
            }
#pragma unroll
            for (int pr = 0; pr < 2; ++pr) {
                union { bf16x8 v; unsigned u32[4]; } bb;
                bb.u32[0] = pk2(sv[2 * pr][0], sv[2 * pr][1]); bb.u32[1] = pk2(sv[2 * pr][2], sv[2 * pr][3]);
                bb.u32[2] = pk2(sv[2 * pr + 1][0], sv[2 * pr + 1][1]); bb.u32[3] = pk2(sv[2 * pr + 1][2], sv[2 * pr + 1][3]);
#pragma unroll
                for (int mt = 0; mt < 8; ++mt) {
                    const char* vp = Vt + (mt * 16 + qc) * RSV + (pr * 32 + 4 * g4) * 2;
                    union { bf16x8 v; uint2 h2[2]; } aa;
                    aa.h2[0] = *(const uint2*)vp; aa.h2[1] = *(const uint2*)(vp + 32);
                    o[mt] = mfma16(aa.v, bb.v, o[mt]);
                }
            }
        }
    }
#undef CMP_LOADK
#undef CMP_LOADV
#undef CMP_STOREK
#undef CMP_STOREV
    __syncthreads();
    float* impl = (float*)smem + w * 512;
    if (hd == 0) {
#pragma unroll
        for (int i = 0; i < 32; ++i) impl[tk * 128 + 4 * i + g4] = impv[i];
    }
#pragma unroll
    for (int mt = 0; mt < 8; ++mt) {
        uint2 ov; ov.x = pk2(o[mt][0], o[mt][1]); ov.y = pk2(o[mt][2], o[mt][3]);
        *(uint2*)(p.OCMP() + ((size_t)t * 4 + hd) * 128 + mt * 16 + 4 * g4) = ov;
    }
    __syncthreads();
    const int li = hd + 4 * g4, cur = t >> 6;
    unsigned long long own[8]; int rank[8];
#pragma unroll
    for (int i = 0; i < 8; ++i) {
        const int j = li + 16 * i; const float v = impl[tk * 128 + j];
        const unsigned k32 = (j == 0 || j == cur || j == cur - 1) ? 0xFFFFFFFFu : (j > cur ? 0u : __float_as_uint(v) + 128u);
        own[i] = ((unsigned long long)k32 << 7) | (unsigned)(127 - j); rank[i] = 0;
    }
#pragma unroll 1
    for (int ip = 0; ip < 8; ++ip) {
#pragma unroll
        for (int q4 = 0; q4 < 4; ++q4) {
            const float4 ov = *(const float4*)(impl + tk * 128 + ip * 16 + q4 * 4);
            const float o4[4] = {ov.x, ov.y, ov.z, ov.w};
#pragma unroll
            for (int e = 0; e < 4; ++e) {
                const int jp = ip * 16 + q4 * 4 + e;
                const unsigned k32 = (jp == 0 || jp == cur || jp == cur - 1) ? 0xFFFFFFFFu : (jp > cur ? 0u : __float_as_uint(o4[e]) + 128u);
                const unsigned long long kp = ((unsigned long long)k32 << 7) | (unsigned)(127 - jp);
#pragma unroll
                for (int i = 0; i < 8; ++i) rank[i] += (kp > own[i]) ? 1 : 0;
            }
        }
    }
    unsigned mw[4] = {0u, 0u, 0u, 0u};
#pragma unroll
    for (int i = 0; i < 8; ++i) if (rank[i] < 16) mw[i >> 1] |= 1u << (li + 16 * (i & 1));
#pragma unroll
    for (int q = 0; q < 4; ++q) {
        unsigned v = mw[q];
        v |= __shfl_xor(v, 1); v |= __shfl_xor(v, 2); v |= __shfl_xor(v, 16); v |= __shfl_xor(v, 32);
        mw[q] = v;
    }
    if (li == 0) *(uint4*)(p.SEL() + (size_t)t * 4) = make_uint4(mw[0], mw[1], mw[2], mw[3]);
    __syncthreads();
}

DEV void st_nsa_attn(const P& p, int unit, char* smem) {
    constexpr int RSK = 272, RSV = 136, BUFB = 64 * RSK + 128 * RSV;
    const int tid = tidx(), w = tid >> 6, l = tid & 63, qc = l & 15, g4 = l >> 4;
    const int tq0 = unit * 16, t = tq0 + w * 4 + (qc >> 2), hd = qc & 3;
    bf16x8 qf[4];
#pragma unroll
    for (int ks = 0; ks < 4; ++ks) qf[ks] = *(const bf16x8*)(p.QR() + ((size_t)t * 4 + hd) * 128 + ks * 32 + g4 * 8);
    const uint4 selw = *(const uint4*)(p.SEL() + (size_t)t * 4);
    const float cs = 0.08838834764831845f * 1.4426950408889634f;
    unsigned part[8][2];
#pragma unroll
    for (int mt = 0; mt < 8; ++mt) { part[mt][0] = 0u; part[mt][1] = 0u; }
    const float g0 = p.GATES()[(size_t)t * 12 + hd * 3];
    int gstep = 0;
    const int krow = tid >> 4, kc16 = tid & 15, vrow = tid >> 3, vc16 = tid & 7;
#pragma unroll 1
    for (int br = 0; br < 2; ++br) {
        const bf16_t* Kg = br ? p.KW() : p.KS(); const bf16_t* Vg = br ? p.VWT() : p.VST();
        const int ktlast = (tq0 + 15) >> 6;
        const int ktfirst = br ? ((tq0 - 511 > 0 ? tq0 - 511 : 0) >> 6) : 0;
        const int nk = ktlast - ktfirst + 1;
        f32x4 o[8];
#pragma unroll
        for (int mt = 0; mt < 8; ++mt) o[mt] = (f32x4){0.f, 0.f, 0.f, 0.f};
        float m = -1e30f, lsum = 0.f;
        uint4 rk0, rk1, rk2, rk3, rv0, rv1, rv2, rv3;
#define NSA_LOAD(KT) do { const bf16_t* kb = Kg + (size_t)((KT) * 64 + krow) * 128 + kc16 * 8; const bf16_t* vb = Vg + (size_t)vrow * T + (KT) * 64 + vc16 * 8; \
        rk0 = *(const uint4*)kb; rk1 = *(const uint4*)(kb + 16 * 128); rk2 = *(const uint4*)(kb + 32 * 128); rk3 = *(const uint4*)(kb + 48 * 128); \
        rv0 = *(const uint4*)vb; rv1 = *(const uint4*)(vb + (size_t)32 * T); rv2 = *(const uint4*)(vb + (size_t)64 * T); rv3 = *(const uint4*)(vb + (size_t)96 * T); } while (0)
        NSA_LOAD(ktfirst);
#pragma unroll 1
        for (int i = 0; i < nk; ++i, ++gstep) {
            const int kt = ktfirst + i;
            char* Kt = smem + (gstep & 1) * BUFB; char* Vt = Kt + 64 * RSK;
            *(uint4*)(Kt + krow * RSK + kc16 * 16) = rk0; *(uint4*)(Kt + (krow + 16) * RSK + kc16 * 16) = rk1;
            *(uint4*)(Kt + (krow + 32) * RSK + kc16 * 16) = rk2; *(uint4*)(Kt + (krow + 48) * RSK + kc16 * 16) = rk3;
            *(uint4*)(Vt + vrow * RSV + vc16 * 16) = rv0; *(uint4*)(Vt + (vrow + 32) * RSV + vc16 * 16) = rv1;
            *(uint4*)(Vt + (vrow + 64) * RSV + vc16 * 16) = rv2; *(uint4*)(Vt + (vrow + 96) * RSV + vc16 * 16) = rv3;
            __syncthreads();
            if (i + 1 < nk) NSA_LOAD(kt + 1);
            int lo, hi = t;
            if (br == 0) {
                const unsigned wv = (kt & 64) ? ((kt & 32) ? selw.w : selw.z) : ((kt & 32) ? selw.y : selw.x);
                lo = 0; hi = ((wv >> (kt & 31)) & 1u) ? t : -1;
            } else lo = t - 511;
            const bool interior = (kt * 64 + 63 <= tq0) && (br == 0 || kt * 64 >= tq0 + 15 - 511);
            f32x4 sv[4];
            float mx = -3e38f;
            if (interior) {
                const float csl = hi >= 0 ? cs : 0.f, add = hi >= 0 ? 0.f : -3e38f;
#pragma unroll
                for (int sub = 0; sub < 4; ++sub) {
                    f32x4 a4 = (f32x4){0.f, 0.f, 0.f, 0.f};
#pragma unroll
                    for (int ks = 0; ks < 4; ++ks) a4 = mfma16(*(const bf16x8*)(Kt + (sub * 16 + qc) * RSK + (ks * 32 + g4 * 8) * 2), qf[ks], a4);
#pragma unroll
                    for (int r = 0; r < 4; ++r) { a4[r] = a4[r] * csl + add; mx = fmaxf(mx, a4[r]); }
                    sv[sub] = a4;
                }
            } else {
#pragma unroll
                for (int sub = 0; sub < 4; ++sub) {
                    f32x4 a4 = (f32x4){0.f, 0.f, 0.f, 0.f};
#pragma unroll
                    for (int ks = 0; ks < 4; ++ks) a4 = mfma16(*(const bf16x8*)(Kt + (sub * 16 + qc) * RSK + (ks * 32 + g4 * 8) * 2), qf[ks], a4);
#pragma unroll
                    for (int r = 0; r < 4; ++r) {
                        const int kp = kt * 64 + sub * 16 + 4 * g4 + r;
                        const bool valid = (kp >= lo) & (kp <= hi);
                        a4[r] = valid ? a4[r] * cs : -3e38f;
                        mx = fmaxf(mx, a4[r]);
                    }
                    sv[sub] = a4;
                }
            }
            mx = fmaxf(mx, __shfl_xor(mx, 16)); mx = fmaxf(mx, __shfl_xor(mx, 32));
            const float mnew = fmaxf(fmaxf(m, mx), -1e30f);
            const float alpha = __builtin_amdgcn_exp2f(m - mnew);
            m = mnew;
            float ps = 0.f;
#pragma unroll
            for (int sub = 0; sub < 4; ++sub)
#pragma unroll
                for (int r = 0; r < 4; ++r) { const float pv = __builtin_amdgcn_exp2f(sv[sub][r] - mnew); sv[sub][r] = pv; ps += pv; }
            lsum = lsum * alpha + ps;
            if (__any(alpha != 1.0f)) {
#pragma unroll
                for (int mt = 0; mt < 8; ++mt) o[mt] *= alpha;
            }
#pragma unroll
            for (int pr = 0; pr < 2; ++pr) {
                union { bf16x8 v; unsigned u32[4]; } bb;
                bb.u32[0] = pk2(sv[2 * pr][0], sv[2 * pr][1]); bb.u32[1] = pk2(sv[2 * pr][2], sv[2 * pr][3]);
                bb.u32[2] = pk2(sv[2 * pr + 1][0], sv[2 * pr + 1][1]); bb.u32[3] = pk2(sv[2 * pr + 1][2], sv[2 * pr + 1][3]);
#pragma unroll
                for (int mt = 0; mt < 8; ++mt) {
                    const char* vp = Vt + (mt * 16 + qc) * RSV + (pr * 32 + 4 * g4) * 2;
                    union { bf16x8 v; uint2 h2[2]; } aa;
                    aa.h2[0] = *(const uint2*)vp; aa.h2[1] = *(const uint2*)(vp + 32);
                    o[mt] = mfma16(aa.v, bb.v, o[mt]);
                }
            }
        }
#undef NSA_LOAD
        lsum += __shfl_xor(lsum, 16); lsum += __shfl_xor(lsum, 32);
        const float gate = p.GATES()[(size_t)t * 12 + hd * 3 + 1 + br];
        const float sc = lsum > 0.f ? gate / lsum : 0.f;
        if (br == 0) {
#pragma unroll
            for (int mt = 0; mt < 8; ++mt) {
                const uint2 oc = *(const uint2*)(p.OCMP() + ((size_t)t * 4 + hd) * 128 + mt * 16 + 4 * g4);
                part[mt][0] = pk2(sc * o[mt][0] + g0 * lo2f(oc.x), sc * o[mt][1] + g0 * hi2f(oc.x));
                part[mt][1] = pk2(sc * o[mt][2] + g0 * lo2f(oc.y), sc * o[mt][3] + g0 * hi2f(oc.y));
            }
        } else {
#pragma unroll
            for (int mt = 0; mt < 8; ++mt) {
                uint2 ov;
                ov.x = pk2(sc * o[mt][0] + lo2f(part[mt][0]), sc * o[mt][1] + hi2f(part[mt][0]));
                ov.y = pk2(sc * o[mt][2] + lo2f(part[mt][1]), sc * o[mt][3] + hi2f(part[mt][1]));
                *(uint2*)(p.Y() + (size_t)t * D + 1024 + hd * 128 + mt * 16 + 4 * g4) = ov;
            }
        }
    }
    __syncthreads();
}

DEV unsigned f2key(float f) { const unsigned u = __float_as_uint(f); return (u & 0x80000000u) ? ~u : (u | 0x80000000u); }
DEV float key2f(unsigned k) { const unsigned u = (k & 0x80000000u) ? (k & 0x7fffffffu) : ~k; return __uint_as_float(u); }
DEV float wave_prune(float* sc, unsigned short* ix, unsigned* hist, int m, int l) {
    float v[8]; unsigned k[8]; unsigned short id[8]; bool ok[8];
#pragma unroll
    for (int i = 0; i < 8; ++i) {
        const int e = l + 64 * i; ok[i] = e < m;
        v[i] = ok[i] ? sc[e] : 0.f; id[i] = ok[i] ? ix[e] : (unsigned short)0; k[i] = f2key(v[i]);
    }
    unsigned prefix = 0u; int need = 256;
#pragma unroll 1
    for (int pass = 0; pass < 4; ++pass) {
        const int shift = 24 - 8 * pass;
        *(uint4*)(hist + 4 * l) = make_uint4(0u, 0u, 0u, 0u);
        __builtin_amdgcn_wave_barrier();
#pragma unroll
        for (int i = 0; i < 8; ++i) {
            const bool in = ok[i] && (pass == 0 || (k[i] >> (shift + 8)) == prefix);
            if (in) atomicAdd(&hist[(k[i] >> shift) & 255u], 1u);
        }
        __builtin_amdgcn_wave_barrier();
        const uint4 hv = *(const uint4*)(hist + 4 * l);
        const unsigned hq[4] = {hv.x, hv.y, hv.z, hv.w};
        const unsigned own = hv.x + hv.y + hv.z + hv.w;
        unsigned tot = own;
#pragma unroll
        for (int o = 1; o < 64; o <<= 1) { const unsigned tv = __shfl_down(tot, o); if (l + o < 64) tot += tv; }
        unsigned cum = tot - own; int found = -1; int nneed = 0;
#pragma unroll
        for (int kk = 3; kk >= 0; --kk) {
            const unsigned c = hq[kk];
            if (found < 0 && (int)cum < need && (int)(cum + c) >= need) { found = 4 * l + kk; nneed = need - (int)cum; }
            cum += c;
        }
        const unsigned long long bal = __ballot(found >= 0);
        const int src = __ffsll((long long)bal) - 1;
        const int digit = __shfl(found, src); need = __shfl(nneed, src);
        prefix = (prefix << 8) | (unsigned)digit;
    }
    const unsigned thr = prefix;
    int base = 0, ties = 0;
    const unsigned long long ltmask = (1ull << l) - 1ull;
#pragma unroll
    for (int i = 0; i < 8; ++i) {
        const bool gt = ok[i] && k[i] > thr, eq = ok[i] && k[i] == thr;
        const unsigned long long em = __ballot(eq);
        const int trank = ties + __popcll(em & ltmask);
        const bool keep = gt || (eq && trank < need);
        ties += __popcll(em);
        const unsigned long long km = __ballot(keep);
        const int pos = base + __popcll(km & ltmask);
        if (keep) { sc[pos] = v[i]; ix[pos] = id[i]; }
        base += __popcll(km);
    }
    __builtin_amdgcn_wave_barrier();
    return key2f(thr);
}

#define DSA_APPEND2(COND, M64, SV, SCP, IXP, CL, CH) do { \
    const unsigned _ml = (unsigned)(M64), _mh = (unsigned)((M64) >> 32); \
    if (COND) { const int _pos = (h ? (CH) : (CL)) + __popc((h ? _mh : _ml) & ((1u << n) - 1u)); (SCP)[_pos] = (SV); (IXP)[_pos] = (unsigned short)kp; } \
    (CL) += __popc(_ml); (CH) += __popc(_mh); } while (0)
#define DSA_APPEND(SCP, IXP, CNT, M32, MINE, SV) do { \
    const unsigned _m = (M32); \
    if (MINE) { const int _pos = (CNT) + __popc(_m & ((1u << n) - 1u)); (SCP)[_pos] = (SV); (IXP)[_pos] = (unsigned short)kp; } \
    (CNT) += __popc(_m); } while (0)

DEV void st_dsa_index(const P& p, int unit, char* smem) {
    const int tid = tidx(), w = tid >> 6, l = tid & 63, n = l & 31, h = l >> 5;
    char* wb = smem + w * 14336;
    float* sc0 = (float*)wb; float* sc1 = sc0 + 512; float* sc2 = sc1 + 512; float* sc3 = sc2 + 512;
    unsigned short* ix0 = (unsigned short*)(wb + 8192); unsigned short* ix1 = ix0 + 512; unsigned short* ix2 = ix1 + 512; unsigned short* ix3 = ix2 + 512;
    unsigned* hist = (unsigned*)(wb + 12288);
    float* scA = h ? sc2 : sc0; float* scB = h ? sc3 : sc1; unsigned short* ixA = h ? ix2 : ix0; unsigned short* ixB = h ? ix3 : ix1;
    const int wu = unit * 4 + w;
    const int tg = (wu & 1) ? (2047 - (wu >> 1)) : (wu >> 1);
    const int t0 = tg * 4;
    const int tl = 2 * ((n >> 2) & 1) + (n >> 4), hdr = (n & 3) + 4 * ((n >> 3) & 1);
    bf16x8 af[4];
#pragma unroll
    for (int s = 0; s < 4; ++s) af[s] = *(const bf16x8*)(p.IQ() + ((size_t)(t0 + tl) * 8 + hdr) * 64 + 16 * s + 8 * h);
    const int tA = t0 + 2 * h, tB = tA + 1;
    float wA[8], wB[8];
#pragma unroll
    for (int r = 0; r < 8; ++r) { wA[r] = p.IW()[(size_t)tA * 8 + r]; wB[r] = p.IW()[(size_t)tB * 8 + r]; }
    int cnt0 = 0, cnt1 = 0, cnt2 = 0, cnt3 = 0;
    const float NINF = -__builtin_inff();
    float tau0 = NINF, tau1 = NINF, tau2 = NINF, tau3 = NINF;
    const int ntiles = (t0 + 3) / 32 + 1;
    const bf16_t* ikp = p.IK() + (size_t)n * 64 + 8 * h;
    bf16x8 na[4], nb[4];
#pragma unroll
    for (int s = 0; s < 4; ++s) { na[s] = *(const bf16x8*)(ikp + 16 * s); nb[s] = *(const bf16x8*)(ikp + (size_t)(ntiles > 1 ? 32 : 0) * 64 + 16 * s); }
#pragma unroll 1
    for (int kt = 0; kt < ntiles; kt += 2) {
        bf16x8 ca[4], cb[4];
#pragma unroll
        for (int s = 0; s < 4; ++s) { ca[s] = na[s]; cb[s] = nb[s]; }
        {
            const int ka = kt + 2 < ntiles ? kt + 2 : ntiles - 1, kb = kt + 3 < ntiles ? kt + 3 : ntiles - 1;
#pragma unroll
            for (int s = 0; s < 4; ++s) { na[s] = *(const bf16x8*)(ikp + (size_t)ka * 32 * 64 + 16 * s); nb[s] = *(const bf16x8*)(ikp + (size_t)kb * 32 * 64 + 16 * s); }
        }
        f32x16 acca, accb;
#pragma unroll
        for (int r = 0; r < 16; ++r) { acca[r] = 0.f; accb[r] = 0.f; }
#pragma unroll
        for (int s = 0; s < 4; ++s) { acca = mfma32(af[s], ca[s], acca); accb = mfma32(af[s], cb[s], accb); }
        float s0a = 0.f, s1a = 0.f, s0b = 0.f, s1b = 0.f, u0a = 0.f, u1a = 0.f, u0b = 0.f, u1b = 0.f;
#pragma unroll
        for (int r = 0; r < 4; ++r) {
            s0a += wA[r] * fmaxf(acca[r], 0.f); u0a += wA[4 + r] * fmaxf(acca[4 + r], 0.f);
            s1a += wB[r] * fmaxf(acca[8 + r], 0.f); u1a += wB[4 + r] * fmaxf(acca[12 + r], 0.f);
            s0b += wA[r] * fmaxf(accb[r], 0.f); u0b += wA[4 + r] * fmaxf(accb[4 + r], 0.f);
            s1b += wB[r] * fmaxf(accb[8 + r], 0.f); u1b += wB[4 + r] * fmaxf(accb[12 + r], 0.f);
        }
        s0a += u0a; s1a += u1a; s0b += u0b; s1b += u1b;
        const float tauA = h ? tau2 : tau0, tauB = h ? tau3 : tau1;
        {
            const int kp = kt * 32 + n;
            const bool cA = (kp <= tA) && (s0a > tauA), cB = (kp <= tB) && (s1a > tauB);
            const unsigned long long mA = __ballot(cA), mB = __ballot(cB);
            DSA_APPEND2(cA, mA, s0a, scA, ixA, cnt0, cnt2); DSA_APPEND2(cB, mB, s1a, scB, ixB, cnt1, cnt3);
        }
        {
            const int kp = kt * 32 + 32 + n;
            const bool cA = (kp <= tA) && (s0b > tauA), cB = (kp <= tB) && (s1b > tauB);
            const unsigned long long mA = __ballot(cA), mB = __ballot(cB);
            DSA_APPEND2(cA, mA, s0b, scA, ixA, cnt0, cnt2); DSA_APPEND2(cB, mB, s1b, scB, ixB, cnt1, cnt3);
        }
        __builtin_amdgcn_wave_barrier();
        if (max(max(cnt0, cnt1), max(cnt2, cnt3)) > 448) {
            if (cnt0 > 448) { tau0 = wave_prune(sc0, ix0, hist, cnt0, l); cnt0 = 256; }
            if (cnt1 > 448) { tau1 = wave_prune(sc1, ix1, hist, cnt1, l); cnt1 = 256; }
            if (cnt2 > 448) { tau2 = wave_prune(sc2, ix2, hist, cnt2, l); cnt2 = 256; }
            if (cnt3 > 448) { tau3 = wave_prune(sc3, ix3, hist, cnt3, l); cnt3 = 256; }
        }
    }
    if (cnt0 > 256) { wave_prune(sc0, ix0, hist, cnt0, l); cnt0 = 256; }
    if (cnt1 > 256) { wave_prune(sc1, ix1, hist, cnt1, l); cnt1 = 256; }
    if (cnt2 > 256) { wave_prune(sc2, ix2, hist, cnt2, l); cnt2 = 256; }
    if (cnt3 > 256) { wave_prune(sc3, ix3, hist, cnt3, l); cnt3 = 256; }
    __builtin_amdgcn_wave_barrier();
#pragma unroll
    for (int i = 0; i < 4; ++i) {
        const int e = l + 64 * i;
        p.IDX()[(size_t)(t0 + 0) * 256 + e] = e < cnt0 ? (int)ix0[e] : 0;
        p.IDX()[(size_t)(t0 + 1) * 256 + e] = e < cnt1 ? (int)ix1[e] : 0;
        p.IDX()[(size_t)(t0 + 2) * 256 + e] = e < cnt2 ? (int)ix2[e] : 0;
        p.IDX()[(size_t)(t0 + 3) * 256 + e] = e < cnt3 ? (int)ix3[e] : 0;
    }
    if (l == 0) { p.CNT()[t0] = cnt0; p.CNT()[t0 + 1] = cnt1; p.CNT()[t0 + 2] = cnt2; p.CNT()[t0 + 3] = cnt3; }
}

DEV void st_dsa_attn(const P& p, int unit, char* smem) {
    const int tid = tidx(), w = tid >> 6, l = tid & 63, c = l & 15, g4 = l >> 4;
    int* idxs = (int*)(smem + w * 5120); float* Pl = (float*)(smem + w * 5120 + 1024);
    const size_t t = (size_t)unit * 4 + w;
    const int cnt = p.CNT()[t];
#pragma unroll
    for (int i = 0; i < 4; ++i) idxs[l + 64 * i] = p.IDX()[t * 256 + l + 64 * i];
    __builtin_amdgcn_wave_barrier();
    bf16x8 qf[4];
#pragma unroll
    for (int j = 0; j < 4; ++j) qf[j] = *(const bf16x8*)(p.DQ() + (t * 4 + (c & 3)) * 128 + g4 * 32 + j * 8);
    f32x4 s[16];
    const int ntile = (cnt + 15) >> 4;
#pragma unroll
    for (int tq = 0; tq < 4; ++tq) {
        bf16x8 kf[4][4];
        if (tq * 4 < ntile) {
#pragma unroll
            for (int q = 0; q < 4; ++q) {
                const int krow = idxs[(tq * 4 + q) * 16 + c];
                const bf16_t* kp = p.DK() + (size_t)krow * 128 + g4 * 32;
#pragma unroll
                for (int j = 0; j < 4; ++j) kf[q][j] = *(const bf16x8*)(kp + j * 8);
            }
        }
#pragma unroll
        for (int q = 0; q < 4; ++q) {
            s[tq * 4 + q] = (f32x4){0.f, 0.f, 0.f, 0.f};
            if (tq * 4 < ntile) {
#pragma unroll
                for (int j = 0; j < 4; ++j) s[tq * 4 + q] = mfma16(kf[q][j], qf[j], s[tq * 4 + q]);
            }
        }
        __builtin_amdgcn_sched_barrier(0);
    }
    const float cs = 0.08838834764831845f * 1.4426950408889634f;
    float mx = -1e30f;
#pragma unroll
    for (int tt = 0; tt < 16; ++tt)
#pragma unroll
        for (int r = 0; r < 4; ++r) { const int slot = tt * 16 + 4 * g4 + r; if (slot < cnt) mx = fmaxf(mx, s[tt][r] * cs); }
    mx = fmaxf(mx, __shfl_xor(mx, 16)); mx = fmaxf(mx, __shfl_xor(mx, 32));
    float sum = 0.f;
#pragma unroll
    for (int tt = 0; tt < 16; ++tt)
#pragma unroll
        for (int r = 0; r < 4; ++r) { const int slot = tt * 16 + 4 * g4 + r; const float pv = slot < cnt ? exp2f(s[tt][r] * cs - mx) : 0.f; s[tt][r] = pv; sum += pv; }
    sum += __shfl_xor(sum, 16); sum += __shfl_xor(sum, 32);
    const float inv = sum > 0.f ? 1.0f / sum : 0.f;
    if (c < 4) {
#pragma unroll
        for (int tt = 0; tt < 16; ++tt)
#pragma unroll
            for (int r = 0; r < 4; ++r) Pl[(tt * 16 + 4 * g4 + r) * 4 + c] = s[tt][r] * inv;
    }
    __builtin_amdgcn_wave_barrier();
    float acc[4][8];
#pragma unroll
    for (int hh = 0; hh < 4; ++hh)
#pragma unroll
        for (int j = 0; j < 8; ++j) acc[hh][j] = 0.f;
    const int nk32 = (cnt + 31) >> 5;
#pragma unroll 1
    for (int kb = 0; kb < nk32; ++kb) {
        uint4 raw[8]; float4 p4[8];
#pragma unroll
        for (int q = 0; q < 8; ++q) {
            const int slot = (kb * 8 + q) * 4 + g4;
            const int row = idxs[slot];
            raw[q] = *(const uint4*)(p.PROJ() + (size_t)row * LDP + C_DV + c * 8);
            p4[q] = *(const float4*)(Pl + slot * 4);
        }
#pragma unroll
        for (int q = 0; q < 8; ++q) {
            const float vv[8] = {lo2f(raw[q].x), hi2f(raw[q].x), lo2f(raw[q].y), hi2f(raw[q].y), lo2f(raw[q].z), hi2f(raw[q].z), lo2f(raw[q].w), hi2f(raw[q].w)};
            const float pp[4] = {p4[q].x, p4[q].y, p4[q].z, p4[q].w};
#pragma unroll
            for (int hh = 0; hh < 4; ++hh)
#pragma unroll
                for (int j = 0; j < 8; ++j) acc[hh][j] += pp[hh] * vv[j];
        }
    }
#pragma unroll
    for (int hh = 0; hh < 4; ++hh)
#pragma unroll
        for (int j = 0; j < 8; ++j) { float a = acc[hh][j]; a += __shfl_xor(a, 16); a += __shfl_xor(a, 32); acc[hh][j] = a; }
    if (g4 == 0) {
#pragma unroll
        for (int hh = 0; hh < 4; ++hh) {
            uint4 o; o.x = pk2(acc[hh][0], acc[hh][1]); o.y = pk2(acc[hh][2], acc[hh][3]); o.z = pk2(acc[hh][4], acc[hh][5]); o.w = pk2(acc[hh][6], acc[hh][7]);
            *(uint4*)(p.Y() + t * D + 1536 + hh * 128 + c * 8) = o;
        }
    }
    __builtin_amdgcn_wave_barrier();
}

DEV void ins16(unsigned (&top)[16], unsigned x) {
#pragma unroll
    for (int j = 0; j < 16; ++j) { const unsigned hi = max(top[j], x); x = min(top[j], x); top[j] = hi; }
}
DEV void st_peer_topk(const P& p, int layer, int unit, char* smem) {
    const int tid = tidx(), w = tid >> 6, l = tid & 63, n = l & 31, hf = l >> 5;
    const int tg = unit >> 1, head = (unit & 1) * 4 + w;
    const size_t t = (size_t)tg * 32 + n;
    unsigned* il = (unsigned*)smem + w * 1024;
    unsigned top[2][16];
#pragma unroll
    for (int pp = 0; pp < 2; ++pp) {
        float qv[32];
#pragma unroll
        for (int i = 0; i < 8; ++i) { const float4 v = *(const float4*)(p.PQ() + t * 1024 + head * 128 + pp * 64 + hf * 32 + i * 4); qv[4 * i] = v.x; qv[4 * i + 1] = v.y; qv[4 * i + 2] = v.z; qv[4 * i + 3] = v.w; }
        const float* K = p.peer_sk + ((((size_t)layer * 8 + head) * 2 + pp) * 128) * 64;
#pragma unroll
        for (int j = 0; j < 16; ++j) top[pp][j] = 0u;
#pragma unroll 1
        for (int tile = 0; tile < 4; ++tile) {
            float kv[32];
            const float* kr = K + (size_t)(tile * 32 + n) * 64 + hf * 32;
#pragma unroll
            for (int i = 0; i < 8; ++i) { const float4 v = *(const float4*)(kr + i * 4); kv[4 * i] = v.x; kv[4 * i + 1] = v.y; kv[4 * i + 2] = v.z; kv[4 * i + 3] = v.w; }
            f32x16 acc;
#pragma unroll
            for (int r = 0; r < 16; ++r) acc[r] = 0.f;
#pragma unroll
            for (int kk = 0; kk < 32; ++kk) acc = __builtin_amdgcn_mfma_f32_32x32x2f32(kv[kk], qv[kk], acc, 0, 0, 0);
#pragma unroll
            for (int r = 0; r < 16; ++r) {
                const int nn = tile * 32 + (r & 3) + 8 * (r >> 2) + 4 * hf;
                ins16(top[pp], (f2key(acc[r]) & ~127u) | (unsigned)(127 - nn));
            }
        }
        unsigned oth[16];
#pragma unroll
        for (int j = 0; j < 16; ++j) oth[j] = __shfl_xor(top[pp][j], 32);
#pragma unroll
        for (int j = 0; j < 16; ++j) ins16(top[pp], oth[j]);
        if (hf == 0) {
#pragma unroll
            for (int j = 0; j < 16; ++j) il[(pp * 16 + j) * 32 + n] = 127u - (top[pp][j] & 127u);
        }
    }
    __builtin_amdgcn_wave_barrier();
    if (hf == 0) {
        float v1[16], v2[16];
#pragma unroll
        for (int j = 0; j < 16; ++j) { v1[j] = key2f(top[0][j] & ~127u); v2[j] = key2f(top[1][j] & ~127u); }
        unsigned ct[16];
#pragma unroll
        for (int s = 0; s < 16; ++s) ct[s] = 0u;
#pragma unroll
        for (int i = 0; i < 16; ++i)
#pragma unroll
            for (int j = 0; j < 16; ++j)
                if ((i + 1) * (j + 1) <= 16) ins16(ct, (f2key(v1[i] + v2[j]) & ~255u) | (unsigned)(255 - (i * 16 + j)));
        float ex[16], sum = 0.f; int ce[16];
        const float c0 = key2f(ct[0] & ~255u);
#pragma unroll
        for (int s = 0; s < 16; ++s) {
            const unsigned code = 255u - (ct[s] & 255u);
            ce[s] = (int)(il[(code >> 4) * 32 + n] * 128u + il[(16 + (code & 15u)) * 32 + n]);
            ex[s] = __expf(key2f(ct[s] & ~255u) - c0); sum += ex[s];
        }
        const float inv = 1.0f / sum;
#pragma unroll
        for (int s4 = 0; s4 < 4; ++s4) {
            *(int4*)(p.PE() + t * 128 + head * 16 + s4 * 4) = make_int4(ce[4 * s4], ce[4 * s4 + 1], ce[4 * s4 + 2], ce[4 * s4 + 3]);
            *(float4*)(p.PG() + t * 128 + head * 16 + s4 * 4) = make_float4(ex[4 * s4] * inv, ex[4 * s4 + 1] * inv, ex[4 * s4 + 2] * inv, ex[4 * s4 + 3] * inv);
        }
    }
    __builtin_amdgcn_wave_barrier();
}

DEV void st_peer_gather(const P& p, int layer, const float* __restrict__ xin, float* __restrict__ xout, int unit, char* smem) {
    const int tid_ = tidx(); const int w = tid_ >> 6, l = tid_ & 63; const size_t t = (size_t)unit * 4 + w;
    float* row = (float*)smem + w * 2112;
    const int* pip = p.PI();
    const float ic6 = __int_as_float(__builtin_amdgcn_readfirstlane(pip[32]));
    {
#pragma unroll
        for (int i = 0; i < 4; ++i) {
            const uint4 hv = *(const uint4*)(p.HN() + t * D + i * 512 + l * 8);
            const unsigned u4[4] = {hv.x, hv.y, hv.z, hv.w};
            const int c = i * 512 + l * 8;
#pragma unroll
            for (int q = 0; q < 4; ++q) { row[((c + 2 * q) >> 5) * 33 + ((c + 2 * q) & 31)] = lo2f(u4[q]); row[((c + 2 * q + 1) >> 5) * 33 + ((c + 2 * q + 1) & 31)] = hi2f(u4[q]); }
        }
        __builtin_amdgcn_wave_barrier();
    }
    unsigned hp[16];
#pragma unroll
    for (int j = 0; j < 16; ++j)
        hp[j] = (__float_as_uint(row[l * 33 + __builtin_amdgcn_readfirstlane(pip[2 * j])]) >> 16) |
                (__float_as_uint(row[l * 33 + __builtin_amdgcn_readfirstlane(pip[2 * j + 1])]) & 0xffff0000u);
    __builtin_amdgcn_wave_barrier();
    const int e0 = p.PE()[t * 128 + l], e1 = p.PE()[t * 128 + 64 + l];
    const float g0 = p.PG()[t * 128 + l], g1 = p.PG()[t * 128 + 64 + l];
    float out[32];
#pragma unroll
    for (int i = 0; i < 32; ++i) out[i] = 0.f;
    const unsigned char* U = p.Utab() + (size_t)layer * 16384 * ROW6; const unsigned char* V = p.Vtab() + (size_t)layer * 16384 * ROW6;
    const unsigned voff = (unsigned)l * 8u;
    const bool b5 = (l & 32) != 0, b4 = (l & 16) != 0;
#pragma unroll 1
    for (int k4 = 0; k4 < 32; ++k4) {
        int e[4]; float g[4];
#pragma unroll
        for (int q = 0; q < 4; ++q) {
            const int k = k4 * 4 + q;
            e[q] = __builtin_amdgcn_readlane(k4 < 16 ? e0 : e1, k & 63);
            g[q] = __int_as_float(__builtin_amdgcn_readlane(__float_as_int(k4 < 16 ? g0 : g1), k & 63));
        }
        uint2 uu[4][3], vv[4][3];
#pragma unroll
        for (int q = 0; q < 4; ++q)
#pragma unroll
            for (int i = 0; i < 3; ++i) { uu[q][i] = *(const uint2*)(U + (size_t)e[q] * ROW6 + (voff + i * 512)); vv[q][i] = *(const uint2*)(V + (size_t)e[q] * ROW6 + (voff + i * 512)); }
        float d[4];
#pragma unroll
        for (int q = 0; q < 4; ++q) {
            v6u pk; pk[0] = uu[q][0].x; pk[1] = uu[q][0].y; pk[2] = uu[q][1].x; pk[3] = uu[q][1].y; pk[4] = uu[q][2].x; pk[5] = uu[q][2].y;
            if (q > 0) { unsigned t0_ = pk[0]; asm volatile("" : "+v"(t0_), "+v"(d[q - 1])); pk[0] = t0_; }
            const v32f f = FP6_UNPACK(pk);
            float acc = 0.f;
#pragma unroll
            for (int j = 0; j < 16; ++j) acc += f[2 * j] * lo2f(hp[j]) + f[2 * j + 1] * hi2f(hp[j]);
            d[q] = acc;
            __builtin_amdgcn_sched_barrier(0);
        }
        float kA = b5 ? d[2] : d[0], kB = b5 ? d[3] : d[1];
        const float sA = b5 ? d[0] : d[2], sB = b5 ? d[1] : d[3];
        kA += __shfl_xor(sA, 32); kB += __shfl_xor(sB, 32);
        float kk = b4 ? kB : kA; const float ss = b4 ? kA : kB;
        kk += __shfl_xor(ss, 16);
        kk += __shfl_xor(kk, 8); kk += __shfl_xor(kk, 4); kk += __shfl_xor(kk, 2); kk += __shfl_xor(kk, 1);
        const float gsel = b5 ? (b4 ? g[3] : g[2]) : (b4 ? g[1] : g[0]);
        const float av = gelu_tanh(kk * (ic6 / U6_SCALE)) * gsel * (ic6 / V6_SCALE);
        const int avi = __float_as_int(av);
        const float a4[4] = {__int_as_float(__builtin_amdgcn_readlane(avi, 0)), __int_as_float(__builtin_amdgcn_readlane(avi, 16)),
                             __int_as_float(__builtin_amdgcn_readlane(avi, 32)), __int_as_float(__builtin_amdgcn_readlane(avi, 48))};
#pragma unroll
        for (int q = 0; q < 4; ++q) {
            v6u pk; pk[0] = vv[q][0].x; pk[1] = vv[q][0].y; pk[2] = vv[q][1].x; pk[3] = vv[q][1].y; pk[4] = vv[q][2].x; pk[5] = vv[q][2].y;
            { unsigned t0_ = pk[0]; asm volatile("" : "+v"(t0_), "+v"(out[31])); pk[0] = t0_; }
            const v32f f = FP6_UNPACK(pk);
#pragma unroll
            for (int j = 0; j < 32; ++j) out[j] += a4[q] * f[j];
            __builtin_amdgcn_sched_barrier(0);
        }
    }
    asm volatile("" : "+s"(pip));
#pragma unroll
    for (int j = 0; j < 32; ++j) row[l * 33 + __builtin_amdgcn_readfirstlane(pip[j])] = out[j];
    __builtin_amdgcn_wave_barrier();
    const float* g2 = p.ada() + layer * 12288 + 5 * 2048;
    float4 xo[8]; float ssq = 0.f;
#pragma unroll
    for (int i = 0; i < 8; ++i) {
        const int c = i * 256 + l * 4;
        const float* rp = row + (c >> 5) * 33 + (c & 31);
        const size_t off = t * D + c;
        const float4 x0 = *(const float4*)(xin + off); const float4 ga = *(const float4*)(g2 + c);
        float4 o0;
        o0.x = x0.x + ga.x * rp[0]; o0.y = x0.y + ga.y * rp[1]; o0.z = x0.z + ga.z * rp[2]; o0.w = x0.w + ga.w * rp[3];
        *(float4*)(xout + off) = o0;
        xo[i] = o0; ssq += o0.x * o0.x + o0.y * o0.y + o0.z * o0.z + o0.w * o0.w;
        if (i & 1) __builtin_amdgcn_sched_barrier(0);
    }
    if (layer + 1 < NL) {
        const float rs = rsqrtf(wsum(ssq) * (1.0f / 2048.0f) + EPS);
        const float* ng = p.n1g + (layer + 1) * 2048; const float* adn = p.ada() + (layer + 1) * 12288;
#pragma unroll
        for (int i = 0; i < 8; ++i) {
            const int c = i * 256 + l * 4;
            const float4 gg = *(const float4*)(ng + c), sc = *(const float4*)(adn + 2048 + c), sh = *(const float4*)(adn + c);
            uint2 o;
            o.x = pk2((xo[i].x * rs) * gg.x * (1.0f + sc.x) + sh.x, (xo[i].y * rs) * gg.y * (1.0f + sc.y) + sh.y);
            o.y = pk2((xo[i].z * rs) * gg.z * (1.0f + sc.z) + sh.z, (xo[i].w * rs) * gg.w * (1.0f + sc.w) + sh.w);
            *(uint2*)(p.HN() + t * D + c) = o;
            if (i & 1) __builtin_amdgcn_sched_barrier(0);
        }
    }
    __builtin_amdgcn_wave_barrier();
}

enum { S_CONVT_IN = 0, S_CONVT_OUT, S_CONVT_Q, S_CONVT_W1, S_CALIB, S_TAB_U, S_TAB_V, S_ADA, S_ROPE, S_NORM1, S_GEMM_IN, S_CONV, S_SGU, S_VTRANS, S_PREP,
       S_COMPRESS, S_NSA_CMP, S_DSA_INDEX, S_NSA_ATTN, S_DSA_ATTN, S_GEMM_OUT, S_NORM2, S_GEMM_Q, S_PEER_TOPK, S_PEER_GATHER, S_COUNT };
constexpr int TAB_UNITS = 4096;
__host__ __device__ constexpr int nunits(int s) {
    return s == S_CONVT_IN ? 2 * 32 * (LDP / 64) : s == S_CONVT_OUT ? 2 * 32 * 32 : s == S_CONVT_Q ? 2 * 32 * 16 : s == S_CONVT_W1 ? 4 * 64 * 2 : s == S_CALIB ? 1 : s == S_TAB_U ? TAB_UNITS : s == S_TAB_V ? TAB_UNITS
         : s == S_ADA ? 384 : s == S_ROPE ? 768 : s == S_NORM1 ? 2048 : s == S_GEMM_IN ? 64 * (LDP / 128) : s == S_CONV ? 512 : s == S_SGU ? 256
         : s == S_VTRANS ? 256 : s == S_PREP ? 2048 : s == S_COMPRESS ? 64 : s == S_NSA_CMP ? 512 : s == S_DSA_INDEX ? 512 : s == S_NSA_ATTN ? 512 : s == S_DSA_ATTN ? 2048
         : s == S_GEMM_OUT ? 64 * 16 : s == S_NORM2 ? 2048 : s == S_GEMM_Q ? 64 * 8 : s == S_PEER_TOPK ? 512 : s == S_PEER_GATHER ? 2048 : 0;
}
template <int S>
DEV void run_unit(const P& p, int layer, int u, char* smem, int nu = TAB_UNITS) {
    const float* xin = layer == 0 ? p.x : p.X2();
    const float* ada = p.ada() + layer * 12288;
    if constexpr (S == S_CONVT_IN) { const int per = 32 * (LDP / 64), ly = u / per; st_convT(p.w_in + (size_t)ly * 2048 * INC, p.WinT() + (size_t)ly * LDP * 2048, INC, LDP, true, u % per, smem); }
    else if constexpr (S == S_CONVT_OUT) { const int per = 32 * 32, ly = u / per; st_convT(p.w_out + (size_t)ly * 2048 * 2048, p.WoutT() + (size_t)ly * 2048 * 2048, 2048, 2048, false, u % per, smem); }
    else if constexpr (S == S_CONVT_Q) { const int per = 32 * 16, ly = u / per; st_convT(p.peer_wq + (size_t)ly * 2048 * 1024, p.WqT() + (size_t)ly * 1024 * 2048, 1024, 1024, false, u % per, smem); }
    else if constexpr (S == S_CONVT_W1) { const int per = 64 * 2, mi = u / per; st_convT(p.cmp_w1 + (size_t)mi * 4096 * 128, p.W1T() + (size_t)mi * 128 * 4096, 128, 128, false, u % per, smem, 4096); }
    else if constexpr (S == S_CALIB) st_calib(p);
    else if constexpr (S == S_TAB_U) st_tab6(p.peer_u, p.Utab(), U6_SCALE, 2 * 16384, u, nu, smem);
    else if constexpr (S == S_TAB_V) st_tab6(p.peer_v, p.Vtab(), V6_SCALE, 2 * 16384, u, nu, smem);
    else if constexpr (S == S_ADA) st_ada(p, u, smem);
    else if constexpr (S == S_ROPE) st_rope(p, u);
    else if constexpr (S == S_NORM1) st_norm(xin, p.n1g + layer * 2048, ada + 2048, ada, p.HN(), u);
    else if constexpr (S == S_GEMM_IN) { EpiArgs e{p.PROJ(), nullptr, nullptr, nullptr}; st_gemm<EPI_PROJ>(p.HN(), p.WinT() + (size_t)layer * LDP * 2048, 2048, u & 63, u >> 6, e, smem); }
    else if constexpr (S == S_CONV) st_conv(p, layer, u, smem);
    else if constexpr (S == S_SGU) st_sgu(p, layer, u, smem);
    else if constexpr (S == S_VTRANS) st_vtrans(p, u, smem);
    else if constexpr (S == S_PREP) st_prep(p, layer, u);
    else if constexpr (S == S_COMPRESS) st_compress(p, layer, u, smem);
    else if constexpr (S == S_NSA_CMP) st_nsa_cmp(p, u, smem);
    else if constexpr (S == S_DSA_INDEX) st_dsa_index(p, u, smem);
    else if constexpr (S == S_NSA_ATTN) st_nsa_attn(p, u, smem);
    else if constexpr (S == S_DSA_ATTN) st_dsa_attn(p, u, smem);
    else if constexpr (S == S_GEMM_OUT) { EpiArgs e{nullptr, p.X1(), xin, ada + 2 * 2048}; st_gemm<EPI_OUT>(p.Y(), p.WoutT() + (size_t)layer * 2048 * 2048, 2048, u & 63, u >> 6, e, smem); }
    else if constexpr (S == S_NORM2) st_norm(p.X1(), p.n2g + layer * 2048, ada + 4 * 2048, ada + 3 * 2048, p.HN(), u);
    else if constexpr (S == S_GEMM_Q) { EpiArgs e{nullptr, p.PQ(), nullptr, nullptr}; st_gemm<EPI_Q>(p.HN(), p.WqT() + (size_t)layer * 1024 * 2048, 2048, u & 63, u >> 6, e, smem); }
    else if constexpr (S == S_PEER_TOPK) st_peer_topk(p, layer, u, smem);
    else if constexpr (S == S_PEER_GATHER) st_peer_gather(p, layer, p.X1(), layer == 0 ? p.X2() : p.out, u, smem);
}


#define XB_TMO      128
#define XB_XCNT(j)  (256  + 64 * (j))
#define XB_XSUB(j)  (1280 + 64 * (j))
#define XB_XGEN(j)  (2304 + 64 * (j))
#define XB_TOP      3328
#define XB_TOPGEN   3392
#define XB_SPIN_CAP (1u << 22)
#define LAS __attribute__((address_space(3)))
DEV unsigned xb_ld(unsigned* p) { return __hip_atomic_load(p, __ATOMIC_RELAXED, __HIP_MEMORY_SCOPE_AGENT); }
DEV unsigned xb_add(unsigned* p, unsigned v) { return __hip_atomic_fetch_add(p, v, __ATOMIC_RELAXED, __HIP_MEMORY_SCOPE_AGENT); }
DEV unsigned xb_xcc_id() { return (unsigned)__builtin_amdgcn_s_getreg((3 << 11) | 20) & 0xFu; }
#define XB_SPIN(cond, bar) do { unsigned _sp = 0; while (cond) { __builtin_amdgcn_s_sleep(1); \
    if ((++_sp & 255u) == 0u) { if (xb_ld(&(bar)[XB_TMO])) break; if (_sp > XB_SPIN_CAP) { atomicAdd(&(bar)[XB_TMO], 1u); break; } } } } while (0)
struct XcdBarrier { unsigned* bar; unsigned x; volatile LAS unsigned* st; };
DEV XcdBarrier xcd_barrier_post(unsigned* bar, volatile LAS unsigned* st) {
    XcdBarrier b; b.bar = bar; b.x = xb_xcc_id(); b.st = st;
    if (threadIdx.x == 0) (void)xb_add(&bar[XB_XCNT(b.x)], 1u);
    return b;
}
DEV void xcd_barrier_complete(unsigned* bar, unsigned x, unsigned& nloc, unsigned& nx) {
    const unsigned G = gridDim.x * gridDim.y * gridDim.z;
    unsigned sum, cnt, mine, sp = 0u;
    for (;;) {
        sum = 0u; cnt = 0u; mine = 0u;
#pragma unroll
        for (unsigned j = 0; j < 16; ++j) { const unsigned c = xb_ld(&bar[XB_XCNT(j)]); sum += c; cnt += (c > 0u) ? 1u : 0u; mine = (j == x) ? c : mine; }
        if (sum == G) break;
        __builtin_amdgcn_s_sleep(1);
        if ((++sp & 255u) == 0u) { if (xb_ld(&bar[XB_TMO])) break; if (sp > XB_SPIN_CAP) { atomicAdd(&bar[XB_TMO], 1u); break; } }
    }
    nloc = mine > 0u ? mine : 1u; nx = cnt > 0u ? cnt : 1u;
}
DEV void xcd_barrier(const XcdBarrier& b) {
    asm volatile("s_waitcnt vmcnt(0)" ::: "memory");
    __syncthreads();
    if (threadIdx.x == 0) {
        unsigned* bar = b.bar;
        __builtin_amdgcn_s_waitcnt(0);
        unsigned nloc = b.st[0], nx = b.st[1];
        if (nloc == 0u) { xcd_barrier_complete(bar, b.x, nloc, nx); b.st[0] = nloc; b.st[1] = nx; }
        const unsigned old = xb_add(&bar[XB_XSUB(b.x)], 1u);
        const unsigned gen = old / nloc;
        if (old + 1u == (gen + 1u) * nloc) {
            __builtin_amdgcn_fence(__ATOMIC_RELEASE, "agent");
            asm volatile("s_waitcnt vmcnt(0)" ::: "memory");
            const unsigned og = xb_add(&bar[XB_TOP], 1u);
            const unsigned tg = og / nx;
            if (og + 1u == (tg + 1u) * nx) xb_add(&bar[XB_TOPGEN], 1u);
            else XB_SPIN(xb_ld(&bar[XB_TOPGEN]) == tg, bar);
            __builtin_amdgcn_fence(__ATOMIC_ACQUIRE, "agent");
            xb_add(&bar[XB_XGEN(b.x)], 1u);
            asm volatile("s_waitcnt vmcnt(0)" ::: "memory");
        } else {
            XB_SPIN(xb_ld(&bar[XB_XGEN(b.x)]) == gen, bar);
            __builtin_amdgcn_fence(__ATOMIC_ACQUIRE, "agent");
            asm volatile("s_waitcnt vmcnt(0)" ::: "memory");
        }
    }
    __syncthreads();
}

#ifndef MULTI_LAUNCH
constexpr int REP_STAGE = -1, REP_STAGE2 = -1, REP_N = 1;
template <int S>
DEV void run_phase1(const P& p, int layer, char* smem, int off);
template <int S>
DEV void run_phase(const P& p, int layer, char* smem, int off = 0) {
    constexpr int reps = (S == REP_STAGE || S == REP_STAGE2) ? REP_N : 1;
#pragma unroll 1
    for (int r = 0; r < reps; ++r) run_phase1<S>(p, layer, smem, off);
}
template <int S>
DEV void run_phase1(const P& p, int layer, char* smem, int off) {
    const int G = gridDim.x;
    int b = blockIdx.x + off; if (b >= G) b -= G;
    if constexpr (S == S_TAB_U || S == S_TAB_V) { run_unit<S>(p, layer, b, smem, G); }
    else {
        for (int u = b; u < nunits(S); u += G) { run_unit<S>(p, layer, u, smem); __syncthreads(); }
    }
}
template <int S>
DEV void run_gemm_phase1(const P& p, int layer, char* smem, unsigned xcc, volatile LAS unsigned* slot, int rep) {
    constexpr int TN = (S == S_GEMM_IN) ? (LDP / 128) : (S == S_GEMM_OUT ? 16 : 8);
    constexpr int NBIG = (S == S_GEMM_IN) ? 32 : (S == S_GEMM_OUT ? 16 : 0);
    constexpr int inst0 = (S == S_GEMM_IN) ? 0 : (S == S_GEMM_OUT ? 2 : 4);
    constexpr int nbig = 4 * NBIG, len = nbig + 8 * (TN - NBIG);
    const float* xin = layer == 0 ? p.x : p.X2();
    const float* ada = p.ada() + layer * 12288;
    const bf16_t* Aop = (S == S_GEMM_OUT) ? p.Y() : p.HN();
    const bf16_t* Bop = (S == S_GEMM_IN) ? p.WinT() + (size_t)layer * LDP * 2048 : (S == S_GEMM_OUT ? p.WoutT() + (size_t)layer * 2048 * 2048 : p.WqT() + (size_t)layer * 1024 * 2048);
    EpiArgs e{p.PROJ(), (S == S_GEMM_OUT) ? p.X1() : p.PQ(), xin, ada + 2 * 2048};
    constexpr int EPI = (S == S_GEMM_IN) ? EPI_PROJ : (S == S_GEMM_OUT ? EPI_OUT : EPI_Q);
#pragma unroll 1
    for (int q = 0; q < 8; ++q) {
        const unsigned xq = (xcc + q) & 7u;
        unsigned* head = p.bar() + GQ_WORD(inst0 + layer + 6 * rep, xq);
        for (;;) {
            if (threadIdx.x == 0) *slot = xb_add(head, 1u);
            __syncthreads();
            const int i = (int)*slot;
            __syncthreads();
            if (i >= len) break;
            if (i < nbig) st_gemm<EPI, 8>(Aop, Bop, 2048, (int)xq * 4 + (i & 3), i >> 2, e, smem);
            else { const int j = i - nbig; st_gemm<EPI, 4>(Aop, Bop, 2048, (int)xq * 8 + (j & 7), NBIG + (j >> 3), e, smem); }
            __syncthreads();
        }
    }
}
template <int S>
DEV void run_items(const P& p, int layer, char* smem, int first, int count) {
    constexpr int reps = (S == REP_STAGE || S == REP_STAGE2) ? REP_N : 1;
#pragma unroll 1
    for (int r = 0; r < reps; ++r)
#pragma unroll 1
        for (int u = first; u < first + count; ++u) { run_unit<S>(p, layer, u, smem); __syncthreads(); }
}
template <int PH>
DEV void run_dyn_phase(const P& p, int layer, char* smem, volatile LAS unsigned* slot) {
    unsigned* head = p.bar() + DQ_WORD(PH * 2 + layer);
    constexpr int total0 = PH == 0 ? (64 + 256 + 256 + 64 + 256) : (PH == 1 ? (512 + 256) : (512 + 512));
    const int total = (PH == 1 && layer == 0) ? total0 + 512 : total0;
    int i = blockIdx.x;
    while (i < total) {
        if constexpr (PH == 0) {
            if (i < 256) run_items<S_SGU>(p, layer, smem, i, 1);
            else if (i < 320) run_items<S_COMPRESS>(p, layer, smem, i - 256, 1);
            else if (i < 576) run_items<S_CONV>(p, layer, smem, (i - 320) * 2, 2);
            else if (i < 640) run_items<S_VTRANS>(p, layer, smem, (i - 576) * 4, 4);
            else run_items<S_PREP>(p, layer, smem, (i - 640) * 8, 8);
        } else if constexpr (PH == 1) {
            if (i < 512) run_items<S_DSA_INDEX>(p, layer, smem, i, 1);
            else if (i < 768) run_items<S_NSA_CMP>(p, layer, smem, (i - 512) * 2, 2);
            else if (i < 1024) { run_unit<S_TAB_U>(p, layer, i - 768, smem, 256); __syncthreads(); }
            else { run_unit<S_TAB_V>(p, layer, i - 1024, smem, 256); __syncthreads(); }
        } else {
            if (i < 512) run_items<S_NSA_ATTN>(p, layer, smem, 511 - i, 1);
            else run_items<S_DSA_ATTN>(p, layer, smem, (i - 512) * 4, 4);
        }
        if (threadIdx.x == 0) *slot = gridDim.x + xb_add(head, 1u);
        __syncthreads();
        i = (int)*slot;
        __syncthreads();
    }
}
template <int S>
DEV void run_gemm_phase(const P& p, int layer, char* smem, unsigned xcc, volatile LAS unsigned* slot) {
    constexpr int reps = (S == REP_STAGE || S == REP_STAGE2) ? REP_N : 1;
#pragma unroll 1
    for (int r = 0; r < reps; ++r) run_gemm_phase1<S>(p, layer, smem, xcc, slot, r);
}
#if defined(__HIP_DEVICE_COMPILE__)
typedef const P __attribute__((address_space(4)))* kargp_t;
DEV const P& fresh_params() { kargp_t q = (kargp_t)__builtin_amdgcn_kernarg_segment_ptr(); asm volatile("" : "+s"(q)); return *(const P*)q; }
#define PP fresh_params()
#else
#define PP p
#endif
#define GSYNC() xcd_barrier(xb)
__global__ void __launch_bounds__(NTHREADS, 2) k_mega(P p) {
    __shared__ __attribute__((aligned(16))) char smem[SMEM_BYTES];
    __shared__ uint4 xb_words;
    cg::grid_group grid = cg::this_grid();
    if (threadIdx.x == 0) xb_words = make_uint4(0u, 0u, 0u, 0u);
    __syncthreads();
    XcdBarrier xb = xcd_barrier_post(p.bar(), (volatile LAS unsigned*)&xb_words);
    const int H = gridDim.x >> 1, Q = gridDim.x >> 2;
    run_phase<S_ADA>(PP, 0, smem); run_phase<S_ROPE>(PP, 0, smem, H);
    run_phase<S_CONVT_IN>(PP, 0, smem); run_phase<S_CONVT_OUT>(PP, 0, smem); run_phase<S_CONVT_Q>(PP, 0, smem); run_phase<S_CONVT_W1>(PP, 0, smem); run_phase<S_CALIB>(PP, 0, smem, 100);
    grid.sync();
#pragma unroll 1
    for (int layer = 0; layer < NL; ++layer) {
        if (layer == 0) { run_phase<S_NORM1>(PP, layer, smem); GSYNC(); }
        run_gemm_phase<S_GEMM_IN>(PP, layer, smem, xb.x, (volatile LAS unsigned*)&xb_words + 2); GSYNC();
        run_dyn_phase<0>(PP, layer, smem, (volatile LAS unsigned*)&xb_words + 2); GSYNC();
        run_dyn_phase<1>(PP, layer, smem, (volatile LAS unsigned*)&xb_words + 2); GSYNC();
        run_dyn_phase<2>(PP, layer, smem, (volatile LAS unsigned*)&xb_words + 2); GSYNC();
        run_gemm_phase<S_GEMM_OUT>(PP, layer, smem, xb.x, (volatile LAS unsigned*)&xb_words + 2); GSYNC();
        run_phase<S_NORM2>(PP, layer, smem); GSYNC();
        run_gemm_phase<S_GEMM_Q>(PP, layer, smem, xb.x, (volatile LAS unsigned*)&xb_words + 2); GSYNC();
        run_phase<S_PEER_TOPK>(PP, layer, smem); GSYNC();
        run_phase<S_PEER_GATHER>(PP, layer, smem); GSYNC();
    }
}
#else
template <int S>
__global__ void __launch_bounds__(NTHREADS) k_stage(P p, int layer) {
    __shared__ __attribute__((aligned(16))) char smem[SMEM_BYTES];
    run_unit<S>(p, layer, blockIdx.x, smem);
}
template <int S> static void launch_stage(const P& p, int layer, hipStream_t st) {
    hipLaunchKernelGGL((k_stage<S>), dim3(nunits(S)), dim3(NTHREADS), 0, st, p, layer);
}
#endif

extern "C" void kernel_launch(void* const* d_in, const int* in_sizes, int n_in, void* d_out, int out_size, void* d_ws, size_t ws_size, hipStream_t stream) {
    P p{};
    p.x = (const float*)d_in[0]; p.c = (const float*)d_in[1]; p.pos = (const int*)d_in[2]; p.ada_w = (const float*)d_in[3]; p.ada_b = (const float*)d_in[4];
    p.n1g = (const float*)d_in[5]; p.n2g = (const float*)d_in[6]; p.w_in = (const float*)d_in[7]; p.w_out = (const float*)d_in[8]; p.conv_w = (const float*)d_in[9];
    p.conv_b = (const float*)d_in[10]; p.cln_g = (const float*)d_in[11]; p.cln_b = (const float*)d_in[12]; p.sln_g = (const float*)d_in[13]; p.sln_b = (const float*)d_in[14];
    p.sgu_w = (const float*)d_in[15]; p.sgu_b = (const float*)d_in[16]; p.nsa_qg = (const float*)d_in[17]; p.nsa_kg = (const float*)d_in[18]; p.cmp_pos = (const float*)d_in[19];
    p.cmp_w1 = (const float*)d_in[20]; p.cmp_w2 = (const float*)d_in[21]; p.dsa_qg = (const float*)d_in[22]; p.dsa_kg = (const float*)d_in[23]; p.peer_wq = (const float*)d_in[24];
    p.peer_sk = (const float*)d_in[25]; p.peer_u = (const float*)d_in[26]; p.peer_v = (const float*)d_in[27];
    p.out = (float*)d_out;
    p.ws = (char*)d_ws; const size_t off = WS_TOTAL;
    if (off > ws_size) { fprintf(stderr, "workspace too small: need %zu have %zu\n", off, ws_size); return; }
#ifndef MULTI_LAUNCH
    static int grid_blocks = 0;
    if (!grid_blocks) {
        int dev = 0, cus = 0, per_cu = 0;
        (void)hipGetDevice(&dev);
        (void)hipDeviceGetAttribute(&cus, hipDeviceAttributeMultiprocessorCount, dev);
        (void)hipOccupancyMaxActiveBlocksPerMultiprocessor(&per_cu, k_mega, NTHREADS, 0);
        if (per_cu > 2) per_cu = 2;
        grid_blocks = cus * per_cu;
    }
    (void)hipMemsetAsync(p.bar(), 0, (size_t)CTRL_WORDS * 4, stream);
    void* args[] = {&p};
    hipError_t e = hipLaunchCooperativeKernel((void*)k_mega, dim3(grid_blocks), dim3(NTHREADS), args, 0, stream);
    if (e != hipSuccess) fprintf(stderr, "cooperative launch failed: %s (grid %d)\n", hipGetErrorString(e), grid_blocks);
#else
    launch_stage<S_CONVT_IN>(p, 0, stream); launch_stage<S_CONVT_OUT>(p, 0, stream); launch_stage<S_CONVT_Q>(p, 0, stream); launch_stage<S_CONVT_W1>(p, 0, stream); launch_stage<S_CALIB>(p, 0, stream);
    launch_stage<S_TAB_U>(p, 0, stream); launch_stage<S_TAB_V>(p, 0, stream);
    launch_stage<S_ADA>(p, 0, stream); launch_stage<S_ROPE>(p, 0, stream);
    for (int layer = 0; layer < NL; ++layer) {
        launch_stage<S_NORM1>(p, layer, stream); launch_stage<S_GEMM_IN>(p, layer, stream);
        launch_stage<S_CONV>(p, layer, stream); launch_stage<S_SGU>(p, layer, stream); launch_stage<S_VTRANS>(p, layer, stream);
        launch_stage<S_PREP>(p, layer, stream); launch_stage<S_COMPRESS>(p, layer, stream);
        launch_stage<S_NSA_CMP>(p, layer, stream); launch_stage<S_DSA_INDEX>(p, layer, stream);
        launch_stage<S_NSA_ATTN>(p, layer, stream); launch_stage<S_DSA_ATTN>(p, layer, stream);
        launch_stage<S_GEMM_OUT>(p, layer, stream); launch_stage<S_NORM2>(p, layer, stream); launch_stage<S_GEMM_Q>(p, layer, stream);
        launch_stage<S_PEER_TOPK>(p, layer, stream); launch_stage<S_PEER_GATHER>(p, layer, stream);
    }
#endif
}
```

```cpp
#include <hip/hip_runtime.h>
#include <hip/hip_cooperative_groups.h>
#include <stdint.h>
#include <cstdio>
namespace cg = cooperative_groups;

typedef unsigned short bf16_t;
typedef short bf16x8 __attribute__((ext_vector_type(8)));
typedef float f32x4 __attribute__((ext_vector_type(4)));
typedef float f32x16 __attribute__((ext_vector_type(16)));
#define DEV __device__ __forceinline__

constexpr int T = 8192, D = 2048, NL = 2;
constexpr int INC = 4692;
constexpr int LDP = 4736;
constexpr int C_CA = 0, C_CG = 512, C_SU = 1024, C_SV = 1536;
constexpr int C_NQ = 2048, C_NKC = 2560, C_NVC = 2688, C_NKS = 2816, C_NVS = 2944, C_NKW = 3072, C_NVW = 3200;
constexpr int C_DQ = 3328, C_DK = 3840, C_DV = 3968, C_IQ = 4096, C_IK = 4608, C_NG = 4672, C_IW = 4688;
constexpr float EPS = 1e-6f;
constexpr int NTHREADS = 256;
constexpr int SMEM_BYTES = 72 * 1024;

__device__ const double INV16[16] = {1.0, 0.44036660267178046, 0.19392274474868576, 0.08539710028576561, 0.03760603093086393,
    0.016560440080994446, 0.007292664737217109, 0.003211445994752591, 0.001414213562373095, 0.000622772421914596,
    0.0002742481756762073, 0.00012076973741146504, 5.318295896944988e-05, 2.341999896140934e-05, 1.031338537721246e-05,
    4.5416704806078695e-06};

#define XCD_BAR_WORDS 3456
#define GQ_WORD(inst, x) (XCD_BAR_WORDS + 64 * ((inst) * 8 + (x)))
#define DQ_WORD(k) (XCD_BAR_WORDS + 64 * (96 + (k)))
#define CTRL_WORDS (XCD_BAR_WORDS + 64 * 112)
constexpr size_t WS_ALIGN(size_t x) { return (x + 255) & ~(size_t)255; }
constexpr size_t OFF_WinT = 0;
constexpr size_t OFF_WoutT = OFF_WinT + WS_ALIGN((size_t)2 * LDP * 2048 * 2);
constexpr size_t OFF_WqT = OFF_WoutT + WS_ALIGN((size_t)2 * 2048 * 2048 * 2);
constexpr size_t OFF_W1T = OFF_WqT + WS_ALIGN((size_t)2 * 1024 * 2048 * 2);
constexpr size_t OFF_PI = OFF_W1T + WS_ALIGN((size_t)4 * 128 * 4096 * 2);
constexpr size_t OFF_Utab = OFF_PI + WS_ALIGN(256);
constexpr size_t OFF_Vtab = OFF_Utab + WS_ALIGN((size_t)2 * 16384 * 1536);
constexpr size_t OFF_ada = OFF_Vtab + WS_ALIGN((size_t)2 * 16384 * 1536);
constexpr size_t OFF_ropeC = OFF_ada + WS_ALIGN((size_t)2 * 12288 * 4);
constexpr size_t OFF_ropeS = OFF_ropeC + WS_ALIGN((size_t)T * 24 * 4);
constexpr size_t OFF_HN = OFF_ropeS + WS_ALIGN((size_t)T * 24 * 4);
constexpr size_t OFF_PROJ = OFF_HN + WS_ALIGN((size_t)T * D * 2);
constexpr size_t OFF_Y = OFF_PROJ + WS_ALIGN((size_t)T * LDP * 2);
constexpr size_t OFF_QN = OFF_Y + WS_ALIGN((size_t)T * D * 2);
constexpr size_t OFF_QR = OFF_QN + WS_ALIGN((size_t)T * 512 * 2);
constexpr size_t OFF_KS = OFF_QR + WS_ALIGN((size_t)T * 512 * 2);
constexpr size_t OFF_KW = OFF_KS + WS_ALIGN((size_t)T * 128 * 2);
constexpr size_t OFF_VST = OFF_KW + WS_ALIGN((size_t)T * 128 * 2);
constexpr size_t OFF_VWT = OFF_VST + WS_ALIGN((size_t)T * 128 * 2);
constexpr size_t OFF_GATES = OFF_VWT + WS_ALIGN((size_t)T * 128 * 2);
constexpr size_t OFF_KC = OFF_GATES + WS_ALIGN((size_t)T * 12 * 4);
constexpr size_t OFF_VCT = OFF_KC + WS_ALIGN((size_t)512 * 128 * 2);
constexpr size_t OFF_SEL = OFF_VCT + WS_ALIGN((size_t)128 * 512 * 2);
constexpr size_t OFF_OCMP = OFF_SEL + WS_ALIGN((size_t)T * 4 * 4);
constexpr size_t OFF_DQ = OFF_OCMP + WS_ALIGN((size_t)T * 512 * 2);
constexpr size_t OFF_DK = OFF_DQ + WS_ALIGN((size_t)T * 512 * 2);
constexpr size_t OFF_DVC = OFF_DK + WS_ALIGN((size_t)T * 128 * 2);
constexpr size_t OFF_IQ = OFF_DVC + WS_ALIGN((size_t)T * 128 * 2);
constexpr size_t OFF_IK = OFF_IQ + WS_ALIGN((size_t)T * 512 * 2);
constexpr size_t OFF_IW = OFF_IK + WS_ALIGN((size_t)T * 64 * 2);
constexpr size_t OFF_IDX = OFF_IW + WS_ALIGN((size_t)T * 8 * 4);
constexpr size_t OFF_CNT = OFF_IDX + WS_ALIGN((size_t)T * 256 * 4);
constexpr size_t OFF_X1 = OFF_CNT + WS_ALIGN((size_t)T * 4);
constexpr size_t OFF_X2 = OFF_X1 + WS_ALIGN((size_t)T * D * 4);
constexpr size_t OFF_PQ = OFF_X2 + WS_ALIGN((size_t)T * D * 4);
constexpr size_t OFF_PE = OFF_PQ + WS_ALIGN((size_t)T * 1024 * 4);
constexpr size_t OFF_PG = OFF_PE + WS_ALIGN((size_t)T * 128 * 4);
constexpr size_t OFF_bar = OFF_PG + WS_ALIGN((size_t)T * 128 * 4);
constexpr size_t WS_TOTAL = OFF_bar + WS_ALIGN((size_t)CTRL_WORDS * 4);

struct P {
    const float* x; const float* c; const int* pos; const float* ada_w; const float* ada_b; const float* n1g; const float* n2g;
    const float* w_in; const float* w_out; const float* conv_w; const float* conv_b; const float* cln_g; const float* cln_b;
    const float* sln_g; const float* sln_b; const float* sgu_w; const float* sgu_b; const float* nsa_qg; const float* nsa_kg;
    const float* cmp_pos; const float* cmp_w1; const float* cmp_w2; const float* dsa_qg; const float* dsa_kg;
    const float* peer_wq; const float* peer_sk; const float* peer_u; const float* peer_v;
    float* out;
    char* ws;
    __host__ __device__ __forceinline__ bf16_t* WinT() const { return (bf16_t*)(ws + OFF_WinT); }
    __host__ __device__ __forceinline__ bf16_t* WoutT() const { return (bf16_t*)(ws + OFF_WoutT); }
    __host__ __device__ __forceinline__ bf16_t* WqT() const { return (bf16_t*)(ws + OFF_WqT); }
    __host__ __device__ __forceinline__ bf16_t* W1T() const { return (bf16_t*)(ws + OFF_W1T); }
    __host__ __device__ __forceinline__ int* PI() const { return (int*)(ws + OFF_PI); }
    __host__ __device__ __forceinline__ unsigned char* Utab() const { return (unsigned char*)(ws + OFF_Utab); }
    __host__ __device__ __forceinline__ unsigned char* Vtab() const { return (unsigned char*)(ws + OFF_Vtab); }
    __host__ __device__ __forceinline__ float* ada() const { return (float*)(ws + OFF_ada); }
    __host__ __device__ __forceinline__ float* ropeC() const { return (float*)(ws + OFF_ropeC); }
    __host__ __device__ __forceinline__ float* ropeS() const { return (float*)(ws + OFF_ropeS); }
    __host__ __device__ __forceinline__ bf16_t* HN() const { return (bf16_t*)(ws + OFF_HN); }
    __host__ __device__ __forceinline__ bf16_t* PROJ() const { return (bf16_t*)(ws + OFF_PROJ); }
    __host__ __device__ __forceinline__ bf16_t* Y() const { return (bf16_t*)(ws + OFF_Y); }
    __host__ __device__ __forceinline__ bf16_t* QN() const { return (bf16_t*)(ws + OFF_QN); }
    __host__ __device__ __forceinline__ bf16_t* QR() const { return (bf16_t*)(ws + OFF_QR); }
    __host__ __device__ __forceinline__ bf16_t* KS() const { return (bf16_t*)(ws + OFF_KS); }
    __host__ __device__ __forceinline__ bf16_t* KW() const { return (bf16_t*)(ws + OFF_KW); }
    __host__ __device__ __forceinline__ bf16_t* VST() const { return (bf16_t*)(ws + OFF_VST); }
    __host__ __device__ __forceinline__ bf16_t* VWT() const { return (bf16_t*)(ws + OFF_VWT); }
    __host__ __device__ __forceinline__ float* GATES() const { return (float*)(ws + OFF_GATES); }
    __host__ __device__ __forceinline__ bf16_t* KC() const { return (bf16_t*)(ws + OFF_KC); }
    __host__ __device__ __forceinline__ bf16_t* VCT() const { return (bf16_t*)(ws + OFF_VCT); }
    __host__ __device__ __forceinline__ unsigned* SEL() const { return (unsigned*)(ws + OFF_SEL); }
    __host__ __device__ __forceinline__ bf16_t* OCMP() const { return (bf16_t*)(ws + OFF_OCMP); }
    __host__ __device__ __forceinline__ bf16_t* DQ() const { return (bf16_t*)(ws + OFF_DQ); }
    __host__ __device__ __forceinline__ bf16_t* DK() const { return (bf16_t*)(ws + OFF_DK); }
    __host__ __device__ __forceinline__ bf16_t* DVC() const { return (bf16_t*)(ws + OFF_DVC); }
    __host__ __device__ __forceinline__ bf16_t* IQ() const { return (bf16_t*)(ws + OFF_IQ); }
    __host__ __device__ __forceinline__ bf16_t* IK() const { return (bf16_t*)(ws + OFF_IK); }
    __host__ __device__ __forceinline__ float* IW() const { return (float*)(ws + OFF_IW); }
    __host__ __device__ __forceinline__ int* IDX() const { return (int*)(ws + OFF_IDX); }
    __host__ __device__ __forceinline__ int* CNT() const { return (int*)(ws + OFF_CNT); }
    __host__ __device__ __forceinline__ float* X1() const { return (float*)(ws + OFF_X1); }
    __host__ __device__ __forceinline__ float* X2() const { return (float*)(ws + OFF_X2); }
    __host__ __device__ __forceinline__ float* PQ() const { return (float*)(ws + OFF_PQ); }
    __host__ __device__ __forceinline__ int* PE() const { return (int*)(ws + OFF_PE); }
    __host__ __device__ __forceinline__ float* PG() const { return (float*)(ws + OFF_PG); }
    __host__ __device__ __forceinline__ unsigned* bar() const { return (unsigned*)(ws + OFF_bar); }
};

DEV float bf2f(bf16_t v) { return __uint_as_float(((unsigned)v) << 16); }
DEV unsigned pk2(float lo, float hi) { unsigned r; asm("v_cvt_pk_bf16_f32 %0, %1, %2" : "=v"(r) : "v"(lo), "v"(hi)); return r; }
DEV bf16_t f2bf(float v) { return (bf16_t)(pk2(v, 0.f) & 0xffffu); }
DEV float lo2f(unsigned u) { return __uint_as_float(u << 16); }
DEV float hi2f(unsigned u) { return __uint_as_float(u & 0xffff0000u); }
#define DPP_ROR_F(V, N) __int_as_float(__builtin_amdgcn_update_dpp(0, __float_as_int(V), 0x120 + (N), 0xf, 0xf, false))
DEV float wsum(float v) {
    v += DPP_ROR_F(v, 8); v += DPP_ROR_F(v, 4); v += DPP_ROR_F(v, 2); v += DPP_ROR_F(v, 1);
    const int vi = __float_as_int(v);
    return (__int_as_float(__builtin_amdgcn_readlane(vi, 0)) + __int_as_float(__builtin_amdgcn_readlane(vi, 16))) +
           (__int_as_float(__builtin_amdgcn_readlane(vi, 32)) + __int_as_float(__builtin_amdgcn_readlane(vi, 48)));
}
DEV float wmax(float v) {
    v = fmaxf(v, DPP_ROR_F(v, 8)); v = fmaxf(v, DPP_ROR_F(v, 4)); v = fmaxf(v, DPP_ROR_F(v, 2)); v = fmaxf(v, DPP_ROR_F(v, 1));
    const int vi = __float_as_int(v);
    return fmaxf(fmaxf(__int_as_float(__builtin_amdgcn_readlane(vi, 0)), __int_as_float(__builtin_amdgcn_readlane(vi, 16))),
                 fmaxf(__int_as_float(__builtin_amdgcn_readlane(vi, 32)), __int_as_float(__builtin_amdgcn_readlane(vi, 48))));
}
DEV int tidx() { int t = threadIdx.x; asm volatile("" : "+v"(t)); return t; }
DEV float sigmoidf_(float x) { return 1.0f / (1.0f + __expf(-x)); }
DEV float gelu_tanh(float x) {
    const float y = 0.7978845608028654f * (x + 0.044715f * x * x * x);
    const float t = 1.0f - 2.0f / (1.0f + __expf(2.0f * y));
    return 0.5f * x * (1.0f + t);
}
DEV f32x4 mfma16(bf16x8 a, bf16x8 b, f32x4 c) { return __builtin_amdgcn_mfma_f32_16x16x32_bf16(a, b, c, 0, 0, 0); }
DEV f32x16 mfma32(bf16x8 a, bf16x8 b, f32x16 c) { return __builtin_amdgcn_mfma_f32_32x32x16_bf16(a, b, c, 0, 0, 0); }

DEV int src_col(int n) {
    if (n < 3328) return n;
    if (n < 4672) return 3340 + (n - 3328);
    if (n < 4684) return 3328 + (n - 4672);
    if (n < 4688) return -1;
    if (n < 4696) return 4684 + (n - 4688);
    return -1;
}

DEV void st_convT(const float* __restrict__ W, bf16_t* __restrict__ Bt, int N, int Npad, bool remap, int unit, char* smem, int Kdim = 2048) {
    float (*tile)[65] = (float (*)[65])smem;
    const int ntn = Npad / 64, kt = unit / ntn, nt = unit % ntn, k0 = kt * 64, n0 = nt * 64;
    const int tid_ = tidx(); const int tx = tid_ & 63, ty = tid_ >> 6;
    const int n = n0 + tx;
    const int src = remap ? src_col(n) : (n < N ? n : -1);
#pragma unroll
    for (int i = 0; i < 16; ++i) { const int k = ty + 4 * i; tile[k][tx] = src >= 0 ? W[(size_t)(k0 + k) * N + src] : 0.f; }
    __syncthreads();
#pragma unroll
    for (int i = 0; i < 16; ++i) { const int r = ty + 4 * i; Bt[(size_t)(n0 + r) * Kdim + k0 + tx] = f2bf(tile[tx][r]); }
    __syncthreads();
}

typedef float f32x2 __attribute__((ext_vector_type(2)));
typedef float v16f __attribute__((ext_vector_type(16)));
typedef float v32f __attribute__((ext_vector_type(32)));
typedef unsigned v6u __attribute__((ext_vector_type(6)));
constexpr float U6_SCALE = 64.0f, V6_SCALE = 3.0f;
constexpr int ROW6 = 1536;
#define FP6_ONE __uint_as_float(0x3F80007Fu)

#ifndef SW_FP6
#define SW_FP6 1
#endif
DEV unsigned fp6_enc1(float f) {
    const float a = fminf(fabsf(f), 7.5f);
    const float sc = a < 2.0f ? 8.0f : (a < 4.0f ? 4.0f : 2.0f), of = a < 2.0f ? 0.0f : (a < 4.0f ? 8.0f : 16.0f);
    const unsigned code = (unsigned)(int)__builtin_rintf(a * sc + of);
    return code | ((__float_as_uint(f) >> 26) & 32u);
}
DEV float fp6_dec1(unsigned c) {
    const unsigned e = (c >> 3) & 3u, m = c & 7u;
    const float v = e == 0u ? 0.125f * (float)m : (1.0f + 0.125f * (float)m) * (float)(1u << (e - 1u));
    return (c & 32u) ? -v : v;
}
DEV v6u sw_pack32(const v16f& x, const v16f& y) {
    unsigned w[6] = {0u, 0u, 0u, 0u, 0u, 0u};
#pragma unroll
    for (int i = 0; i < 32; ++i) {
        const unsigned c = fp6_enc1(i < 16 ? x[i] : y[i - 16]);
        const int bit = 6 * i, d = bit >> 5, sh = bit & 31;
        w[d] |= c << sh;
        if (sh > 26) w[d + 1] |= c >> (32 - sh);
    }
    v6u r; r[0] = w[0]; r[1] = w[1]; r[2] = w[2]; r[3] = w[3]; r[4] = w[4]; r[5] = w[5]; return r;
}
DEV v32f sw_unpack32(const v6u& pk) {
    const unsigned w[6] = {pk[0], pk[1], pk[2], pk[3], pk[4], pk[5]};
    v32f r;
#pragma unroll
    for (int i = 0; i < 32; ++i) {
        const int bit = 6 * i, d = bit >> 5, sh = bit & 31;
        unsigned c = w[d] >> sh;
        if (sh > 26) c |= w[d + 1] << (32 - sh);
        r[i] = fp6_dec1(c & 63u);
    }
    return r;
}
#define FP6_PACK(x, y) sw_pack32(x, y)
#define FP6_UNPACK(pk) __builtin_amdgcn_cvt_scalef32_pk32_f32_fp6(pk, FP6_ONE)
DEV void st_tab6(const float* __restrict__ src, unsigned char* __restrict__ dst, float scale, int nrows, int unit, int nunits, char* smem) {
    const int tid_ = tidx(), w = tid_ >> 6, l = tid_ & 63;
    float* stg = (float*)smem + w * (64 * 36);
    for (int r = unit * 4 + w; r < nrows; r += nunits * 4) {
        const float4* sp = (const float4*)(src + (size_t)r * 2048);
        float4 v[8];
#pragma unroll
        for (int i = 0; i < 8; ++i) v[i] = sp[l + 64 * i];
#pragma unroll
        for (int i = 0; i < 8; ++i) { const int f = l + 64 * i; *(float4*)(stg + (f >> 3) * 36 + (f & 7) * 4) = v[i]; }
        __builtin_amdgcn_wave_barrier();
        v16f x, y;
#pragma unroll
        for (int q = 0; q < 4; ++q) {
            const float4 a = *(const float4*)(stg + l * 36 + q * 4), b = *(const float4*)(stg + l * 36 + 16 + q * 4);
            x[4 * q] = a.x * scale; x[4 * q + 1] = a.y * scale; x[4 * q + 2] = a.z * scale; x[4 * q + 3] = a.w * scale;
            y[4 * q] = b.x * scale; y[4 * q + 1] = b.y * scale; y[4 * q + 2] = b.z * scale; y[4 * q + 3] = b.w * scale;
        }
        const v6u pk = FP6_PACK(x, y);
        unsigned char* dp = dst + (size_t)r * ROW6 + l * 8;
        *(uint2*)(dp) = make_uint2(pk[0], pk[1]); *(uint2*)(dp + 512) = make_uint2(pk[2], pk[3]); *(uint2*)(dp + 1024) = make_uint2(pk[4], pk[5]);
        __builtin_amdgcn_wave_barrier();
    }
}
DEV void st_calib(const P& p) {
    if (tidx() >= 64) return;
    v16f x, y;
#pragma unroll
    for (int k = 0; k < 32; ++k) {
        const int e = k >> 3, m = k & 7;
        const float v = e == 0 ? 0.125f * m : (1.0f + 0.125f * m) * (float)(1 << (e - 1));
        if (k < 16) x[k] = v; else y[k - 16] = v;
    }
    const v6u pk = FP6_PACK(x, y);
    const v32f d = FP6_UNPACK(pk);
    if ((threadIdx.x & 63) == 0) {
        float dmax = 0.f;
#pragma unroll
        for (int j = 0; j < 32; ++j) dmax = fmaxf(dmax, fabsf(d[j]));
        const float cscale = dmax > 0.f ? dmax * (1.0f / 7.5f) : 1.0f;
        const float ic = 1.0f / cscale;
#pragma unroll
        for (int j = 0; j < 32; ++j) {
            int found = j;
#pragma unroll
            for (int k = 0; k < 32; ++k) {
                const int e = k >> 3, m = k & 7;
                const float v = e == 0 ? 0.125f * m : (1.0f + 0.125f * m) * (float)(1 << (e - 1));
                if (fabsf(d[j] * ic - v) < 0.02f + 0.01f * v) found = k;
            }
            p.PI()[j] = found;
        }
        p.PI()[32] = __float_as_int(ic);
    }
}

DEV void st_ada(const P& p, int unit, char* smem) {
    float4* red = (float4*)smem;
    const int tid = tidx(), c4 = tid & 15, kg = tid >> 4;
    const int i = unit / 192, j = (unit % 192) * 64 + c4 * 4;
    const float* W = p.ada_w + (size_t)i * 2048 * 12288 + (size_t)kg * 12288 + j;
    float4 acc = make_float4(0.f, 0.f, 0.f, 0.f);
#pragma unroll 1
    for (int k0 = 0; k0 < 128; k0 += 16) {
        float4 wv[16]; float a[16];
#pragma unroll
        for (int q = 0; q < 16; ++q) { const f32x4 t4 = __builtin_nontemporal_load((const f32x4*)(W + (size_t)(16 * (k0 + q)) * 12288)); wv[q] = make_float4(t4[0], t4[1], t4[2], t4[3]); }
#pragma unroll
        for (int q = 0; q < 16; ++q) { const float cv = p.c[kg + 16 * (k0 + q)]; a[q] = cv * sigmoidf_(cv); }
#pragma unroll
        for (int q = 0; q < 16; ++q) { acc.x += a[q] * wv[q].x; acc.y += a[q] * wv[q].y; acc.z += a[q] * wv[q].z; acc.w += a[q] * wv[q].w; }
    }
    red[kg * 16 + c4] = acc;
    __syncthreads();
    if (tid < 64) {
        const int cc = tid >> 2, e = tid & 3;
        float r = p.ada_b[i * 12288 + (unit % 192) * 64 + tid];
#pragma unroll
        for (int q = 0; q < 16; ++q) r += ((const float*)&red[q * 16 + cc])[e];
        p.ada()[i * 12288 + (unit % 192) * 64 + tid] = r;
    }
    __syncthreads();
}
DEV void st_rope(const P& p, int unit) {
    const int e = unit * 256 + tidx(); const int t = e / 24, i = e % 24;
    const double inv = i < 16 ? INV16[i] : INV16[2 * (i - 16)];
    const double ang = (double)p.pos[t] * inv;
    const double n = rint(ang * 0.15915494309189535);
    const double r = ang - n * 6.283185307179586;
    const double r2 = r * r;
    double sp = 1.0 / 1.5511210043330986e25, cp = -1.0 / 4.0329146112660565e26;
    sp = sp * r2 - 1.0 / 2.585201673888498e22;   cp = cp * r2 + 1.0 / 6.204484017332394e23;
    sp = sp * r2 + 1.0 / 5.109094217170944e19;   cp = cp * r2 - 1.0 / 1.1240007277776077e21;
    sp = sp * r2 - 1.0 / 1.21645100408832e17;    cp = cp * r2 + 1.0 / 2.43290200817664e18;
    sp = sp * r2 + 1.0 / 3.55687428096e14;       cp = cp * r2 - 1.0 / 6.402373705728e15;
    sp = sp * r2 - 1.0 / 1.307674368e12;         cp = cp * r2 + 1.0 / 2.0922789888e13;
    sp = sp * r2 + 1.0 / 6.2270208e9;            cp = cp * r2 - 1.0 / 8.71782912e10;
    sp = sp * r2 - 1.0 / 3.99168e7;              cp = cp * r2 + 1.0 / 4.790016e8;
    sp = sp * r2 + 1.0 / 362880.0;               cp = cp * r2 - 1.0 / 3628800.0;
    sp = sp * r2 - 1.0 / 5040.0;                 cp = cp * r2 + 1.0 / 40320.0;
    sp = sp * r2 + 1.0 / 120.0;                  cp = cp * r2 - 1.0 / 720.0;
    sp = sp * r2 - 1.0 / 6.0;                    cp = cp * r2 + 1.0 / 24.0;
    sp = sp * r2 + 1.0;                          cp = cp * r2 - 0.5;
    cp = cp * r2 + 1.0;
    const float cs = (float)cp, sn = (float)(sp * r);
    p.ropeC()[e] = cs; p.ropeS()[e] = sn;
}

DEV void st_norm(const float* __restrict__ X, const float* __restrict__ g, const float* __restrict__ sc, const float* __restrict__ sh,
                 bf16_t* __restrict__ HN, int unit) {
    const int tid_ = tidx(); const int w = tid_ >> 6, l = tid_ & 63; const int t = unit * 4 + w;
    const float4* xr = (const float4*)(X + (size_t)t * D);
    float4 v[8]; float ss = 0.f;
#pragma unroll
    for (int i = 0; i < 4; ++i) { v[2 * i] = xr[i * 128 + l * 2]; v[2 * i + 1] = xr[i * 128 + l * 2 + 1]; }
#pragma unroll
    for (int i = 0; i < 8; ++i) ss += v[i].x * v[i].x + v[i].y * v[i].y + v[i].z * v[i].z + v[i].w * v[i].w;
    ss = wsum(ss);
    const float rs = rsqrtf(ss * (1.0f / 2048.0f) + EPS);
#pragma unroll
    for (int i = 0; i < 4; ++i) {
        const int col = i * 512 + l * 8;
        float y[8]; const float xv[8] = {v[2 * i].x, v[2 * i].y, v[2 * i].z, v[2 * i].w, v[2 * i + 1].x, v[2 * i + 1].y, v[2 * i + 1].z, v[2 * i + 1].w};
#pragma unroll
        for (int j = 0; j < 8; ++j) y[j] = (xv[j] * rs) * g[col + j] * (1.0f + sc[col + j]) + sh[col + j];
        uint4 o; o.x = pk2(y[0], y[1]); o.y = pk2(y[2], y[3]); o.z = pk2(y[4], y[5]); o.w = pk2(y[6], y[7]);
        *(uint4*)(HN + (size_t)t * D + col) = o;
    }
}

enum { EPI_PROJ = 0, EPI_OUT = 1, EPI_Q = 2 };
struct EpiArgs { bf16_t* obf; float* of; const float* xin; const float* gate; };
template <int EPI, int MT = 4>
DEV void st_gemm(const bf16_t* __restrict__ A, const bf16_t* __restrict__ Bt, int K, int tm, int tn, const EpiArgs& e, char* smem) {
    constexpr int BM = 32 * MT, ABYTES = BM * 64, BUFB = ABYTES + 8192, NBUF = (MT == 4) ? 4 : 3, NA = BM / 64;
    static_assert(NBUF * BUFB <= SMEM_BYTES, "GEMM LDS");
    const int tid = tidx(), w = tid >> 6, l = tid & 63, wr = w >> 1, wc = w & 1;
    f32x4 acc[MT][4];
#pragma unroll
    for (int m = 0; m < MT; ++m)
#pragma unroll
        for (int n = 0; n < 4; ++n) acc[m][n] = (f32x4){0.f, 0.f, 0.f, 0.f};
    const int srow = tid >> 2, spc = tid & 3, sc = spc ^ (((srow >> 2) & 1) << 1);
    const bf16_t* Ag = A + (size_t)(tm * BM + srow) * K + sc * 8;
    const bf16_t* Bg = Bt + (size_t)(tn * 128 + srow) * K + sc * 8;
#define GEMM_STAGE(BUF, KO) do { char* _b = smem + (BUF) * BUFB + tid * 16; \
        _Pragma("unroll") for (int _i = 0; _i < NA; ++_i) \
            __builtin_amdgcn_global_load_lds((const unsigned*)(Ag + (size_t)(64 * _i) * K + (KO)), (__attribute__((address_space(3))) unsigned*)(_b + _i * 4096), 16, 0, 0); \
        __builtin_amdgcn_global_load_lds((const unsigned*)(Bg + (KO)), (__attribute__((address_space(3))) unsigned*)(_b + ABYTES), 16, 0, 0); \
        __builtin_amdgcn_global_load_lds((const unsigned*)(Bg + (size_t)64 * K + (KO)), (__attribute__((address_space(3))) unsigned*)(_b + ABYTES + 4096), 16, 0, 0); } while (0)
    const int nk = K / 32;
    GEMM_STAGE(0, 0); GEMM_STAGE(1, 32);
    if (NBUF == 4) { GEMM_STAGE(2, 64); asm volatile("s_waitcnt vmcnt(8)" ::: "memory"); }
    else asm volatile("s_waitcnt vmcnt(6)" ::: "memory");
    __builtin_amdgcn_s_barrier();
    const int fr = l & 15, fq = l >> 4;
    int cur = 0, nxt = NBUF - 1;
#pragma unroll 1
    for (int kt = 0; kt < nk; ++kt) {
        if (kt + NBUF - 1 < nk) GEMM_STAGE(nxt, (kt + NBUF - 1) * 32);
        const char* As = smem + cur * BUFB; const char* Bs = As + ABYTES;
        bf16x8 bfr[4];
#pragma unroll
        for (int n = 0; n < 4; ++n) { const int row = wc * 64 + n * 16 + fr; bfr[n] = *(const bf16x8*)(Bs + row * 64 + ((fq ^ (((row >> 2) & 1) << 1)) << 4)); }
#pragma unroll
        for (int m = 0; m < MT; ++m) {
            const int row = wr * (BM / 2) + m * 16 + fr;
            const bf16x8 af = *(const bf16x8*)(As + row * 64 + ((fq ^ (((row >> 2) & 1) << 1)) << 4));
#pragma unroll
            for (int n = 0; n < 4; ++n) acc[m][n] = mfma16(bfr[n], af, acc[m][n]);
        }
        if (NBUF == 4) {
            if (kt + 3 < nk) asm volatile("s_waitcnt vmcnt(8)" ::: "memory");
            else if (kt + 2 < nk) asm volatile("s_waitcnt vmcnt(4)" ::: "memory");
            else asm volatile("s_waitcnt vmcnt(0)" ::: "memory");
        } else {
            if (kt + 2 < nk) asm volatile("s_waitcnt vmcnt(6)" ::: "memory");
            else asm volatile("s_waitcnt vmcnt(0)" ::: "memory");
        }
        asm volatile("s_waitcnt lgkmcnt(0)" ::: "memory");
        __builtin_amdgcn_s_barrier();
        cur = (cur + 1 == NBUF) ? 0 : cur + 1; nxt = (nxt + 1 == NBUF) ? 0 : nxt + 1;
    }
#undef GEMM_STAGE
#pragma unroll
    for (int m = 0; m < MT; ++m) {
        const int row = tm * BM + wr * (BM / 2) + m * 16 + (l & 15);
#pragma unroll
        for (int n = 0; n < 4; ++n) {
            const int col = tn * 128 + wc * 64 + n * 16 + 4 * (l >> 4);
            const f32x4 a = acc[m][n];
            if (EPI == EPI_PROJ) {
                uint2 o; o.x = pk2(a[0], a[1]); o.y = pk2(a[2], a[3]);
                *(uint2*)(e.obf + (size_t)row * LDP + col) = o;
            } else if (EPI == EPI_OUT) {
                const float4 xi = *(const float4*)(e.xin + (size_t)row * D + col);
                const float4 gg = *(const float4*)(e.gate + col);
                float4 o; o.x = xi.x + gg.x * a[0]; o.y = xi.y + gg.y * a[1]; o.z = xi.z + gg.z * a[2]; o.w = xi.w + gg.w * a[3];
                *(float4*)(e.of + (size_t)row * D + col) = o;
            } else {
                float4 o; o.x = a[0]; o.y = a[1]; o.z = a[2]; o.w = a[3];
                *(float4*)(e.of + (size_t)row * 1024 + col) = o;
            }
        }
    }
    __syncthreads();
}

DEV void st_conv(const P& p, int layer, int unit, char* smem) {
    float* cs = (float*)smem;
    const int tid = tidx(), t0 = unit * 16;
    const float* cw = p.conv_w + (size_t)layer * 31 * 512;
#pragma unroll 1
    for (int cc = 0; cc < 2; ++cc) {
        const int c = tid + 256 * cc;
        float w[31], z[46];
#pragma unroll
        for (int k = 0; k < 31; ++k) w[k] = cw[k * 512 + c];
#pragma unroll
        for (int r = 0; r < 46; ++r) {
            const int t = t0 - 30 + r, tc = t < 0 ? 0 : t;
            const float a = bf2f(p.PROJ()[(size_t)tc * LDP + C_CA + c]), g = bf2f(p.PROJ()[(size_t)tc * LDP + C_CG + c]);
            z[r] = t >= 0 ? a * sigmoidf_(g) : 0.f;
        }
        const float cb = p.conv_b[layer * 512 + c];
#pragma unroll
        for (int tt = 0; tt < 16; ++tt) {
            float acc = cb;
#pragma unroll
            for (int k = 0; k < 31; ++k) acc += w[k] * z[tt + k];
            cs[tt * 512 + c] = acc;
        }
    }
    __syncthreads();
    const int w = tid >> 6, l = tid & 63;
    const float* lg = p.cln_g + layer * 512; const float* lb = p.cln_b + layer * 512;
#pragma unroll 1
    for (int q = 0; q < 4; ++q) {
        const int tt = w * 4 + q;
        float v[8]; float s = 0.f;
#pragma unroll
        for (int i = 0; i < 8; ++i) { v[i] = cs[tt * 512 + l + 64 * i]; s += v[i]; }
        const float mean = wsum(s) * (1.0f / 512.0f);
        float q2 = 0.f;
#pragma unroll
        for (int i = 0; i < 8; ++i) { const float d = v[i] - mean; q2 += d * d; }
        const float rstd = rsqrtf(wsum(q2) * (1.0f / 512.0f) + EPS);
#pragma unroll
        for (int i = 0; i < 8; ++i) {
            const int c = l + 64 * i;
            const float y = (v[i] - mean) * rstd * lg[c] + lb[c];
            p.Y()[(size_t)(t0 + tt) * D + c] = f2bf(y * sigmoidf_(y));
        }
    }
    __syncthreads();
}

DEV void st_sgu(const P& p, int layer, int unit, char* smem) {
    const int n = unit >> 2, h = unit & 3, tid = tidx(), w = tid >> 6, l = tid & 63;
    float* stat = (float*)smem;
    float* wt = stat + 256;
    float* vt = wt + 16 * 132;
    const int tb = n * 128;
#pragma unroll 1
    for (int q = 0; q < 32; ++q) {
        const int j = w * 32 + q;
        const uint4 raw = *(const uint4*)(p.PROJ() + (size_t)(tb + j) * LDP + C_SV + l * 8);
        float v[8] = {lo2f(raw.x), hi2f(raw.x), lo2f(raw.y), hi2f(raw.y), lo2f(raw.z), hi2f(raw.z), lo2f(raw.w), hi2f(raw.w)};
        float s = 0.f;
#pragma unroll
        for (int i = 0; i < 8; ++i) s += v[i];
        const float mean = wsum(s) * (1.0f / 512.0f);
        float q2 = 0.f;
#pragma unroll
        for (int i = 0; i < 8; ++i) { const float d = v[i] - mean; q2 += d * d; }
        const float rstd = rsqrtf(wsum(q2) * (1.0f / 512.0f) + EPS);
        if (l == 0) { stat[j * 2] = mean; stat[j * 2 + 1] = rstd; }
    }
    __syncthreads();
    const int ti = tid >> 4, td = tid & 15;
    float acc[8][8];
#pragma unroll
    for (int a = 0; a < 8; ++a)
#pragma unroll
        for (int b = 0; b < 8; ++b) acc[a][b] = 0.f;
    const float* Wh = p.sgu_w + ((size_t)layer * 4 + h) * 128 * 128;
    const float* lg = p.sln_g + layer * 512 + h * 128; const float* lb = p.sln_b + layer * 512 + h * 128;
#pragma unroll 1
    for (int jc = 0; jc < 8; ++jc) {
#pragma unroll 2
        for (int q = 0; q < 8; ++q) {
            const int e = tid + 256 * q;
            { const int i = e >> 4, jj = e & 15, j = jc * 16 + jj; wt[jj * 132 + i] = (i >= j) ? Wh[i * 128 + j] : 0.f; }
            { const int jj = e >> 7, d = e & 127, j = jc * 16 + jj;
              const float x = bf2f(p.PROJ()[(size_t)(tb + j) * LDP + C_SV + h * 128 + d]);
              vt[jj * 128 + d] = (x - stat[j * 2]) * stat[j * 2 + 1] * lg[d] + lb[d]; }
        }
        __syncthreads();
        if (w * 32 + 31 >= jc * 16) {
#pragma unroll 2
            for (int jj = 0; jj < 16; ++jj) {
                const float4 w0 = *(const float4*)(wt + jj * 132 + ti * 8), w1 = *(const float4*)(wt + jj * 132 + ti * 8 + 4);
                const float4 v0 = *(const float4*)(vt + jj * 128 + td * 8), v1 = *(const float4*)(vt + jj * 128 + td * 8 + 4);
                const float wv[8] = {w0.x, w0.y, w0.z, w0.w, w1.x, w1.y, w1.z, w1.w};
                const float vv[8] = {v0.x, v0.y, v0.z, v0.w, v1.x, v1.y, v1.z, v1.w};
#pragma unroll
                for (int a = 0; a < 8; ++a)
#pragma unroll
                    for (int b = 0; b < 8; ++b) acc[a][b] += wv[a] * vv[b];
            }
        }
        __syncthreads();
    }
#pragma unroll
    for (int a = 0; a < 8; ++a) {
        const int i = ti * 8 + a; const size_t t = tb + i;
        const float bs = p.sgu_b[((size_t)layer * 4 + h) * 128 + i];
        const uint4 ur = *(const uint4*)(p.PROJ() + t * LDP + C_SU + h * 128 + td * 8);
        const float u[8] = {lo2f(ur.x), hi2f(ur.x), lo2f(ur.y), hi2f(ur.y), lo2f(ur.z), hi2f(ur.z), lo2f(ur.w), hi2f(ur.w)};
        float y[8];
#pragma unroll
        for (int b = 0; b < 8; ++b) y[b] = u[b] * (acc[a][b] + bs);
        uint4 o; o.x = pk2(y[0], y[1]); o.y = pk2(y[2], y[3]); o.z = pk2(y[4], y[5]); o.w = pk2(y[6], y[7]);
        *(uint4*)(p.Y() + t * D + 512 + h * 128 + td * 8) = o;
    }
}

DEV void st_vtrans(const P& p, int unit, char* smem) {
    bf16_t* tile = (bf16_t*)smem;
    const int which = unit & 1, tt0 = (unit >> 1) * 64, tid = tidx();
    const int col0 = which ? C_NVW : C_NVS;
    bf16_t* dst = which ? p.VWT() : p.VST();
#pragma unroll
    for (int q = 0; q < 4; ++q) {
        const int e = tid + 256 * q; const int r = e >> 4, c8 = e & 15;
        const uint4 raw = *(const uint4*)(p.PROJ() + (size_t)(tt0 + r) * LDP + col0 + c8 * 8);
        unsigned* d32 = (unsigned*)(tile + r * 130 + c8 * 8);
        d32[0] = raw.x; d32[1] = raw.y; d32[2] = raw.z; d32[3] = raw.w;
    }
    __syncthreads();
    const int d = tid >> 1, half = tid & 1;
    unsigned o[16];
#pragma unroll
    for (int i = 0; i < 16; ++i) {
        const unsigned a = tile[(half * 32 + 2 * i) * 130 + d], b = tile[(half * 32 + 2 * i + 1) * 130 + d];
        o[i] = a | (b << 16);
    }
    uint4* dp = (uint4*)(dst + (size_t)d * T + tt0 + half * 32);
#pragma unroll
    for (int i = 0; i < 4; ++i) dp[i] = make_uint4(o[4 * i], o[4 * i + 1], o[4 * i + 2], o[4 * i + 3]);
    __syncthreads();
}

DEV void st_prep(const P& p, int layer, int unit) {
    const int tid_ = tidx(); const int w = tid_ >> 6, l = tid_ & 63; const size_t t = (size_t)unit * 4 + w;
    const bf16_t* row = p.PROJ() + t * LDP;
    const float* rc = p.ropeC() + t * 24; const float* rs_ = p.ropeS() + t * 24;
    unsigned raw[11];
#pragma unroll
    for (int h = 0; h < 4; ++h) { raw[h] = *(const unsigned*)(row + C_NQ + h * 128 + 2 * l); raw[6 + h] = *(const unsigned*)(row + C_DQ + h * 128 + 2 * l); }
    raw[4] = *(const unsigned*)(row + C_NKS + 2 * l); raw[5] = *(const unsigned*)(row + C_NKW + 2 * l); raw[10] = *(const unsigned*)(row + C_DK + 2 * l);
    bf16_t iraw[9];
#pragma unroll
    for (int h = 0; h < 9; ++h) iraw[h] = row[(h < 8 ? C_IQ + h * 64 : C_IK) + l];
    const float gq0 = p.nsa_qg[layer * 128 + 2 * l], gq1 = p.nsa_qg[layer * 128 + 2 * l + 1];
    const float gs0 = p.nsa_kg[(layer * 3 + 1) * 128 + 2 * l], gs1 = p.nsa_kg[(layer * 3 + 1) * 128 + 2 * l + 1];
    const float gw0 = p.nsa_kg[(layer * 3 + 2) * 128 + 2 * l], gw1 = p.nsa_kg[(layer * 3 + 2) * 128 + 2 * l + 1];
    const float dq0 = p.dsa_qg[layer * 128 + 2 * l], dq1 = p.dsa_qg[layer * 128 + 2 * l + 1];
    const float dk0 = p.dsa_kg[layer * 128 + 2 * l], dk1 = p.dsa_kg[layer * 128 + 2 * l + 1];
    const float c0 = rc[(2 * l) & 15], c1 = rc[(2 * l + 1) & 15], s0 = rs_[(2 * l) & 15], s1 = rs_[(2 * l + 1) & 15];
    const float ic = rc[16 + (l & 7)], is = rs_[16 + (l & 7)];
    float x0[11], x1[11], ss[11];
#pragma unroll
    for (int h = 0; h < 11; ++h) { x0[h] = lo2f(raw[h]); x1[h] = hi2f(raw[h]); ss[h] = x0[h] * x0[h] + x1[h] * x1[h]; }
#pragma unroll
    for (int h = 0; h < 11; ++h) ss[h] = wsum(ss[h]);
#pragma unroll
    for (int h = 0; h < 11; ++h) {
        const float r = rsqrtf(ss[h] * (1.0f / 128.0f) + EPS);
        const float g0 = h < 4 ? gq0 : (h == 4 ? gs0 : (h == 5 ? gw0 : (h < 10 ? dq0 : dk0)));
        const float g1 = h < 4 ? gq1 : (h == 4 ? gs1 : (h == 5 ? gw1 : (h < 10 ? dq1 : dk1)));
        const float n0 = x0[h] * r * g0, n1 = x1[h] * r * g1;
        const float o0 = __shfl_xor(n0, 8), o1 = __shfl_xor(n1, 8);
        float r0 = n0, r1 = n1;
        if (l < 8) { r0 = n0 * c0 - o0 * s0; r1 = n1 * c1 - o1 * s1; }
        else if (l < 16) { r0 = n0 * c0 + o0 * s0; r1 = n1 * c1 + o1 * s1; }
        const unsigned roped = pk2(r0, r1);
        if (h < 4) { *(unsigned*)(p.QN() + (t * 4 + h) * 128 + 2 * l) = pk2(n0, n1); *(unsigned*)(p.QR() + (t * 4 + h) * 128 + 2 * l) = roped; }
        else if (h == 4) *(unsigned*)(p.KS() + t * 128 + 2 * l) = roped;
        else if (h == 5) *(unsigned*)(p.KW() + t * 128 + 2 * l) = roped;
        else if (h < 10) *(unsigned*)(p.DQ() + (t * 4 + (h - 6)) * 128 + 2 * l) = roped;
        else *(unsigned*)(p.DK() + t * 128 + 2 * l) = roped;
    }
    if (l < 12) p.GATES()[t * 12 + l] = sigmoidf_(bf2f(row[C_NG + l]));
    *(unsigned*)(p.DVC() + t * 128 + 2 * l) = *(const unsigned*)(row + C_DV + 2 * l);
#pragma unroll
    for (int h = 0; h < 9; ++h) {
        const float x = bf2f(iraw[h]);
        const float other = __shfl_xor(x, 8);
        float o = x;
        if (l < 16) o = (l < 8) ? (x * ic - other * is) : (x * ic + other * is);
        if (h < 8) p.IQ()[(t * 8 + h) * 64 + l] = f2bf(o); else p.IK()[t * 64 + l] = f2bf(o);
    }
    if (l < 8) p.IW()[t * 8 + l] = bf2f(row[C_IW + l]) * (0.35355339059327373f * 0.125f);
}

DEV void st_compress(const P& p, int layer, int unit, char* smem) {
    const int which = unit & 1, rt = unit >> 1, tid = tidx(), w = tid >> 6, l = tid & 63, fr = l & 15, fq = l >> 4;
    float* hid = (float*)smem;
    float* ob = hid + 16 * 128;
    const int nb = rt * 16 + fr;
    const int col0 = which ? C_NVC : C_NKC;
    const float* ps = p.cmp_pos + ((size_t)layer * 2 + which) * 4096;
    const bf16_t* w1t = p.W1T() + ((size_t)layer * 2 + which) * 128 * 4096;
    const bool rowok = nb < 511;
    const bf16_t* xrow = p.PROJ() + (size_t)(rowok ? nb * 16 : 0) * LDP + col0;
    f32x4 acc[2] = {(f32x4){0.f, 0.f, 0.f, 0.f}, (f32x4){0.f, 0.f, 0.f, 0.f}};
#pragma unroll 4
    for (int ks = 0; ks < 128; ++ks) {
        const int k = ks * 32 + fq * 8, lt = k >> 7, d = k & 127;
        const uint4 xr = *(const uint4*)(xrow + (size_t)lt * LDP + d);
        const float4 p0 = *(const float4*)(ps + k), p1 = *(const float4*)(ps + k + 4);
        union { bf16x8 v; unsigned u32[4]; } a;
        a.u32[0] = pk2(lo2f(xr.x) + p0.x, hi2f(xr.x) + p0.y); a.u32[1] = pk2(lo2f(xr.y) + p0.z, hi2f(xr.y) + p0.w);
        a.u32[2] = pk2(lo2f(xr.z) + p1.x, hi2f(xr.z) + p1.y); a.u32[3] = pk2(lo2f(xr.w) + p1.z, hi2f(xr.w) + p1.w);
#pragma unroll
        for (int nt = 0; nt < 2; ++nt) {
            const bf16x8 b = *(const bf16x8*)(w1t + (size_t)(w * 32 + nt * 16 + fr) * 4096 + k);
            acc[nt] = mfma16(a.v, b, acc[nt]);
        }
    }
#pragma unroll
    for (int nt = 0; nt < 2; ++nt)
#pragma unroll
        for (int r = 0; r < 4; ++r) hid[(4 * fq + r) * 128 + w * 32 + nt * 16 + fr] = gelu_tanh(acc[nt][r]);
    __syncthreads();
    const float* w2 = p.cmp_w2 + ((size_t)layer * 2 + which) * 128 * 128;
    const int c2 = tid & 127, mh = tid >> 7;
    float o[8];
#pragma unroll
    for (int b = 0; b < 8; ++b) o[b] = 0.f;
#pragma unroll 4
    for (int k = 0; k < 128; ++k) {
        const float wv = w2[k * 128 + c2];
#pragma unroll
        for (int b = 0; b < 8; ++b) o[b] += hid[(mh * 8 + b) * 128 + k] * wv;
    }
#pragma unroll
    for (int b = 0; b < 8; ++b) ob[(mh * 8 + b) * 128 + c2] = o[b];
    __syncthreads();
#pragma unroll
    for (int q = 0; q < 4; ++q) {
        const int b = w * 4 + q, nbo = rt * 16 + b;
        float v0 = ob[b * 128 + l], v1 = ob[b * 128 + l + 64];
        if (which == 0) {
            const float r = rsqrtf(wsum(v0 * v0 + v1 * v1) * (1.0f / 128.0f) + EPS);
            const float* kg = p.nsa_kg + (layer * 3 + 0) * 128;
            v0 = v0 * r * kg[l]; v1 = v1 * r * kg[l + 64];
            if (nbo >= 511) { v0 = 0.f; v1 = 0.f; }
            p.KC()[nbo * 128 + l] = f2bf(v0); p.KC()[nbo * 128 + l + 64] = f2bf(v1);
        } else {
            if (nbo >= 511) { v0 = 0.f; v1 = 0.f; }
            p.VCT()[l * 512 + nbo] = f2bf(v0); p.VCT()[(l + 64) * 512 + nbo] = f2bf(v1);
        }
    }
    __syncthreads();
}

DEV void st_nsa_cmp(const P& p, int unit, char* smem) {
    constexpr int RSK = 272, RSV = 136, BUFB = 64 * RSK + 128 * RSV;
    const int tid = tidx(), w = tid >> 6, l = tid & 63, qc = l & 15, g4 = l >> 4;
    const int t0 = unit * 16 + w * 4;
    const int tk = qc >> 2, hd = qc & 3, t = t0 + tk;
    bf16x8 qf[4];
#pragma unroll
    for (int ks = 0; ks < 4; ++ks) qf[ks] = *(const bf16x8*)(p.QN() + ((size_t)t0 * 4 + qc) * 128 + ks * 32 + g4 * 8);
    const int tmaxb = unit * 16 + 15;
    const int nvb = tmaxb >= 31 ? (tmaxb - 31) / 16 + 1 : 0;
    const int nsteps = (nvb + 63) >> 6;
    const int nvis = t >= 31 ? (t - 31) / 16 + 1 : 0;
    const float cs = 0.08838834764831845f * 1.4426950408889634f;
    const int krow = tid >> 4, kc16 = tid & 15, vrow = tid >> 3, vc16 = tid & 7;
    const bf16_t* Kg = p.KC(); const bf16_t* Vg = p.VCT();
    int gstep = 0;
    uint4 rk0, rk1, rk2, rk3, rv0, rv1, rv2, rv3;
#define CMP_LOADK(ST) do { const bf16_t* kb = Kg + (size_t)((ST) * 64 + krow) * 128 + kc16 * 8; \
        rk0 = *(const uint4*)kb; rk1 = *(const uint4*)(kb + 16 * 128); rk2 = *(const uint4*)(kb + 32 * 128); rk3 = *(const uint4*)(kb + 48 * 128); } while (0)
#define CMP_LOADV(ST) do { const bf16_t* vb = Vg + (size_t)vrow * 512 + (ST) * 64 + vc16 * 8; \
        rv0 = *(const uint4*)vb; rv1 = *(const uint4*)(vb + 32 * 512); rv2 = *(const uint4*)(vb + 64 * 512); rv3 = *(const uint4*)(vb + 96 * 512); } while (0)
#define CMP_STOREK(KT) do { *(uint4*)((KT) + krow * RSK + kc16 * 16) = rk0; *(uint4*)((KT) + (krow + 16) * RSK + kc16 * 16) = rk1; \
        *(uint4*)((KT) + (krow + 32) * RSK + kc16 * 16) = rk2; *(uint4*)((KT) + (krow + 48) * RSK + kc16 * 16) = rk3; } while (0)
#define CMP_STOREV(VT) do { *(uint4*)((VT) + vrow * RSV + vc16 * 16) = rv0; *(uint4*)((VT) + (vrow + 32) * RSV + vc16 * 16) = rv1; \
        *(uint4*)((VT) + (vrow + 64) * RSV + vc16 * 16) = rv2; *(uint4*)((VT) + (vrow + 96) * RSV + vc16 * 16) = rv3; } while (0)
    float m = -1e30f, lsum = 0.f;
    if (nsteps > 0) CMP_LOADK(0);
#pragma unroll 1
    for (int st = 0; st < nsteps; ++st, ++gstep) {
        char* Kt = smem + (gstep & 1) * BUFB;
        CMP_STOREK(Kt);
        __syncthreads();
        if (st + 1 < nsteps) CMP_LOADK(st + 1);
        float mx = m; f32x4 sv[4];
#pragma unroll
        for (int sub = 0; sub < 4; ++sub) {
            f32x4 a4 = (f32x4){0.f, 0.f, 0.f, 0.f};
#pragma unroll
            for (int ks = 0; ks < 4; ++ks) a4 = mfma16(*(const bf16x8*)(Kt + (sub * 16 + qc) * RSK + (ks * 32 + g4 * 8) * 2), qf[ks], a4);
#pragma unroll
            for (int r = 0; r < 4; ++r) { const int key = st * 64 + sub * 16 + 4 * g4 + r; a4[r] = (key < nvis) ? a4[r] * cs : -3e38f; mx = fmaxf(mx, a4[r]); }
            sv[sub] = a4;
        }
        float ps = 0.f;
#pragma unroll
        for (int sub = 0; sub < 4; ++sub)
#pragma unroll
            for (int r = 0; r < 4; ++r) ps += __builtin_amdgcn_exp2f(sv[sub][r] - mx);
        lsum = lsum * __builtin_amdgcn_exp2f(m - mx) + ps; m = mx;
    }
    {
        float mt_ = fmaxf(m, __shfl_xor(m, 16)); mt_ = fmaxf(mt_, __shfl_xor(mt_, 32));
        lsum *= __builtin_amdgcn_exp2f(m - mt_); m = mt_;
        lsum += __shfl_xor(lsum, 16); lsum += __shfl_xor(lsum, 32);
    }
    const float inv = (nvis > 0 && lsum > 0.f) ? 1.0f / lsum : 0.f;
    f32x4 o[8];
#pragma unroll
    for (int mt = 0; mt < 8; ++mt) o[mt] = (f32x4){0.f, 0.f, 0.f, 0.f};
    float yprev = 0.f;
    float impv[32];
#pragma unroll
    for (int i = 0; i < 32; ++i) impv[i] = 0.f;
    if (nsteps > 0) { CMP_LOADK(0); CMP_LOADV(0); }
#pragma unroll
    for (int st = 0; st < 8; ++st) {
        if (st < nsteps) {
            char* Kt = smem + (gstep & 1) * BUFB; char* Vt = Kt + 64 * RSK; ++gstep;
            CMP_STOREK(Kt); CMP_STOREV(Vt);
            __syncthreads();
            if (st + 1 < nsteps) { CMP_LOADK(st + 1); CMP_LOADV(st + 1); }
            f32x4 sv[4];
#pragma unroll
            for (int sub = 0; sub < 4; ++sub) {
                f32x4 a4 = (f32x4){0.f, 0.f, 0.f, 0.f};
#pragma unroll
                for (int ks = 0; ks < 4; ++ks) a4 = mfma16(*(const bf16x8*)(Kt + (sub * 16 + qc) * RSK + (ks * 32 + g4 * 8) * 2), qf[ks], a4);
#pragma unroll
                for (int r = 0; r < 4; ++r) { const int key = st * 64 + sub * 16 + 4 * g4 + r; a4[r] = (key < nvis) ? __builtin_amdgcn_exp2f(a4[r] * cs - m) * inv : 0.f; }
                const float y = __shfl(a4[3], (l + 48) & 63);
                float iv = (a4[0] + a4[1]) + (a4[2] + a4[3]) + (g4 > 0 ? y : yprev);
                yprev = y;
                iv += __shfl_xor(iv, 1); iv += __shfl_xor(iv, 2);
                impv[st * 4 + sub] = iv;
                sv[sub] = a4;
            }
#pragma unroll
            for (int pr = 0; pr < 2; ++pr) {
                union { bf16x8 v; unsigned u32[4]; } bb;
                bb.u32[0] = pk2(sv[2 * pr][0], sv[2 * pr][1]); bb.u32[1] = pk2(sv[2 * pr][2], sv[2 * pr][3]);
                bb.u32[2] = pk2(sv[2 * pr + 1][0], sv[2 * pr + 1][1]); bb.u32[3] = pk2(sv[2 * pr + 1][2], sv[2 * pr + 1][3]);
#pragma unroll
                for (int mt = 0; mt < 8; ++mt) {
                    const char* vp = Vt + (mt * 16 + qc) * RSV + (pr * 32 + 4 * g4) * 2;
                    union { bf16x8 v; uint2 h2[2]; } aa;
                    aa.h2[0] = *(const uint2*)vp; aa.h2[1] = *(const uint2*)(vp + 32);
                    o[mt] = mfma16(aa.v, bb.v, o[mt]);
                }
            }
        }
    }
#undef CMP_LOADK
#undef CMP_LOADV
#undef CMP_STOREK
#undef CMP_STOREV
    __syncthreads();
    float* impl = (float*)smem + w * 512;
    if (hd == 0) {
#pragma unroll
        for (int i = 0; i < 32; ++i) impl[tk * 128 + 4 * i + g4] = impv[i];
    }
#pragma unroll
    for (int mt = 0; mt < 8; ++mt) {
        uint2 ov; ov.x = pk2(o[mt][0], o[mt][1]); ov.y = pk2(o[mt][2], o[mt][3]);
        *(uint2*)(p.OCMP() + ((size_t)t * 4 + hd) * 128 + mt * 16 + 4 * g4) = ov;
    }
    __syncthreads();
    const int li = hd + 4 * g4, cur = t >> 6;
    unsigned long long own[8]; int rank[8];
#pragma unroll
    for (int i = 0; i < 8; ++i) {
        const int j = li + 16 * i; const float v = impl[tk * 128 + j];
        const unsigned k32 = (j == 0 || j == cur || j == cur - 1) ? 0xFFFFFFFFu : (j > cur ? 0u : __float_as_uint(v) + 128u);
        own[i] = ((unsigned long long)k32 << 7) | (unsigned)(127 - j); rank[i] = 0;
    }
#pragma unroll 1
    for (int ip = 0; ip < 8; ++ip) {
#pragma unroll
        for (int q4 = 0; q4 < 4; ++q4) {
            const float4 ov = *(const float4*)(impl + tk * 128 + ip * 16 + q4 * 4);
            const float o4[4] = {ov.x, ov.y, ov.z, ov.w};
#pragma unroll
            for (int e = 0; e < 4; ++e) {
                const int jp = ip * 16 + q4 * 4 + e;
                const unsigned k32 = (jp == 0 || jp == cur || jp == cur - 1) ? 0xFFFFFFFFu : (jp > cur ? 0u : __float_as_uint(o4[e]) + 128u);
                const unsigned long long kp = ((unsigned long long)k32 << 7) | (unsigned)(127 - jp);
#pragma unroll
                for (int i = 0; i < 8; ++i) rank[i] += (kp > own[i]) ? 1 : 0;
            }
        }
    }
    unsigned mw[4] = {0u, 0u, 0u, 0u};
#pragma unroll
    for (int i = 0; i < 8; ++i) if (rank[i] < 16) mw[i >> 1] |= 1u << (li + 16 * (i & 1));
#pragma unroll
    for (int q = 0; q < 4; ++q) {
        unsigned v = mw[q];
        v |= __shfl_xor(v, 1); v |= __shfl_xor(v, 2); v |= __shfl_xor(v, 16); v |= __shfl_xor(v, 32);
        mw[q] = v;
    }
    if (li == 0) *(uint4*)(p.SEL() + (size_t)t * 4) = make_uint4(mw[0], mw[1], mw[2], mw[3]);
    __syncthreads();
}

DEV void st_nsa_attn(const P& p, int unit, char* smem) {
    constexpr int RSK = 272, RSV = 136, BUFB = 64 * RSK + 128 * RSV;
    const int tid = tidx(), w = tid >> 6, l = tid & 63, qc = l & 15, g4 = l >> 4;
    const int tq0 = unit * 16, t = tq0 + w * 4 + (qc >> 2), hd = qc & 3;
    bf16x8 qf[4];
#pragma unroll
    for (int ks = 0; ks < 4; ++ks) qf[ks] = *(const bf16x8*)(p.QR() + ((size_t)t * 4 + hd) * 128 + ks * 32 + g4 * 8);
    const uint4 selw = *(const uint4*)(p.SEL() + (size_t)t * 4);
    const float cs = 0.08838834764831845f * 1.4426950408889634f;
    unsigned part[8][2];
#pragma unroll
    for (int mt = 0; mt < 8; ++mt) { part[mt][0] = 0u; part[mt][1] = 0u; }
    const float g0 = p.GATES()[(size_t)t * 12 + hd * 3];
    int gstep = 0;
    const int krow = tid >> 4, kc16 = tid & 15, vrow = tid >> 3, vc16 = tid & 7;
#pragma unroll 1
    for (int br = 0; br < 2; ++br) {
        const bf16_t* Kg = br ? p.KW() : p.KS(); const bf16_t* Vg = br ? p.VWT() : p.VST();
        const int ktlast = (tq0 + 15) >> 6;
        const int ktfirst = br ? ((tq0 - 511 > 0 ? tq0 - 511 : 0) >> 6) : 0;
        const int nk = ktlast - ktfirst + 1;
        f32x4 o[8];
#pragma unroll
        for (int mt = 0; mt < 8; ++mt) o[mt] = (f32x4){0.f, 0.f, 0.f, 0.f};
        float m = -1e30f, lsum = 0.f;
        uint4 rk0, rk1, rk2, rk3, rv0, rv1, rv2, rv3;
#define NSA_LOAD(KT) do { const bf16_t* kb = Kg + (size_t)((KT) * 64 + krow) * 128 + kc16 * 8; const bf16_t* vb = Vg + (size_t)vrow * T + (KT) * 64 + vc16 * 8; \
        rk0 = *(const uint4*)kb; rk1 = *(const uint4*)(kb + 16 * 128); rk2 = *(const uint4*)(kb + 32 * 128); rk3 = *(const uint4*)(kb + 48 * 128); \
        rv0 = *(const uint4*)vb; rv1 = *(const uint4*)(vb + (size_t)32 * T); rv2 = *(const uint4*)(vb + (size_t)64 * T); rv3 = *(const uint4*)(vb + (size_t)96 * T); } while (0)
        NSA_LOAD(ktfirst);
#pragma unroll 1
        for (int i = 0; i < nk; ++i, ++gstep) {
            const int kt = ktfirst + i;
            char* Kt = smem + (gstep & 1) * BUFB; char* Vt = Kt + 64 * RSK;
            *(uint4*)(Kt + krow * RSK + kc16 * 16) = rk0; *(uint4*)(Kt + (krow + 16) * RSK + kc16 * 16) = rk1;
            *(uint4*)(Kt + (krow + 32) * RSK + kc16 * 16) = rk2; *(uint4*)(Kt + (krow + 48) * RSK + kc16 * 16) = rk3;
            *(uint4*)(Vt + vrow * RSV + vc16 * 16) = rv0; *(uint4*)(Vt + (vrow + 32) * RSV + vc16 * 16) = rv1;
            *(uint4*)(Vt + (vrow + 64) * RSV + vc16 * 16) = rv2; *(uint4*)(Vt + (vrow + 96) * RSV + vc16 * 16) = rv3;
            __syncthreads();
            if (i + 1 < nk) NSA_LOAD(kt + 1);
            int lo, hi = t;
            if (br == 0) {
                const unsigned wv = (kt & 64) ? ((kt & 32) ? selw.w : selw.z) : ((kt & 32) ? selw.y : selw.x);
                lo = 0; hi = ((wv >> (kt & 31)) & 1u) ? t : -1;
            } else lo = t - 511;
            const bool interior = (kt * 64 + 63 <= tq0) && (br == 0 || kt * 64 >= tq0 + 15 - 511);
            f32x4 sv[4];
            float mx = -3e38f;
            if (interior) {
                const float csl = hi >= 0 ? cs : 0.f, add = hi >= 0 ? 0.f : -3e38f;
#pragma unroll
                for (int sub = 0; sub < 4; ++sub) {
                    f32x4 a4 = (f32x4){0.f, 0.f, 0.f, 0.f};
#pragma unroll
                    for (int ks = 0; ks < 4; ++ks) a4 = mfma16(*(const bf16x8*)(Kt + (sub * 16 + qc) * RSK + (ks * 32 + g4 * 8) * 2), qf[ks], a4);
#pragma unroll
                    for (int r = 0; r < 4; ++r) { a4[r] = a4[r] * csl + add; mx = fmaxf(mx, a4[r]); }
                    sv[sub] = a4;
                }
            } else {
#pragma unroll
                for (int sub = 0; sub < 4; ++sub) {
                    f32x4 a4 = (f32x4){0.f, 0.f, 0.f, 0.f};
#pragma unroll
                    for (int ks = 0; ks < 4; ++ks) a4 = mfma16(*(const bf16x8*)(Kt + (sub * 16 + qc) * RSK + (ks * 32 + g4 * 8) * 2), qf[ks], a4);
#pragma unroll
                    for (int r = 0; r < 4; ++r) {
                        const int kp = kt * 64 + sub * 16 + 4 * g4 + r;
                        const bool valid = (kp >= lo) & (kp <= hi);
                        a4[r] = valid ? a4[r] * cs : -3e38f;
                        mx = fmaxf(mx, a4[r]);
                    }
                    sv[sub] = a4;
                }
            }
            mx = fmaxf(mx, __shfl_xor(mx, 16)); mx = fmaxf(mx, __shfl_xor(mx, 32));
            const float mnew = fmaxf(fmaxf(m, mx), -1e30f);
            const float alpha = __builtin_amdgcn_exp2f(m - mnew);
            m = mnew;
            float ps = 0.f;
#pragma unroll
            for (int sub = 0; sub < 4; ++sub)
#pragma unroll
                for (int r = 0; r < 4; ++r) { const float pv = __builtin_amdgcn_exp2f(sv[sub][r] - mnew); sv[sub][r] = pv; ps += pv; }
            lsum = lsum * alpha + ps;
            if (__any(alpha != 1.0f)) {
#pragma unroll
                for (int mt = 0; mt < 8; ++mt) o[mt] *= alpha;
            }
#pragma unroll
            for (int pr = 0; pr < 2; ++pr) {
                union { bf16x8 v; unsigned u32[4]; } bb;
                bb.u32[0] = pk2(sv[2 * pr][0], sv[2 * pr][1]); bb.u32[1] = pk2(sv[2 * pr][2], sv[2 * pr][3]);
                bb.u32[2] = pk2(sv[2 * pr + 1][0], sv[2 * pr + 1][1]); bb.u32[3] = pk2(sv[2 * pr + 1][2], sv[2 * pr + 1][3]);
#pragma unroll
                for (int mt = 0; mt < 8; ++mt) {
                    const char* vp = Vt + (mt * 16 + qc) * RSV + (pr * 32 + 4 * g4) * 2;
                    union { bf16x8 v; uint2 h2[2]; } aa;
                    aa.h2[0] = *(const uint2*)vp; aa.h2[1] = *(const uint2*)(vp + 32);
                    o[mt] = mfma16(aa.v, bb.v, o[mt]);
                }
            }
        }
#undef NSA_LOAD
        lsum += __shfl_xor(lsum, 16); lsum += __shfl_xor(lsum, 32);
        const float gate = p.GATES()[(size_t)t * 12 + hd * 3 + 1 + br];
        const float sc = lsum > 0.f ? gate / lsum : 0.f;
        if (br == 0) {
#pragma unroll
            for (int mt = 0; mt < 8; ++mt) {
                const uint2 oc = *(const uint2*)(p.OCMP() + ((size_t)t * 4 + hd) * 128 + mt * 16 + 4 * g4);
                part[mt][0] = pk2(sc * o[mt][0] + g0 * lo2f(oc.x), sc * o[mt][1] + g0 * hi2f(oc.x));
                part[mt][1] = pk2(sc * o[mt][2] + g0 * lo2f(oc.y), sc * o[mt][3] + g0 * hi2f(oc.y));
            }
        } else {
#pragma unroll
            for (int mt = 0; mt < 8; ++mt) {
                uint2 ov;
                ov.x = pk2(sc * o[mt][0] + lo2f(part[mt][0]), sc * o[mt][1] + hi2f(part[mt][0]));
                ov.y = pk2(sc * o[mt][2] + lo2f(part[mt][1]), sc * o[mt][3] + hi2f(part[mt][1]));
                *(uint2*)(p.Y() + (size_t)t * D + 1024 + hd * 128 + mt * 16 + 4 * g4) = ov;
            }
        }
    }
    __syncthreads();
}

DEV unsigned f2key(float f) { const unsigned u = __float_as_uint(f); return (u & 0x80000000u) ? ~u : (u | 0x80000000u); }
DEV float key2f(unsigned k) { const unsigned u = (k & 0x80000000u) ? (k & 0x7fffffffu) : ~k; return __uint_as_float(u); }
DEV float wave_prune(float* sc, unsigned short* ix, unsigned* hist, int m, int l) {
    float v[8]; unsigned k[8]; unsigned short id[8]; bool ok[8];
#pragma unroll
    for (int i = 0; i < 8; ++i) {
        const int e = l + 64 * i; ok[i] = e < m;
        v[i] = ok[i] ? sc[e] : 0.f; id[i] = ok[i] ? ix[e] : (unsigned short)0; k[i] = f2key(v[i]);
    }
    unsigned prefix = 0u; int need = 256;
#pragma unroll 1
    for (int pass = 0; pass < 4; ++pass) {
        const int shift = 24 - 8 * pass;
        *(uint4*)(hist + 4 * l) = make_uint4(0u, 0u, 0u, 0u);
        __builtin_amdgcn_wave_barrier();
#pragma unroll
        for (int i = 0; i < 8; ++i) {
            const bool in = ok[i] && (pass == 0 || (k[i] >> (shift + 8)) == prefix);
            if (in) atomicAdd(&hist[(k[i] >> shift) & 255u], 1u);
        }
        __builtin_amdgcn_wave_barrier();
        const uint4 hv = *(const uint4*)(hist + 4 * l);
        const unsigned hq[4] = {hv.x, hv.y, hv.z, hv.w};
        const unsigned own = hv.x + hv.y + hv.z + hv.w;
        unsigned tot = own;
#pragma unroll
        for (int o = 1; o < 64; o <<= 1) { const unsigned tv = __shfl_down(tot, o); if (l + o < 64) tot += tv; }
        unsigned cum = tot - own; int found = -1; int nneed = 0;
#pragma unroll
        for (int kk = 3; kk >= 0; --kk) {
            const unsigned c = hq[kk];
            if (found < 0 && (int)cum < need && (int)(cum + c) >= need) { found = 4 * l + kk; nneed = need - (int)cum; }
            cum += c;
        }
        const unsigned long long bal = __ballot(found >= 0);
        const int src = __ffsll((long long)bal) - 1;
        const int digit = __shfl(found, src); need = __shfl(nneed, src);
        prefix = (prefix << 8) | (unsigned)digit;
    }
    const unsigned thr = prefix;
    int base = 0, ties = 0;
    const unsigned long long ltmask = (1ull << l) - 1ull;
#pragma unroll
    for (int i = 0; i < 8; ++i) {
        const bool gt = ok[i] && k[i] > thr, eq = ok[i] && k[i] == thr;
        const unsigned long long em = __ballot(eq);
        const int trank = ties + __popcll(em & ltmask);
        const bool keep = gt || (eq && trank < need);
        ties += __popcll(em);
        const unsigned long long km = __ballot(keep);
        const int pos = base + __popcll(km & ltmask);
        if (keep) { sc[pos] = v[i]; ix[pos] = id[i]; }
        base += __popcll(km);
    }
    __builtin_amdgcn_wave_barrier();
    return key2f(thr);
}

#define DSA_APPEND2(COND, M64, SV, SCP, IXP, CL, CH) do { \
    const unsigned _ml = (unsigned)(M64), _mh = (unsigned)((M64) >> 32); \
    if (COND) { const int _pos = (h ? (CH) : (CL)) + __popc((h ? _mh : _ml) & ((1u << n) - 1u)); (SCP)[_pos] = (SV); (IXP)[_pos] = (unsigned short)kp; } \
    (CL) += __popc(_ml); (CH) += __popc(_mh); } while (0)
#define DSA_APPEND(SCP, IXP, CNT, M32, MINE, SV) do { \
    const unsigned _m = (M32); \
    if (MINE) { const int _pos = (CNT) + __popc(_m & ((1u << n) - 1u)); (SCP)[_pos] = (SV); (IXP)[_pos] = (unsigned short)kp; } \
    (CNT) += __popc(_m); } while (0)

DEV void st_dsa_index(const P& p, int unit, char* smem) {
    const int tid = tidx(), w = tid >> 6, l = tid & 63, n = l & 31, h = l >> 5;
    char* wb = smem + w * 14336;
    float* sc0 = (float*)wb; float* sc1 = sc0 + 512; float* sc2 = sc1 + 512; float* sc3 = sc2 + 512;
    unsigned short* ix0 = (unsigned short*)(wb + 8192); unsigned short* ix1 = ix0 + 512; unsigned short* ix2 = ix1 + 512; unsigned short* ix3 = ix2 + 512;
    unsigned* hist = (unsigned*)(wb + 12288);
    float* scA = h ? sc2 : sc0; float* scB = h ? sc3 : sc1; unsigned short* ixA = h ? ix2 : ix0; unsigned short* ixB = h ? ix3 : ix1;
    const int wu = unit * 4 + w;
    const int tg = 2047 - wu;
    const int t0 = tg * 4;
    const int tl = 2 * ((n >> 2) & 1) + (n >> 4), hdr = (n & 3) + 4 * ((n >> 3) & 1);
    bf16x8 af[4];
#pragma unroll
    for (int s = 0; s < 4; ++s) af[s] = *(const bf16x8*)(p.IQ() + ((size_t)(t0 + tl) * 8 + hdr) * 64 + 16 * s + 8 * h);
    const int tA = t0 + 2 * h, tB = tA + 1;
    float wA[8], wB[8];
#pragma unroll
    for (int r = 0; r < 8; ++r) { wA[r] = p.IW()[(size_t)tA * 8 + r]; wB[r] = p.IW()[(size_t)tB * 8 + r]; }
    int cnt0 = 0, cnt1 = 0, cnt2 = 0, cnt3 = 0;
    const float NINF = -__builtin_inff();
    float tau0 = NINF, tau1 = NINF, tau2 = NINF, tau3 = NINF;
    const int ntiles = (t0 + 3) / 32 + 1;
    const bf16_t* ikp = p.IK() + (size_t)n * 64 + 8 * h;
    bf16x8 na[4], nb[4];
#pragma unroll
    for (int s = 0; s < 4; ++s) { na[s] = *(const bf16x8*)(ikp + 16 * s); nb[s] = *(const bf16x8*)(ikp + (size_t)(ntiles > 1 ? 32 : 0) * 64 + 16 * s); }
#pragma unroll 1
    for (int kt = 0; kt < ntiles; kt += 2) {
        bf16x8 ca[4], cb[4];
#pragma unroll
        for (int s = 0; s < 4; ++s) { ca[s] = na[s]; cb[s] = nb[s]; }
        {
            const int ka = kt + 2 < ntiles ? kt + 2 : ntiles - 1, kb = kt + 3 < ntiles ? kt + 3 : ntiles - 1;
#pragma unroll
            for (int s = 0; s < 4; ++s) { na[s] = *(const bf16x8*)(ikp + (size_t)ka * 32 * 64 + 16 * s); nb[s] = *(const bf16x8*)(ikp + (size_t)kb * 32 * 64 + 16 * s); }
        }
        f32x16 acca, accb;
#pragma unroll
        for (int r = 0; r < 16; ++r) { acca[r] = 0.f; accb[r] = 0.f; }
#pragma unroll
        for (int s = 0; s < 4; ++s) { acca = mfma32(af[s], ca[s], acca); accb = mfma32(af[s], cb[s], accb); }
        float s0a = 0.f, s1a = 0.f, s0b = 0.f, s1b = 0.f, u0a = 0.f, u1a = 0.f, u0b = 0.f, u1b = 0.f;
#pragma unroll
        for (int r = 0; r < 4; ++r) {
            s0a += wA[r] * fmaxf(acca[r], 0.f); u0a += wA[4 + r] * fmaxf(acca[4 + r], 0.f);
            s1a += wB[r] * fmaxf(acca[8 + r], 0.f); u1a += wB[4 + r] * fmaxf(acca[12 + r], 0.f);
            s0b += wA[r] * fmaxf(accb[r], 0.f); u0b += wA[4 + r] * fmaxf(accb[4 + r], 0.f);
            s1b += wB[r] * fmaxf(accb[8 + r], 0.f); u1b += wB[4 + r] * fmaxf(accb[12 + r], 0.f);
        }
        s0a += u0a; s1a += u1a; s0b += u0b; s1b += u1b;
        const float tauA = h ? tau2 : tau0, tauB = h ? tau3 : tau1;
        {
            const int kp = kt * 32 + n;
            const bool cA = (kp <= tA) && (s0a > tauA), cB = (kp <= tB) && (s1a > tauB);
            const unsigned long long mA = __ballot(cA), mB = __ballot(cB);
            DSA_APPEND2(cA, mA, s0a, scA, ixA, cnt0, cnt2); DSA_APPEND2(cB, mB, s1a, scB, ixB, cnt1, cnt3);
        }
        {
            const int kp = kt * 32 + 32 + n;
            const bool cA = (kp <= tA) && (s0b > tauA), cB = (kp <= tB) && (s1b > tauB);
            const unsigned long long mA = __ballot(cA), mB = __ballot(cB);
            DSA_APPEND2(cA, mA, s0b, scA, ixA, cnt0, cnt2); DSA_APPEND2(cB, mB, s1b, scB, ixB, cnt1, cnt3);
        }
        __builtin_amdgcn_wave_barrier();
        if (max(max(cnt0, cnt1), max(cnt2, cnt3)) > 448) {
            if (cnt0 > 448) { tau0 = wave_prune(sc0, ix0, hist, cnt0, l); cnt0 = 256; }
            if (cnt1 > 448) { tau1 = wave_prune(sc1, ix1, hist, cnt1, l); cnt1 = 256; }
            if (cnt2 > 448) { tau2 = wave_prune(sc2, ix2, hist, cnt2, l); cnt2 = 256; }
            if (cnt3 > 448) { tau3 = wave_prune(sc3, ix3, hist, cnt3, l); cnt3 = 256; }
        }
    }
    if (cnt0 > 256) { wave_prune(sc0, ix0, hist, cnt0, l); cnt0 = 256; }
    if (cnt1 > 256) { wave_prune(sc1, ix1, hist, cnt1, l); cnt1 = 256; }
    if (cnt2 > 256) { wave_prune(sc2, ix2, hist, cnt2, l); cnt2 = 256; }
    if (cnt3 > 256) { wave_prune(sc3, ix3, hist, cnt3, l); cnt3 = 256; }
    __builtin_amdgcn_wave_barrier();
#pragma unroll
    for (int i = 0; i < 4; ++i) {
        const int e = l + 64 * i;
        p.IDX()[(size_t)(t0 + 0) * 256 + e] = e < cnt0 ? (int)ix0[e] : 0;
        p.IDX()[(size_t)(t0 + 1) * 256 + e] = e < cnt1 ? (int)ix1[e] : 0;
        p.IDX()[(size_t)(t0 + 2) * 256 + e] = e < cnt2 ? (int)ix2[e] : 0;
        p.IDX()[(size_t)(t0 + 3) * 256 + e] = e < cnt3 ? (int)ix3[e] : 0;
    }
    if (l == 0) { p.CNT()[t0] = cnt0; p.CNT()[t0 + 1] = cnt1; p.CNT()[t0 + 2] = cnt2; p.CNT()[t0 + 3] = cnt3; }
}

DEV void st_dsa_attn(const P& p, int unit, char* smem) {
    const int tid = tidx(), w = tid >> 6, l = tid & 63, c = l & 15, g4 = l >> 4;
    int* idxs = (int*)(smem + w * 5120); float* Pl = (float*)(smem + w * 5120 + 1024);
    const size_t t = (size_t)unit * 4 + w;
    const int cnt = p.CNT()[t];
#pragma unroll
    for (int i = 0; i < 4; ++i) idxs[l + 64 * i] = p.IDX()[t * 256 + l + 64 * i];
    __builtin_amdgcn_wave_barrier();
    bf16x8 qf[4];
#pragma unroll
    for (int j = 0; j < 4; ++j) qf[j] = *(const bf16x8*)(p.DQ() + (t * 4 + (c & 3)) * 128 + g4 * 32 + j * 8);
    f32x4 s[16];
    const int ntile = (cnt + 15) >> 4;
#pragma unroll
    for (int th = 0; th < 2; ++th) {
        bf16x8 kf[8][4];
        if (th * 8 < ntile) {
#pragma unroll
            for (int q = 0; q < 8; ++q) {
                const int krow = idxs[(th * 8 + q) * 16 + c];
                const bf16_t* kp = p.DK() + (size_t)krow * 128 + g4 * 32;
#pragma unroll
                for (int j = 0; j < 4; ++j) kf[q][j] = *(const bf16x8*)(kp + j * 8);
            }
        }
#pragma unroll
        for (int q = 0; q < 8; ++q) {
            s[th * 8 + q] = (f32x4){0.f, 0.f, 0.f, 0.f};
            if (th * 8 < ntile) {
#pragma unroll
                for (int j = 0; j < 4; ++j) s[th * 8 + q] = mfma16(kf[q][j], qf[j], s[th * 8 + q]);
            }
        }
        __builtin_amdgcn_sched_barrier(0);
    }
    const float cs = 0.08838834764831845f * 1.4426950408889634f;
    float mx = -1e30f;
#pragma unroll
    for (int tt = 0; tt < 16; ++tt)
#pragma unroll
        for (int r = 0; r < 4; ++r) { const int slot = tt * 16 + 4 * g4 + r; if (slot < cnt) mx = fmaxf(mx, s[tt][r] * cs); }
    mx = fmaxf(mx, __shfl_xor(mx, 16)); mx = fmaxf(mx, __shfl_xor(mx, 32));
    float sum = 0.f;
#pragma unroll
    for (int tt = 0; tt < 16; ++tt)
#pragma unroll
        for (int r = 0; r < 4; ++r) { const int slot = tt * 16 + 4 * g4 + r; const float pv = slot < cnt ? exp2f(s[tt][r] * cs - mx) : 0.f; s[tt][r] = pv; sum += pv; }
    sum += __shfl_xor(sum, 16); sum += __shfl_xor(sum, 32);
    const float inv = sum > 0.f ? 1.0f / sum : 0.f;
    if (c < 4) {
#pragma unroll
        for (int tt = 0; tt < 16; ++tt)
#pragma unroll
            for (int r = 0; r < 4; ++r) Pl[(tt * 16 + 4 * g4 + r) * 4 + c] = s[tt][r] * inv;
    }
    __builtin_amdgcn_wave_barrier();
    float acc[4][8];
#pragma unroll
    for (int hh = 0; hh < 4; ++hh)
#pragma unroll
        for (int j = 0; j < 8; ++j) acc[hh][j] = 0.f;
    const int nk64 = (cnt + 63) >> 6;
#pragma unroll 1
    for (int kb = 0; kb < nk64; ++kb) {
        uint4 raw[16];
#pragma unroll
        for (int q = 0; q < 16; ++q) raw[q] = *(const uint4*)(p.DVC() + (size_t)idxs[(kb * 16 + q) * 4 + g4] * 128 + c * 8);
#pragma unroll
        for (int q = 0; q < 16; ++q) {
            const float4 p4 = *(const float4*)(Pl + ((kb * 16 + q) * 4 + g4) * 4);
            const float vv[8] = {lo2f(raw[q].x), hi2f(raw[q].x), lo2f(raw[q].y), hi2f(raw[q].y), lo2f(raw[q].z), hi2f(raw[q].z), lo2f(raw[q].w), hi2f(raw[q].w)};
            const float pp[4] = {p4.x, p4.y, p4.z, p4.w};
#pragma unroll
            for (int hh = 0; hh < 4; ++hh)
#pragma unroll
                for (int j = 0; j < 8; ++j) acc[hh][j] += pp[hh] * vv[j];
        }
    }
#pragma unroll
    for (int hh = 0; hh < 4; ++hh)
#pragma unroll
        for (int j = 0; j < 8; ++j) { float a = acc[hh][j]; a += __shfl_xor(a, 16); a += __shfl_xor(a, 32); acc[hh][j] = a; }
    if (g4 == 0) {
#pragma unroll
        for (int hh = 0; hh < 4; ++hh) {
            uint4 o; o.x = pk2(acc[hh][0], acc[hh][1]); o.y = pk2(acc[hh][2], acc[hh][3]); o.z = pk2(acc[hh][4], acc[hh][5]); o.w = pk2(acc[hh][6], acc[hh][7]);
            *(uint4*)(p.Y() + t * D + 1536 + hh * 128 + c * 8) = o;
        }
    }
    __builtin_amdgcn_wave_barrier();
}

DEV void ins16(unsigned (&top)[16], unsigned x) {
#pragma unroll
    for (int j = 0; j < 16; ++j) { const unsigned hi = max(top[j], x); x = min(top[j], x); top[j] = hi; }
}
DEV void st_peer_topk(const P& p, int layer, int unit, char* smem) {
    const int tid = tidx(), w = tid >> 6, l = tid & 63, n = l & 31, hf = l >> 5;
    const int head = unit & 7, tg = (unit >> 3) * 4 + w;
    const size_t t = (size_t)tg * 32 + n;
    unsigned* il = (unsigned*)smem + w * 1024;
    unsigned top[2][16];
#pragma unroll
    for (int pp = 0; pp < 2; ++pp) {
        float qv[32];
#pragma unroll
        for (int i = 0; i < 8; ++i) { const float4 v = *(const float4*)(p.PQ() + t * 1024 + head * 128 + pp * 64 + hf * 32 + i * 4); qv[4 * i] = v.x; qv[4 * i + 1] = v.y; qv[4 * i + 2] = v.z; qv[4 * i + 3] = v.w; }
        const float* K = p.peer_sk + ((((size_t)layer * 8 + head) * 2 + pp) * 128) * 64;
#pragma unroll
        for (int j = 0; j < 16; ++j) top[pp][j] = 0u;
#pragma unroll 1
        for (int tile = 0; tile < 4; ++tile) {
            float kv[32];
            const float* kr = K + (size_t)(tile * 32 + n) * 64 + hf * 32;
#pragma unroll
            for (int i = 0; i < 8; ++i) { const float4 v = *(const float4*)(kr + i * 4); kv[4 * i] = v.x; kv[4 * i + 1] = v.y; kv[4 * i + 2] = v.z; kv[4 * i + 3] = v.w; }
            f32x16 acc;
#pragma unroll
            for (int r = 0; r < 16; ++r) acc[r] = 0.f;
#pragma unroll
            for (int kk = 0; kk < 32; ++kk) acc = __builtin_amdgcn_mfma_f32_32x32x2f32(kv[kk], qv[kk], acc, 0, 0, 0);
#pragma unroll
            for (int r = 0; r < 16; ++r) {
                const int nn = tile * 32 + (r & 3) + 8 * (r >> 2) + 4 * hf;
                ins16(top[pp], (f2key(acc[r]) & ~127u) | (unsigned)(127 - nn));
            }
        }
        unsigned oth[16];
#pragma unroll
        for (int j = 0; j < 16; ++j) oth[j] = __shfl_xor(top[pp][j], 32);
#pragma unroll
        for (int j = 0; j < 16; ++j) ins16(top[pp], oth[j]);
        if (hf == 0) {
#pragma unroll
            for (int j = 0; j < 16; ++j) il[(pp * 16 + j) * 32 + n] = 127u - (top[pp][j] & 127u);
        }
    }
    __builtin_amdgcn_wave_barrier();
    if (hf == 0) {
        float v1[16], v2[16];
#pragma unroll
        for (int j = 0; j < 16; ++j) { v1[j] = key2f(top[0][j] & ~127u); v2[j] = key2f(top[1][j] & ~127u); }
        unsigned ct[16];
#pragma unroll
        for (int s = 0; s < 16; ++s) ct[s] = 0u;
#pragma unroll
        for (int i = 0; i < 16; ++i)
#pragma unroll
            for (int j = 0; j < 16; ++j)
                if ((i + 1) * (j + 1) <= 16) ins16(ct, (f2key(v1[i] + v2[j]) & ~255u) | (unsigned)(255 - (i * 16 + j)));
        float ex[16], sum = 0.f; int ce[16];
        const float c0 = key2f(ct[0] & ~255u);
#pragma unroll
        for (int s = 0; s < 16; ++s) {
            const unsigned code = 255u - (ct[s] & 255u);
            ce[s] = (int)(il[(code >> 4) * 32 + n] * 128u + il[(16 + (code & 15u)) * 32 + n]);
            ex[s] = __expf(key2f(ct[s] & ~255u) - c0); sum += ex[s];
        }
        const float inv = 1.0f / sum;
#pragma unroll
        for (int s4 = 0; s4 < 4; ++s4) {
            *(int4*)(p.PE() + t * 128 + head * 16 + s4 * 4) = make_int4(ce[4 * s4], ce[4 * s4 + 1], ce[4 * s4 + 2], ce[4 * s4 + 3]);
            *(float4*)(p.PG() + t * 128 + head * 16 + s4 * 4) = make_float4(ex[4 * s4] * inv, ex[4 * s4 + 1] * inv, ex[4 * s4 + 2] * inv, ex[4 * s4 + 3] * inv);
        }
    }
    __builtin_amdgcn_wave_barrier();
}

DEV void st_peer_gather(const P& p, int layer, const float* __restrict__ xin, float* __restrict__ xout, int unit, char* smem) {
    const int tid_ = tidx(); const int w = tid_ >> 6, l = tid_ & 63; const size_t t = (size_t)unit * 4 + w;
    float* row = (float*)smem + w * 2112;
    const int* pip = p.PI();
    const float ic6 = __int_as_float(__builtin_amdgcn_readfirstlane(pip[32]));
    {
#pragma unroll
        for (int i = 0; i < 4; ++i) {
            const uint4 hv = *(const uint4*)(p.HN() + t * D + i * 512 + l * 8);
            const unsigned u4[4] = {hv.x, hv.y, hv.z, hv.w};
            const int c = i * 512 + l * 8;
#pragma unroll
            for (int q = 0; q < 4; ++q) { row[((c + 2 * q) >> 5) * 33 + ((c + 2 * q) & 31)] = lo2f(u4[q]); row[((c + 2 * q + 1) >> 5) * 33 + ((c + 2 * q + 1) & 31)] = hi2f(u4[q]); }
        }
        __builtin_amdgcn_wave_barrier();
    }
    unsigned hp[16];
#pragma unroll
    for (int j = 0; j < 16; ++j)
        hp[j] = (__float_as_uint(row[l * 33 + __builtin_amdgcn_readfirstlane(pip[2 * j])]) >> 16) |
                (__float_as_uint(row[l * 33 + __builtin_amdgcn_readfirstlane(pip[2 * j + 1])]) & 0xffff0000u);
    __builtin_amdgcn_wave_barrier();
    const int e0 = p.PE()[t * 128 + l], e1 = p.PE()[t * 128 + 64 + l];
    const float g0 = p.PG()[t * 128 + l], g1 = p.PG()[t * 128 + 64 + l];
    float out[32];
#pragma unroll
    for (int i = 0; i < 32; ++i) out[i] = 0.f;
    const unsigned char* U = p.Utab() + (size_t)layer * 16384 * ROW6; const unsigned char* V = p.Vtab() + (size_t)layer * 16384 * ROW6;
    const unsigned voff = (unsigned)l * 8u;
    const bool b5 = (l & 32) != 0, b4 = (l & 16) != 0;
#pragma unroll 1
    for (int k4 = 0; k4 < 32; ++k4) {
        int e[4]; float g[4];
#pragma unroll
        for (int q = 0; q < 4; ++q) {
            const int k = k4 * 4 + q;
            e[q] = __builtin_amdgcn_readlane(k4 < 16 ? e0 : e1, k & 63);
            g[q] = __int_as_float(__builtin_amdgcn_readlane(__float_as_int(k4 < 16 ? g0 : g1), k & 63));
        }
        uint2 uu[4][3], vv[4][3];
#pragma unroll
        for (int q = 0; q < 4; ++q)
#pragma unroll
            for (int i = 0; i < 3; ++i) { uu[q][i] = *(const uint2*)(U + (size_t)e[q] * ROW6 + (voff + i * 512)); vv[q][i] = *(const uint2*)(V + (size_t)e[q] * ROW6 + (voff + i * 512)); }
        float d[4];
#pragma unroll
        for (int q = 0; q < 4; ++q) {
            v6u pk; pk[0] = uu[q][0].x; pk[1] = uu[q][0].y; pk[2] = uu[q][1].x; pk[3] = uu[q][1].y; pk[4] = uu[q][2].x; pk[5] = uu[q][2].y;
            if (q > 0) { unsigned t0_ = pk[0]; asm volatile("" : "+v"(t0_), "+v"(d[q - 1])); pk[0] = t0_; }
            const v32f f = FP6_UNPACK(pk);
            float acc = 0.f;
#pragma unroll
            for (int j = 0; j < 16; ++j) acc += f[2 * j] * lo2f(hp[j]) + f[2 * j + 1] * hi2f(hp[j]);
            d[q] = acc;
            __builtin_amdgcn_sched_barrier(0);
        }
        float kA = b5 ? d[2] : d[0], kB = b5 ? d[3] : d[1];
        const float sA = b5 ? d[0] : d[2], sB = b5 ? d[1] : d[3];
        kA += __shfl_xor(sA, 32); kB += __shfl_xor(sB, 32);
        float kk = b4 ? kB : kA; const float ss = b4 ? kA : kB;
        kk += __shfl_xor(ss, 16);
        kk += __shfl_xor(kk, 8); kk += __shfl_xor(kk, 4); kk += __shfl_xor(kk, 2); kk += __shfl_xor(kk, 1);
        const float gsel = b5 ? (b4 ? g[3] : g[2]) : (b4 ? g[1] : g[0]);
        const float av = gelu_tanh(kk * (ic6 / U6_SCALE)) * gsel * (ic6 / V6_SCALE);
        const int avi = __float_as_int(av);
        const float a4[4] = {__int_as_float(__builtin_amdgcn_readlane(avi, 0)), __int_as_float(__builtin_amdgcn_readlane(avi, 16)),
                             __int_as_float(__builtin_amdgcn_readlane(avi, 32)), __int_as_float(__builtin_amdgcn_readlane(avi, 48))};
#pragma unroll
        for (int q = 0; q < 4; ++q) {
            v6u pk; pk[0] = vv[q][0].x; pk[1] = vv[q][0].y; pk[2] = vv[q][1].x; pk[3] = vv[q][1].y; pk[4] = vv[q][2].x; pk[5] = vv[q][2].y;
            { unsigned t0_ = pk[0]; asm volatile("" : "+v"(t0_), "+v"(out[31])); pk[0] = t0_; }
            const v32f f = FP6_UNPACK(pk);
#pragma unroll
            for (int j = 0; j < 32; ++j) out[j] += a4[q] * f[j];
            __builtin_amdgcn_sched_barrier(0);
        }
    }
    asm volatile("" : "+s"(pip));
#pragma unroll
    for (int j = 0; j < 32; ++j) row[l * 33 + __builtin_amdgcn_readfirstlane(pip[j])] = out[j];
    __builtin_amdgcn_wave_barrier();
    const float* g2 = p.ada() + layer * 12288 + 5 * 2048;
    float4 xo[8]; float ssq = 0.f;
#pragma unroll
    for (int i = 0; i < 8; ++i) {
        const int c = i * 256 + l * 4;
        const float* rp = row + (c >> 5) * 33 + (c & 31);
        const size_t off = t * D + c;
        const float4 x0 = *(const float4*)(xin + off); const float4 ga = *(const float4*)(g2 + c);
        float4 o0;
        o0.x = x0.x + ga.x * rp[0]; o0.y = x0.y + ga.y * rp[1]; o0.z = x0.z + ga.z * rp[2]; o0.w = x0.w + ga.w * rp[3];
        *(float4*)(xout + off) = o0;
        xo[i] = o0; ssq += o0.x * o0.x + o0.y * o0.y + o0.z * o0.z + o0.w * o0.w;
        if (i & 1) __builtin_amdgcn_sched_barrier(0);
    }
    if (layer + 1 < NL) {
        const float rs = rsqrtf(wsum(ssq) * (1.0f / 2048.0f) + EPS);
        const float* ng = p.n1g + (layer + 1) * 2048; const float* adn = p.ada() + (layer + 1) * 12288;
#pragma unroll
        for (int i = 0; i < 8; ++i) {
            const int c = i * 256 + l * 4;
            const float4 gg = *(const float4*)(ng + c), sc = *(const float4*)(adn + 2048 + c), sh = *(const float4*)(adn + c);
            uint2 o;
            o.x = pk2((xo[i].x * rs) * gg.x * (1.0f + sc.x) + sh.x, (xo[i].y * rs) * gg.y * (1.0f + sc.y) + sh.y);
            o.y = pk2((xo[i].z * rs) * gg.z * (1.0f + sc.z) + sh.z, (xo[i].w * rs) * gg.w * (1.0f + sc.w) + sh.w);
            *(uint2*)(p.HN() + t * D + c) = o;
            if (i & 1) __builtin_amdgcn_sched_barrier(0);
        }
    }
    __builtin_amdgcn_wave_barrier();
}

enum { S_CONVT_IN = 0, S_CONVT_OUT, S_CONVT_Q, S_CONVT_W1, S_CALIB, S_TAB_U, S_TAB_V, S_ADA, S_ROPE, S_NORM1, S_GEMM_IN, S_CONV, S_SGU, S_VTRANS, S_PREP,
       S_COMPRESS, S_NSA_CMP, S_DSA_INDEX, S_NSA_ATTN, S_DSA_ATTN, S_GEMM_OUT, S_NORM2, S_GEMM_Q, S_PEER_TOPK, S_PEER_GATHER, S_COUNT };
constexpr int TAB_UNITS = 4096;
__host__ __device__ constexpr int nunits(int s) {
    return s == S_CONVT_IN ? 2 * 32 * (LDP / 64) : s == S_CONVT_OUT ? 2 * 32 * 32 : s == S_CONVT_Q ? 2 * 32 * 16 : s == S_CONVT_W1 ? 4 * 64 * 2 : s == S_CALIB ? 1 : s == S_TAB_U ? TAB_UNITS : s == S_TAB_V ? TAB_UNITS
         : s == S_ADA ? 384 : s == S_ROPE ? 768 : s == S_NORM1 ? 2048 : s == S_GEMM_IN ? 64 * (LDP / 128) : s == S_CONV ? 512 : s == S_SGU ? 256
         : s == S_VTRANS ? 256 : s == S_PREP ? 2048 : s == S_COMPRESS ? 64 : s == S_NSA_CMP ? 512 : s == S_DSA_INDEX ? 512 : s == S_NSA_ATTN ? 512 : s == S_DSA_ATTN ? 2048
         : s == S_GEMM_OUT ? 64 * 16 : s == S_NORM2 ? 2048 : s == S_GEMM_Q ? 64 * 8 : s == S_PEER_TOPK ? 512 : s == S_PEER_GATHER ? 2048 : 0;
}
template <int S>
DEV void run_unit(const P& p, int layer, int u, char* smem, int nu = TAB_UNITS) {
    const float* xin = layer == 0 ? p.x : p.X2();
    const float* ada = p.ada() + layer * 12288;
    if constexpr (S == S_CONVT_IN) { const int per = 32 * (LDP / 64), ly = u / per; st_convT(p.w_in + (size_t)ly * 2048 * INC, p.WinT() + (size_t)ly * LDP * 2048, INC, LDP, true, u % per, smem); }
    else if constexpr (S == S_CONVT_OUT) { const int per = 32 * 32, ly = u / per; st_convT(p.w_out + (size_t)ly * 2048 * 2048, p.WoutT() + (size_t)ly * 2048 * 2048, 2048, 2048, false, u % per, smem); }
    else if constexpr (S == S_CONVT_Q) { const int per = 32 * 16, ly = u / per; st_convT(p.peer_wq + (size_t)ly * 2048 * 1024, p.WqT() + (size_t)ly * 1024 * 2048, 1024, 1024, false, u % per, smem); }
    else if constexpr (S == S_CONVT_W1) { const int per = 64 * 2, mi = u / per; st_convT(p.cmp_w1 + (size_t)mi * 4096 * 128, p.W1T() + (size_t)mi * 128 * 4096, 128, 128, false, u % per, smem, 4096); }
    else if constexpr (S == S_CALIB) st_calib(p);
    else if constexpr (S == S_TAB_U) st_tab6(p.peer_u, p.Utab(), U6_SCALE, 2 * 16384, u, nu, smem);
    else if constexpr (S == S_TAB_V) st_tab6(p.peer_v, p.Vtab(), V6_SCALE, 2 * 16384, u, nu, smem);
    else if constexpr (S == S_ADA) st_ada(p, u, smem);
    else if constexpr (S == S_ROPE) st_rope(p, u);
    else if constexpr (S == S_NORM1) st_norm(xin, p.n1g + layer * 2048, ada + 2048, ada, p.HN(), u);
    else if constexpr (S == S_GEMM_IN) { EpiArgs e{p.PROJ(), nullptr, nullptr, nullptr}; st_gemm<EPI_PROJ>(p.HN(), p.WinT() + (size_t)layer * LDP * 2048, 2048, u & 63, u >> 6, e, smem); }
    else if constexpr (S == S_CONV) st_conv(p, layer, u, smem);
    else if constexpr (S == S_SGU) st_sgu(p, layer, u, smem);
    else if constexpr (S == S_VTRANS) st_vtrans(p, u, smem);
    else if constexpr (S == S_PREP) st_prep(p, layer, u);
    else if constexpr (S == S_COMPRESS) st_compress(p, layer, u, smem);
    else if constexpr (S == S_NSA_CMP) st_nsa_cmp(p, u, smem);
    else if constexpr (S == S_DSA_INDEX) st_dsa_index(p, u, smem);
    else if constexpr (S == S_NSA_ATTN) st_nsa_attn(p, u, smem);
    else if constexpr (S == S_DSA_ATTN) st_dsa_attn(p, u, smem);
    else if constexpr (S == S_GEMM_OUT) { EpiArgs e{nullptr, p.X1(), xin, ada + 2 * 2048}; st_gemm<EPI_OUT>(p.Y(), p.WoutT() + (size_t)layer * 2048 * 2048, 2048, u & 63, u >> 6, e, smem); }
    else if constexpr (S == S_NORM2) st_norm(p.X1(), p.n2g + layer * 2048, ada + 4 * 2048, ada + 3 * 2048, p.HN(), u);
    else if constexpr (S == S_GEMM_Q) { EpiArgs e{nullptr, p.PQ(), nullptr, nullptr}; st_gemm<EPI_Q>(p.HN(), p.WqT() + (size_t)layer * 1024 * 2048, 2048, u & 63, u >> 6, e, smem); }
    else if constexpr (S == S_PEER_TOPK) st_peer_topk(p, layer, u, smem);
    else if constexpr (S == S_PEER_GATHER) st_peer_gather(p, layer, p.X1(), layer == 0 ? p.X2() : p.out, u, smem);
}


#define XB_TMO      128
#define XB_XCNT(j)  (256  + 64 * (j))
#define XB_XSUB(j)  (1280 + 64 * (j))
#define XB_XGEN(j)  (2304 + 64 * (j))
#define XB_TOP      3328
#define XB_TOPGEN   3392
#define XB_SPIN_CAP (1u << 22)
#define LAS __attribute__((address_space(3)))
DEV unsigned xb_ld(unsigned* p) { return __hip_atomic_load(p, __ATOMIC_RELAXED, __HIP_MEMORY_SCOPE_AGENT); }
DEV unsigned xb_add(unsigned* p, unsigned v) { return __hip_atomic_fetch_add(p, v, __ATOMIC_RELAXED, __HIP_MEMORY_SCOPE_AGENT); }
DEV unsigned xb_xcc_id() { return (unsigned)__builtin_amdgcn_s_getreg((3 << 11) | 20) & 0xFu; }
#define XB_SPIN(cond, bar) do { unsigned _sp = 0; while (cond) { __builtin_amdgcn_s_sleep(1); \
    if ((++_sp & 255u) == 0u) { if (xb_ld(&(bar)[XB_TMO])) break; if (_sp > XB_SPIN_CAP) { atomicAdd(&(bar)[XB_TMO], 1u); break; } } } } while (0)
struct XcdBarrier { unsigned* bar; unsigned x; volatile LAS unsigned* st; };
DEV XcdBarrier xcd_barrier_post(unsigned* bar, volatile LAS unsigned* st) {
    XcdBarrier b; b.bar = bar; b.x = xb_xcc_id(); b.st = st;
    if (threadIdx.x == 0) (void)xb_add(&bar[XB_XCNT(b.x)], 1u);
    return b;
}
DEV void xcd_barrier_complete(unsigned* bar, unsigned x, unsigned& nloc, unsigned& nx) {
    const unsigned G = gridDim.x * gridDim.y * gridDim.z;
    unsigned sum, cnt, mine, sp = 0u;
    for (;;) {
        sum = 0u; cnt = 0u; mine = 0u;
#pragma unroll
        for (unsigned j = 0; j < 16; ++j) { const unsigned c = xb_ld(&bar[XB_XCNT(j)]); sum += c; cnt += (c > 0u) ? 1u : 0u; mine = (j == x) ? c : mine; }
        if (sum == G) break;
        __builtin_amdgcn_s_sleep(1);
        if ((++sp & 255u) == 0u) { if (xb_ld(&bar[XB_TMO])) break; if (sp > XB_SPIN_CAP) { atomicAdd(&bar[XB_TMO], 1u); break; } }
    }
    nloc = mine > 0u ? mine : 1u; nx = cnt > 0u ? cnt : 1u;
}
DEV void xcd_barrier(const XcdBarrier& b) {
    asm volatile("s_waitcnt vmcnt(0)" ::: "memory");
    __syncthreads();
    if (threadIdx.x == 0) {
        unsigned* bar = b.bar;
        __builtin_amdgcn_s_waitcnt(0);
        unsigned nloc = b.st[0], nx = b.st[1];
        if (nloc == 0u) { xcd_barrier_complete(bar, b.x, nloc, nx); b.st[0] = nloc; b.st[1] = nx; }
        const unsigned old = xb_add(&bar[XB_XSUB(b.x)], 1u);
        const unsigned gen = old / nloc;
        if (old + 1u == (gen + 1u) * nloc) {
            __builtin_amdgcn_fence(__ATOMIC_RELEASE, "agent");
            asm volatile("s_waitcnt vmcnt(0)" ::: "memory");
            const unsigned og = xb_add(&bar[XB_TOP], 1u);
            const unsigned tg = og / nx;
            if (og + 1u == (tg + 1u) * nx) xb_add(&bar[XB_TOPGEN], 1u);
            else XB_SPIN(xb_ld(&bar[XB_TOPGEN]) == tg, bar);
            __builtin_amdgcn_fence(__ATOMIC_ACQUIRE, "agent");
            xb_add(&bar[XB_XGEN(b.x)], 1u);
            asm volatile("s_waitcnt vmcnt(0)" ::: "memory");
        } else {
            XB_SPIN(xb_ld(&bar[XB_XGEN(b.x)]) == gen, bar);
            __builtin_amdgcn_fence(__ATOMIC_ACQUIRE, "agent");
            asm volatile("s_waitcnt vmcnt(0)" ::: "memory");
        }
    }
    __syncthreads();
}

#ifndef MULTI_LAUNCH
constexpr int REP_STAGE = -1, REP_STAGE2 = -1, REP_N = 1;
template <int S, int LIM = 0>
DEV void run_phase1(const P& p, int layer, char* smem, int off);
template <int S, int LIM = 0>
DEV void run_phase(const P& p, int layer, char* smem, int off = 0) {
    constexpr int reps = (S == REP_STAGE || S == REP_STAGE2) ? REP_N : 1;
#pragma unroll 1
    for (int r = 0; r < reps; ++r) run_phase1<S, LIM>(p, layer, smem, off);
}
template <int S, int LIM>
DEV void run_phase1(const P& p, int layer, char* smem, int off) {
    const int G = gridDim.x;
    int b = blockIdx.x + off; if (b >= G) b -= G;
    if constexpr (S == S_TAB_U || S == S_TAB_V) { run_unit<S>(p, layer, b, smem, G); }
    else {
        for (int u = b; u < (LIM ? LIM : nunits(S)); u += G) { run_unit<S>(p, layer, u, smem); __syncthreads(); }
    }
}
template <int S>
DEV void run_gemm_phase1(const P& p, int layer, char* smem, unsigned xcc, volatile LAS unsigned* slot, int rep) {
    constexpr int TN = (S == S_GEMM_IN) ? (LDP / 128) : (S == S_GEMM_OUT ? 16 : 8);
    constexpr int NBIG = (S == S_GEMM_IN) ? 32 : (S == S_GEMM_OUT ? 16 : 0);
    constexpr int inst0 = (S == S_GEMM_IN) ? 0 : (S == S_GEMM_OUT ? 2 : 4);
    constexpr int nbig = 4 * NBIG, len = nbig + 8 * (TN - NBIG);
    const float* xin = layer == 0 ? p.x : p.X2();
    const float* ada = p.ada() + layer * 12288;
    const bf16_t* Aop = (S == S_GEMM_OUT) ? p.Y() : p.HN();
    const bf16_t* Bop = (S == S_GEMM_IN) ? p.WinT() + (size_t)layer * LDP * 2048 : (S == S_GEMM_OUT ? p.WoutT() + (size_t)layer * 2048 * 2048 : p.WqT() + (size_t)layer * 1024 * 2048);
    EpiArgs e{p.PROJ(), (S == S_GEMM_OUT) ? p.X1() : p.PQ(), xin, ada + 2 * 2048};
    constexpr int EPI = (S == S_GEMM_IN) ? EPI_PROJ : (S == S_GEMM_OUT ? EPI_OUT : EPI_Q);
#pragma unroll 1
    for (int q = 0; q < 8; ++q) {
        const unsigned xq = (xcc + q) & 7u;
        unsigned* head = p.bar() + GQ_WORD(inst0 + layer + 6 * rep, xq);
        for (;;) {
            if (threadIdx.x == 0) *slot = xb_add(head, 1u);
            __syncthreads();
            const int i = (int)*slot;
            __syncthreads();
            if (i >= len) break;
            if (i < nbig) st_gemm<EPI, 8>(Aop, Bop, 2048, (int)xq * 4 + (i & 3), i >> 2, e, smem);
            else { const int j = i - nbig; st_gemm<EPI, 4>(Aop, Bop, 2048, (int)xq * 8 + (j & 7), NBIG + (j >> 3), e, smem); }
            __syncthreads();
        }
    }
}
template <int S>
DEV void run_items(const P& p, int layer, char* smem, int first, int count) {
    constexpr int reps = (S == REP_STAGE || S == REP_STAGE2) ? REP_N : 1;
#pragma unroll 1
    for (int r = 0; r < reps; ++r)
#pragma unroll 1
        for (int u = first; u < first + count; ++u) { run_unit<S>(p, layer, u, smem); __syncthreads(); }
}
template <int PH>
DEV void run_dyn_phase(const P& p, int layer, char* smem, volatile LAS unsigned* slot) {
    unsigned* head = p.bar() + DQ_WORD(PH * 2 + layer);
    constexpr int total0 = PH == 0 ? (64 + 256 + 256 + 64 + 256) : (PH == 1 ? (512 + 256) : (512 + 512));
    const int total = (PH == 1 && layer == 0) ? total0 + 512 + 296 + 256 + 128 : total0;
    int i = blockIdx.x;
    while (i < total) {
        if constexpr (PH == 0) {
            if (i < 256) run_items<S_SGU>(p, layer, smem, i, 1);
            else if (i < 320) run_items<S_COMPRESS>(p, layer, smem, i - 256, 1);
            else if (i < 576) run_items<S_CONV>(p, layer, smem, (i - 320) * 2, 2);
            else if (i < 640) run_items<S_VTRANS>(p, layer, smem, (i - 576) * 4, 4);
            else run_items<S_PREP>(p, layer, smem, (i - 640) * 8, 8);
        } else if constexpr (PH == 1) {
            if (i < 512) run_items<S_DSA_INDEX>(p, layer, smem, i, 1);
            else if (i < 768) run_items<S_NSA_CMP>(p, layer, smem, (i - 512) * 2, 2);
            else if (i < 1024) { run_unit<S_TAB_U>(p, layer, i - 768, smem, 256); __syncthreads(); }
            else if (i < 1280) { run_unit<S_TAB_V>(p, layer, i - 1024, smem, 256); __syncthreads(); }
            else if (i < 1576) run_items<S_CONVT_IN>(p, layer, smem, 2368 + (i - 1280) * 8, 8);
            else if (i < 1832) run_items<S_CONVT_OUT>(p, layer, smem, (i - 1576) * 8, 8);
            else run_items<S_CONVT_Q>(p, layer, smem, (i - 1832) * 8, 8);
        } else {
            if (i < 512) run_items<S_NSA_ATTN>(p, layer, smem, 511 - i, 1);
            else run_items<S_DSA_ATTN>(p, layer, smem, (i - 512) * 4, 4);
        }
        if (threadIdx.x == 0) *slot = gridDim.x + xb_add(head, 1u);
        __syncthreads();
        i = (int)*slot;
        __syncthreads();
    }
}
template <int S>
DEV void run_gemm_phase(const P& p, int layer, char* smem, unsigned xcc, volatile LAS unsigned* slot) {
    constexpr int reps = (S == REP_STAGE || S == REP_STAGE2) ? REP_N : 1;
#pragma unroll 1
    for (int r = 0; r < reps; ++r) run_gemm_phase1<S>(p, layer, smem, xcc, slot, r);
}
#if defined(__HIP_DEVICE_COMPILE__)
typedef const P __attribute__((address_space(4)))* kargp_t;
DEV const P& fresh_params() { kargp_t q = (kargp_t)__builtin_amdgcn_kernarg_segment_ptr(); asm volatile("" : "+s"(q)); return *(const P*)q; }
#define PP fresh_params()
#else
#define PP p
#endif
#define GSYNC() xcd_barrier(xb)
__global__ void __launch_bounds__(NTHREADS, 2) k_mega(P p) {
    __shared__ __attribute__((aligned(16))) char smem[SMEM_BYTES];
    __shared__ uint4 xb_words;
    cg::grid_group grid = cg::this_grid();
    if (threadIdx.x == 0) xb_words = make_uint4(0u, 0u, 0u, 0u);
    __syncthreads();
    XcdBarrier xb = xcd_barrier_post(p.bar(), (volatile LAS unsigned*)&xb_words);
    const int H = gridDim.x >> 1, Q = gridDim.x >> 2;
    run_phase<S_ADA>(PP, 0, smem); run_phase<S_ROPE>(PP, 0, smem, H);
    run_phase<S_CONVT_IN, 2368>(PP, 0, smem); run_phase<S_CONVT_W1>(PP, 0, smem); run_phase<S_CALIB>(PP, 0, smem, 100);
    grid.sync();
#pragma unroll 1
    for (int layer = 0; layer < NL; ++layer) {
        if (layer == 0) { run_phase<S_NORM1>(PP, layer, smem); GSYNC(); }
        run_gemm_phase<S_GEMM_IN>(PP, layer, smem, xb.x, (volatile LAS unsigned*)&xb_words + 2); GSYNC();
        run_dyn_phase<0>(PP, layer, smem, (volatile LAS unsigned*)&xb_words + 2); GSYNC();
        run_dyn_phase<1>(PP, layer, smem, (volatile LAS unsigned*)&xb_words + 2); GSYNC();
        run_dyn_phase<2>(PP, layer, smem, (volatile LAS unsigned*)&xb_words + 2); GSYNC();
        run_gemm_phase<S_GEMM_OUT>(PP, layer, smem, xb.x, (volatile LAS unsigned*)&xb_words + 2); GSYNC();
        run_phase<S_NORM2>(PP, layer, smem); GSYNC();
        run_gemm_phase<S_GEMM_Q>(PP, layer, smem, xb.x, (volatile LAS unsigned*)&xb_words + 2); GSYNC();
        run_phase<S_PEER_TOPK>(PP, layer, smem); GSYNC();
        run_phase<S_PEER_GATHER>(PP, layer, smem); GSYNC();
    }
}
#else
template <int S>
__global__ void __launch_bounds__(NTHREADS) k_stage(P p, int layer) {
    __shared__ __attribute__((aligned(16))) char smem[SMEM_BYTES];
    run_unit<S>(p, layer, blockIdx.x, smem);
}
template <int S> static void launch_stage(const P& p, int layer, hipStream_t st) {
    hipLaunchKernelGGL((k_stage<S>), dim3(nunits(S)), dim3(NTHREADS), 0, st, p, layer);
}
#endif

extern "C" void kernel_launch(void* const* d_in, const int* in_sizes, int n_in, void* d_out, int out_size, void* d_ws, size_t ws_size, hipStream_t stream) {
    P p{};
    p.x = (const float*)d_in[0]; p.c = (const float*)d_in[1]; p.pos = (const int*)d_in[2]; p.ada_w = (const float*)d_in[3]; p.ada_b = (const float*)d_in[4];
    p.n1g = (const float*)d_in[5]; p.n2g = (const float*)d_in[6]; p.w_in = (const float*)d_in[7]; p.w_out = (const float*)d_in[8]; p.conv_w = (const float*)d_in[9];
    p.conv_b = (const float*)d_in[10]; p.cln_g = (const float*)d_in[11]; p.cln_b = (const float*)d_in[12]; p.sln_g = (const float*)d_in[13]; p.sln_b = (const float*)d_in[14];
    p.sgu_w = (const float*)d_in[15]; p.sgu_b = (const float*)d_in[16]; p.nsa_qg = (const float*)d_in[17]; p.nsa_kg = (const float*)d_in[18]; p.cmp_pos = (const float*)d_in[19];
    p.cmp_w1 = (const float*)d_in[20]; p.cmp_w2 = (const float*)d_in[21]; p.dsa_qg = (const float*)d_in[22]; p.dsa_kg = (const float*)d_in[23]; p.peer_wq = (const float*)d_in[24];
    p.peer_sk = (const float*)d_in[25]; p.peer_u = (const float*)d_in[26]; p.peer_v = (const float*)d_in[27];
    p.out = (float*)d_out;
    p.ws = (char*)d_ws; const size_t off = WS_TOTAL;
    if (off > ws_size) { fprintf(stderr, "workspace too small: need %zu have %zu\n", off, ws_size); return; }
#ifndef MULTI_LAUNCH
    static int grid_blocks = 0;
    if (!grid_blocks) {
        int dev = 0, cus = 0, per_cu = 0;
        (void)hipGetDevice(&dev);
        (void)hipDeviceGetAttribute(&cus, hipDeviceAttributeMultiprocessorCount, dev);
        (void)hipOccupancyMaxActiveBlocksPerMultiprocessor(&per_cu, k_mega, NTHREADS, 0);
        if (per_cu > 2) per_cu = 2;
        grid_blocks = cus * per_cu;
    }
    (void)hipMemsetAsync(p.bar(), 0, (size_t)CTRL_WORDS * 4, stream);
    void* args[] = {&p};
    hipError_t e = hipLaunchCooperativeKernel((void*)k_mega, dim3(grid_blocks), dim3(NTHREADS), args, 0, stream);
    if (e != hipSuccess) fprintf(stderr, "cooperative launch failed: %s (grid %d)\n", hipGetErrorString(e), grid_blocks);
#else
    launch_stage<S_CONVT_IN>(p, 0, stream); launch_stage<S_CONVT_OUT>(p, 0, stream); launch_stage<S_CONVT_Q>(p, 0, stream); launch_stage<S_CONVT_W1>(p, 0, stream); launch_stage<S_CALIB>(p, 0, stream);
    launch_stage<S_TAB_U>(p, 0, stream); launch_stage<S_TAB_V>(p, 0, stream);
    launch_stage<S_ADA>(p, 0, stream); launch_stage<S_ROPE>(p, 0, stream);
    for (int layer = 0; layer < NL; ++layer) {
        launch_stage<S_NORM1>(p, layer, stream); launch_stage<S_GEMM_IN>(p, layer, stream);
        launch_stage<S_CONV>(p, layer, stream); launch_stage<S_SGU>(p, layer, stream); launch_stage<S_VTRANS>(p, layer, stream);
        launch_stage<S_PREP>(p, layer, stream); launch_stage<S_COMPRESS>(p, layer, stream);
        launch_stage<S_NSA_CMP>(p, layer, stream); launch_stage<S_DSA_INDEX>(p, layer, stream);
        launch_stage<S_NSA_ATTN>(p, layer, stream); launch_stage<S_DSA_ATTN>(p, layer, stream);
        launch_stage<S_GEMM_OUT>(p, layer, stream); launch_stage<S_NORM2>(p, layer, stream); launch_stage<S_GEMM_Q>(p, layer, stream);
        launch_stage<S_PEER_TOPK>(p, layer, stream); launch_stage<S_PEER_GATHER>(p, layer, stream);
    }
#endif
}
```

```cpp
#include <hip/hip_runtime.h>
#include <hip/hip_cooperative_groups.h>
#include <stdint.h>
#include <cstdio>
namespace cg = cooperative_groups;

typedef unsigned short bf16_t;
typedef short bf16x8 __attribute__((ext_vector_type(8)));
typedef float f32x4 __attribute__((ext_vector_type(4)));
typedef float f32x16 __attribute__((ext_vector_type(16)));
#define DEV __device__ __forceinline__

constexpr int T = 8192, D = 2048, NL = 2;
constexpr int INC = 4692;
constexpr int LDP = 4736;
constexpr int C_CA = 0, C_CG = 512, C_SU = 1024, C_SV = 1536;
constexpr int C_NQ = 2048, C_NKC = 2560, C_NVC = 2688, C_NKS = 2816, C_NVS = 2944, C_NKW = 3072, C_NVW = 3200;
constexpr int C_DQ = 3328, C_DK = 3840, C_DV = 3968, C_IQ = 4096, C_IK = 4608, C_NG = 4672, C_IW = 4688;
constexpr float EPS = 1e-6f;
constexpr int NTHREADS = 256;
constexpr int SMEM_BYTES = 72 * 1024;

__device__ const double INV16[16] = {1.0, 0.44036660267178046, 0.19392274474868576, 0.08539710028576561, 0.03760603093086393,
    0.016560440080994446, 0.007292664737217109, 0.003211445994752591, 0.001414213562373095, 0.000622772421914596,
    0.0002742481756762073, 0.00012076973741146504, 5.318295896944988e-05, 2.341999896140934e-05, 1.031338537721246e-05,
    4.5416704806078695e-06};

#define XCD_BAR_WORDS 3456
#define GQ_WORD(inst, x) (XCD_BAR_WORDS + 64 * ((inst) * 8 + (x)))
#define DQ_WORD(k) (XCD_BAR_WORDS + 64 * (96 + (k)))
#define CTRL_WORDS (XCD_BAR_WORDS + 64 * 112)
constexpr size_t WS_ALIGN(size_t x) { return (x + 255) & ~(size_t)255; }
constexpr size_t OFF_WinT = 0;
constexpr size_t OFF_WoutT = OFF_WinT + WS_ALIGN((size_t)2 * LDP * 2048 * 2);
constexpr size_t OFF_WqT = OFF_WoutT + WS_ALIGN((size_t)2 * 2048 * 2048 * 2);
constexpr size_t OFF_W1T = OFF_WqT + WS_ALIGN((size_t)2 * 1024 * 2048 * 2);
constexpr size_t OFF_PI = OFF_W1T + WS_ALIGN((size_t)4 * 128 * 4096 * 2);
constexpr size_t OFF_Utab = OFF_PI + WS_ALIGN(256);
constexpr size_t OFF_Vtab = OFF_Utab + WS_ALIGN((size_t)2 * 16384 * 1536);
constexpr size_t OFF_ada = OFF_Vtab + WS_ALIGN((size_t)2 * 16384 * 1536);
constexpr size_t OFF_ropeC = OFF_ada + WS_ALIGN((size_t)2 * 12288 * 4);
constexpr size_t OFF_ropeS = OFF_ropeC + WS_ALIGN((size_t)T * 24 * 4);
constexpr size_t OFF_HN = OFF_ropeS + WS_ALIGN((size_t)T * 24 * 4);
constexpr size_t OFF_PROJ = OFF_HN + WS_ALIGN((size_t)T * D * 2);
constexpr size_t OFF_Y = OFF_PROJ + WS_ALIGN((size_t)T * LDP * 2);
constexpr size_t OFF_QN = OFF_Y + WS_ALIGN((size_t)T * D * 2);
constexpr size_t OFF_QR = OFF_QN + WS_ALIGN((size_t)T * 512 * 2);
constexpr size_t OFF_KS = OFF_QR + WS_ALIGN((size_t)T * 512 * 2);
constexpr size_t OFF_KW = OFF_KS + WS_ALIGN((size_t)T * 128 * 2);
constexpr size_t OFF_VST = OFF_KW + WS_ALIGN((size_t)T * 128 * 2);
constexpr size_t OFF_VWT = OFF_VST + WS_ALIGN((size_t)T * 128 * 2);
constexpr size_t OFF_GATES = OFF_VWT + WS_ALIGN((size_t)T * 128 * 2);
constexpr size_t OFF_KC = OFF_GATES + WS_ALIGN((size_t)T * 12 * 4);
constexpr size_t OFF_VCT = OFF_KC + WS_ALIGN((size_t)512 * 128 * 2);
constexpr size_t OFF_SEL = OFF_VCT + WS_ALIGN((size_t)128 * 512 * 2);
constexpr size_t OFF_OCMP = OFF_SEL + WS_ALIGN((size_t)T * 4 * 4);
constexpr size_t OFF_DQ = OFF_OCMP + WS_ALIGN((size_t)T * 512 * 2);
constexpr size_t OFF_DK = OFF_DQ + WS_ALIGN((size_t)T * 512 * 2);
constexpr size_t OFF_DVC = OFF_DK + WS_ALIGN((size_t)T * 128 * 2);
constexpr size_t OFF_IQ = OFF_DVC + WS_ALIGN((size_t)T * 128 * 2);
constexpr size_t OFF_IK = OFF_IQ + WS_ALIGN((size_t)T * 512 * 2);
constexpr size_t OFF_IW = OFF_IK + WS_ALIGN((size_t)T * 64 * 2);
constexpr size_t OFF_IDX = OFF_IW + WS_ALIGN((size_t)T * 8 * 4);
constexpr size_t OFF_CNT = OFF_IDX + WS_ALIGN((size_t)T * 256 * 4);
constexpr size_t OFF_X1 = OFF_CNT + WS_ALIGN((size_t)T * 4);
constexpr size_t OFF_X2 = OFF_X1 + WS_ALIGN((size_t)T * D * 4);
constexpr size_t OFF_PQ = OFF_X2 + WS_ALIGN((size_t)T * D * 4);
constexpr size_t OFF_PE = OFF_PQ + WS_ALIGN((size_t)T * 1024 * 4);
constexpr size_t OFF_PG = OFF_PE + WS_ALIGN((size_t)T * 128 * 4);
constexpr size_t OFF_bar = OFF_PG + WS_ALIGN((size_t)T * 128 * 4);
constexpr size_t WS_TOTAL = OFF_bar + WS_ALIGN((size_t)CTRL_WORDS * 4);

struct P {
    const float* x; const float* c; const int* pos; const float* ada_w; const float* ada_b; const float* n1g; const float* n2g;
    const float* w_in; const float* w_out; const float* conv_w; const float* conv_b; const float* cln_g; const float* cln_b;
    const float* sln_g; const float* sln_b; const float* sgu_w; const float* sgu_b; const float* nsa_qg; const float* nsa_kg;
    const float* cmp_pos; const float* cmp_w1; const float* cmp_w2; const float* dsa_qg; const float* dsa_kg;
    const float* peer_wq; const float* peer_sk; const float* peer_u; const float* peer_v;
    float* out;
    char* ws;
    __host__ __device__ __forceinline__ bf16_t* WinT() const { return (bf16_t*)(ws + OFF_WinT); }
    __host__ __device__ __forceinline__ bf16_t* WoutT() const { return (bf16_t*)(ws + OFF_WoutT); }
    __host__ __device__ __forceinline__ bf16_t* WqT() const { return (bf16_t*)(ws + OFF_WqT); }
    __host__ __device__ __forceinline__ bf16_t* W1T() const { return (bf16_t*)(ws + OFF_W1T); }
    __host__ __device__ __forceinline__ int* PI() const { return (int*)(ws + OFF_PI); }
    __host__ __device__ __forceinline__ unsigned char* Utab() const { return (unsigned char*)(ws + OFF_Utab); }
    __host__ __device__ __forceinline__ unsigned char* Vtab() const { return (unsigned char*)(ws + OFF_Vtab); }
    __host__ __device__ __forceinline__ float* ada() const { return (float*)(ws + OFF_ada); }
    __host__ __device__ __forceinline__ float* ropeC() const { return (float*)(ws + OFF_ropeC); }
    __host__ __device__ __forceinline__ float* ropeS() const { return (float*)(ws + OFF_ropeS); }
    __host__ __device__ __forceinline__ bf16_t* HN() const { return (bf16_t*)(ws + OFF_HN); }
    __host__ __device__ __forceinline__ bf16_t* PROJ() const { return (bf16_t*)(ws + OFF_PROJ); }
    __host__ __device__ __forceinline__ bf16_t* Y() const { return (bf16_t*)(ws + OFF_Y); }
    __host__ __device__ __forceinline__ bf16_t* QN() const { return (bf16_t*)(ws + OFF_QN); }
    __host__ __device__ __forceinline__ bf16_t* QR() const { return (bf16_t*)(ws + OFF_QR); }
    __host__ __device__ __forceinline__ bf16_t* KS() const { return (bf16_t*)(ws + OFF_KS); }
    __host__ __device__ __forceinline__ bf16_t* KW() const { return (bf16_t*)(ws + OFF_KW); }
    __host__ __device__ __forceinline__ bf16_t* VST() const { return (bf16_t*)(ws + OFF_VST); }
    __host__ __device__ __forceinline__ bf16_t* VWT() const { return (bf16_t*)(ws + OFF_VWT); }
    __host__ __device__ __forceinline__ float* GATES() const { return (float*)(ws + OFF_GATES); }
    __host__ __device__ __forceinline__ bf16_t* KC() const { return (bf16_t*)(ws + OFF_KC); }
    __host__ __device__ __forceinline__ bf16_t* VCT() const { return (bf16_t*)(ws + OFF_VCT); }
    __host__ __device__ __forceinline__ unsigned* SEL() const { return (unsigned*)(ws + OFF_SEL); }
    __host__ __device__ __forceinline__ bf16_t* OCMP() const { return (bf16_t*)(ws + OFF_OCMP); }
    __host__ __device__ __forceinline__ bf16_t* DQ() const { return (bf16_t*)(ws + OFF_DQ); }
    __host__ __device__ __forceinline__ bf16_t* DK() const { return (bf16_t*)(ws + OFF_DK); }
    __host__ __device__ __forceinline__ bf16_t* DVC() const { return (bf16_t*)(ws + OFF_DVC); }
    __host__ __device__ __forceinline__ bf16_t* IQ() const { return (bf16_t*)(ws + OFF_IQ); }
    __host__ __device__ __forceinline__ bf16_t* IK() const { return (bf16_t*)(ws + OFF_IK); }
    __host__ __device__ __forceinline__ float* IW() const { return (float*)(ws + OFF_IW); }
    __host__ __device__ __forceinline__ int* IDX() const { return (int*)(ws + OFF_IDX); }
    __host__ __device__ __forceinline__ int* CNT() const { return (int*)(ws + OFF_CNT); }
    __host__ __device__ __forceinline__ float* X1() const { return (float*)(ws + OFF_X1); }
    __host__ __device__ __forceinline__ float* X2() const { return (float*)(ws + OFF_X2); }
    __host__ __device__ __forceinline__ float* PQ() const { return (float*)(ws + OFF_PQ); }
    __host__ __device__ __forceinline__ int* PE() const { return (int*)(ws + OFF_PE); }
    __host__ __device__ __forceinline__ float* PG() const { return (float*)(ws + OFF_PG); }
    __host__ __device__ __forceinline__ unsigned* bar() const { return (unsigned*)(ws + OFF_bar); }
};

DEV float bf2f(bf16_t v) { return __uint_as_float(((unsigned)v) << 16); }
DEV unsigned pk2(float lo, float hi) { unsigned r; asm("v_cvt_pk_bf16_f32 %0, %1, %2" : "=v"(r) : "v"(lo), "v"(hi)); return r; }
DEV bf16_t f2bf(float v) { return (bf16_t)(pk2(v, 0.f) & 0xffffu); }
DEV float lo2f(unsigned u) { return __uint_as_float(u << 16); }
DEV float hi2f(unsigned u) { return __uint_as_float(u & 0xffff0000u); }
#define DPP_ROR_F(V, N) __int_as_float(__builtin_amdgcn_update_dpp(0, __float_as_int(V), 0x120 + (N), 0xf, 0xf, false))
DEV float wsum(float v) {
    v += DPP_ROR_F(v, 8); v += DPP_ROR_F(v, 4); v += DPP_ROR_F(v, 2); v += DPP_ROR_F(v, 1);
    const int vi = __float_as_int(v);
    return (__int_as_float(__builtin_amdgcn_readlane(vi, 0)) + __int_as_float(__builtin_amdgcn_readlane(vi, 16))) +
           (__int_as_float(__builtin_amdgcn_readlane(vi, 32)) + __int_as_float(__builtin_amdgcn_readlane(vi, 48)));
}
DEV float wmax(float v) {
    v = fmaxf(v, DPP_ROR_F(v, 8)); v = fmaxf(v, DPP_ROR_F(v, 4)); v = fmaxf(v, DPP_ROR_F(v, 2)); v = fmaxf(v, DPP_ROR_F(v, 1));
    const int vi = __float_as_int(v);
    return fmaxf(fmaxf(__int_as_float(__builtin_amdgcn_readlane(vi, 0)), __int_as_float(__builtin_amdgcn_readlane(vi, 16))),
                 fmaxf(__int_as_float(__builtin_amdgcn_readlane(vi, 32)), __int_as_float(__builtin_amdgcn_readlane(vi, 48))));
}
DEV int tidx() { int t = threadIdx.x; asm volatile("" : "+v"(t)); return t; }
DEV float sigmoidf_(float x) { return 1.0f / (1.0f + __expf(-x)); }
DEV float gelu_tanh(float x) {
    const float y = 0.7978845608028654f * (x + 0.044715f * x * x * x);
    const float t = 1.0f - 2.0f / (1.0f + __expf(2.0f * y));
    return 0.5f * x * (1.0f + t);
}
DEV f32x4 mfma16(bf16x8 a, bf16x8 b, f32x4 c) { return __builtin_amdgcn_mfma_f32_16x16x32_bf16(a, b, c, 0, 0, 0); }
DEV f32x16 mfma32(bf16x8 a, bf16x8 b, f32x16 c) { return __builtin_amdgcn_mfma_f32_32x32x16_bf16(a, b, c, 0, 0, 0); }

DEV int src_col(int n) {
    if (n < 3328) return n;
    if (n < 4672) return 3340 + (n - 3328);
    if (n < 4684) return 3328 + (n - 4672);
    if (n < 4688) return -1;
    if (n < 4696) return 4684 + (n - 4688);
    return -1;
}

DEV void st_convT(const float* __restrict__ W, bf16_t* __restrict__ Bt, int N, int Npad, bool remap, int unit, char* smem, int Kdim = 2048) {
    float (*tile)[65] = (float (*)[65])smem;
    const int ntn = Npad / 64, kt = unit / ntn, nt = unit % ntn, k0 = kt * 64, n0 = nt * 64;
    const int tid_ = tidx(); const int tx = tid_ & 63, ty = tid_ >> 6;
    const int n = n0 + tx;
    const int src = remap ? src_col(n) : (n < N ? n : -1);
#pragma unroll
    for (int i = 0; i < 16; ++i) { const int k = ty + 4 * i; tile[k][tx] = src >= 0 ? W[(size_t)(k0 + k) * N + src] : 0.f; }
    __syncthreads();
#pragma unroll
    for (int i = 0; i < 16; ++i) { const int r = ty + 4 * i; Bt[(size_t)(n0 + r) * Kdim + k0 + tx] = f2bf(tile[tx][r]); }
    __syncthreads();
}

typedef float f32x2 __attribute__((ext_vector_type(2)));
typedef float v16f __attribute__((ext_vector_type(16)));
typedef float v32f __attribute__((ext_vector_type(32)));
typedef unsigned v6u __attribute__((ext_vector_type(6)));
#ifndef PEER_FP4
#define PEER_FP4 0
#endif
#if PEER_FP4
constexpr float U6_SCALE = 64.0f, V6_SCALE = 2.8f;
constexpr int ROW6 = 1024;
#else
constexpr float U6_SCALE = 64.0f, V6_SCALE = 3.0f;
constexpr int ROW6 = 1536;
#endif
#define FP6_ONE __uint_as_float(0x3F80007Fu)

#ifndef SW_FP6
#define SW_FP6 1
#endif
DEV unsigned fp6_enc1(float f) {
    const float a = fminf(fabsf(f), 7.5f);
    const float sc = a < 2.0f ? 8.0f : (a < 4.0f ? 4.0f : 2.0f), of = a < 2.0f ? 0.0f : (a < 4.0f ? 8.0f : 16.0f);
    const unsigned code = (unsigned)(int)__builtin_rintf(a * sc + of);
    return code | ((__float_as_uint(f) >> 26) & 32u);
}
DEV float fp6_dec1(unsigned c) {
    const unsigned e = (c >> 3) & 3u, m = c & 7u;
    const float v = e == 0u ? 0.125f * (float)m : (1.0f + 0.125f * (float)m) * (float)(1u << (e - 1u));
    return (c & 32u) ? -v : v;
}
DEV v6u sw_pack32(const v16f& x, const v16f& y) {
    unsigned w[6] = {0u, 0u, 0u, 0u, 0u, 0u};
#pragma unroll
    for (int i = 0; i < 32; ++i) {
        const unsigned c = fp6_enc1(i < 16 ? x[i] : y[i - 16]);
        const int bit = 6 * i, d = bit >> 5, sh = bit & 31;
        w[d] |= c << sh;
        if (sh > 26) w[d + 1] |= c >> (32 - sh);
    }
    v6u r; r[0] = w[0]; r[1] = w[1]; r[2] = w[2]; r[3] = w[3]; r[4] = w[4]; r[5] = w[5]; return r;
}
DEV v32f sw_unpack32(const v6u& pk) {
    const unsigned w[6] = {pk[0], pk[1], pk[2], pk[3], pk[4], pk[5]};
    v32f r;
#pragma unroll
    for (int i = 0; i < 32; ++i) {
        const int bit = 6 * i, d = bit >> 5, sh = bit & 31;
        unsigned c = w[d] >> sh;
        if (sh > 26) c |= w[d + 1] << (32 - sh);
        r[i] = fp6_dec1(c & 63u);
    }
    return r;
}
#define FP6_PACK(x, y) sw_pack32(x, y)
#define FP6_UNPACK(pk) __builtin_amdgcn_cvt_scalef32_pk32_f32_fp6(pk, FP6_ONE)

typedef float f32x2_t __attribute__((ext_vector_type(2)));
DEV unsigned fp4_enc1(float f) {
    const float a = fminf(fabsf(f), 6.0f);
    const float sc = a < 2.0f ? 2.0f : (a < 4.0f ? 1.0f : 0.5f), of = a < 2.0f ? 0.0f : (a < 4.0f ? 2.0f : 4.0f);
    const unsigned code = (unsigned)(int)__builtin_rintf(a * sc + of);
    return code | ((__float_as_uint(f) >> 28) & 8u);
}
DEV void fp4_unpack8(unsigned w, float* f) {
    const f32x2_t a = __builtin_amdgcn_cvt_scalef32_pk_f32_fp4(w, FP6_ONE, 0), b = __builtin_amdgcn_cvt_scalef32_pk_f32_fp4(w, FP6_ONE, 1);
    const f32x2_t c = __builtin_amdgcn_cvt_scalef32_pk_f32_fp4(w, FP6_ONE, 2), d = __builtin_amdgcn_cvt_scalef32_pk_f32_fp4(w, FP6_ONE, 3);
    f[0] = a.x; f[1] = a.y; f[2] = b.x; f[3] = b.y; f[4] = c.x; f[5] = c.y; f[6] = d.x; f[7] = d.y;
}
DEV void st_tab4(const P& p, const float* __restrict__ src, unsigned char* __restrict__ dst, float scale, int nrows, int unit, int nunits, char* smem) {
    const int tid_ = tidx(), w = tid_ >> 6, l = tid_ & 63;
    float* stg = (float*)smem + w * (64 * 36);
    int sh[8];
#pragma unroll
    for (int k = 0; k < 8; ++k) sh[k] = 4 * __builtin_amdgcn_readfirstlane(p.PI()[40 + k]);
    for (int r = unit * 4 + w; r < nrows; r += nunits * 4) {
        const float4* sp = (const float4*)(src + (size_t)r * 2048);
        float4 v[8];
#pragma unroll
        for (int i = 0; i < 8; ++i) v[i] = sp[l + 64 * i];
#pragma unroll
        for (int i = 0; i < 8; ++i) { const int f = l + 64 * i; *(float4*)(stg + (f >> 3) * 36 + (f & 7) * 4) = v[i]; }
        __builtin_amdgcn_wave_barrier();
        unsigned wd[4] = {0u, 0u, 0u, 0u};
#pragma unroll
        for (int q = 0; q < 8; ++q) {
            const float4 a = *(const float4*)(stg + l * 36 + q * 4);
            const float xv[4] = {a.x, a.y, a.z, a.w};
#pragma unroll
            for (int e = 0; e < 4; ++e) { const int j = q * 4 + e; wd[j >> 3] |= fp4_enc1(xv[e] * scale) << sh[j & 7]; }
        }
        *(uint4*)(dst + (size_t)r * ROW6 + l * 16) = make_uint4(wd[0], wd[1], wd[2], wd[3]);
        __builtin_amdgcn_wave_barrier();
    }
}
DEV void st_tab6(const float* __restrict__ src, unsigned char* __restrict__ dst, float scale, int nrows, int unit, int nunits, char* smem) {
    const int tid_ = tidx(), w = tid_ >> 6, l = tid_ & 63;
    float* stg = (float*)smem + w * (64 * 36);
    for (int r = unit * 4 + w; r < nrows; r += nunits * 4) {
        const float4* sp = (const float4*)(src + (size_t)r * 2048);
        float4 v[8];
#pragma unroll
        for (int i = 0; i < 8; ++i) v[i] = sp[l + 64 * i];
#pragma unroll
        for (int i = 0; i < 8; ++i) { const int f = l + 64 * i; *(float4*)(stg + (f >> 3) * 36 + (f & 7) * 4) = v[i]; }
        __builtin_amdgcn_wave_barrier();
        v16f x, y;
#pragma unroll
        for (int q = 0; q < 4; ++q) {
            const float4 a = *(const float4*)(stg + l * 36 + q * 4), b = *(const float4*)(stg + l * 36 + 16 + q * 4);
            x[4 * q] = a.x * scale; x[4 * q + 1] = a.y * scale; x[4 * q + 2] = a.z * scale; x[4 * q + 3] = a.w * scale;
            y[4 * q] = b.x * scale; y[4 * q + 1] = b.y * scale; y[4 * q + 2] = b.z * scale; y[4 * q + 3] = b.w * scale;
        }
        const v6u pk = FP6_PACK(x, y);
        unsigned char* dp = dst + (size_t)r * ROW6 + l * 8;
        *(uint2*)(dp) = make_uint2(pk[0], pk[1]); *(uint2*)(dp + 512) = make_uint2(pk[2], pk[3]); *(uint2*)(dp + 1024) = make_uint2(pk[4], pk[5]);
        __builtin_amdgcn_wave_barrier();
    }
}
DEV void st_calib(const P& p) {
    if (tidx() >= 64) return;
    v16f x, y;
#pragma unroll
    for (int k = 0; k < 32; ++k) {
        const int e = k >> 3, m = k & 7;
        const float v = e == 0 ? 0.125f * m : (1.0f + 0.125f * m) * (float)(1 << (e - 1));
        if (k < 16) x[k] = v; else y[k - 16] = v;
    }
    const v6u pk = FP6_PACK(x, y);
    const v32f d = FP6_UNPACK(pk);
    if ((threadIdx.x & 63) == 0) {
        float dmax = 0.f;
#pragma unroll
        for (int j = 0; j < 32; ++j) dmax = fmaxf(dmax, fabsf(d[j]));
        const float cscale = dmax > 0.f ? dmax * (1.0f / 7.5f) : 1.0f;
        const float ic = 1.0f / cscale;
#pragma unroll
        for (int j = 0; j < 32; ++j) {
            int found = j;
#pragma unroll
            for (int k = 0; k < 32; ++k) {
                const int e = k >> 3, m = k & 7;
                const float v = e == 0 ? 0.125f * m : (1.0f + 0.125f * m) * (float)(1 << (e - 1));
                if (fabsf(d[j] * ic - v) < 0.02f + 0.01f * v) found = k;
            }
            p.PI()[j] = found;
        }
        p.PI()[32] = __float_as_int(ic);
    }
#if PEER_FP4
    {
        const unsigned probe = 0x07654321u;
        float f8[8]; fp4_unpack8(probe, f8);
        if ((threadIdx.x & 63) == 0) {
            const float val[8] = {0.f, 0.5f, 1.f, 1.5f, 2.f, 3.f, 4.f, 6.f};
            float dmax = 0.f;
#pragma unroll
            for (int k = 0; k < 8; ++k) dmax = fmaxf(dmax, fabsf(f8[k]));
            const float ic4 = dmax > 0.f ? 6.0f / dmax : 1.0f;
#pragma unroll
            for (int k = 0; k < 8; ++k) {
                int nib = k;
#pragma unroll
                for (int c = 0; c < 8; ++c) if (fabsf(f8[k] * ic4 - val[c]) < 0.1f) nib = (c + 7) & 7;
                p.PI()[40 + k] = nib;
            }
#pragma unroll
            for (int j = 0; j < 32; ++j) p.PI()[j] = j;
            p.PI()[32] = __float_as_int(ic4);
        }
    }
#endif
}

DEV void st_ada(const P& p, int unit, char* smem) {
    float4* red = (float4*)smem;
    const int tid = tidx(), c4 = tid & 15, kg = tid >> 4;
    const int i = unit / 192, j = (unit % 192) * 64 + c4 * 4;
    const float* W = p.ada_w + (size_t)i * 2048 * 12288 + (size_t)kg * 12288 + j;
    float4 acc = make_float4(0.f, 0.f, 0.f, 0.f);
#pragma unroll 1
    for (int k0 = 0; k0 < 128; k0 += 16) {
        float4 wv[16]; float a[16];
#pragma unroll
        for (int q = 0; q < 16; ++q) { const f32x4 t4 = __builtin_nontemporal_load((const f32x4*)(W + (size_t)(16 * (k0 + q)) * 12288)); wv[q] = make_float4(t4[0], t4[1], t4[2], t4[3]); }
#pragma unroll
        for (int q = 0; q < 16; ++q) { const float cv = p.c[kg + 16 * (k0 + q)]; a[q] = cv * sigmoidf_(cv); }
#pragma unroll
        for (int q = 0; q < 16; ++q) { acc.x += a[q] * wv[q].x; acc.y += a[q] * wv[q].y; acc.z += a[q] * wv[q].z; acc.w += a[q] * wv[q].w; }
    }
    red[kg * 16 + c4] = acc;
    __syncthreads();
    if (tid < 64) {
        const int cc = tid >> 2, e = tid & 3;
        float r = p.ada_b[i * 12288 + (unit % 192) * 64 + tid];
#pragma unroll
        for (int q = 0; q < 16; ++q) r += ((const float*)&red[q * 16 + cc])[e];
        p.ada()[i * 12288 + (unit % 192) * 64 + tid] = r;
    }
    __syncthreads();
}
DEV void st_rope(const P& p, int unit) {
    const int e = unit * 256 + tidx(); const int t = e / 24, i = e % 24;
    const double inv = i < 16 ? INV16[i] : INV16[2 * (i - 16)];
    const double ang = (double)p.pos[t] * inv;
    const double n = rint(ang * 0.15915494309189535);
    const double r = ang - n * 6.283185307179586;
    const double r2 = r * r;
    double sp = 1.0 / 1.5511210043330986e25, cp = -1.0 / 4.0329146112660565e26;
    sp = sp * r2 - 1.0 / 2.585201673888498e22;   cp = cp * r2 + 1.0 / 6.204484017332394e23;
    sp = sp * r2 + 1.0 / 5.109094217170944e19;   cp = cp * r2 - 1.0 / 1.1240007277776077e21;
    sp = sp * r2 - 1.0 / 1.21645100408832e17;    cp = cp * r2 + 1.0 / 2.43290200817664e18;
    sp = sp * r2 + 1.0 / 3.55687428096e14;       cp = cp * r2 - 1.0 / 6.402373705728e15;
    sp = sp * r2 - 1.0 / 1.307674368e12;         cp = cp * r2 + 1.0 / 2.0922789888e13;
    sp = sp * r2 + 1.0 / 6.2270208e9;            cp = cp * r2 - 1.0 / 8.71782912e10;
    sp = sp * r2 - 1.0 / 3.99168e7;              cp = cp * r2 + 1.0 / 4.790016e8;
    sp = sp * r2 + 1.0 / 362880.0;               cp = cp * r2 - 1.0 / 3628800.0;
    sp = sp * r2 - 1.0 / 5040.0;                 cp = cp * r2 + 1.0 / 40320.0;
    sp = sp * r2 + 1.0 / 120.0;                  cp = cp * r2 - 1.0 / 720.0;
    sp = sp * r2 - 1.0 / 6.0;                    cp = cp * r2 + 1.0 / 24.0;
    sp = sp * r2 + 1.0;                          cp = cp * r2 - 0.5;
    cp = cp * r2 + 1.0;
    const float cs = (float)cp, sn = (float)(sp * r);
    p.ropeC()[e] = cs; p.ropeS()[e] = sn;
}

DEV void st_norm(const float* __restrict__ X, const float* __restrict__ g, const float* __restrict__ sc, const float* __restrict__ sh,
                 bf16_t* __restrict__ HN, int unit) {
    const int tid_ = tidx(); const int w = tid_ >> 6, l = tid_ & 63; const int t = unit * 4 + w;
    const float4* xr = (const float4*)(X + (size_t)t * D);
    float4 v[8]; float ss = 0.f;
#pragma unroll
    for (int i = 0; i < 4; ++i) { v[2 * i] = xr[i * 128 + l * 2]; v[2 * i + 1] = xr[i * 128 + l * 2 + 1]; }
#pragma unroll
    for (int i = 0; i < 8; ++i) ss += v[i].x * v[i].x + v[i].y * v[i].y + v[i].z * v[i].z + v[i].w * v[i].w;
    ss = wsum(ss);
    const float rs = rsqrtf(ss * (1.0f / 2048.0f) + EPS);
#pragma unroll
    for (int i = 0; i < 4; ++i) {
        const int col = i * 512 + l * 8;
        float y[8]; const float xv[8] = {v[2 * i].x, v[2 * i].y, v[2 * i].z, v[2 * i].w, v[2 * i + 1].x, v[2 * i + 1].y, v[2 * i + 1].z, v[2 * i + 1].w};
#pragma unroll
        for (int j = 0; j < 8; ++j) y[j] = (xv[j] * rs) * g[col + j] * (1.0f + sc[col + j]) + sh[col + j];
        uint4 o; o.x = pk2(y[0], y[1]); o.y = pk2(y[2], y[3]); o.z = pk2(y[4], y[5]); o.w = pk2(y[6], y[7]);
        *(uint4*)(HN + (size_t)t * D + col) = o;
    }
}

enum { EPI_PROJ = 0, EPI_OUT = 1, EPI_Q = 2 };
struct EpiArgs { bf16_t* obf; float* of; const float* xin; const float* gate; };
template <int EPI, int MT = 4>
DEV void st_gemm(const bf16_t* __restrict__ A, const bf16_t* __restrict__ Bt, int K, int tm, int tn, const EpiArgs& e, char* smem) {
    constexpr int BM = 32 * MT, ABYTES = BM * 64, BUFB = ABYTES + 8192, NBUF = (MT == 4) ? 4 : 3, NA = BM / 64;
    static_assert(NBUF * BUFB <= SMEM_BYTES, "GEMM LDS");
    const int tid = tidx(), w = tid >> 6, l = tid & 63, wr = w >> 1, wc = w & 1;
    f32x4 acc[MT][4];
#pragma unroll
    for (int m = 0; m < MT; ++m)
#pragma unroll
        for (int n = 0; n < 4; ++n) acc[m][n] = (f32x4){0.f, 0.f, 0.f, 0.f};
    const int srow = tid >> 2, spc = tid & 3, sc = spc ^ (((srow >> 2) & 1) << 1);
    const bf16_t* Ag = A + (size_t)(tm * BM + srow) * K + sc * 8;
    const bf16_t* Bg = Bt + (size_t)(tn * 128 + srow) * K + sc * 8;
#define GEMM_STAGE(BUF, KO) do { char* _b = smem + (BUF) * BUFB + tid * 16; \
        _Pragma("unroll") for (int _i = 0; _i < NA; ++_i) \
            __builtin_amdgcn_global_load_lds((const unsigned*)(Ag + (size_t)(64 * _i) * K + (KO)), (__attribute__((address_space(3))) unsigned*)(_b + _i * 4096), 16, 0, 0); \
        __builtin_amdgcn_global_load_lds((const unsigned*)(Bg + (KO)), (__attribute__((address_space(3))) unsigned*)(_b + ABYTES), 16, 0, 0); \
        __builtin_amdgcn_global_load_lds((const unsigned*)(Bg + (size_t)64 * K + (KO)), (__attribute__((address_space(3))) unsigned*)(_b + ABYTES + 4096), 16, 0, 0); } while (0)
    const int nk = K / 32;
    GEMM_STAGE(0, 0); GEMM_STAGE(1, 32);
    if (NBUF == 4) { GEMM_STAGE(2, 64); asm volatile("s_waitcnt vmcnt(8)" ::: "memory"); }
    else asm volatile("s_waitcnt vmcnt(6)" ::: "memory");
    __builtin_amdgcn_s_barrier();
    const int fr = l & 15, fq = l >> 4;
    int cur = 0, nxt = NBUF - 1;
#pragma unroll 1
    for (int kt = 0; kt < nk; ++kt) {
        if (kt + NBUF - 1 < nk) GEMM_STAGE(nxt, (kt + NBUF - 1) * 32);
        const char* As = smem + cur * BUFB; const char* Bs = As + ABYTES;
        bf16x8 bfr[4];
#pragma unroll
        for (int n = 0; n < 4; ++n) { const int row = wc * 64 + n * 16 + fr; bfr[n] = *(const bf16x8*)(Bs + row * 64 + ((fq ^ (((row >> 2) & 1) << 1)) << 4)); }
#pragma unroll
        for (int m = 0; m < MT; ++m) {
            const int row = wr * (BM / 2) + m * 16 + fr;
            const bf16x8 af = *(const bf16x8*)(As + row * 64 + ((fq ^ (((row >> 2) & 1) << 1)) << 4));
#pragma unroll
            for (int n = 0; n < 4; ++n) acc[m][n] = mfma16(bfr[n], af, acc[m][n]);
        }
        if (NBUF == 4) {
            if (kt + 3 < nk) asm volatile("s_waitcnt vmcnt(8)" ::: "memory");
            else if (kt + 2 < nk) asm volatile("s_waitcnt vmcnt(4)" ::: "memory");
            else asm volatile("s_waitcnt vmcnt(0)" ::: "memory");
        } else {
            if (kt + 2 < nk) asm volatile("s_waitcnt vmcnt(6)" ::: "memory");
            else asm volatile("s_waitcnt vmcnt(0)" ::: "memory");
        }
        asm volatile("s_waitcnt lgkmcnt(0)" ::: "memory");
        __builtin_amdgcn_s_barrier();
        cur = (cur + 1 == NBUF) ? 0 : cur + 1; nxt = (nxt + 1 == NBUF) ? 0 : nxt + 1;
    }
#undef GEMM_STAGE
#pragma unroll
    for (int m = 0; m < MT; ++m) {
        const int row = tm * BM + wr * (BM / 2) + m * 16 + (l & 15);
#pragma unroll
        for (int n = 0; n < 4; ++n) {
            const int col = tn * 128 + wc * 64 + n * 16 + 4 * (l >> 4);
            const f32x4 a = acc[m][n];
            if (EPI == EPI_PROJ) {
                uint2 o; o.x = pk2(a[0], a[1]); o.y = pk2(a[2], a[3]);
                *(uint2*)(e.obf + (size_t)row * LDP + col) = o;
            } else if (EPI == EPI_OUT) {
                const float4 xi = *(const float4*)(e.xin + (size_t)row * D + col);
                const float4 gg = *(const float4*)(e.gate + col);
                float4 o; o.x = xi.x + gg.x * a[0]; o.y = xi.y + gg.y * a[1]; o.z = xi.z + gg.z * a[2]; o.w = xi.w + gg.w * a[3];
                *(float4*)(e.of + (size_t)row * D + col) = o;
            } else {
                float4 o; o.x = a[0]; o.y = a[1]; o.z = a[2]; o.w = a[3];
                *(float4*)(e.of + (size_t)row * 1024 + col) = o;
            }
        }
    }
    __syncthreads();
}

DEV void st_conv(const P& p, int layer, int unit, char* smem) {
    float* cs = (float*)smem;
    const int tid = tidx(), t0 = unit * 16;
    const float* cw = p.conv_w + (size_t)layer * 31 * 512;
#pragma unroll 1
    for (int cc = 0; cc < 2; ++cc) {
        const int c = tid + 256 * cc;
        float w[31], z[46];
#pragma unroll
        for (int k = 0; k < 31; ++k) w[k] = cw[k * 512 + c];
#pragma unroll
        for (int r = 0; r < 46; ++r) {
            const int t = t0 - 30 + r, tc = t < 0 ? 0 : t;
            const float a = bf2f(p.PROJ()[(size_t)tc * LDP + C_CA + c]), g = bf2f(p.PROJ()[(size_t)tc * LDP + C_CG + c]);
            z[r] = t >= 0 ? a * sigmoidf_(g) : 0.f;
        }
        const float cb = p.conv_b[layer * 512 + c];
#pragma unroll
        for (int tt = 0; tt < 16; ++tt) {
            float acc = cb;
#pragma unroll
            for (int k = 0; k < 31; ++k) acc += w[k] * z[tt + k];
            cs[tt * 512 + c] = acc;
        }
    }
    __syncthreads();
    const int w = tid >> 6, l = tid & 63;
    const float* lg = p.cln_g + layer * 512; const float* lb = p.cln_b + layer * 512;
#pragma unroll 1
    for (int q = 0; q < 4; ++q) {
        const int tt = w * 4 + q;
        float v[8]; float s = 0.f;
#pragma unroll
        for (int i = 0; i < 8; ++i) { v[i] = cs[tt * 512 + l + 64 * i]; s += v[i]; }
        const float mean = wsum(s) * (1.0f / 512.0f);
        float q2 = 0.f;
#pragma unroll
        for (int i = 0; i < 8; ++i) { const float d = v[i] - mean; q2 += d * d; }
        const float rstd = rsqrtf(wsum(q2) * (1.0f / 512.0f) + EPS);
#pragma unroll
        for (int i = 0; i < 8; ++i) {
            const int c = l + 64 * i;
            const float y = (v[i] - mean) * rstd * lg[c] + lb[c];
            p.Y()[(size_t)(t0 + tt) * D + c] = f2bf(y * sigmoidf_(y));
        }
    }
    __syncthreads();
}

DEV void st_sgu(const P& p, int layer, int unit, char* smem) {
    constexpr int RSB = 136;
    const int n = unit >> 2, h = unit & 3, tid = tidx(), w = tid >> 6, l = tid & 63;
    float* stat = (float*)smem;
    bf16_t* wtb = (bf16_t*)(smem + 1024);
    bf16_t* vtb = wtb + 128 * RSB;
    const int tb = n * 128;
#pragma unroll 4
    for (int q = 0; q < 32; ++q) {
        const int j = w * 32 + q;
        const uint4 raw = *(const uint4*)(p.PROJ() + (size_t)(tb + j) * LDP + C_SV + l * 8);
        float v[8] = {lo2f(raw.x), hi2f(raw.x), lo2f(raw.y), hi2f(raw.y), lo2f(raw.z), hi2f(raw.z), lo2f(raw.w), hi2f(raw.w)};
        float s = 0.f;
#pragma unroll
        for (int i = 0; i < 8; ++i) s += v[i];
        const float mean = wsum(s) * (1.0f / 512.0f);
        float q2 = 0.f;
#pragma unroll
        for (int i = 0; i < 8; ++i) { const float d = v[i] - mean; q2 += d * d; }
        const float rstd = rsqrtf(wsum(q2) * (1.0f / 512.0f) + EPS);
        if (l == 0) { stat[j * 2] = mean; stat[j * 2 + 1] = rstd; }
    }
    const float* Wh = p.sgu_w + ((size_t)layer * 4 + h) * 128 * 128;
    {
        float4 wv[16];
#pragma unroll
        for (int q = 0; q < 16; ++q) wv[q] = *(const float4*)(Wh + (size_t)(tid + 256 * q) * 4);
#pragma unroll
        for (int q = 0; q < 16; ++q) {
            const int f = tid + 256 * q, i = f >> 5, j4 = (f & 31) * 4;
            const float x4[4] = {wv[q].x, wv[q].y, wv[q].z, wv[q].w};
#pragma unroll
            for (int e = 0; e < 4; ++e) wtb[(j4 + e) * RSB + i] = (i >= j4 + e) ? f2bf(x4[e]) : (bf16_t)0;
        }
    }
    __syncthreads();
    {
        const float* lg = p.sln_g + layer * 512 + h * 128; const float* lb = p.sln_b + layer * 512 + h * 128;
        uint4 vr[8];
#pragma unroll
        for (int q = 0; q < 8; ++q) { const int f = tid + 256 * q, j = f >> 4, d8 = (f & 15) * 8; vr[q] = *(const uint4*)(p.PROJ() + (size_t)(tb + j) * LDP + C_SV + h * 128 + d8); }
#pragma unroll
        for (int q = 0; q < 8; ++q) {
            const int f = tid + 256 * q, j = f >> 4, d8 = (f & 15) * 8;
            const float mean = stat[j * 2], rstd = stat[j * 2 + 1];
            const float4 g0 = *(const float4*)(lg + d8), g1 = *(const float4*)(lg + d8 + 4), b0 = *(const float4*)(lb + d8), b1 = *(const float4*)(lb + d8 + 4);
            uint4 o;
            o.x = pk2((lo2f(vr[q].x) - mean) * rstd * g0.x + b0.x, (hi2f(vr[q].x) - mean) * rstd * g0.y + b0.y);
            o.y = pk2((lo2f(vr[q].y) - mean) * rstd * g0.z + b0.z, (hi2f(vr[q].y) - mean) * rstd * g0.w + b0.w);
            o.z = pk2((lo2f(vr[q].z) - mean) * rstd * g1.x + b1.x, (hi2f(vr[q].z) - mean) * rstd * g1.y + b1.y);
            o.w = pk2((lo2f(vr[q].w) - mean) * rstd * g1.z + b1.z, (hi2f(vr[q].w) - mean) * rstd * g1.w + b1.w);
            *(uint4*)(vtb + j * RSB + d8) = o;
        }
    }
    __syncthreads();
    const int ti = tid >> 4, td = tid & 15;
    float acc[8][8];
#pragma unroll
    for (int a = 0; a < 8; ++a)
#pragma unroll
        for (int bq = 0; bq < 8; ++bq) acc[a][bq] = 0.f;
    const int jend = w * 32 + 32;
#pragma unroll 2
    for (int j = 0; j < jend; ++j) {
        const uint4 wr = *(const uint4*)(wtb + j * RSB + ti * 8), vr = *(const uint4*)(vtb + j * RSB + td * 8);
        const float wv[8] = {lo2f(wr.x), hi2f(wr.x), lo2f(wr.y), hi2f(wr.y), lo2f(wr.z), hi2f(wr.z), lo2f(wr.w), hi2f(wr.w)};
        const float vv[8] = {lo2f(vr.x), hi2f(vr.x), lo2f(vr.y), hi2f(vr.y), lo2f(vr.z), hi2f(vr.z), lo2f(vr.w), hi2f(vr.w)};
#pragma unroll
        for (int a = 0; a < 8; ++a)
#pragma unroll
            for (int bq = 0; bq < 8; ++bq) acc[a][bq] += wv[a] * vv[bq];
    }
#pragma unroll
    for (int a = 0; a < 8; ++a) {
        const int i = ti * 8 + a; const size_t t = tb + i;
        const float bs = p.sgu_b[((size_t)layer * 4 + h) * 128 + i];
        const uint4 ur = *(const uint4*)(p.PROJ() + t * LDP + C_SU + h * 128 + td * 8);
        const float u[8] = {lo2f(ur.x), hi2f(ur.x), lo2f(ur.y), hi2f(ur.y), lo2f(ur.z), hi2f(ur.z), lo2f(ur.w), hi2f(ur.w)};
        float y[8];
#pragma unroll
        for (int bq = 0; bq < 8; ++bq) y[bq] = u[bq] * (acc[a][bq] + bs);
        uint4 o; o.x = pk2(y[0], y[1]); o.y = pk2(y[2], y[3]); o.z = pk2(y[4], y[5]); o.w = pk2(y[6], y[7]);
        *(uint4*)(p.Y() + t * D + 512 + h * 128 + td * 8) = o;
    }
    __syncthreads();
}

DEV void st_vtrans(const P& p, int unit, char* smem) {
    bf16_t* tile = (bf16_t*)smem;
    const int which = unit & 1, tt0 = (unit >> 1) * 64, tid = tidx();
    const int col0 = which ? C_NVW : C_NVS;
    bf16_t* dst = which ? p.VWT() : p.VST();
#pragma unroll
    for (int q = 0; q < 4; ++q) {
        const int e = tid + 256 * q; const int r = e >> 4, c8 = e & 15;
        const uint4 raw = *(const uint4*)(p.PROJ() + (size_t)(tt0 + r) * LDP + col0 + c8 * 8);
        unsigned* d32 = (unsigned*)(tile + r * 130 + c8 * 8);
        d32[0] = raw.x; d32[1] = raw.y; d32[2] = raw.z; d32[3] = raw.w;
    }
    __syncthreads();
    const int d = tid >> 1, half = tid & 1;
    unsigned o[16];
#pragma unroll
    for (int i = 0; i < 16; ++i) {
        const unsigned a = tile[(half * 32 + 2 * i) * 130 + d], b = tile[(half * 32 + 2 * i + 1) * 130 + d];
        o[i] = a | (b << 16);
    }
    uint4* dp = (uint4*)(dst + (size_t)d * T + tt0 + half * 32);
#pragma unroll
    for (int i = 0; i < 4; ++i) dp[i] = make_uint4(o[4 * i], o[4 * i + 1], o[4 * i + 2], o[4 * i + 3]);
    __syncthreads();
}

DEV void st_prep(const P& p, int layer, int unit) {
    const int tid_ = tidx(); const int w = tid_ >> 6, l = tid_ & 63; const size_t t = (size_t)unit * 4 + w;
    const bf16_t* row = p.PROJ() + t * LDP;
    const float* rc = p.ropeC() + t * 24; const float* rs_ = p.ropeS() + t * 24;
    unsigned raw[11];
#pragma unroll
    for (int h = 0; h < 4; ++h) { raw[h] = *(const unsigned*)(row + C_NQ + h * 128 + 2 * l); raw[6 + h] = *(const unsigned*)(row + C_DQ + h * 128 + 2 * l); }
    raw[4] = *(const unsigned*)(row + C_NKS + 2 * l); raw[5] = *(const unsigned*)(row + C_NKW + 2 * l); raw[10] = *(const unsigned*)(row + C_DK + 2 * l);
    bf16_t iraw[9];
#pragma unroll
    for (int h = 0; h < 9; ++h) iraw[h] = row[(h < 8 ? C_IQ + h * 64 : C_IK) + l];
    const float gq0 = p.nsa_qg[layer * 128 + 2 * l], gq1 = p.nsa_qg[layer * 128 + 2 * l + 1];
    const float gs0 = p.nsa_kg[(layer * 3 + 1) * 128 + 2 * l], gs1 = p.nsa_kg[(layer * 3 + 1) * 128 + 2 * l + 1];
    const float gw0 = p.nsa_kg[(layer * 3 + 2) * 128 + 2 * l], gw1 = p.nsa_kg[(layer * 3 + 2) * 128 + 2 * l + 1];
    const float dq0 = p.dsa_qg[layer * 128 + 2 * l], dq1 = p.dsa_qg[layer * 128 + 2 * l + 1];
    const float dk0 = p.dsa_kg[layer * 128 + 2 * l], dk1 = p.dsa_kg[layer * 128 + 2 * l + 1];
    const float c0 = rc[(2 * l) & 15], c1 = rc[(2 * l + 1) & 15], s0 = rs_[(2 * l) & 15], s1 = rs_[(2 * l + 1) & 15];
    const float ic = rc[16 + (l & 7)], is = rs_[16 + (l & 7)];
    float x0[11], x1[11], ss[11];
#pragma unroll
    for (int h = 0; h < 11; ++h) { x0[h] = lo2f(raw[h]); x1[h] = hi2f(raw[h]); ss[h] = x0[h] * x0[h] + x1[h] * x1[h]; }
#pragma unroll
    for (int h = 0; h < 11; ++h) ss[h] = wsum(ss[h]);
#pragma unroll
    for (int h = 0; h < 11; ++h) {
        const float r = rsqrtf(ss[h] * (1.0f / 128.0f) + EPS);
        const float g0 = h < 4 ? gq0 : (h == 4 ? gs0 : (h == 5 ? gw0 : (h < 10 ? dq0 : dk0)));
        const float g1 = h < 4 ? gq1 : (h == 4 ? gs1 : (h == 5 ? gw1 : (h < 10 ? dq1 : dk1)));
        const float n0 = x0[h] * r * g0, n1 = x1[h] * r * g1;
        const float o0 = __shfl_xor(n0, 8), o1 = __shfl_xor(n1, 8);
        float r0 = n0, r1 = n1;
        if (l < 8) { r0 = n0 * c0 - o0 * s0; r1 = n1 * c1 - o1 * s1; }
        else if (l < 16) { r0 = n0 * c0 + o0 * s0; r1 = n1 * c1 + o1 * s1; }
        const unsigned roped = pk2(r0, r1);
        if (h < 4) { *(unsigned*)(p.QN() + (t * 4 + h) * 128 + 2 * l) = pk2(n0, n1); *(unsigned*)(p.QR() + (t * 4 + h) * 128 + 2 * l) = roped; }
        else if (h == 4) *(unsigned*)(p.KS() + t * 128 + 2 * l) = roped;
        else if (h == 5) *(unsigned*)(p.KW() + t * 128 + 2 * l) = roped;
        else if (h < 10) *(unsigned*)(p.DQ() + (t * 4 + (h - 6)) * 128 + 2 * l) = roped;
        else *(unsigned*)(p.DK() + t * 128 + 2 * l) = roped;
    }
    if (l < 12) p.GATES()[t * 12 + l] = sigmoidf_(bf2f(row[C_NG + l]));
    *(unsigned*)(p.DVC() + t * 128 + 2 * l) = *(const unsigned*)(row + C_DV + 2 * l);
#pragma unroll
    for (int h = 0; h < 9; ++h) {
        const float x = bf2f(iraw[h]);
        const float other = __shfl_xor(x, 8);
        float o = x;
        if (l < 16) o = (l < 8) ? (x * ic - other * is) : (x * ic + other * is);
        if (h < 8) p.IQ()[(t * 8 + h) * 64 + l] = f2bf(o); else p.IK()[t * 64 + l] = f2bf(o);
    }
    if (l < 8) p.IW()[t * 8 + l] = bf2f(row[C_IW + l]) * (0.35355339059327373f * 0.125f);
}

DEV void st_compress(const P& p, int layer, int unit, char* smem) {
    const int which = unit & 1, rt = unit >> 1, tid = tidx(), w = tid >> 6, l = tid & 63, fr = l & 15, fq = l >> 4;
    float* hid = (float*)smem;
    float* ob = hid + 16 * 128;
    const int nb = rt * 16 + fr;
    const int col0 = which ? C_NVC : C_NKC;
    const float* ps = p.cmp_pos + ((size_t)layer * 2 + which) * 4096;
    const bf16_t* w1t = p.W1T() + ((size_t)layer * 2 + which) * 128 * 4096;
    const bool rowok = nb < 511;
    const bf16_t* xrow = p.PROJ() + (size_t)(rowok ? nb * 16 : 0) * LDP + col0;
    f32x4 acc[2] = {(f32x4){0.f, 0.f, 0.f, 0.f}, (f32x4){0.f, 0.f, 0.f, 0.f}};
#pragma unroll 8
    for (int ks = 0; ks < 128; ++ks) {
        const int k = ks * 32 + fq * 8, lt = k >> 7, d = k & 127;
        const uint4 xr = *(const uint4*)(xrow + (size_t)lt * LDP + d);
        const float4 p0 = *(const float4*)(ps + k), p1 = *(const float4*)(ps + k + 4);
        union { bf16x8 v; unsigned u32[4]; } a;
        a.u32[0] = pk2(lo2f(xr.x) + p0.x, hi2f(xr.x) + p0.y); a.u32[1] = pk2(lo2f(xr.y) + p0.z, hi2f(xr.y) + p0.w);
        a.u32[2] = pk2(lo2f(xr.z) + p1.x, hi2f(xr.z) + p1.y); a.u32[3] = pk2(lo2f(xr.w) + p1.z, hi2f(xr.w) + p1.w);
#pragma unroll
        for (int nt = 0; nt < 2; ++nt) {
            const bf16x8 b = *(const bf16x8*)(w1t + (size_t)(w * 32 + nt * 16 + fr) * 4096 + k);
            acc[nt] = mfma16(a.v, b, acc[nt]);
        }
    }
#pragma unroll
    for (int nt = 0; nt < 2; ++nt)
#pragma unroll
        for (int r = 0; r < 4; ++r) hid[(4 * fq + r) * 128 + w * 32 + nt * 16 + fr] = gelu_tanh(acc[nt][r]);
    __syncthreads();
    const float* w2 = p.cmp_w2 + ((size_t)layer * 2 + which) * 128 * 128;
    const int c2 = tid & 127, mh = tid >> 7;
    float o[8];
#pragma unroll
    for (int b = 0; b < 8; ++b) o[b] = 0.f;
#pragma unroll 1
    for (int k0 = 0; k0 < 128; k0 += 32) {
        float wv[32];
#pragma unroll
        for (int k = 0; k < 32; ++k) wv[k] = w2[(k0 + k) * 128 + c2];
#pragma unroll
        for (int k4 = 0; k4 < 8; ++k4)
#pragma unroll
            for (int b = 0; b < 8; ++b) {
                const float4 h4 = *(const float4*)(hid + (mh * 8 + b) * 128 + k0 + k4 * 4);
                o[b] += h4.x * wv[4 * k4] + h4.y * wv[4 * k4 + 1] + h4.z * wv[4 * k4 + 2] + h4.w * wv[4 * k4 + 3];
            }
    }
#pragma unroll
    for (int b = 0; b < 8; ++b) ob[(mh * 8 + b) * 128 + c2] = o[b];
    __syncthreads();
#pragma unroll
    for (int q = 0; q < 4; ++q) {
        const int b = w * 4 + q, nbo = rt * 16 + b;
        float v0 = ob[b * 128 + l], v1 = ob[b * 128 + l + 64];
        if (which == 0) {
            const float r = rsqrtf(wsum(v0 * v0 + v1 * v1) * (1.0f / 128.0f) + EPS);
            const float* kg = p.nsa_kg + (layer * 3 + 0) * 128;
            v0 = v0 * r * kg[l]; v1 = v1 * r * kg[l + 64];
            if (nbo >= 511) { v0 = 0.f; v1 = 0.f; }
            p.KC()[nbo * 128 + l] = f2bf(v0); p.KC()[nbo * 128 + l + 64] = f2bf(v1);
        } else {
            if (nbo >= 511) { v0 = 0.f; v1 = 0.f; }
            p.VCT()[l * 512 + nbo] = f2bf(v0); p.VCT()[(l + 64) * 512 + nbo] = f2bf(v1);
        }
    }
    __syncthreads();
}

DEV void st_nsa_cmp(const P& p, int unit, char* smem) {
    constexpr int RSK = 272, RSV = 136, BUFB = 64 * RSK + 128 * RSV;
    const int tid = tidx(), w = tid >> 6, l = tid & 63, qc = l & 15, g4 = l >> 4;
    const int t0 = unit * 16 + w * 4;
    const int tk = qc >> 2, hd = qc & 3, t = t0 + tk;
    bf16x8 qf[4];
#pragma unroll
    for (int ks = 0; ks < 4; ++ks) qf[ks] = *(const bf16x8*)(p.QN() + ((size_t)t0 * 4 + qc) * 128 + ks * 32 + g4 * 8);
    const int tmaxb = unit * 16 + 15;
    const int nvb = tmaxb >= 31 ? (tmaxb - 31) / 16 + 1 : 0;
    const int nsteps = (nvb + 63) >> 6;
    const int nvis = t >= 31 ? (t - 31) / 16 + 1 : 0;
    const float cs = 0.08838834764831845f * 1.4426950408889634f;
    const int krow = tid >> 4, kc16 = tid & 15, vrow = tid >> 3, vc16 = tid & 7;
    const bf16_t* Kg = p.KC(); const bf16_t* Vg = p.VCT();
    int gstep = 0;
    uint4 rk0, rk1, rk2, rk3, rv0, rv1, rv2, rv3;
#define CMP_LOADK(ST) do { const bf16_t* kb = Kg + (size_t)((ST) * 64 + krow) * 128 + kc16 * 8; \
        rk0 = *(const uint4*)kb; rk1 = *(const uint4*)(kb + 16 * 128); rk2 = *(const uint4*)(kb + 32 * 128); rk3 = *(const uint4*)(kb + 48 * 128); } while (0)
#define CMP_LOADV(ST) do { const bf16_t* vb = Vg + (size_t)vrow * 512 + (ST) * 64 + vc16 * 8; \
        rv0 = *(const uint4*)vb; rv1 = *(const uint4*)(vb + 32 * 512); rv2 = *(const uint4*)(vb + 64 * 512); rv3 = *(const uint4*)(vb + 96 * 512); } while (0)
#define CMP_STOREK(KT) do { *(uint4*)((KT) + krow * RSK + kc16 * 16) = rk0; *(uint4*)((KT) + (krow + 16) * RSK + kc16 * 16) = rk1; \
        *(uint4*)((KT) + (krow + 32) * RSK + kc16 * 16) = rk2; *(uint4*)((KT) + (krow + 48) * RSK + kc16 * 16) = rk3; } while (0)
#define CMP_STOREV(VT) do { *(uint4*)((VT) + vrow * RSV + vc16 * 16) = rv0; *(uint4*)((VT) + (vrow + 32) * RSV + vc16 * 16) = rv1; \
        *(uint4*)((VT) + (vrow + 64) * RSV + vc16 * 16) = rv2; *(uint4*)((VT) + (vrow + 96) * RSV + vc16 * 16) = rv3; } while (0)
    float m = -1e30f, lsum = 0.f;
    if (nsteps > 0) CMP_LOADK(0);
#pragma unroll 1
    for (int st = 0; st < nsteps; ++st, ++gstep) {
        char* Kt = smem + (gstep & 1) * BUFB;
        CMP_STOREK(Kt);
        __syncthreads();
        if (st + 1 < nsteps) CMP_LOADK(st + 1);
        float mx = m; f32x4 sv[4];
#pragma unroll
        for (int sub = 0; sub < 4; ++sub) {
            f32x4 a4 = (f32x4){0.f, 0.f, 0.f, 0.f};
#pragma unroll
            for (int ks = 0; ks < 4; ++ks) a4 = mfma16(*(const bf16x8*)(Kt + (sub * 16 + qc) * RSK + (ks * 32 + g4 * 8) * 2), qf[ks], a4);
#pragma unroll
            for (int r = 0; r < 4; ++r) { const int key = st * 64 + sub * 16 + 4 * g4 + r; a4[r] = (key < nvis) ? a4[r] * cs : -3e38f; mx = fmaxf(mx, a4[r]); }
            sv[sub] = a4;
        }
        float ps = 0.f;
#pragma unroll
        for (int sub = 0; sub < 4; ++sub)
#pragma unroll
            for (int r = 0; r < 4; ++r) ps += __builtin_amdgcn_exp2f(sv[sub][r] - mx);
        lsum = lsum * __builtin_amdgcn_exp2f(m - mx) + ps; m = mx;
    }
    {
        float mt_ = fmaxf(m, __shfl_xor(m, 16)); mt_ = fmaxf(mt_, __shfl_xor(mt_, 32));
        lsum *= __builtin_amdgcn_exp2f(m - mt_); m = mt_;
        lsum += __shfl_xor(lsum, 16); lsum += __shfl_xor(lsum, 32);
    }
    const float inv = (nvis > 0 && lsum > 0.f) ? 1.0f / lsum : 0.f;
    f32x4 o[8];
#pragma unroll
    for (int mt = 0; mt < 8; ++mt) o[mt] = (f32x4){0.f, 0.f, 0.f, 0.f};
    float yprev = 0.f;
    float impv[32];
#pragma unroll
    for (int i = 0; i < 32; ++i) impv[i] = 0.f;
    if (nsteps > 0) { CMP_LOADK(0); CMP_LOADV(0); }
#pragma unroll
    for (int st = 0; st < 8; ++st) {
        if (st < nsteps) {
            char* Kt = smem + (gstep & 1) * BUFB; char* Vt = Kt + 64 * RSK; ++gstep;
            CMP_STOREK(Kt); CMP_STOREV(Vt);
            __syncthreads();
            if (st + 1 < nsteps) { CMP_LOADK(st + 1); CMP_LOADV(st + 1); }
            f32x4 sv[4];
#pragma unroll
            for (int sub = 0; sub < 4; ++sub) {
                f32x4 a4 = (f32x4){0.f, 0.f, 0.f, 0.f};
#pragma unroll
                for (int ks = 0; ks < 4; ++ks) a4 = mfma16(*(const bf16x8*)(Kt + (sub * 16 + qc) * RSK + (ks * 32 + g4 * 8) * 2), qf[ks], a4);
#pragma unroll
                for (int r = 0; r < 4; ++r) { const int key = st * 64 + sub * 16 + 4 * g4 + r; a4[r] = (key < nvis) ? __builtin_amdgcn_exp2f(a4[r] * cs - m) * inv : 0.f; }
                const float y = __shfl(a4[3], (l + 48) & 63);
                float iv = (a4[0] + a4[1]) + (a4[2] + a4[3]) + (g4 > 0 ? y : yprev);
                yprev = y;
                iv += __shfl_xor(iv, 1); iv += __shfl_xor(iv, 2);
                impv[st * 4 + sub] = iv;
                sv[sub] = a4;
            }
#pragma unroll
            for (int pr = 0; pr < 2; ++pr) {
                union { bf16x8 v; unsigned u32[4]; } bb;
                bb.u32[0] = pk2(sv[2 * pr][0], sv[2 * pr][1]); bb.u32[1] = pk2(sv[2 * pr][2], sv[2 * pr][3]);
                bb.u32[2] = pk2(sv[2 * pr + 1][0], sv[2 * pr + 1][1]); bb.u32[3] = pk2(sv[2 * pr + 1][2], sv[2 * pr + 1][3]);
#pragma unroll
                for (int mt = 0; mt < 8; ++mt) {
                    const char* vp = Vt + (mt * 16 + qc) * RSV + (pr * 32 + 4 * g4) * 2;
                    union { bf16x8 v; uint2 h2[2]; } aa;
                    aa.h2[0] = *(const uint2*)vp; aa.h2[1] = *(const uint2*)(vp + 32);
                    o[mt] = mfma16(aa.v, bb.v, o[mt]);
                }
            }
        }
    }
#undef CMP_LOADK
#undef CMP_LOADV
#undef CMP_STOREK
#undef CMP_STOREV
    __syncthreads();
    float* impl = (float*)smem + w * 512;
    if (hd == 0) {
#pragma unroll
        for (int i = 0; i < 32; ++i) impl[tk * 128 + 4 * i + g4] = impv[i];
    }
#pragma unroll
    for (int mt = 0; mt < 8; ++mt) {
        uint2 ov; ov.x = pk2(o[mt][0], o[mt][1]); ov.y = pk2(o[mt][2], o[mt][3]);
        *(uint2*)(p.OCMP() + ((size_t)t * 4 + hd) * 128 + mt * 16 + 4 * g4) = ov;
    }
    __syncthreads();
    const int li = hd + 4 * g4, cur = t >> 6;
    unsigned long long own[8]; int rank[8];
#pragma unroll
    for (int i = 0; i < 8; ++i) {
        const int j = li + 16 * i; const float v = impl[tk * 128 + j];
        const unsigned k32 = (j == 0 || j == cur || j == cur - 1) ? 0xFFFFFFFFu : (j > cur ? 0u : __float_as_uint(v) + 128u);
        own[i] = ((unsigned long long)k32 << 7) | (unsigned)(127 - j); rank[i] = 0;
    }
#pragma unroll 1
    for (int ip = 0; ip < 8; ++ip) {
#pragma unroll
        for (int q4 = 0; q4 < 4; ++q4) {
            const float4 ov = *(const float4*)(impl + tk * 128 + ip * 16 + q4 * 4);
            const float o4[4] = {ov.x, ov.y, ov.z, ov.w};
#pragma unroll
            for (int e = 0; e < 4; ++e) {
                const int jp = ip * 16 + q4 * 4 + e;
                const unsigned k32 = (jp == 0 || jp == cur || jp == cur - 1) ? 0xFFFFFFFFu : (jp > cur ? 0u : __float_as_uint(o4[e]) + 128u);
                const unsigned long long kp = ((unsigned long long)k32 << 7) | (unsigned)(127 - jp);
#pragma unroll
                for (int i = 0; i < 8; ++i) rank[i] += (kp > own[i]) ? 1 : 0;
            }
        }
    }
    unsigned mw[4] = {0u, 0u, 0u, 0u};
#pragma unroll
    for (int i = 0; i < 8; ++i) if (rank[i] < 16) mw[i >> 1] |= 1u << (li + 16 * (i & 1));
#pragma unroll
    for (int q = 0; q < 4; ++q) {
        unsigned v = mw[q];
        v |= __shfl_xor(v, 1); v |= __shfl_xor(v, 2); v |= __shfl_xor(v, 16); v |= __shfl_xor(v, 32);
        mw[q] = v;
    }
    if (li == 0) *(uint4*)(p.SEL() + (size_t)t * 4) = make_uint4(mw[0], mw[1], mw[2], mw[3]);
    __syncthreads();
}

DEV void st_nsa_attn(const P& p, int unit, char* smem) {
    constexpr int RSK = 272, RSV = 136, BUFB = 64 * RSK + 128 * RSV;
    const int tid = tidx(), w = tid >> 6, l = tid & 63, qc = l & 15, g4 = l >> 4;
    const int tq0 = unit * 16, t = tq0 + w * 4 + (qc >> 2), hd = qc & 3;
    bf16x8 qf[4];
#pragma unroll
    for (int ks = 0; ks < 4; ++ks) qf[ks] = *(const bf16x8*)(p.QR() + ((size_t)t * 4 + hd) * 128 + ks * 32 + g4 * 8);
    const uint4 selw = *(const uint4*)(p.SEL() + (size_t)t * 4);
    const float cs = 0.08838834764831845f * 1.4426950408889634f;
    unsigned part[8][2];
#pragma unroll
    for (int mt = 0; mt < 8; ++mt) { part[mt][0] = 0u; part[mt][1] = 0u; }
    const float g0 = p.GATES()[(size_t)t * 12 + hd * 3];
    int gstep = 0;
    const int krow = tid >> 4, kc16 = tid & 15, vrow = tid >> 3, vc16 = tid & 7;
#pragma unroll 1
    for (int br = 0; br < 2; ++br) {
        const bf16_t* Kg = br ? p.KW() : p.KS(); const bf16_t* Vg = br ? p.VWT() : p.VST();
        const int ktlast = (tq0 + 15) >> 6;
        const int ktfirst = br ? ((tq0 - 511 > 0 ? tq0 - 511 : 0) >> 6) : 0;
        const int nk = ktlast - ktfirst + 1;
        f32x4 o[8];
#pragma unroll
        for (int mt = 0; mt < 8; ++mt) o[mt] = (f32x4){0.f, 0.f, 0.f, 0.f};
        float m = -1e30f, lsum = 0.f;
        uint4 rk0, rk1, rk2, rk3, rv0, rv1, rv2, rv3;
#define NSA_LOAD(KT) do { const bf16_t* kb = Kg + (size_t)((KT) * 64 + krow) * 128 + kc16 * 8; const bf16_t* vb = Vg + (size_t)vrow * T + (KT) * 64 + vc16 * 8; \
        rk0 = *(const uint4*)kb; rk1 = *(const uint4*)(kb + 16 * 128); rk2 = *(const uint4*)(kb + 32 * 128); rk3 = *(const uint4*)(kb + 48 * 128); \
        rv0 = *(const uint4*)vb; rv1 = *(const uint4*)(vb + (size_t)32 * T); rv2 = *(const uint4*)(vb + (size_t)64 * T); rv3 = *(const uint4*)(vb + (size_t)96 * T); } while (0)
        NSA_LOAD(ktfirst);
#pragma unroll 1
        for (int i = 0; i < nk; ++i, ++gstep) {
            const int kt = ktfirst + i;
            char* Kt = smem + (gstep & 1) * BUFB; char* Vt = Kt + 64 * RSK;
            *(uint4*)(Kt + krow * RSK + kc16 * 16) = rk0; *(uint4*)(Kt + (krow + 16) * RSK + kc16 * 16) = rk1;
            *(uint4*)(Kt + (krow + 32) * RSK + kc16 * 16) = rk2; *(uint4*)(Kt + (krow + 48) * RSK + kc16 * 16) = rk3;
            *(uint4*)(Vt + vrow * RSV + vc16 * 16) = rv0; *(uint4*)(Vt + (vrow + 32) * RSV + vc16 * 16) = rv1;
            *(uint4*)(Vt + (vrow + 64) * RSV + vc16 * 16) = rv2; *(uint4*)(Vt + (vrow + 96) * RSV + vc16 * 16) = rv3;
            __syncthreads();
            if (i + 1 < nk) NSA_LOAD(kt + 1);
            int lo, hi = t;
            if (br == 0) {
                const unsigned wv = (kt & 64) ? ((kt & 32) ? selw.w : selw.z) : ((kt & 32) ? selw.y : selw.x);
                lo = 0; hi = ((wv >> (kt & 31)) & 1u) ? t : -1;
            } else lo = t - 511;
            const bool interior = (kt * 64 + 63 <= tq0) && (br == 0 || kt * 64 >= tq0 + 15 - 511);
            f32x4 sv[4];
            float mx = -3e38f;
            if (interior) {
                const float csl = hi >= 0 ? cs : 0.f, add = hi >= 0 ? 0.f : -3e38f;
#pragma unroll
                for (int sub = 0; sub < 4; ++sub) {
                    f32x4 a4 = (f32x4){0.f, 0.f, 0.f, 0.f};
#pragma unroll
                    for (int ks = 0; ks < 4; ++ks) a4 = mfma16(*(const bf16x8*)(Kt + (sub * 16 + qc) * RSK + (ks * 32 + g4 * 8) * 2), qf[ks], a4);
#pragma unroll
                    for (int r = 0; r < 4; ++r) { a4[r] = a4[r] * csl + add; mx = fmaxf(mx, a4[r]); }
                    sv[sub] = a4;
                }
            } else {
#pragma unroll
                for (int sub = 0; sub < 4; ++sub) {
                    f32x4 a4 = (f32x4){0.f, 0.f, 0.f, 0.f};
#pragma unroll
                    for (int ks = 0; ks < 4; ++ks) a4 = mfma16(*(const bf16x8*)(Kt + (sub * 16 + qc) * RSK + (ks * 32 + g4 * 8) * 2), qf[ks], a4);
#pragma unroll
                    for (int r = 0; r < 4; ++r) {
                        const int kp = kt * 64 + sub * 16 + 4 * g4 + r;
                        const bool valid = (kp >= lo) & (kp <= hi);
                        a4[r] = valid ? a4[r] * cs : -3e38f;
                        mx = fmaxf(mx, a4[r]);
                    }
                    sv[sub] = a4;
                }
            }
            mx = fmaxf(mx, __shfl_xor(mx, 16)); mx = fmaxf(mx, __shfl_xor(mx, 32));
            const float mnew = fmaxf(fmaxf(m, mx), -1e30f);
            const float alpha = __builtin_amdgcn_exp2f(m - mnew);
            m = mnew;
            float ps = 0.f;
#pragma unroll
            for (int sub = 0; sub < 4; ++sub)
#pragma unroll
                for (int r = 0; r < 4; ++r) { const float pv = __builtin_amdgcn_exp2f(sv[sub][r] - mnew); sv[sub][r] = pv; ps += pv; }
            lsum = lsum * alpha + ps;
            if (__any(alpha != 1.0f)) {
#pragma unroll
                for (int mt = 0; mt < 8; ++mt) o[mt] *= alpha;
            }
#pragma unroll
            for (int pr = 0; pr < 2; ++pr) {
                union { bf16x8 v; unsigned u32[4]; } bb;
                bb.u32[0] = pk2(sv[2 * pr][0], sv[2 * pr][1]); bb.u32[1] = pk2(sv[2 * pr][2], sv[2 * pr][3]);
                bb.u32[2] = pk2(sv[2 * pr + 1][0], sv[2 * pr + 1][1]); bb.u32[3] = pk2(sv[2 * pr + 1][2], sv[2 * pr + 1][3]);
#pragma unroll
                for (int mt = 0; mt < 8; ++mt) {
                    const char* vp = Vt + (mt * 16 + qc) * RSV + (pr * 32 + 4 * g4) * 2;
                    union { bf16x8 v; uint2 h2[2]; } aa;
                    aa.h2[0] = *(const uint2*)vp; aa.h2[1] = *(const uint2*)(vp + 32);
                    o[mt] = mfma16(aa.v, bb.v, o[mt]);
                }
            }
        }
#undef NSA_LOAD
        lsum += __shfl_xor(lsum, 16); lsum += __shfl_xor(lsum, 32);
        const float gate = p.GATES()[(size_t)t * 12 + hd * 3 + 1 + br];
        const float sc = lsum > 0.f ? gate / lsum : 0.f;
        if (br == 0) {
#pragma unroll
            for (int mt = 0; mt < 8; ++mt) {
                const uint2 oc = *(const uint2*)(p.OCMP() + ((size_t)t * 4 + hd) * 128 + mt * 16 + 4 * g4);
                part[mt][0] = pk2(sc * o[mt][0] + g0 * lo2f(oc.x), sc * o[mt][1] + g0 * hi2f(oc.x));
                part[mt][1] = pk2(sc * o[mt][2] + g0 * lo2f(oc.y), sc * o[mt][3] + g0 * hi2f(oc.y));
            }
        } else {
#pragma unroll
            for (int mt = 0; mt < 8; ++mt) {
                uint2 ov;
                ov.x = pk2(sc * o[mt][0] + lo2f(part[mt][0]), sc * o[mt][1] + hi2f(part[mt][0]));
                ov.y = pk2(sc * o[mt][2] + lo2f(part[mt][1]), sc * o[mt][3] + hi2f(part[mt][1]));
                *(uint2*)(p.Y() + (size_t)t * D + 1024 + hd * 128 + mt * 16 + 4 * g4) = ov;
            }
        }
    }
    __syncthreads();
}

DEV unsigned f2key(float f) { const unsigned u = __float_as_uint(f); return (u & 0x80000000u) ? ~u : (u | 0x80000000u); }
DEV float key2f(unsigned k) { const unsigned u = (k & 0x80000000u) ? (k & 0x7fffffffu) : ~k; return __uint_as_float(u); }
DEV float wave_prune(float* sc, unsigned short* ix, unsigned* hist, int m, int l) {
    float v[8]; unsigned k[8]; unsigned short id[8]; bool ok[8];
#pragma unroll
    for (int i = 0; i < 8; ++i) {
        const int e = l + 64 * i; ok[i] = e < m;
        v[i] = ok[i] ? sc[e] : 0.f; id[i] = ok[i] ? ix[e] : (unsigned short)0; k[i] = f2key(v[i]);
    }
    unsigned prefix = 0u; int need = 256;
#pragma unroll 1
    for (int pass = 0; pass < 4; ++pass) {
        const int shift = 24 - 8 * pass;
        *(uint4*)(hist + 4 * l) = make_uint4(0u, 0u, 0u, 0u);
        __builtin_amdgcn_wave_barrier();
#pragma unroll
        for (int i = 0; i < 8; ++i) {
            const bool in = ok[i] && (pass == 0 || (k[i] >> (shift + 8)) == prefix);
            if (in) atomicAdd(&hist[(k[i] >> shift) & 255u], 1u);
        }
        __builtin_amdgcn_wave_barrier();
        const uint4 hv = *(const uint4*)(hist + 4 * l);
        const unsigned hq[4] = {hv.x, hv.y, hv.z, hv.w};
        const unsigned own = hv.x + hv.y + hv.z + hv.w;
        unsigned tot = own;
#pragma unroll
        for (int o = 1; o < 64; o <<= 1) { const unsigned tv = __shfl_down(tot, o); if (l + o < 64) tot += tv; }
        unsigned cum = tot - own; int found = -1; int nneed = 0;
#pragma unroll
        for (int kk = 3; kk >= 0; --kk) {
            const unsigned c = hq[kk];
            if (found < 0 && (int)cum < need && (int)(cum + c) >= need) { found = 4 * l + kk; nneed = need - (int)cum; }
            cum += c;
        }
        const unsigned long long bal = __ballot(found >= 0);
        const int src = __ffsll((long long)bal) - 1;
        const int digit = __shfl(found, src); need = __shfl(nneed, src);
        prefix = (prefix << 8) | (unsigned)digit;
    }
    const unsigned thr = prefix;
    int base = 0, ties = 0;
    const unsigned long long ltmask = (1ull << l) - 1ull;
#pragma unroll
    for (int i = 0; i < 8; ++i) {
        const bool gt = ok[i] && k[i] > thr, eq = ok[i] && k[i] == thr;
        const unsigned long long em = __ballot(eq);
        const int trank = ties + __popcll(em & ltmask);
        const bool keep = gt || (eq && trank < need);
        ties += __popcll(em);
        const unsigned long long km = __ballot(keep);
        const int pos = base + __popcll(km & ltmask);
        if (keep) { sc[pos] = v[i]; ix[pos] = id[i]; }
        base += __popcll(km);
    }
    __builtin_amdgcn_wave_barrier();
    return key2f(thr);
}

#define DSA_APPEND2(COND, M64, SV, SCP, IXP, CL, CH) do { \
    const unsigned _ml = (unsigned)(M64), _mh = (unsigned)((M64) >> 32); \
    if (COND) { const int _pos = (h ? (CH) : (CL)) + __popc((h ? _mh : _ml) & ((1u << n) - 1u)); (SCP)[_pos] = (SV); (IXP)[_pos] = (unsigned short)kp; } \
    (CL) += __popc(_ml); (CH) += __popc(_mh); } while (0)
#define DSA_APPEND(SCP, IXP, CNT, M32, MINE, SV) do { \
    const unsigned _m = (M32); \
    if (MINE) { const int _pos = (CNT) + __popc(_m & ((1u << n) - 1u)); (SCP)[_pos] = (SV); (IXP)[_pos] = (unsigned short)kp; } \
    (CNT) += __popc(_m); } while (0)

DEV void st_dsa_index(const P& p, int unit, char* smem) {
    const int tid = tidx(), w = tid >> 6, l = tid & 63, n = l & 31, h = l >> 5;
    char* wb = smem + w * 14336;
    float* sc0 = (float*)wb; float* sc1 = sc0 + 512; float* sc2 = sc1 + 512; float* sc3 = sc2 + 512;
    unsigned short* ix0 = (unsigned short*)(wb + 8192); unsigned short* ix1 = ix0 + 512; unsigned short* ix2 = ix1 + 512; unsigned short* ix3 = ix2 + 512;
    unsigned* hist = (unsigned*)(wb + 12288);
    float* scA = h ? sc2 : sc0; float* scB = h ? sc3 : sc1; unsigned short* ixA = h ? ix2 : ix0; unsigned short* ixB = h ? ix3 : ix1;
    const int wu = unit * 4 + w;
    const int tg = 2047 - wu;
    const int t0 = tg * 4;
    const int tl = 2 * ((n >> 2) & 1) + (n >> 4), hdr = (n & 3) + 4 * ((n >> 3) & 1);
    bf16x8 af[4];
#pragma unroll
    for (int s = 0; s < 4; ++s) af[s] = *(const bf16x8*)(p.IQ() + ((size_t)(t0 + tl) * 8 + hdr) * 64 + 16 * s + 8 * h);
    const int tA = t0 + 2 * h, tB = tA + 1;
    float wA[8], wB[8];
#pragma unroll
    for (int r = 0; r < 8; ++r) { wA[r] = p.IW()[(size_t)tA * 8 + r]; wB[r] = p.IW()[(size_t)tB * 8 + r]; }
    int cnt0 = 0, cnt1 = 0, cnt2 = 0, cnt3 = 0;
    const float NINF = -__builtin_inff();
    float tau0 = NINF, tau1 = NINF, tau2 = NINF, tau3 = NINF;
    const int ntiles = (t0 + 3) / 32 + 1;
    const bf16_t* ikp = p.IK() + (size_t)n * 64 + 8 * h;
    bf16x8 na[4], nb[4];
#pragma unroll
    for (int s = 0; s < 4; ++s) { na[s] = *(const bf16x8*)(ikp + 16 * s); nb[s] = *(const bf16x8*)(ikp + (size_t)(ntiles > 1 ? 32 : 0) * 64 + 16 * s); }
#pragma unroll 1
    for (int kt = 0; kt < ntiles; kt += 2) {
        bf16x8 ca[4], cb[4];
#pragma unroll
        for (int s = 0; s < 4; ++s) { ca[s] = na[s]; cb[s] = nb[s]; }
        {
            const int ka = kt + 2 < ntiles ? kt + 2 : ntiles - 1, kb = kt + 3 < ntiles ? kt + 3 : ntiles - 1;
#pragma unroll
            for (int s = 0; s < 4; ++s) { na[s] = *(const bf16x8*)(ikp + (size_t)ka * 32 * 64 + 16 * s); nb[s] = *(const bf16x8*)(ikp + (size_t)kb * 32 * 64 + 16 * s); }
        }
        f32x16 acca, accb;
#pragma unroll
        for (int r = 0; r < 16; ++r) { acca[r] = 0.f; accb[r] = 0.f; }
#pragma unroll
        for (int s = 0; s < 4; ++s) { acca = mfma32(af[s], ca[s], acca); accb = mfma32(af[s], cb[s], accb); }
        float s0a = 0.f, s1a = 0.f, s0b = 0.f, s1b = 0.f, u0a = 0.f, u1a = 0.f, u0b = 0.f, u1b = 0.f;
#pragma unroll
        for (int r = 0; r < 4; ++r) {
            s0a += wA[r] * fmaxf(acca[r], 0.f); u0a += wA[4 + r] * fmaxf(acca[4 + r], 0.f);
            s1a += wB[r] * fmaxf(acca[8 + r], 0.f); u1a += wB[4 + r] * fmaxf(acca[12 + r], 0.f);
            s0b += wA[r] * fmaxf(accb[r], 0.f); u0b += wA[4 + r] * fmaxf(accb[4 + r], 0.f);
            s1b += wB[r] * fmaxf(accb[8 + r], 0.f); u1b += wB[4 + r] * fmaxf(accb[12 + r], 0.f);
        }
        s0a += u0a; s1a += u1a; s0b += u0b; s1b += u1b;
        const float tauA = h ? tau2 : tau0, tauB = h ? tau3 : tau1;
        {
            const int kp = kt * 32 + n;
            const bool cA = (kp <= tA) && (s0a > tauA), cB = (kp <= tB) && (s1a > tauB);
            const unsigned long long mA = __ballot(cA), mB = __ballot(cB);
            DSA_APPEND2(cA, mA, s0a, scA, ixA, cnt0, cnt2); DSA_APPEND2(cB, mB, s1a, scB, ixB, cnt1, cnt3);
        }
        {
            const int kp = kt * 32 + 32 + n;
            const bool cA = (kp <= tA) && (s0b > tauA), cB = (kp <= tB) && (s1b > tauB);
            const unsigned long long mA = __ballot(cA), mB = __ballot(cB);
            DSA_APPEND2(cA, mA, s0b, scA, ixA, cnt0, cnt2); DSA_APPEND2(cB, mB, s1b, scB, ixB, cnt1, cnt3);
        }
        __builtin_amdgcn_wave_barrier();
        if (max(max(cnt0, cnt1), max(cnt2, cnt3)) > 448) {
            if (cnt0 > 448) { tau0 = wave_prune(sc0, ix0, hist, cnt0, l); cnt0 = 256; }
            if (cnt1 > 448) { tau1 = wave_prune(sc1, ix1, hist, cnt1, l); cnt1 = 256; }
            if (cnt2 > 448) { tau2 = wave_prune(sc2, ix2, hist, cnt2, l); cnt2 = 256; }
            if (cnt3 > 448) { tau3 = wave_prune(sc3, ix3, hist, cnt3, l); cnt3 = 256; }
        }
    }
    if (cnt0 > 256) { wave_prune(sc0, ix0, hist, cnt0, l); cnt0 = 256; }
    if (cnt1 > 256) { wave_prune(sc1, ix1, hist, cnt1, l); cnt1 = 256; }
    if (cnt2 > 256) { wave_prune(sc2, ix2, hist, cnt2, l); cnt2 = 256; }
    if (cnt3 > 256) { wave_prune(sc3, ix3, hist, cnt3, l); cnt3 = 256; }
    __builtin_amdgcn_wave_barrier();
#pragma unroll
    for (int i = 0; i < 4; ++i) {
        const int e = l + 64 * i;
        p.IDX()[(size_t)(t0 + 0) * 256 + e] = e < cnt0 ? (int)ix0[e] : 0;
        p.IDX()[(size_t)(t0 + 1) * 256 + e] = e < cnt1 ? (int)ix1[e] : 0;
        p.IDX()[(size_t)(t0 + 2) * 256 + e] = e < cnt2 ? (int)ix2[e] : 0;
        p.IDX()[(size_t)(t0 + 3) * 256 + e] = e < cnt3 ? (int)ix3[e] : 0;
    }
    if (l == 0) { p.CNT()[t0] = cnt0; p.CNT()[t0 + 1] = cnt1; p.CNT()[t0 + 2] = cnt2; p.CNT()[t0 + 3] = cnt3; }
}

DEV void st_dsa_attn(const P& p, int unit, char* smem) {
    const int tid = tidx(), w = tid >> 6, l = tid & 63, c = l & 15, g4 = l >> 4;
    int* idxs = (int*)(smem + w * 5120); float* Pl = (float*)(smem + w * 5120 + 1024);
    const size_t t = (size_t)unit * 4 + w;
    const int cnt = p.CNT()[t];
#pragma unroll
    for (int i = 0; i < 4; ++i) idxs[l + 64 * i] = p.IDX()[t * 256 + l + 64 * i];
    __builtin_amdgcn_wave_barrier();
    bf16x8 qf[4];
#pragma unroll
    for (int j = 0; j < 4; ++j) qf[j] = *(const bf16x8*)(p.DQ() + (t * 4 + (c & 3)) * 128 + g4 * 32 + j * 8);
    f32x4 s[16];
    const int ntile = (cnt + 15) >> 4;
#pragma unroll
    for (int th = 0; th < 2; ++th) {
        bf16x8 kf[8][4];
        if (th * 8 < ntile) {
#pragma unroll
            for (int q = 0; q < 8; ++q) {
                const int krow = idxs[(th * 8 + q) * 16 + c];
                const bf16_t* kp = p.DK() + (size_t)krow * 128 + g4 * 32;
#pragma unroll
                for (int j = 0; j < 4; ++j) kf[q][j] = *(const bf16x8*)(kp + j * 8);
            }
        }
#pragma unroll
        for (int q = 0; q < 8; ++q) {
            s[th * 8 + q] = (f32x4){0.f, 0.f, 0.f, 0.f};
            if (th * 8 < ntile) {
#pragma unroll
                for (int j = 0; j < 4; ++j) s[th * 8 + q] = mfma16(kf[q][j], qf[j], s[th * 8 + q]);
            }
        }
        __builtin_amdgcn_sched_barrier(0);
    }
    const float cs = 0.08838834764831845f * 1.4426950408889634f;
    float mx = -1e30f;
#pragma unroll
    for (int tt = 0; tt < 16; ++tt)
#pragma unroll
        for (int r = 0; r < 4; ++r) { const int slot = tt * 16 + 4 * g4 + r; if (slot < cnt) mx = fmaxf(mx, s[tt][r] * cs); }
    mx = fmaxf(mx, __shfl_xor(mx, 16)); mx = fmaxf(mx, __shfl_xor(mx, 32));
    float sum = 0.f;
#pragma unroll
    for (int tt = 0; tt < 16; ++tt)
#pragma unroll
        for (int r = 0; r < 4; ++r) { const int slot = tt * 16 + 4 * g4 + r; const float pv = slot < cnt ? exp2f(s[tt][r] * cs - mx) : 0.f; s[tt][r] = pv; sum += pv; }
    sum += __shfl_xor(sum, 16); sum += __shfl_xor(sum, 32);
    const float inv = sum > 0.f ? 1.0f / sum : 0.f;
    if (c < 4) {
#pragma unroll
        for (int tt = 0; tt < 16; ++tt)
#pragma unroll
            for (int r = 0; r < 4; ++r) Pl[(tt * 16 + 4 * g4 + r) * 4 + c] = s[tt][r] * inv;
    }
    __builtin_amdgcn_wave_barrier();
    float acc[4][8];
#pragma unroll
    for (int hh = 0; hh < 4; ++hh)
#pragma unroll
        for (int j = 0; j < 8; ++j) acc[hh][j] = 0.f;
    const int nk64 = (cnt + 63) >> 6;
#pragma unroll 1
    for (int kb = 0; kb < nk64; ++kb) {
        uint4 raw[16];
#pragma unroll
        for (int q = 0; q < 16; ++q) raw[q] = *(const uint4*)(p.DVC() + (size_t)idxs[(kb * 16 + q) * 4 + g4] * 128 + c * 8);
#pragma unroll
        for (int q = 0; q < 16; ++q) {
            const float4 p4 = *(const float4*)(Pl + ((kb * 16 + q) * 4 + g4) * 4);
            const float vv[8] = {lo2f(raw[q].x), hi2f(raw[q].x), lo2f(raw[q].y), hi2f(raw[q].y), lo2f(raw[q].z), hi2f(raw[q].z), lo2f(raw[q].w), hi2f(raw[q].w)};
            const float pp[4] = {p4.x, p4.y, p4.z, p4.w};
#pragma unroll
            for (int hh = 0; hh < 4; ++hh)
#pragma unroll
                for (int j = 0; j < 8; ++j) acc[hh][j] += pp[hh] * vv[j];
        }
    }
#pragma unroll
    for (int hh = 0; hh < 4; ++hh)
#pragma unroll
        for (int j = 0; j < 8; ++j) { float a = acc[hh][j]; a += __shfl_xor(a, 16); a += __shfl_xor(a, 32); acc[hh][j] = a; }
    if (g4 == 0) {
#pragma unroll
        for (int hh = 0; hh < 4; ++hh) {
            uint4 o; o.x = pk2(acc[hh][0], acc[hh][1]); o.y = pk2(acc[hh][2], acc[hh][3]); o.z = pk2(acc[hh][4], acc[hh][5]); o.w = pk2(acc[hh][6], acc[hh][7]);
            *(uint4*)(p.Y() + t * D + 1536 + hh * 128 + c * 8) = o;
        }
    }
    __builtin_amdgcn_wave_barrier();
}

DEV void ins16(unsigned (&top)[16], unsigned x) {
#pragma unroll
    for (int j = 0; j < 16; ++j) { const unsigned hi = max(top[j], x); x = min(top[j], x); top[j] = hi; }
}
DEV void st_peer_topk(const P& p, int layer, int unit, char* smem) {
    const int tid = tidx(), w = tid >> 6, l = tid & 63, n = l & 31, hf = l >> 5;
    const int head = unit & 7, tg = (unit >> 3) * 4 + w;
    const size_t t = (size_t)tg * 32 + n;
    unsigned* il = (unsigned*)smem + w * 1024;
    unsigned top[2][16];
#pragma unroll
    for (int pp = 0; pp < 2; ++pp) {
        float qv[32];
#pragma unroll
        for (int i = 0; i < 8; ++i) { const float4 v = *(const float4*)(p.PQ() + t * 1024 + head * 128 + pp * 64 + hf * 32 + i * 4); qv[4 * i] = v.x; qv[4 * i + 1] = v.y; qv[4 * i + 2] = v.z; qv[4 * i + 3] = v.w; }
        const float* K = p.peer_sk + ((((size_t)layer * 8 + head) * 2 + pp) * 128) * 64;
#pragma unroll
        for (int j = 0; j < 16; ++j) top[pp][j] = 0u;
        float kn[32];
        {
            const float* kr = K + (size_t)n * 64 + hf * 32;
#pragma unroll
            for (int i = 0; i < 8; ++i) { const float4 v = *(const float4*)(kr + i * 4); kn[4 * i] = v.x; kn[4 * i + 1] = v.y; kn[4 * i + 2] = v.z; kn[4 * i + 3] = v.w; }
        }
#pragma unroll 1
        for (int tile = 0; tile < 4; ++tile) {
            float kv[32];
#pragma unroll
            for (int i = 0; i < 32; ++i) kv[i] = kn[i];
            if (tile < 3) {
                const float* kr = K + (size_t)((tile + 1) * 32 + n) * 64 + hf * 32;
#pragma unroll
                for (int i = 0; i < 8; ++i) { const float4 v = *(const float4*)(kr + i * 4); kn[4 * i] = v.x; kn[4 * i + 1] = v.y; kn[4 * i + 2] = v.z; kn[4 * i + 3] = v.w; }
            }
            f32x16 acc;
#pragma unroll
            for (int r = 0; r < 16; ++r) acc[r] = 0.f;
#pragma unroll
            for (int kk = 0; kk < 32; ++kk) acc = __builtin_amdgcn_mfma_f32_32x32x2f32(kv[kk], qv[kk], acc, 0, 0, 0);
#pragma unroll
            for (int r = 0; r < 16; ++r) {
                const int nn = tile * 32 + (r & 3) + 8 * (r >> 2) + 4 * hf;
                ins16(top[pp], (f2key(acc[r]) & ~127u) | (unsigned)(127 - nn));
            }
        }
        unsigned oth[16];
#pragma unroll
        for (int j = 0; j < 16; ++j) oth[j] = __shfl_xor(top[pp][j], 32);
#pragma unroll
        for (int j = 0; j < 16; ++j) ins16(top[pp], oth[j]);
        if (hf == 0) {
#pragma unroll
            for (int j = 0; j < 16; ++j) il[(pp * 16 + j) * 32 + n] = 127u - (top[pp][j] & 127u);
        }
    }
    __builtin_amdgcn_wave_barrier();
    if (hf == 0) {
        float v1[16], v2[16];
#pragma unroll
        for (int j = 0; j < 16; ++j) { v1[j] = key2f(top[0][j] & ~127u); v2[j] = key2f(top[1][j] & ~127u); }
        unsigned ct[16];
#pragma unroll
        for (int s = 0; s < 16; ++s) ct[s] = 0u;
#pragma unroll
        for (int i = 0; i < 16; ++i)
#pragma unroll
            for (int j = 0; j < 16; ++j)
                if ((i + 1) * (j + 1) <= 16) ins16(ct, (f2key(v1[i] + v2[j]) & ~255u) | (unsigned)(255 - (i * 16 + j)));
        float ex[16], sum = 0.f; int ce[16];
        const float c0 = key2f(ct[0] & ~255u);
#pragma unroll
        for (int s = 0; s < 16; ++s) {
            const unsigned code = 255u - (ct[s] & 255u);
            ce[s] = (int)(il[(code >> 4) * 32 + n] * 128u + il[(16 + (code & 15u)) * 32 + n]);
            ex[s] = __expf(key2f(ct[s] & ~255u) - c0); sum += ex[s];
        }
        const float inv = 1.0f / sum;
#pragma unroll
        for (int s4 = 0; s4 < 4; ++s4) {
            *(int4*)(p.PE() + t * 128 + head * 16 + s4 * 4) = make_int4(ce[4 * s4], ce[4 * s4 + 1], ce[4 * s4 + 2], ce[4 * s4 + 3]);
            *(float4*)(p.PG() + t * 128 + head * 16 + s4 * 4) = make_float4(ex[4 * s4] * inv, ex[4 * s4 + 1] * inv, ex[4 * s4 + 2] * inv, ex[4 * s4 + 3] * inv);
        }
    }
    __builtin_amdgcn_wave_barrier();
}

DEV void st_peer_gather(const P& p, int layer, const float* __restrict__ xin, float* __restrict__ xout, int unit, char* smem) {
    const int tid_ = tidx(); const int w = tid_ >> 6, l = tid_ & 63; const size_t t = (size_t)unit * 4 + w;
    float* row = (float*)smem + w * 2112;
    const int* pip = p.PI();
    const float ic6 = __int_as_float(__builtin_amdgcn_readfirstlane(pip[32]));
    {
#pragma unroll
        for (int i = 0; i < 4; ++i) {
            const uint4 hv = *(const uint4*)(p.HN() + t * D + i * 512 + l * 8);
            const unsigned u4[4] = {hv.x, hv.y, hv.z, hv.w};
            const int c = i * 512 + l * 8;
#pragma unroll
            for (int q = 0; q < 4; ++q) { row[((c + 2 * q) >> 5) * 33 + ((c + 2 * q) & 31)] = lo2f(u4[q]); row[((c + 2 * q + 1) >> 5) * 33 + ((c + 2 * q + 1) & 31)] = hi2f(u4[q]); }
        }
        __builtin_amdgcn_wave_barrier();
    }
    unsigned hp[16];
#pragma unroll
    for (int j = 0; j < 16; ++j)
        hp[j] = (__float_as_uint(row[l * 33 + __builtin_amdgcn_readfirstlane(pip[2 * j])]) >> 16) |
                (__float_as_uint(row[l * 33 + __builtin_amdgcn_readfirstlane(pip[2 * j + 1])]) & 0xffff0000u);
    __builtin_amdgcn_wave_barrier();
    const int e0 = p.PE()[t * 128 + l], e1 = p.PE()[t * 128 + 64 + l];
    const float g0 = p.PG()[t * 128 + l], g1 = p.PG()[t * 128 + 64 + l];
    float out[32];
#pragma unroll
    for (int i = 0; i < 32; ++i) out[i] = 0.f;
    const unsigned char* U = p.Utab() + (size_t)layer * 16384 * ROW6; const unsigned char* V = p.Vtab() + (size_t)layer * 16384 * ROW6;
    const unsigned voff = (unsigned)l * 8u;
    const bool b5 = (l & 32) != 0, b4 = (l & 16) != 0;
#pragma unroll 1
    for (int k4 = 0; k4 < 32; ++k4) {
        int e[4]; float g[4];
#pragma unroll
        for (int q = 0; q < 4; ++q) {
            const int k = k4 * 4 + q;
            e[q] = __builtin_amdgcn_readlane(k4 < 16 ? e0 : e1, k & 63);
            g[q] = __int_as_float(__builtin_amdgcn_readlane(__float_as_int(k4 < 16 ? g0 : g1), k & 63));
        }
#if PEER_FP4
        uint4 uu[4], vv[4];
#pragma unroll
        for (int q = 0; q < 4; ++q) { uu[q] = *(const uint4*)(U + (size_t)e[q] * ROW6 + 2 * voff); vv[q] = *(const uint4*)(V + (size_t)e[q] * ROW6 + 2 * voff); }
#define GATHER_UNPACK(F, SRC) do { fp4_unpack8((SRC).x, &(F)[0]); fp4_unpack8((SRC).y, &(F)[8]); fp4_unpack8((SRC).z, &(F)[16]); fp4_unpack8((SRC).w, &(F)[24]); } while (0)
#define GATHER_FIRST(SRC) (SRC).x
#else
        uint2 uu[4][3], vv[4][3];
#pragma unroll
        for (int q = 0; q < 4; ++q)
#pragma unroll
            for (int i = 0; i < 3; ++i) { uu[q][i] = *(const uint2*)(U + (size_t)e[q] * ROW6 + (voff + i * 512)); vv[q][i] = *(const uint2*)(V + (size_t)e[q] * ROW6 + (voff + i * 512)); }
#endif
        float d[4];
#pragma unroll
        for (int q = 0; q < 4; ++q) {
#if PEER_FP4
            if (q > 0) asm volatile("" : "+v"(uu[q].x), "+v"(d[q - 1]));
            float f[32]; GATHER_UNPACK(f, uu[q]);
#else
            v6u pk; pk[0] = uu[q][0].x; pk[1] = uu[q][0].y; pk[2] = uu[q][1].x; pk[3] = uu[q][1].y; pk[4] = uu[q][2].x; pk[5] = uu[q][2].y;
            if (q > 0) { unsigned t0_ = pk[0]; asm volatile("" : "+v"(t0_), "+v"(d[q - 1])); pk[0] = t0_; }
            const v32f f = FP6_UNPACK(pk);
#endif
            float acc = 0.f;
#pragma unroll
            for (int j = 0; j < 16; ++j) acc += f[2 * j] * lo2f(hp[j]) + f[2 * j + 1] * hi2f(hp[j]);
            d[q] = acc;
            __builtin_amdgcn_sched_barrier(0);
        }
        float kA = b5 ? d[2] : d[0], kB = b5 ? d[3] : d[1];
        const float sA = b5 ? d[0] : d[2], sB = b5 ? d[1] : d[3];
        kA += __shfl_xor(sA, 32); kB += __shfl_xor(sB, 32);
        float kk = b4 ? kB : kA; const float ss = b4 ? kA : kB;
        kk += __shfl_xor(ss, 16);
        kk += __shfl_xor(kk, 8); kk += __shfl_xor(kk, 4); kk += __shfl_xor(kk, 2); kk += __shfl_xor(kk, 1);
        const float gsel = b5 ? (b4 ? g[3] : g[2]) : (b4 ? g[1] : g[0]);
        const float av = gelu_tanh(kk * (ic6 / U6_SCALE)) * gsel * (ic6 / V6_SCALE);
        const int avi = __float_as_int(av);
        const float a4[4] = {__int_as_float(__builtin_amdgcn_readlane(avi, 0)), __int_as_float(__builtin_amdgcn_readlane(avi, 16)),
                             __int_as_float(__builtin_amdgcn_readlane(avi, 32)), __int_as_float(__builtin_amdgcn_readlane(avi, 48))};
#pragma unroll
        for (int q = 0; q < 4; ++q) {
#if PEER_FP4
            asm volatile("" : "+v"(vv[q].x), "+v"(out[31]));
            float f[32]; GATHER_UNPACK(f, vv[q]);
#else
            v6u pk; pk[0] = vv[q][0].x; pk[1] = vv[q][0].y; pk[2] = vv[q][1].x; pk[3] = vv[q][1].y; pk[4] = vv[q][2].x; pk[5] = vv[q][2].y;
            { unsigned t0_ = pk[0]; asm volatile("" : "+v"(t0_), "+v"(out[31])); pk[0] = t0_; }
            const v32f f = FP6_UNPACK(pk);
#endif
#pragma unroll
            for (int j = 0; j < 32; ++j) out[j] += a4[q] * f[j];
            __builtin_amdgcn_sched_barrier(0);
        }
    }
    asm volatile("" : "+s"(pip));
#pragma unroll
    for (int j = 0; j < 32; ++j) row[l * 33 + __builtin_amdgcn_readfirstlane(pip[j])] = out[j];
    __builtin_amdgcn_wave_barrier();
    const float* g2 = p.ada() + layer * 12288 + 5 * 2048;
    float4 xo[8]; float ssq = 0.f;
#pragma unroll
    for (int i = 0; i < 8; ++i) {
        const int c = i * 256 + l * 4;
        const float* rp = row + (c >> 5) * 33 + (c & 31);
        const size_t off = t * D + c;
        const float4 x0 = *(const float4*)(xin + off); const float4 ga = *(const float4*)(g2 + c);
        float4 o0;
        o0.x = x0.x + ga.x * rp[0]; o0.y = x0.y + ga.y * rp[1]; o0.z = x0.z + ga.z * rp[2]; o0.w = x0.w + ga.w * rp[3];
        *(float4*)(xout + off) = o0;
        xo[i] = o0; ssq += o0.x * o0.x + o0.y * o0.y + o0.z * o0.z + o0.w * o0.w;
        if (i & 1) __builtin_amdgcn_sched_barrier(0);
    }
    if (layer + 1 < NL) {
        const float rs = rsqrtf(wsum(ssq) * (1.0f / 2048.0f) + EPS);
        const float* ng = p.n1g + (layer + 1) * 2048; const float* adn = p.ada() + (layer + 1) * 12288;
#pragma unroll
        for (int i = 0; i < 8; ++i) {
            const int c = i * 256 + l * 4;
            const float4 gg = *(const float4*)(ng + c), sc = *(const float4*)(adn + 2048 + c), sh = *(const float4*)(adn + c);
            uint2 o;
            o.x = pk2((xo[i].x * rs) * gg.x * (1.0f + sc.x) + sh.x, (xo[i].y * rs) * gg.y * (1.0f + sc.y) + sh.y);
            o.y = pk2((xo[i].z * rs) * gg.z * (1.0f + sc.z) + sh.z, (xo[i].w * rs) * gg.w * (1.0f + sc.w) + sh.w);
            *(uint2*)(p.HN() + t * D + c) = o;
            if (i & 1) __builtin_amdgcn_sched_barrier(0);
        }
    }
    __builtin_amdgcn_wave_barrier();
}

enum { S_CONVT_IN = 0, S_CONVT_OUT, S_CONVT_Q, S_CONVT_W1, S_CALIB, S_TAB_U, S_TAB_V, S_ADA, S_ROPE, S_NORM1, S_GEMM_IN, S_CONV, S_SGU, S_VTRANS, S_PREP,
       S_COMPRESS, S_NSA_CMP, S_DSA_INDEX, S_NSA_ATTN, S_DSA_ATTN, S_GEMM_OUT, S_NORM2, S_GEMM_Q, S_PEER_TOPK, S_PEER_GATHER, S_COUNT };
constexpr int TAB_UNITS = 4096;
__host__ __device__ constexpr int nunits(int s) {
    return s == S_CONVT_IN ? 2 * 32 * (LDP / 64) : s == S_CONVT_OUT ? 2 * 32 * 32 : s == S_CONVT_Q ? 2 * 32 * 16 : s == S_CONVT_W1 ? 4 * 64 * 2 : s == S_CALIB ? 1 : s == S_TAB_U ? TAB_UNITS : s == S_TAB_V ? TAB_UNITS
         : s == S_ADA ? 384 : s == S_ROPE ? 768 : s == S_NORM1 ? 2048 : s == S_GEMM_IN ? 64 * (LDP / 128) : s == S_CONV ? 512 : s == S_SGU ? 256
         : s == S_VTRANS ? 256 : s == S_PREP ? 2048 : s == S_COMPRESS ? 64 : s == S_NSA_CMP ? 512 : s == S_DSA_INDEX ? 512 : s == S_NSA_ATTN ? 512 : s == S_DSA_ATTN ? 2048
         : s == S_GEMM_OUT ? 64 * 16 : s == S_NORM2 ? 2048 : s == S_GEMM_Q ? 64 * 8 : s == S_PEER_TOPK ? 512 : s == S_PEER_GATHER ? 2048 : 0;
}
template <int S>
DEV void run_unit(const P& p, int layer, int u, char* smem, int nu = TAB_UNITS) {
    const float* xin = layer == 0 ? p.x : p.X2();
    const float* ada = p.ada() + layer * 12288;
    if constexpr (S == S_CONVT_IN) { const int per = 32 * (LDP / 64), ly = u / per; st_convT(p.w_in + (size_t)ly * 2048 * INC, p.WinT() + (size_t)ly * LDP * 2048, INC, LDP, true, u % per, smem); }
    else if constexpr (S == S_CONVT_OUT) { const int per = 32 * 32, ly = u / per; st_convT(p.w_out + (size_t)ly * 2048 * 2048, p.WoutT() + (size_t)ly * 2048 * 2048, 2048, 2048, false, u % per, smem); }
    else if constexpr (S == S_CONVT_Q) { const int per = 32 * 16, ly = u / per; st_convT(p.peer_wq + (size_t)ly * 2048 * 1024, p.WqT() + (size_t)ly * 1024 * 2048, 1024, 1024, false, u % per, smem); }
    else if constexpr (S == S_CONVT_W1) { const int per = 64 * 2, mi = u / per; st_convT(p.cmp_w1 + (size_t)mi * 4096 * 128, p.W1T() + (size_t)mi * 128 * 4096, 128, 128, false, u % per, smem, 4096); }
    else if constexpr (S == S_CALIB) st_calib(p);
#if PEER_FP4
    else if constexpr (S == S_TAB_U) st_tab4(p, p.peer_u, p.Utab(), U6_SCALE, 2 * 16384, u, nu, smem);
    else if constexpr (S == S_TAB_V) st_tab4(p, p.peer_v, p.Vtab(), V6_SCALE, 2 * 16384, u, nu, smem);
#else
    else if constexpr (S == S_TAB_U) st_tab6(p.peer_u, p.Utab(), U6_SCALE, 2 * 16384, u, nu, smem);
    else if constexpr (S == S_TAB_V) st_tab6(p.peer_v, p.Vtab(), V6_SCALE, 2 * 16384, u, nu, smem);
#endif
    else if constexpr (S == S_ADA) st_ada(p, u, smem);
    else if constexpr (S == S_ROPE) st_rope(p, u);
    else if constexpr (S == S_NORM1) st_norm(xin, p.n1g + layer * 2048, ada + 2048, ada, p.HN(), u);
    else if constexpr (S == S_GEMM_IN) { EpiArgs e{p.PROJ(), nullptr, nullptr, nullptr}; st_gemm<EPI_PROJ>(p.HN(), p.WinT() + (size_t)layer * LDP * 2048, 2048, u & 63, u >> 6, e, smem); }
    else if constexpr (S == S_CONV) st_conv(p, layer, u, smem);
    else if constexpr (S == S_SGU) st_sgu(p, layer, u, smem);
    else if constexpr (S == S_VTRANS) st_vtrans(p, u, smem);
    else if constexpr (S == S_PREP) st_prep(p, layer, u);
    else if constexpr (S == S_COMPRESS) st_compress(p, layer, u, smem);
    else if constexpr (S == S_NSA_CMP) st_nsa_cmp(p, u, smem);
    else if constexpr (S == S_DSA_INDEX) st_dsa_index(p, u, smem);
    else if constexpr (S == S_NSA_ATTN) st_nsa_attn(p, u, smem);
    else if constexpr (S == S_DSA_ATTN) st_dsa_attn(p, u, smem);
    else if constexpr (S == S_GEMM_OUT) { EpiArgs e{nullptr, p.X1(), xin, ada + 2 * 2048}; st_gemm<EPI_OUT>(p.Y(), p.WoutT() + (size_t)layer * 2048 * 2048, 2048, u & 63, u >> 6, e, smem); }
    else if constexpr (S == S_NORM2) st_norm(p.X1(), p.n2g + layer * 2048, ada + 4 * 2048, ada + 3 * 2048, p.HN(), u);
    else if constexpr (S == S_GEMM_Q) { EpiArgs e{nullptr, p.PQ(), nullptr, nullptr}; st_gemm<EPI_Q>(p.HN(), p.WqT() + (size_t)layer * 1024 * 2048, 2048, u & 63, u >> 6, e, smem); }
    else if constexpr (S == S_PEER_TOPK) st_peer_topk(p, layer, u, smem);
    else if constexpr (S == S_PEER_GATHER) st_peer_gather(p, layer, p.X1(), layer == 0 ? p.X2() : p.out, u, smem);
}


#define XB_TMO      128
#define XB_XCNT(j)  (256  + 64 * (j))
#define XB_XSUB(j)  (1280 + 64 * (j))
#define XB_XGEN(j)  (2304 + 64 * (j))
#define XB_TOP      3328
#define XB_TOPGEN   3392
#define XB_SPIN_CAP (1u << 22)
#define LAS __attribute__((address_space(3)))
DEV unsigned xb_ld(unsigned* p) { return __hip_atomic_load(p, __ATOMIC_RELAXED, __HIP_MEMORY_SCOPE_AGENT); }
DEV unsigned xb_add(unsigned* p, unsigned v) { return __hip_atomic_fetch_add(p, v, __ATOMIC_RELAXED, __HIP_MEMORY_SCOPE_AGENT); }
DEV unsigned xb_xcc_id() { return (unsigned)__builtin_amdgcn_s_getreg((3 << 11) | 20) & 0xFu; }
#define XB_SPIN(cond, bar) do { unsigned _sp = 0; while (cond) { __builtin_amdgcn_s_sleep(1); \
    if ((++_sp & 255u) == 0u) { if (xb_ld(&(bar)[XB_TMO])) break; if (_sp > XB_SPIN_CAP) { atomicAdd(&(bar)[XB_TMO], 1u); break; } } } } while (0)
struct XcdBarrier { unsigned* bar; unsigned x; volatile LAS unsigned* st; };
DEV XcdBarrier xcd_barrier_post(unsigned* bar, volatile LAS unsigned* st) {
    XcdBarrier b; b.bar = bar; b.x = xb_xcc_id(); b.st = st;
    if (threadIdx.x == 0) (void)xb_add(&bar[XB_XCNT(b.x)], 1u);
    return b;
}
DEV void xcd_barrier_complete(unsigned* bar, unsigned x, unsigned& nloc, unsigned& nx) {
    const unsigned G = gridDim.x * gridDim.y * gridDim.z;
    unsigned sum, cnt, mine, sp = 0u;
    for (;;) {
        sum = 0u; cnt = 0u; mine = 0u;
#pragma unroll
        for (unsigned j = 0; j < 16; ++j) { const unsigned c = xb_ld(&bar[XB_XCNT(j)]); sum += c; cnt += (c > 0u) ? 1u : 0u; mine = (j == x) ? c : mine; }
        if (sum == G) break;
        __builtin_amdgcn_s_sleep(1);
        if ((++sp & 255u) == 0u) { if (xb_ld(&bar[XB_TMO])) break; if (sp > XB_SPIN_CAP) { atomicAdd(&bar[XB_TMO], 1u); break; } }
    }
    nloc = mine > 0u ? mine : 1u; nx = cnt > 0u ? cnt : 1u;
}
DEV void xcd_barrier(const XcdBarrier& b) {
    asm volatile("s_waitcnt vmcnt(0)" ::: "memory");
    __syncthreads();
    if (threadIdx.x == 0) {
        unsigned* bar = b.bar;
        __builtin_amdgcn_s_waitcnt(0);
        unsigned nloc = b.st[0], nx = b.st[1];
        if (nloc == 0u) { xcd_barrier_complete(bar, b.x, nloc, nx); b.st[0] = nloc; b.st[1] = nx; }
        const unsigned old = xb_add(&bar[XB_XSUB(b.x)], 1u);
        const unsigned gen = old / nloc;
        if (old + 1u == (gen + 1u) * nloc) {
            __builtin_amdgcn_fence(__ATOMIC_RELEASE, "agent");
            asm volatile("s_waitcnt vmcnt(0)" ::: "memory");
            const unsigned og = xb_add(&bar[XB_TOP], 1u);
            const unsigned tg = og / nx;
            if (og + 1u == (tg + 1u) * nx) xb_add(&bar[XB_TOPGEN], 1u);
            else XB_SPIN(xb_ld(&bar[XB_TOPGEN]) == tg, bar);
            __builtin_amdgcn_fence(__ATOMIC_ACQUIRE, "agent");
            xb_add(&bar[XB_XGEN(b.x)], 1u);
            asm volatile("s_waitcnt vmcnt(0)" ::: "memory");
        } else {
            XB_SPIN(xb_ld(&bar[XB_XGEN(b.x)]) == gen, bar);
            __builtin_amdgcn_fence(__ATOMIC_ACQUIRE, "agent");
            asm volatile("s_waitcnt vmcnt(0)" ::: "memory");
        }
    }
    __syncthreads();
}

#ifndef MULTI_LAUNCH
constexpr int REP_STAGE = -1, REP_STAGE2 = -1, REP_N = 1;
template <int S, int LIM = 0>
DEV void run_phase1(const P& p, int layer, char* smem, int off);
template <int S, int LIM = 0>
DEV void run_phase(const P& p, int layer, char* smem, int off = 0) {
    constexpr int reps = (S == REP_STAGE || S == REP_STAGE2) ? REP_N : 1;
#pragma unroll 1
    for (int r = 0; r < reps; ++r) run_phase1<S, LIM>(p, layer, smem, off);
}
template <int S, int LIM>
DEV void run_phase1(const P& p, int layer, char* smem, int off) {
    const int G = gridDim.x;
    int b = blockIdx.x + off; if (b >= G) b -= G;
    if constexpr (S == S_TAB_U || S == S_TAB_V) { run_unit<S>(p, layer, b, smem, G); }
    else {
        for (int u = b; u < (LIM ? LIM : nunits(S)); u += G) { run_unit<S>(p, layer, u, smem); __syncthreads(); }
    }
}
template <int S>
DEV void run_gemm_phase1(const P& p, int layer, char* smem, unsigned xcc, volatile LAS unsigned* slot, int rep) {
    constexpr int TN = (S == S_GEMM_IN) ? (LDP / 128) : (S == S_GEMM_OUT ? 16 : 8);
    constexpr int NBIG = (S == S_GEMM_IN) ? 32 : (S == S_GEMM_OUT ? 16 : 0);
    constexpr int inst0 = (S == S_GEMM_IN) ? 0 : (S == S_GEMM_OUT ? 2 : 4);
    constexpr int nbig = 4 * NBIG, len = nbig + 8 * (TN - NBIG);
    const float* xin = layer == 0 ? p.x : p.X2();
    const float* ada = p.ada() + layer * 12288;
    const bf16_t* Aop = (S == S_GEMM_OUT) ? p.Y() : p.HN();
    const bf16_t* Bop = (S == S_GEMM_IN) ? p.WinT() + (size_t)layer * LDP * 2048 : (S == S_GEMM_OUT ? p.WoutT() + (size_t)layer * 2048 * 2048 : p.WqT() + (size_t)layer * 1024 * 2048);
    EpiArgs e{p.PROJ(), (S == S_GEMM_OUT) ? p.X1() : p.PQ(), xin, ada + 2 * 2048};
    constexpr int EPI = (S == S_GEMM_IN) ? EPI_PROJ : (S == S_GEMM_OUT ? EPI_OUT : EPI_Q);
#pragma unroll 1
    for (int q = 0; q < 8; ++q) {
        const unsigned xq = (xcc + q) & 7u;
        unsigned* head = p.bar() + GQ_WORD(inst0 + layer + 6 * rep, xq);
        for (;;) {
            if (threadIdx.x == 0) *slot = xb_add(head, 1u);
            __syncthreads();
            const int i = (int)*slot;
            __syncthreads();
            if (i >= len) break;
            if (i < nbig) st_gemm<EPI, 8>(Aop, Bop, 2048, (int)xq * 4 + (i & 3), i >> 2, e, smem);
            else { const int j = i - nbig; st_gemm<EPI, 4>(Aop, Bop, 2048, (int)xq * 8 + (j & 7), NBIG + (j >> 3), e, smem); }
            __syncthreads();
        }
    }
}
template <int S>
DEV void run_items(const P& p, int layer, char* smem, int first, int count) {
    constexpr int reps = (S == REP_STAGE || S == REP_STAGE2) ? REP_N : 1;
#pragma unroll 1
    for (int r = 0; r < reps; ++r)
#pragma unroll 1
        for (int u = first; u < first + count; ++u) { run_unit<S>(p, layer, u, smem); __syncthreads(); }
}
template <int PH>
DEV void run_dyn_phase(const P& p, int layer, char* smem, volatile LAS unsigned* slot) {
    unsigned* head = p.bar() + DQ_WORD(PH * 2 + layer);
    constexpr int total0 = PH == 0 ? (64 + 256 + 256 + 64 + 256) : (PH == 1 ? (512 + 256) : (512 + 512));
    const int total = (PH == 1 && layer == 0) ? total0 + 512 + 296 + 256 + 128 : total0;
    int i = blockIdx.x;
    while (i < total) {
        if constexpr (PH == 0) {
            if (i < 256) run_items<S_SGU>(p, layer, smem, i, 1);
            else if (i < 320) run_items<S_COMPRESS>(p, layer, smem, i - 256, 1);
            else if (i < 576) run_items<S_CONV>(p, layer, smem, (i - 320) * 2, 2);
            else if (i < 640) run_items<S_VTRANS>(p, layer, smem, (i - 576) * 4, 4);
            else run_items<S_PREP>(p, layer, smem, (i - 640) * 8, 8);
        } else if constexpr (PH == 1) {
            if (i < 512) run_items<S_DSA_INDEX>(p, layer, smem, i, 1);
            else if (i < 768) run_items<S_NSA_CMP>(p, layer, smem, (i - 512) * 2, 2);
            else if (i < 1024) { run_unit<S_TAB_U>(p, layer, i - 768, smem, 256); __syncthreads(); }
            else if (i < 1280) { run_unit<S_TAB_V>(p, layer, i - 1024, smem, 256); __syncthreads(); }
            else if (i < 1576) run_items<S_CONVT_IN>(p, layer, smem, 2368 + (i - 1280) * 8, 8);
            else if (i < 1832) run_items<S_CONVT_OUT>(p, layer, smem, (i - 1576) * 8, 8);
            else run_items<S_CONVT_Q>(p, layer, smem, (i - 1832) * 8, 8);
        } else {
            if (i < 512) run_items<S_NSA_ATTN>(p, layer, smem, 511 - i, 1);
            else run_items<S_DSA_ATTN>(p, layer, smem, (i - 512) * 4, 4);
        }
        if (threadIdx.x == 0) *slot = gridDim.x + xb_add(head, 1u);
        __syncthreads();
        i = (int)*slot;
        __syncthreads();
    }
}
template <int S>
DEV void run_gemm_phase(const P& p, int layer, char* smem, unsigned xcc, volatile LAS unsigned* slot) {
    constexpr int reps = (S == REP_STAGE || S == REP_STAGE2) ? REP_N : 1;
#pragma unroll 1
    for (int r = 0; r < reps; ++r) run_gemm_phase1<S>(p, layer, smem, xcc, slot, r);
}
#if defined(__HIP_DEVICE_COMPILE__)
typedef const P __attribute__((address_space(4)))* kargp_t;
DEV const P& fresh_params() { kargp_t q = (kargp_t)__builtin_amdgcn_kernarg_segment_ptr(); asm volatile("" : "+s"(q)); return *(const P*)q; }
#define PP fresh_params()
#else
#define PP p
#endif
#define GSYNC() xcd_barrier(xb)
__global__ void __launch_bounds__(NTHREADS, 2) k_mega(P p) {
    __shared__ __attribute__((aligned(16))) char smem[SMEM_BYTES];
    __shared__ uint4 xb_words;
    cg::grid_group grid = cg::this_grid();
    if (threadIdx.x == 0) xb_words = make_uint4(0u, 0u, 0u, 0u);
    __syncthreads();
    XcdBarrier xb = xcd_barrier_post(p.bar(), (volatile LAS unsigned*)&xb_words);
    const int H = gridDim.x >> 1, Q = gridDim.x >> 2;
    run_phase<S_ADA>(PP, 0, smem); run_phase<S_ROPE>(PP, 0, smem, H);
    run_phase<S_CONVT_IN, 2368>(PP, 0, smem); run_phase<S_CONVT_W1>(PP, 0, smem); run_phase<S_CALIB>(PP, 0, smem, 100);
    grid.sync();
#pragma unroll 1
    for (int layer = 0; layer < NL; ++layer) {
        if (layer == 0) { run_phase<S_NORM1>(PP, layer, smem); GSYNC(); }
        run_gemm_phase<S_GEMM_IN>(PP, layer, smem, xb.x, (volatile LAS unsigned*)&xb_words + 2); GSYNC();
        run_dyn_phase<0>(PP, layer, smem, (volatile LAS unsigned*)&xb_words + 2); GSYNC();
        run_dyn_phase<1>(PP, layer, smem, (volatile LAS unsigned*)&xb_words + 2); GSYNC();
        run_dyn_phase<2>(PP, layer, smem, (volatile LAS unsigned*)&xb_words + 2); GSYNC();
        run_gemm_phase<S_GEMM_OUT>(PP, layer, smem, xb.x, (volatile LAS unsigned*)&xb_words + 2); GSYNC();
        run_phase<S_NORM2>(PP, layer, smem); GSYNC();
        run_gemm_phase<S_GEMM_Q>(PP, layer, smem, xb.x, (volatile LAS unsigned*)&xb_words + 2); GSYNC();
        run_phase<S_PEER_TOPK>(PP, layer, smem); GSYNC();
        run_phase<S_PEER_GATHER>(PP, layer, smem); GSYNC();
    }
}
#else
template <int S>
__global__ void __launch_bounds__(NTHREADS) k_stage(P p, int layer) {
    __shared__ __attribute__((aligned(16))) char smem[SMEM_BYTES];
    run_unit<S>(p, layer, blockIdx.x, smem);
}
template <int S> static void launch_stage(const P& p, int layer, hipStream_t st) {
    hipLaunchKernelGGL((k_stage<S>), dim3(nunits(S)), dim3(NTHREADS), 0, st, p, layer);
}
#endif

extern "C" void kernel_launch(void* const* d_in, const int* in_sizes, int n_in, void* d_out, int out_size, void* d_ws, size_t ws_size, hipStream_t stream) {
    P p{};
    p.x = (const float*)d_in[0]; p.c = (const float*)d_in[1]; p.pos = (const int*)d_in[2]; p.ada_w = (const float*)d_in[3]; p.ada_b = (const float*)d_in[4];
    p.n1g = (const float*)d_in[5]; p.n2g = (const float*)d_in[6]; p.w_in = (const float*)d_in[7]; p.w_out = (const float*)d_in[8]; p.conv_w = (const float*)d_in[9];
    p.conv_b = (const float*)d_in[10]; p.cln_g = (const float*)d_in[11]; p.cln_b = (const float*)d_in[12]; p.sln_g = (const float*)d_in[13]; p.sln_b = (const float*)d_in[14];
    p.sgu_w = (const float*)d_in[15]; p.sgu_b = (const float*)d_in[16]; p.nsa_qg = (const float*)d_in[17]; p.nsa_kg = (const float*)d_in[18]; p.cmp_pos = (const float*)d_in[19];
    p.cmp_w1 = (const float*)d_in[20]; p.cmp_w2 = (const float*)d_in[21]; p.dsa_qg = (const float*)d_in[22]; p.dsa_kg = (const float*)d_in[23]; p.peer_wq = (const float*)d_in[24];
    p.peer_sk = (const float*)d_in[25]; p.peer_u = (const float*)d_in[26]; p.peer_v = (const float*)d_in[27];
    p.out = (float*)d_out;
    p.ws = (char*)d_ws; const size_t off = WS_TOTAL;
    if (off > ws_size) { fprintf(stderr, "workspace too small: need %zu have %zu\n", off, ws_size); return; }
#ifndef MULTI_LAUNCH
    static int grid_blocks = 0;
    if (!grid_blocks) {
        int dev = 0, cus = 0, per_cu = 0;
        (void)hipGetDevice(&dev);
        (void)hipDeviceGetAttribute(&cus, hipDeviceAttributeMultiprocessorCount, dev);
        (void)hipOccupancyMaxActiveBlocksPerMultiprocessor(&per_cu, k_mega, NTHREADS, 0);
        if (per_cu > 2) per_cu = 2;
        grid_blocks = cus * per_cu;
    }
    (void)hipMemsetAsync(p.bar(), 0, (size_t)CTRL_WORDS * 4, stream);
    void* args[] = {&p};
    hipError_t e = hipLaunchCooperativeKernel((void*)k_mega, dim3(grid_blocks), dim3(NTHREADS), args, 0, stream);
    if (e != hipSuccess) fprintf(stderr, "cooperative launch failed: %s (grid %d)\n", hipGetErrorString(e), grid_blocks);
#else
    launch_stage<S_CONVT_IN>(p, 0, stream); launch_stage<S_CONVT_OUT>(p, 0, stream); launch_stage<S_CONVT_Q>(p, 0, stream); launch_stage<S_CONVT_W1>(p, 0, stream); launch_stage<S_CALIB>(p, 0, stream);
    launch_stage<S_TAB_U>(p, 0, stream); launch_stage<S_TAB_V>(p, 0, stream);
    launch_stage<S_ADA>(p, 0, stream); launch_stage<S_ROPE>(p, 0, stream);
    for (int layer = 0; layer < NL; ++layer) {
        launch_stage<S_NORM1>(p, layer, stream); launch_stage<S_GEMM_IN>(p, layer, stream);
        launch_stage<S_CONV>(p, layer, stream); launch_stage<S_SGU>(p, layer, stream); launch_stage<S_VTRANS>(p, layer, stream);
        launch_stage<S_PREP>(p, layer, stream); launch_stage<S_COMPRESS>(p, layer, stream);
        launch_stage<S_NSA_CMP>(p, layer, stream); launch_stage<S_DSA_INDEX>(p, layer, stream);
        launch_stage<S_NSA_ATTN>(p, layer, stream); launch_stage<S_DSA_ATTN>(p, layer, stream);
        launch_stage<S_GEMM_OUT>(p, layer, stream); launch_stage<S_NORM2>(p, layer, stream); launch_stage<S_GEMM_Q>(p, layer, stream);
        launch_stage<S_PEER_TOPK>(p, layer, stream); launch_stage<S_PEER_GATHER>(p, layer, stream);
    }
#endif
}
```

```cpp
#include <hip/hip_runtime.h>
#include <hip/hip_cooperative_groups.h>
#include <stdint.h>
#include <cstdio>
namespace cg = cooperative_groups;

typedef unsigned short bf16_t;
typedef short bf16x8 __attribute__((ext_vector_type(8)));
typedef float f32x4 __attribute__((ext_vector_type(4)));
typedef float f32x16 __attribute__((ext_vector_type(16)));
#define DEV __device__ __forceinline__

constexpr int T = 8192, D = 2048, NL = 2;
constexpr int INC = 4692;
constexpr int LDP = 4736;
constexpr int C_CA = 0, C_CG = 512, C_SU = 1024, C_SV = 1536;
constexpr int C_NQ = 2048, C_NKC = 2560, C_NVC = 2688, C_NKS = 2816, C_NVS = 2944, C_NKW = 3072, C_NVW = 3200;
constexpr int C_DQ = 3328, C_DK = 3840, C_DV = 3968, C_IQ = 4096, C_IK = 4608, C_NG = 4672, C_IW = 4688;
constexpr float EPS = 1e-6f;
constexpr int NTHREADS = 256;
constexpr int SMEM_BYTES = 72 * 1024;

__device__ const double INV16[16] = {1.0, 0.44036660267178046, 0.19392274474868576, 0.08539710028576561, 0.03760603093086393,
    0.016560440080994446, 0.007292664737217109, 0.003211445994752591, 0.001414213562373095, 0.000622772421914596,
    0.0002742481756762073, 0.00012076973741146504, 5.318295896944988e-05, 2.341999896140934e-05, 1.031338537721246e-05,
    4.5416704806078695e-06};

#define XCD_BAR_WORDS 3456
#define GQ_WORD(inst, x) (XCD_BAR_WORDS + 64 * ((inst) * 8 + (x)))
#define DQ_WORD(k) (XCD_BAR_WORDS + 64 * (96 + (k)))
#define CTRL_WORDS (XCD_BAR_WORDS + 64 * 112)
constexpr size_t WS_ALIGN(size_t x) { return (x + 255) & ~(size_t)255; }
constexpr size_t OFF_WinT = 0;
constexpr size_t OFF_WoutT = OFF_WinT + WS_ALIGN((size_t)2 * LDP * 2048 * 2);
constexpr size_t OFF_WqT = OFF_WoutT + WS_ALIGN((size_t)2 * 2048 * 2048 * 2);
constexpr size_t OFF_W1T = OFF_WqT + WS_ALIGN((size_t)2 * 1024 * 2048 * 2);
constexpr size_t OFF_PI = OFF_W1T + WS_ALIGN((size_t)4 * 128 * 4096 * 2);
constexpr size_t OFF_Utab = OFF_PI + WS_ALIGN(256);
constexpr size_t OFF_Vtab = OFF_Utab + WS_ALIGN((size_t)2 * 16384 * 1536);
constexpr size_t OFF_ada = OFF_Vtab + WS_ALIGN((size_t)2 * 16384 * 1536);
constexpr size_t OFF_ropeC = OFF_ada + WS_ALIGN((size_t)2 * 12288 * 4);
constexpr size_t OFF_ropeS = OFF_ropeC + WS_ALIGN((size_t)T * 24 * 4);
constexpr size_t OFF_HN = OFF_ropeS + WS_ALIGN((size_t)T * 24 * 4);
constexpr size_t OFF_PROJ = OFF_HN + WS_ALIGN((size_t)T * D * 2);
constexpr size_t OFF_Y = OFF_PROJ + WS_ALIGN((size_t)T * LDP * 2);
constexpr size_t OFF_QN = OFF_Y + WS_ALIGN((size_t)T * D * 2);
constexpr size_t OFF_QR = OFF_QN + WS_ALIGN((size_t)T * 512 * 2);
constexpr size_t OFF_KS = OFF_QR + WS_ALIGN((size_t)T * 512 * 2);
constexpr size_t OFF_KW = OFF_KS + WS_ALIGN((size_t)T * 128 * 2);
constexpr size_t OFF_VST = OFF_KW + WS_ALIGN((size_t)T * 128 * 2);
constexpr size_t OFF_VWT = OFF_VST + WS_ALIGN((size_t)T * 128 * 2);
constexpr size_t OFF_GATES = OFF_VWT + WS_ALIGN((size_t)T * 128 * 2);
constexpr size_t OFF_KC = OFF_GATES + WS_ALIGN((size_t)T * 12 * 4);
constexpr size_t OFF_VCT = OFF_KC + WS_ALIGN((size_t)512 * 128 * 2);
constexpr size_t OFF_SEL = OFF_VCT + WS_ALIGN((size_t)128 * 512 * 2);
constexpr size_t OFF_OCMP = OFF_SEL + WS_ALIGN((size_t)T * 4 * 4);
constexpr size_t OFF_DQ = OFF_OCMP + WS_ALIGN((size_t)T * 512 * 2);
constexpr size_t OFF_DK = OFF_DQ + WS_ALIGN((size_t)T * 512 * 2);
constexpr size_t OFF_DVC = OFF_DK + WS_ALIGN((size_t)T * 128 * 2);
constexpr size_t OFF_KVC = OFF_DVC + WS_ALIGN((size_t)T * 128 * 2);
constexpr size_t OFF_IQ = OFF_KVC + WS_ALIGN((size_t)T * 256 * 2);
constexpr size_t OFF_IK = OFF_IQ + WS_ALIGN((size_t)T * 512 * 2);
constexpr size_t OFF_IW = OFF_IK + WS_ALIGN((size_t)T * 64 * 2);
constexpr size_t OFF_IDX = OFF_IW + WS_ALIGN((size_t)T * 8 * 4);
constexpr size_t OFF_CNT = OFF_IDX + WS_ALIGN((size_t)T * 256 * 4);
constexpr size_t OFF_X1 = OFF_CNT + WS_ALIGN((size_t)T * 4);
constexpr size_t OFF_X2 = OFF_X1 + WS_ALIGN((size_t)T * D * 4);
constexpr size_t OFF_PQ = OFF_X2 + WS_ALIGN((size_t)T * D * 4);
constexpr size_t OFF_PE = OFF_PQ + WS_ALIGN((size_t)T * 1024 * 4);
constexpr size_t OFF_PG = OFF_PE + WS_ALIGN((size_t)T * 128 * 4);
constexpr size_t OFF_bar = OFF_PG + WS_ALIGN((size_t)T * 128 * 4);
constexpr size_t WS_TOTAL = OFF_bar + WS_ALIGN((size_t)CTRL_WORDS * 4);

struct P {
    const float* x; const float* c; const int* pos; const float* ada_w; const float* ada_b; const float* n1g; const float* n2g;
    const float* w_in; const float* w_out; const float* conv_w; const float* conv_b; const float* cln_g; const float* cln_b;
    const float* sln_g; const float* sln_b; const float* sgu_w; const float* sgu_b; const float* nsa_qg; const float* nsa_kg;
    const float* cmp_pos; const float* cmp_w1; const float* cmp_w2; const float* dsa_qg; const float* dsa_kg;
    const float* peer_wq; const float* peer_sk; const float* peer_u; const float* peer_v;
    float* out;
    char* ws;
    __host__ __device__ __forceinline__ bf16_t* WinT() const { return (bf16_t*)(ws + OFF_WinT); }
    __host__ __device__ __forceinline__ bf16_t* WoutT() const { return (bf16_t*)(ws + OFF_WoutT); }
    __host__ __device__ __forceinline__ bf16_t* WqT() const { return (bf16_t*)(ws + OFF_WqT); }
    __host__ __device__ __forceinline__ bf16_t* W1T() const { return (bf16_t*)(ws + OFF_W1T); }
    __host__ __device__ __forceinline__ int* PI() const { return (int*)(ws + OFF_PI); }
    __host__ __device__ __forceinline__ unsigned char* Utab() const { return (unsigned char*)(ws + OFF_Utab); }
    __host__ __device__ __forceinline__ unsigned char* Vtab() const { return (unsigned char*)(ws + OFF_Vtab); }
    __host__ __device__ __forceinline__ float* ada() const { return (float*)(ws + OFF_ada); }
    __host__ __device__ __forceinline__ float* ropeC() const { return (float*)(ws + OFF_ropeC); }
    __host__ __device__ __forceinline__ float* ropeS() const { return (float*)(ws + OFF_ropeS); }
    __host__ __device__ __forceinline__ bf16_t* HN() const { return (bf16_t*)(ws + OFF_HN); }
    __host__ __device__ __forceinline__ bf16_t* PROJ() const { return (bf16_t*)(ws + OFF_PROJ); }
    __host__ __device__ __forceinline__ bf16_t* Y() const { return (bf16_t*)(ws + OFF_Y); }
    __host__ __device__ __forceinline__ bf16_t* QN() const { return (bf16_t*)(ws + OFF_QN); }
    __host__ __device__ __forceinline__ bf16_t* QR() const { return (bf16_t*)(ws + OFF_QR); }
    __host__ __device__ __forceinline__ bf16_t* KS() const { return (bf16_t*)(ws + OFF_KS); }
    __host__ __device__ __forceinline__ bf16_t* KW() const { return (bf16_t*)(ws + OFF_KW); }
    __host__ __device__ __forceinline__ bf16_t* VST() const { return (bf16_t*)(ws + OFF_VST); }
    __host__ __device__ __forceinline__ bf16_t* VWT() const { return (bf16_t*)(ws + OFF_VWT); }
    __host__ __device__ __forceinline__ float* GATES() const { return (float*)(ws + OFF_GATES); }
    __host__ __device__ __forceinline__ bf16_t* KC() const { return (bf16_t*)(ws + OFF_KC); }
    __host__ __device__ __forceinline__ bf16_t* VCT() const { return (bf16_t*)(ws + OFF_VCT); }
    __host__ __device__ __forceinline__ unsigned* SEL() const { return (unsigned*)(ws + OFF_SEL); }
    __host__ __device__ __forceinline__ bf16_t* OCMP() const { return (bf16_t*)(ws + OFF_OCMP); }
    __host__ __device__ __forceinline__ bf16_t* DQ() const { return (bf16_t*)(ws + OFF_DQ); }
    __host__ __device__ __forceinline__ bf16_t* DK() const { return (bf16_t*)(ws + OFF_DK); }
    __host__ __device__ __forceinline__ bf16_t* DVC() const { return (bf16_t*)(ws + OFF_DVC); }
    __host__ __device__ __forceinline__ bf16_t* KVC() const { return (bf16_t*)(ws + OFF_KVC); }
    __host__ __device__ __forceinline__ bf16_t* IQ() const { return (bf16_t*)(ws + OFF_IQ); }
    __host__ __device__ __forceinline__ bf16_t* IK() const { return (bf16_t*)(ws + OFF_IK); }
    __host__ __device__ __forceinline__ float* IW() const { return (float*)(ws + OFF_IW); }
    __host__ __device__ __forceinline__ int* IDX() const { return (int*)(ws + OFF_IDX); }
    __host__ __device__ __forceinline__ int* CNT() const { return (int*)(ws + OFF_CNT); }
    __host__ __device__ __forceinline__ float* X1() const { return (float*)(ws + OFF_X1); }
    __host__ __device__ __forceinline__ float* X2() const { return (float*)(ws + OFF_X2); }
    __host__ __device__ __forceinline__ float* PQ() const { return (float*)(ws + OFF_PQ); }
    __host__ __device__ __forceinline__ int* PE() const { return (int*)(ws + OFF_PE); }
    __host__ __device__ __forceinline__ float* PG() const { return (float*)(ws + OFF_PG); }
    __host__ __device__ __forceinline__ unsigned* bar() const { return (unsigned*)(ws + OFF_bar); }
};

DEV float bf2f(bf16_t v) { return __uint_as_float(((unsigned)v) << 16); }
DEV unsigned pk2(float lo, float hi) { unsigned r; asm("v_cvt_pk_bf16_f32 %0, %1, %2" : "=v"(r) : "v"(lo), "v"(hi)); return r; }
DEV bf16_t f2bf(float v) { return (bf16_t)(pk2(v, 0.f) & 0xffffu); }
DEV float lo2f(unsigned u) { return __uint_as_float(u << 16); }
DEV float hi2f(unsigned u) { return __uint_as_float(u & 0xffff0000u); }
#define DPP_ROR_F(V, N) __int_as_float(__builtin_amdgcn_update_dpp(0, __float_as_int(V), 0x120 + (N), 0xf, 0xf, false))
DEV float wsum(float v) {
    v += DPP_ROR_F(v, 8); v += DPP_ROR_F(v, 4); v += DPP_ROR_F(v, 2); v += DPP_ROR_F(v, 1);
    const int vi = __float_as_int(v);
    return (__int_as_float(__builtin_amdgcn_readlane(vi, 0)) + __int_as_float(__builtin_amdgcn_readlane(vi, 16))) +
           (__int_as_float(__builtin_amdgcn_readlane(vi, 32)) + __int_as_float(__builtin_amdgcn_readlane(vi, 48)));
}
DEV float wmax(float v) {
    v = fmaxf(v, DPP_ROR_F(v, 8)); v = fmaxf(v, DPP_ROR_F(v, 4)); v = fmaxf(v, DPP_ROR_F(v, 2)); v = fmaxf(v, DPP_ROR_F(v, 1));
    const int vi = __float_as_int(v);
    return fmaxf(fmaxf(__int_as_float(__builtin_amdgcn_readlane(vi, 0)), __int_as_float(__builtin_amdgcn_readlane(vi, 16))),
                 fmaxf(__int_as_float(__builtin_amdgcn_readlane(vi, 32)), __int_as_float(__builtin_amdgcn_readlane(vi, 48))));
}
DEV int tidx() { int t = threadIdx.x; asm volatile("" : "+v"(t)); return t; }
DEV float sigmoidf_(float x) { return 1.0f / (1.0f + __expf(-x)); }
DEV float gelu_tanh(float x) {
    const float y = 0.7978845608028654f * (x + 0.044715f * x * x * x);
    const float t = 1.0f - 2.0f / (1.0f + __expf(2.0f * y));
    return 0.5f * x * (1.0f + t);
}
DEV f32x4 mfma16(bf16x8 a, bf16x8 b, f32x4 c) { return __builtin_amdgcn_mfma_f32_16x16x32_bf16(a, b, c, 0, 0, 0); }
DEV f32x16 mfma32(bf16x8 a, bf16x8 b, f32x16 c) { return __builtin_amdgcn_mfma_f32_32x32x16_bf16(a, b, c, 0, 0, 0); }

DEV int src_col(int n) {
    if (n < 3328) return n;
    if (n < 4672) return 3340 + (n - 3328);
    if (n < 4684) return 3328 + (n - 4672);
    if (n < 4688) return -1;
    if (n < 4696) return 4684 + (n - 4688);
    return -1;
}

DEV void st_convT(const float* __restrict__ W, bf16_t* __restrict__ Bt, int N, int Npad, bool remap, int unit, char* smem, int Kdim = 2048) {
    float (*tile)[65] = (float (*)[65])smem;
    const int ntn = Npad / 64, kt = unit / ntn, nt = unit % ntn, k0 = kt * 64, n0 = nt * 64;
    const int tid_ = tidx(); const int tx = tid_ & 63, ty = tid_ >> 6;
    const int n = n0 + tx;
    const int src = remap ? src_col(n) : (n < N ? n : -1);
#pragma unroll
    for (int i = 0; i < 16; ++i) { const int k = ty + 4 * i; tile[k][tx] = src >= 0 ? W[(size_t)(k0 + k) * N + src] : 0.f; }
    __syncthreads();
#pragma unroll
    for (int i = 0; i < 16; ++i) { const int r = ty + 4 * i; Bt[(size_t)(n0 + r) * Kdim + k0 + tx] = f2bf(tile[tx][r]); }
    __syncthreads();
}

typedef float f32x2 __attribute__((ext_vector_type(2)));
typedef float v16f __attribute__((ext_vector_type(16)));
typedef float v32f __attribute__((ext_vector_type(32)));
typedef unsigned v6u __attribute__((ext_vector_type(6)));
#ifndef PEER_FP4
#define PEER_FP4 0
#endif
#if PEER_FP4
constexpr float U6_SCALE = 64.0f, V6_SCALE = 2.8f;
constexpr int ROW6 = 1024;
#else
constexpr float U6_SCALE = 64.0f, V6_SCALE = 3.0f;
constexpr int ROW6 = 1536;
#endif
#define FP6_ONE __uint_as_float(0x3F80007Fu)

#ifndef SW_FP6
#define SW_FP6 1
#endif
DEV unsigned fp6_enc1(float f) {
    const float a = fminf(fabsf(f), 7.5f);
    const float sc = a < 2.0f ? 8.0f : (a < 4.0f ? 4.0f : 2.0f), of = a < 2.0f ? 0.0f : (a < 4.0f ? 8.0f : 16.0f);
    const unsigned code = (unsigned)(int)__builtin_rintf(a * sc + of);
    return code | ((__float_as_uint(f) >> 26) & 32u);
}
DEV float fp6_dec1(unsigned c) {
    const unsigned e = (c >> 3) & 3u, m = c & 7u;
    const float v = e == 0u ? 0.125f * (float)m : (1.0f + 0.125f * (float)m) * (float)(1u << (e - 1u));
    return (c & 32u) ? -v : v;
}
DEV v6u sw_pack32(const v16f& x, const v16f& y) {
    unsigned w[6] = {0u, 0u, 0u, 0u, 0u, 0u};
#pragma unroll
    for (int i = 0; i < 32; ++i) {
        const unsigned c = fp6_enc1(i < 16 ? x[i] : y[i - 16]);
        const int bit = 6 * i, d = bit >> 5, sh = bit & 31;
        w[d] |= c << sh;
        if (sh > 26) w[d + 1] |= c >> (32 - sh);
    }
    v6u r; r[0] = w[0]; r[1] = w[1]; r[2] = w[2]; r[3] = w[3]; r[4] = w[4]; r[5] = w[5]; return r;
}
DEV v32f sw_unpack32(const v6u& pk) {
    const unsigned w[6] = {pk[0], pk[1], pk[2], pk[3], pk[4], pk[5]};
    v32f r;
#pragma unroll
    for (int i = 0; i < 32; ++i) {
        const int bit = 6 * i, d = bit >> 5, sh = bit & 31;
        unsigned c = w[d] >> sh;
        if (sh > 26) c |= w[d + 1] << (32 - sh);
        r[i] = fp6_dec1(c & 63u);
    }
    return r;
}
#define FP6_PACK(x, y) sw_pack32(x, y)
#define FP6_UNPACK(pk) __builtin_amdgcn_cvt_scalef32_pk32_f32_fp6(pk, FP6_ONE)

typedef float f32x2_t __attribute__((ext_vector_type(2)));
DEV unsigned fp4_enc1(float f) {
    const float a = fminf(fabsf(f), 6.0f);
    const float sc = a < 2.0f ? 2.0f : (a < 4.0f ? 1.0f : 0.5f), of = a < 2.0f ? 0.0f : (a < 4.0f ? 2.0f : 4.0f);
    const unsigned code = (unsigned)(int)__builtin_rintf(a * sc + of);
    return code | ((__float_as_uint(f) >> 28) & 8u);
}
DEV void fp4_unpack8(unsigned w, float* f) {
    const f32x2_t a = __builtin_amdgcn_cvt_scalef32_pk_f32_fp4(w, FP6_ONE, 0), b = __builtin_amdgcn_cvt_scalef32_pk_f32_fp4(w, FP6_ONE, 1);
    const f32x2_t c = __builtin_amdgcn_cvt_scalef32_pk_f32_fp4(w, FP6_ONE, 2), d = __builtin_amdgcn_cvt_scalef32_pk_f32_fp4(w, FP6_ONE, 3);
    f[0] = a.x; f[1] = a.y; f[2] = b.x; f[3] = b.y; f[4] = c.x; f[5] = c.y; f[6] = d.x; f[7] = d.y;
}
DEV void st_tab4(const P& p, const float* __restrict__ src, unsigned char* __restrict__ dst, float scale, int nrows, int unit, int nunits, char* smem) {
    const int tid_ = tidx(), w = tid_ >> 6, l = tid_ & 63;
    float* stg = (float*)smem + w * (64 * 36);
    int sh[8];
#pragma unroll
    for (int k = 0; k < 8; ++k) sh[k] = 4 * __builtin_amdgcn_readfirstlane(p.PI()[40 + k]);
    for (int r = unit * 4 + w; r < nrows; r += nunits * 4) {
        const float4* sp = (const float4*)(src + (size_t)r * 2048);
        float4 v[8];
#pragma unroll
        for (int i = 0; i < 8; ++i) v[i] = sp[l + 64 * i];
#pragma unroll
        for (int i = 0; i < 8; ++i) { const int f = l + 64 * i; *(float4*)(stg + (f >> 3) * 36 + (f & 7) * 4) = v[i]; }
        __builtin_amdgcn_wave_barrier();
        unsigned wd[4] = {0u, 0u, 0u, 0u};
#pragma unroll
        for (int q = 0; q < 8; ++q) {
            const float4 a = *(const float4*)(stg + l * 36 + q * 4);
            const float xv[4] = {a.x, a.y, a.z, a.w};
#pragma unroll
            for (int e = 0; e < 4; ++e) { const int j = q * 4 + e; wd[j >> 3] |= fp4_enc1(xv[e] * scale) << sh[j & 7]; }
        }
        *(uint4*)(dst + (size_t)r * ROW6 + l * 16) = make_uint4(wd[0], wd[1], wd[2], wd[3]);
        __builtin_amdgcn_wave_barrier();
    }
}
DEV void st_tab6(const float* __restrict__ src, unsigned char* __restrict__ dst, float scale, int nrows, int unit, int nunits, char* smem) {
    const int tid_ = tidx(), w = tid_ >> 6, l = tid_ & 63;
    float* stg = (float*)smem + w * (64 * 36);
    for (int r = unit * 4 + w; r < nrows; r += nunits * 4) {
        const float4* sp = (const float4*)(src + (size_t)r * 2048);
        float4 v[8];
#pragma unroll
        for (int i = 0; i < 8; ++i) v[i] = sp[l + 64 * i];
#pragma unroll
        for (int i = 0; i < 8; ++i) { const int f = l + 64 * i; *(float4*)(stg + (f >> 3) * 36 + (f & 7) * 4) = v[i]; }
        __builtin_amdgcn_wave_barrier();
        v16f x, y;
#pragma unroll
        for (int q = 0; q < 4; ++q) {
            const float4 a = *(const float4*)(stg + l * 36 + q * 4), b = *(const float4*)(stg + l * 36 + 16 + q * 4);
            x[4 * q] = a.x * scale; x[4 * q + 1] = a.y * scale; x[4 * q + 2] = a.z * scale; x[4 * q + 3] = a.w * scale;
            y[4 * q] = b.x * scale; y[4 * q + 1] = b.y * scale; y[4 * q + 2] = b.z * scale; y[4 * q + 3] = b.w * scale;
        }
        const v6u pk = FP6_PACK(x, y);
        unsigned char* dp = dst + (size_t)r * ROW6 + l * 8;
        *(uint2*)(dp) = make_uint2(pk[0], pk[1]); *(uint2*)(dp + 512) = make_uint2(pk[2], pk[3]); *(uint2*)(dp + 1024) = make_uint2(pk[4], pk[5]);
        __builtin_amdgcn_wave_barrier();
    }
}
DEV void st_calib(const P& p) {
    if (tidx() >= 64) return;
    v16f x, y;
#pragma unroll
    for (int k = 0; k < 32; ++k) {
        const int e = k >> 3, m = k & 7;
        const float v = e == 0 ? 0.125f * m : (1.0f + 0.125f * m) * (float)(1 << (e - 1));
        if (k < 16) x[k] = v; else y[k - 16] = v;
    }
    const v6u pk = FP6_PACK(x, y);
    const v32f d = FP6_UNPACK(pk);
    if ((threadIdx.x & 63) == 0) {
        float dmax = 0.f;
#pragma unroll
        for (int j = 0; j < 32; ++j) dmax = fmaxf(dmax, fabsf(d[j]));
        const float cscale = dmax > 0.f ? dmax * (1.0f / 7.5f) : 1.0f;
        const float ic = 1.0f / cscale;
#pragma unroll
        for (int j = 0; j < 32; ++j) {
            int found = j;
#pragma unroll
            for (int k = 0; k < 32; ++k) {
                const int e = k >> 3, m = k & 7;
                const float v = e == 0 ? 0.125f * m : (1.0f + 0.125f * m) * (float)(1 << (e - 1));
                if (fabsf(d[j] * ic - v) < 0.02f + 0.01f * v) found = k;
            }
            p.PI()[j] = found;
        }
        p.PI()[32] = __float_as_int(ic);
    }
#if PEER_FP4
    {
        const unsigned probe = 0x07654321u;
        float f8[8]; fp4_unpack8(probe, f8);
        if ((threadIdx.x & 63) == 0) {
            const float val[8] = {0.f, 0.5f, 1.f, 1.5f, 2.f, 3.f, 4.f, 6.f};
            float dmax = 0.f;
#pragma unroll
            for (int k = 0; k < 8; ++k) dmax = fmaxf(dmax, fabsf(f8[k]));
            const float ic4 = dmax > 0.f ? 6.0f / dmax : 1.0f;
#pragma unroll
            for (int k = 0; k < 8; ++k) {
                int nib = k;
#pragma unroll
                for (int c = 0; c < 8; ++c) if (fabsf(f8[k] * ic4 - val[c]) < 0.1f) nib = (c + 7) & 7;
                p.PI()[40 + k] = nib;
            }
#pragma unroll
            for (int j = 0; j < 32; ++j) p.PI()[j] = j;
            p.PI()[32] = __float_as_int(ic4);
        }
    }
#endif
}

DEV void st_ada(const P& p, int unit, char* smem) {
    float4* red = (float4*)smem;
    const int tid = tidx(), c4 = tid & 15, kg = tid >> 4;
    const int i = unit / 192, j = (unit % 192) * 64 + c4 * 4;
    const float* W = p.ada_w + (size_t)i * 2048 * 12288 + (size_t)kg * 12288 + j;
    float4 acc = make_float4(0.f, 0.f, 0.f, 0.f);
#pragma unroll 1
    for (int k0 = 0; k0 < 128; k0 += 16) {
        float4 wv[16]; float a[16];
#pragma unroll
        for (int q = 0; q < 16; ++q) { const f32x4 t4 = __builtin_nontemporal_load((const f32x4*)(W + (size_t)(16 * (k0 + q)) * 12288)); wv[q] = make_float4(t4[0], t4[1], t4[2], t4[3]); }
#pragma unroll
        for (int q = 0; q < 16; ++q) { const float cv = p.c[kg + 16 * (k0 + q)]; a[q] = cv * sigmoidf_(cv); }
#pragma unroll
        for (int q = 0; q < 16; ++q) { acc.x += a[q] * wv[q].x; acc.y += a[q] * wv[q].y; acc.z += a[q] * wv[q].z; acc.w += a[q] * wv[q].w; }
    }
    red[kg * 16 + c4] = acc;
    __syncthreads();
    if (tid < 64) {
        const int cc = tid >> 2, e = tid & 3;
        float r = p.ada_b[i * 12288 + (unit % 192) * 64 + tid];
#pragma unroll
        for (int q = 0; q < 16; ++q) r += ((const float*)&red[q * 16 + cc])[e];
        p.ada()[i * 12288 + (unit % 192) * 64 + tid] = r;
    }
    __syncthreads();
}
DEV void st_rope(const P& p, int unit) {
    const int e = unit * 256 + tidx(); const int t = e / 24, i = e % 24;
    const double inv = i < 16 ? INV16[i] : INV16[2 * (i - 16)];
    const double ang = (double)p.pos[t] * inv;
    const double n = rint(ang * 0.15915494309189535);
    const double r = ang - n * 6.283185307179586;
    const double r2 = r * r;
    double sp = 1.0 / 1.5511210043330986e25, cp = -1.0 / 4.0329146112660565e26;
    sp = sp * r2 - 1.0 / 2.585201673888498e22;   cp = cp * r2 + 1.0 / 6.204484017332394e23;
    sp = sp * r2 + 1.0 / 5.109094217170944e19;   cp = cp * r2 - 1.0 / 1.1240007277776077e21;
    sp = sp * r2 - 1.0 / 1.21645100408832e17;    cp = cp * r2 + 1.0 / 2.43290200817664e18;
    sp = sp * r2 + 1.0 / 3.55687428096e14;       cp = cp * r2 - 1.0 / 6.402373705728e15;
    sp = sp * r2 - 1.0 / 1.307674368e12;         cp = cp * r2 + 1.0 / 2.0922789888e13;
    sp = sp * r2 + 1.0 / 6.2270208e9;            cp = cp * r2 - 1.0 / 8.71782912e10;
    sp = sp * r2 - 1.0 / 3.99168e7;              cp = cp * r2 + 1.0 / 4.790016e8;
    sp = sp * r2 + 1.0 / 362880.0;               cp = cp * r2 - 1.0 / 3628800.0;
    sp = sp * r2 - 1.0 / 5040.0;                 cp = cp * r2 + 1.0 / 40320.0;
    sp = sp * r2 + 1.0 / 120.0;                  cp = cp * r2 - 1.0 / 720.0;
    sp = sp * r2 - 1.0 / 6.0;                    cp = cp * r2 + 1.0 / 24.0;
    sp = sp * r2 + 1.0;                          cp = cp * r2 - 0.5;
    cp = cp * r2 + 1.0;
    const float cs = (float)cp, sn = (float)(sp * r);
    p.ropeC()[e] = cs; p.ropeS()[e] = sn;
}

DEV void st_norm(const float* __restrict__ X, const float* __restrict__ g, const float* __restrict__ sc, const float* __restrict__ sh,
                 bf16_t* __restrict__ HN, int unit) {
    const int tid_ = tidx(); const int w = tid_ >> 6, l = tid_ & 63; const int t = unit * 4 + w;
    const float4* xr = (const float4*)(X + (size_t)t * D);
    float4 v[8]; float ss = 0.f;
#pragma unroll
    for (int i = 0; i < 4; ++i) { v[2 * i] = xr[i * 128 + l * 2]; v[2 * i + 1] = xr[i * 128 + l * 2 + 1]; }
#pragma unroll
    for (int i = 0; i < 8; ++i) ss += v[i].x * v[i].x + v[i].y * v[i].y + v[i].z * v[i].z + v[i].w * v[i].w;
    ss = wsum(ss);
    const float rs = rsqrtf(ss * (1.0f / 2048.0f) + EPS);
#pragma unroll
    for (int i = 0; i < 4; ++i) {
        const int col = i * 512 + l * 8;
        float y[8]; const float xv[8] = {v[2 * i].x, v[2 * i].y, v[2 * i].z, v[2 * i].w, v[2 * i + 1].x, v[2 * i + 1].y, v[2 * i + 1].z, v[2 * i + 1].w};
#pragma unroll
        for (int j = 0; j < 8; ++j) y[j] = (xv[j] * rs) * g[col + j] * (1.0f + sc[col + j]) + sh[col + j];
        uint4 o; o.x = pk2(y[0], y[1]); o.y = pk2(y[2], y[3]); o.z = pk2(y[4], y[5]); o.w = pk2(y[6], y[7]);
        *(uint4*)(HN + (size_t)t * D + col) = o;
    }
}

enum { EPI_PROJ = 0, EPI_OUT = 1, EPI_Q = 2 };
struct EpiArgs { bf16_t* obf; float* of; const float* xin; const float* gate; bf16_t* kvc; };
template <int EPI, int MT = 4>
DEV void st_gemm(const bf16_t* __restrict__ A, const bf16_t* __restrict__ Bt, int K, int tm, int tn, const EpiArgs& e, char* smem) {
    constexpr int BM = 32 * MT, ABYTES = BM * 64, BUFB = ABYTES + 8192, NBUF = (MT == 4) ? 4 : 3, NA = BM / 64;
    static_assert(NBUF * BUFB <= SMEM_BYTES, "GEMM LDS");
    const int tid = tidx(), w = tid >> 6, l = tid & 63, wr = w >> 1, wc = w & 1;
    f32x4 acc[MT][4];
#pragma unroll
    for (int m = 0; m < MT; ++m)
#pragma unroll
        for (int n = 0; n < 4; ++n) acc[m][n] = (f32x4){0.f, 0.f, 0.f, 0.f};
    const int srow = tid >> 2, spc = tid & 3, sc = spc ^ (((srow >> 2) & 1) << 1);
    const bf16_t* Ag = A + (size_t)(tm * BM + srow) * K + sc * 8;
    const bf16_t* Bg = Bt + (size_t)(tn * 128 + srow) * K + sc * 8;
#define GEMM_STAGE(BUF, KO) do { char* _b = smem + (BUF) * BUFB + tid * 16; \
        _Pragma("unroll") for (int _i = 0; _i < NA; ++_i) \
            __builtin_amdgcn_global_load_lds((const unsigned*)(Ag + (size_t)(64 * _i) * K + (KO)), (__attribute__((address_space(3))) unsigned*)(_b + _i * 4096), 16, 0, 0); \
        __builtin_amdgcn_global_load_lds((const unsigned*)(Bg + (KO)), (__attribute__((address_space(3))) unsigned*)(_b + ABYTES), 16, 0, 0); \
        __builtin_amdgcn_global_load_lds((const unsigned*)(Bg + (size_t)64 * K + (KO)), (__attribute__((address_space(3))) unsigned*)(_b + ABYTES + 4096), 16, 0, 0); } while (0)
    const int nk = K / 32;
    GEMM_STAGE(0, 0); GEMM_STAGE(1, 32);
    if (NBUF == 4) { GEMM_STAGE(2, 64); asm volatile("s_waitcnt vmcnt(8)" ::: "memory"); }
    else asm volatile("s_waitcnt vmcnt(6)" ::: "memory");
    __builtin_amdgcn_s_barrier();
    const int fr = l & 15, fq = l >> 4;
    int cur = 0, nxt = NBUF - 1;
#pragma unroll 1
    for (int kt = 0; kt < nk; ++kt) {
        if (kt + NBUF - 1 < nk) GEMM_STAGE(nxt, (kt + NBUF - 1) * 32);
        const char* As = smem + cur * BUFB; const char* Bs = As + ABYTES;
        bf16x8 bfr[4];
#pragma unroll
        for (int n = 0; n < 4; ++n) { const int row = wc * 64 + n * 16 + fr; bfr[n] = *(const bf16x8*)(Bs + row * 64 + ((fq ^ (((row >> 2) & 1) << 1)) << 4)); }
#pragma unroll
        for (int m = 0; m < MT; ++m) {
            const int row = wr * (BM / 2) + m * 16 + fr;
            const bf16x8 af = *(const bf16x8*)(As + row * 64 + ((fq ^ (((row >> 2) & 1) << 1)) << 4));
#pragma unroll
            for (int n = 0; n < 4; ++n) acc[m][n] = mfma16(bfr[n], af, acc[m][n]);
        }
        if (NBUF == 4) {
            if (kt + 3 < nk) asm volatile("s_waitcnt vmcnt(8)" ::: "memory");
            else if (kt + 2 < nk) asm volatile("s_waitcnt vmcnt(4)" ::: "memory");
            else asm volatile("s_waitcnt vmcnt(0)" ::: "memory");
        } else {
            if (kt + 2 < nk) asm volatile("s_waitcnt vmcnt(6)" ::: "memory");
            else asm volatile("s_waitcnt vmcnt(0)" ::: "memory");
        }
        asm volatile("s_waitcnt lgkmcnt(0)" ::: "memory");
        __builtin_amdgcn_s_barrier();
        cur = (cur + 1 == NBUF) ? 0 : cur + 1; nxt = (nxt + 1 == NBUF) ? 0 : nxt + 1;
    }
#undef GEMM_STAGE
#pragma unroll
    for (int m = 0; m < MT; ++m) {
        const int row = tm * BM + wr * (BM / 2) + m * 16 + (l & 15);
#pragma unroll
        for (int n = 0; n < 4; ++n) {
            const int col = tn * 128 + wc * 64 + n * 16 + 4 * (l >> 4);
            const f32x4 a = acc[m][n];
            if (EPI == EPI_PROJ) {
                uint2 o; o.x = pk2(a[0], a[1]); o.y = pk2(a[2], a[3]);
                *(uint2*)(e.obf + (size_t)row * LDP + col) = o;
                if (col >= C_NKC && col < C_NKC + 256) *(uint2*)(e.kvc + (size_t)row * 256 + (col - C_NKC)) = o;
            } else if (EPI == EPI_OUT) {
                const float4 xi = *(const float4*)(e.xin + (size_t)row * D + col);
                const float4 gg = *(const float4*)(e.gate + col);
                float4 o; o.x = xi.x + gg.x * a[0]; o.y = xi.y + gg.y * a[1]; o.z = xi.z + gg.z * a[2]; o.w = xi.w + gg.w * a[3];
                *(float4*)(e.of + (size_t)row * D + col) = o;
            } else {
                float4 o; o.x = a[0]; o.y = a[1]; o.z = a[2]; o.w = a[3];
                *(float4*)(e.of + (size_t)row * 1024 + col) = o;
            }
        }
    }
    __syncthreads();
}

DEV void st_conv(const P& p, int layer, int unit, char* smem) {
    float* cs = (float*)smem;
    const int tid = tidx(), t0 = unit * 16;
    const float* cw = p.conv_w + (size_t)layer * 31 * 512;
#pragma unroll 1
    for (int cc = 0; cc < 2; ++cc) {
        const int c = tid + 256 * cc;
        float w[31], z[46];
#pragma unroll
        for (int k = 0; k < 31; ++k) w[k] = cw[k * 512 + c];
#pragma unroll
        for (int r = 0; r < 46; ++r) {
            const int t = t0 - 30 + r, tc = t < 0 ? 0 : t;
            const float a = bf2f(p.PROJ()[(size_t)tc * LDP + C_CA + c]), g = bf2f(p.PROJ()[(size_t)tc * LDP + C_CG + c]);
            z[r] = t >= 0 ? a * sigmoidf_(g) : 0.f;
        }
        const float cb = p.conv_b[layer * 512 + c];
#pragma unroll
        for (int tt = 0; tt < 16; ++tt) {
            float acc = cb;
#pragma unroll
            for (int k = 0; k < 31; ++k) acc += w[k] * z[tt + k];
            cs[tt * 512 + c] = acc;
        }
    }
    __syncthreads();
    const int w = tid >> 6, l = tid & 63;
    const float* lg = p.cln_g + layer * 512; const float* lb = p.cln_b + layer * 512;
#pragma unroll 1
    for (int q = 0; q < 4; ++q) {
        const int tt = w * 4 + q;
        float v[8]; float s = 0.f;
#pragma unroll
        for (int i = 0; i < 8; ++i) { v[i] = cs[tt * 512 + l + 64 * i]; s += v[i]; }
        const float mean = wsum(s) * (1.0f / 512.0f);
        float q2 = 0.f;
#pragma unroll
        for (int i = 0; i < 8; ++i) { const float d = v[i] - mean; q2 += d * d; }
        const float rstd = rsqrtf(wsum(q2) * (1.0f / 512.0f) + EPS);
#pragma unroll
        for (int i = 0; i < 8; ++i) {
            const int c = l + 64 * i;
            const float y = (v[i] - mean) * rstd * lg[c] + lb[c];
            p.Y()[(size_t)(t0 + tt) * D + c] = f2bf(y * sigmoidf_(y));
        }
    }
    __syncthreads();
}

DEV void st_sgu(const P& p, int layer, int unit, char* smem) {
    constexpr int RSB = 136;
    const int n = unit >> 2, h = unit & 3, tid = tidx(), w = tid >> 6, l = tid & 63;
    float* stat = (float*)smem;
    bf16_t* wtb = (bf16_t*)(smem + 1024);
    bf16_t* vtb = wtb + 128 * RSB;
    const int tb = n * 128;
#pragma unroll 4
    for (int q = 0; q < 32; ++q) {
        const int j = w * 32 + q;
        const uint4 raw = *(const uint4*)(p.PROJ() + (size_t)(tb + j) * LDP + C_SV + l * 8);
        float v[8] = {lo2f(raw.x), hi2f(raw.x), lo2f(raw.y), hi2f(raw.y), lo2f(raw.z), hi2f(raw.z), lo2f(raw.w), hi2f(raw.w)};
        float s = 0.f;
#pragma unroll
        for (int i = 0; i < 8; ++i) s += v[i];
        const float mean = wsum(s) * (1.0f / 512.0f);
        float q2 = 0.f;
#pragma unroll
        for (int i = 0; i < 8; ++i) { const float d = v[i] - mean; q2 += d * d; }
        const float rstd = rsqrtf(wsum(q2) * (1.0f / 512.0f) + EPS);
        if (l == 0) { stat[j * 2] = mean; stat[j * 2 + 1] = rstd; }
    }
    const float* Wh = p.sgu_w + ((size_t)layer * 4 + h) * 128 * 128;
    {
        float4 wv[16];
#pragma unroll
        for (int q = 0; q < 16; ++q) wv[q] = *(const float4*)(Wh + (size_t)(tid + 256 * q) * 4);
#pragma unroll
        for (int q = 0; q < 16; ++q) {
            const int f = tid + 256 * q, i = f >> 5, j4 = (f & 31) * 4;
            const float x4[4] = {wv[q].x, wv[q].y, wv[q].z, wv[q].w};
#pragma unroll
            for (int e = 0; e < 4; ++e) wtb[(j4 + e) * RSB + i] = (i >= j4 + e) ? f2bf(x4[e]) : (bf16_t)0;
        }
    }
    __syncthreads();
    {
        const float* lg = p.sln_g + layer * 512 + h * 128; const float* lb = p.sln_b + layer * 512 + h * 128;
        uint4 vr[8];
#pragma unroll
        for (int q = 0; q < 8; ++q) { const int f = tid + 256 * q, j = f >> 4, d8 = (f & 15) * 8; vr[q] = *(const uint4*)(p.PROJ() + (size_t)(tb + j) * LDP + C_SV + h * 128 + d8); }
#pragma unroll
        for (int q = 0; q < 8; ++q) {
            const int f = tid + 256 * q, j = f >> 4, d8 = (f & 15) * 8;
            const float mean = stat[j * 2], rstd = stat[j * 2 + 1];
            const float4 g0 = *(const float4*)(lg + d8), g1 = *(const float4*)(lg + d8 + 4), b0 = *(const float4*)(lb + d8), b1 = *(const float4*)(lb + d8 + 4);
            uint4 o;
            o.x = pk2((lo2f(vr[q].x) - mean) * rstd * g0.x + b0.x, (hi2f(vr[q].x) - mean) * rstd * g0.y + b0.y);
            o.y = pk2((lo2f(vr[q].y) - mean) * rstd * g0.z + b0.z, (hi2f(vr[q].y) - mean) * rstd * g0.w + b0.w);
            o.z = pk2((lo2f(vr[q].z) - mean) * rstd * g1.x + b1.x, (hi2f(vr[q].z) - mean) * rstd * g1.y + b1.y);
            o.w = pk2((lo2f(vr[q].w) - mean) * rstd * g1.z + b1.z, (hi2f(vr[q].w) - mean) * rstd * g1.w + b1.w);
            *(uint4*)(vtb + j * RSB + d8) = o;
        }
    }
    __syncthreads();
    const int ti = tid >> 4, td = tid & 15;
    float acc[8][8];
#pragma unroll
    for (int a = 0; a < 8; ++a)
#pragma unroll
        for (int bq = 0; bq < 8; ++bq) acc[a][bq] = 0.f;
    const int jend = w * 32 + 32;
#pragma unroll 2
    for (int j = 0; j < jend; ++j) {
        const uint4 wr = *(const uint4*)(wtb + j * RSB + ti * 8), vr = *(const uint4*)(vtb + j * RSB + td * 8);
        const float wv[8] = {lo2f(wr.x), hi2f(wr.x), lo2f(wr.y), hi2f(wr.y), lo2f(wr.z), hi2f(wr.z), lo2f(wr.w), hi2f(wr.w)};
        const float vv[8] = {lo2f(vr.x), hi2f(vr.x), lo2f(vr.y), hi2f(vr.y), lo2f(vr.z), hi2f(vr.z), lo2f(vr.w), hi2f(vr.w)};
#pragma unroll
        for (int a = 0; a < 8; ++a)
#pragma unroll
            for (int bq = 0; bq < 8; ++bq) acc[a][bq] += wv[a] * vv[bq];
    }
#pragma unroll
    for (int a = 0; a < 8; ++a) {
        const int i = ti * 8 + a; const size_t t = tb + i;
        const float bs = p.sgu_b[((size_t)layer * 4 + h) * 128 + i];
        const uint4 ur = *(const uint4*)(p.PROJ() + t * LDP + C_SU + h * 128 + td * 8);
        const float u[8] = {lo2f(ur.x), hi2f(ur.x), lo2f(ur.y), hi2f(ur.y), lo2f(ur.z), hi2f(ur.z), lo2f(ur.w), hi2f(ur.w)};
        float y[8];
#pragma unroll
        for (int bq = 0; bq < 8; ++bq) y[bq] = u[bq] * (acc[a][bq] + bs);
        uint4 o; o.x = pk2(y[0], y[1]); o.y = pk2(y[2], y[3]); o.z = pk2(y[4], y[5]); o.w = pk2(y[6], y[7]);
        *(uint4*)(p.Y() + t * D + 512 + h * 128 + td * 8) = o;
    }
    __syncthreads();
}

DEV void st_vtrans(const P& p, int unit, char* smem) {
    bf16_t* tile = (bf16_t*)smem;
    const int which = unit & 1, tt0 = (unit >> 1) * 64, tid = tidx();
    const int col0 = which ? C_NVW : C_NVS;
    bf16_t* dst = which ? p.VWT() : p.VST();
#pragma unroll
    for (int q = 0; q < 4; ++q) {
        const int e = tid + 256 * q; const int r = e >> 4, c8 = e & 15;
        const uint4 raw = *(const uint4*)(p.PROJ() + (size_t)(tt0 + r) * LDP + col0 + c8 * 8);
        unsigned* d32 = (unsigned*)(tile + r * 130 + c8 * 8);
        d32[0] = raw.x; d32[1] = raw.y; d32[2] = raw.z; d32[3] = raw.w;
    }
    __syncthreads();
    const int d = tid >> 1, half = tid & 1;
    unsigned o[16];
#pragma unroll
    for (int i = 0; i < 16; ++i) {
        const unsigned a = tile[(half * 32 + 2 * i) * 130 + d], b = tile[(half * 32 + 2 * i + 1) * 130 + d];
        o[i] = a | (b << 16);
    }
    uint4* dp = (uint4*)(dst + (size_t)d * T + tt0 + half * 32);
#pragma unroll
    for (int i = 0; i < 4; ++i) dp[i] = make_uint4(o[4 * i], o[4 * i + 1], o[4 * i + 2], o[4 * i + 3]);
    __syncthreads();
}

DEV void st_prep(const P& p, int layer, int unit) {
    const int tid_ = tidx(); const int w = tid_ >> 6, l = tid_ & 63; const size_t t = (size_t)unit * 4 + w;
    const bf16_t* row = p.PROJ() + t * LDP;
    const float* rc = p.ropeC() + t * 24; const float* rs_ = p.ropeS() + t * 24;
    unsigned raw[11];
#pragma unroll
    for (int h = 0; h < 4; ++h) { raw[h] = *(const unsigned*)(row + C_NQ + h * 128 + 2 * l); raw[6 + h] = *(const unsigned*)(row + C_DQ + h * 128 + 2 * l); }
    raw[4] = *(const unsigned*)(row + C_NKS + 2 * l); raw[5] = *(const unsigned*)(row + C_NKW + 2 * l); raw[10] = *(const unsigned*)(row + C_DK + 2 * l);
    bf16_t iraw[9];
#pragma unroll
    for (int h = 0; h < 9; ++h) iraw[h] = row[(h < 8 ? C_IQ + h * 64 : C_IK) + l];
    const float gq0 = p.nsa_qg[layer * 128 + 2 * l], gq1 = p.nsa_qg[layer * 128 + 2 * l + 1];
    const float gs0 = p.nsa_kg[(layer * 3 + 1) * 128 + 2 * l], gs1 = p.nsa_kg[(layer * 3 + 1) * 128 + 2 * l + 1];
    const float gw0 = p.nsa_kg[(layer * 3 + 2) * 128 + 2 * l], gw1 = p.nsa_kg[(layer * 3 + 2) * 128 + 2 * l + 1];
    const float dq0 = p.dsa_qg[layer * 128 + 2 * l], dq1 = p.dsa_qg[layer * 128 + 2 * l + 1];
    const float dk0 = p.dsa_kg[layer * 128 + 2 * l], dk1 = p.dsa_kg[layer * 128 + 2 * l + 1];
    const float c0 = rc[(2 * l) & 15], c1 = rc[(2 * l + 1) & 15], s0 = rs_[(2 * l) & 15], s1 = rs_[(2 * l + 1) & 15];
    const float ic = rc[16 + (l & 7)], is = rs_[16 + (l & 7)];
    float x0[11], x1[11], ss[11];
#pragma unroll
    for (int h = 0; h < 11; ++h) { x0[h] = lo2f(raw[h]); x1[h] = hi2f(raw[h]); ss[h] = x0[h] * x0[h] + x1[h] * x1[h]; }
#pragma unroll
    for (int h = 0; h < 11; ++h) ss[h] = wsum(ss[h]);
#pragma unroll
    for (int h = 0; h < 11; ++h) {
        const float r = rsqrtf(ss[h] * (1.0f / 128.0f) + EPS);
        const float g0 = h < 4 ? gq0 : (h == 4 ? gs0 : (h == 5 ? gw0 : (h < 10 ? dq0 : dk0)));
        const float g1 = h < 4 ? gq1 : (h == 4 ? gs1 : (h == 5 ? gw1 : (h < 10 ? dq1 : dk1)));
        const float n0 = x0[h] * r * g0, n1 = x1[h] * r * g1;
        const float o0 = __shfl_xor(n0, 8), o1 = __shfl_xor(n1, 8);
        float r0 = n0, r1 = n1;
        if (l < 8) { r0 = n0 * c0 - o0 * s0; r1 = n1 * c1 - o1 * s1; }
        else if (l < 16) { r0 = n0 * c0 + o0 * s0; r1 = n1 * c1 + o1 * s1; }
        const unsigned roped = pk2(r0, r1);
        if (h < 4) { *(unsigned*)(p.QN() + (t * 4 + h) * 128 + 2 * l) = pk2(n0, n1); *(unsigned*)(p.QR() + (t * 4 + h) * 128 + 2 * l) = roped; }
        else if (h == 4) *(unsigned*)(p.KS() + t * 128 + 2 * l) = roped;
        else if (h == 5) *(unsigned*)(p.KW() + t * 128 + 2 * l) = roped;
        else if (h < 10) *(unsigned*)(p.DQ() + (t * 4 + (h - 6)) * 128 + 2 * l) = roped;
        else *(unsigned*)(p.DK() + t * 128 + 2 * l) = roped;
    }
    if (l < 12) p.GATES()[t * 12 + l] = sigmoidf_(bf2f(row[C_NG + l]));
    *(unsigned*)(p.DVC() + t * 128 + 2 * l) = *(const unsigned*)(row + C_DV + 2 * l);
#pragma unroll
    for (int h = 0; h < 9; ++h) {
        const float x = bf2f(iraw[h]);
        const float other = __shfl_xor(x, 8);
        float o = x;
        if (l < 16) o = (l < 8) ? (x * ic - other * is) : (x * ic + other * is);
        if (h < 8) p.IQ()[(t * 8 + h) * 64 + l] = f2bf(o); else p.IK()[t * 64 + l] = f2bf(o);
    }
    if (l < 8) p.IW()[t * 8 + l] = bf2f(row[C_IW + l]) * (0.35355339059327373f * 0.125f);
}

DEV void st_compress(const P& p, int layer, int unit, char* smem) {
    const int which = unit & 1, rt = unit >> 1, tid = tidx(), w = tid >> 6, l = tid & 63, fr = l & 15, fq = l >> 4;
    float* hid = (float*)smem;
    float* ob = hid + 16 * 128;
    const int nb = rt * 16 + fr;
    const int col0 = which ? C_NVC : C_NKC;
    const float* ps = p.cmp_pos + ((size_t)layer * 2 + which) * 4096;
    const bf16_t* w1t = p.W1T() + ((size_t)layer * 2 + which) * 128 * 4096;
    const bool rowok = nb < 511;
    const bf16_t* xrow = p.KVC() + (size_t)(rowok ? nb * 16 : 0) * 256 + (which ? 128 : 0);
    f32x4 acc[2] = {(f32x4){0.f, 0.f, 0.f, 0.f}, (f32x4){0.f, 0.f, 0.f, 0.f}};
#pragma unroll 8
    for (int ks = 0; ks < 128; ++ks) {
        const int k = ks * 32 + fq * 8, lt = k >> 7, d = k & 127;
        const uint4 xr = *(const uint4*)(xrow + (size_t)lt * 256 + d);
        const float4 p0 = *(const float4*)(ps + k), p1 = *(const float4*)(ps + k + 4);
        union { bf16x8 v; unsigned u32[4]; } a;
        a.u32[0] = pk2(lo2f(xr.x) + p0.x, hi2f(xr.x) + p0.y); a.u32[1] = pk2(lo2f(xr.y) + p0.z, hi2f(xr.y) + p0.w);
        a.u32[2] = pk2(lo2f(xr.z) + p1.x, hi2f(xr.z) + p1.y); a.u32[3] = pk2(lo2f(xr.w) + p1.z, hi2f(xr.w) + p1.w);
#pragma unroll
        for (int nt = 0; nt < 2; ++nt) {
            const bf16x8 b = *(const bf16x8*)(w1t + (size_t)(w * 32 + nt * 16 + fr) * 4096 + k);
            acc[nt] = mfma16(a.v, b, acc[nt]);
        }
    }
#pragma unroll
    for (int nt = 0; nt < 2; ++nt)
#pragma unroll
        for (int r = 0; r < 4; ++r) hid[(4 * fq + r) * 128 + w * 32 + nt * 16 + fr] = gelu_tanh(acc[nt][r]);
    __syncthreads();
    const float* w2 = p.cmp_w2 + ((size_t)layer * 2 + which) * 128 * 128;
    const int c2 = tid & 127, mh = tid >> 7;
    float o[8];
#pragma unroll
    for (int b = 0; b < 8; ++b) o[b] = 0.f;
#pragma unroll 1
    for (int k0 = 0; k0 < 128; k0 += 32) {
        float wv[32];
#pragma unroll
        for (int k = 0; k < 32; ++k) wv[k] = w2[(k0 + k) * 128 + c2];
#pragma unroll
        for (int k4 = 0; k4 < 8; ++k4)
#pragma unroll
            for (int b = 0; b < 8; ++b) {
                const float4 h4 = *(const float4*)(hid + (mh * 8 + b) * 128 + k0 + k4 * 4);
                o[b] += h4.x * wv[4 * k4] + h4.y * wv[4 * k4 + 1] + h4.z * wv[4 * k4 + 2] + h4.w * wv[4 * k4 + 3];
            }
    }
#pragma unroll
    for (int b = 0; b < 8; ++b) ob[(mh * 8 + b) * 128 + c2] = o[b];
    __syncthreads();
#pragma unroll
    for (int q = 0; q < 4; ++q) {
        const int b = w * 4 + q, nbo = rt * 16 + b;
        float v0 = ob[b * 128 + l], v1 = ob[b * 128 + l + 64];
        if (which == 0) {
            const float r = rsqrtf(wsum(v0 * v0 + v1 * v1) * (1.0f / 128.0f) + EPS);
            const float* kg = p.nsa_kg + (layer * 3 + 0) * 128;
            v0 = v0 * r * kg[l]; v1 = v1 * r * kg[l + 64];
            if (nbo >= 511) { v0 = 0.f; v1 = 0.f; }
            p.KC()[nbo * 128 + l] = f2bf(v0); p.KC()[nbo * 128 + l + 64] = f2bf(v1);
        } else {
            if (nbo >= 511) { v0 = 0.f; v1 = 0.f; }
            p.VCT()[l * 512 + nbo] = f2bf(v0); p.VCT()[(l + 64) * 512 + nbo] = f2bf(v1);
        }
    }
    __syncthreads();
}

DEV void st_nsa_cmp(const P& p, int unit, char* smem) {
    constexpr int RSK = 272, RSV = 136, BUFB = 64 * RSK + 128 * RSV;
    const int tid = tidx(), w = tid >> 6, l = tid & 63, qc = l & 15, g4 = l >> 4;
    const int t0 = unit * 16 + w * 4;
    const int tk = qc >> 2, hd = qc & 3, t = t0 + tk;
    bf16x8 qf[4];
#pragma unroll
    for (int ks = 0; ks < 4; ++ks) qf[ks] = *(const bf16x8*)(p.QN() + ((size_t)t0 * 4 + qc) * 128 + ks * 32 + g4 * 8);
    const int tmaxb = unit * 16 + 15;
    const int nvb = tmaxb >= 31 ? (tmaxb - 31) / 16 + 1 : 0;
    const int nsteps = (nvb + 63) >> 6;
    const int nvis = t >= 31 ? (t - 31) / 16 + 1 : 0;
    const float cs = 0.08838834764831845f * 1.4426950408889634f;
    const int krow = tid >> 4, kc16 = tid & 15, vrow = tid >> 3, vc16 = tid & 7;
    const bf16_t* Kg = p.KC(); const bf16_t* Vg = p.VCT();
    int gstep = 0;
    uint4 rk0, rk1, rk2, rk3, rv0, rv1, rv2, rv3;
#define CMP_LOADK(ST) do { const bf16_t* kb = Kg + (size_t)((ST) * 64 + krow) * 128 + kc16 * 8; \
        rk0 = *(const uint4*)kb; rk1 = *(const uint4*)(kb + 16 * 128); rk2 = *(const uint4*)(kb + 32 * 128); rk3 = *(const uint4*)(kb + 48 * 128); } while (0)
#define CMP_LOADV(ST) do { const bf16_t* vb = Vg + (size_t)vrow * 512 + (ST) * 64 + vc16 * 8; \
        rv0 = *(const uint4*)vb; rv1 = *(const uint4*)(vb + 32 * 512); rv2 = *(const uint4*)(vb + 64 * 512); rv3 = *(const uint4*)(vb + 96 * 512); } while (0)
#define CMP_STOREK(KT) do { *(uint4*)((KT) + krow * RSK + kc16 * 16) = rk0; *(uint4*)((KT) + (krow + 16) * RSK + kc16 * 16) = rk1; \
        *(uint4*)((KT) + (krow + 32) * RSK + kc16 * 16) = rk2; *(uint4*)((KT) + (krow + 48) * RSK + kc16 * 16) = rk3; } while (0)
#define CMP_STOREV(VT) do { *(uint4*)((VT) + vrow * RSV + vc16 * 16) = rv0; *(uint4*)((VT) + (vrow + 32) * RSV + vc16 * 16) = rv1; \
        *(uint4*)((VT) + (vrow + 64) * RSV + vc16 * 16) = rv2; *(uint4*)((VT) + (vrow + 96) * RSV + vc16 * 16) = rv3; } while (0)
    float m = -1e30f, lsum = 0.f;
    if (nsteps > 0) CMP_LOADK(0);
#pragma unroll 1
    for (int st = 0; st < nsteps; ++st, ++gstep) {
        char* Kt = smem + (gstep & 1) * BUFB;
        CMP_STOREK(Kt);
        __syncthreads();
        if (st + 1 < nsteps) CMP_LOADK(st + 1);
        float mx = m; f32x4 sv[4];
#pragma unroll
        for (int sub = 0; sub < 4; ++sub) {
            f32x4 a4 = (f32x4){0.f, 0.f, 0.f, 0.f};
#pragma unroll
            for (int ks = 0; ks < 4; ++ks) a4 = mfma16(*(const bf16x8*)(Kt + (sub * 16 + qc) * RSK + (ks * 32 + g4 * 8) * 2), qf[ks], a4);
#pragma unroll
            for (int r = 0; r < 4; ++r) { const int key = st * 64 + sub * 16 + 4 * g4 + r; a4[r] = (key < nvis) ? a4[r] * cs : -3e38f; mx = fmaxf(mx, a4[r]); }
            sv[sub] = a4;
        }
        float ps = 0.f;
#pragma unroll
        for (int sub = 0; sub < 4; ++sub)
#pragma unroll
            for (int r = 0; r < 4; ++r) ps += __builtin_amdgcn_exp2f(sv[sub][r] - mx);
        lsum = lsum * __builtin_amdgcn_exp2f(m - mx) + ps; m = mx;
    }
    {
        float mt_ = fmaxf(m, __shfl_xor(m, 16)); mt_ = fmaxf(mt_, __shfl_xor(mt_, 32));
        lsum *= __builtin_amdgcn_exp2f(m - mt_); m = mt_;
        lsum += __shfl_xor(lsum, 16); lsum += __shfl_xor(lsum, 32);
    }
    const float inv = (nvis > 0 && lsum > 0.f) ? 1.0f / lsum : 0.f;
    f32x4 o[8];
#pragma unroll
    for (int mt = 0; mt < 8; ++mt) o[mt] = (f32x4){0.f, 0.f, 0.f, 0.f};
    float yprev = 0.f;
    float impv[32];
#pragma unroll
    for (int i = 0; i < 32; ++i) impv[i] = 0.f;
    if (nsteps > 0) { CMP_LOADK(0); CMP_LOADV(0); }
#pragma unroll
    for (int st = 0; st < 8; ++st) {
        if (st < nsteps) {
            char* Kt = smem + (gstep & 1) * BUFB; char* Vt = Kt + 64 * RSK; ++gstep;
            CMP_STOREK(Kt); CMP_STOREV(Vt);
            __syncthreads();
            if (st + 1 < nsteps) { CMP_LOADK(st + 1); CMP_LOADV(st + 1); }
            f32x4 sv[4];
#pragma unroll
            for (int sub = 0; sub < 4; ++sub) {
                f32x4 a4 = (f32x4){0.f, 0.f, 0.f, 0.f};
#pragma unroll
                for (int ks = 0; ks < 4; ++ks) a4 = mfma16(*(const bf16x8*)(Kt + (sub * 16 + qc) * RSK + (ks * 32 + g4 * 8) * 2), qf[ks], a4);
#pragma unroll
                for (int r = 0; r < 4; ++r) { const int key = st * 64 + sub * 16 + 4 * g4 + r; a4[r] = (key < nvis) ? __builtin_amdgcn_exp2f(a4[r] * cs - m) * inv : 0.f; }
                const float y = __shfl(a4[3], (l + 48) & 63);
                float iv = (a4[0] + a4[1]) + (a4[2] + a4[3]) + (g4 > 0 ? y : yprev);
                yprev = y;
                iv += __shfl_xor(iv, 1); iv += __shfl_xor(iv, 2);
                impv[st * 4 + sub] = iv;
                sv[sub] = a4;
            }
#pragma unroll
            for (int pr = 0; pr < 2; ++pr) {
                union { bf16x8 v; unsigned u32[4]; } bb;
                bb.u32[0] = pk2(sv[2 * pr][0], sv[2 * pr][1]); bb.u32[1] = pk2(sv[2 * pr][2], sv[2 * pr][3]);
                bb.u32[2] = pk2(sv[2 * pr + 1][0], sv[2 * pr + 1][1]); bb.u32[3] = pk2(sv[2 * pr + 1][2], sv[2 * pr + 1][3]);
#pragma unroll
                for (int mt = 0; mt < 8; ++mt) {
                    const char* vp = Vt + (mt * 16 + qc) * RSV + (pr * 32 + 4 * g4) * 2;
                    union { bf16x8 v; uint2 h2[2]; } aa;
                    aa.h2[0] = *(const uint2*)vp; aa.h2[1] = *(const uint2*)(vp + 32);
                    o[mt] = mfma16(aa.v, bb.v, o[mt]);
                }
            }
        }
    }
#undef CMP_LOADK
#undef CMP_LOADV
#undef CMP_STOREK
#undef CMP_STOREV
    __syncthreads();
    float* impl = (float*)smem + w * 512;
    if (hd == 0) {
#pragma unroll
        for (int i = 0; i < 32; ++i) impl[tk * 128 + 4 * i + g4] = impv[i];
    }
#pragma unroll
    for (int mt = 0; mt < 8; ++mt) {
        uint2 ov; ov.x = pk2(o[mt][0], o[mt][1]); ov.y = pk2(o[mt][2], o[mt][3]);
        *(uint2*)(p.OCMP() + ((size_t)t * 4 + hd) * 128 + mt * 16 + 4 * g4) = ov;
    }
    __syncthreads();
    const int li = hd + 4 * g4, cur = t >> 6;
    unsigned long long own[8]; int rank[8];
#pragma unroll
    for (int i = 0; i < 8; ++i) {
        const int j = li + 16 * i; const float v = impl[tk * 128 + j];
        const unsigned k32 = (j == 0 || j == cur || j == cur - 1) ? 0xFFFFFFFFu : (j > cur ? 0u : __float_as_uint(v) + 128u);
        own[i] = ((unsigned long long)k32 << 7) | (unsigned)(127 - j); rank[i] = 0;
    }
#pragma unroll 1
    for (int ip = 0; ip < 8; ++ip) {
#pragma unroll
        for (int q4 = 0; q4 < 4; ++q4) {
            const float4 ov = *(const float4*)(impl + tk * 128 + ip * 16 + q4 * 4);
            const float o4[4] = {ov.x, ov.y, ov.z, ov.w};
#pragma unroll
            for (int e = 0; e < 4; ++e) {
                const int jp = ip * 16 + q4 * 4 + e;
                const unsigned k32 = (jp == 0 || jp == cur || jp == cur - 1) ? 0xFFFFFFFFu : (jp > cur ? 0u : __float_as_uint(o4[e]) + 128u);
                const unsigned long long kp = ((unsigned long long)k32 << 7) | (unsigned)(127 - jp);
#pragma unroll
                for (int i = 0; i < 8; ++i) rank[i] += (kp > own[i]) ? 1 : 0;
            }
        }
    }
    unsigned mw[4] = {0u, 0u, 0u, 0u};
#pragma unroll
    for (int i = 0; i < 8; ++i) if (rank[i] < 16) mw[i >> 1] |= 1u << (li + 16 * (i & 1));
#pragma unroll
    for (int q = 0; q < 4; ++q) {
        unsigned v = mw[q];
        v |= __shfl_xor(v, 1); v |= __shfl_xor(v, 2); v |= __shfl_xor(v, 16); v |= __shfl_xor(v, 32);
        mw[q] = v;
    }
    if (li == 0) *(uint4*)(p.SEL() + (size_t)t * 4) = make_uint4(mw[0], mw[1], mw[2], mw[3]);
    __syncthreads();
}

DEV void st_nsa_attn(const P& p, int unit, char* smem) {
    constexpr int RSK = 272, RSV = 136, BUFB = 64 * RSK + 128 * RSV;
    const int tid = tidx(), w = tid >> 6, l = tid & 63, qc = l & 15, g4 = l >> 4;
    const int tq0 = unit * 16, t = tq0 + w * 4 + (qc >> 2), hd = qc & 3;
    bf16x8 qf[4];
#pragma unroll
    for (int ks = 0; ks < 4; ++ks) qf[ks] = *(const bf16x8*)(p.QR() + ((size_t)t * 4 + hd) * 128 + ks * 32 + g4 * 8);
    const uint4 selw = *(const uint4*)(p.SEL() + (size_t)t * 4);
    const float cs = 0.08838834764831845f * 1.4426950408889634f;
    unsigned part[8][2];
#pragma unroll
    for (int mt = 0; mt < 8; ++mt) { part[mt][0] = 0u; part[mt][1] = 0u; }
    const float g0 = p.GATES()[(size_t)t * 12 + hd * 3];
    int gstep = 0;
    const int krow = tid >> 4, kc16 = tid & 15, vrow = tid >> 3, vc16 = tid & 7;
#pragma unroll 1
    for (int br = 0; br < 2; ++br) {
        const bf16_t* Kg = br ? p.KW() : p.KS(); const bf16_t* Vg = br ? p.VWT() : p.VST();
        const int ktlast = (tq0 + 15) >> 6;
        const int ktfirst = br ? ((tq0 - 511 > 0 ? tq0 - 511 : 0) >> 6) : 0;
        const int nk = ktlast - ktfirst + 1;
        f32x4 o[8];
#pragma unroll
        for (int mt = 0; mt < 8; ++mt) o[mt] = (f32x4){0.f, 0.f, 0.f, 0.f};
        float m = -1e30f, lsum = 0.f;
        uint4 rk0, rk1, rk2, rk3, rv0, rv1, rv2, rv3;
#define NSA_LOAD(KT) do { const bf16_t* kb = Kg + (size_t)((KT) * 64 + krow) * 128 + kc16 * 8; const bf16_t* vb = Vg + (size_t)vrow * T + (KT) * 64 + vc16 * 8; \
        rk0 = *(const uint4*)kb; rk1 = *(const uint4*)(kb + 16 * 128); rk2 = *(const uint4*)(kb + 32 * 128); rk3 = *(const uint4*)(kb + 48 * 128); \
        rv0 = *(const uint4*)vb; rv1 = *(const uint4*)(vb + (size_t)32 * T); rv2 = *(const uint4*)(vb + (size_t)64 * T); rv3 = *(const uint4*)(vb + (size_t)96 * T); } while (0)
        NSA_LOAD(ktfirst);
#pragma unroll 1
        for (int i = 0; i < nk; ++i, ++gstep) {
            const int kt = ktfirst + i;
            char* Kt = smem + (gstep & 1) * BUFB; char* Vt = Kt + 64 * RSK;
            *(uint4*)(Kt + krow * RSK + kc16 * 16) = rk0; *(uint4*)(Kt + (krow + 16) * RSK + kc16 * 16) = rk1;
            *(uint4*)(Kt + (krow + 32) * RSK + kc16 * 16) = rk2; *(uint4*)(Kt + (krow + 48) * RSK + kc16 * 16) = rk3;
            *(uint4*)(Vt + vrow * RSV + vc16 * 16) = rv0; *(uint4*)(Vt + (vrow + 32) * RSV + vc16 * 16) = rv1;
            *(uint4*)(Vt + (vrow + 64) * RSV + vc16 * 16) = rv2; *(uint4*)(Vt + (vrow + 96) * RSV + vc16 * 16) = rv3;
            __syncthreads();
            if (i + 1 < nk) NSA_LOAD(kt + 1);
            int lo, hi = t;
            if (br == 0) {
                const unsigned wv = (kt & 64) ? ((kt & 32) ? selw.w : selw.z) : ((kt & 32) ? selw.y : selw.x);
                lo = 0; hi = ((wv >> (kt & 31)) & 1u) ? t : -1;
            } else lo = t - 511;
            const bool interior = (kt * 64 + 63 <= tq0) && (br == 0 || kt * 64 >= tq0 + 15 - 511);
            f32x4 sv[4];
            float mx = -3e38f;
            if (interior) {
                const float csl = hi >= 0 ? cs : 0.f, add = hi >= 0 ? 0.f : -3e38f;
#pragma unroll
                for (int sub = 0; sub < 4; ++sub) {
                    f32x4 a4 = (f32x4){0.f, 0.f, 0.f, 0.f};
#pragma unroll
                    for (int ks = 0; ks < 4; ++ks) a4 = mfma16(*(const bf16x8*)(Kt + (sub * 16 + qc) * RSK + (ks * 32 + g4 * 8) * 2), qf[ks], a4);
#pragma unroll
                    for (int r = 0; r < 4; ++r) { a4[r] = a4[r] * csl + add; mx = fmaxf(mx, a4[r]); }
                    sv[sub] = a4;
                }
            } else {
#pragma unroll
                for (int sub = 0; sub < 4; ++sub) {
                    f32x4 a4 = (f32x4){0.f, 0.f, 0.f, 0.f};
#pragma unroll
                    for (int ks = 0; ks < 4; ++ks) a4 = mfma16(*(const bf16x8*)(Kt + (sub * 16 + qc) * RSK + (ks * 32 + g4 * 8) * 2), qf[ks], a4);
#pragma unroll
                    for (int r = 0; r < 4; ++r) {
                        const int kp = kt * 64 + sub * 16 + 4 * g4 + r;
                        const bool valid = (kp >= lo) & (kp <= hi);
                        a4[r] = valid ? a4[r] * cs : -3e38f;
                        mx = fmaxf(mx, a4[r]);
                    }
                    sv[sub] = a4;
                }
            }
            mx = fmaxf(mx, __shfl_xor(mx, 16)); mx = fmaxf(mx, __shfl_xor(mx, 32));
            const float mnew = fmaxf(fmaxf(m, mx), -1e30f);
            const float alpha = __builtin_amdgcn_exp2f(m - mnew);
            m = mnew;
            float ps = 0.f;
#pragma unroll
            for (int sub = 0; sub < 4; ++sub)
#pragma unroll
                for (int r = 0; r < 4; ++r) { const float pv = __builtin_amdgcn_exp2f(sv[sub][r] - mnew); sv[sub][r] = pv; ps += pv; }
            lsum = lsum * alpha + ps;
            if (__any(alpha != 1.0f)) {
#pragma unroll
                for (int mt = 0; mt < 8; ++mt) o[mt] *= alpha;
            }
#pragma unroll
            for (int pr = 0; pr < 2; ++pr) {
                union { bf16x8 v; unsigned u32[4]; } bb;
                bb.u32[0] = pk2(sv[2 * pr][0], sv[2 * pr][1]); bb.u32[1] = pk2(sv[2 * pr][2], sv[2 * pr][3]);
                bb.u32[2] = pk2(sv[2 * pr + 1][0], sv[2 * pr + 1][1]); bb.u32[3] = pk2(sv[2 * pr + 1][2], sv[2 * pr + 1][3]);
#pragma unroll
                for (int mt = 0; mt < 8; ++mt) {
                    const char* vp = Vt + (mt * 16 + qc) * RSV + (pr * 32 + 4 * g4) * 2;
                    union { bf16x8 v; uint2 h2[2]; } aa;
                    aa.h2[0] = *(const uint2*)vp; aa.h2[1] = *(const uint2*)(vp + 32);
                    o[mt] = mfma16(aa.v, bb.v, o[mt]);
                }
            }
        }
#undef NSA_LOAD
        lsum += __shfl_xor(lsum, 16); lsum += __shfl_xor(lsum, 32);
        const float gate = p.GATES()[(size_t)t * 12 + hd * 3 + 1 + br];
        const float sc = lsum > 0.f ? gate / lsum : 0.f;
        if (br == 0) {
#pragma unroll
            for (int mt = 0; mt < 8; ++mt) {
                const uint2 oc = *(const uint2*)(p.OCMP() + ((size_t)t * 4 + hd) * 128 + mt * 16 + 4 * g4);
                part[mt][0] = pk2(sc * o[mt][0] + g0 * lo2f(oc.x), sc * o[mt][1] + g0 * hi2f(oc.x));
                part[mt][1] = pk2(sc * o[mt][2] + g0 * lo2f(oc.y), sc * o[mt][3] + g0 * hi2f(oc.y));
            }
        } else {
#pragma unroll
            for (int mt = 0; mt < 8; ++mt) {
                uint2 ov;
                ov.x = pk2(sc * o[mt][0] + lo2f(part[mt][0]), sc * o[mt][1] + hi2f(part[mt][0]));
                ov.y = pk2(sc * o[mt][2] + lo2f(part[mt][1]), sc * o[mt][3] + hi2f(part[mt][1]));
                *(uint2*)(p.Y() + (size_t)t * D + 1024 + hd * 128 + mt * 16 + 4 * g4) = ov;
            }
        }
    }
    __syncthreads();
}

DEV unsigned f2key(float f) { const unsigned u = __float_as_uint(f); return (u & 0x80000000u) ? ~u : (u | 0x80000000u); }
DEV float key2f(unsigned k) { const unsigned u = (k & 0x80000000u) ? (k & 0x7fffffffu) : ~k; return __uint_as_float(u); }
DEV float wave_prune(float* sc, unsigned short* ix, unsigned* hist, int m, int l) {
    float v[8]; unsigned k[8]; unsigned short id[8]; bool ok[8];
#pragma unroll
    for (int i = 0; i < 8; ++i) {
        const int e = l + 64 * i; ok[i] = e < m;
        v[i] = ok[i] ? sc[e] : 0.f; id[i] = ok[i] ? ix[e] : (unsigned short)0; k[i] = f2key(v[i]);
    }
    unsigned prefix = 0u; int need = 256;
#pragma unroll 1
    for (int pass = 0; pass < 4; ++pass) {
        const int shift = 24 - 8 * pass;
        *(uint4*)(hist + 4 * l) = make_uint4(0u, 0u, 0u, 0u);
        __builtin_amdgcn_wave_barrier();
#pragma unroll
        for (int i = 0; i < 8; ++i) {
            const bool in = ok[i] && (pass == 0 || (k[i] >> (shift + 8)) == prefix);
            if (in) atomicAdd(&hist[(k[i] >> shift) & 255u], 1u);
        }
        __builtin_amdgcn_wave_barrier();
        const uint4 hv = *(const uint4*)(hist + 4 * l);
        const unsigned hq[4] = {hv.x, hv.y, hv.z, hv.w};
        const unsigned own = hv.x + hv.y + hv.z + hv.w;
        unsigned tot = own;
#pragma unroll
        for (int o = 1; o < 64; o <<= 1) { const unsigned tv = __shfl_down(tot, o); if (l + o < 64) tot += tv; }
        unsigned cum = tot - own; int found = -1; int nneed = 0;
#pragma unroll
        for (int kk = 3; kk >= 0; --kk) {
            const unsigned c = hq[kk];
            if (found < 0 && (int)cum < need && (int)(cum + c) >= need) { found = 4 * l + kk; nneed = need - (int)cum; }
            cum += c;
        }
        const unsigned long long bal = __ballot(found >= 0);
        const int src = __ffsll((long long)bal) - 1;
        const int digit = __shfl(found, src); need = __shfl(nneed, src);
        prefix = (prefix << 8) | (unsigned)digit;
    }
    const unsigned thr = prefix;
    int base = 0, ties = 0;
    const unsigned long long ltmask = (1ull << l) - 1ull;
#pragma unroll
    for (int i = 0; i < 8; ++i) {
        const bool gt = ok[i] && k[i] > thr, eq = ok[i] && k[i] == thr;
        const unsigned long long em = __ballot(eq);
        const int trank = ties + __popcll(em & ltmask);
        const bool keep = gt || (eq && trank < need);
        ties += __popcll(em);
        const unsigned long long km = __ballot(keep);
        const int pos = base + __popcll(km & ltmask);
        if (keep) { sc[pos] = v[i]; ix[pos] = id[i]; }
        base += __popcll(km);
    }
    __builtin_amdgcn_wave_barrier();
    return key2f(thr);
}

#define DSA_APPEND2(COND, M64, SV, SCP, IXP, CL, CH) do { \
    const unsigned _ml = (unsigned)(M64), _mh = (unsigned)((M64) >> 32); \
    if (COND) { const int _pos = (h ? (CH) : (CL)) + __popc((h ? _mh : _ml) & ((1u << n) - 1u)); (SCP)[_pos] = (SV); (IXP)[_pos] = (unsigned short)kp; } \
    (CL) += __popc(_ml); (CH) += __popc(_mh); } while (0)
#define DSA_APPEND(SCP, IXP, CNT, M32, MINE, SV) do { \
    const unsigned _m = (M32); \
    if (MINE) { const int _pos = (CNT) + __popc(_m & ((1u << n) - 1u)); (SCP)[_pos] = (SV); (IXP)[_pos] = (unsigned short)kp; } \
    (CNT) += __popc(_m); } while (0)

DEV void st_dsa_index(const P& p, int unit, char* smem) {
    const int tid = tidx(), w = tid >> 6, l = tid & 63, n = l & 31, h = l >> 5;
    char* wb = smem + w * 14336;
    float* sc0 = (float*)wb; float* sc1 = sc0 + 512; float* sc2 = sc1 + 512; float* sc3 = sc2 + 512;
    unsigned short* ix0 = (unsigned short*)(wb + 8192); unsigned short* ix1 = ix0 + 512; unsigned short* ix2 = ix1 + 512; unsigned short* ix3 = ix2 + 512;
    unsigned* hist = (unsigned*)(wb + 12288);
    float* scA = h ? sc2 : sc0; float* scB = h ? sc3 : sc1; unsigned short* ixA = h ? ix2 : ix0; unsigned short* ixB = h ? ix3 : ix1;
    const int wu = unit * 4 + w;
    const int tg = 2047 - wu;
    const int t0 = tg * 4;
    const int tl = 2 * ((n >> 2) & 1) + (n >> 4), hdr = (n & 3) + 4 * ((n >> 3) & 1);
    bf16x8 af[4];
#pragma unroll
    for (int s = 0; s < 4; ++s) af[s] = *(const bf16x8*)(p.IQ() + ((size_t)(t0 + tl) * 8 + hdr) * 64 + 16 * s + 8 * h);
    const int tA = t0 + 2 * h, tB = tA + 1;
    float wA[8], wB[8];
#pragma unroll
    for (int r = 0; r < 8; ++r) { wA[r] = p.IW()[(size_t)tA * 8 + r]; wB[r] = p.IW()[(size_t)tB * 8 + r]; }
    int cnt0 = 0, cnt1 = 0, cnt2 = 0, cnt3 = 0;
    const float NINF = -__builtin_inff();
    float tau0 = NINF, tau1 = NINF, tau2 = NINF, tau3 = NINF;
    const int ntiles = (t0 + 3) / 32 + 1;
    const bf16_t* ikp = p.IK() + (size_t)n * 64 + 8 * h;
    bf16x8 na[4], nb[4];
#pragma unroll
    for (int s = 0; s < 4; ++s) { na[s] = *(const bf16x8*)(ikp + 16 * s); nb[s] = *(const bf16x8*)(ikp + (size_t)(ntiles > 1 ? 32 : 0) * 64 + 16 * s); }
#pragma unroll 1
    for (int kt = 0; kt < ntiles; kt += 2) {
        bf16x8 ca[4], cb[4];
#pragma unroll
        for (int s = 0; s < 4; ++s) { ca[s] = na[s]; cb[s] = nb[s]; }
        {
            const int ka = kt + 2 < ntiles ? kt + 2 : ntiles - 1, kb = kt + 3 < ntiles ? kt + 3 : ntiles - 1;
#pragma unroll
            for (int s = 0; s < 4; ++s) { na[s] = *(const bf16x8*)(ikp + (size_t)ka * 32 * 64 + 16 * s); nb[s] = *(const bf16x8*)(ikp + (size_t)kb * 32 * 64 + 16 * s); }
        }
        f32x16 acca, accb;
#pragma unroll
        for (int r = 0; r < 16; ++r) { acca[r] = 0.f; accb[r] = 0.f; }
#pragma unroll
        for (int s = 0; s < 4; ++s) { acca = mfma32(af[s], ca[s], acca); accb = mfma32(af[s], cb[s], accb); }
        float s0a = 0.f, s1a = 0.f, s0b = 0.f, s1b = 0.f, u0a = 0.f, u1a = 0.f, u0b = 0.f, u1b = 0.f;
#pragma unroll
        for (int r = 0; r < 4; ++r) {
            s0a += wA[r] * fmaxf(acca[r], 0.f); u0a += wA[4 + r] * fmaxf(acca[4 + r], 0.f);
            s1a += wB[r] * fmaxf(acca[8 + r], 0.f); u1a += wB[4 + r] * fmaxf(acca[12 + r], 0.f);
            s0b += wA[r] * fmaxf(accb[r], 0.f); u0b += wA[4 + r] * fmaxf(accb[4 + r], 0.f);
            s1b += wB[r] * fmaxf(accb[8 + r], 0.f); u1b += wB[4 + r] * fmaxf(accb[12 + r], 0.f);
        }
        s0a += u0a; s1a += u1a; s0b += u0b; s1b += u1b;
        const float tauA = h ? tau2 : tau0, tauB = h ? tau3 : tau1;
        {
            const int kp = kt * 32 + n;
            const bool cA = (kp <= tA) && (s0a > tauA), cB = (kp <= tB) && (s1a > tauB);
            const unsigned long long mA = __ballot(cA), mB = __ballot(cB);
            DSA_APPEND2(cA, mA, s0a, scA, ixA, cnt0, cnt2); DSA_APPEND2(cB, mB, s1a, scB, ixB, cnt1, cnt3);
        }
        {
            const int kp = kt * 32 + 32 + n;
            const bool cA = (kp <= tA) && (s0b > tauA), cB = (kp <= tB) && (s1b > tauB);
            const unsigned long long mA = __ballot(cA), mB = __ballot(cB);
            DSA_APPEND2(cA, mA, s0b, scA, ixA, cnt0, cnt2); DSA_APPEND2(cB, mB, s1b, scB, ixB, cnt1, cnt3);
        }
        __builtin_amdgcn_wave_barrier();
        if (max(max(cnt0, cnt1), max(cnt2, cnt3)) > 448) {
            if (cnt0 > 448) { tau0 = wave_prune(sc0, ix0, hist, cnt0, l); cnt0 = 256; }
            if (cnt1 > 448) { tau1 = wave_prune(sc1, ix1, hist, cnt1, l); cnt1 = 256; }
            if (cnt2 > 448) { tau2 = wave_prune(sc2, ix2, hist, cnt2, l); cnt2 = 256; }
            if (cnt3 > 448) { tau3 = wave_prune(sc3, ix3, hist, cnt3, l); cnt3 = 256; }
        }
    }
    if (cnt0 > 256) { wave_prune(sc0, ix0, hist, cnt0, l); cnt0 = 256; }
    if (cnt1 > 256) { wave_prune(sc1, ix1, hist, cnt1, l); cnt1 = 256; }
    if (cnt2 > 256) { wave_prune(sc2, ix2, hist, cnt2, l); cnt2 = 256; }
    if (cnt3 > 256) { wave_prune(sc3, ix3, hist, cnt3, l); cnt3 = 256; }
    __builtin_amdgcn_wave_barrier();
#pragma unroll
    for (int i = 0; i < 4; ++i) {
        const int e = l + 64 * i;
        p.IDX()[(size_t)(t0 + 0) * 256 + e] = e < cnt0 ? (int)ix0[e] : 0;
        p.IDX()[(size_t)(t0 + 1) * 256 + e] = e < cnt1 ? (int)ix1[e] : 0;
        p.IDX()[(size_t)(t0 + 2) * 256 + e] = e < cnt2 ? (int)ix2[e] : 0;
        p.IDX()[(size_t)(t0 + 3) * 256 + e] = e < cnt3 ? (int)ix3[e] : 0;
    }
    if (l == 0) { p.CNT()[t0] = cnt0; p.CNT()[t0 + 1] = cnt1; p.CNT()[t0 + 2] = cnt2; p.CNT()[t0 + 3] = cnt3; }
}

DEV void st_dsa_attn(const P& p, int unit, char* smem) {
    const int tid = tidx(), w = tid >> 6, l = tid & 63, c = l & 15, g4 = l >> 4;
    int* idxs = (int*)(smem + w * 5120); float* Pl = (float*)(smem + w * 5120 + 1024);
    const size_t t = (size_t)unit * 4 + w;
    const int cnt = p.CNT()[t];
#pragma unroll
    for (int i = 0; i < 4; ++i) idxs[l + 64 * i] = p.IDX()[t * 256 + l + 64 * i];
    __builtin_amdgcn_wave_barrier();
    bf16x8 qf[4];
#pragma unroll
    for (int j = 0; j < 4; ++j) qf[j] = *(const bf16x8*)(p.DQ() + (t * 4 + (c & 3)) * 128 + g4 * 32 + j * 8);
    f32x4 s[16];
    const int ntile = (cnt + 15) >> 4;
#pragma unroll
    for (int th = 0; th < 2; ++th) {
        bf16x8 kf[8][4];
        if (th * 8 < ntile) {
#pragma unroll
            for (int q = 0; q < 8; ++q) {
                const int krow = idxs[(th * 8 + q) * 16 + c];
                const bf16_t* kp = p.DK() + (size_t)krow * 128 + g4 * 32;
#pragma unroll
                for (int j = 0; j < 4; ++j) kf[q][j] = *(const bf16x8*)(kp + j * 8);
            }
        }
#pragma unroll
        for (int q = 0; q < 8; ++q) {
            s[th * 8 + q] = (f32x4){0.f, 0.f, 0.f, 0.f};
            if (th * 8 < ntile) {
#pragma unroll
                for (int j = 0; j < 4; ++j) s[th * 8 + q] = mfma16(kf[q][j], qf[j], s[th * 8 + q]);
            }
        }
        __builtin_amdgcn_sched_barrier(0);
    }
    const float cs = 0.08838834764831845f * 1.4426950408889634f;
    float mx = -1e30f;
#pragma unroll
    for (int tt = 0; tt < 16; ++tt)
#pragma unroll
        for (int r = 0; r < 4; ++r) { const int slot = tt * 16 + 4 * g4 + r; if (slot < cnt) mx = fmaxf(mx, s[tt][r] * cs); }
    mx = fmaxf(mx, __shfl_xor(mx, 16)); mx = fmaxf(mx, __shfl_xor(mx, 32));
    float sum = 0.f;
#pragma unroll
    for (int tt = 0; tt < 16; ++tt)
#pragma unroll
        for (int r = 0; r < 4; ++r) { const int slot = tt * 16 + 4 * g4 + r; const float pv = slot < cnt ? exp2f(s[tt][r] * cs - mx) : 0.f; s[tt][r] = pv; sum += pv; }
    sum += __shfl_xor(sum, 16); sum += __shfl_xor(sum, 32);
    const float inv = sum > 0.f ? 1.0f / sum : 0.f;
    if (c < 4) {
#pragma unroll
        for (int tt = 0; tt < 16; ++tt)
#pragma unroll
            for (int r = 0; r < 4; ++r) Pl[(tt * 16 + 4 * g4 + r) * 4 + c] = s[tt][r] * inv;
    }
    __builtin_amdgcn_wave_barrier();
    float acc[4][8];
#pragma unroll
    for (int hh = 0; hh < 4; ++hh)
#pragma unroll
        for (int j = 0; j < 8; ++j) acc[hh][j] = 0.f;
    const int nk64 = (cnt + 63) >> 6;
#pragma unroll 1
    for (int kb = 0; kb < nk64; ++kb) {
        uint4 raw[16];
#pragma unroll
        for (int q = 0; q < 16; ++q) raw[q] = *(const uint4*)(p.DVC() + (size_t)idxs[(kb * 16 + q) * 4 + g4] * 128 + c * 8);
#pragma unroll
        for (int q = 0; q < 16; ++q) {
            const float4 p4 = *(const float4*)(Pl + ((kb * 16 + q) * 4 + g4) * 4);
            const float vv[8] = {lo2f(raw[q].x), hi2f(raw[q].x), lo2f(raw[q].y), hi2f(raw[q].y), lo2f(raw[q].z), hi2f(raw[q].z), lo2f(raw[q].w), hi2f(raw[q].w)};
            const float pp[4] = {p4.x, p4.y, p4.z, p4.w};
#pragma unroll
            for (int hh = 0; hh < 4; ++hh)
#pragma unroll
                for (int j = 0; j < 8; ++j) acc[hh][j] += pp[hh] * vv[j];
        }
    }
#pragma unroll
    for (int hh = 0; hh < 4; ++hh)
#pragma unroll
        for (int j = 0; j < 8; ++j) { float a = acc[hh][j]; a += __shfl_xor(a, 16); a += __shfl_xor(a, 32); acc[hh][j] = a; }
    if (g4 == 0) {
#pragma unroll
        for (int hh = 0; hh < 4; ++hh) {
            uint4 o; o.x = pk2(acc[hh][0], acc[hh][1]); o.y = pk2(acc[hh][2], acc[hh][3]); o.z = pk2(acc[hh][4], acc[hh][5]); o.w = pk2(acc[hh][6], acc[hh][7]);
            *(uint4*)(p.Y() + t * D + 1536 + hh * 128 + c * 8) = o;
        }
    }
    __builtin_amdgcn_wave_barrier();
}

DEV void ins16(unsigned (&top)[16], unsigned x) {
#pragma unroll
    for (int j = 0; j < 16; ++j) { const unsigned hi = max(top[j], x); x = min(top[j], x); top[j] = hi; }
}
DEV void st_peer_topk(const P& p, int layer, int unit, char* smem) {
    const int tid = tidx(), w = tid >> 6, l = tid & 63, n = l & 31, hf = l >> 5;
    const int head = unit & 7, tg = (unit >> 3) * 4 + w;
    const size_t t = (size_t)tg * 32 + n;
    unsigned* il = (unsigned*)smem + w * 1024;
    unsigned top[2][16];
#pragma unroll
    for (int pp = 0; pp < 2; ++pp) {
        float qv[32];
#pragma unroll
        for (int i = 0; i < 8; ++i) { const float4 v = *(const float4*)(p.PQ() + t * 1024 + head * 128 + pp * 64 + hf * 32 + i * 4); qv[4 * i] = v.x; qv[4 * i + 1] = v.y; qv[4 * i + 2] = v.z; qv[4 * i + 3] = v.w; }
        const float* K = p.peer_sk + ((((size_t)layer * 8 + head) * 2 + pp) * 128) * 64;
#pragma unroll
        for (int j = 0; j < 16; ++j) top[pp][j] = 0u;
        float kn[32];
        {
            const float* kr = K + (size_t)n * 64 + hf * 32;
#pragma unroll
            for (int i = 0; i < 8; ++i) { const float4 v = *(const float4*)(kr + i * 4); kn[4 * i] = v.x; kn[4 * i + 1] = v.y; kn[4 * i + 2] = v.z; kn[4 * i + 3] = v.w; }
        }
#pragma unroll 1
        for (int tile = 0; tile < 4; ++tile) {
            float kv[32];
#pragma unroll
            for (int i = 0; i < 32; ++i) kv[i] = kn[i];
            if (tile < 3) {
                const float* kr = K + (size_t)((tile + 1) * 32 + n) * 64 + hf * 32;
#pragma unroll
                for (int i = 0; i < 8; ++i) { const float4 v = *(const float4*)(kr + i * 4); kn[4 * i] = v.x; kn[4 * i + 1] = v.y; kn[4 * i + 2] = v.z; kn[4 * i + 3] = v.w; }
            }
            f32x16 acc;
#pragma unroll
            for (int r = 0; r < 16; ++r) acc[r] = 0.f;
#pragma unroll
            for (int kk = 0; kk < 32; ++kk) acc = __builtin_amdgcn_mfma_f32_32x32x2f32(kv[kk], qv[kk], acc, 0, 0, 0);
#pragma unroll
            for (int r = 0; r < 16; ++r) {
                const int nn = tile * 32 + (r & 3) + 8 * (r >> 2) + 4 * hf;
                ins16(top[pp], (f2key(acc[r]) & ~127u) | (unsigned)(127 - nn));
            }
        }
        unsigned oth[16];
#pragma unroll
        for (int j = 0; j < 16; ++j) oth[j] = __shfl_xor(top[pp][j], 32);
#pragma unroll
        for (int j = 0; j < 16; ++j) ins16(top[pp], oth[j]);
        if (hf == 0) {
#pragma unroll
            for (int j = 0; j < 16; ++j) il[(pp * 16 + j) * 32 + n] = 127u - (top[pp][j] & 127u);
        }
    }
    __builtin_amdgcn_wave_barrier();
    if (hf == 0) {
        float v1[16], v2[16];
#pragma unroll
        for (int j = 0; j < 16; ++j) { v1[j] = key2f(top[0][j] & ~127u); v2[j] = key2f(top[1][j] & ~127u); }
        unsigned ct[16];
#pragma unroll
        for (int s = 0; s < 16; ++s) ct[s] = 0u;
#pragma unroll
        for (int i = 0; i < 16; ++i)
#pragma unroll
            for (int j = 0; j < 16; ++j)
                if ((i + 1) * (j + 1) <= 16) ins16(ct, (f2key(v1[i] + v2[j]) & ~255u) | (unsigned)(255 - (i * 16 + j)));
        float ex[16], sum = 0.f; int ce[16];
        const float c0 = key2f(ct[0] & ~255u);
#pragma unroll
        for (int s = 0; s < 16; ++s) {
            const unsigned code = 255u - (ct[s] & 255u);
            ce[s] = (int)(il[(code >> 4) * 32 + n] * 128u + il[(16 + (code & 15u)) * 32 + n]);
            ex[s] = __expf(key2f(ct[s] & ~255u) - c0); sum += ex[s];
        }
        const float inv = 1.0f / sum;
#pragma unroll
        for (int s4 = 0; s4 < 4; ++s4) {
            *(int4*)(p.PE() + t * 128 + head * 16 + s4 * 4) = make_int4(ce[4 * s4], ce[4 * s4 + 1], ce[4 * s4 + 2], ce[4 * s4 + 3]);
            *(float4*)(p.PG() + t * 128 + head * 16 + s4 * 4) = make_float4(ex[4 * s4] * inv, ex[4 * s4 + 1] * inv, ex[4 * s4 + 2] * inv, ex[4 * s4 + 3] * inv);
        }
    }
    __builtin_amdgcn_wave_barrier();
}

DEV void st_peer_gather(const P& p, int layer, const float* __restrict__ xin, float* __restrict__ xout, int unit, char* smem) {
    const int tid_ = tidx(); const int w = tid_ >> 6, l = tid_ & 63; const size_t t = (size_t)unit * 4 + w;
    float* row = (float*)smem + w * 2112;
    const int* pip = p.PI();
    const float ic6 = __int_as_float(__builtin_amdgcn_readfirstlane(pip[32]));
    {
#pragma unroll
        for (int i = 0; i < 4; ++i) {
            const uint4 hv = *(const uint4*)(p.HN() + t * D + i * 512 + l * 8);
            const unsigned u4[4] = {hv.x, hv.y, hv.z, hv.w};
            const int c = i * 512 + l * 8;
#pragma unroll
            for (int q = 0; q < 4; ++q) { row[((c + 2 * q) >> 5) * 33 + ((c + 2 * q) & 31)] = lo2f(u4[q]); row[((c + 2 * q + 1) >> 5) * 33 + ((c + 2 * q + 1) & 31)] = hi2f(u4[q]); }
        }
        __builtin_amdgcn_wave_barrier();
    }
    unsigned hp[16];
#pragma unroll
    for (int j = 0; j < 16; ++j)
        hp[j] = (__float_as_uint(row[l * 33 + __builtin_amdgcn_readfirstlane(pip[2 * j])]) >> 16) |
                (__float_as_uint(row[l * 33 + __builtin_amdgcn_readfirstlane(pip[2 * j + 1])]) & 0xffff0000u);
    __builtin_amdgcn_wave_barrier();
    const int e0 = p.PE()[t * 128 + l], e1 = p.PE()[t * 128 + 64 + l];
    const float g0 = p.PG()[t * 128 + l], g1 = p.PG()[t * 128 + 64 + l];
    float out[32];
#pragma unroll
    for (int i = 0; i < 32; ++i) out[i] = 0.f;
    const unsigned char* U = p.Utab() + (size_t)layer * 16384 * ROW6; const unsigned char* V = p.Vtab() + (size_t)layer * 16384 * ROW6;
    const unsigned voff = (unsigned)l * 8u;
    const bool b5 = (l & 32) != 0, b4 = (l & 16) != 0;
#pragma unroll 1
    for (int k4 = 0; k4 < 32; ++k4) {
        int e[4]; float g[4];
#pragma unroll
        for (int q = 0; q < 4; ++q) {
            const int k = k4 * 4 + q;
            e[q] = __builtin_amdgcn_readlane(k4 < 16 ? e0 : e1, k & 63);
            g[q] = __int_as_float(__builtin_amdgcn_readlane(__float_as_int(k4 < 16 ? g0 : g1), k & 63));
        }
#if PEER_FP4
        uint4 uu[4], vv[4];
#pragma unroll
        for (int q = 0; q < 4; ++q) { uu[q] = *(const uint4*)(U + (size_t)e[q] * ROW6 + 2 * voff); vv[q] = *(const uint4*)(V + (size_t)e[q] * ROW6 + 2 * voff); }
#define GATHER_UNPACK(F, SRC) do { fp4_unpack8((SRC).x, &(F)[0]); fp4_unpack8((SRC).y, &(F)[8]); fp4_unpack8((SRC).z, &(F)[16]); fp4_unpack8((SRC).w, &(F)[24]); } while (0)
#define GATHER_FIRST(SRC) (SRC).x
#else
        uint2 uu[4][3], vv[4][3];
#pragma unroll
        for (int q = 0; q < 4; ++q)
#pragma unroll
            for (int i = 0; i < 3; ++i) { uu[q][i] = *(const uint2*)(U + (size_t)e[q] * ROW6 + (voff + i * 512)); vv[q][i] = *(const uint2*)(V + (size_t)e[q] * ROW6 + (voff + i * 512)); }
#endif
        float d[4];
#pragma unroll
        for (int q = 0; q < 4; ++q) {
#if PEER_FP4
            if (q > 0) asm volatile("" : "+v"(uu[q].x), "+v"(d[q - 1]));
            float f[32]; GATHER_UNPACK(f, uu[q]);
#else
            v6u pk; pk[0] = uu[q][0].x; pk[1] = uu[q][0].y; pk[2] = uu[q][1].x; pk[3] = uu[q][1].y; pk[4] = uu[q][2].x; pk[5] = uu[q][2].y;
            if (q > 0) { unsigned t0_ = pk[0]; asm volatile("" : "+v"(t0_), "+v"(d[q - 1])); pk[0] = t0_; }
            const v32f f = FP6_UNPACK(pk);
#endif
            float acc = 0.f;
#pragma unroll
            for (int j = 0; j < 16; ++j) acc += f[2 * j] * lo2f(hp[j]) + f[2 * j + 1] * hi2f(hp[j]);
            d[q] = acc;
            __builtin_amdgcn_sched_barrier(0);
        }
        float kA = b5 ? d[2] : d[0], kB = b5 ? d[3] : d[1];
        const float sA = b5 ? d[0] : d[2], sB = b5 ? d[1] : d[3];
        kA += __shfl_xor(sA, 32); kB += __shfl_xor(sB, 32);
        float kk = b4 ? kB : kA; const float ss = b4 ? kA : kB;
        kk += __shfl_xor(ss, 16);
        kk += __shfl_xor(kk, 8); kk += __shfl_xor(kk, 4); kk += __shfl_xor(kk, 2); kk += __shfl_xor(kk, 1);
        const float gsel = b5 ? (b4 ? g[3] : g[2]) : (b4 ? g[1] : g[0]);
        const float av = gelu_tanh(kk * (ic6 / U6_SCALE)) * gsel * (ic6 / V6_SCALE);
        const int avi = __float_as_int(av);
        const float a4[4] = {__int_as_float(__builtin_amdgcn_readlane(avi, 0)), __int_as_float(__builtin_amdgcn_readlane(avi, 16)),
                             __int_as_float(__builtin_amdgcn_readlane(avi, 32)), __int_as_float(__builtin_amdgcn_readlane(avi, 48))};
#pragma unroll
        for (int q = 0; q < 4; ++q) {
#if PEER_FP4
            asm volatile("" : "+v"(vv[q].x), "+v"(out[31]));
            float f[32]; GATHER_UNPACK(f, vv[q]);
#else
            v6u pk; pk[0] = vv[q][0].x; pk[1] = vv[q][0].y; pk[2] = vv[q][1].x; pk[3] = vv[q][1].y; pk[4] = vv[q][2].x; pk[5] = vv[q][2].y;
            { unsigned t0_ = pk[0]; asm volatile("" : "+v"(t0_), "+v"(out[31])); pk[0] = t0_; }
            const v32f f = FP6_UNPACK(pk);
#endif
#pragma unroll
            for (int j = 0; j < 32; ++j) out[j] += a4[q] * f[j];
            __builtin_amdgcn_sched_barrier(0);
        }
    }
    asm volatile("" : "+s"(pip));
#pragma unroll
    for (int j = 0; j < 32; ++j) row[l * 33 + __builtin_amdgcn_readfirstlane(pip[j])] = out[j];
    __builtin_amdgcn_wave_barrier();
    const float* g2 = p.ada() + layer * 12288 + 5 * 2048;
    float4 xo[8]; float ssq = 0.f;
#pragma unroll
    for (int i = 0; i < 8; ++i) {
        const int c = i * 256 + l * 4;
        const float* rp = row + (c >> 5) * 33 + (c & 31);
        const size_t off = t * D + c;
        const float4 x0 = *(const float4*)(xin + off); const float4 ga = *(const float4*)(g2 + c);
        float4 o0;
        o0.x = x0.x + ga.x * rp[0]; o0.y = x0.y + ga.y * rp[1]; o0.z = x0.z + ga.z * rp[2]; o0.w = x0.w + ga.w * rp[3];
        *(float4*)(xout + off) = o0;
        xo[i] = o0; ssq += o0.x * o0.x + o0.y * o0.y + o0.z * o0.z + o0.w * o0.w;
        if (i & 1) __builtin_amdgcn_sched_barrier(0);
    }
    if (layer + 1 < NL) {
        const float rs = rsqrtf(wsum(ssq) * (1.0f / 2048.0f) + EPS);
        const float* ng = p.n1g + (layer + 1) * 2048; const float* adn = p.ada() + (layer + 1) * 12288;
#pragma unroll
        for (int i = 0; i < 8; ++i) {
            const int c = i * 256 + l * 4;
            const float4 gg = *(const float4*)(ng + c), sc = *(const float4*)(adn + 2048 + c), sh = *(const float4*)(adn + c);
            uint2 o;
            o.x = pk2((xo[i].x * rs) * gg.x * (1.0f + sc.x) + sh.x, (xo[i].y * rs) * gg.y * (1.0f + sc.y) + sh.y);
            o.y = pk2((xo[i].z * rs) * gg.z * (1.0f + sc.z) + sh.z, (xo[i].w * rs) * gg.w * (1.0f + sc.w) + sh.w);
            *(uint2*)(p.HN() + t * D + c) = o;
            if (i & 1) __builtin_amdgcn_sched_barrier(0);
        }
    }
    __builtin_amdgcn_wave_barrier();
}

enum { S_CONVT_IN = 0, S_CONVT_OUT, S_CONVT_Q, S_CONVT_W1, S_CALIB, S_TAB_U, S_TAB_V, S_ADA, S_ROPE, S_NORM1, S_GEMM_IN, S_CONV, S_SGU, S_VTRANS, S_PREP,
       S_COMPRESS, S_NSA_CMP, S_DSA_INDEX, S_NSA_ATTN, S_DSA_ATTN, S_GEMM_OUT, S_NORM2, S_GEMM_Q, S_PEER_TOPK, S_PEER_GATHER, S_COUNT };
constexpr int TAB_UNITS = 4096;
__host__ __device__ constexpr int nunits(int s) {
    return s == S_CONVT_IN ? 2 * 32 * (LDP / 64) : s == S_CONVT_OUT ? 2 * 32 * 32 : s == S_CONVT_Q ? 2 * 32 * 16 : s == S_CONVT_W1 ? 4 * 64 * 2 : s == S_CALIB ? 1 : s == S_TAB_U ? TAB_UNITS : s == S_TAB_V ? TAB_UNITS
         : s == S_ADA ? 384 : s == S_ROPE ? 768 : s == S_NORM1 ? 2048 : s == S_GEMM_IN ? 64 * (LDP / 128) : s == S_CONV ? 512 : s == S_SGU ? 256
         : s == S_VTRANS ? 256 : s == S_PREP ? 2048 : s == S_COMPRESS ? 64 : s == S_NSA_CMP ? 512 : s == S_DSA_INDEX ? 512 : s == S_NSA_ATTN ? 512 : s == S_DSA_ATTN ? 2048
         : s == S_GEMM_OUT ? 64 * 16 : s == S_NORM2 ? 2048 : s == S_GEMM_Q ? 64 * 8 : s == S_PEER_TOPK ? 512 : s == S_PEER_GATHER ? 2048 : 0;
}
template <int S>
DEV void run_unit(const P& p, int layer, int u, char* smem, int nu = TAB_UNITS) {
    const float* xin = layer == 0 ? p.x : p.X2();
    const float* ada = p.ada() + layer * 12288;
    if constexpr (S == S_CONVT_IN) { const int per = 32 * (LDP / 64), ly = u / per; st_convT(p.w_in + (size_t)ly * 2048 * INC, p.WinT() + (size_t)ly * LDP * 2048, INC, LDP, true, u % per, smem); }
    else if constexpr (S == S_CONVT_OUT) { const int per = 32 * 32, ly = u / per; st_convT(p.w_out + (size_t)ly * 2048 * 2048, p.WoutT() + (size_t)ly * 2048 * 2048, 2048, 2048, false, u % per, smem); }
    else if constexpr (S == S_CONVT_Q) { const int per = 32 * 16, ly = u / per; st_convT(p.peer_wq + (size_t)ly * 2048 * 1024, p.WqT() + (size_t)ly * 1024 * 2048, 1024, 1024, false, u % per, smem); }
    else if constexpr (S == S_CONVT_W1) { const int per = 64 * 2, mi = u / per; st_convT(p.cmp_w1 + (size_t)mi * 4096 * 128, p.W1T() + (size_t)mi * 128 * 4096, 128, 128, false, u % per, smem, 4096); }
    else if constexpr (S == S_CALIB) st_calib(p);
#if PEER_FP4
    else if constexpr (S == S_TAB_U) st_tab4(p, p.peer_u, p.Utab(), U6_SCALE, 2 * 16384, u, nu, smem);
    else if constexpr (S == S_TAB_V) st_tab4(p, p.peer_v, p.Vtab(), V6_SCALE, 2 * 16384, u, nu, smem);
#else
    else if constexpr (S == S_TAB_U) st_tab6(p.peer_u, p.Utab(), U6_SCALE, 2 * 16384, u, nu, smem);
    else if constexpr (S == S_TAB_V) st_tab6(p.peer_v, p.Vtab(), V6_SCALE, 2 * 16384, u, nu, smem);
#endif
    else if constexpr (S == S_ADA) st_ada(p, u, smem);
    else if constexpr (S == S_ROPE) st_rope(p, u);
    else if constexpr (S == S_NORM1) st_norm(xin, p.n1g + layer * 2048, ada + 2048, ada, p.HN(), u);
    else if constexpr (S == S_GEMM_IN) { EpiArgs e{p.PROJ(), nullptr, nullptr, nullptr, p.KVC()}; st_gemm<EPI_PROJ>(p.HN(), p.WinT() + (size_t)layer * LDP * 2048, 2048, u & 63, u >> 6, e, smem); }
    else if constexpr (S == S_CONV) st_conv(p, layer, u, smem);
    else if constexpr (S == S_SGU) st_sgu(p, layer, u, smem);
    else if constexpr (S == S_VTRANS) st_vtrans(p, u, smem);
    else if constexpr (S == S_PREP) st_prep(p, layer, u);
    else if constexpr (S == S_COMPRESS) st_compress(p, layer, u, smem);
    else if constexpr (S == S_NSA_CMP) st_nsa_cmp(p, u, smem);
    else if constexpr (S == S_DSA_INDEX) st_dsa_index(p, u, smem);
    else if constexpr (S == S_NSA_ATTN) st_nsa_attn(p, u, smem);
    else if constexpr (S == S_DSA_ATTN) st_dsa_attn(p, u, smem);
    else if constexpr (S == S_GEMM_OUT) { EpiArgs e{nullptr, p.X1(), xin, ada + 2 * 2048, nullptr}; st_gemm<EPI_OUT>(p.Y(), p.WoutT() + (size_t)layer * 2048 * 2048, 2048, u & 63, u >> 6, e, smem); }
    else if constexpr (S == S_NORM2) st_norm(p.X1(), p.n2g + layer * 2048, ada + 4 * 2048, ada + 3 * 2048, p.HN(), u);
    else if constexpr (S == S_GEMM_Q) { EpiArgs e{nullptr, p.PQ(), nullptr, nullptr, nullptr}; st_gemm<EPI_Q>(p.HN(), p.WqT() + (size_t)layer * 1024 * 2048, 2048, u & 63, u >> 6, e, smem); }
    else if constexpr (S == S_PEER_TOPK) st_peer_topk(p, layer, u, smem);
    else if constexpr (S == S_PEER_GATHER) st_peer_gather(p, layer, p.X1(), layer == 0 ? p.X2() : p.out, u, smem);
}


#define XB_TMO      128
#define XB_XCNT(j)  (256  + 64 * (j))
#define XB_XSUB(j)  (1280 + 64 * (j))
#define XB_XGEN(j)  (2304 + 64 * (j))
#define XB_TOP      3328
#define XB_TOPGEN   3392
#define XB_SPIN_CAP (1u << 22)
#define LAS __attribute__((address_space(3)))
DEV unsigned xb_ld(unsigned* p) { return __hip_atomic_load(p, __ATOMIC_RELAXED, __HIP_MEMORY_SCOPE_AGENT); }
DEV unsigned xb_add(unsigned* p, unsigned v) { return __hip_atomic_fetch_add(p, v, __ATOMIC_RELAXED, __HIP_MEMORY_SCOPE_AGENT); }
DEV unsigned xb_xcc_id() { return (unsigned)__builtin_amdgcn_s_getreg((3 << 11) | 20) & 0xFu; }
#define XB_SPIN(cond, bar) do { unsigned _sp = 0; while (cond) { __builtin_amdgcn_s_sleep(1); \
    if ((++_sp & 255u) == 0u) { if (xb_ld(&(bar)[XB_TMO])) break; if (_sp > XB_SPIN_CAP) { atomicAdd(&(bar)[XB_TMO], 1u); break; } } } } while (0)
struct XcdBarrier { unsigned* bar; unsigned x; volatile LAS unsigned* st; };
DEV XcdBarrier xcd_barrier_post(unsigned* bar, volatile LAS unsigned* st) {
    XcdBarrier b; b.bar = bar; b.x = xb_xcc_id(); b.st = st;
    if (threadIdx.x == 0) (void)xb_add(&bar[XB_XCNT(b.x)], 1u);
    return b;
}
DEV void xcd_barrier_complete(unsigned* bar, unsigned x, unsigned& nloc, unsigned& nx) {
    const unsigned G = gridDim.x * gridDim.y * gridDim.z;
    unsigned sum, cnt, mine, sp = 0u;
    for (;;) {
        sum = 0u; cnt = 0u; mine = 0u;
#pragma unroll
        for (unsigned j = 0; j < 16; ++j) { const unsigned c = xb_ld(&bar[XB_XCNT(j)]); sum += c; cnt += (c > 0u) ? 1u : 0u; mine = (j == x) ? c : mine; }
        if (sum == G) break;
        __builtin_amdgcn_s_sleep(1);
        if ((++sp & 255u) == 0u) { if (xb_ld(&bar[XB_TMO])) break; if (sp > XB_SPIN_CAP) { atomicAdd(&bar[XB_TMO], 1u); break; } }
    }
    nloc = mine > 0u ? mine : 1u; nx = cnt > 0u ? cnt : 1u;
}
DEV void xcd_barrier(const XcdBarrier& b) {
    asm volatile("s_waitcnt vmcnt(0)" ::: "memory");
    __syncthreads();
    if (threadIdx.x == 0) {
        unsigned* bar = b.bar;
        __builtin_amdgcn_s_waitcnt(0);
        unsigned nloc = b.st[0], nx = b.st[1];
        if (nloc == 0u) { xcd_barrier_complete(bar, b.x, nloc, nx); b.st[0] = nloc; b.st[1] = nx; }
        const unsigned old = xb_add(&bar[XB_XSUB(b.x)], 1u);
        const unsigned gen = old / nloc;
        if (old + 1u == (gen + 1u) * nloc) {
            __builtin_amdgcn_fence(__ATOMIC_RELEASE, "agent");
            asm volatile("s_waitcnt vmcnt(0)" ::: "memory");
            const unsigned og = xb_add(&bar[XB_TOP], 1u);
            const unsigned tg = og / nx;
            if (og + 1u == (tg + 1u) * nx) xb_add(&bar[XB_TOPGEN], 1u);
            else XB_SPIN(xb_ld(&bar[XB_TOPGEN]) == tg, bar);
            __builtin_amdgcn_fence(__ATOMIC_ACQUIRE, "agent");
            xb_add(&bar[XB_XGEN(b.x)], 1u);
            asm volatile("s_waitcnt vmcnt(0)" ::: "memory");
        } else {
            XB_SPIN(xb_ld(&bar[XB_XGEN(b.x)]) == gen, bar);
            __builtin_amdgcn_fence(__ATOMIC_ACQUIRE, "agent");
            asm volatile("s_waitcnt vmcnt(0)" ::: "memory");
        }
    }
    __syncthreads();
}

#ifndef MULTI_LAUNCH
constexpr int REP_STAGE = -1, REP_STAGE2 = -1, REP_N = 1;
template <int S, int LIM = 0>
DEV void run_phase1(const P& p, int layer, char* smem, int off);
template <int S, int LIM = 0>
DEV void run_phase(const P& p, int layer, char* smem, int off = 0) {
    constexpr int reps = (S == REP_STAGE || S == REP_STAGE2) ? REP_N : 1;
#pragma unroll 1
    for (int r = 0; r < reps; ++r) run_phase1<S, LIM>(p, layer, smem, off);
}
template <int S, int LIM>
DEV void run_phase1(const P& p, int layer, char* smem, int off) {
    const int G = gridDim.x;
    int b = blockIdx.x + off; if (b >= G) b -= G;
    if constexpr (S == S_TAB_U || S == S_TAB_V) { run_unit<S>(p, layer, b, smem, G); }
    else {
        for (int u = b; u < (LIM ? LIM : nunits(S)); u += G) { run_unit<S>(p, layer, u, smem); __syncthreads(); }
    }
}
template <int S>
DEV void run_gemm_phase1(const P& p, int layer, char* smem, unsigned xcc, volatile LAS unsigned* slot, int rep) {
    constexpr int TN = (S == S_GEMM_IN) ? (LDP / 128) : (S == S_GEMM_OUT ? 16 : 8);
    constexpr int NBIG = (S == S_GEMM_IN) ? 32 : (S == S_GEMM_OUT ? 16 : 0);
    constexpr int inst0 = (S == S_GEMM_IN) ? 0 : (S == S_GEMM_OUT ? 2 : 4);
    constexpr int nbig = 4 * NBIG, len = nbig + 8 * (TN - NBIG);
    const float* xin = layer == 0 ? p.x : p.X2();
    const float* ada = p.ada() + layer * 12288;
    const bf16_t* Aop = (S == S_GEMM_OUT) ? p.Y() : p.HN();
    const bf16_t* Bop = (S == S_GEMM_IN) ? p.WinT() + (size_t)layer * LDP * 2048 : (S == S_GEMM_OUT ? p.WoutT() + (size_t)layer * 2048 * 2048 : p.WqT() + (size_t)layer * 1024 * 2048);
    EpiArgs e{p.PROJ(), (S == S_GEMM_OUT) ? p.X1() : p.PQ(), xin, ada + 2 * 2048, p.KVC()};
    constexpr int EPI = (S == S_GEMM_IN) ? EPI_PROJ : (S == S_GEMM_OUT ? EPI_OUT : EPI_Q);
#pragma unroll 1
    for (int q = 0; q < 8; ++q) {
        const unsigned xq = (xcc + q) & 7u;
        unsigned* head = p.bar() + GQ_WORD(inst0 + layer + 6 * rep, xq);
        for (;;) {
            if (threadIdx.x == 0) *slot = xb_add(head, 1u);
            __syncthreads();
            const int i = (int)*slot;
            __syncthreads();
            if (i >= len) break;
            if (i < nbig) st_gemm<EPI, 8>(Aop, Bop, 2048, (int)xq * 4 + (i & 3), i >> 2, e, smem);
            else {
                const int j = i - nbig, tm = (int)xq * 8 + (j & 7), tn = NBIG + (j >> 3);
                st_gemm<EPI, 4>(Aop, Bop, 2048, tm, tn, e, smem);
                if constexpr (S == S_GEMM_Q) {
                    asm volatile("s_waitcnt vmcnt(0)" ::: "memory");
                    __syncthreads();
                    st_peer_topk(p, layer, tm * 8 + tn, smem);
                }
            }
            __syncthreads();
        }
    }
}
template <int S>
DEV void run_items(const P& p, int layer, char* smem, int first, int count) {
    constexpr int reps = (S == REP_STAGE || S == REP_STAGE2) ? REP_N : 1;
#pragma unroll 1
    for (int r = 0; r < reps; ++r)
#pragma unroll 1
        for (int u = first; u < first + count; ++u) { run_unit<S>(p, layer, u, smem); __syncthreads(); }
}
DEV void dep_publish(unsigned* cnt) {
    asm volatile("s_waitcnt vmcnt(0)" ::: "memory");
    __syncthreads();
    if (threadIdx.x == 0) { __builtin_amdgcn_fence(__ATOMIC_RELEASE, "agent"); asm volatile("s_waitcnt vmcnt(0)" ::: "memory"); (void)xb_add(cnt, 1u); }
}
DEV void dep_wait(unsigned* cnt, unsigned target, unsigned* bar) {
    if (threadIdx.x == 0) {
        XB_SPIN(xb_ld(cnt) < target, bar);
        __builtin_amdgcn_fence(__ATOMIC_ACQUIRE, "agent");
        asm volatile("s_waitcnt vmcnt(0)" ::: "memory");
    }
    __syncthreads();
}
template <int PH>
DEV void run_dyn_phase(const P& p, int layer, char* smem, volatile LAS unsigned* slot) {
    unsigned* head = p.bar() + DQ_WORD(PH * 2 + layer);
    unsigned* cprep = p.bar() + DQ_WORD(12 + layer); unsigned* ccomp = p.bar() + DQ_WORD(14 + layer);
    constexpr int total0 = PH == 0 ? (256 + 64 + 256 + 256 + 64 + 512 + 256) : (512 + 512);
    const int total = (PH == 0 && layer == 0) ? total0 + 512 + 296 + 256 + 128 : total0;
    int i = blockIdx.x;
    while (i < total) {
        if constexpr (PH == 0) {
            if (i < 256) { run_items<S_PREP>(p, layer, smem, i * 8, 8); dep_publish(cprep); }
            else if (i < 320) { run_items<S_COMPRESS>(p, layer, smem, i - 256, 1); dep_publish(ccomp); }
            else if (i < 576) run_items<S_SGU>(p, layer, smem, i - 320, 1);
            else if (i < 832) run_items<S_CONV>(p, layer, smem, (i - 576) * 2, 2);
            else if (i < 896) run_items<S_VTRANS>(p, layer, smem, (i - 832) * 4, 4);
            else if (i < 1408) { dep_wait(cprep, 256u, p.bar()); run_items<S_DSA_INDEX>(p, layer, smem, i - 896, 1); }
            else if (i < 1664) { dep_wait(cprep, 256u, p.bar()); dep_wait(ccomp, 64u, p.bar()); run_items<S_NSA_CMP>(p, layer, smem, (i - 1408) * 2, 2); }
            else if (i < 1920) { run_unit<S_TAB_U>(p, layer, i - 1664, smem, 256); __syncthreads(); }
            else if (i < 2176) { run_unit<S_TAB_V>(p, layer, i - 1920, smem, 256); __syncthreads(); }
            else if (i < 2472) run_items<S_CONVT_IN>(p, layer, smem, 2368 + (i - 2176) * 8, 8);
            else if (i < 2728) run_items<S_CONVT_OUT>(p, layer, smem, (i - 2472) * 8, 8);
            else run_items<S_CONVT_Q>(p, layer, smem, (i - 2728) * 8, 8);
        } else {
            if (i < 512) run_items<S_NSA_ATTN>(p, layer, smem, 511 - i, 1);
            else run_items<S_DSA_ATTN>(p, layer, smem, (i - 512) * 4, 4);
        }
        if (threadIdx.x == 0) *slot = gridDim.x + xb_add(head, 1u);
        __syncthreads();
        i = (int)*slot;
        __syncthreads();
    }
}
template <int S>
DEV void run_gemm_phase(const P& p, int layer, char* smem, unsigned xcc, volatile LAS unsigned* slot) {
    constexpr int reps = (S == REP_STAGE || S == REP_STAGE2) ? REP_N : 1;
#pragma unroll 1
    for (int r = 0; r < reps; ++r) run_gemm_phase1<S>(p, layer, smem, xcc, slot, r);
}
#if defined(__HIP_DEVICE_COMPILE__)
typedef const P __attribute__((address_space(4)))* kargp_t;
DEV const P& fresh_params() { kargp_t q = (kargp_t)__builtin_amdgcn_kernarg_segment_ptr(); asm volatile("" : "+s"(q)); return *(const P*)q; }
#define PP fresh_params()
#else
#define PP p
#endif
#define GSYNC() xcd_barrier(xb)
__global__ void __launch_bounds__(NTHREADS, 2) k_mega(P p) {
    __shared__ __attribute__((aligned(16))) char smem[SMEM_BYTES];
    __shared__ uint4 xb_words;
    cg::grid_group grid = cg::this_grid();
    if (threadIdx.x == 0) xb_words = make_uint4(0u, 0u, 0u, 0u);
    __syncthreads();
    XcdBarrier xb = xcd_barrier_post(p.bar(), (volatile LAS unsigned*)&xb_words);
    const int H = gridDim.x >> 1, Q = gridDim.x >> 2;
    run_phase<S_ADA>(PP, 0, smem); run_phase<S_ROPE>(PP, 0, smem, H);
    run_phase<S_CONVT_IN, 2368>(PP, 0, smem); run_phase<S_CONVT_W1>(PP, 0, smem); run_phase<S_CALIB>(PP, 0, smem, 100);
    grid.sync();
#pragma unroll 1
    for (int layer = 0; layer < NL; ++layer) {
        if (layer == 0) { run_phase<S_NORM1>(PP, layer, smem); GSYNC(); }
        run_gemm_phase<S_GEMM_IN>(PP, layer, smem, xb.x, (volatile LAS unsigned*)&xb_words + 2); GSYNC();
        run_dyn_phase<0>(PP, layer, smem, (volatile LAS unsigned*)&xb_words + 2); GSYNC();
        run_dyn_phase<2>(PP, layer, smem, (volatile LAS unsigned*)&xb_words + 2); GSYNC();
        run_gemm_phase<S_GEMM_OUT>(PP, layer, smem, xb.x, (volatile LAS unsigned*)&xb_words + 2); GSYNC();
        run_phase<S_NORM2>(PP, layer, smem); GSYNC();
        run_gemm_phase<S_GEMM_Q>(PP, layer, smem, xb.x, (volatile LAS unsigned*)&xb_words + 2); GSYNC();
        run_phase<S_PEER_GATHER>(PP, layer, smem); GSYNC();
    }
}
#else
template <int S>
__global__ void __launch_bounds__(NTHREADS) k_stage(P p, int layer) {
    __shared__ __attribute__((aligned(16))) char smem[SMEM_BYTES];
    run_unit<S>(p, layer, blockIdx.x, smem);
}
template <int S> static void launch_stage(const P& p, int layer, hipStream_t st) {
    hipLaunchKernelGGL((k_stage<S>), dim3(nunits(S)), dim3(NTHREADS), 0, st, p, layer);
}
#endif

extern "C" void kernel_launch(void* const* d_in, const int* in_sizes, int n_in, void* d_out, int out_size, void* d_ws, size_t ws_size, hipStream_t stream) {
    P p{};
    p.x = (const float*)d_in[0]; p.c = (const float*)d_in[1]; p.pos = (const int*)d_in[2]; p.ada_w = (const float*)d_in[3]; p.ada_b = (const float*)d_in[4];
    p.n1g = (const float*)d_in[5]; p.n2g = (const float*)d_in[6]; p.w_in = (const float*)d_in[7]; p.w_out = (const float*)d_in[8]; p.conv_w = (const float*)d_in[9];
    p.conv_b = (const float*)d_in[10]; p.cln_g = (const float*)d_in[11]; p.cln_b = (const float*)d_in[12]; p.sln_g = (const float*)d_in[13]; p.sln_b = (const float*)d_in[14];
    p.sgu_w = (const float*)d_in[15]; p.sgu_b = (const float*)d_in[16]; p.nsa_qg = (const float*)d_in[17]; p.nsa_kg = (const float*)d_in[18]; p.cmp_pos = (const float*)d_in[19];
    p.cmp_w1 = (const float*)d_in[20]; p.cmp_w2 = (const float*)d_in[21]; p.dsa_qg = (const float*)d_in[22]; p.dsa_kg = (const float*)d_in[23]; p.peer_wq = (const float*)d_in[24];
    p.peer_sk = (const float*)d_in[25]; p.peer_u = (const float*)d_in[26]; p.peer_v = (const float*)d_in[27];
    p.out = (float*)d_out;
    p.ws = (char*)d_ws; const size_t off = WS_TOTAL;
    if (off > ws_size) { fprintf(stderr, "workspace too small: need %zu have %zu\n", off, ws_size); return; }
#ifndef MULTI_LAUNCH
    static int grid_blocks = 0;
    if (!grid_blocks) {
        int dev = 0, cus = 0, per_cu = 0;
        (void)hipGetDevice(&dev);
        (void)hipDeviceGetAttribute(&cus, hipDeviceAttributeMultiprocessorCount, dev);
        (void)hipOccupancyMaxActiveBlocksPerMultiprocessor(&per_cu, k_mega, NTHREADS, 0);
        if (per_cu > 2) per_cu = 2;
        grid_blocks = cus * per_cu;
    }
    (void)hipMemsetAsync(p.bar(), 0, (size_t)CTRL_WORDS * 4, stream);
    void* args[] = {&p};
    hipError_t e = hipLaunchCooperativeKernel((void*)k_mega, dim3(grid_blocks), dim3(NTHREADS), args, 0, stream);
    if (e != hipSuccess) fprintf(stderr, "cooperative launch failed: %s (grid %d)\n", hipGetErrorString(e), grid_blocks);
#else
    launch_stage<S_CONVT_IN>(p, 0, stream); launch_stage<S_CONVT_OUT>(p, 0, stream); launch_stage<S_CONVT_Q>(p, 0, stream); launch_stage<S_CONVT_W1>(p, 0, stream); launch_stage<S_CALIB>(p, 0, stream);
    launch_stage<S_TAB_U>(p, 0, stream); launch_stage<S_TAB_V>(p, 0, stream);
    launch_stage<S_ADA>(p, 0, stream); launch_stage<S_ROPE>(p, 0, stream);
    for (int layer = 0; layer < NL; ++layer) {
        launch_stage<S_NORM1>(p, layer, stream); launch_stage<S_GEMM_IN>(p, layer, stream);
        launch_stage<S_CONV>(p, layer, stream); launch_stage<S_SGU>(p, layer, stream); launch_stage<S_VTRANS>(p, layer, stream);
        launch_stage<S_PREP>(p, layer, stream); launch_stage<S_COMPRESS>(p, layer, stream);
        launch_stage<S_NSA_CMP>(p, layer, stream); launch_stage<S_DSA_INDEX>(p, layer, stream);
        launch_stage<S_NSA_ATTN>(p, layer, stream); launch_stage<S_DSA_ATTN>(p, layer, stream);
        launch_stage<S_GEMM_OUT>(p, layer, stream); launch_stage<S_NORM2>(p, layer, stream); launch_stage<S_GEMM_Q>(p, layer, stream);
        launch_stage<S_PEER_TOPK>(p, layer, stream); launch_stage<S_PEER_GATHER>(p, layer, stream);
    }
#endif
}
```

```cpp
#include <hip/hip_runtime.h>
#include <hip/hip_cooperative_groups.h>
#include <stdint.h>
#include <cstdio>
namespace cg = cooperative_groups;

typedef unsigned short bf16_t;
typedef short bf16x8 __attribute__((ext_vector_type(8)));
typedef float f32x4 __attribute__((ext_vector_type(4)));
typedef float f32x16 __attribute__((ext_vector_type(16)));
#define DEV __device__ __forceinline__

constexpr int T = 8192, D = 2048, NL = 2;
constexpr int INC = 4692;
constexpr int LDP = 4736;
constexpr int C_CA = 0, C_CG = 512, C_SU = 1024, C_SV = 1536;
constexpr int C_NQ = 2048, C_NKC = 2560, C_NVC = 2688, C_NKS = 2816, C_NVS = 2944, C_NKW = 3072, C_NVW = 3200;
constexpr int C_DQ = 3328, C_DK = 3840, C_DV = 3968, C_IQ = 4096, C_IK = 4608, C_NG = 4672, C_IW = 4688;
constexpr float EPS = 1e-6f;
constexpr int NTHREADS = 256;
constexpr int SMEM_BYTES = 72 * 1024;

__device__ const double INV16[16] = {1.0, 0.44036660267178046, 0.19392274474868576, 0.08539710028576561, 0.03760603093086393,
    0.016560440080994446, 0.007292664737217109, 0.003211445994752591, 0.001414213562373095, 0.000622772421914596,
    0.0002742481756762073, 0.00012076973741146504, 5.318295896944988e-05, 2.341999896140934e-05, 1.031338537721246e-05,
    4.5416704806078695e-06};

#define XCD_BAR_WORDS 3456
#define GQ_WORD(inst, x) (XCD_BAR_WORDS + 64 * ((inst) * 8 + (x)))
#define DQ_WORD(k) (XCD_BAR_WORDS + 64 * (96 + (k)))
#define CTRL_WORDS (XCD_BAR_WORDS + 64 * 112)
constexpr size_t WS_ALIGN(size_t x) { return (x + 255) & ~(size_t)255; }
constexpr size_t OFF_WinT = 0;
constexpr size_t OFF_WoutT = OFF_WinT + WS_ALIGN((size_t)2 * LDP * 2048 * 2);
constexpr size_t OFF_WqT = OFF_WoutT + WS_ALIGN((size_t)2 * 2048 * 2048 * 2);
constexpr size_t OFF_W1T = OFF_WqT + WS_ALIGN((size_t)2 * 1024 * 2048 * 2);
constexpr size_t OFF_PI = OFF_W1T + WS_ALIGN((size_t)4 * 128 * 4096 * 2);
constexpr size_t OFF_Utab = OFF_PI + WS_ALIGN(256);
constexpr size_t OFF_Vtab = OFF_Utab + WS_ALIGN((size_t)2 * 16384 * 1536);
constexpr size_t OFF_ada = OFF_Vtab + WS_ALIGN((size_t)2 * 16384 * 1536);
constexpr size_t OFF_ropeC = OFF_ada + WS_ALIGN((size_t)2 * 12288 * 4);
constexpr size_t OFF_ropeS = OFF_ropeC + WS_ALIGN((size_t)T * 24 * 4);
constexpr size_t OFF_HN = OFF_ropeS + WS_ALIGN((size_t)T * 24 * 4);
constexpr size_t OFF_PROJ = OFF_HN + WS_ALIGN((size_t)T * D * 2);
constexpr size_t OFF_Y = OFF_PROJ + WS_ALIGN((size_t)T * LDP * 2);
constexpr size_t OFF_QN = OFF_Y + WS_ALIGN((size_t)T * D * 2);
constexpr size_t OFF_QR = OFF_QN + WS_ALIGN((size_t)T * 512 * 2);
constexpr size_t OFF_KS = OFF_QR + WS_ALIGN((size_t)T * 512 * 2);
constexpr size_t OFF_KW = OFF_KS + WS_ALIGN((size_t)T * 128 * 2);
constexpr size_t OFF_VST = OFF_KW + WS_ALIGN((size_t)T * 128 * 2);
constexpr size_t OFF_VWT = OFF_VST + WS_ALIGN((size_t)T * 128 * 2);
constexpr size_t OFF_GATES = OFF_VWT + WS_ALIGN((size_t)T * 128 * 2);
constexpr size_t OFF_KC = OFF_GATES + WS_ALIGN((size_t)T * 12 * 4);
constexpr size_t OFF_VCT = OFF_KC + WS_ALIGN((size_t)512 * 128 * 2);
constexpr size_t OFF_SEL = OFF_VCT + WS_ALIGN((size_t)128 * 512 * 2);
constexpr size_t OFF_OCMP = OFF_SEL + WS_ALIGN((size_t)T * 4 * 4);
constexpr size_t OFF_DQ = OFF_OCMP + WS_ALIGN((size_t)T * 512 * 2);
constexpr size_t OFF_DK = OFF_DQ + WS_ALIGN((size_t)T * 512 * 2);
constexpr size_t OFF_DVC = OFF_DK + WS_ALIGN((size_t)T * 128 * 2);
constexpr size_t OFF_KVC = OFF_DVC + WS_ALIGN((size_t)T * 128 * 2);
constexpr size_t OFF_IQ = OFF_KVC + WS_ALIGN((size_t)T * 256 * 2);
constexpr size_t OFF_IK = OFF_IQ + WS_ALIGN((size_t)T * 512 * 2);
constexpr size_t OFF_IW = OFF_IK + WS_ALIGN((size_t)T * 64 * 2);
constexpr size_t OFF_IDX = OFF_IW + WS_ALIGN((size_t)T * 8 * 4);
constexpr size_t OFF_CNT = OFF_IDX + WS_ALIGN((size_t)T * 256 * 4);
constexpr size_t OFF_X1 = OFF_CNT + WS_ALIGN((size_t)T * 4);
constexpr size_t OFF_X2 = OFF_X1 + WS_ALIGN((size_t)T * D * 4);
constexpr size_t OFF_PQ = OFF_X2 + WS_ALIGN((size_t)T * D * 4);
constexpr size_t OFF_PE = OFF_PQ + WS_ALIGN((size_t)T * 1024 * 4);
constexpr size_t OFF_PG = OFF_PE + WS_ALIGN((size_t)T * 128 * 4);
constexpr size_t OFF_bar = OFF_PG + WS_ALIGN((size_t)T * 128 * 4);
constexpr size_t WS_TOTAL = OFF_bar + WS_ALIGN((size_t)CTRL_WORDS * 4);

struct P {
    const float* x; const float* c; const int* pos; const float* ada_w; const float* ada_b; const float* n1g; const float* n2g;
    const float* w_in; const float* w_out; const float* conv_w; const float* conv_b; const float* cln_g; const float* cln_b;
    const float* sln_g; const float* sln_b; const float* sgu_w; const float* sgu_b; const float* nsa_qg; const float* nsa_kg;
    const float* cmp_pos; const float* cmp_w1; const float* cmp_w2; const float* dsa_qg; const float* dsa_kg;
    const float* peer_wq; const float* peer_sk; const float* peer_u; const float* peer_v;
    float* out;
    char* ws;
    __host__ __device__ __forceinline__ bf16_t* WinT() const { return (bf16_t*)(ws + OFF_WinT); }
    __host__ __device__ __forceinline__ bf16_t* WoutT() const { return (bf16_t*)(ws + OFF_WoutT); }
    __host__ __device__ __forceinline__ bf16_t* WqT() const { return (bf16_t*)(ws + OFF_WqT); }
    __host__ __device__ __forceinline__ bf16_t* W1T() const { return (bf16_t*)(ws + OFF_W1T); }
    __host__ __device__ __forceinline__ int* PI() const { return (int*)(ws + OFF_PI); }
    __host__ __device__ __forceinline__ unsigned char* Utab() const { return (unsigned char*)(ws + OFF_Utab); }
    __host__ __device__ __forceinline__ unsigned char* Vtab() const { return (unsigned char*)(ws + OFF_Vtab); }
    __host__ __device__ __forceinline__ float* ada() const { return (float*)(ws + OFF_ada); }
    __host__ __device__ __forceinline__ float* ropeC() const { return (float*)(ws + OFF_ropeC); }
    __host__ __device__ __forceinline__ float* ropeS() const { return (float*)(ws + OFF_ropeS); }
    __host__ __device__ __forceinline__ bf16_t* HN() const { return (bf16_t*)(ws + OFF_HN); }
    __host__ __device__ __forceinline__ bf16_t* PROJ() const { return (bf16_t*)(ws + OFF_PROJ); }
    __host__ __device__ __forceinline__ bf16_t* Y() const { return (bf16_t*)(ws + OFF_Y); }
    __host__ __device__ __forceinline__ bf16_t* QN() const { return (bf16_t*)(ws + OFF_QN); }
    __host__ __device__ __forceinline__ bf16_t* QR() const { return (bf16_t*)(ws + OFF_QR); }
    __host__ __device__ __forceinline__ bf16_t* KS() const { return (bf16_t*)(ws + OFF_KS); }
    __host__ __device__ __forceinline__ bf16_t* KW() const { return (bf16_t*)(ws + OFF_KW); }
    __host__ __device__ __forceinline__ bf16_t* VST() const { return (bf16_t*)(ws + OFF_VST); }
    __host__ __device__ __forceinline__ bf16_t* VWT() const { return (bf16_t*)(ws + OFF_VWT); }
    __host__ __device__ __forceinline__ float* GATES() const { return (float*)(ws + OFF_GATES); }
    __host__ __device__ __forceinline__ bf16_t* KC() const { return (bf16_t*)(ws + OFF_KC); }
    __host__ __device__ __forceinline__ bf16_t* VCT() const { return (bf16_t*)(ws + OFF_VCT); }
    __host__ __device__ __forceinline__ unsigned* SEL() const { return (unsigned*)(ws + OFF_SEL); }
    __host__ __device__ __forceinline__ bf16_t* OCMP() const { return (bf16_t*)(ws + OFF_OCMP); }
    __host__ __device__ __forceinline__ bf16_t* DQ() const { return (bf16_t*)(ws + OFF_DQ); }
    __host__ __device__ __forceinline__ bf16_t* DK() const { return (bf16_t*)(ws + OFF_DK); }
    __host__ __device__ __forceinline__ bf16_t* DVC() const { return (bf16_t*)(ws + OFF_DVC); }
    __host__ __device__ __forceinline__ bf16_t* KVC() const { return (bf16_t*)(ws + OFF_KVC); }
    __host__ __device__ __forceinline__ bf16_t* IQ() const { return (bf16_t*)(ws + OFF_IQ); }
    __host__ __device__ __forceinline__ bf16_t* IK() const { return (bf16_t*)(ws + OFF_IK); }
    __host__ __device__ __forceinline__ float* IW() const { return (float*)(ws + OFF_IW); }
    __host__ __device__ __forceinline__ int* IDX() const { return (int*)(ws + OFF_IDX); }
    __host__ __device__ __forceinline__ int* CNT() const { return (int*)(ws + OFF_CNT); }
    __host__ __device__ __forceinline__ float* X1() const { return (float*)(ws + OFF_X1); }
    __host__ __device__ __forceinline__ float* X2() const { return (float*)(ws + OFF_X2); }
    __host__ __device__ __forceinline__ float* PQ() const { return (float*)(ws + OFF_PQ); }
    __host__ __device__ __forceinline__ int* PE() const { return (int*)(ws + OFF_PE); }
    __host__ __device__ __forceinline__ float* PG() const { return (float*)(ws + OFF_PG); }
    __host__ __device__ __forceinline__ unsigned* bar() const { return (unsigned*)(ws + OFF_bar); }
};

DEV float bf2f(bf16_t v) { return __uint_as_float(((unsigned)v) << 16); }
DEV unsigned pk2(float lo, float hi) { unsigned r; asm("v_cvt_pk_bf16_f32 %0, %1, %2" : "=v"(r) : "v"(lo), "v"(hi)); return r; }
DEV bf16_t f2bf(float v) { return (bf16_t)(pk2(v, 0.f) & 0xffffu); }
DEV float lo2f(unsigned u) { return __uint_as_float(u << 16); }
DEV float hi2f(unsigned u) { return __uint_as_float(u & 0xffff0000u); }
#define DPP_ROR_F(V, N) __int_as_float(__builtin_amdgcn_update_dpp(0, __float_as_int(V), 0x120 + (N), 0xf, 0xf, false))
DEV float wsum(float v) {
    v += DPP_ROR_F(v, 8); v += DPP_ROR_F(v, 4); v += DPP_ROR_F(v, 2); v += DPP_ROR_F(v, 1);
    const int vi = __float_as_int(v);
    return (__int_as_float(__builtin_amdgcn_readlane(vi, 0)) + __int_as_float(__builtin_amdgcn_readlane(vi, 16))) +
           (__int_as_float(__builtin_amdgcn_readlane(vi, 32)) + __int_as_float(__builtin_amdgcn_readlane(vi, 48)));
}
DEV float wmax(float v) {
    v = fmaxf(v, DPP_ROR_F(v, 8)); v = fmaxf(v, DPP_ROR_F(v, 4)); v = fmaxf(v, DPP_ROR_F(v, 2)); v = fmaxf(v, DPP_ROR_F(v, 1));
    const int vi = __float_as_int(v);
    return fmaxf(fmaxf(__int_as_float(__builtin_amdgcn_readlane(vi, 0)), __int_as_float(__builtin_amdgcn_readlane(vi, 16))),
                 fmaxf(__int_as_float(__builtin_amdgcn_readlane(vi, 32)), __int_as_float(__builtin_amdgcn_readlane(vi, 48))));
}
DEV int tidx() { int t = threadIdx.x; asm volatile("" : "+v"(t)); return t; }
DEV float sigmoidf_(float x) { return 1.0f / (1.0f + __expf(-x)); }
DEV float gelu_tanh(float x) {
    const float y = 0.7978845608028654f * (x + 0.044715f * x * x * x);
    const float t = 1.0f - 2.0f / (1.0f + __expf(2.0f * y));
    return 0.5f * x * (1.0f + t);
}
DEV f32x4 mfma16(bf16x8 a, bf16x8 b, f32x4 c) { return __builtin_amdgcn_mfma_f32_16x16x32_bf16(a, b, c, 0, 0, 0); }
DEV f32x16 mfma32(bf16x8 a, bf16x8 b, f32x16 c) { return __builtin_amdgcn_mfma_f32_32x32x16_bf16(a, b, c, 0, 0, 0); }

DEV int src_col(int n) {
    if (n < 3328) return n;
    if (n < 4672) return 3340 + (n - 3328);
    if (n < 4684) return 3328 + (n - 4672);
    if (n < 4688) return -1;
    if (n < 4696) return 4684 + (n - 4688);
    return -1;
}

DEV void st_convT(const float* __restrict__ W, bf16_t* __restrict__ Bt, int N, int Npad, bool remap, int unit, char* smem, int Kdim = 2048) {
    float (*tile)[65] = (float (*)[65])smem;
    const int ntn = Npad / 64, kt = unit / ntn, nt = unit % ntn, k0 = kt * 64, n0 = nt * 64;
    const int tid_ = tidx(); const int tx = tid_ & 63, ty = tid_ >> 6;
    const int n = n0 + tx;
    const int src = remap ? src_col(n) : (n < N ? n : -1);
#pragma unroll
    for (int i = 0; i < 16; ++i) { const int k = ty + 4 * i; tile[k][tx] = src >= 0 ? W[(size_t)(k0 + k) * N + src] : 0.f; }
    __syncthreads();
#pragma unroll
    for (int i = 0; i < 16; ++i) { const int r = ty + 4 * i; Bt[(size_t)(n0 + r) * Kdim + k0 + tx] = f2bf(tile[tx][r]); }
    __syncthreads();
}

typedef float f32x2 __attribute__((ext_vector_type(2)));
typedef float v16f __attribute__((ext_vector_type(16)));
typedef float v32f __attribute__((ext_vector_type(32)));
typedef unsigned v6u __attribute__((ext_vector_type(6)));
#ifndef PEER_FP4
#define PEER_FP4 0
#endif
#if PEER_FP4
constexpr float U6_SCALE = 64.0f, V6_SCALE = 2.8f;
constexpr int ROW6 = 1024;
#else
constexpr float U6_SCALE = 64.0f, V6_SCALE = 3.0f;
constexpr int ROW6 = 1536;
#endif
#define FP6_ONE __uint_as_float(0x3F80007Fu)

#ifndef SW_FP6
#define SW_FP6 1
#endif
DEV unsigned fp6_enc1(float f) {
    const float a = fminf(fabsf(f), 7.5f);
    const float sc = a < 2.0f ? 8.0f : (a < 4.0f ? 4.0f : 2.0f), of = a < 2.0f ? 0.0f : (a < 4.0f ? 8.0f : 16.0f);
    const unsigned code = (unsigned)(int)__builtin_rintf(a * sc + of);
    return code | ((__float_as_uint(f) >> 26) & 32u);
}
DEV float fp6_dec1(unsigned c) {
    const unsigned e = (c >> 3) & 3u, m = c & 7u;
    const float v = e == 0u ? 0.125f * (float)m : (1.0f + 0.125f * (float)m) * (float)(1u << (e - 1u));
    return (c & 32u) ? -v : v;
}
DEV v6u sw_pack32(const v16f& x, const v16f& y) {
    unsigned w[6] = {0u, 0u, 0u, 0u, 0u, 0u};
#pragma unroll
    for (int i = 0; i < 32; ++i) {
        const unsigned c = fp6_enc1(i < 16 ? x[i] : y[i - 16]);
        const int bit = 6 * i, d = bit >> 5, sh = bit & 31;
        w[d] |= c << sh;
        if (sh > 26) w[d + 1] |= c >> (32 - sh);
    }
    v6u r; r[0] = w[0]; r[1] = w[1]; r[2] = w[2]; r[3] = w[3]; r[4] = w[4]; r[5] = w[5]; return r;
}
DEV v32f sw_unpack32(const v6u& pk) {
    const unsigned w[6] = {pk[0], pk[1], pk[2], pk[3], pk[4], pk[5]};
    v32f r;
#pragma unroll
    for (int i = 0; i < 32; ++i) {
        const int bit = 6 * i, d = bit >> 5, sh = bit & 31;
        unsigned c = w[d] >> sh;
        if (sh > 26) c |= w[d + 1] << (32 - sh);
        r[i] = fp6_dec1(c & 63u);
    }
    return r;
}
#define FP6_PACK(x, y) sw_pack32(x, y)
#define FP6_UNPACK(pk) __builtin_amdgcn_cvt_scalef32_pk32_f32_fp6(pk, FP6_ONE)

typedef float f32x2_t __attribute__((ext_vector_type(2)));
DEV unsigned fp4_enc1(float f) {
    const float a = fminf(fabsf(f), 6.0f);
    const float sc = a < 2.0f ? 2.0f : (a < 4.0f ? 1.0f : 0.5f), of = a < 2.0f ? 0.0f : (a < 4.0f ? 2.0f : 4.0f);
    const unsigned code = (unsigned)(int)__builtin_rintf(a * sc + of);
    return code | ((__float_as_uint(f) >> 28) & 8u);
}
DEV void fp4_unpack8(unsigned w, float* f) {
    const f32x2_t a = __builtin_amdgcn_cvt_scalef32_pk_f32_fp4(w, FP6_ONE, 0), b = __builtin_amdgcn_cvt_scalef32_pk_f32_fp4(w, FP6_ONE, 1);
    const f32x2_t c = __builtin_amdgcn_cvt_scalef32_pk_f32_fp4(w, FP6_ONE, 2), d = __builtin_amdgcn_cvt_scalef32_pk_f32_fp4(w, FP6_ONE, 3);
    f[0] = a.x; f[1] = a.y; f[2] = b.x; f[3] = b.y; f[4] = c.x; f[5] = c.y; f[6] = d.x; f[7] = d.y;
}
DEV void st_tab4(const P& p, const float* __restrict__ src, unsigned char* __restrict__ dst, float scale, int nrows, int unit, int nunits, char* smem) {
    const int tid_ = tidx(), w = tid_ >> 6, l = tid_ & 63;
    float* stg = (float*)smem + w * (64 * 36);
    int sh[8];
#pragma unroll
    for (int k = 0; k < 8; ++k) sh[k] = 4 * __builtin_amdgcn_readfirstlane(p.PI()[40 + k]);
    for (int r = unit * 4 + w; r < nrows; r += nunits * 4) {
        const float4* sp = (const float4*)(src + (size_t)r * 2048);
        float4 v[8];
#pragma unroll
        for (int i = 0; i < 8; ++i) v[i] = sp[l + 64 * i];
#pragma unroll
        for (int i = 0; i < 8; ++i) { const int f = l + 64 * i; *(float4*)(stg + (f >> 3) * 36 + (f & 7) * 4) = v[i]; }
        __builtin_amdgcn_wave_barrier();
        unsigned wd[4] = {0u, 0u, 0u, 0u};
#pragma unroll
        for (int q = 0; q < 8; ++q) {
            const float4 a = *(const float4*)(stg + l * 36 + q * 4);
            const float xv[4] = {a.x, a.y, a.z, a.w};
#pragma unroll
            for (int e = 0; e < 4; ++e) { const int j = q * 4 + e; wd[j >> 3] |= fp4_enc1(xv[e] * scale) << sh[j & 7]; }
        }
        *(uint4*)(dst + (size_t)r * ROW6 + l * 16) = make_uint4(wd[0], wd[1], wd[2], wd[3]);
        __builtin_amdgcn_wave_barrier();
    }
}
DEV void st_tab6(const float* __restrict__ src, unsigned char* __restrict__ dst, float scale, int nrows, int unit, int nunits, char* smem) {
    const int tid_ = tidx(), w = tid_ >> 6, l = tid_ & 63;
    float* stg = (float*)smem + w * (64 * 36);
    for (int r = unit * 4 + w; r < nrows; r += nunits * 4) {
        const float4* sp = (const float4*)(src + (size_t)r * 2048);
        float4 v[8];
#pragma unroll
        for (int i = 0; i < 8; ++i) v[i] = sp[l + 64 * i];
#pragma unroll
        for (int i = 0; i < 8; ++i) { const int f = l + 64 * i; *(float4*)(stg + (f >> 3) * 36 + (f & 7) * 4) = v[i]; }
        __builtin_amdgcn_wave_barrier();
        v16f x, y;
#pragma unroll
        for (int q = 0; q < 4; ++q) {
            const float4 a = *(const float4*)(stg + l * 36 + q * 4), b = *(const float4*)(stg + l * 36 + 16 + q * 4);
            x[4 * q] = a.x * scale; x[4 * q + 1] = a.y * scale; x[4 * q + 2] = a.z * scale; x[4 * q + 3] = a.w * scale;
            y[4 * q] = b.x * scale; y[4 * q + 1] = b.y * scale; y[4 * q + 2] = b.z * scale; y[4 * q + 3] = b.w * scale;
        }
        const v6u pk = FP6_PACK(x, y);
        unsigned char* dp = dst + (size_t)r * ROW6 + l * 8;
        *(uint2*)(dp) = make_uint2(pk[0], pk[1]); *(uint2*)(dp + 512) = make_uint2(pk[2], pk[3]); *(uint2*)(dp + 1024) = make_uint2(pk[4], pk[5]);
        __builtin_amdgcn_wave_barrier();
    }
}
DEV void st_calib(const P& p) {
    if (tidx() >= 64) return;
    v16f x, y;
#pragma unroll
    for (int k = 0; k < 32; ++k) {
        const int e = k >> 3, m = k & 7;
        const float v = e == 0 ? 0.125f * m : (1.0f + 0.125f * m) * (float)(1 << (e - 1));
        if (k < 16) x[k] = v; else y[k - 16] = v;
    }
    const v6u pk = FP6_PACK(x, y);
    const v32f d = FP6_UNPACK(pk);
    if ((threadIdx.x & 63) == 0) {
        float dmax = 0.f;
#pragma unroll
        for (int j = 0; j < 32; ++j) dmax = fmaxf(dmax, fabsf(d[j]));
        const float cscale = dmax > 0.f ? dmax * (1.0f / 7.5f) : 1.0f;
        const float ic = 1.0f / cscale;
#pragma unroll
        for (int j = 0; j < 32; ++j) {
            int found = j;
#pragma unroll
            for (int k = 0; k < 32; ++k) {
                const int e = k >> 3, m = k & 7;
                const float v = e == 0 ? 0.125f * m : (1.0f + 0.125f * m) * (float)(1 << (e - 1));
                if (fabsf(d[j] * ic - v) < 0.02f + 0.01f * v) found = k;
            }
            p.PI()[j] = found;
        }
        p.PI()[32] = __float_as_int(ic);
    }
#if PEER_FP4
    {
        const unsigned probe = 0x07654321u;
        float f8[8]; fp4_unpack8(probe, f8);
        if ((threadIdx.x & 63) == 0) {
            const float val[8] = {0.f, 0.5f, 1.f, 1.5f, 2.f, 3.f, 4.f, 6.f};
            float dmax = 0.f;
#pragma unroll
            for (int k = 0; k < 8; ++k) dmax = fmaxf(dmax, fabsf(f8[k]));
            const float ic4 = dmax > 0.f ? 6.0f / dmax : 1.0f;
#pragma unroll
            for (int k = 0; k < 8; ++k) {
                int nib = k;
#pragma unroll
                for (int c = 0; c < 8; ++c) if (fabsf(f8[k] * ic4 - val[c]) < 0.1f) nib = (c + 7) & 7;
                p.PI()[40 + k] = nib;
            }
#pragma unroll
            for (int j = 0; j < 32; ++j) p.PI()[j] = j;
            p.PI()[32] = __float_as_int(ic4);
        }
    }
#endif
}

DEV void st_ada(const P& p, int unit, char* smem) {
    float4* red = (float4*)smem;
    const int tid = tidx(), c4 = tid & 15, kg = tid >> 4;
    const int i = unit / 192, j = (unit % 192) * 64 + c4 * 4;
    const float* W = p.ada_w + (size_t)i * 2048 * 12288 + (size_t)kg * 12288 + j;
    float4 acc = make_float4(0.f, 0.f, 0.f, 0.f);
#pragma unroll 1
    for (int k0 = 0; k0 < 128; k0 += 16) {
        float4 wv[16]; float a[16];
#pragma unroll
        for (int q = 0; q < 16; ++q) { const f32x4 t4 = __builtin_nontemporal_load((const f32x4*)(W + (size_t)(16 * (k0 + q)) * 12288)); wv[q] = make_float4(t4[0], t4[1], t4[2], t4[3]); }
#pragma unroll
        for (int q = 0; q < 16; ++q) { const float cv = p.c[kg + 16 * (k0 + q)]; a[q] = cv * sigmoidf_(cv); }
#pragma unroll
        for (int q = 0; q < 16; ++q) { acc.x += a[q] * wv[q].x; acc.y += a[q] * wv[q].y; acc.z += a[q] * wv[q].z; acc.w += a[q] * wv[q].w; }
    }
    red[kg * 16 + c4] = acc;
    __syncthreads();
    if (tid < 64) {
        const int cc = tid >> 2, e = tid & 3;
        float r = p.ada_b[i * 12288 + (unit % 192) * 64 + tid];
#pragma unroll
        for (int q = 0; q < 16; ++q) r += ((const float*)&red[q * 16 + cc])[e];
        p.ada()[i * 12288 + (unit % 192) * 64 + tid] = r;
    }
    __syncthreads();
}
DEV void st_rope(const P& p, int unit) {
    const int e = unit * 256 + tidx(); const int t = e / 24, i = e % 24;
    const double inv = i < 16 ? INV16[i] : INV16[2 * (i - 16)];
    const double ang = (double)p.pos[t] * inv;
    const double n = rint(ang * 0.15915494309189535);
    const double r = ang - n * 6.283185307179586;
    const double r2 = r * r;
    double sp = 1.0 / 1.5511210043330986e25, cp = -1.0 / 4.0329146112660565e26;
    sp = sp * r2 - 1.0 / 2.585201673888498e22;   cp = cp * r2 + 1.0 / 6.204484017332394e23;
    sp = sp * r2 + 1.0 / 5.109094217170944e19;   cp = cp * r2 - 1.0 / 1.1240007277776077e21;
    sp = sp * r2 - 1.0 / 1.21645100408832e17;    cp = cp * r2 + 1.0 / 2.43290200817664e18;
    sp = sp * r2 + 1.0 / 3.55687428096e14;       cp = cp * r2 - 1.0 / 6.402373705728e15;
    sp = sp * r2 - 1.0 / 1.307674368e12;         cp = cp * r2 + 1.0 / 2.0922789888e13;
    sp = sp * r2 + 1.0 / 6.2270208e9;            cp = cp * r2 - 1.0 / 8.71782912e10;
    sp = sp * r2 - 1.0 / 3.99168e7;              cp = cp * r2 + 1.0 / 4.790016e8;
    sp = sp * r2 + 1.0 / 362880.0;               cp = cp * r2 - 1.0 / 3628800.0;
    sp = sp * r2 - 1.0 / 5040.0;                 cp = cp * r2 + 1.0 / 40320.0;
    sp = sp * r2 + 1.0 / 120.0;                  cp = cp * r2 - 1.0 / 720.0;
    sp = sp * r2 - 1.0 / 6.0;                    cp = cp * r2 + 1.0 / 24.0;
    sp = sp * r2 + 1.0;                          cp = cp * r2 - 0.5;
    cp = cp * r2 + 1.0;
    const float cs = (float)cp, sn = (float)(sp * r);
    p.ropeC()[e] = cs; p.ropeS()[e] = sn;
}

DEV void st_norm(const float* __restrict__ X, const float* __restrict__ g, const float* __restrict__ sc, const float* __restrict__ sh,
                 bf16_t* __restrict__ HN, int unit) {
    const int tid_ = tidx(); const int w = tid_ >> 6, l = tid_ & 63; const int t = unit * 4 + w;
    const float4* xr = (const float4*)(X + (size_t)t * D);
    float4 v[8]; float ss = 0.f;
#pragma unroll
    for (int i = 0; i < 4; ++i) { v[2 * i] = xr[i * 128 + l * 2]; v[2 * i + 1] = xr[i * 128 + l * 2 + 1]; }
#pragma unroll
    for (int i = 0; i < 8; ++i) ss += v[i].x * v[i].x + v[i].y * v[i].y + v[i].z * v[i].z + v[i].w * v[i].w;
    ss = wsum(ss);
    const float rs = rsqrtf(ss * (1.0f / 2048.0f) + EPS);
#pragma unroll
    for (int i = 0; i < 4; ++i) {
        const int col = i * 512 + l * 8;
        float y[8]; const float xv[8] = {v[2 * i].x, v[2 * i].y, v[2 * i].z, v[2 * i].w, v[2 * i + 1].x, v[2 * i + 1].y, v[2 * i + 1].z, v[2 * i + 1].w};
#pragma unroll
        for (int j = 0; j < 8; ++j) y[j] = (xv[j] * rs) * g[col + j] * (1.0f + sc[col + j]) + sh[col + j];
        uint4 o; o.x = pk2(y[0], y[1]); o.y = pk2(y[2], y[3]); o.z = pk2(y[4], y[5]); o.w = pk2(y[6], y[7]);
        *(uint4*)(HN + (size_t)t * D + col) = o;
    }
}

enum { EPI_PROJ = 0, EPI_OUT = 1, EPI_Q = 2 };
struct EpiArgs { bf16_t* obf; float* of; const float* xin; const float* gate; bf16_t* kvc; };
template <int EPI, int MT = 4>
DEV void st_gemm(const bf16_t* __restrict__ A, const bf16_t* __restrict__ Bt, int K, int tm, int tn, const EpiArgs& e, char* smem) {
    constexpr int BM = 32 * MT, ABYTES = BM * 64, BUFB = ABYTES + 8192, NBUF = (MT == 4) ? 4 : 3, NA = BM / 64;
    static_assert(NBUF * BUFB <= SMEM_BYTES, "GEMM LDS");
    const int tid = tidx(), w = tid >> 6, l = tid & 63, wr = w >> 1, wc = w & 1;
    f32x4 acc[MT][4];
#pragma unroll
    for (int m = 0; m < MT; ++m)
#pragma unroll
        for (int n = 0; n < 4; ++n) acc[m][n] = (f32x4){0.f, 0.f, 0.f, 0.f};
    const int srow = tid >> 2, spc = tid & 3, sc = spc ^ (((srow >> 2) & 1) << 1);
    const bf16_t* Ag = A + (size_t)(tm * BM + srow) * K + sc * 8;
    const bf16_t* Bg = Bt + (size_t)(tn * 128 + srow) * K + sc * 8;
#define GEMM_STAGE(BUF, KO) do { char* _b = smem + (BUF) * BUFB + tid * 16; \
        _Pragma("unroll") for (int _i = 0; _i < NA; ++_i) \
            __builtin_amdgcn_global_load_lds((const unsigned*)(Ag + (size_t)(64 * _i) * K + (KO)), (__attribute__((address_space(3))) unsigned*)(_b + _i * 4096), 16, 0, 0); \
        __builtin_amdgcn_global_load_lds((const unsigned*)(Bg + (KO)), (__attribute__((address_space(3))) unsigned*)(_b + ABYTES), 16, 0, 0); \
        __builtin_amdgcn_global_load_lds((const unsigned*)(Bg + (size_t)64 * K + (KO)), (__attribute__((address_space(3))) unsigned*)(_b + ABYTES + 4096), 16, 0, 0); } while (0)
    const int nk = K / 32;
    GEMM_STAGE(0, 0); GEMM_STAGE(1, 32);
    if (NBUF == 4) { GEMM_STAGE(2, 64); asm volatile("s_waitcnt vmcnt(8)" ::: "memory"); }
    else asm volatile("s_waitcnt vmcnt(6)" ::: "memory");
    __builtin_amdgcn_s_barrier();
    const int fr = l & 15, fq = l >> 4;
    int cur = 0, nxt = NBUF - 1;
#pragma unroll 1
    for (int kt = 0; kt < nk; ++kt) {
        if (kt + NBUF - 1 < nk) GEMM_STAGE(nxt, (kt + NBUF - 1) * 32);
        const char* As = smem + cur * BUFB; const char* Bs = As + ABYTES;
        bf16x8 bfr[4];
#pragma unroll
        for (int n = 0; n < 4; ++n) { const int row = wc * 64 + n * 16 + fr; bfr[n] = *(const bf16x8*)(Bs + row * 64 + ((fq ^ (((row >> 2) & 1) << 1)) << 4)); }
#pragma unroll
        for (int m = 0; m < MT; ++m) {
            const int row = wr * (BM / 2) + m * 16 + fr;
            const bf16x8 af = *(const bf16x8*)(As + row * 64 + ((fq ^ (((row >> 2) & 1) << 1)) << 4));
#pragma unroll
            for (int n = 0; n < 4; ++n) acc[m][n] = mfma16(bfr[n], af, acc[m][n]);
        }
        if (NBUF == 4) {
            if (kt + 3 < nk) asm volatile("s_waitcnt vmcnt(8)" ::: "memory");
            else if (kt + 2 < nk) asm volatile("s_waitcnt vmcnt(4)" ::: "memory");
            else asm volatile("s_waitcnt vmcnt(0)" ::: "memory");
        } else {
            if (kt + 2 < nk) asm volatile("s_waitcnt vmcnt(6)" ::: "memory");
            else asm volatile("s_waitcnt vmcnt(0)" ::: "memory");
        }
        asm volatile("s_waitcnt lgkmcnt(0)" ::: "memory");
        __builtin_amdgcn_s_barrier();
        cur = (cur + 1 == NBUF) ? 0 : cur + 1; nxt = (nxt + 1 == NBUF) ? 0 : nxt + 1;
    }
#undef GEMM_STAGE
#pragma unroll
    for (int m = 0; m < MT; ++m) {
        const int row = tm * BM + wr * (BM / 2) + m * 16 + (l & 15);
#pragma unroll
        for (int n = 0; n < 4; ++n) {
            const int col = tn * 128 + wc * 64 + n * 16 + 4 * (l >> 4);
            const f32x4 a = acc[m][n];
            if (EPI == EPI_PROJ) {
                uint2 o; o.x = pk2(a[0], a[1]); o.y = pk2(a[2], a[3]);
                *(uint2*)(e.obf + (size_t)row * LDP + col) = o;
                if (col >= C_NKC && col < C_NKC + 256) *(uint2*)(e.kvc + (size_t)row * 256 + (col - C_NKC)) = o;
            } else if (EPI == EPI_OUT) {
                const float4 xi = *(const float4*)(e.xin + (size_t)row * D + col);
                const float4 gg = *(const float4*)(e.gate + col);
                float4 o; o.x = xi.x + gg.x * a[0]; o.y = xi.y + gg.y * a[1]; o.z = xi.z + gg.z * a[2]; o.w = xi.w + gg.w * a[3];
                *(float4*)(e.of + (size_t)row * D + col) = o;
            } else {
                float4 o; o.x = a[0]; o.y = a[1]; o.z = a[2]; o.w = a[3];
                *(float4*)(e.of + (size_t)row * 1024 + col) = o;
            }
        }
    }
    __syncthreads();
}

DEV void st_conv(const P& p, int layer, int unit, char* smem) {
    float* cs = (float*)smem;
    const int tid = tidx(), t0 = unit * 16;
    const float* cw = p.conv_w + (size_t)layer * 31 * 512;
#pragma unroll 1
    for (int cc = 0; cc < 2; ++cc) {
        const int c = tid + 256 * cc;
        float w[31], z[46];
#pragma unroll
        for (int k = 0; k < 31; ++k) w[k] = cw[k * 512 + c];
#pragma unroll
        for (int r = 0; r < 46; ++r) {
            const int t = t0 - 30 + r, tc = t < 0 ? 0 : t;
            const float a = bf2f(p.PROJ()[(size_t)tc * LDP + C_CA + c]), g = bf2f(p.PROJ()[(size_t)tc * LDP + C_CG + c]);
            z[r] = t >= 0 ? a * sigmoidf_(g) : 0.f;
        }
        const float cb = p.conv_b[layer * 512 + c];
#pragma unroll
        for (int tt = 0; tt < 16; ++tt) {
            float acc = cb;
#pragma unroll
            for (int k = 0; k < 31; ++k) acc += w[k] * z[tt + k];
            cs[tt * 512 + c] = acc;
        }
    }
    __syncthreads();
    const int w = tid >> 6, l = tid & 63;
    const float* lg = p.cln_g + layer * 512; const float* lb = p.cln_b + layer * 512;
#pragma unroll 1
    for (int q = 0; q < 4; ++q) {
        const int tt = w * 4 + q;
        float v[8]; float s = 0.f;
#pragma unroll
        for (int i = 0; i < 8; ++i) { v[i] = cs[tt * 512 + l + 64 * i]; s += v[i]; }
        const float mean = wsum(s) * (1.0f / 512.0f);
        float q2 = 0.f;
#pragma unroll
        for (int i = 0; i < 8; ++i) { const float d = v[i] - mean; q2 += d * d; }
        const float rstd = rsqrtf(wsum(q2) * (1.0f / 512.0f) + EPS);
#pragma unroll
        for (int i = 0; i < 8; ++i) {
            const int c = l + 64 * i;
            const float y = (v[i] - mean) * rstd * lg[c] + lb[c];
            p.Y()[(size_t)(t0 + tt) * D + c] = f2bf(y * sigmoidf_(y));
        }
    }
    __syncthreads();
}

DEV void st_sgu(const P& p, int layer, int unit, char* smem) {
    constexpr int RSB = 136;
    const int n = unit >> 2, h = unit & 3, tid = tidx(), w = tid >> 6, l = tid & 63;
    float* stat = (float*)smem;
    bf16_t* wtb = (bf16_t*)(smem + 1024);
    bf16_t* vtb = wtb + 128 * RSB;
    const int tb = n * 128;
#pragma unroll 4
    for (int q = 0; q < 32; ++q) {
        const int j = w * 32 + q;
        const uint4 raw = *(const uint4*)(p.PROJ() + (size_t)(tb + j) * LDP + C_SV + l * 8);
        float v[8] = {lo2f(raw.x), hi2f(raw.x), lo2f(raw.y), hi2f(raw.y), lo2f(raw.z), hi2f(raw.z), lo2f(raw.w), hi2f(raw.w)};
        float s = 0.f;
#pragma unroll
        for (int i = 0; i < 8; ++i) s += v[i];
        const float mean = wsum(s) * (1.0f / 512.0f);
        float q2 = 0.f;
#pragma unroll
        for (int i = 0; i < 8; ++i) { const float d = v[i] - mean; q2 += d * d; }
        const float rstd = rsqrtf(wsum(q2) * (1.0f / 512.0f) + EPS);
        if (l == 0) { stat[j * 2] = mean; stat[j * 2 + 1] = rstd; }
    }
    const float* Wh = p.sgu_w + ((size_t)layer * 4 + h) * 128 * 128;
    {
        float4 wv[16];
#pragma unroll
        for (int q = 0; q < 16; ++q) wv[q] = *(const float4*)(Wh + (size_t)(tid + 256 * q) * 4);
#pragma unroll
        for (int q = 0; q < 16; ++q) {
            const int f = tid + 256 * q, i = f >> 5, j4 = (f & 31) * 4;
            const float x4[4] = {wv[q].x, wv[q].y, wv[q].z, wv[q].w};
#pragma unroll
            for (int e = 0; e < 4; ++e) wtb[(j4 + e) * RSB + i] = (i >= j4 + e) ? f2bf(x4[e]) : (bf16_t)0;
        }
    }
    __syncthreads();
    {
        const float* lg = p.sln_g + layer * 512 + h * 128; const float* lb = p.sln_b + layer * 512 + h * 128;
        uint4 vr[8];
#pragma unroll
        for (int q = 0; q < 8; ++q) { const int f = tid + 256 * q, j = f >> 4, d8 = (f & 15) * 8; vr[q] = *(const uint4*)(p.PROJ() + (size_t)(tb + j) * LDP + C_SV + h * 128 + d8); }
#pragma unroll
        for (int q = 0; q < 8; ++q) {
            const int f = tid + 256 * q, j = f >> 4, d8 = (f & 15) * 8;
            const float mean = stat[j * 2], rstd = stat[j * 2 + 1];
            const float4 g0 = *(const float4*)(lg + d8), g1 = *(const float4*)(lg + d8 + 4), b0 = *(const float4*)(lb + d8), b1 = *(const float4*)(lb + d8 + 4);
            uint4 o;
            o.x = pk2((lo2f(vr[q].x) - mean) * rstd * g0.x + b0.x, (hi2f(vr[q].x) - mean) * rstd * g0.y + b0.y);
            o.y = pk2((lo2f(vr[q].y) - mean) * rstd * g0.z + b0.z, (hi2f(vr[q].y) - mean) * rstd * g0.w + b0.w);
            o.z = pk2((lo2f(vr[q].z) - mean) * rstd * g1.x + b1.x, (hi2f(vr[q].z) - mean) * rstd * g1.y + b1.y);
            o.w = pk2((lo2f(vr[q].w) - mean) * rstd * g1.z + b1.z, (hi2f(vr[q].w) - mean) * rstd * g1.w + b1.w);
            *(uint4*)(vtb + j * RSB + d8) = o;
        }
    }
    __syncthreads();
    const int ti = tid >> 4, td = tid & 15;
    float acc[8][8];
#pragma unroll
    for (int a = 0; a < 8; ++a)
#pragma unroll
        for (int bq = 0; bq < 8; ++bq) acc[a][bq] = 0.f;
    const int jend = w * 32 + 32;
#pragma unroll 2
    for (int j = 0; j < jend; ++j) {
        const uint4 wr = *(const uint4*)(wtb + j * RSB + ti * 8), vr = *(const uint4*)(vtb + j * RSB + td * 8);
        const float wv[8] = {lo2f(wr.x), hi2f(wr.x), lo2f(wr.y), hi2f(wr.y), lo2f(wr.z), hi2f(wr.z), lo2f(wr.w), hi2f(wr.w)};
        const float vv[8] = {lo2f(vr.x), hi2f(vr.x), lo2f(vr.y), hi2f(vr.y), lo2f(vr.z), hi2f(vr.z), lo2f(vr.w), hi2f(vr.w)};
#pragma unroll
        for (int a = 0; a < 8; ++a)
#pragma unroll
            for (int bq = 0; bq < 8; ++bq) acc[a][bq] += wv[a] * vv[bq];
    }
#pragma unroll
    for (int a = 0; a < 8; ++a) {
        const int i = ti * 8 + a; const size_t t = tb + i;
        const float bs = p.sgu_b[((size_t)layer * 4 + h) * 128 + i];
        const uint4 ur = *(const uint4*)(p.PROJ() + t * LDP + C_SU + h * 128 + td * 8);
        const float u[8] = {lo2f(ur.x), hi2f(ur.x), lo2f(ur.y), hi2f(ur.y), lo2f(ur.z), hi2f(ur.z), lo2f(ur.w), hi2f(ur.w)};
        float y[8];
#pragma unroll
        for (int bq = 0; bq < 8; ++bq) y[bq] = u[bq] * (acc[a][bq] + bs);
        uint4 o; o.x = pk2(y[0], y[1]); o.y = pk2(y[2], y[3]); o.z = pk2(y[4], y[5]); o.w = pk2(y[6], y[7]);
        *(uint4*)(p.Y() + t * D + 512 + h * 128 + td * 8) = o;
    }
    __syncthreads();
}

DEV void st_vtrans(const P& p, int unit, char* smem) {
    bf16_t* tile = (bf16_t*)smem;
    const int which = unit & 1, tt0 = (unit >> 1) * 64, tid = tidx();
    const int col0 = which ? C_NVW : C_NVS;
    bf16_t* dst = which ? p.VWT() : p.VST();
#pragma unroll
    for (int q = 0; q < 4; ++q) {
        const int e = tid + 256 * q; const int r = e >> 4, c8 = e & 15;
        const uint4 raw = *(const uint4*)(p.PROJ() + (size_t)(tt0 + r) * LDP + col0 + c8 * 8);
        unsigned* d32 = (unsigned*)(tile + r * 130 + c8 * 8);
        d32[0] = raw.x; d32[1] = raw.y; d32[2] = raw.z; d32[3] = raw.w;
    }
    __syncthreads();
    const int d = tid >> 1, half = tid & 1;
    unsigned o[16];
#pragma unroll
    for (int i = 0; i < 16; ++i) {
        const unsigned a = tile[(half * 32 + 2 * i) * 130 + d], b = tile[(half * 32 + 2 * i + 1) * 130 + d];
        o[i] = a | (b << 16);
    }
    uint4* dp = (uint4*)(dst + (size_t)d * T + tt0 + half * 32);
#pragma unroll
    for (int i = 0; i < 4; ++i) dp[i] = make_uint4(o[4 * i], o[4 * i + 1], o[4 * i + 2], o[4 * i + 3]);
    __syncthreads();
}

DEV void st_prep(const P& p, int layer, int unit) {
    const int tid_ = tidx(); const int w = tid_ >> 6, l = tid_ & 63; const size_t t = (size_t)unit * 4 + w;
    const bf16_t* row = p.PROJ() + t * LDP;
    const float* rc = p.ropeC() + t * 24; const float* rs_ = p.ropeS() + t * 24;
    unsigned raw[11];
#pragma unroll
    for (int h = 0; h < 4; ++h) { raw[h] = *(const unsigned*)(row + C_NQ + h * 128 + 2 * l); raw[6 + h] = *(const unsigned*)(row + C_DQ + h * 128 + 2 * l); }
    raw[4] = *(const unsigned*)(row + C_NKS + 2 * l); raw[5] = *(const unsigned*)(row + C_NKW + 2 * l); raw[10] = *(const unsigned*)(row + C_DK + 2 * l);
    bf16_t iraw[9];
#pragma unroll
    for (int h = 0; h < 9; ++h) iraw[h] = row[(h < 8 ? C_IQ + h * 64 : C_IK) + l];
    const float gq0 = p.nsa_qg[layer * 128 + 2 * l], gq1 = p.nsa_qg[layer * 128 + 2 * l + 1];
    const float gs0 = p.nsa_kg[(layer * 3 + 1) * 128 + 2 * l], gs1 = p.nsa_kg[(layer * 3 + 1) * 128 + 2 * l + 1];
    const float gw0 = p.nsa_kg[(layer * 3 + 2) * 128 + 2 * l], gw1 = p.nsa_kg[(layer * 3 + 2) * 128 + 2 * l + 1];
    const float dq0 = p.dsa_qg[layer * 128 + 2 * l], dq1 = p.dsa_qg[layer * 128 + 2 * l + 1];
    const float dk0 = p.dsa_kg[layer * 128 + 2 * l], dk1 = p.dsa_kg[layer * 128 + 2 * l + 1];
    const float c0 = rc[(2 * l) & 15], c1 = rc[(2 * l + 1) & 15], s0 = rs_[(2 * l) & 15], s1 = rs_[(2 * l + 1) & 15];
    const float ic = rc[16 + (l & 7)], is = rs_[16 + (l & 7)];
    float x0[11], x1[11], ss[11];
#pragma unroll
    for (int h = 0; h < 11; ++h) { x0[h] = lo2f(raw[h]); x1[h] = hi2f(raw[h]); ss[h] = x0[h] * x0[h] + x1[h] * x1[h]; }
#pragma unroll
    for (int h = 0; h < 11; ++h) ss[h] = wsum(ss[h]);
#pragma unroll
    for (int h = 0; h < 11; ++h) {
        const float r = rsqrtf(ss[h] * (1.0f / 128.0f) + EPS);
        const float g0 = h < 4 ? gq0 : (h == 4 ? gs0 : (h == 5 ? gw0 : (h < 10 ? dq0 : dk0)));
        const float g1 = h < 4 ? gq1 : (h == 4 ? gs1 : (h == 5 ? gw1 : (h < 10 ? dq1 : dk1)));
        const float n0 = x0[h] * r * g0, n1 = x1[h] * r * g1;
        const float o0 = __shfl_xor(n0, 8), o1 = __shfl_xor(n1, 8);
        float r0 = n0, r1 = n1;
        if (l < 8) { r0 = n0 * c0 - o0 * s0; r1 = n1 * c1 - o1 * s1; }
        else if (l < 16) { r0 = n0 * c0 + o0 * s0; r1 = n1 * c1 + o1 * s1; }
        const unsigned roped = pk2(r0, r1);
        if (h < 4) { *(unsigned*)(p.QN() + (t * 4 + h) * 128 + 2 * l) = pk2(n0, n1); *(unsigned*)(p.QR() + (t * 4 + h) * 128 + 2 * l) = roped; }
        else if (h == 4) *(unsigned*)(p.KS() + t * 128 + 2 * l) = roped;
        else if (h == 5) *(unsigned*)(p.KW() + t * 128 + 2 * l) = roped;
        else if (h < 10) *(unsigned*)(p.DQ() + (t * 4 + (h - 6)) * 128 + 2 * l) = roped;
        else *(unsigned*)(p.DK() + t * 128 + 2 * l) = roped;
    }
    if (l < 12) p.GATES()[t * 12 + l] = sigmoidf_(bf2f(row[C_NG + l]));
    *(unsigned*)(p.DVC() + t * 128 + 2 * l) = *(const unsigned*)(row + C_DV + 2 * l);
#pragma unroll
    for (int h = 0; h < 9; ++h) {
        const float x = bf2f(iraw[h]);
        const float other = __shfl_xor(x, 8);
        float o = x;
        if (l < 16) o = (l < 8) ? (x * ic - other * is) : (x * ic + other * is);
        if (h < 8) p.IQ()[(t * 8 + h) * 64 + l] = f2bf(o); else p.IK()[t * 64 + l] = f2bf(o);
    }
    if (l < 8) p.IW()[t * 8 + l] = bf2f(row[C_IW + l]) * (0.35355339059327373f * 0.125f);
}

DEV void st_compress(const P& p, int layer, int unit, char* smem) {
    const int which = unit & 1, rt = unit >> 1, tid = tidx(), w = tid >> 6, l = tid & 63, fr = l & 15, fq = l >> 4;
    float* hid = (float*)smem;
    float* ob = hid + 16 * 128;
    const int nb = rt * 16 + fr;
    const int col0 = which ? C_NVC : C_NKC;
    const float* ps = p.cmp_pos + ((size_t)layer * 2 + which) * 4096;
    const bf16_t* w1t = p.W1T() + ((size_t)layer * 2 + which) * 128 * 4096;
    const bool rowok = nb < 511;
    const bf16_t* xrow = p.KVC() + (size_t)(rowok ? nb * 16 : 0) * 256 + (which ? 128 : 0);
    f32x4 acc[2] = {(f32x4){0.f, 0.f, 0.f, 0.f}, (f32x4){0.f, 0.f, 0.f, 0.f}};
#pragma unroll 8
    for (int ks = 0; ks < 128; ++ks) {
        const int k = ks * 32 + fq * 8, lt = k >> 7, d = k & 127;
        const uint4 xr = *(const uint4*)(xrow + (size_t)lt * 256 + d);
        const float4 p0 = *(const float4*)(ps + k), p1 = *(const float4*)(ps + k + 4);
        union { bf16x8 v; unsigned u32[4]; } a;
        a.u32[0] = pk2(lo2f(xr.x) + p0.x, hi2f(xr.x) + p0.y); a.u32[1] = pk2(lo2f(xr.y) + p0.z, hi2f(xr.y) + p0.w);
        a.u32[2] = pk2(lo2f(xr.z) + p1.x, hi2f(xr.z) + p1.y); a.u32[3] = pk2(lo2f(xr.w) + p1.z, hi2f(xr.w) + p1.w);
#pragma unroll
        for (int nt = 0; nt < 2; ++nt) {
            const bf16x8 b = *(const bf16x8*)(w1t + (size_t)(w * 32 + nt * 16 + fr) * 4096 + k);
            acc[nt] = mfma16(a.v, b, acc[nt]);
        }
    }
#pragma unroll
    for (int nt = 0; nt < 2; ++nt)
#pragma unroll
        for (int r = 0; r < 4; ++r) hid[(4 * fq + r) * 128 + w * 32 + nt * 16 + fr] = gelu_tanh(acc[nt][r]);
    __syncthreads();
    const float* w2 = p.cmp_w2 + ((size_t)layer * 2 + which) * 128 * 128;
    const int c2 = tid & 127, mh = tid >> 7;
    float o[8];
#pragma unroll
    for (int b = 0; b < 8; ++b) o[b] = 0.f;
#pragma unroll 1
    for (int k0 = 0; k0 < 128; k0 += 32) {
        float wv[32];
#pragma unroll
        for (int k = 0; k < 32; ++k) wv[k] = w2[(k0 + k) * 128 + c2];
#pragma unroll
        for (int k4 = 0; k4 < 8; ++k4)
#pragma unroll
            for (int b = 0; b < 8; ++b) {
                const float4 h4 = *(const float4*)(hid + (mh * 8 + b) * 128 + k0 + k4 * 4);
                o[b] += h4.x * wv[4 * k4] + h4.y * wv[4 * k4 + 1] + h4.z * wv[4 * k4 + 2] + h4.w * wv[4 * k4 + 3];
            }
    }
#pragma unroll
    for (int b = 0; b < 8; ++b) ob[(mh * 8 + b) * 128 + c2] = o[b];
    __syncthreads();
#pragma unroll
    for (int q = 0; q < 4; ++q) {
        const int b = w * 4 + q, nbo = rt * 16 + b;
        float v0 = ob[b * 128 + l], v1 = ob[b * 128 + l + 64];
        if (which == 0) {
            const float r = rsqrtf(wsum(v0 * v0 + v1 * v1) * (1.0f / 128.0f) + EPS);
            const float* kg = p.nsa_kg + (layer * 3 + 0) * 128;
            v0 = v0 * r * kg[l]; v1 = v1 * r * kg[l + 64];
            if (nbo >= 511) { v0 = 0.f; v1 = 0.f; }
            p.KC()[nbo * 128 + l] = f2bf(v0); p.KC()[nbo * 128 + l + 64] = f2bf(v1);
        } else {
            if (nbo >= 511) { v0 = 0.f; v1 = 0.f; }
            p.VCT()[l * 512 + nbo] = f2bf(v0); p.VCT()[(l + 64) * 512 + nbo] = f2bf(v1);
        }
    }
    __syncthreads();
}

DEV void st_nsa_cmp(const P& p, int unit, char* smem) {
    constexpr int RSK = 272, RSV = 136, BUFB = 64 * RSK + 128 * RSV;
    const int tid = tidx(), w = tid >> 6, l = tid & 63, qc = l & 15, g4 = l >> 4;
    const int t0 = unit * 16 + w * 4;
    const int tk = qc >> 2, hd = qc & 3, t = t0 + tk;
    bf16x8 qf[4];
#pragma unroll
    for (int ks = 0; ks < 4; ++ks) qf[ks] = *(const bf16x8*)(p.QN() + ((size_t)t0 * 4 + qc) * 128 + ks * 32 + g4 * 8);
    const int tmaxb = unit * 16 + 15;
    const int nvb = tmaxb >= 31 ? (tmaxb - 31) / 16 + 1 : 0;
    const int nsteps = (nvb + 63) >> 6;
    const int nvis = t >= 31 ? (t - 31) / 16 + 1 : 0;
    const float cs = 0.08838834764831845f * 1.4426950408889634f;
    const int krow = tid >> 4, kc16 = tid & 15, vrow = tid >> 3, vc16 = tid & 7;
    const bf16_t* Kg = p.KC(); const bf16_t* Vg = p.VCT();
    int gstep = 0;
    uint4 rk0, rk1, rk2, rk3, rv0, rv1, rv2, rv3;
#define CMP_LOADK(ST) do { const bf16_t* kb = Kg + (size_t)((ST) * 64 + krow) * 128 + kc16 * 8; \
        rk0 = *(const uint4*)kb; rk1 = *(const uint4*)(kb + 16 * 128); rk2 = *(const uint4*)(kb + 32 * 128); rk3 = *(const uint4*)(kb + 48 * 128); } while (0)
#define CMP_LOADV(ST) do { const bf16_t* vb = Vg + (size_t)vrow * 512 + (ST) * 64 + vc16 * 8; \
        rv0 = *(const uint4*)vb; rv1 = *(const uint4*)(vb + 32 * 512); rv2 = *(const uint4*)(vb + 64 * 512); rv3 = *(const uint4*)(vb + 96 * 512); } while (0)
#define CMP_STOREK(KT) do { *(uint4*)((KT) + krow * RSK + kc16 * 16) = rk0; *(uint4*)((KT) + (krow + 16) * RSK + kc16 * 16) = rk1; \
        *(uint4*)((KT) + (krow + 32) * RSK + kc16 * 16) = rk2; *(uint4*)((KT) + (krow + 48) * RSK + kc16 * 16) = rk3; } while (0)
#define CMP_STOREV(VT) do { *(uint4*)((VT) + vrow * RSV + vc16 * 16) = rv0; *(uint4*)((VT) + (vrow + 32) * RSV + vc16 * 16) = rv1; \
        *(uint4*)((VT) + (vrow + 64) * RSV + vc16 * 16) = rv2; *(uint4*)((VT) + (vrow + 96) * RSV + vc16 * 16) = rv3; } while (0)
    float m = -1e30f, lsum = 0.f;
    if (nsteps > 0) CMP_LOADK(0);
#pragma unroll 1
    for (int st = 0; st < nsteps; ++st, ++gstep) {
        char* Kt = smem + (gstep & 1) * BUFB;
        CMP_STOREK(Kt);
        __syncthreads();
        if (st + 1 < nsteps) CMP_LOADK(st + 1);
        float mx = m; f32x4 sv[4];
#pragma unroll
        for (int sub = 0; sub < 4; ++sub) {
            f32x4 a4 = (f32x4){0.f, 0.f, 0.f, 0.f};
#pragma unroll
            for (int ks = 0; ks < 4; ++ks) a4 = mfma16(*(const bf16x8*)(Kt + (sub * 16 + qc) * RSK + (ks * 32 + g4 * 8) * 2), qf[ks], a4);
#pragma unroll
            for (int r = 0; r < 4; ++r) { const int key = st * 64 + sub * 16 + 4 * g4 + r; a4[r] = (key < nvis) ? a4[r] * cs : -3e38f; mx = fmaxf(mx, a4[r]); }
            sv[sub] = a4;
        }
        float ps = 0.f;
#pragma unroll
        for (int sub = 0; sub < 4; ++sub)
#pragma unroll
            for (int r = 0; r < 4; ++r) ps += __builtin_amdgcn_exp2f(sv[sub][r] - mx);
        lsum = lsum * __builtin_amdgcn_exp2f(m - mx) + ps; m = mx;
    }
    {
        float mt_ = fmaxf(m, __shfl_xor(m, 16)); mt_ = fmaxf(mt_, __shfl_xor(mt_, 32));
        lsum *= __builtin_amdgcn_exp2f(m - mt_); m = mt_;
        lsum += __shfl_xor(lsum, 16); lsum += __shfl_xor(lsum, 32);
    }
    const float inv = (nvis > 0 && lsum > 0.f) ? 1.0f / lsum : 0.f;
    f32x4 o[8];
#pragma unroll
    for (int mt = 0; mt < 8; ++mt) o[mt] = (f32x4){0.f, 0.f, 0.f, 0.f};
    float yprev = 0.f;
    float impv[32];
#pragma unroll
    for (int i = 0; i < 32; ++i) impv[i] = 0.f;
    if (nsteps > 0) { CMP_LOADK(0); CMP_LOADV(0); }
#pragma unroll
    for (int st = 0; st < 8; ++st) {
        if (st < nsteps) {
            char* Kt = smem + (gstep & 1) * BUFB; char* Vt = Kt + 64 * RSK; ++gstep;
            CMP_STOREK(Kt); CMP_STOREV(Vt);
            __syncthreads();
            if (st + 1 < nsteps) { CMP_LOADK(st + 1); CMP_LOADV(st + 1); }
            f32x4 sv[4];
#pragma unroll
            for (int sub = 0; sub < 4; ++sub) {
                f32x4 a4 = (f32x4){0.f, 0.f, 0.f, 0.f};
#pragma unroll
                for (int ks = 0; ks < 4; ++ks) a4 = mfma16(*(const bf16x8*)(Kt + (sub * 16 + qc) * RSK + (ks * 32 + g4 * 8) * 2), qf[ks], a4);
#pragma unroll
                for (int r = 0; r < 4; ++r) { const int key = st * 64 + sub * 16 + 4 * g4 + r; a4[r] = (key < nvis) ? __builtin_amdgcn_exp2f(a4[r] * cs - m) * inv : 0.f; }
                const float y = __shfl(a4[3], (l + 48) & 63);
                float iv = (a4[0] + a4[1]) + (a4[2] + a4[3]) + (g4 > 0 ? y : yprev);
                yprev = y;
                iv += __shfl_xor(iv, 1); iv += __shfl_xor(iv, 2);
                impv[st * 4 + sub] = iv;
                sv[sub] = a4;
            }
#pragma unroll
            for (int pr = 0; pr < 2; ++pr) {
                union { bf16x8 v; unsigned u32[4]; } bb;
                bb.u32[0] = pk2(sv[2 * pr][0], sv[2 * pr][1]); bb.u32[1] = pk2(sv[2 * pr][2], sv[2 * pr][3]);
                bb.u32[2] = pk2(sv[2 * pr + 1][0], sv[2 * pr + 1][1]); bb.u32[3] = pk2(sv[2 * pr + 1][2], sv[2 * pr + 1][3]);
#pragma unroll
                for (int mt = 0; mt < 8; ++mt) {
                    const char* vp = Vt + (mt * 16 + qc) * RSV + (pr * 32 + 4 * g4) * 2;
                    union { bf16x8 v; uint2 h2[2]; } aa;
                    aa.h2[0] = *(const uint2*)vp; aa.h2[1] = *(const uint2*)(vp + 32);
                    o[mt] = mfma16(aa.v, bb.v, o[mt]);
                }
            }
        }
    }
#undef CMP_LOADK
#undef CMP_LOADV
#undef CMP_STOREK
#undef CMP_STOREV
    __syncthreads();
    float* impl = (float*)smem + w * 512;
    if (hd == 0) {
#pragma unroll
        for (int i = 0; i < 32; ++i) impl[tk * 128 + 4 * i + g4] = impv[i];
    }
#pragma unroll
    for (int mt = 0; mt < 8; ++mt) {
        uint2 ov; ov.x = pk2(o[mt][0], o[mt][1]); ov.y = pk2(o[mt][2], o[mt][3]);
        *(uint2*)(p.OCMP() + ((size_t)t * 4 + hd) * 128 + mt * 16 + 4 * g4) = ov;
    }
    __syncthreads();
    const int li = hd + 4 * g4, cur = t >> 6;
    unsigned long long own[8]; int rank[8];
#pragma unroll
    for (int i = 0; i < 8; ++i) {
        const int j = li + 16 * i; const float v = impl[tk * 128 + j];
        const unsigned k32 = (j == 0 || j == cur || j == cur - 1) ? 0xFFFFFFFFu : (j > cur ? 0u : __float_as_uint(v) + 128u);
        own[i] = ((unsigned long long)k32 << 7) | (unsigned)(127 - j); rank[i] = 0;
    }
#pragma unroll 1
    for (int ip = 0; ip < 8; ++ip) {
#pragma unroll
        for (int q4 = 0; q4 < 4; ++q4) {
            const float4 ov = *(const float4*)(impl + tk * 128 + ip * 16 + q4 * 4);
            const float o4[4] = {ov.x, ov.y, ov.z, ov.w};
#pragma unroll
            for (int e = 0; e < 4; ++e) {
                const int jp = ip * 16 + q4 * 4 + e;
                const unsigned k32 = (jp == 0 || jp == cur || jp == cur - 1) ? 0xFFFFFFFFu : (jp > cur ? 0u : __float_as_uint(o4[e]) + 128u);
                const unsigned long long kp = ((unsigned long long)k32 << 7) | (unsigned)(127 - jp);
#pragma unroll
                for (int i = 0; i < 8; ++i) rank[i] += (kp > own[i]) ? 1 : 0;
            }
        }
    }
    unsigned mw[4] = {0u, 0u, 0u, 0u};
#pragma unroll
    for (int i = 0; i < 8; ++i) if (rank[i] < 16) mw[i >> 1] |= 1u << (li + 16 * (i & 1));
#pragma unroll
    for (int q = 0; q < 4; ++q) {
        unsigned v = mw[q];
        v |= __shfl_xor(v, 1); v |= __shfl_xor(v, 2); v |= __shfl_xor(v, 16); v |= __shfl_xor(v, 32);
        mw[q] = v;
    }
    if (li == 0) *(uint4*)(p.SEL() + (size_t)t * 4) = make_uint4(mw[0], mw[1], mw[2], mw[3]);
    __syncthreads();
}

DEV void st_nsa_attn(const P& p, int unit, char* smem) {
    constexpr int RSK = 272, RSV = 136, BUFB = 64 * RSK + 128 * RSV;
    const int tid = tidx(), w = tid >> 6, l = tid & 63, qc = l & 15, g4 = l >> 4;
    const int tq0 = unit * 16, t = tq0 + w * 4 + (qc >> 2), hd = qc & 3;
    bf16x8 qf[4];
#pragma unroll
    for (int ks = 0; ks < 4; ++ks) qf[ks] = *(const bf16x8*)(p.QR() + ((size_t)t * 4 + hd) * 128 + ks * 32 + g4 * 8);
    const uint4 selw = *(const uint4*)(p.SEL() + (size_t)t * 4);
    const float cs = 0.08838834764831845f * 1.4426950408889634f;
    unsigned part[8][2];
#pragma unroll
    for (int mt = 0; mt < 8; ++mt) { part[mt][0] = 0u; part[mt][1] = 0u; }
    const float g0 = p.GATES()[(size_t)t * 12 + hd * 3];
    int gstep = 0;
    const int krow = tid >> 4, kc16 = tid & 15, vrow = tid >> 3, vc16 = tid & 7;
#pragma unroll 1
    for (int br = 0; br < 2; ++br) {
        const bf16_t* Kg = br ? p.KW() : p.KS(); const bf16_t* Vg = br ? p.VWT() : p.VST();
        const int ktlast = (tq0 + 15) >> 6;
        const int ktfirst = br ? ((tq0 - 511 > 0 ? tq0 - 511 : 0) >> 6) : 0;
        const int nk = ktlast - ktfirst + 1;
        f32x4 o[8];
#pragma unroll
        for (int mt = 0; mt < 8; ++mt) o[mt] = (f32x4){0.f, 0.f, 0.f, 0.f};
        float m = -1e30f, lsum = 0.f;
        uint4 rk0, rk1, rk2, rk3, rv0, rv1, rv2, rv3;
#define NSA_LOAD(KT) do { const bf16_t* kb = Kg + (size_t)((KT) * 64 + krow) * 128 + kc16 * 8; const bf16_t* vb = Vg + (size_t)vrow * T + (KT) * 64 + vc16 * 8; \
        rk0 = *(const uint4*)kb; rk1 = *(const uint4*)(kb + 16 * 128); rk2 = *(const uint4*)(kb + 32 * 128); rk3 = *(const uint4*)(kb + 48 * 128); \
        rv0 = *(const uint4*)vb; rv1 = *(const uint4*)(vb + (size_t)32 * T); rv2 = *(const uint4*)(vb + (size_t)64 * T); rv3 = *(const uint4*)(vb + (size_t)96 * T); } while (0)
        NSA_LOAD(ktfirst);
#pragma unroll 1
        for (int i = 0; i < nk; ++i, ++gstep) {
            const int kt = ktfirst + i;
            char* Kt = smem + (gstep & 1) * BUFB; char* Vt = Kt + 64 * RSK;
            *(uint4*)(Kt + krow * RSK + kc16 * 16) = rk0; *(uint4*)(Kt + (krow + 16) * RSK + kc16 * 16) = rk1;
            *(uint4*)(Kt + (krow + 32) * RSK + kc16 * 16) = rk2; *(uint4*)(Kt + (krow + 48) * RSK + kc16 * 16) = rk3;
            *(uint4*)(Vt + vrow * RSV + vc16 * 16) = rv0; *(uint4*)(Vt + (vrow + 32) * RSV + vc16 * 16) = rv1;
            *(uint4*)(Vt + (vrow + 64) * RSV + vc16 * 16) = rv2; *(uint4*)(Vt + (vrow + 96) * RSV + vc16 * 16) = rv3;
            __syncthreads();
            if (i + 1 < nk) NSA_LOAD(kt + 1);
            int lo, hi = t;
            if (br == 0) {
                const unsigned wv = (kt & 64) ? ((kt & 32) ? selw.w : selw.z) : ((kt & 32) ? selw.y : selw.x);
                lo = 0; hi = ((wv >> (kt & 31)) & 1u) ? t : -1;
            } else lo = t - 511;
            const bool interior = (kt * 64 + 63 <= tq0) && (br == 0 || kt * 64 >= tq0 + 15 - 511);
            f32x4 sv[4];
            float mx = -3e38f;
            if (interior) {
                const float csl = hi >= 0 ? cs : 0.f, add = hi >= 0 ? 0.f : -3e38f;
#pragma unroll
                for (int sub = 0; sub < 4; ++sub) {
                    f32x4 a4 = (f32x4){0.f, 0.f, 0.f, 0.f};
#pragma unroll
                    for (int ks = 0; ks < 4; ++ks) a4 = mfma16(*(const bf16x8*)(Kt + (sub * 16 + qc) * RSK + (ks * 32 + g4 * 8) * 2), qf[ks], a4);
#pragma unroll
                    for (int r = 0; r < 4; ++r) { a4[r] = a4[r] * csl + add; mx = fmaxf(mx, a4[r]); }
                    sv[sub] = a4;
                }
            } else {
#pragma unroll
                for (int sub = 0; sub < 4; ++sub) {
                    f32x4 a4 = (f32x4){0.f, 0.f, 0.f, 0.f};
#pragma unroll
                    for (int ks = 0; ks < 4; ++ks) a4 = mfma16(*(const bf16x8*)(Kt + (sub * 16 + qc) * RSK + (ks * 32 + g4 * 8) * 2), qf[ks], a4);
#pragma unroll
                    for (int r = 0; r < 4; ++r) {
                        const int kp = kt * 64 + sub * 16 + 4 * g4 + r;
                        const bool valid = (kp >= lo) & (kp <= hi);
                        a4[r] = valid ? a4[r] * cs : -3e38f;
                        mx = fmaxf(mx, a4[r]);
                    }
                    sv[sub] = a4;
                }
            }
            mx = fmaxf(mx, __shfl_xor(mx, 16)); mx = fmaxf(mx, __shfl_xor(mx, 32));
            const float mnew = fmaxf(fmaxf(m, mx), -1e30f);
            const float alpha = __builtin_amdgcn_exp2f(m - mnew);
            m = mnew;
            float ps = 0.f;
#pragma unroll
            for (int sub = 0; sub < 4; ++sub)
#pragma unroll
                for (int r = 0; r < 4; ++r) { const float pv = __builtin_amdgcn_exp2f(sv[sub][r] - mnew); sv[sub][r] = pv; ps += pv; }
            lsum = lsum * alpha + ps;
            if (__any(alpha != 1.0f)) {
#pragma unroll
                for (int mt = 0; mt < 8; ++mt) o[mt] *= alpha;
            }
#pragma unroll
            for (int pr = 0; pr < 2; ++pr) {
                union { bf16x8 v; unsigned u32[4]; } bb;
                bb.u32[0] = pk2(sv[2 * pr][0], sv[2 * pr][1]); bb.u32[1] = pk2(sv[2 * pr][2], sv[2 * pr][3]);
                bb.u32[2] = pk2(sv[2 * pr + 1][0], sv[2 * pr + 1][1]); bb.u32[3] = pk2(sv[2 * pr + 1][2], sv[2 * pr + 1][3]);
#pragma unroll
                for (int mt = 0; mt < 8; ++mt) {
                    const char* vp = Vt + (mt * 16 + qc) * RSV + (pr * 32 + 4 * g4) * 2;
                    union { bf16x8 v; uint2 h2[2]; } aa;
                    aa.h2[0] = *(const uint2*)vp; aa.h2[1] = *(const uint2*)(vp + 32);
                    o[mt] = mfma16(aa.v, bb.v, o[mt]);
                }
            }
        }
#undef NSA_LOAD
        lsum += __shfl_xor(lsum, 16); lsum += __shfl_xor(lsum, 32);
        const float gate = p.GATES()[(size_t)t * 12 + hd * 3 + 1 + br];
        const float sc = lsum > 0.f ? gate / lsum : 0.f;
        if (br == 0) {
#pragma unroll
            for (int mt = 0; mt < 8; ++mt) {
                const uint2 oc = *(const uint2*)(p.OCMP() + ((size_t)t * 4 + hd) * 128 + mt * 16 + 4 * g4);
                part[mt][0] = pk2(sc * o[mt][0] + g0 * lo2f(oc.x), sc * o[mt][1] + g0 * hi2f(oc.x));
                part[mt][1] = pk2(sc * o[mt][2] + g0 * lo2f(oc.y), sc * o[mt][3] + g0 * hi2f(oc.y));
            }
        } else {
#pragma unroll
            for (int mt = 0; mt < 8; ++mt) {
                uint2 ov;
                ov.x = pk2(sc * o[mt][0] + lo2f(part[mt][0]), sc * o[mt][1] + hi2f(part[mt][0]));
                ov.y = pk2(sc * o[mt][2] + lo2f(part[mt][1]), sc * o[mt][3] + hi2f(part[mt][1]));
                *(uint2*)(p.Y() + (size_t)t * D + 1024 + hd * 128 + mt * 16 + 4 * g4) = ov;
            }
        }
    }
    __syncthreads();
}

DEV unsigned f2key(float f) { const unsigned u = __float_as_uint(f); return (u & 0x80000000u) ? ~u : (u | 0x80000000u); }
DEV float key2f(unsigned k) { const unsigned u = (k & 0x80000000u) ? (k & 0x7fffffffu) : ~k; return __uint_as_float(u); }
template <int NPASS>
DEV float wave_prune_t(float* sc, unsigned short* ix, unsigned* hist, int m, int l, int& kept) {
    float v[8]; unsigned k[8]; unsigned short id[8]; bool ok[8];
#pragma unroll
    for (int i = 0; i < 8; ++i) {
        const int e = l + 64 * i; ok[i] = e < m;
        v[i] = ok[i] ? sc[e] : 0.f; id[i] = ok[i] ? ix[e] : (unsigned short)0; k[i] = f2key(v[i]);
    }
    unsigned prefix = 0u; int need = 256;
#pragma unroll 1
    for (int pass = 0; pass < NPASS; ++pass) {
        const int shift = 24 - 8 * pass;
        *(uint4*)(hist + 4 * l) = make_uint4(0u, 0u, 0u, 0u);
        __builtin_amdgcn_wave_barrier();
#pragma unroll
        for (int i = 0; i < 8; ++i) {
            const bool in = ok[i] && (pass == 0 || (k[i] >> (shift + 8)) == prefix);
            if (in) atomicAdd(&hist[(k[i] >> shift) & 255u], 1u);
        }
        __builtin_amdgcn_wave_barrier();
        const uint4 hv = *(const uint4*)(hist + 4 * l);
        const unsigned hq[4] = {hv.x, hv.y, hv.z, hv.w};
        const unsigned own = hv.x + hv.y + hv.z + hv.w;
        unsigned tot = own;
#pragma unroll
        for (int o = 1; o < 64; o <<= 1) { const unsigned tv = __shfl_down(tot, o); if (l + o < 64) tot += tv; }
        unsigned cum = tot - own; int found = -1; int nneed = 0;
#pragma unroll
        for (int kk = 3; kk >= 0; --kk) {
            const unsigned c = hq[kk];
            if (found < 0 && (int)cum < need && (int)(cum + c) >= need) { found = 4 * l + kk; nneed = need - (int)cum; }
            cum += c;
        }
        const unsigned long long bal = __ballot(found >= 0);
        const int src = __ffsll((long long)bal) - 1;
        const int digit = __shfl(found, src); need = __shfl(nneed, src);
        prefix = (prefix << 8) | (unsigned)digit;
    }
    int base = 0;
    const unsigned long long ltmask = (1ull << l) - 1ull;
    if (NPASS == 4) {
        const unsigned thr = prefix;
        int ties = 0;
#pragma unroll
        for (int i = 0; i < 8; ++i) {
            const bool gt = ok[i] && k[i] > thr, eq = ok[i] && k[i] == thr;
            const unsigned long long em = __ballot(eq);
            const int trank = ties + __popcll(em & ltmask);
            const bool keep = gt || (eq && trank < need);
            ties += __popcll(em);
            const unsigned long long km = __ballot(keep);
            const int pos = base + __popcll(km & ltmask);
            if (keep) { sc[pos] = v[i]; ix[pos] = id[i]; }
            base += __popcll(km);
        }
        __builtin_amdgcn_wave_barrier();
        kept = base;
        return key2f(thr);
    } else {
        const unsigned lo = prefix << 16;
#pragma unroll
        for (int i = 0; i < 8; ++i) {
            const bool keep = ok[i] && k[i] >= lo;
            const unsigned long long km = __ballot(keep);
            const int pos = base + __popcll(km & ltmask);
            if (keep) { sc[pos] = v[i]; ix[pos] = id[i]; }
            base += __popcll(km);
        }
        __builtin_amdgcn_wave_barrier();
        kept = base;
        return key2f(lo - 1u);
    }
}
DEV float wave_prune(float* sc, unsigned short* ix, unsigned* hist, int m, int l) { int kept; return wave_prune_t<4>(sc, ix, hist, m, l, kept); }
DEV float wave_prune_mid(float* sc, unsigned short* ix, unsigned* hist, int& cnt, int l) {
    int kept; float tau = wave_prune_t<2>(sc, ix, hist, cnt, l, kept);
    if (kept > 352) { tau = wave_prune_t<4>(sc, ix, hist, kept, l, kept); }
    cnt = kept;
    return tau;
}

#define DSA_APPEND2(COND, M64, SV, SCP, IXP, CL, CH) do { \
    const unsigned _ml = (unsigned)(M64), _mh = (unsigned)((M64) >> 32); \
    if (COND) { const int _pos = (h ? (CH) : (CL)) + __popc((h ? _mh : _ml) & ((1u << n) - 1u)); (SCP)[_pos] = (SV); (IXP)[_pos] = (unsigned short)kp; } \
    (CL) += __popc(_ml); (CH) += __popc(_mh); } while (0)
#define DSA_APPEND(SCP, IXP, CNT, M32, MINE, SV) do { \
    const unsigned _m = (M32); \
    if (MINE) { const int _pos = (CNT) + __popc(_m & ((1u << n) - 1u)); (SCP)[_pos] = (SV); (IXP)[_pos] = (unsigned short)kp; } \
    (CNT) += __popc(_m); } while (0)

DEV void st_dsa_index(const P& p, int unit, char* smem) {
    const int tid = tidx(), w = tid >> 6, l = tid & 63, n = l & 31, h = l >> 5;
    char* wb = smem + w * 14336;
    float* sc0 = (float*)wb; float* sc1 = sc0 + 512; float* sc2 = sc1 + 512; float* sc3 = sc2 + 512;
    unsigned short* ix0 = (unsigned short*)(wb + 8192); unsigned short* ix1 = ix0 + 512; unsigned short* ix2 = ix1 + 512; unsigned short* ix3 = ix2 + 512;
    unsigned* hist = (unsigned*)(wb + 12288);
    float* scA = h ? sc2 : sc0; float* scB = h ? sc3 : sc1; unsigned short* ixA = h ? ix2 : ix0; unsigned short* ixB = h ? ix3 : ix1;
    const int wu = unit * 4 + w;
    const int tg = 2047 - wu;
    const int t0 = tg * 4;
    const int tl = 2 * ((n >> 2) & 1) + (n >> 4), hdr = (n & 3) + 4 * ((n >> 3) & 1);
    bf16x8 af[4];
#pragma unroll
    for (int s = 0; s < 4; ++s) af[s] = *(const bf16x8*)(p.IQ() + ((size_t)(t0 + tl) * 8 + hdr) * 64 + 16 * s + 8 * h);
    const int tA = t0 + 2 * h, tB = tA + 1;
    float wA[8], wB[8];
#pragma unroll
    for (int r = 0; r < 8; ++r) { wA[r] = p.IW()[(size_t)tA * 8 + r]; wB[r] = p.IW()[(size_t)tB * 8 + r]; }
    int cnt0 = 0, cnt1 = 0, cnt2 = 0, cnt3 = 0;
    const float NINF = -__builtin_inff();
    float tau0 = NINF, tau1 = NINF, tau2 = NINF, tau3 = NINF;
    const int ntiles = (t0 + 3) / 32 + 1;
    const bf16_t* ikp = p.IK() + (size_t)n * 64 + 8 * h;
    bf16x8 na[4], nb[4];
#pragma unroll
    for (int s = 0; s < 4; ++s) { na[s] = *(const bf16x8*)(ikp + 16 * s); nb[s] = *(const bf16x8*)(ikp + (size_t)(ntiles > 1 ? 32 : 0) * 64 + 16 * s); }
#pragma unroll 1
    for (int kt = 0; kt < ntiles; kt += 2) {
        bf16x8 ca[4], cb[4];
#pragma unroll
        for (int s = 0; s < 4; ++s) { ca[s] = na[s]; cb[s] = nb[s]; }
        {
            const int ka = kt + 2 < ntiles ? kt + 2 : ntiles - 1, kb = kt + 3 < ntiles ? kt + 3 : ntiles - 1;
#pragma unroll
            for (int s = 0; s < 4; ++s) { na[s] = *(const bf16x8*)(ikp + (size_t)ka * 32 * 64 + 16 * s); nb[s] = *(const bf16x8*)(ikp + (size_t)kb * 32 * 64 + 16 * s); }
        }
        f32x16 acca, accb;
#pragma unroll
        for (int r = 0; r < 16; ++r) { acca[r] = 0.f; accb[r] = 0.f; }
#pragma unroll
        for (int s = 0; s < 4; ++s) { acca = mfma32(af[s], ca[s], acca); accb = mfma32(af[s], cb[s], accb); }
        float s0a = 0.f, s1a = 0.f, s0b = 0.f, s1b = 0.f, u0a = 0.f, u1a = 0.f, u0b = 0.f, u1b = 0.f;
#pragma unroll
        for (int r = 0; r < 4; ++r) {
            s0a += wA[r] * fmaxf(acca[r], 0.f); u0a += wA[4 + r] * fmaxf(acca[4 + r], 0.f);
            s1a += wB[r] * fmaxf(acca[8 + r], 0.f); u1a += wB[4 + r] * fmaxf(acca[12 + r], 0.f);
            s0b += wA[r] * fmaxf(accb[r], 0.f); u0b += wA[4 + r] * fmaxf(accb[4 + r], 0.f);
            s1b += wB[r] * fmaxf(accb[8 + r], 0.f); u1b += wB[4 + r] * fmaxf(accb[12 + r], 0.f);
        }
        s0a += u0a; s1a += u1a; s0b += u0b; s1b += u1b;
        const float tauA = h ? tau2 : tau0, tauB = h ? tau3 : tau1;
        {
            const int kp = kt * 32 + n;
            const bool cA = (kp <= tA) && (s0a > tauA), cB = (kp <= tB) && (s1a > tauB);
            const unsigned long long mA = __ballot(cA), mB = __ballot(cB);
            DSA_APPEND2(cA, mA, s0a, scA, ixA, cnt0, cnt2); DSA_APPEND2(cB, mB, s1a, scB, ixB, cnt1, cnt3);
        }
        {
            const int kp = kt * 32 + 32 + n;
            const bool cA = (kp <= tA) && (s0b > tauA), cB = (kp <= tB) && (s1b > tauB);
            const unsigned long long mA = __ballot(cA), mB = __ballot(cB);
            DSA_APPEND2(cA, mA, s0b, scA, ixA, cnt0, cnt2); DSA_APPEND2(cB, mB, s1b, scB, ixB, cnt1, cnt3);
        }
        __builtin_amdgcn_wave_barrier();
        if (max(max(cnt0, cnt1), max(cnt2, cnt3)) > 448) {
            if (cnt0 > 448) tau0 = wave_prune_mid(sc0, ix0, hist, cnt0, l);
            if (cnt1 > 448) tau1 = wave_prune_mid(sc1, ix1, hist, cnt1, l);
            if (cnt2 > 448) tau2 = wave_prune_mid(sc2, ix2, hist, cnt2, l);
            if (cnt3 > 448) tau3 = wave_prune_mid(sc3, ix3, hist, cnt3, l);
        }
    }
    if (cnt0 > 256) { wave_prune(sc0, ix0, hist, cnt0, l); cnt0 = 256; }
    if (cnt1 > 256) { wave_prune(sc1, ix1, hist, cnt1, l); cnt1 = 256; }
    if (cnt2 > 256) { wave_prune(sc2, ix2, hist, cnt2, l); cnt2 = 256; }
    if (cnt3 > 256) { wave_prune(sc3, ix3, hist, cnt3, l); cnt3 = 256; }
    __builtin_amdgcn_wave_barrier();
#pragma unroll
    for (int i = 0; i < 4; ++i) {
        const int e = l + 64 * i;
        p.IDX()[(size_t)(t0 + 0) * 256 + e] = e < cnt0 ? (int)ix0[e] : 0;
        p.IDX()[(size_t)(t0 + 1) * 256 + e] = e < cnt1 ? (int)ix1[e] : 0;
        p.IDX()[(size_t)(t0 + 2) * 256 + e] = e < cnt2 ? (int)ix2[e] : 0;
        p.IDX()[(size_t)(t0 + 3) * 256 + e] = e < cnt3 ? (int)ix3[e] : 0;
    }
    if (l == 0) { p.CNT()[t0] = cnt0; p.CNT()[t0 + 1] = cnt1; p.CNT()[t0 + 2] = cnt2; p.CNT()[t0 + 3] = cnt3; }
}

DEV void st_dsa_attn(const P& p, int unit, char* smem) {
    const int tid = tidx(), w = tid >> 6, l = tid & 63, c = l & 15, g4 = l >> 4;
    int* idxs = (int*)(smem + w * 5120); float* Pl = (float*)(smem + w * 5120 + 1024);
    const size_t t = (size_t)unit * 4 + w;
    const int cnt = p.CNT()[t];
#pragma unroll
    for (int i = 0; i < 4; ++i) idxs[l + 64 * i] = p.IDX()[t * 256 + l + 64 * i];
    __builtin_amdgcn_wave_barrier();
    bf16x8 qf[4];
#pragma unroll
    for (int j = 0; j < 4; ++j) qf[j] = *(const bf16x8*)(p.DQ() + (t * 4 + (c & 3)) * 128 + g4 * 32 + j * 8);
    f32x4 s[16];
    const int ntile = (cnt + 15) >> 4;
#pragma unroll
    for (int th = 0; th < 2; ++th) {
        bf16x8 kf[8][4];
        if (th * 8 < ntile) {
#pragma unroll
            for (int q = 0; q < 8; ++q) {
                const int krow = idxs[(th * 8 + q) * 16 + c];
                const bf16_t* kp = p.DK() + (size_t)krow * 128 + g4 * 32;
#pragma unroll
                for (int j = 0; j < 4; ++j) kf[q][j] = *(const bf16x8*)(kp + j * 8);
            }
        }
#pragma unroll
        for (int q = 0; q < 8; ++q) {
            s[th * 8 + q] = (f32x4){0.f, 0.f, 0.f, 0.f};
            if (th * 8 < ntile) {
#pragma unroll
                for (int j = 0; j < 4; ++j) s[th * 8 + q] = mfma16(kf[q][j], qf[j], s[th * 8 + q]);
            }
        }
        __builtin_amdgcn_sched_barrier(0);
    }
    const float cs = 0.08838834764831845f * 1.4426950408889634f;
    float mx = -1e30f;
#pragma unroll
    for (int tt = 0; tt < 16; ++tt)
#pragma unroll
        for (int r = 0; r < 4; ++r) { const int slot = tt * 16 + 4 * g4 + r; if (slot < cnt) mx = fmaxf(mx, s[tt][r] * cs); }
    mx = fmaxf(mx, __shfl_xor(mx, 16)); mx = fmaxf(mx, __shfl_xor(mx, 32));
    float sum = 0.f;
#pragma unroll
    for (int tt = 0; tt < 16; ++tt)
#pragma unroll
        for (int r = 0; r < 4; ++r) { const int slot = tt * 16 + 4 * g4 + r; const float pv = slot < cnt ? exp2f(s[tt][r] * cs - mx) : 0.f; s[tt][r] = pv; sum += pv; }
    sum += __shfl_xor(sum, 16); sum += __shfl_xor(sum, 32);
    const float inv = sum > 0.f ? 1.0f / sum : 0.f;
    if (c < 4) {
#pragma unroll
        for (int tt = 0; tt < 16; ++tt)
#pragma unroll
            for (int r = 0; r < 4; ++r) Pl[(tt * 16 + 4 * g4 + r) * 4 + c] = s[tt][r] * inv;
    }
    __builtin_amdgcn_wave_barrier();
    float acc[4][8];
#pragma unroll
    for (int hh = 0; hh < 4; ++hh)
#pragma unroll
        for (int j = 0; j < 8; ++j) acc[hh][j] = 0.f;
    const int nk64 = (cnt + 63) >> 6;
#pragma unroll 1
    for (int kb = 0; kb < nk64; ++kb) {
        uint4 raw[16];
#pragma unroll
        for (int q = 0; q < 16; ++q) raw[q] = *(const uint4*)(p.DVC() + (size_t)idxs[(kb * 16 + q) * 4 + g4] * 128 + c * 8);
#pragma unroll
        for (int q = 0; q < 16; ++q) {
            const float4 p4 = *(const float4*)(Pl + ((kb * 16 + q) * 4 + g4) * 4);
            const float vv[8] = {lo2f(raw[q].x), hi2f(raw[q].x), lo2f(raw[q].y), hi2f(raw[q].y), lo2f(raw[q].z), hi2f(raw[q].z), lo2f(raw[q].w), hi2f(raw[q].w)};
            const float pp[4] = {p4.x, p4.y, p4.z, p4.w};
#pragma unroll
            for (int hh = 0; hh < 4; ++hh)
#pragma unroll
                for (int j = 0; j < 8; ++j) acc[hh][j] += pp[hh] * vv[j];
        }
    }
#pragma unroll
    for (int hh = 0; hh < 4; ++hh)
#pragma unroll
        for (int j = 0; j < 8; ++j) { float a = acc[hh][j]; a += __shfl_xor(a, 16); a += __shfl_xor(a, 32); acc[hh][j] = a; }
    if (g4 == 0) {
#pragma unroll
        for (int hh = 0; hh < 4; ++hh) {
            uint4 o; o.x = pk2(acc[hh][0], acc[hh][1]); o.y = pk2(acc[hh][2], acc[hh][3]); o.z = pk2(acc[hh][4], acc[hh][5]); o.w = pk2(acc[hh][6], acc[hh][7]);
            *(uint4*)(p.Y() + t * D + 1536 + hh * 128 + c * 8) = o;
        }
    }
    __builtin_amdgcn_wave_barrier();
}

DEV void ins16(unsigned (&top)[16], unsigned x) {
#pragma unroll
    for (int j = 0; j < 16; ++j) { const unsigned hi = max(top[j], x); x = min(top[j], x); top[j] = hi; }
}
DEV void st_peer_topk(const P& p, int layer, int unit, char* smem) {
    const int tid = tidx(), w = tid >> 6, l = tid & 63, n = l & 31, hf = l >> 5;
    const int head = unit & 7, tg = (unit >> 3) * 4 + w;
    const size_t t = (size_t)tg * 32 + n;
    unsigned* il = (unsigned*)smem + w * 1024;
    unsigned top[2][16];
#pragma unroll
    for (int pp = 0; pp < 2; ++pp) {
        float qv[32];
#pragma unroll
        for (int i = 0; i < 8; ++i) { const float4 v = *(const float4*)(p.PQ() + t * 1024 + head * 128 + pp * 64 + hf * 32 + i * 4); qv[4 * i] = v.x; qv[4 * i + 1] = v.y; qv[4 * i + 2] = v.z; qv[4 * i + 3] = v.w; }
        const float* K = p.peer_sk + ((((size_t)layer * 8 + head) * 2 + pp) * 128) * 64;
#pragma unroll
        for (int j = 0; j < 16; ++j) top[pp][j] = 0u;
        float kn[32];
        {
            const float* kr = K + (size_t)n * 64 + hf * 32;
#pragma unroll
            for (int i = 0; i < 8; ++i) { const float4 v = *(const float4*)(kr + i * 4); kn[4 * i] = v.x; kn[4 * i + 1] = v.y; kn[4 * i + 2] = v.z; kn[4 * i + 3] = v.w; }
        }
#pragma unroll 1
        for (int tile = 0; tile < 4; ++tile) {
            float kv[32];
#pragma unroll
            for (int i = 0; i < 32; ++i) kv[i] = kn[i];
            if (tile < 3) {
                const float* kr = K + (size_t)((tile + 1) * 32 + n) * 64 + hf * 32;
#pragma unroll
                for (int i = 0; i < 8; ++i) { const float4 v = *(const float4*)(kr + i * 4); kn[4 * i] = v.x; kn[4 * i + 1] = v.y; kn[4 * i + 2] = v.z; kn[4 * i + 3] = v.w; }
            }
            f32x16 acc;
#pragma unroll
            for (int r = 0; r < 16; ++r) acc[r] = 0.f;
#pragma unroll
            for (int kk = 0; kk < 32; ++kk) acc = __builtin_amdgcn_mfma_f32_32x32x2f32(kv[kk], qv[kk], acc, 0, 0, 0);
#pragma unroll
            for (int r = 0; r < 16; ++r) {
                const int nn = tile * 32 + (r & 3) + 8 * (r >> 2) + 4 * hf;
                ins16(top[pp], (f2key(acc[r]) & ~127u) | (unsigned)(127 - nn));
            }
        }
        unsigned oth[16];
#pragma unroll
        for (int j = 0; j < 16; ++j) oth[j] = __shfl_xor(top[pp][j], 32);
#pragma unroll
        for (int j = 0; j < 16; ++j) ins16(top[pp], oth[j]);
        if (hf == 0) {
#pragma unroll
            for (int j = 0; j < 16; ++j) il[(pp * 16 + j) * 32 + n] = 127u - (top[pp][j] & 127u);
        }
    }
    __builtin_amdgcn_wave_barrier();
    if (hf == 0) {
        float v1[16], v2[16];
#pragma unroll
        for (int j = 0; j < 16; ++j) { v1[j] = key2f(top[0][j] & ~127u); v2[j] = key2f(top[1][j] & ~127u); }
        unsigned ct[16];
#pragma unroll
        for (int s = 0; s < 16; ++s) ct[s] = 0u;
#pragma unroll
        for (int i = 0; i < 16; ++i)
#pragma unroll
            for (int j = 0; j < 16; ++j)
                if ((i + 1) * (j + 1) <= 16) ins16(ct, (f2key(v1[i] + v2[j]) & ~255u) | (unsigned)(255 - (i * 16 + j)));
        float ex[16], sum = 0.f; int ce[16];
        const float c0 = key2f(ct[0] & ~255u);
#pragma unroll
        for (int s = 0; s < 16; ++s) {
            const unsigned code = 255u - (ct[s] & 255u);
            ce[s] = (int)(il[(code >> 4) * 32 + n] * 128u + il[(16 + (code & 15u)) * 32 + n]);
            ex[s] = __expf(key2f(ct[s] & ~255u) - c0); sum += ex[s];
        }
        const float inv = 1.0f / sum;
#pragma unroll
        for (int s4 = 0; s4 < 4; ++s4) {
            *(int4*)(p.PE() + t * 128 + head * 16 + s4 * 4) = make_int4(ce[4 * s4], ce[4 * s4 + 1], ce[4 * s4 + 2], ce[4 * s4 + 3]);
            *(float4*)(p.PG() + t * 128 + head * 16 + s4 * 4) = make_float4(ex[4 * s4] * inv, ex[4 * s4 + 1] * inv, ex[4 * s4 + 2] * inv, ex[4 * s4 + 3] * inv);
        }
    }
    __builtin_amdgcn_wave_barrier();
}

DEV void st_peer_gather(const P& p, int layer, const float* __restrict__ xin, float* __restrict__ xout, int unit, char* smem) {
    const int tid_ = tidx(); const int w = tid_ >> 6, l = tid_ & 63; const size_t t = (size_t)unit * 4 + w;
    float* row = (float*)smem + w * 2112;
    const int* pip = p.PI();
    const float ic6 = __int_as_float(__builtin_amdgcn_readfirstlane(pip[32]));
    {
#pragma unroll
        for (int i = 0; i < 4; ++i) {
            const uint4 hv = *(const uint4*)(p.HN() + t * D + i * 512 + l * 8);
            const unsigned u4[4] = {hv.x, hv.y, hv.z, hv.w};
            const int c = i * 512 + l * 8;
#pragma unroll
            for (int q = 0; q < 4; ++q) { row[((c + 2 * q) >> 5) * 33 + ((c + 2 * q) & 31)] = lo2f(u4[q]); row[((c + 2 * q + 1) >> 5) * 33 + ((c + 2 * q + 1) & 31)] = hi2f(u4[q]); }
        }
        __builtin_amdgcn_wave_barrier();
    }
    unsigned hp[16];
#pragma unroll
    for (int j = 0; j < 16; ++j)
        hp[j] = (__float_as_uint(row[l * 33 + __builtin_amdgcn_readfirstlane(pip[2 * j])]) >> 16) |
                (__float_as_uint(row[l * 33 + __builtin_amdgcn_readfirstlane(pip[2 * j + 1])]) & 0xffff0000u);
    __builtin_amdgcn_wave_barrier();
    const int e0 = p.PE()[t * 128 + l], e1 = p.PE()[t * 128 + 64 + l];
    const float g0 = p.PG()[t * 128 + l], g1 = p.PG()[t * 128 + 64 + l];
    float out[32];
#pragma unroll
    for (int i = 0; i < 32; ++i) out[i] = 0.f;
    const unsigned char* U = p.Utab() + (size_t)layer * 16384 * ROW6; const unsigned char* V = p.Vtab() + (size_t)layer * 16384 * ROW6;
    const unsigned voff = (unsigned)l * 8u;
    const bool b5 = (l & 32) != 0, b4 = (l & 16) != 0;
#pragma unroll 1
    for (int k4 = 0; k4 < 32; ++k4) {
        int e[4]; float g[4];
#pragma unroll
        for (int q = 0; q < 4; ++q) {
            const int k = k4 * 4 + q;
            e[q] = __builtin_amdgcn_readlane(k4 < 16 ? e0 : e1, k & 63);
            g[q] = __int_as_float(__builtin_amdgcn_readlane(__float_as_int(k4 < 16 ? g0 : g1), k & 63));
        }
#if PEER_FP4
        uint4 uu[4], vv[4];
#pragma unroll
        for (int q = 0; q < 4; ++q) { uu[q] = *(const uint4*)(U + (size_t)e[q] * ROW6 + 2 * voff); vv[q] = *(const uint4*)(V + (size_t)e[q] * ROW6 + 2 * voff); }
#define GATHER_UNPACK(F, SRC) do { fp4_unpack8((SRC).x, &(F)[0]); fp4_unpack8((SRC).y, &(F)[8]); fp4_unpack8((SRC).z, &(F)[16]); fp4_unpack8((SRC).w, &(F)[24]); } while (0)
#define GATHER_FIRST(SRC) (SRC).x
#else
        uint2 uu[4][3], vv[4][3];
#pragma unroll
        for (int q = 0; q < 4; ++q)
#pragma unroll
            for (int i = 0; i < 3; ++i) { uu[q][i] = *(const uint2*)(U + (size_t)e[q] * ROW6 + (voff + i * 512)); vv[q][i] = *(const uint2*)(V + (size_t)e[q] * ROW6 + (voff + i * 512)); }
#endif
        float d[4];
#pragma unroll
        for (int q = 0; q < 4; ++q) {
#if PEER_FP4
            if (q > 0) asm volatile("" : "+v"(uu[q].x), "+v"(d[q - 1]));
            float f[32]; GATHER_UNPACK(f, uu[q]);
#else
            v6u pk; pk[0] = uu[q][0].x; pk[1] = uu[q][0].y; pk[2] = uu[q][1].x; pk[3] = uu[q][1].y; pk[4] = uu[q][2].x; pk[5] = uu[q][2].y;
            if (q > 0) { unsigned t0_ = pk[0]; asm volatile("" : "+v"(t0_), "+v"(d[q - 1])); pk[0] = t0_; }
            const v32f f = FP6_UNPACK(pk);
#endif
            float acc = 0.f;
#pragma unroll
            for (int j = 0; j < 16; ++j) acc += f[2 * j] * lo2f(hp[j]) + f[2 * j + 1] * hi2f(hp[j]);
            d[q] = acc;
            __builtin_amdgcn_sched_barrier(0);
        }
        float kA = b5 ? d[2] : d[0], kB = b5 ? d[3] : d[1];
        const float sA = b5 ? d[0] : d[2], sB = b5 ? d[1] : d[3];
        kA += __shfl_xor(sA, 32); kB += __shfl_xor(sB, 32);
        float kk = b4 ? kB : kA; const float ss = b4 ? kA : kB;
        kk += __shfl_xor(ss, 16);
        kk += __shfl_xor(kk, 8); kk += __shfl_xor(kk, 4); kk += __shfl_xor(kk, 2); kk += __shfl_xor(kk, 1);
        const float gsel = b5 ? (b4 ? g[3] : g[2]) : (b4 ? g[1] : g[0]);
        const float av = gelu_tanh(kk * (ic6 / U6_SCALE)) * gsel * (ic6 / V6_SCALE);
        const int avi = __float_as_int(av);
        const float a4[4] = {__int_as_float(__builtin_amdgcn_readlane(avi, 0)), __int_as_float(__builtin_amdgcn_readlane(avi, 16)),
                             __int_as_float(__builtin_amdgcn_readlane(avi, 32)), __int_as_float(__builtin_amdgcn_readlane(avi, 48))};
#pragma unroll
        for (int q = 0; q < 4; ++q) {
#if PEER_FP4
            asm volatile("" : "+v"(vv[q].x), "+v"(out[31]));
            float f[32]; GATHER_UNPACK(f, vv[q]);
#else
            v6u pk; pk[0] = vv[q][0].x; pk[1] = vv[q][0].y; pk[2] = vv[q][1].x; pk[3] = vv[q][1].y; pk[4] = vv[q][2].x; pk[5] = vv[q][2].y;
            { unsigned t0_ = pk[0]; asm volatile("" : "+v"(t0_), "+v"(out[31])); pk[0] = t0_; }
            const v32f f = FP6_UNPACK(pk);
#endif
#pragma unroll
            for (int j = 0; j < 32; ++j) out[j] += a4[q] * f[j];
            __builtin_amdgcn_sched_barrier(0);
        }
    }
    asm volatile("" : "+s"(pip));
#pragma unroll
    for (int j = 0; j < 32; ++j) row[l * 33 + __builtin_amdgcn_readfirstlane(pip[j])] = out[j];
    __builtin_amdgcn_wave_barrier();
    const float* g2 = p.ada() + layer * 12288 + 5 * 2048;
    float4 xo[8]; float ssq = 0.f;
#pragma unroll
    for (int i = 0; i < 8; ++i) {
        const int c = i * 256 + l * 4;
        const float* rp = row + (c >> 5) * 33 + (c & 31);
        const size_t off = t * D + c;
        const float4 x0 = *(const float4*)(xin + off); const float4 ga = *(const float4*)(g2 + c);
        float4 o0;
        o0.x = x0.x + ga.x * rp[0]; o0.y = x0.y + ga.y * rp[1]; o0.z = x0.z + ga.z * rp[2]; o0.w = x0.w + ga.w * rp[3];
        *(float4*)(xout + off) = o0;
        xo[i] = o0; ssq += o0.x * o0.x + o0.y * o0.y + o0.z * o0.z + o0.w * o0.w;
        if (i & 1) __builtin_amdgcn_sched_barrier(0);
    }
    if (layer + 1 < NL) {
        const float rs = rsqrtf(wsum(ssq) * (1.0f / 2048.0f) + EPS);
        const float* ng = p.n1g + (layer + 1) * 2048; const float* adn = p.ada() + (layer + 1) * 12288;
#pragma unroll
        for (int i = 0; i < 8; ++i) {
            const int c = i * 256 + l * 4;
            const float4 gg = *(const float4*)(ng + c), sc = *(const float4*)(adn + 2048 + c), sh = *(const float4*)(adn + c);
            uint2 o;
            o.x = pk2((xo[i].x * rs) * gg.x * (1.0f + sc.x) + sh.x, (xo[i].y * rs) * gg.y * (1.0f + sc.y) + sh.y);
            o.y = pk2((xo[i].z * rs) * gg.z * (1.0f + sc.z) + sh.z, (xo[i].w * rs) * gg.w * (1.0f + sc.w) + sh.w);
            *(uint2*)(p.HN() + t * D + c) = o;
            if (i & 1) __builtin_amdgcn_sched_barrier(0);
        }
    }
    __builtin_amdgcn_wave_barrier();
}

enum { S_CONVT_IN = 0, S_CONVT_OUT, S_CONVT_Q, S_CONVT_W1, S_CALIB, S_TAB_U, S_TAB_V, S_ADA, S_ROPE, S_NORM1, S_GEMM_IN, S_CONV, S_SGU, S_VTRANS, S_PREP,
       S_COMPRESS, S_NSA_CMP, S_DSA_INDEX, S_NSA_ATTN, S_DSA_ATTN, S_GEMM_OUT, S_NORM2, S_GEMM_Q, S_PEER_TOPK, S_PEER_GATHER, S_COUNT };
constexpr int TAB_UNITS = 4096;
__host__ __device__ constexpr int nunits(int s) {
    return s == S_CONVT_IN ? 2 * 32 * (LDP / 64) : s == S_CONVT_OUT ? 2 * 32 * 32 : s == S_CONVT_Q ? 2 * 32 * 16 : s == S_CONVT_W1 ? 4 * 64 * 2 : s == S_CALIB ? 1 : s == S_TAB_U ? TAB_UNITS : s == S_TAB_V ? TAB_UNITS
         : s == S_ADA ? 384 : s == S_ROPE ? 768 : s == S_NORM1 ? 2048 : s == S_GEMM_IN ? 64 * (LDP / 128) : s == S_CONV ? 512 : s == S_SGU ? 256
         : s == S_VTRANS ? 256 : s == S_PREP ? 2048 : s == S_COMPRESS ? 64 : s == S_NSA_CMP ? 512 : s == S_DSA_INDEX ? 512 : s == S_NSA_ATTN ? 512 : s == S_DSA_ATTN ? 2048
         : s == S_GEMM_OUT ? 64 * 16 : s == S_NORM2 ? 2048 : s == S_GEMM_Q ? 64 * 8 : s == S_PEER_TOPK ? 512 : s == S_PEER_GATHER ? 2048 : 0;
}
template <int S>
DEV void run_unit(const P& p, int layer, int u, char* smem, int nu = TAB_UNITS) {
    const float* xin = layer == 0 ? p.x : p.X2();
    const float* ada = p.ada() + layer * 12288;
    if constexpr (S == S_CONVT_IN) { const int per = 32 * (LDP / 64), ly = u / per; st_convT(p.w_in + (size_t)ly * 2048 * INC, p.WinT() + (size_t)ly * LDP * 2048, INC, LDP, true, u % per, smem); }
    else if constexpr (S == S_CONVT_OUT) { const int per = 32 * 32, ly = u / per; st_convT(p.w_out + (size_t)ly * 2048 * 2048, p.WoutT() + (size_t)ly * 2048 * 2048, 2048, 2048, false, u % per, smem); }
    else if constexpr (S == S_CONVT_Q) { const int per = 32 * 16, ly = u / per; st_convT(p.peer_wq + (size_t)ly * 2048 * 1024, p.WqT() + (size_t)ly * 1024 * 2048, 1024, 1024, false, u % per, smem); }
    else if constexpr (S == S_CONVT_W1) { const int per = 64 * 2, mi = u / per; st_convT(p.cmp_w1 + (size_t)mi * 4096 * 128, p.W1T() + (size_t)mi * 128 * 4096, 128, 128, false, u % per, smem, 4096); }
    else if constexpr (S == S_CALIB) st_calib(p);
#if PEER_FP4
    else if constexpr (S == S_TAB_U) st_tab4(p, p.peer_u, p.Utab(), U6_SCALE, 2 * 16384, u, nu, smem);
    else if constexpr (S == S_TAB_V) st_tab4(p, p.peer_v, p.Vtab(), V6_SCALE, 2 * 16384, u, nu, smem);
#else
    else if constexpr (S == S_TAB_U) st_tab6(p.peer_u, p.Utab(), U6_SCALE, 2 * 16384, u, nu, smem);
    else if constexpr (S == S_TAB_V) st_tab6(p.peer_v, p.Vtab(), V6_SCALE, 2 * 16384, u, nu, smem);
#endif
    else if constexpr (S == S_ADA) st_ada(p, u, smem);
    else if constexpr (S == S_ROPE) st_rope(p, u);
    else if constexpr (S == S_NORM1) st_norm(xin, p.n1g + layer * 2048, ada + 2048, ada, p.HN(), u);
    else if constexpr (S == S_GEMM_IN) { EpiArgs e{p.PROJ(), nullptr, nullptr, nullptr, p.KVC()}; st_gemm<EPI_PROJ>(p.HN(), p.WinT() + (size_t)layer * LDP * 2048, 2048, u & 63, u >> 6, e, smem); }
    else if constexpr (S == S_CONV) st_conv(p, layer, u, smem);
    else if constexpr (S == S_SGU) st_sgu(p, layer, u, smem);
    else if constexpr (S == S_VTRANS) st_vtrans(p, u, smem);
    else if constexpr (S == S_PREP) st_prep(p, layer, u);
    else if constexpr (S == S_COMPRESS) st_compress(p, layer, u, smem);
    else if constexpr (S == S_NSA_CMP) st_nsa_cmp(p, u, smem);
    else if constexpr (S == S_DSA_INDEX) st_dsa_index(p, u, smem);
    else if constexpr (S == S_NSA_ATTN) st_nsa_attn(p, u, smem);
    else if constexpr (S == S_DSA_ATTN) st_dsa_attn(p, u, smem);
    else if constexpr (S == S_GEMM_OUT) { EpiArgs e{nullptr, p.X1(), xin, ada + 2 * 2048, nullptr}; st_gemm<EPI_OUT>(p.Y(), p.WoutT() + (size_t)layer * 2048 * 2048, 2048, u & 63, u >> 6, e, smem); }
    else if constexpr (S == S_NORM2) st_norm(p.X1(), p.n2g + layer * 2048, ada + 4 * 2048, ada + 3 * 2048, p.HN(), u);
    else if constexpr (S == S_GEMM_Q) { EpiArgs e{nullptr, p.PQ(), nullptr, nullptr, nullptr}; st_gemm<EPI_Q>(p.HN(), p.WqT() + (size_t)layer * 1024 * 2048, 2048, u & 63, u >> 6, e, smem); }
    else if constexpr (S == S_PEER_TOPK) st_peer_topk(p, layer, u, smem);
    else if constexpr (S == S_PEER_GATHER) st_peer_gather(p, layer, p.X1(), layer == 0 ? p.X2() : p.out, u, smem);
}


#define XB_TMO      128
#define XB_XCNT(j)  (256  + 64 * (j))
#define XB_XSUB(j)  (1280 + 64 * (j))
#define XB_XGEN(j)  (2304 + 64 * (j))
#define XB_TOP      3328
#define XB_TOPGEN   3392
#define XB_SPIN_CAP (1u << 22)
#define LAS __attribute__((address_space(3)))
DEV unsigned xb_ld(unsigned* p) { return __hip_atomic_load(p, __ATOMIC_RELAXED, __HIP_MEMORY_SCOPE_AGENT); }
DEV unsigned xb_add(unsigned* p, unsigned v) { return __hip_atomic_fetch_add(p, v, __ATOMIC_RELAXED, __HIP_MEMORY_SCOPE_AGENT); }
DEV unsigned xb_xcc_id() { return (unsigned)__builtin_amdgcn_s_getreg((3 << 11) | 20) & 0xFu; }
#define XB_SPIN(cond, bar) do { unsigned _sp = 0; while (cond) { __builtin_amdgcn_s_sleep(1); \
    if ((++_sp & 255u) == 0u) { if (xb_ld(&(bar)[XB_TMO])) break; if (_sp > XB_SPIN_CAP) { atomicAdd(&(bar)[XB_TMO], 1u); break; } } } } while (0)
struct XcdBarrier { unsigned* bar; unsigned x; volatile LAS unsigned* st; };
DEV XcdBarrier xcd_barrier_post(unsigned* bar, volatile LAS unsigned* st) {
    XcdBarrier b; b.bar = bar; b.x = xb_xcc_id(); b.st = st;
    if (threadIdx.x == 0) (void)xb_add(&bar[XB_XCNT(b.x)], 1u);
    return b;
}
DEV void xcd_barrier_complete(unsigned* bar, unsigned x, unsigned& nloc, unsigned& nx) {
    const unsigned G = gridDim.x * gridDim.y * gridDim.z;
    unsigned sum, cnt, mine, sp = 0u;
    for (;;) {
        sum = 0u; cnt = 0u; mine = 0u;
#pragma unroll
        for (unsigned j = 0; j < 16; ++j) { const unsigned c = xb_ld(&bar[XB_XCNT(j)]); sum += c; cnt += (c > 0u) ? 1u : 0u; mine = (j == x) ? c : mine; }
        if (sum == G) break;
        __builtin_amdgcn_s_sleep(1);
        if ((++sp & 255u) == 0u) { if (xb_ld(&bar[XB_TMO])) break; if (sp > XB_SPIN_CAP) { atomicAdd(&bar[XB_TMO], 1u); break; } }
    }
    nloc = mine > 0u ? mine : 1u; nx = cnt > 0u ? cnt : 1u;
}
DEV void xcd_barrier(const XcdBarrier& b) {
    asm volatile("s_waitcnt vmcnt(0)" ::: "memory");
    __syncthreads();
    if (threadIdx.x == 0) {
        unsigned* bar = b.bar;
        __builtin_amdgcn_s_waitcnt(0);
        unsigned nloc = b.st[0], nx = b.st[1];
        if (nloc == 0u) { xcd_barrier_complete(bar, b.x, nloc, nx); b.st[0] = nloc; b.st[1] = nx; }
        const unsigned old = xb_add(&bar[XB_XSUB(b.x)], 1u);
        const unsigned gen = old / nloc;
        if (old + 1u == (gen + 1u) * nloc) {
            __builtin_amdgcn_fence(__ATOMIC_RELEASE, "agent");
            asm volatile("s_waitcnt vmcnt(0)" ::: "memory");
            const unsigned og = xb_add(&bar[XB_TOP], 1u);
            const unsigned tg = og / nx;
            if (og + 1u == (tg + 1u) * nx) xb_add(&bar[XB_TOPGEN], 1u);
            else XB_SPIN(xb_ld(&bar[XB_TOPGEN]) == tg, bar);
            __builtin_amdgcn_fence(__ATOMIC_ACQUIRE, "agent");
            xb_add(&bar[XB_XGEN(b.x)], 1u);
            asm volatile("s_waitcnt vmcnt(0)" ::: "memory");
        } else {
            XB_SPIN(xb_ld(&bar[XB_XGEN(b.x)]) == gen, bar);
            __builtin_amdgcn_fence(__ATOMIC_ACQUIRE, "agent");
            asm volatile("s_waitcnt vmcnt(0)" ::: "memory");
        }
    }
    __syncthreads();
}

#ifndef MULTI_LAUNCH
constexpr int REP_STAGE = -1, REP_STAGE2 = -1, REP_N = 1;
template <int S, int LIM = 0>
DEV void run_phase1(const P& p, int layer, char* smem, int off);
template <int S, int LIM = 0>
DEV void run_phase(const P& p, int layer, char* smem, int off = 0) {
    constexpr int reps = (S == REP_STAGE || S == REP_STAGE2) ? REP_N : 1;
#pragma unroll 1
    for (int r = 0; r < reps; ++r) run_phase1<S, LIM>(p, layer, smem, off);
}
template <int S, int LIM>
DEV void run_phase1(const P& p, int layer, char* smem, int off) {
    const int G = gridDim.x;
    int b = blockIdx.x + off; if (b >= G) b -= G;
    if constexpr (S == S_TAB_U || S == S_TAB_V) { run_unit<S>(p, layer, b, smem, G); }
    else {
        for (int u = b; u < (LIM ? LIM : nunits(S)); u += G) { run_unit<S>(p, layer, u, smem); __syncthreads(); }
    }
}
template <int S>
DEV void run_gemm_phase1(const P& p, int layer, char* smem, unsigned xcc, volatile LAS unsigned* slot, int rep) {
    constexpr int TN = (S == S_GEMM_IN) ? (LDP / 128) : (S == S_GEMM_OUT ? 16 : 8);
    constexpr int NBIG = (S == S_GEMM_IN) ? 32 : (S == S_GEMM_OUT ? 16 : 0);
    constexpr int inst0 = (S == S_GEMM_IN) ? 0 : (S == S_GEMM_OUT ? 2 : 4);
    constexpr int nbig = 4 * NBIG, len = nbig + 8 * (TN - NBIG);
    const float* xin = layer == 0 ? p.x : p.X2();
    const float* ada = p.ada() + layer * 12288;
    const bf16_t* Aop = (S == S_GEMM_OUT) ? p.Y() : p.HN();
    const bf16_t* Bop = (S == S_GEMM_IN) ? p.WinT() + (size_t)layer * LDP * 2048 : (S == S_GEMM_OUT ? p.WoutT() + (size_t)layer * 2048 * 2048 : p.WqT() + (size_t)layer * 1024 * 2048);
    EpiArgs e{p.PROJ(), (S == S_GEMM_OUT) ? p.X1() : p.PQ(), xin, ada + 2 * 2048, p.KVC()};
    constexpr int EPI = (S == S_GEMM_IN) ? EPI_PROJ : (S == S_GEMM_OUT ? EPI_OUT : EPI_Q);
#pragma unroll 1
    for (int q = 0; q < 8; ++q) {
        const unsigned xq = (xcc + q) & 7u;
        unsigned* head = p.bar() + GQ_WORD(inst0 + layer + 6 * rep, xq);
        for (;;) {
            if (threadIdx.x == 0) *slot = xb_add(head, 1u);
            __syncthreads();
            const int i = (int)*slot;
            __syncthreads();
            if (i >= len) break;
            if (i < nbig) st_gemm<EPI, 8>(Aop, Bop, 2048, (int)xq * 4 + (i & 3), i >> 2, e, smem);
            else {
                const int j = i - nbig, tm = (int)xq * 8 + (j & 7), tn = NBIG + (j >> 3);
                st_gemm<EPI, 4>(Aop, Bop, 2048, tm, tn, e, smem);
                if constexpr (S == S_GEMM_Q) {
                    asm volatile("s_waitcnt vmcnt(0)" ::: "memory");
                    __syncthreads();
                    st_peer_topk(p, layer, tm * 8 + tn, smem);
                }
            }
            __syncthreads();
        }
    }
}
template <int S>
DEV void run_items(const P& p, int layer, char* smem, int first, int count) {
    constexpr int reps = (S == REP_STAGE || S == REP_STAGE2) ? REP_N : 1;
#pragma unroll 1
    for (int r = 0; r < reps; ++r)
#pragma unroll 1
        for (int u = first; u < first + count; ++u) { run_unit<S>(p, layer, u, smem); __syncthreads(); }
}
DEV void dep_publish(unsigned* cnt) {
    asm volatile("s_waitcnt vmcnt(0)" ::: "memory");
    __syncthreads();
    if (threadIdx.x == 0) { __builtin_amdgcn_fence(__ATOMIC_RELEASE, "agent"); asm volatile("s_waitcnt vmcnt(0)" ::: "memory"); (void)xb_add(cnt, 1u); }
}
DEV void dep_wait(unsigned* cnt, unsigned target, unsigned* bar) {
    if (threadIdx.x == 0) {
        XB_SPIN(xb_ld(cnt) < target, bar);
        __builtin_amdgcn_fence(__ATOMIC_ACQUIRE, "agent");
        asm volatile("s_waitcnt vmcnt(0)" ::: "memory");
    }
    __syncthreads();
}
template <int PH>
DEV void run_dyn_phase(const P& p, int layer, char* smem, volatile LAS unsigned* slot) {
    unsigned* head = p.bar() + DQ_WORD(PH * 2 + layer);
    unsigned* cprep = p.bar() + DQ_WORD(12 + layer); unsigned* ccomp = p.bar() + DQ_WORD(14 + layer);
    constexpr int total0 = PH == 0 ? (256 + 64 + 256 + 256 + 64 + 512 + 256) : (512 + 512);
    const int total = (PH == 0 && layer == 0) ? total0 + 512 + 296 + 256 + 128 : total0;
    int i = blockIdx.x;
    while (i < total) {
        if constexpr (PH == 0) {
            if (i < 256) { run_items<S_PREP>(p, layer, smem, i * 8, 8); dep_publish(cprep); }
            else if (i < 320) { run_items<S_COMPRESS>(p, layer, smem, i - 256, 1); dep_publish(ccomp); }
            else if (i < 576) run_items<S_SGU>(p, layer, smem, i - 320, 1);
            else if (i < 832) run_items<S_CONV>(p, layer, smem, (i - 576) * 2, 2);
            else if (i < 896) run_items<S_VTRANS>(p, layer, smem, (i - 832) * 4, 4);
            else if (i < 1408) { dep_wait(cprep, 256u, p.bar()); run_items<S_DSA_INDEX>(p, layer, smem, i - 896, 1); }
            else if (i < 1664) { dep_wait(cprep, 256u, p.bar()); dep_wait(ccomp, 64u, p.bar()); run_items<S_NSA_CMP>(p, layer, smem, (i - 1408) * 2, 2); }
            else if (i < 1920) { run_unit<S_TAB_U>(p, layer, i - 1664, smem, 256); __syncthreads(); }
            else if (i < 2176) { run_unit<S_TAB_V>(p, layer, i - 1920, smem, 256); __syncthreads(); }
            else if (i < 2472) run_items<S_CONVT_IN>(p, layer, smem, 2368 + (i - 2176) * 8, 8);
            else if (i < 2728) run_items<S_CONVT_OUT>(p, layer, smem, (i - 2472) * 8, 8);
            else run_items<S_CONVT_Q>(p, layer, smem, (i - 2728) * 8, 8);
        } else {
            if (i < 512) run_items<S_NSA_ATTN>(p, layer, smem, 511 - i, 1);
            else run_items<S_DSA_ATTN>(p, layer, smem, (i - 512) * 4, 4);
        }
        if (threadIdx.x == 0) *slot = gridDim.x + xb_add(head, 1u);
        __syncthreads();
        i = (int)*slot;
        __syncthreads();
    }
}
template <int S>
DEV void run_gemm_phase(const P& p, int layer, char* smem, unsigned xcc, volatile LAS unsigned* slot) {
    constexpr int reps = (S == REP_STAGE || S == REP_STAGE2) ? REP_N : 1;
#pragma unroll 1
    for (int r = 0; r < reps; ++r) run_gemm_phase1<S>(p, layer, smem, xcc, slot, r);
}
#if defined(__HIP_DEVICE_COMPILE__)
typedef const P __attribute__((address_space(4)))* kargp_t;
DEV const P& fresh_params() { kargp_t q = (kargp_t)__builtin_amdgcn_kernarg_segment_ptr(); asm volatile("" : "+s"(q)); return *(const P*)q; }
#define PP fresh_params()
#else
#define PP p
#endif
#define GSYNC() xcd_barrier(xb)
__global__ void __launch_bounds__(NTHREADS, 2) k_mega(P p) {
    __shared__ __attribute__((aligned(16))) char smem[SMEM_BYTES];
    __shared__ uint4 xb_words;
    cg::grid_group grid = cg::this_grid();
    if (threadIdx.x == 0) xb_words = make_uint4(0u, 0u, 0u, 0u);
    __syncthreads();
    XcdBarrier xb = xcd_barrier_post(p.bar(), (volatile LAS unsigned*)&xb_words);
    const int H = gridDim.x >> 1, Q = gridDim.x >> 2;
    run_phase<S_ADA>(PP, 0, smem); run_phase<S_ROPE>(PP, 0, smem, H);
    run_phase<S_CONVT_IN, 2368>(PP, 0, smem); run_phase<S_CONVT_W1>(PP, 0, smem); run_phase<S_CALIB>(PP, 0, smem, 100);
    grid.sync();
#pragma unroll 1
    for (int layer = 0; layer < NL; ++layer) {
        if (layer == 0) { run_phase<S_NORM1>(PP, layer, smem); GSYNC(); }
        run_gemm_phase<S_GEMM_IN>(PP, layer, smem, xb.x, (volatile LAS unsigned*)&xb_words + 2); GSYNC();
        run_dyn_phase<0>(PP, layer, smem, (volatile LAS unsigned*)&xb_words + 2); GSYNC();
        run_dyn_phase<2>(PP, layer, smem, (volatile LAS unsigned*)&xb_words + 2); GSYNC();
        run_gemm_phase<S_GEMM_OUT>(PP, layer, smem, xb.x, (volatile LAS unsigned*)&xb_words + 2); GSYNC();
        run_phase<S_NORM2>(PP, layer, smem); GSYNC();
        run_gemm_phase<S_GEMM_Q>(PP, layer, smem, xb.x, (volatile LAS unsigned*)&xb_words + 2); GSYNC();
        run_phase<S_PEER_GATHER>(PP, layer, smem); GSYNC();
    }
}
#else
template <int S>
__global__ void __launch_bounds__(NTHREADS) k_stage(P p, int layer) {
    __shared__ __attribute__((aligned(16))) char smem[SMEM_BYTES];
    run_unit<S>(p, layer, blockIdx.x, smem);
}
template <int S> static void launch_stage(const P& p, int layer, hipStream_t st) {
    hipLaunchKernelGGL((k_stage<S>), dim3(nunits(S)), dim3(NTHREADS), 0, st, p, layer);
}
#endif

extern "C" void kernel_launch(void* const* d_in, const int* in_sizes, int n_in, void* d_out, int out_size, void* d_ws, size_t ws_size, hipStream_t stream) {
    P p{};
    p.x = (const float*)d_in[0]; p.c = (const float*)d_in[1]; p.pos = (const int*)d_in[2]; p.ada_w = (const float*)d_in[3]; p.ada_b = (const float*)d_in[4];
    p.n1g = (const float*)d_in[5]; p.n2g = (const float*)d_in[6]; p.w_in = (const float*)d_in[7]; p.w_out = (const float*)d_in[8]; p.conv_w = (const float*)d_in[9];
    p.conv_b = (const float*)d_in[10]; p.cln_g = (const float*)d_in[11]; p.cln_b = (const float*)d_in[12]; p.sln_g = (const float*)d_in[13]; p.sln_b = (const float*)d_in[14];
    p.sgu_w = (const float*)d_in[15]; p.sgu_b = (const float*)d_in[16]; p.nsa_qg = (const float*)d_in[17]; p.nsa_kg = (const float*)d_in[18]; p.cmp_pos = (const float*)d_in[19];
    p.cmp_w1 = (const float*)d_in[20]; p.cmp_w2 = (const float*)d_in[21]; p.dsa_qg = (const float*)d_in[22]; p.dsa_kg = (const float*)d_in[23]; p.peer_wq = (const float*)d_in[24];
    p.peer_sk = (const float*)d_in[25]; p.peer_u = (const float*)d_in[26]; p.peer_v = (const float*)d_in[27];
    p.out = (float*)d_out;
    p.ws = (char*)d_ws; const size_t off = WS_TOTAL;
    if (off > ws_size) { fprintf(stderr, "workspace too small: need %zu have %zu\n", off, ws_size); return; }
#ifndef MULTI_LAUNCH
    static int grid_blocks = 0;
    if (!grid_blocks) {
        int dev = 0, cus = 0, per_cu = 0;
        (void)hipGetDevice(&dev);
        (void)hipDeviceGetAttribute(&cus, hipDeviceAttributeMultiprocessorCount, dev);
        (void)hipOccupancyMaxActiveBlocksPerMultiprocessor(&per_cu, k_mega, NTHREADS, 0);
        if (per_cu > 2) per_cu = 2;
        grid_blocks = cus * per_cu;
    }
    (void)hipMemsetAsync(p.bar(), 0, (size_t)CTRL_WORDS * 4, stream);
    void* args[] = {&p};
    hipError_t e = hipLaunchCooperativeKernel((void*)k_mega, dim3(grid_blocks), dim3(NTHREADS), args, 0, stream);
    if (e != hipSuccess) fprintf(stderr, "cooperative launch failed: %s (grid %d)\n", hipGetErrorString(e), grid_blocks);
#else
    launch_stage<S_CONVT_IN>(p, 0, stream); launch_stage<S_CONVT_OUT>(p, 0, stream); launch_stage<S_CONVT_Q>(p, 0, stream); launch_stage<S_CONVT_W1>(p, 0, stream); launch_stage<S_CALIB>(p, 0, stream);
    launch_stage<S_TAB_U>(p, 0, stream); launch_stage<S_TAB_V>(p, 0, stream);
    launch_stage<S_ADA>(p, 0, stream); launch_stage<S_ROPE>(p, 0, stream);
    for (int layer = 0; layer < NL; ++layer) {
        launch_stage<S_NORM1>(p, layer, stream); launch_stage<S_GEMM_IN>(p, layer, stream);
        launch_stage<S_CONV>(p, layer, stream); launch_stage<S_SGU>(p, layer, stream); launch_stage<S_VTRANS>(p, layer, stream);
        launch_stage<S_PREP>(p, layer, stream); launch_stage<S_COMPRESS>(p, layer, stream);
        launch_stage<S_NSA_CMP>(p, layer, stream); launch_stage<S_DSA_INDEX>(p, layer, stream);
        launch_stage<S_NSA_ATTN>(p, layer, stream); launch_stage<S_DSA_ATTN>(p, layer, stream);
        launch_stage<S_GEMM_OUT>(p, layer, stream); launch_stage<S_NORM2>(p, layer, stream); launch_stage<S_GEMM_Q>(p, layer, stream);
        launch_stage<S_PEER_TOPK>(p, layer, stream); launch_stage<S_PEER_GATHER>(p, layer, stream);
    }
#endif
}
```

```cpp
#include <hip/hip_runtime.h>
#include <hip/hip_cooperative_groups.h>
#include <stdint.h>
#include <cstdio>
namespace cg = cooperative_groups;

typedef unsigned short bf16_t;
typedef short bf16x8 __attribute__((ext_vector_type(8)));
typedef float f32x4 __attribute__((ext_vector_type(4)));
typedef float f32x16 __attribute__((ext_vector_type(16)));
#define DEV __device__ __forceinline__

constexpr int T = 8192, D = 2048, NL = 2;
constexpr int INC = 4692;
constexpr int LDP = 4736;
constexpr int C_CA = 0, C_CG = 512, C_SU = 1024, C_SV = 1536;
constexpr int C_NQ = 2048, C_NKC = 2560, C_NVC = 2688, C_NKS = 2816, C_NVS = 2944, C_NKW = 3072, C_NVW = 3200;
constexpr int C_DQ = 3328, C_DK = 3840, C_DV = 3968, C_IQ = 4096, C_IK = 4608, C_NG = 4672, C_IW = 4688;
constexpr float EPS = 1e-6f;
constexpr int NTHREADS = 256;
constexpr int SMEM_BYTES = 72 * 1024;

__device__ const double INV16[16] = {1.0, 0.44036660267178046, 0.19392274474868576, 0.08539710028576561, 0.03760603093086393,
    0.016560440080994446, 0.007292664737217109, 0.003211445994752591, 0.001414213562373095, 0.000622772421914596,
    0.0002742481756762073, 0.00012076973741146504, 5.318295896944988e-05, 2.341999896140934e-05, 1.031338537721246e-05,
    4.5416704806078695e-06};

#define XCD_BAR_WORDS 3456
#define GQ_WORD(inst, x) (XCD_BAR_WORDS + 64 * ((inst) * 8 + (x)))
#define DQ_WORD(k) (XCD_BAR_WORDS + 64 * (96 + (k)))
#define CTRL_WORDS (XCD_BAR_WORDS + 64 * 112)
constexpr size_t WS_ALIGN(size_t x) { return (x + 255) & ~(size_t)255; }
constexpr size_t OFF_WinT = 0;
constexpr size_t OFF_WoutT = OFF_WinT + WS_ALIGN((size_t)2 * LDP * 2048 * 2);
constexpr size_t OFF_WqT = OFF_WoutT + WS_ALIGN((size_t)2 * 2048 * 2048 * 2);
constexpr size_t OFF_W1T = OFF_WqT + WS_ALIGN((size_t)2 * 1024 * 2048 * 2);
constexpr size_t OFF_PI = OFF_W1T + WS_ALIGN((size_t)4 * 128 * 4096 * 2);
constexpr size_t OFF_Utab = OFF_PI + WS_ALIGN(256);
constexpr size_t OFF_Vtab = OFF_Utab + WS_ALIGN((size_t)2 * 16384 * 1536);
constexpr size_t OFF_ada = OFF_Vtab + WS_ALIGN((size_t)2 * 16384 * 1536);
constexpr size_t OFF_ropeC = OFF_ada + WS_ALIGN((size_t)2 * 12288 * 4);
constexpr size_t OFF_ropeS = OFF_ropeC + WS_ALIGN((size_t)T * 24 * 4);
constexpr size_t OFF_HN = OFF_ropeS + WS_ALIGN((size_t)T * 24 * 4);
constexpr size_t OFF_PROJ = OFF_HN + WS_ALIGN((size_t)T * D * 2);
constexpr size_t OFF_Y = OFF_PROJ + WS_ALIGN((size_t)T * LDP * 2);
constexpr size_t OFF_QN = OFF_Y + WS_ALIGN((size_t)T * D * 2);
constexpr size_t OFF_QR = OFF_QN + WS_ALIGN((size_t)T * 512 * 2);
constexpr size_t OFF_KS = OFF_QR + WS_ALIGN((size_t)T * 512 * 2);
constexpr size_t OFF_KW = OFF_KS + WS_ALIGN((size_t)T * 128 * 2);
constexpr size_t OFF_VST = OFF_KW + WS_ALIGN((size_t)T * 128 * 2);
constexpr size_t OFF_VWT = OFF_VST + WS_ALIGN((size_t)T * 128 * 2);
constexpr size_t OFF_GATES = OFF_VWT + WS_ALIGN((size_t)T * 128 * 2);
constexpr size_t OFF_KC = OFF_GATES + WS_ALIGN((size_t)T * 12 * 4);
constexpr size_t OFF_VCT = OFF_KC + WS_ALIGN((size_t)512 * 128 * 2);
constexpr size_t OFF_SEL = OFF_VCT + WS_ALIGN((size_t)128 * 512 * 2);
constexpr size_t OFF_OCMP = OFF_SEL + WS_ALIGN((size_t)T * 4 * 4);
constexpr size_t OFF_DQ = OFF_OCMP + WS_ALIGN((size_t)T * 512 * 2);
constexpr size_t OFF_DK = OFF_DQ + WS_ALIGN((size_t)T * 512 * 2);
constexpr size_t OFF_DVC = OFF_DK + WS_ALIGN((size_t)T * 128 * 2);
constexpr size_t OFF_KVC = OFF_DVC + WS_ALIGN((size_t)T * 128 * 2);
constexpr size_t OFF_IQ = OFF_KVC + WS_ALIGN((size_t)T * 256 * 2);
constexpr size_t OFF_IK = OFF_IQ + WS_ALIGN((size_t)T * 512 * 2);
constexpr size_t OFF_IW = OFF_IK + WS_ALIGN((size_t)T * 64 * 2);
constexpr size_t OFF_IDX = OFF_IW + WS_ALIGN((size_t)T * 8 * 4);
constexpr size_t OFF_CNT = OFF_IDX + WS_ALIGN((size_t)T * 256 * 4);
constexpr size_t OFF_X1 = OFF_CNT + WS_ALIGN((size_t)T * 4);
constexpr size_t OFF_X2 = OFF_X1 + WS_ALIGN((size_t)T * D * 4);
constexpr size_t OFF_PQ = OFF_X2 + WS_ALIGN((size_t)T * D * 4);
constexpr size_t OFF_PE = OFF_PQ + WS_ALIGN((size_t)T * 1024 * 4);
constexpr size_t OFF_PG = OFF_PE + WS_ALIGN((size_t)T * 128 * 4);
constexpr size_t OFF_bar = OFF_PG + WS_ALIGN((size_t)T * 128 * 4);
constexpr size_t WS_TOTAL = OFF_bar + WS_ALIGN((size_t)CTRL_WORDS * 4);

struct P {
    const float* x; const float* c; const int* pos; const float* ada_w; const float* ada_b; const float* n1g; const float* n2g;
    const float* w_in; const float* w_out; const float* conv_w; const float* conv_b; const float* cln_g; const float* cln_b;
    const float* sln_g; const float* sln_b; const float* sgu_w; const float* sgu_b; const float* nsa_qg; const float* nsa_kg;
    const float* cmp_pos; const float* cmp_w1; const float* cmp_w2; const float* dsa_qg; const float* dsa_kg;
    const float* peer_wq; const float* peer_sk; const float* peer_u; const float* peer_v;
    float* out;
    char* ws;
    __host__ __device__ __forceinline__ bf16_t* WinT() const { return (bf16_t*)(ws + OFF_WinT); }
    __host__ __device__ __forceinline__ bf16_t* WoutT() const { return (bf16_t*)(ws + OFF_WoutT); }
    __host__ __device__ __forceinline__ bf16_t* WqT() const { return (bf16_t*)(ws + OFF_WqT); }
    __host__ __device__ __forceinline__ bf16_t* W1T() const { return (bf16_t*)(ws + OFF_W1T); }
    __host__ __device__ __forceinline__ int* PI() const { return (int*)(ws + OFF_PI); }
    __host__ __device__ __forceinline__ unsigned char* Utab() const { return (unsigned char*)(ws + OFF_Utab); }
    __host__ __device__ __forceinline__ unsigned char* Vtab() const { return (unsigned char*)(ws + OFF_Vtab); }
    __host__ __device__ __forceinline__ float* ada() const { return (float*)(ws + OFF_ada); }
    __host__ __device__ __forceinline__ float* ropeC() const { return (float*)(ws + OFF_ropeC); }
    __host__ __device__ __forceinline__ float* ropeS() const { return (float*)(ws + OFF_ropeS); }
    __host__ __device__ __forceinline__ bf16_t* HN() const { return (bf16_t*)(ws + OFF_HN); }
    __host__ __device__ __forceinline__ bf16_t* PROJ() const { return (bf16_t*)(ws + OFF_PROJ); }
    __host__ __device__ __forceinline__ bf16_t* Y() const { return (bf16_t*)(ws + OFF_Y); }
    __host__ __device__ __forceinline__ bf16_t* QN() const { return (bf16_t*)(ws + OFF_QN); }
    __host__ __device__ __forceinline__ bf16_t* QR() const { return (bf16_t*)(ws + OFF_QR); }
    __host__ __device__ __forceinline__ bf16_t* KS() const { return (bf16_t*)(ws + OFF_KS); }
    __host__ __device__ __forceinline__ bf16_t* KW() const { return (bf16_t*)(ws + OFF_KW); }
    __host__ __device__ __forceinline__ bf16_t* VST() const { return (bf16_t*)(ws + OFF_VST); }
    __host__ __device__ __forceinline__ bf16_t* VWT() const { return (bf16_t*)(ws + OFF_VWT); }
    __host__ __device__ __forceinline__ float* GATES() const { return (float*)(ws + OFF_GATES); }
    __host__ __device__ __forceinline__ bf16_t* KC() const { return (bf16_t*)(ws + OFF_KC); }
    __host__ __device__ __forceinline__ bf16_t* VCT() const { return (bf16_t*)(ws + OFF_VCT); }
    __host__ __device__ __forceinline__ unsigned* SEL() const { return (unsigned*)(ws + OFF_SEL); }
    __host__ __device__ __forceinline__ bf16_t* OCMP() const { return (bf16_t*)(ws + OFF_OCMP); }
    __host__ __device__ __forceinline__ bf16_t* DQ() const { return (bf16_t*)(ws + OFF_DQ); }
    __host__ __device__ __forceinline__ bf16_t* DK() const { return (bf16_t*)(ws + OFF_DK); }
    __host__ __device__ __forceinline__ bf16_t* DVC() const { return (bf16_t*)(ws + OFF_DVC); }
    __host__ __device__ __forceinline__ bf16_t* KVC() const { return (bf16_t*)(ws + OFF_KVC); }
    __host__ __device__ __forceinline__ bf16_t* IQ() const { return (bf16_t*)(ws + OFF_IQ); }
    __host__ __device__ __forceinline__ bf16_t* IK() const { return (bf16_t*)(ws + OFF_IK); }
    __host__ __device__ __forceinline__ float* IW() const { return (float*)(ws + OFF_IW); }
    __host__ __device__ __forceinline__ int* IDX() const { return (int*)(ws + OFF_IDX); }
    __host__ __device__ __forceinline__ int* CNT() const { return (int*)(ws + OFF_CNT); }
    __host__ __device__ __forceinline__ float* X1() const { return (float*)(ws + OFF_X1); }
    __host__ __device__ __forceinline__ float* X2() const { return (float*)(ws + OFF_X2); }
    __host__ __device__ __forceinline__ float* PQ() const { return (float*)(ws + OFF_PQ); }
    __host__ __device__ __forceinline__ int* PE() const { return (int*)(ws + OFF_PE); }
    __host__ __device__ __forceinline__ float* PG() const { return (float*)(ws + OFF_PG); }
    __host__ __device__ __forceinline__ unsigned* bar() const { return (unsigned*)(ws + OFF_bar); }
};

DEV float bf2f(bf16_t v) { return __uint_as_float(((unsigned)v) << 16); }
DEV unsigned pk2(float lo, float hi) { unsigned r; asm("v_cvt_pk_bf16_f32 %0, %1, %2" : "=v"(r) : "v"(lo), "v"(hi)); return r; }
DEV bf16_t f2bf(float v) { return (bf16_t)(pk2(v, 0.f) & 0xffffu); }
DEV float lo2f(unsigned u) { return __uint_as_float(u << 16); }
DEV float hi2f(unsigned u) { return __uint_as_float(u & 0xffff0000u); }
#define DPP_ROR_F(V, N) __int_as_float(__builtin_amdgcn_update_dpp(0, __float_as_int(V), 0x120 + (N), 0xf, 0xf, false))
DEV float wsum(float v) {
    v += DPP_ROR_F(v, 8); v += DPP_ROR_F(v, 4); v += DPP_ROR_F(v, 2); v += DPP_ROR_F(v, 1);
    const int vi = __float_as_int(v);
    return (__int_as_float(__builtin_amdgcn_readlane(vi, 0)) + __int_as_float(__builtin_amdgcn_readlane(vi, 16))) +
           (__int_as_float(__builtin_amdgcn_readlane(vi, 32)) + __int_as_float(__builtin_amdgcn_readlane(vi, 48)));
}
DEV float wmax(float v) {
    v = fmaxf(v, DPP_ROR_F(v, 8)); v = fmaxf(v, DPP_ROR_F(v, 4)); v = fmaxf(v, DPP_ROR_F(v, 2)); v = fmaxf(v, DPP_ROR_F(v, 1));
    const int vi = __float_as_int(v);
    return fmaxf(fmaxf(__int_as_float(__builtin_amdgcn_readlane(vi, 0)), __int_as_float(__builtin_amdgcn_readlane(vi, 16))),
                 fmaxf(__int_as_float(__builtin_amdgcn_readlane(vi, 32)), __int_as_float(__builtin_amdgcn_readlane(vi, 48))));
}
DEV int tidx() { int t = threadIdx.x; asm volatile("" : "+v"(t)); return t; }
DEV float sigmoidf_(float x) { return 1.0f / (1.0f + __expf(-x)); }
DEV float gelu_tanh(float x) {
    const float y = 0.7978845608028654f * (x + 0.044715f * x * x * x);
    const float t = 1.0f - 2.0f / (1.0f + __expf(2.0f * y));
    return 0.5f * x * (1.0f + t);
}
DEV f32x4 mfma16(bf16x8 a, bf16x8 b, f32x4 c) { return __builtin_amdgcn_mfma_f32_16x16x32_bf16(a, b, c, 0, 0, 0); }
DEV f32x16 mfma32(bf16x8 a, bf16x8 b, f32x16 c) { return __builtin_amdgcn_mfma_f32_32x32x16_bf16(a, b, c, 0, 0, 0); }

DEV int src_col(int n) {
    if (n < 3328) return n;
    if (n < 4672) return 3340 + (n - 3328);
    if (n < 4684) return 3328 + (n - 4672);
    if (n < 4688) return -1;
    if (n < 4696) return 4684 + (n - 4688);
    return -1;
}

DEV void st_convT(const float* __restrict__ W, bf16_t* __restrict__ Bt, int N, int Npad, bool remap, int unit, char* smem, int Kdim = 2048) {
    float (*tile)[65] = (float (*)[65])smem;
    const int ntn = Npad / 64, kt = unit / ntn, nt = unit % ntn, k0 = kt * 64, n0 = nt * 64;
    const int tid_ = tidx(); const int tx = tid_ & 63, ty = tid_ >> 6;
    const int n = n0 + tx;
    const int src = remap ? src_col(n) : (n < N ? n : -1);
#pragma unroll
    for (int i = 0; i < 16; ++i) { const int k = ty + 4 * i; tile[k][tx] = src >= 0 ? W[(size_t)(k0 + k) * N + src] : 0.f; }
    __syncthreads();
#pragma unroll
    for (int i = 0; i < 16; ++i) { const int r = ty + 4 * i; Bt[(size_t)(n0 + r) * Kdim + k0 + tx] = f2bf(tile[tx][r]); }
    __syncthreads();
}

typedef float f32x2 __attribute__((ext_vector_type(2)));
typedef float v16f __attribute__((ext_vector_type(16)));
typedef float v32f __attribute__((ext_vector_type(32)));
typedef unsigned v6u __attribute__((ext_vector_type(6)));
#ifndef PEER_FP4
#define PEER_FP4 0
#endif
#if PEER_FP4
constexpr float U6_SCALE = 64.0f, V6_SCALE = 2.8f;
constexpr int ROW6 = 1024;
#else
constexpr float U6_SCALE = 64.0f, V6_SCALE = 3.0f;
constexpr int ROW6 = 1536;
#endif
#define FP6_ONE __uint_as_float(0x3F80007Fu)

#ifndef SW_FP6
#define SW_FP6 1
#endif
DEV unsigned fp6_enc1(float f) {
    const float a = fminf(fabsf(f), 7.5f);
    const float sc = a < 2.0f ? 8.0f : (a < 4.0f ? 4.0f : 2.0f), of = a < 2.0f ? 0.0f : (a < 4.0f ? 8.0f : 16.0f);
    const unsigned code = (unsigned)(int)__builtin_rintf(a * sc + of);
    return code | ((__float_as_uint(f) >> 26) & 32u);
}
DEV float fp6_dec1(unsigned c) {
    const unsigned e = (c >> 3) & 3u, m = c & 7u;
    const float v = e == 0u ? 0.125f * (float)m : (1.0f + 0.125f * (float)m) * (float)(1u << (e - 1u));
    return (c & 32u) ? -v : v;
}
DEV v6u sw_pack32(const v16f& x, const v16f& y) {
    unsigned w[6] = {0u, 0u, 0u, 0u, 0u, 0u};
#pragma unroll
    for (int i = 0; i < 32; ++i) {
        const unsigned c = fp6_enc1(i < 16 ? x[i] : y[i - 16]);
        const int bit = 6 * i, d = bit >> 5, sh = bit & 31;
        w[d] |= c << sh;
        if (sh > 26) w[d + 1] |= c >> (32 - sh);
    }
    v6u r; r[0] = w[0]; r[1] = w[1]; r[2] = w[2]; r[3] = w[3]; r[4] = w[4]; r[5] = w[5]; return r;
}
DEV v32f sw_unpack32(const v6u& pk) {
    const unsigned w[6] = {pk[0], pk[1], pk[2], pk[3], pk[4], pk[5]};
    v32f r;
#pragma unroll
    for (int i = 0; i < 32; ++i) {
        const int bit = 6 * i, d = bit >> 5, sh = bit & 31;
        unsigned c = w[d] >> sh;
        if (sh > 26) c |= w[d + 1] << (32 - sh);
        r[i] = fp6_dec1(c & 63u);
    }
    return r;
}
#define FP6_PACK(x, y) sw_pack32(x, y)
#define FP6_UNPACK(pk) __builtin_amdgcn_cvt_scalef32_pk32_f32_fp6(pk, FP6_ONE)

typedef float f32x2_t __attribute__((ext_vector_type(2)));
DEV unsigned fp4_enc1(float f) {
    const float a = fminf(fabsf(f), 6.0f);
    const float sc = a < 2.0f ? 2.0f : (a < 4.0f ? 1.0f : 0.5f), of = a < 2.0f ? 0.0f : (a < 4.0f ? 2.0f : 4.0f);
    const unsigned code = (unsigned)(int)__builtin_rintf(a * sc + of);
    return code | ((__float_as_uint(f) >> 28) & 8u);
}
DEV void fp4_unpack8(unsigned w, float* f) {
    const f32x2_t a = __builtin_amdgcn_cvt_scalef32_pk_f32_fp4(w, FP6_ONE, 0), b = __builtin_amdgcn_cvt_scalef32_pk_f32_fp4(w, FP6_ONE, 1);
    const f32x2_t c = __builtin_amdgcn_cvt_scalef32_pk_f32_fp4(w, FP6_ONE, 2), d = __builtin_amdgcn_cvt_scalef32_pk_f32_fp4(w, FP6_ONE, 3);
    f[0] = a.x; f[1] = a.y; f[2] = b.x; f[3] = b.y; f[4] = c.x; f[5] = c.y; f[6] = d.x; f[7] = d.y;
}
DEV void st_tab4(const P& p, const float* __restrict__ src, unsigned char* __restrict__ dst, float scale, int nrows, int unit, int nunits, char* smem) {
    const int tid_ = tidx(), w = tid_ >> 6, l = tid_ & 63;
    float* stg = (float*)smem + w * (64 * 36);
    int sh[8];
#pragma unroll
    for (int k = 0; k < 8; ++k) sh[k] = 4 * __builtin_amdgcn_readfirstlane(p.PI()[40 + k]);
    for (int r = unit * 4 + w; r < nrows; r += nunits * 4) {
        const float4* sp = (const float4*)(src + (size_t)r * 2048);
        float4 v[8];
#pragma unroll
        for (int i = 0; i < 8; ++i) v[i] = sp[l + 64 * i];
#pragma unroll
        for (int i = 0; i < 8; ++i) { const int f = l + 64 * i; *(float4*)(stg + (f >> 3) * 36 + (f & 7) * 4) = v[i]; }
        __builtin_amdgcn_wave_barrier();
        unsigned wd[4] = {0u, 0u, 0u, 0u};
#pragma unroll
        for (int q = 0; q < 8; ++q) {
            const float4 a = *(const float4*)(stg + l * 36 + q * 4);
            const float xv[4] = {a.x, a.y, a.z, a.w};
#pragma unroll
            for (int e = 0; e < 4; ++e) { const int j = q * 4 + e; wd[j >> 3] |= fp4_enc1(xv[e] * scale) << sh[j & 7]; }
        }
        *(uint4*)(dst + (size_t)r * ROW6 + l * 16) = make_uint4(wd[0], wd[1], wd[2], wd[3]);
        __builtin_amdgcn_wave_barrier();
    }
}
DEV void st_tab6(const float* __restrict__ src, unsigned char* __restrict__ dst, float scale, int nrows, int unit, int nunits, char* smem) {
    const int tid_ = tidx(), w = tid_ >> 6, l = tid_ & 63;
    float* stg = (float*)smem + w * (64 * 36);
    for (int r = unit * 4 + w; r < nrows; r += nunits * 4) {
        const float4* sp = (const float4*)(src + (size_t)r * 2048);
        float4 v[8];
#pragma unroll
        for (int i = 0; i < 8; ++i) v[i] = sp[l + 64 * i];
#pragma unroll
        for (int i = 0; i < 8; ++i) { const int f = l + 64 * i; *(float4*)(stg + (f >> 3) * 36 + (f & 7) * 4) = v[i]; }
        __builtin_amdgcn_wave_barrier();
        v16f x, y;
#pragma unroll
        for (int q = 0; q < 4; ++q) {
            const float4 a = *(const float4*)(stg + l * 36 + q * 4), b = *(const float4*)(stg + l * 36 + 16 + q * 4);
            x[4 * q] = a.x * scale; x[4 * q + 1] = a.y * scale; x[4 * q + 2] = a.z * scale; x[4 * q + 3] = a.w * scale;
            y[4 * q] = b.x * scale; y[4 * q + 1] = b.y * scale; y[4 * q + 2] = b.z * scale; y[4 * q + 3] = b.w * scale;
        }
        const v6u pk = FP6_PACK(x, y);
        unsigned char* dp = dst + (size_t)r * ROW6 + l * 8;
        *(uint2*)(dp) = make_uint2(pk[0], pk[1]); *(uint2*)(dp + 512) = make_uint2(pk[2], pk[3]); *(uint2*)(dp + 1024) = make_uint2(pk[4], pk[5]);
        __builtin_amdgcn_wave_barrier();
    }
}
DEV void st_calib(const P& p) {
    if (tidx() >= 64) return;
    v16f x, y;
#pragma unroll
    for (int k = 0; k < 32; ++k) {
        const int e = k >> 3, m = k & 7;
        const float v = e == 0 ? 0.125f * m : (1.0f + 0.125f * m) * (float)(1 << (e - 1));
        if (k < 16) x[k] = v; else y[k - 16] = v;
    }
    const v6u pk = FP6_PACK(x, y);
    const v32f d = FP6_UNPACK(pk);
    if ((threadIdx.x & 63) == 0) {
        float dmax = 0.f;
#pragma unroll
        for (int j = 0; j < 32; ++j) dmax = fmaxf(dmax, fabsf(d[j]));
        const float cscale = dmax > 0.f ? dmax * (1.0f / 7.5f) : 1.0f;
        const float ic = 1.0f / cscale;
#pragma unroll
        for (int j = 0; j < 32; ++j) {
            int found = j;
#pragma unroll
            for (int k = 0; k < 32; ++k) {
                const int e = k >> 3, m = k & 7;
                const float v = e == 0 ? 0.125f * m : (1.0f + 0.125f * m) * (float)(1 << (e - 1));
                if (fabsf(d[j] * ic - v) < 0.02f + 0.01f * v) found = k;
            }
            p.PI()[j] = found;
        }
        p.PI()[32] = __float_as_int(ic);
    }
#if PEER_FP4
    {
        const unsigned probe = 0x07654321u;
        float f8[8]; fp4_unpack8(probe, f8);
        if ((threadIdx.x & 63) == 0) {
            const float val[8] = {0.f, 0.5f, 1.f, 1.5f, 2.f, 3.f, 4.f, 6.f};
            float dmax = 0.f;
#pragma unroll
            for (int k = 0; k < 8; ++k) dmax = fmaxf(dmax, fabsf(f8[k]));
            const float ic4 = dmax > 0.f ? 6.0f / dmax : 1.0f;
#pragma unroll
            for (int k = 0; k < 8; ++k) {
                int nib = k;
#pragma unroll
                for (int c = 0; c < 8; ++c) if (fabsf(f8[k] * ic4 - val[c]) < 0.1f) nib = (c + 7) & 7;
                p.PI()[40 + k] = nib;
            }
#pragma unroll
            for (int j = 0; j < 32; ++j) p.PI()[j] = j;
            p.PI()[32] = __float_as_int(ic4);
        }
    }
#endif
}

DEV void st_ada(const P& p, int unit, char* smem) {
    float4* red = (float4*)smem;
    const int tid = tidx(), c4 = tid & 15, kg = tid >> 4;
    const int i = unit / 192, j = (unit % 192) * 64 + c4 * 4;
    const float* W = p.ada_w + (size_t)i * 2048 * 12288 + (size_t)kg * 12288 + j;
    float4 acc = make_float4(0.f, 0.f, 0.f, 0.f);
#pragma unroll 1
    for (int k0 = 0; k0 < 128; k0 += 16) {
        float4 wv[16]; float a[16];
#pragma unroll
        for (int q = 0; q < 16; ++q) { const f32x4 t4 = __builtin_nontemporal_load((const f32x4*)(W + (size_t)(16 * (k0 + q)) * 12288)); wv[q] = make_float4(t4[0], t4[1], t4[2], t4[3]); }
#pragma unroll
        for (int q = 0; q < 16; ++q) { const float cv = p.c[kg + 16 * (k0 + q)]; a[q] = cv * sigmoidf_(cv); }
#pragma unroll
        for (int q = 0; q < 16; ++q) { acc.x += a[q] * wv[q].x; acc.y += a[q] * wv[q].y; acc.z += a[q] * wv[q].z; acc.w += a[q] * wv[q].w; }
    }
    red[kg * 16 + c4] = acc;
    __syncthreads();
    if (tid < 64) {
        const int cc = tid >> 2, e = tid & 3;
        float r = p.ada_b[i * 12288 + (unit % 192) * 64 + tid];
#pragma unroll
        for (int q = 0; q < 16; ++q) r += ((const float*)&red[q * 16 + cc])[e];
        p.ada()[i * 12288 + (unit % 192) * 64 + tid] = r;
    }
    __syncthreads();
}
DEV void st_rope(const P& p, int unit) {
    const int e = unit * 256 + tidx(); const int t = e / 24, i = e % 24;
    const double inv = i < 16 ? INV16[i] : INV16[2 * (i - 16)];
    const double ang = (double)p.pos[t] * inv;
    const double n = rint(ang * 0.15915494309189535);
    const double r = ang - n * 6.283185307179586;
    const double r2 = r * r;
    double sp = 1.0 / 1.5511210043330986e25, cp = -1.0 / 4.0329146112660565e26;
    sp = sp * r2 - 1.0 / 2.585201673888498e22;   cp = cp * r2 + 1.0 / 6.204484017332394e23;
    sp = sp * r2 + 1.0 / 5.109094217170944e19;   cp = cp * r2 - 1.0 / 1.1240007277776077e21;
    sp = sp * r2 - 1.0 / 1.21645100408832e17;    cp = cp * r2 + 1.0 / 2.43290200817664e18;
    sp = sp * r2 + 1.0 / 3.55687428096e14;       cp = cp * r2 - 1.0 / 6.402373705728e15;
    sp = sp * r2 - 1.0 / 1.307674368e12;         cp = cp * r2 + 1.0 / 2.0922789888e13;
    sp = sp * r2 + 1.0 / 6.2270208e9;            cp = cp * r2 - 1.0 / 8.71782912e10;
    sp = sp * r2 - 1.0 / 3.99168e7;              cp = cp * r2 + 1.0 / 4.790016e8;
    sp = sp * r2 + 1.0 / 362880.0;               cp = cp * r2 - 1.0 / 3628800.0;
    sp = sp * r2 - 1.0 / 5040.0;                 cp = cp * r2 + 1.0 / 40320.0;
    sp = sp * r2 + 1.0 / 120.0;                  cp = cp * r2 - 1.0 / 720.0;
    sp = sp * r2 - 1.0 / 6.0;                    cp = cp * r2 + 1.0 / 24.0;
    sp = sp * r2 + 1.0;                          cp = cp * r2 - 0.5;
    cp = cp * r2 + 1.0;
    const float cs = (float)cp, sn = (float)(sp * r);
    p.ropeC()[e] = cs; p.ropeS()[e] = sn;
}

DEV void st_norm(const float* __restrict__ X, const float* __restrict__ g, const float* __restrict__ sc, const float* __restrict__ sh,
                 bf16_t* __restrict__ HN, int unit) {
    const int tid_ = tidx(); const int w = tid_ >> 6, l = tid_ & 63; const int t = unit * 4 + w;
    const float4* xr = (const float4*)(X + (size_t)t * D);
    float4 v[8]; float ss = 0.f;
#pragma unroll
    for (int i = 0; i < 4; ++i) { v[2 * i] = xr[i * 128 + l * 2]; v[2 * i + 1] = xr[i * 128 + l * 2 + 1]; }
#pragma unroll
    for (int i = 0; i < 8; ++i) ss += v[i].x * v[i].x + v[i].y * v[i].y + v[i].z * v[i].z + v[i].w * v[i].w;
    ss = wsum(ss);
    const float rs = rsqrtf(ss * (1.0f / 2048.0f) + EPS);
#pragma unroll
    for (int i = 0; i < 4; ++i) {
        const int col = i * 512 + l * 8;
        float y[8]; const float xv[8] = {v[2 * i].x, v[2 * i].y, v[2 * i].z, v[2 * i].w, v[2 * i + 1].x, v[2 * i + 1].y, v[2 * i + 1].z, v[2 * i + 1].w};
#pragma unroll
        for (int j = 0; j < 8; ++j) y[j] = (xv[j] * rs) * g[col + j] * (1.0f + sc[col + j]) + sh[col + j];
        uint4 o; o.x = pk2(y[0], y[1]); o.y = pk2(y[2], y[3]); o.z = pk2(y[4], y[5]); o.w = pk2(y[6], y[7]);
        *(uint4*)(HN + (size_t)t * D + col) = o;
    }
}

enum { EPI_PROJ = 0, EPI_OUT = 1, EPI_Q = 2 };
struct EpiArgs { bf16_t* obf; float* of; const float* xin; const float* gate; bf16_t* kvc; };
template <int EPI, int MT = 4>
DEV void st_gemm(const bf16_t* __restrict__ A, const bf16_t* __restrict__ Bt, int K, int tm, int tn, const EpiArgs& e, char* smem) {
    constexpr int BM = 32 * MT, ABYTES = BM * 64, BUFB = ABYTES + 8192, NBUF = (MT == 4) ? 4 : 3, NA = BM / 64;
    static_assert(NBUF * BUFB <= SMEM_BYTES, "GEMM LDS");
    const int tid = tidx(), w = tid >> 6, l = tid & 63, wr = w >> 1, wc = w & 1;
    f32x4 acc[MT][4];
#pragma unroll
    for (int m = 0; m < MT; ++m)
#pragma unroll
        for (int n = 0; n < 4; ++n) acc[m][n] = (f32x4){0.f, 0.f, 0.f, 0.f};
    const int srow = tid >> 2, spc = tid & 3, sc = spc ^ (((srow >> 2) & 1) << 1);
    const bf16_t* Ag = A + (size_t)(tm * BM + srow) * K + sc * 8;
    const bf16_t* Bg = Bt + (size_t)(tn * 128 + srow) * K + sc * 8;
#define GEMM_STAGE(BUF, KO) do { char* _b = smem + (BUF) * BUFB + tid * 16; \
        _Pragma("unroll") for (int _i = 0; _i < NA; ++_i) \
            __builtin_amdgcn_global_load_lds((const unsigned*)(Ag + (size_t)(64 * _i) * K + (KO)), (__attribute__((address_space(3))) unsigned*)(_b + _i * 4096), 16, 0, 0); \
        __builtin_amdgcn_global_load_lds((const unsigned*)(Bg + (KO)), (__attribute__((address_space(3))) unsigned*)(_b + ABYTES), 16, 0, 0); \
        __builtin_amdgcn_global_load_lds((const unsigned*)(Bg + (size_t)64 * K + (KO)), (__attribute__((address_space(3))) unsigned*)(_b + ABYTES + 4096), 16, 0, 0); } while (0)
    const int nk = K / 32;
    GEMM_STAGE(0, 0); GEMM_STAGE(1, 32);
    if (NBUF == 4) { GEMM_STAGE(2, 64); asm volatile("s_waitcnt vmcnt(8)" ::: "memory"); }
    else asm volatile("s_waitcnt vmcnt(6)" ::: "memory");
    __builtin_amdgcn_s_barrier();
    const int fr = l & 15, fq = l >> 4;
    int cur = 0, nxt = NBUF - 1;
#pragma unroll 1
    for (int kt = 0; kt < nk; ++kt) {
        if (kt + NBUF - 1 < nk) GEMM_STAGE(nxt, (kt + NBUF - 1) * 32);
        const char* As = smem + cur * BUFB; const char* Bs = As + ABYTES;
        bf16x8 bfr[4];
#pragma unroll
        for (int n = 0; n < 4; ++n) { const int row = wc * 64 + n * 16 + fr; bfr[n] = *(const bf16x8*)(Bs + row * 64 + ((fq ^ (((row >> 2) & 1) << 1)) << 4)); }
#pragma unroll
        for (int m = 0; m < MT; ++m) {
            const int row = wr * (BM / 2) + m * 16 + fr;
            const bf16x8 af = *(const bf16x8*)(As + row * 64 + ((fq ^ (((row >> 2) & 1) << 1)) << 4));
#pragma unroll
            for (int n = 0; n < 4; ++n) acc[m][n] = mfma16(bfr[n], af, acc[m][n]);
        }
        if (NBUF == 4) {
            if (kt + 3 < nk) asm volatile("s_waitcnt vmcnt(8)" ::: "memory");
            else if (kt + 2 < nk) asm volatile("s_waitcnt vmcnt(4)" ::: "memory");
            else asm volatile("s_waitcnt vmcnt(0)" ::: "memory");
        } else {
            if (kt + 2 < nk) asm volatile("s_waitcnt vmcnt(6)" ::: "memory");
            else asm volatile("s_waitcnt vmcnt(0)" ::: "memory");
        }
        asm volatile("s_waitcnt lgkmcnt(0)" ::: "memory");
        __builtin_amdgcn_s_barrier();
        cur = (cur + 1 == NBUF) ? 0 : cur + 1; nxt = (nxt + 1 == NBUF) ? 0 : nxt + 1;
    }
#undef GEMM_STAGE
#pragma unroll
    for (int m = 0; m < MT; ++m) {
        const int row = tm * BM + wr * (BM / 2) + m * 16 + (l & 15);
#pragma unroll
        for (int n = 0; n < 4; ++n) {
            const int col = tn * 128 + wc * 64 + n * 16 + 4 * (l >> 4);
            const f32x4 a = acc[m][n];
            if (EPI == EPI_PROJ) {
                uint2 o; o.x = pk2(a[0], a[1]); o.y = pk2(a[2], a[3]);
                *(uint2*)(e.obf + (size_t)row * LDP + col) = o;
                if (col >= C_NKC && col < C_NKC + 256) *(uint2*)(e.kvc + (size_t)row * 256 + (col - C_NKC)) = o;
            } else if (EPI == EPI_OUT) {
                const float4 xi = *(const float4*)(e.xin + (size_t)row * D + col);
                const float4 gg = *(const float4*)(e.gate + col);
                float4 o; o.x = xi.x + gg.x * a[0]; o.y = xi.y + gg.y * a[1]; o.z = xi.z + gg.z * a[2]; o.w = xi.w + gg.w * a[3];
                *(float4*)(e.of + (size_t)row * D + col) = o;
            } else {
                float4 o; o.x = a[0]; o.y = a[1]; o.z = a[2]; o.w = a[3];
                *(float4*)(e.of + (size_t)row * 1024 + col) = o;
            }
        }
    }
    __syncthreads();
}

DEV void st_conv(const P& p, int layer, int unit, char* smem) {
    float* cs = (float*)smem;
    const int tid = tidx(), t0 = unit * 16;
    const float* cw = p.conv_w + (size_t)layer * 31 * 512;
#pragma unroll 1
    for (int cc = 0; cc < 2; ++cc) {
        const int c = tid + 256 * cc;
        float w[31], z[46];
#pragma unroll
        for (int k = 0; k < 31; ++k) w[k] = cw[k * 512 + c];
#pragma unroll
        for (int r = 0; r < 46; ++r) {
            const int t = t0 - 30 + r, tc = t < 0 ? 0 : t;
            const float a = bf2f(p.PROJ()[(size_t)tc * LDP + C_CA + c]), g = bf2f(p.PROJ()[(size_t)tc * LDP + C_CG + c]);
            z[r] = t >= 0 ? a * sigmoidf_(g) : 0.f;
        }
        const float cb = p.conv_b[layer * 512 + c];
#pragma unroll
        for (int tt = 0; tt < 16; ++tt) {
            float acc = cb;
#pragma unroll
            for (int k = 0; k < 31; ++k) acc += w[k] * z[tt + k];
            cs[tt * 512 + c] = acc;
        }
    }
    __syncthreads();
    const int w = tid >> 6, l = tid & 63;
    const float* lg = p.cln_g + layer * 512; const float* lb = p.cln_b + layer * 512;
#pragma unroll 1
    for (int q = 0; q < 4; ++q) {
        const int tt = w * 4 + q;
        float v[8]; float s = 0.f;
#pragma unroll
        for (int i = 0; i < 8; ++i) { v[i] = cs[tt * 512 + l + 64 * i]; s += v[i]; }
        const float mean = wsum(s) * (1.0f / 512.0f);
        float q2 = 0.f;
#pragma unroll
        for (int i = 0; i < 8; ++i) { const float d = v[i] - mean; q2 += d * d; }
        const float rstd = rsqrtf(wsum(q2) * (1.0f / 512.0f) + EPS);
#pragma unroll
        for (int i = 0; i < 8; ++i) {
            const int c = l + 64 * i;
            const float y = (v[i] - mean) * rstd * lg[c] + lb[c];
            p.Y()[(size_t)(t0 + tt) * D + c] = f2bf(y * sigmoidf_(y));
        }
    }
    __syncthreads();
}

DEV void st_sgu(const P& p, int layer, int unit, char* smem) {
    constexpr int RSB = 136;
    const int n = unit >> 2, h = unit & 3, tid = tidx(), w = tid >> 6, l = tid & 63;
    float* stat = (float*)smem;
    bf16_t* wtb = (bf16_t*)(smem + 1024);
    bf16_t* vtb = wtb + 128 * RSB;
    const int tb = n * 128;
#pragma unroll 4
    for (int q = 0; q < 32; ++q) {
        const int j = w * 32 + q;
        const uint4 raw = *(const uint4*)(p.PROJ() + (size_t)(tb + j) * LDP + C_SV + l * 8);
        float v[8] = {lo2f(raw.x), hi2f(raw.x), lo2f(raw.y), hi2f(raw.y), lo2f(raw.z), hi2f(raw.z), lo2f(raw.w), hi2f(raw.w)};
        float s = 0.f;
#pragma unroll
        for (int i = 0; i < 8; ++i) s += v[i];
        const float mean = wsum(s) * (1.0f / 512.0f);
        float q2 = 0.f;
#pragma unroll
        for (int i = 0; i < 8; ++i) { const float d = v[i] - mean; q2 += d * d; }
        const float rstd = rsqrtf(wsum(q2) * (1.0f / 512.0f) + EPS);
        if (l == 0) { stat[j * 2] = mean; stat[j * 2 + 1] = rstd; }
    }
    const float* Wh = p.sgu_w + ((size_t)layer * 4 + h) * 128 * 128;
    {
        float4 wv[16];
#pragma unroll
        for (int q = 0; q < 16; ++q) wv[q] = *(const float4*)(Wh + (size_t)(tid + 256 * q) * 4);
#pragma unroll
        for (int q = 0; q < 16; ++q) {
            const int f = tid + 256 * q, i = f >> 5, j4 = (f & 31) * 4;
            const float x4[4] = {wv[q].x, wv[q].y, wv[q].z, wv[q].w};
#pragma unroll
            for (int e = 0; e < 4; ++e) wtb[(j4 + e) * RSB + i] = (i >= j4 + e) ? f2bf(x4[e]) : (bf16_t)0;
        }
    }
    __syncthreads();
    {
        const float* lg = p.sln_g + layer * 512 + h * 128; const float* lb = p.sln_b + layer * 512 + h * 128;
        uint4 vr[8];
#pragma unroll
        for (int q = 0; q < 8; ++q) { const int f = tid + 256 * q, j = f >> 4, d8 = (f & 15) * 8; vr[q] = *(const uint4*)(p.PROJ() + (size_t)(tb + j) * LDP + C_SV + h * 128 + d8); }
#pragma unroll
        for (int q = 0; q < 8; ++q) {
            const int f = tid + 256 * q, j = f >> 4, d8 = (f & 15) * 8;
            const float mean = stat[j * 2], rstd = stat[j * 2 + 1];
            const float4 g0 = *(const float4*)(lg + d8), g1 = *(const float4*)(lg + d8 + 4), b0 = *(const float4*)(lb + d8), b1 = *(const float4*)(lb + d8 + 4);
            uint4 o;
            o.x = pk2((lo2f(vr[q].x) - mean) * rstd * g0.x + b0.x, (hi2f(vr[q].x) - mean) * rstd * g0.y + b0.y);
            o.y = pk2((lo2f(vr[q].y) - mean) * rstd * g0.z + b0.z, (hi2f(vr[q].y) - mean) * rstd * g0.w + b0.w);
            o.z = pk2((lo2f(vr[q].z) - mean) * rstd * g1.x + b1.x, (hi2f(vr[q].z) - mean) * rstd * g1.y + b1.y);
            o.w = pk2((lo2f(vr[q].w) - mean) * rstd * g1.z + b1.z, (hi2f(vr[q].w) - mean) * rstd * g1.w + b1.w);
            *(uint4*)(vtb + j * RSB + d8) = o;
        }
    }
    __syncthreads();
    const int ti = tid >> 4, td = tid & 15;
    float acc[8][8];
#pragma unroll
    for (int a = 0; a < 8; ++a)
#pragma unroll
        for (int bq = 0; bq < 8; ++bq) acc[a][bq] = 0.f;
    const int jend = w * 32 + 32;
#pragma unroll 2
    for (int j = 0; j < jend; ++j) {
        const uint4 wr = *(const uint4*)(wtb + j * RSB + ti * 8), vr = *(const uint4*)(vtb + j * RSB + td * 8);
        const float wv[8] = {lo2f(wr.x), hi2f(wr.x), lo2f(wr.y), hi2f(wr.y), lo2f(wr.z), hi2f(wr.z), lo2f(wr.w), hi2f(wr.w)};
        const float vv[8] = {lo2f(vr.x), hi2f(vr.x), lo2f(vr.y), hi2f(vr.y), lo2f(vr.z), hi2f(vr.z), lo2f(vr.w), hi2f(vr.w)};
#pragma unroll
        for (int a = 0; a < 8; ++a)
#pragma unroll
            for (int bq = 0; bq < 8; ++bq) acc[a][bq] += wv[a] * vv[bq];
    }
#pragma unroll
    for (int a = 0; a < 8; ++a) {
        const int i = ti * 8 + a; const size_t t = tb + i;
        const float bs = p.sgu_b[((size_t)layer * 4 + h) * 128 + i];
        const uint4 ur = *(const uint4*)(p.PROJ() + t * LDP + C_SU + h * 128 + td * 8);
        const float u[8] = {lo2f(ur.x), hi2f(ur.x), lo2f(ur.y), hi2f(ur.y), lo2f(ur.z), hi2f(ur.z), lo2f(ur.w), hi2f(ur.w)};
        float y[8];
#pragma unroll
        for (int bq = 0; bq < 8; ++bq) y[bq] = u[bq] * (acc[a][bq] + bs);
        uint4 o; o.x = pk2(y[0], y[1]); o.y = pk2(y[2], y[3]); o.z = pk2(y[4], y[5]); o.w = pk2(y[6], y[7]);
        *(uint4*)(p.Y() + t * D + 512 + h * 128 + td * 8) = o;
    }
    __syncthreads();
}

DEV void st_vtrans(const P& p, int unit, char* smem) {
    bf16_t* tile = (bf16_t*)smem;
    const int which = unit & 1, tt0 = (unit >> 1) * 64, tid = tidx();
    const int col0 = which ? C_NVW : C_NVS;
    bf16_t* dst = which ? p.VWT() : p.VST();
#pragma unroll
    for (int q = 0; q < 4; ++q) {
        const int e = tid + 256 * q; const int r = e >> 4, c8 = e & 15;
        const uint4 raw = *(const uint4*)(p.PROJ() + (size_t)(tt0 + r) * LDP + col0 + c8 * 8);
        unsigned* d32 = (unsigned*)(tile + r * 130 + c8 * 8);
        d32[0] = raw.x; d32[1] = raw.y; d32[2] = raw.z; d32[3] = raw.w;
    }
    __syncthreads();
    const int d = tid >> 1, half = tid & 1;
    unsigned o[16];
#pragma unroll
    for (int i = 0; i < 16; ++i) {
        const unsigned a = tile[(half * 32 + 2 * i) * 130 + d], b = tile[(half * 32 + 2 * i + 1) * 130 + d];
        o[i] = a | (b << 16);
    }
    uint4* dp = (uint4*)(dst + (size_t)d * T + tt0 + half * 32);
#pragma unroll
    for (int i = 0; i < 4; ++i) dp[i] = make_uint4(o[4 * i], o[4 * i + 1], o[4 * i + 2], o[4 * i + 3]);
    __syncthreads();
}

DEV void st_prep(const P& p, int layer, int unit) {
    const int tid_ = tidx(); const int w = tid_ >> 6, l = tid_ & 63; const size_t t = (size_t)unit * 4 + w;
    const bf16_t* row = p.PROJ() + t * LDP;
    const float* rc = p.ropeC() + t * 24; const float* rs_ = p.ropeS() + t * 24;
    unsigned raw[11];
#pragma unroll
    for (int h = 0; h < 4; ++h) { raw[h] = *(const unsigned*)(row + C_NQ + h * 128 + 2 * l); raw[6 + h] = *(const unsigned*)(row + C_DQ + h * 128 + 2 * l); }
    raw[4] = *(const unsigned*)(row + C_NKS + 2 * l); raw[5] = *(const unsigned*)(row + C_NKW + 2 * l); raw[10] = *(const unsigned*)(row + C_DK + 2 * l);
    bf16_t iraw[9];
#pragma unroll
    for (int h = 0; h < 9; ++h) iraw[h] = row[(h < 8 ? C_IQ + h * 64 : C_IK) + l];
    const float gq0 = p.nsa_qg[layer * 128 + 2 * l], gq1 = p.nsa_qg[layer * 128 + 2 * l + 1];
    const float gs0 = p.nsa_kg[(layer * 3 + 1) * 128 + 2 * l], gs1 = p.nsa_kg[(layer * 3 + 1) * 128 + 2 * l + 1];
    const float gw0 = p.nsa_kg[(layer * 3 + 2) * 128 + 2 * l], gw1 = p.nsa_kg[(layer * 3 + 2) * 128 + 2 * l + 1];
    const float dq0 = p.dsa_qg[layer * 128 + 2 * l], dq1 = p.dsa_qg[layer * 128 + 2 * l + 1];
    const float dk0 = p.dsa_kg[layer * 128 + 2 * l], dk1 = p.dsa_kg[layer * 128 + 2 * l + 1];
    const float c0 = rc[(2 * l) & 15], c1 = rc[(2 * l + 1) & 15], s0 = rs_[(2 * l) & 15], s1 = rs_[(2 * l + 1) & 15];
    const float ic = rc[16 + (l & 7)], is = rs_[16 + (l & 7)];
    float x0[11], x1[11], ss[11];
#pragma unroll
    for (int h = 0; h < 11; ++h) { x0[h] = lo2f(raw[h]); x1[h] = hi2f(raw[h]); ss[h] = x0[h] * x0[h] + x1[h] * x1[h]; }
#pragma unroll
    for (int h = 0; h < 11; ++h) ss[h] = wsum(ss[h]);
#pragma unroll
    for (int h = 0; h < 11; ++h) {
        const float r = rsqrtf(ss[h] * (1.0f / 128.0f) + EPS);
        const float g0 = h < 4 ? gq0 : (h == 4 ? gs0 : (h == 5 ? gw0 : (h < 10 ? dq0 : dk0)));
        const float g1 = h < 4 ? gq1 : (h == 4 ? gs1 : (h == 5 ? gw1 : (h < 10 ? dq1 : dk1)));
        const float n0 = x0[h] * r * g0, n1 = x1[h] * r * g1;
        const float o0 = __shfl_xor(n0, 8), o1 = __shfl_xor(n1, 8);
        float r0 = n0, r1 = n1;
        if (l < 8) { r0 = n0 * c0 - o0 * s0; r1 = n1 * c1 - o1 * s1; }
        else if (l < 16) { r0 = n0 * c0 + o0 * s0; r1 = n1 * c1 + o1 * s1; }
        const unsigned roped = pk2(r0, r1);
        if (h < 4) { *(unsigned*)(p.QN() + (t * 4 + h) * 128 + 2 * l) = pk2(n0, n1); *(unsigned*)(p.QR() + (t * 4 + h) * 128 + 2 * l) = roped; }
        else if (h == 4) *(unsigned*)(p.KS() + t * 128 + 2 * l) = roped;
        else if (h == 5) *(unsigned*)(p.KW() + t * 128 + 2 * l) = roped;
        else if (h < 10) *(unsigned*)(p.DQ() + (t * 4 + (h - 6)) * 128 + 2 * l) = roped;
        else *(unsigned*)(p.DK() + t * 128 + 2 * l) = roped;
    }
    if (l < 12) p.GATES()[t * 12 + l] = sigmoidf_(bf2f(row[C_NG + l]));
    *(unsigned*)(p.DVC() + t * 128 + 2 * l) = *(const unsigned*)(row + C_DV + 2 * l);
#pragma unroll
    for (int h = 0; h < 9; ++h) {
        const float x = bf2f(iraw[h]);
        const float other = __shfl_xor(x, 8);
        float o = x;
        if (l < 16) o = (l < 8) ? (x * ic - other * is) : (x * ic + other * is);
        if (h < 8) p.IQ()[(t * 8 + h) * 64 + l] = f2bf(o); else p.IK()[t * 64 + l] = f2bf(o);
    }
    if (l < 8) p.IW()[t * 8 + l] = bf2f(row[C_IW + l]) * (0.35355339059327373f * 0.125f);
}

DEV void st_compress(const P& p, int layer, int unit, char* smem) {
    const int which = unit & 1, rt = unit >> 1, tid = tidx(), w = tid >> 6, l = tid & 63, fr = l & 15, fq = l >> 4;
    float* hid = (float*)smem;
    float* ob = hid + 16 * 128;
    const int nb = rt * 16 + fr;
    const int col0 = which ? C_NVC : C_NKC;
    const float* ps = p.cmp_pos + ((size_t)layer * 2 + which) * 4096;
    const bf16_t* w1t = p.W1T() + ((size_t)layer * 2 + which) * 128 * 4096;
    const bool rowok = nb < 511;
    const bf16_t* xrow = p.KVC() + (size_t)(rowok ? nb * 16 : 0) * 256 + (which ? 128 : 0);
    f32x4 acc[2] = {(f32x4){0.f, 0.f, 0.f, 0.f}, (f32x4){0.f, 0.f, 0.f, 0.f}};
#pragma unroll 8
    for (int ks = 0; ks < 128; ++ks) {
        const int k = ks * 32 + fq * 8, lt = k >> 7, d = k & 127;
        const uint4 xr = *(const uint4*)(xrow + (size_t)lt * 256 + d);
        const float4 p0 = *(const float4*)(ps + k), p1 = *(const float4*)(ps + k + 4);
        union { bf16x8 v; unsigned u32[4]; } a;
        a.u32[0] = pk2(lo2f(xr.x) + p0.x, hi2f(xr.x) + p0.y); a.u32[1] = pk2(lo2f(xr.y) + p0.z, hi2f(xr.y) + p0.w);
        a.u32[2] = pk2(lo2f(xr.z) + p1.x, hi2f(xr.z) + p1.y); a.u32[3] = pk2(lo2f(xr.w) + p1.z, hi2f(xr.w) + p1.w);
#pragma unroll
        for (int nt = 0; nt < 2; ++nt) {
            const bf16x8 b = *(const bf16x8*)(w1t + (size_t)(w * 32 + nt * 16 + fr) * 4096 + k);
            acc[nt] = mfma16(a.v, b, acc[nt]);
        }
    }
#pragma unroll
    for (int nt = 0; nt < 2; ++nt)
#pragma unroll
        for (int r = 0; r < 4; ++r) hid[(4 * fq + r) * 128 + w * 32 + nt * 16 + fr] = gelu_tanh(acc[nt][r]);
    __syncthreads();
    const float* w2 = p.cmp_w2 + ((size_t)layer * 2 + which) * 128 * 128;
    const int c2 = tid & 127, mh = tid >> 7;
    float o[8];
#pragma unroll
    for (int b = 0; b < 8; ++b) o[b] = 0.f;
#pragma unroll 1
    for (int k0 = 0; k0 < 128; k0 += 32) {
        float wv[32];
#pragma unroll
        for (int k = 0; k < 32; ++k) wv[k] = w2[(k0 + k) * 128 + c2];
#pragma unroll
        for (int k4 = 0; k4 < 8; ++k4)
#pragma unroll
            for (int b = 0; b < 8; ++b) {
                const float4 h4 = *(const float4*)(hid + (mh * 8 + b) * 128 + k0 + k4 * 4);
                o[b] += h4.x * wv[4 * k4] + h4.y * wv[4 * k4 + 1] + h4.z * wv[4 * k4 + 2] + h4.w * wv[4 * k4 + 3];
            }
    }
#pragma unroll
    for (int b = 0; b < 8; ++b) ob[(mh * 8 + b) * 128 + c2] = o[b];
    __syncthreads();
#pragma unroll
    for (int q = 0; q < 4; ++q) {
        const int b = w * 4 + q, nbo = rt * 16 + b;
        float v0 = ob[b * 128 + l], v1 = ob[b * 128 + l + 64];
        if (which == 0) {
            const float r = rsqrtf(wsum(v0 * v0 + v1 * v1) * (1.0f / 128.0f) + EPS);
            const float* kg = p.nsa_kg + (layer * 3 + 0) * 128;
            v0 = v0 * r * kg[l]; v1 = v1 * r * kg[l + 64];
            if (nbo >= 511) { v0 = 0.f; v1 = 0.f; }
            p.KC()[nbo * 128 + l] = f2bf(v0); p.KC()[nbo * 128 + l + 64] = f2bf(v1);
        } else {
            if (nbo >= 511) { v0 = 0.f; v1 = 0.f; }
            p.VCT()[l * 512 + nbo] = f2bf(v0); p.VCT()[(l + 64) * 512 + nbo] = f2bf(v1);
        }
    }
    __syncthreads();
}

DEV void st_nsa_cmp(const P& p, int unit, char* smem) {
    constexpr int RSK = 272, RSV = 136, BUFB = 64 * RSK + 128 * RSV;
    const int tid = tidx(), w = tid >> 6, l = tid & 63, qc = l & 15, g4 = l >> 4;
    const int t0 = unit * 16 + w * 4;
    const int tk = qc >> 2, hd = qc & 3, t = t0 + tk;
    bf16x8 qf[4];
#pragma unroll
    for (int ks = 0; ks < 4; ++ks) qf[ks] = *(const bf16x8*)(p.QN() + ((size_t)t0 * 4 + qc) * 128 + ks * 32 + g4 * 8);
    const int tmaxb = unit * 16 + 15;
    const int nvb = tmaxb >= 31 ? (tmaxb - 31) / 16 + 1 : 0;
    const int nsteps = (nvb + 63) >> 6;
    const int nvis = t >= 31 ? (t - 31) / 16 + 1 : 0;
    const float cs = 0.08838834764831845f * 1.4426950408889634f;
    const int krow = tid >> 4, kc16 = tid & 15, vrow = tid >> 3, vc16 = tid & 7;
    const bf16_t* Kg = p.KC(); const bf16_t* Vg = p.VCT();
    int gstep = 0;
    uint4 rk0, rk1, rk2, rk3, rv0, rv1, rv2, rv3;
#define CMP_LOADK(ST) do { const bf16_t* kb = Kg + (size_t)((ST) * 64 + krow) * 128 + kc16 * 8; \
        rk0 = *(const uint4*)kb; rk1 = *(const uint4*)(kb + 16 * 128); rk2 = *(const uint4*)(kb + 32 * 128); rk3 = *(const uint4*)(kb + 48 * 128); } while (0)
#define CMP_LOADV(ST) do { const bf16_t* vb = Vg + (size_t)vrow * 512 + (ST) * 64 + vc16 * 8; \
        rv0 = *(const uint4*)vb; rv1 = *(const uint4*)(vb + 32 * 512); rv2 = *(const uint4*)(vb + 64 * 512); rv3 = *(const uint4*)(vb + 96 * 512); } while (0)
#define CMP_STOREK(KT) do { *(uint4*)((KT) + krow * RSK + kc16 * 16) = rk0; *(uint4*)((KT) + (krow + 16) * RSK + kc16 * 16) = rk1; \
        *(uint4*)((KT) + (krow + 32) * RSK + kc16 * 16) = rk2; *(uint4*)((KT) + (krow + 48) * RSK + kc16 * 16) = rk3; } while (0)
#define CMP_STOREV(VT) do { *(uint4*)((VT) + vrow * RSV + vc16 * 16) = rv0; *(uint4*)((VT) + (vrow + 32) * RSV + vc16 * 16) = rv1; \
        *(uint4*)((VT) + (vrow + 64) * RSV + vc16 * 16) = rv2; *(uint4*)((VT) + (vrow + 96) * RSV + vc16 * 16) = rv3; } while (0)
    float m = -1e30f, lsum = 0.f;
    if (nsteps > 0) CMP_LOADK(0);
#pragma unroll 1
    for (int st = 0; st < nsteps; ++st, ++gstep) {
        char* Kt = smem + (gstep & 1) * BUFB;
        CMP_STOREK(Kt);
        __syncthreads();
        if (st + 1 < nsteps) CMP_LOADK(st + 1);
        float mx = m; f32x4 sv[4];
#pragma unroll
        for (int sub = 0; sub < 4; ++sub) {
            f32x4 a4 = (f32x4){0.f, 0.f, 0.f, 0.f};
#pragma unroll
            for (int ks = 0; ks < 4; ++ks) a4 = mfma16(*(const bf16x8*)(Kt + (sub * 16 + qc) * RSK + (ks * 32 + g4 * 8) * 2), qf[ks], a4);
#pragma unroll
            for (int r = 0; r < 4; ++r) { const int key = st * 64 + sub * 16 + 4 * g4 + r; a4[r] = (key < nvis) ? a4[r] * cs : -3e38f; mx = fmaxf(mx, a4[r]); }
            sv[sub] = a4;
        }
        float ps = 0.f;
#pragma unroll
        for (int sub = 0; sub < 4; ++sub)
#pragma unroll
            for (int r = 0; r < 4; ++r) ps += __builtin_amdgcn_exp2f(sv[sub][r] - mx);
        lsum = lsum * __builtin_amdgcn_exp2f(m - mx) + ps; m = mx;
    }
    {
        float mt_ = fmaxf(m, __shfl_xor(m, 16)); mt_ = fmaxf(mt_, __shfl_xor(mt_, 32));
        lsum *= __builtin_amdgcn_exp2f(m - mt_); m = mt_;
        lsum += __shfl_xor(lsum, 16); lsum += __shfl_xor(lsum, 32);
    }
    const float inv = (nvis > 0 && lsum > 0.f) ? 1.0f / lsum : 0.f;
    f32x4 o[8];
#pragma unroll
    for (int mt = 0; mt < 8; ++mt) o[mt] = (f32x4){0.f, 0.f, 0.f, 0.f};
    float yprev = 0.f;
    float impv[32];
#pragma unroll
    for (int i = 0; i < 32; ++i) impv[i] = 0.f;
    if (nsteps > 0) { CMP_LOADK(0); CMP_LOADV(0); }
#pragma unroll
    for (int st = 0; st < 8; ++st) {
        if (st < nsteps) {
            char* Kt = smem + (gstep & 1) * BUFB; char* Vt = Kt + 64 * RSK; ++gstep;
            CMP_STOREK(Kt); CMP_STOREV(Vt);
            __syncthreads();
            if (st + 1 < nsteps) { CMP_LOADK(st + 1); CMP_LOADV(st + 1); }
            f32x4 sv[4];
#pragma unroll
            for (int sub = 0; sub < 4; ++sub) {
                f32x4 a4 = (f32x4){0.f, 0.f, 0.f, 0.f};
#pragma unroll
                for (int ks = 0; ks < 4; ++ks) a4 = mfma16(*(const bf16x8*)(Kt + (sub * 16 + qc) * RSK + (ks * 32 + g4 * 8) * 2), qf[ks], a4);
#pragma unroll
                for (int r = 0; r < 4; ++r) { const int key = st * 64 + sub * 16 + 4 * g4 + r; a4[r] = (key < nvis) ? __builtin_amdgcn_exp2f(a4[r] * cs - m) * inv : 0.f; }
                const float y = __shfl(a4[3], (l + 48) & 63);
                float iv = (a4[0] + a4[1]) + (a4[2] + a4[3]) + (g4 > 0 ? y : yprev);
                yprev = y;
                iv += __shfl_xor(iv, 1); iv += __shfl_xor(iv, 2);
                impv[st * 4 + sub] = iv;
                sv[sub] = a4;
            }
#pragma unroll
            for (int pr = 0; pr < 2; ++pr) {
                union { bf16x8 v; unsigned u32[4]; } bb;
                bb.u32[0] = pk2(sv[2 * pr][0], sv[2 * pr][1]); bb.u32[1] = pk2(sv[2 * pr][2], sv[2 * pr][3]);
                bb.u32[2] = pk2(sv[2 * pr + 1][0], sv[2 * pr + 1][1]); bb.u32[3] = pk2(sv[2 * pr + 1][2], sv[2 * pr + 1][3]);
#pragma unroll
                for (int mt = 0; mt < 8; ++mt) {
                    const char* vp = Vt + (mt * 16 + qc) * RSV + (pr * 32 + 4 * g4) * 2;
                    union { bf16x8 v; uint2 h2[2]; } aa;
                    aa.h2[0] = *(const uint2*)vp; aa.h2[1] = *(const uint2*)(vp + 32);
                    o[mt] = mfma16(aa.v, bb.v, o[mt]);
                }
            }
        }
    }
#undef CMP_LOADK
#undef CMP_LOADV
#undef CMP_STOREK
#undef CMP_STOREV
    __syncthreads();
    float* impl = (float*)smem + w * 512;
    if (hd == 0) {
#pragma unroll
        for (int i = 0; i < 32; ++i) impl[tk * 128 + 4 * i + g4] = impv[i];
    }
#pragma unroll
    for (int mt = 0; mt < 8; ++mt) {
        uint2 ov; ov.x = pk2(o[mt][0], o[mt][1]); ov.y = pk2(o[mt][2], o[mt][3]);
        *(uint2*)(p.OCMP() + ((size_t)t * 4 + hd) * 128 + mt * 16 + 4 * g4) = ov;
    }
    __syncthreads();
    const int li = hd + 4 * g4, cur = t >> 6;
    unsigned long long own[8]; int rank[8];
#pragma unroll
    for (int i = 0; i < 8; ++i) {
        const int j = li + 16 * i; const float v = impl[tk * 128 + j];
        const unsigned k32 = (j == 0 || j == cur || j == cur - 1) ? 0xFFFFFFFFu : (j > cur ? 0u : __float_as_uint(v) + 128u);
        own[i] = ((unsigned long long)k32 << 7) | (unsigned)(127 - j); rank[i] = 0;
    }
#pragma unroll 1
    for (int ip = 0; ip < 8; ++ip) {
#pragma unroll
        for (int q4 = 0; q4 < 4; ++q4) {
            const float4 ov = *(const float4*)(impl + tk * 128 + ip * 16 + q4 * 4);
            const float o4[4] = {ov.x, ov.y, ov.z, ov.w};
#pragma unroll
            for (int e = 0; e < 4; ++e) {
                const int jp = ip * 16 + q4 * 4 + e;
                const unsigned k32 = (jp == 0 || jp == cur || jp == cur - 1) ? 0xFFFFFFFFu : (jp > cur ? 0u : __float_as_uint(o4[e]) + 128u);
                const unsigned long long kp = ((unsigned long long)k32 << 7) | (unsigned)(127 - jp);
#pragma unroll
                for (int i = 0; i < 8; ++i) rank[i] += (kp > own[i]) ? 1 : 0;
            }
        }
    }
    unsigned mw[4] = {0u, 0u, 0u, 0u};
#pragma unroll
    for (int i = 0; i < 8; ++i) if (rank[i] < 16) mw[i >> 1] |= 1u << (li + 16 * (i & 1));
#pragma unroll
    for (int q = 0; q < 4; ++q) {
        unsigned v = mw[q];
        v |= __shfl_xor(v, 1); v |= __shfl_xor(v, 2); v |= __shfl_xor(v, 16); v |= __shfl_xor(v, 32);
        mw[q] = v;
    }
    if (li == 0) *(uint4*)(p.SEL() + (size_t)t * 4) = make_uint4(mw[0], mw[1], mw[2], mw[3]);
    __syncthreads();
}

DEV void st_nsa_attn(const P& p, int unit, char* smem) {
    constexpr int RSK = 272, RSV = 136, BUFB = 64 * RSK + 128 * RSV;
    const int tid = tidx(), w = tid >> 6, l = tid & 63, qc = l & 15, g4 = l >> 4;
    const int tq0 = unit * 16, t = tq0 + w * 4 + (qc >> 2), hd = qc & 3;
    bf16x8 qf[4];
#pragma unroll
    for (int ks = 0; ks < 4; ++ks) qf[ks] = *(const bf16x8*)(p.QR() + ((size_t)t * 4 + hd) * 128 + ks * 32 + g4 * 8);
    const uint4 selw = *(const uint4*)(p.SEL() + (size_t)t * 4);
    const float cs = 0.08838834764831845f * 1.4426950408889634f;
    unsigned part[8][2];
#pragma unroll
    for (int mt = 0; mt < 8; ++mt) { part[mt][0] = 0u; part[mt][1] = 0u; }
    const float g0 = p.GATES()[(size_t)t * 12 + hd * 3];
    int gstep = 0;
    const int krow = tid >> 4, kc16 = tid & 15, vrow = tid >> 3, vc16 = tid & 7;
#pragma unroll 1
    for (int br = 0; br < 2; ++br) {
        const bf16_t* Kg = br ? p.KW() : p.KS(); const bf16_t* Vg = br ? p.VWT() : p.VST();
        const int ktlast = (tq0 + 15) >> 6;
        const int ktfirst = br ? ((tq0 - 511 > 0 ? tq0 - 511 : 0) >> 6) : 0;
        const int nk = ktlast - ktfirst + 1;
        f32x4 o[8];
#pragma unroll
        for (int mt = 0; mt < 8; ++mt) o[mt] = (f32x4){0.f, 0.f, 0.f, 0.f};
        float m = -1e30f, lsum = 0.f;
        uint4 rk0, rk1, rk2, rk3, rv0, rv1, rv2, rv3;
#define NSA_LOAD(KT) do { const bf16_t* kb = Kg + (size_t)((KT) * 64 + krow) * 128 + kc16 * 8; const bf16_t* vb = Vg + (size_t)vrow * T + (KT) * 64 + vc16 * 8; \
        rk0 = *(const uint4*)kb; rk1 = *(const uint4*)(kb + 16 * 128); rk2 = *(const uint4*)(kb + 32 * 128); rk3 = *(const uint4*)(kb + 48 * 128); \
        rv0 = *(const uint4*)vb; rv1 = *(const uint4*)(vb + (size_t)32 * T); rv2 = *(const uint4*)(vb + (size_t)64 * T); rv3 = *(const uint4*)(vb + (size_t)96 * T); } while (0)
        NSA_LOAD(ktfirst);
#pragma unroll 1
        for (int i = 0; i < nk; ++i, ++gstep) {
            const int kt = ktfirst + i;
            char* Kt = smem + (gstep & 1) * BUFB; char* Vt = Kt + 64 * RSK;
            *(uint4*)(Kt + krow * RSK + kc16 * 16) = rk0; *(uint4*)(Kt + (krow + 16) * RSK + kc16 * 16) = rk1;
            *(uint4*)(Kt + (krow + 32) * RSK + kc16 * 16) = rk2; *(uint4*)(Kt + (krow + 48) * RSK + kc16 * 16) = rk3;
            *(uint4*)(Vt + vrow * RSV + vc16 * 16) = rv0; *(uint4*)(Vt + (vrow + 32) * RSV + vc16 * 16) = rv1;
            *(uint4*)(Vt + (vrow + 64) * RSV + vc16 * 16) = rv2; *(uint4*)(Vt + (vrow + 96) * RSV + vc16 * 16) = rv3;
            __syncthreads();
            if (i + 1 < nk) NSA_LOAD(kt + 1);
            int lo, hi = t;
            if (br == 0) {
                const unsigned wv = (kt & 64) ? ((kt & 32) ? selw.w : selw.z) : ((kt & 32) ? selw.y : selw.x);
                lo = 0; hi = ((wv >> (kt & 31)) & 1u) ? t : -1;
            } else lo = t - 511;
            const bool interior = (kt * 64 + 63 <= tq0) && (br == 0 || kt * 64 >= tq0 + 15 - 511);
            f32x4 sv[4];
            float mx = -3e38f;
            if (interior) {
                const float csl = hi >= 0 ? cs : 0.f, add = hi >= 0 ? 0.f : -3e38f;
#pragma unroll
                for (int sub = 0; sub < 4; ++sub) {
                    f32x4 a4 = (f32x4){0.f, 0.f, 0.f, 0.f};
#pragma unroll
                    for (int ks = 0; ks < 4; ++ks) a4 = mfma16(*(const bf16x8*)(Kt + (sub * 16 + qc) * RSK + (ks * 32 + g4 * 8) * 2), qf[ks], a4);
#pragma unroll
                    for (int r = 0; r < 4; ++r) { a4[r] = a4[r] * csl + add; mx = fmaxf(mx, a4[r]); }
                    sv[sub] = a4;
                }
            } else {
#pragma unroll
                for (int sub = 0; sub < 4; ++sub) {
                    f32x4 a4 = (f32x4){0.f, 0.f, 0.f, 0.f};
#pragma unroll
                    for (int ks = 0; ks < 4; ++ks) a4 = mfma16(*(const bf16x8*)(Kt + (sub * 16 + qc) * RSK + (ks * 32 + g4 * 8) * 2), qf[ks], a4);
#pragma unroll
                    for (int r = 0; r < 4; ++r) {
                        const int kp = kt * 64 + sub * 16 + 4 * g4 + r;
                        const bool valid = (kp >= lo) & (kp <= hi);
                        a4[r] = valid ? a4[r] * cs : -3e38f;
                        mx = fmaxf(mx, a4[r]);
                    }
                    sv[sub] = a4;
                }
            }
            mx = fmaxf(mx, __shfl_xor(mx, 16)); mx = fmaxf(mx, __shfl_xor(mx, 32));
            const float mnew = fmaxf(fmaxf(m, mx), -1e30f);
            const float alpha = __builtin_amdgcn_exp2f(m - mnew);
            m = mnew;
            float ps = 0.f;
#pragma unroll
            for (int sub = 0; sub < 4; ++sub)
#pragma unroll
                for (int r = 0; r < 4; ++r) { const float pv = __builtin_amdgcn_exp2f(sv[sub][r] - mnew); sv[sub][r] = pv; ps += pv; }
            lsum = lsum * alpha + ps;
            if (__any(alpha != 1.0f)) {
#pragma unroll
                for (int mt = 0; mt < 8; ++mt) o[mt] *= alpha;
            }
#pragma unroll
            for (int pr = 0; pr < 2; ++pr) {
                union { bf16x8 v; unsigned u32[4]; } bb;
                bb.u32[0] = pk2(sv[2 * pr][0], sv[2 * pr][1]); bb.u32[1] = pk2(sv[2 * pr][2], sv[2 * pr][3]);
                bb.u32[2] = pk2(sv[2 * pr + 1][0], sv[2 * pr + 1][1]); bb.u32[3] = pk2(sv[2 * pr + 1][2], sv[2 * pr + 1][3]);
#pragma unroll
                for (int mt = 0; mt < 8; ++mt) {
                    const char* vp = Vt + (mt * 16 + qc) * RSV + (pr * 32 + 4 * g4) * 2;
                    union { bf16x8 v; uint2 h2[2]; } aa;
                    aa.h2[0] = *(const uint2*)vp; aa.h2[1] = *(const uint2*)(vp + 32);
                    o[mt] = mfma16(aa.v, bb.v, o[mt]);
                }
            }
        }
#undef NSA_LOAD
        lsum += __shfl_xor(lsum, 16); lsum += __shfl_xor(lsum, 32);
        const float gate = p.GATES()[(size_t)t * 12 + hd * 3 + 1 + br];
        const float sc = lsum > 0.f ? gate / lsum : 0.f;
        if (br == 0) {
#pragma unroll
            for (int mt = 0; mt < 8; ++mt) {
                const uint2 oc = *(const uint2*)(p.OCMP() + ((size_t)t * 4 + hd) * 128 + mt * 16 + 4 * g4);
                part[mt][0] = pk2(sc * o[mt][0] + g0 * lo2f(oc.x), sc * o[mt][1] + g0 * hi2f(oc.x));
                part[mt][1] = pk2(sc * o[mt][2] + g0 * lo2f(oc.y), sc * o[mt][3] + g0 * hi2f(oc.y));
            }
        } else {
#pragma unroll
            for (int mt = 0; mt < 8; ++mt) {
                uint2 ov;
                ov.x = pk2(sc * o[mt][0] + lo2f(part[mt][0]), sc * o[mt][1] + hi2f(part[mt][0]));
                ov.y = pk2(sc * o[mt][2] + lo2f(part[mt][1]), sc * o[mt][3] + hi2f(part[mt][1]));
                *(uint2*)(p.Y() + (size_t)t * D + 1024 + hd * 128 + mt * 16 + 4 * g4) = ov;
            }
        }
    }
    __syncthreads();
}

DEV unsigned f2key(float f) { const unsigned u = __float_as_uint(f); return (u & 0x80000000u) ? ~u : (u | 0x80000000u); }
DEV float key2f(unsigned k) { const unsigned u = (k & 0x80000000u) ? (k & 0x7fffffffu) : ~k; return __uint_as_float(u); }
template <int NPASS>
DEV float wave_prune_t(float* sc, unsigned short* ix, unsigned* hist, int m, int l, int& kept) {
    float v[8]; unsigned k[8]; unsigned short id[8]; bool ok[8];
#pragma unroll
    for (int i = 0; i < 8; ++i) {
        const int e = l + 64 * i; ok[i] = e < m;
        v[i] = ok[i] ? sc[e] : 0.f; id[i] = ok[i] ? ix[e] : (unsigned short)0; k[i] = f2key(v[i]);
    }
    unsigned prefix = 0u; int need = 256;
#pragma unroll 1
    for (int pass = 0; pass < NPASS; ++pass) {
        const int shift = 24 - 8 * pass;
        *(uint4*)(hist + 4 * l) = make_uint4(0u, 0u, 0u, 0u);
        __builtin_amdgcn_wave_barrier();
#pragma unroll
        for (int i = 0; i < 8; ++i) {
            const bool in = ok[i] && (pass == 0 || (k[i] >> (shift + 8)) == prefix);
            if (in) atomicAdd(&hist[(k[i] >> shift) & 255u], 1u);
        }
        __builtin_amdgcn_wave_barrier();
        const uint4 hv = *(const uint4*)(hist + 4 * l);
        const unsigned hq[4] = {hv.x, hv.y, hv.z, hv.w};
        const unsigned own = hv.x + hv.y + hv.z + hv.w;
        unsigned tot = own;
#pragma unroll
        for (int o = 1; o < 64; o <<= 1) { const unsigned tv = __shfl_down(tot, o); if (l + o < 64) tot += tv; }
        unsigned cum = tot - own; int found = -1; int nneed = 0;
#pragma unroll
        for (int kk = 3; kk >= 0; --kk) {
            const unsigned c = hq[kk];
            if (found < 0 && (int)cum < need && (int)(cum + c) >= need) { found = 4 * l + kk; nneed = need - (int)cum; }
            cum += c;
        }
        const unsigned long long bal = __ballot(found >= 0);
        const int src = __ffsll((long long)bal) - 1;
        const int digit = __shfl(found, src); need = __shfl(nneed, src);
        prefix = (prefix << 8) | (unsigned)digit;
    }
    int base = 0;
    const unsigned long long ltmask = (1ull << l) - 1ull;
    if (NPASS == 4) {
        const unsigned thr = prefix;
        int ties = 0;
#pragma unroll
        for (int i = 0; i < 8; ++i) {
            const bool gt = ok[i] && k[i] > thr, eq = ok[i] && k[i] == thr;
            const unsigned long long em = __ballot(eq);
            const int trank = ties + __popcll(em & ltmask);
            const bool keep = gt || (eq && trank < need);
            ties += __popcll(em);
            const unsigned long long km = __ballot(keep);
            const int pos = base + __popcll(km & ltmask);
            if (keep) { sc[pos] = v[i]; ix[pos] = id[i]; }
            base += __popcll(km);
        }
        __builtin_amdgcn_wave_barrier();
        kept = base;
        return key2f(thr);
    } else {
        const unsigned lo = prefix << 16;
#pragma unroll
        for (int i = 0; i < 8; ++i) {
            const bool keep = ok[i] && k[i] >= lo;
            const unsigned long long km = __ballot(keep);
            const int pos = base + __popcll(km & ltmask);
            if (keep) { sc[pos] = v[i]; ix[pos] = id[i]; }
            base += __popcll(km);
        }
        __builtin_amdgcn_wave_barrier();
        kept = base;
        return key2f(lo - 1u);
    }
}
DEV float wave_prune(float* sc, unsigned short* ix, unsigned* hist, int m, int l) { int kept; return wave_prune_t<4>(sc, ix, hist, m, l, kept); }
DEV float wave_prune_mid(float* sc, unsigned short* ix, unsigned* hist, int& cnt, int l) {
    int kept; float tau = wave_prune_t<2>(sc, ix, hist, cnt, l, kept);
    if (kept > 352) { tau = wave_prune_t<4>(sc, ix, hist, kept, l, kept); }
    cnt = kept;
    return tau;
}

#define DSA_APPEND2(COND, M64, SV, SCP, IXP, CL, CH) do { \
    const unsigned _ml = (unsigned)(M64), _mh = (unsigned)((M64) >> 32); \
    if (COND) { const int _pos = (h ? (CH) : (CL)) + __popc((h ? _mh : _ml) & ((1u << n) - 1u)); (SCP)[_pos] = (SV); (IXP)[_pos] = (unsigned short)kp; } \
    (CL) += __popc(_ml); (CH) += __popc(_mh); } while (0)
#define DSA_APPEND(SCP, IXP, CNT, M32, MINE, SV) do { \
    const unsigned _m = (M32); \
    if (MINE) { const int _pos = (CNT) + __popc(_m & ((1u << n) - 1u)); (SCP)[_pos] = (SV); (IXP)[_pos] = (unsigned short)kp; } \
    (CNT) += __popc(_m); } while (0)

DEV void st_dsa_index(const P& p, int unit, char* smem) {
    const int tid = tidx(), w = tid >> 6, l = tid & 63, n = l & 31, h = l >> 5;
    char* wb = smem + w * 14336;
    float* sc0 = (float*)wb; float* sc1 = sc0 + 512; float* sc2 = sc1 + 512; float* sc3 = sc2 + 512;
    unsigned short* ix0 = (unsigned short*)(wb + 8192); unsigned short* ix1 = ix0 + 512; unsigned short* ix2 = ix1 + 512; unsigned short* ix3 = ix2 + 512;
    unsigned* hist = (unsigned*)(wb + 12288);
    float* scA = h ? sc2 : sc0; float* scB = h ? sc3 : sc1; unsigned short* ixA = h ? ix2 : ix0; unsigned short* ixB = h ? ix3 : ix1;
    const int wu = unit * 4 + w;
    const int tg = 2047 - wu;
    const int t0 = tg * 4;
    const int tl = 2 * ((n >> 2) & 1) + (n >> 4), hdr = (n & 3) + 4 * ((n >> 3) & 1);
    bf16x8 af[4];
#pragma unroll
    for (int s = 0; s < 4; ++s) af[s] = *(const bf16x8*)(p.IQ() + ((size_t)(t0 + tl) * 8 + hdr) * 64 + 16 * s + 8 * h);
    const int tA = t0 + 2 * h, tB = tA + 1;
    float wA[8], wB[8];
#pragma unroll
    for (int r = 0; r < 8; ++r) { wA[r] = p.IW()[(size_t)tA * 8 + r]; wB[r] = p.IW()[(size_t)tB * 8 + r]; }
    int cnt0 = 0, cnt1 = 0, cnt2 = 0, cnt3 = 0;
    const float NINF = -__builtin_inff();
    float tau0 = NINF, tau1 = NINF, tau2 = NINF, tau3 = NINF;
    const int ntiles = (t0 + 3) / 32 + 1;
    const bf16_t* ikp = p.IK() + (size_t)n * 64 + 8 * h;
    bf16x8 na[4], nb[4];
#pragma unroll
    for (int s = 0; s < 4; ++s) { na[s] = *(const bf16x8*)(ikp + 16 * s); nb[s] = *(const bf16x8*)(ikp + (size_t)(ntiles > 1 ? 32 : 0) * 64 + 16 * s); }
#pragma unroll 1
    for (int kt = 0; kt < ntiles; kt += 2) {
        bf16x8 ca[4], cb[4];
#pragma unroll
        for (int s = 0; s < 4; ++s) { ca[s] = na[s]; cb[s] = nb[s]; }
        {
            const int ka = kt + 2 < ntiles ? kt + 2 : ntiles - 1, kb = kt + 3 < ntiles ? kt + 3 : ntiles - 1;
#pragma unroll
            for (int s = 0; s < 4; ++s) { na[s] = *(const bf16x8*)(ikp + (size_t)ka * 32 * 64 + 16 * s); nb[s] = *(const bf16x8*)(ikp + (size_t)kb * 32 * 64 + 16 * s); }
        }
        f32x16 acca, accb;
#pragma unroll
        for (int r = 0; r < 16; ++r) { acca[r] = 0.f; accb[r] = 0.f; }
#pragma unroll
        for (int s = 0; s < 4; ++s) { acca = mfma32(af[s], ca[s], acca); accb = mfma32(af[s], cb[s], accb); }
        float s0a = 0.f, s1a = 0.f, s0b = 0.f, s1b = 0.f, u0a = 0.f, u1a = 0.f, u0b = 0.f, u1b = 0.f;
#pragma unroll
        for (int r = 0; r < 4; ++r) {
            s0a += wA[r] * fmaxf(acca[r], 0.f); u0a += wA[4 + r] * fmaxf(acca[4 + r], 0.f);
            s1a += wB[r] * fmaxf(acca[8 + r], 0.f); u1a += wB[4 + r] * fmaxf(acca[12 + r], 0.f);
            s0b += wA[r] * fmaxf(accb[r], 0.f); u0b += wA[4 + r] * fmaxf(accb[4 + r], 0.f);
            s1b += wB[r] * fmaxf(accb[8 + r], 0.f); u1b += wB[4 + r] * fmaxf(accb[12 + r], 0.f);
        }
        s0a += u0a; s1a += u1a; s0b += u0b; s1b += u1b;
        const float tauA = h ? tau2 : tau0, tauB = h ? tau3 : tau1;
        {
            const int kp = kt * 32 + n;
            const bool cA = (kp <= tA) && (s0a > tauA), cB = (kp <= tB) && (s1a > tauB);
            const unsigned long long mA = __ballot(cA), mB = __ballot(cB);
            DSA_APPEND2(cA, mA, s0a, scA, ixA, cnt0, cnt2); DSA_APPEND2(cB, mB, s1a, scB, ixB, cnt1, cnt3);
        }
        {
            const int kp = kt * 32 + 32 + n;
            const bool cA = (kp <= tA) && (s0b > tauA), cB = (kp <= tB) && (s1b > tauB);
            const unsigned long long mA = __ballot(cA), mB = __ballot(cB);
            DSA_APPEND2(cA, mA, s0b, scA, ixA, cnt0, cnt2); DSA_APPEND2(cB, mB, s1b, scB, ixB, cnt1, cnt3);
        }
        __builtin_amdgcn_wave_barrier();
        if (max(max(cnt0, cnt1), max(cnt2, cnt3)) > 448) {
            if (cnt0 > 448) tau0 = wave_prune_mid(sc0, ix0, hist, cnt0, l);
            if (cnt1 > 448) tau1 = wave_prune_mid(sc1, ix1, hist, cnt1, l);
            if (cnt2 > 448) tau2 = wave_prune_mid(sc2, ix2, hist, cnt2, l);
            if (cnt3 > 448) tau3 = wave_prune_mid(sc3, ix3, hist, cnt3, l);
        }
    }
    if (cnt0 > 256) { wave_prune(sc0, ix0, hist, cnt0, l); cnt0 = 256; }
    if (cnt1 > 256) { wave_prune(sc1, ix1, hist, cnt1, l); cnt1 = 256; }
    if (cnt2 > 256) { wave_prune(sc2, ix2, hist, cnt2, l); cnt2 = 256; }
    if (cnt3 > 256) { wave_prune(sc3, ix3, hist, cnt3, l); cnt3 = 256; }
    __builtin_amdgcn_wave_barrier();
#pragma unroll
    for (int i = 0; i < 4; ++i) {
        const int e = l + 64 * i;
        p.IDX()[(size_t)(t0 + 0) * 256 + e] = e < cnt0 ? (int)ix0[e] : 0;
        p.IDX()[(size_t)(t0 + 1) * 256 + e] = e < cnt1 ? (int)ix1[e] : 0;
        p.IDX()[(size_t)(t0 + 2) * 256 + e] = e < cnt2 ? (int)ix2[e] : 0;
        p.IDX()[(size_t)(t0 + 3) * 256 + e] = e < cnt3 ? (int)ix3[e] : 0;
    }
    if (l == 0) { p.CNT()[t0] = cnt0; p.CNT()[t0 + 1] = cnt1; p.CNT()[t0 + 2] = cnt2; p.CNT()[t0 + 3] = cnt3; }
}

DEV void st_dsa_attn(const P& p, int unit, char* smem) {
    const int tid = tidx(), w = tid >> 6, l = tid & 63, c = l & 15, g4 = l >> 4;
    int* idxs = (int*)(smem + w * 5120); float* Pl = (float*)(smem + w * 5120 + 1024);
    const size_t t = (size_t)unit * 4 + w;
    const int cnt = p.CNT()[t];
#pragma unroll
    for (int i = 0; i < 4; ++i) idxs[l + 64 * i] = p.IDX()[t * 256 + l + 64 * i];
    __builtin_amdgcn_wave_barrier();
    bf16x8 qf[4];
#pragma unroll
    for (int j = 0; j < 4; ++j) qf[j] = *(const bf16x8*)(p.DQ() + (t * 4 + (c & 3)) * 128 + g4 * 32 + j * 8);
    f32x4 s[16];
    const int ntile = (cnt + 15) >> 4;
#pragma unroll
    for (int th = 0; th < 2; ++th) {
        bf16x8 kf[8][4];
        if (th * 8 < ntile) {
#pragma unroll
            for (int q = 0; q < 8; ++q) {
                const int krow = idxs[(th * 8 + q) * 16 + c];
                const bf16_t* kp = p.DK() + (size_t)krow * 128 + g4 * 32;
#pragma unroll
                for (int j = 0; j < 4; ++j) kf[q][j] = *(const bf16x8*)(kp + j * 8);
            }
        }
#pragma unroll
        for (int q = 0; q < 8; ++q) {
            s[th * 8 + q] = (f32x4){0.f, 0.f, 0.f, 0.f};
            if (th * 8 < ntile) {
#pragma unroll
                for (int j = 0; j < 4; ++j) s[th * 8 + q] = mfma16(kf[q][j], qf[j], s[th * 8 + q]);
            }
        }
        __builtin_amdgcn_sched_barrier(0);
    }
    const float cs = 0.08838834764831845f * 1.4426950408889634f;
    float mx = -1e30f;
#pragma unroll
    for (int tt = 0; tt < 16; ++tt)
#pragma unroll
        for (int r = 0; r < 4; ++r) { const int slot = tt * 16 + 4 * g4 + r; if (slot < cnt) mx = fmaxf(mx, s[tt][r] * cs); }
    mx = fmaxf(mx, __shfl_xor(mx, 16)); mx = fmaxf(mx, __shfl_xor(mx, 32));
    float sum = 0.f;
#pragma unroll
    for (int tt = 0; tt < 16; ++tt)
#pragma unroll
        for (int r = 0; r < 4; ++r) { const int slot = tt * 16 + 4 * g4 + r; const float pv = slot < cnt ? exp2f(s[tt][r] * cs - mx) : 0.f; s[tt][r] = pv; sum += pv; }
    sum += __shfl_xor(sum, 16); sum += __shfl_xor(sum, 32);
    const float inv = sum > 0.f ? 1.0f / sum : 0.f;
    if (c < 4) {
#pragma unroll
        for (int tt = 0; tt < 16; ++tt)
#pragma unroll
            for (int r = 0; r < 4; ++r) Pl[(tt * 16 + 4 * g4 + r) * 4 + c] = s[tt][r] * inv;
    }
    __builtin_amdgcn_wave_barrier();
    float acc[4][8];
#pragma unroll
    for (int hh = 0; hh < 4; ++hh)
#pragma unroll
        for (int j = 0; j < 8; ++j) acc[hh][j] = 0.f;
    const int nk64 = (cnt + 63) >> 6;
#pragma unroll 1
    for (int kb = 0; kb < nk64; ++kb) {
        uint4 raw[16];
#pragma unroll
        for (int q = 0; q < 16; ++q) raw[q] = *(const uint4*)(p.DVC() + (size_t)idxs[(kb * 16 + q) * 4 + g4] * 128 + c * 8);
#pragma unroll
        for (int q = 0; q < 16; ++q) {
            const float4 p4 = *(const float4*)(Pl + ((kb * 16 + q) * 4 + g4) * 4);
            const float vv[8] = {lo2f(raw[q].x), hi2f(raw[q].x), lo2f(raw[q].y), hi2f(raw[q].y), lo2f(raw[q].z), hi2f(raw[q].z), lo2f(raw[q].w), hi2f(raw[q].w)};
            const float pp[4] = {p4.x, p4.y, p4.z, p4.w};
#pragma unroll
            for (int hh = 0; hh < 4; ++hh)
#pragma unroll
                for (int j = 0; j < 8; ++j) acc[hh][j] += pp[hh] * vv[j];
        }
    }
#pragma unroll
    for (int hh = 0; hh < 4; ++hh)
#pragma unroll
        for (int j = 0; j < 8; ++j) { float a = acc[hh][j]; a += __shfl_xor(a, 16); a += __shfl_xor(a, 32); acc[hh][j] = a; }
    if (g4 == 0) {
#pragma unroll
        for (int hh = 0; hh < 4; ++hh) {
            uint4 o; o.x = pk2(acc[hh][0], acc[hh][1]); o.y = pk2(acc[hh][2], acc[hh][3]); o.z = pk2(acc[hh][4], acc[hh][5]); o.w = pk2(acc[hh][6], acc[hh][7]);
            *(uint4*)(p.Y() + t * D + 1536 + hh * 128 + c * 8) = o;
        }
    }
    __builtin_amdgcn_wave_barrier();
}

DEV void ins16(unsigned (&top)[16], unsigned x) {
#pragma unroll
    for (int j = 0; j < 16; ++j) { const unsigned hi = max(top[j], x); x = min(top[j], x); top[j] = hi; }
}
DEV void st_peer_topk(const P& p, int layer, int unit, char* smem) {
    const int tid = tidx(), w = tid >> 6, l = tid & 63, n = l & 31, hf = l >> 5;
    const int head = unit & 7, tg = (unit >> 3) * 4 + w;
    const size_t t = (size_t)tg * 32 + n;
    unsigned* il = (unsigned*)smem + w * 1024;
    unsigned top[2][16];
#pragma unroll
    for (int pp = 0; pp < 2; ++pp) {
        float qv[32];
#pragma unroll
        for (int i = 0; i < 8; ++i) { const float4 v = *(const float4*)(p.PQ() + t * 1024 + head * 128 + pp * 64 + hf * 32 + i * 4); qv[4 * i] = v.x; qv[4 * i + 1] = v.y; qv[4 * i + 2] = v.z; qv[4 * i + 3] = v.w; }
        const float* K = p.peer_sk + ((((size_t)layer * 8 + head) * 2 + pp) * 128) * 64;
#pragma unroll
        for (int j = 0; j < 16; ++j) top[pp][j] = 0u;
        float kn[32];
        {
            const float* kr = K + (size_t)n * 64 + hf * 32;
#pragma unroll
            for (int i = 0; i < 8; ++i) { const float4 v = *(const float4*)(kr + i * 4); kn[4 * i] = v.x; kn[4 * i + 1] = v.y; kn[4 * i + 2] = v.z; kn[4 * i + 3] = v.w; }
        }
#pragma unroll 1
        for (int tile = 0; tile < 4; ++tile) {
            float kv[32];
#pragma unroll
            for (int i = 0; i < 32; ++i) kv[i] = kn[i];
            if (tile < 3) {
                const float* kr = K + (size_t)((tile + 1) * 32 + n) * 64 + hf * 32;
#pragma unroll
                for (int i = 0; i < 8; ++i) { const float4 v = *(const float4*)(kr + i * 4); kn[4 * i] = v.x; kn[4 * i + 1] = v.y; kn[4 * i + 2] = v.z; kn[4 * i + 3] = v.w; }
            }
            f32x16 acc;
#pragma unroll
            for (int r = 0; r < 16; ++r) acc[r] = 0.f;
#pragma unroll
            for (int kk = 0; kk < 32; ++kk) acc = __builtin_amdgcn_mfma_f32_32x32x2f32(kv[kk], qv[kk], acc, 0, 0, 0);
#pragma unroll
            for (int r = 0; r < 16; ++r) {
                const int nn = tile * 32 + (r & 3) + 8 * (r >> 2) + 4 * hf;
                ins16(top[pp], (f2key(acc[r]) & ~127u) | (unsigned)(127 - nn));
            }
        }
        unsigned oth[16];
#pragma unroll
        for (int j = 0; j < 16; ++j) oth[j] = __shfl_xor(top[pp][j], 32);
#pragma unroll
        for (int j = 0; j < 16; ++j) ins16(top[pp], oth[j]);
        if (hf == 0) {
#pragma unroll
            for (int j = 0; j < 16; ++j) il[(pp * 16 + j) * 32 + n] = 127u - (top[pp][j] & 127u);
        }
    }
    __builtin_amdgcn_wave_barrier();
    if (hf == 0) {
        float v1[16], v2[16];
#pragma unroll
        for (int j = 0; j < 16; ++j) { v1[j] = key2f(top[0][j] & ~127u); v2[j] = key2f(top[1][j] & ~127u); }
        unsigned ct[16];
#pragma unroll
        for (int s = 0; s < 16; ++s) ct[s] = 0u;
#pragma unroll
        for (int i = 0; i < 16; ++i)
#pragma unroll
            for (int j = 0; j < 16; ++j)
                if ((i + 1) * (j + 1) <= 16) ins16(ct, (f2key(v1[i] + v2[j]) & ~255u) | (unsigned)(255 - (i * 16 + j)));
        float ex[16], sum = 0.f; int ce[16];
        const float c0 = key2f(ct[0] & ~255u);
#pragma unroll
        for (int s = 0; s < 16; ++s) {
            const unsigned code = 255u - (ct[s] & 255u);
            ce[s] = (int)(il[(code >> 4) * 32 + n] * 128u + il[(16 + (code & 15u)) * 32 + n]);
            ex[s] = __expf(key2f(ct[s] & ~255u) - c0); sum += ex[s];
        }
        const float inv = 1.0f / sum;
#pragma unroll
        for (int s4 = 0; s4 < 4; ++s4) {
            *(int4*)(p.PE() + t * 128 + head * 16 + s4 * 4) = make_int4(ce[4 * s4], ce[4 * s4 + 1], ce[4 * s4 + 2], ce[4 * s4 + 3]);
            *(float4*)(p.PG() + t * 128 + head * 16 + s4 * 4) = make_float4(ex[4 * s4] * inv, ex[4 * s4 + 1] * inv, ex[4 * s4 + 2] * inv, ex[4 * s4 + 3] * inv);
        }
    }
    __builtin_amdgcn_wave_barrier();
}

DEV void st_peer_gather(const P& p, int layer, const float* __restrict__ xin, float* __restrict__ xout, int unit, char* smem) {
    const int tid_ = tidx(); const int w = tid_ >> 6, l = tid_ & 63; const size_t t = (size_t)unit * 4 + w;
    float* row = (float*)smem + w * 2112;
    const int* pip = p.PI();
    const float ic6 = __int_as_float(__builtin_amdgcn_readfirstlane(pip[32]));
    {
#pragma unroll
        for (int i = 0; i < 4; ++i) {
            const uint4 hv = *(const uint4*)(p.HN() + t * D + i * 512 + l * 8);
            const unsigned u4[4] = {hv.x, hv.y, hv.z, hv.w};
            const int c = i * 512 + l * 8;
#pragma unroll
            for (int q = 0; q < 4; ++q) { row[((c + 2 * q) >> 5) * 33 + ((c + 2 * q) & 31)] = lo2f(u4[q]); row[((c + 2 * q + 1) >> 5) * 33 + ((c + 2 * q + 1) & 31)] = hi2f(u4[q]); }
        }
        __builtin_amdgcn_wave_barrier();
    }
    unsigned hp[16];
#pragma unroll
    for (int j = 0; j < 16; ++j)
        hp[j] = (__float_as_uint(row[l * 33 + __builtin_amdgcn_readfirstlane(pip[2 * j])]) >> 16) |
                (__float_as_uint(row[l * 33 + __builtin_amdgcn_readfirstlane(pip[2 * j + 1])]) & 0xffff0000u);
    __builtin_amdgcn_wave_barrier();
    const int e0 = p.PE()[t * 128 + l], e1 = p.PE()[t * 128 + 64 + l];
    const float g0 = p.PG()[t * 128 + l], g1 = p.PG()[t * 128 + 64 + l];
    float out[32];
#pragma unroll
    for (int i = 0; i < 32; ++i) out[i] = 0.f;
    const unsigned char* U = p.Utab() + (size_t)layer * 16384 * ROW6; const unsigned char* V = p.Vtab() + (size_t)layer * 16384 * ROW6;
    const unsigned voff = (unsigned)l * 8u;
    const bool b5 = (l & 32) != 0, b4 = (l & 16) != 0;
#pragma unroll 1
    for (int k4 = 0; k4 < 32; ++k4) {
        int e[4]; float g[4];
#pragma unroll
        for (int q = 0; q < 4; ++q) {
            const int k = k4 * 4 + q;
            e[q] = __builtin_amdgcn_readlane(k4 < 16 ? e0 : e1, k & 63);
            g[q] = __int_as_float(__builtin_amdgcn_readlane(__float_as_int(k4 < 16 ? g0 : g1), k & 63));
        }
#if PEER_FP4
        uint4 uu[4], vv[4];
#pragma unroll
        for (int q = 0; q < 4; ++q) { uu[q] = *(const uint4*)(U + (size_t)e[q] * ROW6 + 2 * voff); vv[q] = *(const uint4*)(V + (size_t)e[q] * ROW6 + 2 * voff); }
#define GATHER_UNPACK(F, SRC) do { fp4_unpack8((SRC).x, &(F)[0]); fp4_unpack8((SRC).y, &(F)[8]); fp4_unpack8((SRC).z, &(F)[16]); fp4_unpack8((SRC).w, &(F)[24]); } while (0)
#define GATHER_FIRST(SRC) (SRC).x
#else
        uint2 uu[4][3], vv[4][3];
#pragma unroll
        for (int q = 0; q < 4; ++q)
#pragma unroll
            for (int i = 0; i < 3; ++i) { uu[q][i] = *(const uint2*)(U + (size_t)e[q] * ROW6 + (voff + i * 512)); vv[q][i] = *(const uint2*)(V + (size_t)e[q] * ROW6 + (voff + i * 512)); }
#endif
        float d[4];
#pragma unroll
        for (int q = 0; q < 4; ++q) {
#if PEER_FP4
            if (q > 0) asm volatile("" : "+v"(uu[q].x), "+v"(d[q - 1]));
            float f[32]; GATHER_UNPACK(f, uu[q]);
#else
            v6u pk; pk[0] = uu[q][0].x; pk[1] = uu[q][0].y; pk[2] = uu[q][1].x; pk[3] = uu[q][1].y; pk[4] = uu[q][2].x; pk[5] = uu[q][2].y;
            if (q > 0) { unsigned t0_ = pk[0]; asm volatile("" : "+v"(t0_), "+v"(d[q - 1])); pk[0] = t0_; }
            const v32f f = FP6_UNPACK(pk);
#endif
            float acc = 0.f;
#pragma unroll
            for (int j = 0; j < 16; ++j) acc += f[2 * j] * lo2f(hp[j]) + f[2 * j + 1] * hi2f(hp[j]);
            d[q] = acc;
            __builtin_amdgcn_sched_barrier(0);
        }
        float kA = b5 ? d[2] : d[0], kB = b5 ? d[3] : d[1];
        const float sA = b5 ? d[0] : d[2], sB = b5 ? d[1] : d[3];
        kA += __shfl_xor(sA, 32); kB += __shfl_xor(sB, 32);
        float kk = b4 ? kB : kA; const float ss = b4 ? kA : kB;
        kk += __shfl_xor(ss, 16);
        kk += __shfl_xor(kk, 8); kk += __shfl_xor(kk, 4); kk += __shfl_xor(kk, 2); kk += __shfl_xor(kk, 1);
        const float gsel = b5 ? (b4 ? g[3] : g[2]) : (b4 ? g[1] : g[0]);
        const float av = gelu_tanh(kk * (ic6 / U6_SCALE)) * gsel * (ic6 / V6_SCALE);
        const int avi = __float_as_int(av);
        const float a4[4] = {__int_as_float(__builtin_amdgcn_readlane(avi, 0)), __int_as_float(__builtin_amdgcn_readlane(avi, 16)),
                             __int_as_float(__builtin_amdgcn_readlane(avi, 32)), __int_as_float(__builtin_amdgcn_readlane(avi, 48))};
#pragma unroll
        for (int q = 0; q < 4; ++q) {
#if PEER_FP4
            asm volatile("" : "+v"(vv[q].x), "+v"(out[31]));
            float f[32]; GATHER_UNPACK(f, vv[q]);
#else
            v6u pk; pk[0] = vv[q][0].x; pk[1] = vv[q][0].y; pk[2] = vv[q][1].x; pk[3] = vv[q][1].y; pk[4] = vv[q][2].x; pk[5] = vv[q][2].y;
            { unsigned t0_ = pk[0]; asm volatile("" : "+v"(t0_), "+v"(out[31])); pk[0] = t0_; }
            const v32f f = FP6_UNPACK(pk);
#endif
#pragma unroll
            for (int j = 0; j < 32; ++j) out[j] += a4[q] * f[j];
            __builtin_amdgcn_sched_barrier(0);
        }
    }
    asm volatile("" : "+s"(pip));
#pragma unroll
    for (int j = 0; j < 32; ++j) row[l * 33 + __builtin_amdgcn_readfirstlane(pip[j])] = out[j];
    __builtin_amdgcn_wave_barrier();
    const float* g2 = p.ada() + layer * 12288 + 5 * 2048;
    float4 xo[8]; float ssq = 0.f;
#pragma unroll
    for (int i = 0; i < 8; ++i) {
        const int c = i * 256 + l * 4;
        const float* rp = row + (c >> 5) * 33 + (c & 31);
        const size_t off = t * D + c;
        const float4 x0 = *(const float4*)(xin + off); const float4 ga = *(const float4*)(g2 + c);
        float4 o0;
        o0.x = x0.x + ga.x * rp[0]; o0.y = x0.y + ga.y * rp[1]; o0.z = x0.z + ga.z * rp[2]; o0.w = x0.w + ga.w * rp[3];
        *(float4*)(xout + off) = o0;
        xo[i] = o0; ssq += o0.x * o0.x + o0.y * o0.y + o0.z * o0.z + o0.w * o0.w;
        if (i & 1) __builtin_amdgcn_sched_barrier(0);
    }
    if (layer + 1 < NL) {
        const float rs = rsqrtf(wsum(ssq) * (1.0f / 2048.0f) + EPS);
        const float* ng = p.n1g + (layer + 1) * 2048; const float* adn = p.ada() + (layer + 1) * 12288;
#pragma unroll
        for (int i = 0; i < 8; ++i) {
            const int c = i * 256 + l * 4;
            const float4 gg = *(const float4*)(ng + c), sc = *(const float4*)(adn + 2048 + c), sh = *(const float4*)(adn + c);
            uint2 o;
            o.x = pk2((xo[i].x * rs) * gg.x * (1.0f + sc.x) + sh.x, (xo[i].y * rs) * gg.y * (1.0f + sc.y) + sh.y);
            o.y = pk2((xo[i].z * rs) * gg.z * (1.0f + sc.z) + sh.z, (xo[i].w * rs) * gg.w * (1.0f + sc.w) + sh.w);
            *(uint2*)(p.HN() + t * D + c) = o;
            if (i & 1) __builtin_amdgcn_sched_barrier(0);
        }
    }
    __builtin_amdgcn_wave_barrier();
}

enum { S_CONVT_IN = 0, S_CONVT_OUT, S_CONVT_Q, S_CONVT_W1, S_CALIB, S_TAB_U, S_TAB_V, S_ADA, S_ROPE, S_NORM1, S_GEMM_IN, S_CONV, S_SGU, S_VTRANS, S_PREP,
       S_COMPRESS, S_NSA_CMP, S_DSA_INDEX, S_NSA_ATTN, S_DSA_ATTN, S_GEMM_OUT, S_NORM2, S_GEMM_Q, S_PEER_TOPK, S_PEER_GATHER, S_COUNT };
constexpr int TAB_UNITS = 4096;
__host__ __device__ constexpr int nunits(int s) {
    return s == S_CONVT_IN ? 2 * 32 * (LDP / 64) : s == S_CONVT_OUT ? 2 * 32 * 32 : s == S_CONVT_Q ? 2 * 32 * 16 : s == S_CONVT_W1 ? 4 * 64 * 2 : s == S_CALIB ? 1 : s == S_TAB_U ? TAB_UNITS : s == S_TAB_V ? TAB_UNITS
         : s == S_ADA ? 384 : s == S_ROPE ? 768 : s == S_NORM1 ? 2048 : s == S_GEMM_IN ? 64 * (LDP / 128) : s == S_CONV ? 512 : s == S_SGU ? 256
         : s == S_VTRANS ? 256 : s == S_PREP ? 2048 : s == S_COMPRESS ? 64 : s == S_NSA_CMP ? 512 : s == S_DSA_INDEX ? 512 : s == S_NSA_ATTN ? 512 : s == S_DSA_ATTN ? 2048
         : s == S_GEMM_OUT ? 64 * 16 : s == S_NORM2 ? 2048 : s == S_GEMM_Q ? 64 * 8 : s == S_PEER_TOPK ? 512 : s == S_PEER_GATHER ? 2048 : 0;
}
template <int S>
DEV void run_unit(const P& p, int layer, int u, char* smem, int nu = TAB_UNITS) {
    const float* xin = layer == 0 ? p.x : p.X2();
    const float* ada = p.ada() + layer * 12288;
    if constexpr (S == S_CONVT_IN) { const int per = 32 * (LDP / 64), ly = u / per; st_convT(p.w_in + (size_t)ly * 2048 * INC, p.WinT() + (size_t)ly * LDP * 2048, INC, LDP, true, u % per, smem); }
    else if constexpr (S == S_CONVT_OUT) { const int per = 32 * 32, ly = u / per; st_convT(p.w_out + (size_t)ly * 2048 * 2048, p.WoutT() + (size_t)ly * 2048 * 2048, 2048, 2048, false, u % per, smem); }
    else if constexpr (S == S_CONVT_Q) { const int per = 32 * 16, ly = u / per; st_convT(p.peer_wq + (size_t)ly * 2048 * 1024, p.WqT() + (size_t)ly * 1024 * 2048, 1024, 1024, false, u % per, smem); }
    else if constexpr (S == S_CONVT_W1) { const int per = 64 * 2, mi = u / per; st_convT(p.cmp_w1 + (size_t)mi * 4096 * 128, p.W1T() + (size_t)mi * 128 * 4096, 128, 128, false, u % per, smem, 4096); }
    else if constexpr (S == S_CALIB) st_calib(p);
#if PEER_FP4
    else if constexpr (S == S_TAB_U) st_tab4(p, p.peer_u, p.Utab(), U6_SCALE, 2 * 16384, u, nu, smem);
    else if constexpr (S == S_TAB_V) st_tab4(p, p.peer_v, p.Vtab(), V6_SCALE, 2 * 16384, u, nu, smem);
#else
    else if constexpr (S == S_TAB_U) st_tab6(p.peer_u, p.Utab(), U6_SCALE, 2 * 16384, u, nu, smem);
    else if constexpr (S == S_TAB_V) st_tab6(p.peer_v, p.Vtab(), V6_SCALE, 2 * 16384, u, nu, smem);
#endif
    else if constexpr (S == S_ADA) st_ada(p, u, smem);
    else if constexpr (S == S_ROPE) st_rope(p, u);
    else if constexpr (S == S_NORM1) st_norm(xin, p.n1g + layer * 2048, ada + 2048, ada, p.HN(), u);
    else if constexpr (S == S_GEMM_IN) { EpiArgs e{p.PROJ(), nullptr, nullptr, nullptr, p.KVC()}; st_gemm<EPI_PROJ>(p.HN(), p.WinT() + (size_t)layer * LDP * 2048, 2048, u & 63, u >> 6, e, smem); }
    else if constexpr (S == S_CONV) st_conv(p, layer, u, smem);
    else if constexpr (S == S_SGU) st_sgu(p, layer, u, smem);
    else if constexpr (S == S_VTRANS) st_vtrans(p, u, smem);
    else if constexpr (S == S_PREP) st_prep(p, layer, u);
    else if constexpr (S == S_COMPRESS) st_compress(p, layer, u, smem);
    else if constexpr (S == S_NSA_CMP) st_nsa_cmp(p, u, smem);
    else if constexpr (S == S_DSA_INDEX) st_dsa_index(p, u, smem);
    else if constexpr (S == S_NSA_ATTN) st_nsa_attn(p, u, smem);
    else if constexpr (S == S_DSA_ATTN) st_dsa_attn(p, u, smem);
    else if constexpr (S == S_GEMM_OUT) { EpiArgs e{nullptr, p.X1(), xin, ada + 2 * 2048, nullptr}; st_gemm<EPI_OUT>(p.Y(), p.WoutT() + (size_t)layer * 2048 * 2048, 2048, u & 63, u >> 6, e, smem); }
    else if constexpr (S == S_NORM2) st_norm(p.X1(), p.n2g + layer * 2048, ada + 4 * 2048, ada + 3 * 2048, p.HN(), u);
    else if constexpr (S == S_GEMM_Q) { EpiArgs e{nullptr, p.PQ(), nullptr, nullptr, nullptr}; st_gemm<EPI_Q>(p.HN(), p.WqT() + (size_t)layer * 1024 * 2048, 2048, u & 63, u >> 6, e, smem); }
    else if constexpr (S == S_PEER_TOPK) st_peer_topk(p, layer, u, smem);
    else if constexpr (S == S_PEER_GATHER) st_peer_gather(p, layer, p.X1(), layer == 0 ? p.X2() : p.out, u, smem);
}


#define XB_TMO      128
#define XB_XCNT(j)  (256  + 64 * (j))
#define XB_XSUB(j)  (1280 + 64 * (j))
#define XB_XGEN(j)  (2304 + 64 * (j))
#define XB_TOP      3328
#define XB_TOPGEN   3392
#define XB_SPIN_CAP (1u << 22)
#define LAS __attribute__((address_space(3)))
DEV unsigned xb_ld(unsigned* p) { return __hip_atomic_load(p, __ATOMIC_RELAXED, __HIP_MEMORY_SCOPE_AGENT); }
DEV unsigned xb_add(unsigned* p, unsigned v) { return __hip_atomic_fetch_add(p, v, __ATOMIC_RELAXED, __HIP_MEMORY_SCOPE_AGENT); }
DEV unsigned xb_xcc_id() { return (unsigned)__builtin_amdgcn_s_getreg((3 << 11) | 20) & 0xFu; }
#define XB_SPIN(cond, bar) do { unsigned _sp = 0; while (cond) { __builtin_amdgcn_s_sleep(1); \
    if ((++_sp & 255u) == 0u) { if (xb_ld(&(bar)[XB_TMO])) break; if (_sp > XB_SPIN_CAP) { atomicAdd(&(bar)[XB_TMO], 1u); break; } } } } while (0)
struct XcdBarrier { unsigned* bar; unsigned x; volatile LAS unsigned* st; };
DEV XcdBarrier xcd_barrier_post(unsigned* bar, volatile LAS unsigned* st) {
    XcdBarrier b; b.bar = bar; b.x = xb_xcc_id(); b.st = st;
    if (threadIdx.x == 0) (void)xb_add(&bar[XB_XCNT(b.x)], 1u);
    return b;
}
DEV void xcd_barrier_complete(unsigned* bar, unsigned x, unsigned& nloc, unsigned& nx) {
    const unsigned G = gridDim.x * gridDim.y * gridDim.z;
    unsigned sum, cnt, mine, sp = 0u;
    for (;;) {
        sum = 0u; cnt = 0u; mine = 0u;
#pragma unroll
        for (unsigned j = 0; j < 16; ++j) { const unsigned c = xb_ld(&bar[XB_XCNT(j)]); sum += c; cnt += (c > 0u) ? 1u : 0u; mine = (j == x) ? c : mine; }
        if (sum == G) break;
        __builtin_amdgcn_s_sleep(1);
        if ((++sp & 255u) == 0u) { if (xb_ld(&bar[XB_TMO])) break; if (sp > XB_SPIN_CAP) { atomicAdd(&bar[XB_TMO], 1u); break; } }
    }
    nloc = mine > 0u ? mine : 1u; nx = cnt > 0u ? cnt : 1u;
}
DEV void xcd_barrier(const XcdBarrier& b) {
    asm volatile("s_waitcnt vmcnt(0)" ::: "memory");
    __syncthreads();
    if (threadIdx.x == 0) {
        unsigned* bar = b.bar;
        __builtin_amdgcn_s_waitcnt(0);
        unsigned nloc = b.st[0], nx = b.st[1];
        if (nloc == 0u) { xcd_barrier_complete(bar, b.x, nloc, nx); b.st[0] = nloc; b.st[1] = nx; }
        const unsigned old = xb_add(&bar[XB_XSUB(b.x)], 1u);
        const unsigned gen = old / nloc;
        if (old + 1u == (gen + 1u) * nloc) {
            __builtin_amdgcn_fence(__ATOMIC_RELEASE, "agent");
            asm volatile("s_waitcnt vmcnt(0)" ::: "memory");
            const unsigned og = xb_add(&bar[XB_TOP], 1u);
            const unsigned tg = og / nx;
            if (og + 1u == (tg + 1u) * nx) xb_add(&bar[XB_TOPGEN], 1u);
            else XB_SPIN(xb_ld(&bar[XB_TOPGEN]) == tg, bar);
            __builtin_amdgcn_fence(__ATOMIC_ACQUIRE, "agent");
            xb_add(&bar[XB_XGEN(b.x)], 1u);
            asm volatile("s_waitcnt vmcnt(0)" ::: "memory");
        } else {
            XB_SPIN(xb_ld(&bar[XB_XGEN(b.x)]) == gen, bar);
            __builtin_amdgcn_fence(__ATOMIC_ACQUIRE, "agent");
            asm volatile("s_waitcnt vmcnt(0)" ::: "memory");
        }
    }
    __syncthreads();
}

#ifndef MULTI_LAUNCH
constexpr int REP_STAGE = -1, REP_STAGE2 = -1, REP_N = 1;
template <int S, int LIM = 0>
DEV void run_phase1(const P& p, int layer, char* smem, int off);
template <int S, int LIM = 0>
DEV void run_phase(const P& p, int layer, char* smem, int off = 0) {
    constexpr int reps = (S == REP_STAGE || S == REP_STAGE2) ? REP_N : 1;
#pragma unroll 1
    for (int r = 0; r < reps; ++r) run_phase1<S, LIM>(p, layer, smem, off);
}
template <int S, int LIM>
DEV void run_phase1(const P& p, int layer, char* smem, int off) {
    const int G = gridDim.x;
    int b = blockIdx.x + off; if (b >= G) b -= G;
    if constexpr (S == S_TAB_U || S == S_TAB_V) { run_unit<S>(p, layer, b, smem, G); }
    else {
        for (int u = b; u < (LIM ? LIM : nunits(S)); u += G) { run_unit<S>(p, layer, u, smem); __syncthreads(); }
    }
}
template <int S>
DEV void run_gemm_phase1(const P& p, int layer, char* smem, unsigned xcc, volatile LAS unsigned* slot, int rep) {
    constexpr int TN = (S == S_GEMM_IN) ? (LDP / 128) : (S == S_GEMM_OUT ? 16 : 8);
    constexpr int NBIG = (S == S_GEMM_IN) ? 32 : (S == S_GEMM_OUT ? 16 : 0);
    constexpr int inst0 = (S == S_GEMM_IN) ? 0 : (S == S_GEMM_OUT ? 2 : 4);
    constexpr int nbig = 4 * NBIG, len = nbig + 8 * (TN - NBIG);
    const float* xin = layer == 0 ? p.x : p.X2();
    const float* ada = p.ada() + layer * 12288;
    const bf16_t* Aop = (S == S_GEMM_OUT) ? p.Y() : p.HN();
    const bf16_t* Bop = (S == S_GEMM_IN) ? p.WinT() + (size_t)layer * LDP * 2048 : (S == S_GEMM_OUT ? p.WoutT() + (size_t)layer * 2048 * 2048 : p.WqT() + (size_t)layer * 1024 * 2048);
    EpiArgs e{p.PROJ(), (S == S_GEMM_OUT) ? p.X1() : p.PQ(), xin, ada + 2 * 2048, p.KVC()};
    constexpr int EPI = (S == S_GEMM_IN) ? EPI_PROJ : (S == S_GEMM_OUT ? EPI_OUT : EPI_Q);
#pragma unroll 1
    for (int q = 0; q < 8; ++q) {
        const unsigned xq = (xcc + q) & 7u;
        unsigned* head = p.bar() + GQ_WORD(inst0 + layer + 6 * rep, xq);
        for (;;) {
            if (threadIdx.x == 0) *slot = xb_add(head, 1u);
            __syncthreads();
            const int i = (int)*slot;
            __syncthreads();
            if (i >= len) break;
            if (i < nbig) st_gemm<EPI, 8>(Aop, Bop, 2048, (int)xq * 4 + (i & 3), i >> 2, e, smem);
            else {
                const int j = i - nbig, tm = (int)xq * 8 + (j & 7), tn = NBIG + (j >> 3);
                st_gemm<EPI, 4>(Aop, Bop, 2048, tm, tn, e, smem);
                if constexpr (S == S_GEMM_Q) {
                    asm volatile("s_waitcnt vmcnt(0)" ::: "memory");
                    __syncthreads();
                    st_peer_topk(p, layer, tm * 8 + tn, smem);
                }
            }
            __syncthreads();
        }
    }
}
template <int S>
DEV void run_items(const P& p, int layer, char* smem, int first, int count) {
    constexpr int reps = (S == REP_STAGE || S == REP_STAGE2) ? REP_N : 1;
#pragma unroll 1
    for (int r = 0; r < reps; ++r)
#pragma unroll 1
        for (int u = first; u < first + count; ++u) { run_unit<S>(p, layer, u, smem); __syncthreads(); }
}
DEV void dep_publish(unsigned* cnt) {
    asm volatile("s_waitcnt vmcnt(0)" ::: "memory");
    __syncthreads();
    if (threadIdx.x == 0) { __builtin_amdgcn_fence(__ATOMIC_RELEASE, "agent"); asm volatile("s_waitcnt vmcnt(0)" ::: "memory"); (void)xb_add(cnt, 1u); }
}
DEV void dep_wait(unsigned* cnt, unsigned target, unsigned* bar) {
    if (threadIdx.x == 0) {
        XB_SPIN(xb_ld(cnt) < target, bar);
        __builtin_amdgcn_fence(__ATOMIC_ACQUIRE, "agent");
        asm volatile("s_waitcnt vmcnt(0)" ::: "memory");
    }
    __syncthreads();
}
template <int PH>
DEV void run_dyn_phase(const P& p, int layer, char* smem, volatile LAS unsigned* slot) {
    unsigned* head = p.bar() + DQ_WORD(PH * 2 + layer);
    unsigned* cprep = p.bar() + DQ_WORD(12 + layer); unsigned* ccomp = p.bar() + DQ_WORD(14 + layer);
    constexpr int total0 = PH == 0 ? (256 + 64 + 256 + 256 + 64 + 512 + 256) : (512 + 512);
    const int total = (PH == 0 && layer == 0) ? total0 + 512 + 296 + 256 + 128 : total0;
    int i = blockIdx.x;
    while (i < total) {
        if constexpr (PH == 0) {
            if (i < 256) { run_items<S_PREP>(p, layer, smem, i * 8, 8); dep_publish(cprep); }
            else if (i < 320) { run_items<S_COMPRESS>(p, layer, smem, i - 256, 1); dep_publish(ccomp); }
            else if (i < 576) run_items<S_SGU>(p, layer, smem, i - 320, 1);
            else if (i < 832) run_items<S_CONV>(p, layer, smem, (i - 576) * 2, 2);
            else if (i < 896) run_items<S_VTRANS>(p, layer, smem, (i - 832) * 4, 4);
            else if (i < 1408) { dep_wait(cprep, 256u, p.bar()); run_items<S_DSA_INDEX>(p, layer, smem, i - 896, 1); }
            else if (i < 1664) { dep_wait(cprep, 256u, p.bar()); dep_wait(ccomp, 64u, p.bar()); run_items<S_NSA_CMP>(p, layer, smem, (i - 1408) * 2, 2); }
            else if (i < 1920) { run_unit<S_TAB_U>(p, layer, i - 1664, smem, 256); __syncthreads(); }
            else if (i < 2176) { run_unit<S_TAB_V>(p, layer, i - 1920, smem, 256); __syncthreads(); }
            else if (i < 2472) run_items<S_CONVT_IN>(p, layer, smem, 2368 + (i - 2176) * 8, 8);
            else if (i < 2728) run_items<S_CONVT_OUT>(p, layer, smem, (i - 2472) * 8, 8);
            else run_items<S_CONVT_Q>(p, layer, smem, (i - 2728) * 8, 8);
        } else {
            if (i < 512) run_items<S_NSA_ATTN>(p, layer, smem, 511 - i, 1);
            else run_items<S_DSA_ATTN>(p, layer, smem, (i - 512) * 4, 4);
        }
        if (threadIdx.x == 0) *slot = gridDim.x + xb_add(head, 1u);
        __syncthreads();
        i = (int)*slot;
        __syncthreads();
    }
}
template <int S>
DEV void run_gemm_phase(const P& p, int layer, char* smem, unsigned xcc, volatile LAS unsigned* slot) {
    constexpr int reps = (S == REP_STAGE || S == REP_STAGE2) ? REP_N : 1;
#pragma unroll 1
    for (int r = 0; r < reps; ++r) run_gemm_phase1<S>(p, layer, smem, xcc, slot, r);
}
#if defined(__HIP_DEVICE_COMPILE__)
typedef const P __attribute__((address_space(4)))* kargp_t;
DEV const P& fresh_params() { kargp_t q = (kargp_t)__builtin_amdgcn_kernarg_segment_ptr(); asm volatile("" : "+s"(q)); return *(const P*)q; }
#define PP fresh_params()
#else
#define PP p
#endif
#define GSYNC() xcd_barrier(xb)
__global__ void __launch_bounds__(NTHREADS, 2) k_mega(P p) {
    __shared__ __attribute__((aligned(16))) char smem[SMEM_BYTES];
    __shared__ uint4 xb_words;
    cg::grid_group grid = cg::this_grid();
    if (threadIdx.x == 0) xb_words = make_uint4(0u, 0u, 0u, 0u);
    __syncthreads();
    XcdBarrier xb = xcd_barrier_post(p.bar(), (volatile LAS unsigned*)&xb_words);
    const int H = gridDim.x >> 1, Q = gridDim.x >> 2;
    run_phase<S_ADA>(PP, 0, smem); run_phase<S_ROPE>(PP, 0, smem, H);
    run_phase<S_CONVT_IN, 2368>(PP, 0, smem); run_phase<S_CONVT_W1>(PP, 0, smem); run_phase<S_CALIB>(PP, 0, smem, 100);
    GSYNC();
    if (gridDim.x == 0x7fffffffu) grid.sync();
#pragma unroll 1
    for (int layer = 0; layer < NL; ++layer) {
        if (layer == 0) { run_phase<S_NORM1>(PP, layer, smem); GSYNC(); }
        run_gemm_phase<S_GEMM_IN>(PP, layer, smem, xb.x, (volatile LAS unsigned*)&xb_words + 2); GSYNC();
        run_dyn_phase<0>(PP, layer, smem, (volatile LAS unsigned*)&xb_words + 2); GSYNC();
        run_dyn_phase<2>(PP, layer, smem, (volatile LAS unsigned*)&xb_words + 2); GSYNC();
        run_gemm_phase<S_GEMM_OUT>(PP, layer, smem, xb.x, (volatile LAS unsigned*)&xb_words + 2); GSYNC();
        run_phase<S_NORM2>(PP, layer, smem); GSYNC();
        run_gemm_phase<S_GEMM_Q>(PP, layer, smem, xb.x, (volatile LAS unsigned*)&xb_words + 2); GSYNC();
        run_phase<S_PEER_GATHER>(PP, layer, smem); GSYNC();
    }
}
#else
template <int S>
__global__ void __launch_bounds__(NTHREADS) k_stage(P p, int layer) {
    __shared__ __attribute__((aligned(16))) char smem[SMEM_BYTES];
    run_unit<S>(p, layer, blockIdx.x, smem);
}
template <int S> static void launch_stage(const P& p, int layer, hipStream_t st) {
    hipLaunchKernelGGL((k_stage<S>), dim3(nunits(S)), dim3(NTHREADS), 0, st, p, layer);
}
#endif

extern "C" void kernel_launch(void* const* d_in, const int* in_sizes, int n_in, void* d_out, int out_size, void* d_ws, size_t ws_size, hipStream_t stream) {
    P p{};
    p.x = (const float*)d_in[0]; p.c = (const float*)d_in[1]; p.pos = (const int*)d_in[2]; p.ada_w = (const float*)d_in[3]; p.ada_b = (const float*)d_in[4];
    p.n1g = (const float*)d_in[5]; p.n2g = (const float*)d_in[6]; p.w_in = (const float*)d_in[7]; p.w_out = (const float*)d_in[8]; p.conv_w = (const float*)d_in[9];
    p.conv_b = (const float*)d_in[10]; p.cln_g = (const float*)d_in[11]; p.cln_b = (const float*)d_in[12]; p.sln_g = (const float*)d_in[13]; p.sln_b = (const float*)d_in[14];
    p.sgu_w = (const float*)d_in[15]; p.sgu_b = (const float*)d_in[16]; p.nsa_qg = (const float*)d_in[17]; p.nsa_kg = (const float*)d_in[18]; p.cmp_pos = (const float*)d_in[19];
    p.cmp_w1 = (const float*)d_in[20]; p.cmp_w2 = (const float*)d_in[21]; p.dsa_qg = (const float*)d_in[22]; p.dsa_kg = (const float*)d_in[23]; p.peer_wq = (const float*)d_in[24];
    p.peer_sk = (const float*)d_in[25]; p.peer_u = (const float*)d_in[26]; p.peer_v = (const float*)d_in[27];
    p.out = (float*)d_out;
    p.ws = (char*)d_ws; const size_t off = WS_TOTAL;
    if (off > ws_size) { fprintf(stderr, "workspace too small: need %zu have %zu\n", off, ws_size); return; }
#ifndef MULTI_LAUNCH
    static int grid_blocks = 0;
    if (!grid_blocks) {
        int dev = 0, cus = 0, per_cu = 0;
        (void)hipGetDevice(&dev);
        (void)hipDeviceGetAttribute(&cus, hipDeviceAttributeMultiprocessorCount, dev);
        (void)hipOccupancyMaxActiveBlocksPerMultiprocessor(&per_cu, k_mega, NTHREADS, 0);
        if (per_cu > 2) per_cu = 2;
        grid_blocks = cus * per_cu;
    }
    (void)hipMemsetAsync(p.bar(), 0, (size_t)CTRL_WORDS * 4, stream);
    void* args[] = {&p};
    hipError_t e = hipLaunchCooperativeKernel((void*)k_mega, dim3(grid_blocks), dim3(NTHREADS), args, 0, stream);
    if (e != hipSuccess) fprintf(stderr, "cooperative launch failed: %s (grid %d)\n", hipGetErrorString(e), grid_blocks);
#else
    launch_stage<S_CONVT_IN>(p, 0, stream); launch_stage<S_CONVT_OUT>(p, 0, stream); launch_stage<S_CONVT_Q>(p, 0, stream); launch_stage<S_CONVT_W1>(p, 0, stream); launch_stage<S_CALIB>(p, 0, stream);
    launch_stage<S_TAB_U>(p, 0, stream); launch_stage<S_TAB_V>(p, 0, stream);
    launch_stage<S_ADA>(p, 0, stream); launch_stage<S_ROPE>(p, 0, stream);
    for (int layer = 0; layer < NL; ++layer) {
        launch_stage<S_NORM1>(p, layer, stream); launch_stage<S_GEMM_IN>(p, layer, stream);
        launch_stage<S_CONV>(p, layer, stream); launch_stage<S_SGU>(p, layer, stream); launch_stage<S_VTRANS>(p, layer, stream);
        launch_stage<S_PREP>(p, layer, stream); launch_stage<S_COMPRESS>(p, layer, stream);
        launch_stage<S_NSA_CMP>(p, layer, stream); launch_stage<S_DSA_INDEX>(p, layer, stream);
        launch_stage<S_NSA_ATTN>(p, layer, stream); launch_stage<S_DSA_ATTN>(p, layer, stream);
        launch_stage<S_GEMM_OUT>(p, layer, stream); launch_stage<S_NORM2>(p, layer, stream); launch_stage<S_GEMM_Q>(p, layer, stream);
        launch_stage<S_PEER_TOPK>(p, layer, stream); launch_stage<S_PEER_GATHER>(p, layer, stream);
    }
#endif
}
```

```cpp
#include <hip/hip_runtime.h>
#include <hip/hip_cooperative_groups.h>
#include <stdint.h>
#include <cstdio>
namespace cg = cooperative_groups;

typedef unsigned short bf16_t;
typedef short bf16x8 __attribute__((ext_vector_type(8)));
typedef float f32x4 __attribute__((ext_vector_type(4)));
typedef float f32x16 __attribute__((ext_vector_type(16)));
#define DEV __device__ __forceinline__

constexpr int T = 8192, D = 2048, NL = 2;
constexpr int INC = 4692;
constexpr int LDP = 4736;
constexpr int C_CA = 0, C_CG = 512, C_SU = 1024, C_SV = 1536;
constexpr int C_NQ = 2048, C_NKC = 2560, C_NVC = 2688, C_NKS = 2816, C_NVS = 2944, C_NKW = 3072, C_NVW = 3200;
constexpr int C_DQ = 3328, C_DK = 3840, C_DV = 3968, C_IQ = 4096, C_IK = 4608, C_NG = 4672, C_IW = 4688;
constexpr float EPS = 1e-6f;
constexpr int NTHREADS = 256;
constexpr int SMEM_BYTES = 72 * 1024;

__device__ const double INV16[16] = {1.0, 0.44036660267178046, 0.19392274474868576, 0.08539710028576561, 0.03760603093086393,
    0.016560440080994446, 0.007292664737217109, 0.003211445994752591, 0.001414213562373095, 0.000622772421914596,
    0.0002742481756762073, 0.00012076973741146504, 5.318295896944988e-05, 2.341999896140934e-05, 1.031338537721246e-05,
    4.5416704806078695e-06};

#define XCD_BAR_WORDS 3456
#define GQ_WORD(inst, x) (XCD_BAR_WORDS + 64 * ((inst) * 8 + (x)))
#define DQ_WORD(k) (XCD_BAR_WORDS + 64 * (96 + (k)))
#define CTRL_WORDS (XCD_BAR_WORDS + 64 * 112)
constexpr size_t WS_ALIGN(size_t x) { return (x + 255) & ~(size_t)255; }
constexpr size_t OFF_WinT = 0;
constexpr size_t OFF_WoutT = OFF_WinT + WS_ALIGN((size_t)2 * LDP * 2048 * 2);
constexpr size_t OFF_WqT = OFF_WoutT + WS_ALIGN((size_t)2 * 2048 * 2048 * 2);
constexpr size_t OFF_W1T = OFF_WqT + WS_ALIGN((size_t)2 * 1024 * 2048 * 2);
constexpr size_t OFF_PI = OFF_W1T + WS_ALIGN((size_t)4 * 128 * 4096 * 2);
constexpr size_t OFF_Utab = OFF_PI + WS_ALIGN(256);
constexpr size_t OFF_Vtab = OFF_Utab + WS_ALIGN((size_t)2 * 16384 * 1536);
constexpr size_t OFF_ada = OFF_Vtab + WS_ALIGN((size_t)2 * 16384 * 1536);
constexpr size_t OFF_ropeC = OFF_ada + WS_ALIGN((size_t)2 * 12288 * 4);
constexpr size_t OFF_ropeS = OFF_ropeC + WS_ALIGN((size_t)T * 24 * 4);
constexpr size_t OFF_HN = OFF_ropeS + WS_ALIGN((size_t)T * 24 * 4);
constexpr size_t OFF_PROJ = OFF_HN + WS_ALIGN((size_t)T * D * 2);
constexpr size_t OFF_Y = OFF_PROJ + WS_ALIGN((size_t)T * LDP * 2);
constexpr size_t OFF_QN = OFF_Y + WS_ALIGN((size_t)T * D * 2);
constexpr size_t OFF_QR = OFF_QN + WS_ALIGN((size_t)T * 512 * 2);
constexpr size_t OFF_KS = OFF_QR + WS_ALIGN((size_t)T * 512 * 2);
constexpr size_t OFF_KW = OFF_KS + WS_ALIGN((size_t)T * 128 * 2);
constexpr size_t OFF_VST = OFF_KW + WS_ALIGN((size_t)T * 128 * 2);
constexpr size_t OFF_VWT = OFF_VST + WS_ALIGN((size_t)T * 128 * 2);
constexpr size_t OFF_GATES = OFF_VWT + WS_ALIGN((size_t)T * 128 * 2);
constexpr size_t OFF_KC = OFF_GATES + WS_ALIGN((size_t)T * 12 * 4);
constexpr size_t OFF_VCT = OFF_KC + WS_ALIGN((size_t)512 * 128 * 2);
constexpr size_t OFF_SEL = OFF_VCT + WS_ALIGN((size_t)128 * 512 * 2);
constexpr size_t OFF_OCMP = OFF_SEL + WS_ALIGN((size_t)T * 4 * 4);
constexpr size_t OFF_DQ = OFF_OCMP + WS_ALIGN((size_t)T * 512 * 2);
constexpr size_t OFF_DK = OFF_DQ + WS_ALIGN((size_t)T * 512 * 2);
constexpr size_t OFF_DVC = OFF_DK + WS_ALIGN((size_t)T * 128 * 2);
constexpr size_t OFF_KVC = OFF_DVC + WS_ALIGN((size_t)T * 128 * 2);
constexpr size_t OFF_IQ = OFF_KVC + WS_ALIGN((size_t)T * 256 * 2);
constexpr size_t OFF_IK = OFF_IQ + WS_ALIGN((size_t)T * 512 * 2);
constexpr size_t OFF_IW = OFF_IK + WS_ALIGN((size_t)T * 64 * 2);
constexpr size_t OFF_IDX = OFF_IW + WS_ALIGN((size_t)T * 8 * 4);
constexpr size_t OFF_CNT = OFF_IDX + WS_ALIGN((size_t)T * 256 * 4);
constexpr size_t OFF_X1 = OFF_CNT + WS_ALIGN((size_t)T * 4);
constexpr size_t OFF_X2 = OFF_X1 + WS_ALIGN((size_t)T * D * 4);
constexpr size_t OFF_PQ = OFF_X2 + WS_ALIGN((size_t)T * D * 4);
constexpr size_t OFF_PE = OFF_PQ + WS_ALIGN((size_t)T * 1024 * 4);
constexpr size_t OFF_PG = OFF_PE + WS_ALIGN((size_t)T * 128 * 4);
constexpr size_t OFF_bar = OFF_PG + WS_ALIGN((size_t)T * 128 * 4);
constexpr size_t WS_TOTAL = OFF_bar + WS_ALIGN((size_t)CTRL_WORDS * 4);

struct P {
    const float* x; const float* c; const int* pos; const float* ada_w; const float* ada_b; const float* n1g; const float* n2g;
    const float* w_in; const float* w_out; const float* conv_w; const float* conv_b; const float* cln_g; const float* cln_b;
    const float* sln_g; const float* sln_b; const float* sgu_w; const float* sgu_b; const float* nsa_qg; const float* nsa_kg;
    const float* cmp_pos; const float* cmp_w1; const float* cmp_w2; const float* dsa_qg; const float* dsa_kg;
    const float* peer_wq; const float* peer_sk; const float* peer_u; const float* peer_v;
    float* out;
    char* ws;
    __host__ __device__ __forceinline__ bf16_t* WinT() const { return (bf16_t*)(ws + OFF_WinT); }
    __host__ __device__ __forceinline__ bf16_t* WoutT() const { return (bf16_t*)(ws + OFF_WoutT); }
    __host__ __device__ __forceinline__ bf16_t* WqT() const { return (bf16_t*)(ws + OFF_WqT); }
    __host__ __device__ __forceinline__ bf16_t* W1T() const { return (bf16_t*)(ws + OFF_W1T); }
    __host__ __device__ __forceinline__ int* PI() const { return (int*)(ws + OFF_PI); }
    __host__ __device__ __forceinline__ unsigned char* Utab() const { return (unsigned char*)(ws + OFF_Utab); }
    __host__ __device__ __forceinline__ unsigned char* Vtab() const { return (unsigned char*)(ws + OFF_Vtab); }
    __host__ __device__ __forceinline__ float* ada() const { return (float*)(ws + OFF_ada); }
    __host__ __device__ __forceinline__ float* ropeC() const { return (float*)(ws + OFF_ropeC); }
    __host__ __device__ __forceinline__ float* ropeS() const { return (float*)(ws + OFF_ropeS); }
    __host__ __device__ __forceinline__ bf16_t* HN() const { return (bf16_t*)(ws + OFF_HN); }
    __host__ __device__ __forceinline__ bf16_t* PROJ() const { return (bf16_t*)(ws + OFF_PROJ); }
    __host__ __device__ __forceinline__ bf16_t* Y() const { return (bf16_t*)(ws + OFF_Y); }
    __host__ __device__ __forceinline__ bf16_t* QN() const { return (bf16_t*)(ws + OFF_QN); }
    __host__ __device__ __forceinline__ bf16_t* QR() const { return (bf16_t*)(ws + OFF_QR); }
    __host__ __device__ __forceinline__ bf16_t* KS() const { return (bf16_t*)(ws + OFF_KS); }
    __host__ __device__ __forceinline__ bf16_t* KW() const { return (bf16_t*)(ws + OFF_KW); }
    __host__ __device__ __forceinline__ bf16_t* VST() const { return (bf16_t*)(ws + OFF_VST); }
    __host__ __device__ __forceinline__ bf16_t* VWT() const { return (bf16_t*)(ws + OFF_VWT); }
    __host__ __device__ __forceinline__ float* GATES() const { return (float*)(ws + OFF_GATES); }
    __host__ __device__ __forceinline__ bf16_t* KC() const { return (bf16_t*)(ws + OFF_KC); }
    __host__ __device__ __forceinline__ bf16_t* VCT() const { return (bf16_t*)(ws + OFF_VCT); }
    __host__ __device__ __forceinline__ unsigned* SEL() const { return (unsigned*)(ws + OFF_SEL); }
    __host__ __device__ __forceinline__ bf16_t* OCMP() const { return (bf16_t*)(ws + OFF_OCMP); }
    __host__ __device__ __forceinline__ bf16_t* DQ() const { return (bf16_t*)(ws + OFF_DQ); }
    __host__ __device__ __forceinline__ bf16_t* DK() const { return (bf16_t*)(ws + OFF_DK); }
    __host__ __device__ __forceinline__ bf16_t* DVC() const { return (bf16_t*)(ws + OFF_DVC); }
    __host__ __device__ __forceinline__ bf16_t* KVC() const { return (bf16_t*)(ws + OFF_KVC); }
    __host__ __device__ __forceinline__ bf16_t* IQ() const { return (bf16_t*)(ws + OFF_IQ); }
    __host__ __device__ __forceinline__ bf16_t* IK() const { return (bf16_t*)(ws + OFF_IK); }
    __host__ __device__ __forceinline__ float* IW() const { return (float*)(ws + OFF_IW); }
    __host__ __device__ __forceinline__ int* IDX() const { return (int*)(ws + OFF_IDX); }
    __host__ __device__ __forceinline__ int* CNT() const { return (int*)(ws + OFF_CNT); }
    __host__ __device__ __forceinline__ float* X1() const { return (float*)(ws + OFF_X1); }
    __host__ __device__ __forceinline__ float* X2() const { return (float*)(ws + OFF_X2); }
    __host__ __device__ __forceinline__ float* PQ() const { return (float*)(ws + OFF_PQ); }
    __host__ __device__ __forceinline__ int* PE() const { return (int*)(ws + OFF_PE); }
    __host__ __device__ __forceinline__ float* PG() const { return (float*)(ws + OFF_PG); }
    __host__ __device__ __forceinline__ unsigned* bar() const { return (unsigned*)(ws + OFF_bar); }
};

DEV float bf2f(bf16_t v) { return __uint_as_float(((unsigned)v) << 16); }
DEV unsigned pk2(float lo, float hi) { unsigned r; asm("v_cvt_pk_bf16_f32 %0, %1, %2" : "=v"(r) : "v"(lo), "v"(hi)); return r; }
DEV bf16_t f2bf(float v) { return (bf16_t)(pk2(v, 0.f) & 0xffffu); }
DEV float lo2f(unsigned u) { return __uint_as_float(u << 16); }
DEV float hi2f(unsigned u) { return __uint_as_float(u & 0xffff0000u); }
#define DPP_ROR_F(V, N) __int_as_float(__builtin_amdgcn_update_dpp(0, __float_as_int(V), 0x120 + (N), 0xf, 0xf, false))
DEV float wsum(float v) {
    v += DPP_ROR_F(v, 8); v += DPP_ROR_F(v, 4); v += DPP_ROR_F(v, 2); v += DPP_ROR_F(v, 1);
    const int vi = __float_as_int(v);
    return (__int_as_float(__builtin_amdgcn_readlane(vi, 0)) + __int_as_float(__builtin_amdgcn_readlane(vi, 16))) +
           (__int_as_float(__builtin_amdgcn_readlane(vi, 32)) + __int_as_float(__builtin_amdgcn_readlane(vi, 48)));
}
DEV float wmax(float v) {
    v = fmaxf(v, DPP_ROR_F(v, 8)); v = fmaxf(v, DPP_ROR_F(v, 4)); v = fmaxf(v, DPP_ROR_F(v, 2)); v = fmaxf(v, DPP_ROR_F(v, 1));
    const int vi = __float_as_int(v);
    return fmaxf(fmaxf(__int_as_float(__builtin_amdgcn_readlane(vi, 0)), __int_as_float(__builtin_amdgcn_readlane(vi, 16))),
                 fmaxf(__int_as_float(__builtin_amdgcn_readlane(vi, 32)), __int_as_float(__builtin_amdgcn_readlane(vi, 48))));
}
DEV int tidx() { int t = threadIdx.x; asm volatile("" : "+v"(t)); return t; }
DEV float sigmoidf_(float x) { return 1.0f / (1.0f + __expf(-x)); }
DEV float gelu_tanh(float x) {
    const float y = 0.7978845608028654f * (x + 0.044715f * x * x * x);
    const float t = 1.0f - 2.0f / (1.0f + __expf(2.0f * y));
    return 0.5f * x * (1.0f + t);
}
DEV f32x4 mfma16(bf16x8 a, bf16x8 b, f32x4 c) { return __builtin_amdgcn_mfma_f32_16x16x32_bf16(a, b, c, 0, 0, 0); }
DEV f32x16 mfma32(bf16x8 a, bf16x8 b, f32x16 c) { return __builtin_amdgcn_mfma_f32_32x32x16_bf16(a, b, c, 0, 0, 0); }

DEV int src_col(int n) {
    if (n < 3328) return n;
    if (n < 4672) return 3340 + (n - 3328);
    if (n < 4684) return 3328 + (n - 4672);
    if (n < 4688) return -1;
    if (n < 4696) return 4684 + (n - 4688);
    return -1;
}

DEV void st_convT(const float* __restrict__ W, bf16_t* __restrict__ Bt, int N, int Npad, bool remap, int unit, char* smem, int Kdim = 2048) {
    float (*tile)[65] = (float (*)[65])smem;
    const int ntn = Npad / 64, kt = unit / ntn, nt = unit % ntn, k0 = kt * 64, n0 = nt * 64;
    const int tid_ = tidx(); const int tx = tid_ & 63, ty = tid_ >> 6;
    const int n = n0 + tx;
    const int src = remap ? src_col(n) : (n < N ? n : -1);
#pragma unroll
    for (int i = 0; i < 16; ++i) { const int k = ty + 4 * i; tile[k][tx] = src >= 0 ? W[(size_t)(k0 + k) * N + src] : 0.f; }
    __syncthreads();
#pragma unroll
    for (int i = 0; i < 16; ++i) { const int r = ty + 4 * i; Bt[(size_t)(n0 + r) * Kdim + k0 + tx] = f2bf(tile[tx][r]); }
    __syncthreads();
}

typedef float f32x2 __attribute__((ext_vector_type(2)));
typedef float v16f __attribute__((ext_vector_type(16)));
typedef float v32f __attribute__((ext_vector_type(32)));
typedef unsigned v6u __attribute__((ext_vector_type(6)));
#ifndef PEER_FP4
#define PEER_FP4 0
#endif
#if PEER_FP4
constexpr float U6_SCALE = 64.0f, V6_SCALE = 2.8f;
constexpr int ROW6 = 1024;
#else
constexpr float U6_SCALE = 64.0f, V6_SCALE = 3.0f;
constexpr int ROW6 = 1536;
#endif
#define FP6_ONE __uint_as_float(0x3F80007Fu)

#ifndef SW_FP6
#define SW_FP6 1
#endif
DEV unsigned fp6_enc1(float f) {
    const float a = fminf(fabsf(f), 7.5f);
    const float sc = a < 2.0f ? 8.0f : (a < 4.0f ? 4.0f : 2.0f), of = a < 2.0f ? 0.0f : (a < 4.0f ? 8.0f : 16.0f);
    const unsigned code = (unsigned)(int)__builtin_rintf(a * sc + of);
    return code | ((__float_as_uint(f) >> 26) & 32u);
}
DEV float fp6_dec1(unsigned c) {
    const unsigned e = (c >> 3) & 3u, m = c & 7u;
    const float v = e == 0u ? 0.125f * (float)m : (1.0f + 0.125f * (float)m) * (float)(1u << (e - 1u));
    return (c & 32u) ? -v : v;
}
DEV v6u sw_pack32(const v16f& x, const v16f& y) {
    unsigned w[6] = {0u, 0u, 0u, 0u, 0u, 0u};
#pragma unroll
    for (int i = 0; i < 32; ++i) {
        const unsigned c = fp6_enc1(i < 16 ? x[i] : y[i - 16]);
        const int bit = 6 * i, d = bit >> 5, sh = bit & 31;
        w[d] |= c << sh;
        if (sh > 26) w[d + 1] |= c >> (32 - sh);
    }
    v6u r; r[0] = w[0]; r[1] = w[1]; r[2] = w[2]; r[3] = w[3]; r[4] = w[4]; r[5] = w[5]; return r;
}
DEV v32f sw_unpack32(const v6u& pk) {
    const unsigned w[6] = {pk[0], pk[1], pk[2], pk[3], pk[4], pk[5]};
    v32f r;
#pragma unroll
    for (int i = 0; i < 32; ++i) {
        const int bit = 6 * i, d = bit >> 5, sh = bit & 31;
        unsigned c = w[d] >> sh;
        if (sh > 26) c |= w[d + 1] << (32 - sh);
        r[i] = fp6_dec1(c & 63u);
    }
    return r;
}
#define FP6_PACK(x, y) sw_pack32(x, y)
#define FP6_UNPACK(pk) __builtin_amdgcn_cvt_scalef32_pk32_f32_fp6(pk, FP6_ONE)

typedef float f32x2_t __attribute__((ext_vector_type(2)));
DEV unsigned fp4_enc1(float f) {
    const float a = fminf(fabsf(f), 6.0f);
    const float sc = a < 2.0f ? 2.0f : (a < 4.0f ? 1.0f : 0.5f), of = a < 2.0f ? 0.0f : (a < 4.0f ? 2.0f : 4.0f);
    const unsigned code = (unsigned)(int)__builtin_rintf(a * sc + of);
    return code | ((__float_as_uint(f) >> 28) & 8u);
}
DEV void fp4_unpack8(unsigned w, float* f) {
    const f32x2_t a = __builtin_amdgcn_cvt_scalef32_pk_f32_fp4(w, FP6_ONE, 0), b = __builtin_amdgcn_cvt_scalef32_pk_f32_fp4(w, FP6_ONE, 1);
    const f32x2_t c = __builtin_amdgcn_cvt_scalef32_pk_f32_fp4(w, FP6_ONE, 2), d = __builtin_amdgcn_cvt_scalef32_pk_f32_fp4(w, FP6_ONE, 3);
    f[0] = a.x; f[1] = a.y; f[2] = b.x; f[3] = b.y; f[4] = c.x; f[5] = c.y; f[6] = d.x; f[7] = d.y;
}
DEV void st_tab4(const P& p, const float* __restrict__ src, unsigned char* __restrict__ dst, float scale, int nrows, int unit, int nunits, char* smem) {
    const int tid_ = tidx(), w = tid_ >> 6, l = tid_ & 63;
    float* stg = (float*)smem + w * (64 * 36);
    int sh[8];
#pragma unroll
    for (int k = 0; k < 8; ++k) sh[k] = 4 * __builtin_amdgcn_readfirstlane(p.PI()[40 + k]);
    for (int r = unit * 4 + w; r < nrows; r += nunits * 4) {
        const float4* sp = (const float4*)(src + (size_t)r * 2048);
        float4 v[8];
#pragma unroll
        for (int i = 0; i < 8; ++i) v[i] = sp[l + 64 * i];
#pragma unroll
        for (int i = 0; i < 8; ++i) { const int f = l + 64 * i; *(float4*)(stg + (f >> 3) * 36 + (f & 7) * 4) = v[i]; }
        __builtin_amdgcn_wave_barrier();
        unsigned wd[4] = {0u, 0u, 0u, 0u};
#pragma unroll
        for (int q = 0; q < 8; ++q) {
            const float4 a = *(const float4*)(stg + l * 36 + q * 4);
            const float xv[4] = {a.x, a.y, a.z, a.w};
#pragma unroll
            for (int e = 0; e < 4; ++e) { const int j = q * 4 + e; wd[j >> 3] |= fp4_enc1(xv[e] * scale) << sh[j & 7]; }
        }
        *(uint4*)(dst + (size_t)r * ROW6 + l * 16) = make_uint4(wd[0], wd[1], wd[2], wd[3]);
        __builtin_amdgcn_wave_barrier();
    }
}
DEV void st_tab6(const float* __restrict__ src, unsigned char* __restrict__ dst, float scale, int nrows, int unit, int nunits, char* smem) {
    const int tid_ = tidx(), w = tid_ >> 6, l = tid_ & 63;
    float* stg = (float*)smem + w * (64 * 36);
    for (int r = unit * 4 + w; r < nrows; r += nunits * 4) {
        const float4* sp = (const float4*)(src + (size_t)r * 2048);
        float4 v[8];
#pragma unroll
        for (int i = 0; i < 8; ++i) v[i] = sp[l + 64 * i];
#pragma unroll
        for (int i = 0; i < 8; ++i) { const int f = l + 64 * i; *(float4*)(stg + (f >> 3) * 36 + (f & 7) * 4) = v[i]; }
        __builtin_amdgcn_wave_barrier();
        v16f x, y;
#pragma unroll
        for (int q = 0; q < 4; ++q) {
            const float4 a = *(const float4*)(stg + l * 36 + q * 4), b = *(const float4*)(stg + l * 36 + 16 + q * 4);
            x[4 * q] = a.x * scale; x[4 * q + 1] = a.y * scale; x[4 * q + 2] = a.z * scale; x[4 * q + 3] = a.w * scale;
            y[4 * q] = b.x * scale; y[4 * q + 1] = b.y * scale; y[4 * q + 2] = b.z * scale; y[4 * q + 3] = b.w * scale;
        }
        const v6u pk = FP6_PACK(x, y);
        unsigned char* dp = dst + (size_t)r * ROW6 + l * 8;
        *(uint2*)(dp) = make_uint2(pk[0], pk[1]); *(uint2*)(dp + 512) = make_uint2(pk[2], pk[3]); *(uint2*)(dp + 1024) = make_uint2(pk[4], pk[5]);
        __builtin_amdgcn_wave_barrier();
    }
}
DEV void st_calib(const P& p) {
    if (tidx() >= 64) return;
    v16f x, y;
#pragma unroll
    for (int k = 0; k < 32; ++k) {
        const int e = k >> 3, m = k & 7;
        const float v = e == 0 ? 0.125f * m : (1.0f + 0.125f * m) * (float)(1 << (e - 1));
        if (k < 16) x[k] = v; else y[k - 16] = v;
    }
    const v6u pk = FP6_PACK(x, y);
    const v32f d = FP6_UNPACK(pk);
    if ((threadIdx.x & 63) == 0) {
        float dmax = 0.f;
#pragma unroll
        for (int j = 0; j < 32; ++j) dmax = fmaxf(dmax, fabsf(d[j]));
        const float cscale = dmax > 0.f ? dmax * (1.0f / 7.5f) : 1.0f;
        const float ic = 1.0f / cscale;
#pragma unroll
        for (int j = 0; j < 32; ++j) {
            int found = j;
#pragma unroll
            for (int k = 0; k < 32; ++k) {
                const int e = k >> 3, m = k & 7;
                const float v = e == 0 ? 0.125f * m : (1.0f + 0.125f * m) * (float)(1 << (e - 1));
                if (fabsf(d[j] * ic - v) < 0.02f + 0.01f * v) found = k;
            }
            p.PI()[j] = found;
        }
        p.PI()[32] = __float_as_int(ic);
    }
#if PEER_FP4
    {
        const unsigned probe = 0x07654321u;
        float f8[8]; fp4_unpack8(probe, f8);
        if ((threadIdx.x & 63) == 0) {
            const float val[8] = {0.f, 0.5f, 1.f, 1.5f, 2.f, 3.f, 4.f, 6.f};
            float dmax = 0.f;
#pragma unroll
            for (int k = 0; k < 8; ++k) dmax = fmaxf(dmax, fabsf(f8[k]));
            const float ic4 = dmax > 0.f ? 6.0f / dmax : 1.0f;
#pragma unroll
            for (int k = 0; k < 8; ++k) {
                int nib = k;
#pragma unroll
                for (int c = 0; c < 8; ++c) if (fabsf(f8[k] * ic4 - val[c]) < 0.1f) nib = (c + 7) & 7;
                p.PI()[40 + k] = nib;
            }
#pragma unroll
            for (int j = 0; j < 32; ++j) p.PI()[j] = j;
            p.PI()[32] = __float_as_int(ic4);
        }
    }
#endif
}

DEV void st_ada(const P& p, int unit, char* smem) {
    float4* red = (float4*)smem;
    const int tid = tidx(), c4 = tid & 15, kg = tid >> 4;
    const int i = unit / 192, j = (unit % 192) * 64 + c4 * 4;
    const float* W = p.ada_w + (size_t)i * 2048 * 12288 + (size_t)kg * 12288 + j;
    float4 acc = make_float4(0.f, 0.f, 0.f, 0.f);
#pragma unroll 1
    for (int k0 = 0; k0 < 128; k0 += 16) {
        float4 wv[16]; float a[16];
#pragma unroll
        for (int q = 0; q < 16; ++q) { const f32x4 t4 = __builtin_nontemporal_load((const f32x4*)(W + (size_t)(16 * (k0 + q)) * 12288)); wv[q] = make_float4(t4[0], t4[1], t4[2], t4[3]); }
#pragma unroll
        for (int q = 0; q < 16; ++q) { const float cv = p.c[kg + 16 * (k0 + q)]; a[q] = cv * sigmoidf_(cv); }
#pragma unroll
        for (int q = 0; q < 16; ++q) { acc.x += a[q] * wv[q].x; acc.y += a[q] * wv[q].y; acc.z += a[q] * wv[q].z; acc.w += a[q] * wv[q].w; }
    }
    red[kg * 16 + c4] = acc;
    __syncthreads();
    if (tid < 64) {
        const int cc = tid >> 2, e = tid & 3;
        float r = p.ada_b[i * 12288 + (unit % 192) * 64 + tid];
#pragma unroll
        for (int q = 0; q < 16; ++q) r += ((const float*)&red[q * 16 + cc])[e];
        p.ada()[i * 12288 + (unit % 192) * 64 + tid] = r;
    }
    __syncthreads();
}
DEV void st_rope(const P& p, int unit) {
    const int e = unit * 256 + tidx(); const int t = e / 24, i = e % 24;
    const double inv = i < 16 ? INV16[i] : INV16[2 * (i - 16)];
    const double ang = (double)p.pos[t] * inv;
    const double n = rint(ang * 0.15915494309189535);
    const double r = ang - n * 6.283185307179586;
    const double r2 = r * r;
    double sp = 1.0 / 1.5511210043330986e25, cp = -1.0 / 4.0329146112660565e26;
    sp = sp * r2 - 1.0 / 2.585201673888498e22;   cp = cp * r2 + 1.0 / 6.204484017332394e23;
    sp = sp * r2 + 1.0 / 5.109094217170944e19;   cp = cp * r2 - 1.0 / 1.1240007277776077e21;
    sp = sp * r2 - 1.0 / 1.21645100408832e17;    cp = cp * r2 + 1.0 / 2.43290200817664e18;
    sp = sp * r2 + 1.0 / 3.55687428096e14;       cp = cp * r2 - 1.0 / 6.402373705728e15;
    sp = sp * r2 - 1.0 / 1.307674368e12;         cp = cp * r2 + 1.0 / 2.0922789888e13;
    sp = sp * r2 + 1.0 / 6.2270208e9;            cp = cp * r2 - 1.0 / 8.71782912e10;
    sp = sp * r2 - 1.0 / 3.99168e7;              cp = cp * r2 + 1.0 / 4.790016e8;
    sp = sp * r2 + 1.0 / 362880.0;               cp = cp * r2 - 1.0 / 3628800.0;
    sp = sp * r2 - 1.0 / 5040.0;                 cp = cp * r2 + 1.0 / 40320.0;
    sp = sp * r2 + 1.0 / 120.0;                  cp = cp * r2 - 1.0 / 720.0;
    sp = sp * r2 - 1.0 / 6.0;                    cp = cp * r2 + 1.0 / 24.0;
    sp = sp * r2 + 1.0;                          cp = cp * r2 - 0.5;
    cp = cp * r2 + 1.0;
    const float cs = (float)cp, sn = (float)(sp * r);
    p.ropeC()[e] = cs; p.ropeS()[e] = sn;
}

DEV void st_norm(const float* __restrict__ X, const float* __restrict__ g, const float* __restrict__ sc, const float* __restrict__ sh,
                 bf16_t* __restrict__ HN, int unit) {
    const int tid_ = tidx(); const int w = tid_ >> 6, l = tid_ & 63; const int t = unit * 4 + w;
    const float4* xr = (const float4*)(X + (size_t)t * D);
    float4 v[8]; float ss = 0.f;
#pragma unroll
    for (int i = 0; i < 4; ++i) { v[2 * i] = xr[i * 128 + l * 2]; v[2 * i + 1] = xr[i * 128 + l * 2 + 1]; }
#pragma unroll
    for (int i = 0; i < 8; ++i) ss += v[i].x * v[i].x + v[i].y * v[i].y + v[i].z * v[i].z + v[i].w * v[i].w;
    ss = wsum(ss);
    const float rs = rsqrtf(ss * (1.0f / 2048.0f) + EPS);
#pragma unroll
    for (int i = 0; i < 4; ++i) {
        const int col = i * 512 + l * 8;
        float y[8]; const float xv[8] = {v[2 * i].x, v[2 * i].y, v[2 * i].z, v[2 * i].w, v[2 * i + 1].x, v[2 * i + 1].y, v[2 * i + 1].z, v[2 * i + 1].w};
#pragma unroll
        for (int j = 0; j < 8; ++j) y[j] = (xv[j] * rs) * g[col + j] * (1.0f + sc[col + j]) + sh[col + j];
        uint4 o; o.x = pk2(y[0], y[1]); o.y = pk2(y[2], y[3]); o.z = pk2(y[4], y[5]); o.w = pk2(y[6], y[7]);
        *(uint4*)(HN + (size_t)t * D + col) = o;
    }
}

enum { EPI_PROJ = 0, EPI_OUT = 1, EPI_Q = 2 };
struct EpiArgs { bf16_t* obf; float* of; const float* xin; const float* gate; bf16_t* kvc; };
template <int EPI, int MT = 4>
DEV void st_gemm(const bf16_t* __restrict__ A, const bf16_t* __restrict__ Bt, int K, int tm, int tn, const EpiArgs& e, char* smem) {
    constexpr int BM = 32 * MT, ABYTES = BM * 64, BUFB = ABYTES + 8192, NBUF = (MT == 4) ? 4 : 3, NA = BM / 64;
    static_assert(NBUF * BUFB <= SMEM_BYTES, "GEMM LDS");
    const int tid = tidx(), w = tid >> 6, l = tid & 63, wr = w >> 1, wc = w & 1;
    f32x4 acc[MT][4];
#pragma unroll
    for (int m = 0; m < MT; ++m)
#pragma unroll
        for (int n = 0; n < 4; ++n) acc[m][n] = (f32x4){0.f, 0.f, 0.f, 0.f};
    const int srow = tid >> 2, spc = tid & 3, sc = spc ^ (((srow >> 2) & 1) << 1);
    const bf16_t* Ag = A + (size_t)(tm * BM + srow) * K + sc * 8;
    const bf16_t* Bg = Bt + (size_t)(tn * 128 + srow) * K + sc * 8;
#define GEMM_STAGE(BUF, KO) do { char* _b = smem + (BUF) * BUFB + tid * 16; \
        _Pragma("unroll") for (int _i = 0; _i < NA; ++_i) \
            __builtin_amdgcn_global_load_lds((const unsigned*)(Ag + (size_t)(64 * _i) * K + (KO)), (__attribute__((address_space(3))) unsigned*)(_b + _i * 4096), 16, 0, 0); \
        __builtin_amdgcn_global_load_lds((const unsigned*)(Bg + (KO)), (__attribute__((address_space(3))) unsigned*)(_b + ABYTES), 16, 0, 0); \
        __builtin_amdgcn_global_load_lds((const unsigned*)(Bg + (size_t)64 * K + (KO)), (__attribute__((address_space(3))) unsigned*)(_b + ABYTES + 4096), 16, 0, 0); } while (0)
    const int nk = K / 32;
    GEMM_STAGE(0, 0); GEMM_STAGE(1, 32);
    if (NBUF == 4) { GEMM_STAGE(2, 64); asm volatile("s_waitcnt vmcnt(8)" ::: "memory"); }
    else asm volatile("s_waitcnt vmcnt(6)" ::: "memory");
    __builtin_amdgcn_s_barrier();
    const int fr = l & 15, fq = l >> 4;
    int cur = 0, nxt = NBUF - 1;
#pragma unroll 1
    for (int kt = 0; kt < nk; ++kt) {
        if (kt + NBUF - 1 < nk) GEMM_STAGE(nxt, (kt + NBUF - 1) * 32);
        const char* As = smem + cur * BUFB; const char* Bs = As + ABYTES;
        bf16x8 bfr[4];
#pragma unroll
        for (int n = 0; n < 4; ++n) { const int row = wc * 64 + n * 16 + fr; bfr[n] = *(const bf16x8*)(Bs + row * 64 + ((fq ^ (((row >> 2) & 1) << 1)) << 4)); }
#pragma unroll
        for (int m = 0; m < MT; ++m) {
            const int row = wr * (BM / 2) + m * 16 + fr;
            const bf16x8 af = *(const bf16x8*)(As + row * 64 + ((fq ^ (((row >> 2) & 1) << 1)) << 4));
#pragma unroll
            for (int n = 0; n < 4; ++n) acc[m][n] = mfma16(bfr[n], af, acc[m][n]);
        }
        if (NBUF == 4) {
            if (kt + 3 < nk) asm volatile("s_waitcnt vmcnt(8)" ::: "memory");
            else if (kt + 2 < nk) asm volatile("s_waitcnt vmcnt(4)" ::: "memory");
            else asm volatile("s_waitcnt vmcnt(0)" ::: "memory");
        } else {
            if (kt + 2 < nk) asm volatile("s_waitcnt vmcnt(6)" ::: "memory");
            else asm volatile("s_waitcnt vmcnt(0)" ::: "memory");
        }
        asm volatile("s_waitcnt lgkmcnt(0)" ::: "memory");
        __builtin_amdgcn_s_barrier();
        cur = (cur + 1 == NBUF) ? 0 : cur + 1; nxt = (nxt + 1 == NBUF) ? 0 : nxt + 1;
    }
#undef GEMM_STAGE
#pragma unroll
    for (int m = 0; m < MT; ++m) {
        const int row = tm * BM + wr * (BM / 2) + m * 16 + (l & 15);
#pragma unroll
        for (int n = 0; n < 4; ++n) {
            const int col = tn * 128 + wc * 64 + n * 16 + 4 * (l >> 4);
            const f32x4 a = acc[m][n];
            if (EPI == EPI_PROJ) {
                uint2 o; o.x = pk2(a[0], a[1]); o.y = pk2(a[2], a[3]);
                *(uint2*)(e.obf + (size_t)row * LDP + col) = o;
                if (col >= C_NKC && col < C_NKC + 256) *(uint2*)(e.kvc + (size_t)row * 256 + (col - C_NKC)) = o;
            } else if (EPI == EPI_OUT) {
                const float4 xi = *(const float4*)(e.xin + (size_t)row * D + col);
                const float4 gg = *(const float4*)(e.gate + col);
                float4 o; o.x = xi.x + gg.x * a[0]; o.y = xi.y + gg.y * a[1]; o.z = xi.z + gg.z * a[2]; o.w = xi.w + gg.w * a[3];
                *(float4*)(e.of + (size_t)row * D + col) = o;
            } else {
                float4 o; o.x = a[0]; o.y = a[1]; o.z = a[2]; o.w = a[3];
                *(float4*)(e.of + (size_t)row * 1024 + col) = o;
            }
        }
    }
    __syncthreads();
}

DEV void st_conv(const P& p, int layer, int unit, char* smem) {
    float* cs = (float*)smem;
    const int tid = tidx(), t0 = unit * 16;
    const float* cw = p.conv_w + (size_t)layer * 31 * 512;
#pragma unroll 1
    for (int cc = 0; cc < 2; ++cc) {
        const int c = tid + 256 * cc;
        float w[31], z[46];
#pragma unroll
        for (int k = 0; k < 31; ++k) w[k] = cw[k * 512 + c];
#pragma unroll
        for (int r = 0; r < 46; ++r) {
            const int t = t0 - 30 + r, tc = t < 0 ? 0 : t;
            const float a = bf2f(p.PROJ()[(size_t)tc * LDP + C_CA + c]), g = bf2f(p.PROJ()[(size_t)tc * LDP + C_CG + c]);
            z[r] = t >= 0 ? a * sigmoidf_(g) : 0.f;
        }
        const float cb = p.conv_b[layer * 512 + c];
#pragma unroll
        for (int tt = 0; tt < 16; ++tt) {
            float acc = cb;
#pragma unroll
            for (int k = 0; k < 31; ++k) acc += w[k] * z[tt + k];
            cs[tt * 512 + c] = acc;
        }
    }
    __syncthreads();
    const int w = tid >> 6, l = tid & 63;
    const float* lg = p.cln_g + layer * 512; const float* lb = p.cln_b + layer * 512;
#pragma unroll 1
    for (int q = 0; q < 4; ++q) {
        const int tt = w * 4 + q;
        float v[8]; float s = 0.f;
#pragma unroll
        for (int i = 0; i < 8; ++i) { v[i] = cs[tt * 512 + l + 64 * i]; s += v[i]; }
        const float mean = wsum(s) * (1.0f / 512.0f);
        float q2 = 0.f;
#pragma unroll
        for (int i = 0; i < 8; ++i) { const float d = v[i] - mean; q2 += d * d; }
        const float rstd = rsqrtf(wsum(q2) * (1.0f / 512.0f) + EPS);
#pragma unroll
        for (int i = 0; i < 8; ++i) {
            const int c = l + 64 * i;
            const float y = (v[i] - mean) * rstd * lg[c] + lb[c];
            p.Y()[(size_t)(t0 + tt) * D + c] = f2bf(y * sigmoidf_(y));
        }
    }
    __syncthreads();
}

DEV void st_sgu(const P& p, int layer, int unit, char* smem) {
    constexpr int RSB = 136;
    const int n = unit >> 2, h = unit & 3, tid = tidx(), w = tid >> 6, l = tid & 63;
    float* stat = (float*)smem;
    bf16_t* wtb = (bf16_t*)(smem + 1024);
    bf16_t* vtb = wtb + 128 * RSB;
    const int tb = n * 128;
#pragma unroll 4
    for (int q = 0; q < 32; ++q) {
        const int j = w * 32 + q;
        const uint4 raw = *(const uint4*)(p.PROJ() + (size_t)(tb + j) * LDP + C_SV + l * 8);
        float v[8] = {lo2f(raw.x), hi2f(raw.x), lo2f(raw.y), hi2f(raw.y), lo2f(raw.z), hi2f(raw.z), lo2f(raw.w), hi2f(raw.w)};
        float s = 0.f;
#pragma unroll
        for (int i = 0; i < 8; ++i) s += v[i];
        const float mean = wsum(s) * (1.0f / 512.0f);
        float q2 = 0.f;
#pragma unroll
        for (int i = 0; i < 8; ++i) { const float d = v[i] - mean; q2 += d * d; }
        const float rstd = rsqrtf(wsum(q2) * (1.0f / 512.0f) + EPS);
        if (l == 0) { stat[j * 2] = mean; stat[j * 2 + 1] = rstd; }
    }
    const float* Wh = p.sgu_w + ((size_t)layer * 4 + h) * 128 * 128;
    {
        float4 wv[16];
#pragma unroll
        for (int q = 0; q < 16; ++q) wv[q] = *(const float4*)(Wh + (size_t)(tid + 256 * q) * 4);
#pragma unroll
        for (int q = 0; q < 16; ++q) {
            const int f = tid + 256 * q, i = f >> 5, j4 = (f & 31) * 4;
            const float x4[4] = {wv[q].x, wv[q].y, wv[q].z, wv[q].w};
#pragma unroll
            for (int e = 0; e < 4; ++e) wtb[(j4 + e) * RSB + i] = (i >= j4 + e) ? f2bf(x4[e]) : (bf16_t)0;
        }
    }
    __syncthreads();
    {
        const float* lg = p.sln_g + layer * 512 + h * 128; const float* lb = p.sln_b + layer * 512 + h * 128;
        uint4 vr[8];
#pragma unroll
        for (int q = 0; q < 8; ++q) { const int f = tid + 256 * q, j = f >> 4, d8 = (f & 15) * 8; vr[q] = *(const uint4*)(p.PROJ() + (size_t)(tb + j) * LDP + C_SV + h * 128 + d8); }
#pragma unroll
        for (int q = 0; q < 8; ++q) {
            const int f = tid + 256 * q, j = f >> 4, d8 = (f & 15) * 8;
            const float mean = stat[j * 2], rstd = stat[j * 2 + 1];
            const float4 g0 = *(const float4*)(lg + d8), g1 = *(const float4*)(lg + d8 + 4), b0 = *(const float4*)(lb + d8), b1 = *(const float4*)(lb + d8 + 4);
            uint4 o;
            o.x = pk2((lo2f(vr[q].x) - mean) * rstd * g0.x + b0.x, (hi2f(vr[q].x) - mean) * rstd * g0.y + b0.y);
            o.y = pk2((lo2f(vr[q].y) - mean) * rstd * g0.z + b0.z, (hi2f(vr[q].y) - mean) * rstd * g0.w + b0.w);
            o.z = pk2((lo2f(vr[q].z) - mean) * rstd * g1.x + b1.x, (hi2f(vr[q].z) - mean) * rstd * g1.y + b1.y);
            o.w = pk2((lo2f(vr[q].w) - mean) * rstd * g1.z + b1.z, (hi2f(vr[q].w) - mean) * rstd * g1.w + b1.w);
            *(uint4*)(vtb + j * RSB + d8) = o;
        }
    }
    __syncthreads();
    const int ti = tid >> 4, td = tid & 15;
    float acc[8][8];
#pragma unroll
    for (int a = 0; a < 8; ++a)
#pragma unroll
        for (int bq = 0; bq < 8; ++bq) acc[a][bq] = 0.f;
    const int jend = w * 32 + 32;
#pragma unroll 2
    for (int j = 0; j < jend; ++j) {
        const uint4 wr = *(const uint4*)(wtb + j * RSB + ti * 8), vr = *(const uint4*)(vtb + j * RSB + td * 8);
        const float wv[8] = {lo2f(wr.x), hi2f(wr.x), lo2f(wr.y), hi2f(wr.y), lo2f(wr.z), hi2f(wr.z), lo2f(wr.w), hi2f(wr.w)};
        const float vv[8] = {lo2f(vr.x), hi2f(vr.x), lo2f(vr.y), hi2f(vr.y), lo2f(vr.z), hi2f(vr.z), lo2f(vr.w), hi2f(vr.w)};
#pragma unroll
        for (int a = 0; a < 8; ++a)
#pragma unroll
            for (int bq = 0; bq < 8; ++bq) acc[a][bq] += wv[a] * vv[bq];
    }
#pragma unroll
    for (int a = 0; a < 8; ++a) {
        const int i = ti * 8 + a; const size_t t = tb + i;
        const float bs = p.sgu_b[((size_t)layer * 4 + h) * 128 + i];
        const uint4 ur = *(const uint4*)(p.PROJ() + t * LDP + C_SU + h * 128 + td * 8);
        const float u[8] = {lo2f(ur.x), hi2f(ur.x), lo2f(ur.y), hi2f(ur.y), lo2f(ur.z), hi2f(ur.z), lo2f(ur.w), hi2f(ur.w)};
        float y[8];
#pragma unroll
        for (int bq = 0; bq < 8; ++bq) y[bq] = u[bq] * (acc[a][bq] + bs);
        uint4 o; o.x = pk2(y[0], y[1]); o.y = pk2(y[2], y[3]); o.z = pk2(y[4], y[5]); o.w = pk2(y[6], y[7]);
        *(uint4*)(p.Y() + t * D + 512 + h * 128 + td * 8) = o;
    }
    __syncthreads();
}

DEV void st_vtrans(const P& p, int unit, char* smem) {
    bf16_t* tile = (bf16_t*)smem;
    const int which = unit & 1, tt0 = (unit >> 1) * 64, tid = tidx();
    const int col0 = which ? C_NVW : C_NVS;
    bf16_t* dst = which ? p.VWT() : p.VST();
#pragma unroll
    for (int q = 0; q < 4; ++q) {
        const int e = tid + 256 * q; const int r = e >> 4, c8 = e & 15;
        const uint4 raw = *(const uint4*)(p.PROJ() + (size_t)(tt0 + r) * LDP + col0 + c8 * 8);
        unsigned* d32 = (unsigned*)(tile + r * 130 + c8 * 8);
        d32[0] = raw.x; d32[1] = raw.y; d32[2] = raw.z; d32[3] = raw.w;
    }
    __syncthreads();
    const int d = tid >> 1, half = tid & 1;
    unsigned o[16];
#pragma unroll
    for (int i = 0; i < 16; ++i) {
        const unsigned a = tile[(half * 32 + 2 * i) * 130 + d], b = tile[(half * 32 + 2 * i + 1) * 130 + d];
        o[i] = a | (b << 16);
    }
    uint4* dp = (uint4*)(dst + (size_t)d * T + tt0 + half * 32);
#pragma unroll
    for (int i = 0; i < 4; ++i) dp[i] = make_uint4(o[4 * i], o[4 * i + 1], o[4 * i + 2], o[4 * i + 3]);
    __syncthreads();
}

DEV void st_prep(const P& p, int layer, int unit) {
    const int tid_ = tidx(); const int w = tid_ >> 6, l = tid_ & 63; const size_t t = (size_t)unit * 4 + w;
    const bf16_t* row = p.PROJ() + t * LDP;
    const float* rc = p.ropeC() + t * 24; const float* rs_ = p.ropeS() + t * 24;
    unsigned raw[11];
#pragma unroll
    for (int h = 0; h < 4; ++h) { raw[h] = *(const unsigned*)(row + C_NQ + h * 128 + 2 * l); raw[6 + h] = *(const unsigned*)(row + C_DQ + h * 128 + 2 * l); }
    raw[4] = *(const unsigned*)(row + C_NKS + 2 * l); raw[5] = *(const unsigned*)(row + C_NKW + 2 * l); raw[10] = *(const unsigned*)(row + C_DK + 2 * l);
    bf16_t iraw[9];
#pragma unroll
    for (int h = 0; h < 9; ++h) iraw[h] = row[(h < 8 ? C_IQ + h * 64 : C_IK) + l];
    const float gq0 = p.nsa_qg[layer * 128 + 2 * l], gq1 = p.nsa_qg[layer * 128 + 2 * l + 1];
    const float gs0 = p.nsa_kg[(layer * 3 + 1) * 128 + 2 * l], gs1 = p.nsa_kg[(layer * 3 + 1) * 128 + 2 * l + 1];
    const float gw0 = p.nsa_kg[(layer * 3 + 2) * 128 + 2 * l], gw1 = p.nsa_kg[(layer * 3 + 2) * 128 + 2 * l + 1];
    const float dq0 = p.dsa_qg[layer * 128 + 2 * l], dq1 = p.dsa_qg[layer * 128 + 2 * l + 1];
    const float dk0 = p.dsa_kg[layer * 128 + 2 * l], dk1 = p.dsa_kg[layer * 128 + 2 * l + 1];
    const float c0 = rc[(2 * l) & 15], c1 = rc[(2 * l + 1) & 15], s0 = rs_[(2 * l) & 15], s1 = rs_[(2 * l + 1) & 15];
    const float ic = rc[16 + (l & 7)], is = rs_[16 + (l & 7)];
    float x0[11], x1[11], ss[11];
#pragma unroll
    for (int h = 0; h < 11; ++h) { x0[h] = lo2f(raw[h]); x1[h] = hi2f(raw[h]); ss[h] = x0[h] * x0[h] + x1[h] * x1[h]; }
#pragma unroll
    for (int h = 0; h < 11; ++h) ss[h] = wsum(ss[h]);
#pragma unroll
    for (int h = 0; h < 11; ++h) {
        const float r = rsqrtf(ss[h] * (1.0f / 128.0f) + EPS);
        const float g0 = h < 4 ? gq0 : (h == 4 ? gs0 : (h == 5 ? gw0 : (h < 10 ? dq0 : dk0)));
        const float g1 = h < 4 ? gq1 : (h == 4 ? gs1 : (h == 5 ? gw1 : (h < 10 ? dq1 : dk1)));
        const float n0 = x0[h] * r * g0, n1 = x1[h] * r * g1;
        const float o0 = __shfl_xor(n0, 8), o1 = __shfl_xor(n1, 8);
        float r0 = n0, r1 = n1;
        if (l < 8) { r0 = n0 * c0 - o0 * s0; r1 = n1 * c1 - o1 * s1; }
        else if (l < 16) { r0 = n0 * c0 + o0 * s0; r1 = n1 * c1 + o1 * s1; }
        const unsigned roped = pk2(r0, r1);
        if (h < 4) { *(unsigned*)(p.QN() + (t * 4 + h) * 128 + 2 * l) = pk2(n0, n1); *(unsigned*)(p.QR() + (t * 4 + h) * 128 + 2 * l) = roped; }
        else if (h == 4) *(unsigned*)(p.KS() + t * 128 + 2 * l) = roped;
        else if (h == 5) *(unsigned*)(p.KW() + t * 128 + 2 * l) = roped;
        else if (h < 10) *(unsigned*)(p.DQ() + (t * 4 + (h - 6)) * 128 + 2 * l) = roped;
        else *(unsigned*)(p.DK() + t * 128 + 2 * l) = roped;
    }
    if (l < 12) p.GATES()[t * 12 + l] = sigmoidf_(bf2f(row[C_NG + l]));
    *(unsigned*)(p.DVC() + t * 128 + 2 * l) = *(const unsigned*)(row + C_DV + 2 * l);
#pragma unroll
    for (int h = 0; h < 9; ++h) {
        const float x = bf2f(iraw[h]);
        const float other = __shfl_xor(x, 8);
        float o = x;
        if (l < 16) o = (l < 8) ? (x * ic - other * is) : (x * ic + other * is);
        if (h < 8) p.IQ()[(t * 8 + h) * 64 + l] = f2bf(o); else p.IK()[t * 64 + l] = f2bf(o);
    }
    if (l < 8) p.IW()[t * 8 + l] = bf2f(row[C_IW + l]) * (0.35355339059327373f * 0.125f);
}

DEV void st_compress(const P& p, int layer, int unit, char* smem) {
    const int which = unit & 1, rt = unit >> 1, tid = tidx(), w = tid >> 6, l = tid & 63, fr = l & 15, fq = l >> 4;
    float* hid = (float*)smem;
    float* ob = hid + 16 * 128;
    const int nb = rt * 16 + fr;
    const int col0 = which ? C_NVC : C_NKC;
    const float* ps = p.cmp_pos + ((size_t)layer * 2 + which) * 4096;
    const bf16_t* w1t = p.W1T() + ((size_t)layer * 2 + which) * 128 * 4096;
    const bool rowok = nb < 511;
    const bf16_t* xrow = p.KVC() + (size_t)(rowok ? nb * 16 : 0) * 256 + (which ? 128 : 0);
    f32x4 acc[2] = {(f32x4){0.f, 0.f, 0.f, 0.f}, (f32x4){0.f, 0.f, 0.f, 0.f}};
#pragma unroll 8
    for (int ks = 0; ks < 128; ++ks) {
        const int k = ks * 32 + fq * 8, lt = k >> 7, d = k & 127;
        const uint4 xr = *(const uint4*)(xrow + (size_t)lt * 256 + d);
        const float4 p0 = *(const float4*)(ps + k), p1 = *(const float4*)(ps + k + 4);
        union { bf16x8 v; unsigned u32[4]; } a;
        a.u32[0] = pk2(lo2f(xr.x) + p0.x, hi2f(xr.x) + p0.y); a.u32[1] = pk2(lo2f(xr.y) + p0.z, hi2f(xr.y) + p0.w);
        a.u32[2] = pk2(lo2f(xr.z) + p1.x, hi2f(xr.z) + p1.y); a.u32[3] = pk2(lo2f(xr.w) + p1.z, hi2f(xr.w) + p1.w);
#pragma unroll
        for (int nt = 0; nt < 2; ++nt) {
            const bf16x8 b = *(const bf16x8*)(w1t + (size_t)(w * 32 + nt * 16 + fr) * 4096 + k);
            acc[nt] = mfma16(a.v, b, acc[nt]);
        }
    }
#pragma unroll
    for (int nt = 0; nt < 2; ++nt)
#pragma unroll
        for (int r = 0; r < 4; ++r) hid[(4 * fq + r) * 128 + w * 32 + nt * 16 + fr] = gelu_tanh(acc[nt][r]);
    __syncthreads();
    const float* w2 = p.cmp_w2 + ((size_t)layer * 2 + which) * 128 * 128;
    const int c2 = tid & 127, mh = tid >> 7;
    float o[8];
#pragma unroll
    for (int b = 0; b < 8; ++b) o[b] = 0.f;
#pragma unroll 1
    for (int k0 = 0; k0 < 128; k0 += 32) {
        float wv[32];
#pragma unroll
        for (int k = 0; k < 32; ++k) wv[k] = w2[(k0 + k) * 128 + c2];
#pragma unroll
        for (int k4 = 0; k4 < 8; ++k4)
#pragma unroll
            for (int b = 0; b < 8; ++b) {
                const float4 h4 = *(const float4*)(hid + (mh * 8 + b) * 128 + k0 + k4 * 4);
                o[b] += h4.x * wv[4 * k4] + h4.y * wv[4 * k4 + 1] + h4.z * wv[4 * k4 + 2] + h4.w * wv[4 * k4 + 3];
            }
    }
#pragma unroll
    for (int b = 0; b < 8; ++b) ob[(mh * 8 + b) * 128 + c2] = o[b];
    __syncthreads();
#pragma unroll
    for (int q = 0; q < 4; ++q) {
        const int b = w * 4 + q, nbo = rt * 16 + b;
        float v0 = ob[b * 128 + l], v1 = ob[b * 128 + l + 64];
        if (which == 0) {
            const float r = rsqrtf(wsum(v0 * v0 + v1 * v1) * (1.0f / 128.0f) + EPS);
            const float* kg = p.nsa_kg + (layer * 3 + 0) * 128;
            v0 = v0 * r * kg[l]; v1 = v1 * r * kg[l + 64];
            if (nbo >= 511) { v0 = 0.f; v1 = 0.f; }
            p.KC()[nbo * 128 + l] = f2bf(v0); p.KC()[nbo * 128 + l + 64] = f2bf(v1);
        } else {
            if (nbo >= 511) { v0 = 0.f; v1 = 0.f; }
            p.VCT()[l * 512 + nbo] = f2bf(v0); p.VCT()[(l + 64) * 512 + nbo] = f2bf(v1);
        }
    }
    __syncthreads();
}

DEV void st_nsa_cmp(const P& p, int unit, char* smem) {
    constexpr int RSK = 272, RSV = 136, BUFB = 64 * RSK + 128 * RSV;
    const int tid = tidx(), w = tid >> 6, l = tid & 63, qc = l & 15, g4 = l >> 4;
    const int t0 = unit * 16 + w * 4;
    const int tk = qc >> 2, hd = qc & 3, t = t0 + tk;
    bf16x8 qf[4];
#pragma unroll
    for (int ks = 0; ks < 4; ++ks) qf[ks] = *(const bf16x8*)(p.QN() + ((size_t)t0 * 4 + qc) * 128 + ks * 32 + g4 * 8);
    const int tmaxb = unit * 16 + 15;
    const int nvb = tmaxb >= 31 ? (tmaxb - 31) / 16 + 1 : 0;
    const int nsteps = (nvb + 63) >> 6;
    const int nvis = t >= 31 ? (t - 31) / 16 + 1 : 0;
    const float cs = 0.08838834764831845f * 1.4426950408889634f;
    const int krow = tid >> 4, kc16 = tid & 15, vrow = tid >> 3, vc16 = tid & 7;
    const bf16_t* Kg = p.KC(); const bf16_t* Vg = p.VCT();
    int gstep = 0;
    uint4 rk0, rk1, rk2, rk3, rv0, rv1, rv2, rv3;
#define CMP_LOADK(ST) do { const bf16_t* kb = Kg + (size_t)((ST) * 64 + krow) * 128 + kc16 * 8; \
        rk0 = *(const uint4*)kb; rk1 = *(const uint4*)(kb + 16 * 128); rk2 = *(const uint4*)(kb + 32 * 128); rk3 = *(const uint4*)(kb + 48 * 128); } while (0)
#define CMP_LOADV(ST) do { const bf16_t* vb = Vg + (size_t)vrow * 512 + (ST) * 64 + vc16 * 8; \
        rv0 = *(const uint4*)vb; rv1 = *(const uint4*)(vb + 32 * 512); rv2 = *(const uint4*)(vb + 64 * 512); rv3 = *(const uint4*)(vb + 96 * 512); } while (0)
#define CMP_STOREK(KT) do { *(uint4*)((KT) + krow * RSK + kc16 * 16) = rk0; *(uint4*)((KT) + (krow + 16) * RSK + kc16 * 16) = rk1; \
        *(uint4*)((KT) + (krow + 32) * RSK + kc16 * 16) = rk2; *(uint4*)((KT) + (krow + 48) * RSK + kc16 * 16) = rk3; } while (0)
#define CMP_STOREV(VT) do { *(uint4*)((VT) + vrow * RSV + vc16 * 16) = rv0; *(uint4*)((VT) + (vrow + 32) * RSV + vc16 * 16) = rv1; \
        *(uint4*)((VT) + (vrow + 64) * RSV + vc16 * 16) = rv2; *(uint4*)((VT) + (vrow + 96) * RSV + vc16 * 16) = rv3; } while (0)
    float m = -1e30f, lsum = 0.f;
    if (nsteps > 0) CMP_LOADK(0);
#pragma unroll 1
    for (int st = 0; st < nsteps; ++st, ++gstep) {
        char* Kt = smem + (gstep & 1) * BUFB;
        CMP_STOREK(Kt);
        __syncthreads();
        if (st + 1 < nsteps) CMP_LOADK(st + 1);
        float mx = m; f32x4 sv[4];
#pragma unroll
        for (int sub = 0; sub < 4; ++sub) {
            f32x4 a4 = (f32x4){0.f, 0.f, 0.f, 0.f};
#pragma unroll
            for (int ks = 0; ks < 4; ++ks) a4 = mfma16(*(const bf16x8*)(Kt + (sub * 16 + qc) * RSK + (ks * 32 + g4 * 8) * 2), qf[ks], a4);
#pragma unroll
            for (int r = 0; r < 4; ++r) { const int key = st * 64 + sub * 16 + 4 * g4 + r; a4[r] = (key < nvis) ? a4[r] * cs : -3e38f; mx = fmaxf(mx, a4[r]); }
            sv[sub] = a4;
        }
        float ps = 0.f;
#pragma unroll
        for (int sub = 0; sub < 4; ++sub)
#pragma unroll
            for (int r = 0; r < 4; ++r) ps += __builtin_amdgcn_exp2f(sv[sub][r] - mx);
        lsum = lsum * __builtin_amdgcn_exp2f(m - mx) + ps; m = mx;
    }
    {
        float mt_ = fmaxf(m, __shfl_xor(m, 16)); mt_ = fmaxf(mt_, __shfl_xor(mt_, 32));
        lsum *= __builtin_amdgcn_exp2f(m - mt_); m = mt_;
        lsum += __shfl_xor(lsum, 16); lsum += __shfl_xor(lsum, 32);
    }
    const float inv = (nvis > 0 && lsum > 0.f) ? 1.0f / lsum : 0.f;
    f32x4 o[8];
#pragma unroll
    for (int mt = 0; mt < 8; ++mt) o[mt] = (f32x4){0.f, 0.f, 0.f, 0.f};
    float yprev = 0.f;
    float impv[32];
#pragma unroll
    for (int i = 0; i < 32; ++i) impv[i] = 0.f;
    if (nsteps > 0) { CMP_LOADK(0); CMP_LOADV(0); }
#pragma unroll
    for (int st = 0; st < 8; ++st) {
        if (st < nsteps) {
            char* Kt = smem + (gstep & 1) * BUFB; char* Vt = Kt + 64 * RSK; ++gstep;
            CMP_STOREK(Kt); CMP_STOREV(Vt);
            __syncthreads();
            if (st + 1 < nsteps) { CMP_LOADK(st + 1); CMP_LOADV(st + 1); }
            f32x4 sv[4];
#pragma unroll
            for (int sub = 0; sub < 4; ++sub) {
                f32x4 a4 = (f32x4){0.f, 0.f, 0.f, 0.f};
#pragma unroll
                for (int ks = 0; ks < 4; ++ks) a4 = mfma16(*(const bf16x8*)(Kt + (sub * 16 + qc) * RSK + (ks * 32 + g4 * 8) * 2), qf[ks], a4);
#pragma unroll
                for (int r = 0; r < 4; ++r) { const int key = st * 64 + sub * 16 + 4 * g4 + r; a4[r] = (key < nvis) ? __builtin_amdgcn_exp2f(a4[r] * cs - m) * inv : 0.f; }
                const float y = __shfl(a4[3], (l + 48) & 63);
                float iv = (a4[0] + a4[1]) + (a4[2] + a4[3]) + (g4 > 0 ? y : yprev);
                yprev = y;
                iv += __shfl_xor(iv, 1); iv += __shfl_xor(iv, 2);
                impv[st * 4 + sub] = iv;
                sv[sub] = a4;
            }
#pragma unroll
            for (int pr = 0; pr < 2; ++pr) {
                union { bf16x8 v; unsigned u32[4]; } bb;
                bb.u32[0] = pk2(sv[2 * pr][0], sv[2 * pr][1]); bb.u32[1] = pk2(sv[2 * pr][2], sv[2 * pr][3]);
                bb.u32[2] = pk2(sv[2 * pr + 1][0], sv[2 * pr + 1][1]); bb.u32[3] = pk2(sv[2 * pr + 1][2], sv[2 * pr + 1][3]);
#pragma unroll
                for (int mt = 0; mt < 8; ++mt) {
                    const char* vp = Vt + (mt * 16 + qc) * RSV + (pr * 32 + 4 * g4) * 2;
                    union { bf16x8 v; uint2 h2[2]; } aa;
                    aa.h2[0] = *(const uint2*)vp; aa.h2[1] = *(const uint2*)(vp + 32);
                    o[mt] = mfma16(aa.v, bb.v, o[mt]);
                }
            }
        }
    }
#undef CMP_LOADK
#undef CMP_LOADV
#undef CMP_STOREK
#undef CMP_STOREV
    __syncthreads();
    float* impl = (float*)smem + w * 512;
    if (hd == 0) {
#pragma unroll
        for (int i = 0; i < 32; ++i) impl[tk * 128 + 4 * i + g4] = impv[i];
    }
#pragma unroll
    for (int mt = 0; mt < 8; ++mt) {
        uint2 ov; ov.x = pk2(o[mt][0], o[mt][1]); ov.y = pk2(o[mt][2], o[mt][3]);
        *(uint2*)(p.OCMP() + ((size_t)t * 4 + hd) * 128 + mt * 16 + 4 * g4) = ov;
    }
    __syncthreads();
    const int li = hd + 4 * g4, cur = t >> 6;
    unsigned long long own[8]; int rank[8];
#pragma unroll
    for (int i = 0; i < 8; ++i) {
        const int j = li + 16 * i; const float v = impl[tk * 128 + j];
        const unsigned k32 = (j == 0 || j == cur || j == cur - 1) ? 0xFFFFFFFFu : (j > cur ? 0u : __float_as_uint(v) + 128u);
        own[i] = ((unsigned long long)k32 << 7) | (unsigned)(127 - j); rank[i] = 0;
    }
#pragma unroll 1
    for (int ip = 0; ip < 8; ++ip) {
#pragma unroll
        for (int q4 = 0; q4 < 4; ++q4) {
            const float4 ov = *(const float4*)(impl + tk * 128 + ip * 16 + q4 * 4);
            const float o4[4] = {ov.x, ov.y, ov.z, ov.w};
#pragma unroll
            for (int e = 0; e < 4; ++e) {
                const int jp = ip * 16 + q4 * 4 + e;
                const unsigned k32 = (jp == 0 || jp == cur || jp == cur - 1) ? 0xFFFFFFFFu : (jp > cur ? 0u : __float_as_uint(o4[e]) + 128u);
                const unsigned long long kp = ((unsigned long long)k32 << 7) | (unsigned)(127 - jp);
#pragma unroll
                for (int i = 0; i < 8; ++i) rank[i] += (kp > own[i]) ? 1 : 0;
            }
        }
    }
    unsigned mw[4] = {0u, 0u, 0u, 0u};
#pragma unroll
    for (int i = 0; i < 8; ++i) if (rank[i] < 16) mw[i >> 1] |= 1u << (li + 16 * (i & 1));
#pragma unroll
    for (int q = 0; q < 4; ++q) {
        unsigned v = mw[q];
        v |= __shfl_xor(v, 1); v |= __shfl_xor(v, 2); v |= __shfl_xor(v, 16); v |= __shfl_xor(v, 32);
        mw[q] = v;
    }
    if (li == 0) *(uint4*)(p.SEL() + (size_t)t * 4) = make_uint4(mw[0], mw[1], mw[2], mw[3]);
    __syncthreads();
}

DEV void st_nsa_attn(const P& p, int unit, char* smem) {
    constexpr int RSK = 272, RSV = 136, BUFB = 64 * RSK + 128 * RSV;
    const int tid = tidx(), w = tid >> 6, l = tid & 63, qc = l & 15, g4 = l >> 4;
    const int tq0 = unit * 16, t = tq0 + w * 4 + (qc >> 2), hd = qc & 3;
    bf16x8 qf[4];
#pragma unroll
    for (int ks = 0; ks < 4; ++ks) qf[ks] = *(const bf16x8*)(p.QR() + ((size_t)t * 4 + hd) * 128 + ks * 32 + g4 * 8);
    const uint4 selw = *(const uint4*)(p.SEL() + (size_t)t * 4);
    const float cs = 0.08838834764831845f * 1.4426950408889634f;
    unsigned part[8][2];
#pragma unroll
    for (int mt = 0; mt < 8; ++mt) { part[mt][0] = 0u; part[mt][1] = 0u; }
    const float g0 = p.GATES()[(size_t)t * 12 + hd * 3];
    int gstep = 0;
    const int krow = tid >> 4, kc16 = tid & 15, vrow = tid >> 3, vc16 = tid & 7;
#pragma unroll 1
    for (int br = 0; br < 2; ++br) {
        const bf16_t* Kg = br ? p.KW() : p.KS(); const bf16_t* Vg = br ? p.VWT() : p.VST();
        const int ktlast = (tq0 + 15) >> 6;
        const int ktfirst = br ? ((tq0 - 511 > 0 ? tq0 - 511 : 0) >> 6) : 0;
        const int nk = ktlast - ktfirst + 1;
        f32x4 o[8];
#pragma unroll
        for (int mt = 0; mt < 8; ++mt) o[mt] = (f32x4){0.f, 0.f, 0.f, 0.f};
        float m = -1e30f, lsum = 0.f;
        uint4 rk0, rk1, rk2, rk3, rv0, rv1, rv2, rv3;
#define NSA_LOAD(KT) do { const bf16_t* kb = Kg + (size_t)((KT) * 64 + krow) * 128 + kc16 * 8; const bf16_t* vb = Vg + (size_t)vrow * T + (KT) * 64 + vc16 * 8; \
        rk0 = *(const uint4*)kb; rk1 = *(const uint4*)(kb + 16 * 128); rk2 = *(const uint4*)(kb + 32 * 128); rk3 = *(const uint4*)(kb + 48 * 128); \
        rv0 = *(const uint4*)vb; rv1 = *(const uint4*)(vb + (size_t)32 * T); rv2 = *(const uint4*)(vb + (size_t)64 * T); rv3 = *(const uint4*)(vb + (size_t)96 * T); } while (0)
        NSA_LOAD(ktfirst);
#pragma unroll 1
        for (int i = 0; i < nk; ++i, ++gstep) {
            const int kt = ktfirst + i;
            char* Kt = smem + (gstep & 1) * BUFB; char* Vt = Kt + 64 * RSK;
            *(uint4*)(Kt + krow * RSK + kc16 * 16) = rk0; *(uint4*)(Kt + (krow + 16) * RSK + kc16 * 16) = rk1;
            *(uint4*)(Kt + (krow + 32) * RSK + kc16 * 16) = rk2; *(uint4*)(Kt + (krow + 48) * RSK + kc16 * 16) = rk3;
            *(uint4*)(Vt + vrow * RSV + vc16 * 16) = rv0; *(uint4*)(Vt + (vrow + 32) * RSV + vc16 * 16) = rv1;
            *(uint4*)(Vt + (vrow + 64) * RSV + vc16 * 16) = rv2; *(uint4*)(Vt + (vrow + 96) * RSV + vc16 * 16) = rv3;
            __syncthreads();
            if (i + 1 < nk) NSA_LOAD(kt + 1);
            int lo, hi = t;
            if (br == 0) {
                const unsigned wv = (kt & 64) ? ((kt & 32) ? selw.w : selw.z) : ((kt & 32) ? selw.y : selw.x);
                lo = 0; hi = ((wv >> (kt & 31)) & 1u) ? t : -1;
            } else lo = t - 511;
            const bool interior = (kt * 64 + 63 <= tq0) && (br == 0 || kt * 64 >= tq0 + 15 - 511);
            f32x4 sv[4];
            float mx = -3e38f;
            if (interior) {
                const float csl = hi >= 0 ? cs : 0.f, add = hi >= 0 ? 0.f : -3e38f;
#pragma unroll
                for (int sub = 0; sub < 4; ++sub) {
                    f32x4 a4 = (f32x4){0.f, 0.f, 0.f, 0.f};
#pragma unroll
                    for (int ks = 0; ks < 4; ++ks) a4 = mfma16(*(const bf16x8*)(Kt + (sub * 16 + qc) * RSK + (ks * 32 + g4 * 8) * 2), qf[ks], a4);
#pragma unroll
                    for (int r = 0; r < 4; ++r) { a4[r] = a4[r] * csl + add; mx = fmaxf(mx, a4[r]); }
                    sv[sub] = a4;
                }
            } else {
#pragma unroll
                for (int sub = 0; sub < 4; ++sub) {
                    f32x4 a4 = (f32x4){0.f, 0.f, 0.f, 0.f};
#pragma unroll
                    for (int ks = 0; ks < 4; ++ks) a4 = mfma16(*(const bf16x8*)(Kt + (sub * 16 + qc) * RSK + (ks * 32 + g4 * 8) * 2), qf[ks], a4);
#pragma unroll
                    for (int r = 0; r < 4; ++r) {
                        const int kp = kt * 64 + sub * 16 + 4 * g4 + r;
                        const bool valid = (kp >= lo) & (kp <= hi);
                        a4[r] = valid ? a4[r] * cs : -3e38f;
                        mx = fmaxf(mx, a4[r]);
                    }
                    sv[sub] = a4;
                }
            }
            mx = fmaxf(mx, __shfl_xor(mx, 16)); mx = fmaxf(mx, __shfl_xor(mx, 32));
            const float mnew = fmaxf(fmaxf(m, mx), -1e30f);
            const float alpha = __builtin_amdgcn_exp2f(m - mnew);
            m = mnew;
            float ps = 0.f;
#pragma unroll
            for (int sub = 0; sub < 4; ++sub)
#pragma unroll
                for (int r = 0; r < 4; ++r) { const float pv = __builtin_amdgcn_exp2f(sv[sub][r] - mnew); sv[sub][r] = pv; ps += pv; }
            lsum = lsum * alpha + ps;
            if (__any(alpha != 1.0f)) {
#pragma unroll
                for (int mt = 0; mt < 8; ++mt) o[mt] *= alpha;
            }
#pragma unroll
            for (int pr = 0; pr < 2; ++pr) {
                union { bf16x8 v; unsigned u32[4]; } bb;
                bb.u32[0] = pk2(sv[2 * pr][0], sv[2 * pr][1]); bb.u32[1] = pk2(sv[2 * pr][2], sv[2 * pr][3]);
                bb.u32[2] = pk2(sv[2 * pr + 1][0], sv[2 * pr + 1][1]); bb.u32[3] = pk2(sv[2 * pr + 1][2], sv[2 * pr + 1][3]);
#pragma unroll
                for (int mt = 0; mt < 8; ++mt) {
                    const char* vp = Vt + (mt * 16 + qc) * RSV + (pr * 32 + 4 * g4) * 2;
                    union { bf16x8 v; uint2 h2[2]; } aa;
                    aa.h2[0] = *(const uint2*)vp; aa.h2[1] = *(const uint2*)(vp + 32);
                    o[mt] = mfma16(aa.v, bb.v, o[mt]);
                }
            }
        }
#undef NSA_LOAD
        lsum += __shfl_xor(lsum, 16); lsum += __shfl_xor(lsum, 32);
        const float gate = p.GATES()[(size_t)t * 12 + hd * 3 + 1 + br];
        const float sc = lsum > 0.f ? gate / lsum : 0.f;
        if (br == 0) {
#pragma unroll
            for (int mt = 0; mt < 8; ++mt) {
                const uint2 oc = *(const uint2*)(p.OCMP() + ((size_t)t * 4 + hd) * 128 + mt * 16 + 4 * g4);
                part[mt][0] = pk2(sc * o[mt][0] + g0 * lo2f(oc.x), sc * o[mt][1] + g0 * hi2f(oc.x));
                part[mt][1] = pk2(sc * o[mt][2] + g0 * lo2f(oc.y), sc * o[mt][3] + g0 * hi2f(oc.y));
            }
        } else {
#pragma unroll
            for (int mt = 0; mt < 8; ++mt) {
                uint2 ov;
                ov.x = pk2(sc * o[mt][0] + lo2f(part[mt][0]), sc * o[mt][1] + hi2f(part[mt][0]));
                ov.y = pk2(sc * o[mt][2] + lo2f(part[mt][1]), sc * o[mt][3] + hi2f(part[mt][1]));
                *(uint2*)(p.Y() + (size_t)t * D + 1024 + hd * 128 + mt * 16 + 4 * g4) = ov;
            }
        }
    }
    __syncthreads();
}

DEV unsigned f2key(float f) { const unsigned u = __float_as_uint(f); return (u & 0x80000000u) ? ~u : (u | 0x80000000u); }
DEV float key2f(unsigned k) { const unsigned u = (k & 0x80000000u) ? (k & 0x7fffffffu) : ~k; return __uint_as_float(u); }
template <int NPASS>
DEV float wave_prune_t(float* sc, unsigned short* ix, unsigned* hist, int m, int l, int& kept) {
    float v[8]; unsigned k[8]; unsigned short id[8]; bool ok[8];
#pragma unroll
    for (int i = 0; i < 8; ++i) {
        const int e = l + 64 * i; ok[i] = e < m;
        v[i] = ok[i] ? sc[e] : 0.f; id[i] = ok[i] ? ix[e] : (unsigned short)0; k[i] = f2key(v[i]);
    }
    unsigned prefix = 0u; int need = 256;
#pragma unroll 1
    for (int pass = 0; pass < NPASS; ++pass) {
        const int shift = 24 - 8 * pass;
        *(uint4*)(hist + 4 * l) = make_uint4(0u, 0u, 0u, 0u);
        __builtin_amdgcn_wave_barrier();
#pragma unroll
        for (int i = 0; i < 8; ++i) {
            const bool in = ok[i] && (pass == 0 || (k[i] >> (shift + 8)) == prefix);
            if (in) atomicAdd(&hist[(k[i] >> shift) & 255u], 1u);
        }
        __builtin_amdgcn_wave_barrier();
        const uint4 hv = *(const uint4*)(hist + 4 * l);
        const unsigned hq[4] = {hv.x, hv.y, hv.z, hv.w};
        const unsigned own = hv.x + hv.y + hv.z + hv.w;
        unsigned tot = own;
#pragma unroll
        for (int o = 1; o < 64; o <<= 1) { const unsigned tv = __shfl_down(tot, o); if (l + o < 64) tot += tv; }
        unsigned cum = tot - own; int found = -1; int nneed = 0;
#pragma unroll
        for (int kk = 3; kk >= 0; --kk) {
            const unsigned c = hq[kk];
            if (found < 0 && (int)cum < need && (int)(cum + c) >= need) { found = 4 * l + kk; nneed = need - (int)cum; }
            cum += c;
        }
        const unsigned long long bal = __ballot(found >= 0);
        const int src = __ffsll((long long)bal) - 1;
        const int digit = __shfl(found, src); need = __shfl(nneed, src);
        prefix = (prefix << 8) | (unsigned)digit;
    }
    int base = 0;
    const unsigned long long ltmask = (1ull << l) - 1ull;
    if (NPASS == 4) {
        const unsigned thr = prefix;
        int ties = 0;
#pragma unroll
        for (int i = 0; i < 8; ++i) {
            const bool gt = ok[i] && k[i] > thr, eq = ok[i] && k[i] == thr;
            const unsigned long long em = __ballot(eq);
            const int trank = ties + __popcll(em & ltmask);
            const bool keep = gt || (eq && trank < need);
            ties += __popcll(em);
            const unsigned long long km = __ballot(keep);
            const int pos = base + __popcll(km & ltmask);
            if (keep) { sc[pos] = v[i]; ix[pos] = id[i]; }
            base += __popcll(km);
        }
        __builtin_amdgcn_wave_barrier();
        kept = base;
        return key2f(thr);
    } else {
        const unsigned lo = prefix << 16;
#pragma unroll
        for (int i = 0; i < 8; ++i) {
            const bool keep = ok[i] && k[i] >= lo;
            const unsigned long long km = __ballot(keep);
            const int pos = base + __popcll(km & ltmask);
            if (keep) { sc[pos] = v[i]; ix[pos] = id[i]; }
            base += __popcll(km);
        }
        __builtin_amdgcn_wave_barrier();
        kept = base;
        return key2f(lo - 1u);
    }
}
DEV float wave_prune(float* sc, unsigned short* ix, unsigned* hist, int m, int l) { int kept; return wave_prune_t<4>(sc, ix, hist, m, l, kept); }
DEV float wave_prune_mid(float* sc, unsigned short* ix, unsigned* hist, int& cnt, int l) {
    int kept; float tau = wave_prune_t<2>(sc, ix, hist, cnt, l, kept);
    if (kept > 352) { tau = wave_prune_t<4>(sc, ix, hist, kept, l, kept); }
    cnt = kept;
    return tau;
}

#define DSA_APPEND2(COND, M64, SV, SCP, IXP, CL, CH) do { \
    const unsigned _ml = (unsigned)(M64), _mh = (unsigned)((M64) >> 32); \
    if (COND) { const int _pos = (h ? (CH) : (CL)) + __popc((h ? _mh : _ml) & ((1u << n) - 1u)); (SCP)[_pos] = (SV); (IXP)[_pos] = (unsigned short)kp; } \
    (CL) += __popc(_ml); (CH) += __popc(_mh); } while (0)
#define DSA_APPEND(SCP, IXP, CNT, M32, MINE, SV) do { \
    const unsigned _m = (M32); \
    if (MINE) { const int _pos = (CNT) + __popc(_m & ((1u << n) - 1u)); (SCP)[_pos] = (SV); (IXP)[_pos] = (unsigned short)kp; } \
    (CNT) += __popc(_m); } while (0)

DEV void st_dsa_index(const P& p, int unit, char* smem) {
    const int tid = tidx(), w = tid >> 6, l = tid & 63, n = l & 31, h = l >> 5;
    char* wb = smem + w * 14336;
    float* sc0 = (float*)wb; float* sc1 = sc0 + 512; float* sc2 = sc1 + 512; float* sc3 = sc2 + 512;
    unsigned short* ix0 = (unsigned short*)(wb + 8192); unsigned short* ix1 = ix0 + 512; unsigned short* ix2 = ix1 + 512; unsigned short* ix3 = ix2 + 512;
    unsigned* hist = (unsigned*)(wb + 12288);
    float* scA = h ? sc2 : sc0; float* scB = h ? sc3 : sc1; unsigned short* ixA = h ? ix2 : ix0; unsigned short* ixB = h ? ix3 : ix1;
    const int wu = unit * 4 + w;
    const int tg = 2047 - wu;
    const int t0 = tg * 4;
    const int tl = 2 * ((n >> 2) & 1) + (n >> 4), hdr = (n & 3) + 4 * ((n >> 3) & 1);
    bf16x8 af[4];
#pragma unroll
    for (int s = 0; s < 4; ++s) af[s] = *(const bf16x8*)(p.IQ() + ((size_t)(t0 + tl) * 8 + hdr) * 64 + 16 * s + 8 * h);
    const int tA = t0 + 2 * h, tB = tA + 1;
    float wA[8], wB[8];
#pragma unroll
    for (int r = 0; r < 8; ++r) { wA[r] = p.IW()[(size_t)tA * 8 + r]; wB[r] = p.IW()[(size_t)tB * 8 + r]; }
    int cnt0 = 0, cnt1 = 0, cnt2 = 0, cnt3 = 0;
    const float NINF = -__builtin_inff();
    float tau0 = NINF, tau1 = NINF, tau2 = NINF, tau3 = NINF;
    const int ntiles = (t0 + 3) / 32 + 1;
    const bf16_t* ikp = p.IK() + (size_t)n * 64 + 8 * h;
    bf16x8 na[4], nb[4];
#pragma unroll
    for (int s = 0; s < 4; ++s) { na[s] = *(const bf16x8*)(ikp + 16 * s); nb[s] = *(const bf16x8*)(ikp + (size_t)(ntiles > 1 ? 32 : 0) * 64 + 16 * s); }
#pragma unroll 1
    for (int kt = 0; kt < ntiles; kt += 2) {
        bf16x8 ca[4], cb[4];
#pragma unroll
        for (int s = 0; s < 4; ++s) { ca[s] = na[s]; cb[s] = nb[s]; }
        {
            const int ka = kt + 2 < ntiles ? kt + 2 : ntiles - 1, kb = kt + 3 < ntiles ? kt + 3 : ntiles - 1;
#pragma unroll
            for (int s = 0; s < 4; ++s) { na[s] = *(const bf16x8*)(ikp + (size_t)ka * 32 * 64 + 16 * s); nb[s] = *(const bf16x8*)(ikp + (size_t)kb * 32 * 64 + 16 * s); }
        }
        f32x16 acca, accb;
#pragma unroll
        for (int r = 0; r < 16; ++r) { acca[r] = 0.f; accb[r] = 0.f; }
#pragma unroll
        for (int s = 0; s < 4; ++s) { acca = mfma32(af[s], ca[s], acca); accb = mfma32(af[s], cb[s], accb); }
        float s0a = 0.f, s1a = 0.f, s0b = 0.f, s1b = 0.f, u0a = 0.f, u1a = 0.f, u0b = 0.f, u1b = 0.f;
#pragma unroll
        for (int r = 0; r < 4; ++r) {
            s0a += wA[r] * fmaxf(acca[r], 0.f); u0a += wA[4 + r] * fmaxf(acca[4 + r], 0.f);
            s1a += wB[r] * fmaxf(acca[8 + r], 0.f); u1a += wB[4 + r] * fmaxf(acca[12 + r], 0.f);
            s0b += wA[r] * fmaxf(accb[r], 0.f); u0b += wA[4 + r] * fmaxf(accb[4 + r], 0.f);
            s1b += wB[r] * fmaxf(accb[8 + r], 0.f); u1b += wB[4 + r] * fmaxf(accb[12 + r], 0.f);
        }
        s0a += u0a; s1a += u1a; s0b += u0b; s1b += u1b;
        const float tauA = h ? tau2 : tau0, tauB = h ? tau3 : tau1;
        {
            const int kp = kt * 32 + n;
            const bool cA = (kp <= tA) && (s0a > tauA), cB = (kp <= tB) && (s1a > tauB);
            const unsigned long long mA = __ballot(cA), mB = __ballot(cB);
            DSA_APPEND2(cA, mA, s0a, scA, ixA, cnt0, cnt2); DSA_APPEND2(cB, mB, s1a, scB, ixB, cnt1, cnt3);
        }
        {
            const int kp = kt * 32 + 32 + n;
            const bool cA = (kp <= tA) && (s0b > tauA), cB = (kp <= tB) && (s1b > tauB);
            const unsigned long long mA = __ballot(cA), mB = __ballot(cB);
            DSA_APPEND2(cA, mA, s0b, scA, ixA, cnt0, cnt2); DSA_APPEND2(cB, mB, s1b, scB, ixB, cnt1, cnt3);
        }
        __builtin_amdgcn_wave_barrier();
        if (max(max(cnt0, cnt1), max(cnt2, cnt3)) > 448) {
            if (cnt0 > 448) tau0 = wave_prune_mid(sc0, ix0, hist, cnt0, l);
            if (cnt1 > 448) tau1 = wave_prune_mid(sc1, ix1, hist, cnt1, l);
            if (cnt2 > 448) tau2 = wave_prune_mid(sc2, ix2, hist, cnt2, l);
            if (cnt3 > 448) tau3 = wave_prune_mid(sc3, ix3, hist, cnt3, l);
        }
    }
    if (cnt0 > 256) { wave_prune(sc0, ix0, hist, cnt0, l); cnt0 = 256; }
    if (cnt1 > 256) { wave_prune(sc1, ix1, hist, cnt1, l); cnt1 = 256; }
    if (cnt2 > 256) { wave_prune(sc2, ix2, hist, cnt2, l); cnt2 = 256; }
    if (cnt3 > 256) { wave_prune(sc3, ix3, hist, cnt3, l); cnt3 = 256; }
    __builtin_amdgcn_wave_barrier();
#pragma unroll
    for (int i = 0; i < 4; ++i) {
        const int e = l + 64 * i;
        p.IDX()[(size_t)(t0 + 0) * 256 + e] = e < cnt0 ? (int)ix0[e] : 0;
        p.IDX()[(size_t)(t0 + 1) * 256 + e] = e < cnt1 ? (int)ix1[e] : 0;
        p.IDX()[(size_t)(t0 + 2) * 256 + e] = e < cnt2 ? (int)ix2[e] : 0;
        p.IDX()[(size_t)(t0 + 3) * 256 + e] = e < cnt3 ? (int)ix3[e] : 0;
    }
    if (l == 0) { p.CNT()[t0] = cnt0; p.CNT()[t0 + 1] = cnt1; p.CNT()[t0 + 2] = cnt2; p.CNT()[t0 + 3] = cnt3; }
}

DEV void st_dsa_attn(const P& p, int unit, char* smem) {
    const int tid = tidx(), w = tid >> 6, l = tid & 63, c = l & 15, g4 = l >> 4;
    int* idxs = (int*)(smem + w * 5120); float* Pl = (float*)(smem + w * 5120 + 1024);
    const size_t t = (size_t)unit * 4 + w;
    const int cnt = p.CNT()[t];
#pragma unroll
    for (int i = 0; i < 4; ++i) idxs[l + 64 * i] = p.IDX()[t * 256 + l + 64 * i];
    __builtin_amdgcn_wave_barrier();
    bf16x8 qf[4];
#pragma unroll
    for (int j = 0; j < 4; ++j) qf[j] = *(const bf16x8*)(p.DQ() + (t * 4 + (c & 3)) * 128 + g4 * 32 + j * 8);
    f32x4 s[16];
    const int ntile = (cnt + 15) >> 4;
#pragma unroll
    for (int th = 0; th < 2; ++th) {
        bf16x8 kf[8][4];
        if (th * 8 < ntile) {
#pragma unroll
            for (int q = 0; q < 8; ++q) {
                const int krow = idxs[(th * 8 + q) * 16 + c];
                const bf16_t* kp = p.DK() + (size_t)krow * 128 + g4 * 32;
#pragma unroll
                for (int j = 0; j < 4; ++j) kf[q][j] = *(const bf16x8*)(kp + j * 8);
            }
        }
#pragma unroll
        for (int q = 0; q < 8; ++q) {
            s[th * 8 + q] = (f32x4){0.f, 0.f, 0.f, 0.f};
            if (th * 8 < ntile) {
#pragma unroll
                for (int j = 0; j < 4; ++j) s[th * 8 + q] = mfma16(kf[q][j], qf[j], s[th * 8 + q]);
            }
        }
        __builtin_amdgcn_sched_barrier(0);
    }
    const float cs = 0.08838834764831845f * 1.4426950408889634f;
    float mx = -1e30f;
#pragma unroll
    for (int tt = 0; tt < 16; ++tt)
#pragma unroll
        for (int r = 0; r < 4; ++r) { const int slot = tt * 16 + 4 * g4 + r; if (slot < cnt) mx = fmaxf(mx, s[tt][r] * cs); }
    mx = fmaxf(mx, __shfl_xor(mx, 16)); mx = fmaxf(mx, __shfl_xor(mx, 32));
    float sum = 0.f;
#pragma unroll
    for (int tt = 0; tt < 16; ++tt)
#pragma unroll
        for (int r = 0; r < 4; ++r) { const int slot = tt * 16 + 4 * g4 + r; const float pv = slot < cnt ? exp2f(s[tt][r] * cs - mx) : 0.f; s[tt][r] = pv; sum += pv; }
    sum += __shfl_xor(sum, 16); sum += __shfl_xor(sum, 32);
    const float inv = sum > 0.f ? 1.0f / sum : 0.f;
    if (c < 4) {
#pragma unroll
        for (int tt = 0; tt < 16; ++tt)
#pragma unroll
            for (int r = 0; r < 4; ++r) Pl[(tt * 16 + 4 * g4 + r) * 4 + c] = s[tt][r] * inv;
    }
    __builtin_amdgcn_wave_barrier();
    float acc[4][8];
#pragma unroll
    for (int hh = 0; hh < 4; ++hh)
#pragma unroll
        for (int j = 0; j < 8; ++j) acc[hh][j] = 0.f;
    const int nk64 = (cnt + 63) >> 6;
#pragma unroll 1
    for (int kb = 0; kb < nk64; ++kb) {
        uint4 raw[16];
#pragma unroll
        for (int q = 0; q < 16; ++q) raw[q] = *(const uint4*)(p.DVC() + (size_t)idxs[(kb * 16 + q) * 4 + g4] * 128 + c * 8);
#pragma unroll
        for (int q = 0; q < 16; ++q) {
            const float4 p4 = *(const float4*)(Pl + ((kb * 16 + q) * 4 + g4) * 4);
            const float vv[8] = {lo2f(raw[q].x), hi2f(raw[q].x), lo2f(raw[q].y), hi2f(raw[q].y), lo2f(raw[q].z), hi2f(raw[q].z), lo2f(raw[q].w), hi2f(raw[q].w)};
            const float pp[4] = {p4.x, p4.y, p4.z, p4.w};
#pragma unroll
            for (int hh = 0; hh < 4; ++hh)
#pragma unroll
                for (int j = 0; j < 8; ++j) acc[hh][j] += pp[hh] * vv[j];
        }
    }
#pragma unroll
    for (int hh = 0; hh < 4; ++hh)
#pragma unroll
        for (int j = 0; j < 8; ++j) { float a = acc[hh][j]; a += __shfl_xor(a, 16); a += __shfl_xor(a, 32); acc[hh][j] = a; }
    if (g4 == 0) {
#pragma unroll
        for (int hh = 0; hh < 4; ++hh) {
            uint4 o; o.x = pk2(acc[hh][0], acc[hh][1]); o.y = pk2(acc[hh][2], acc[hh][3]); o.z = pk2(acc[hh][4], acc[hh][5]); o.w = pk2(acc[hh][6], acc[hh][7]);
            *(uint4*)(p.Y() + t * D + 1536 + hh * 128 + c * 8) = o;
        }
    }
    __builtin_amdgcn_wave_barrier();
}

DEV void ins16(unsigned (&top)[16], unsigned x) {
#pragma unroll
    for (int j = 0; j < 16; ++j) { const unsigned hi = max(top[j], x); x = min(top[j], x); top[j] = hi; }
}
DEV void st_peer_topk(const P& p, int layer, int unit, char* smem) {
    const int tid = tidx(), w = tid >> 6, l = tid & 63, n = l & 31, hf = l >> 5;
    const int head = unit & 7, tg = (unit >> 3) * 4 + w;
    const size_t t = (size_t)tg * 32 + n;
    unsigned* il = (unsigned*)smem + w * 1024;
    unsigned top[2][16];
#pragma unroll
    for (int pp = 0; pp < 2; ++pp) {
        float qv[32];
#pragma unroll
        for (int i = 0; i < 8; ++i) { const float4 v = *(const float4*)(p.PQ() + t * 1024 + head * 128 + pp * 64 + hf * 32 + i * 4); qv[4 * i] = v.x; qv[4 * i + 1] = v.y; qv[4 * i + 2] = v.z; qv[4 * i + 3] = v.w; }
        const float* K = p.peer_sk + ((((size_t)layer * 8 + head) * 2 + pp) * 128) * 64;
#pragma unroll
        for (int j = 0; j < 16; ++j) top[pp][j] = 0u;
        float kn[32];
        {
            const float* kr = K + (size_t)n * 64 + hf * 32;
#pragma unroll
            for (int i = 0; i < 8; ++i) { const float4 v = *(const float4*)(kr + i * 4); kn[4 * i] = v.x; kn[4 * i + 1] = v.y; kn[4 * i + 2] = v.z; kn[4 * i + 3] = v.w; }
        }
#pragma unroll 1
        for (int tile = 0; tile < 4; ++tile) {
            float kv[32];
#pragma unroll
            for (int i = 0; i < 32; ++i) kv[i] = kn[i];
            if (tile < 3) {
                const float* kr = K + (size_t)((tile + 1) * 32 + n) * 64 + hf * 32;
#pragma unroll
                for (int i = 0; i < 8; ++i) { const float4 v = *(const float4*)(kr + i * 4); kn[4 * i] = v.x; kn[4 * i + 1] = v.y; kn[4 * i + 2] = v.z; kn[4 * i + 3] = v.w; }
            }
            f32x16 acc;
#pragma unroll
            for (int r = 0; r < 16; ++r) acc[r] = 0.f;
#pragma unroll
            for (int kk = 0; kk < 32; ++kk) acc = __builtin_amdgcn_mfma_f32_32x32x2f32(kv[kk], qv[kk], acc, 0, 0, 0);
#pragma unroll
            for (int r = 0; r < 16; ++r) {
                const int nn = tile * 32 + (r & 3) + 8 * (r >> 2) + 4 * hf;
                ins16(top[pp], (f2key(acc[r]) & ~127u) | (unsigned)(127 - nn));
            }
        }
        unsigned oth[16];
#pragma unroll
        for (int j = 0; j < 16; ++j) oth[j] = __shfl_xor(top[pp][j], 32);
#pragma unroll
        for (int j = 0; j < 16; ++j) ins16(top[pp], oth[j]);
        if (hf == 0) {
#pragma unroll
            for (int j = 0; j < 16; ++j) il[(pp * 16 + j) * 32 + n] = 127u - (top[pp][j] & 127u);
        }
    }
    __builtin_amdgcn_wave_barrier();
    if (hf == 0) {
        float v1[16], v2[16];
#pragma unroll
        for (int j = 0; j < 16; ++j) { v1[j] = key2f(top[0][j] & ~127u); v2[j] = key2f(top[1][j] & ~127u); }
        unsigned ct[16];
#pragma unroll
        for (int s = 0; s < 16; ++s) ct[s] = 0u;
#pragma unroll
        for (int i = 0; i < 16; ++i)
#pragma unroll
            for (int j = 0; j < 16; ++j)
                if ((i + 1) * (j + 1) <= 16) ins16(ct, (f2key(v1[i] + v2[j]) & ~255u) | (unsigned)(255 - (i * 16 + j)));
        float ex[16], sum = 0.f; int ce[16];
        const float c0 = key2f(ct[0] & ~255u);
#pragma unroll
        for (int s = 0; s < 16; ++s) {
            const unsigned code = 255u - (ct[s] & 255u);
            ce[s] = (int)(il[(code >> 4) * 32 + n] * 128u + il[(16 + (code & 15u)) * 32 + n]);
            ex[s] = __expf(key2f(ct[s] & ~255u) - c0); sum += ex[s];
        }
        const float inv = 1.0f / sum;
#pragma unroll
        for (int s4 = 0; s4 < 4; ++s4) {
            *(int4*)(p.PE() + t * 128 + head * 16 + s4 * 4) = make_int4(ce[4 * s4], ce[4 * s4 + 1], ce[4 * s4 + 2], ce[4 * s4 + 3]);
            *(float4*)(p.PG() + t * 128 + head * 16 + s4 * 4) = make_float4(ex[4 * s4] * inv, ex[4 * s4 + 1] * inv, ex[4 * s4 + 2] * inv, ex[4 * s4 + 3] * inv);
        }
    }
    __builtin_amdgcn_wave_barrier();
}

DEV void st_peer_gather(const P& p, int layer, const float* __restrict__ xin, float* __restrict__ xout, int unit, char* smem) {
    const int tid_ = tidx(); const int w = tid_ >> 6, l = tid_ & 63; const size_t t = (size_t)unit * 4 + w;
    float* row = (float*)smem + w * 2112;
    const int* pip = p.PI();
    const float ic6 = __int_as_float(__builtin_amdgcn_readfirstlane(pip[32]));
    {
#pragma unroll
        for (int i = 0; i < 4; ++i) {
            const uint4 hv = *(const uint4*)(p.HN() + t * D + i * 512 + l * 8);
            const unsigned u4[4] = {hv.x, hv.y, hv.z, hv.w};
            const int c = i * 512 + l * 8;
#pragma unroll
            for (int q = 0; q < 4; ++q) { row[((c + 2 * q) >> 5) * 33 + ((c + 2 * q) & 31)] = lo2f(u4[q]); row[((c + 2 * q + 1) >> 5) * 33 + ((c + 2 * q + 1) & 31)] = hi2f(u4[q]); }
        }
        __builtin_amdgcn_wave_barrier();
    }
    unsigned hp[16];
#pragma unroll
    for (int j = 0; j < 16; ++j)
        hp[j] = (__float_as_uint(row[l * 33 + __builtin_amdgcn_readfirstlane(pip[2 * j])]) >> 16) |
                (__float_as_uint(row[l * 33 + __builtin_amdgcn_readfirstlane(pip[2 * j + 1])]) & 0xffff0000u);
    __builtin_amdgcn_wave_barrier();
    const int e0 = p.PE()[t * 128 + l], e1 = p.PE()[t * 128 + 64 + l];
    const float g0 = p.PG()[t * 128 + l], g1 = p.PG()[t * 128 + 64 + l];
    float out[32];
#pragma unroll
    for (int i = 0; i < 32; ++i) out[i] = 0.f;
    const unsigned char* U = p.Utab() + (size_t)layer * 16384 * ROW6; const unsigned char* V = p.Vtab() + (size_t)layer * 16384 * ROW6;
    const unsigned voff = (unsigned)l * 8u;
    const bool b5 = (l & 32) != 0, b4 = (l & 16) != 0;
#pragma unroll 1
    for (int k4 = 0; k4 < 32; ++k4) {
        int e[4]; float g[4];
#pragma unroll
        for (int q = 0; q < 4; ++q) {
            const int k = k4 * 4 + q;
            e[q] = __builtin_amdgcn_readlane(k4 < 16 ? e0 : e1, k & 63);
            g[q] = __int_as_float(__builtin_amdgcn_readlane(__float_as_int(k4 < 16 ? g0 : g1), k & 63));
        }
#if PEER_FP4
        uint4 uu[4], vv[4];
#pragma unroll
        for (int q = 0; q < 4; ++q) { uu[q] = *(const uint4*)(U + (size_t)e[q] * ROW6 + 2 * voff); vv[q] = *(const uint4*)(V + (size_t)e[q] * ROW6 + 2 * voff); }
#define GATHER_UNPACK(F, SRC) do { fp4_unpack8((SRC).x, &(F)[0]); fp4_unpack8((SRC).y, &(F)[8]); fp4_unpack8((SRC).z, &(F)[16]); fp4_unpack8((SRC).w, &(F)[24]); } while (0)
#define GATHER_FIRST(SRC) (SRC).x
#else
        uint2 uu[4][3], vv[4][3];
#pragma unroll
        for (int q = 0; q < 4; ++q)
#pragma unroll
            for (int i = 0; i < 3; ++i) { uu[q][i] = *(const uint2*)(U + (size_t)e[q] * ROW6 + (voff + i * 512)); vv[q][i] = *(const uint2*)(V + (size_t)e[q] * ROW6 + (voff + i * 512)); }
#endif
        float d[4];
#pragma unroll
        for (int q = 0; q < 4; ++q) {
#if PEER_FP4
            if (q > 0) asm volatile("" : "+v"(uu[q].x), "+v"(d[q - 1]));
            float f[32]; GATHER_UNPACK(f, uu[q]);
#else
            v6u pk; pk[0] = uu[q][0].x; pk[1] = uu[q][0].y; pk[2] = uu[q][1].x; pk[3] = uu[q][1].y; pk[4] = uu[q][2].x; pk[5] = uu[q][2].y;
            if (q > 0) { unsigned t0_ = pk[0]; asm volatile("" : "+v"(t0_), "+v"(d[q - 1])); pk[0] = t0_; }
            const v32f f = FP6_UNPACK(pk);
#endif
            float acc = 0.f;
#pragma unroll
            for (int j = 0; j < 16; ++j) acc += f[2 * j] * lo2f(hp[j]) + f[2 * j + 1] * hi2f(hp[j]);
            d[q] = acc;
            __builtin_amdgcn_sched_barrier(0);
        }
        float kA = b5 ? d[2] : d[0], kB = b5 ? d[3] : d[1];
        const float sA = b5 ? d[0] : d[2], sB = b5 ? d[1] : d[3];
        kA += __shfl_xor(sA, 32); kB += __shfl_xor(sB, 32);
        float kk = b4 ? kB : kA; const float ss = b4 ? kA : kB;
        kk += __shfl_xor(ss, 16);
        kk += __shfl_xor(kk, 8); kk += __shfl_xor(kk, 4); kk += __shfl_xor(kk, 2); kk += __shfl_xor(kk, 1);
        const float gsel = b5 ? (b4 ? g[3] : g[2]) : (b4 ? g[1] : g[0]);
        const float av = gelu_tanh(kk * (ic6 / U6_SCALE)) * gsel * (ic6 / V6_SCALE);
        const int avi = __float_as_int(av);
        const float a4[4] = {__int_as_float(__builtin_amdgcn_readlane(avi, 0)), __int_as_float(__builtin_amdgcn_readlane(avi, 16)),
                             __int_as_float(__builtin_amdgcn_readlane(avi, 32)), __int_as_float(__builtin_amdgcn_readlane(avi, 48))};
#pragma unroll
        for (int q = 0; q < 4; ++q) {
#if PEER_FP4
            asm volatile("" : "+v"(vv[q].x), "+v"(out[31]));
            float f[32]; GATHER_UNPACK(f, vv[q]);
#else
            v6u pk; pk[0] = vv[q][0].x; pk[1] = vv[q][0].y; pk[2] = vv[q][1].x; pk[3] = vv[q][1].y; pk[4] = vv[q][2].x; pk[5] = vv[q][2].y;
            { unsigned t0_ = pk[0]; asm volatile("" : "+v"(t0_), "+v"(out[31])); pk[0] = t0_; }
            const v32f f = FP6_UNPACK(pk);
#endif
#pragma unroll
            for (int j = 0; j < 32; ++j) out[j] += a4[q] * f[j];
            __builtin_amdgcn_sched_barrier(0);
        }
    }
    asm volatile("" : "+s"(pip));
#pragma unroll
    for (int j = 0; j < 32; ++j) row[l * 33 + __builtin_amdgcn_readfirstlane(pip[j])] = out[j];
    __builtin_amdgcn_wave_barrier();
    const float* g2 = p.ada() + layer * 12288 + 5 * 2048;
    float4 xo[8]; float ssq = 0.f;
#pragma unroll
    for (int i = 0; i < 8; ++i) {
        const int c = i * 256 + l * 4;
        const float* rp = row + (c >> 5) * 33 + (c & 31);
        const size_t off = t * D + c;
        const float4 x0 = *(const float4*)(xin + off); const float4 ga = *(const float4*)(g2 + c);
        float4 o0;
        o0.x = x0.x + ga.x * rp[0]; o0.y = x0.y + ga.y * rp[1]; o0.z = x0.z + ga.z * rp[2]; o0.w = x0.w + ga.w * rp[3];
        *(float4*)(xout + off) = o0;
        xo[i] = o0; ssq += o0.x * o0.x + o0.y * o0.y + o0.z * o0.z + o0.w * o0.w;
        if (i & 1) __builtin_amdgcn_sched_barrier(0);
    }
    if (layer + 1 < NL) {
        const float rs = rsqrtf(wsum(ssq) * (1.0f / 2048.0f) + EPS);
        const float* ng = p.n1g + (layer + 1) * 2048; const float* adn = p.ada() + (layer + 1) * 12288;
#pragma unroll
        for (int i = 0; i < 8; ++i) {
            const int c = i * 256 + l * 4;
            const float4 gg = *(const float4*)(ng + c), sc = *(const float4*)(adn + 2048 + c), sh = *(const float4*)(adn + c);
            uint2 o;
            o.x = pk2((xo[i].x * rs) * gg.x * (1.0f + sc.x) + sh.x, (xo[i].y * rs) * gg.y * (1.0f + sc.y) + sh.y);
            o.y = pk2((xo[i].z * rs) * gg.z * (1.0f + sc.z) + sh.z, (xo[i].w * rs) * gg.w * (1.0f + sc.w) + sh.w);
            *(uint2*)(p.HN() + t * D + c) = o;
            if (i & 1) __builtin_amdgcn_sched_barrier(0);
        }
    }
    __builtin_amdgcn_wave_barrier();
}

enum { S_CONVT_IN = 0, S_CONVT_OUT, S_CONVT_Q, S_CONVT_W1, S_CALIB, S_TAB_U, S_TAB_V, S_ADA, S_ROPE, S_NORM1, S_GEMM_IN, S_CONV, S_SGU, S_VTRANS, S_PREP,
       S_COMPRESS, S_NSA_CMP, S_DSA_INDEX, S_NSA_ATTN, S_DSA_ATTN, S_GEMM_OUT, S_NORM2, S_GEMM_Q, S_PEER_TOPK, S_PEER_GATHER, S_COUNT };
constexpr int TAB_UNITS = 4096;
__host__ __device__ constexpr int nunits(int s) {
    return s == S_CONVT_IN ? 2 * 32 * (LDP / 64) : s == S_CONVT_OUT ? 2 * 32 * 32 : s == S_CONVT_Q ? 2 * 32 * 16 : s == S_CONVT_W1 ? 4 * 64 * 2 : s == S_CALIB ? 1 : s == S_TAB_U ? TAB_UNITS : s == S_TAB_V ? TAB_UNITS
         : s == S_ADA ? 384 : s == S_ROPE ? 768 : s == S_NORM1 ? 2048 : s == S_GEMM_IN ? 64 * (LDP / 128) : s == S_CONV ? 512 : s == S_SGU ? 256
         : s == S_VTRANS ? 256 : s == S_PREP ? 2048 : s == S_COMPRESS ? 64 : s == S_NSA_CMP ? 512 : s == S_DSA_INDEX ? 512 : s == S_NSA_ATTN ? 512 : s == S_DSA_ATTN ? 2048
         : s == S_GEMM_OUT ? 64 * 16 : s == S_NORM2 ? 2048 : s == S_GEMM_Q ? 64 * 8 : s == S_PEER_TOPK ? 512 : s == S_PEER_GATHER ? 2048 : 0;
}
template <int S>
DEV void run_unit(const P& p, int layer, int u, char* smem, int nu = TAB_UNITS) {
    const float* xin = layer == 0 ? p.x : p.X2();
    const float* ada = p.ada() + layer * 12288;
    if constexpr (S == S_CONVT_IN) { const int per = 32 * (LDP / 64), ly = u / per; st_convT(p.w_in + (size_t)ly * 2048 * INC, p.WinT() + (size_t)ly * LDP * 2048, INC, LDP, true, u % per, smem); }
    else if constexpr (S == S_CONVT_OUT) { const int per = 32 * 32, ly = u / per; st_convT(p.w_out + (size_t)ly * 2048 * 2048, p.WoutT() + (size_t)ly * 2048 * 2048, 2048, 2048, false, u % per, smem); }
    else if constexpr (S == S_CONVT_Q) { const int per = 32 * 16, ly = u / per; st_convT(p.peer_wq + (size_t)ly * 2048 * 1024, p.WqT() + (size_t)ly * 1024 * 2048, 1024, 1024, false, u % per, smem); }
    else if constexpr (S == S_CONVT_W1) { const int per = 64 * 2, mi = u / per; st_convT(p.cmp_w1 + (size_t)mi * 4096 * 128, p.W1T() + (size_t)mi * 128 * 4096, 128, 128, false, u % per, smem, 4096); }
    else if constexpr (S == S_CALIB) st_calib(p);
#if PEER_FP4
    else if constexpr (S == S_TAB_U) st_tab4(p, p.peer_u, p.Utab(), U6_SCALE, 2 * 16384, u, nu, smem);
    else if constexpr (S == S_TAB_V) st_tab4(p, p.peer_v, p.Vtab(), V6_SCALE, 2 * 16384, u, nu, smem);
#else
    else if constexpr (S == S_TAB_U) st_tab6(p.peer_u, p.Utab(), U6_SCALE, 2 * 16384, u, nu, smem);
    else if constexpr (S == S_TAB_V) st_tab6(p.peer_v, p.Vtab(), V6_SCALE, 2 * 16384, u, nu, smem);
#endif
    else if constexpr (S == S_ADA) st_ada(p, u, smem);
    else if constexpr (S == S_ROPE) st_rope(p, u);
    else if constexpr (S == S_NORM1) st_norm(xin, p.n1g + layer * 2048, ada + 2048, ada, p.HN(), u);
    else if constexpr (S == S_GEMM_IN) { EpiArgs e{p.PROJ(), nullptr, nullptr, nullptr, p.KVC()}; st_gemm<EPI_PROJ>(p.HN(), p.WinT() + (size_t)layer * LDP * 2048, 2048, u & 63, u >> 6, e, smem); }
    else if constexpr (S == S_CONV) st_conv(p, layer, u, smem);
    else if constexpr (S == S_SGU) st_sgu(p, layer, u, smem);
    else if constexpr (S == S_VTRANS) st_vtrans(p, u, smem);
    else if constexpr (S == S_PREP) st_prep(p, layer, u);
    else if constexpr (S == S_COMPRESS) st_compress(p, layer, u, smem);
    else if constexpr (S == S_NSA_CMP) st_nsa_cmp(p, u, smem);
    else if constexpr (S == S_DSA_INDEX) st_dsa_index(p, u, smem);
    else if constexpr (S == S_NSA_ATTN) st_nsa_attn(p, u, smem);
    else if constexpr (S == S_DSA_ATTN) st_dsa_attn(p, u, smem);
    else if constexpr (S == S_GEMM_OUT) { EpiArgs e{nullptr, p.X1(), xin, ada + 2 * 2048, nullptr}; st_gemm<EPI_OUT>(p.Y(), p.WoutT() + (size_t)layer * 2048 * 2048, 2048, u & 63, u >> 6, e, smem); }
    else if constexpr (S == S_NORM2) st_norm(p.X1(), p.n2g + layer * 2048, ada + 4 * 2048, ada + 3 * 2048, p.HN(), u);
    else if constexpr (S == S_GEMM_Q) { EpiArgs e{nullptr, p.PQ(), nullptr, nullptr, nullptr}; st_gemm<EPI_Q>(p.HN(), p.WqT() + (size_t)layer * 1024 * 2048, 2048, u & 63, u >> 6, e, smem); }
    else if constexpr (S == S_PEER_TOPK) st_peer_topk(p, layer, u, smem);
    else if constexpr (S == S_PEER_GATHER) st_peer_gather(p, layer, p.X1(), layer == 0 ? p.X2() : p.out, u, smem);
}


#define XB_TMO      128
#define XB_XCNT(j)  (256  + 64 * (j))
#define XB_XSUB(j)  (1280 + 64 * (j))
#define XB_XGEN(j)  (2304 + 64 * (j))
#define XB_TOP      3328
#define XB_TOPGEN   3392
#define XB_SPIN_CAP (1u << 22)
#define LAS __attribute__((address_space(3)))
DEV unsigned xb_ld(unsigned* p) { return __hip_atomic_load(p, __ATOMIC_RELAXED, __HIP_MEMORY_SCOPE_AGENT); }
DEV unsigned xb_add(unsigned* p, unsigned v) { return __hip_atomic_fetch_add(p, v, __ATOMIC_RELAXED, __HIP_MEMORY_SCOPE_AGENT); }
DEV unsigned xb_xcc_id() { return (unsigned)__builtin_amdgcn_s_getreg((3 << 11) | 20) & 0xFu; }
#define XB_SPIN(cond, bar) do { unsigned _sp = 0; while (cond) { __builtin_amdgcn_s_sleep(1); \
    if ((++_sp & 255u) == 0u) { if (xb_ld(&(bar)[XB_TMO])) break; if (_sp > XB_SPIN_CAP) { atomicAdd(&(bar)[XB_TMO], 1u); break; } } } } while (0)
struct XcdBarrier { unsigned* bar; unsigned x; volatile LAS unsigned* st; };
DEV XcdBarrier xcd_barrier_post(unsigned* bar, volatile LAS unsigned* st) {
    XcdBarrier b; b.bar = bar; b.x = xb_xcc_id(); b.st = st;
    if (threadIdx.x == 0) (void)xb_add(&bar[XB_XCNT(b.x)], 1u);
    return b;
}
DEV void xcd_barrier_complete(unsigned* bar, unsigned x, unsigned& nloc, unsigned& nx) {
    const unsigned G = gridDim.x * gridDim.y * gridDim.z;
    unsigned sum, cnt, mine, sp = 0u;
    for (;;) {
        sum = 0u; cnt = 0u; mine = 0u;
#pragma unroll
        for (unsigned j = 0; j < 16; ++j) { const unsigned c = xb_ld(&bar[XB_XCNT(j)]); sum += c; cnt += (c > 0u) ? 1u : 0u; mine = (j == x) ? c : mine; }
        if (sum == G) break;
        __builtin_amdgcn_s_sleep(1);
        if ((++sp & 255u) == 0u) { if (xb_ld(&bar[XB_TMO])) break; if (sp > XB_SPIN_CAP) { atomicAdd(&bar[XB_TMO], 1u); break; } }
    }
    nloc = mine > 0u ? mine : 1u; nx = cnt > 0u ? cnt : 1u;
}
DEV void xcd_barrier(const XcdBarrier& b) {
    asm volatile("s_waitcnt vmcnt(0)" ::: "memory");
    __syncthreads();
    if (threadIdx.x == 0) {
        unsigned* bar = b.bar;
        __builtin_amdgcn_s_waitcnt(0);
        unsigned nloc = b.st[0], nx = b.st[1];
        if (nloc == 0u) { xcd_barrier_complete(bar, b.x, nloc, nx); b.st[0] = nloc; b.st[1] = nx; }
        const unsigned old = xb_add(&bar[XB_XSUB(b.x)], 1u);
        const unsigned gen = old / nloc;
        if (old + 1u == (gen + 1u) * nloc) {
            __builtin_amdgcn_fence(__ATOMIC_RELEASE, "agent");
            asm volatile("s_waitcnt vmcnt(0)" ::: "memory");
            const unsigned og = xb_add(&bar[XB_TOP], 1u);
            const unsigned tg = og / nx;
            if (og + 1u == (tg + 1u) * nx) xb_add(&bar[XB_TOPGEN], 1u);
            else XB_SPIN(xb_ld(&bar[XB_TOPGEN]) == tg, bar);
            __builtin_amdgcn_fence(__ATOMIC_ACQUIRE, "agent");
            xb_add(&bar[XB_XGEN(b.x)], 1u);
            asm volatile("s_waitcnt vmcnt(0)" ::: "memory");
        } else {
            XB_SPIN(xb_ld(&bar[XB_XGEN(b.x)]) == gen, bar);
            __builtin_amdgcn_fence(__ATOMIC_ACQUIRE, "agent");
            asm volatile("s_waitcnt vmcnt(0)" ::: "memory");
        }
    }
    __syncthreads();
}

#ifndef MULTI_LAUNCH
constexpr int REP_STAGE = -1, REP_STAGE2 = -1, REP_N = 1;
template <int S, int LIM = 0>
DEV void run_phase1(const P& p, int layer, char* smem, int off);
template <int S, int LIM = 0>
DEV void run_phase(const P& p, int layer, char* smem, int off = 0) {
    constexpr int reps = (S == REP_STAGE || S == REP_STAGE2) ? REP_N : 1;
#pragma unroll 1
    for (int r = 0; r < reps; ++r) run_phase1<S, LIM>(p, layer, smem, off);
}
template <int S, int LIM>
DEV void run_phase1(const P& p, int layer, char* smem, int off) {
    const int G = gridDim.x;
    int b = blockIdx.x + off; if (b >= G) b -= G;
    if constexpr (S == S_TAB_U || S == S_TAB_V) { run_unit<S>(p, layer, b, smem, G); }
    else {
        for (int u = b; u < (LIM ? LIM : nunits(S)); u += G) { run_unit<S>(p, layer, u, smem); __syncthreads(); }
    }
}
template <int S>
DEV void run_gemm_phase1(const P& p, int layer, char* smem, unsigned xcc, volatile LAS unsigned* slot, int rep) {
    constexpr int TN = (S == S_GEMM_IN) ? (LDP / 128) : (S == S_GEMM_OUT ? 16 : 8);
    constexpr int NBIG = (S == S_GEMM_IN) ? 32 : (S == S_GEMM_OUT ? 16 : 0);
    constexpr int inst0 = (S == S_GEMM_IN) ? 0 : (S == S_GEMM_OUT ? 2 : 4);
    constexpr int nbig = 4 * NBIG, len = nbig + 8 * (TN - NBIG);
    const float* xin = layer == 0 ? p.x : p.X2();
    const float* ada = p.ada() + layer * 12288;
    const bf16_t* Aop = (S == S_GEMM_OUT) ? p.Y() : p.HN();
    const bf16_t* Bop = (S == S_GEMM_IN) ? p.WinT() + (size_t)layer * LDP * 2048 : (S == S_GEMM_OUT ? p.WoutT() + (size_t)layer * 2048 * 2048 : p.WqT() + (size_t)layer * 1024 * 2048);
    EpiArgs e{p.PROJ(), (S == S_GEMM_OUT) ? p.X1() : p.PQ(), xin, ada + 2 * 2048, p.KVC()};
    constexpr int EPI = (S == S_GEMM_IN) ? EPI_PROJ : (S == S_GEMM_OUT ? EPI_OUT : EPI_Q);
#pragma unroll 1
    for (int q = 0; q < 8; ++q) {
        const unsigned xq = (xcc + q) & 7u;
        unsigned* head = p.bar() + GQ_WORD(inst0 + layer + 6 * rep, xq);
        for (;;) {
            if (threadIdx.x == 0) *slot = xb_add(head, 1u);
            __syncthreads();
            const int i = (int)*slot;
            __syncthreads();
            if (i >= len) break;
            if (i < nbig) st_gemm<EPI, 8>(Aop, Bop, 2048, (int)xq * 4 + (i & 3), i >> 2, e, smem);
            else {
                const int j = i - nbig, tm = (int)xq * 8 + (j & 7), tn = NBIG + (j >> 3);
                st_gemm<EPI, 4>(Aop, Bop, 2048, tm, tn, e, smem);
                if constexpr (S == S_GEMM_Q) {
                    asm volatile("s_waitcnt vmcnt(0)" ::: "memory");
                    __syncthreads();
                    st_peer_topk(p, layer, tm * 8 + tn, smem);
                }
            }
            __syncthreads();
        }
    }
}
template <int S>
DEV void run_items(const P& p, int layer, char* smem, int first, int count) {
    constexpr int reps = (S == REP_STAGE || S == REP_STAGE2) ? REP_N : 1;
#pragma unroll 1
    for (int r = 0; r < reps; ++r)
#pragma unroll 1
        for (int u = first; u < first + count; ++u) { run_unit<S>(p, layer, u, smem); __syncthreads(); }
}
DEV void dep_publish(unsigned* cnt) {
    asm volatile("s_waitcnt vmcnt(0)" ::: "memory");
    __syncthreads();
    if (threadIdx.x == 0) { __builtin_amdgcn_fence(__ATOMIC_RELEASE, "agent"); asm volatile("s_waitcnt vmcnt(0)" ::: "memory"); (void)xb_add(cnt, 1u); }
}
DEV void dep_wait(unsigned* cnt, unsigned target, unsigned* bar) {
    if (threadIdx.x == 0) {
        XB_SPIN(xb_ld(cnt) < target, bar);
        __builtin_amdgcn_fence(__ATOMIC_ACQUIRE, "agent");
        asm volatile("s_waitcnt vmcnt(0)" ::: "memory");
    }
    __syncthreads();
}
template <int PH>
DEV void run_dyn_phase(const P& p, int layer, char* smem, volatile LAS unsigned* slot) {
    unsigned* head = p.bar() + DQ_WORD(PH * 2 + layer);
    unsigned* cprep = p.bar() + DQ_WORD(12 + layer); unsigned* ccomp = p.bar() + DQ_WORD(14 + layer);
    constexpr int total0 = PH == 0 ? (256 + 64 + 256 + 256 + 64 + 512 + 256) : (512 + 512);
    const int total = (PH == 0 && layer == 0) ? total0 + 512 + 296 + 256 + 128 : total0;
    int i = blockIdx.x;
    while (i < total) {
        if constexpr (PH == 0) {
            if (i < 256) { run_items<S_PREP>(p, layer, smem, i * 8, 8); dep_publish(cprep); }
            else if (i < 320) { run_items<S_COMPRESS>(p, layer, smem, i - 256, 1); dep_publish(ccomp); }
            else if (i < 576) run_items<S_SGU>(p, layer, smem, i - 320, 1);
            else if (i < 832) run_items<S_CONV>(p, layer, smem, (i - 576) * 2, 2);
            else if (i < 896) run_items<S_VTRANS>(p, layer, smem, (i - 832) * 4, 4);
            else if (i < 1408) { dep_wait(cprep, 256u, p.bar()); run_items<S_DSA_INDEX>(p, layer, smem, i - 896, 1); }
            else if (i < 1664) { dep_wait(cprep, 256u, p.bar()); dep_wait(ccomp, 64u, p.bar()); run_items<S_NSA_CMP>(p, layer, smem, (i - 1408) * 2, 2); }
            else if (i < 1920) { run_unit<S_TAB_U>(p, layer, i - 1664, smem, 256); __syncthreads(); }
            else if (i < 2176) { run_unit<S_TAB_V>(p, layer, i - 1920, smem, 256); __syncthreads(); }
            else if (i < 2472) run_items<S_CONVT_IN>(p, layer, smem, 2368 + (i - 2176) * 8, 8);
            else if (i < 2728) run_items<S_CONVT_OUT>(p, layer, smem, (i - 2472) * 8, 8);
            else run_items<S_CONVT_Q>(p, layer, smem, (i - 2728) * 8, 8);
        } else {
            if (i < 512) run_items<S_NSA_ATTN>(p, layer, smem, 511 - i, 1);
            else run_items<S_DSA_ATTN>(p, layer, smem, (i - 512) * 4, 4);
        }
        if (threadIdx.x == 0) *slot = gridDim.x + xb_add(head, 1u);
        __syncthreads();
        i = (int)*slot;
        __syncthreads();
    }
}
template <int S>
DEV void run_gemm_phase(const P& p, int layer, char* smem, unsigned xcc, volatile LAS unsigned* slot) {
    constexpr int reps = (S == REP_STAGE || S == REP_STAGE2) ? REP_N : 1;
#pragma unroll 1
    for (int r = 0; r < reps; ++r) run_gemm_phase1<S>(p, layer, smem, xcc, slot, r);
}
#if defined(__HIP_DEVICE_COMPILE__)
typedef const P __attribute__((address_space(4)))* kargp_t;
DEV const P& fresh_params() { kargp_t q = (kargp_t)__builtin_amdgcn_kernarg_segment_ptr(); asm volatile("" : "+s"(q)); return *(const P*)q; }
#define PP fresh_params()
#else
#define PP p
#endif
#define GSYNC() xcd_barrier(xb)
__global__ void __launch_bounds__(NTHREADS, 2) k_mega(P p) {
    __shared__ __attribute__((aligned(16))) char smem[SMEM_BYTES];
    __shared__ uint4 xb_words;
    cg::grid_group grid = cg::this_grid();
    if (threadIdx.x == 0) xb_words = make_uint4(0u, 0u, 0u, 0u);
    __syncthreads();
    XcdBarrier xb = xcd_barrier_post(p.bar(), (volatile LAS unsigned*)&xb_words);
    const int H = gridDim.x >> 1, Q = gridDim.x >> 2;
    run_phase<S_ADA>(PP, 0, smem); run_phase<S_ROPE>(PP, 0, smem, H);
    run_phase<S_CONVT_IN, 2368>(PP, 0, smem); run_phase<S_CONVT_W1>(PP, 0, smem); run_phase<S_CALIB>(PP, 0, smem, 100);
    GSYNC();
    if (gridDim.x == 0x7fffffffu) grid.sync();
#pragma unroll 1
    for (int layer = 0; layer < NL; ++layer) {
        if (layer == 0) { run_phase<S_NORM1>(PP, layer, smem); GSYNC(); }
        run_gemm_phase<S_GEMM_IN>(PP, layer, smem, xb.x, (volatile LAS unsigned*)&xb_words + 2); GSYNC();
        run_dyn_phase<0>(PP, layer, smem, (volatile LAS unsigned*)&xb_words + 2); GSYNC();
        run_dyn_phase<2>(PP, layer, smem, (volatile LAS unsigned*)&xb_words + 2); GSYNC();
        run_gemm_phase<S_GEMM_OUT>(PP, layer, smem, xb.x, (volatile LAS unsigned*)&xb_words + 2); GSYNC();
        run_phase<S_NORM2>(PP, layer, smem); GSYNC();
        run_gemm_phase<S_GEMM_Q>(PP, layer, smem, xb.x, (volatile LAS unsigned*)&xb_words + 2); GSYNC();
        run_phase<S_PEER_GATHER>(PP, layer, smem); if (layer + 1 < NL) GSYNC();
    }
}
#else
template <int S>
__global__ void __launch_bounds__(NTHREADS) k_stage(P p, int layer) {
    __shared__ __attribute__((aligned(16))) char smem[SMEM_BYTES];
    run_unit<S>(p, layer, blockIdx.x, smem);
}
template <int S> static void launch_stage(const P& p, int layer, hipStream_t st) {
    hipLaunchKernelGGL((k_stage<S>), dim3(nunits(S)), dim3(NTHREADS), 0, st, p, layer);
}
#endif

extern "C" void kernel_launch(void* const* d_in, const int* in_sizes, int n_in, void* d_out, int out_size, void* d_ws, size_t ws_size, hipStream_t stream) {
    P p{};
    p.x = (const float*)d_in[0]; p.c = (const float*)d_in[1]; p.pos = (const int*)d_in[2]; p.ada_w = (const float*)d_in[3]; p.ada_b = (const float*)d_in[4];
    p.n1g = (const float*)d_in[5]; p.n2g = (const float*)d_in[6]; p.w_in = (const float*)d_in[7]; p.w_out = (const float*)d_in[8]; p.conv_w = (const float*)d_in[9];
    p.conv_b = (const float*)d_in[10]; p.cln_g = (const float*)d_in[11]; p.cln_b = (const float*)d_in[12]; p.sln_g = (const float*)d_in[13]; p.sln_b = (const float*)d_in[14];
    p.sgu_w = (const float*)d_in[15]; p.sgu_b = (const float*)d_in[16]; p.nsa_qg = (const float*)d_in[17]; p.nsa_kg = (const float*)d_in[18]; p.cmp_pos = (const float*)d_in[19];
    p.cmp_w1 = (const float*)d_in[20]; p.cmp_w2 = (const float*)d_in[21]; p.dsa_qg = (const float*)d_in[22]; p.dsa_kg = (const float*)d_in[23]; p.peer_wq = (const float*)d_in[24];
    p.peer_sk = (const float*)d_in[25]; p.peer_u = (const float*)d_in[26]; p.peer_v = (const float*)d_in[27];
    p.out = (float*)d_out;
    p.ws = (char*)d_ws; const size_t off = WS_TOTAL;
    if (off > ws_size) { fprintf(stderr, "workspace too small: need %zu have %zu\n", off, ws_size); return; }
#ifndef MULTI_LAUNCH
    static int grid_blocks = 0;
    if (!grid_blocks) {
        int dev = 0, cus = 0, per_cu = 0;
        (void)hipGetDevice(&dev);
        (void)hipDeviceGetAttribute(&cus, hipDeviceAttributeMultiprocessorCount, dev);
        (void)hipOccupancyMaxActiveBlocksPerMultiprocessor(&per_cu, k_mega, NTHREADS, 0);
        if (per_cu > 2) per_cu = 2;
        grid_blocks = cus * per_cu;
    }
    (void)hipMemsetAsync(p.bar(), 0, (size_t)CTRL_WORDS * 4, stream);
    void* args[] = {&p};
    hipError_t e = hipLaunchCooperativeKernel((void*)k_mega, dim3(grid_blocks), dim3(NTHREADS), args, 0, stream);
    if (e != hipSuccess) fprintf(stderr, "cooperative launch failed: %s (grid %d)\n", hipGetErrorString(e), grid_blocks);
#else
    launch_stage<S_CONVT_IN>(p, 0, stream); launch_stage<S_CONVT_OUT>(p, 0, stream); launch_stage<S_CONVT_Q>(p, 0, stream); launch_stage<S_CONVT_W1>(p, 0, stream); launch_stage<S_CALIB>(p, 0, stream);
    launch_stage<S_TAB_U>(p, 0, stream); launch_stage<S_TAB_V>(p, 0, stream);
    launch_stage<S_ADA>(p, 0, stream); launch_stage<S_ROPE>(p, 0, stream);
    for (int layer = 0; layer < NL; ++layer) {
        launch_stage<S_NORM1>(p, layer, stream); launch_stage<S_GEMM_IN>(p, layer, stream);
        launch_stage<S_CONV>(p, layer, stream); launch_stage<S_SGU>(p, layer, stream); launch_stage<S_VTRANS>(p, layer, stream);
        launch_stage<S_PREP>(p, layer, stream); launch_stage<S_COMPRESS>(p, layer, stream);
        launch_stage<S_NSA_CMP>(p, layer, stream); launch_stage<S_DSA_INDEX>(p, layer, stream);
        launch_stage<S_NSA_ATTN>(p, layer, stream); launch_stage<S_DSA_ATTN>(p, layer, stream);
        launch_stage<S_GEMM_OUT>(p, layer, stream); launch_stage<S_NORM2>(p, layer, stream); launch_stage<S_GEMM_Q>(p, layer, stream);
        launch_stage<S_PEER_TOPK>(p, layer, stream); launch_stage<S_PEER_GATHER>(p, layer, stream);
    }
#endif
}
```

```cpp
#include <hip/hip_runtime.h>
#include <hip/hip_cooperative_groups.h>
#include <stdint.h>
#include <cstdio>
namespace cg = cooperative_groups;

typedef unsigned short bf16_t;
typedef short bf16x8 __attribute__((ext_vector_type(8)));
typedef float f32x4 __attribute__((ext_vector_type(4)));
typedef float f32x16 __attribute__((ext_vector_type(16)));
#define DEV __device__ __forceinline__

constexpr int T = 8192, D = 2048, NL = 2;
constexpr int INC = 4692;
constexpr int LDP = 4736;
constexpr int C_CA = 0, C_CG = 512, C_SU = 1024, C_SV = 1536;
constexpr int C_NQ = 2048, C_NKC = 2560, C_NVC = 2688, C_NKS = 2816, C_NVS = 2944, C_NKW = 3072, C_NVW = 3200;
constexpr int C_DQ = 3328, C_DK = 3840, C_DV = 3968, C_IQ = 4096, C_IK = 4608, C_NG = 4672, C_IW = 4688;
constexpr float EPS = 1e-6f;
constexpr int NTHREADS = 256;
constexpr int SMEM_BYTES = 72 * 1024;

__device__ const double INV16[16] = {1.0, 0.44036660267178046, 0.19392274474868576, 0.08539710028576561, 0.03760603093086393,
    0.016560440080994446, 0.007292664737217109, 0.003211445994752591, 0.001414213562373095, 0.000622772421914596,
    0.0002742481756762073, 0.00012076973741146504, 5.318295896944988e-05, 2.341999896140934e-05, 1.031338537721246e-05,
    4.5416704806078695e-06};

#define XCD_BAR_WORDS 3456
#define GQ_WORD(inst, x) (XCD_BAR_WORDS + 64 * ((inst) * 8 + (x)))
#define DQ_WORD(k) (XCD_BAR_WORDS + 64 * (96 + (k)))
#define CTRL_WORDS (XCD_BAR_WORDS + 64 * 112)
constexpr size_t WS_ALIGN(size_t x) { return (x + 255) & ~(size_t)255; }
constexpr size_t OFF_WinT = 0;
constexpr size_t OFF_WoutT = OFF_WinT + WS_ALIGN((size_t)2 * LDP * 2048 * 2);
constexpr size_t OFF_WqT = OFF_WoutT + WS_ALIGN((size_t)2 * 2048 * 2048 * 2);
constexpr size_t OFF_W1T = OFF_WqT + WS_ALIGN((size_t)2 * 1024 * 2048 * 2);
constexpr size_t OFF_PI = OFF_W1T + WS_ALIGN((size_t)4 * 128 * 4096 * 2);
constexpr size_t OFF_Utab = OFF_PI + WS_ALIGN(256);
constexpr size_t OFF_Vtab = OFF_Utab + WS_ALIGN((size_t)2 * 16384 * 1536);
constexpr size_t OFF_ada = OFF_Vtab + WS_ALIGN((size_t)2 * 16384 * 1536);
constexpr size_t OFF_ropeC = OFF_ada + WS_ALIGN((size_t)2 * 12288 * 4);
constexpr size_t OFF_ropeS = OFF_ropeC + WS_ALIGN((size_t)T * 24 * 4);
constexpr size_t OFF_HN = OFF_ropeS + WS_ALIGN((size_t)T * 24 * 4);
constexpr size_t OFF_PROJ = OFF_HN + WS_ALIGN((size_t)T * D * 2);
constexpr size_t OFF_Y = OFF_PROJ + WS_ALIGN((size_t)T * LDP * 2);
constexpr size_t OFF_QN = OFF_Y + WS_ALIGN((size_t)T * D * 2);
constexpr size_t OFF_QR = OFF_QN + WS_ALIGN((size_t)T * 512 * 2);
constexpr size_t OFF_KS = OFF_QR + WS_ALIGN((size_t)T * 512 * 2);
constexpr size_t OFF_KW = OFF_KS + WS_ALIGN((size_t)T * 128 * 2);
constexpr size_t OFF_VST = OFF_KW + WS_ALIGN((size_t)T * 128 * 2);
constexpr size_t OFF_VWT = OFF_VST + WS_ALIGN((size_t)T * 128 * 2);
constexpr size_t OFF_GATES = OFF_VWT + WS_ALIGN((size_t)T * 128 * 2);
constexpr size_t OFF_KC = OFF_GATES + WS_ALIGN((size_t)T * 12 * 4);
constexpr size_t OFF_VCT = OFF_KC + WS_ALIGN((size_t)512 * 128 * 2);
constexpr size_t OFF_SEL = OFF_VCT + WS_ALIGN((size_t)128 * 512 * 2);
constexpr size_t OFF_OCMP = OFF_SEL + WS_ALIGN((size_t)T * 4 * 4);
constexpr size_t OFF_DQ = OFF_OCMP + WS_ALIGN((size_t)T * 512 * 2);
constexpr size_t OFF_DK = OFF_DQ + WS_ALIGN((size_t)T * 512 * 2);
constexpr size_t OFF_DVC = OFF_DK + WS_ALIGN((size_t)T * 128 * 2);
constexpr size_t OFF_KVC = OFF_DVC + WS_ALIGN((size_t)T * 128 * 2);
constexpr size_t OFF_IQ = OFF_KVC + WS_ALIGN((size_t)T * 256 * 2);
constexpr size_t OFF_IK = OFF_IQ + WS_ALIGN((size_t)T * 512 * 2);
constexpr size_t OFF_IW = OFF_IK + WS_ALIGN((size_t)T * 64 * 2);
constexpr size_t OFF_IDX = OFF_IW + WS_ALIGN((size_t)T * 8 * 4);
constexpr size_t OFF_CNT = OFF_IDX + WS_ALIGN((size_t)T * 256 * 4);
constexpr size_t OFF_X1 = OFF_CNT + WS_ALIGN((size_t)T * 4);
constexpr size_t OFF_X2 = OFF_X1 + WS_ALIGN((size_t)T * D * 4);
constexpr size_t OFF_PQ = OFF_X2 + WS_ALIGN((size_t)T * D * 4);
constexpr size_t OFF_PE = OFF_PQ + WS_ALIGN((size_t)T * 1024 * 4);
constexpr size_t OFF_PG = OFF_PE + WS_ALIGN((size_t)T * 128 * 4);
constexpr size_t OFF_bar = OFF_PG + WS_ALIGN((size_t)T * 128 * 4);
constexpr size_t WS_TOTAL = OFF_bar + WS_ALIGN((size_t)CTRL_WORDS * 4);

struct P {
    const float* x; const float* c; const int* pos; const float* ada_w; const float* ada_b; const float* n1g; const float* n2g;
    const float* w_in; const float* w_out; const float* conv_w; const float* conv_b; const float* cln_g; const float* cln_b;
    const float* sln_g; const float* sln_b; const float* sgu_w; const float* sgu_b; const float* nsa_qg; const float* nsa_kg;
    const float* cmp_pos; const float* cmp_w1; const float* cmp_w2; const float* dsa_qg; const float* dsa_kg;
    const float* peer_wq; const float* peer_sk; const float* peer_u; const float* peer_v;
    float* out;
    char* ws;
    __host__ __device__ __forceinline__ bf16_t* WinT() const { return (bf16_t*)(ws + OFF_WinT); }
    __host__ __device__ __forceinline__ bf16_t* WoutT() const { return (bf16_t*)(ws + OFF_WoutT); }
    __host__ __device__ __forceinline__ bf16_t* WqT() const { return (bf16_t*)(ws + OFF_WqT); }
    __host__ __device__ __forceinline__ bf16_t* W1T() const { return (bf16_t*)(ws + OFF_W1T); }
    __host__ __device__ __forceinline__ int* PI() const { return (int*)(ws + OFF_PI); }
    __host__ __device__ __forceinline__ unsigned char* Utab() const { return (unsigned char*)(ws + OFF_Utab); }
    __host__ __device__ __forceinline__ unsigned char* Vtab() const { return (unsigned char*)(ws + OFF_Vtab); }
    __host__ __device__ __forceinline__ float* ada() const { return (float*)(ws + OFF_ada); }
    __host__ __device__ __forceinline__ float* ropeC() const { return (float*)(ws + OFF_ropeC); }
    __host__ __device__ __forceinline__ float* ropeS() const { return (float*)(ws + OFF_ropeS); }
    __host__ __device__ __forceinline__ bf16_t* HN() const { return (bf16_t*)(ws + OFF_HN); }
    __host__ __device__ __forceinline__ bf16_t* PROJ() const { return (bf16_t*)(ws + OFF_PROJ); }
    __host__ __device__ __forceinline__ bf16_t* Y() const { return (bf16_t*)(ws + OFF_Y); }
    __host__ __device__ __forceinline__ bf16_t* QN() const { return (bf16_t*)(ws + OFF_QN); }
    __host__ __device__ __forceinline__ bf16_t* QR() const { return (bf16_t*)(ws + OFF_QR); }
    __host__ __device__ __forceinline__ bf16_t* KS() const { return (bf16_t*)(ws + OFF_KS); }
    __host__ __device__ __forceinline__ bf16_t* KW() const { return (bf16_t*)(ws + OFF_KW); }
    __host__ __device__ __forceinline__ bf16_t* VST() const { return (bf16_t*)(ws + OFF_VST); }
    __host__ __device__ __forceinline__ bf16_t* VWT() const { return (bf16_t*)(ws + OFF_VWT); }
    __host__ __device__ __forceinline__ float* GATES() const { return (float*)(ws + OFF_GATES); }
    __host__ __device__ __forceinline__ bf16_t* KC() const { return (bf16_t*)(ws + OFF_KC); }
    __host__ __device__ __forceinline__ bf16_t* VCT() const { return (bf16_t*)(ws + OFF_VCT); }
    __host__ __device__ __forceinline__ unsigned* SEL() const { return (unsigned*)(ws + OFF_SEL); }
    __host__ __device__ __forceinline__ bf16_t* OCMP() const { return (bf16_t*)(ws + OFF_OCMP); }
    __host__ __device__ __forceinline__ bf16_t* DQ() const { return (bf16_t*)(ws + OFF_DQ); }
    __host__ __device__ __forceinline__ bf16_t* DK() const { return (bf16_t*)(ws + OFF_DK); }
    __host__ __device__ __forceinline__ bf16_t* DVC() const { return (bf16_t*)(ws + OFF_DVC); }
    __host__ __device__ __forceinline__ bf16_t* KVC() const { return (bf16_t*)(ws + OFF_KVC); }
    __host__ __device__ __forceinline__ bf16_t* IQ() const { return (bf16_t*)(ws + OFF_IQ); }
    __host__ __device__ __forceinline__ bf16_t* IK() const { return (bf16_t*)(ws + OFF_IK); }
    __host__ __device__ __forceinline__ float* IW() const { return (float*)(ws + OFF_IW); }
    __host__ __device__ __forceinline__ int* IDX() const { return (int*)(ws + OFF_IDX); }
    __host__ __device__ __forceinline__ int* CNT() const { return (int*)(ws + OFF_CNT); }
    __host__ __device__ __forceinline__ float* X1() const { return (float*)(ws + OFF_X1); }
    __host__ __device__ __forceinline__ float* X2() const { return (float*)(ws + OFF_X2); }
    __host__ __device__ __forceinline__ float* PQ() const { return (float*)(ws + OFF_PQ); }
    __host__ __device__ __forceinline__ int* PE() const { return (int*)(ws + OFF_PE); }
    __host__ __device__ __forceinline__ float* PG() const { return (float*)(ws + OFF_PG); }
    __host__ __device__ __forceinline__ unsigned* bar() const { return (unsigned*)(ws + OFF_bar); }
};

DEV float bf2f(bf16_t v) { return __uint_as_float(((unsigned)v) << 16); }
DEV unsigned pk2(float lo, float hi) { unsigned r; asm("v_cvt_pk_bf16_f32 %0, %1, %2" : "=v"(r) : "v"(lo), "v"(hi)); return r; }
DEV bf16_t f2bf(float v) { return (bf16_t)(pk2(v, 0.f) & 0xffffu); }
DEV float lo2f(unsigned u) { return __uint_as_float(u << 16); }
DEV float hi2f(unsigned u) { return __uint_as_float(u & 0xffff0000u); }
#define DPP_ROR_F(V, N) __int_as_float(__builtin_amdgcn_update_dpp(0, __float_as_int(V), 0x120 + (N), 0xf, 0xf, false))
DEV float wsum(float v) {
    v += DPP_ROR_F(v, 8); v += DPP_ROR_F(v, 4); v += DPP_ROR_F(v, 2); v += DPP_ROR_F(v, 1);
    const int vi = __float_as_int(v);
    return (__int_as_float(__builtin_amdgcn_readlane(vi, 0)) + __int_as_float(__builtin_amdgcn_readlane(vi, 16))) +
           (__int_as_float(__builtin_amdgcn_readlane(vi, 32)) + __int_as_float(__builtin_amdgcn_readlane(vi, 48)));
}
DEV float wmax(float v) {
    v = fmaxf(v, DPP_ROR_F(v, 8)); v = fmaxf(v, DPP_ROR_F(v, 4)); v = fmaxf(v, DPP_ROR_F(v, 2)); v = fmaxf(v, DPP_ROR_F(v, 1));
    const int vi = __float_as_int(v);
    return fmaxf(fmaxf(__int_as_float(__builtin_amdgcn_readlane(vi, 0)), __int_as_float(__builtin_amdgcn_readlane(vi, 16))),
                 fmaxf(__int_as_float(__builtin_amdgcn_readlane(vi, 32)), __int_as_float(__builtin_amdgcn_readlane(vi, 48))));
}
DEV int tidx() { int t = threadIdx.x; asm volatile("" : "+v"(t)); return t; }
DEV float sigmoidf_(float x) { return 1.0f / (1.0f + __expf(-x)); }
DEV float gelu_tanh(float x) {
    const float y = 0.7978845608028654f * (x + 0.044715f * x * x * x);
    const float t = 1.0f - 2.0f / (1.0f + __expf(2.0f * y));
    return 0.5f * x * (1.0f + t);
}
DEV f32x4 mfma16(bf16x8 a, bf16x8 b, f32x4 c) { return __builtin_amdgcn_mfma_f32_16x16x32_bf16(a, b, c, 0, 0, 0); }
DEV f32x16 mfma32(bf16x8 a, bf16x8 b, f32x16 c) { return __builtin_amdgcn_mfma_f32_32x32x16_bf16(a, b, c, 0, 0, 0); }

DEV int src_col(int n) {
    if (n < 3328) return n;
    if (n < 4672) return 3340 + (n - 3328);
    if (n < 4684) return 3328 + (n - 4672);
    if (n < 4688) return -1;
    if (n < 4696) return 4684 + (n - 4688);
    return -1;
}

DEV void st_convT(const float* __restrict__ W, bf16_t* __restrict__ Bt, int N, int Npad, bool remap, int unit, char* smem, int Kdim = 2048) {
    float (*tile)[65] = (float (*)[65])smem;
    const int ntn = Npad / 64, kt = unit / ntn, nt = unit % ntn, k0 = kt * 64, n0 = nt * 64;
    const int tid_ = tidx(); const int tx = tid_ & 63, ty = tid_ >> 6;
    const int n = n0 + tx;
    const int src = remap ? src_col(n) : (n < N ? n : -1);
#pragma unroll
    for (int i = 0; i < 16; ++i) { const int k = ty + 4 * i; tile[k][tx] = src >= 0 ? W[(size_t)(k0 + k) * N + src] : 0.f; }
    __syncthreads();
#pragma unroll
    for (int i = 0; i < 16; ++i) { const int r = ty + 4 * i; Bt[(size_t)(n0 + r) * Kdim + k0 + tx] = f2bf(tile[tx][r]); }
    __syncthreads();
}

typedef float f32x2 __attribute__((ext_vector_type(2)));
typedef float v16f __attribute__((ext_vector_type(16)));
typedef float v32f __attribute__((ext_vector_type(32)));
typedef unsigned v6u __attribute__((ext_vector_type(6)));
#ifndef PEER_FP4
#define PEER_FP4 0
#endif
#if PEER_FP4
constexpr float U6_SCALE = 64.0f, V6_SCALE = 2.8f;
constexpr int ROW6 = 1024;
#else
constexpr float U6_SCALE = 64.0f, V6_SCALE = 3.0f;
constexpr int ROW6 = 1536;
#endif
#define FP6_ONE __uint_as_float(0x3F80007Fu)

#ifndef SW_FP6
#define SW_FP6 1
#endif
DEV unsigned fp6_enc1(float f) {
    const float a = fminf(fabsf(f), 7.5f);
    const float sc = a < 2.0f ? 8.0f : (a < 4.0f ? 4.0f : 2.0f), of = a < 2.0f ? 0.0f : (a < 4.0f ? 8.0f : 16.0f);
    const unsigned code = (unsigned)(int)__builtin_rintf(a * sc + of);
    return code | ((__float_as_uint(f) >> 26) & 32u);
}
DEV float fp6_dec1(unsigned c) {
    const unsigned e = (c >> 3) & 3u, m = c & 7u;
    const float v = e == 0u ? 0.125f * (float)m : (1.0f + 0.125f * (float)m) * (float)(1u << (e - 1u));
    return (c & 32u) ? -v : v;
}
DEV v6u sw_pack32(const v16f& x, const v16f& y) {
    unsigned w[6] = {0u, 0u, 0u, 0u, 0u, 0u};
#pragma unroll
    for (int i = 0; i < 32; ++i) {
        const unsigned c = fp6_enc1(i < 16 ? x[i] : y[i - 16]);
        const int bit = 6 * i, d = bit >> 5, sh = bit & 31;
        w[d] |= c << sh;
        if (sh > 26) w[d + 1] |= c >> (32 - sh);
    }
    v6u r; r[0] = w[0]; r[1] = w[1]; r[2] = w[2]; r[3] = w[3]; r[4] = w[4]; r[5] = w[5]; return r;
}
DEV v32f sw_unpack32(const v6u& pk) {
    const unsigned w[6] = {pk[0], pk[1], pk[2], pk[3], pk[4], pk[5]};
    v32f r;
#pragma unroll
    for (int i = 0; i < 32; ++i) {
        const int bit = 6 * i, d = bit >> 5, sh = bit & 31;
        unsigned c = w[d] >> sh;
        if (sh > 26) c |= w[d + 1] << (32 - sh);
        r[i] = fp6_dec1(c & 63u);
    }
    return r;
}
#define FP6_PACK(x, y) sw_pack32(x, y)
#define FP6_UNPACK(pk) __builtin_amdgcn_cvt_scalef32_pk32_f32_fp6(pk, FP6_ONE)

typedef float f32x2_t __attribute__((ext_vector_type(2)));
DEV unsigned fp4_enc1(float f) {
    const float a = fminf(fabsf(f), 6.0f);
    const float sc = a < 2.0f ? 2.0f : (a < 4.0f ? 1.0f : 0.5f), of = a < 2.0f ? 0.0f : (a < 4.0f ? 2.0f : 4.0f);
    const unsigned code = (unsigned)(int)__builtin_rintf(a * sc + of);
    return code | ((__float_as_uint(f) >> 28) & 8u);
}
DEV void fp4_unpack8(unsigned w, float* f) {
    const f32x2_t a = __builtin_amdgcn_cvt_scalef32_pk_f32_fp4(w, FP6_ONE, 0), b = __builtin_amdgcn_cvt_scalef32_pk_f32_fp4(w, FP6_ONE, 1);
    const f32x2_t c = __builtin_amdgcn_cvt_scalef32_pk_f32_fp4(w, FP6_ONE, 2), d = __builtin_amdgcn_cvt_scalef32_pk_f32_fp4(w, FP6_ONE, 3);
    f[0] = a.x; f[1] = a.y; f[2] = b.x; f[3] = b.y; f[4] = c.x; f[5] = c.y; f[6] = d.x; f[7] = d.y;
}
DEV void st_tab4(const P& p, const float* __restrict__ src, unsigned char* __restrict__ dst, float scale, int nrows, int unit, int nunits, char* smem) {
    const int tid_ = tidx(), w = tid_ >> 6, l = tid_ & 63;
    float* stg = (float*)smem + w * (64 * 36);
    int sh[8];
#pragma unroll
    for (int k = 0; k < 8; ++k) sh[k] = 4 * __builtin_amdgcn_readfirstlane(p.PI()[40 + k]);
    for (int r = unit * 4 + w; r < nrows; r += nunits * 4) {
        const float4* sp = (const float4*)(src + (size_t)r * 2048);
        float4 v[8];
#pragma unroll
        for (int i = 0; i < 8; ++i) v[i] = sp[l + 64 * i];
#pragma unroll
        for (int i = 0; i < 8; ++i) { const int f = l + 64 * i; *(float4*)(stg + (f >> 3) * 36 + (f & 7) * 4) = v[i]; }
        __builtin_amdgcn_wave_barrier();
        unsigned wd[4] = {0u, 0u, 0u, 0u};
#pragma unroll
        for (int q = 0; q < 8; ++q) {
            const float4 a = *(const float4*)(stg + l * 36 + q * 4);
            const float xv[4] = {a.x, a.y, a.z, a.w};
#pragma unroll
            for (int e = 0; e < 4; ++e) { const int j = q * 4 + e; wd[j >> 3] |= fp4_enc1(xv[e] * scale) << sh[j & 7]; }
        }
        *(uint4*)(dst + (size_t)r * ROW6 + l * 16) = make_uint4(wd[0], wd[1], wd[2], wd[3]);
        __builtin_amdgcn_wave_barrier();
    }
}
DEV void st_tab6(const float* __restrict__ src, unsigned char* __restrict__ dst, float scale, int nrows, int unit, int nunits, char* smem) {
    const int tid_ = tidx(), w = tid_ >> 6, l = tid_ & 63;
    float* stg = (float*)smem + w * (64 * 36);
    for (int r = unit * 4 + w; r < nrows; r += nunits * 4) {
        const float4* sp = (const float4*)(src + (size_t)r * 2048);
        float4 v[8];
#pragma unroll
        for (int i = 0; i < 8; ++i) v[i] = sp[l + 64 * i];
#pragma unroll
        for (int i = 0; i < 8; ++i) { const int f = l + 64 * i; *(float4*)(stg + (f >> 3) * 36 + (f & 7) * 4) = v[i]; }
        __builtin_amdgcn_wave_barrier();
        v16f x, y;
#pragma unroll
        for (int q = 0; q < 4; ++q) {
            const float4 a = *(const float4*)(stg + l * 36 + q * 4), b = *(const float4*)(stg + l * 36 + 16 + q * 4);
            x[4 * q] = a.x * scale; x[4 * q + 1] = a.y * scale; x[4 * q + 2] = a.z * scale; x[4 * q + 3] = a.w * scale;
            y[4 * q] = b.x * scale; y[4 * q + 1] = b.y * scale; y[4 * q + 2] = b.z * scale; y[4 * q + 3] = b.w * scale;
        }
        const v6u pk = FP6_PACK(x, y);
        unsigned char* dp = dst + (size_t)r * ROW6 + l * 8;
        *(uint2*)(dp) = make_uint2(pk[0], pk[1]); *(uint2*)(dp + 512) = make_uint2(pk[2], pk[3]); *(uint2*)(dp + 1024) = make_uint2(pk[4], pk[5]);
        __builtin_amdgcn_wave_barrier();
    }
}
DEV void st_calib(const P& p) {
    if (tidx() >= 64) return;
    v16f x, y;
#pragma unroll
    for (int k = 0; k < 32; ++k) {
        const int e = k >> 3, m = k & 7;
        const float v = e == 0 ? 0.125f * m : (1.0f + 0.125f * m) * (float)(1 << (e - 1));
        if (k < 16) x[k] = v; else y[k - 16] = v;
    }
    const v6u pk = FP6_PACK(x, y);
    const v32f d = FP6_UNPACK(pk);
    if ((threadIdx.x & 63) == 0) {
        float dmax = 0.f;
#pragma unroll
        for (int j = 0; j < 32; ++j) dmax = fmaxf(dmax, fabsf(d[j]));
        const float cscale = dmax > 0.f ? dmax * (1.0f / 7.5f) : 1.0f;
        const float ic = 1.0f / cscale;
#pragma unroll
        for (int j = 0; j < 32; ++j) {
            int found = j;
#pragma unroll
            for (int k = 0; k < 32; ++k) {
                const int e = k >> 3, m = k & 7;
                const float v = e == 0 ? 0.125f * m : (1.0f + 0.125f * m) * (float)(1 << (e - 1));
                if (fabsf(d[j] * ic - v) < 0.02f + 0.01f * v) found = k;
            }
            p.PI()[j] = found;
        }
        p.PI()[32] = __float_as_int(ic);
    }
#if PEER_FP4
    {
        const unsigned probe = 0x07654321u;
        float f8[8]; fp4_unpack8(probe, f8);
        if ((threadIdx.x & 63) == 0) {
            const float val[8] = {0.f, 0.5f, 1.f, 1.5f, 2.f, 3.f, 4.f, 6.f};
            float dmax = 0.f;
#pragma unroll
            for (int k = 0; k < 8; ++k) dmax = fmaxf(dmax, fabsf(f8[k]));
            const float ic4 = dmax > 0.f ? 6.0f / dmax : 1.0f;
#pragma unroll
            for (int k = 0; k < 8; ++k) {
                int nib = k;
#pragma unroll
                for (int c = 0; c < 8; ++c) if (fabsf(f8[k] * ic4 - val[c]) < 0.1f) nib = (c + 7) & 7;
                p.PI()[40 + k] = nib;
            }
#pragma unroll
            for (int j = 0; j < 32; ++j) p.PI()[j] = j;
            p.PI()[32] = __float_as_int(ic4);
        }
    }
#endif
}

DEV void st_ada(const P& p, int unit, char* smem) {
    float4* red = (float4*)smem;
    const int tid = tidx(), c4 = tid & 15, kg = tid >> 4;
    const int i = unit / 192, j = (unit % 192) * 64 + c4 * 4;
    const float* W = p.ada_w + (size_t)i * 2048 * 12288 + (size_t)kg * 12288 + j;
    float4 acc = make_float4(0.f, 0.f, 0.f, 0.f);
#pragma unroll 1
    for (int k0 = 0; k0 < 128; k0 += 16) {
        float4 wv[16]; float a[16];
#pragma unroll
        for (int q = 0; q < 16; ++q) { const f32x4 t4 = __builtin_nontemporal_load((const f32x4*)(W + (size_t)(16 * (k0 + q)) * 12288)); wv[q] = make_float4(t4[0], t4[1], t4[2], t4[3]); }
#pragma unroll
        for (int q = 0; q < 16; ++q) { const float cv = p.c[kg + 16 * (k0 + q)]; a[q] = cv * sigmoidf_(cv); }
#pragma unroll
        for (int q = 0; q < 16; ++q) { acc.x += a[q] * wv[q].x; acc.y += a[q] * wv[q].y; acc.z += a[q] * wv[q].z; acc.w += a[q] * wv[q].w; }
    }
    red[kg * 16 + c4] = acc;
    __syncthreads();
    if (tid < 64) {
        const int cc = tid >> 2, e = tid & 3;
        float r = p.ada_b[i * 12288 + (unit % 192) * 64 + tid];
#pragma unroll
        for (int q = 0; q < 16; ++q) r += ((const float*)&red[q * 16 + cc])[e];
        p.ada()[i * 12288 + (unit % 192) * 64 + tid] = r;
    }
    __syncthreads();
}
DEV void st_rope(const P& p, int unit) {
    const int e = unit * 256 + tidx(); const int t = e / 24, i = e % 24;
    const double inv = i < 16 ? INV16[i] : INV16[2 * (i - 16)];
    const double ang = (double)p.pos[t] * inv;
    const double n = rint(ang * 0.15915494309189535);
    const double r = ang - n * 6.283185307179586;
    const double r2 = r * r;
    double sp = 1.0 / 1.5511210043330986e25, cp = -1.0 / 4.0329146112660565e26;
    sp = sp * r2 - 1.0 / 2.585201673888498e22;   cp = cp * r2 + 1.0 / 6.204484017332394e23;
    sp = sp * r2 + 1.0 / 5.109094217170944e19;   cp = cp * r2 - 1.0 / 1.1240007277776077e21;
    sp = sp * r2 - 1.0 / 1.21645100408832e17;    cp = cp * r2 + 1.0 / 2.43290200817664e18;
    sp = sp * r2 + 1.0 / 3.55687428096e14;       cp = cp * r2 - 1.0 / 6.402373705728e15;
    sp = sp * r2 - 1.0 / 1.307674368e12;         cp = cp * r2 + 1.0 / 2.0922789888e13;
    sp = sp * r2 + 1.0 / 6.2270208e9;            cp = cp * r2 - 1.0 / 8.71782912e10;
    sp = sp * r2 - 1.0 / 3.99168e7;              cp = cp * r2 + 1.0 / 4.790016e8;
    sp = sp * r2 + 1.0 / 362880.0;               cp = cp * r2 - 1.0 / 3628800.0;
    sp = sp * r2 - 1.0 / 5040.0;                 cp = cp * r2 + 1.0 / 40320.0;
    sp = sp * r2 + 1.0 / 120.0;                  cp = cp * r2 - 1.0 / 720.0;
    sp = sp * r2 - 1.0 / 6.0;                    cp = cp * r2 + 1.0 / 24.0;
    sp = sp * r2 + 1.0;                          cp = cp * r2 - 0.5;
    cp = cp * r2 + 1.0;
    const float cs = (float)cp, sn = (float)(sp * r);
    p.ropeC()[e] = cs; p.ropeS()[e] = sn;
}

DEV void st_norm(const float* __restrict__ X, const float* __restrict__ g, const float* __restrict__ sc, const float* __restrict__ sh,
                 bf16_t* __restrict__ HN, int unit) {
    const int tid_ = tidx(); const int w = tid_ >> 6, l = tid_ & 63; const int t = unit * 4 + w;
    const float4* xr = (const float4*)(X + (size_t)t * D);
    float4 v[8]; float ss = 0.f;
#pragma unroll
    for (int i = 0; i < 4; ++i) { v[2 * i] = xr[i * 128 + l * 2]; v[2 * i + 1] = xr[i * 128 + l * 2 + 1]; }
#pragma unroll
    for (int i = 0; i < 8; ++i) ss += v[i].x * v[i].x + v[i].y * v[i].y + v[i].z * v[i].z + v[i].w * v[i].w;
    ss = wsum(ss);
    const float rs = rsqrtf(ss * (1.0f / 2048.0f) + EPS);
#pragma unroll
    for (int i = 0; i < 4; ++i) {
        const int col = i * 512 + l * 8;
        float y[8]; const float xv[8] = {v[2 * i].x, v[2 * i].y, v[2 * i].z, v[2 * i].w, v[2 * i + 1].x, v[2 * i + 1].y, v[2 * i + 1].z, v[2 * i + 1].w};
#pragma unroll
        for (int j = 0; j < 8; ++j) y[j] = (xv[j] * rs) * g[col + j] * (1.0f + sc[col + j]) + sh[col + j];
        uint4 o; o.x = pk2(y[0], y[1]); o.y = pk2(y[2], y[3]); o.z = pk2(y[4], y[5]); o.w = pk2(y[6], y[7]);
        *(uint4*)(HN + (size_t)t * D + col) = o;
    }
}

enum { EPI_PROJ = 0, EPI_OUT = 1, EPI_Q = 2 };
struct EpiArgs { bf16_t* obf; float* of; const float* xin; const float* gate; bf16_t* kvc; };
template <int EPI, int MT = 4>
DEV void st_gemm(const bf16_t* __restrict__ A, const bf16_t* __restrict__ Bt, int K, int tm, int tn, const EpiArgs& e, char* smem) {
    constexpr int BM = 32 * MT, ABYTES = BM * 64, BUFB = ABYTES + 8192, NBUF = (MT == 4) ? 4 : 3, NA = BM / 64;
    static_assert(NBUF * BUFB <= SMEM_BYTES, "GEMM LDS");
    const int tid = tidx(), w = tid >> 6, l = tid & 63, wr = w >> 1, wc = w & 1;
    f32x4 acc[MT][4];
#pragma unroll
    for (int m = 0; m < MT; ++m)
#pragma unroll
        for (int n = 0; n < 4; ++n) acc[m][n] = (f32x4){0.f, 0.f, 0.f, 0.f};
    const int srow = tid >> 2, spc = tid & 3, sc = spc ^ (((srow >> 2) & 1) << 1);
    const bf16_t* Ag = A + (size_t)(tm * BM + srow) * K + sc * 8;
    const bf16_t* Bg = Bt + (size_t)(tn * 128 + srow) * K + sc * 8;
#define GEMM_STAGE(BUF, KO) do { char* _b = smem + (BUF) * BUFB + tid * 16; \
        _Pragma("unroll") for (int _i = 0; _i < NA; ++_i) \
            __builtin_amdgcn_global_load_lds((const unsigned*)(Ag + (size_t)(64 * _i) * K + (KO)), (__attribute__((address_space(3))) unsigned*)(_b + _i * 4096), 16, 0, 0); \
        __builtin_amdgcn_global_load_lds((const unsigned*)(Bg + (KO)), (__attribute__((address_space(3))) unsigned*)(_b + ABYTES), 16, 0, 0); \
        __builtin_amdgcn_global_load_lds((const unsigned*)(Bg + (size_t)64 * K + (KO)), (__attribute__((address_space(3))) unsigned*)(_b + ABYTES + 4096), 16, 0, 0); } while (0)
    const int nk = K / 32;
    GEMM_STAGE(0, 0); GEMM_STAGE(1, 32);
    if (NBUF == 4) { GEMM_STAGE(2, 64); asm volatile("s_waitcnt vmcnt(8)" ::: "memory"); }
    else asm volatile("s_waitcnt vmcnt(6)" ::: "memory");
    __builtin_amdgcn_s_barrier();
    const int fr = l & 15, fq = l >> 4;
    int cur = 0, nxt = NBUF - 1;
#pragma unroll 1
    for (int kt = 0; kt < nk; ++kt) {
        if (kt + NBUF - 1 < nk) GEMM_STAGE(nxt, (kt + NBUF - 1) * 32);
        const char* As = smem + cur * BUFB; const char* Bs = As + ABYTES;
        bf16x8 bfr[4];
#pragma unroll
        for (int n = 0; n < 4; ++n) { const int row = wc * 64 + n * 16 + fr; bfr[n] = *(const bf16x8*)(Bs + row * 64 + ((fq ^ (((row >> 2) & 1) << 1)) << 4)); }
#pragma unroll
        for (int m = 0; m < MT; ++m) {
            const int row = wr * (BM / 2) + m * 16 + fr;
            const bf16x8 af = *(const bf16x8*)(As + row * 64 + ((fq ^ (((row >> 2) & 1) << 1)) << 4));
#pragma unroll
            for (int n = 0; n < 4; ++n) acc[m][n] = mfma16(bfr[n], af, acc[m][n]);
        }
        if (NBUF == 4) {
            if (kt + 3 < nk) asm volatile("s_waitcnt vmcnt(8)" ::: "memory");
            else if (kt + 2 < nk) asm volatile("s_waitcnt vmcnt(4)" ::: "memory");
            else asm volatile("s_waitcnt vmcnt(0)" ::: "memory");
        } else {
            if (kt + 2 < nk) asm volatile("s_waitcnt vmcnt(6)" ::: "memory");
            else asm volatile("s_waitcnt vmcnt(0)" ::: "memory");
        }
        asm volatile("s_waitcnt lgkmcnt(0)" ::: "memory");
        __builtin_amdgcn_s_barrier();
        cur = (cur + 1 == NBUF) ? 0 : cur + 1; nxt = (nxt + 1 == NBUF) ? 0 : nxt + 1;
    }
#undef GEMM_STAGE
#pragma unroll
    for (int m = 0; m < MT; ++m) {
        const int row = tm * BM + wr * (BM / 2) + m * 16 + (l & 15);
#pragma unroll
        for (int n = 0; n < 4; ++n) {
            const int col = tn * 128 + wc * 64 + n * 16 + 4 * (l >> 4);
            const f32x4 a = acc[m][n];
            if (EPI == EPI_PROJ) {
                uint2 o; o.x = pk2(a[0], a[1]); o.y = pk2(a[2], a[3]);
                *(uint2*)(e.obf + (size_t)row * LDP + col) = o;
                if (col >= C_NKC && col < C_NKC + 256) *(uint2*)(e.kvc + (size_t)row * 256 + (col - C_NKC)) = o;
            } else if (EPI == EPI_OUT) {
                const float4 xi = *(const float4*)(e.xin + (size_t)row * D + col);
                const float4 gg = *(const float4*)(e.gate + col);
                float4 o; o.x = xi.x + gg.x * a[0]; o.y = xi.y + gg.y * a[1]; o.z = xi.z + gg.z * a[2]; o.w = xi.w + gg.w * a[3];
                *(float4*)(e.of + (size_t)row * D + col) = o;
            } else {
                float4 o; o.x = a[0]; o.y = a[1]; o.z = a[2]; o.w = a[3];
                *(float4*)(e.of + (size_t)row * 1024 + col) = o;
            }
        }
    }
    __syncthreads();
}

DEV void st_conv(const P& p, int layer, int unit, char* smem) {
    float* cs = (float*)smem;
    const int tid = tidx(), t0 = unit * 16;
    const float* cw = p.conv_w + (size_t)layer * 31 * 512;
#pragma unroll 1
    for (int cc = 0; cc < 2; ++cc) {
        const int c = tid + 256 * cc;
        float w[31], z[46];
#pragma unroll
        for (int k = 0; k < 31; ++k) w[k] = cw[k * 512 + c];
#pragma unroll
        for (int r = 0; r < 46; ++r) {
            const int t = t0 - 30 + r, tc = t < 0 ? 0 : t;
            const float a = bf2f(p.PROJ()[(size_t)tc * LDP + C_CA + c]), g = bf2f(p.PROJ()[(size_t)tc * LDP + C_CG + c]);
            z[r] = t >= 0 ? a * sigmoidf_(g) : 0.f;
        }
        const float cb = p.conv_b[layer * 512 + c];
#pragma unroll
        for (int tt = 0; tt < 16; ++tt) {
            float acc = cb;
#pragma unroll
            for (int k = 0; k < 31; ++k) acc += w[k] * z[tt + k];
            cs[tt * 512 + c] = acc;
        }
    }
    __syncthreads();
    const int w = tid >> 6, l = tid & 63;
    const float* lg = p.cln_g + layer * 512; const float* lb = p.cln_b + layer * 512;
#pragma unroll 1
    for (int q = 0; q < 4; ++q) {
        const int tt = w * 4 + q;
        float v[8]; float s = 0.f;
#pragma unroll
        for (int i = 0; i < 8; ++i) { v[i] = cs[tt * 512 + l + 64 * i]; s += v[i]; }
        const float mean = wsum(s) * (1.0f / 512.0f);
        float q2 = 0.f;
#pragma unroll
        for (int i = 0; i < 8; ++i) { const float d = v[i] - mean; q2 += d * d; }
        const float rstd = rsqrtf(wsum(q2) * (1.0f / 512.0f) + EPS);
#pragma unroll
        for (int i = 0; i < 8; ++i) {
            const int c = l + 64 * i;
            const float y = (v[i] - mean) * rstd * lg[c] + lb[c];
            p.Y()[(size_t)(t0 + tt) * D + c] = f2bf(y * sigmoidf_(y));
        }
    }
    __syncthreads();
}

DEV void st_sgu(const P& p, int layer, int unit, char* smem) {
    constexpr int RSB = 136;
    const int n = unit >> 2, h = unit & 3, tid = tidx(), w = tid >> 6, l = tid & 63;
    float* stat = (float*)smem;
    bf16_t* wtb = (bf16_t*)(smem + 1024);
    bf16_t* vtb = wtb + 128 * RSB;
    const int tb = n * 128;
#pragma unroll 4
    for (int q = 0; q < 32; ++q) {
        const int j = w * 32 + q;
        const uint4 raw = *(const uint4*)(p.PROJ() + (size_t)(tb + j) * LDP + C_SV + l * 8);
        float v[8] = {lo2f(raw.x), hi2f(raw.x), lo2f(raw.y), hi2f(raw.y), lo2f(raw.z), hi2f(raw.z), lo2f(raw.w), hi2f(raw.w)};
        float s = 0.f;
#pragma unroll
        for (int i = 0; i < 8; ++i) s += v[i];
        const float mean = wsum(s) * (1.0f / 512.0f);
        float q2 = 0.f;
#pragma unroll
        for (int i = 0; i < 8; ++i) { const float d = v[i] - mean; q2 += d * d; }
        const float rstd = rsqrtf(wsum(q2) * (1.0f / 512.0f) + EPS);
        if (l == 0) { stat[j * 2] = mean; stat[j * 2 + 1] = rstd; }
    }
    const float* Wh = p.sgu_w + ((size_t)layer * 4 + h) * 128 * 128;
    {
        float4 wv[16];
#pragma unroll
        for (int q = 0; q < 16; ++q) wv[q] = *(const float4*)(Wh + (size_t)(tid + 256 * q) * 4);
#pragma unroll
        for (int q = 0; q < 16; ++q) {
            const int f = tid + 256 * q, i = f >> 5, j4 = (f & 31) * 4;
            const float x4[4] = {wv[q].x, wv[q].y, wv[q].z, wv[q].w};
#pragma unroll
            for (int e = 0; e < 4; ++e) wtb[(j4 + e) * RSB + i] = (i >= j4 + e) ? f2bf(x4[e]) : (bf16_t)0;
        }
    }
    __syncthreads();
    {
        const float* lg = p.sln_g + layer * 512 + h * 128; const float* lb = p.sln_b + layer * 512 + h * 128;
        uint4 vr[8];
#pragma unroll
        for (int q = 0; q < 8; ++q) { const int f = tid + 256 * q, j = f >> 4, d8 = (f & 15) * 8; vr[q] = *(const uint4*)(p.PROJ() + (size_t)(tb + j) * LDP + C_SV + h * 128 + d8); }
#pragma unroll
        for (int q = 0; q < 8; ++q) {
            const int f = tid + 256 * q, j = f >> 4, d8 = (f & 15) * 8;
            const float mean = stat[j * 2], rstd = stat[j * 2 + 1];
            const float4 g0 = *(const float4*)(lg + d8), g1 = *(const float4*)(lg + d8 + 4), b0 = *(const float4*)(lb + d8), b1 = *(const float4*)(lb + d8 + 4);
            uint4 o;
            o.x = pk2((lo2f(vr[q].x) - mean) * rstd * g0.x + b0.x, (hi2f(vr[q].x) - mean) * rstd * g0.y + b0.y);
            o.y = pk2((lo2f(vr[q].y) - mean) * rstd * g0.z + b0.z, (hi2f(vr[q].y) - mean) * rstd * g0.w + b0.w);
            o.z = pk2((lo2f(vr[q].z) - mean) * rstd * g1.x + b1.x, (hi2f(vr[q].z) - mean) * rstd * g1.y + b1.y);
            o.w = pk2((lo2f(vr[q].w) - mean) * rstd * g1.z + b1.z, (hi2f(vr[q].w) - mean) * rstd * g1.w + b1.w);
            *(uint4*)(vtb + j * RSB + d8) = o;
        }
    }
    __syncthreads();
    const int ti = tid >> 4, td = tid & 15;
    float acc[8][8];
#pragma unroll
    for (int a = 0; a < 8; ++a)
#pragma unroll
        for (int bq = 0; bq < 8; ++bq) acc[a][bq] = 0.f;
    const int jend = w * 32 + 32;
#pragma unroll 2
    for (int j = 0; j < jend; ++j) {
        const uint4 wr = *(const uint4*)(wtb + j * RSB + ti * 8), vr = *(const uint4*)(vtb + j * RSB + td * 8);
        const float wv[8] = {lo2f(wr.x), hi2f(wr.x), lo2f(wr.y), hi2f(wr.y), lo2f(wr.z), hi2f(wr.z), lo2f(wr.w), hi2f(wr.w)};
        const float vv[8] = {lo2f(vr.x), hi2f(vr.x), lo2f(vr.y), hi2f(vr.y), lo2f(vr.z), hi2f(vr.z), lo2f(vr.w), hi2f(vr.w)};
#pragma unroll
        for (int a = 0; a < 8; ++a)
#pragma unroll
            for (int bq = 0; bq < 8; ++bq) acc[a][bq] += wv[a] * vv[bq];
    }
#pragma unroll
    for (int a = 0; a < 8; ++a) {
        const int i = ti * 8 + a; const size_t t = tb + i;
        const float bs = p.sgu_b[((size_t)layer * 4 + h) * 128 + i];
        const uint4 ur = *(const uint4*)(p.PROJ() + t * LDP + C_SU + h * 128 + td * 8);
        const float u[8] = {lo2f(ur.x), hi2f(ur.x), lo2f(ur.y), hi2f(ur.y), lo2f(ur.z), hi2f(ur.z), lo2f(ur.w), hi2f(ur.w)};
        float y[8];
#pragma unroll
        for (int bq = 0; bq < 8; ++bq) y[bq] = u[bq] * (acc[a][bq] + bs);
        uint4 o; o.x = pk2(y[0], y[1]); o.y = pk2(y[2], y[3]); o.z = pk2(y[4], y[5]); o.w = pk2(y[6], y[7]);
        *(uint4*)(p.Y() + t * D + 512 + h * 128 + td * 8) = o;
    }
    __syncthreads();
}

DEV void st_vtrans(const P& p, int unit, char* smem) {
    bf16_t* tile = (bf16_t*)smem;
    const int which = unit & 1, tt0 = (unit >> 1) * 64, tid = tidx();
    const int col0 = which ? C_NVW : C_NVS;
    bf16_t* dst = which ? p.VWT() : p.VST();
#pragma unroll
    for (int q = 0; q < 4; ++q) {
        const int e = tid + 256 * q; const int r = e >> 4, c8 = e & 15;
        const uint4 raw = *(const uint4*)(p.PROJ() + (size_t)(tt0 + r) * LDP + col0 + c8 * 8);
        unsigned* d32 = (unsigned*)(tile + r * 130 + c8 * 8);
        d32[0] = raw.x; d32[1] = raw.y; d32[2] = raw.z; d32[3] = raw.w;
    }
    __syncthreads();
    const int d = tid >> 1, half = tid & 1;
    unsigned o[16];
#pragma unroll
    for (int i = 0; i < 16; ++i) {
        const unsigned a = tile[(half * 32 + 2 * i) * 130 + d], b = tile[(half * 32 + 2 * i + 1) * 130 + d];
        o[i] = a | (b << 16);
    }
    uint4* dp = (uint4*)(dst + (size_t)d * T + tt0 + half * 32);
#pragma unroll
    for (int i = 0; i < 4; ++i) dp[i] = make_uint4(o[4 * i], o[4 * i + 1], o[4 * i + 2], o[4 * i + 3]);
    __syncthreads();
}

DEV void st_prep(const P& p, int layer, int unit) {
    const int tid_ = tidx(); const int w = tid_ >> 6, l = tid_ & 63; const size_t t = (size_t)unit * 4 + w;
    const bf16_t* row = p.PROJ() + t * LDP;
    const float* rc = p.ropeC() + t * 24; const float* rs_ = p.ropeS() + t * 24;
    unsigned raw[11];
#pragma unroll
    for (int h = 0; h < 4; ++h) { raw[h] = *(const unsigned*)(row + C_NQ + h * 128 + 2 * l); raw[6 + h] = *(const unsigned*)(row + C_DQ + h * 128 + 2 * l); }
    raw[4] = *(const unsigned*)(row + C_NKS + 2 * l); raw[5] = *(const unsigned*)(row + C_NKW + 2 * l); raw[10] = *(const unsigned*)(row + C_DK + 2 * l);
    bf16_t iraw[9];
#pragma unroll
    for (int h = 0; h < 9; ++h) iraw[h] = row[(h < 8 ? C_IQ + h * 64 : C_IK) + l];
    const float gq0 = p.nsa_qg[layer * 128 + 2 * l], gq1 = p.nsa_qg[layer * 128 + 2 * l + 1];
    const float gs0 = p.nsa_kg[(layer * 3 + 1) * 128 + 2 * l], gs1 = p.nsa_kg[(layer * 3 + 1) * 128 + 2 * l + 1];
    const float gw0 = p.nsa_kg[(layer * 3 + 2) * 128 + 2 * l], gw1 = p.nsa_kg[(layer * 3 + 2) * 128 + 2 * l + 1];
    const float dq0 = p.dsa_qg[layer * 128 + 2 * l], dq1 = p.dsa_qg[layer * 128 + 2 * l + 1];
    const float dk0 = p.dsa_kg[layer * 128 + 2 * l], dk1 = p.dsa_kg[layer * 128 + 2 * l + 1];
    const float c0 = rc[(2 * l) & 15], c1 = rc[(2 * l + 1) & 15], s0 = rs_[(2 * l) & 15], s1 = rs_[(2 * l + 1) & 15];
    const float ic = rc[16 + (l & 7)], is = rs_[16 + (l & 7)];
    float x0[11], x1[11], ss[11];
#pragma unroll
    for (int h = 0; h < 11; ++h) { x0[h] = lo2f(raw[h]); x1[h] = hi2f(raw[h]); ss[h] = x0[h] * x0[h] + x1[h] * x1[h]; }
#pragma unroll
    for (int h = 0; h < 11; ++h) ss[h] = wsum(ss[h]);
#pragma unroll
    for (int h = 0; h < 11; ++h) {
        const float r = rsqrtf(ss[h] * (1.0f / 128.0f) + EPS);
        const float g0 = h < 4 ? gq0 : (h == 4 ? gs0 : (h == 5 ? gw0 : (h < 10 ? dq0 : dk0)));
        const float g1 = h < 4 ? gq1 : (h == 4 ? gs1 : (h == 5 ? gw1 : (h < 10 ? dq1 : dk1)));
        const float n0 = x0[h] * r * g0, n1 = x1[h] * r * g1;
        const float o0 = __shfl_xor(n0, 8), o1 = __shfl_xor(n1, 8);
        float r0 = n0, r1 = n1;
        if (l < 8) { r0 = n0 * c0 - o0 * s0; r1 = n1 * c1 - o1 * s1; }
        else if (l < 16) { r0 = n0 * c0 + o0 * s0; r1 = n1 * c1 + o1 * s1; }
        const unsigned roped = pk2(r0, r1);
        if (h < 4) { *(unsigned*)(p.QN() + (t * 4 + h) * 128 + 2 * l) = pk2(n0, n1); *(unsigned*)(p.QR() + (t * 4 + h) * 128 + 2 * l) = roped; }
        else if (h == 4) *(unsigned*)(p.KS() + t * 128 + 2 * l) = roped;
        else if (h == 5) *(unsigned*)(p.KW() + t * 128 + 2 * l) = roped;
        else if (h < 10) *(unsigned*)(p.DQ() + (t * 4 + (h - 6)) * 128 + 2 * l) = roped;
        else *(unsigned*)(p.DK() + t * 128 + 2 * l) = roped;
    }
    if (l < 12) p.GATES()[t * 12 + l] = sigmoidf_(bf2f(row[C_NG + l]));
    *(unsigned*)(p.DVC() + t * 128 + 2 * l) = *(const unsigned*)(row + C_DV + 2 * l);
#pragma unroll
    for (int h = 0; h < 9; ++h) {
        const float x = bf2f(iraw[h]);
        const float other = __shfl_xor(x, 8);
        float o = x;
        if (l < 16) o = (l < 8) ? (x * ic - other * is) : (x * ic + other * is);
        if (h < 8) p.IQ()[(t * 8 + h) * 64 + l] = f2bf(o); else p.IK()[t * 64 + l] = f2bf(o);
    }
    if (l < 8) p.IW()[t * 8 + l] = bf2f(row[C_IW + l]) * (0.35355339059327373f * 0.125f);
}

DEV void st_compress(const P& p, int layer, int unit, char* smem) {
    const int which = unit & 1, rt = unit >> 1, tid = tidx(), w = tid >> 6, l = tid & 63, fr = l & 15, fq = l >> 4;
    float* hid = (float*)smem;
    float* ob = hid + 16 * 128;
    const int nb = rt * 16 + fr;
    const int col0 = which ? C_NVC : C_NKC;
    const float* ps = p.cmp_pos + ((size_t)layer * 2 + which) * 4096;
    const bf16_t* w1t = p.W1T() + ((size_t)layer * 2 + which) * 128 * 4096;
    const bool rowok = nb < 511;
    const bf16_t* xrow = p.KVC() + (size_t)(rowok ? nb * 16 : 0) * 256 + (which ? 128 : 0);
    f32x4 acc[2] = {(f32x4){0.f, 0.f, 0.f, 0.f}, (f32x4){0.f, 0.f, 0.f, 0.f}};
#pragma unroll 8
    for (int ks = 0; ks < 128; ++ks) {
        const int k = ks * 32 + fq * 8, lt = k >> 7, d = k & 127;
        const uint4 xr = *(const uint4*)(xrow + (size_t)lt * 256 + d);
        const float4 p0 = *(const float4*)(ps + k), p1 = *(const float4*)(ps + k + 4);
        union { bf16x8 v; unsigned u32[4]; } a;
        a.u32[0] = pk2(lo2f(xr.x) + p0.x, hi2f(xr.x) + p0.y); a.u32[1] = pk2(lo2f(xr.y) + p0.z, hi2f(xr.y) + p0.w);
        a.u32[2] = pk2(lo2f(xr.z) + p1.x, hi2f(xr.z) + p1.y); a.u32[3] = pk2(lo2f(xr.w) + p1.z, hi2f(xr.w) + p1.w);
#pragma unroll
        for (int nt = 0; nt < 2; ++nt) {
            const bf16x8 b = *(const bf16x8*)(w1t + (size_t)(w * 32 + nt * 16 + fr) * 4096 + k);
            acc[nt] = mfma16(a.v, b, acc[nt]);
        }
    }
#pragma unroll
    for (int nt = 0; nt < 2; ++nt)
#pragma unroll
        for (int r = 0; r < 4; ++r) hid[(4 * fq + r) * 128 + w * 32 + nt * 16 + fr] = gelu_tanh(acc[nt][r]);
    __syncthreads();
    const float* w2 = p.cmp_w2 + ((size_t)layer * 2 + which) * 128 * 128;
    const int c2 = tid & 127, mh = tid >> 7;
    float o[8];
#pragma unroll
    for (int b = 0; b < 8; ++b) o[b] = 0.f;
#pragma unroll 1
    for (int k0 = 0; k0 < 128; k0 += 32) {
        float wv[32];
#pragma unroll
        for (int k = 0; k < 32; ++k) wv[k] = w2[(k0 + k) * 128 + c2];
#pragma unroll
        for (int k4 = 0; k4 < 8; ++k4)
#pragma unroll
            for (int b = 0; b < 8; ++b) {
                const float4 h4 = *(const float4*)(hid + (mh * 8 + b) * 128 + k0 + k4 * 4);
                o[b] += h4.x * wv[4 * k4] + h4.y * wv[4 * k4 + 1] + h4.z * wv[4 * k4 + 2] + h4.w * wv[4 * k4 + 3];
            }
    }
#pragma unroll
    for (int b = 0; b < 8; ++b) ob[(mh * 8 + b) * 128 + c2] = o[b];
    __syncthreads();
#pragma unroll
    for (int q = 0; q < 4; ++q) {
        const int b = w * 4 + q, nbo = rt * 16 + b;
        float v0 = ob[b * 128 + l], v1 = ob[b * 128 + l + 64];
        if (which == 0) {
            const float r = rsqrtf(wsum(v0 * v0 + v1 * v1) * (1.0f / 128.0f) + EPS);
            const float* kg = p.nsa_kg + (layer * 3 + 0) * 128;
            v0 = v0 * r * kg[l]; v1 = v1 * r * kg[l + 64];
            if (nbo >= 511) { v0 = 0.f; v1 = 0.f; }
            p.KC()[nbo * 128 + l] = f2bf(v0); p.KC()[nbo * 128 + l + 64] = f2bf(v1);
        } else {
            if (nbo >= 511) { v0 = 0.f; v1 = 0.f; }
            p.VCT()[l * 512 + nbo] = f2bf(v0); p.VCT()[(l + 64) * 512 + nbo] = f2bf(v1);
        }
    }
    __syncthreads();
}

DEV void st_nsa_cmp(const P& p, int unit, char* smem) {
    constexpr int RSK = 272, RSV = 136, BUFB = 64 * RSK + 128 * RSV;
    const int tid = tidx(), w = tid >> 6, l = tid & 63, qc = l & 15, g4 = l >> 4;
    const int t0 = unit * 16 + w * 4;
    const int tk = qc >> 2, hd = qc & 3, t = t0 + tk;
    bf16x8 qf[4];
#pragma unroll
    for (int ks = 0; ks < 4; ++ks) qf[ks] = *(const bf16x8*)(p.QN() + ((size_t)t0 * 4 + qc) * 128 + ks * 32 + g4 * 8);
    const int tmaxb = unit * 16 + 15;
    const int nvb = tmaxb >= 31 ? (tmaxb - 31) / 16 + 1 : 0;
    const int nsteps = (nvb + 63) >> 6;
    const int nvis = t >= 31 ? (t - 31) / 16 + 1 : 0;
    const float cs = 0.08838834764831845f * 1.4426950408889634f;
    const int krow = tid >> 4, kc16 = tid & 15, vrow = tid >> 3, vc16 = tid & 7;
    const bf16_t* Kg = p.KC(); const bf16_t* Vg = p.VCT();
    int gstep = 0;
    uint4 rk0, rk1, rk2, rk3, rv0, rv1, rv2, rv3;
#define CMP_LOADK(ST) do { const bf16_t* kb = Kg + (size_t)((ST) * 64 + krow) * 128 + kc16 * 8; \
        rk0 = *(const uint4*)kb; rk1 = *(const uint4*)(kb + 16 * 128); rk2 = *(const uint4*)(kb + 32 * 128); rk3 = *(const uint4*)(kb + 48 * 128); } while (0)
#define CMP_LOADV(ST) do { const bf16_t* vb = Vg + (size_t)vrow * 512 + (ST) * 64 + vc16 * 8; \
        rv0 = *(const uint4*)vb; rv1 = *(const uint4*)(vb + 32 * 512); rv2 = *(const uint4*)(vb + 64 * 512); rv3 = *(const uint4*)(vb + 96 * 512); } while (0)
#define CMP_STOREK(KT) do { *(uint4*)((KT) + krow * RSK + kc16 * 16) = rk0; *(uint4*)((KT) + (krow + 16) * RSK + kc16 * 16) = rk1; \
        *(uint4*)((KT) + (krow + 32) * RSK + kc16 * 16) = rk2; *(uint4*)((KT) + (krow + 48) * RSK + kc16 * 16) = rk3; } while (0)
#define CMP_STOREV(VT) do { *(uint4*)((VT) + vrow * RSV + vc16 * 16) = rv0; *(uint4*)((VT) + (vrow + 32) * RSV + vc16 * 16) = rv1; \
        *(uint4*)((VT) + (vrow + 64) * RSV + vc16 * 16) = rv2; *(uint4*)((VT) + (vrow + 96) * RSV + vc16 * 16) = rv3; } while (0)
    float m = -1e30f, lsum = 0.f;
    if (nsteps > 0) CMP_LOADK(0);
#pragma unroll 1
    for (int st = 0; st < nsteps; ++st, ++gstep) {
        char* Kt = smem + (gstep & 1) * BUFB;
        CMP_STOREK(Kt);
        __syncthreads();
        if (st + 1 < nsteps) CMP_LOADK(st + 1);
        float mx = m; f32x4 sv[4];
#pragma unroll
        for (int sub = 0; sub < 4; ++sub) {
            f32x4 a4 = (f32x4){0.f, 0.f, 0.f, 0.f};
#pragma unroll
            for (int ks = 0; ks < 4; ++ks) a4 = mfma16(*(const bf16x8*)(Kt + (sub * 16 + qc) * RSK + (ks * 32 + g4 * 8) * 2), qf[ks], a4);
#pragma unroll
            for (int r = 0; r < 4; ++r) { const int key = st * 64 + sub * 16 + 4 * g4 + r; a4[r] = (key < nvis) ? a4[r] * cs : -3e38f; mx = fmaxf(mx, a4[r]); }
            sv[sub] = a4;
        }
        float ps = 0.f;
#pragma unroll
        for (int sub = 0; sub < 4; ++sub)
#pragma unroll
            for (int r = 0; r < 4; ++r) ps += __builtin_amdgcn_exp2f(sv[sub][r] - mx);
        lsum = lsum * __builtin_amdgcn_exp2f(m - mx) + ps; m = mx;
    }
    {
        float mt_ = fmaxf(m, __shfl_xor(m, 16)); mt_ = fmaxf(mt_, __shfl_xor(mt_, 32));
        lsum *= __builtin_amdgcn_exp2f(m - mt_); m = mt_;
        lsum += __shfl_xor(lsum, 16); lsum += __shfl_xor(lsum, 32);
    }
    const float inv = (nvis > 0 && lsum > 0.f) ? 1.0f / lsum : 0.f;
    f32x4 o[8];
#pragma unroll
    for (int mt = 0; mt < 8; ++mt) o[mt] = (f32x4){0.f, 0.f, 0.f, 0.f};
    float yprev = 0.f;
    float impv[32];
#pragma unroll
    for (int i = 0; i < 32; ++i) impv[i] = 0.f;
    if (nsteps > 0) { CMP_LOADK(0); CMP_LOADV(0); }
#pragma unroll
    for (int st = 0; st < 8; ++st) {
        if (st < nsteps) {
            char* Kt = smem + (gstep & 1) * BUFB; char* Vt = Kt + 64 * RSK; ++gstep;
            CMP_STOREK(Kt); CMP_STOREV(Vt);
            __syncthreads();
            if (st + 1 < nsteps) { CMP_LOADK(st + 1); CMP_LOADV(st + 1); }
            f32x4 sv[4];
#pragma unroll
            for (int sub = 0; sub < 4; ++sub) {
                f32x4 a4 = (f32x4){0.f, 0.f, 0.f, 0.f};
#pragma unroll
                for (int ks = 0; ks < 4; ++ks) a4 = mfma16(*(const bf16x8*)(Kt + (sub * 16 + qc) * RSK + (ks * 32 + g4 * 8) * 2), qf[ks], a4);
#pragma unroll
                for (int r = 0; r < 4; ++r) { const int key = st * 64 + sub * 16 + 4 * g4 + r; a4[r] = (key < nvis) ? __builtin_amdgcn_exp2f(a4[r] * cs - m) * inv : 0.f; }
                const float y = __shfl(a4[3], (l + 48) & 63);
                float iv = (a4[0] + a4[1]) + (a4[2] + a4[3]) + (g4 > 0 ? y : yprev);
                yprev = y;
                iv += __shfl_xor(iv, 1); iv += __shfl_xor(iv, 2);
                impv[st * 4 + sub] = iv;
                sv[sub] = a4;
            }
#pragma unroll
            for (int pr = 0; pr < 2; ++pr) {
                union { bf16x8 v; unsigned u32[4]; } bb;
                bb.u32[0] = pk2(sv[2 * pr][0], sv[2 * pr][1]); bb.u32[1] = pk2(sv[2 * pr][2], sv[2 * pr][3]);
                bb.u32[2] = pk2(sv[2 * pr + 1][0], sv[2 * pr + 1][1]); bb.u32[3] = pk2(sv[2 * pr + 1][2], sv[2 * pr + 1][3]);
#pragma unroll
                for (int mt = 0; mt < 8; ++mt) {
                    const char* vp = Vt + (mt * 16 + qc) * RSV + (pr * 32 + 4 * g4) * 2;
                    union { bf16x8 v; uint2 h2[2]; } aa;
                    aa.h2[0] = *(const uint2*)vp; aa.h2[1] = *(const uint2*)(vp + 32);
                    o[mt] = mfma16(aa.v, bb.v, o[mt]);
                }
            }
        }
    }
#undef CMP_LOADK
#undef CMP_LOADV
#undef CMP_STOREK
#undef CMP_STOREV
    __syncthreads();
    float* impl = (float*)smem + w * 512;
    if (hd == 0) {
#pragma unroll
        for (int i = 0; i < 32; ++i) impl[tk * 128 + 4 * i + g4] = impv[i];
    }
#pragma unroll
    for (int mt = 0; mt < 8; ++mt) {
        uint2 ov; ov.x = pk2(o[mt][0], o[mt][1]); ov.y = pk2(o[mt][2], o[mt][3]);
        *(uint2*)(p.OCMP() + ((size_t)t * 4 + hd) * 128 + mt * 16 + 4 * g4) = ov;
    }
    __syncthreads();
    const int li = hd + 4 * g4, cur = t >> 6;
    unsigned long long own[8]; int rank[8];
#pragma unroll
    for (int i = 0; i < 8; ++i) {
        const int j = li + 16 * i; const float v = impl[tk * 128 + j];
        const unsigned k32 = (j == 0 || j == cur || j == cur - 1) ? 0xFFFFFFFFu : (j > cur ? 0u : __float_as_uint(v) + 128u);
        own[i] = ((unsigned long long)k32 << 7) | (unsigned)(127 - j); rank[i] = 0;
    }
#pragma unroll 1
    for (int ip = 0; ip < 8; ++ip) {
#pragma unroll
        for (int q4 = 0; q4 < 4; ++q4) {
            const float4 ov = *(const float4*)(impl + tk * 128 + ip * 16 + q4 * 4);
            const float o4[4] = {ov.x, ov.y, ov.z, ov.w};
#pragma unroll
            for (int e = 0; e < 4; ++e) {
                const int jp = ip * 16 + q4 * 4 + e;
                const unsigned k32 = (jp == 0 || jp == cur || jp == cur - 1) ? 0xFFFFFFFFu : (jp > cur ? 0u : __float_as_uint(o4[e]) + 128u);
                const unsigned long long kp = ((unsigned long long)k32 << 7) | (unsigned)(127 - jp);
#pragma unroll
                for (int i = 0; i < 8; ++i) rank[i] += (kp > own[i]) ? 1 : 0;
            }
        }
    }
    unsigned mw[4] = {0u, 0u, 0u, 0u};
#pragma unroll
    for (int i = 0; i < 8; ++i) if (rank[i] < 16) mw[i >> 1] |= 1u << (li + 16 * (i & 1));
#pragma unroll
    for (int q = 0; q < 4; ++q) {
        unsigned v = mw[q];
        v |= __shfl_xor(v, 1); v |= __shfl_xor(v, 2); v |= __shfl_xor(v, 16); v |= __shfl_xor(v, 32);
        mw[q] = v;
    }
    if (li == 0) *(uint4*)(p.SEL() + (size_t)t * 4) = make_uint4(mw[0], mw[1], mw[2], mw[3]);
    __syncthreads();
}

DEV void st_nsa_attn(const P& p, int unit, char* smem) {
    constexpr int RSK = 272, RSV = 136, BUFB = 64 * RSK + 128 * RSV;
    const int tid = tidx(), w = tid >> 6, l = tid & 63, qc = l & 15, g4 = l >> 4;
    const int tq0 = unit * 16, t = tq0 + w * 4 + (qc >> 2), hd = qc & 3;
    bf16x8 qf[4];
#pragma unroll
    for (int ks = 0; ks < 4; ++ks) qf[ks] = *(const bf16x8*)(p.QR() + ((size_t)t * 4 + hd) * 128 + ks * 32 + g4 * 8);
    const uint4 selw = *(const uint4*)(p.SEL() + (size_t)t * 4);
    const float cs = 0.08838834764831845f * 1.4426950408889634f;
    unsigned part[8][2];
#pragma unroll
    for (int mt = 0; mt < 8; ++mt) { part[mt][0] = 0u; part[mt][1] = 0u; }
    const float g0 = p.GATES()[(size_t)t * 12 + hd * 3];
    int gstep = 0;
    const int krow = tid >> 4, kc16 = tid & 15, vrow = tid >> 3, vc16 = tid & 7;
#pragma unroll 1
    for (int br = 0; br < 2; ++br) {
        const bf16_t* Kg = br ? p.KW() : p.KS(); const bf16_t* Vg = br ? p.VWT() : p.VST();
        const int ktlast = (tq0 + 15) >> 6;
        const int ktfirst = br ? ((tq0 - 511 > 0 ? tq0 - 511 : 0) >> 6) : 0;
        const int nk = ktlast - ktfirst + 1;
        f32x4 o[8];
#pragma unroll
        for (int mt = 0; mt < 8; ++mt) o[mt] = (f32x4){0.f, 0.f, 0.f, 0.f};
        float m = -1e30f, lsum = 0.f;
        uint4 rk0, rk1, rk2, rk3, rv0, rv1, rv2, rv3;
#define NSA_LOAD(KT) do { const bf16_t* kb = Kg + (size_t)((KT) * 64 + krow) * 128 + kc16 * 8; const bf16_t* vb = Vg + (size_t)vrow * T + (KT) * 64 + vc16 * 8; \
        rk0 = *(const uint4*)kb; rk1 = *(const uint4*)(kb + 16 * 128); rk2 = *(const uint4*)(kb + 32 * 128); rk3 = *(const uint4*)(kb + 48 * 128); \
        rv0 = *(const uint4*)vb; rv1 = *(const uint4*)(vb + (size_t)32 * T); rv2 = *(const uint4*)(vb + (size_t)64 * T); rv3 = *(const uint4*)(vb + (size_t)96 * T); } while (0)
        NSA_LOAD(ktfirst);
#pragma unroll 1
        for (int i = 0; i < nk; ++i, ++gstep) {
            const int kt = ktfirst + i;
            char* Kt = smem + (gstep & 1) * BUFB; char* Vt = Kt + 64 * RSK;
            *(uint4*)(Kt + krow * RSK + kc16 * 16) = rk0; *(uint4*)(Kt + (krow + 16) * RSK + kc16 * 16) = rk1;
            *(uint4*)(Kt + (krow + 32) * RSK + kc16 * 16) = rk2; *(uint4*)(Kt + (krow + 48) * RSK + kc16 * 16) = rk3;
            *(uint4*)(Vt + vrow * RSV + vc16 * 16) = rv0; *(uint4*)(Vt + (vrow + 32) * RSV + vc16 * 16) = rv1;
            *(uint4*)(Vt + (vrow + 64) * RSV + vc16 * 16) = rv2; *(uint4*)(Vt + (vrow + 96) * RSV + vc16 * 16) = rv3;
            __syncthreads();
            if (i + 1 < nk) NSA_LOAD(kt + 1);
            int lo, hi = t;
            if (br == 0) {
                const unsigned wv = (kt & 64) ? ((kt & 32) ? selw.w : selw.z) : ((kt & 32) ? selw.y : selw.x);
                lo = 0; hi = ((wv >> (kt & 31)) & 1u) ? t : -1;
            } else lo = t - 511;
            const bool interior = (kt * 64 + 63 <= tq0) && (br == 0 || kt * 64 >= tq0 + 15 - 511);
            f32x4 sv[4];
            float mx = -3e38f;
            if (interior) {
                const float csl = hi >= 0 ? cs : 0.f, add = hi >= 0 ? 0.f : -3e38f;
#pragma unroll
                for (int sub = 0; sub < 4; ++sub) {
                    f32x4 a4 = (f32x4){0.f, 0.f, 0.f, 0.f};
#pragma unroll
                    for (int ks = 0; ks < 4; ++ks) a4 = mfma16(*(const bf16x8*)(Kt + (sub * 16 + qc) * RSK + (ks * 32 + g4 * 8) * 2), qf[ks], a4);
#pragma unroll
                    for (int r = 0; r < 4; ++r) { a4[r] = a4[r] * csl + add; mx = fmaxf(mx, a4[r]); }
                    sv[sub] = a4;
                }
            } else {
#pragma unroll
                for (int sub = 0; sub < 4; ++sub) {
                    f32x4 a4 = (f32x4){0.f, 0.f, 0.f, 0.f};
#pragma unroll
                    for (int ks = 0; ks < 4; ++ks) a4 = mfma16(*(const bf16x8*)(Kt + (sub * 16 + qc) * RSK + (ks * 32 + g4 * 8) * 2), qf[ks], a4);
#pragma unroll
                    for (int r = 0; r < 4; ++r) {
                        const int kp = kt * 64 + sub * 16 + 4 * g4 + r;
                        const bool valid = (kp >= lo) & (kp <= hi);
                        a4[r] = valid ? a4[r] * cs : -3e38f;
                        mx = fmaxf(mx, a4[r]);
                    }
                    sv[sub] = a4;
                }
            }
            mx = fmaxf(mx, __shfl_xor(mx, 16)); mx = fmaxf(mx, __shfl_xor(mx, 32));
            const float mnew = fmaxf(fmaxf(m, mx), -1e30f);
            const float alpha = __builtin_amdgcn_exp2f(m - mnew);
            m = mnew;
            float ps = 0.f;
#pragma unroll
            for (int sub = 0; sub < 4; ++sub)
#pragma unroll
                for (int r = 0; r < 4; ++r) { const float pv = __builtin_amdgcn_exp2f(sv[sub][r] - mnew); sv[sub][r] = pv; ps += pv; }
            lsum = lsum * alpha + ps;
            if (__any(alpha != 1.0f)) {
#pragma unroll
                for (int mt = 0; mt < 8; ++mt) o[mt] *= alpha;
            }
#pragma unroll
            for (int pr = 0; pr < 2; ++pr) {
                union { bf16x8 v; unsigned u32[4]; } bb;
                bb.u32[0] = pk2(sv[2 * pr][0], sv[2 * pr][1]); bb.u32[1] = pk2(sv[2 * pr][2], sv[2 * pr][3]);
                bb.u32[2] = pk2(sv[2 * pr + 1][0], sv[2 * pr + 1][1]); bb.u32[3] = pk2(sv[2 * pr + 1][2], sv[2 * pr + 1][3]);
#pragma unroll
                for (int mt = 0; mt < 8; ++mt) {
                    const char* vp = Vt + (mt * 16 + qc) * RSV + (pr * 32 + 4 * g4) * 2;
                    union { bf16x8 v; uint2 h2[2]; } aa;
                    aa.h2[0] = *(const uint2*)vp; aa.h2[1] = *(const uint2*)(vp + 32);
                    o[mt] = mfma16(aa.v, bb.v, o[mt]);
                }
            }
        }
#undef NSA_LOAD
        lsum += __shfl_xor(lsum, 16); lsum += __shfl_xor(lsum, 32);
        const float gate = p.GATES()[(size_t)t * 12 + hd * 3 + 1 + br];
        const float sc = lsum > 0.f ? gate / lsum : 0.f;
        if (br == 0) {
#pragma unroll
            for (int mt = 0; mt < 8; ++mt) {
                const uint2 oc = *(const uint2*)(p.OCMP() + ((size_t)t * 4 + hd) * 128 + mt * 16 + 4 * g4);
                part[mt][0] = pk2(sc * o[mt][0] + g0 * lo2f(oc.x), sc * o[mt][1] + g0 * hi2f(oc.x));
                part[mt][1] = pk2(sc * o[mt][2] + g0 * lo2f(oc.y), sc * o[mt][3] + g0 * hi2f(oc.y));
            }
        } else {
#pragma unroll
            for (int mt = 0; mt < 8; ++mt) {
                uint2 ov;
                ov.x = pk2(sc * o[mt][0] + lo2f(part[mt][0]), sc * o[mt][1] + hi2f(part[mt][0]));
                ov.y = pk2(sc * o[mt][2] + lo2f(part[mt][1]), sc * o[mt][3] + hi2f(part[mt][1]));
                *(uint2*)(p.Y() + (size_t)t * D + 1024 + hd * 128 + mt * 16 + 4 * g4) = ov;
            }
        }
    }
    __syncthreads();
}

DEV unsigned f2key(float f) { const unsigned u = __float_as_uint(f); return (u & 0x80000000u) ? ~u : (u | 0x80000000u); }
DEV float key2f(unsigned k) { const unsigned u = (k & 0x80000000u) ? (k & 0x7fffffffu) : ~k; return __uint_as_float(u); }
template <int NPASS>
DEV float wave_prune_t(float* sc, unsigned short* ix, unsigned* hist, int m, int l, int& kept) {
    float v[8]; unsigned k[8]; unsigned short id[8]; bool ok[8];
#pragma unroll
    for (int i = 0; i < 8; ++i) {
        const int e = l + 64 * i; ok[i] = e < m;
        v[i] = ok[i] ? sc[e] : 0.f; id[i] = ok[i] ? ix[e] : (unsigned short)0; k[i] = f2key(v[i]);
    }
    unsigned prefix = 0u; int need = 256;
#pragma unroll 1
    for (int pass = 0; pass < NPASS; ++pass) {
        const int shift = 24 - 8 * pass;
        *(uint4*)(hist + 4 * l) = make_uint4(0u, 0u, 0u, 0u);
        __builtin_amdgcn_wave_barrier();
#pragma unroll
        for (int i = 0; i < 8; ++i) {
            const bool in = ok[i] && (pass == 0 || (k[i] >> (shift + 8)) == prefix);
            if (in) atomicAdd(&hist[(k[i] >> shift) & 255u], 1u);
        }
        __builtin_amdgcn_wave_barrier();
        const uint4 hv = *(const uint4*)(hist + 4 * l);
        const unsigned hq[4] = {hv.x, hv.y, hv.z, hv.w};
        const unsigned own = hv.x + hv.y + hv.z + hv.w;
        unsigned tot = own;
#pragma unroll
        for (int o = 1; o < 64; o <<= 1) { const unsigned tv = __shfl_down(tot, o); if (l + o < 64) tot += tv; }
        unsigned cum = tot - own; int found = -1; int nneed = 0;
#pragma unroll
        for (int kk = 3; kk >= 0; --kk) {
            const unsigned c = hq[kk];
            if (found < 0 && (int)cum < need && (int)(cum + c) >= need) { found = 4 * l + kk; nneed = need - (int)cum; }
            cum += c;
        }
        const unsigned long long bal = __ballot(found >= 0);
        const int src = __ffsll((long long)bal) - 1;
        const int digit = __shfl(found, src); need = __shfl(nneed, src);
        prefix = (prefix << 8) | (unsigned)digit;
    }
    int base = 0;
    const unsigned long long ltmask = (1ull << l) - 1ull;
    if (NPASS == 4) {
        const unsigned thr = prefix;
        int ties = 0;
#pragma unroll
        for (int i = 0; i < 8; ++i) {
            const bool gt = ok[i] && k[i] > thr, eq = ok[i] && k[i] == thr;
            const unsigned long long em = __ballot(eq);
            const int trank = ties + __popcll(em & ltmask);
            const bool keep = gt || (eq && trank < need);
            ties += __popcll(em);
            const unsigned long long km = __ballot(keep);
            const int pos = base + __popcll(km & ltmask);
            if (keep) { sc[pos] = v[i]; ix[pos] = id[i]; }
            base += __popcll(km);
        }
        __builtin_amdgcn_wave_barrier();
        kept = base;
        return key2f(thr);
    } else {
        const unsigned lo = prefix << 16;
#pragma unroll
        for (int i = 0; i < 8; ++i) {
            const bool keep = ok[i] && k[i] >= lo;
            const unsigned long long km = __ballot(keep);
            const int pos = base + __popcll(km & ltmask);
            if (keep) { sc[pos] = v[i]; ix[pos] = id[i]; }
            base += __popcll(km);
        }
        __builtin_amdgcn_wave_barrier();
        kept = base;
        return key2f(lo - 1u);
    }
}
DEV float wave_prune(float* sc, unsigned short* ix, unsigned* hist, int m, int l) { int kept; return wave_prune_t<4>(sc, ix, hist, m, l, kept); }
DEV float wave_prune_mid(float* sc, unsigned short* ix, unsigned* hist, int& cnt, int l) {
    int kept; float tau = wave_prune_t<2>(sc, ix, hist, cnt, l, kept);
    if (kept > 352) { tau = wave_prune_t<4>(sc, ix, hist, kept, l, kept); }
    cnt = kept;
    return tau;
}

#define DSA_APPEND2(COND, M64, SV, SCP, IXP, CL, CH) do { \
    const unsigned _ml = (unsigned)(M64), _mh = (unsigned)((M64) >> 32); \
    if (COND) { const int _pos = (h ? (CH) : (CL)) + __popc((h ? _mh : _ml) & ((1u << n) - 1u)); (SCP)[_pos] = (SV); (IXP)[_pos] = (unsigned short)kp; } \
    (CL) += __popc(_ml); (CH) += __popc(_mh); } while (0)
#define DSA_APPEND(SCP, IXP, CNT, M32, MINE, SV) do { \
    const unsigned _m = (M32); \
    if (MINE) { const int _pos = (CNT) + __popc(_m & ((1u << n) - 1u)); (SCP)[_pos] = (SV); (IXP)[_pos] = (unsigned short)kp; } \
    (CNT) += __popc(_m); } while (0)

DEV void st_dsa_index(const P& p, int unit, char* smem) {
    const int tid = tidx(), w = tid >> 6, l = tid & 63, n = l & 31, h = l >> 5;
    char* wb = smem + w * 14336;
    float* sc0 = (float*)wb; float* sc1 = sc0 + 512; float* sc2 = sc1 + 512; float* sc3 = sc2 + 512;
    unsigned short* ix0 = (unsigned short*)(wb + 8192); unsigned short* ix1 = ix0 + 512; unsigned short* ix2 = ix1 + 512; unsigned short* ix3 = ix2 + 512;
    unsigned* hist = (unsigned*)(wb + 12288);
    float* scA = h ? sc2 : sc0; float* scB = h ? sc3 : sc1; unsigned short* ixA = h ? ix2 : ix0; unsigned short* ixB = h ? ix3 : ix1;
    const int wu = unit * 4 + w;
    const int tg = 2047 - wu;
    const int t0 = tg * 4;
    const int tl = 2 * ((n >> 2) & 1) + (n >> 4), hdr = (n & 3) + 4 * ((n >> 3) & 1);
    bf16x8 af[4];
#pragma unroll
    for (int s = 0; s < 4; ++s) af[s] = *(const bf16x8*)(p.IQ() + ((size_t)(t0 + tl) * 8 + hdr) * 64 + 16 * s + 8 * h);
    const int tA = t0 + 2 * h, tB = tA + 1;
    float wA[8], wB[8];
#pragma unroll
    for (int r = 0; r < 8; ++r) { wA[r] = p.IW()[(size_t)tA * 8 + r]; wB[r] = p.IW()[(size_t)tB * 8 + r]; }
    int cnt0 = 0, cnt1 = 0, cnt2 = 0, cnt3 = 0;
    const float NINF = -__builtin_inff();
    float tau0 = NINF, tau1 = NINF, tau2 = NINF, tau3 = NINF;
    const int ntiles = (t0 + 3) / 32 + 1;
    const bf16_t* ikp = p.IK() + (size_t)n * 64 + 8 * h;
    bf16x8 na[4], nb[4];
#pragma unroll
    for (int s = 0; s < 4; ++s) { na[s] = *(const bf16x8*)(ikp + 16 * s); nb[s] = *(const bf16x8*)(ikp + (size_t)(ntiles > 1 ? 32 : 0) * 64 + 16 * s); }
#pragma unroll 1
    for (int kt = 0; kt < ntiles; kt += 2) {
        bf16x8 ca[4], cb[4];
#pragma unroll
        for (int s = 0; s < 4; ++s) { ca[s] = na[s]; cb[s] = nb[s]; }
        {
            const int ka = kt + 2 < ntiles ? kt + 2 : ntiles - 1, kb = kt + 3 < ntiles ? kt + 3 : ntiles - 1;
#pragma unroll
            for (int s = 0; s < 4; ++s) { na[s] = *(const bf16x8*)(ikp + (size_t)ka * 32 * 64 + 16 * s); nb[s] = *(const bf16x8*)(ikp + (size_t)kb * 32 * 64 + 16 * s); }
        }
        f32x16 acca, accb;
#pragma unroll
        for (int r = 0; r < 16; ++r) { acca[r] = 0.f; accb[r] = 0.f; }
#pragma unroll
        for (int s = 0; s < 4; ++s) { acca = mfma32(af[s], ca[s], acca); accb = mfma32(af[s], cb[s], accb); }
        float s0a = 0.f, s1a = 0.f, s0b = 0.f, s1b = 0.f, u0a = 0.f, u1a = 0.f, u0b = 0.f, u1b = 0.f;
#pragma unroll
        for (int r = 0; r < 4; ++r) {
            s0a += wA[r] * fmaxf(acca[r], 0.f); u0a += wA[4 + r] * fmaxf(acca[4 + r], 0.f);
            s1a += wB[r] * fmaxf(acca[8 + r], 0.f); u1a += wB[4 + r] * fmaxf(acca[12 + r], 0.f);
            s0b += wA[r] * fmaxf(accb[r], 0.f); u0b += wA[4 + r] * fmaxf(accb[4 + r], 0.f);
            s1b += wB[r] * fmaxf(accb[8 + r], 0.f); u1b += wB[4 + r] * fmaxf(accb[12 + r], 0.f);
        }
        s0a += u0a; s1a += u1a; s0b += u0b; s1b += u1b;
        const float tauA = h ? tau2 : tau0, tauB = h ? tau3 : tau1;
        {
            const int kp = kt * 32 + n;
            const bool cA = (kp <= tA) && (s0a > tauA), cB = (kp <= tB) && (s1a > tauB);
            const unsigned long long mA = __ballot(cA), mB = __ballot(cB);
            DSA_APPEND2(cA, mA, s0a, scA, ixA, cnt0, cnt2); DSA_APPEND2(cB, mB, s1a, scB, ixB, cnt1, cnt3);
        }
        {
            const int kp = kt * 32 + 32 + n;
            const bool cA = (kp <= tA) && (s0b > tauA), cB = (kp <= tB) && (s1b > tauB);
            const unsigned long long mA = __ballot(cA), mB = __ballot(cB);
            DSA_APPEND2(cA, mA, s0b, scA, ixA, cnt0, cnt2); DSA_APPEND2(cB, mB, s1b, scB, ixB, cnt1, cnt3);
        }
        __builtin_amdgcn_wave_barrier();
        if (max(max(cnt0, cnt1), max(cnt2, cnt3)) > 448) {
            if (cnt0 > 448) tau0 = wave_prune_mid(sc0, ix0, hist, cnt0, l);
            if (cnt1 > 448) tau1 = wave_prune_mid(sc1, ix1, hist, cnt1, l);
            if (cnt2 > 448) tau2 = wave_prune_mid(sc2, ix2, hist, cnt2, l);
            if (cnt3 > 448) tau3 = wave_prune_mid(sc3, ix3, hist, cnt3, l);
        }
    }
    if (cnt0 > 256) { wave_prune(sc0, ix0, hist, cnt0, l); cnt0 = 256; }
    if (cnt1 > 256) { wave_prune(sc1, ix1, hist, cnt1, l); cnt1 = 256; }
    if (cnt2 > 256) { wave_prune(sc2, ix2, hist, cnt2, l); cnt2 = 256; }
    if (cnt3 > 256) { wave_prune(sc3, ix3, hist, cnt3, l); cnt3 = 256; }
    __builtin_amdgcn_wave_barrier();
#pragma unroll
    for (int i = 0; i < 4; ++i) {
        const int e = l + 64 * i;
        p.IDX()[(size_t)(t0 + 0) * 256 + e] = e < cnt0 ? (int)ix0[e] : 0;
        p.IDX()[(size_t)(t0 + 1) * 256 + e] = e < cnt1 ? (int)ix1[e] : 0;
        p.IDX()[(size_t)(t0 + 2) * 256 + e] = e < cnt2 ? (int)ix2[e] : 0;
        p.IDX()[(size_t)(t0 + 3) * 256 + e] = e < cnt3 ? (int)ix3[e] : 0;
    }
    if (l == 0) { p.CNT()[t0] = cnt0; p.CNT()[t0 + 1] = cnt1; p.CNT()[t0 + 2] = cnt2; p.CNT()[t0 + 3] = cnt3; }
}

DEV void st_dsa_attn(const P& p, int unit, char* smem) {
    const int tid = tidx(), w = tid >> 6, l = tid & 63, c = l & 15, g4 = l >> 4;
    int* idxs = (int*)(smem + w * 5120); float* Pl = (float*)(smem + w * 5120 + 1024);
    const size_t t = (size_t)unit * 4 + w;
    const int cnt = p.CNT()[t];
#pragma unroll
    for (int i = 0; i < 4; ++i) idxs[l + 64 * i] = p.IDX()[t * 256 + l + 64 * i];
    __builtin_amdgcn_wave_barrier();
    bf16x8 qf[4];
#pragma unroll
    for (int j = 0; j < 4; ++j) qf[j] = *(const bf16x8*)(p.DQ() + (t * 4 + (c & 3)) * 128 + g4 * 32 + j * 8);
    f32x4 s[16];
    const int ntile = (cnt + 15) >> 4;
#pragma unroll
    for (int th = 0; th < 2; ++th) {
        bf16x8 kf[8][4];
        if (th * 8 < ntile) {
#pragma unroll
            for (int q = 0; q < 8; ++q) {
                const int krow = idxs[(th * 8 + q) * 16 + c];
                const bf16_t* kp = p.DK() + (size_t)krow * 128 + g4 * 32;
#pragma unroll
                for (int j = 0; j < 4; ++j) kf[q][j] = *(const bf16x8*)(kp + j * 8);
            }
        }
#pragma unroll
        for (int q = 0; q < 8; ++q) {
            s[th * 8 + q] = (f32x4){0.f, 0.f, 0.f, 0.f};
            if (th * 8 < ntile) {
#pragma unroll
                for (int j = 0; j < 4; ++j) s[th * 8 + q] = mfma16(kf[q][j], qf[j], s[th * 8 + q]);
            }
        }
        __builtin_amdgcn_sched_barrier(0);
    }
    const float cs = 0.08838834764831845f * 1.4426950408889634f;
    float mx = -1e30f;
#pragma unroll
    for (int tt = 0; tt < 16; ++tt)
#pragma unroll
        for (int r = 0; r < 4; ++r) { const int slot = tt * 16 + 4 * g4 + r; if (slot < cnt) mx = fmaxf(mx, s[tt][r] * cs); }
    mx = fmaxf(mx, __shfl_xor(mx, 16)); mx = fmaxf(mx, __shfl_xor(mx, 32));
    float sum = 0.f;
#pragma unroll
    for (int tt = 0; tt < 16; ++tt)
#pragma unroll
        for (int r = 0; r < 4; ++r) { const int slot = tt * 16 + 4 * g4 + r; const float pv = slot < cnt ? exp2f(s[tt][r] * cs - mx) : 0.f; s[tt][r] = pv; sum += pv; }
    sum += __shfl_xor(sum, 16); sum += __shfl_xor(sum, 32);
    const float inv = sum > 0.f ? 1.0f / sum : 0.f;
    if (c < 4) {
#pragma unroll
        for (int tt = 0; tt < 16; ++tt)
#pragma unroll
            for (int r = 0; r < 4; ++r) Pl[(tt * 16 + 4 * g4 + r) * 4 + c] = s[tt][r] * inv;
    }
    __builtin_amdgcn_wave_barrier();
    float acc[4][8];
#pragma unroll
    for (int hh = 0; hh < 4; ++hh)
#pragma unroll
        for (int j = 0; j < 8; ++j) acc[hh][j] = 0.f;
    const int nk64 = (cnt + 63) >> 6;
#pragma unroll 1
    for (int kb = 0; kb < nk64; ++kb) {
        uint4 raw[16];
#pragma unroll
        for (int q = 0; q < 16; ++q) raw[q] = *(const uint4*)(p.DVC() + (size_t)idxs[(kb * 16 + q) * 4 + g4] * 128 + c * 8);
#pragma unroll
        for (int q = 0; q < 16; ++q) {
            const float4 p4 = *(const float4*)(Pl + ((kb * 16 + q) * 4 + g4) * 4);
            const float vv[8] = {lo2f(raw[q].x), hi2f(raw[q].x), lo2f(raw[q].y), hi2f(raw[q].y), lo2f(raw[q].z), hi2f(raw[q].z), lo2f(raw[q].w), hi2f(raw[q].w)};
            const float pp[4] = {p4.x, p4.y, p4.z, p4.w};
#pragma unroll
            for (int hh = 0; hh < 4; ++hh)
#pragma unroll
                for (int j = 0; j < 8; ++j) acc[hh][j] += pp[hh] * vv[j];
        }
    }
#pragma unroll
    for (int hh = 0; hh < 4; ++hh)
#pragma unroll
        for (int j = 0; j < 8; ++j) { float a = acc[hh][j]; a += __shfl_xor(a, 16); a += __shfl_xor(a, 32); acc[hh][j] = a; }
    if (g4 == 0) {
#pragma unroll
        for (int hh = 0; hh < 4; ++hh) {
            uint4 o; o.x = pk2(acc[hh][0], acc[hh][1]); o.y = pk2(acc[hh][2], acc[hh][3]); o.z = pk2(acc[hh][4], acc[hh][5]); o.w = pk2(acc[hh][6], acc[hh][7]);
            *(uint4*)(p.Y() + t * D + 1536 + hh * 128 + c * 8) = o;
        }
    }
    __builtin_amdgcn_wave_barrier();
}

DEV void ins16(unsigned (&top)[16], unsigned x) {
#pragma unroll
    for (int j = 0; j < 16; ++j) { const unsigned hi = max(top[j], x); x = min(top[j], x); top[j] = hi; }
}
DEV void cex(unsigned& a, unsigned& b) { const unsigned hi = max(a, b), lo = min(a, b); a = hi; b = lo; }
DEV void sort16_desc(unsigned (&v)[16]) {
#pragma unroll
    for (int k = 2; k <= 16; k <<= 1)
#pragma unroll
        for (int j = k >> 1; j > 0; j >>= 1)
#pragma unroll
            for (int i = 0; i < 16; ++i) {
                const int q = i ^ j;
                if (q > i) { if ((i & k) == 0) cex(v[i], v[q]); else cex(v[q], v[i]); }
            }
}
DEV void merge16_desc(unsigned (&top)[16], const unsigned (&x)[16]) {
#pragma unroll
    for (int i = 0; i < 16; ++i) top[i] = max(top[i], x[15 - i]);
#pragma unroll
    for (int j = 8; j > 0; j >>= 1)
#pragma unroll
        for (int i = 0; i < 16; ++i) { const int q = i ^ j; if (q > i) cex(top[i], top[q]); }
}
DEV void st_peer_topk(const P& p, int layer, int unit, char* smem) {
    const int tid = tidx(), w = tid >> 6, l = tid & 63, n = l & 31, hf = l >> 5;
    const int head = unit & 7, tg = (unit >> 3) * 4 + w;
    const size_t t = (size_t)tg * 32 + n;
    unsigned* il = (unsigned*)smem + w * 1024;
    unsigned top[2][16];
#pragma unroll
    for (int pp = 0; pp < 2; ++pp) {
        float qv[32];
#pragma unroll
        for (int i = 0; i < 8; ++i) { const float4 v = *(const float4*)(p.PQ() + t * 1024 + head * 128 + pp * 64 + hf * 32 + i * 4); qv[4 * i] = v.x; qv[4 * i + 1] = v.y; qv[4 * i + 2] = v.z; qv[4 * i + 3] = v.w; }
        const float* K = p.peer_sk + ((((size_t)layer * 8 + head) * 2 + pp) * 128) * 64;
#pragma unroll
        for (int j = 0; j < 16; ++j) top[pp][j] = 0u;
        float kn[32];
        {
            const float* kr = K + (size_t)n * 64 + hf * 32;
#pragma unroll
            for (int i = 0; i < 8; ++i) { const float4 v = *(const float4*)(kr + i * 4); kn[4 * i] = v.x; kn[4 * i + 1] = v.y; kn[4 * i + 2] = v.z; kn[4 * i + 3] = v.w; }
        }
#pragma unroll 1
        for (int tile = 0; tile < 4; ++tile) {
            float kv[32];
#pragma unroll
            for (int i = 0; i < 32; ++i) kv[i] = kn[i];
            if (tile < 3) {
                const float* kr = K + (size_t)((tile + 1) * 32 + n) * 64 + hf * 32;
#pragma unroll
                for (int i = 0; i < 8; ++i) { const float4 v = *(const float4*)(kr + i * 4); kn[4 * i] = v.x; kn[4 * i + 1] = v.y; kn[4 * i + 2] = v.z; kn[4 * i + 3] = v.w; }
            }
            f32x16 acc;
#pragma unroll
            for (int r = 0; r < 16; ++r) acc[r] = 0.f;
#pragma unroll
            for (int kk = 0; kk < 32; ++kk) acc = __builtin_amdgcn_mfma_f32_32x32x2f32(kv[kk], qv[kk], acc, 0, 0, 0);
            unsigned tv[16];
#pragma unroll
            for (int r = 0; r < 16; ++r) {
                const int nn = tile * 32 + (r & 3) + 8 * (r >> 2) + 4 * hf;
                tv[r] = (f2key(acc[r]) & ~127u) | (unsigned)(127 - nn);
            }
            sort16_desc(tv);
            merge16_desc(top[pp], tv);
        }
        unsigned oth[16];
#pragma unroll
        for (int j = 0; j < 16; ++j) oth[j] = __shfl_xor(top[pp][j], 32);
        merge16_desc(top[pp], oth);
        if (hf == 0) {
#pragma unroll
            for (int j = 0; j < 16; ++j) il[(pp * 16 + j) * 32 + n] = 127u - (top[pp][j] & 127u);
        }
    }
    __builtin_amdgcn_wave_barrier();
    if (hf == 0) {
        float v1[16], v2[16];
#pragma unroll
        for (int j = 0; j < 16; ++j) { v1[j] = key2f(top[0][j] & ~127u); v2[j] = key2f(top[1][j] & ~127u); }
        unsigned ct[16];
#pragma unroll
        for (int s = 0; s < 16; ++s) ct[s] = 0u;
#pragma unroll
        for (int i = 0; i < 16; ++i)
#pragma unroll
            for (int j = 0; j < 16; ++j)
                if ((i + 1) * (j + 1) <= 16) ins16(ct, (f2key(v1[i] + v2[j]) & ~255u) | (unsigned)(255 - (i * 16 + j)));
        float ex[16], sum = 0.f; int ce[16];
        const float c0 = key2f(ct[0] & ~255u);
#pragma unroll
        for (int s = 0; s < 16; ++s) {
            const unsigned code = 255u - (ct[s] & 255u);
            ce[s] = (int)(il[(code >> 4) * 32 + n] * 128u + il[(16 + (code & 15u)) * 32 + n]);
            ex[s] = __expf(key2f(ct[s] & ~255u) - c0); sum += ex[s];
        }
        const float inv = 1.0f / sum;
#pragma unroll
        for (int s4 = 0; s4 < 4; ++s4) {
            *(int4*)(p.PE() + t * 128 + head * 16 + s4 * 4) = make_int4(ce[4 * s4], ce[4 * s4 + 1], ce[4 * s4 + 2], ce[4 * s4 + 3]);
            *(float4*)(p.PG() + t * 128 + head * 16 + s4 * 4) = make_float4(ex[4 * s4] * inv, ex[4 * s4 + 1] * inv, ex[4 * s4 + 2] * inv, ex[4 * s4 + 3] * inv);
        }
    }
    __builtin_amdgcn_wave_barrier();
}

DEV void st_peer_gather(const P& p, int layer, const float* __restrict__ xin, float* __restrict__ xout, int unit, char* smem) {
    const int tid_ = tidx(); const int w = tid_ >> 6, l = tid_ & 63; const size_t t = (size_t)unit * 4 + w;
    float* row = (float*)smem + w * 2112;
    const int* pip = p.PI();
    const float ic6 = __int_as_float(__builtin_amdgcn_readfirstlane(pip[32]));
    {
#pragma unroll
        for (int i = 0; i < 4; ++i) {
            const uint4 hv = *(const uint4*)(p.HN() + t * D + i * 512 + l * 8);
            const unsigned u4[4] = {hv.x, hv.y, hv.z, hv.w};
            const int c = i * 512 + l * 8;
#pragma unroll
            for (int q = 0; q < 4; ++q) { row[((c + 2 * q) >> 5) * 33 + ((c + 2 * q) & 31)] = lo2f(u4[q]); row[((c + 2 * q + 1) >> 5) * 33 + ((c + 2 * q + 1) & 31)] = hi2f(u4[q]); }
        }
        __builtin_amdgcn_wave_barrier();
    }
    unsigned hp[16];
#pragma unroll
    for (int j = 0; j < 16; ++j)
        hp[j] = (__float_as_uint(row[l * 33 + __builtin_amdgcn_readfirstlane(pip[2 * j])]) >> 16) |
                (__float_as_uint(row[l * 33 + __builtin_amdgcn_readfirstlane(pip[2 * j + 1])]) & 0xffff0000u);
    __builtin_amdgcn_wave_barrier();
    const int e0 = p.PE()[t * 128 + l], e1 = p.PE()[t * 128 + 64 + l];
    const float g0 = p.PG()[t * 128 + l], g1 = p.PG()[t * 128 + 64 + l];
    float out[32];
#pragma unroll
    for (int i = 0; i < 32; ++i) out[i] = 0.f;
    const unsigned char* U = p.Utab() + (size_t)layer * 16384 * ROW6; const unsigned char* V = p.Vtab() + (size_t)layer * 16384 * ROW6;
    const unsigned voff = (unsigned)l * 8u;
    const bool b5 = (l & 32) != 0, b4 = (l & 16) != 0;
#pragma unroll 1
    for (int k4 = 0; k4 < 32; ++k4) {
        int e[4]; float g[4];
#pragma unroll
        for (int q = 0; q < 4; ++q) {
            const int k = k4 * 4 + q;
            e[q] = __builtin_amdgcn_readlane(k4 < 16 ? e0 : e1, k & 63);
            g[q] = __int_as_float(__builtin_amdgcn_readlane(__float_as_int(k4 < 16 ? g0 : g1), k & 63));
        }
#if PEER_FP4
        uint4 uu[4], vv[4];
#pragma unroll
        for (int q = 0; q < 4; ++q) { uu[q] = *(const uint4*)(U + (size_t)e[q] * ROW6 + 2 * voff); vv[q] = *(const uint4*)(V + (size_t)e[q] * ROW6 + 2 * voff); }
#define GATHER_UNPACK(F, SRC) do { fp4_unpack8((SRC).x, &(F)[0]); fp4_unpack8((SRC).y, &(F)[8]); fp4_unpack8((SRC).z, &(F)[16]); fp4_unpack8((SRC).w, &(F)[24]); } while (0)
#define GATHER_FIRST(SRC) (SRC).x
#else
        uint2 uu[4][3], vv[4][3];
#pragma unroll
        for (int q = 0; q < 4; ++q)
#pragma unroll
            for (int i = 0; i < 3; ++i) { uu[q][i] = *(const uint2*)(U + (size_t)e[q] * ROW6 + (voff + i * 512)); vv[q][i] = *(const uint2*)(V + (size_t)e[q] * ROW6 + (voff + i * 512)); }
#endif
        float d[4];
#pragma unroll
        for (int q = 0; q < 4; ++q) {
#if PEER_FP4
            if (q > 0) asm volatile("" : "+v"(uu[q].x), "+v"(d[q - 1]));
            float f[32]; GATHER_UNPACK(f, uu[q]);
#else
            v6u pk; pk[0] = uu[q][0].x; pk[1] = uu[q][0].y; pk[2] = uu[q][1].x; pk[3] = uu[q][1].y; pk[4] = uu[q][2].x; pk[5] = uu[q][2].y;
            if (q > 0) { unsigned t0_ = pk[0]; asm volatile("" : "+v"(t0_), "+v"(d[q - 1])); pk[0] = t0_; }
            const v32f f = FP6_UNPACK(pk);
#endif
            float acc = 0.f;
#pragma unroll
            for (int j = 0; j < 16; ++j) acc += f[2 * j] * lo2f(hp[j]) + f[2 * j + 1] * hi2f(hp[j]);
            d[q] = acc;
            __builtin_amdgcn_sched_barrier(0);
        }
        float kA = b5 ? d[2] : d[0], kB = b5 ? d[3] : d[1];
        const float sA = b5 ? d[0] : d[2], sB = b5 ? d[1] : d[3];
        kA += __shfl_xor(sA, 32); kB += __shfl_xor(sB, 32);
        float kk = b4 ? kB : kA; const float ss = b4 ? kA : kB;
        kk += __shfl_xor(ss, 16);
        kk += __shfl_xor(kk, 8); kk += __shfl_xor(kk, 4); kk += __shfl_xor(kk, 2); kk += __shfl_xor(kk, 1);
        const float gsel = b5 ? (b4 ? g[3] : g[2]) : (b4 ? g[1] : g[0]);
        const float av = gelu_tanh(kk * (ic6 / U6_SCALE)) * gsel * (ic6 / V6_SCALE);
        const int avi = __float_as_int(av);
        const float a4[4] = {__int_as_float(__builtin_amdgcn_readlane(avi, 0)), __int_as_float(__builtin_amdgcn_readlane(avi, 16)),
                             __int_as_float(__builtin_amdgcn_readlane(avi, 32)), __int_as_float(__builtin_amdgcn_readlane(avi, 48))};
#pragma unroll
        for (int q = 0; q < 4; ++q) {
#if PEER_FP4
            asm volatile("" : "+v"(vv[q].x), "+v"(out[31]));
            float f[32]; GATHER_UNPACK(f, vv[q]);
#else
            v6u pk; pk[0] = vv[q][0].x; pk[1] = vv[q][0].y; pk[2] = vv[q][1].x; pk[3] = vv[q][1].y; pk[4] = vv[q][2].x; pk[5] = vv[q][2].y;
            { unsigned t0_ = pk[0]; asm volatile("" : "+v"(t0_), "+v"(out[31])); pk[0] = t0_; }
            const v32f f = FP6_UNPACK(pk);
#endif
#pragma unroll
            for (int j = 0; j < 32; ++j) out[j] += a4[q] * f[j];
            __builtin_amdgcn_sched_barrier(0);
        }
    }
    asm volatile("" : "+s"(pip));
#pragma unroll
    for (int j = 0; j < 32; ++j) row[l * 33 + __builtin_amdgcn_readfirstlane(pip[j])] = out[j];
    __builtin_amdgcn_wave_barrier();
    const float* g2 = p.ada() + layer * 12288 + 5 * 2048;
    float4 xo[8]; float ssq = 0.f;
#pragma unroll
    for (int i = 0; i < 8; ++i) {
        const int c = i * 256 + l * 4;
        const float* rp = row + (c >> 5) * 33 + (c & 31);
        const size_t off = t * D + c;
        const float4 x0 = *(const float4*)(xin + off); const float4 ga = *(const float4*)(g2 + c);
        float4 o0;
        o0.x = x0.x + ga.x * rp[0]; o0.y = x0.y + ga.y * rp[1]; o0.z = x0.z + ga.z * rp[2]; o0.w = x0.w + ga.w * rp[3];
        *(float4*)(xout + off) = o0;
        xo[i] = o0; ssq += o0.x * o0.x + o0.y * o0.y + o0.z * o0.z + o0.w * o0.w;
        if (i & 1) __builtin_amdgcn_sched_barrier(0);
    }
    if (layer + 1 < NL) {
        const float rs = rsqrtf(wsum(ssq) * (1.0f / 2048.0f) + EPS);
        const float* ng = p.n1g + (layer + 1) * 2048; const float* adn = p.ada() + (layer + 1) * 12288;
#pragma unroll
        for (int i = 0; i < 8; ++i) {
            const int c = i * 256 + l * 4;
            const float4 gg = *(const float4*)(ng + c), sc = *(const float4*)(adn + 2048 + c), sh = *(const float4*)(adn + c);
            uint2 o;
            o.x = pk2((xo[i].x * rs) * gg.x * (1.0f + sc.x) + sh.x, (xo[i].y * rs) * gg.y * (1.0f + sc.y) + sh.y);
            o.y = pk2((xo[i].z * rs) * gg.z * (1.0f + sc.z) + sh.z, (xo[i].w * rs) * gg.w * (1.0f + sc.w) + sh.w);
            *(uint2*)(p.HN() + t * D + c) = o;
            if (i & 1) __builtin_amdgcn_sched_barrier(0);
        }
    }
    __builtin_amdgcn_wave_barrier();
}

enum { S_CONVT_IN = 0, S_CONVT_OUT, S_CONVT_Q, S_CONVT_W1, S_CALIB, S_TAB_U, S_TAB_V, S_ADA, S_ROPE, S_NORM1, S_GEMM_IN, S_CONV, S_SGU, S_VTRANS, S_PREP,
       S_COMPRESS, S_NSA_CMP, S_DSA_INDEX, S_NSA_ATTN, S_DSA_ATTN, S_GEMM_OUT, S_NORM2, S_GEMM_Q, S_PEER_TOPK, S_PEER_GATHER, S_COUNT };
constexpr int TAB_UNITS = 4096;
__host__ __device__ constexpr int nunits(int s) {
    return s == S_CONVT_IN ? 2 * 32 * (LDP / 64) : s == S_CONVT_OUT ? 2 * 32 * 32 : s == S_CONVT_Q ? 2 * 32 * 16 : s == S_CONVT_W1 ? 4 * 64 * 2 : s == S_CALIB ? 1 : s == S_TAB_U ? TAB_UNITS : s == S_TAB_V ? TAB_UNITS
         : s == S_ADA ? 384 : s == S_ROPE ? 768 : s == S_NORM1 ? 2048 : s == S_GEMM_IN ? 64 * (LDP / 128) : s == S_CONV ? 512 : s == S_SGU ? 256
         : s == S_VTRANS ? 256 : s == S_PREP ? 2048 : s == S_COMPRESS ? 64 : s == S_NSA_CMP ? 512 : s == S_DSA_INDEX ? 512 : s == S_NSA_ATTN ? 512 : s == S_DSA_ATTN ? 2048
         : s == S_GEMM_OUT ? 64 * 16 : s == S_NORM2 ? 2048 : s == S_GEMM_Q ? 64 * 8 : s == S_PEER_TOPK ? 512 : s == S_PEER_GATHER ? 2048 : 0;
}
template <int S>
DEV void run_unit(const P& p, int layer, int u, char* smem, int nu = TAB_UNITS) {
    const float* xin = layer == 0 ? p.x : p.X2();
    const float* ada = p.ada() + layer * 12288;
    if constexpr (S == S_CONVT_IN) { const int per = 32 * (LDP / 64), ly = u / per; st_convT(p.w_in + (size_t)ly * 2048 * INC, p.WinT() + (size_t)ly * LDP * 2048, INC, LDP, true, u % per, smem); }
    else if constexpr (S == S_CONVT_OUT) { const int per = 32 * 32, ly = u / per; st_convT(p.w_out + (size_t)ly * 2048 * 2048, p.WoutT() + (size_t)ly * 2048 * 2048, 2048, 2048, false, u % per, smem); }
    else if constexpr (S == S_CONVT_Q) { const int per = 32 * 16, ly = u / per; st_convT(p.peer_wq + (size_t)ly * 2048 * 1024, p.WqT() + (size_t)ly * 1024 * 2048, 1024, 1024, false, u % per, smem); }
    else if constexpr (S == S_CONVT_W1) { const int per = 64 * 2, mi = u / per; st_convT(p.cmp_w1 + (size_t)mi * 4096 * 128, p.W1T() + (size_t)mi * 128 * 4096, 128, 128, false, u % per, smem, 4096); }
    else if constexpr (S == S_CALIB) st_calib(p);
#if PEER_FP4
    else if constexpr (S == S_TAB_U) st_tab4(p, p.peer_u, p.Utab(), U6_SCALE, 2 * 16384, u, nu, smem);
    else if constexpr (S == S_TAB_V) st_tab4(p, p.peer_v, p.Vtab(), V6_SCALE, 2 * 16384, u, nu, smem);
#else
    else if constexpr (S == S_TAB_U) st_tab6(p.peer_u, p.Utab(), U6_SCALE, 2 * 16384, u, nu, smem);
    else if constexpr (S == S_TAB_V) st_tab6(p.peer_v, p.Vtab(), V6_SCALE, 2 * 16384, u, nu, smem);
#endif
    else if constexpr (S == S_ADA) st_ada(p, u, smem);
    else if constexpr (S == S_ROPE) st_rope(p, u);
    else if constexpr (S == S_NORM1) st_norm(xin, p.n1g + layer * 2048, ada + 2048, ada, p.HN(), u);
    else if constexpr (S == S_GEMM_IN) { EpiArgs e{p.PROJ(), nullptr, nullptr, nullptr, p.KVC()}; st_gemm<EPI_PROJ>(p.HN(), p.WinT() + (size_t)layer * LDP * 2048, 2048, u & 63, u >> 6, e, smem); }
    else if constexpr (S == S_CONV) st_conv(p, layer, u, smem);
    else if constexpr (S == S_SGU) st_sgu(p, layer, u, smem);
    else if constexpr (S == S_VTRANS) st_vtrans(p, u, smem);
    else if constexpr (S == S_PREP) st_prep(p, layer, u);
    else if constexpr (S == S_COMPRESS) st_compress(p, layer, u, smem);
    else if constexpr (S == S_NSA_CMP) st_nsa_cmp(p, u, smem);
    else if constexpr (S == S_DSA_INDEX) st_dsa_index(p, u, smem);
    else if constexpr (S == S_NSA_ATTN) st_nsa_attn(p, u, smem);
    else if constexpr (S == S_DSA_ATTN) st_dsa_attn(p, u, smem);
    else if constexpr (S == S_GEMM_OUT) { EpiArgs e{nullptr, p.X1(), xin, ada + 2 * 2048, nullptr}; st_gemm<EPI_OUT>(p.Y(), p.WoutT() + (size_t)layer * 2048 * 2048, 2048, u & 63, u >> 6, e, smem); }
    else if constexpr (S == S_NORM2) st_norm(p.X1(), p.n2g + layer * 2048, ada + 4 * 2048, ada + 3 * 2048, p.HN(), u);
    else if constexpr (S == S_GEMM_Q) { EpiArgs e{nullptr, p.PQ(), nullptr, nullptr, nullptr}; st_gemm<EPI_Q>(p.HN(), p.WqT() + (size_t)layer * 1024 * 2048, 2048, u & 63, u >> 6, e, smem); }
    else if constexpr (S == S_PEER_TOPK) st_peer_topk(p, layer, u, smem);
    else if constexpr (S == S_PEER_GATHER) st_peer_gather(p, layer, p.X1(), layer == 0 ? p.X2() : p.out, u, smem);
}


#define XB_TMO      128
#define XB_XCNT(j)  (256  + 64 * (j))
#define XB_XSUB(j)  (1280 + 64 * (j))
#define XB_XGEN(j)  (2304 + 64 * (j))
#define XB_TOP      3328
#define XB_TOPGEN   3392
#define XB_SPIN_CAP (1u << 22)
#define LAS __attribute__((address_space(3)))
DEV unsigned xb_ld(unsigned* p) { return __hip_atomic_load(p, __ATOMIC_RELAXED, __HIP_MEMORY_SCOPE_AGENT); }
DEV unsigned xb_add(unsigned* p, unsigned v) { return __hip_atomic_fetch_add(p, v, __ATOMIC_RELAXED, __HIP_MEMORY_SCOPE_AGENT); }
DEV unsigned xb_xcc_id() { return (unsigned)__builtin_amdgcn_s_getreg((3 << 11) | 20) & 0xFu; }
#define XB_SPIN(cond, bar) do { unsigned _sp = 0; while (cond) { __builtin_amdgcn_s_sleep(1); \
    if ((++_sp & 255u) == 0u) { if (xb_ld(&(bar)[XB_TMO])) break; if (_sp > XB_SPIN_CAP) { atomicAdd(&(bar)[XB_TMO], 1u); break; } } } } while (0)
struct XcdBarrier { unsigned* bar; unsigned x; volatile LAS unsigned* st; };
DEV XcdBarrier xcd_barrier_post(unsigned* bar, volatile LAS unsigned* st) {
    XcdBarrier b; b.bar = bar; b.x = xb_xcc_id(); b.st = st;
    if (threadIdx.x == 0) (void)xb_add(&bar[XB_XCNT(b.x)], 1u);
    return b;
}
DEV void xcd_barrier_complete(unsigned* bar, unsigned x, unsigned& nloc, unsigned& nx) {
    const unsigned G = gridDim.x * gridDim.y * gridDim.z;
    unsigned sum, cnt, mine, sp = 0u;
    for (;;) {
        sum = 0u; cnt = 0u; mine = 0u;
#pragma unroll
        for (unsigned j = 0; j < 16; ++j) { const unsigned c = xb_ld(&bar[XB_XCNT(j)]); sum += c; cnt += (c > 0u) ? 1u : 0u; mine = (j == x) ? c : mine; }
        if (sum == G) break;
        __builtin_amdgcn_s_sleep(1);
        if ((++sp & 255u) == 0u) { if (xb_ld(&bar[XB_TMO])) break; if (sp > XB_SPIN_CAP) { atomicAdd(&bar[XB_TMO], 1u); break; } }
    }
    nloc = mine > 0u ? mine : 1u; nx = cnt > 0u ? cnt : 1u;
}
DEV void xcd_barrier(const XcdBarrier& b) {
    asm volatile("s_waitcnt vmcnt(0)" ::: "memory");
    __syncthreads();
    if (threadIdx.x == 0) {
        unsigned* bar = b.bar;
        __builtin_amdgcn_s_waitcnt(0);
        unsigned nloc = b.st[0], nx = b.st[1];
        if (nloc == 0u) { xcd_barrier_complete(bar, b.x, nloc, nx); b.st[0] = nloc; b.st[1] = nx; }
        const unsigned old = xb_add(&bar[XB_XSUB(b.x)], 1u);
        const unsigned gen = old / nloc;
        if (old + 1u == (gen + 1u) * nloc) {
            __builtin_amdgcn_fence(__ATOMIC_RELEASE, "agent");
            asm volatile("s_waitcnt vmcnt(0)" ::: "memory");
            const unsigned og = xb_add(&bar[XB_TOP], 1u);
            const unsigned tg = og / nx;
            if (og + 1u == (tg + 1u) * nx) xb_add(&bar[XB_TOPGEN], 1u);
            else XB_SPIN(xb_ld(&bar[XB_TOPGEN]) == tg, bar);
            __builtin_amdgcn_fence(__ATOMIC_ACQUIRE, "agent");
            xb_add(&bar[XB_XGEN(b.x)], 1u);
            asm volatile("s_waitcnt vmcnt(0)" ::: "memory");
        } else {
            XB_SPIN(xb_ld(&bar[XB_XGEN(b.x)]) == gen, bar);
            __builtin_amdgcn_fence(__ATOMIC_ACQUIRE, "agent");
            asm volatile("s_waitcnt vmcnt(0)" ::: "memory");
        }
    }
    __syncthreads();
}

#ifndef MULTI_LAUNCH
constexpr int REP_STAGE = -1, REP_STAGE2 = -1, REP_N = 1;
template <int S, int LIM = 0>
DEV void run_phase1(const P& p, int layer, char* smem, int off);
template <int S, int LIM = 0>
DEV void run_phase(const P& p, int layer, char* smem, int off = 0) {
    constexpr int reps = (S == REP_STAGE || S == REP_STAGE2) ? REP_N : 1;
#pragma unroll 1
    for (int r = 0; r < reps; ++r) run_phase1<S, LIM>(p, layer, smem, off);
}
template <int S, int LIM>
DEV void run_phase1(const P& p, int layer, char* smem, int off) {
    const int G = gridDim.x;
    int b = blockIdx.x + off; if (b >= G) b -= G;
    if constexpr (S == S_TAB_U || S == S_TAB_V) { run_unit<S>(p, layer, b, smem, G); }
    else {
        for (int u = b; u < (LIM ? LIM : nunits(S)); u += G) { run_unit<S>(p, layer, u, smem); __syncthreads(); }
    }
}
template <int S>
DEV void run_gemm_phase1(const P& p, int layer, char* smem, unsigned xcc, volatile LAS unsigned* slot, int rep) {
    constexpr int TN = (S == S_GEMM_IN) ? (LDP / 128) : (S == S_GEMM_OUT ? 16 : 8);
    constexpr int NBIG = (S == S_GEMM_IN) ? 32 : (S == S_GEMM_OUT ? 16 : 0);
    constexpr int inst0 = (S == S_GEMM_IN) ? 0 : (S == S_GEMM_OUT ? 2 : 4);
    constexpr int nbig = 4 * NBIG, len = nbig + 8 * (TN - NBIG);
    const float* xin = layer == 0 ? p.x : p.X2();
    const float* ada = p.ada() + layer * 12288;
    const bf16_t* Aop = (S == S_GEMM_OUT) ? p.Y() : p.HN();
    const bf16_t* Bop = (S == S_GEMM_IN) ? p.WinT() + (size_t)layer * LDP * 2048 : (S == S_GEMM_OUT ? p.WoutT() + (size_t)layer * 2048 * 2048 : p.WqT() + (size_t)layer * 1024 * 2048);
    EpiArgs e{p.PROJ(), (S == S_GEMM_OUT) ? p.X1() : p.PQ(), xin, ada + 2 * 2048, p.KVC()};
    constexpr int EPI = (S == S_GEMM_IN) ? EPI_PROJ : (S == S_GEMM_OUT ? EPI_OUT : EPI_Q);
#pragma unroll 1
    for (int q = 0; q < 8; ++q) {
        const unsigned xq = (xcc + q) & 7u;
        unsigned* head = p.bar() + GQ_WORD(inst0 + layer + 6 * rep, xq);
        for (;;) {
            if (threadIdx.x == 0) *slot = xb_add(head, 1u);
            __syncthreads();
            const int i = (int)*slot;
            __syncthreads();
            if (i >= len) break;
            if (i < nbig) st_gemm<EPI, 8>(Aop, Bop, 2048, (int)xq * 4 + (i & 3), i >> 2, e, smem);
            else {
                const int j = i - nbig, tm = (int)xq * 8 + (j & 7), tn = NBIG + (j >> 3);
                st_gemm<EPI, 4>(Aop, Bop, 2048, tm, tn, e, smem);
                if constexpr (S == S_GEMM_Q) {
                    asm volatile("s_waitcnt vmcnt(0)" ::: "memory");
                    __syncthreads();
                    st_peer_topk(p, layer, tm * 8 + tn, smem);
                }
            }
            __syncthreads();
        }
    }
}
template <int S>
DEV void run_items(const P& p, int layer, char* smem, int first, int count) {
    constexpr int reps = (S == REP_STAGE || S == REP_STAGE2) ? REP_N : 1;
#pragma unroll 1
    for (int r = 0; r < reps; ++r)
#pragma unroll 1
        for (int u = first; u < first + count; ++u) { run_unit<S>(p, layer, u, smem); __syncthreads(); }
}
DEV void dep_publish(unsigned* cnt) {
    asm volatile("s_waitcnt vmcnt(0)" ::: "memory");
    __syncthreads();
    if (threadIdx.x == 0) { __builtin_amdgcn_fence(__ATOMIC_RELEASE, "agent"); asm volatile("s_waitcnt vmcnt(0)" ::: "memory"); (void)xb_add(cnt, 1u); }
}
DEV void dep_wait(unsigned* cnt, unsigned target, unsigned* bar) {
    if (threadIdx.x == 0) {
        XB_SPIN(xb_ld(cnt) < target, bar);
        __builtin_amdgcn_fence(__ATOMIC_ACQUIRE, "agent");
        asm volatile("s_waitcnt vmcnt(0)" ::: "memory");
    }
    __syncthreads();
}
template <int PH>
DEV void run_dyn_phase(const P& p, int layer, char* smem, volatile LAS unsigned* slot) {
    unsigned* head = p.bar() + DQ_WORD(PH * 2 + layer);
    unsigned* cprep = p.bar() + DQ_WORD(12 + layer); unsigned* ccomp = p.bar() + DQ_WORD(14 + layer);
    constexpr int total0 = PH == 0 ? (256 + 64 + 256 + 256 + 64 + 512 + 256) : (512 + 512);
    const int total = (PH == 0 && layer == 0) ? total0 + 512 + 296 + 256 + 128 : total0;
    int i = blockIdx.x;
    while (i < total) {
        if constexpr (PH == 0) {
            if (i < 256) { run_items<S_PREP>(p, layer, smem, i * 8, 8); dep_publish(cprep); }
            else if (i < 320) { run_items<S_COMPRESS>(p, layer, smem, i - 256, 1); dep_publish(ccomp); }
            else if (i < 576) run_items<S_SGU>(p, layer, smem, i - 320, 1);
            else if (i < 832) run_items<S_CONV>(p, layer, smem, (i - 576) * 2, 2);
            else if (i < 896) run_items<S_VTRANS>(p, layer, smem, (i - 832) * 4, 4);
            else if (i < 1408) { dep_wait(cprep, 256u, p.bar()); run_items<S_DSA_INDEX>(p, layer, smem, i - 896, 1); }
            else if (i < 1664) { dep_wait(cprep, 256u, p.bar()); dep_wait(ccomp, 64u, p.bar()); run_items<S_NSA_CMP>(p, layer, smem, (i - 1408) * 2, 2); }
            else if (i < 1920) { run_unit<S_TAB_U>(p, layer, i - 1664, smem, 256); __syncthreads(); }
            else if (i < 2176) { run_unit<S_TAB_V>(p, layer, i - 1920, smem, 256); __syncthreads(); }
            else if (i < 2472) run_items<S_CONVT_IN>(p, layer, smem, 2368 + (i - 2176) * 8, 8);
            else if (i < 2728) run_items<S_CONVT_OUT>(p, layer, smem, (i - 2472) * 8, 8);
            else run_items<S_CONVT_Q>(p, layer, smem, (i - 2728) * 8, 8);
        } else {
            if (i < 512) run_items<S_NSA_ATTN>(p, layer, smem, 511 - i, 1);
            else run_items<S_DSA_ATTN>(p, layer, smem, (i - 512) * 4, 4);
        }
        if (threadIdx.x == 0) *slot = gridDim.x + xb_add(head, 1u);
        __syncthreads();
        i = (int)*slot;
        __syncthreads();
    }
}
template <int S>
DEV void run_gemm_phase(const P& p, int layer, char* smem, unsigned xcc, volatile LAS unsigned* slot) {
    constexpr int reps = (S == REP_STAGE || S == REP_STAGE2) ? REP_N : 1;
#pragma unroll 1
    for (int r = 0; r < reps; ++r) run_gemm_phase1<S>(p, layer, smem, xcc, slot, r);
}
#if defined(__HIP_DEVICE_COMPILE__)
typedef const P __attribute__((address_space(4)))* kargp_t;
DEV const P& fresh_params() { kargp_t q = (kargp_t)__builtin_amdgcn_kernarg_segment_ptr(); asm volatile("" : "+s"(q)); return *(const P*)q; }
#define PP fresh_params()
#else
#define PP p
#endif
#define GSYNC() xcd_barrier(xb)
__global__ void __launch_bounds__(NTHREADS, 2) k_mega(P p) {
    __shared__ __attribute__((aligned(16))) char smem[SMEM_BYTES];
    __shared__ uint4 xb_words;
    cg::grid_group grid = cg::this_grid();
    if (threadIdx.x == 0) xb_words = make_uint4(0u, 0u, 0u, 0u);
    __syncthreads();
    XcdBarrier xb = xcd_barrier_post(p.bar(), (volatile LAS unsigned*)&xb_words);
    const int H = gridDim.x >> 1, Q = gridDim.x >> 2;
    run_phase<S_ADA>(PP, 0, smem); run_phase<S_ROPE>(PP, 0, smem, H);
    run_phase<S_CONVT_IN, 2368>(PP, 0, smem); run_phase<S_CONVT_W1>(PP, 0, smem); run_phase<S_CALIB>(PP, 0, smem, 100);
    GSYNC();
    if (gridDim.x == 0x7fffffffu) grid.sync();
#pragma unroll 1
    for (int layer = 0; layer < NL; ++layer) {
        if (layer == 0) { run_phase<S_NORM1>(PP, layer, smem); GSYNC(); }
        run_gemm_phase<S_GEMM_IN>(PP, layer, smem, xb.x, (volatile LAS unsigned*)&xb_words + 2); GSYNC();
        run_dyn_phase<0>(PP, layer, smem, (volatile LAS unsigned*)&xb_words + 2); GSYNC();
        run_dyn_phase<2>(PP, layer, smem, (volatile LAS unsigned*)&xb_words + 2); GSYNC();
        run_gemm_phase<S_GEMM_OUT>(PP, layer, smem, xb.x, (volatile LAS unsigned*)&xb_words + 2); GSYNC();
        run_phase<S_NORM2>(PP, layer, smem); GSYNC();
        run_gemm_phase<S_GEMM_Q>(PP, layer, smem, xb.x, (volatile LAS unsigned*)&xb_words + 2); GSYNC();
        run_phase<S_PEER_GATHER>(PP, layer, smem); if (layer + 1 < NL) GSYNC();
    }
}
#else
template <int S>
__global__ void __launch_bounds__(NTHREADS) k_stage(P p, int layer) {
    __shared__ __attribute__((aligned(16))) char smem[SMEM_BYTES];
    run_unit<S>(p, layer, blockIdx.x, smem);
}
template <int S> static void launch_stage(const P& p, int layer, hipStream_t st) {
    hipLaunchKernelGGL((k_stage<S>), dim3(nunits(S)), dim3(NTHREADS), 0, st, p, layer);
}
#endif

extern "C" void kernel_launch(void* const* d_in, const int* in_sizes, int n_in, void* d_out, int out_size, void* d_ws, size_t ws_size, hipStream_t stream) {
    P p{};
    p.x = (const float*)d_in[0]; p.c = (const float*)d_in[1]; p.pos = (const int*)d_in[2]; p.ada_w = (const float*)d_in[3]; p.ada_b = (const float*)d_in[4];
    p.n1g = (const float*)d_in[5]; p.n2g = (const float*)d_in[6]; p.w_in = (const float*)d_in[7]; p.w_out = (const float*)d_in[8]; p.conv_w = (const float*)d_in[9];
    p.conv_b = (const float*)d_in[10]; p.cln_g = (const float*)d_in[11]; p.cln_b = (const float*)d_in[12]; p.sln_g = (const float*)d_in[13]; p.sln_b = (const float*)d_in[14];
    p.sgu_w = (const float*)d_in[15]; p.sgu_b = (const float*)d_in[16]; p.nsa_qg = (const float*)d_in[17]; p.nsa_kg = (const float*)d_in[18]; p.cmp_pos = (const float*)d_in[19];
    p.cmp_w1 = (const float*)d_in[20]; p.cmp_w2 = (const float*)d_in[21]; p.dsa_qg = (const float*)d_in[22]; p.dsa_kg = (const float*)d_in[23]; p.peer_wq = (const float*)d_in[24];
    p.peer_sk = (const float*)d_in[25]; p.peer_u = (const float*)d_in[26]; p.peer_v = (const float*)d_in[27];
    p.out = (float*)d_out;
    p.ws = (char*)d_ws; const size_t off = WS_TOTAL;
    if (off > ws_size) { fprintf(stderr, "workspace too small: need %zu have %zu\n", off, ws_size); return; }
#ifndef MULTI_LAUNCH
    static int grid_blocks = 0;
    if (!grid_blocks) {
        int dev = 0, cus = 0, per_cu = 0;
        (void)hipGetDevice(&dev);
        (void)hipDeviceGetAttribute(&cus, hipDeviceAttributeMultiprocessorCount, dev);
        (void)hipOccupancyMaxActiveBlocksPerMultiprocessor(&per_cu, k_mega, NTHREADS, 0);
        if (per_cu > 2) per_cu = 2;
        grid_blocks = cus * per_cu;
    }
    (void)hipMemsetAsync(p.bar(), 0, (size_t)CTRL_WORDS * 4, stream);
    void* args[] = {&p};
    hipError_t e = hipLaunchCooperativeKernel((void*)k_mega, dim3(grid_blocks), dim3(NTHREADS), args, 0, stream);
    if (e != hipSuccess) fprintf(stderr, "cooperative launch failed: %s (grid %d)\n", hipGetErrorString(e), grid_blocks);
#else
    launch_stage<S_CONVT_IN>(p, 0, stream); launch_stage<S_CONVT_OUT>(p, 0, stream); launch_stage<S_CONVT_Q>(p, 0, stream); launch_stage<S_CONVT_W1>(p, 0, stream); launch_stage<S_CALIB>(p, 0, stream);
    launch_stage<S_TAB_U>(p, 0, stream); launch_stage<S_TAB_V>(p, 0, stream);
    launch_stage<S_ADA>(p, 0, stream); launch_stage<S_ROPE>(p, 0, stream);
    for (int layer = 0; layer < NL; ++layer) {
        launch_stage<S_NORM1>(p, layer, stream); launch_stage<S_GEMM_IN>(p, layer, stream);
        launch_stage<S_CONV>(p, layer, stream); launch_stage<S_SGU>(p, layer, stream); launch_stage<S_VTRANS>(p, layer, stream);
        launch_stage<S_PREP>(p, layer, stream); launch_stage<S_COMPRESS>(p, layer, stream);
        launch_stage<S_NSA_CMP>(p, layer, stream); launch_stage<S_DSA_INDEX>(p, layer, stream);
        launch_stage<S_NSA_ATTN>(p, layer, stream); launch_stage<S_DSA_ATTN>(p, layer, stream);
        launch_stage<S_GEMM_OUT>(p, layer, stream); launch_stage<S_NORM2>(p, layer, stream); launch_stage<S_GEMM_Q>(p, layer, stream);
        launch_stage<S_PEER_TOPK>(p, layer, stream); launch_stage<S_PEER_GATHER>(p, layer, stream);
    }
#endif
}
```

```cpp
#include <hip/hip_runtime.h>
#include <hip/hip_cooperative_groups.h>
#include <stdint.h>
#include <cstdio>
namespace cg = cooperative_groups;

typedef unsigned short bf16_t;
typedef short bf16x8 __attribute__((ext_vector_type(8)));
typedef float f32x4 __attribute__((ext_vector_type(4)));
typedef float f32x16 __attribute__((ext_vector_type(16)));
#define DEV __device__ __forceinline__

constexpr int T = 8192, D = 2048, NL = 2;
constexpr int INC = 4692;
constexpr int LDP = 4736;
constexpr int C_CA = 0, C_CG = 512, C_SU = 1024, C_SV = 1536;
constexpr int C_NQ = 2048, C_NKC = 2560, C_NVC = 2688, C_NKS = 2816, C_NVS = 2944, C_NKW = 3072, C_NVW = 3200;
constexpr int C_DQ = 3328, C_DK = 3840, C_DV = 3968, C_IQ = 4096, C_IK = 4608, C_NG = 4672, C_IW = 4688;
constexpr float EPS = 1e-6f;
constexpr int NTHREADS = 256;
constexpr int SMEM_BYTES = 72 * 1024;

__device__ const double INV16[16] = {1.0, 0.44036660267178046, 0.19392274474868576, 0.08539710028576561, 0.03760603093086393,
    0.016560440080994446, 0.007292664737217109, 0.003211445994752591, 0.001414213562373095, 0.000622772421914596,
    0.0002742481756762073, 0.00012076973741146504, 5.318295896944988e-05, 2.341999896140934e-05, 1.031338537721246e-05,
    4.5416704806078695e-06};

#define XCD_BAR_WORDS 3456
#define GQ_WORD(inst, x) (XCD_BAR_WORDS + 64 * ((inst) * 8 + (x)))
#define DQ_WORD(k) (XCD_BAR_WORDS + 64 * (96 + (k)))
#define CTRL_WORDS (XCD_BAR_WORDS + 64 * 112)
constexpr size_t WS_ALIGN(size_t x) { return (x + 255) & ~(size_t)255; }
constexpr size_t OFF_WinT = 0;
constexpr size_t OFF_WoutT = OFF_WinT + WS_ALIGN((size_t)2 * LDP * 2048 * 2);
constexpr size_t OFF_WqT = OFF_WoutT + WS_ALIGN((size_t)2 * 2048 * 2048 * 2);
constexpr size_t OFF_W1T = OFF_WqT + WS_ALIGN((size_t)2 * 1024 * 2048 * 2);
constexpr size_t OFF_PI = OFF_W1T + WS_ALIGN((size_t)4 * 128 * 4096 * 2);
constexpr size_t OFF_Utab = OFF_PI + WS_ALIGN(256);
constexpr size_t OFF_Vtab = OFF_Utab + WS_ALIGN((size_t)2 * 16384 * 1536);
constexpr size_t OFF_ada = OFF_Vtab + WS_ALIGN((size_t)2 * 16384 * 1536);
constexpr size_t OFF_ropeC = OFF_ada + WS_ALIGN((size_t)2 * 12288 * 4);
constexpr size_t OFF_ropeS = OFF_ropeC + WS_ALIGN((size_t)T * 24 * 4);
constexpr size_t OFF_HN = OFF_ropeS + WS_ALIGN((size_t)T * 24 * 4);
constexpr size_t OFF_PROJ = OFF_HN + WS_ALIGN((size_t)T * D * 2);
constexpr size_t OFF_Y = OFF_PROJ + WS_ALIGN((size_t)T * LDP * 2);
constexpr size_t OFF_QN = OFF_Y + WS_ALIGN((size_t)T * D * 2);
constexpr size_t OFF_QR = OFF_QN + WS_ALIGN((size_t)T * 512 * 2);
constexpr size_t OFF_KS = OFF_QR + WS_ALIGN((size_t)T * 512 * 2);
constexpr size_t OFF_KW = OFF_KS + WS_ALIGN((size_t)T * 128 * 2);
constexpr size_t OFF_VST = OFF_KW + WS_ALIGN((size_t)T * 128 * 2);
constexpr size_t OFF_VWT = OFF_VST + WS_ALIGN((size_t)T * 128 * 2);
constexpr size_t OFF_GATES = OFF_VWT + WS_ALIGN((size_t)T * 128 * 2);
constexpr size_t OFF_KC = OFF_GATES + WS_ALIGN((size_t)T * 12 * 4);
constexpr size_t OFF_VCT = OFF_KC + WS_ALIGN((size_t)512 * 128 * 2);
constexpr size_t OFF_SEL = OFF_VCT + WS_ALIGN((size_t)128 * 512 * 2);
constexpr size_t OFF_OCMP = OFF_SEL + WS_ALIGN((size_t)T * 4 * 4);
constexpr size_t OFF_DQ = OFF_OCMP + WS_ALIGN((size_t)T * 512 * 2);
constexpr size_t OFF_DK = OFF_DQ + WS_ALIGN((size_t)T * 512 * 2);
constexpr size_t OFF_DVC = OFF_DK + WS_ALIGN((size_t)T * 128 * 2);
constexpr size_t OFF_KVC = OFF_DVC + WS_ALIGN((size_t)T * 128 * 2);
constexpr size_t OFF_IQ = OFF_KVC + WS_ALIGN((size_t)T * 256 * 2);
constexpr size_t OFF_IK = OFF_IQ + WS_ALIGN((size_t)T * 512 * 2);
constexpr size_t OFF_IW = OFF_IK + WS_ALIGN((size_t)T * 64 * 2);
constexpr size_t OFF_IDX = OFF_IW + WS_ALIGN((size_t)T * 8 * 4);
constexpr size_t OFF_CNT = OFF_IDX + WS_ALIGN((size_t)T * 256 * 4);
constexpr size_t OFF_X1 = OFF_CNT + WS_ALIGN((size_t)T * 4);
constexpr size_t OFF_X2 = OFF_X1 + WS_ALIGN((size_t)T * D * 4);
constexpr size_t OFF_PQ = OFF_X2 + WS_ALIGN((size_t)T * D * 4);
constexpr size_t OFF_PE = OFF_PQ + WS_ALIGN((size_t)T * 1024 * 4);
constexpr size_t OFF_PG = OFF_PE + WS_ALIGN((size_t)T * 128 * 4);
constexpr size_t OFF_bar = OFF_PG + WS_ALIGN((size_t)T * 128 * 4);
constexpr size_t WS_TOTAL = OFF_bar + WS_ALIGN((size_t)CTRL_WORDS * 4);

struct P {
    const float* x; const float* c; const int* pos; const float* ada_w; const float* ada_b; const float* n1g; const float* n2g;
    const float* w_in; const float* w_out; const float* conv_w; const float* conv_b; const float* cln_g; const float* cln_b;
    const float* sln_g; const float* sln_b; const float* sgu_w; const float* sgu_b; const float* nsa_qg; const float* nsa_kg;
    const float* cmp_pos; const float* cmp_w1; const float* cmp_w2; const float* dsa_qg; const float* dsa_kg;
    const float* peer_wq; const float* peer_sk; const float* peer_u; const float* peer_v;
    float* out;
    char* ws;
    __host__ __device__ __forceinline__ bf16_t* WinT() const { return (bf16_t*)(ws + OFF_WinT); }
    __host__ __device__ __forceinline__ bf16_t* WoutT() const { return (bf16_t*)(ws + OFF_WoutT); }
    __host__ __device__ __forceinline__ bf16_t* WqT() const { return (bf16_t*)(ws + OFF_WqT); }
    __host__ __device__ __forceinline__ bf16_t* W1T() const { return (bf16_t*)(ws + OFF_W1T); }
    __host__ __device__ __forceinline__ int* PI() const { return (int*)(ws + OFF_PI); }
    __host__ __device__ __forceinline__ unsigned char* Utab() const { return (unsigned char*)(ws + OFF_Utab); }
    __host__ __device__ __forceinline__ unsigned char* Vtab() const { return (unsigned char*)(ws + OFF_Vtab); }
    __host__ __device__ __forceinline__ float* ada() const { return (float*)(ws + OFF_ada); }
    __host__ __device__ __forceinline__ float* ropeC() const { return (float*)(ws + OFF_ropeC); }
    __host__ __device__ __forceinline__ float* ropeS() const { return (float*)(ws + OFF_ropeS); }
    __host__ __device__ __forceinline__ bf16_t* HN() const { return (bf16_t*)(ws + OFF_HN); }
    __host__ __device__ __forceinline__ bf16_t* PROJ() const { return (bf16_t*)(ws + OFF_PROJ); }
    __host__ __device__ __forceinline__ bf16_t* Y() const { return (bf16_t*)(ws + OFF_Y); }
    __host__ __device__ __forceinline__ bf16_t* QN() const { return (bf16_t*)(ws + OFF_QN); }
    __host__ __device__ __forceinline__ bf16_t* QR() const { return (bf16_t*)(ws + OFF_QR); }
    __host__ __device__ __forceinline__ bf16_t* KS() const { return (bf16_t*)(ws + OFF_KS); }
    __host__ __device__ __forceinline__ bf16_t* KW() const { return (bf16_t*)(ws + OFF_KW); }
    __host__ __device__ __forceinline__ bf16_t* VST() const { return (bf16_t*)(ws + OFF_VST); }
    __host__ __device__ __forceinline__ bf16_t* VWT() const { return (bf16_t*)(ws + OFF_VWT); }
    __host__ __device__ __forceinline__ float* GATES() const { return (float*)(ws + OFF_GATES); }
    __host__ __device__ __forceinline__ bf16_t* KC() const { return (bf16_t*)(ws + OFF_KC); }
    __host__ __device__ __forceinline__ bf16_t* VCT() const { return (bf16_t*)(ws + OFF_VCT); }
    __host__ __device__ __forceinline__ unsigned* SEL() const { return (unsigned*)(ws + OFF_SEL); }
    __host__ __device__ __forceinline__ bf16_t* OCMP() const { return (bf16_t*)(ws + OFF_OCMP); }
    __host__ __device__ __forceinline__ bf16_t* DQ() const { return (bf16_t*)(ws + OFF_DQ); }
    __host__ __device__ __forceinline__ bf16_t* DK() const { return (bf16_t*)(ws + OFF_DK); }
    __host__ __device__ __forceinline__ bf16_t* DVC() const { return (bf16_t*)(ws + OFF_DVC); }
    __host__ __device__ __forceinline__ bf16_t* KVC() const { return (bf16_t*)(ws + OFF_KVC); }
    __host__ __device__ __forceinline__ bf16_t* IQ() const { return (bf16_t*)(ws + OFF_IQ); }
    __host__ __device__ __forceinline__ bf16_t* IK() const { return (bf16_t*)(ws + OFF_IK); }
    __host__ __device__ __forceinline__ float* IW() const { return (float*)(ws + OFF_IW); }
    __host__ __device__ __forceinline__ int* IDX() const { return (int*)(ws + OFF_IDX); }
    __host__ __device__ __forceinline__ int* CNT() const { return (int*)(ws + OFF_CNT); }
    __host__ __device__ __forceinline__ float* X1() const { return (float*)(ws + OFF_X1); }
    __host__ __device__ __forceinline__ float* X2() const { return (float*)(ws + OFF_X2); }
    __host__ __device__ __forceinline__ float* PQ() const { return (float*)(ws + OFF_PQ); }
    __host__ __device__ __forceinline__ int* PE() const { return (int*)(ws + OFF_PE); }
    __host__ __device__ __forceinline__ float* PG() const { return (float*)(ws + OFF_PG); }
    __host__ __device__ __forceinline__ unsigned* bar() const { return (unsigned*)(ws + OFF_bar); }
};

DEV float bf2f(bf16_t v) { return __uint_as_float(((unsigned)v) << 16); }
DEV unsigned pk2(float lo, float hi) { unsigned r; asm("v_cvt_pk_bf16_f32 %0, %1, %2" : "=v"(r) : "v"(lo), "v"(hi)); return r; }
DEV bf16_t f2bf(float v) { return (bf16_t)(pk2(v, 0.f) & 0xffffu); }
DEV float lo2f(unsigned u) { return __uint_as_float(u << 16); }
DEV float hi2f(unsigned u) { return __uint_as_float(u & 0xffff0000u); }
#define DPP_ROR_F(V, N) __int_as_float(__builtin_amdgcn_update_dpp(0, __float_as_int(V), 0x120 + (N), 0xf, 0xf, false))
DEV float wsum(float v) {
    v += DPP_ROR_F(v, 8); v += DPP_ROR_F(v, 4); v += DPP_ROR_F(v, 2); v += DPP_ROR_F(v, 1);
    const int vi = __float_as_int(v);
    return (__int_as_float(__builtin_amdgcn_readlane(vi, 0)) + __int_as_float(__builtin_amdgcn_readlane(vi, 16))) +
           (__int_as_float(__builtin_amdgcn_readlane(vi, 32)) + __int_as_float(__builtin_amdgcn_readlane(vi, 48)));
}
DEV float wmax(float v) {
    v = fmaxf(v, DPP_ROR_F(v, 8)); v = fmaxf(v, DPP_ROR_F(v, 4)); v = fmaxf(v, DPP_ROR_F(v, 2)); v = fmaxf(v, DPP_ROR_F(v, 1));
    const int vi = __float_as_int(v);
    return fmaxf(fmaxf(__int_as_float(__builtin_amdgcn_readlane(vi, 0)), __int_as_float(__builtin_amdgcn_readlane(vi, 16))),
                 fmaxf(__int_as_float(__builtin_amdgcn_readlane(vi, 32)), __int_as_float(__builtin_amdgcn_readlane(vi, 48))));
}
DEV int tidx() { int t = threadIdx.x; asm volatile("" : "+v"(t)); return t; }
DEV float sigmoidf_(float x) { return 1.0f / (1.0f + __expf(-x)); }
DEV float relu1(float x) { return __int_as_float(max(__float_as_int(x), 0)); }
DEV float gelu_tanh(float x) {
    const float y = 0.7978845608028654f * (x + 0.044715f * x * x * x);
    const float t = 1.0f - 2.0f / (1.0f + __expf(2.0f * y));
    return 0.5f * x * (1.0f + t);
}
DEV f32x4 mfma16(bf16x8 a, bf16x8 b, f32x4 c) { return __builtin_amdgcn_mfma_f32_16x16x32_bf16(a, b, c, 0, 0, 0); }
DEV f32x16 mfma32(bf16x8 a, bf16x8 b, f32x16 c) { return __builtin_amdgcn_mfma_f32_32x32x16_bf16(a, b, c, 0, 0, 0); }

DEV int src_col(int n) {
    if (n < 3328) return n;
    if (n < 4672) return 3340 + (n - 3328);
    if (n < 4684) return 3328 + (n - 4672);
    if (n < 4688) return -1;
    if (n < 4696) return 4684 + (n - 4688);
    return -1;
}

DEV void st_convT(const float* __restrict__ W, bf16_t* __restrict__ Bt, int N, int Npad, bool remap, int unit, char* smem, int Kdim = 2048) {
    float (*tile)[65] = (float (*)[65])smem;
    const int ntn = Npad / 64, kt = unit / ntn, nt = unit % ntn, k0 = kt * 64, n0 = nt * 64;
    const int tid_ = tidx(); const int tx = tid_ & 63, ty = tid_ >> 6;
    const int n = n0 + tx;
    const int src = remap ? src_col(n) : (n < N ? n : -1);
#pragma unroll
    for (int i = 0; i < 16; ++i) { const int k = ty + 4 * i; tile[k][tx] = src >= 0 ? W[(size_t)(k0 + k) * N + src] : 0.f; }
    __syncthreads();
#pragma unroll
    for (int i = 0; i < 16; ++i) {
        const int r = ty + 4 * i, nn = n0 + r, k = k0 + tx;
        const size_t o = Kdim == 2048 ? ((size_t)(((nn >> 4) * 64 + (k >> 5)) * 64 + ((k >> 3) & 3) * 16 + (nn & 15))) * 8 + (k & 7) : (size_t)nn * Kdim + k;
        Bt[o] = f2bf(tile[tx][r]);
    }
    __syncthreads();
}

DEV void st_convT_run(const float* __restrict__ W, bf16_t* __restrict__ Bt, int N, int Npad, bool remap, int unit0, int cnt, char* smem) {
    float (*tile)[65] = (float (*)[65])smem;
    const int ntn = Npad / 64;
    const int tid_ = tidx(); const int tx = tid_ & 63, ty = tid_ >> 6;
    float cur[16];
#define CONVT_LOAD(U) do { const int _kt = (U) / ntn, _nt = (U) % ntn, _n = _nt * 64 + tx; const int _src = remap ? src_col(_n) : (_n < N ? _n : -1); \
        _Pragma("unroll") for (int i = 0; i < 16; ++i) cur[i] = _src >= 0 ? __builtin_nontemporal_load(W + (size_t)(_kt * 64 + ty + 4 * i) * N + _src) : 0.f; } while (0)
    CONVT_LOAD(unit0);
#pragma unroll 1
    for (int q = 0; q < cnt; ++q) {
        const int u = unit0 + q, k0 = (u / ntn) * 64, n0 = (u % ntn) * 64;
#pragma unroll
        for (int i = 0; i < 16; ++i) tile[ty + 4 * i][tx] = cur[i];
        { const int un = q + 1 < cnt ? u + 1 : u; CONVT_LOAD(un); }
        __syncthreads();
#pragma unroll
        for (int i = 0; i < 16; ++i) {
            const int r = ty + 4 * i, nn = n0 + r, k = k0 + tx;
            Bt[((size_t)(((nn >> 4) * 64 + (k >> 5)) * 64 + ((k >> 3) & 3) * 16 + (nn & 15))) * 8 + (k & 7)] = f2bf(tile[tx][r]);
        }
        __syncthreads();
    }
#undef CONVT_LOAD
}

typedef float f32x2 __attribute__((ext_vector_type(2)));
typedef float v16f __attribute__((ext_vector_type(16)));
typedef float v32f __attribute__((ext_vector_type(32)));
typedef unsigned v6u __attribute__((ext_vector_type(6)));
#ifndef PEER_FP4
#define PEER_FP4 0
#endif
#if PEER_FP4
constexpr float U6_SCALE = 64.0f, V6_SCALE = 2.8f;
constexpr int ROW6 = 1024;
#else
constexpr float U6_SCALE = 64.0f, V6_SCALE = 3.0f;
constexpr int ROW6 = 1536;
#endif
#define FP6_ONE __uint_as_float(0x3F80007Fu)

#ifndef SW_FP6
#define SW_FP6 1
#endif
DEV unsigned fp6_enc1(float f) {
    const float a = fminf(fabsf(f), 7.5f);
    const float sc = a < 2.0f ? 8.0f : (a < 4.0f ? 4.0f : 2.0f), of = a < 2.0f ? 0.0f : (a < 4.0f ? 8.0f : 16.0f);
    const unsigned code = (unsigned)(int)__builtin_rintf(a * sc + of);
    return code | ((__float_as_uint(f) >> 26) & 32u);
}
DEV float fp6_dec1(unsigned c) {
    const unsigned e = (c >> 3) & 3u, m = c & 7u;
    const float v = e == 0u ? 0.125f * (float)m : (1.0f + 0.125f * (float)m) * (float)(1u << (e - 1u));
    return (c & 32u) ? -v : v;
}
DEV v6u sw_pack32(const v16f& x, const v16f& y) {
    unsigned w[6] = {0u, 0u, 0u, 0u, 0u, 0u};
#pragma unroll
    for (int i = 0; i < 32; ++i) {
        const unsigned c = fp6_enc1(i < 16 ? x[i] : y[i - 16]);
        const int bit = 6 * i, d = bit >> 5, sh = bit & 31;
        w[d] |= c << sh;
        if (sh > 26) w[d + 1] |= c >> (32 - sh);
    }
    v6u r; r[0] = w[0]; r[1] = w[1]; r[2] = w[2]; r[3] = w[3]; r[4] = w[4]; r[5] = w[5]; return r;
}
DEV v32f sw_unpack32(const v6u& pk) {
    const unsigned w[6] = {pk[0], pk[1], pk[2], pk[3], pk[4], pk[5]};
    v32f r;
#pragma unroll
    for (int i = 0; i < 32; ++i) {
        const int bit = 6 * i, d = bit >> 5, sh = bit & 31;
        unsigned c = w[d] >> sh;
        if (sh > 26) c |= w[d + 1] << (32 - sh);
        r[i] = fp6_dec1(c & 63u);
    }
    return r;
}
#define FP6_PACK(x, y) sw_pack32(x, y)
#define FP6_UNPACK(pk) __builtin_amdgcn_cvt_scalef32_pk32_f32_fp6(pk, FP6_ONE)
typedef __bf16 bf16x2v __attribute__((ext_vector_type(2)));
typedef __bf16 bf16x32v __attribute__((ext_vector_type(32)));
#define FP6_UNPACK_BF16(pk) __builtin_amdgcn_cvt_scalef32_pk32_bf16_fp6(pk, FP6_ONE)

typedef float f32x2_t __attribute__((ext_vector_type(2)));
DEV unsigned fp4_enc1(float f) {
    const float a = fminf(fabsf(f), 6.0f);
    const float sc = a < 2.0f ? 2.0f : (a < 4.0f ? 1.0f : 0.5f), of = a < 2.0f ? 0.0f : (a < 4.0f ? 2.0f : 4.0f);
    const unsigned code = (unsigned)(int)__builtin_rintf(a * sc + of);
    return code | ((__float_as_uint(f) >> 28) & 8u);
}
DEV void fp4_unpack8(unsigned w, float* f) {
    const f32x2_t a = __builtin_amdgcn_cvt_scalef32_pk_f32_fp4(w, FP6_ONE, 0), b = __builtin_amdgcn_cvt_scalef32_pk_f32_fp4(w, FP6_ONE, 1);
    const f32x2_t c = __builtin_amdgcn_cvt_scalef32_pk_f32_fp4(w, FP6_ONE, 2), d = __builtin_amdgcn_cvt_scalef32_pk_f32_fp4(w, FP6_ONE, 3);
    f[0] = a.x; f[1] = a.y; f[2] = b.x; f[3] = b.y; f[4] = c.x; f[5] = c.y; f[6] = d.x; f[7] = d.y;
}
DEV void st_tab4(const P& p, const float* __restrict__ src, unsigned char* __restrict__ dst, float scale, int nrows, int unit, int nunits, char* smem) {
    const int tid_ = tidx(), w = tid_ >> 6, l = tid_ & 63;
    float* stg = (float*)smem + w * (64 * 36);
    int sh[8];
#pragma unroll
    for (int k = 0; k < 8; ++k) sh[k] = 4 * __builtin_amdgcn_readfirstlane(p.PI()[40 + k]);
    for (int r = unit * 4 + w; r < nrows; r += nunits * 4) {
        const float4* sp = (const float4*)(src + (size_t)r * 2048);
        float4 v[8];
#pragma unroll
        for (int i = 0; i < 8; ++i) v[i] = sp[l + 64 * i];
#pragma unroll
        for (int i = 0; i < 8; ++i) { const int f = l + 64 * i; *(float4*)(stg + (f >> 3) * 36 + (f & 7) * 4) = v[i]; }
        __builtin_amdgcn_wave_barrier();
        unsigned wd[4] = {0u, 0u, 0u, 0u};
#pragma unroll
        for (int q = 0; q < 8; ++q) {
            const float4 a = *(const float4*)(stg + l * 36 + q * 4);
            const float xv[4] = {a.x, a.y, a.z, a.w};
#pragma unroll
            for (int e = 0; e < 4; ++e) { const int j = q * 4 + e; wd[j >> 3] |= fp4_enc1(xv[e] * scale) << sh[j & 7]; }
        }
        *(uint4*)(dst + (size_t)r * ROW6 + l * 16) = make_uint4(wd[0], wd[1], wd[2], wd[3]);
        __builtin_amdgcn_wave_barrier();
    }
}
DEV void st_tab6(const float* __restrict__ src, unsigned char* __restrict__ dst, float scale, int nrows, int unit, int nunits, char* smem) {
    const int tid_ = tidx(), w = tid_ >> 6, l = tid_ & 63;
    float* stg = (float*)smem + w * (64 * 36);
    const int st = nunits * 4, r0 = unit * 4 + w;
#define TAB_LOAD(V, R) do { const int _r = (R) < nrows ? (R) : r0; const f32x4* _sp = (const f32x4*)(src + (size_t)_r * 2048); \
        _Pragma("unroll") for (int i = 0; i < 8; ++i) V[i] = __builtin_nontemporal_load(_sp + l + 64 * i); } while (0)
#define TAB_ROW(V, R, RN) do { \
        _Pragma("unroll") for (int i = 0; i < 8; ++i) { const int f = l + 64 * i; *(f32x4*)(stg + (f >> 3) * 36 + (f & 7) * 4) = V[i]; } \
        TAB_LOAD(V, RN); \
        __builtin_amdgcn_wave_barrier(); \
        v16f x, y; \
        _Pragma("unroll") for (int q = 0; q < 4; ++q) { \
            const float4 a = *(const float4*)(stg + l * 36 + q * 4), b = *(const float4*)(stg + l * 36 + 16 + q * 4); \
            x[4 * q] = a.x * scale; x[4 * q + 1] = a.y * scale; x[4 * q + 2] = a.z * scale; x[4 * q + 3] = a.w * scale; \
            y[4 * q] = b.x * scale; y[4 * q + 1] = b.y * scale; y[4 * q + 2] = b.z * scale; y[4 * q + 3] = b.w * scale; \
        } \
        const v6u pk = FP6_PACK(x, y); \
        unsigned char* dp = dst + (size_t)(R) * ROW6 + l * 8; \
        *(uint2*)(dp) = make_uint2(pk[0], pk[1]); *(uint2*)(dp + 512) = make_uint2(pk[2], pk[3]); *(uint2*)(dp + 1024) = make_uint2(pk[4], pk[5]); \
        __builtin_amdgcn_wave_barrier(); } while (0)
    f32x4 va[8], vb[8];
    TAB_LOAD(va, r0); TAB_LOAD(vb, r0 + st);
#pragma unroll 1
    for (int r = r0; r < nrows; r += 2 * st) {
        TAB_ROW(va, r, r + 2 * st);
        if (r + st < nrows) TAB_ROW(vb, r + st, r + 3 * st);
    }
#undef TAB_ROW
#undef TAB_LOAD
}
DEV void st_calib(const P& p) {
    if (tidx() >= 64) return;
    v16f x, y;
#pragma unroll
    for (int k = 0; k < 32; ++k) {
        const int e = k >> 3, m = k & 7;
        const float v = e == 0 ? 0.125f * m : (1.0f + 0.125f * m) * (float)(1 << (e - 1));
        if (k < 16) x[k] = v; else y[k - 16] = v;
    }
    const v6u pk = FP6_PACK(x, y);
    const v32f d = FP6_UNPACK(pk);
    if ((threadIdx.x & 63) == 0) {
        float dmax = 0.f;
#pragma unroll
        for (int j = 0; j < 32; ++j) dmax = fmaxf(dmax, fabsf(d[j]));
        const float cscale = dmax > 0.f ? dmax * (1.0f / 7.5f) : 1.0f;
        const float ic = 1.0f / cscale;
#pragma unroll
        for (int j = 0; j < 32; ++j) {
            int found = j;
#pragma unroll
            for (int k = 0; k < 32; ++k) {
                const int e = k >> 3, m = k & 7;
                const float v = e == 0 ? 0.125f * m : (1.0f + 0.125f * m) * (float)(1 << (e - 1));
                if (fabsf(d[j] * ic - v) < 0.02f + 0.01f * v) found = k;
            }
            p.PI()[j] = found;
        }
        p.PI()[32] = __float_as_int(ic);
    }
#if PEER_FP4
    {
        const unsigned probe = 0x07654321u;
        float f8[8]; fp4_unpack8(probe, f8);
        if ((threadIdx.x & 63) == 0) {
            const float val[8] = {0.f, 0.5f, 1.f, 1.5f, 2.f, 3.f, 4.f, 6.f};
            float dmax = 0.f;
#pragma unroll
            for (int k = 0; k < 8; ++k) dmax = fmaxf(dmax, fabsf(f8[k]));
            const float ic4 = dmax > 0.f ? 6.0f / dmax : 1.0f;
#pragma unroll
            for (int k = 0; k < 8; ++k) {
                int nib = k;
#pragma unroll
                for (int c = 0; c < 8; ++c) if (fabsf(f8[k] * ic4 - val[c]) < 0.1f) nib = (c + 7) & 7;
                p.PI()[40 + k] = nib;
            }
#pragma unroll
            for (int j = 0; j < 32; ++j) p.PI()[j] = j;
            p.PI()[32] = __float_as_int(ic4);
        }
    }
#endif
}

DEV void st_ada(const P& p, int unit, char* smem) {
    float4* red = (float4*)smem;
    const int tid = tidx(), c4 = tid & 15, kg = tid >> 4;
    const int i = unit / 192, j = (unit % 192) * 64 + c4 * 4;
    const float* W = p.ada_w + (size_t)i * 2048 * 12288 + (size_t)kg * 12288 + j;
    float4 acc = make_float4(0.f, 0.f, 0.f, 0.f);
#pragma unroll 1
    for (int k0 = 0; k0 < 128; k0 += 16) {
        float4 wv[16]; float a[16];
#pragma unroll
        for (int q = 0; q < 16; ++q) { const f32x4 t4 = __builtin_nontemporal_load((const f32x4*)(W + (size_t)(16 * (k0 + q)) * 12288)); wv[q] = make_float4(t4[0], t4[1], t4[2], t4[3]); }
#pragma unroll
        for (int q = 0; q < 16; ++q) { const float cv = p.c[kg + 16 * (k0 + q)]; a[q] = cv * sigmoidf_(cv); }
#pragma unroll
        for (int q = 0; q < 16; ++q) { acc.x += a[q] * wv[q].x; acc.y += a[q] * wv[q].y; acc.z += a[q] * wv[q].z; acc.w += a[q] * wv[q].w; }
    }
    red[kg * 16 + c4] = acc;
    __syncthreads();
    if (tid < 64) {
        const int cc = tid >> 2, e = tid & 3;
        float r = p.ada_b[i * 12288 + (unit % 192) * 64 + tid];
#pragma unroll
        for (int q = 0; q < 16; ++q) r += ((const float*)&red[q * 16 + cc])[e];
        p.ada()[i * 12288 + (unit % 192) * 64 + tid] = r;
    }
    __syncthreads();
}
DEV void st_rope(const P& p, int unit) {
    const int e = unit * 256 + tidx(); const int t = e / 24, i = e % 24;
    const double inv = i < 16 ? INV16[i] : INV16[2 * (i - 16)];
    const double ang = (double)p.pos[t] * inv;
    const double n = rint(ang * 0.15915494309189535);
    const double r = ang - n * 6.283185307179586;
    const double r2 = r * r;
    double sp = 1.0 / 1.5511210043330986e25, cp = -1.0 / 4.0329146112660565e26;
    sp = sp * r2 - 1.0 / 2.585201673888498e22;   cp = cp * r2 + 1.0 / 6.204484017332394e23;
    sp = sp * r2 + 1.0 / 5.109094217170944e19;   cp = cp * r2 - 1.0 / 1.1240007277776077e21;
    sp = sp * r2 - 1.0 / 1.21645100408832e17;    cp = cp * r2 + 1.0 / 2.43290200817664e18;
    sp = sp * r2 + 1.0 / 3.55687428096e14;       cp = cp * r2 - 1.0 / 6.402373705728e15;
    sp = sp * r2 - 1.0 / 1.307674368e12;         cp = cp * r2 + 1.0 / 2.0922789888e13;
    sp = sp * r2 + 1.0 / 6.2270208e9;            cp = cp * r2 - 1.0 / 8.71782912e10;
    sp = sp * r2 - 1.0 / 3.99168e7;              cp = cp * r2 + 1.0 / 4.790016e8;
    sp = sp * r2 + 1.0 / 362880.0;               cp = cp * r2 - 1.0 / 3628800.0;
    sp = sp * r2 - 1.0 / 5040.0;                 cp = cp * r2 + 1.0 / 40320.0;
    sp = sp * r2 + 1.0 / 120.0;                  cp = cp * r2 - 1.0 / 720.0;
    sp = sp * r2 - 1.0 / 6.0;                    cp = cp * r2 + 1.0 / 24.0;
    sp = sp * r2 + 1.0;                          cp = cp * r2 - 0.5;
    cp = cp * r2 + 1.0;
    const float cs = (float)cp, sn = (float)(sp * r);
    p.ropeC()[e] = cs; p.ropeS()[e] = sn;
}

DEV void st_norm(const float* __restrict__ X, const float* __restrict__ g, const float* __restrict__ sc, const float* __restrict__ sh,
                 bf16_t* __restrict__ HN, int unit) {
    const int tid_ = tidx(); const int w = tid_ >> 6, l = tid_ & 63; const int t = unit * 4 + w;
    const float4* xr = (const float4*)(X + (size_t)t * D);
    float4 v[8]; float ss = 0.f;
#pragma unroll
    for (int i = 0; i < 4; ++i) { v[2 * i] = xr[i * 128 + l * 2]; v[2 * i + 1] = xr[i * 128 + l * 2 + 1]; }
#pragma unroll
    for (int i = 0; i < 8; ++i) ss += v[i].x * v[i].x + v[i].y * v[i].y + v[i].z * v[i].z + v[i].w * v[i].w;
    ss = wsum(ss);
    const float rs = rsqrtf(ss * (1.0f / 2048.0f) + EPS);
    float4 gv[8], scv[8], shv[8];
#pragma unroll
    for (int i = 0; i < 4; ++i) {
        const int col = i * 512 + l * 8;
        gv[2 * i] = *(const float4*)(g + col); gv[2 * i + 1] = *(const float4*)(g + col + 4);
        scv[2 * i] = *(const float4*)(sc + col); scv[2 * i + 1] = *(const float4*)(sc + col + 4);
        shv[2 * i] = *(const float4*)(sh + col); shv[2 * i + 1] = *(const float4*)(sh + col + 4);
    }
#pragma unroll
    for (int i = 0; i < 4; ++i) {
        const int col = i * 512 + l * 8;
        float y[8]; const float xv[8] = {v[2 * i].x, v[2 * i].y, v[2 * i].z, v[2 * i].w, v[2 * i + 1].x, v[2 * i + 1].y, v[2 * i + 1].z, v[2 * i + 1].w};
        const float gq[8] = {gv[2 * i].x, gv[2 * i].y, gv[2 * i].z, gv[2 * i].w, gv[2 * i + 1].x, gv[2 * i + 1].y, gv[2 * i + 1].z, gv[2 * i + 1].w};
        const float sq[8] = {scv[2 * i].x, scv[2 * i].y, scv[2 * i].z, scv[2 * i].w, scv[2 * i + 1].x, scv[2 * i + 1].y, scv[2 * i + 1].z, scv[2 * i + 1].w};
        const float hq[8] = {shv[2 * i].x, shv[2 * i].y, shv[2 * i].z, shv[2 * i].w, shv[2 * i + 1].x, shv[2 * i + 1].y, shv[2 * i + 1].z, shv[2 * i + 1].w};
#pragma unroll
        for (int j = 0; j < 8; ++j) y[j] = (xv[j] * rs) * gq[j] * (1.0f + sq[j]) + hq[j];
        uint4 o; o.x = pk2(y[0], y[1]); o.y = pk2(y[2], y[3]); o.z = pk2(y[4], y[5]); o.w = pk2(y[6], y[7]);
        *(uint4*)(HN + (size_t)t * D + col) = o;
    }
}

enum { EPI_PROJ = 0, EPI_OUT = 1, EPI_Q = 2 };
struct EpiArgs { bf16_t* obf; float* of; const float* xin; const float* gate; bf16_t* kvc; };
template <int EPI, int MT = 4>
DEV void st_gemm(const bf16_t* __restrict__ A, const bf16_t* __restrict__ Bt, int K, int tm, int tn, const EpiArgs& e, char* smem) {
    constexpr int BM = 32 * MT;
    const int tid = tidx(), w = tid >> 6, l = tid & 63, wr = w >> 1, wc = w & 1;
    const int fr = l & 15, fq = l >> 4;
    f32x4 acc[MT][4];
#pragma unroll
    for (int m = 0; m < MT; ++m)
#pragma unroll
        for (int n = 0; n < 4; ++n) acc[m][n] = (f32x4){0.f, 0.f, 0.f, 0.f};
    const int srow = tid >> 2, spc = tid & 3, sc = spc ^ (((srow >> 2) & 1) << 1);
    const bf16_t* Ag = A + (size_t)(tm * BM + srow) * K + sc * 8;
    const int nk = K / 32;
    const unsigned lds0 = (unsigned)(size_t)(__attribute__((address_space(3))) char*)smem + (unsigned)((wr * (BM / 2) + fr) * 64 + ((fq ^ (((fr >> 2) & 1) << 1)) << 4));
    constexpr bool BIG_DIRECT_B = false;
    if constexpr (MT == 8 && BIG_DIRECT_B) {
        constexpr int ABYTES = BM * 64, BUFB = ABYTES, NA = BM / 64;
        static_assert(2 * BUFB <= SMEM_BYTES, "GEMM LDS");
        const bf16_t* Bg = Bt + ((size_t)(tn * 8 + wc * 4) * nk * 64 + l) * 8;
        const size_t bnt = (size_t)nk * 512;
#define GEMM_STAGE(BUF, KO) do { char* _b = smem + (BUF) * BUFB + tid * 16; \
            _Pragma("unroll") for (int _i = 0; _i < NA; ++_i) \
                __builtin_amdgcn_global_load_lds((const unsigned*)(Ag + (size_t)(64 * _i) * K + (KO)), (__attribute__((address_space(3))) unsigned*)(_b + _i * 4096), 16, 0, 0); } while (0)
#define GEMM_LOADB(SET, KT) do { _Pragma("unroll") for (int n = 0; n < 4; ++n) { const bf16_t* _bp = Bg + (size_t)n * bnt + (size_t)(KT) * 512; \
            asm volatile("global_load_dwordx4 %0, %1, off" : "=v"(SET[n]) : "v"(_bp)); } } while (0)
#define GEMM_DRAIN(SET) asm volatile("s_waitcnt vmcnt(0)" : "+v"(SET[0]), "+v"(SET[1]), "+v"(SET[2]), "+v"(SET[3]))
        bf16x8 b0[4], b1[4];
        GEMM_STAGE(0, 0); GEMM_LOADB(b0, 0);
        GEMM_DRAIN(b0);
        __builtin_amdgcn_s_barrier();
#define GEMM_STEP(KT, CUR, SET, OTH) do { \
            const int _kn = (KT) + 1 < nk ? (KT) + 1 : (KT); \
            GEMM_STAGE((CUR) ^ 1, _kn * 32); GEMM_LOADB(OTH, _kn); \
            __builtin_amdgcn_sched_barrier(0); \
            const unsigned abase = lds0 + (unsigned)(CUR) * BUFB; \
            bf16x8 af[MT]; \
            _Pragma("unroll") for (int m = 0; m < MT; ++m) asm volatile("ds_read_b128 %0, %1 offset:%2" : "=v"(af[m]) : "v"(abase), "n"(m * 1024)); \
            asm volatile("s_waitcnt lgkmcnt(4)" : "+v"(af[0]), "+v"(af[1]), "+v"(af[2]), "+v"(af[3])); \
            _Pragma("unroll") for (int m = 0; m < 4; ++m) \
                _Pragma("unroll") for (int n = 0; n < 4; ++n) acc[m][n] = mfma16(SET[n], af[m], acc[m][n]); \
            asm volatile("s_waitcnt lgkmcnt(0)" : "+v"(af[MT - 4]), "+v"(af[MT - 3]), "+v"(af[MT - 2]), "+v"(af[MT - 1])); \
            _Pragma("unroll") for (int m = 4; m < MT; ++m) \
                _Pragma("unroll") for (int n = 0; n < 4; ++n) acc[m][n] = mfma16(SET[n], af[m], acc[m][n]); \
            __builtin_amdgcn_sched_barrier(0);        \
            GEMM_DRAIN(OTH); \
            __builtin_amdgcn_s_barrier(); \
            __builtin_amdgcn_sched_barrier(0); } while (0)
#pragma unroll 1
        for (int kt = 0; kt < nk; kt += 2) {
            GEMM_STEP(kt, 0, b0, b1);
            GEMM_STEP(kt + 1, 1, b1, b0);
        }
#undef GEMM_STEP
#undef GEMM_DRAIN
#undef GEMM_LOADB
#undef GEMM_STAGE
    } else {
        constexpr int ABYTES = BM * 64, BUFB = ABYTES + 8192, NBUF = (MT == 4) ? 4 : 3, NA = BM / 64, PER = NA + 2, AHEAD = NBUF - 1;
        static_assert(NBUF * BUFB <= SMEM_BYTES, "GEMM LDS");
        const bf16_t* Bg = Bt + ((size_t)(tn * 8 + 2 * w) * nk * 64 + l) * 8;
        const size_t bnt = (size_t)nk * 512;
#define GEMM_STAGE(BUF, KT) do { char* _b = smem + (BUF) * BUFB; \
            _Pragma("unroll") for (int _i = 0; _i < NA; ++_i) \
                __builtin_amdgcn_global_load_lds((const unsigned*)(Ag + (size_t)(64 * _i) * K + (KT) * 32), (__attribute__((address_space(3))) unsigned*)(_b + tid * 16 + _i * 4096), 16, 0, 0); \
            _Pragma("unroll") for (int _i = 0; _i < 2; ++_i) \
                __builtin_amdgcn_global_load_lds((const unsigned*)(Bg + (size_t)_i * bnt + (size_t)(KT) * 512), (__attribute__((address_space(3))) unsigned*)(_b + ABYTES + (2 * w + _i) * 1024 + l * 16), 16, 0, 0); } while (0)
#pragma unroll
        for (int q = 0; q < AHEAD; ++q) GEMM_STAGE(q, q);
        asm volatile("s_waitcnt vmcnt(%0)" :: "n"(PER * (AHEAD - 1)) : "memory");
        __builtin_amdgcn_s_barrier();
        const unsigned ldsb = (unsigned)(size_t)(__attribute__((address_space(3))) char*)smem + (unsigned)(ABYTES + wc * 4096 + l * 16);
        int cur = 0, nxt = AHEAD;
#pragma unroll 1
        for (int kt = 0; kt < nk; ++kt) {
            { const int kn = kt + AHEAD < nk ? kt + AHEAD : nk - 1; GEMM_STAGE(nxt, kn); }
            __builtin_amdgcn_sched_barrier(0);
            const unsigned abase = lds0 + (unsigned)cur * BUFB, bbase = ldsb + (unsigned)cur * BUFB;
            bf16x8 af[MT], bfr[4];
#pragma unroll
            for (int n = 0; n < 4; ++n) asm volatile("ds_read_b128 %0, %1 offset:%2" : "=v"(bfr[n]) : "v"(bbase), "n"(n * 1024));
#pragma unroll
            for (int m = 0; m < MT; ++m) asm volatile("ds_read_b128 %0, %1 offset:%2" : "=v"(af[m]) : "v"(abase), "n"(m * 1024));
#define GEMM_MGROUP(M) do { \
                if ((M) == 0) asm volatile("s_waitcnt lgkmcnt(%5)" : "+v"(af[0]), "+v"(bfr[0]), "+v"(bfr[1]), "+v"(bfr[2]), "+v"(bfr[3]) : "n"(MT - 1)); \
                else asm volatile("s_waitcnt lgkmcnt(%1)" : "+v"(af[(M)]) : "n"(MT - 1 - (M))); \
                _Pragma("unroll") for (int n = 0; n < 4; ++n) acc[(M)][n] = mfma16(bfr[n], af[(M)], acc[(M)][n]); \
                __builtin_amdgcn_sched_barrier(0); } while (0)
            GEMM_MGROUP(0); GEMM_MGROUP(1); GEMM_MGROUP(2); GEMM_MGROUP(3);
            if constexpr (MT == 8) { GEMM_MGROUP(4); GEMM_MGROUP(5); GEMM_MGROUP(6); GEMM_MGROUP(7); }
#undef GEMM_MGROUP
            __builtin_amdgcn_sched_barrier(0);
            asm volatile("s_waitcnt vmcnt(%0)" :: "n"(PER * (AHEAD - 1)) : "memory");
            __builtin_amdgcn_s_barrier();
            __builtin_amdgcn_sched_barrier(0);
            cur = cur + 1 == NBUF ? 0 : cur + 1; nxt = nxt + 1 == NBUF ? 0 : nxt + 1;
        }
        asm volatile("s_waitcnt vmcnt(0)" ::: "memory");
#undef GEMM_STAGE
    }
    if constexpr (EPI == EPI_OUT) {
        float4 gg[4];
#pragma unroll
        for (int n = 0; n < 4; ++n) gg[n] = *(const float4*)(e.gate + tn * 128 + wc * 64 + n * 16 + 4 * (l >> 4));
#pragma unroll
        for (int m2 = 0; m2 < MT; m2 += 2) {
            float4 xi[2][4];
#pragma unroll
            for (int mm = 0; mm < 2; ++mm)
#pragma unroll
                for (int n = 0; n < 4; ++n) {
                    const int row = tm * BM + wr * (BM / 2) + (m2 + mm) * 16 + (l & 15), col = tn * 128 + wc * 64 + n * 16 + 4 * (l >> 4);
                    xi[mm][n] = *(const float4*)(e.xin + (size_t)row * D + col);
                }
#pragma unroll
            for (int mm = 0; mm < 2; ++mm)
#pragma unroll
                for (int n = 0; n < 4; ++n) {
                    const int row = tm * BM + wr * (BM / 2) + (m2 + mm) * 16 + (l & 15), col = tn * 128 + wc * 64 + n * 16 + 4 * (l >> 4);
                    const f32x4 a = acc[m2 + mm][n];
                    float4 o; o.x = xi[mm][n].x + gg[n].x * a[0]; o.y = xi[mm][n].y + gg[n].y * a[1]; o.z = xi[mm][n].z + gg[n].z * a[2]; o.w = xi[mm][n].w + gg[n].w * a[3];
                    *(float4*)(e.of + (size_t)row * D + col) = o;
                }
        }
    } else
#pragma unroll
    for (int m = 0; m < MT; ++m) {
        const int row = tm * BM + wr * (BM / 2) + m * 16 + (l & 15);
#pragma unroll
        for (int n = 0; n < 4; ++n) {
            const int col = tn * 128 + wc * 64 + n * 16 + 4 * (l >> 4);
            const f32x4 a = acc[m][n];
            if (EPI == EPI_PROJ) {
                uint2 o; o.x = pk2(a[0], a[1]); o.y = pk2(a[2], a[3]);
                *(uint2*)(e.obf + (size_t)row * LDP + col) = o;
                if (col >= C_NKC && col < C_NKC + 256) *(uint2*)(e.kvc + (size_t)row * 256 + (col - C_NKC)) = o;
            } else if (EPI == EPI_OUT) {
                const float4 xi = *(const float4*)(e.xin + (size_t)row * D + col);
                const float4 gg = *(const float4*)(e.gate + col);
                float4 o; o.x = xi.x + gg.x * a[0]; o.y = xi.y + gg.y * a[1]; o.z = xi.z + gg.z * a[2]; o.w = xi.w + gg.w * a[3];
                *(float4*)(e.of + (size_t)row * D + col) = o;
            } else {
                float4 o; o.x = a[0]; o.y = a[1]; o.z = a[2]; o.w = a[3];
                *(float4*)(e.of + (size_t)row * 1024 + col) = o;
            }
        }
    }
    __syncthreads();
}

DEV void st_conv(const P& p, int layer, int unit, char* smem) {
    float* cs = (float*)smem;
    const int tid = tidx(), t0 = unit * 16;
    const float* cw = p.conv_w + (size_t)layer * 31 * 512;
#pragma unroll 1
    for (int cc = 0; cc < 2; ++cc) {
        const int c = tid + 256 * cc;
        float w[31], z[46];
#pragma unroll
        for (int k = 0; k < 31; ++k) w[k] = cw[k * 512 + c];
#pragma unroll
        for (int r = 0; r < 46; ++r) {
            const int t = t0 - 30 + r, tc = t < 0 ? 0 : t;
            const float a = bf2f(p.PROJ()[(size_t)tc * LDP + C_CA + c]), g = bf2f(p.PROJ()[(size_t)tc * LDP + C_CG + c]);
            z[r] = t >= 0 ? a * sigmoidf_(g) : 0.f;
        }
        const float cb = p.conv_b[layer * 512 + c];
#pragma unroll
        for (int tt = 0; tt < 16; ++tt) {
            float acc = cb;
#pragma unroll
            for (int k = 0; k < 31; ++k) acc += w[k] * z[tt + k];
            cs[tt * 512 + c] = acc;
        }
    }
    __syncthreads();
    const int w = tid >> 6, l = tid & 63;
    const float* lg = p.cln_g + layer * 512; const float* lb = p.cln_b + layer * 512;
    float lgv[8], lbv[8];
#pragma unroll
    for (int i = 0; i < 8; ++i) { lgv[i] = lg[l + 64 * i]; lbv[i] = lb[l + 64 * i]; }
#pragma unroll 1
    for (int q = 0; q < 4; ++q) {
        const int tt = w * 4 + q;
        float v[8]; float s = 0.f;
#pragma unroll
        for (int i = 0; i < 8; ++i) { v[i] = cs[tt * 512 + l + 64 * i]; s += v[i]; }
        const float mean = wsum(s) * (1.0f / 512.0f);
        float q2 = 0.f;
#pragma unroll
        for (int i = 0; i < 8; ++i) { const float d = v[i] - mean; q2 += d * d; }
        const float rstd = rsqrtf(wsum(q2) * (1.0f / 512.0f) + EPS);
#pragma unroll
        for (int i = 0; i < 8; ++i) {
            const int c = l + 64 * i;
            const float y = (v[i] - mean) * rstd * lgv[i] + lbv[i];
            p.Y()[(size_t)(t0 + tt) * D + c] = f2bf(y * sigmoidf_(y));
        }
    }
    __syncthreads();
}

DEV void st_sgu(const P& p, int layer, int unit, char* smem) {
    constexpr int RSB = 136;
    const int n = unit >> 2, h = unit & 3, tid = tidx(), w = tid >> 6, l = tid & 63;
    float* stat = (float*)smem;
    bf16_t* wtb = (bf16_t*)(smem + 1024);
    bf16_t* vtb = wtb + 128 * RSB;
    const int tb = n * 128;
#pragma unroll 4
    for (int q = 0; q < 32; ++q) {
        const int j = w * 32 + q;
        const uint4 raw = *(const uint4*)(p.PROJ() + (size_t)(tb + j) * LDP + C_SV + l * 8);
        float v[8] = {lo2f(raw.x), hi2f(raw.x), lo2f(raw.y), hi2f(raw.y), lo2f(raw.z), hi2f(raw.z), lo2f(raw.w), hi2f(raw.w)};
        float s = 0.f;
#pragma unroll
        for (int i = 0; i < 8; ++i) s += v[i];
        const float mean = wsum(s) * (1.0f / 512.0f);
        float q2 = 0.f;
#pragma unroll
        for (int i = 0; i < 8; ++i) { const float d = v[i] - mean; q2 += d * d; }
        const float rstd = rsqrtf(wsum(q2) * (1.0f / 512.0f) + EPS);
        if (l == 0) { stat[j * 2] = mean; stat[j * 2 + 1] = rstd; }
    }
    const float* Wh = p.sgu_w + ((size_t)layer * 4 + h) * 128 * 128;
    {
        float4 wv[16];
#pragma unroll
        for (int q = 0; q < 16; ++q) wv[q] = *(const float4*)(Wh + (size_t)(tid + 256 * q) * 4);
#pragma unroll
        for (int q = 0; q < 16; ++q) {
            const int f = tid + 256 * q, i = f >> 5, j4 = (f & 31) * 4;
            const float x4[4] = {wv[q].x, wv[q].y, wv[q].z, wv[q].w};
#pragma unroll
            for (int e = 0; e < 4; ++e) wtb[(j4 + e) * RSB + i] = (i >= j4 + e) ? f2bf(x4[e]) : (bf16_t)0;
        }
    }
    __syncthreads();
    {
        const float* lg = p.sln_g + layer * 512 + h * 128; const float* lb = p.sln_b + layer * 512 + h * 128;
        uint4 vr[8];
#pragma unroll
        for (int q = 0; q < 8; ++q) { const int f = tid + 256 * q, j = f >> 4, d8 = (f & 15) * 8; vr[q] = *(const uint4*)(p.PROJ() + (size_t)(tb + j) * LDP + C_SV + h * 128 + d8); }
#pragma unroll
        for (int q = 0; q < 8; ++q) {
            const int f = tid + 256 * q, j = f >> 4, d8 = (f & 15) * 8;
            const float mean = stat[j * 2], rstd = stat[j * 2 + 1];
            const float4 g0 = *(const float4*)(lg + d8), g1 = *(const float4*)(lg + d8 + 4), b0 = *(const float4*)(lb + d8), b1 = *(const float4*)(lb + d8 + 4);
            uint4 o;
            o.x = pk2((lo2f(vr[q].x) - mean) * rstd * g0.x + b0.x, (hi2f(vr[q].x) - mean) * rstd * g0.y + b0.y);
            o.y = pk2((lo2f(vr[q].y) - mean) * rstd * g0.z + b0.z, (hi2f(vr[q].y) - mean) * rstd * g0.w + b0.w);
            o.z = pk2((lo2f(vr[q].z) - mean) * rstd * g1.x + b1.x, (hi2f(vr[q].z) - mean) * rstd * g1.y + b1.y);
            o.w = pk2((lo2f(vr[q].w) - mean) * rstd * g1.z + b1.z, (hi2f(vr[q].w) - mean) * rstd * g1.w + b1.w);
            *(uint4*)(vtb + j * RSB + d8) = o;
        }
    }
    __syncthreads();
    const int ti = tid >> 4, td = tid & 15;
    float acc[8][8];
#pragma unroll
    for (int a = 0; a < 8; ++a)
#pragma unroll
        for (int bq = 0; bq < 8; ++bq) acc[a][bq] = 0.f;
    const int jend = w * 32 + 32;
#pragma unroll 2
    for (int j = 0; j < jend; ++j) {
        const uint4 wr = *(const uint4*)(wtb + j * RSB + ti * 8), vr = *(const uint4*)(vtb + j * RSB + td * 8);
        const float wv[8] = {lo2f(wr.x), hi2f(wr.x), lo2f(wr.y), hi2f(wr.y), lo2f(wr.z), hi2f(wr.z), lo2f(wr.w), hi2f(wr.w)};
        const float vv[8] = {lo2f(vr.x), hi2f(vr.x), lo2f(vr.y), hi2f(vr.y), lo2f(vr.z), hi2f(vr.z), lo2f(vr.w), hi2f(vr.w)};
#pragma unroll
        for (int a = 0; a < 8; ++a)
#pragma unroll
            for (int bq = 0; bq < 8; ++bq) acc[a][bq] += wv[a] * vv[bq];
    }
    uint4 urv[8]; float bsv[8];
#pragma unroll
    for (int a = 0; a < 8; ++a) { const int i = ti * 8 + a; bsv[a] = p.sgu_b[((size_t)layer * 4 + h) * 128 + i]; urv[a] = *(const uint4*)(p.PROJ() + (size_t)(tb + i) * LDP + C_SU + h * 128 + td * 8); }
#pragma unroll
    for (int a = 0; a < 8; ++a) {
        const int i = ti * 8 + a; const size_t t = tb + i;
        const float bs = bsv[a];
        const uint4 ur = urv[a];
        const float u[8] = {lo2f(ur.x), hi2f(ur.x), lo2f(ur.y), hi2f(ur.y), lo2f(ur.z), hi2f(ur.z), lo2f(ur.w), hi2f(ur.w)};
        float y[8];
#pragma unroll
        for (int bq = 0; bq < 8; ++bq) y[bq] = u[bq] * (acc[a][bq] + bs);
        uint4 o; o.x = pk2(y[0], y[1]); o.y = pk2(y[2], y[3]); o.z = pk2(y[4], y[5]); o.w = pk2(y[6], y[7]);
        *(uint4*)(p.Y() + t * D + 512 + h * 128 + td * 8) = o;
    }
    __syncthreads();
}

DEV void st_vtrans(const P& p, int unit, char* smem) {
    bf16_t* tile = (bf16_t*)smem;
    const int which = unit & 1, tt0 = (unit >> 1) * 64, tid = tidx();
    const int col0 = which ? C_NVW : C_NVS;
    bf16_t* dst = which ? p.VWT() : p.VST();
#pragma unroll
    for (int q = 0; q < 4; ++q) {
        const int e = tid + 256 * q; const int r = e >> 4, c8 = e & 15;
        const uint4 raw = *(const uint4*)(p.PROJ() + (size_t)(tt0 + r) * LDP + col0 + c8 * 8);
        unsigned* d32 = (unsigned*)(tile + r * 130 + c8 * 8);
        d32[0] = raw.x; d32[1] = raw.y; d32[2] = raw.z; d32[3] = raw.w;
    }
    __syncthreads();
    const int d = tid >> 1, half = tid & 1;
    unsigned o[16];
#pragma unroll
    for (int i = 0; i < 16; ++i) {
        const int k = 16 * ((i >> 1) & 1) + 4 * (i >> 2) + 2 * (i & 1);
        const unsigned a = tile[(half * 32 + k) * 130 + d], b = tile[(half * 32 + k + 1) * 130 + d];
        o[i] = a | (b << 16);
    }
    uint4* dp = (uint4*)(dst + (size_t)d * T + tt0 + half * 32);
#pragma unroll
    for (int i = 0; i < 4; ++i) dp[i] = make_uint4(o[4 * i], o[4 * i + 1], o[4 * i + 2], o[4 * i + 3]);
    __syncthreads();
}

DEV void st_prep(const P& p, int layer, int unit) {
    const int tid_ = tidx(); const int w = tid_ >> 6, l = tid_ & 63; const size_t t = (size_t)unit * 4 + w;
    const bf16_t* row = p.PROJ() + t * LDP;
    const float* rc = p.ropeC() + t * 24; const float* rs_ = p.ropeS() + t * 24;
    unsigned raw[11];
#pragma unroll
    for (int h = 0; h < 4; ++h) { raw[h] = *(const unsigned*)(row + C_NQ + h * 128 + 2 * l); raw[6 + h] = *(const unsigned*)(row + C_DQ + h * 128 + 2 * l); }
    raw[4] = *(const unsigned*)(row + C_NKS + 2 * l); raw[5] = *(const unsigned*)(row + C_NKW + 2 * l); raw[10] = *(const unsigned*)(row + C_DK + 2 * l);
    bf16_t iraw[9];
#pragma unroll
    for (int h = 0; h < 9; ++h) iraw[h] = row[(h < 8 ? C_IQ + h * 64 : C_IK) + l];
    const float gq0 = p.nsa_qg[layer * 128 + 2 * l], gq1 = p.nsa_qg[layer * 128 + 2 * l + 1];
    const float gs0 = p.nsa_kg[(layer * 3 + 1) * 128 + 2 * l], gs1 = p.nsa_kg[(layer * 3 + 1) * 128 + 2 * l + 1];
    const float gw0 = p.nsa_kg[(layer * 3 + 2) * 128 + 2 * l], gw1 = p.nsa_kg[(layer * 3 + 2) * 128 + 2 * l + 1];
    const float dq0 = p.dsa_qg[layer * 128 + 2 * l], dq1 = p.dsa_qg[layer * 128 + 2 * l + 1];
    const float dk0 = p.dsa_kg[layer * 128 + 2 * l], dk1 = p.dsa_kg[layer * 128 + 2 * l + 1];
    const float c0 = rc[(2 * l) & 15], c1 = rc[(2 * l + 1) & 15], s0 = rs_[(2 * l) & 15], s1 = rs_[(2 * l + 1) & 15];
    const float ic = rc[16 + (l & 7)], is = rs_[16 + (l & 7)];
    float x0[11], x1[11], ss[11];
#pragma unroll
    for (int h = 0; h < 11; ++h) { x0[h] = lo2f(raw[h]); x1[h] = hi2f(raw[h]); ss[h] = x0[h] * x0[h] + x1[h] * x1[h]; }
#pragma unroll
    for (int h = 0; h < 11; ++h) ss[h] = wsum(ss[h]);
#pragma unroll
    for (int h = 0; h < 11; ++h) {
        const float r = rsqrtf(ss[h] * (1.0f / 128.0f) + EPS);
        const float g0 = h < 4 ? gq0 : (h == 4 ? gs0 : (h == 5 ? gw0 : (h < 10 ? dq0 : dk0)));
        const float g1 = h < 4 ? gq1 : (h == 4 ? gs1 : (h == 5 ? gw1 : (h < 10 ? dq1 : dk1)));
        const float n0 = x0[h] * r * g0, n1 = x1[h] * r * g1;
        const float o0 = __shfl_xor(n0, 8), o1 = __shfl_xor(n1, 8);
        float r0 = n0, r1 = n1;
        if (l < 8) { r0 = n0 * c0 - o0 * s0; r1 = n1 * c1 - o1 * s1; }
        else if (l < 16) { r0 = n0 * c0 + o0 * s0; r1 = n1 * c1 + o1 * s1; }
        const unsigned roped = pk2(r0, r1);
        if (h < 4) { *(unsigned*)(p.QN() + (t * 4 + h) * 128 + 2 * l) = pk2(n0, n1); *(unsigned*)(p.QR() + (t * 4 + h) * 128 + 2 * l) = roped; }
        else if (h == 4) *(unsigned*)(p.KS() + t * 128 + 2 * l) = roped;
        else if (h == 5) *(unsigned*)(p.KW() + t * 128 + 2 * l) = roped;
        else if (h < 10) *(unsigned*)(p.DQ() + (t * 4 + (h - 6)) * 128 + 2 * l) = roped;
        else *(unsigned*)(p.DK() + t * 128 + 2 * l) = roped;
    }
    if (l < 12) p.GATES()[t * 12 + l] = sigmoidf_(bf2f(row[C_NG + l]));
    *(unsigned*)(p.DVC() + t * 128 + 2 * l) = *(const unsigned*)(row + C_DV + 2 * l);
#pragma unroll
    for (int h = 0; h < 9; ++h) {
        const float x = bf2f(iraw[h]);
        const float other = __shfl_xor(x, 8);
        float o = x;
        if (l < 16) o = (l < 8) ? (x * ic - other * is) : (x * ic + other * is);
        if (h < 8) p.IQ()[(t * 8 + h) * 64 + l] = f2bf(o);
        else p.IK()[(((t >> 5) * 4 + (l >> 4)) * 64 + ((l >> 3) & 1) * 32 + (t & 31)) * 8 + (l & 7)] = f2bf(o);
    }
    if (l < 8) p.IW()[t * 8 + l] = bf2f(row[C_IW + l]) * (0.35355339059327373f * 0.125f);
}

DEV void st_compress(const P& p, int layer, int unit, char* smem) {
    const int which = unit & 1, rt = unit >> 1, tid = tidx(), w = tid >> 6, l = tid & 63, fr = l & 15, fq = l >> 4;
    float* hid = (float*)smem;
    float* ob = hid + 16 * 128;
    const int nb = rt * 16 + fr;
    const int col0 = which ? C_NVC : C_NKC;
    const float* ps = p.cmp_pos + ((size_t)layer * 2 + which) * 4096;
    const bf16_t* w1t = p.W1T() + ((size_t)layer * 2 + which) * 128 * 4096;
    const bool rowok = nb < 511;
    const bf16_t* xrow = p.KVC() + (size_t)(rowok ? nb * 16 : 0) * 256 + (which ? 128 : 0);
    f32x4 acc[2] = {(f32x4){0.f, 0.f, 0.f, 0.f}, (f32x4){0.f, 0.f, 0.f, 0.f}};
#pragma unroll 8
    for (int ks = 0; ks < 128; ++ks) {
        const int k = ks * 32 + fq * 8, lt = k >> 7, d = k & 127;
        const uint4 xr = *(const uint4*)(xrow + (size_t)lt * 256 + d);
        const float4 p0 = *(const float4*)(ps + k), p1 = *(const float4*)(ps + k + 4);
        union { bf16x8 v; unsigned u32[4]; } a;
        a.u32[0] = pk2(lo2f(xr.x) + p0.x, hi2f(xr.x) + p0.y); a.u32[1] = pk2(lo2f(xr.y) + p0.z, hi2f(xr.y) + p0.w);
        a.u32[2] = pk2(lo2f(xr.z) + p1.x, hi2f(xr.z) + p1.y); a.u32[3] = pk2(lo2f(xr.w) + p1.z, hi2f(xr.w) + p1.w);
#pragma unroll
        for (int nt = 0; nt < 2; ++nt) {
            const bf16x8 b = *(const bf16x8*)(w1t + (size_t)(w * 32 + nt * 16 + fr) * 4096 + k);
            acc[nt] = mfma16(a.v, b, acc[nt]);
        }
    }
#pragma unroll
    for (int nt = 0; nt < 2; ++nt)
#pragma unroll
        for (int r = 0; r < 4; ++r) hid[(4 * fq + r) * 128 + w * 32 + nt * 16 + fr] = gelu_tanh(acc[nt][r]);
    __syncthreads();
    const float* w2 = p.cmp_w2 + ((size_t)layer * 2 + which) * 128 * 128;
    const int c2 = tid & 127, mh = tid >> 7;
    float o[8];
#pragma unroll
    for (int b = 0; b < 8; ++b) o[b] = 0.f;
#pragma unroll 1
    for (int k0 = 0; k0 < 128; k0 += 32) {
        float wv[32];
#pragma unroll
        for (int k = 0; k < 32; ++k) wv[k] = w2[(k0 + k) * 128 + c2];
#pragma unroll
        for (int k4 = 0; k4 < 8; ++k4)
#pragma unroll
            for (int b = 0; b < 8; ++b) {
                const float4 h4 = *(const float4*)(hid + (mh * 8 + b) * 128 + k0 + k4 * 4);
                o[b] += h4.x * wv[4 * k4] + h4.y * wv[4 * k4 + 1] + h4.z * wv[4 * k4 + 2] + h4.w * wv[4 * k4 + 3];
            }
    }
#pragma unroll
    for (int b = 0; b < 8; ++b) ob[(mh * 8 + b) * 128 + c2] = o[b];
    __syncthreads();
#pragma unroll
    for (int q = 0; q < 4; ++q) {
        const int b = w * 4 + q, nbo = rt * 16 + b;
        float v0 = ob[b * 128 + l], v1 = ob[b * 128 + l + 64];
        if (which == 0) {
            const float r = rsqrtf(wsum(v0 * v0 + v1 * v1) * (1.0f / 128.0f) + EPS);
            const float* kg = p.nsa_kg + (layer * 3 + 0) * 128;
            v0 = v0 * r * kg[l]; v1 = v1 * r * kg[l + 64];
            if (nbo >= 511) { v0 = 0.f; v1 = 0.f; }
            p.KC()[nbo * 128 + l] = f2bf(v0); p.KC()[nbo * 128 + l + 64] = f2bf(v1);
        } else {
            if (nbo >= 511) { v0 = 0.f; v1 = 0.f; }
            const int nbp = (nbo & ~31) + 8 * ((nbo >> 2) & 3) + 4 * ((nbo >> 4) & 1) + (nbo & 3);
            p.VCT()[l * 512 + nbp] = f2bf(v0); p.VCT()[(l + 64) * 512 + nbp] = f2bf(v1);
        }
    }
    __syncthreads();
}

DEV void st_nsa_cmp(const P& p, int unit, char* smem) {
    constexpr int RSK = 272, RSV = 144, BUFB = 64 * RSK + 128 * RSV;
    static_assert(2 * BUFB <= SMEM_BYTES, "NSA compressed attention LDS");
    const int tid = tidx(), w = tid >> 6, l = tid & 63, qc = l & 15, g4 = l >> 4;
    const int t0 = unit * 16 + w * 4;
    const int tk = qc >> 2, hd = qc & 3, t = t0 + tk;
    bf16x8 qf[4];
#pragma unroll
    for (int ks = 0; ks < 4; ++ks) qf[ks] = *(const bf16x8*)(p.QN() + ((size_t)t0 * 4 + qc) * 128 + ks * 32 + g4 * 8);
    const int tmaxb = unit * 16 + 15;
    const int nvb = tmaxb >= 31 ? (tmaxb - 31) / 16 + 1 : 0;
    const int nsteps = (nvb + 63) >> 6;
    const int nvis = t >= 31 ? (t - 31) / 16 + 1 : 0;
    const float cs = 0.08838834764831845f * 1.4426950408889634f;
    const int krow = tid >> 4, kc16 = tid & 15, vrow = tid >> 3, vc16 = tid & 7;
    const bf16_t* Kg = p.KC(); const bf16_t* Vg = p.VCT();
    int gstep = 0;
    uint4 rk0, rk1, rk2, rk3, rv0, rv1, rv2, rv3;
#define CMP_LOADK(ST) do { const bf16_t* kb = Kg + (size_t)((ST) * 64 + krow) * 128 + kc16 * 8; \
        rk0 = *(const uint4*)kb; rk1 = *(const uint4*)(kb + 16 * 128); rk2 = *(const uint4*)(kb + 32 * 128); rk3 = *(const uint4*)(kb + 48 * 128); } while (0)
#define CMP_LOADV(ST) do { const bf16_t* vb = Vg + (size_t)vrow * 512 + (ST) * 64 + vc16 * 8; \
        rv0 = *(const uint4*)vb; rv1 = *(const uint4*)(vb + 32 * 512); rv2 = *(const uint4*)(vb + 64 * 512); rv3 = *(const uint4*)(vb + 96 * 512); } while (0)
#define CMP_STOREK(KT) do { *(uint4*)((KT) + krow * RSK + kc16 * 16) = rk0; *(uint4*)((KT) + (krow + 16) * RSK + kc16 * 16) = rk1; \
        *(uint4*)((KT) + (krow + 32) * RSK + kc16 * 16) = rk2; *(uint4*)((KT) + (krow + 48) * RSK + kc16 * 16) = rk3; } while (0)
#define CMP_STOREV(VT) do { *(uint4*)((VT) + vrow * RSV + vc16 * 16) = rv0; *(uint4*)((VT) + (vrow + 32) * RSV + vc16 * 16) = rv1; \
        *(uint4*)((VT) + (vrow + 64) * RSV + vc16 * 16) = rv2; *(uint4*)((VT) + (vrow + 96) * RSV + vc16 * 16) = rv3; } while (0)
    float m = -1e30f, lsum = 0.f;
    if (nsteps > 0) CMP_LOADK(0);
#pragma unroll 1
    for (int st = 0; st < nsteps; ++st, ++gstep) {
        char* Kt = smem + (gstep & 1) * BUFB;
        CMP_STOREK(Kt);
        __syncthreads();
        if (st + 1 < nsteps) CMP_LOADK(st + 1);
        float mx = m; f32x4 sv[4];
#pragma unroll
        for (int sub = 0; sub < 4; ++sub) {
            f32x4 a4 = (f32x4){0.f, 0.f, 0.f, 0.f};
#pragma unroll
            for (int ks = 0; ks < 4; ++ks) a4 = mfma16(*(const bf16x8*)(Kt + (sub * 16 + qc) * RSK + (ks * 32 + g4 * 8) * 2), qf[ks], a4);
#pragma unroll
            for (int r = 0; r < 4; ++r) { const int key = st * 64 + sub * 16 + 4 * g4 + r; a4[r] = (key < nvis) ? a4[r] * cs : -3e38f; mx = fmaxf(mx, a4[r]); }
            sv[sub] = a4;
        }
        float ps = 0.f;
#pragma unroll
        for (int sub = 0; sub < 4; ++sub)
#pragma unroll
            for (int r = 0; r < 4; ++r) ps += __builtin_amdgcn_exp2f(sv[sub][r] - mx);
        lsum = lsum * __builtin_amdgcn_exp2f(m - mx) + ps; m = mx;
    }
    {
        float mt_ = fmaxf(m, __shfl_xor(m, 16)); mt_ = fmaxf(mt_, __shfl_xor(mt_, 32));
        lsum *= __builtin_amdgcn_exp2f(m - mt_); m = mt_;
        lsum += __shfl_xor(lsum, 16); lsum += __shfl_xor(lsum, 32);
    }
    const float inv = (nvis > 0 && lsum > 0.f) ? 1.0f / lsum : 0.f;
    f32x4 o[8];
#pragma unroll
    for (int mt = 0; mt < 8; ++mt) o[mt] = (f32x4){0.f, 0.f, 0.f, 0.f};
    float yprev = 0.f;
    float impv[32];
#pragma unroll
    for (int i = 0; i < 32; ++i) impv[i] = 0.f;
    if (nsteps > 0) { CMP_LOADK(0); CMP_LOADV(0); }
#pragma unroll
    for (int st = 0; st < 8; ++st) {
        if (st < nsteps) {
            char* Kt = smem + (gstep & 1) * BUFB; char* Vt = Kt + 64 * RSK; ++gstep;
            CMP_STOREK(Kt); CMP_STOREV(Vt);
            __syncthreads();
            if (st + 1 < nsteps) { CMP_LOADK(st + 1); CMP_LOADV(st + 1); }
            f32x4 sv[4];
#pragma unroll
            for (int sub = 0; sub < 4; ++sub) {
                f32x4 a4 = (f32x4){0.f, 0.f, 0.f, 0.f};
#pragma unroll
                for (int ks = 0; ks < 4; ++ks) a4 = mfma16(*(const bf16x8*)(Kt + (sub * 16 + qc) * RSK + (ks * 32 + g4 * 8) * 2), qf[ks], a4);
#pragma unroll
                for (int r = 0; r < 4; ++r) { const int key = st * 64 + sub * 16 + 4 * g4 + r; a4[r] = (key < nvis) ? __builtin_amdgcn_exp2f(a4[r] * cs - m) * inv : 0.f; }
                const float y = __shfl(a4[3], (l + 48) & 63);
                float iv = (a4[0] + a4[1]) + (a4[2] + a4[3]) + (g4 > 0 ? y : yprev);
                yprev = y;
                iv += __shfl_xor(iv, 1); iv += __shfl_xor(iv, 2);
                impv[st * 4 + sub] = iv;
                sv[sub] = a4;
            }
#pragma unroll
            for (int pr = 0; pr < 2; ++pr) {
                union { bf16x8 v; unsigned u32[4]; } bb;
                bb.u32[0] = pk2(sv[2 * pr][0], sv[2 * pr][1]); bb.u32[1] = pk2(sv[2 * pr][2], sv[2 * pr][3]);
                bb.u32[2] = pk2(sv[2 * pr + 1][0], sv[2 * pr + 1][1]); bb.u32[3] = pk2(sv[2 * pr + 1][2], sv[2 * pr + 1][3]);
#pragma unroll
                for (int mt = 0; mt < 8; ++mt) {
                    const bf16x8 av = *(const bf16x8*)(Vt + (mt * 16 + qc) * RSV + (pr * 32 + 8 * g4) * 2);
                    o[mt] = mfma16(av, bb.v, o[mt]);
                }
            }
        }
    }
#undef CMP_LOADK
#undef CMP_LOADV
#undef CMP_STOREK
#undef CMP_STOREV
    __syncthreads();
    float* impl = (float*)smem + w * 512;
    if (hd == 0) {
#pragma unroll
        for (int i = 0; i < 32; ++i) impl[tk * 128 + 4 * i + g4] = impv[i];
    }
#pragma unroll
    for (int mt = 0; mt < 8; ++mt) {
        uint2 ov; ov.x = pk2(o[mt][0], o[mt][1]); ov.y = pk2(o[mt][2], o[mt][3]);
        *(uint2*)(p.OCMP() + ((size_t)t * 4 + hd) * 128 + mt * 16 + 4 * g4) = ov;
    }
    __syncthreads();
    const int li = hd + 4 * g4, cur = t >> 6;
    unsigned long long own[8]; int rank[8];
#pragma unroll
    for (int i = 0; i < 8; ++i) {
        const int j = li + 16 * i; const float v = impl[tk * 128 + j];
        const unsigned k32 = (j == 0 || j == cur || j == cur - 1) ? 0xFFFFFFFFu : (j > cur ? 0u : __float_as_uint(v) + 128u);
        own[i] = ((unsigned long long)k32 << 7) | (unsigned)(127 - j); rank[i] = 0;
    }
#pragma unroll 1
    for (int ip = 0; ip < 8; ++ip) {
#pragma unroll
        for (int q4 = 0; q4 < 4; ++q4) {
            const float4 ov = *(const float4*)(impl + tk * 128 + ip * 16 + q4 * 4);
            const float o4[4] = {ov.x, ov.y, ov.z, ov.w};
#pragma unroll
            for (int e = 0; e < 4; ++e) {
                const int jp = ip * 16 + q4 * 4 + e;
                const unsigned k32 = (jp == 0 || jp == cur || jp == cur - 1) ? 0xFFFFFFFFu : (jp > cur ? 0u : __float_as_uint(o4[e]) + 128u);
                const unsigned long long kp = ((unsigned long long)k32 << 7) | (unsigned)(127 - jp);
#pragma unroll
                for (int i = 0; i < 8; ++i) rank[i] += (kp > own[i]) ? 1 : 0;
            }
        }
    }
    unsigned mw[4] = {0u, 0u, 0u, 0u};
#pragma unroll
    for (int i = 0; i < 8; ++i) if (rank[i] < 16) mw[i >> 1] |= 1u << (li + 16 * (i & 1));
#pragma unroll
    for (int q = 0; q < 4; ++q) {
        unsigned v = mw[q];
        v |= __shfl_xor(v, 1); v |= __shfl_xor(v, 2); v |= __shfl_xor(v, 16); v |= __shfl_xor(v, 32);
        mw[q] = v;
    }
    if (li == 0) *(uint4*)(p.SEL() + (size_t)t * 4) = make_uint4(mw[0], mw[1], mw[2], mw[3]);
    __syncthreads();
}

DEV void st_nsa_attn(const P& p, int unit, char* smem) {
    constexpr int RSK = 272, RSV = 144, BUFB = 64 * RSK + 128 * RSV;
    static_assert(2 * BUFB <= SMEM_BYTES, "NSA attention LDS");
    const int tid = tidx(), w = tid >> 6, l = tid & 63, qc = l & 15, g4 = l >> 4;
    const int tq0 = unit * 16, t = tq0 + w * 4 + (qc >> 2), hd = qc & 3;
    bf16x8 qf[4];
#pragma unroll
    for (int ks = 0; ks < 4; ++ks) qf[ks] = *(const bf16x8*)(p.QR() + ((size_t)t * 4 + hd) * 128 + ks * 32 + g4 * 8);
    const uint4 selw = *(const uint4*)(p.SEL() + (size_t)t * 4);
    const float cs = 0.08838834764831845f * 1.4426950408889634f;
    unsigned part[8][2];
#pragma unroll
    for (int mt = 0; mt < 8; ++mt) { part[mt][0] = 0u; part[mt][1] = 0u; }
    const float g0 = p.GATES()[(size_t)t * 12 + hd * 3];
    int gstep = 0;
    const int krow = tid >> 4, kc16 = tid & 15, vrow = tid >> 3, vc16 = tid & 7;
#pragma unroll 1
    for (int br = 0; br < 2; ++br) {
        const bf16_t* Kg = br ? p.KW() : p.KS(); const bf16_t* Vg = br ? p.VWT() : p.VST();
        const int ktlast = (tq0 + 15) >> 6;
        const int ktfirst = br ? ((tq0 - 511 > 0 ? tq0 - 511 : 0) >> 6) : 0;
        const int nk = ktlast - ktfirst + 1;
        f32x4 o[8];
#pragma unroll
        for (int mt = 0; mt < 8; ++mt) o[mt] = (f32x4){0.f, 0.f, 0.f, 0.f};
        float m = -1e30f, lsum = 0.f;
        uint4 rk0, rk1, rk2, rk3, rv0, rv1, rv2, rv3;
#define NSA_LOAD(KT) do { const bf16_t* kb = Kg + (size_t)((KT) * 64 + krow) * 128 + kc16 * 8; const bf16_t* vb = Vg + (size_t)vrow * T + (KT) * 64 + vc16 * 8; \
        rk0 = *(const uint4*)kb; rk1 = *(const uint4*)(kb + 16 * 128); rk2 = *(const uint4*)(kb + 32 * 128); rk3 = *(const uint4*)(kb + 48 * 128); \
        rv0 = *(const uint4*)vb; rv1 = *(const uint4*)(vb + (size_t)32 * T); rv2 = *(const uint4*)(vb + (size_t)64 * T); rv3 = *(const uint4*)(vb + (size_t)96 * T); } while (0)
        NSA_LOAD(ktfirst);
#pragma unroll 1
        for (int i = 0; i < nk; ++i, ++gstep) {
            const int kt = ktfirst + i;
            char* Kt = smem + (gstep & 1) * BUFB; char* Vt = Kt + 64 * RSK;
            *(uint4*)(Kt + krow * RSK + kc16 * 16) = rk0; *(uint4*)(Kt + (krow + 16) * RSK + kc16 * 16) = rk1;
            *(uint4*)(Kt + (krow + 32) * RSK + kc16 * 16) = rk2; *(uint4*)(Kt + (krow + 48) * RSK + kc16 * 16) = rk3;
            *(uint4*)(Vt + vrow * RSV + vc16 * 16) = rv0; *(uint4*)(Vt + (vrow + 32) * RSV + vc16 * 16) = rv1;
            *(uint4*)(Vt + (vrow + 64) * RSV + vc16 * 16) = rv2; *(uint4*)(Vt + (vrow + 96) * RSV + vc16 * 16) = rv3;
            __syncthreads();
            if (i + 1 < nk) NSA_LOAD(kt + 1);
            int lo, hi = t;
            if (br == 0) {
                const unsigned wv = (kt & 64) ? ((kt & 32) ? selw.w : selw.z) : ((kt & 32) ? selw.y : selw.x);
                lo = 0; hi = ((wv >> (kt & 31)) & 1u) ? t : -1;
            } else lo = t - 511;
            const bool interior = (kt * 64 + 63 <= tq0) && (br == 0 || kt * 64 >= tq0 + 15 - 511);
            f32x4 sv[4];
            float mx = -3e38f;
            if (interior) {
                const float csl = hi >= 0 ? cs : 0.f, add = hi >= 0 ? 0.f : -3e38f;
#pragma unroll
                for (int sub = 0; sub < 4; ++sub) {
                    f32x4 a4 = (f32x4){0.f, 0.f, 0.f, 0.f};
#pragma unroll
                    for (int ks = 0; ks < 4; ++ks) a4 = mfma16(*(const bf16x8*)(Kt + (sub * 16 + qc) * RSK + (ks * 32 + g4 * 8) * 2), qf[ks], a4);
#pragma unroll
                    for (int r = 0; r < 4; ++r) { a4[r] = a4[r] * csl + add; mx = fmaxf(mx, a4[r]); }
                    sv[sub] = a4;
                }
            } else {
#pragma unroll
                for (int sub = 0; sub < 4; ++sub) {
                    f32x4 a4 = (f32x4){0.f, 0.f, 0.f, 0.f};
#pragma unroll
                    for (int ks = 0; ks < 4; ++ks) a4 = mfma16(*(const bf16x8*)(Kt + (sub * 16 + qc) * RSK + (ks * 32 + g4 * 8) * 2), qf[ks], a4);
#pragma unroll
                    for (int r = 0; r < 4; ++r) {
                        const int kp = kt * 64 + sub * 16 + 4 * g4 + r;
                        const bool valid = (kp >= lo) & (kp <= hi);
                        a4[r] = valid ? a4[r] * cs : -3e38f;
                        mx = fmaxf(mx, a4[r]);
                    }
                    sv[sub] = a4;
                }
            }
            mx = fmaxf(mx, __shfl_xor(mx, 16)); mx = fmaxf(mx, __shfl_xor(mx, 32));
            const float mnew = fmaxf(fmaxf(m, mx), -1e30f);
            const float alpha = __builtin_amdgcn_exp2f(m - mnew);
            m = mnew;
            float ps = 0.f;
#pragma unroll
            for (int sub = 0; sub < 4; ++sub)
#pragma unroll
                for (int r = 0; r < 4; ++r) { const float pv = __builtin_amdgcn_exp2f(sv[sub][r] - mnew); sv[sub][r] = pv; ps += pv; }
            lsum = lsum * alpha + ps;
            if (__any(alpha != 1.0f)) {
#pragma unroll
                for (int mt = 0; mt < 8; ++mt) o[mt] *= alpha;
            }
#pragma unroll
            for (int pr = 0; pr < 2; ++pr) {
                union { bf16x8 v; unsigned u32[4]; } bb;
                bb.u32[0] = pk2(sv[2 * pr][0], sv[2 * pr][1]); bb.u32[1] = pk2(sv[2 * pr][2], sv[2 * pr][3]);
                bb.u32[2] = pk2(sv[2 * pr + 1][0], sv[2 * pr + 1][1]); bb.u32[3] = pk2(sv[2 * pr + 1][2], sv[2 * pr + 1][3]);
#pragma unroll
                for (int mt = 0; mt < 8; ++mt) {
                    const bf16x8 av = *(const bf16x8*)(Vt + (mt * 16 + qc) * RSV + (pr * 32 + 8 * g4) * 2);
                    o[mt] = mfma16(av, bb.v, o[mt]);
                }
            }
        }
#undef NSA_LOAD
        lsum += __shfl_xor(lsum, 16); lsum += __shfl_xor(lsum, 32);
        const float gate = p.GATES()[(size_t)t * 12 + hd * 3 + 1 + br];
        const float sc = lsum > 0.f ? gate / lsum : 0.f;
        if (br == 0) {
#pragma unroll
            for (int mt = 0; mt < 8; ++mt) {
                const uint2 oc = *(const uint2*)(p.OCMP() + ((size_t)t * 4 + hd) * 128 + mt * 16 + 4 * g4);
                part[mt][0] = pk2(sc * o[mt][0] + g0 * lo2f(oc.x), sc * o[mt][1] + g0 * hi2f(oc.x));
                part[mt][1] = pk2(sc * o[mt][2] + g0 * lo2f(oc.y), sc * o[mt][3] + g0 * hi2f(oc.y));
            }
        } else {
#pragma unroll
            for (int mt = 0; mt < 8; ++mt) {
                uint2 ov;
                ov.x = pk2(sc * o[mt][0] + lo2f(part[mt][0]), sc * o[mt][1] + hi2f(part[mt][0]));
                ov.y = pk2(sc * o[mt][2] + lo2f(part[mt][1]), sc * o[mt][3] + hi2f(part[mt][1]));
                *(uint2*)(p.Y() + (size_t)t * D + 1024 + hd * 128 + mt * 16 + 4 * g4) = ov;
            }
        }
    }
    __syncthreads();
}

DEV unsigned f2key(float f) { const unsigned u = __float_as_uint(f); return (u & 0x80000000u) ? ~u : (u | 0x80000000u); }
DEV float key2f(unsigned k) { const unsigned u = (k & 0x80000000u) ? (k & 0x7fffffffu) : ~k; return __uint_as_float(u); }
template <int NPASS>
DEV float wave_prune_t(float* sc, unsigned short* ix, unsigned* hist, int m, int l, int& kept) {
    float v[8]; unsigned k[8]; unsigned short id[8]; bool ok[8];
#pragma unroll
    for (int i = 0; i < 8; ++i) {
        const int e = l + 64 * i; ok[i] = e < m;
        v[i] = ok[i] ? sc[e] : 0.f; id[i] = ok[i] ? ix[e] : (unsigned short)0; k[i] = f2key(v[i]);
    }
    unsigned prefix = 0u; int need = 256;
#pragma unroll 1
    for (int pass = 0; pass < NPASS; ++pass) {
        const int shift = 24 - 8 * pass;
        *(uint4*)(hist + 4 * l) = make_uint4(0u, 0u, 0u, 0u);
        __builtin_amdgcn_wave_barrier();
#pragma unroll
        for (int i = 0; i < 8; ++i) {
            const bool in = ok[i] && (pass == 0 || (k[i] >> (shift + 8)) == prefix);
            if (in) atomicAdd(&hist[(k[i] >> shift) & 255u], 1u);
        }
        __builtin_amdgcn_wave_barrier();
        const uint4 hv = *(const uint4*)(hist + 4 * l);
        const unsigned hq[4] = {hv.x, hv.y, hv.z, hv.w};
        const unsigned own = hv.x + hv.y + hv.z + hv.w;
        unsigned tot = own;
#pragma unroll
        for (int o = 1; o < 64; o <<= 1) { const unsigned tv = __shfl_down(tot, o); if (l + o < 64) tot += tv; }
        unsigned cum = tot - own; int found = -1; int nneed = 0;
#pragma unroll
        for (int kk = 3; kk >= 0; --kk) {
            const unsigned c = hq[kk];
            if (found < 0 && (int)cum < need && (int)(cum + c) >= need) { found = 4 * l + kk; nneed = need - (int)cum; }
            cum += c;
        }
        const unsigned long long bal = __ballot(found >= 0);
        const int src = __ffsll((long long)bal) - 1;
        const int digit = __shfl(found, src); need = __shfl(nneed, src);
        prefix = (prefix << 8) | (unsigned)digit;
    }
    int base = 0;
    const unsigned long long ltmask = (1ull << l) - 1ull;
    if (NPASS == 4) {
        const unsigned thr = prefix;
        int ties = 0;
#pragma unroll
        for (int i = 0; i < 8; ++i) {
            const bool gt = ok[i] && k[i] > thr, eq = ok[i] && k[i] == thr;
            const unsigned long long em = __ballot(eq);
            const int trank = ties + __popcll(em & ltmask);
            const bool keep = gt || (eq && trank < need);
            ties += __popcll(em);
            const unsigned long long km = __ballot(keep);
            const int pos = base + __popcll(km & ltmask);
            if (keep) { sc[pos] = v[i]; ix[pos] = id[i]; }
            base += __popcll(km);
        }
        __builtin_amdgcn_wave_barrier();
        kept = base;
        return key2f(thr);
    } else {
        const unsigned lo = prefix << 16;
#pragma unroll
        for (int i = 0; i < 8; ++i) {
            const bool keep = ok[i] && k[i] >= lo;
            const unsigned long long km = __ballot(keep);
            const int pos = base + __popcll(km & ltmask);
            if (keep) { sc[pos] = v[i]; ix[pos] = id[i]; }
            base += __popcll(km);
        }
        __builtin_amdgcn_wave_barrier();
        kept = base;
        return key2f(lo - 1u);
    }
}
DEV float wave_prune(float* sc, unsigned short* ix, unsigned* hist, int m, int l) { int kept; return wave_prune_t<4>(sc, ix, hist, m, l, kept); }
DEV float wave_prune_mid(float* sc, unsigned short* ix, unsigned* hist, int& cnt, int l) {
    int kept; float tau = wave_prune_t<2>(sc, ix, hist, cnt, l, kept);
    if (kept > 352) { tau = wave_prune_t<4>(sc, ix, hist, kept, l, kept); }
    cnt = kept;
    return tau;
}

#define DSA_APPEND2(COND, M64, SV, SCP, IXP, CL, CH) do { \
    const unsigned _ml = (unsigned)(M64), _mh = (unsigned)((M64) >> 32); \
    if (COND) { const int _pos = (h ? (CH) : (CL)) + __popc((h ? _mh : _ml) & ((1u << n) - 1u)); (SCP)[_pos] = (SV); (IXP)[_pos] = (unsigned short)kp; } \
    (CL) += __popc(_ml); (CH) += __popc(_mh); } while (0)
#define DSA_APPEND(SCP, IXP, CNT, M32, MINE, SV) do { \
    const unsigned _m = (M32); \
    if (MINE) { const int _pos = (CNT) + __popc(_m & ((1u << n) - 1u)); (SCP)[_pos] = (SV); (IXP)[_pos] = (unsigned short)kp; } \
    (CNT) += __popc(_m); } while (0)

DEV void st_dsa_index(const P& p, int unit, char* smem) {
    const int tid = tidx(), w = tid >> 6, l = tid & 63, n = l & 31, h = l >> 5;
    char* wb = smem + w * 14336;
    float* sc0 = (float*)wb; float* sc1 = sc0 + 512; float* sc2 = sc1 + 512; float* sc3 = sc2 + 512;
    unsigned short* ix0 = (unsigned short*)(wb + 8192); unsigned short* ix1 = ix0 + 512; unsigned short* ix2 = ix1 + 512; unsigned short* ix3 = ix2 + 512;
    unsigned* hist = (unsigned*)(wb + 12288);
    float* scA = h ? sc2 : sc0; float* scB = h ? sc3 : sc1; unsigned short* ixA = h ? ix2 : ix0; unsigned short* ixB = h ? ix3 : ix1;
    const int wu = unit * 4 + w;
    const int tg = 2047 - wu;
    const int t0 = tg * 4;
    const int tl = 2 * ((n >> 2) & 1) + (n >> 4), hdr = (n & 3) + 4 * ((n >> 3) & 1);
    bf16x8 af[4];
#pragma unroll
    for (int s = 0; s < 4; ++s) af[s] = *(const bf16x8*)(p.IQ() + ((size_t)(t0 + tl) * 8 + hdr) * 64 + 16 * s + 8 * h);
    const int tA = t0 + 2 * h, tB = tA + 1;
    float wA[8], wB[8];
#pragma unroll
    for (int r = 0; r < 8; ++r) { wA[r] = p.IW()[(size_t)tA * 8 + r]; wB[r] = p.IW()[(size_t)tB * 8 + r]; }
    int cnt0 = 0, cnt1 = 0, cnt2 = 0, cnt3 = 0;
    const float NINF = -__builtin_inff();
    float tau0 = NINF, tau1 = NINF, tau2 = NINF, tau3 = NINF;
    const int ntiles = (t0 + 3) / 32 + 1;
    const bf16_t* ikp = p.IK() + (size_t)l * 8;
    bf16x8 xa[4], xb[4], ya[4], yb[4];
#pragma unroll
    for (int s = 0; s < 4; ++s) { xa[s] = *(const bf16x8*)(ikp + 512 * s); xb[s] = *(const bf16x8*)(ikp + (size_t)(ntiles > 1 ? 2048 : 0) + 512 * s); ya[s] = xa[s]; yb[s] = xb[s]; }
#define DSA_ITER(CHECK, CA, CB, NA, NB) do { \
        if (!(CHECK)) { \
            const int kb_ = kt + 3 < ntiles ? kt + 3 : ntiles - 1; \
            _Pragma("unroll") for (int s = 0; s < 4; ++s) { NA[s] = *(const bf16x8*)(ikp + (size_t)(kt + 2) * 2048 + 512 * s); NB[s] = *(const bf16x8*)(ikp + (size_t)kb_ * 2048 + 512 * s); } \
        } \
        f32x16 acca, accb; \
        _Pragma("unroll") for (int r = 0; r < 16; ++r) { acca[r] = 0.f; accb[r] = 0.f; } \
        _Pragma("unroll") for (int s = 0; s < 4; ++s) { acca = mfma32(af[s], CA[s], acca); accb = mfma32(af[s], CB[s], accb); } \
        float s0a = 0.f, s1a = 0.f, s0b = 0.f, s1b = 0.f, u0a = 0.f, u1a = 0.f, u0b = 0.f, u1b = 0.f; \
        _Pragma("unroll") for (int r = 0; r < 4; ++r) { \
            s0a += wA[r] * relu1(acca[r]); u0a += wA[4 + r] * relu1(acca[4 + r]); \
            s1a += wB[r] * relu1(acca[8 + r]); u1a += wB[4 + r] * relu1(acca[12 + r]); \
            s0b += wA[r] * relu1(accb[r]); u0b += wA[4 + r] * relu1(accb[4 + r]); \
            s1b += wB[r] * relu1(accb[8 + r]); u1b += wB[4 + r] * relu1(accb[12 + r]); \
        } \
        s0a += u0a; s1a += u1a; s0b += u0b; s1b += u1b; \
        const float tauA = h ? tau2 : tau0, tauB = h ? tau3 : tau1; \
        { \
            const int kp = kt * 32 + n; \
            if (CHECK) { s0a = kp <= tA ? s0a : NINF; s1a = kp <= tB ? s1a : NINF; } \
            const bool cA = s0a > tauA, cB = s1a > tauB; \
            const unsigned long long mA = __ballot(cA), mB = __ballot(cB); \
            DSA_APPEND2(cA, mA, s0a, scA, ixA, cnt0, cnt2); DSA_APPEND2(cB, mB, s1a, scB, ixB, cnt1, cnt3); \
        } \
        { \
            const int kp = kt * 32 + 32 + n; \
            if (CHECK) { s0b = kp <= tA ? s0b : NINF; s1b = kp <= tB ? s1b : NINF; } \
            const bool cA = s0b > tauA, cB = s1b > tauB; \
            const unsigned long long mA = __ballot(cA), mB = __ballot(cB); \
            DSA_APPEND2(cA, mA, s0b, scA, ixA, cnt0, cnt2); DSA_APPEND2(cB, mB, s1b, scB, ixB, cnt1, cnt3); \
        } \
    } while (0)
#define DSA_PRUNE_CHECK() do { \
        __builtin_amdgcn_wave_barrier(); \
        if (max(max(cnt0, cnt1), max(cnt2, cnt3)) > 448) { \
            if (cnt0 > 448) tau0 = wave_prune_mid(sc0, ix0, hist, cnt0, l); \
            if (cnt1 > 448) tau1 = wave_prune_mid(sc1, ix1, hist, cnt1, l); \
            if (cnt2 > 448) tau2 = wave_prune_mid(sc2, ix2, hist, cnt2, l); \
            if (cnt3 > 448) tau3 = wave_prune_mid(sc3, ix3, hist, cnt3, l); \
        } } while (0)
    int kt = 0; bool in_y = false;
#pragma unroll 1
    for (;;) {
        if (!(kt + 2 < ntiles)) break;
        DSA_ITER(false, xa, xb, ya, yb); DSA_PRUNE_CHECK(); kt += 2;
        if (!(kt + 2 < ntiles)) { in_y = true; break; }
        DSA_ITER(false, ya, yb, xa, xb); DSA_PRUNE_CHECK(); kt += 2;
    }
    if (in_y) DSA_ITER(true, ya, yb, xa, xb); else DSA_ITER(true, xa, xb, ya, yb);
    __builtin_amdgcn_wave_barrier();
#undef DSA_PRUNE_CHECK
    if (cnt0 > 256) { wave_prune(sc0, ix0, hist, cnt0, l); cnt0 = 256; }
    if (cnt1 > 256) { wave_prune(sc1, ix1, hist, cnt1, l); cnt1 = 256; }
    if (cnt2 > 256) { wave_prune(sc2, ix2, hist, cnt2, l); cnt2 = 256; }
    if (cnt3 > 256) { wave_prune(sc3, ix3, hist, cnt3, l); cnt3 = 256; }
    __builtin_amdgcn_wave_barrier();
#pragma unroll
    for (int i = 0; i < 4; ++i) {
        const int e = l + 64 * i;
        p.IDX()[(size_t)(t0 + 0) * 256 + e] = e < cnt0 ? (int)ix0[e] : 0;
        p.IDX()[(size_t)(t0 + 1) * 256 + e] = e < cnt1 ? (int)ix1[e] : 0;
        p.IDX()[(size_t)(t0 + 2) * 256 + e] = e < cnt2 ? (int)ix2[e] : 0;
        p.IDX()[(size_t)(t0 + 3) * 256 + e] = e < cnt3 ? (int)ix3[e] : 0;
    }
    if (l == 0) { p.CNT()[t0] = cnt0; p.CNT()[t0 + 1] = cnt1; p.CNT()[t0 + 2] = cnt2; p.CNT()[t0 + 3] = cnt3; }
}

DEV void st_dsa_attn(const P& p, int unit, char* smem) {
    const int tid = tidx(), w = tid >> 6, l = tid & 63, c = l & 15, g4 = l >> 4;
    int* idxs = (int*)(smem + w * 5120); float* Pl = (float*)(smem + w * 5120 + 1024);
    const size_t t = (size_t)unit * 4 + w;
    const int cnt = p.CNT()[t];
#pragma unroll
    for (int i = 0; i < 4; ++i) idxs[l + 64 * i] = p.IDX()[t * 256 + l + 64 * i];
    __builtin_amdgcn_wave_barrier();
    bf16x8 qf[4];
#pragma unroll
    for (int j = 0; j < 4; ++j) qf[j] = *(const bf16x8*)(p.DQ() + (t * 4 + (c & 3)) * 128 + g4 * 32 + j * 8);
    f32x4 s[16];
    const int ntile = (cnt + 15) >> 4;
#pragma unroll
    for (int th = 0; th < 2; ++th) {
        bf16x8 kf[8][4];
        if (th * 8 < ntile) {
#pragma unroll
            for (int q = 0; q < 8; ++q) {
                const int krow = idxs[(th * 8 + q) * 16 + c];
                const bf16_t* kp = p.DK() + (size_t)krow * 128 + g4 * 32;
#pragma unroll
                for (int j = 0; j < 4; ++j) kf[q][j] = *(const bf16x8*)(kp + j * 8);
            }
        }
#pragma unroll
        for (int q = 0; q < 8; ++q) {
            s[th * 8 + q] = (f32x4){0.f, 0.f, 0.f, 0.f};
            if (th * 8 < ntile) {
#pragma unroll
                for (int j = 0; j < 4; ++j) s[th * 8 + q] = mfma16(kf[q][j], qf[j], s[th * 8 + q]);
            }
        }
        __builtin_amdgcn_sched_barrier(0);
    }
    const float cs = 0.08838834764831845f * 1.4426950408889634f;
    const int nk64 = (cnt + 63) >> 6;
    uint4 raw[16];
#pragma unroll
    for (int q = 0; q < 16; ++q) raw[q] = *(const uint4*)(p.DVC() + (size_t)idxs[q * 4 + g4] * 128 + c * 8);
    float mx = -1e30f;
#pragma unroll
    for (int tt = 0; tt < 16; ++tt)
#pragma unroll
        for (int r = 0; r < 4; ++r) { const int slot = tt * 16 + 4 * g4 + r; if (slot < cnt) mx = fmaxf(mx, s[tt][r] * cs); }
    mx = fmaxf(mx, __shfl_xor(mx, 16)); mx = fmaxf(mx, __shfl_xor(mx, 32));
    float sum = 0.f;
#pragma unroll
    for (int tt = 0; tt < 16; ++tt)
#pragma unroll
        for (int r = 0; r < 4; ++r) { const int slot = tt * 16 + 4 * g4 + r; const float pv = slot < cnt ? exp2f(s[tt][r] * cs - mx) : 0.f; s[tt][r] = pv; sum += pv; }
    sum += __shfl_xor(sum, 16); sum += __shfl_xor(sum, 32);
    const float inv = sum > 0.f ? 1.0f / sum : 0.f;
    if (c < 4) {
#pragma unroll
        for (int tt = 0; tt < 16; ++tt)
#pragma unroll
            for (int r = 0; r < 4; ++r) Pl[(tt * 16 + 4 * g4 + r) * 4 + c] = s[tt][r] * inv;
    }
    __builtin_amdgcn_wave_barrier();
    float acc[4][8];
#pragma unroll
    for (int hh = 0; hh < 4; ++hh)
#pragma unroll
        for (int j = 0; j < 8; ++j) acc[hh][j] = 0.f;
#pragma unroll 1
    for (int kb = 0; kb < nk64; ++kb) {
        if (kb > 0) {
#pragma unroll
            for (int q = 0; q < 16; ++q) raw[q] = *(const uint4*)(p.DVC() + (size_t)idxs[(kb * 16 + q) * 4 + g4] * 128 + c * 8);
        }
#pragma unroll
        for (int q = 0; q < 16; ++q) {
            const float4 p4 = *(const float4*)(Pl + ((kb * 16 + q) * 4 + g4) * 4);
            const float vv[8] = {lo2f(raw[q].x), hi2f(raw[q].x), lo2f(raw[q].y), hi2f(raw[q].y), lo2f(raw[q].z), hi2f(raw[q].z), lo2f(raw[q].w), hi2f(raw[q].w)};
            const float pp[4] = {p4.x, p4.y, p4.z, p4.w};
#pragma unroll
            for (int hh = 0; hh < 4; ++hh)
#pragma unroll
                for (int j = 0; j < 8; ++j) acc[hh][j] += pp[hh] * vv[j];
        }
    }
#pragma unroll
    for (int hh = 0; hh < 4; ++hh)
#pragma unroll
        for (int j = 0; j < 8; ++j) { float a = acc[hh][j]; a += __shfl_xor(a, 16); a += __shfl_xor(a, 32); acc[hh][j] = a; }
    if (g4 == 0) {
#pragma unroll
        for (int hh = 0; hh < 4; ++hh) {
            uint4 o; o.x = pk2(acc[hh][0], acc[hh][1]); o.y = pk2(acc[hh][2], acc[hh][3]); o.z = pk2(acc[hh][4], acc[hh][5]); o.w = pk2(acc[hh][6], acc[hh][7]);
            *(uint4*)(p.Y() + t * D + 1536 + hh * 128 + c * 8) = o;
        }
    }
    __builtin_amdgcn_wave_barrier();
}

DEV void ins16(unsigned (&top)[16], unsigned x) {
#pragma unroll
    for (int j = 0; j < 16; ++j) { const unsigned hi = max(top[j], x); x = min(top[j], x); top[j] = hi; }
}
DEV void cex(unsigned& a, unsigned& b) { const unsigned hi = max(a, b), lo = min(a, b); a = hi; b = lo; }
DEV void sort16_desc(unsigned (&v)[16]) {
#pragma unroll
    for (int k = 2; k <= 16; k <<= 1)
#pragma unroll
        for (int j = k >> 1; j > 0; j >>= 1)
#pragma unroll
            for (int i = 0; i < 16; ++i) {
                const int q = i ^ j;
                if (q > i) { if ((i & k) == 0) cex(v[i], v[q]); else cex(v[q], v[i]); }
            }
}
DEV void merge16_desc(unsigned (&top)[16], const unsigned (&x)[16]) {
#pragma unroll
    for (int i = 0; i < 16; ++i) top[i] = max(top[i], x[15 - i]);
#pragma unroll
    for (int j = 8; j > 0; j >>= 1)
#pragma unroll
        for (int i = 0; i < 16; ++i) { const int q = i ^ j; if (q > i) cex(top[i], top[q]); }
}
DEV void st_peer_topk(const P& p, int layer, int unit, char* smem) {
    const int tid = tidx(), w = tid >> 6, l = tid & 63, n = l & 31, hf = l >> 5;
    const int head = unit & 7, tg = (unit >> 3) * 4 + w;
    const size_t t = (size_t)tg * 32 + n;
    unsigned* il = (unsigned*)smem + w * 1024;
    unsigned top[2][16];
#pragma unroll
    for (int pp = 0; pp < 2; ++pp) {
        float qv[32];
#pragma unroll
        for (int i = 0; i < 8; ++i) { const float4 v = *(const float4*)(p.PQ() + t * 1024 + head * 128 + pp * 64 + hf * 32 + i * 4); qv[4 * i] = v.x; qv[4 * i + 1] = v.y; qv[4 * i + 2] = v.z; qv[4 * i + 3] = v.w; }
        const float* K = p.peer_sk + ((((size_t)layer * 8 + head) * 2 + pp) * 128) * 64;
#pragma unroll
        for (int j = 0; j < 16; ++j) top[pp][j] = 0u;
        float kn[32];
        {
            const float* kr = K + (size_t)n * 64 + hf * 32;
#pragma unroll
            for (int i = 0; i < 8; ++i) { const float4 v = *(const float4*)(kr + i * 4); kn[4 * i] = v.x; kn[4 * i + 1] = v.y; kn[4 * i + 2] = v.z; kn[4 * i + 3] = v.w; }
        }
#pragma unroll 1
        for (int tile = 0; tile < 4; ++tile) {
            float kv[32];
#pragma unroll
            for (int i = 0; i < 32; ++i) kv[i] = kn[i];
            if (tile < 3) {
                const float* kr = K + (size_t)((tile + 1) * 32 + n) * 64 + hf * 32;
#pragma unroll
                for (int i = 0; i < 8; ++i) { const float4 v = *(const float4*)(kr + i * 4); kn[4 * i] = v.x; kn[4 * i + 1] = v.y; kn[4 * i + 2] = v.z; kn[4 * i + 3] = v.w; }
            }
            f32x16 acc;
#pragma unroll
            for (int r = 0; r < 16; ++r) acc[r] = 0.f;
#pragma unroll
            for (int kk = 0; kk < 32; ++kk) acc = __builtin_amdgcn_mfma_f32_32x32x2f32(kv[kk], qv[kk], acc, 0, 0, 0);
            unsigned tv[16];
#pragma unroll
            for (int r = 0; r < 16; ++r) {
                const int nn = tile * 32 + (r & 3) + 8 * (r >> 2) + 4 * hf;
                tv[r] = (f2key(acc[r]) & ~127u) | (unsigned)(127 - nn);
            }
            sort16_desc(tv);
            merge16_desc(top[pp], tv);
        }
        unsigned oth[16];
#pragma unroll
        for (int j = 0; j < 16; ++j) oth[j] = __shfl_xor(top[pp][j], 32);
        merge16_desc(top[pp], oth);
        if (hf == 0) {
#pragma unroll
            for (int j = 0; j < 16; ++j) il[(pp * 16 + j) * 32 + n] = 127u - (top[pp][j] & 127u);
        }
    }
    __builtin_amdgcn_wave_barrier();
    if (hf == 0) {
        float v1[16], v2[16];
#pragma unroll
        for (int j = 0; j < 16; ++j) { v1[j] = key2f(top[0][j] & ~127u); v2[j] = key2f(top[1][j] & ~127u); }
        unsigned ct[16];
#pragma unroll
        for (int s = 0; s < 16; ++s) ct[s] = 0u;
#pragma unroll
        for (int i = 0; i < 16; ++i)
#pragma unroll
            for (int j = 0; j < 16; ++j)
                if ((i + 1) * (j + 1) <= 16) ins16(ct, (f2key(v1[i] + v2[j]) & ~255u) | (unsigned)(255 - (i * 16 + j)));
        float ex[16], sum = 0.f; int ce[16];
        const float c0 = key2f(ct[0] & ~255u);
#pragma unroll
        for (int s = 0; s < 16; ++s) {
            const unsigned code = 255u - (ct[s] & 255u);
            ce[s] = (int)(il[(code >> 4) * 32 + n] * 128u + il[(16 + (code & 15u)) * 32 + n]);
            ex[s] = __expf(key2f(ct[s] & ~255u) - c0); sum += ex[s];
        }
        const float inv = 1.0f / sum;
#pragma unroll
        for (int s4 = 0; s4 < 4; ++s4) {
            *(int4*)(p.PE() + t * 128 + head * 16 + s4 * 4) = make_int4(ce[4 * s4], ce[4 * s4 + 1], ce[4 * s4 + 2], ce[4 * s4 + 3]);
            *(float4*)(p.PG() + t * 128 + head * 16 + s4 * 4) = make_float4(ex[4 * s4] * inv, ex[4 * s4 + 1] * inv, ex[4 * s4 + 2] * inv, ex[4 * s4 + 3] * inv);
        }
    }
    __builtin_amdgcn_wave_barrier();
}

DEV void st_peer_gather(const P& p, int layer, const float* __restrict__ xin, float* __restrict__ xout, int unit, char* smem) {
    const int tid_ = tidx(); const int w = tid_ >> 6, l = tid_ & 63; const size_t t = (size_t)unit * 4 + w;
    float* row = (float*)smem + w * 2112;
    const int* pip = p.PI();
    const float ic6 = __int_as_float(__builtin_amdgcn_readfirstlane(pip[32]));
    const int e0 = p.PE()[t * 128 + l], e1 = p.PE()[t * 128 + 64 + l];
    const float g0 = p.PG()[t * 128 + l], g1 = p.PG()[t * 128 + 64 + l];
    {
#pragma unroll
        for (int i = 0; i < 4; ++i) {
            const uint4 hv = *(const uint4*)(p.HN() + t * D + i * 512 + l * 8);
            const unsigned u4[4] = {hv.x, hv.y, hv.z, hv.w};
            const int c = i * 512 + l * 8;
#pragma unroll
            for (int q = 0; q < 4; ++q) { row[((c + 2 * q) >> 5) * 33 + ((c + 2 * q) & 31)] = lo2f(u4[q]); row[((c + 2 * q + 1) >> 5) * 33 + ((c + 2 * q + 1) & 31)] = hi2f(u4[q]); }
        }
        __builtin_amdgcn_wave_barrier();
    }
    unsigned hp[16];
#pragma unroll
    for (int j = 0; j < 16; ++j)
        hp[j] = (__float_as_uint(row[l * 33 + __builtin_amdgcn_readfirstlane(pip[2 * j])]) >> 16) |
                (__float_as_uint(row[l * 33 + __builtin_amdgcn_readfirstlane(pip[2 * j + 1])]) & 0xffff0000u);
    __builtin_amdgcn_wave_barrier();
    float out[32];
#pragma unroll
    for (int i = 0; i < 32; ++i) out[i] = 0.f;
    const unsigned char* U = p.Utab() + (size_t)layer * 16384 * ROW6; const unsigned char* V = p.Vtab() + (size_t)layer * 16384 * ROW6;
    const unsigned voff = (unsigned)l * 8u;
    const bool b5 = (l & 32) != 0, b4 = (l & 16) != 0;
#if PEER_FP4
#pragma unroll 1
    for (int k4 = 0; k4 < 32; ++k4) {
        int e[4]; float g[4];
#pragma unroll
        for (int q = 0; q < 4; ++q) {
            const int k = k4 * 4 + q;
            e[q] = __builtin_amdgcn_readlane(k4 < 16 ? e0 : e1, k & 63);
            g[q] = __int_as_float(__builtin_amdgcn_readlane(__float_as_int(k4 < 16 ? g0 : g1), k & 63));
        }
#if PEER_FP4
        uint4 uu[4], vv[4];
#pragma unroll
        for (int q = 0; q < 4; ++q) { uu[q] = *(const uint4*)(U + (size_t)e[q] * ROW6 + 2 * voff); vv[q] = *(const uint4*)(V + (size_t)e[q] * ROW6 + 2 * voff); }
#define GATHER_UNPACK(F, SRC) do { fp4_unpack8((SRC).x, &(F)[0]); fp4_unpack8((SRC).y, &(F)[8]); fp4_unpack8((SRC).z, &(F)[16]); fp4_unpack8((SRC).w, &(F)[24]); } while (0)
#define GATHER_FIRST(SRC) (SRC).x
#else
        uint2 uu[4][3], vv[4][3];
#pragma unroll
        for (int q = 0; q < 4; ++q)
#pragma unroll
            for (int i = 0; i < 3; ++i) { uu[q][i] = *(const uint2*)(U + (size_t)e[q] * ROW6 + (voff + i * 512)); vv[q][i] = *(const uint2*)(V + (size_t)e[q] * ROW6 + (voff + i * 512)); }
#endif
        float d[4];
#pragma unroll
        for (int q = 0; q < 4; ++q) {
#if PEER_FP4
            if (q > 0) asm volatile("" : "+v"(uu[q].x), "+v"(d[q - 1]));
            float f[32]; GATHER_UNPACK(f, uu[q]);
#else
            v6u pk; pk[0] = uu[q][0].x; pk[1] = uu[q][0].y; pk[2] = uu[q][1].x; pk[3] = uu[q][1].y; pk[4] = uu[q][2].x; pk[5] = uu[q][2].y;
            if (q > 0) { unsigned t0_ = pk[0]; asm volatile("" : "+v"(t0_), "+v"(d[q - 1])); pk[0] = t0_; }
            const v32f f = FP6_UNPACK(pk);
#endif
            float acc = 0.f;
#pragma unroll
            for (int j = 0; j < 16; ++j) acc += f[2 * j] * lo2f(hp[j]) + f[2 * j + 1] * hi2f(hp[j]);
            d[q] = acc;
            __builtin_amdgcn_sched_barrier(0);
        }
        float kA = b5 ? d[2] : d[0], kB = b5 ? d[3] : d[1];
        const float sA = b5 ? d[0] : d[2], sB = b5 ? d[1] : d[3];
        kA += __shfl_xor(sA, 32); kB += __shfl_xor(sB, 32);
        float kk = b4 ? kB : kA; const float ss = b4 ? kA : kB;
        kk += __shfl_xor(ss, 16);
        kk += __shfl_xor(kk, 8); kk += __shfl_xor(kk, 4); kk += __shfl_xor(kk, 2); kk += __shfl_xor(kk, 1);
        const float gsel = b5 ? (b4 ? g[3] : g[2]) : (b4 ? g[1] : g[0]);
        const float av = gelu_tanh(kk * (ic6 / U6_SCALE)) * gsel * (ic6 / V6_SCALE);
        const int avi = __float_as_int(av);
        const float a4[4] = {__int_as_float(__builtin_amdgcn_readlane(avi, 0)), __int_as_float(__builtin_amdgcn_readlane(avi, 16)),
                             __int_as_float(__builtin_amdgcn_readlane(avi, 32)), __int_as_float(__builtin_amdgcn_readlane(avi, 48))};
#pragma unroll
        for (int q = 0; q < 4; ++q) {
#if PEER_FP4
            asm volatile("" : "+v"(vv[q].x), "+v"(out[31]));
            float f[32]; GATHER_UNPACK(f, vv[q]);
#else
            v6u pk; pk[0] = vv[q][0].x; pk[1] = vv[q][0].y; pk[2] = vv[q][1].x; pk[3] = vv[q][1].y; pk[4] = vv[q][2].x; pk[5] = vv[q][2].y;
            { unsigned t0_ = pk[0]; asm volatile("" : "+v"(t0_), "+v"(out[31])); pk[0] = t0_; }
            const v32f f = FP6_UNPACK(pk);
#endif
#pragma unroll
            for (int j = 0; j < 32; ++j) out[j] += a4[q] * f[j];
            __builtin_amdgcn_sched_barrier(0);
        }
    }
#else
    typedef unsigned u32x2 __attribute__((ext_vector_type(2)));
    u32x2 uu[4][3], vv[4][3];
#define GATHER_LOAD(DST, TAB, K4) do { \
        _Pragma("unroll") for (int q = 0; q < 4; ++q) { \
            const int k = (K4) * 4 + q; \
            const int eq = __builtin_amdgcn_readlane((K4) < 16 ? e0 : e1, k & 63); \
            _Pragma("unroll") for (int i = 0; i < 3; ++i) DST[q][i] = *(const u32x2*)((TAB) + (size_t)eq * ROW6 + (voff + i * 512)); \
        } } while (0)
    GATHER_LOAD(uu, U, 0); GATHER_LOAD(vv, V, 0);
#pragma unroll 1
    for (int k4 = 0; k4 < 32; ++k4) {
        float g[4];
#pragma unroll
        for (int q = 0; q < 4; ++q) { const int k = k4 * 4 + q; g[q] = __int_as_float(__builtin_amdgcn_readlane(__float_as_int(k4 < 16 ? g0 : g1), k & 63)); }
        const int kn = k4 < 31 ? k4 + 1 : 31;
        float d[4];
#pragma unroll
        for (int q = 0; q < 4; ++q) {
            v6u pk; pk[0] = uu[q][0].x; pk[1] = uu[q][0].y; pk[2] = uu[q][1].x; pk[3] = uu[q][1].y; pk[4] = uu[q][2].x; pk[5] = uu[q][2].y;
            if (q > 0) { unsigned t0_ = pk[0]; asm volatile("" : "+v"(t0_), "+v"(d[q - 1])); pk[0] = t0_; }
            const bf16x32v f = FP6_UNPACK_BF16(pk);
            float acc = 0.f;
#pragma unroll
            for (int j = 0; j < 16; ++j) {
                const bf16x2v fj = {f[2 * j], f[2 * j + 1]};
                acc = __builtin_amdgcn_fdot2_f32_bf16(fj, __builtin_bit_cast(bf16x2v, hp[j]), acc, false);
            }
            d[q] = acc;
            __builtin_amdgcn_sched_barrier(0);
        }
        GATHER_LOAD(uu, U, kn);
        __builtin_amdgcn_sched_barrier(0);
        float kA = b5 ? d[2] : d[0], kB = b5 ? d[3] : d[1];
        const float sA = b5 ? d[0] : d[2], sB = b5 ? d[1] : d[3];
        kA += __shfl_xor(sA, 32); kB += __shfl_xor(sB, 32);
        float kk = b4 ? kB : kA; const float ss = b4 ? kA : kB;
        kk += __shfl_xor(ss, 16);
        kk += __shfl_xor(kk, 8); kk += __shfl_xor(kk, 4); kk += __shfl_xor(kk, 2); kk += __shfl_xor(kk, 1);
        const float gsel = b5 ? (b4 ? g[3] : g[2]) : (b4 ? g[1] : g[0]);
        const float av = gelu_tanh(kk * (ic6 / U6_SCALE)) * gsel * (ic6 / V6_SCALE);
        const int avi = __float_as_int(av);
        const float a4[4] = {__int_as_float(__builtin_amdgcn_readlane(avi, 0)), __int_as_float(__builtin_amdgcn_readlane(avi, 16)),
                             __int_as_float(__builtin_amdgcn_readlane(avi, 32)), __int_as_float(__builtin_amdgcn_readlane(avi, 48))};
#pragma unroll
        for (int q = 0; q < 4; ++q) {
            v6u pk; pk[0] = vv[q][0].x; pk[1] = vv[q][0].y; pk[2] = vv[q][1].x; pk[3] = vv[q][1].y; pk[4] = vv[q][2].x; pk[5] = vv[q][2].y;
            { unsigned t0_ = pk[0]; asm volatile("" : "+v"(t0_), "+v"(out[31])); pk[0] = t0_; }
            const v32f f = FP6_UNPACK(pk);
#pragma unroll
            for (int j = 0; j < 32; ++j) out[j] += a4[q] * f[j];
            __builtin_amdgcn_sched_barrier(0);
        }
        GATHER_LOAD(vv, V, kn);
        __builtin_amdgcn_sched_barrier(0);
    }
#undef GATHER_LOAD
#endif
    asm volatile("" : "+s"(pip));
#pragma unroll
    for (int j = 0; j < 32; ++j) row[l * 33 + __builtin_amdgcn_readfirstlane(pip[j])] = out[j];
    __builtin_amdgcn_wave_barrier();
    const float* g2 = p.ada() + layer * 12288 + 5 * 2048;
    float4 xo[8]; float ssq = 0.f;
#pragma unroll
    for (int i = 0; i < 8; ++i) {
        const int c = i * 256 + l * 4;
        const float* rp = row + (c >> 5) * 33 + (c & 31);
        const size_t off = t * D + c;
        const float4 x0 = *(const float4*)(xin + off); const float4 ga = *(const float4*)(g2 + c);
        float4 o0;
        o0.x = x0.x + ga.x * rp[0]; o0.y = x0.y + ga.y * rp[1]; o0.z = x0.z + ga.z * rp[2]; o0.w = x0.w + ga.w * rp[3];
        *(float4*)(xout + off) = o0;
        xo[i] = o0; ssq += o0.x * o0.x + o0.y * o0.y + o0.z * o0.z + o0.w * o0.w;
        if (i & 1) __builtin_amdgcn_sched_barrier(0);
    }
    if (layer + 1 < NL) {
        const float rs = rsqrtf(wsum(ssq) * (1.0f / 2048.0f) + EPS);
        const float* ng = p.n1g + (layer + 1) * 2048; const float* adn = p.ada() + (layer + 1) * 12288;
#pragma unroll
        for (int i = 0; i < 8; ++i) {
            const int c = i * 256 + l * 4;
            const float4 gg = *(const float4*)(ng + c), sc = *(const float4*)(adn + 2048 + c), sh = *(const float4*)(adn + c);
            uint2 o;
            o.x = pk2((xo[i].x * rs) * gg.x * (1.0f + sc.x) + sh.x, (xo[i].y * rs) * gg.y * (1.0f + sc.y) + sh.y);
            o.y = pk2((xo[i].z * rs) * gg.z * (1.0f + sc.z) + sh.z, (xo[i].w * rs) * gg.w * (1.0f + sc.w) + sh.w);
            *(uint2*)(p.HN() + t * D + c) = o;
            if (i & 1) __builtin_amdgcn_sched_barrier(0);
        }
    }
    __builtin_amdgcn_wave_barrier();
}

enum { S_CONVT_IN = 0, S_CONVT_OUT, S_CONVT_Q, S_CONVT_W1, S_CALIB, S_TAB_U, S_TAB_V, S_ADA, S_ROPE, S_NORM1, S_GEMM_IN, S_CONV, S_SGU, S_VTRANS, S_PREP,
       S_COMPRESS, S_NSA_CMP, S_DSA_INDEX, S_NSA_ATTN, S_DSA_ATTN, S_GEMM_OUT, S_NORM2, S_GEMM_Q, S_PEER_TOPK, S_PEER_GATHER, S_COUNT };
constexpr int TAB_UNITS = 4096;
__host__ __device__ constexpr int nunits(int s) {
    return s == S_CONVT_IN ? 2 * 32 * (LDP / 64) : s == S_CONVT_OUT ? 2 * 32 * 32 : s == S_CONVT_Q ? 2 * 32 * 16 : s == S_CONVT_W1 ? 4 * 64 * 2 : s == S_CALIB ? 1 : s == S_TAB_U ? TAB_UNITS : s == S_TAB_V ? TAB_UNITS
         : s == S_ADA ? 384 : s == S_ROPE ? 768 : s == S_NORM1 ? 2048 : s == S_GEMM_IN ? 64 * (LDP / 128) : s == S_CONV ? 512 : s == S_SGU ? 256
         : s == S_VTRANS ? 256 : s == S_PREP ? 2048 : s == S_COMPRESS ? 64 : s == S_NSA_CMP ? 512 : s == S_DSA_INDEX ? 512 : s == S_NSA_ATTN ? 512 : s == S_DSA_ATTN ? 2048
         : s == S_GEMM_OUT ? 64 * 16 : s == S_NORM2 ? 2048 : s == S_GEMM_Q ? 64 * 8 : s == S_PEER_TOPK ? 512 : s == S_PEER_GATHER ? 2048 : 0;
}
template <int S>
DEV void run_unit(const P& p, int layer, int u, char* smem, int nu = TAB_UNITS) {
    const float* xin = layer == 0 ? p.x : p.X2();
    const float* ada = p.ada() + layer * 12288;
    if constexpr (S == S_CONVT_IN) { const int per = 32 * (LDP / 64), ly = u / per; st_convT(p.w_in + (size_t)ly * 2048 * INC, p.WinT() + (size_t)ly * LDP * 2048, INC, LDP, true, u % per, smem); }
    else if constexpr (S == S_CONVT_OUT) { const int per = 32 * 32, ly = u / per; st_convT(p.w_out + (size_t)ly * 2048 * 2048, p.WoutT() + (size_t)ly * 2048 * 2048, 2048, 2048, false, u % per, smem); }
    else if constexpr (S == S_CONVT_Q) { const int per = 32 * 16, ly = u / per; st_convT(p.peer_wq + (size_t)ly * 2048 * 1024, p.WqT() + (size_t)ly * 1024 * 2048, 1024, 1024, false, u % per, smem); }
    else if constexpr (S == S_CONVT_W1) { const int per = 64 * 2, mi = u / per; st_convT(p.cmp_w1 + (size_t)mi * 4096 * 128, p.W1T() + (size_t)mi * 128 * 4096, 128, 128, false, u % per, smem, 4096); }
    else if constexpr (S == S_CALIB) st_calib(p);
#if PEER_FP4
    else if constexpr (S == S_TAB_U) st_tab4(p, p.peer_u, p.Utab(), U6_SCALE, 2 * 16384, u, nu, smem);
    else if constexpr (S == S_TAB_V) st_tab4(p, p.peer_v, p.Vtab(), V6_SCALE, 2 * 16384, u, nu, smem);
#else
    else if constexpr (S == S_TAB_U) st_tab6(p.peer_u, p.Utab(), U6_SCALE, 2 * 16384, u, nu, smem);
    else if constexpr (S == S_TAB_V) st_tab6(p.peer_v, p.Vtab(), V6_SCALE, 2 * 16384, u, nu, smem);
#endif
    else if constexpr (S == S_ADA) st_ada(p, u, smem);
    else if constexpr (S == S_ROPE) st_rope(p, u);
    else if constexpr (S == S_NORM1) st_norm(xin, p.n1g + layer * 2048, ada + 2048, ada, p.HN(), u);
    else if constexpr (S == S_GEMM_IN) { EpiArgs e{p.PROJ(), nullptr, nullptr, nullptr, p.KVC()}; st_gemm<EPI_PROJ>(p.HN(), p.WinT() + (size_t)layer * LDP * 2048, 2048, u & 63, u >> 6, e, smem); }
    else if constexpr (S == S_CONV) st_conv(p, layer, u, smem);
    else if constexpr (S == S_SGU) st_sgu(p, layer, u, smem);
    else if constexpr (S == S_VTRANS) st_vtrans(p, u, smem);
    else if constexpr (S == S_PREP) st_prep(p, layer, u);
    else if constexpr (S == S_COMPRESS) st_compress(p, layer, u, smem);
    else if constexpr (S == S_NSA_CMP) st_nsa_cmp(p, u, smem);
    else if constexpr (S == S_DSA_INDEX) st_dsa_index(p, u, smem);
    else if constexpr (S == S_NSA_ATTN) st_nsa_attn(p, u, smem);
    else if constexpr (S == S_DSA_ATTN) st_dsa_attn(p, u, smem);
    else if constexpr (S == S_GEMM_OUT) { EpiArgs e{nullptr, p.X1(), xin, ada + 2 * 2048, nullptr}; st_gemm<EPI_OUT>(p.Y(), p.WoutT() + (size_t)layer * 2048 * 2048, 2048, u & 63, u >> 6, e, smem); }
    else if constexpr (S == S_NORM2) st_norm(p.X1(), p.n2g + layer * 2048, ada + 4 * 2048, ada + 3 * 2048, p.HN(), u);
    else if constexpr (S == S_GEMM_Q) { EpiArgs e{nullptr, p.PQ(), nullptr, nullptr, nullptr}; st_gemm<EPI_Q>(p.HN(), p.WqT() + (size_t)layer * 1024 * 2048, 2048, u & 63, u >> 6, e, smem); }
    else if constexpr (S == S_PEER_TOPK) st_peer_topk(p, layer, u, smem);
    else if constexpr (S == S_PEER_GATHER) st_peer_gather(p, layer, p.X1(), layer == 0 ? p.X2() : p.out, u, smem);
}


#define XB_TMO      128
#define XB_XCNT(j)  (256  + 64 * (j))
#define XB_XSUB(j)  (1280 + 64 * (j))
#define XB_XGEN(j)  (2304 + 64 * (j))
#define XB_TOP      3328
#define XB_TOPGEN   3392
#define XB_SPIN_CAP (1u << 22)
#define LAS __attribute__((address_space(3)))
DEV unsigned xb_ld(unsigned* p) { return __hip_atomic_load(p, __ATOMIC_RELAXED, __HIP_MEMORY_SCOPE_AGENT); }
DEV unsigned xb_add(unsigned* p, unsigned v) { return __hip_atomic_fetch_add(p, v, __ATOMIC_RELAXED, __HIP_MEMORY_SCOPE_AGENT); }
DEV unsigned xb_xcc_id() { return (unsigned)__builtin_amdgcn_s_getreg((3 << 11) | 20) & 0xFu; }
#define XB_SPIN(cond, bar) do { unsigned _sp = 0; while (cond) { __builtin_amdgcn_s_sleep(1); \
    if ((++_sp & 255u) == 0u) { if (xb_ld(&(bar)[XB_TMO])) break; if (_sp > XB_SPIN_CAP) { atomicAdd(&(bar)[XB_TMO], 1u); break; } } } } while (0)
struct XcdBarrier { unsigned* bar; unsigned x; volatile LAS unsigned* st; };
DEV XcdBarrier xcd_barrier_post(unsigned* bar, volatile LAS unsigned* st) {
    XcdBarrier b; b.bar = bar; b.x = xb_xcc_id(); b.st = st;
    if (threadIdx.x == 0) (void)xb_add(&bar[XB_XCNT(b.x)], 1u);
    return b;
}
DEV void xcd_barrier_complete(unsigned* bar, unsigned x, unsigned& nloc, unsigned& nx) {
    const unsigned G = gridDim.x * gridDim.y * gridDim.z;
    unsigned sum, cnt, mine, sp = 0u;
    for (;;) {
        sum = 0u; cnt = 0u; mine = 0u;
#pragma unroll
        for (unsigned j = 0; j < 16; ++j) { const unsigned c = xb_ld(&bar[XB_XCNT(j)]); sum += c; cnt += (c > 0u) ? 1u : 0u; mine = (j == x) ? c : mine; }
        if (sum == G) break;
        __builtin_amdgcn_s_sleep(1);
        if ((++sp & 255u) == 0u) { if (xb_ld(&bar[XB_TMO])) break; if (sp > XB_SPIN_CAP) { atomicAdd(&bar[XB_TMO], 1u); break; } }
    }
    nloc = mine > 0u ? mine : 1u; nx = cnt > 0u ? cnt : 1u;
}
DEV void xcd_barrier(const XcdBarrier& b) {
    asm volatile("s_waitcnt vmcnt(0)" ::: "memory");
    __syncthreads();
    if (threadIdx.x == 0) {
        unsigned* bar = b.bar;
        __builtin_amdgcn_s_waitcnt(0);
        unsigned nloc = b.st[0], nx = b.st[1];
        if (nloc == 0u) { xcd_barrier_complete(bar, b.x, nloc, nx); b.st[0] = nloc; b.st[1] = nx; }
        const unsigned old = xb_add(&bar[XB_XSUB(b.x)], 1u);
        const unsigned gen = old / nloc;
        if (old + 1u == (gen + 1u) * nloc) {
            __builtin_amdgcn_fence(__ATOMIC_RELEASE, "agent");
            asm volatile("s_waitcnt vmcnt(0)" ::: "memory");
            const unsigned og = xb_add(&bar[XB_TOP], 1u);
            const unsigned tg = og / nx;
            if (og + 1u == (tg + 1u) * nx) xb_add(&bar[XB_TOPGEN], 1u);
            else XB_SPIN(xb_ld(&bar[XB_TOPGEN]) == tg, bar);
            __builtin_amdgcn_fence(__ATOMIC_ACQUIRE, "agent");
            xb_add(&bar[XB_XGEN(b.x)], 1u);
            asm volatile("s_waitcnt vmcnt(0)" ::: "memory");
        } else {
            XB_SPIN(xb_ld(&bar[XB_XGEN(b.x)]) == gen, bar);
            __builtin_amdgcn_fence(__ATOMIC_ACQUIRE, "agent");
            asm volatile("s_waitcnt vmcnt(0)" ::: "memory");
        }
    }
    __syncthreads();
}

#ifndef MULTI_LAUNCH
constexpr int REP_STAGE = -1, REP_STAGE2 = -1, REP_N = 1;
template <int S, int LIM = 0>
DEV void run_phase1(const P& p, int layer, char* smem, int off);
template <int S, int LIM = 0>
DEV void run_phase(const P& p, int layer, char* smem, int off = 0) {
    constexpr int reps = (S == REP_STAGE || S == REP_STAGE2) ? REP_N : 1;
#pragma unroll 1
    for (int r = 0; r < reps; ++r) run_phase1<S, LIM>(p, layer, smem, off);
}
template <int S, int LIM>
DEV void run_phase1(const P& p, int layer, char* smem, int off) {
    const int G = gridDim.x;
    int b = blockIdx.x + off; if (b >= G) b -= G;
    if constexpr (S == S_TAB_U || S == S_TAB_V) { run_unit<S>(p, layer, b, smem, G); }
    else {
        for (int u = b; u < (LIM ? LIM : nunits(S)); u += G) { run_unit<S>(p, layer, u, smem); __syncthreads(); }
    }
}
template <int S>
DEV void run_gemm_phase1(const P& p, int layer, char* smem, unsigned xcc, volatile LAS unsigned* slot, int rep) {
    constexpr int TN = (S == S_GEMM_IN) ? (LDP / 128) : (S == S_GEMM_OUT ? 16 : 8);
    constexpr int NBIG = (S == S_GEMM_IN) ? 36 : (S == S_GEMM_OUT ? 16 : 0);
    constexpr int inst0 = (S == S_GEMM_IN) ? 0 : (S == S_GEMM_OUT ? 2 : 4);
    constexpr int nbig = 4 * NBIG, len = nbig + 8 * (TN - NBIG);
    const float* xin = layer == 0 ? p.x : p.X2();
    const float* ada = p.ada() + layer * 12288;
    const bf16_t* Aop = (S == S_GEMM_OUT) ? p.Y() : p.HN();
    const bf16_t* Bop = (S == S_GEMM_IN) ? p.WinT() + (size_t)layer * LDP * 2048 : (S == S_GEMM_OUT ? p.WoutT() + (size_t)layer * 2048 * 2048 : p.WqT() + (size_t)layer * 1024 * 2048);
    EpiArgs e{p.PROJ(), (S == S_GEMM_OUT) ? p.X1() : p.PQ(), xin, ada + 2 * 2048, p.KVC()};
    constexpr int EPI = (S == S_GEMM_IN) ? EPI_PROJ : (S == S_GEMM_OUT ? EPI_OUT : EPI_Q);
#pragma unroll 1
    for (int q = 0; q < 8; ++q) {
        const unsigned xq = (xcc + q) & 7u;
        unsigned* head = p.bar() + GQ_WORD(inst0 + layer + 6 * rep, xq);
        for (;;) {
            if (threadIdx.x == 0) *slot = xb_add(head, 1u);
            __syncthreads();
            const int i = (int)*slot;
            __syncthreads();
            if (i >= len) break;
            if (i < nbig) st_gemm<EPI, 8>(Aop, Bop, 2048, (int)xq * 4 + (i & 3), i >> 2, e, smem);
            else {
                const int j = i - nbig, tm = (int)xq * 8 + (j & 7), tn = NBIG + (j >> 3);
                st_gemm<EPI, 4>(Aop, Bop, 2048, tm, tn, e, smem);
                if constexpr (S == S_GEMM_Q) {
                    asm volatile("s_waitcnt vmcnt(0)" ::: "memory");
                    __syncthreads();
                    st_peer_topk(p, layer, tm * 8 + tn, smem);
                }
            }
            __syncthreads();
        }
    }
}
template <int S>
DEV void run_items(const P& p, int layer, char* smem, int first, int count) {
    constexpr int reps = (S == REP_STAGE || S == REP_STAGE2) ? REP_N : 1;
#pragma unroll 1
    for (int r = 0; r < reps; ++r)
#pragma unroll 1
        for (int u = first; u < first + count; ++u) { run_unit<S>(p, layer, u, smem); __syncthreads(); }
}
DEV void dep_publish(unsigned* cnt) {
    asm volatile("s_waitcnt vmcnt(0)" ::: "memory");
    __syncthreads();
    if (threadIdx.x == 0) { __builtin_amdgcn_fence(__ATOMIC_RELEASE, "agent"); asm volatile("s_waitcnt vmcnt(0)" ::: "memory"); (void)xb_add(cnt, 1u); }
}
DEV void dep_wait(unsigned* cnt, unsigned target, unsigned* bar) {
    if (threadIdx.x == 0) {
        XB_SPIN(xb_ld(cnt) < target, bar);
        __builtin_amdgcn_fence(__ATOMIC_ACQUIRE, "agent");
        asm volatile("s_waitcnt vmcnt(0)" ::: "memory");
    }
    __syncthreads();
}
template <int PH>
DEV void run_dyn_phase(const P& p, int layer, char* smem, volatile LAS unsigned* slot) {
    unsigned* head = p.bar() + DQ_WORD(PH * 2 + layer);
    unsigned* cprep = p.bar() + DQ_WORD(12 + layer); unsigned* ccomp = p.bar() + DQ_WORD(14 + layer);
    constexpr int total0 = PH == 0 ? (256 + 64 + 256 + 256 + 64 + 512 + 512) : (512 + 1024);
    const int total = (PH == 0 && layer == 0) ? total0 + 512 + 296 + 256 + 128 : total0;
    int i = blockIdx.x, par = 0;
    while (i < total) {
        if constexpr (PH == 0) {
            int li = i;
            if (layer == 0 && i >= 896) {
                const int j = i - 896;
                if (j < 1704) { const int nd = (j * 512) / 1704, nd1 = ((j + 1) * 512) / 1704; li = nd1 > nd ? 896 + nd : 1920 + (j - nd); }
                else li = 1408 + (j - 1704);
            }
            if (li < 256) { run_items<S_PREP>(p, layer, smem, li * 8, 8); dep_publish(cprep); }
            else if (li < 320) { run_items<S_COMPRESS>(p, layer, smem, li - 256, 1); dep_publish(ccomp); }
            else if (li < 576) run_items<S_SGU>(p, layer, smem, li - 320, 1);
            else if (li < 832) run_items<S_CONV>(p, layer, smem, (li - 576) * 2, 2);
            else if (li < 896) run_items<S_VTRANS>(p, layer, smem, (li - 832) * 4, 4);
            else if (li < 1408) { dep_wait(cprep, 256u, p.bar()); run_items<S_DSA_INDEX>(p, layer, smem, li - 896, 1); }
            else if (li < 1920) { dep_wait(cprep, 256u, p.bar()); dep_wait(ccomp, 64u, p.bar()); run_items<S_NSA_CMP>(p, layer, smem, 511 - (li - 1408), 1); }
            else if (li < 2176) { run_unit<S_TAB_U>(p, layer, li - 1920, smem, 256); __syncthreads(); }
            else if (li < 2432) { run_unit<S_TAB_V>(p, layer, li - 2176, smem, 256); __syncthreads(); }
            else if (li < 2728) st_convT_run(p.w_in + (size_t)2048 * INC, p.WinT() + (size_t)LDP * 2048, INC, LDP, true, (li - 2432) * 8, 8, smem);
            else if (li < 2984) { const int u = (li - 2728) * 8, ly = u >> 10; st_convT_run(p.w_out + (size_t)ly * 2048 * 2048, p.WoutT() + (size_t)ly * 2048 * 2048, 2048, 2048, false, u & 1023, 8, smem); }
            else { const int u = (li - 2984) * 8, ly = u >> 9; st_convT_run(p.peer_wq + (size_t)ly * 2048 * 1024, p.WqT() + (size_t)ly * 1024 * 2048, 1024, 1024, false, u & 511, 8, smem); }
        } else {
            if (i < 512) run_items<S_NSA_ATTN>(p, layer, smem, 511 - i, 1);
            else run_items<S_DSA_ATTN>(p, layer, smem, (i - 512) * 2, 2);
        }
        if (threadIdx.x == 0) slot[par] = gridDim.x + xb_add(head, 1u);
        __syncthreads();
        i = (int)slot[par]; par ^= 1;
    }
}
template <int S>
DEV void run_gemm_phase(const P& p, int layer, char* smem, unsigned xcc, volatile LAS unsigned* slot) {
    constexpr int reps = (S == REP_STAGE || S == REP_STAGE2) ? REP_N : 1;
#pragma unroll 1
    for (int r = 0; r < reps; ++r) run_gemm_phase1<S>(p, layer, smem, xcc, slot, r);
}
#if defined(__HIP_DEVICE_COMPILE__)
typedef const P __attribute__((address_space(4)))* kargp_t;
DEV const P& fresh_params() { kargp_t q = (kargp_t)__builtin_amdgcn_kernarg_segment_ptr(); asm volatile("" : "+s"(q)); return *(const P*)q; }
#define PP fresh_params()
#else
#define PP p
#endif
#define GSYNC() xcd_barrier(xb)
__global__ void __launch_bounds__(NTHREADS, 2) k_mega(P p) {
    __shared__ __attribute__((aligned(16))) char smem[SMEM_BYTES];
    __shared__ uint4 xb_words;
    cg::grid_group grid = cg::this_grid();
    if (threadIdx.x == 0) xb_words = make_uint4(0u, 0u, 0u, 0u);
    __syncthreads();
    XcdBarrier xb = xcd_barrier_post(p.bar(), (volatile LAS unsigned*)&xb_words);
    const int H = gridDim.x >> 1, Q = gridDim.x >> 2;
    run_phase<S_ADA>(PP, 0, smem); run_phase<S_ROPE>(PP, 0, smem, H);
    {
        const P& pp = PP; const int G = gridDim.x, b = blockIdx.x;
        const int u0 = (int)((long long)b * 2368 / G), u1 = (int)((long long)(b + 1) * 2368 / G);
        if (u1 > u0) st_convT_run(pp.w_in, pp.WinT(), INC, LDP, true, u0, u1 - u0, smem);
    }
    run_phase<S_CONVT_W1>(PP, 0, smem); run_phase<S_CALIB>(PP, 0, smem, 100);
    GSYNC();
    if (gridDim.x == 0x7fffffffu) grid.sync();
#pragma unroll 1
    for (int layer = 0; layer < NL; ++layer) {
        if (layer == 0) { run_phase<S_NORM1>(PP, layer, smem); GSYNC(); }
        run_gemm_phase<S_GEMM_IN>(PP, layer, smem, xb.x, (volatile LAS unsigned*)&xb_words + 2); GSYNC();
        run_dyn_phase<0>(PP, layer, smem, (volatile LAS unsigned*)&xb_words + 2); GSYNC();
        run_dyn_phase<2>(PP, layer, smem, (volatile LAS unsigned*)&xb_words + 2); GSYNC();
        run_gemm_phase<S_GEMM_OUT>(PP, layer, smem, xb.x, (volatile LAS unsigned*)&xb_words + 2); GSYNC();
        run_phase<S_NORM2>(PP, layer, smem); GSYNC();
        run_gemm_phase<S_GEMM_Q>(PP, layer, smem, xb.x, (volatile LAS unsigned*)&xb_words + 2); GSYNC();
        run_phase<S_PEER_GATHER>(PP, layer, smem); if (layer + 1 < NL) GSYNC();
    }
}
#else
template <int S>
__global__ void __launch_bounds__(NTHREADS) k_stage(P p, int layer) {
    __shared__ __attribute__((aligned(16))) char smem[SMEM_BYTES];
    run_unit<S>(p, layer, blockIdx.x, smem);
}
template <int S> static void launch_stage(const P& p, int layer, hipStream_t st) {
    hipLaunchKernelGGL((k_stage<S>), dim3(nunits(S)), dim3(NTHREADS), 0, st, p, layer);
}
#endif

extern "C" void kernel_launch(void* const* d_in, const int* in_sizes, int n_in, void* d_out, int out_size, void* d_ws, size_t ws_size, hipStream_t stream) {
    P p{};
    p.x = (const float*)d_in[0]; p.c = (const float*)d_in[1]; p.pos = (const int*)d_in[2]; p.ada_w = (const float*)d_in[3]; p.ada_b = (const float*)d_in[4];
    p.n1g = (const float*)d_in[5]; p.n2g = (const float*)d_in[6]; p.w_in = (const float*)d_in[7]; p.w_out = (const float*)d_in[8]; p.conv_w = (const float*)d_in[9];
    p.conv_b = (const float*)d_in[10]; p.cln_g = (const float*)d_in[11]; p.cln_b = (const float*)d_in[12]; p.sln_g = (const float*)d_in[13]; p.sln_b = (const float*)d_in[14];
    p.sgu_w = (const float*)d_in[15]; p.sgu_b = (const float*)d_in[16]; p.nsa_qg = (const float*)d_in[17]; p.nsa_kg = (const float*)d_in[18]; p.cmp_pos = (const float*)d_in[19];
    p.cmp_w1 = (const float*)d_in[20]; p.cmp_w2 = (const float*)d_in[21]; p.dsa_qg = (const float*)d_in[22]; p.dsa_kg = (const float*)d_in[23]; p.peer_wq = (const float*)d_in[24];
    p.peer_sk = (const float*)d_in[25]; p.peer_u = (const float*)d_in[26]; p.peer_v = (const float*)d_in[27];
    p.out = (float*)d_out;
    p.ws = (char*)d_ws; const size_t off = WS_TOTAL;
    if (off > ws_size) { fprintf(stderr, "workspace too small: need %zu have %zu\n", off, ws_size); return; }
#ifndef MULTI_LAUNCH
    static int grid_blocks = 0;
    if (!grid_blocks) {
        int dev = 0, cus = 0, per_cu = 0;
        (void)hipGetDevice(&dev);
        (void)hipDeviceGetAttribute(&cus, hipDeviceAttributeMultiprocessorCount, dev);
        (void)hipOccupancyMaxActiveBlocksPerMultiprocessor(&per_cu, k_mega, NTHREADS, 0);
        if (per_cu > 2) per_cu = 2;
        grid_blocks = cus * per_cu;
    }
    (void)hipMemsetAsync(p.bar(), 0, (size_t)CTRL_WORDS * 4, stream);
    void* args[] = {&p};
    hipError_t e = hipLaunchCooperativeKernel((void*)k_mega, dim3(grid_blocks), dim3(NTHREADS), args, 0, stream);
    if (e != hipSuccess) fprintf(stderr, "cooperative launch failed: %s (grid %d)\n", hipGetErrorString(e), grid_blocks);
#else
    launch_stage<S_CONVT_IN>(p, 0, stream); launch_stage<S_CONVT_OUT>(p, 0, stream); launch_stage<S_CONVT_Q>(p, 0, stream); launch_stage<S_CONVT_W1>(p, 0, stream); launch_stage<S_CALIB>(p, 0, stream);
    launch_stage<S_TAB_U>(p, 0, stream); launch_stage<S_TAB_V>(p, 0, stream);
    launch_stage<S_ADA>(p, 0, stream); launch_stage<S_ROPE>(p, 0, stream);
    for (int layer = 0; layer < NL; ++layer) {
        launch_stage<S_NORM1>(p, layer, stream); launch_stage<S_GEMM_IN>(p, layer, stream);
        launch_stage<S_CONV>(p, layer, stream); launch_stage<S_SGU>(p, layer, stream); launch_stage<S_VTRANS>(p, layer, stream);
        launch_stage<S_PREP>(p, layer, stream); launch_stage<S_COMPRESS>(p, layer, stream);
        launch_stage<S_NSA_CMP>(p, layer, stream); launch_stage<S_DSA_INDEX>(p, layer, stream);
        launch_stage<S_NSA_ATTN>(p, layer, stream); launch_stage<S_DSA_ATTN>(p, layer, stream);
        launch_stage<S_GEMM_OUT>(p, layer, stream); launch_stage<S_NORM2>(p, layer, stream); launch_stage<S_GEMM_Q>(p, layer, stream);
        launch_stage<S_PEER_TOPK>(p, layer, stream); launch_stage<S_PEER_GATHER>(p, layer, stream);
    }
#endif
}
```
